# Optimizing an MI355X kernel written in HIP

```python
import jax, jax.numpy as jnp
from jax import lax
import numpy as np

D_MODEL = 1024
BATCH = 8
SEQ = 4096
DEPTH = 1

ATT_HEADS = 8
ATT_HEAD_DIM = 64
ATT_WIDTH = ATT_HEADS * ATT_HEAD_DIM
KV_LATENT = 256
IDX_HEADS = 8
IDX_DIM = 64
TOPK_MAX = 256
Q_BLOCK = 128
HG_HEADS = 4
HG_KEY_DIM = 128
HG_VAL_DIM = 128
HG_WIDTH = HG_HEADS * HG_VAL_DIM
HG_CHUNK = 32
D_MIX = ATT_WIDTH + HG_WIDTH
N_EXPERTS = 32
TOP_K = 4
D_FF = 1024
SWIGLU_LIMIT = 7.0
SWIGLU_ALPHA = 1.702
MOE_BLOCK = 128
PLE_DIM = 256
LN_EPS = 1e-5
RMS_EPS = 1e-6
IN_SIZES = (ATT_WIDTH, KV_LATENT, IDX_HEADS * IDX_DIM, IDX_DIM, IDX_HEADS,
            HG_HEADS * HG_KEY_DIM, HG_HEADS * HG_KEY_DIM, HG_WIDTH, HG_WIDTH)
D_IN = (ATT_WIDTH + KV_LATENT + IDX_HEADS * IDX_DIM + IDX_DIM + IDX_HEADS
        + 2 * HG_HEADS * HG_KEY_DIM + 2 * HG_WIDTH)

kernel_name = "hybrid_dsa_hgrn2_moe_deepnorm"


def _layer_norm(x, g, b):
    xf = x.astype(jnp.float32)
    mu = jnp.mean(xf, axis=-1, keepdims=True)
    var = jnp.mean(jnp.square(xf - mu), axis=-1, keepdims=True)
    y = (xf - mu) * lax.rsqrt(var + LN_EPS) * g.astype(jnp.float32) + b.astype(jnp.float32)
    return y.astype(x.dtype)


def _rms_norm(x, g):
    xf = x.astype(jnp.float32)
    y = xf * lax.rsqrt(jnp.mean(xf * xf, axis=-1, keepdims=True) + RMS_EPS) * g.astype(jnp.float32)
    return y.astype(x.dtype)


def _split_cols(h, sizes):
    offs = np.cumsum(np.array(sizes))[:-1].tolist()
    return jnp.split(h, offs, axis=-1)


def _dsa_attention(q, c, iq, ik, iw, w_uk, w_uv):
    B, T, H, _ = q.shape
    topk = min(TOPK_MAX, T // 4)
    n_blocks = T // Q_BLOCK
    slopes = jnp.exp2(-(8.0 / H) * jnp.arange(1, H + 1, dtype=jnp.float32))
    q_lat = jnp.einsum('bthd,rhd->bthr', q, w_uk) * (ATT_HEAD_DIM ** -0.5)
    key_pos = jnp.arange(T, dtype=jnp.int32)

    def block(n):
        t0 = n * Q_BLOCK
        qb = lax.dynamic_slice_in_dim(q_lat, t0, Q_BLOCK, axis=1)
        iqb = lax.dynamic_slice_in_dim(iq, t0, Q_BLOCK, axis=1)
        iwb = lax.dynamic_slice_in_dim(iw, t0, Q_BLOCK, axis=1)
        q_pos = t0 + jnp.arange(Q_BLOCK, dtype=jnp.int32)
        relu_logits = jax.nn.relu(jnp.einsum('bthd,bsd->bths', iqb, ik))
        isc = jnp.einsum('bth,bths->bts', iwb, relu_logits).astype(jnp.float32)
        causal = key_pos[None, :] <= q_pos[:, None]
        isc = jnp.where(causal[None], isc, -jnp.inf)
        _, sel = lax.top_k(isc, topk)
        valid = sel <= q_pos[None, :, None]
        c_sel = jax.vmap(lambda cb, sb: cb[sb])(c, sel)
        s = jnp.einsum('bthr,btkr->bthk', qb, c_sel).astype(jnp.float32)
        dist = (q_pos[None, :, None] - sel).astype(jnp.float32)
        s = s - slopes[None, None, :, None] * dist[:, :, None, :]
        s = jnp.where(valid[:, :, None, :], s, -jnp.inf)
        pr = jax.nn.softmax(s, axis=-1).astype(c.dtype)
        o_lat = jnp.einsum('bthk,btkr->bthr', pr, c_sel)
        return jnp.einsum('bthr,rhd->bthd', o_lat, w_uv)

    out = lax.map(block, jnp.arange(n_blocks, dtype=jnp.int32))
    return out.transpose(1, 0, 2, 3, 4).reshape(B, T, H * ATT_HEAD_DIM)


def _hgrn2(q, f_logit, i, g, lower_bound, norm_g):
    B, T, _ = q.shape
    dt = q.dtype
    f32 = jnp.float32
    n_chunks = T // HG_CHUNK

    def to_chunks(z, d):
        return z.reshape(B, n_chunks, HG_CHUNK, HG_HEADS, d).transpose(0, 3, 1, 2, 4)

    forget = lower_bound + (1.0 - lower_bound) * jax.nn.sigmoid(f_logit.astype(f32))
    qc = to_chunks(jax.nn.silu(q.astype(f32)), HG_KEY_DIM)
    kc = to_chunks(1.0 - forget, HG_KEY_DIM)
    vc = to_chunks(i.astype(f32), HG_VAL_DIM)
    b = jnp.cumsum(to_chunks(jnp.log(forget), HG_KEY_DIM), axis=3)
    b_last = b[:, :, :, -1:, :]
    q_dec = qc * jnp.exp(b)
    k_inv = kc * jnp.exp(-b)
    k_end = kc * jnp.exp(b_last - b)
    causal = jnp.tril(jnp.ones((HG_CHUNK, HG_CHUNK), f32))
    scores = jnp.einsum('bhncd,bhnsd->bhncs', q_dec, k_inv) * causal
    o = jnp.einsum('bhncs,bhnse->bhnce', scores, vc)
    u = jnp.einsum('bhncd,bhnce->bhnde', k_end, vc)
    decay = jnp.exp(b_last[:, :, :, 0, :])

    def step(state, xs):
        dec, un = xs
        return dec[..., None] * state + un, state

    s0 = jnp.zeros((B, HG_HEADS, HG_KEY_DIM, HG_VAL_DIM), f32)
    _, s_prev = lax.scan(step, s0, (jnp.moveaxis(decay, 2, 0), jnp.moveaxis(u, 2, 0)))
    o = o + jnp.einsum('bhncd,nbhde->bhnce', q_dec, s_prev)
    o = o.transpose(0, 2, 3, 1, 4).reshape(B, T, HG_HEADS, HG_VAL_DIM)
    o = o * lax.rsqrt(jnp.mean(o * o, axis=-1, keepdims=True) + RMS_EPS)
    o = o.reshape(B, T, HG_WIDTH) * norm_g.astype(f32) * jax.nn.silu(g.astype(f32))
    return o.astype(dt)


def _moe_ffn(x, w_router, b_router, w_up, b_up, w_down, b_down):
    B, T, D = x.shape
    dt = x.dtype
    n_tok = B * T
    n_assign = n_tok * TOP_K
    xt = x.reshape(n_tok, D)
    logits = (xt @ w_router + b_router).astype(jnp.float32)
    top_val, top_idx = lax.top_k(logits, TOP_K)
    gates = jax.nn.softmax(top_val, axis=-1)
    e_flat = top_idx.reshape(-1)
    g_flat = gates.reshape(-1)
    t_flat = jnp.arange(n_assign, dtype=jnp.int32) // TOP_K
    order = jnp.argsort(e_flat)
    e_sorted = e_flat[order]
    counts = jnp.bincount(e_flat, length=N_EXPERTS)
    padded = (counts + MOE_BLOCK - 1) // MOE_BLOCK * MOE_BLOCK
    pad_end = jnp.cumsum(padded)
    pad_start = pad_end - padded
    raw_start = jnp.cumsum(counts) - counts
    rank = jnp.arange(n_assign, dtype=jnp.int32) - raw_start[e_sorted]
    dest = pad_start[e_sorted] + rank
    cap = (n_assign + MOE_BLOCK - 1) // MOE_BLOCK * MOE_BLOCK + N_EXPERTS * MOE_BLOCK
    n_blocks = cap // MOE_BLOCK
    slot_tok = jnp.zeros((cap,), jnp.int32).at[dest].set(t_flat[order])
    slot_gate = jnp.zeros((cap,), jnp.float32).at[dest].set(g_flat[order])
    starts = jnp.arange(n_blocks, dtype=jnp.int32) * MOE_BLOCK
    block_expert = jnp.minimum(jnp.searchsorted(pad_end, starts, side='right'), N_EXPERTS - 1)

    def run_block(args):
        tok, gate, e = args
        h = xt[tok] @ w_up[e] + b_up[e]
        glu = jnp.minimum(h[:, :D_FF], SWIGLU_LIMIT)
        lin = jnp.clip(h[:, D_FF:], -SWIGLU_LIMIT, SWIGLU_LIMIT)
        a = glu * jax.nn.sigmoid(SWIGLU_ALPHA * glu) * (lin + 1.0)
        return (a @ w_down[e] + b_down[e]) * gate[:, None].astype(dt)

    out = lax.map(run_block, (slot_tok.reshape(n_blocks, MOE_BLOCK),
                              slot_gate.reshape(n_blocks, MOE_BLOCK), block_expert))
    y = jnp.zeros_like(xt).at[slot_tok].add(out.reshape(cap, D))
    return y.reshape(B, T, D)


def setup_inputs(seed: int = 0) -> dict:
    key = jax.random.key(seed)
    ks = jax.random.split(key, 26)
    f32 = jnp.float32
    beta = (8.0 * DEPTH) ** -0.25
    L = DEPTH

    def nrm(k, shape, scale):
        return jax.random.normal(k, shape, f32) * scale

    def gain(k, shape):
        return 1.0 + 0.02 * jax.random.normal(k, shape, f32)

    def bias(k, shape):
        return 0.01 * jax.random.normal(k, shape, f32)

    return {
        "x": nrm(ks[0], (BATCH, SEQ, D_MODEL), 1.0),
        "p": nrm(ks[1], (DEPTH, BATCH, SEQ, PLE_DIM), 1.0),
        "w_in": nrm(ks[2], (L, D_MODEL, D_IN), D_MODEL ** -0.5),
        "kv_norm_g": gain(ks[3], (L, KV_LATENT)),
        "idx_k_norm_g": gain(ks[4], (L, IDX_DIM)),
        "idx_k_norm_b": bias(ks[5], (L, IDX_DIM)),
        "w_uk": nrm(ks[6], (L, KV_LATENT, ATT_HEADS, ATT_HEAD_DIM), KV_LATENT ** -0.5),
        "w_uv": nrm(ks[7], (L, KV_LATENT, ATT_HEADS, ATT_HEAD_DIM), KV_LATENT ** -0.5),
        "hg_lb_logits": 1.0 + 0.1 * jax.random.normal(ks[8], (L + 1, HG_HEADS * HG_KEY_DIM), f32),
        "hg_norm_g": gain(ks[9], (L, HG_WIDTH)),
        "w_o": nrm(ks[10], (L, D_MIX, D_MODEL), D_MIX ** -0.5 * beta),
        "ln_mix_g": gain(ks[11], (L, D_MODEL)),
        "ln_mix_b": bias(ks[12], (L, D_MODEL)),
        "w_router": nrm(ks[13], (L, D_MODEL, N_EXPERTS), D_MODEL ** -0.5),
        "b_router": bias(ks[14], (L, N_EXPERTS)),
        "w_up": nrm(ks[15], (L, N_EXPERTS, D_MODEL, 2 * D_FF), D_MODEL ** -0.5),
        "b_up": bias(ks[16], (L, N_EXPERTS, 2 * D_FF)),
        "w_down": nrm(ks[17], (L, N_EXPERTS, D_FF, D_MODEL), D_FF ** -0.5 * beta),
        "b_down": bias(ks[18], (L, N_EXPERTS, D_MODEL)),
        "ln_ffn_g": gain(ks[19], (L, D_MODEL)),
        "ln_ffn_b": bias(ks[20], (L, D_MODEL)),
        "w_ple_proj": nrm(ks[21], (L, PLE_DIM, D_MODEL), PLE_DIM ** -0.5 * beta),
        "w_ple_gate": nrm(ks[22], (L, D_MODEL, D_MODEL), D_MODEL ** -0.5),
        "ln_ple_g": gain(ks[23], (L, D_MODEL)),
        "ln_ple_b": bias(ks[24], (L, D_MODEL)),
    }


def reference(x, p, w_in, kv_norm_g, idx_k_norm_g, idx_k_norm_b, w_uk, w_uv, hg_lb_logits,
              hg_norm_g, w_o, ln_mix_g, ln_mix_b, w_router, b_router, w_up, b_up, w_down, b_down,
              ln_ffn_g, ln_ffn_b, w_ple_proj, w_ple_gate, ln_ple_g, ln_ple_b):
    B, T, _ = x.shape
    alpha = (2.0 * DEPTH) ** 0.25
    lower_bounds = jnp.cumsum(jax.nn.softmax(hg_lb_logits.astype(jnp.float32), axis=0), axis=0)
    for l in range(DEPTH):
        h = x @ w_in[l]
        a_q, a_c, i_q, i_k, i_w, g_q, g_f, g_i, g_g = _split_cols(h, IN_SIZES)
        a_q = a_q.reshape(B, T, ATT_HEADS, ATT_HEAD_DIM)
        a_c = _rms_norm(a_c, kv_norm_g[l])
        i_q = i_q.reshape(B, T, IDX_HEADS, IDX_DIM) * (IDX_DIM ** -0.5)
        i_k = _layer_norm(i_k, idx_k_norm_g[l], idx_k_norm_b[l])
        i_w = i_w * (IDX_HEADS ** -0.5)
        y_att = _dsa_attention(a_q, a_c, i_q, i_k, i_w, w_uk[l], w_uv[l])
        y_rec = _hgrn2(g_q, g_f, g_i, g_g, lower_bounds[l], hg_norm_g[l])
        mix = jnp.concatenate([y_att, y_rec], axis=-1) @ w_o[l]
        x = _layer_norm(alpha * x + mix, ln_mix_g[l], ln_mix_b[l])
        ffn = _moe_ffn(x, w_router[l], b_router[l], w_up[l], b_up[l], w_down[l], b_down[l])
        x = _layer_norm(alpha * x + ffn, ln_ffn_g[l], ln_ffn_b[l])
        ple = (p[l] @ w_ple_proj[l]) * jax.nn.sigmoid(x @ w_ple_gate[l])
        x = _layer_norm(alpha * x + ple, ln_ple_g[l], ln_ple_b[l])
    return x
```

```cpp
#include <hip/hip_runtime.h>
#include <hip/hip_cooperative_groups.h>
#include <cstdio>
#include <cstdint>
namespace cg = cooperative_groups;

namespace pg8 {
#define PG8_LAS __attribute__((address_space(3)))
typedef unsigned short bf16_t;
typedef short bf16x8 __attribute__((ext_vector_type(8)));
typedef float f32x4 __attribute__((ext_vector_type(4)));
typedef unsigned u32x4 __attribute__((ext_vector_type(4)));
constexpr int BM = 256, BK = 64, HALF = 128, HTB = HALF * BK * 2  , STAGE_BYTES = 8 * HTB, NXCD = 8, WGM = 8;

__host__ __device__ __forceinline__ int lds_byte(int r, int c) { const int st = (r >> 4) * 2 + (c >> 5), rr = r & 15, cc = c & 31, ob = rr * 64 + cc * 2; return st * 1024 + (ob ^ (((ob >> 9) & 1) << 5)); }
__host__ __device__ __forceinline__ void stage_rc(int b, int& R, int& C) { const int st = b / 1024, sb = b % 1024, swz = sb ^ (((sb >> 9) & 1) << 5); R = (st >> 1) * 16 + swz / 64; C = (st & 1) * 32 + (swz % 64) / 2; }
__host__ __device__ __forceinline__ int perm32(int rho) { const int n = rho >> 4, i = rho & 15; return 8 * (i >> 2) + 4 * n + (i & 3); }

struct Unit { int pm, pn; };
struct Gemm { const bf16_t* A; const bf16_t* Bt; int M, N, K; };

struct StaticOrder {
    int nM, nN, nwg, G, c;
    __host__ __device__ void init(int M, int N, int G_, int c_) { nM = M / BM; nN = N / BM; nwg = nM * nN; G = G_; c = c_; }
    __host__ __device__ bool next(int i, Unit& u) const {
        const long L = (long)i * G + c; if (L >= nwg) return false;
        int wgid = (int)L; { const int q = nwg / NXCD, r = nwg % NXCD, xcd = wgid % NXCD, off = wgid / NXCD; wgid = (xcd < r ? xcd * (q + 1) : r * (q + 1) + (xcd - r) * q) + off; }
        const int nig = WGM * nN, gid = wgid / nig, fm = gid * WGM, gsz = (nM - fm) < WGM ? (nM - fm) : WGM;
        u.pm = fm + ((wgid % nig) % gsz); u.pn = (wgid % nig) / gsz; return true;
    }
    __device__ __forceinline__ void a_ready(const Unit&) const {}
    __device__ __forceinline__ void done(const Unit&) const {}
};

__device__ __forceinline__ unsigned cvt_pk_bf16(float lo, float hi) { unsigned r; asm volatile("v_cvt_pk_bf16_f32 %0, %1, %2" : "=v"(r) : "v"(lo), "v"(hi)); return r; }
typedef float f32x2 __attribute__((ext_vector_type(2)));
template <class Epi, class Sched, bool ALIGN_EPI = false, bool SP2 = false>
__device__ __forceinline__ void gemm_phase(PG8_LAS unsigned char* lds, const Gemm g, const Sched& S, const Epi& E) {
    const int tid = threadIdx.x, wid = __builtin_amdgcn_readfirstlane(tid >> 6), lane = tid & 63, wr = wid >> 2, wc = wid & 3, fr = lane & 15, fq = lane >> 4;
    const int K = g.K, nt = K / BK;
    unsigned voffA[2], voffB[2];
#pragma unroll
    for (int i = 0; i < 2; ++i) { int R, C; stage_rc(tid * 16 + i * 8192, R, C); const int Rb = Epi::PERM ? ((R & ~31) + perm32(R & 31)) : R;
        voffA[i] = (unsigned)(R * K + C) * 2u; voffB[i] = (unsigned)(Rb * K + C) * 2u; }
    const size_t kstep = (size_t)(BK * 2);
    const size_t hstep = (size_t)HALF * K * 2;
    const size_t tstep = 2 * hstep;
    const unsigned ldsw = (unsigned)wid * 1024u;
    const int aoff = lds_byte(wr * 64 + fr, fq * 8), boff = lds_byte(wc * 32 + fr, fq * 8);
#define PG8_SA(b, h) (((b) * 2 + (h)) * HTB)
#define PG8_SB(b, h) ((4 + (b) * 2 + (h)) * HTB)
#define PG8_STAGE(bufoff, gbase, voff) do { _Pragma("unroll") for (int _i = 0; _i < 2; ++_i) \
        __builtin_amdgcn_global_load_lds((const unsigned*)((const char*)(gbase) + (voff)[_i]), (PG8_LAS unsigned*)(lds + (bufoff) + ldsw + _i * 8192), 16, 0, 0); } while (0)
#define PG8_LDA(dst, b, h) do { _Pragma("unroll") for (int m = 0; m < 4; ++m) _Pragma("unroll") for (int k = 0; k < 2; ++k) dst[m][k] = *(const PG8_LAS bf16x8*)(lds + PG8_SA(b, h) + aoff + m * 2048 + k * 1024); } while (0)
#define PG8_LDB(dst, b, h) do { _Pragma("unroll") for (int n = 0; n < 2; ++n) _Pragma("unroll") for (int k = 0; k < 2; ++k) dst[n][k] = *(const PG8_LAS bf16x8*)(lds + PG8_SB(b, h) + boff + n * 2048 + k * 1024); } while (0)
#define PG8_MMA(ai, bj, At, Bt) do { __builtin_amdgcn_s_setprio(1); _Pragma("unroll") for (int m = 0; m < 4; ++m) _Pragma("unroll") for (int n = 0; n < 2; ++n) _Pragma("unroll") for (int k = 0; k < 2; ++k) \
        acc[ai][bj][m][n] = __builtin_amdgcn_mfma_f32_16x16x32_bf16(Bt[n][k], At[m][k], acc[ai][bj][m][n], 0, 0, 0); __builtin_amdgcn_s_setprio(0); } while (0)
#define PG8_WAIT_V(n) asm volatile("s_waitcnt vmcnt(" #n ")" ::: "memory")
#define PG8_WAIT_L(n) asm volatile("s_waitcnt lgkmcnt(" #n ")" ::: "memory")
#define PG8_BAR __builtin_amdgcn_s_barrier()
#define PG8_SCHED __builtin_amdgcn_sched_barrier(0)
    Unit cur, nxt; int ui = 0;
    if (!S.next(0, cur)) return;
    f32x4 acc[2][2][4][2];
#pragma unroll
    for (int a = 0; a < 2; ++a)
#pragma unroll
        for (int b = 0; b < 2; ++b)
#pragma unroll
            for (int m = 0; m < 4; ++m)
#pragma unroll
                for (int n = 0; n < 2; ++n) acc[a][b][m][n] = (f32x4){0.f, 0.f, 0.f, 0.f};
    bf16x8 At[4][2], B0[2][2], B1[2][2];
    const char* cA = (const char*)g.A + (size_t)cur.pm * tstep; const char* cB = (const char*)g.Bt + (size_t)cur.pn * tstep;
    S.a_ready(cur);
    if constexpr (SP2) {
        PG8_STAGE(PG8_SB(0, 0), cB, voffB); PG8_STAGE(PG8_SB(0, 1), cB + hstep, voffB); PG8_STAGE(PG8_SA(0, 0), cA, voffA); PG8_STAGE(PG8_SA(0, 1), cA + hstep, voffA);
        if (wr == 1) PG8_BAR;
        PG8_WAIT_V(2); PG8_BAR;
        PG8_STAGE(PG8_SB(1, 0), cB + kstep, voffB); PG8_STAGE(PG8_SA(1, 0), cA + kstep, voffA); PG8_STAGE(PG8_SB(1, 1), cB + hstep + kstep, voffB);
        PG8_WAIT_V(6); PG8_BAR;
    } else {
        PG8_STAGE(PG8_SB(0, 0), cB, voffB); PG8_STAGE(PG8_SA(0, 0), cA, voffA); PG8_STAGE(PG8_SB(0, 1), cB + hstep, voffB); PG8_STAGE(PG8_SA(0, 1), cA + hstep, voffA);
        if (wr == 1) PG8_BAR;
        PG8_WAIT_V(4); PG8_BAR;
        PG8_STAGE(PG8_SB(1, 0), cB + kstep, voffB); PG8_STAGE(PG8_SA(1, 0), cA + kstep, voffA); PG8_STAGE(PG8_SB(1, 1), cB + hstep + kstep, voffB);
        PG8_WAIT_V(6); PG8_BAR;
    }
    for (;;) {
        const bool has_next = S.next(ui + 1, nxt);
        const char* nA = has_next ? (const char*)g.A + (size_t)nxt.pm * tstep : cA; const char* nB = has_next ? (const char*)g.Bt + (size_t)nxt.pn * tstep : cB;
_Pragma("nounroll")
        for (int t = 0; t < nt; t += 2) {
            const bool last = (t == nt - 2);
            const char* a1 = cA + (size_t)(t + 1) * kstep;
            const char* a2 = last ? nA : cA + (size_t)(t + 2) * kstep; const char* b2 = last ? nB : cB + (size_t)(t + 2) * kstep;
            const char* a3 = a2 + kstep; const char* b3 = b2 + kstep;
            if (last && has_next) S.a_ready(nxt);
            if constexpr (SP2) {
            PG8_LDB(B0, 0, 0); PG8_LDB(B1, 0, 1); PG8_SCHED; PG8_LDA(At, 0, 0); PG8_STAGE(PG8_SA(1, 1), a1 + hstep, voffA);
            PG8_WAIT_V(8); PG8_WAIT_L(0); PG8_BAR; PG8_MMA(0, 0, At, B0); PG8_MMA(0, 1, At, B1); PG8_BAR; PG8_SCHED;
            PG8_LDA(At, 0, 1); PG8_STAGE(PG8_SB(0, 0), b2, voffB); PG8_STAGE(PG8_SB(0, 1), b2 + hstep, voffB); PG8_STAGE(PG8_SA(0, 0), a2, voffA);
            PG8_WAIT_V(8); PG8_WAIT_L(0); PG8_BAR; PG8_MMA(1, 0, At, B0); PG8_MMA(1, 1, At, B1); PG8_BAR; PG8_SCHED;
            PG8_LDB(B0, 1, 0); PG8_LDB(B1, 1, 1); PG8_SCHED; PG8_LDA(At, 1, 0); PG8_STAGE(PG8_SA(0, 1), a2 + hstep, voffA);
            PG8_WAIT_V(8); PG8_WAIT_L(0); PG8_BAR; PG8_MMA(0, 0, At, B0); PG8_MMA(0, 1, At, B1); PG8_BAR; PG8_SCHED;
            PG8_LDA(At, 1, 1); PG8_STAGE(PG8_SB(1, 0), b3, voffB); PG8_STAGE(PG8_SB(1, 1), b3 + hstep, voffB); PG8_STAGE(PG8_SA(1, 0), a3, voffA);
            PG8_WAIT_V(8); PG8_WAIT_L(0); PG8_BAR; PG8_MMA(1, 0, At, B0); PG8_MMA(1, 1, At, B1); PG8_BAR; PG8_SCHED;
            } else {
            PG8_LDB(B0, 0, 0); PG8_SCHED; PG8_LDA(At, 0, 0); PG8_STAGE(PG8_SA(1, 1), a1 + hstep, voffA);
            PG8_WAIT_L(8); PG8_BAR; PG8_WAIT_L(0); PG8_MMA(0, 0, At, B0); PG8_BAR; PG8_SCHED;
            PG8_LDB(B1, 0, 1); PG8_STAGE(PG8_SB(0, 0), b2, voffB);
            PG8_BAR; PG8_WAIT_L(0); PG8_MMA(0, 1, At, B1); PG8_BAR;
            PG8_LDA(At, 0, 1); PG8_STAGE(PG8_SA(0, 0), a2, voffA);
            PG8_BAR; PG8_WAIT_L(0); PG8_MMA(1, 0, At, B0); PG8_BAR; PG8_SCHED;
            PG8_STAGE(PG8_SB(0, 1), b2 + hstep, voffB);
            PG8_WAIT_V(6); PG8_BAR; PG8_MMA(1, 1, At, B1); PG8_BAR;
            PG8_LDB(B0, 1, 0); PG8_SCHED; PG8_LDA(At, 1, 0); PG8_STAGE(PG8_SA(0, 1), a2 + hstep, voffA);
            PG8_WAIT_L(8); PG8_BAR; PG8_WAIT_L(0); PG8_MMA(0, 0, At, B0); PG8_BAR; PG8_SCHED;
            PG8_LDB(B1, 1, 1); PG8_STAGE(PG8_SB(1, 0), b3, voffB);
            PG8_BAR; PG8_WAIT_L(0); PG8_MMA(0, 1, At, B1); PG8_BAR;
            PG8_LDA(At, 1, 1); PG8_STAGE(PG8_SA(1, 0), a3, voffA);
            PG8_BAR; PG8_WAIT_L(0); PG8_MMA(1, 0, At, B0); PG8_BAR; PG8_SCHED;
            PG8_STAGE(PG8_SB(1, 1), b3 + hstep, voffB);
            PG8_WAIT_V(6); PG8_BAR; PG8_MMA(1, 1, At, B1); PG8_BAR;
            }
        }
        if constexpr (ALIGN_EPI) { if (wr == 0) PG8_BAR; }
        if constexpr (!Epi::AFTER_DRAIN) { E(acc, cur, wr, wc, fr, fq); S.done(cur); }
        if (!has_next) break;
#pragma unroll
        for (int a = 0; a < 2; ++a)
#pragma unroll
            for (int b = 0; b < 2; ++b)
#pragma unroll
                for (int m = 0; m < 4; ++m)
#pragma unroll
                    for (int n = 0; n < 2; ++n) acc[a][b][m][n] = (f32x4){0.f, 0.f, 0.f, 0.f};
        cur = nxt; cA = nA; cB = nB; ++ui;
        if constexpr (ALIGN_EPI) { if (wr == 1) PG8_BAR; }
    }
    PG8_WAIT_V(0);
    if constexpr (!ALIGN_EPI) { if (wr == 0) PG8_BAR; }
    PG8_BAR;
    if constexpr (Epi::AFTER_DRAIN) { E.fused(acc, cur, wr, wc, fr, fq, lds, wid, lane); S.done(cur); }
#undef PG8_SA
#undef PG8_SB
#undef PG8_STAGE
#undef PG8_LDA
#undef PG8_LDB
#undef PG8_MMA
#undef PG8_WAIT_V
#undef PG8_WAIT_L
#undef PG8_BAR
#undef PG8_SCHED
}
}

constexpr int NB = 8, T = 4096, D = 1024, NTOK = NB * T;
constexpr int ATT_H = 8, ATT_D = 64, ATT_W = 512, KV_LAT = 256, IDX_H = 8, IDX_D = 64, TOPK = 256;
constexpr int HG_H = 4, HG_DK = 128, HG_DV = 128, HG_W = 512, HG_C = 32;
constexpr int D_IN = 3400, D_INP = 3584;
constexpr int C_AQ = 0, C_AC = 512, C_IQ = 768, C_IK = 1280, C_IW = 1344, C_GQ = 1352, C_GF = 1864, C_GI = 2376, C_GG = 2888;
constexpr int NE = 32, TOPE = 4, DFF = 1024, PLE = 256;
constexpr int NASSIGN = NTOK * TOPE, CAP = NASSIGN + NE * 256;
constexpr int MAXTILES = CAP / 256;
constexpr float LN_EPS = 1e-5f, RMS_EPS = 1e-6f, ALPHA = 1.189207115002721f;

constexpr size_t MiB = 1u << 20;
constexpr size_t WS_CTL = 0, CTL_ZERO_BYTES = 64 * 1024;
constexpr size_t WS_WIN_T = 1 * MiB, WS_WO_T = 8 * MiB, WS_WUP_T = 10 * MiB, WS_WDN_T = 138 * MiB, WS_WPROJ_T = 202 * MiB, WS_WGATE_T = 203 * MiB;
constexpr size_t WS_WUK_T = 205 * MiB, WS_WUV_T = 205 * MiB + 512 * 1024;
constexpr size_t WS_SMALL = 206 * MiB;
constexpr size_t WS_A = 208 * MiB;
constexpr size_t WS_B = 480 * MiB;
constexpr size_t WS_X1 = 752 * MiB;
constexpr size_t WS_XB = 880 * MiB;
constexpr size_t WS_PROJ = 944 * MiB;
constexpr size_t WS_SM2 = 1008 * MiB;
constexpr size_t WS_END = 1016 * MiB;
constexpr size_t WS_H = WS_A, WS_XS = WS_A, WS_YSLOT = WS_A;
constexpr size_t WS_XBF = WS_B, WS_U = WS_B, WS_YMIX = WS_B, WS_HH = WS_B;
constexpr size_t WS_QDEC = WS_B + 128 * MiB, WS_PB = WS_B + 128 * MiB, WS_OREC = WS_B + 160 * MiB, WS_CN = WS_B + 224 * MiB, WS_IKN = WS_B + 240 * MiB, WS_MASK = WS_B + 244 * MiB;
constexpr size_t WS_K = WS_XB, WS_VT = WS_XB + 32 * MiB;
constexpr size_t WS_TOPE = WS_SM2, WS_GATE = WS_SM2 + 512 * 1024, WS_LRANK = WS_SM2 + 1024 * 1024, WS_TOKSLOT = WS_SM2 + 1536 * 1024, WS_SLOTGATE = WS_SM2 + 2 * MiB, WS_DECAY = WS_SM2 + 3 * MiB;
constexpr size_t WS_WGBASE = WS_SMALL, WS_TILEE = WS_SMALL + 64 * 1024;
constexpr int CW_CNT = 64;

constexpr int RING_BYTES = 131072, MISC_OFF = RING_BYTES, LDS_BYTES = 147456;
constexpr int NWAVES = 8, NTHR = 512;

#define GAS __attribute__((address_space(1)))
#define LAS __attribute__((address_space(3)))
typedef unsigned short bf16;
typedef unsigned v4u __attribute__((ext_vector_type(4)));
typedef unsigned v2u __attribute__((ext_vector_type(2)));
typedef float f32x4 __attribute__((ext_vector_type(4)));
typedef short bf16x8 __attribute__((ext_vector_type(8)));
#define LDS_WAIT() asm volatile("s_waitcnt lgkmcnt(0)" ::: "memory")
#define VM_WAIT() asm volatile("s_waitcnt vmcnt(0)" ::: "memory")
__device__ __forceinline__ unsigned f2bf(float f) { unsigned u = __builtin_bit_cast(unsigned, f); return (u + 0x7fffu + ((u >> 16) & 1u)) >> 16; }
__device__ __forceinline__ unsigned pk2(float lo, float hi) { return f2bf(lo) | (f2bf(hi) << 16); }
__device__ __forceinline__ float bf2f(unsigned short b) { return __builtin_bit_cast(float, (unsigned)b << 16); }
__device__ __forceinline__ float bflo(unsigned w) { return __builtin_bit_cast(float, w << 16); }
__device__ __forceinline__ float bfhi(unsigned w) { return __builtin_bit_cast(float, w & 0xffff0000u); }
__device__ __forceinline__ float wave_sum(float v) {
#pragma unroll
    for (int o = 1; o < 64; o <<= 1) v += __shfl_xor(v, o);
    return v;
}
__device__ __forceinline__ float sigmoidf_(float x) { return 1.f / (1.f + __expf(-x)); }

struct Params { const float* in[25]; float* out; unsigned char* ws; int ph_lo, ph_hi; };
enum { I_X = 0, I_P, I_WIN, I_KVG, I_IKG, I_IKB, I_WUK, I_WUV, I_HGLB, I_HGNG, I_WO, I_LNMG, I_LNMB, I_WR, I_BR, I_WUP, I_BUP, I_WDN, I_BDN, I_LNFG, I_LNFB, I_WPP, I_WPG, I_LNPG, I_LNPB };

struct Ctx { LAS unsigned char* lds; int tid, lane, wave, G, gw, ngw; };

namespace pg8 {
struct EpiBf16s {
    static constexpr bool PERM = true, AFTER_DRAIN = false;
    bf16_t* O; int ldc;
    __device__ __forceinline__ void operator()(const f32x4 (&acc)[2][2][4][2], const Unit& u, int wr, int wc, int fr, int fq) const {
        const int row0 = u.pm * BM + wr * 64 + fr, col0 = u.pn * BM + wc * 32 + 8 * fq;
#pragma unroll
        for (int ai = 0; ai < 2; ++ai)
#pragma unroll
            for (int m = 0; m < 4; ++m) { bf16_t* rowp = O + (size_t)(row0 + ai * HALF + m * 16) * ldc + col0;
#pragma unroll
                for (int bj = 0; bj < 2; ++bj) { const f32x4 v0 = acc[ai][bj][m][0], v1 = acc[ai][bj][m][1];
                    u32x4 w; w.x = cvt_pk_bf16(v0[0], v0[1]); w.y = cvt_pk_bf16(v0[2], v0[3]); w.z = cvt_pk_bf16(v1[0], v1[1]); w.w = cvt_pk_bf16(v1[2], v1[3]);
                    *(u32x4*)(rowp + bj * HALF) = w; } }
    }
};
struct EpiResid {
    static constexpr bool PERM = false, AFTER_DRAIN = false;
    const float* res; float* out; int ldc; float alpha;
    __device__ __forceinline__ void operator()(const f32x4 (&acc)[2][2][4][2], const Unit& u, int wr, int wc, int fr, int fq) const {
        const int row0 = u.pm * BM + wr * 64 + fr, col0 = u.pn * BM + wc * 32 + 4 * fq;
#pragma unroll
        for (int ai = 0; ai < 2; ++ai)
#pragma unroll
            for (int m = 0; m < 4; ++m) { const size_t off = (size_t)(row0 + ai * HALF + m * 16) * ldc + col0;
#pragma unroll
                for (int bj = 0; bj < 2; ++bj)
#pragma unroll
                    for (int n = 0; n < 2; ++n) { const f32x4 r = *(const f32x4*)(res + off + bj * HALF + n * 16); *(f32x4*)(out + off + bj * HALF + n * 16) = r * alpha + acc[ai][bj][m][n]; }
                asm volatile("" ::: "memory"); }
    }
};
struct EpiPle {
    static constexpr bool PERM = false, AFTER_DRAIN = false;
    const float* x2; const bf16_t* proj; float* out; float alpha;
    __device__ __forceinline__ void operator()(const f32x4 (&acc)[2][2][4][2], const Unit& u, int wr, int wc, int fr, int fq) const {
        const int row0 = u.pm * BM + wr * 64 + fr, col0 = u.pn * BM + wc * 32 + 4 * fq;
#pragma unroll
        for (int ai = 0; ai < 2; ++ai)
#pragma unroll
            for (int m = 0; m < 4; ++m) { const size_t off = (size_t)(row0 + ai * HALF + m * 16) * 1024 + col0;
#pragma unroll
                for (int bj = 0; bj < 2; ++bj)
#pragma unroll
                    for (int n = 0; n < 2; ++n) { const size_t o2 = off + bj * HALF + n * 16; const f32x4 r = *(const f32x4*)(x2 + o2); const v2u pw = *(const v2u*)(proj + o2);
                        const f32x4 a = acc[ai][bj][m][n]; f32x4 o;
                        o[0] = r[0] * alpha + bflo(pw.x) * sigmoidf_(a[0]); o[1] = r[1] * alpha + bfhi(pw.x) * sigmoidf_(a[1]);
                        o[2] = r[2] * alpha + bflo(pw.y) * sigmoidf_(a[2]); o[3] = r[3] * alpha + bfhi(pw.y) * sigmoidf_(a[3]);
                        *(f32x4*)(out + o2) = o; }
                asm volatile("" ::: "memory"); }
    }
};
struct EpiSwiglu {
    static constexpr bool PERM = true, AFTER_DRAIN = false;
    bf16_t* H; const float* b_up;
    __device__ __forceinline__ void operator()(const f32x4 (&acc)[2][2][4][2], const Unit& u, int wr, int wc, int fr, int fq) const {
        const int e = u.pn >> 3, pnT = u.pn & 7;
        const int row0 = u.pm * BM + wr * 64 + fr, col0 = pnT * 128 + wc * 32 + 8 * fq;
        const float* bg = b_up + (size_t)e * 2048 + col0; const float* bl = bg + 1024;
        float bgv[8], blv[8];
#pragma unroll
        for (int j = 0; j < 8; ++j) { bgv[j] = bg[j]; blv[j] = bl[j]; }
#pragma unroll
        for (int ai = 0; ai < 2; ++ai)
#pragma unroll
            for (int m = 0; m < 4; ++m) { bf16_t* rowp = H + (size_t)(row0 + ai * HALF + m * 16) * 1024 + col0; float a[8];
#pragma unroll
                for (int n = 0; n < 2; ++n)
#pragma unroll
                    for (int j = 0; j < 4; ++j) { float g = acc[ai][0][m][n][j] + bgv[4 * n + j], l = acc[ai][1][m][n][j] + blv[4 * n + j];
                        g = fminf(g, 7.0f); l = fminf(fmaxf(l, -7.0f), 7.0f); a[4 * n + j] = g * sigmoidf_(1.702f * g) * (l + 1.0f); }
                u32x4 w; w.x = cvt_pk_bf16(a[0], a[1]); w.y = cvt_pk_bf16(a[2], a[3]); w.z = cvt_pk_bf16(a[4], a[5]); w.w = cvt_pk_bf16(a[6], a[7]);
                *(u32x4*)rowp = w; }
    }
};
struct EpiDown {
    static constexpr bool PERM = true, AFTER_DRAIN = false;
    bf16_t* Y; const float* b_dn; const float* gate;
    __device__ __forceinline__ void operator()(const f32x4 (&acc)[2][2][4][2], const Unit& u, int wr, int wc, int fr, int fq) const {
        const int e = u.pn >> 2, pnT = u.pn & 3;
        const int row0 = u.pm * BM + wr * 64 + fr, col0 = pnT * 256 + wc * 32 + 8 * fq;
        const float* bb = b_dn + (size_t)e * 1024 + col0;
        float bv[2][8];
#pragma unroll
        for (int bj = 0; bj < 2; ++bj)
#pragma unroll
            for (int j = 0; j < 8; ++j) bv[bj][j] = bb[bj * HALF + j];
#pragma unroll
        for (int ai = 0; ai < 2; ++ai)
#pragma unroll
            for (int m = 0; m < 4; ++m) { const int row = row0 + ai * HALF + m * 16; const float gt = gate[row]; bf16_t* rowp = Y + (size_t)row * 1024 + col0;
#pragma unroll
                for (int bj = 0; bj < 2; ++bj) { const f32x4 v0 = acc[ai][bj][m][0], v1 = acc[ai][bj][m][1];
                    u32x4 w; w.x = cvt_pk_bf16((v0[0] + bv[bj][0]) * gt, (v0[1] + bv[bj][1]) * gt); w.y = cvt_pk_bf16((v0[2] + bv[bj][2]) * gt, (v0[3] + bv[bj][3]) * gt);
                    w.z = cvt_pk_bf16((v1[0] + bv[bj][4]) * gt, (v1[1] + bv[bj][5]) * gt); w.w = cvt_pk_bf16((v1[2] + bv[bj][6]) * gt, (v1[3] + bv[bj][7]) * gt);
                    *(u32x4*)(rowp + bj * HALF) = w; } }
    }
};
struct MoeOrder {
    const int* tile_e; int ntiles, nN, G, c;
    __device__ __forceinline__ bool next(int i, Unit& u) const {
        const int L = i * G + c; if (L >= ntiles * nN) return false;
        const int pm = L / nN, pl = L - pm * nN; u.pm = pm; u.pn = tile_e[pm] * nN + pl; return true;
    }
    __device__ __forceinline__ void a_ready(const Unit&) const {}
    __device__ __forceinline__ void done(const Unit&) const {}
};
}

template <class RowMap>
__device__ __forceinline__ void transpose_item(const float* W, int ldw, int Nvalid, bf16* WT, int Kdim, RowMap rm, LAS float* scr, int kb, int nb, int lane) {
    const int k0 = 64 * kb, n0 = 32 * nb; const int nl0 = lane & 31, nn = n0 + nl0;
#pragma unroll 8
    for (int i = 0; i < 32; ++i) { const int kk = 2 * i + (lane >> 5); scr[kk * 33 + nl0] = (nn < Nvalid) ? W[(size_t)(k0 + kk) * ldw + nn] : 0.f; }
    LDS_WAIT(); asm volatile("" ::: "memory");
    const int c = lane & 7;
#pragma unroll
    for (int j = 0; j < 4; ++j) { const int n = (lane >> 3) + 8 * j; const LAS float* s = scr + (8 * c) * 33 + n;
        v4u o; o.x = pk2(s[0 * 33], s[1 * 33]); o.y = pk2(s[2 * 33], s[3 * 33]); o.z = pk2(s[4 * 33], s[5 * 33]); o.w = pk2(s[6 * 33], s[7 * 33]);
        *(GAS v4u*)(WT + (size_t)rm(n0 + n) * Kdim + k0 + 8 * c) = o; }
    LDS_WAIT(); asm volatile("" ::: "memory");
}
struct RmId { __device__ __forceinline__ int operator()(int n) const { return n; } };
struct RmUp { int e; __device__ __forceinline__ int operator()(int n) const { return e * 2048 + ((n & 1023) >> 7) * 256 + (n >> 10) * 128 + (n & 127); } };
struct RmOff { int off; __device__ __forceinline__ int operator()(int n) const { return off + n; } };

__device__ __forceinline__ void p0_prologue(const Params& P, const Ctx& C) {
    LAS float* scr = (LAS float*)(C.lds + C.wave * 16384);
    unsigned char* ws = P.ws;
    constexpr int I_IN = 16 * (D_INP / 32), I_O = 16 * 32, I_UP = 16 * 64, I_DN = 16 * 32, I_PP = 4 * 32, I_PG = 16 * 32, I_UK = 4 * 16, I_UV = 4 * 16;
    constexpr int NITEMS = I_IN + I_O + NE * I_UP + NE * I_DN + I_PP + I_PG + I_UK + I_UV;
    for (int it = C.gw; it < NITEMS; it += C.ngw) {
        int r = it;
        if (r < I_IN) { transpose_item(P.in[I_WIN], D_IN, D_IN, (bf16*)(ws + WS_WIN_T), 1024, RmId{}, scr, r / (D_INP / 32), r % (D_INP / 32), C.lane); continue; } r -= I_IN;
        if (r < I_O) { transpose_item(P.in[I_WO], 1024, 1024, (bf16*)(ws + WS_WO_T), 1024, RmId{}, scr, r / 32, r % 32, C.lane); continue; } r -= I_O;
        if (r < NE * I_UP) { const int e = r / I_UP, q = r % I_UP; transpose_item(P.in[I_WUP] + (size_t)e * 1024 * 2048, 2048, 2048, (bf16*)(ws + WS_WUP_T), 1024, RmUp{e}, scr, q / 64, q % 64, C.lane); continue; } r -= NE * I_UP;
        if (r < NE * I_DN) { const int e = r / I_DN, q = r % I_DN; transpose_item(P.in[I_WDN] + (size_t)e * 1024 * 1024, 1024, 1024, (bf16*)(ws + WS_WDN_T), 1024, RmOff{e * 1024}, scr, q / 32, q % 32, C.lane); continue; } r -= NE * I_DN;
        if (r < I_PP) { transpose_item(P.in[I_WPP], 1024, 1024, (bf16*)(ws + WS_WPROJ_T), 256, RmId{}, scr, r / 32, r % 32, C.lane); continue; } r -= I_PP;
        if (r < I_PG) { transpose_item(P.in[I_WPG], 1024, 1024, (bf16*)(ws + WS_WGATE_T), 1024, RmId{}, scr, r / 32, r % 32, C.lane); continue; } r -= I_PG;
        if (r < I_UK) { transpose_item(P.in[I_WUK], 512, 512, (bf16*)(ws + WS_WUK_T), 256, RmId{}, scr, r / 16, r % 16, C.lane); continue; } r -= I_UK;
        transpose_item(P.in[I_WUV], 512, 512, (bf16*)(ws + WS_WUV_T), 256, RmId{}, scr, r / 16, r % 16, C.lane);
    }
    {
        const float* x = P.in[I_X]; bf16* xb = (bf16*)(ws + WS_XBF);
        const size_t n8 = (size_t)NTOK * D / 8, stride = (size_t)C.ngw * 64;
        for (size_t i = (size_t)C.gw * 64 + C.lane; i < n8; i += stride) { const f32x4 a = *(const GAS f32x4*)(x + i * 8), b = *(const GAS f32x4*)(x + i * 8 + 4);
            v4u o; o.x = pk2(a[0], a[1]); o.y = pk2(a[2], a[3]); o.z = pk2(b[0], b[1]); o.w = pk2(b[2], b[3]); *(GAS v4u*)(xb + i * 8) = o; }
        const float* p = P.in[I_P]; bf16* pb = (bf16*)(ws + WS_PB);
        const size_t m8 = (size_t)NTOK * PLE / 8;
        for (size_t i = (size_t)C.gw * 64 + C.lane; i < m8; i += stride) { const f32x4 a = *(const GAS f32x4*)(p + i * 8), b = *(const GAS f32x4*)(p + i * 8 + 4);
            v4u o; o.x = pk2(a[0], a[1]); o.y = pk2(a[2], a[3]); o.z = pk2(b[0], b[1]); o.w = pk2(b[2], b[3]); *(GAS v4u*)(pb + i * 8) = o; }
    }
}

__device__ __forceinline__ void ln_row(f32x4 (&v)[4], const float* g, const float* b, int lane) {
    float s = 0.f;
#pragma unroll
    for (int j = 0; j < 4; ++j) s += (v[j][0] + v[j][1]) + (v[j][2] + v[j][3]);
    const float mean = wave_sum(s) * (1.f / D); float s2 = 0.f;
#pragma unroll
    for (int j = 0; j < 4; ++j) { v[j] = v[j] - mean; s2 += (v[j][0] * v[j][0] + v[j][1] * v[j][1]) + (v[j][2] * v[j][2] + v[j][3] * v[j][3]); }
    const float rstd = 1.f / sqrtf(wave_sum(s2) * (1.f / D) + LN_EPS);
#pragma unroll
    for (int j = 0; j < 4; ++j) { const f32x4 gg = *(const f32x4*)(g + 4 * lane + 256 * j), bb = *(const f32x4*)(b + 4 * lane + 256 * j); v[j] = v[j] * rstd * gg + bb; }
}
__device__ __forceinline__ void store_row_f32(float* row, const f32x4 (&v)[4], int lane) {
#pragma unroll
    for (int j = 0; j < 4; ++j) *(GAS f32x4*)(row + 4 * lane + 256 * j) = v[j];
}
__device__ __forceinline__ void store_row_bf16(bf16* row, const f32x4 (&v)[4], int lane) {
#pragma unroll
    for (int j = 0; j < 4; ++j) { v2u o; o.x = pk2(v[j][0], v[j][1]); o.y = pk2(v[j][2], v[j][3]); *(GAS v2u*)(row + 4 * lane + 256 * j) = o; }
}
__device__ __forceinline__ void load_row_f32(f32x4 (&v)[4], const float* row, int lane) {
#pragma unroll
    for (int j = 0; j < 4; ++j) v[j] = *(const GAS f32x4*)(row + 4 * lane + 256 * j);
}
#ifndef FEAT_MIX
#define FEAT_MIX 1
#endif
#ifndef FEAT_MOE
#define FEAT_MOE 1
#endif
#ifndef FEAT_PLE
#define FEAT_PLE 1
#endif
#ifndef FEAT_ATT
#define FEAT_ATT 1
#endif

typedef float f32x16 __attribute__((ext_vector_type(16)));
typedef short s16x4 __attribute__((ext_vector_type(4)));
__device__ __forceinline__ unsigned cvtpk(float lo, float hi) { typedef float f2 __attribute__((ext_vector_type(2))); typedef __bf16 b2 __attribute__((ext_vector_type(2))); f2 v = {lo, hi}; b2 b = __builtin_convertvector(v, b2); return __builtin_bit_cast(unsigned, b); }
__device__ __forceinline__ bf16x8 pack8(const f32x16& x, int base) {
    v4u w; w.x = cvtpk(x[base + 0], x[base + 1]); w.y = cvtpk(x[base + 2], x[base + 3]); w.z = cvtpk(x[base + 4], x[base + 5]); w.w = cvtpk(x[base + 6], x[base + 7]);
    return __builtin_bit_cast(bf16x8, w);
}

__device__ __forceinline__ void p2_post(const Params& P, const Ctx& C) {
    unsigned char* ws = P.ws;
    const bf16* H = (const bf16*)(ws + WS_H); bf16* CN = (bf16*)(ws + WS_CN); bf16* IKN = (bf16*)(ws + WS_IKN);
    const float* kvg = P.in[I_KVG]; const float* ikg = P.in[I_IKG]; const float* ikb = P.in[I_IKB];
    const f32x4 g4 = *(const f32x4*)(kvg + 4 * C.lane); const float ig = ikg[C.lane], ib = ikb[C.lane];
    for (int m = C.gw; m < NTOK; m += C.ngw) {
        const bf16* hr = H + (size_t)m * D_INP;
        const v2u w = *(const GAS v2u*)(hr + C_AC + 4 * C.lane);
        float a0 = bflo(w.x), a1 = bfhi(w.x), a2 = bflo(w.y), a3 = bfhi(w.y);
        const float ss = wave_sum((a0 * a0 + a1 * a1) + (a2 * a2 + a3 * a3));
        const float rs = 1.f / sqrtf(ss * (1.f / 256.f) + RMS_EPS);
        v2u o; o.x = pk2(a0 * rs * g4[0], a1 * rs * g4[1]); o.y = pk2(a2 * rs * g4[2], a3 * rs * g4[3]);
        *(GAS v2u*)(CN + (size_t)m * 256 + 4 * C.lane) = o;
        const float k = bf2f(hr[C_IK + C.lane]);
        const float mu = wave_sum(k) * (1.f / 64.f); const float dk = k - mu;
        const float var = wave_sum(dk * dk) * (1.f / 64.f);
        IKN[(size_t)m * 64 + C.lane] = (bf16)f2bf(dk * (1.f / sqrtf(var + LN_EPS)) * ig + ib);
    }
}

constexpr int HP_QD = 0, HP_KI = 8704, HP_KET = 17408, HP_VT = 27648, HP_GS = 37888, HP_BYTES = 39936;
__device__ __forceinline__ void p2_hgrn_prep(const Params& P, const Ctx& C) {
    unsigned char* ws = P.ws;
    const bf16* H = (const bf16*)(ws + WS_H);
    bf16* UT = (bf16*)(ws + WS_U); bf16* QDEC = (bf16*)(ws + WS_QDEC); float* OREC = (float*)(ws + WS_OREC); float* DEC = (float*)(ws + WS_DECAY);
    LAS bf16* QD = (LAS bf16*)(C.lds + HP_QD); LAS bf16* KI = (LAS bf16*)(C.lds + HP_KI); LAS bf16* KET = (LAS bf16*)(C.lds + HP_KET); LAS bf16* VT = (LAS bf16*)(C.lds + HP_VT);
    LAS float* GS = (LAS float*)(C.lds + HP_GS);
    const int d = C.tid & 127, tg = C.tid >> 7;
    const int lane = C.lane, r32 = lane & 31, hf = lane >> 5;
    for (int unit = blockIdx.x; unit < NB * HG_H * (T / HG_C); unit += C.G) {
        const int n = unit & 127, hh = (unit >> 7) & 3, b = unit >> 9;
        const int m0 = b * T + n * HG_C;
        const float l0 = P.in[I_HGLB][hh * 128 + d], l1 = P.in[I_HGLB][512 + hh * 128 + d];
        const float lb = 1.f / (1.f + __expf(l1 - l0));
        float fg[8], bl[8], qv[8]; float run = 0.f; unsigned vv[4];
#pragma unroll
        for (int c = 0; c < 8; ++c) { const bf16* hr = H + (size_t)(m0 + tg * 8 + c) * D_INP + hh * 128 + d;
            const float f = bf2f(hr[C_GF]), q = bf2f(hr[C_GQ]); const unsigned iv = hr[C_GI];
            fg[c] = lb + (1.f - lb) * sigmoidf_(f); run += __logf(fg[c]); bl[c] = run; qv[c] = q * sigmoidf_(q);
            if (c & 1) vv[c >> 1] |= iv << 16; else vv[c >> 1] = iv; }
        GS[tg * 128 + d] = run;
        *(LAS v4u*)(VT + d * 40 + tg * 8) = (v4u){vv[0], vv[1], vv[2], vv[3]};
        __syncthreads();
        float pre = 0.f, tot = 0.f;
#pragma unroll
        for (int g = 0; g < 4; ++g) { const float s = GS[g * 128 + d]; tot += s; if (g < tg) pre += s; }
        unsigned ke[4];
#pragma unroll
        for (int c = 0; c < 8; ++c) { const float bc = pre + bl[c]; const float kc = 1.f - fg[c];
            const float qd = qv[c] * __expf(bc), ki = kc * __expf(-bc), kend = kc * __expf(tot - bc);
            const unsigned qb = f2bf(qd);
            QD[(tg * 8 + c) * 136 + d] = (bf16)qb; KI[(tg * 8 + c) * 136 + d] = (bf16)f2bf(ki);
            QDEC[(size_t)(m0 + tg * 8 + c) * 512 + hh * 128 + d] = (bf16)qb;
            if (c & 1) ke[c >> 1] |= f2bf(kend) << 16; else ke[c >> 1] = f2bf(kend); }
        *(LAS v4u*)(KET + d * 40 + tg * 8) = (v4u){ke[0], ke[1], ke[2], ke[3]};
        if (tg == 0) DEC[(size_t)unit * 128 + d] = __expf(tot);
        __syncthreads();
        if (C.wave < 4) {
            f32x16 X = {0.f, 0.f, 0.f, 0.f, 0.f, 0.f, 0.f, 0.f, 0.f, 0.f, 0.f, 0.f, 0.f, 0.f, 0.f, 0.f};
#pragma unroll
            for (int k = 0; k < 8; ++k) { const bf16x8 a = *(const LAS bf16x8*)(KI + r32 * 136 + 16 * k + 8 * hf), bq = *(const LAS bf16x8*)(QD + r32 * 136 + 16 * k + 8 * hf);
                X = __builtin_amdgcn_mfma_f32_32x32x16_bf16(a, bq, X, 0, 0, 0); }
#pragma unroll
            for (int r = 0; r < 16; ++r) { const int s = (r & 3) + 8 * (r >> 2) + 4 * hf; if (s > r32) X[r] = 0.f; }
            f32x16 Z = {0.f, 0.f, 0.f, 0.f, 0.f, 0.f, 0.f, 0.f, 0.f, 0.f, 0.f, 0.f, 0.f, 0.f, 0.f, 0.f};
            const int e = C.wave * 32 + r32;
#pragma unroll
            for (int sp = 0; sp < 2; ++sp) { const bf16x8 a = pack8(X, 8 * sp);
                const s16x4 lo = *(const LAS s16x4*)(VT + e * 40 + 16 * sp + 4 * hf), hi = *(const LAS s16x4*)(VT + e * 40 + 16 * sp + 8 + 4 * hf);
                const bf16x8 bv = (bf16x8){lo[0], lo[1], lo[2], lo[3], hi[0], hi[1], hi[2], hi[3]};
                Z = __builtin_amdgcn_mfma_f32_32x32x16_bf16(a, bv, Z, 0, 0, 0); }
#pragma unroll
            for (int r = 0; r < 16; ++r) { const int c = (r & 3) + 8 * (r >> 2) + 4 * hf; OREC[(size_t)(m0 + c) * 512 + hh * 128 + e] = Z[r]; }
        }
        {
            const int dt = C.wave >> 1;
            const bf16x8 a0 = *(const LAS bf16x8*)(KET + (dt * 32 + r32) * 40 + 8 * hf), a1 = *(const LAS bf16x8*)(KET + (dt * 32 + r32) * 40 + 16 + 8 * hf);
#pragma unroll
            for (int ei = 0; ei < 2; ++ei) { const int et = 2 * (C.wave & 1) + ei;
                const bf16x8 b0 = *(const LAS bf16x8*)(VT + (et * 32 + r32) * 40 + 8 * hf), b1 = *(const LAS bf16x8*)(VT + (et * 32 + r32) * 40 + 16 + 8 * hf);
                f32x16 U = {0.f, 0.f, 0.f, 0.f, 0.f, 0.f, 0.f, 0.f, 0.f, 0.f, 0.f, 0.f, 0.f, 0.f, 0.f, 0.f};
                U = __builtin_amdgcn_mfma_f32_32x32x16_bf16(a0, b0, U, 0, 0, 0); U = __builtin_amdgcn_mfma_f32_32x32x16_bf16(a1, b1, U, 0, 0, 0);
                bf16* up = UT + (size_t)unit * 16384 + (size_t)(et * 32 + r32) * 128 + dt * 32 + 4 * hf;
#pragma unroll
                for (int q = 0; q < 4; ++q) { v2u o; o.x = cvtpk(U[4 * q], U[4 * q + 1]); o.y = cvtpk(U[4 * q + 2], U[4 * q + 3]); *(GAS v2u*)(up + 8 * q) = o; } }
        }
        __syncthreads();
    }
}

__device__ __forceinline__ void p3_hgrn_scan(const Params& P, const Ctx& C) {
    unsigned char* ws = P.ws;
    const bf16* UT = (const bf16*)(ws + WS_U); const bf16* QDEC = (const bf16*)(ws + WS_QDEC); float* OREC = (float*)(ws + WS_OREC); const float* DEC = (const float*)(ws + WS_DECAY);
    LAS bf16* ST = (LAS bf16*)C.lds;
    typedef float f32x4v __attribute__((ext_vector_type(4)));
    for (int unit = blockIdx.x; unit < NB * HG_H * 8; unit += C.G) {
        const int sl = unit & 7, hh = (unit >> 3) & 3, b = unit >> 5; const int e0 = sl * 16;
        const int e = C.tid & 15, dq = C.tid >> 4;
        float S[4] = {0.f, 0.f, 0.f, 0.f};
        *(LAS v2u*)(ST + e * 136 + 4 * dq) = (v2u){0u, 0u};
        const int cu0 = (b * HG_H + hh) * 128;
        const int lane = C.lane, fr = lane & 15, fq = lane >> 4;
        v2u un = *(const GAS v2u*)(UT + (size_t)cu0 * 16384 + (size_t)(e0 + e) * 128 + 4 * dq);
        f32x4 dn = *(const GAS f32x4*)(DEC + (size_t)cu0 * 128 + 4 * dq);
        bf16x8 qa[4];
        if (C.wave < 2) {
#pragma unroll
            for (int k = 0; k < 4; ++k) qa[k] = *(const GAS bf16x8*)(QDEC + (size_t)(b * T + C.wave * 16 + fr) * 512 + hh * 128 + 32 * k + 8 * fq);
        }
        __syncthreads();
        for (int n = 0; n < 128; ++n) {
            const v2u uc = un; const f32x4 dc = dn; bf16x8 qc[4];
#pragma unroll
            for (int k = 0; k < 4; ++k) qc[k] = qa[k];
            if (n + 1 < 128) {
                un = *(const GAS v2u*)(UT + (size_t)(cu0 + n + 1) * 16384 + (size_t)(e0 + e) * 128 + 4 * dq);
                dn = *(const GAS f32x4*)(DEC + (size_t)(cu0 + n + 1) * 128 + 4 * dq);
                if (C.wave < 2) {
#pragma unroll
                    for (int k = 0; k < 4; ++k) qa[k] = *(const GAS bf16x8*)(QDEC + (size_t)(b * T + (n + 1) * 32 + C.wave * 16 + fr) * 512 + hh * 128 + 32 * k + 8 * fq);
                }
            }
            const LAS bf16* stc = ST + (n & 1) * (16 * 136); LAS bf16* stn = ST + ((n + 1) & 1) * (16 * 136);
            if (C.wave < 2) {
                f32x4v acc = {0.f, 0.f, 0.f, 0.f};
#pragma unroll
                for (int k = 0; k < 4; ++k) { const bf16x8 bs = *(const LAS bf16x8*)(stc + fr * 136 + 32 * k + 8 * fq); acc = __builtin_amdgcn_mfma_f32_16x16x32_bf16(qc[k], bs, acc, 0, 0, 0); }
                float* op = OREC + (size_t)(b * T + n * 32 + C.wave * 16 + 4 * fq) * 512 + hh * 128 + e0 + fr;
#pragma unroll
                for (int j = 0; j < 4; ++j) op[(size_t)j * 512] += acc[j];
            }
            S[0] = dc[0] * S[0] + bflo(uc.x); S[1] = dc[1] * S[1] + bfhi(uc.x); S[2] = dc[2] * S[2] + bflo(uc.y); S[3] = dc[3] * S[3] + bfhi(uc.y);
            *(LAS v2u*)(stn + e * 136 + 4 * dq) = (v2u){cvtpk(S[0], S[1]), cvtpk(S[2], S[3])};
            __syncthreads();
        }
    }
}

__device__ __forceinline__ void p4_yrec(const Params& P, const Ctx& C) {
    unsigned char* ws = P.ws;
    const float* OREC = (const float*)(ws + WS_OREC); const bf16* H = (const bf16*)(ws + WS_H); bf16* YM = (bf16*)(ws + WS_YMIX);
    const float* ng = P.in[I_HGNG];
    const f32x4 g0 = *(const f32x4*)(ng + 8 * C.lane), g1 = *(const f32x4*)(ng + 8 * C.lane + 4);
    for (int m = C.gw; m < NTOK; m += C.ngw) {
        const f32x4 a = *(const GAS f32x4*)(OREC + (size_t)m * 512 + 8 * C.lane), bq = *(const GAS f32x4*)(OREC + (size_t)m * 512 + 8 * C.lane + 4);
        float ss = (a[0] * a[0] + a[1] * a[1]) + (a[2] * a[2] + a[3] * a[3]) + (bq[0] * bq[0] + bq[1] * bq[1]) + (bq[2] * bq[2] + bq[3] * bq[3]);
        ss += __shfl_xor(ss, 1); ss += __shfl_xor(ss, 2); ss += __shfl_xor(ss, 4); ss += __shfl_xor(ss, 8);
        const float rs = 1.f / sqrtf(ss * (1.f / 128.f) + RMS_EPS);
        const v4u gw = *(const GAS v4u*)(H + (size_t)m * D_INP + C_GG + 8 * C.lane);
        float gv[8] = {bflo(gw.x), bfhi(gw.x), bflo(gw.y), bfhi(gw.y), bflo(gw.z), bfhi(gw.z), bflo(gw.w), bfhi(gw.w)};
        float o[8];
#pragma unroll
        for (int j = 0; j < 4; ++j) { o[j] = a[j] * rs * g0[j] * (gv[j] * sigmoidf_(gv[j])); o[4 + j] = bq[j] * rs * g1[j] * (gv[4 + j] * sigmoidf_(gv[4 + j])); }
        v4u w; w.x = pk2(o[0], o[1]); w.y = pk2(o[2], o[3]); w.z = pk2(o[4], o[5]); w.w = pk2(o[6], o[7]);
        *(GAS v4u*)(YM + (size_t)m * D + 512 + 8 * C.lane) = w;
#if !FEAT_ATT
        *(GAS v4u*)(YM + (size_t)m * D + 8 * C.lane) = (v4u){0u, 0u, 0u, 0u};
#endif
    }
}

namespace pg8 {
struct EpiKhead {
    static constexpr bool PERM = true, AFTER_DRAIN = false;
    bf16_t* O;
    __device__ __forceinline__ void operator()(const f32x4 (&acc)[2][2][4][2], const Unit& u, int wr, int wc, int fr, int fq) const {
        const int row0 = u.pm * BM + wr * 64 + fr, col0 = u.pn * BM + wc * 32 + 8 * fq;
#pragma unroll
        for (int ai = 0; ai < 2; ++ai)
#pragma unroll
            for (int m = 0; m < 4; ++m) { const int row = row0 + ai * HALF + m * 16; const int b = row >> 12, t = row & 4095;
#pragma unroll
                for (int bj = 0; bj < 2; ++bj) { const int col = col0 + bj * HALF; const f32x4 v0 = acc[ai][bj][m][0], v1 = acc[ai][bj][m][1];
                    u32x4 w; w.x = cvt_pk_bf16(v0[0], v0[1]); w.y = cvt_pk_bf16(v0[2], v0[3]); w.z = cvt_pk_bf16(v1[0], v1[1]); w.w = cvt_pk_bf16(v1[2], v1[3]);
                    *(u32x4*)(O + ((size_t)((b * 8 + (col >> 6)) * 4096 + t)) * 64 + (col & 63)) = w; } }
    }
};
struct EpiVt {
    static constexpr bool PERM = true, AFTER_DRAIN = false;
    bf16_t* O;
    __device__ __forceinline__ void operator()(const f32x4 (&acc)[2][2][4][2], const Unit& u, int wr, int wc, int fr, int fq) const {
        const int row0 = u.pm * BM + wr * 64 + fr, col0 = u.pn * BM + wc * 32 + 8 * fq;
#pragma unroll
        for (int ai = 0; ai < 2; ++ai)
#pragma unroll
            for (int m = 0; m < 4; ++m) { const int row = row0 + ai * HALF + m * 16;
#pragma unroll
                for (int bj = 0; bj < 2; ++bj) { const int col = col0 + bj * HALF; const int b = col >> 12, t = col & 4095; const f32x4 v0 = acc[ai][bj][m][0], v1 = acc[ai][bj][m][1];
                    u32x4 w; w.x = cvt_pk_bf16(v0[0], v0[1]); w.y = cvt_pk_bf16(v0[2], v0[3]); w.z = cvt_pk_bf16(v1[0], v1[1]); w.w = cvt_pk_bf16(v1[2], v1[3]);
                    *(u32x4*)(O + ((size_t)(b * 512 + row)) * 4096 + t) = w; } }
    }
};
}

__device__ __forceinline__ unsigned f2ord(float x) { const unsigned b = __builtin_bit_cast(unsigned, x); return b ^ ((unsigned)((int)b >> 31) | 0x80000000u); }
__device__ __forceinline__ void p3_indexer(const Params& P, const Ctx& C) {
    unsigned char* ws = P.ws;
    const bf16* H = (const bf16*)(ws + WS_H); const bf16* IKN = (const bf16*)(ws + WS_IKN); unsigned* MASK = (unsigned*)(ws + WS_MASK);
    LAS float* ISC = (LAS float*)C.lds; LAS unsigned* HIST = (LAS unsigned*)(C.lds + 131072) + C.wave * 256;
    const int lane = C.lane, r32 = lane & 31, hf = lane >> 5;
    const int ql = 2 * (r32 >> 4) + ((r32 >> 2) & 1), hd = 4 * ((r32 >> 3) & 1) + (r32 & 3);
    for (int u = blockIdx.x; u < NTOK / 8; u += C.G) {
        const int b = (u & 255) >> 5, j = u & 31, i = u >> 8; const int pi = i >> 1; const int blk = (i & 1) ? (511 - (j + 32 * pi)) : (j + 32 * pi);
        const int t0 = blk * 8; const size_t mb = (size_t)b * T;
        const int nkt = (t0 + 8 + 31) >> 5;
        bf16x8 af[2][4]; float wq[2][2][8];
#pragma unroll
        for (int a = 0; a < 2; ++a) {
            const bf16* qp = H + (mb + t0 + 4 * a + ql) * D_INP + C_IQ + hd * 64 + 8 * hf;
#pragma unroll
            for (int k = 0; k < 4; ++k) af[a][k] = *(const GAS bf16x8*)(qp + 16 * k);
#pragma unroll
            for (int qh = 0; qh < 2; ++qh) { const v4u w = *(const GAS v4u*)(H + (mb + t0 + 4 * a + 2 * qh + hf) * D_INP + C_IW);
                const float sc = 0.125f * 0.35355339059327373f;
                wq[a][qh][0] = bflo(w.x) * sc; wq[a][qh][1] = bfhi(w.x) * sc; wq[a][qh][2] = bflo(w.y) * sc; wq[a][qh][3] = bfhi(w.y) * sc;
                wq[a][qh][4] = bflo(w.z) * sc; wq[a][qh][5] = bfhi(w.z) * sc; wq[a][qh][6] = bflo(w.w) * sc; wq[a][qh][7] = bfhi(w.w) * sc; }
        }
        for (int kt = C.wave; kt < nkt; kt += NWAVES) {
            const int s0 = kt * 32; const bf16* kp = IKN + (mb + s0 + r32) * 64 + 8 * hf;
            bf16x8 bk[4];
#pragma unroll
            for (int k = 0; k < 4; ++k) bk[k] = *(const GAS bf16x8*)(kp + 16 * k);
#pragma unroll
            for (int a = 0; a < 2; ++a) {
                f32x16 acc = {0.f, 0.f, 0.f, 0.f, 0.f, 0.f, 0.f, 0.f, 0.f, 0.f, 0.f, 0.f, 0.f, 0.f, 0.f, 0.f};
#pragma unroll
                for (int k = 0; k < 4; ++k) acc = __builtin_amdgcn_mfma_f32_32x32x16_bf16(af[a][k], bk[k], acc, 0, 0, 0);
#pragma unroll
                for (int qh = 0; qh < 2; ++qh) { float s = 0.f;
#pragma unroll
                    for (int h8 = 0; h8 < 8; ++h8) s += wq[a][qh][h8] * fmaxf(acc[8 * qh + h8], 0.f);
                    const int q = 4 * a + 2 * qh + hf, key = s0 + r32;
                    ISC[q * 4096 + key] = (key <= t0 + q) ? (s + 0.0f) : -INFINITY; }
            }
        }
        __syncthreads();
        {
            const int q = C.wave, t = t0 + q, n = t + 1; const LAS float* row = ISC + q * 4096;
            unsigned* mrow = MASK + (mb + t) * 128;
            if (n <= TOPK) {
#pragma unroll
                for (int w2 = 0; w2 < 2; ++w2) { const int wi = lane + 64 * w2; const int lo = 32 * wi; unsigned bits;
                    if (lo + 31 <= t) bits = 0xffffffffu; else if (lo > t) bits = 0u; else bits = (1u << (t - lo + 1)) - 1u;
                    mrow[wi] = bits; }
            } else {
                unsigned prefix = 0u; int need = TOPK;
                for (int pass = 3; pass >= 0; --pass) {
                    const int shift = 8 * pass;
#pragma unroll
                    for (int z = 0; z < 4; ++z) HIST[lane + 64 * z] = 0u;
                    LDS_WAIT();
                    for (int e = lane; e < n; e += 64) { const unsigned uu = f2ord(row[e]);
                        const bool match = (pass == 3) || ((uu >> (shift + 8)) == (prefix >> (shift + 8)));
                        if (match) atomicAdd((unsigned*)&HIST[(uu >> shift) & 255u], 1u); }
                    LDS_WAIT();
                    const unsigned c0 = HIST[4 * lane], c1 = HIST[4 * lane + 1], c2 = HIST[4 * lane + 2], c3 = HIST[4 * lane + 3];
                    const unsigned s4 = c0 + c1 + c2 + c3;
                    unsigned suf = s4;
#pragma unroll
                    for (int o = 1; o < 64; o <<= 1) { const unsigned v = __shfl_down(suf, o); if (lane + o < 64) suf += v; }
                    unsigned cum = suf - s4; int dsel = -1; int nnew = 0;
                    if (cum < (unsigned)need && (unsigned)need <= cum + c3) { dsel = 4 * lane + 3; nnew = need - (int)cum; } cum += c3;
                    if (dsel < 0 && cum < (unsigned)need && (unsigned)need <= cum + c2) { dsel = 4 * lane + 2; nnew = need - (int)cum; } cum += c2;
                    if (dsel < 0 && cum < (unsigned)need && (unsigned)need <= cum + c1) { dsel = 4 * lane + 1; nnew = need - (int)cum; } cum += c1;
                    if (dsel < 0 && cum < (unsigned)need && (unsigned)need <= cum + c0) { dsel = 4 * lane + 0; nnew = need - (int)cum; }
                    const unsigned long long bal = __ballot(dsel >= 0);
                    const int src = (bal != 0ull) ? (int)__builtin_ctzll(bal) : 0;
                    const int d = __shfl(dsel, src); need = __shfl(nnew, src);
                    prefix |= ((unsigned)d & 255u) << shift;
                }
                int run_eq = 0;
                for (int it = 0; it < 64; ++it) { const int e = it * 64 + lane; const unsigned uu = f2ord(row[e]); const bool valid = e <= t;
                    const bool eq = valid && (uu == prefix); const unsigned long long beq = __ballot(eq);
                    const int rk = run_eq + __builtin_popcountll(beq & ((1ull << lane) - 1ull));
                    const bool sel = valid && ((uu > prefix) || (eq && rk < need)); run_eq += __builtin_popcountll(beq);
                    const unsigned long long bs = __ballot(sel);
                    if (lane == 0) *(GAS v2u*)(mrow + 2 * it) = (v2u){(unsigned)bs, (unsigned)(bs >> 32)}; }
            }
        }
        __syncthreads();
    }
}

__device__ __forceinline__ void attn_task(const bf16* H, const bf16* KH, const bf16* VT, const unsigned* MASK, bf16* YM, int b, int hh, int t0, int lane) {
    const int r32 = lane & 31, hf = lane >> 5;
    const float LOG2E = 1.4426950408889634f; const float c1 = 0.125f * LOG2E; const float sl2 = exp2f(-(float)(hh + 1)) * LOG2E;
    const size_t mb = (size_t)b * T;
    bf16x8 qf[4];
#pragma unroll
    for (int k = 0; k < 4; ++k) qf[k] = *(const GAS bf16x8*)(H + (mb + t0 + r32) * D_INP + C_AQ + hh * 64 + 16 * k + 8 * hf);
    const bf16* kbase = KH + ((size_t)(b * 8 + hh) * T) * 64; const bf16* vbase = VT + ((size_t)(b * 512 + hh * 64)) * T; const unsigned* mrow = MASK + (mb + t0 + r32) * 128;
    float m_run = -1e30f, l = 0.f;
    f32x16 O0 = {0.f, 0.f, 0.f, 0.f, 0.f, 0.f, 0.f, 0.f, 0.f, 0.f, 0.f, 0.f, 0.f, 0.f, 0.f, 0.f}, O1 = O0;
    const int nkt = (t0 + 32 + 63) >> 6;
    for (int kt = 0; kt < nkt; ++kt) {
        const int s0 = kt * 64;
        bf16x8 kf[2][4];
#pragma unroll
        for (int uu = 0; uu < 2; ++uu)
#pragma unroll
            for (int k = 0; k < 4; ++k) kf[uu][k] = *(const GAS bf16x8*)(kbase + (size_t)(s0 + 32 * uu + r32) * 64 + 16 * k + 8 * hf);
        const v2u mw = *(const GAS v2u*)(mrow + 2 * kt);
        s16x4 vl[2][2][2], vh[2][2][2];
#pragma unroll
        for (int uu = 0; uu < 2; ++uu)
#pragma unroll
            for (int sp = 0; sp < 2; ++sp)
#pragma unroll
                for (int dt = 0; dt < 2; ++dt) { const bf16* vp = vbase + (size_t)(dt * 32 + r32) * T + s0 + 32 * uu + 16 * sp + 4 * hf;
                    vl[uu][sp][dt] = *(const GAS s16x4*)vp; vh[uu][sp][dt] = *(const GAS s16x4*)(vp + 8); }
        f32x16 a0 = {0.f, 0.f, 0.f, 0.f, 0.f, 0.f, 0.f, 0.f, 0.f, 0.f, 0.f, 0.f, 0.f, 0.f, 0.f, 0.f}, a1 = a0;
#pragma unroll
        for (int k = 0; k < 4; ++k) { a0 = __builtin_amdgcn_mfma_f32_32x32x16_bf16(kf[0][k], qf[k], a0, 0, 0, 0); a1 = __builtin_amdgcn_mfma_f32_32x32x16_bf16(kf[1][k], qf[k], a1, 0, 0, 0); }
        const float dist0 = (float)(t0 + r32 - s0 - 4 * hf);
        const unsigned m0 = mw.x >> (4 * hf), m1 = mw.y >> (4 * hf);
        float mx = -1e30f;
#pragma unroll
        for (int r = 0; r < 16; ++r) { const int ko = (r & 3) + 8 * (r >> 2);
            const float d0 = dist0 - (float)ko;
            a0[r] = ((m0 >> ko) & 1u) ? (a0[r] * c1 - sl2 * d0) : -1e30f;
            a1[r] = ((m1 >> ko) & 1u) ? (a1[r] * c1 - sl2 * (d0 - 32.f)) : -1e30f;
            mx = fmaxf(mx, fmaxf(a0[r], a1[r])); }
        mx = fmaxf(mx, __shfl_xor(mx, 32));
        const float m_new = fmaxf(m_run, mx); const float alpha = __builtin_amdgcn_exp2f(m_run - m_new); m_run = m_new;
        float ps = 0.f;
#pragma unroll
        for (int r = 0; r < 16; ++r) { const int ko = (r & 3) + 8 * (r >> 2);
            const float p0 = ((m0 >> ko) & 1u) ? __builtin_amdgcn_exp2f(a0[r] - m_new) : 0.f;
            const float p1 = ((m1 >> ko) & 1u) ? __builtin_amdgcn_exp2f(a1[r] - m_new) : 0.f;
            a0[r] = p0; a1[r] = p1; ps += p0 + p1; }
        l = l * alpha + ps;
#pragma unroll
        for (int r = 0; r < 16; ++r) { O0[r] *= alpha; O1[r] *= alpha; }
#pragma unroll
        for (int sp = 0; sp < 2; ++sp) {
            const bf16x8 pb0 = pack8(a0, 8 * sp), pb1 = pack8(a1, 8 * sp);
#define VFR(uu, dt) ((bf16x8){vl[uu][sp][dt][0], vl[uu][sp][dt][1], vl[uu][sp][dt][2], vl[uu][sp][dt][3], vh[uu][sp][dt][0], vh[uu][sp][dt][1], vh[uu][sp][dt][2], vh[uu][sp][dt][3]})
            O0 = __builtin_amdgcn_mfma_f32_32x32x16_bf16(VFR(0, 0), pb0, O0, 0, 0, 0);
            O1 = __builtin_amdgcn_mfma_f32_32x32x16_bf16(VFR(0, 1), pb0, O1, 0, 0, 0);
            O0 = __builtin_amdgcn_mfma_f32_32x32x16_bf16(VFR(1, 0), pb1, O0, 0, 0, 0);
            O1 = __builtin_amdgcn_mfma_f32_32x32x16_bf16(VFR(1, 1), pb1, O1, 0, 0, 0);
#undef VFR
        }
    }
    l += __shfl_xor(l, 32);
    const float inv = 1.f / l;
    bf16* yp = YM + (mb + t0 + r32) * D + hh * 64 + 4 * hf;
#pragma unroll
    for (int rq = 0; rq < 4; ++rq) {
        v2u o; o.x = cvtpk(O0[4 * rq] * inv, O0[4 * rq + 1] * inv); o.y = cvtpk(O0[4 * rq + 2] * inv, O0[4 * rq + 3] * inv); *(GAS v2u*)(yp + 8 * rq) = o;
        v2u o2; o2.x = cvtpk(O1[4 * rq] * inv, O1[4 * rq + 1] * inv); o2.y = cvtpk(O1[4 * rq + 2] * inv, O1[4 * rq + 3] * inv); *(GAS v2u*)(yp + 32 + 8 * rq) = o2; }
}
__device__ __forceinline__ void p4_attention(const Params& P, const Ctx& C) {
    unsigned char* ws = P.ws;
    const bf16* H = (const bf16*)(ws + WS_H); const bf16* KH = (const bf16*)(ws + WS_K); const bf16* VT = (const bf16*)(ws + WS_VT); const unsigned* MASK = (const unsigned*)(ws + WS_MASK); bf16* YM = (bf16*)(ws + WS_YMIX);
    for (int p = blockIdx.x; p < 512; p += C.G) {
        const int bh = p >> 3, j = p & 7; const int b = bh >> 3, hh = bh & 7;
        attn_task(H, KH, VT, MASK, YM, b, hh, j * 256 + C.wave * 32, C.lane);
        attn_task(H, KH, VT, MASK, YM, b, hh, (15 - j) * 256 + (7 - C.wave) * 32, C.lane);
    }
}

#ifndef FEAT_MIX
#define FEAT_MIX 1
#endif
#ifndef FEAT_MOE
#define FEAT_MOE 1
#endif
#ifndef FEAT_PLE
#define FEAT_PLE 1
#endif
#ifndef FEAT_ATT
#define FEAT_ATT 1
#endif

__device__ __forceinline__ void p6_ln1_router(const Params& P, const Ctx& C) {
    unsigned char* ws = P.ws;
    float* X1 = (float*)(ws + WS_X1); bf16* XB = (bf16*)(ws + WS_XB);
    LAS float* wl = (LAS float*)C.lds;
    LAS int* hist = (LAS int*)(C.lds + MISC_OFF);
#if FEAT_MOE
    { const float* wr = P.in[I_WR];
      for (int i = C.tid; i < 32 * 1024; i += NTHR) { const int e = i >> 10, k = i & 1023; wl[i] = wr[k * 32 + e]; }
      if (C.tid < 32) hist[C.tid] = 0; }
    __syncthreads();
    int* tope = (int*)(ws + WS_TOPE); float* gate = (float*)(ws + WS_GATE); int* lrank = (int*)(ws + WS_LRANK);
    const float* br = P.in[I_BR];
#endif
#if FEAT_MIX
    const float* src = X1; const float sc = 1.0f;
#else
    const float* src = P.in[I_X]; const float sc = ALPHA;
#endif
    for (int m = C.gw; m < NTOK; m += C.ngw) {
        f32x4 v[4]; load_row_f32(v, src + (size_t)m * D, C.lane);
#pragma unroll
        for (int j = 0; j < 4; ++j) v[j] = v[j] * sc;
        ln_row(v, P.in[I_LNMG], P.in[I_LNMB], C.lane);
        store_row_f32(X1 + (size_t)m * D, v, C.lane);
        store_row_bf16(XB + (size_t)m * D, v, C.lane);
#if FEAT_MOE
        float lv[32];
#pragma unroll
        for (int e = 0; e < 32; ++e) { float a = 0.f;
#pragma unroll
            for (int j = 0; j < 4; ++j) { const f32x4 w = *(const LAS f32x4*)(wl + e * 1024 + 4 * C.lane + 256 * j); a += (v[j][0] * w[0] + v[j][1] * w[1]) + (v[j][2] * w[2] + v[j][3] * w[3]); }
            lv[e] = wave_sum(a) + br[e]; }
        int se[4]; float sv[4];
#pragma unroll
        for (int k = 0; k < 4; ++k) { float best = -INFINITY; int bi = 0;
#pragma unroll
            for (int e = 0; e < 32; ++e) if (lv[e] > best) { best = lv[e]; bi = e; }
            se[k] = bi; sv[k] = best;
#pragma unroll
            for (int e = 0; e < 32; ++e) lv[e] = (e == bi) ? -INFINITY : lv[e]; }
        float ex[4], sum = 0.f;
#pragma unroll
        for (int k = 0; k < 4; ++k) { ex[k] = __expf(sv[k] - sv[0]); sum += ex[k]; }
        const float inv = 1.f / sum;
        if (C.lane == 0) {
#pragma unroll
            for (int k = 0; k < 4; ++k) { const int lr = atomicAdd((int*)&hist[se[k]], 1); tope[m * 4 + k] = se[k]; gate[m * 4 + k] = ex[k] * inv; lrank[m * 4 + k] = lr; } }
#endif
    }
#if FEAT_MOE
    __syncthreads();
    if (C.tid < 32) { unsigned* cnt = (unsigned*)(ws + WS_CTL) + CW_CNT; const int base = (int)atomicAdd(cnt + C.tid, (unsigned)hist[C.tid]); ((int*)(ws + WS_WGBASE))[blockIdx.x * 32 + C.tid] = base; }
#endif
}

__device__ __forceinline__ void p7_dispatch(const Params& P, const Ctx& C) {
    unsigned char* ws = P.ws;
    LAS int* ps = (LAS int*)(C.lds + MISC_OFF + 256);
    const unsigned* cnt = (const unsigned*)(ws + WS_CTL) + CW_CNT;
    int* tile_e = (int*)(ws + WS_TILEE);
    if (C.tid == 0) { int run = 0;
        for (int e = 0; e < NE; ++e) { const int c = (int)__hip_atomic_load(cnt + e, __ATOMIC_RELAXED, __HIP_MEMORY_SCOPE_AGENT); ps[e] = run; const int nt = (c + 255) >> 8;
            if (blockIdx.x == 0) for (int t = 0; t < nt; ++t) tile_e[(run >> 8) + t] = e;
            run += nt << 8; }
        if (blockIdx.x == 0) tile_e[MAXTILES] = run >> 8; }
    __syncthreads();
    const int* tope = (const int*)(ws + WS_TOPE); const float* gate = (const float*)(ws + WS_GATE); const int* lrank = (const int*)(ws + WS_LRANK);
    const int* wgb = (const int*)(ws + WS_WGBASE);
    int* tokslot = (int*)(ws + WS_TOKSLOT); float* slotgate = (float*)(ws + WS_SLOTGATE);
    const bf16* XB = (const bf16*)(ws + WS_XB); bf16* xs = (bf16*)(ws + WS_XS);
    for (int m = C.gw; m < NTOK; m += C.ngw) {
        const int wgm = (m % C.ngw) >> 3;
        const v4u r0 = *(const GAS v4u*)(XB + (size_t)m * D + 8 * C.lane), r1 = *(const GAS v4u*)(XB + (size_t)m * D + 512 + 8 * C.lane);
#pragma unroll
        for (int k = 0; k < 4; ++k) { const int e = tope[m * 4 + k]; const int slot = ps[e] + wgb[wgm * 32 + e] + lrank[m * 4 + k];
            bf16* dst = xs + (size_t)slot * D; *(GAS v4u*)(dst + 8 * C.lane) = r0; *(GAS v4u*)(dst + 512 + 8 * C.lane) = r1;
            if (C.lane == 0) { slotgate[slot] = gate[m * 4 + k]; tokslot[m * 4 + k] = slot; } }
    }
}

__device__ __forceinline__ void p10_combine_ln2(const Params& P, const Ctx& C) {
    unsigned char* ws = P.ws;
    float* X1 = (float*)(ws + WS_X1); bf16* XB = (bf16*)(ws + WS_XB);
    const int* tokslot = (const int*)(ws + WS_TOKSLOT); const bf16* ys = (const bf16*)(ws + WS_YSLOT);
    for (int m = C.gw; m < NTOK; m += C.ngw) {
        f32x4 v[4]; load_row_f32(v, X1 + (size_t)m * D, C.lane);
#pragma unroll
        for (int j = 0; j < 4; ++j) v[j] = v[j] * ALPHA;
#if FEAT_MOE
#pragma unroll
        for (int k = 0; k < 4; ++k) { const int slot = tokslot[m * 4 + k]; const bf16* yr = ys + (size_t)slot * D;
#pragma unroll
            for (int j = 0; j < 4; ++j) { const v2u w = *(const GAS v2u*)(yr + 4 * C.lane + 256 * j); v[j][0] += bflo(w.x); v[j][1] += bfhi(w.x); v[j][2] += bflo(w.y); v[j][3] += bfhi(w.y); } }
#endif
        ln_row(v, P.in[I_LNFG], P.in[I_LNFB], C.lane);
        store_row_f32(X1 + (size_t)m * D, v, C.lane);
        store_row_bf16(XB + (size_t)m * D, v, C.lane);
    }
}

__device__ __forceinline__ void p12_final_ln(const Params& P, const Ctx& C) {
#if FEAT_PLE
    const float* src = P.out; const float sc = 1.0f;
#else
    const float* src = (const float*)(P.ws + WS_X1); const float sc = ALPHA;
#endif
    for (int m = C.gw; m < NTOK; m += C.ngw) {
        f32x4 v[4]; load_row_f32(v, src + (size_t)m * D, C.lane);
#pragma unroll
        for (int j = 0; j < 4; ++j) v[j] = v[j] * sc;
        ln_row(v, P.in[I_LNPG], P.in[I_LNPB], C.lane);
        store_row_f32(P.out + (size_t)m * D, v, C.lane);
    }
}

#ifndef SYNC_MODE
#define SYNC_MODE 0
#endif
__global__ void __launch_bounds__(NTHR, 2) mega_fwd(Params P) {
    extern __shared__ __attribute__((aligned(16))) unsigned char lds_raw[];
    cg::grid_group grid = cg::this_grid();
    Ctx C;
    C.lds = (LAS unsigned char*)lds_raw;
    C.tid = threadIdx.x; C.lane = C.tid & 63; C.wave = __builtin_amdgcn_readfirstlane(C.tid >> 6);
    C.G = gridDim.x; C.gw = blockIdx.x * NWAVES + C.wave; C.ngw = C.G * NWAVES;
    unsigned char* ws = P.ws;
    const int lo = P.ph_lo, hi = P.ph_hi;
#define IN(k) (lo <= (k) && (k) < hi)
#define SEAM(k) do { if (IN(k) && IN((k) + 1)) grid.sync(); } while (0)
    typedef pg8::bf16_t pbf;

    if (IN(0)) p0_prologue(P, C);
    SEAM(0);
    if (IN(1)) {
#if FEAT_MIX
        { pg8::Gemm g{(const pbf*)(ws + WS_XBF), (const pbf*)(ws + WS_WIN_T), NTOK, D_INP, D}; pg8::StaticOrder S; S.init(NTOK, D_INP, C.G, (int)blockIdx.x);
          pg8::EpiBf16s E{(pbf*)(ws + WS_H), D_INP};
          pg8::gemm_phase<pg8::EpiBf16s, pg8::StaticOrder, true, true>(C.lds, g, S, E); }
#endif
#if FEAT_PLE
        { pg8::Gemm g{(const pbf*)(ws + WS_PB), (const pbf*)(ws + WS_WPROJ_T), NTOK, D, PLE}; pg8::StaticOrder S; S.init(NTOK, D, C.G, (int)blockIdx.x);
          pg8::EpiBf16s E{(pbf*)(ws + WS_PROJ), D};
          pg8::gemm_phase<pg8::EpiBf16s, pg8::StaticOrder, true, true>(C.lds, g, S, E); }
#endif
    }
    SEAM(1);
#if FEAT_MIX
    if (IN(2)) { p2_post(P, C); p2_hgrn_prep(P, C); }
    SEAM(2);
    if (IN(3)) {
#if FEAT_ATT
        { pg8::Gemm g{(const pbf*)(ws + WS_CN), (const pbf*)(ws + WS_WUK_T), NTOK, 512, 256}; pg8::StaticOrder S; S.init(NTOK, 512, C.G, (int)blockIdx.x);
          pg8::EpiKhead E{(pbf*)(ws + WS_K)};
          pg8::gemm_phase<pg8::EpiKhead, pg8::StaticOrder, true, true>(C.lds, g, S, E); }
        { pg8::Gemm g{(const pbf*)(ws + WS_WUV_T), (const pbf*)(ws + WS_CN), 512, NTOK, 256}; pg8::StaticOrder S; S.init(512, NTOK, C.G, (int)blockIdx.x);
          pg8::EpiVt E{(pbf*)(ws + WS_VT)};
          pg8::gemm_phase<pg8::EpiVt, pg8::StaticOrder, true, true>(C.lds, g, S, E); }
        p3_indexer(P, C);
        __syncthreads();
#endif
        p3_hgrn_scan(P, C);
    }
    SEAM(3);
    if (IN(4)) {
#if FEAT_ATT
        p4_attention(P, C);
#endif
        p4_yrec(P, C);
    }
    SEAM(4);
    if (IN(5)) {
        pg8::Gemm g{(const pbf*)(ws + WS_YMIX), (const pbf*)(ws + WS_WO_T), NTOK, D, D}; pg8::StaticOrder S; S.init(NTOK, D, C.G, (int)blockIdx.x);
        pg8::EpiResid E{P.in[I_X], (float*)(ws + WS_X1), D, ALPHA};
        pg8::gemm_phase<pg8::EpiResid, pg8::StaticOrder, true, true>(C.lds, g, S, E);
    }
    SEAM(5);
#endif
    if (IN(6)) p6_ln1_router(P, C);
    SEAM(6);
#if FEAT_MOE
    if (IN(7)) p7_dispatch(P, C);
    SEAM(7);
    if (IN(8)) {
        const int* tile_e = (const int*)(ws + WS_TILEE);
        pg8::Gemm g{(const pbf*)(ws + WS_XS), (const pbf*)(ws + WS_WUP_T), CAP, NE * 2048, D};
        pg8::MoeOrder S{tile_e, tile_e[MAXTILES], 8, C.G, (int)blockIdx.x};
        pg8::EpiSwiglu E{(pbf*)(ws + WS_HH), P.in[I_BUP]};
        pg8::gemm_phase<pg8::EpiSwiglu, pg8::MoeOrder, true, true>(C.lds, g, S, E);
    }
    SEAM(8);
    if (IN(9)) {
        const int* tile_e = (const int*)(ws + WS_TILEE);
        pg8::Gemm g{(const pbf*)(ws + WS_HH), (const pbf*)(ws + WS_WDN_T), CAP, NE * 1024, DFF};
        pg8::MoeOrder S{tile_e, tile_e[MAXTILES], 4, C.G, (int)blockIdx.x};
        pg8::EpiDown E{(pbf*)(ws + WS_YSLOT), P.in[I_BDN], (const float*)(ws + WS_SLOTGATE)};
        pg8::gemm_phase<pg8::EpiDown, pg8::MoeOrder, true, true>(C.lds, g, S, E);
    }
    SEAM(9);
#endif
    if (IN(10)) p10_combine_ln2(P, C);
    SEAM(10);
#if FEAT_PLE
    if (IN(11)) {
        pg8::Gemm g{(const pbf*)(ws + WS_XB), (const pbf*)(ws + WS_WGATE_T), NTOK, D, D}; pg8::StaticOrder S; S.init(NTOK, D, C.G, (int)blockIdx.x);
        pg8::EpiPle E{(const float*)(ws + WS_X1), (const pbf*)(ws + WS_PROJ), P.out, ALPHA};
        pg8::gemm_phase<pg8::EpiPle, pg8::StaticOrder, true, true>(C.lds, g, S, E);
    }
    SEAM(11);
#endif
    if (IN(12)) p12_final_ln(P, C);
#undef IN
#undef SEAM
}

extern "C" void kernel_launch(void* const* d_in, const int* in_sizes, int n_in, void* d_out, int out_size, void* d_ws, size_t ws_size, hipStream_t stream) {
    static int grid = 0;
    if (grid == 0) {
        if (n_in != 25 || out_size != NTOK * D || ws_size < WS_END) { fprintf(stderr, "kernel_launch: unexpected shapes (n_in %d out %d ws %zu)\n", n_in, out_size, ws_size); grid = -1; return; }
        int dev = 0, cus = 0, per_cu = 0;
        if (hipGetDevice(&dev) != hipSuccess || hipDeviceGetAttribute(&cus, hipDeviceAttributeMultiprocessorCount, dev) != hipSuccess) { grid = -1; return; }
        if (hipFuncSetAttribute((const void*)mega_fwd, hipFuncAttributeMaxDynamicSharedMemorySize, LDS_BYTES) != hipSuccess) { fprintf(stderr, "kernel_launch: hipFuncSetAttribute failed\n"); grid = -1; return; }
        if (hipOccupancyMaxActiveBlocksPerMultiprocessor(&per_cu, (const void*)mega_fwd, NTHR, LDS_BYTES) != hipSuccess || per_cu < 1) { fprintf(stderr, "kernel_launch: occupancy query failed (%d)\n", per_cu); (void)hipGetLastError(); grid = -1; return; }
        grid = cus * per_cu;
        fprintf(stderr, "kernel_launch: grid %d (%d CUs x %d)\n", grid, cus, per_cu);
    }
    if (grid < 0) return;
    (void)hipMemsetAsync((char*)d_ws + WS_CTL, 0, CTL_ZERO_BYTES, stream);
    Params p{};
    for (int i = 0; i < 25; ++i) p.in[i] = (const float*)d_in[i];
    p.out = (float*)d_out; p.ws = (unsigned char*)d_ws; p.ph_lo = 0; p.ph_hi = 13;
    void* args[] = {&p};
    hipError_t e = hipLaunchCooperativeKernel((const void*)mega_fwd, dim3(grid), dim3(NTHR), args, LDS_BYTES, stream);
    if (e != hipSuccess) fprintf(stderr, "kernel_launch: cooperative launch failed: %s (grid %d)\n", hipGetErrorString(e), grid);
}
```

```cpp
#define SYNC_MODE 1
#include <hip/hip_runtime.h>
#include <hip/hip_cooperative_groups.h>
#include <cstdio>
#include <cstdint>
namespace cg = cooperative_groups;

namespace pg8 {
#define PG8_LAS __attribute__((address_space(3)))
typedef unsigned short bf16_t;
typedef short bf16x8 __attribute__((ext_vector_type(8)));
typedef float f32x4 __attribute__((ext_vector_type(4)));
typedef unsigned u32x4 __attribute__((ext_vector_type(4)));
constexpr int BM = 256, BK = 64, HALF = 128, HTB = HALF * BK * 2  , STAGE_BYTES = 8 * HTB, NXCD = 8, WGM = 8;

__host__ __device__ __forceinline__ int lds_byte(int r, int c) { const int st = (r >> 4) * 2 + (c >> 5), rr = r & 15, cc = c & 31, ob = rr * 64 + cc * 2; return st * 1024 + (ob ^ (((ob >> 9) & 1) << 5)); }
__host__ __device__ __forceinline__ void stage_rc(int b, int& R, int& C) { const int st = b / 1024, sb = b % 1024, swz = sb ^ (((sb >> 9) & 1) << 5); R = (st >> 1) * 16 + swz / 64; C = (st & 1) * 32 + (swz % 64) / 2; }
__host__ __device__ __forceinline__ int perm32(int rho) { const int n = rho >> 4, i = rho & 15; return 8 * (i >> 2) + 4 * n + (i & 3); }

struct Unit { int pm, pn; };
struct Gemm { const bf16_t* A; const bf16_t* Bt; int M, N, K; };

struct StaticOrder {
    int nM, nN, nwg, G, c;
    __host__ __device__ void init(int M, int N, int G_, int c_) { nM = M / BM; nN = N / BM; nwg = nM * nN; G = G_; c = c_; }
    __host__ __device__ bool next(int i, Unit& u) const {
        const long L = (long)i * G + c; if (L >= nwg) return false;
        int wgid = (int)L; { const int q = nwg / NXCD, r = nwg % NXCD, xcd = wgid % NXCD, off = wgid / NXCD; wgid = (xcd < r ? xcd * (q + 1) : r * (q + 1) + (xcd - r) * q) + off; }
        const int nig = WGM * nN, gid = wgid / nig, fm = gid * WGM, gsz = (nM - fm) < WGM ? (nM - fm) : WGM;
        u.pm = fm + ((wgid % nig) % gsz); u.pn = (wgid % nig) / gsz; return true;
    }
    __device__ __forceinline__ void a_ready(const Unit&) const {}
    __device__ __forceinline__ void done(const Unit&) const {}
};

__device__ __forceinline__ unsigned cvt_pk_bf16(float lo, float hi) { unsigned r; asm volatile("v_cvt_pk_bf16_f32 %0, %1, %2" : "=v"(r) : "v"(lo), "v"(hi)); return r; }
typedef float f32x2 __attribute__((ext_vector_type(2)));
template <class Epi, class Sched, bool ALIGN_EPI = false, bool SP2 = false>
__device__ __forceinline__ void gemm_phase(PG8_LAS unsigned char* lds, const Gemm g, const Sched& S, const Epi& E) {
    const int tid = threadIdx.x, wid = __builtin_amdgcn_readfirstlane(tid >> 6), lane = tid & 63, wr = wid >> 2, wc = wid & 3, fr = lane & 15, fq = lane >> 4;
    const int K = g.K, nt = K / BK;
    unsigned voffA[2], voffB[2];
#pragma unroll
    for (int i = 0; i < 2; ++i) { int R, C; stage_rc(tid * 16 + i * 8192, R, C); const int Rb = Epi::PERM ? ((R & ~31) + perm32(R & 31)) : R;
        voffA[i] = (unsigned)(R * K + C) * 2u; voffB[i] = (unsigned)(Rb * K + C) * 2u; }
    const size_t kstep = (size_t)(BK * 2);
    const size_t hstep = (size_t)HALF * K * 2;
    const size_t tstep = 2 * hstep;
    const unsigned ldsw = (unsigned)wid * 1024u;
    const int aoff = lds_byte(wr * 64 + fr, fq * 8), boff = lds_byte(wc * 32 + fr, fq * 8);
#define PG8_SA(b, h) (((b) * 2 + (h)) * HTB)
#define PG8_SB(b, h) ((4 + (b) * 2 + (h)) * HTB)
#define PG8_STAGE(bufoff, gbase, voff) do { _Pragma("unroll") for (int _i = 0; _i < 2; ++_i) \
        __builtin_amdgcn_global_load_lds((const unsigned*)((const char*)(gbase) + (voff)[_i]), (PG8_LAS unsigned*)(lds + (bufoff) + ldsw + _i * 8192), 16, 0, 0); } while (0)
#define PG8_LDA(dst, b, h) do { _Pragma("unroll") for (int m = 0; m < 4; ++m) _Pragma("unroll") for (int k = 0; k < 2; ++k) dst[m][k] = *(const PG8_LAS bf16x8*)(lds + PG8_SA(b, h) + aoff + m * 2048 + k * 1024); } while (0)
#define PG8_LDB(dst, b, h) do { _Pragma("unroll") for (int n = 0; n < 2; ++n) _Pragma("unroll") for (int k = 0; k < 2; ++k) dst[n][k] = *(const PG8_LAS bf16x8*)(lds + PG8_SB(b, h) + boff + n * 2048 + k * 1024); } while (0)
#define PG8_MMA(ai, bj, At, Bt) do { __builtin_amdgcn_s_setprio(1); _Pragma("unroll") for (int m = 0; m < 4; ++m) _Pragma("unroll") for (int n = 0; n < 2; ++n) _Pragma("unroll") for (int k = 0; k < 2; ++k) \
        acc[ai][bj][m][n] = __builtin_amdgcn_mfma_f32_16x16x32_bf16(Bt[n][k], At[m][k], acc[ai][bj][m][n], 0, 0, 0); __builtin_amdgcn_s_setprio(0); } while (0)
#define PG8_WAIT_V(n) asm volatile("s_waitcnt vmcnt(" #n ")" ::: "memory")
#define PG8_WAIT_L(n) asm volatile("s_waitcnt lgkmcnt(" #n ")" ::: "memory")
#define PG8_BAR __builtin_amdgcn_s_barrier()
#define PG8_SCHED __builtin_amdgcn_sched_barrier(0)
    Unit cur, nxt; int ui = 0;
    if (!S.next(0, cur)) return;
    f32x4 acc[2][2][4][2];
#pragma unroll
    for (int a = 0; a < 2; ++a)
#pragma unroll
        for (int b = 0; b < 2; ++b)
#pragma unroll
            for (int m = 0; m < 4; ++m)
#pragma unroll
                for (int n = 0; n < 2; ++n) acc[a][b][m][n] = (f32x4){0.f, 0.f, 0.f, 0.f};
    bf16x8 At[4][2], B0[2][2], B1[2][2];
    const char* cA = (const char*)g.A + (size_t)cur.pm * tstep; const char* cB = (const char*)g.Bt + (size_t)cur.pn * tstep;
    S.a_ready(cur);
    if constexpr (SP2) {
        PG8_STAGE(PG8_SB(0, 0), cB, voffB); PG8_STAGE(PG8_SB(0, 1), cB + hstep, voffB); PG8_STAGE(PG8_SA(0, 0), cA, voffA); PG8_STAGE(PG8_SA(0, 1), cA + hstep, voffA);
        if (wr == 1) PG8_BAR;
        PG8_WAIT_V(2); PG8_BAR;
        PG8_STAGE(PG8_SB(1, 0), cB + kstep, voffB); PG8_STAGE(PG8_SA(1, 0), cA + kstep, voffA); PG8_STAGE(PG8_SB(1, 1), cB + hstep + kstep, voffB);
        PG8_WAIT_V(6); PG8_BAR;
    } else {
        PG8_STAGE(PG8_SB(0, 0), cB, voffB); PG8_STAGE(PG8_SA(0, 0), cA, voffA); PG8_STAGE(PG8_SB(0, 1), cB + hstep, voffB); PG8_STAGE(PG8_SA(0, 1), cA + hstep, voffA);
        if (wr == 1) PG8_BAR;
        PG8_WAIT_V(4); PG8_BAR;
        PG8_STAGE(PG8_SB(1, 0), cB + kstep, voffB); PG8_STAGE(PG8_SA(1, 0), cA + kstep, voffA); PG8_STAGE(PG8_SB(1, 1), cB + hstep + kstep, voffB);
        PG8_WAIT_V(6); PG8_BAR;
    }
    for (;;) {
        const bool has_next = S.next(ui + 1, nxt);
        const char* nA = has_next ? (const char*)g.A + (size_t)nxt.pm * tstep : cA; const char* nB = has_next ? (const char*)g.Bt + (size_t)nxt.pn * tstep : cB;
_Pragma("nounroll")
        for (int t = 0; t < nt; t += 2) {
            const bool last = (t == nt - 2);
            const char* a1 = cA + (size_t)(t + 1) * kstep;
            const char* a2 = last ? nA : cA + (size_t)(t + 2) * kstep; const char* b2 = last ? nB : cB + (size_t)(t + 2) * kstep;
            const char* a3 = a2 + kstep; const char* b3 = b2 + kstep;
            if (last && has_next) S.a_ready(nxt);
            if constexpr (SP2) {
            PG8_LDB(B0, 0, 0); PG8_LDB(B1, 0, 1); PG8_SCHED; PG8_LDA(At, 0, 0); PG8_STAGE(PG8_SA(1, 1), a1 + hstep, voffA);
            PG8_WAIT_V(8); PG8_WAIT_L(0); PG8_BAR; PG8_MMA(0, 0, At, B0); PG8_MMA(0, 1, At, B1); PG8_BAR; PG8_SCHED;
            PG8_LDA(At, 0, 1); PG8_STAGE(PG8_SB(0, 0), b2, voffB); PG8_STAGE(PG8_SB(0, 1), b2 + hstep, voffB); PG8_STAGE(PG8_SA(0, 0), a2, voffA);
            PG8_WAIT_V(8); PG8_WAIT_L(0); PG8_BAR; PG8_MMA(1, 0, At, B0); PG8_MMA(1, 1, At, B1); PG8_BAR; PG8_SCHED;
            PG8_LDB(B0, 1, 0); PG8_LDB(B1, 1, 1); PG8_SCHED; PG8_LDA(At, 1, 0); PG8_STAGE(PG8_SA(0, 1), a2 + hstep, voffA);
            PG8_WAIT_V(8); PG8_WAIT_L(0); PG8_BAR; PG8_MMA(0, 0, At, B0); PG8_MMA(0, 1, At, B1); PG8_BAR; PG8_SCHED;
            PG8_LDA(At, 1, 1); PG8_STAGE(PG8_SB(1, 0), b3, voffB); PG8_STAGE(PG8_SB(1, 1), b3 + hstep, voffB); PG8_STAGE(PG8_SA(1, 0), a3, voffA);
            PG8_WAIT_V(8); PG8_WAIT_L(0); PG8_BAR; PG8_MMA(1, 0, At, B0); PG8_MMA(1, 1, At, B1); PG8_BAR; PG8_SCHED;
            } else {
            PG8_LDB(B0, 0, 0); PG8_SCHED; PG8_LDA(At, 0, 0); PG8_STAGE(PG8_SA(1, 1), a1 + hstep, voffA);
            PG8_WAIT_L(8); PG8_BAR; PG8_WAIT_L(0); PG8_MMA(0, 0, At, B0); PG8_BAR; PG8_SCHED;
            PG8_LDB(B1, 0, 1); PG8_STAGE(PG8_SB(0, 0), b2, voffB);
            PG8_BAR; PG8_WAIT_L(0); PG8_MMA(0, 1, At, B1); PG8_BAR;
            PG8_LDA(At, 0, 1); PG8_STAGE(PG8_SA(0, 0), a2, voffA);
            PG8_BAR; PG8_WAIT_L(0); PG8_MMA(1, 0, At, B0); PG8_BAR; PG8_SCHED;
            PG8_STAGE(PG8_SB(0, 1), b2 + hstep, voffB);
            PG8_WAIT_V(6); PG8_BAR; PG8_MMA(1, 1, At, B1); PG8_BAR;
            PG8_LDB(B0, 1, 0); PG8_SCHED; PG8_LDA(At, 1, 0); PG8_STAGE(PG8_SA(0, 1), a2 + hstep, voffA);
            PG8_WAIT_L(8); PG8_BAR; PG8_WAIT_L(0); PG8_MMA(0, 0, At, B0); PG8_BAR; PG8_SCHED;
            PG8_LDB(B1, 1, 1); PG8_STAGE(PG8_SB(1, 0), b3, voffB);
            PG8_BAR; PG8_WAIT_L(0); PG8_MMA(0, 1, At, B1); PG8_BAR;
            PG8_LDA(At, 1, 1); PG8_STAGE(PG8_SA(1, 0), a3, voffA);
            PG8_BAR; PG8_WAIT_L(0); PG8_MMA(1, 0, At, B0); PG8_BAR; PG8_SCHED;
            PG8_STAGE(PG8_SB(1, 1), b3 + hstep, voffB);
            PG8_WAIT_V(6); PG8_BAR; PG8_MMA(1, 1, At, B1); PG8_BAR;
            }
        }
        if constexpr (ALIGN_EPI) { if (wr == 0) PG8_BAR; }
        if constexpr (!Epi::AFTER_DRAIN) { E(acc, cur, wr, wc, fr, fq); S.done(cur); }
        if (!has_next) break;
#pragma unroll
        for (int a = 0; a < 2; ++a)
#pragma unroll
            for (int b = 0; b < 2; ++b)
#pragma unroll
                for (int m = 0; m < 4; ++m)
#pragma unroll
                    for (int n = 0; n < 2; ++n) acc[a][b][m][n] = (f32x4){0.f, 0.f, 0.f, 0.f};
        cur = nxt; cA = nA; cB = nB; ++ui;
        if constexpr (ALIGN_EPI) { if (wr == 1) PG8_BAR; }
    }
    PG8_WAIT_V(0);
    if constexpr (!ALIGN_EPI) { if (wr == 0) PG8_BAR; }
    PG8_BAR;
    if constexpr (Epi::AFTER_DRAIN) { E.fused(acc, cur, wr, wc, fr, fq, lds, wid, lane); S.done(cur); }
#undef PG8_SA
#undef PG8_SB
#undef PG8_STAGE
#undef PG8_LDA
#undef PG8_LDB
#undef PG8_MMA
#undef PG8_WAIT_V
#undef PG8_WAIT_L
#undef PG8_BAR
#undef PG8_SCHED
}
}

constexpr int NB = 8, T = 4096, D = 1024, NTOK = NB * T;
constexpr int ATT_H = 8, ATT_D = 64, ATT_W = 512, KV_LAT = 256, IDX_H = 8, IDX_D = 64, TOPK = 256;
constexpr int HG_H = 4, HG_DK = 128, HG_DV = 128, HG_W = 512, HG_C = 32;
constexpr int D_IN = 3400, D_INP = 3584;
constexpr int C_AQ = 0, C_AC = 512, C_IQ = 768, C_IK = 1280, C_IW = 1344, C_GQ = 1352, C_GF = 1864, C_GI = 2376, C_GG = 2888;
constexpr int NE = 32, TOPE = 4, DFF = 1024, PLE = 256;
constexpr int NASSIGN = NTOK * TOPE, CAP = NASSIGN + NE * 256;
constexpr int MAXTILES = CAP / 256;
constexpr float LN_EPS = 1e-5f, RMS_EPS = 1e-6f, ALPHA = 1.189207115002721f;

constexpr size_t MiB = 1u << 20;
constexpr size_t WS_CTL = 0, CTL_ZERO_BYTES = 64 * 1024;
constexpr size_t WS_WIN_T = 1 * MiB, WS_WO_T = 8 * MiB, WS_WUP_T = 10 * MiB, WS_WDN_T = 138 * MiB, WS_WPROJ_T = 202 * MiB, WS_WGATE_T = 203 * MiB;
constexpr size_t WS_WUK_T = 205 * MiB, WS_WUV_T = 205 * MiB + 512 * 1024;
constexpr size_t WS_SMALL = 206 * MiB;
constexpr size_t WS_A = 208 * MiB;
constexpr size_t WS_B = 480 * MiB;
constexpr size_t WS_X1 = 752 * MiB;
constexpr size_t WS_XB = 880 * MiB;
constexpr size_t WS_PROJ = 944 * MiB;
constexpr size_t WS_SM2 = 1008 * MiB;
constexpr size_t WS_END = 1016 * MiB;
constexpr size_t WS_H = WS_A, WS_XS = WS_A, WS_YSLOT = WS_A;
constexpr size_t WS_XBF = WS_B, WS_U = WS_B, WS_YMIX = WS_B, WS_HH = WS_B;
constexpr size_t WS_QDEC = WS_B + 128 * MiB, WS_PB = WS_B + 128 * MiB, WS_OREC = WS_B + 160 * MiB, WS_CN = WS_B + 224 * MiB, WS_IKN = WS_B + 240 * MiB, WS_MASK = WS_B + 244 * MiB;
constexpr size_t WS_K = WS_XB, WS_VT = WS_XB + 32 * MiB;
constexpr size_t WS_TOPE = WS_SM2, WS_GATE = WS_SM2 + 512 * 1024, WS_LRANK = WS_SM2 + 1024 * 1024, WS_TOKSLOT = WS_SM2 + 1536 * 1024, WS_SLOTGATE = WS_SM2 + 2 * MiB, WS_DECAY = WS_SM2 + 3 * MiB;
constexpr size_t WS_WGBASE = WS_SMALL, WS_TILEE = WS_SMALL + 64 * 1024;
constexpr int CW_CNT = 64;
constexpr int CW_BAR = 1024;
constexpr int XBW_OFF = 147456 - 16;

constexpr int RING_BYTES = 131072, MISC_OFF = RING_BYTES, LDS_BYTES = 147456;
constexpr int NWAVES = 8, NTHR = 512;

#define GAS __attribute__((address_space(1)))
#define LAS __attribute__((address_space(3)))
typedef unsigned short bf16;
typedef unsigned v4u __attribute__((ext_vector_type(4)));
typedef unsigned v2u __attribute__((ext_vector_type(2)));
typedef float f32x4 __attribute__((ext_vector_type(4)));
typedef short bf16x8 __attribute__((ext_vector_type(8)));
#define LDS_WAIT() asm volatile("s_waitcnt lgkmcnt(0)" ::: "memory")
#define VM_WAIT() asm volatile("s_waitcnt vmcnt(0)" ::: "memory")
__device__ __forceinline__ unsigned f2bf(float f) { unsigned u = __builtin_bit_cast(unsigned, f); return (u + 0x7fffu + ((u >> 16) & 1u)) >> 16; }
__device__ __forceinline__ unsigned pk2(float lo, float hi) { return f2bf(lo) | (f2bf(hi) << 16); }
__device__ __forceinline__ float bf2f(unsigned short b) { return __builtin_bit_cast(float, (unsigned)b << 16); }
__device__ __forceinline__ float bflo(unsigned w) { return __builtin_bit_cast(float, w << 16); }
__device__ __forceinline__ float bfhi(unsigned w) { return __builtin_bit_cast(float, w & 0xffff0000u); }
__device__ __forceinline__ float wave_sum(float v) {
#pragma unroll
    for (int o = 1; o < 64; o <<= 1) v += __shfl_xor(v, o);
    return v;
}
__device__ __forceinline__ float sigmoidf_(float x) { return 1.f / (1.f + __expf(-x)); }

struct Params { const float* in[25]; float* out; unsigned char* ws; };
enum { I_X = 0, I_P, I_WIN, I_KVG, I_IKG, I_IKB, I_WUK, I_WUV, I_HGLB, I_HGNG, I_WO, I_LNMG, I_LNMB, I_WR, I_BR, I_WUP, I_BUP, I_WDN, I_BDN, I_LNFG, I_LNFB, I_WPP, I_WPG, I_LNPG, I_LNPB };

struct Ctx { LAS unsigned char* lds; int tid, lane, wave, G, gw, ngw; };

namespace pg8 {
struct EpiBf16s {
    static constexpr bool PERM = true, AFTER_DRAIN = false;
    bf16_t* O; int ldc;
    __device__ __forceinline__ void operator()(const f32x4 (&acc)[2][2][4][2], const Unit& u, int wr, int wc, int fr, int fq) const {
        const int row0 = u.pm * BM + wr * 64 + fr, col0 = u.pn * BM + wc * 32 + 8 * fq;
#pragma unroll
        for (int ai = 0; ai < 2; ++ai)
#pragma unroll
            for (int m = 0; m < 4; ++m) { bf16_t* rowp = O + (size_t)(row0 + ai * HALF + m * 16) * ldc + col0;
#pragma unroll
                for (int bj = 0; bj < 2; ++bj) { const f32x4 v0 = acc[ai][bj][m][0], v1 = acc[ai][bj][m][1];
                    u32x4 w; w.x = cvt_pk_bf16(v0[0], v0[1]); w.y = cvt_pk_bf16(v0[2], v0[3]); w.z = cvt_pk_bf16(v1[0], v1[1]); w.w = cvt_pk_bf16(v1[2], v1[3]);
                    *(u32x4*)(rowp + bj * HALF) = w; } }
    }
};
struct EpiResid {
    static constexpr bool PERM = false, AFTER_DRAIN = false;
    const float* res; float* out; int ldc; float alpha;
    __device__ __forceinline__ void operator()(const f32x4 (&acc)[2][2][4][2], const Unit& u, int wr, int wc, int fr, int fq) const {
        const int row0 = u.pm * BM + wr * 64 + fr, col0 = u.pn * BM + wc * 32 + 4 * fq;
#pragma unroll
        for (int ai = 0; ai < 2; ++ai)
#pragma unroll
            for (int m = 0; m < 4; ++m) { const size_t off = (size_t)(row0 + ai * HALF + m * 16) * ldc + col0;
#pragma unroll
                for (int bj = 0; bj < 2; ++bj)
#pragma unroll
                    for (int n = 0; n < 2; ++n) { const f32x4 r = *(const f32x4*)(res + off + bj * HALF + n * 16); *(f32x4*)(out + off + bj * HALF + n * 16) = r * alpha + acc[ai][bj][m][n]; }
                asm volatile("" ::: "memory"); }
    }
};
struct EpiPle {
    static constexpr bool PERM = false, AFTER_DRAIN = false;
    const float* x2; const bf16_t* proj; float* out; float alpha;
    __device__ __forceinline__ void operator()(const f32x4 (&acc)[2][2][4][2], const Unit& u, int wr, int wc, int fr, int fq) const {
        const int row0 = u.pm * BM + wr * 64 + fr, col0 = u.pn * BM + wc * 32 + 4 * fq;
#pragma unroll
        for (int ai = 0; ai < 2; ++ai)
#pragma unroll
            for (int m = 0; m < 4; ++m) { const size_t off = (size_t)(row0 + ai * HALF + m * 16) * 1024 + col0;
#pragma unroll
                for (int bj = 0; bj < 2; ++bj)
#pragma unroll
                    for (int n = 0; n < 2; ++n) { const size_t o2 = off + bj * HALF + n * 16; const f32x4 r = *(const f32x4*)(x2 + o2); const v2u pw = *(const v2u*)(proj + o2);
                        const f32x4 a = acc[ai][bj][m][n]; f32x4 o;
                        o[0] = r[0] * alpha + bflo(pw.x) * sigmoidf_(a[0]); o[1] = r[1] * alpha + bfhi(pw.x) * sigmoidf_(a[1]);
                        o[2] = r[2] * alpha + bflo(pw.y) * sigmoidf_(a[2]); o[3] = r[3] * alpha + bfhi(pw.y) * sigmoidf_(a[3]);
                        *(f32x4*)(out + o2) = o; }
                asm volatile("" ::: "memory"); }
    }
};
struct EpiSwiglu {
    static constexpr bool PERM = true, AFTER_DRAIN = false;
    bf16_t* H; const float* b_up;
    __device__ __forceinline__ void operator()(const f32x4 (&acc)[2][2][4][2], const Unit& u, int wr, int wc, int fr, int fq) const {
        const int e = u.pn >> 3, pnT = u.pn & 7;
        const int row0 = u.pm * BM + wr * 64 + fr, col0 = pnT * 128 + wc * 32 + 8 * fq;
        const float* bg = b_up + (size_t)e * 2048 + col0; const float* bl = bg + 1024;
        float bgv[8], blv[8];
#pragma unroll
        for (int j = 0; j < 8; ++j) { bgv[j] = bg[j]; blv[j] = bl[j]; }
#pragma unroll
        for (int ai = 0; ai < 2; ++ai)
#pragma unroll
            for (int m = 0; m < 4; ++m) { bf16_t* rowp = H + (size_t)(row0 + ai * HALF + m * 16) * 1024 + col0; float a[8];
#pragma unroll
                for (int n = 0; n < 2; ++n)
#pragma unroll
                    for (int j = 0; j < 4; ++j) { float g = acc[ai][0][m][n][j] + bgv[4 * n + j], l = acc[ai][1][m][n][j] + blv[4 * n + j];
                        g = fminf(g, 7.0f); l = fminf(fmaxf(l, -7.0f), 7.0f); a[4 * n + j] = g * sigmoidf_(1.702f * g) * (l + 1.0f); }
                u32x4 w; w.x = cvt_pk_bf16(a[0], a[1]); w.y = cvt_pk_bf16(a[2], a[3]); w.z = cvt_pk_bf16(a[4], a[5]); w.w = cvt_pk_bf16(a[6], a[7]);
                *(u32x4*)rowp = w; }
    }
};
struct EpiDown {
    static constexpr bool PERM = true, AFTER_DRAIN = false;
    bf16_t* Y; const float* b_dn; const float* gate;
    __device__ __forceinline__ void operator()(const f32x4 (&acc)[2][2][4][2], const Unit& u, int wr, int wc, int fr, int fq) const {
        const int e = u.pn >> 2, pnT = u.pn & 3;
        const int row0 = u.pm * BM + wr * 64 + fr, col0 = pnT * 256 + wc * 32 + 8 * fq;
        const float* bb = b_dn + (size_t)e * 1024 + col0;
        float bv[2][8];
#pragma unroll
        for (int bj = 0; bj < 2; ++bj)
#pragma unroll
            for (int j = 0; j < 8; ++j) bv[bj][j] = bb[bj * HALF + j];
#pragma unroll
        for (int ai = 0; ai < 2; ++ai)
#pragma unroll
            for (int m = 0; m < 4; ++m) { const int row = row0 + ai * HALF + m * 16; const float gt = gate[row]; bf16_t* rowp = Y + (size_t)row * 1024 + col0;
#pragma unroll
                for (int bj = 0; bj < 2; ++bj) { const f32x4 v0 = acc[ai][bj][m][0], v1 = acc[ai][bj][m][1];
                    u32x4 w; w.x = cvt_pk_bf16((v0[0] + bv[bj][0]) * gt, (v0[1] + bv[bj][1]) * gt); w.y = cvt_pk_bf16((v0[2] + bv[bj][2]) * gt, (v0[3] + bv[bj][3]) * gt);
                    w.z = cvt_pk_bf16((v1[0] + bv[bj][4]) * gt, (v1[1] + bv[bj][5]) * gt); w.w = cvt_pk_bf16((v1[2] + bv[bj][6]) * gt, (v1[3] + bv[bj][7]) * gt);
                    *(u32x4*)(rowp + bj * HALF) = w; } }
    }
};
struct MoeOrder {
    const int* tile_e; int ntiles, nN, G, c;
    __device__ __forceinline__ bool next(int i, Unit& u) const {
        const int L = i * G + c; if (L >= ntiles * nN) return false;
        const int pm = L / nN, pl = L - pm * nN; u.pm = pm; u.pn = tile_e[pm] * nN + pl; return true;
    }
    __device__ __forceinline__ void a_ready(const Unit&) const {}
    __device__ __forceinline__ void done(const Unit&) const {}
};
}

template <class RowMap>
__device__ __forceinline__ void transpose_item(const float* W, int ldw, int Nvalid, bf16* WT, int Kdim, RowMap rm, LAS float* scr, int kb, int nb, int lane) {
    const int k0 = 64 * kb, n0 = 32 * nb; const int nl0 = lane & 31, nn = n0 + nl0;
#pragma unroll 8
    for (int i = 0; i < 32; ++i) { const int kk = 2 * i + (lane >> 5); scr[kk * 33 + nl0] = (nn < Nvalid) ? W[(size_t)(k0 + kk) * ldw + nn] : 0.f; }
    LDS_WAIT(); asm volatile("" ::: "memory");
    const int c = lane & 7;
#pragma unroll
    for (int j = 0; j < 4; ++j) { const int n = (lane >> 3) + 8 * j; const LAS float* s = scr + (8 * c) * 33 + n;
        v4u o; o.x = pk2(s[0 * 33], s[1 * 33]); o.y = pk2(s[2 * 33], s[3 * 33]); o.z = pk2(s[4 * 33], s[5 * 33]); o.w = pk2(s[6 * 33], s[7 * 33]);
        *(GAS v4u*)(WT + (size_t)rm(n0 + n) * Kdim + k0 + 8 * c) = o; }
    LDS_WAIT(); asm volatile("" ::: "memory");
}
struct RmId { __device__ __forceinline__ int operator()(int n) const { return n; } };
struct RmUp { int e; __device__ __forceinline__ int operator()(int n) const { return e * 2048 + ((n & 1023) >> 7) * 256 + (n >> 10) * 128 + (n & 127); } };
struct RmOff { int off; __device__ __forceinline__ int operator()(int n) const { return off + n; } };

__device__ __forceinline__ void p0_prologue(const Params& P, const Ctx& C) {
    LAS float* scr = (LAS float*)(C.lds + C.wave * 16384);
    unsigned char* ws = P.ws;
    constexpr int I_IN = 16 * (D_INP / 32), I_O = 16 * 32, I_UP = 16 * 64, I_DN = 16 * 32, I_PP = 4 * 32, I_PG = 16 * 32, I_UK = 4 * 16, I_UV = 4 * 16;
    constexpr int NITEMS = I_IN + I_O + NE * I_UP + NE * I_DN + I_PP + I_PG + I_UK + I_UV;
    for (int it = C.gw; it < NITEMS; it += C.ngw) {
        int r = it;
        if (r < I_IN) { transpose_item(P.in[I_WIN], D_IN, D_IN, (bf16*)(ws + WS_WIN_T), 1024, RmId{}, scr, r / (D_INP / 32), r % (D_INP / 32), C.lane); continue; } r -= I_IN;
        if (r < I_O) { transpose_item(P.in[I_WO], 1024, 1024, (bf16*)(ws + WS_WO_T), 1024, RmId{}, scr, r / 32, r % 32, C.lane); continue; } r -= I_O;
        if (r < NE * I_UP) { const int e = r / I_UP, q = r % I_UP; transpose_item(P.in[I_WUP] + (size_t)e * 1024 * 2048, 2048, 2048, (bf16*)(ws + WS_WUP_T), 1024, RmUp{e}, scr, q / 64, q % 64, C.lane); continue; } r -= NE * I_UP;
        if (r < NE * I_DN) { const int e = r / I_DN, q = r % I_DN; transpose_item(P.in[I_WDN] + (size_t)e * 1024 * 1024, 1024, 1024, (bf16*)(ws + WS_WDN_T), 1024, RmOff{e * 1024}, scr, q / 32, q % 32, C.lane); continue; } r -= NE * I_DN;
        if (r < I_PP) { transpose_item(P.in[I_WPP], 1024, 1024, (bf16*)(ws + WS_WPROJ_T), 256, RmId{}, scr, r / 32, r % 32, C.lane); continue; } r -= I_PP;
        if (r < I_PG) { transpose_item(P.in[I_WPG], 1024, 1024, (bf16*)(ws + WS_WGATE_T), 1024, RmId{}, scr, r / 32, r % 32, C.lane); continue; } r -= I_PG;
        if (r < I_UK) { transpose_item(P.in[I_WUK], 512, 512, (bf16*)(ws + WS_WUK_T), 256, RmId{}, scr, r / 16, r % 16, C.lane); continue; } r -= I_UK;
        transpose_item(P.in[I_WUV], 512, 512, (bf16*)(ws + WS_WUV_T), 256, RmId{}, scr, r / 16, r % 16, C.lane);
    }
    {
        const float* x = P.in[I_X]; bf16* xb = (bf16*)(ws + WS_XBF);
        const size_t n8 = (size_t)NTOK * D / 8, stride = (size_t)C.ngw * 64;
        for (size_t i = (size_t)C.gw * 64 + C.lane; i < n8; i += stride) { const f32x4 a = *(const GAS f32x4*)(x + i * 8), b = *(const GAS f32x4*)(x + i * 8 + 4);
            v4u o; o.x = pk2(a[0], a[1]); o.y = pk2(a[2], a[3]); o.z = pk2(b[0], b[1]); o.w = pk2(b[2], b[3]); *(GAS v4u*)(xb + i * 8) = o; }
        const float* p = P.in[I_P]; bf16* pb = (bf16*)(ws + WS_PB);
        const size_t m8 = (size_t)NTOK * PLE / 8;
        for (size_t i = (size_t)C.gw * 64 + C.lane; i < m8; i += stride) { const f32x4 a = *(const GAS f32x4*)(p + i * 8), b = *(const GAS f32x4*)(p + i * 8 + 4);
            v4u o; o.x = pk2(a[0], a[1]); o.y = pk2(a[2], a[3]); o.z = pk2(b[0], b[1]); o.w = pk2(b[2], b[3]); *(GAS v4u*)(pb + i * 8) = o; }
    }
}

__device__ __forceinline__ void ln_row(f32x4 (&v)[4], const float* g, const float* b, int lane) {
    float s = 0.f;
#pragma unroll
    for (int j = 0; j < 4; ++j) s += (v[j][0] + v[j][1]) + (v[j][2] + v[j][3]);
    const float mean = wave_sum(s) * (1.f / D); float s2 = 0.f;
#pragma unroll
    for (int j = 0; j < 4; ++j) { v[j] = v[j] - mean; s2 += (v[j][0] * v[j][0] + v[j][1] * v[j][1]) + (v[j][2] * v[j][2] + v[j][3] * v[j][3]); }
    const float rstd = 1.f / sqrtf(wave_sum(s2) * (1.f / D) + LN_EPS);
#pragma unroll
    for (int j = 0; j < 4; ++j) { const f32x4 gg = *(const f32x4*)(g + 4 * lane + 256 * j), bb = *(const f32x4*)(b + 4 * lane + 256 * j); v[j] = v[j] * rstd * gg + bb; }
}
__device__ __forceinline__ void store_row_f32(float* row, const f32x4 (&v)[4], int lane) {
#pragma unroll
    for (int j = 0; j < 4; ++j) *(GAS f32x4*)(row + 4 * lane + 256 * j) = v[j];
}
__device__ __forceinline__ void store_row_bf16(bf16* row, const f32x4 (&v)[4], int lane) {
#pragma unroll
    for (int j = 0; j < 4; ++j) { v2u o; o.x = pk2(v[j][0], v[j][1]); o.y = pk2(v[j][2], v[j][3]); *(GAS v2u*)(row + 4 * lane + 256 * j) = o; }
}
__device__ __forceinline__ void load_row_f32(f32x4 (&v)[4], const float* row, int lane) {
#pragma unroll
    for (int j = 0; j < 4; ++j) v[j] = *(const GAS f32x4*)(row + 4 * lane + 256 * j);
}
#ifndef FEAT_MIX
#define FEAT_MIX 1
#endif
#ifndef FEAT_MOE
#define FEAT_MOE 1
#endif
#ifndef FEAT_PLE
#define FEAT_PLE 1
#endif
#ifndef FEAT_ATT
#define FEAT_ATT 1
#endif
#ifndef SYNC_MODE
#define SYNC_MODE 0
#endif
#ifndef PROGRAM
#define PROGRAM X(0) GS X(10) X(11) SY X(20) X(21) SY X(30) X(31) BS X(32) SY X(40) X(41) SY X(5) SY X(6) SY X(7) SY X(8) SY X(9) SY X(100) SY X(110) SY X(120)
#endif

typedef float f32x16 __attribute__((ext_vector_type(16)));
typedef short s16x4 __attribute__((ext_vector_type(4)));
__device__ __forceinline__ unsigned cvtpk(float lo, float hi) { typedef float f2 __attribute__((ext_vector_type(2))); typedef __bf16 b2 __attribute__((ext_vector_type(2))); f2 v = {lo, hi}; b2 b = __builtin_convertvector(v, b2); return __builtin_bit_cast(unsigned, b); }
__device__ __forceinline__ bf16x8 pack8(const f32x16& x, int base) {
    v4u w; w.x = cvtpk(x[base + 0], x[base + 1]); w.y = cvtpk(x[base + 2], x[base + 3]); w.z = cvtpk(x[base + 4], x[base + 5]); w.w = cvtpk(x[base + 6], x[base + 7]);
    return __builtin_bit_cast(bf16x8, w);
}

__device__ __forceinline__ void p2_post(const Params& P, const Ctx& C) {
    unsigned char* ws = P.ws;
    const bf16* H = (const bf16*)(ws + WS_H); bf16* CN = (bf16*)(ws + WS_CN); bf16* IKN = (bf16*)(ws + WS_IKN);
    const float* kvg = P.in[I_KVG]; const float* ikg = P.in[I_IKG]; const float* ikb = P.in[I_IKB];
    const f32x4 g4 = *(const f32x4*)(kvg + 4 * C.lane); const float ig = ikg[C.lane], ib = ikb[C.lane];
    for (int m = C.gw; m < NTOK; m += C.ngw) {
        const bf16* hr = H + (size_t)m * D_INP;
        const v2u w = *(const GAS v2u*)(hr + C_AC + 4 * C.lane);
        float a0 = bflo(w.x), a1 = bfhi(w.x), a2 = bflo(w.y), a3 = bfhi(w.y);
        const float ss = wave_sum((a0 * a0 + a1 * a1) + (a2 * a2 + a3 * a3));
        const float rs = 1.f / sqrtf(ss * (1.f / 256.f) + RMS_EPS);
        v2u o; o.x = pk2(a0 * rs * g4[0], a1 * rs * g4[1]); o.y = pk2(a2 * rs * g4[2], a3 * rs * g4[3]);
        *(GAS v2u*)(CN + (size_t)m * 256 + 4 * C.lane) = o;
        const float k = bf2f(hr[C_IK + C.lane]);
        const float mu = wave_sum(k) * (1.f / 64.f); const float dk = k - mu;
        const float var = wave_sum(dk * dk) * (1.f / 64.f);
        IKN[(size_t)m * 64 + C.lane] = (bf16)f2bf(dk * (1.f / sqrtf(var + LN_EPS)) * ig + ib);
    }
}

constexpr int HP_QD = 0, HP_KI = 8704, HP_KET = 17408, HP_VT = 27648, HP_GS = 37888, HP_BYTES = 39936;
__device__ __forceinline__ void p2_hgrn_prep(const Params& P, const Ctx& C) {
    unsigned char* ws = P.ws;
    const bf16* H = (const bf16*)(ws + WS_H);
    bf16* UT = (bf16*)(ws + WS_U); bf16* QDEC = (bf16*)(ws + WS_QDEC); float* OREC = (float*)(ws + WS_OREC); float* DEC = (float*)(ws + WS_DECAY);
    LAS bf16* QD = (LAS bf16*)(C.lds + HP_QD); LAS bf16* KI = (LAS bf16*)(C.lds + HP_KI); LAS bf16* KET = (LAS bf16*)(C.lds + HP_KET); LAS bf16* VT = (LAS bf16*)(C.lds + HP_VT);
    LAS float* GS = (LAS float*)(C.lds + HP_GS);
    const int d = C.tid & 127, tg = C.tid >> 7;
    const int lane = C.lane, r32 = lane & 31, hf = lane >> 5;
    for (int unit = blockIdx.x; unit < NB * HG_H * (T / HG_C); unit += C.G) {
        const int n = unit & 127, hh = (unit >> 7) & 3, b = unit >> 9;
        const int m0 = b * T + n * HG_C;
        const float l0 = P.in[I_HGLB][hh * 128 + d], l1 = P.in[I_HGLB][512 + hh * 128 + d];
        const float lb = 1.f / (1.f + __expf(l1 - l0));
        float fg[8], bl[8], qv[8]; float run = 0.f; unsigned vv[4];
#pragma unroll
        for (int c = 0; c < 8; ++c) { const bf16* hr = H + (size_t)(m0 + tg * 8 + c) * D_INP + hh * 128 + d;
            const float f = bf2f(hr[C_GF]), q = bf2f(hr[C_GQ]); const unsigned iv = hr[C_GI];
            fg[c] = lb + (1.f - lb) * sigmoidf_(f); run += __logf(fg[c]); bl[c] = run; qv[c] = q * sigmoidf_(q);
            if (c & 1) vv[c >> 1] |= iv << 16; else vv[c >> 1] = iv; }
        GS[tg * 128 + d] = run;
        *(LAS v4u*)(VT + d * 40 + tg * 8) = (v4u){vv[0], vv[1], vv[2], vv[3]};
        __syncthreads();
        float pre = 0.f, tot = 0.f;
#pragma unroll
        for (int g = 0; g < 4; ++g) { const float s = GS[g * 128 + d]; tot += s; if (g < tg) pre += s; }
        unsigned ke[4];
#pragma unroll
        for (int c = 0; c < 8; ++c) { const float bc = pre + bl[c]; const float kc = 1.f - fg[c];
            const float qd = qv[c] * __expf(bc), ki = kc * __expf(-bc), kend = kc * __expf(tot - bc);
            const unsigned qb = f2bf(qd);
            QD[(tg * 8 + c) * 136 + d] = (bf16)qb; KI[(tg * 8 + c) * 136 + d] = (bf16)f2bf(ki);
            QDEC[(size_t)(m0 + tg * 8 + c) * 512 + hh * 128 + d] = (bf16)qb;
            if (c & 1) ke[c >> 1] |= f2bf(kend) << 16; else ke[c >> 1] = f2bf(kend); }
        *(LAS v4u*)(KET + d * 40 + tg * 8) = (v4u){ke[0], ke[1], ke[2], ke[3]};
        if (tg == 0) DEC[(size_t)unit * 128 + d] = __expf(tot);
        __syncthreads();
        if (C.wave < 4) {
            f32x16 X = {0.f, 0.f, 0.f, 0.f, 0.f, 0.f, 0.f, 0.f, 0.f, 0.f, 0.f, 0.f, 0.f, 0.f, 0.f, 0.f};
#pragma unroll
            for (int k = 0; k < 8; ++k) { const bf16x8 a = *(const LAS bf16x8*)(KI + r32 * 136 + 16 * k + 8 * hf), bq = *(const LAS bf16x8*)(QD + r32 * 136 + 16 * k + 8 * hf);
                X = __builtin_amdgcn_mfma_f32_32x32x16_bf16(a, bq, X, 0, 0, 0); }
#pragma unroll
            for (int r = 0; r < 16; ++r) { const int s = (r & 3) + 8 * (r >> 2) + 4 * hf; if (s > r32) X[r] = 0.f; }
            f32x16 Z = {0.f, 0.f, 0.f, 0.f, 0.f, 0.f, 0.f, 0.f, 0.f, 0.f, 0.f, 0.f, 0.f, 0.f, 0.f, 0.f};
            const int e = C.wave * 32 + r32;
#pragma unroll
            for (int sp = 0; sp < 2; ++sp) { const bf16x8 a = pack8(X, 8 * sp);
                const s16x4 lo = *(const LAS s16x4*)(VT + e * 40 + 16 * sp + 4 * hf), hi = *(const LAS s16x4*)(VT + e * 40 + 16 * sp + 8 + 4 * hf);
                const bf16x8 bv = (bf16x8){lo[0], lo[1], lo[2], lo[3], hi[0], hi[1], hi[2], hi[3]};
                Z = __builtin_amdgcn_mfma_f32_32x32x16_bf16(a, bv, Z, 0, 0, 0); }
#pragma unroll
            for (int r = 0; r < 16; ++r) { const int c = (r & 3) + 8 * (r >> 2) + 4 * hf; OREC[(size_t)(m0 + c) * 512 + hh * 128 + e] = Z[r]; }
        }
        {
            const int dt = C.wave >> 1;
            const bf16x8 a0 = *(const LAS bf16x8*)(KET + (dt * 32 + r32) * 40 + 8 * hf), a1 = *(const LAS bf16x8*)(KET + (dt * 32 + r32) * 40 + 16 + 8 * hf);
#pragma unroll
            for (int ei = 0; ei < 2; ++ei) { const int et = 2 * (C.wave & 1) + ei;
                const bf16x8 b0 = *(const LAS bf16x8*)(VT + (et * 32 + r32) * 40 + 8 * hf), b1 = *(const LAS bf16x8*)(VT + (et * 32 + r32) * 40 + 16 + 8 * hf);
                f32x16 U = {0.f, 0.f, 0.f, 0.f, 0.f, 0.f, 0.f, 0.f, 0.f, 0.f, 0.f, 0.f, 0.f, 0.f, 0.f, 0.f};
                U = __builtin_amdgcn_mfma_f32_32x32x16_bf16(a0, b0, U, 0, 0, 0); U = __builtin_amdgcn_mfma_f32_32x32x16_bf16(a1, b1, U, 0, 0, 0);
                bf16* up = UT + (size_t)unit * 16384 + (size_t)(et * 32 + r32) * 128 + dt * 32 + 4 * hf;
#pragma unroll
                for (int q = 0; q < 4; ++q) { v2u o; o.x = cvtpk(U[4 * q], U[4 * q + 1]); o.y = cvtpk(U[4 * q + 2], U[4 * q + 3]); *(GAS v2u*)(up + 8 * q) = o; } }
        }
        __syncthreads();
    }
}

__device__ __forceinline__ void p3_hgrn_scan(const Params& P, const Ctx& C) {
    unsigned char* ws = P.ws;
    const bf16* UT = (const bf16*)(ws + WS_U); const bf16* QDEC = (const bf16*)(ws + WS_QDEC); float* OREC = (float*)(ws + WS_OREC); const float* DEC = (const float*)(ws + WS_DECAY);
    LAS bf16* ST = (LAS bf16*)C.lds;
    typedef float f32x4v __attribute__((ext_vector_type(4)));
    for (int unit = blockIdx.x; unit < NB * HG_H * 8; unit += C.G) {
        const int sl = unit & 7, hh = (unit >> 3) & 3, b = unit >> 5; const int e0 = sl * 16;
        const int e = C.tid & 15, dq = C.tid >> 4;
        float S[4] = {0.f, 0.f, 0.f, 0.f};
        *(LAS v2u*)(ST + e * 136 + 4 * dq) = (v2u){0u, 0u};
        const int cu0 = (b * HG_H + hh) * 128;
        const int lane = C.lane, fr = lane & 15, fq = lane >> 4;
        v2u un = *(const GAS v2u*)(UT + (size_t)cu0 * 16384 + (size_t)(e0 + e) * 128 + 4 * dq);
        f32x4 dn = *(const GAS f32x4*)(DEC + (size_t)cu0 * 128 + 4 * dq);
        bf16x8 qa[4];
        if (C.wave < 2) {
#pragma unroll
            for (int k = 0; k < 4; ++k) qa[k] = *(const GAS bf16x8*)(QDEC + (size_t)(b * T + C.wave * 16 + fr) * 512 + hh * 128 + 32 * k + 8 * fq);
        }
        __syncthreads();
        for (int n = 0; n < 128; ++n) {
            const v2u uc = un; const f32x4 dc = dn; bf16x8 qc[4];
#pragma unroll
            for (int k = 0; k < 4; ++k) qc[k] = qa[k];
            if (n + 1 < 128) {
                un = *(const GAS v2u*)(UT + (size_t)(cu0 + n + 1) * 16384 + (size_t)(e0 + e) * 128 + 4 * dq);
                dn = *(const GAS f32x4*)(DEC + (size_t)(cu0 + n + 1) * 128 + 4 * dq);
                if (C.wave < 2) {
#pragma unroll
                    for (int k = 0; k < 4; ++k) qa[k] = *(const GAS bf16x8*)(QDEC + (size_t)(b * T + (n + 1) * 32 + C.wave * 16 + fr) * 512 + hh * 128 + 32 * k + 8 * fq);
                }
            }
            const LAS bf16* stc = ST + (n & 1) * (16 * 136); LAS bf16* stn = ST + ((n + 1) & 1) * (16 * 136);
            if (C.wave < 2) {
                f32x4v acc = {0.f, 0.f, 0.f, 0.f};
#pragma unroll
                for (int k = 0; k < 4; ++k) { const bf16x8 bs = *(const LAS bf16x8*)(stc + fr * 136 + 32 * k + 8 * fq); acc = __builtin_amdgcn_mfma_f32_16x16x32_bf16(qc[k], bs, acc, 0, 0, 0); }
                float* op = OREC + (size_t)(b * T + n * 32 + C.wave * 16 + 4 * fq) * 512 + hh * 128 + e0 + fr;
#pragma unroll
                for (int j = 0; j < 4; ++j) op[(size_t)j * 512] += acc[j];
            }
            S[0] = dc[0] * S[0] + bflo(uc.x); S[1] = dc[1] * S[1] + bfhi(uc.x); S[2] = dc[2] * S[2] + bflo(uc.y); S[3] = dc[3] * S[3] + bfhi(uc.y);
            *(LAS v2u*)(stn + e * 136 + 4 * dq) = (v2u){cvtpk(S[0], S[1]), cvtpk(S[2], S[3])};
            __syncthreads();
        }
    }
}

__device__ __forceinline__ void p4_yrec(const Params& P, const Ctx& C) {
    unsigned char* ws = P.ws;
    const float* OREC = (const float*)(ws + WS_OREC); const bf16* H = (const bf16*)(ws + WS_H); bf16* YM = (bf16*)(ws + WS_YMIX);
    const float* ng = P.in[I_HGNG];
    const f32x4 g0 = *(const f32x4*)(ng + 8 * C.lane), g1 = *(const f32x4*)(ng + 8 * C.lane + 4);
    for (int m = C.gw; m < NTOK; m += C.ngw) {
        const f32x4 a = *(const GAS f32x4*)(OREC + (size_t)m * 512 + 8 * C.lane), bq = *(const GAS f32x4*)(OREC + (size_t)m * 512 + 8 * C.lane + 4);
        float ss = (a[0] * a[0] + a[1] * a[1]) + (a[2] * a[2] + a[3] * a[3]) + (bq[0] * bq[0] + bq[1] * bq[1]) + (bq[2] * bq[2] + bq[3] * bq[3]);
        ss += __shfl_xor(ss, 1); ss += __shfl_xor(ss, 2); ss += __shfl_xor(ss, 4); ss += __shfl_xor(ss, 8);
        const float rs = 1.f / sqrtf(ss * (1.f / 128.f) + RMS_EPS);
        const v4u gw = *(const GAS v4u*)(H + (size_t)m * D_INP + C_GG + 8 * C.lane);
        float gv[8] = {bflo(gw.x), bfhi(gw.x), bflo(gw.y), bfhi(gw.y), bflo(gw.z), bfhi(gw.z), bflo(gw.w), bfhi(gw.w)};
        float o[8];
#pragma unroll
        for (int j = 0; j < 4; ++j) { o[j] = a[j] * rs * g0[j] * (gv[j] * sigmoidf_(gv[j])); o[4 + j] = bq[j] * rs * g1[j] * (gv[4 + j] * sigmoidf_(gv[4 + j])); }
        v4u w; w.x = pk2(o[0], o[1]); w.y = pk2(o[2], o[3]); w.z = pk2(o[4], o[5]); w.w = pk2(o[6], o[7]);
        *(GAS v4u*)(YM + (size_t)m * D + 512 + 8 * C.lane) = w;
#if !FEAT_ATT
        *(GAS v4u*)(YM + (size_t)m * D + 8 * C.lane) = (v4u){0u, 0u, 0u, 0u};
#endif
    }
}

namespace pg8 {
struct EpiKhead {
    static constexpr bool PERM = true, AFTER_DRAIN = false;
    bf16_t* O;
    __device__ __forceinline__ void operator()(const f32x4 (&acc)[2][2][4][2], const Unit& u, int wr, int wc, int fr, int fq) const {
        const int row0 = u.pm * BM + wr * 64 + fr, col0 = u.pn * BM + wc * 32 + 8 * fq;
#pragma unroll
        for (int ai = 0; ai < 2; ++ai)
#pragma unroll
            for (int m = 0; m < 4; ++m) { const int row = row0 + ai * HALF + m * 16; const int b = row >> 12, t = row & 4095;
#pragma unroll
                for (int bj = 0; bj < 2; ++bj) { const int col = col0 + bj * HALF; const f32x4 v0 = acc[ai][bj][m][0], v1 = acc[ai][bj][m][1];
                    u32x4 w; w.x = cvt_pk_bf16(v0[0], v0[1]); w.y = cvt_pk_bf16(v0[2], v0[3]); w.z = cvt_pk_bf16(v1[0], v1[1]); w.w = cvt_pk_bf16(v1[2], v1[3]);
                    *(u32x4*)(O + ((size_t)((b * 8 + (col >> 6)) * 4096 + t)) * 64 + (col & 63)) = w; } }
    }
};
struct EpiVt {
    static constexpr bool PERM = true, AFTER_DRAIN = false;
    bf16_t* O;
    __device__ __forceinline__ void operator()(const f32x4 (&acc)[2][2][4][2], const Unit& u, int wr, int wc, int fr, int fq) const {
        const int row0 = u.pm * BM + wr * 64 + fr, col0 = u.pn * BM + wc * 32 + 8 * fq;
#pragma unroll
        for (int ai = 0; ai < 2; ++ai)
#pragma unroll
            for (int m = 0; m < 4; ++m) { const int row = row0 + ai * HALF + m * 16;
#pragma unroll
                for (int bj = 0; bj < 2; ++bj) { const int col = col0 + bj * HALF; const int b = col >> 12, t = col & 4095; const f32x4 v0 = acc[ai][bj][m][0], v1 = acc[ai][bj][m][1];
                    u32x4 w; w.x = cvt_pk_bf16(v0[0], v0[1]); w.y = cvt_pk_bf16(v0[2], v0[3]); w.z = cvt_pk_bf16(v1[0], v1[1]); w.w = cvt_pk_bf16(v1[2], v1[3]);
                    *(u32x4*)(O + ((size_t)(b * 512 + row)) * 4096 + t) = w; } }
    }
};
}

__device__ __forceinline__ unsigned f2ord(float x) { const unsigned b = __builtin_bit_cast(unsigned, x); return b ^ ((unsigned)((int)b >> 31) | 0x80000000u); }
__device__ __forceinline__ void p3_indexer(const Params& P, const Ctx& C) {
    unsigned char* ws = P.ws;
    const bf16* H = (const bf16*)(ws + WS_H); const bf16* IKN = (const bf16*)(ws + WS_IKN); unsigned* MASK = (unsigned*)(ws + WS_MASK);
    LAS float* ISC = (LAS float*)C.lds; LAS unsigned* HIST = (LAS unsigned*)(C.lds + 131072) + C.wave * 256;
    const int lane = C.lane, r32 = lane & 31, hf = lane >> 5;
    const int ql = 2 * (r32 >> 4) + ((r32 >> 2) & 1), hd = 4 * ((r32 >> 3) & 1) + (r32 & 3);
    for (int u = blockIdx.x; u < NTOK / 8; u += C.G) {
        const int b = (u & 255) >> 5, j = u & 31, i = u >> 8; const int pi = i >> 1; const int blk = (i & 1) ? (511 - (j + 32 * pi)) : (j + 32 * pi);
        const int t0 = blk * 8; const size_t mb = (size_t)b * T;
        const int nkt = (t0 + 8 + 31) >> 5;
        bf16x8 af[2][4]; float wq[2][2][8];
#pragma unroll
        for (int a = 0; a < 2; ++a) {
            const bf16* qp = H + (mb + t0 + 4 * a + ql) * D_INP + C_IQ + hd * 64 + 8 * hf;
#pragma unroll
            for (int k = 0; k < 4; ++k) af[a][k] = *(const GAS bf16x8*)(qp + 16 * k);
#pragma unroll
            for (int qh = 0; qh < 2; ++qh) { const v4u w = *(const GAS v4u*)(H + (mb + t0 + 4 * a + 2 * qh + hf) * D_INP + C_IW);
                const float sc = 0.125f * 0.35355339059327373f;
                wq[a][qh][0] = bflo(w.x) * sc; wq[a][qh][1] = bfhi(w.x) * sc; wq[a][qh][2] = bflo(w.y) * sc; wq[a][qh][3] = bfhi(w.y) * sc;
                wq[a][qh][4] = bflo(w.z) * sc; wq[a][qh][5] = bfhi(w.z) * sc; wq[a][qh][6] = bflo(w.w) * sc; wq[a][qh][7] = bfhi(w.w) * sc; }
        }
        for (int kt = C.wave; kt < nkt; kt += NWAVES) {
            const int s0 = kt * 32; const bf16* kp = IKN + (mb + s0 + r32) * 64 + 8 * hf;
            bf16x8 bk[4];
#pragma unroll
            for (int k = 0; k < 4; ++k) bk[k] = *(const GAS bf16x8*)(kp + 16 * k);
#pragma unroll
            for (int a = 0; a < 2; ++a) {
                f32x16 acc = {0.f, 0.f, 0.f, 0.f, 0.f, 0.f, 0.f, 0.f, 0.f, 0.f, 0.f, 0.f, 0.f, 0.f, 0.f, 0.f};
#pragma unroll
                for (int k = 0; k < 4; ++k) acc = __builtin_amdgcn_mfma_f32_32x32x16_bf16(af[a][k], bk[k], acc, 0, 0, 0);
#pragma unroll
                for (int qh = 0; qh < 2; ++qh) { float s = 0.f;
#pragma unroll
                    for (int h8 = 0; h8 < 8; ++h8) s += wq[a][qh][h8] * fmaxf(acc[8 * qh + h8], 0.f);
                    const int q = 4 * a + 2 * qh + hf, key = s0 + r32;
                    ISC[q * 4096 + key] = (key <= t0 + q) ? (s + 0.0f) : -INFINITY; }
            }
        }
        __syncthreads();
        {
            const int q = C.wave, t = t0 + q, n = t + 1; const LAS float* row = ISC + q * 4096;
            unsigned* mrow = MASK + (mb + t) * 128;
            if (n <= TOPK) {
#pragma unroll
                for (int w2 = 0; w2 < 2; ++w2) { const int wi = lane + 64 * w2; const int lo = 32 * wi; unsigned bits;
                    if (lo + 31 <= t) bits = 0xffffffffu; else if (lo > t) bits = 0u; else bits = (1u << (t - lo + 1)) - 1u;
                    mrow[wi] = bits; }
            } else {
                unsigned prefix = 0u; int need = TOPK;
                for (int pass = 3; pass >= 0; --pass) {
                    const int shift = 8 * pass;
#pragma unroll
                    for (int z = 0; z < 4; ++z) HIST[lane + 64 * z] = 0u;
                    LDS_WAIT();
                    for (int e = lane; e < n; e += 64) { const unsigned uu = f2ord(row[e]);
                        const bool match = (pass == 3) || ((uu >> (shift + 8)) == (prefix >> (shift + 8)));
                        if (match) atomicAdd((unsigned*)&HIST[(uu >> shift) & 255u], 1u); }
                    LDS_WAIT();
                    const unsigned c0 = HIST[4 * lane], c1 = HIST[4 * lane + 1], c2 = HIST[4 * lane + 2], c3 = HIST[4 * lane + 3];
                    const unsigned s4 = c0 + c1 + c2 + c3;
                    unsigned suf = s4;
#pragma unroll
                    for (int o = 1; o < 64; o <<= 1) { const unsigned v = __shfl_down(suf, o); if (lane + o < 64) suf += v; }
                    unsigned cum = suf - s4; int dsel = -1; int nnew = 0;
                    if (cum < (unsigned)need && (unsigned)need <= cum + c3) { dsel = 4 * lane + 3; nnew = need - (int)cum; } cum += c3;
                    if (dsel < 0 && cum < (unsigned)need && (unsigned)need <= cum + c2) { dsel = 4 * lane + 2; nnew = need - (int)cum; } cum += c2;
                    if (dsel < 0 && cum < (unsigned)need && (unsigned)need <= cum + c1) { dsel = 4 * lane + 1; nnew = need - (int)cum; } cum += c1;
                    if (dsel < 0 && cum < (unsigned)need && (unsigned)need <= cum + c0) { dsel = 4 * lane + 0; nnew = need - (int)cum; }
                    const unsigned long long bal = __ballot(dsel >= 0);
                    const int src = (bal != 0ull) ? (int)__builtin_ctzll(bal) : 0;
                    const int d = __shfl(dsel, src); need = __shfl(nnew, src);
                    prefix |= ((unsigned)d & 255u) << shift;
                }
                int run_eq = 0;
                for (int it = 0; it < 64; ++it) { const int e = it * 64 + lane; const unsigned uu = f2ord(row[e]); const bool valid = e <= t;
                    const bool eq = valid && (uu == prefix); const unsigned long long beq = __ballot(eq);
                    const int rk = run_eq + __builtin_popcountll(beq & ((1ull << lane) - 1ull));
                    const bool sel = valid && ((uu > prefix) || (eq && rk < need)); run_eq += __builtin_popcountll(beq);
                    const unsigned long long bs = __ballot(sel);
                    if (lane == 0) *(GAS v2u*)(mrow + 2 * it) = (v2u){(unsigned)bs, (unsigned)(bs >> 32)}; }
            }
        }
        __syncthreads();
    }
}

__device__ __forceinline__ void attn_task(const bf16* H, const bf16* KH, const bf16* VT, const unsigned* MASK, bf16* YM, int b, int hh, int t0, int lane) {
    const int r32 = lane & 31, hf = lane >> 5;
    const float LOG2E = 1.4426950408889634f; const float c1 = 0.125f * LOG2E; const float sl2 = exp2f(-(float)(hh + 1)) * LOG2E;
    const size_t mb = (size_t)b * T;
    bf16x8 qf[4];
#pragma unroll
    for (int k = 0; k < 4; ++k) qf[k] = *(const GAS bf16x8*)(H + (mb + t0 + r32) * D_INP + C_AQ + hh * 64 + 16 * k + 8 * hf);
    const bf16* kbase = KH + ((size_t)(b * 8 + hh) * T) * 64; const bf16* vbase = VT + ((size_t)(b * 512 + hh * 64)) * T; const unsigned* mrow = MASK + (mb + t0 + r32) * 128;
    float m_run = -1e30f, l = 0.f;
    f32x16 O0 = {0.f, 0.f, 0.f, 0.f, 0.f, 0.f, 0.f, 0.f, 0.f, 0.f, 0.f, 0.f, 0.f, 0.f, 0.f, 0.f}, O1 = O0;
    const int nkt = (t0 + 32 + 63) >> 6;
    for (int kt = 0; kt < nkt; ++kt) {
        const int s0 = kt * 64;
        bf16x8 kf[2][4];
#pragma unroll
        for (int uu = 0; uu < 2; ++uu)
#pragma unroll
            for (int k = 0; k < 4; ++k) kf[uu][k] = *(const GAS bf16x8*)(kbase + (size_t)(s0 + 32 * uu + r32) * 64 + 16 * k + 8 * hf);
        const v2u mw = *(const GAS v2u*)(mrow + 2 * kt);
        s16x4 vl[2][2][2], vh[2][2][2];
#pragma unroll
        for (int uu = 0; uu < 2; ++uu)
#pragma unroll
            for (int sp = 0; sp < 2; ++sp)
#pragma unroll
                for (int dt = 0; dt < 2; ++dt) { const bf16* vp = vbase + (size_t)(dt * 32 + r32) * T + s0 + 32 * uu + 16 * sp + 4 * hf;
                    vl[uu][sp][dt] = *(const GAS s16x4*)vp; vh[uu][sp][dt] = *(const GAS s16x4*)(vp + 8); }
        f32x16 a0 = {0.f, 0.f, 0.f, 0.f, 0.f, 0.f, 0.f, 0.f, 0.f, 0.f, 0.f, 0.f, 0.f, 0.f, 0.f, 0.f}, a1 = a0;
#pragma unroll
        for (int k = 0; k < 4; ++k) { a0 = __builtin_amdgcn_mfma_f32_32x32x16_bf16(kf[0][k], qf[k], a0, 0, 0, 0); a1 = __builtin_amdgcn_mfma_f32_32x32x16_bf16(kf[1][k], qf[k], a1, 0, 0, 0); }
        const float dist0 = (float)(t0 + r32 - s0 - 4 * hf);
        const unsigned m0 = mw.x >> (4 * hf), m1 = mw.y >> (4 * hf);
        float mx = -1e30f;
#pragma unroll
        for (int r = 0; r < 16; ++r) { const int ko = (r & 3) + 8 * (r >> 2);
            const float d0 = dist0 - (float)ko;
            a0[r] = ((m0 >> ko) & 1u) ? (a0[r] * c1 - sl2 * d0) : -1e30f;
            a1[r] = ((m1 >> ko) & 1u) ? (a1[r] * c1 - sl2 * (d0 - 32.f)) : -1e30f;
            mx = fmaxf(mx, fmaxf(a0[r], a1[r])); }
        mx = fmaxf(mx, __shfl_xor(mx, 32));
        const float m_new = fmaxf(m_run, mx); const float alpha = __builtin_amdgcn_exp2f(m_run - m_new); m_run = m_new;
        float ps = 0.f;
#pragma unroll
        for (int r = 0; r < 16; ++r) { const int ko = (r & 3) + 8 * (r >> 2);
            const float p0 = ((m0 >> ko) & 1u) ? __builtin_amdgcn_exp2f(a0[r] - m_new) : 0.f;
            const float p1 = ((m1 >> ko) & 1u) ? __builtin_amdgcn_exp2f(a1[r] - m_new) : 0.f;
            a0[r] = p0; a1[r] = p1; ps += p0 + p1; }
        l = l * alpha + ps;
#pragma unroll
        for (int r = 0; r < 16; ++r) { O0[r] *= alpha; O1[r] *= alpha; }
#pragma unroll
        for (int sp = 0; sp < 2; ++sp) {
            const bf16x8 pb0 = pack8(a0, 8 * sp), pb1 = pack8(a1, 8 * sp);
#define VFR(uu, dt) ((bf16x8){vl[uu][sp][dt][0], vl[uu][sp][dt][1], vl[uu][sp][dt][2], vl[uu][sp][dt][3], vh[uu][sp][dt][0], vh[uu][sp][dt][1], vh[uu][sp][dt][2], vh[uu][sp][dt][3]})
            O0 = __builtin_amdgcn_mfma_f32_32x32x16_bf16(VFR(0, 0), pb0, O0, 0, 0, 0);
            O1 = __builtin_amdgcn_mfma_f32_32x32x16_bf16(VFR(0, 1), pb0, O1, 0, 0, 0);
            O0 = __builtin_amdgcn_mfma_f32_32x32x16_bf16(VFR(1, 0), pb1, O0, 0, 0, 0);
            O1 = __builtin_amdgcn_mfma_f32_32x32x16_bf16(VFR(1, 1), pb1, O1, 0, 0, 0);
#undef VFR
        }
    }
    l += __shfl_xor(l, 32);
    const float inv = 1.f / l;
    bf16* yp = YM + (mb + t0 + r32) * D + hh * 64 + 4 * hf;
#pragma unroll
    for (int rq = 0; rq < 4; ++rq) {
        v2u o; o.x = cvtpk(O0[4 * rq] * inv, O0[4 * rq + 1] * inv); o.y = cvtpk(O0[4 * rq + 2] * inv, O0[4 * rq + 3] * inv); *(GAS v2u*)(yp + 8 * rq) = o;
        v2u o2; o2.x = cvtpk(O1[4 * rq] * inv, O1[4 * rq + 1] * inv); o2.y = cvtpk(O1[4 * rq + 2] * inv, O1[4 * rq + 3] * inv); *(GAS v2u*)(yp + 32 + 8 * rq) = o2; }
}
__device__ __forceinline__ void p4_attention(const Params& P, const Ctx& C) {
    unsigned char* ws = P.ws;
    const bf16* H = (const bf16*)(ws + WS_H); const bf16* KH = (const bf16*)(ws + WS_K); const bf16* VT = (const bf16*)(ws + WS_VT); const unsigned* MASK = (const unsigned*)(ws + WS_MASK); bf16* YM = (bf16*)(ws + WS_YMIX);
    for (int p = blockIdx.x; p < 512; p += C.G) {
        const int bh = p >> 3, j = p & 7; const int b = bh >> 3, hh = bh & 7;
        attn_task(H, KH, VT, MASK, YM, b, hh, j * 256 + C.wave * 32, C.lane);
        attn_task(H, KH, VT, MASK, YM, b, hh, (15 - j) * 256 + (7 - C.wave) * 32, C.lane);
    }
}

constexpr int AT_KB = 64 * 144, AT_VB = 64 * 136, AT_VOFF = 2 * AT_KB;
__device__ __forceinline__ void attn_block(const Ctx& C, const bf16* H, const bf16* KH, const bf16* VT, const unsigned* MASK, bf16* YM, int b, int hh, int qb) {
    const int lane = C.lane, r32 = lane & 31, hf = lane >> 5, tid = C.tid;
    const float LOG2E = 1.4426950408889634f; const float c1 = 0.125f * LOG2E; const float sl2 = exp2f(-(float)(hh + 1)) * LOG2E;
    const size_t mb = (size_t)b * T; const int t0 = qb * 256 + C.wave * 32;
    bf16x8 qf[4];
#pragma unroll
    for (int k = 0; k < 4; ++k) { const v4u w = *(const GAS v4u*)(H + (mb + t0 + r32) * D_INP + C_AQ + hh * 64 + 16 * k + 8 * hf);
        v4u o; o.x = cvtpk(bflo(w.x) * c1, bfhi(w.x) * c1); o.y = cvtpk(bflo(w.y) * c1, bfhi(w.y) * c1); o.z = cvtpk(bflo(w.z) * c1, bfhi(w.z) * c1); o.w = cvtpk(bflo(w.w) * c1, bfhi(w.w) * c1);
        qf[k] = __builtin_bit_cast(bf16x8, o); }
    const bf16* kbase = KH + ((size_t)(b * 8 + hh) * T) * 64; const bf16* vbase = VT + ((size_t)(b * 512 + hh * 64)) * T; const unsigned* mrow = MASK + (mb + t0 + r32) * 128;
    const int srow = tid >> 3, sch = tid & 7;
    const bf16* kst = kbase + (size_t)srow * 64 + 8 * sch; const bf16* vst = vbase + (size_t)srow * T + 8 * sch;
    LAS unsigned char* kw = C.lds + srow * 144 + 16 * sch; LAS unsigned char* vw = C.lds + AT_VOFF + srow * 136 + 16 * sch;
    const LAS unsigned char* kr = C.lds + r32 * 144 + 16 * hf; const LAS unsigned char* vr = C.lds + AT_VOFF + r32 * 136 + 8 * hf;
    float m_run = -1e30f, l = 0.f;
    f32x16 O0 = {0.f, 0.f, 0.f, 0.f, 0.f, 0.f, 0.f, 0.f, 0.f, 0.f, 0.f, 0.f, 0.f, 0.f, 0.f, 0.f}, O1 = O0;
    const int nkt = 4 * (qb + 1), ktw = (t0 + 31) >> 6;
    v4u kn = *(const GAS v4u*)kst, vn = *(const GAS v4u*)vst; v2u mwn = *(const GAS v2u*)mrow;
    *(LAS v4u*)kw = kn; *(LAS v2u*)vw = (v2u){vn.x, vn.y}; *(LAS v2u*)(vw + 8) = (v2u){vn.z, vn.w};
    __syncthreads();
    for (int kt = 0; kt < nkt; ++kt) {
        const int s0 = kt * 64; const int cur = kt & 1; const v2u mw = mwn;
        if (kt + 1 < nkt) { kn = *(const GAS v4u*)(kst + (size_t)(s0 + 64) * 64); vn = *(const GAS v4u*)(vst + s0 + 64); mwn = *(const GAS v2u*)(mrow + 2 * kt + 2); }
        if (kt <= ktw) {
            const LAS unsigned char* kc = kr + cur * AT_KB; const LAS unsigned char* vc = vr + cur * AT_VB;
            const float B0 = -sl2 * (float)(t0 + r32 - s0 - 4 * hf);
            f32x16 a0, a1;
#pragma unroll
            for (int r = 0; r < 16; ++r) { const float ko = (float)((r & 3) + 8 * (r >> 2)); a0[r] = B0 + sl2 * ko; a1[r] = B0 + sl2 * (ko + 32.f); }
#pragma unroll
            for (int k = 0; k < 4; ++k) { const bf16x8 k0 = *(const LAS bf16x8*)(kc + 32 * k), k1 = *(const LAS bf16x8*)(kc + 32 * 144 + 32 * k);
                a0 = __builtin_amdgcn_mfma_f32_32x32x16_bf16(k0, qf[k], a0, 0, 0, 0); a1 = __builtin_amdgcn_mfma_f32_32x32x16_bf16(k1, qf[k], a1, 0, 0, 0); }
            const unsigned m0 = mw.x >> (4 * hf), m1 = mw.y >> (4 * hf);
            float mx = -1e30f;
#pragma unroll
            for (int r = 0; r < 16; ++r) { const int ko = (r & 3) + 8 * (r >> 2);
                a0[r] = (m0 & (1u << ko)) ? a0[r] : -1e30f; a1[r] = (m1 & (1u << ko)) ? a1[r] : -1e30f;
                mx = fmaxf(mx, fmaxf(a0[r], a1[r])); }
            mx = fmaxf(mx, __shfl_xor(mx, 32));
            const float m_new = fmaxf(m_run, mx); const float alpha = __builtin_amdgcn_exp2f(m_run - m_new); m_run = m_new;
            float ps = 0.f;
#pragma unroll
            for (int r = 0; r < 16; ++r) { const int ko = (r & 3) + 8 * (r >> 2);
                const float p0 = (m0 & (1u << ko)) ? __builtin_amdgcn_exp2f(a0[r] - m_new) : 0.f;
                const float p1 = (m1 & (1u << ko)) ? __builtin_amdgcn_exp2f(a1[r] - m_new) : 0.f;
                a0[r] = p0; a1[r] = p1; ps += p0 + p1; }
            l = l * alpha + ps;
#pragma unroll
            for (int r = 0; r < 16; ++r) { O0[r] *= alpha; O1[r] *= alpha; }
#pragma unroll
            for (int sp = 0; sp < 2; ++sp) {
                const bf16x8 pb0 = pack8(a0, 8 * sp), pb1 = pack8(a1, 8 * sp);
#define VLD(uu, dt) ({ const s16x4 lo_ = *(const LAS s16x4*)(vc + (dt) * 32 * 136 + 2 * (32 * (uu) + 16 * sp)), hi_ = *(const LAS s16x4*)(vc + (dt) * 32 * 136 + 2 * (32 * (uu) + 16 * sp + 8)); (bf16x8){lo_[0], lo_[1], lo_[2], lo_[3], hi_[0], hi_[1], hi_[2], hi_[3]}; })
                O0 = __builtin_amdgcn_mfma_f32_32x32x16_bf16(VLD(0, 0), pb0, O0, 0, 0, 0);
                O1 = __builtin_amdgcn_mfma_f32_32x32x16_bf16(VLD(0, 1), pb0, O1, 0, 0, 0);
                O0 = __builtin_amdgcn_mfma_f32_32x32x16_bf16(VLD(1, 0), pb1, O0, 0, 0, 0);
                O1 = __builtin_amdgcn_mfma_f32_32x32x16_bf16(VLD(1, 1), pb1, O1, 0, 0, 0);
#undef VLD
            }
        }
        if (kt + 1 < nkt) { const int nx = cur ^ 1; *(LAS v4u*)(kw + nx * AT_KB) = kn; *(LAS v2u*)(vw + nx * AT_VB) = (v2u){vn.x, vn.y}; *(LAS v2u*)(vw + nx * AT_VB + 8) = (v2u){vn.z, vn.w}; }
        __syncthreads();
    }
    l += __shfl_xor(l, 32);
    const float inv = 1.f / l;
    bf16* yp = YM + (mb + t0 + r32) * D + hh * 64 + 4 * hf;
#pragma unroll
    for (int rq = 0; rq < 4; ++rq) {
        v2u o; o.x = cvtpk(O0[4 * rq] * inv, O0[4 * rq + 1] * inv); o.y = cvtpk(O0[4 * rq + 2] * inv, O0[4 * rq + 3] * inv); *(GAS v2u*)(yp + 8 * rq) = o;
        v2u o2; o2.x = cvtpk(O1[4 * rq] * inv, O1[4 * rq + 1] * inv); o2.y = cvtpk(O1[4 * rq + 2] * inv, O1[4 * rq + 3] * inv); *(GAS v2u*)(yp + 32 + 8 * rq) = o2; }
}
__device__ __forceinline__ void p4_attention2(const Params& P, const Ctx& C) {
    unsigned char* ws = P.ws;
    const bf16* H = (const bf16*)(ws + WS_H); const bf16* KH = (const bf16*)(ws + WS_K); const bf16* VT = (const bf16*)(ws + WS_VT); const unsigned* MASK = (const unsigned*)(ws + WS_MASK); bf16* YM = (bf16*)(ws + WS_YMIX);
    for (int p = blockIdx.x; p < 512; p += C.G) {
        const int b = p & 7, q = p >> 3; const int hh = q >> 3, j = q & 7;
        attn_block(C, H, KH, VT, MASK, YM, b, hh, j);
        attn_block(C, H, KH, VT, MASK, YM, b, hh, 15 - j);
    }
}

#ifndef FEAT_MIX
#define FEAT_MIX 1
#endif
#ifndef FEAT_MOE
#define FEAT_MOE 1
#endif
#ifndef FEAT_PLE
#define FEAT_PLE 1
#endif
#ifndef FEAT_ATT
#define FEAT_ATT 1
#endif

__device__ __forceinline__ void p6_ln1_router(const Params& P, const Ctx& C) {
    unsigned char* ws = P.ws;
    float* X1 = (float*)(ws + WS_X1); bf16* XB = (bf16*)(ws + WS_XB);
    LAS float* wl = (LAS float*)C.lds;
    LAS int* hist = (LAS int*)(C.lds + MISC_OFF);
#if FEAT_MOE
    { const float* wr = P.in[I_WR];
      for (int i = C.tid; i < 32 * 1024; i += NTHR) { const int e = i >> 10, k = i & 1023; wl[i] = wr[k * 32 + e]; }
      if (C.tid < 32) hist[C.tid] = 0; }
    __syncthreads();
    int* tope = (int*)(ws + WS_TOPE); float* gate = (float*)(ws + WS_GATE); int* lrank = (int*)(ws + WS_LRANK);
    const float* br = P.in[I_BR];
#endif
#if FEAT_MIX
    const float* src = P.out; const float sc = 1.0f;
#else
    const float* src = P.in[I_X]; const float sc = ALPHA;
#endif
    for (int m = C.gw; m < NTOK; m += C.ngw) {
        f32x4 v[4]; load_row_f32(v, src + (size_t)m * D, C.lane);
#pragma unroll
        for (int j = 0; j < 4; ++j) v[j] = v[j] * sc;
        ln_row(v, P.in[I_LNMG], P.in[I_LNMB], C.lane);
        store_row_f32(X1 + (size_t)m * D, v, C.lane);
        store_row_bf16(XB + (size_t)m * D, v, C.lane);
#if FEAT_MOE
        float lv[32];
#pragma unroll
        for (int e = 0; e < 32; ++e) { float a = 0.f;
#pragma unroll
            for (int j = 0; j < 4; ++j) { const f32x4 w = *(const LAS f32x4*)(wl + e * 1024 + 4 * C.lane + 256 * j); a += (v[j][0] * w[0] + v[j][1] * w[1]) + (v[j][2] * w[2] + v[j][3] * w[3]); }
            lv[e] = wave_sum(a) + br[e]; }
        int se[4]; float sv[4];
#pragma unroll
        for (int k = 0; k < 4; ++k) { float best = -INFINITY; int bi = 0;
#pragma unroll
            for (int e = 0; e < 32; ++e) if (lv[e] > best) { best = lv[e]; bi = e; }
            se[k] = bi; sv[k] = best;
#pragma unroll
            for (int e = 0; e < 32; ++e) lv[e] = (e == bi) ? -INFINITY : lv[e]; }
        float ex[4], sum = 0.f;
#pragma unroll
        for (int k = 0; k < 4; ++k) { ex[k] = __expf(sv[k] - sv[0]); sum += ex[k]; }
        const float inv = 1.f / sum;
        if (C.lane == 0) {
#pragma unroll
            for (int k = 0; k < 4; ++k) { const int lr = atomicAdd((int*)&hist[se[k]], 1); tope[m * 4 + k] = se[k]; gate[m * 4 + k] = ex[k] * inv; lrank[m * 4 + k] = lr; } }
#endif
    }
#if FEAT_MOE
    __syncthreads();
    if (C.tid < 32) { unsigned* cnt = (unsigned*)(ws + WS_CTL) + CW_CNT; const int base = (int)atomicAdd(cnt + C.tid, (unsigned)hist[C.tid]); ((int*)(ws + WS_WGBASE))[blockIdx.x * 32 + C.tid] = base; }
#endif
}

__device__ __forceinline__ void p7_dispatch(const Params& P, const Ctx& C) {
    unsigned char* ws = P.ws;
    LAS int* ps = (LAS int*)(C.lds + MISC_OFF + 256);
    const unsigned* cnt = (const unsigned*)(ws + WS_CTL) + CW_CNT;
    int* tile_e = (int*)(ws + WS_TILEE);
    if (C.tid == 0) { int run = 0;
        for (int e = 0; e < NE; ++e) { const int c = (int)__hip_atomic_load(cnt + e, __ATOMIC_RELAXED, __HIP_MEMORY_SCOPE_AGENT); ps[e] = run; const int nt = (c + 255) >> 8;
            if (blockIdx.x == 0) for (int t = 0; t < nt; ++t) tile_e[(run >> 8) + t] = e;
            run += nt << 8; }
        if (blockIdx.x == 0) tile_e[MAXTILES] = run >> 8; }
    __syncthreads();
    const int* tope = (const int*)(ws + WS_TOPE); const float* gate = (const float*)(ws + WS_GATE); const int* lrank = (const int*)(ws + WS_LRANK);
    const int* wgb = (const int*)(ws + WS_WGBASE);
    int* tokslot = (int*)(ws + WS_TOKSLOT); float* slotgate = (float*)(ws + WS_SLOTGATE);
    const bf16* XB = (const bf16*)(ws + WS_XB); bf16* xs = (bf16*)(ws + WS_XS);
    for (int m = C.gw; m < NTOK; m += C.ngw) {
        const int wgm = (m % C.ngw) >> 3;
        const v4u r0 = *(const GAS v4u*)(XB + (size_t)m * D + 8 * C.lane), r1 = *(const GAS v4u*)(XB + (size_t)m * D + 512 + 8 * C.lane);
#pragma unroll
        for (int k = 0; k < 4; ++k) { const int e = tope[m * 4 + k]; const int slot = ps[e] + wgb[wgm * 32 + e] + lrank[m * 4 + k];
            bf16* dst = xs + (size_t)slot * D; *(GAS v4u*)(dst + 8 * C.lane) = r0; *(GAS v4u*)(dst + 512 + 8 * C.lane) = r1;
            if (C.lane == 0) { slotgate[slot] = gate[m * 4 + k]; tokslot[m * 4 + k] = slot; } }
    }
}

__device__ __forceinline__ void p10_combine_ln2(const Params& P, const Ctx& C) {
    unsigned char* ws = P.ws;
    float* X1 = (float*)(ws + WS_X1); bf16* XB = (bf16*)(ws + WS_XB);
    const int* tokslot = (const int*)(ws + WS_TOKSLOT); const bf16* ys = (const bf16*)(ws + WS_YSLOT);
    for (int m = C.gw; m < NTOK; m += C.ngw) {
        f32x4 v[4]; load_row_f32(v, X1 + (size_t)m * D, C.lane);
#pragma unroll
        for (int j = 0; j < 4; ++j) v[j] = v[j] * ALPHA;
#if FEAT_MOE
#pragma unroll
        for (int k = 0; k < 4; ++k) { const int slot = tokslot[m * 4 + k]; const bf16* yr = ys + (size_t)slot * D;
#pragma unroll
            for (int j = 0; j < 4; ++j) { const v2u w = *(const GAS v2u*)(yr + 4 * C.lane + 256 * j); v[j][0] += bflo(w.x); v[j][1] += bfhi(w.x); v[j][2] += bflo(w.y); v[j][3] += bfhi(w.y); } }
#endif
        ln_row(v, P.in[I_LNFG], P.in[I_LNFB], C.lane);
        store_row_f32(P.out + (size_t)m * D, v, C.lane);
        store_row_bf16(XB + (size_t)m * D, v, C.lane);
    }
}

__device__ __forceinline__ void p12_final_ln(const Params& P, const Ctx& C) {
#if FEAT_PLE
    const float* src = (const float*)(P.ws + WS_X1); const float sc = 1.0f;
#else
    const float* src = P.out; const float sc = ALPHA;
#endif
    for (int m = C.gw; m < NTOK; m += C.ngw) {
        f32x4 v[4]; load_row_f32(v, src + (size_t)m * D, C.lane);
#pragma unroll
        for (int j = 0; j < 4; ++j) v[j] = v[j] * sc;
        ln_row(v, P.in[I_LNPG], P.in[I_LNPB], C.lane);
        store_row_f32(P.out + (size_t)m * D, v, C.lane);
    }
}
#define XB_TMO      128
#define XB_XCNT(j)  (256  + 64 * (j))
#define XB_XSUB(j)  (1280 + 64 * (j))
#define XB_XGEN(j)  (2304 + 64 * (j))
#define XB_TOP      3328
#define XB_TOPGEN   3392
#define XCD_BAR_WORDS 3456
#define XB_SPIN_CAP (1u << 18)
#define LAS __attribute__((address_space(3)))

__device__ __forceinline__ unsigned xb_ld(unsigned* p)              { return __hip_atomic_load(p, __ATOMIC_RELAXED, __HIP_MEMORY_SCOPE_AGENT); }
__device__ __forceinline__ unsigned xb_add(unsigned* p, unsigned v) { return __hip_atomic_fetch_add(p, v, __ATOMIC_RELAXED, __HIP_MEMORY_SCOPE_AGENT); }
__device__ __forceinline__ unsigned xb_xcc_id() { return (unsigned)__builtin_amdgcn_s_getreg((3 << 11) | 20) & 0xFu; }
#define XB_SPIN(cond, bar) do { unsigned _sp = 0; while (cond) { __builtin_amdgcn_s_sleep(1); \
    if ((++_sp & 255u) == 0u) { if (xb_ld(&(bar)[XB_TMO])) break; if (_sp > XB_SPIN_CAP) { atomicAdd(&(bar)[XB_TMO], 1u); break; } } } } while (0)

struct XcdBarrier {
    unsigned* bar; unsigned x;
    volatile LAS unsigned* st;
};

__device__ __forceinline__ XcdBarrier xcd_barrier_post(unsigned* bar, volatile LAS unsigned* st) {
    XcdBarrier b; b.bar = bar; b.x = xb_xcc_id(); b.st = st;
    if (threadIdx.x == 0) (void)xb_add(&bar[XB_XCNT(b.x)], 1u);
    return b;
}
__device__ __forceinline__ void xcd_barrier_complete(unsigned* bar, unsigned x, unsigned& nloc, unsigned& nx) {
    const unsigned G = gridDim.x * gridDim.y * gridDim.z;
    unsigned sum, cnt, mine, sp = 0u;
    for (;;) {
        sum = 0u; cnt = 0u; mine = 0u;
#pragma unroll
        for (unsigned j = 0; j < 16; ++j) { const unsigned c = xb_ld(&bar[XB_XCNT(j)]); sum += c; cnt += (c > 0u) ? 1u : 0u; mine = (j == x) ? c : mine; }
        if (sum == G) break;
        __builtin_amdgcn_s_sleep(1);
        if ((++sp & 255u) == 0u) { if (xb_ld(&bar[XB_TMO])) break; if (sp > XB_SPIN_CAP) { atomicAdd(&bar[XB_TMO], 1u); break; } }
    }
    nloc = mine > 0u ? mine : 1u; nx = cnt > 0u ? cnt : 1u;
}

__device__ __forceinline__ void xcd_barrier(const XcdBarrier& b) {
    asm volatile("s_waitcnt vmcnt(0)" ::: "memory");
    __syncthreads();
    if (threadIdx.x == 0) {
        unsigned* bar = b.bar;
        __builtin_amdgcn_s_waitcnt(0);
        unsigned nloc = b.st[0], nx = b.st[1];
        if (nloc == 0u) { xcd_barrier_complete(bar, b.x, nloc, nx); b.st[0] = nloc; b.st[1] = nx; }
        const unsigned old = xb_add(&bar[XB_XSUB(b.x)], 1u);
        const unsigned gen = old / nloc;
        if (old + 1u == (gen + 1u) * nloc) {
            __builtin_amdgcn_fence(__ATOMIC_RELEASE, "agent");
            asm volatile("s_waitcnt vmcnt(0)" ::: "memory");
            const unsigned og = xb_add(&bar[XB_TOP], 1u);
            const unsigned tg = og / nx;
            if (og + 1u == (tg + 1u) * nx) xb_add(&bar[XB_TOPGEN], 1u);
            else XB_SPIN(xb_ld(&bar[XB_TOPGEN]) == tg, bar);
            __builtin_amdgcn_fence(__ATOMIC_ACQUIRE, "agent");
            xb_add(&bar[XB_XGEN(b.x)], 1u);
            asm volatile("s_waitcnt vmcnt(0)" ::: "memory");
        } else {
            XB_SPIN(xb_ld(&bar[XB_XGEN(b.x)]) == gen, bar);
            __builtin_amdgcn_fence(__ATOMIC_ACQUIRE, "agent");
            asm volatile("s_waitcnt vmcnt(0)" ::: "memory");
        }
    }
    __syncthreads();
}


template <int PH> __device__ __forceinline__ void run_phase(const Params& P, const Ctx& C) {
    unsigned char* ws = P.ws;
    typedef pg8::bf16_t pbf;
    if constexpr (PH == 0) { p0_prologue(P, C); }
    else if constexpr (PH == 10) {
        pg8::Gemm g{(const pbf*)(ws + WS_XBF), (const pbf*)(ws + WS_WIN_T), NTOK, D_INP, D}; pg8::StaticOrder S; S.init(NTOK, D_INP, C.G, (int)blockIdx.x);
        pg8::EpiBf16s E{(pbf*)(ws + WS_H), D_INP};
        pg8::gemm_phase<pg8::EpiBf16s, pg8::StaticOrder, true, true>(C.lds, g, S, E); }
    else if constexpr (PH == 11) {
        pg8::Gemm g{(const pbf*)(ws + WS_PB), (const pbf*)(ws + WS_WPROJ_T), NTOK, D, PLE}; pg8::StaticOrder S; S.init(NTOK, D, C.G, (int)blockIdx.x);
        pg8::EpiBf16s E{(pbf*)(ws + WS_PROJ), D};
        pg8::gemm_phase<pg8::EpiBf16s, pg8::StaticOrder, true, true>(C.lds, g, S, E); }
    else if constexpr (PH == 20) { p2_post(P, C); }
    else if constexpr (PH == 21) { p2_hgrn_prep(P, C); }
    else if constexpr (PH == 30) {
        { pg8::Gemm g{(const pbf*)(ws + WS_CN), (const pbf*)(ws + WS_WUK_T), NTOK, 512, 256}; pg8::StaticOrder S; S.init(NTOK, 512, C.G, (int)blockIdx.x);
          pg8::EpiKhead E{(pbf*)(ws + WS_K)};
          pg8::gemm_phase<pg8::EpiKhead, pg8::StaticOrder, true, true>(C.lds, g, S, E); }
        { pg8::Gemm g{(const pbf*)(ws + WS_WUV_T), (const pbf*)(ws + WS_CN), 512, NTOK, 256}; pg8::StaticOrder S; S.init(512, NTOK, C.G, (int)blockIdx.x);
          pg8::EpiVt E{(pbf*)(ws + WS_VT)};
          pg8::gemm_phase<pg8::EpiVt, pg8::StaticOrder, true, true>(C.lds, g, S, E); }
    }
    else if constexpr (PH == 31) { p3_indexer(P, C); }
    else if constexpr (PH == 32) { p3_hgrn_scan(P, C); }
    else if constexpr (PH == 40) { p4_attention2(P, C); }
    else if constexpr (PH == 41) { p4_yrec(P, C); }
    else if constexpr (PH == 5) {
        pg8::Gemm g{(const pbf*)(ws + WS_YMIX), (const pbf*)(ws + WS_WO_T), NTOK, D, D}; pg8::StaticOrder S; S.init(NTOK, D, C.G, (int)blockIdx.x);
        pg8::EpiResid E{P.in[I_X], P.out, D, ALPHA};
        pg8::gemm_phase<pg8::EpiResid, pg8::StaticOrder, true, true>(C.lds, g, S, E);
    }
    else if constexpr (PH == 6) { p6_ln1_router(P, C); }
    else if constexpr (PH == 7) { p7_dispatch(P, C); }
    else if constexpr (PH == 8) {
        const int* tile_e = (const int*)(ws + WS_TILEE);
        pg8::Gemm g{(const pbf*)(ws + WS_XS), (const pbf*)(ws + WS_WUP_T), CAP, NE * 2048, D};
        pg8::MoeOrder S{tile_e, tile_e[MAXTILES], 8, C.G, (int)blockIdx.x};
        pg8::EpiSwiglu E{(pbf*)(ws + WS_HH), P.in[I_BUP]};
        pg8::gemm_phase<pg8::EpiSwiglu, pg8::MoeOrder, true, true>(C.lds, g, S, E);
    }
    else if constexpr (PH == 9) {
        const int* tile_e = (const int*)(ws + WS_TILEE);
        pg8::Gemm g{(const pbf*)(ws + WS_HH), (const pbf*)(ws + WS_WDN_T), CAP, NE * 1024, DFF};
        pg8::MoeOrder S{tile_e, tile_e[MAXTILES], 4, C.G, (int)blockIdx.x};
        pg8::EpiDown E{(pbf*)(ws + WS_YSLOT), P.in[I_BDN], (const float*)(ws + WS_SLOTGATE)};
        pg8::gemm_phase<pg8::EpiDown, pg8::MoeOrder, true, true>(C.lds, g, S, E);
    }
    else if constexpr (PH == 100) { p10_combine_ln2(P, C); }
    else if constexpr (PH == 110) {
        pg8::Gemm g{(const pbf*)(ws + WS_XB), (const pbf*)(ws + WS_WGATE_T), NTOK, D, D}; pg8::StaticOrder S; S.init(NTOK, D, C.G, (int)blockIdx.x);
        pg8::EpiPle E{P.out, (const pbf*)(ws + WS_PROJ), (float*)(ws + WS_X1), ALPHA};
        pg8::gemm_phase<pg8::EpiPle, pg8::StaticOrder, true, true>(C.lds, g, S, E);
    }
    else { p12_final_ln(P, C); }
}
__global__ void __launch_bounds__(NTHR, 2) mega_fwd(Params P) {
    extern __shared__ __attribute__((aligned(16))) unsigned char lds_raw[];
    cg::grid_group grid = cg::this_grid();
    Ctx C;
    C.lds = (LAS unsigned char*)lds_raw;
    C.tid = threadIdx.x; C.lane = C.tid & 63; C.wave = __builtin_amdgcn_readfirstlane(C.tid >> 6);
    C.G = gridDim.x; C.gw = blockIdx.x * NWAVES + C.wave; C.ngw = C.G * NWAVES;
#if SYNC_MODE != 0
    if (C.tid < 4) ((LAS unsigned*)(C.lds + XBW_OFF))[C.tid] = 0u;
    __syncthreads();
    XcdBarrier bar = xcd_barrier_post((unsigned*)(P.ws + WS_CTL) + CW_BAR, (volatile LAS unsigned*)(C.lds + XBW_OFF));
#define SY xcd_barrier(bar);
#else
#define SY grid.sync();
#endif
#define GS grid.sync();
#define BS __syncthreads();
#define X(k) run_phase<k>(P, C);
    PROGRAM
#undef X
#undef SY
#undef GS
#undef BS
}

extern "C" void kernel_launch(void* const* d_in, const int* in_sizes, int n_in, void* d_out, int out_size, void* d_ws, size_t ws_size, hipStream_t stream) {
    static int grid = 0;
    if (grid == 0) {
        if (n_in != 25 || out_size != NTOK * D || ws_size < WS_END) { fprintf(stderr, "kernel_launch: unexpected shapes (n_in %d out %d ws %zu)\n", n_in, out_size, ws_size); grid = -1; return; }
        int dev = 0, cus = 0, per_cu = 0;
        if (hipGetDevice(&dev) != hipSuccess || hipDeviceGetAttribute(&cus, hipDeviceAttributeMultiprocessorCount, dev) != hipSuccess) { grid = -1; return; }
        if (hipFuncSetAttribute((const void*)mega_fwd, hipFuncAttributeMaxDynamicSharedMemorySize, LDS_BYTES) != hipSuccess) { fprintf(stderr, "kernel_launch: hipFuncSetAttribute failed\n"); grid = -1; return; }
        if (hipOccupancyMaxActiveBlocksPerMultiprocessor(&per_cu, (const void*)mega_fwd, NTHR, LDS_BYTES) != hipSuccess || per_cu < 1) { fprintf(stderr, "kernel_launch: occupancy query failed (%d)\n", per_cu); (void)hipGetLastError(); grid = -1; return; }
        grid = cus * per_cu;
        fprintf(stderr, "kernel_launch: grid %d (%d CUs x %d)\n", grid, cus, per_cu);
    }
    if (grid < 0) return;
    (void)hipMemsetAsync((char*)d_ws + WS_CTL, 0, CTL_ZERO_BYTES, stream);
    Params p{};
    for (int i = 0; i < 25; ++i) p.in[i] = (const float*)d_in[i];
    p.out = (float*)d_out; p.ws = (unsigned char*)d_ws;

    void* args[] = {&p};
    hipError_t e = hipLaunchCooperativeKernel((const void*)mega_fwd, dim3(grid), dim3(NTHR), args, LDS_BYTES, stream);
    if (e != hipSuccess) fprintf(stderr, "kernel_launch: cooperative launch failed: %s (grid %d)\n", hipGetErrorString(e), grid);
}
```

```cpp
#define SYNC_MODE 1
#include <hip/hip_runtime.h>
#include <hip/hip_cooperative_groups.h>
#include <cstdio>
#include <cstdint>
namespace cg = cooperative_groups;

namespace pg8 {
#define PG8_LAS __attribute__((address_space(3)))
typedef unsigned short bf16_t;
typedef short bf16x8 __attribute__((ext_vector_type(8)));
typedef float f32x4 __attribute__((ext_vector_type(4)));
typedef unsigned u32x4 __attribute__((ext_vector_type(4)));
constexpr int BM = 256, BK = 64, HALF = 128, HTB = HALF * BK * 2  , STAGE_BYTES = 8 * HTB, NXCD = 8, WGM = 8;

__host__ __device__ __forceinline__ int lds_byte(int r, int c) { const int st = (r >> 4) * 2 + (c >> 5), rr = r & 15, cc = c & 31, ob = rr * 64 + cc * 2; return st * 1024 + (ob ^ (((ob >> 9) & 1) << 5)); }
__host__ __device__ __forceinline__ void stage_rc(int b, int& R, int& C) { const int st = b / 1024, sb = b % 1024, swz = sb ^ (((sb >> 9) & 1) << 5); R = (st >> 1) * 16 + swz / 64; C = (st & 1) * 32 + (swz % 64) / 2; }
__host__ __device__ __forceinline__ int perm32(int rho) { const int n = rho >> 4, i = rho & 15; return 8 * (i >> 2) + 4 * n + (i & 3); }

struct Unit { int pm, pn; };
struct Gemm { const bf16_t* A; const bf16_t* Bt; int M, N, K; };

struct StaticOrder {
    int nM, nN, nwg, G, c;
    __host__ __device__ void init(int M, int N, int G_, int c_) { nM = M / BM; nN = N / BM; nwg = nM * nN; G = G_; c = c_; }
    __host__ __device__ bool next(int i, Unit& u) const {
        const long L = (long)i * G + c; if (L >= nwg) return false;
        int wgid = (int)L; { const int q = nwg / NXCD, r = nwg % NXCD, xcd = wgid % NXCD, off = wgid / NXCD; wgid = (xcd < r ? xcd * (q + 1) : r * (q + 1) + (xcd - r) * q) + off; }
        const int nig = WGM * nN, gid = wgid / nig, fm = gid * WGM, gsz = (nM - fm) < WGM ? (nM - fm) : WGM;
        u.pm = fm + ((wgid % nig) % gsz); u.pn = (wgid % nig) / gsz; return true;
    }
    __device__ __forceinline__ void a_ready(const Unit&) const {}
    __device__ __forceinline__ void done(const Unit&) const {}
};

__device__ __forceinline__ unsigned cvt_pk_bf16(float lo, float hi) { unsigned r; asm volatile("v_cvt_pk_bf16_f32 %0, %1, %2" : "=v"(r) : "v"(lo), "v"(hi)); return r; }
typedef float f32x2 __attribute__((ext_vector_type(2)));
template <class Epi, class Sched, bool ALIGN_EPI = false, bool SP2 = false>
__device__ __forceinline__ void gemm_phase(PG8_LAS unsigned char* lds, const Gemm g, const Sched& S, const Epi& E) {
    const int tid = threadIdx.x, wid = __builtin_amdgcn_readfirstlane(tid >> 6), lane = tid & 63, wr = wid >> 2, wc = wid & 3, fr = lane & 15, fq = lane >> 4;
    const int K = g.K, nt = K / BK;
    unsigned voffA[2], voffB[2];
#pragma unroll
    for (int i = 0; i < 2; ++i) { int R, C; stage_rc(tid * 16 + i * 8192, R, C); const int Rb = Epi::PERM ? ((R & ~31) + perm32(R & 31)) : R;
        voffA[i] = (unsigned)(R * K + C) * 2u; voffB[i] = (unsigned)(Rb * K + C) * 2u; }
    const size_t kstep = (size_t)(BK * 2);
    const size_t hstep = (size_t)HALF * K * 2;
    const size_t tstep = 2 * hstep;
    const unsigned ldsw = (unsigned)wid * 1024u;
    const int aoff = lds_byte(wr * 64 + fr, fq * 8), boff = lds_byte(wc * 32 + fr, fq * 8);
#define PG8_SA(b, h) (((b) * 2 + (h)) * HTB)
#define PG8_SB(b, h) ((4 + (b) * 2 + (h)) * HTB)
#define PG8_STAGE(bufoff, gbase, voff) do { _Pragma("unroll") for (int _i = 0; _i < 2; ++_i) \
        __builtin_amdgcn_global_load_lds((const unsigned*)((const char*)(gbase) + (voff)[_i]), (PG8_LAS unsigned*)(lds + (bufoff) + ldsw + _i * 8192), 16, 0, 0); } while (0)
#define PG8_LDA(dst, b, h) do { _Pragma("unroll") for (int m = 0; m < 4; ++m) _Pragma("unroll") for (int k = 0; k < 2; ++k) dst[m][k] = *(const PG8_LAS bf16x8*)(lds + PG8_SA(b, h) + aoff + m * 2048 + k * 1024); } while (0)
#define PG8_LDB(dst, b, h) do { _Pragma("unroll") for (int n = 0; n < 2; ++n) _Pragma("unroll") for (int k = 0; k < 2; ++k) dst[n][k] = *(const PG8_LAS bf16x8*)(lds + PG8_SB(b, h) + boff + n * 2048 + k * 1024); } while (0)
#define PG8_MMA(ai, bj, At, Bt) do { __builtin_amdgcn_s_setprio(1); _Pragma("unroll") for (int m = 0; m < 4; ++m) _Pragma("unroll") for (int n = 0; n < 2; ++n) _Pragma("unroll") for (int k = 0; k < 2; ++k) \
        acc[ai][bj][m][n] = __builtin_amdgcn_mfma_f32_16x16x32_bf16(Bt[n][k], At[m][k], acc[ai][bj][m][n], 0, 0, 0); __builtin_amdgcn_s_setprio(0); } while (0)
#define PG8_WAIT_V(n) asm volatile("s_waitcnt vmcnt(" #n ")" ::: "memory")
#define PG8_WAIT_L(n) asm volatile("s_waitcnt lgkmcnt(" #n ")" ::: "memory")
#define PG8_BAR __builtin_amdgcn_s_barrier()
#define PG8_SCHED __builtin_amdgcn_sched_barrier(0)
    Unit cur, nxt; int ui = 0;
    if (!S.next(0, cur)) return;
    f32x4 acc[2][2][4][2];
#pragma unroll
    for (int a = 0; a < 2; ++a)
#pragma unroll
        for (int b = 0; b < 2; ++b)
#pragma unroll
            for (int m = 0; m < 4; ++m)
#pragma unroll
                for (int n = 0; n < 2; ++n) acc[a][b][m][n] = (f32x4){0.f, 0.f, 0.f, 0.f};
    bf16x8 At[4][2], B0[2][2], B1[2][2];
    const char* cA = (const char*)g.A + (size_t)cur.pm * tstep; const char* cB = (const char*)g.Bt + (size_t)cur.pn * tstep;
    S.a_ready(cur);
    if constexpr (SP2) {
        PG8_STAGE(PG8_SB(0, 0), cB, voffB); PG8_STAGE(PG8_SB(0, 1), cB + hstep, voffB); PG8_STAGE(PG8_SA(0, 0), cA, voffA); PG8_STAGE(PG8_SA(0, 1), cA + hstep, voffA);
        if (wr == 1) PG8_BAR;
        PG8_WAIT_V(2); PG8_BAR;
        PG8_STAGE(PG8_SB(1, 0), cB + kstep, voffB); PG8_STAGE(PG8_SA(1, 0), cA + kstep, voffA); PG8_STAGE(PG8_SB(1, 1), cB + hstep + kstep, voffB);
        PG8_WAIT_V(6); PG8_BAR;
    } else {
        PG8_STAGE(PG8_SB(0, 0), cB, voffB); PG8_STAGE(PG8_SA(0, 0), cA, voffA); PG8_STAGE(PG8_SB(0, 1), cB + hstep, voffB); PG8_STAGE(PG8_SA(0, 1), cA + hstep, voffA);
        if (wr == 1) PG8_BAR;
        PG8_WAIT_V(4); PG8_BAR;
        PG8_STAGE(PG8_SB(1, 0), cB + kstep, voffB); PG8_STAGE(PG8_SA(1, 0), cA + kstep, voffA); PG8_STAGE(PG8_SB(1, 1), cB + hstep + kstep, voffB);
        PG8_WAIT_V(6); PG8_BAR;
    }
    for (;;) {
        const bool has_next = S.next(ui + 1, nxt);
        const char* nA = has_next ? (const char*)g.A + (size_t)nxt.pm * tstep : cA; const char* nB = has_next ? (const char*)g.Bt + (size_t)nxt.pn * tstep : cB;
_Pragma("nounroll")
        for (int t = 0; t < nt; t += 2) {
            const bool last = (t == nt - 2);
            const char* a1 = cA + (size_t)(t + 1) * kstep;
            const char* a2 = last ? nA : cA + (size_t)(t + 2) * kstep; const char* b2 = last ? nB : cB + (size_t)(t + 2) * kstep;
            const char* a3 = a2 + kstep; const char* b3 = b2 + kstep;
            if (last && has_next) S.a_ready(nxt);
            if constexpr (SP2) {
            PG8_LDB(B0, 0, 0); PG8_LDB(B1, 0, 1); PG8_SCHED; PG8_LDA(At, 0, 0); PG8_STAGE(PG8_SA(1, 1), a1 + hstep, voffA);
            PG8_WAIT_V(8); PG8_WAIT_L(0); PG8_BAR; PG8_MMA(0, 0, At, B0); PG8_MMA(0, 1, At, B1); PG8_BAR; PG8_SCHED;
            PG8_LDA(At, 0, 1); PG8_STAGE(PG8_SB(0, 0), b2, voffB); PG8_STAGE(PG8_SB(0, 1), b2 + hstep, voffB); PG8_STAGE(PG8_SA(0, 0), a2, voffA);
            PG8_WAIT_V(8); PG8_WAIT_L(0); PG8_BAR; PG8_MMA(1, 0, At, B0); PG8_MMA(1, 1, At, B1); PG8_BAR; PG8_SCHED;
            PG8_LDB(B0, 1, 0); PG8_LDB(B1, 1, 1); PG8_SCHED; PG8_LDA(At, 1, 0); PG8_STAGE(PG8_SA(0, 1), a2 + hstep, voffA);
            PG8_WAIT_V(8); PG8_WAIT_L(0); PG8_BAR; PG8_MMA(0, 0, At, B0); PG8_MMA(0, 1, At, B1); PG8_BAR; PG8_SCHED;
            PG8_LDA(At, 1, 1); PG8_STAGE(PG8_SB(1, 0), b3, voffB); PG8_STAGE(PG8_SB(1, 1), b3 + hstep, voffB); PG8_STAGE(PG8_SA(1, 0), a3, voffA);
            PG8_WAIT_V(8); PG8_WAIT_L(0); PG8_BAR; PG8_MMA(1, 0, At, B0); PG8_MMA(1, 1, At, B1); PG8_BAR; PG8_SCHED;
            } else {
            PG8_LDB(B0, 0, 0); PG8_SCHED; PG8_LDA(At, 0, 0); PG8_STAGE(PG8_SA(1, 1), a1 + hstep, voffA);
            PG8_WAIT_L(8); PG8_BAR; PG8_WAIT_L(0); PG8_MMA(0, 0, At, B0); PG8_BAR; PG8_SCHED;
            PG8_LDB(B1, 0, 1); PG8_STAGE(PG8_SB(0, 0), b2, voffB);
            PG8_BAR; PG8_WAIT_L(0); PG8_MMA(0, 1, At, B1); PG8_BAR;
            PG8_LDA(At, 0, 1); PG8_STAGE(PG8_SA(0, 0), a2, voffA);
            PG8_BAR; PG8_WAIT_L(0); PG8_MMA(1, 0, At, B0); PG8_BAR; PG8_SCHED;
            PG8_STAGE(PG8_SB(0, 1), b2 + hstep, voffB);
            PG8_WAIT_V(6); PG8_BAR; PG8_MMA(1, 1, At, B1); PG8_BAR;
            PG8_LDB(B0, 1, 0); PG8_SCHED; PG8_LDA(At, 1, 0); PG8_STAGE(PG8_SA(0, 1), a2 + hstep, voffA);
            PG8_WAIT_L(8); PG8_BAR; PG8_WAIT_L(0); PG8_MMA(0, 0, At, B0); PG8_BAR; PG8_SCHED;
            PG8_LDB(B1, 1, 1); PG8_STAGE(PG8_SB(1, 0), b3, voffB);
            PG8_BAR; PG8_WAIT_L(0); PG8_MMA(0, 1, At, B1); PG8_BAR;
            PG8_LDA(At, 1, 1); PG8_STAGE(PG8_SA(1, 0), a3, voffA);
            PG8_BAR; PG8_WAIT_L(0); PG8_MMA(1, 0, At, B0); PG8_BAR; PG8_SCHED;
            PG8_STAGE(PG8_SB(1, 1), b3 + hstep, voffB);
            PG8_WAIT_V(6); PG8_BAR; PG8_MMA(1, 1, At, B1); PG8_BAR;
            }
        }
        if constexpr (ALIGN_EPI) { if (wr == 0) PG8_BAR; }
        if constexpr (!Epi::AFTER_DRAIN) { E(acc, cur, wr, wc, fr, fq); S.done(cur); }
        if (!has_next) break;
#pragma unroll
        for (int a = 0; a < 2; ++a)
#pragma unroll
            for (int b = 0; b < 2; ++b)
#pragma unroll
                for (int m = 0; m < 4; ++m)
#pragma unroll
                    for (int n = 0; n < 2; ++n) acc[a][b][m][n] = (f32x4){0.f, 0.f, 0.f, 0.f};
        cur = nxt; cA = nA; cB = nB; ++ui;
        if constexpr (ALIGN_EPI) { if (wr == 1) PG8_BAR; }
    }
    PG8_WAIT_V(0);
    if constexpr (!ALIGN_EPI) { if (wr == 0) PG8_BAR; }
    PG8_BAR;
    if constexpr (Epi::AFTER_DRAIN) { E.fused(acc, cur, wr, wc, fr, fq, lds, wid, lane); S.done(cur); }
#undef PG8_SA
#undef PG8_SB
#undef PG8_STAGE
#undef PG8_LDA
#undef PG8_LDB
#undef PG8_MMA
#undef PG8_WAIT_V
#undef PG8_WAIT_L
#undef PG8_BAR
#undef PG8_SCHED
}
}

constexpr int NB = 8, T = 4096, D = 1024, NTOK = NB * T;
constexpr int ATT_H = 8, ATT_D = 64, ATT_W = 512, KV_LAT = 256, IDX_H = 8, IDX_D = 64, TOPK = 256;
constexpr int HG_H = 4, HG_DK = 128, HG_DV = 128, HG_W = 512, HG_C = 32;
constexpr int D_IN = 3400, D_INP = 3584;
constexpr int C_AQ = 0, C_AC = 512, C_IQ = 768, C_IK = 1280, C_IW = 1344, C_GQ = 1352, C_GF = 1864, C_GI = 2376, C_GG = 2888;
constexpr int NE = 32, TOPE = 4, DFF = 1024, PLE = 256;
constexpr int NASSIGN = NTOK * TOPE, CAP = NASSIGN + NE * 256;
constexpr int MAXTILES = CAP / 256;
constexpr float LN_EPS = 1e-5f, RMS_EPS = 1e-6f, ALPHA = 1.189207115002721f;

constexpr size_t MiB = 1u << 20;
constexpr size_t WS_CTL = 0, CTL_ZERO_BYTES = 64 * 1024;
constexpr size_t WS_WIN_T = 1 * MiB, WS_WO_T = 8 * MiB, WS_WUP_T = 10 * MiB, WS_WDN_T = 138 * MiB, WS_WPROJ_T = 202 * MiB, WS_WGATE_T = 203 * MiB;
constexpr size_t WS_WUK_T = 205 * MiB, WS_WUV_T = 205 * MiB + 512 * 1024;
constexpr size_t WS_SMALL = 206 * MiB;
constexpr size_t WS_A = 208 * MiB;
constexpr size_t WS_B = 480 * MiB;
constexpr size_t WS_X1 = 752 * MiB;
constexpr size_t WS_XB = 880 * MiB;
constexpr size_t WS_PROJ = 944 * MiB;
constexpr size_t WS_SM2 = 1008 * MiB;
constexpr size_t WS_END = 1016 * MiB;
constexpr size_t WS_H = WS_A, WS_XS = WS_A, WS_YSLOT = WS_A;
constexpr size_t WS_XBF = WS_B, WS_U = WS_B, WS_YMIX = WS_B, WS_HH = WS_B;
constexpr size_t WS_QDEC = WS_B + 128 * MiB, WS_PB = WS_B + 128 * MiB, WS_OREC = WS_B + 160 * MiB, WS_CN = WS_B + 224 * MiB, WS_IKN = WS_B + 240 * MiB, WS_MASK = WS_B + 244 * MiB;
constexpr size_t WS_K = WS_XB, WS_VT = WS_XB + 32 * MiB;
constexpr size_t WS_TOPE = WS_SM2, WS_GATE = WS_SM2 + 512 * 1024, WS_LRANK = WS_SM2 + 1024 * 1024, WS_TOKSLOT = WS_SM2 + 1536 * 1024, WS_SLOTGATE = WS_SM2 + 2 * MiB, WS_DECAY = WS_SM2 + 3 * MiB;
constexpr size_t WS_WGBASE = WS_SMALL, WS_TILEE = WS_SMALL + 64 * 1024;
constexpr int CW_CNT = 64;
constexpr int CW_BAR = 1024;
constexpr int XBW_OFF = 147456 - 16;

constexpr int RING_BYTES = 131072, MISC_OFF = RING_BYTES, LDS_BYTES = 147456;
constexpr int NWAVES = 8, NTHR = 512;

#define GAS __attribute__((address_space(1)))
#define LAS __attribute__((address_space(3)))
typedef unsigned short bf16;
typedef unsigned v4u __attribute__((ext_vector_type(4)));
typedef unsigned v2u __attribute__((ext_vector_type(2)));
typedef float f32x4 __attribute__((ext_vector_type(4)));
typedef short bf16x8 __attribute__((ext_vector_type(8)));
#define LDS_WAIT() asm volatile("s_waitcnt lgkmcnt(0)" ::: "memory")
#define VM_WAIT() asm volatile("s_waitcnt vmcnt(0)" ::: "memory")
__device__ __forceinline__ unsigned f2bf(float f) { unsigned u = __builtin_bit_cast(unsigned, f); return (u + 0x7fffu + ((u >> 16) & 1u)) >> 16; }
__device__ __forceinline__ unsigned pk2(float lo, float hi) { return f2bf(lo) | (f2bf(hi) << 16); }
__device__ __forceinline__ float bf2f(unsigned short b) { return __builtin_bit_cast(float, (unsigned)b << 16); }
__device__ __forceinline__ float bflo(unsigned w) { return __builtin_bit_cast(float, w << 16); }
__device__ __forceinline__ float bfhi(unsigned w) { return __builtin_bit_cast(float, w & 0xffff0000u); }
__device__ __forceinline__ float wave_sum(float v) {
#pragma unroll
    for (int o = 1; o < 64; o <<= 1) v += __shfl_xor(v, o);
    return v;
}
__device__ __forceinline__ float sigmoidf_(float x) { return 1.f / (1.f + __expf(-x)); }

struct Params { const float* in[25]; float* out; unsigned char* ws; };
enum { I_X = 0, I_P, I_WIN, I_KVG, I_IKG, I_IKB, I_WUK, I_WUV, I_HGLB, I_HGNG, I_WO, I_LNMG, I_LNMB, I_WR, I_BR, I_WUP, I_BUP, I_WDN, I_BDN, I_LNFG, I_LNFB, I_WPP, I_WPG, I_LNPG, I_LNPB };

struct Ctx { LAS unsigned char* lds; int tid, lane, wave, G, gw, ngw; };

namespace pg8 {
struct EpiBf16s {
    static constexpr bool PERM = true, AFTER_DRAIN = false;
    bf16_t* O; int ldc;
    __device__ __forceinline__ void operator()(const f32x4 (&acc)[2][2][4][2], const Unit& u, int wr, int wc, int fr, int fq) const {
        const int row0 = u.pm * BM + wr * 64 + fr, col0 = u.pn * BM + wc * 32 + 8 * fq;
#pragma unroll
        for (int ai = 0; ai < 2; ++ai)
#pragma unroll
            for (int m = 0; m < 4; ++m) { bf16_t* rowp = O + (size_t)(row0 + ai * HALF + m * 16) * ldc + col0;
#pragma unroll
                for (int bj = 0; bj < 2; ++bj) { const f32x4 v0 = acc[ai][bj][m][0], v1 = acc[ai][bj][m][1];
                    u32x4 w; w.x = cvt_pk_bf16(v0[0], v0[1]); w.y = cvt_pk_bf16(v0[2], v0[3]); w.z = cvt_pk_bf16(v1[0], v1[1]); w.w = cvt_pk_bf16(v1[2], v1[3]);
                    *(u32x4*)(rowp + bj * HALF) = w; } }
    }
};
struct EpiResid {
    static constexpr bool PERM = false, AFTER_DRAIN = false;
    const float* res; float* out; int ldc; float alpha;
    __device__ __forceinline__ void operator()(const f32x4 (&acc)[2][2][4][2], const Unit& u, int wr, int wc, int fr, int fq) const {
        const int row0 = u.pm * BM + wr * 64 + fr, col0 = u.pn * BM + wc * 32 + 4 * fq;
#pragma unroll
        for (int ai = 0; ai < 2; ++ai)
#pragma unroll
            for (int m = 0; m < 4; ++m) { const size_t off = (size_t)(row0 + ai * HALF + m * 16) * ldc + col0;
#pragma unroll
                for (int bj = 0; bj < 2; ++bj)
#pragma unroll
                    for (int n = 0; n < 2; ++n) { const f32x4 r = *(const f32x4*)(res + off + bj * HALF + n * 16); *(f32x4*)(out + off + bj * HALF + n * 16) = r * alpha + acc[ai][bj][m][n]; }
                asm volatile("" ::: "memory"); }
    }
};
struct EpiPle {
    static constexpr bool PERM = false, AFTER_DRAIN = false;
    const float* x2; const bf16_t* proj; float* out; float alpha;
    __device__ __forceinline__ void operator()(const f32x4 (&acc)[2][2][4][2], const Unit& u, int wr, int wc, int fr, int fq) const {
        const int row0 = u.pm * BM + wr * 64 + fr, col0 = u.pn * BM + wc * 32 + 4 * fq;
#pragma unroll
        for (int ai = 0; ai < 2; ++ai)
#pragma unroll
            for (int m = 0; m < 4; ++m) { const size_t off = (size_t)(row0 + ai * HALF + m * 16) * 1024 + col0;
#pragma unroll
                for (int bj = 0; bj < 2; ++bj)
#pragma unroll
                    for (int n = 0; n < 2; ++n) { const size_t o2 = off + bj * HALF + n * 16; const f32x4 r = *(const f32x4*)(x2 + o2); const v2u pw = *(const v2u*)(proj + o2);
                        const f32x4 a = acc[ai][bj][m][n]; f32x4 o;
                        o[0] = r[0] * alpha + bflo(pw.x) * sigmoidf_(a[0]); o[1] = r[1] * alpha + bfhi(pw.x) * sigmoidf_(a[1]);
                        o[2] = r[2] * alpha + bflo(pw.y) * sigmoidf_(a[2]); o[3] = r[3] * alpha + bfhi(pw.y) * sigmoidf_(a[3]);
                        *(f32x4*)(out + o2) = o; }
                asm volatile("" ::: "memory"); }
    }
};
struct EpiSwiglu {
    static constexpr bool PERM = true, AFTER_DRAIN = false;
    bf16_t* H; const float* b_up;
    __device__ __forceinline__ void operator()(const f32x4 (&acc)[2][2][4][2], const Unit& u, int wr, int wc, int fr, int fq) const {
        const int e = u.pn >> 3, pnT = u.pn & 7;
        const int row0 = u.pm * BM + wr * 64 + fr, col0 = pnT * 128 + wc * 32 + 8 * fq;
        const float* bg = b_up + (size_t)e * 2048 + col0; const float* bl = bg + 1024;
        float bgv[8], blv[8];
#pragma unroll
        for (int j = 0; j < 8; ++j) { bgv[j] = bg[j]; blv[j] = bl[j]; }
#pragma unroll
        for (int ai = 0; ai < 2; ++ai)
#pragma unroll
            for (int m = 0; m < 4; ++m) { bf16_t* rowp = H + (size_t)(row0 + ai * HALF + m * 16) * 1024 + col0; float a[8];
#pragma unroll
                for (int n = 0; n < 2; ++n)
#pragma unroll
                    for (int j = 0; j < 4; ++j) { float g = acc[ai][0][m][n][j] + bgv[4 * n + j], l = acc[ai][1][m][n][j] + blv[4 * n + j];
                        g = fminf(g, 7.0f); l = fminf(fmaxf(l, -7.0f), 7.0f); a[4 * n + j] = g * sigmoidf_(1.702f * g) * (l + 1.0f); }
                u32x4 w; w.x = cvt_pk_bf16(a[0], a[1]); w.y = cvt_pk_bf16(a[2], a[3]); w.z = cvt_pk_bf16(a[4], a[5]); w.w = cvt_pk_bf16(a[6], a[7]);
                *(u32x4*)rowp = w; }
    }
};
struct EpiDown {
    static constexpr bool PERM = true, AFTER_DRAIN = false;
    bf16_t* Y; const float* b_dn; const float* gate;
    __device__ __forceinline__ void operator()(const f32x4 (&acc)[2][2][4][2], const Unit& u, int wr, int wc, int fr, int fq) const {
        const int e = u.pn >> 2, pnT = u.pn & 3;
        const int row0 = u.pm * BM + wr * 64 + fr, col0 = pnT * 256 + wc * 32 + 8 * fq;
        const float* bb = b_dn + (size_t)e * 1024 + col0;
        float bv[2][8];
#pragma unroll
        for (int bj = 0; bj < 2; ++bj)
#pragma unroll
            for (int j = 0; j < 8; ++j) bv[bj][j] = bb[bj * HALF + j];
#pragma unroll
        for (int ai = 0; ai < 2; ++ai)
#pragma unroll
            for (int m = 0; m < 4; ++m) { const int row = row0 + ai * HALF + m * 16; const float gt = gate[row]; bf16_t* rowp = Y + (size_t)row * 1024 + col0;
#pragma unroll
                for (int bj = 0; bj < 2; ++bj) { const f32x4 v0 = acc[ai][bj][m][0], v1 = acc[ai][bj][m][1];
                    u32x4 w; w.x = cvt_pk_bf16((v0[0] + bv[bj][0]) * gt, (v0[1] + bv[bj][1]) * gt); w.y = cvt_pk_bf16((v0[2] + bv[bj][2]) * gt, (v0[3] + bv[bj][3]) * gt);
                    w.z = cvt_pk_bf16((v1[0] + bv[bj][4]) * gt, (v1[1] + bv[bj][5]) * gt); w.w = cvt_pk_bf16((v1[2] + bv[bj][6]) * gt, (v1[3] + bv[bj][7]) * gt);
                    *(u32x4*)(rowp + bj * HALF) = w; } }
    }
};
struct MoeOrder {
    const int* tile_e; int ntiles, nN, G, c;
    __device__ __forceinline__ bool next(int i, Unit& u) const {
        const int L = i * G + c; if (L >= ntiles * nN) return false;
        const int pm = L / nN, pl = L - pm * nN; u.pm = pm; u.pn = tile_e[pm] * nN + pl; return true;
    }
    __device__ __forceinline__ void a_ready(const Unit&) const {}
    __device__ __forceinline__ void done(const Unit&) const {}
};
}

template <class RowMap>
__device__ __forceinline__ void transpose_item(const float* W, int ldw, int Nvalid, bf16* WT, int Kdim, RowMap rm, LAS float* scr, int kb, int nb, int lane) {
    const int k0 = 64 * kb, n0 = 32 * nb; const int nl0 = lane & 31, nn = n0 + nl0;
#pragma unroll 8
    for (int i = 0; i < 32; ++i) { const int kk = 2 * i + (lane >> 5); scr[kk * 33 + nl0] = (nn < Nvalid) ? W[(size_t)(k0 + kk) * ldw + nn] : 0.f; }
    LDS_WAIT(); asm volatile("" ::: "memory");
    const int c = lane & 7;
#pragma unroll
    for (int j = 0; j < 4; ++j) { const int n = (lane >> 3) + 8 * j; const LAS float* s = scr + (8 * c) * 33 + n;
        v4u o; o.x = pk2(s[0 * 33], s[1 * 33]); o.y = pk2(s[2 * 33], s[3 * 33]); o.z = pk2(s[4 * 33], s[5 * 33]); o.w = pk2(s[6 * 33], s[7 * 33]);
        *(GAS v4u*)(WT + (size_t)rm(n0 + n) * Kdim + k0 + 8 * c) = o; }
    LDS_WAIT(); asm volatile("" ::: "memory");
}
struct RmId { __device__ __forceinline__ int operator()(int n) const { return n; } };
struct RmUp { int e; __device__ __forceinline__ int operator()(int n) const { return e * 2048 + ((n & 1023) >> 7) * 256 + (n >> 10) * 128 + (n & 127); } };
struct RmOff { int off; __device__ __forceinline__ int operator()(int n) const { return off + n; } };

__device__ __forceinline__ void p0_prologue(const Params& P, const Ctx& C) {
    LAS float* scr = (LAS float*)(C.lds + C.wave * 16384);
    unsigned char* ws = P.ws;
    constexpr int I_IN = 16 * (D_INP / 32), I_O = 16 * 32, I_UP = 16 * 64, I_DN = 16 * 32, I_PP = 4 * 32, I_PG = 16 * 32, I_UK = 4 * 16, I_UV = 4 * 16;
    constexpr int NITEMS = I_IN + I_O + NE * I_UP + NE * I_DN + I_PP + I_PG + I_UK + I_UV;
    for (int it = C.gw; it < NITEMS; it += C.ngw) {
        int r = it;
        if (r < I_IN) { transpose_item(P.in[I_WIN], D_IN, D_IN, (bf16*)(ws + WS_WIN_T), 1024, RmId{}, scr, r / (D_INP / 32), r % (D_INP / 32), C.lane); continue; } r -= I_IN;
        if (r < I_O) { transpose_item(P.in[I_WO], 1024, 1024, (bf16*)(ws + WS_WO_T), 1024, RmId{}, scr, r / 32, r % 32, C.lane); continue; } r -= I_O;
        if (r < NE * I_UP) { const int e = r / I_UP, q = r % I_UP; transpose_item(P.in[I_WUP] + (size_t)e * 1024 * 2048, 2048, 2048, (bf16*)(ws + WS_WUP_T), 1024, RmUp{e}, scr, q / 64, q % 64, C.lane); continue; } r -= NE * I_UP;
        if (r < NE * I_DN) { const int e = r / I_DN, q = r % I_DN; transpose_item(P.in[I_WDN] + (size_t)e * 1024 * 1024, 1024, 1024, (bf16*)(ws + WS_WDN_T), 1024, RmOff{e * 1024}, scr, q / 32, q % 32, C.lane); continue; } r -= NE * I_DN;
        if (r < I_PP) { transpose_item(P.in[I_WPP], 1024, 1024, (bf16*)(ws + WS_WPROJ_T), 256, RmId{}, scr, r / 32, r % 32, C.lane); continue; } r -= I_PP;
        if (r < I_PG) { transpose_item(P.in[I_WPG], 1024, 1024, (bf16*)(ws + WS_WGATE_T), 1024, RmId{}, scr, r / 32, r % 32, C.lane); continue; } r -= I_PG;
        if (r < I_UK) { transpose_item(P.in[I_WUK], 512, 512, (bf16*)(ws + WS_WUK_T), 256, RmId{}, scr, r / 16, r % 16, C.lane); continue; } r -= I_UK;
        transpose_item(P.in[I_WUV], 512, 512, (bf16*)(ws + WS_WUV_T), 256, RmId{}, scr, r / 16, r % 16, C.lane);
    }
    {
        const float* x = P.in[I_X]; bf16* xb = (bf16*)(ws + WS_XBF);
        const size_t n8 = (size_t)NTOK * D / 8, stride = (size_t)C.ngw * 64;
        for (size_t i = (size_t)C.gw * 64 + C.lane; i < n8; i += stride) { const f32x4 a = *(const GAS f32x4*)(x + i * 8), b = *(const GAS f32x4*)(x + i * 8 + 4);
            v4u o; o.x = pk2(a[0], a[1]); o.y = pk2(a[2], a[3]); o.z = pk2(b[0], b[1]); o.w = pk2(b[2], b[3]); *(GAS v4u*)(xb + i * 8) = o; }
        const float* p = P.in[I_P]; bf16* pb = (bf16*)(ws + WS_PB);
        const size_t m8 = (size_t)NTOK * PLE / 8;
        for (size_t i = (size_t)C.gw * 64 + C.lane; i < m8; i += stride) { const f32x4 a = *(const GAS f32x4*)(p + i * 8), b = *(const GAS f32x4*)(p + i * 8 + 4);
            v4u o; o.x = pk2(a[0], a[1]); o.y = pk2(a[2], a[3]); o.z = pk2(b[0], b[1]); o.w = pk2(b[2], b[3]); *(GAS v4u*)(pb + i * 8) = o; }
    }
}

__device__ __forceinline__ void ln_row(f32x4 (&v)[4], const float* g, const float* b, int lane) {
    float s = 0.f;
#pragma unroll
    for (int j = 0; j < 4; ++j) s += (v[j][0] + v[j][1]) + (v[j][2] + v[j][3]);
    const float mean = wave_sum(s) * (1.f / D); float s2 = 0.f;
#pragma unroll
    for (int j = 0; j < 4; ++j) { v[j] = v[j] - mean; s2 += (v[j][0] * v[j][0] + v[j][1] * v[j][1]) + (v[j][2] * v[j][2] + v[j][3] * v[j][3]); }
    const float rstd = 1.f / sqrtf(wave_sum(s2) * (1.f / D) + LN_EPS);
#pragma unroll
    for (int j = 0; j < 4; ++j) { const f32x4 gg = *(const f32x4*)(g + 4 * lane + 256 * j), bb = *(const f32x4*)(b + 4 * lane + 256 * j); v[j] = v[j] * rstd * gg + bb; }
}
__device__ __forceinline__ void store_row_f32(float* row, const f32x4 (&v)[4], int lane) {
#pragma unroll
    for (int j = 0; j < 4; ++j) *(GAS f32x4*)(row + 4 * lane + 256 * j) = v[j];
}
__device__ __forceinline__ void store_row_bf16(bf16* row, const f32x4 (&v)[4], int lane) {
#pragma unroll
    for (int j = 0; j < 4; ++j) { v2u o; o.x = pk2(v[j][0], v[j][1]); o.y = pk2(v[j][2], v[j][3]); *(GAS v2u*)(row + 4 * lane + 256 * j) = o; }
}
__device__ __forceinline__ void load_row_f32(f32x4 (&v)[4], const float* row, int lane) {
#pragma unroll
    for (int j = 0; j < 4; ++j) v[j] = *(const GAS f32x4*)(row + 4 * lane + 256 * j);
}
#ifndef FEAT_MIX
#define FEAT_MIX 1
#endif
#ifndef FEAT_MOE
#define FEAT_MOE 1
#endif
#ifndef FEAT_PLE
#define FEAT_PLE 1
#endif
#ifndef FEAT_ATT
#define FEAT_ATT 1
#endif
#ifndef SYNC_MODE
#define SYNC_MODE 0
#endif
#ifndef PROGRAM
#define PROGRAM X(0) GS X(10) X(11) SY X(20) X(21) SY X(30) X(31) BS X(32) SY X(40) X(41) SY X(5) SY X(6) SY X(7) SY X(8) SY X(9) SY X(100) SY X(110) SY X(120)
#endif

typedef float f32x16 __attribute__((ext_vector_type(16)));
typedef short s16x4 __attribute__((ext_vector_type(4)));
__device__ __forceinline__ unsigned cvtpk(float lo, float hi) { typedef float f2 __attribute__((ext_vector_type(2))); typedef __bf16 b2 __attribute__((ext_vector_type(2))); f2 v = {lo, hi}; b2 b = __builtin_convertvector(v, b2); return __builtin_bit_cast(unsigned, b); }
__device__ __forceinline__ bf16x8 pack8(const f32x16& x, int base) {
    v4u w; w.x = cvtpk(x[base + 0], x[base + 1]); w.y = cvtpk(x[base + 2], x[base + 3]); w.z = cvtpk(x[base + 4], x[base + 5]); w.w = cvtpk(x[base + 6], x[base + 7]);
    return __builtin_bit_cast(bf16x8, w);
}

__device__ __forceinline__ void p2_post(const Params& P, const Ctx& C) {
    unsigned char* ws = P.ws;
    const bf16* H = (const bf16*)(ws + WS_H); bf16* CN = (bf16*)(ws + WS_CN); bf16* IKN = (bf16*)(ws + WS_IKN);
    const float* kvg = P.in[I_KVG]; const float* ikg = P.in[I_IKG]; const float* ikb = P.in[I_IKB];
    const f32x4 g4 = *(const f32x4*)(kvg + 4 * C.lane); const float ig = ikg[C.lane], ib = ikb[C.lane];
    for (int m = C.gw; m < NTOK; m += C.ngw) {
        const bf16* hr = H + (size_t)m * D_INP;
        const v2u w = *(const GAS v2u*)(hr + C_AC + 4 * C.lane);
        float a0 = bflo(w.x), a1 = bfhi(w.x), a2 = bflo(w.y), a3 = bfhi(w.y);
        const float ss = wave_sum((a0 * a0 + a1 * a1) + (a2 * a2 + a3 * a3));
        const float rs = 1.f / sqrtf(ss * (1.f / 256.f) + RMS_EPS);
        v2u o; o.x = pk2(a0 * rs * g4[0], a1 * rs * g4[1]); o.y = pk2(a2 * rs * g4[2], a3 * rs * g4[3]);
        *(GAS v2u*)(CN + (size_t)m * 256 + 4 * C.lane) = o;
        const float k = bf2f(hr[C_IK + C.lane]);
        const float mu = wave_sum(k) * (1.f / 64.f); const float dk = k - mu;
        const float var = wave_sum(dk * dk) * (1.f / 64.f);
        IKN[(size_t)m * 64 + C.lane] = (bf16)f2bf(dk * (1.f / sqrtf(var + LN_EPS)) * ig + ib);
    }
}

constexpr int HP_QD = 0, HP_KI = 8704, HP_KET = 17408, HP_VT = 27648, HP_GS = 37888, HP_RAW = 40960;
__device__ __forceinline__ void p2_hgrn_prep(const Params& P, const Ctx& C) {
    unsigned char* ws = P.ws;
    const bf16* H = (const bf16*)(ws + WS_H);
    bf16* UT = (bf16*)(ws + WS_U); bf16* QDEC = (bf16*)(ws + WS_QDEC); float* OREC = (float*)(ws + WS_OREC); float* DEC = (float*)(ws + WS_DECAY);
    LAS bf16* QD = (LAS bf16*)(C.lds + HP_QD); LAS bf16* KI = (LAS bf16*)(C.lds + HP_KI); LAS bf16* KET = (LAS bf16*)(C.lds + HP_KET); LAS bf16* VT = (LAS bf16*)(C.lds + HP_VT);
    LAS float* GS = (LAS float*)(C.lds + HP_GS); LAS bf16* RAW = (LAS bf16*)(C.lds + HP_RAW);
    const int d = C.tid & 127, tg = C.tid >> 7;
    const int lane = C.lane, r32 = lane & 31, hf = lane >> 5;
    const int lc = C.tid >> 4, lg = C.tid & 15;
    const int NU = NB * HG_H * (T / HG_C);
    v4u rf, rq, ri;
    { const int unit = blockIdx.x; if (unit < NU) { const int n = unit & 127, hh = (unit >> 7) & 3, b = unit >> 9; const bf16* hr = H + (size_t)(b * T + n * HG_C + lc) * D_INP + hh * 128 + 8 * lg;
        rf = *(const GAS v4u*)(hr + C_GF); rq = *(const GAS v4u*)(hr + C_GQ); ri = *(const GAS v4u*)(hr + C_GI); } }
    for (int unit = blockIdx.x; unit < NU; unit += C.G) {
        const int n = unit & 127, hh = (unit >> 7) & 3, b = unit >> 9;
        const int m0 = b * T + n * HG_C;
        *(LAS v4u*)(RAW + lc * 128 + 8 * lg) = rf; *(LAS v4u*)(RAW + 4096 + lc * 128 + 8 * lg) = rq; *(LAS v4u*)(RAW + 8192 + lc * 128 + 8 * lg) = ri;
        __syncthreads();
        { const int un = unit + C.G; if (un < NU) { const int n2 = un & 127, h2 = (un >> 7) & 3, b2 = un >> 9; const bf16* hr = H + (size_t)(b2 * T + n2 * HG_C + lc) * D_INP + h2 * 128 + 8 * lg;
            rf = *(const GAS v4u*)(hr + C_GF); rq = *(const GAS v4u*)(hr + C_GQ); ri = *(const GAS v4u*)(hr + C_GI); } }
        const float l0 = P.in[I_HGLB][hh * 128 + d], l1 = P.in[I_HGLB][512 + hh * 128 + d];
        const float lb = 1.f / (1.f + __expf(l1 - l0));
        float fg[8], bl[8], qv[8]; float run = 0.f; unsigned vv[4];
#pragma unroll
        for (int c = 0; c < 8; ++c) { const int tok = tg * 8 + c;
            const float f = bf2f(RAW[tok * 128 + d]), q = bf2f(RAW[4096 + tok * 128 + d]); const unsigned iv = RAW[8192 + tok * 128 + d];
            fg[c] = lb + (1.f - lb) * sigmoidf_(f); run += __logf(fg[c]); bl[c] = run; qv[c] = q * sigmoidf_(q);
            if (c & 1) vv[c >> 1] |= iv << 16; else vv[c >> 1] = iv; }
        GS[tg * 128 + d] = run;
        *(LAS v4u*)(VT + d * 40 + tg * 8) = (v4u){vv[0], vv[1], vv[2], vv[3]};
        __syncthreads();
        float pre = 0.f, tot = 0.f;
#pragma unroll
        for (int g = 0; g < 4; ++g) { const float sg = GS[g * 128 + d]; tot += sg; if (g < tg) pre += sg; }
        unsigned ke[4];
#pragma unroll
        for (int c = 0; c < 8; ++c) { const float bc = pre + bl[c]; const float kc = 1.f - fg[c];
            const float qd = qv[c] * __expf(bc), ki = kc * __expf(-bc), kend = kc * __expf(tot - bc);
            const unsigned qb = f2bf(qd);
            QD[(tg * 8 + c) * 136 + d] = (bf16)qb; KI[(tg * 8 + c) * 136 + d] = (bf16)f2bf(ki);
            if (c & 1) ke[c >> 1] |= f2bf(kend) << 16; else ke[c >> 1] = f2bf(kend); }
        *(LAS v4u*)(KET + d * 40 + tg * 8) = (v4u){ke[0], ke[1], ke[2], ke[3]};
        if (tg == 0) DEC[(size_t)unit * 128 + d] = __expf(tot);
        __syncthreads();
        *(GAS v4u*)(QDEC + (size_t)(m0 + lc) * 512 + hh * 128 + 8 * lg) = *(const LAS v4u*)(QD + lc * 136 + 8 * lg);
        if (C.wave < 4) {
            f32x16 X = {0.f, 0.f, 0.f, 0.f, 0.f, 0.f, 0.f, 0.f, 0.f, 0.f, 0.f, 0.f, 0.f, 0.f, 0.f, 0.f};
#pragma unroll
            for (int k = 0; k < 8; ++k) { const bf16x8 a = *(const LAS bf16x8*)(KI + r32 * 136 + 16 * k + 8 * hf), bq = *(const LAS bf16x8*)(QD + r32 * 136 + 16 * k + 8 * hf);
                X = __builtin_amdgcn_mfma_f32_32x32x16_bf16(a, bq, X, 0, 0, 0); }
#pragma unroll
            for (int r = 0; r < 16; ++r) { const int sidx = (r & 3) + 8 * (r >> 2) + 4 * hf; if (sidx > r32) X[r] = 0.f; }
            f32x16 Z = {0.f, 0.f, 0.f, 0.f, 0.f, 0.f, 0.f, 0.f, 0.f, 0.f, 0.f, 0.f, 0.f, 0.f, 0.f, 0.f};
            const int e = C.wave * 32 + r32;
#pragma unroll
            for (int sp = 0; sp < 2; ++sp) { const bf16x8 a = pack8(X, 8 * sp);
                const s16x4 lo = *(const LAS s16x4*)(VT + e * 40 + 16 * sp + 4 * hf), hi = *(const LAS s16x4*)(VT + e * 40 + 16 * sp + 8 + 4 * hf);
                const bf16x8 bv = (bf16x8){lo[0], lo[1], lo[2], lo[3], hi[0], hi[1], hi[2], hi[3]};
                Z = __builtin_amdgcn_mfma_f32_32x32x16_bf16(a, bv, Z, 0, 0, 0); }
#pragma unroll
            for (int r = 0; r < 16; ++r) { const int c = (r & 3) + 8 * (r >> 2) + 4 * hf; OREC[(size_t)(m0 + c) * 512 + hh * 128 + e] = Z[r]; }
        }
        {
            const int dt = C.wave >> 1;
            const bf16x8 a0 = *(const LAS bf16x8*)(KET + (dt * 32 + r32) * 40 + 8 * hf), a1 = *(const LAS bf16x8*)(KET + (dt * 32 + r32) * 40 + 16 + 8 * hf);
#pragma unroll
            for (int ei = 0; ei < 2; ++ei) { const int et = 2 * (C.wave & 1) + ei;
                const bf16x8 b0 = *(const LAS bf16x8*)(VT + (et * 32 + r32) * 40 + 8 * hf), b1 = *(const LAS bf16x8*)(VT + (et * 32 + r32) * 40 + 16 + 8 * hf);
                f32x16 U = {0.f, 0.f, 0.f, 0.f, 0.f, 0.f, 0.f, 0.f, 0.f, 0.f, 0.f, 0.f, 0.f, 0.f, 0.f, 0.f};
                U = __builtin_amdgcn_mfma_f32_32x32x16_bf16(a0, b0, U, 0, 0, 0); U = __builtin_amdgcn_mfma_f32_32x32x16_bf16(a1, b1, U, 0, 0, 0);
                bf16* up = UT + (size_t)unit * 16384 + (size_t)(et * 32 + r32) * 128 + dt * 32 + 4 * hf;
#pragma unroll
                for (int q = 0; q < 4; ++q) { v2u o; o.x = cvtpk(U[4 * q], U[4 * q + 1]); o.y = cvtpk(U[4 * q + 2], U[4 * q + 3]); *(GAS v2u*)(up + 8 * q) = o; } }
        }
        __syncthreads();
    }
}

__device__ __forceinline__ void p3_hgrn_scan(const Params& P, const Ctx& C) {
    unsigned char* ws = P.ws;
    const bf16* UT = (const bf16*)(ws + WS_U); const bf16* QDEC = (const bf16*)(ws + WS_QDEC); float* OREC = (float*)(ws + WS_OREC); const float* DEC = (const float*)(ws + WS_DECAY);
    LAS bf16* ST = (LAS bf16*)C.lds;
    typedef float f32x4v __attribute__((ext_vector_type(4)));
    for (int unit = blockIdx.x; unit < NB * HG_H * 8; unit += C.G) {
        const int sl = unit & 7, hh = (unit >> 3) & 3, b = unit >> 5; const int e0 = sl * 16;
        const int e = C.tid & 15, dq = C.tid >> 4;
        float S[4] = {0.f, 0.f, 0.f, 0.f};
        *(LAS v2u*)(ST + e * 136 + 4 * dq) = (v2u){0u, 0u};
        const int cu0 = (b * HG_H + hh) * 128;
        const int lane = C.lane, fr = lane & 15, fq = lane >> 4;
        const bool mw = C.wave < 2;
        const bf16* up = UT + (size_t)cu0 * 16384 + (size_t)(e0 + e) * 128 + 4 * dq;
        const float* dp = DEC + (size_t)cu0 * 128 + 4 * dq;
        const bf16* qp = QDEC + (size_t)(b * T + C.wave * 16 + fr) * 512 + hh * 128 + 8 * fq;
        float* op = OREC + (size_t)(b * T + C.wave * 16 + 4 * fq) * 512 + hh * 128 + e0 + fr;
        v2u un[4]; f32x4 dn[4]; bf16x8 qa[4][4]; float oi[4][4];
#pragma unroll
        for (int s = 0; s < 4; ++s) { un[s] = *(const GAS v2u*)(up + (size_t)s * 16384); dn[s] = *(const GAS f32x4*)(dp + (size_t)s * 128);
            if (mw) {
#pragma unroll
                for (int k = 0; k < 4; ++k) qa[s][k] = *(const GAS bf16x8*)(qp + (size_t)s * 32 * 512 + 32 * k);
#pragma unroll
                for (int j = 0; j < 4; ++j) oi[s][j] = op[(size_t)(s * 32 + j) * 512]; } }
        __syncthreads();
        for (int nb = 0; nb < 32; ++nb) {
#pragma unroll
            for (int s = 0; s < 4; ++s) {
                const int n = 4 * nb + s;
                const LAS bf16* stc = ST + (n & 1) * (16 * 136); LAS bf16* stn = ST + ((n + 1) & 1) * (16 * 136);
                if (mw) {
                    f32x4v acc = {oi[s][0], oi[s][1], oi[s][2], oi[s][3]};
#pragma unroll
                    for (int k = 0; k < 4; ++k) { const bf16x8 bs = *(const LAS bf16x8*)(stc + fr * 136 + 32 * k + 8 * fq); acc = __builtin_amdgcn_mfma_f32_16x16x32_bf16(qa[s][k], bs, acc, 0, 0, 0); }
#pragma unroll
                    for (int j = 0; j < 4; ++j) op[(size_t)(n * 32 + j) * 512] = acc[j];
                }
                S[0] = dn[s][0] * S[0] + bflo(un[s].x); S[1] = dn[s][1] * S[1] + bfhi(un[s].x); S[2] = dn[s][2] * S[2] + bflo(un[s].y); S[3] = dn[s][3] * S[3] + bfhi(un[s].y);
                *(LAS v2u*)(stn + e * 136 + 4 * dq) = (v2u){cvtpk(S[0], S[1]), cvtpk(S[2], S[3])};
                if (nb + 1 < 32) {
                    const int n2 = n + 4; un[s] = *(const GAS v2u*)(up + (size_t)n2 * 16384); dn[s] = *(const GAS f32x4*)(dp + (size_t)n2 * 128);
                    if (mw) {
#pragma unroll
                        for (int k = 0; k < 4; ++k) qa[s][k] = *(const GAS bf16x8*)(qp + (size_t)n2 * 32 * 512 + 32 * k);
#pragma unroll
                        for (int j = 0; j < 4; ++j) oi[s][j] = op[(size_t)(n2 * 32 + j) * 512]; }
                }
                __syncthreads();
            }
        }
    }
}

__device__ __forceinline__ void p4_yrec(const Params& P, const Ctx& C) {
    unsigned char* ws = P.ws;
    const float* OREC = (const float*)(ws + WS_OREC); const bf16* H = (const bf16*)(ws + WS_H); bf16* YM = (bf16*)(ws + WS_YMIX);
    const float* ng = P.in[I_HGNG];
    const f32x4 g0 = *(const f32x4*)(ng + 8 * C.lane), g1 = *(const f32x4*)(ng + 8 * C.lane + 4);
    for (int m = C.gw; m < NTOK; m += C.ngw) {
        const f32x4 a = *(const GAS f32x4*)(OREC + (size_t)m * 512 + 8 * C.lane), bq = *(const GAS f32x4*)(OREC + (size_t)m * 512 + 8 * C.lane + 4);
        float ss = (a[0] * a[0] + a[1] * a[1]) + (a[2] * a[2] + a[3] * a[3]) + (bq[0] * bq[0] + bq[1] * bq[1]) + (bq[2] * bq[2] + bq[3] * bq[3]);
        ss += __shfl_xor(ss, 1); ss += __shfl_xor(ss, 2); ss += __shfl_xor(ss, 4); ss += __shfl_xor(ss, 8);
        const float rs = 1.f / sqrtf(ss * (1.f / 128.f) + RMS_EPS);
        const v4u gw = *(const GAS v4u*)(H + (size_t)m * D_INP + C_GG + 8 * C.lane);
        float gv[8] = {bflo(gw.x), bfhi(gw.x), bflo(gw.y), bfhi(gw.y), bflo(gw.z), bfhi(gw.z), bflo(gw.w), bfhi(gw.w)};
        float o[8];
#pragma unroll
        for (int j = 0; j < 4; ++j) { o[j] = a[j] * rs * g0[j] * (gv[j] * sigmoidf_(gv[j])); o[4 + j] = bq[j] * rs * g1[j] * (gv[4 + j] * sigmoidf_(gv[4 + j])); }
        v4u w; w.x = pk2(o[0], o[1]); w.y = pk2(o[2], o[3]); w.z = pk2(o[4], o[5]); w.w = pk2(o[6], o[7]);
        *(GAS v4u*)(YM + (size_t)m * D + 512 + 8 * C.lane) = w;
#if !FEAT_ATT
        *(GAS v4u*)(YM + (size_t)m * D + 8 * C.lane) = (v4u){0u, 0u, 0u, 0u};
#endif
    }
}

namespace pg8 {
struct EpiKhead {
    static constexpr bool PERM = true, AFTER_DRAIN = false;
    bf16_t* O;
    __device__ __forceinline__ void operator()(const f32x4 (&acc)[2][2][4][2], const Unit& u, int wr, int wc, int fr, int fq) const {
        const int row0 = u.pm * BM + wr * 64 + fr, col0 = u.pn * BM + wc * 32 + 8 * fq;
#pragma unroll
        for (int ai = 0; ai < 2; ++ai)
#pragma unroll
            for (int m = 0; m < 4; ++m) { const int row = row0 + ai * HALF + m * 16; const int b = row >> 12, t = row & 4095;
#pragma unroll
                for (int bj = 0; bj < 2; ++bj) { const int col = col0 + bj * HALF; const f32x4 v0 = acc[ai][bj][m][0], v1 = acc[ai][bj][m][1];
                    u32x4 w; w.x = cvt_pk_bf16(v0[0], v0[1]); w.y = cvt_pk_bf16(v0[2], v0[3]); w.z = cvt_pk_bf16(v1[0], v1[1]); w.w = cvt_pk_bf16(v1[2], v1[3]);
                    *(u32x4*)(O + ((size_t)((b * 8 + (col >> 6)) * 4096 + t)) * 64 + (col & 63)) = w; } }
    }
};
struct EpiVt {
    static constexpr bool PERM = true, AFTER_DRAIN = false;
    bf16_t* O;
    __device__ __forceinline__ void operator()(const f32x4 (&acc)[2][2][4][2], const Unit& u, int wr, int wc, int fr, int fq) const {
        const int row0 = u.pm * BM + wr * 64 + fr, col0 = u.pn * BM + wc * 32 + 8 * fq;
#pragma unroll
        for (int ai = 0; ai < 2; ++ai)
#pragma unroll
            for (int m = 0; m < 4; ++m) { const int row = row0 + ai * HALF + m * 16;
#pragma unroll
                for (int bj = 0; bj < 2; ++bj) { const int col = col0 + bj * HALF; const int b = col >> 12, t = col & 4095; const f32x4 v0 = acc[ai][bj][m][0], v1 = acc[ai][bj][m][1];
                    u32x4 w; w.x = cvt_pk_bf16(v0[0], v0[1]); w.y = cvt_pk_bf16(v0[2], v0[3]); w.z = cvt_pk_bf16(v1[0], v1[1]); w.w = cvt_pk_bf16(v1[2], v1[3]);
                    *(u32x4*)(O + ((size_t)(b * 512 + row)) * 4096 + t) = w; } }
    }
};
}

__device__ __forceinline__ unsigned f2ord(float x) { const unsigned b = __builtin_bit_cast(unsigned, x); return b ^ ((unsigned)((int)b >> 31) | 0x80000000u); }
__device__ __forceinline__ float relu_i(float x) { const int b = __builtin_bit_cast(int, x); return __builtin_bit_cast(float, b > 0 ? b : 0); }
__device__ __forceinline__ int isc_bucket(float x, float mu, float scale) { const float t = fminf(fmaxf(fmaf(x - mu, scale, 128.f), 0.f), 255.f); return (int)t; }
__device__ __forceinline__ void p3_indexer(const Params& P, const Ctx& C) {
    unsigned char* ws = P.ws;
    const bf16* H = (const bf16*)(ws + WS_H); const bf16* IKN = (const bf16*)(ws + WS_IKN); unsigned* MASK = (unsigned*)(ws + WS_MASK);
    LAS float* ISC = (LAS float*)C.lds; LAS unsigned* HIST = (LAS unsigned*)(C.lds + 131072) + C.wave * 256; LAS float* STAT = (LAS float*)(C.lds + 139264);
    const int lane = C.lane, r32 = lane & 31, hf = lane >> 5;
    const int ql = 2 * (r32 >> 4) + ((r32 >> 2) & 1), hd = 4 * ((r32 >> 3) & 1) + (r32 & 3);
    constexpr int CAND_CAP = 120;
    for (int u = blockIdx.x; u < NTOK / 8; u += C.G) {
        const int b = (u & 255) >> 5, j = u & 31, i = u >> 8; const int pi = i >> 1; const int blk = (i & 1) ? (511 - (j + 32 * pi)) : (j + 32 * pi);
        const int t0 = blk * 8; const size_t mb = (size_t)b * T;
        const int nkt = (t0 + 8 + 31) >> 5;
        bf16x8 af[2][4]; float wq[2][2][8];
#pragma unroll
        for (int a = 0; a < 2; ++a) {
            const bf16* qp = H + (mb + t0 + 4 * a + ql) * D_INP + C_IQ + hd * 64 + 8 * hf;
#pragma unroll
            for (int k = 0; k < 4; ++k) af[a][k] = *(const GAS bf16x8*)(qp + 16 * k);
#pragma unroll
            for (int qh = 0; qh < 2; ++qh) { const v4u w = *(const GAS v4u*)(H + (mb + t0 + 4 * a + 2 * qh + hf) * D_INP + C_IW);
                const float sc = 0.125f * 0.35355339059327373f;
                wq[a][qh][0] = bflo(w.x) * sc; wq[a][qh][1] = bfhi(w.x) * sc; wq[a][qh][2] = bflo(w.y) * sc; wq[a][qh][3] = bfhi(w.y) * sc;
                wq[a][qh][4] = bflo(w.z) * sc; wq[a][qh][5] = bfhi(w.z) * sc; wq[a][qh][6] = bflo(w.w) * sc; wq[a][qh][7] = bfhi(w.w) * sc; }
        }
        {
            float s1[2][2] = {{0.f, 0.f}, {0.f, 0.f}}, s2[2][2] = {{0.f, 0.f}, {0.f, 0.f}};
            int kt = C.wave; bf16x8 bk[4], bn[4];
            if (kt < nkt) { const bf16* kp = IKN + (mb + kt * 32 + r32) * 64 + 8 * hf;
#pragma unroll
                for (int k = 0; k < 4; ++k) bk[k] = *(const GAS bf16x8*)(kp + 16 * k); }
            for (; kt < nkt; kt += NWAVES) {
                const int s0 = kt * 32;
                if (kt + NWAVES < nkt) { const bf16* kp = IKN + (mb + s0 + 32 * NWAVES + r32) * 64 + 8 * hf;
#pragma unroll
                    for (int k = 0; k < 4; ++k) bn[k] = *(const GAS bf16x8*)(kp + 16 * k); }
#pragma unroll
                for (int a = 0; a < 2; ++a) {
                    f32x16 acc = {0.f, 0.f, 0.f, 0.f, 0.f, 0.f, 0.f, 0.f, 0.f, 0.f, 0.f, 0.f, 0.f, 0.f, 0.f, 0.f};
#pragma unroll
                    for (int k = 0; k < 4; ++k) acc = __builtin_amdgcn_mfma_f32_32x32x16_bf16(af[a][k], bk[k], acc, 0, 0, 0);
#pragma unroll
                    for (int qh = 0; qh < 2; ++qh) { float sa = 0.f, sb = 0.f;
#pragma unroll
                        for (int h8 = 0; h8 < 8; h8 += 2) { sa = fmaf(wq[a][qh][h8], relu_i(acc[8 * qh + h8]), sa); sb = fmaf(wq[a][qh][h8 + 1], relu_i(acc[8 * qh + h8 + 1]), sb); }
                        float s = sa + sb;
                        const int q = 4 * a + 2 * qh + hf, key = s0 + r32; const bool valid = key <= t0 + q; s += 0.0f;
                        ISC[q * 4096 + key] = valid ? s : -INFINITY;
                        const float sv = valid ? s : 0.f; s1[a][qh] += sv; s2[a][qh] += sv * sv; }
                }
#pragma unroll
                for (int k = 0; k < 4; ++k) bk[k] = bn[k];
            }
#pragma unroll
            for (int a = 0; a < 2; ++a)
#pragma unroll
                for (int qh = 0; qh < 2; ++qh) { float x1 = s1[a][qh], x2 = s2[a][qh];
#pragma unroll
                    for (int o = 1; o < 32; o <<= 1) { x1 += __shfl_xor(x1, o); x2 += __shfl_xor(x2, o); }
                    if (r32 == 0) { const int q = 4 * a + 2 * qh + hf; STAT[(C.wave * 8 + q) * 2] = x1; STAT[(C.wave * 8 + q) * 2 + 1] = x2; } }
        }
        __syncthreads();
        {
            const int q = C.wave, t = t0 + q, n = t + 1; LAS float* row = ISC + q * 4096;
            unsigned* mrow = MASK + (mb + t) * 128;
            if (n <= TOPK) {
#pragma unroll
                for (int w2 = 0; w2 < 2; ++w2) { const int wi = lane + 64 * w2; const int lo = 32 * wi; unsigned bits;
                    if (lo + 31 <= t) bits = 0xffffffffu; else if (lo > t) bits = 0u; else bits = (1u << (t - lo + 1)) - 1u;
                    mrow[wi] = bits; }
            } else {
                float S1 = 0.f, S2 = 0.f;
#pragma unroll
                for (int w8 = 0; w8 < 8; ++w8) { S1 += STAT[(w8 * 8 + q) * 2]; S2 += STAT[(w8 * 8 + q) * 2 + 1]; }
                const float mu = S1 / (float)n; const float var = fmaxf(S2 / (float)n - mu * mu, 0.f);
                float scale = 48.f / sqrtf(var); if (!(scale < 1e30f)) scale = 0.f;
#pragma unroll
                for (int z = 0; z < 4; ++z) HIST[lane + 64 * z] = 0u;
#pragma unroll 2
                for (int e0 = 4 * lane; e0 < n; e0 += 256) { const f32x4 v = *(const LAS f32x4*)(row + e0);
#pragma unroll
                    for (int jj = 0; jj < 4; ++jj) if (e0 + jj < n) atomicAdd((unsigned*)&HIST[isc_bucket(v[jj], mu, scale)], 1u); }
                LDS_WAIT();
                int B, need;
                {
                    const v4u c4 = *(const LAS v4u*)(HIST + 4 * lane);
                    const unsigned c0 = c4.x, c1 = c4.y, c2 = c4.z, c3 = c4.w; const unsigned s4 = c0 + c1 + c2 + c3;
                    unsigned suf = s4;
#pragma unroll
                    for (int o = 1; o < 64; o <<= 1) { const unsigned v = __shfl_down(suf, o); if (lane + o < 64) suf += v; }
                    unsigned cum = suf - s4; int dsel = -1; int nnew = 0; const unsigned nd = (unsigned)TOPK;
                    if (cum < nd && nd <= cum + c3) { dsel = 4 * lane + 3; nnew = (int)(nd - cum); } cum += c3;
                    if (dsel < 0 && cum < nd && nd <= cum + c2) { dsel = 4 * lane + 2; nnew = (int)(nd - cum); } cum += c2;
                    if (dsel < 0 && cum < nd && nd <= cum + c1) { dsel = 4 * lane + 1; nnew = (int)(nd - cum); } cum += c1;
                    if (dsel < 0 && cum < nd && nd <= cum + c0) { dsel = 4 * lane + 0; nnew = (int)(nd - cum); }
                    const unsigned long long bal = __ballot(dsel >= 0);
                    const int src = (bal != 0ull) ? (int)__builtin_ctzll(bal) : 0;
                    B = __shfl(dsel, src); need = __shfl(nnew, src);
                    const unsigned cb = (B & 3) == 3 ? c3 : (B & 3) == 2 ? c2 : (B & 3) == 1 ? c1 : c0;
                    const int mcand = (int)__shfl((int)cb, src);
                    if (mcand <= CAND_CAP) {
                        LDS_WAIT();
                        int base = 0;
                        for (int e0 = 4 * lane; e0 - 4 * lane < n; e0 += 256) { f32x4 v = {0.f, 0.f, 0.f, 0.f}; if (e0 < n) v = *(const LAS f32x4*)(row + e0);
#pragma unroll
                            for (int jj = 0; jj < 4; ++jj) { const bool cnd = (e0 + jj < n) && isc_bucket(v[jj], mu, scale) == B; const unsigned long long bc = __ballot(cnd);
                                if (cnd) { const int pos = base + __builtin_popcountll(bc & ((1ull << lane) - 1ull)); HIST[2 * pos] = f2ord(v[jj]); HIST[2 * pos + 1] = (unsigned)(e0 + jj); }
                                base += __builtin_popcountll(bc); } }
                        LDS_WAIT();
                        const bool a0 = lane < mcand, a1 = lane + 64 < mcand;
                        const unsigned u0 = a0 ? HIST[2 * lane] : 0u, i0 = a0 ? HIST[2 * lane + 1] : 0u, u1 = a1 ? HIST[2 * lane + 128] : 0u, i1 = a1 ? HIST[2 * lane + 129] : 0u;
                        const unsigned long long k0 = ((unsigned long long)u0 << 32) | (unsigned)(~i0), k1 = ((unsigned long long)u1 << 32) | (unsigned)(~i1);
                        int rk0 = 0, rk1 = 0;
                        const int m0 = mcand < 64 ? mcand : 64;
                        for (int k = 0; k < m0; ++k) { const unsigned long long kk = ((unsigned long long)(unsigned)__builtin_amdgcn_readlane((int)u0, k) << 32) | (unsigned)(~(unsigned)__builtin_amdgcn_readlane((int)i0, k));
                            rk0 += (kk > k0) ? 1 : 0; rk1 += (kk > k1) ? 1 : 0; }
                        for (int k = 64; k < mcand; ++k) { const unsigned long long kk = ((unsigned long long)(unsigned)__builtin_amdgcn_readlane((int)u1, k - 64) << 32) | (unsigned)(~(unsigned)__builtin_amdgcn_readlane((int)i1, k - 64));
                            rk0 += (kk > k0) ? 1 : 0; rk1 += (kk > k1) ? 1 : 0; }
                        if (a0) row[i0] = (rk0 < need) ? INFINITY : -INFINITY;
                        if (a1) row[i1] = (rk1 < need) ? INFINITY : -INFINITY;
                        LDS_WAIT();
                        unsigned long long mine = 0ull; const int nit = (t >> 6) + 1;
#pragma unroll 4
                        for (int it = 0; it < nit; ++it) { const int e = it * 64 + lane; const float x = row[e];
                            const bool sel = (e <= t) && (x == INFINITY || isc_bucket(x, mu, scale) > B);
                            const unsigned long long bs = __ballot(sel); if (lane == it) mine = bs; }
                        *(GAS v2u*)(mrow + 2 * lane) = (v2u){(unsigned)mine, (unsigned)(mine >> 32)};
                    } else {
                        unsigned prefix = 0u; int need2 = TOPK;
                        for (int pass = 3; pass >= 0; --pass) {
                            const int shift = 8 * pass;
                            LDS_WAIT();
#pragma unroll
                            for (int z = 0; z < 4; ++z) HIST[lane + 64 * z] = 0u;
                            const unsigned hmask = (pass == 3) ? 0u : (0xffffffffu << (shift + 8)); const unsigned hpre = prefix & hmask;
                            for (int e0 = 4 * lane; e0 < n; e0 += 256) { const f32x4 v = *(const LAS f32x4*)(row + e0);
#pragma unroll
                                for (int jj = 0; jj < 4; ++jj) { const unsigned uu = f2ord(v[jj]);
                                    if ((e0 + jj < n) && ((uu & hmask) == hpre)) atomicAdd((unsigned*)&HIST[(uu >> shift) & 255u], 1u); } }
                            LDS_WAIT();
                            const v4u d4 = *(const LAS v4u*)(HIST + 4 * lane);
                            const unsigned e0c = d4.x, e1c = d4.y, e2c = d4.z, e3c = d4.w; const unsigned t4 = e0c + e1c + e2c + e3c;
                            unsigned sf = t4;
#pragma unroll
                            for (int o = 1; o < 64; o <<= 1) { const unsigned v = __shfl_down(sf, o); if (lane + o < 64) sf += v; }
                            unsigned cm = sf - t4; int ds = -1; int nn = 0;
                            if (cm < (unsigned)need2 && (unsigned)need2 <= cm + e3c) { ds = 4 * lane + 3; nn = need2 - (int)cm; } cm += e3c;
                            if (ds < 0 && cm < (unsigned)need2 && (unsigned)need2 <= cm + e2c) { ds = 4 * lane + 2; nn = need2 - (int)cm; } cm += e2c;
                            if (ds < 0 && cm < (unsigned)need2 && (unsigned)need2 <= cm + e1c) { ds = 4 * lane + 1; nn = need2 - (int)cm; } cm += e1c;
                            if (ds < 0 && cm < (unsigned)need2 && (unsigned)need2 <= cm + e0c) { ds = 4 * lane + 0; nn = need2 - (int)cm; }
                            const unsigned long long bl2 = __ballot(ds >= 0);
                            const int sr = (bl2 != 0ull) ? (int)__builtin_ctzll(bl2) : 0;
                            const int dd = __shfl(ds, sr); need2 = __shfl(nn, sr);
                            prefix |= ((unsigned)dd & 255u) << shift;
                        }
                        int run_eq = 0; unsigned long long mine = 0ull;
                        for (int it = 0; it < 64; ++it) { const int e = it * 64 + lane; const unsigned uu = f2ord(row[e]); const bool valid = e <= t;
                            const bool eq = valid && (uu == prefix); const unsigned long long beq = __ballot(eq);
                            const int rk = run_eq + __builtin_popcountll(beq & ((1ull << lane) - 1ull));
                            const bool sel = valid && ((uu > prefix) || (eq && rk < need2)); run_eq += __builtin_popcountll(beq);
                            const unsigned long long bs = __ballot(sel);
                            if (lane == it) mine = bs; }
                        *(GAS v2u*)(mrow + 2 * lane) = (v2u){(unsigned)mine, (unsigned)(mine >> 32)};
                    }
                }
            }
        }
        __syncthreads();
    }
}

__device__ __forceinline__ void attn_task(const bf16* H, const bf16* KH, const bf16* VT, const unsigned* MASK, bf16* YM, int b, int hh, int t0, int lane) {
    const int r32 = lane & 31, hf = lane >> 5;
    const float LOG2E = 1.4426950408889634f; const float c1 = 0.125f * LOG2E; const float sl2 = exp2f(-(float)(hh + 1)) * LOG2E;
    const size_t mb = (size_t)b * T;
    bf16x8 qf[4];
#pragma unroll
    for (int k = 0; k < 4; ++k) qf[k] = *(const GAS bf16x8*)(H + (mb + t0 + r32) * D_INP + C_AQ + hh * 64 + 16 * k + 8 * hf);
    const bf16* kbase = KH + ((size_t)(b * 8 + hh) * T) * 64; const bf16* vbase = VT + ((size_t)(b * 512 + hh * 64)) * T; const unsigned* mrow = MASK + (mb + t0 + r32) * 128;
    float m_run = -1e30f, l = 0.f;
    f32x16 O0 = {0.f, 0.f, 0.f, 0.f, 0.f, 0.f, 0.f, 0.f, 0.f, 0.f, 0.f, 0.f, 0.f, 0.f, 0.f, 0.f}, O1 = O0;
    const int nkt = (t0 + 32 + 63) >> 6;
    for (int kt = 0; kt < nkt; ++kt) {
        const int s0 = kt * 64;
        bf16x8 kf[2][4];
#pragma unroll
        for (int uu = 0; uu < 2; ++uu)
#pragma unroll
            for (int k = 0; k < 4; ++k) kf[uu][k] = *(const GAS bf16x8*)(kbase + (size_t)(s0 + 32 * uu + r32) * 64 + 16 * k + 8 * hf);
        const v2u mw = *(const GAS v2u*)(mrow + 2 * kt);
        s16x4 vl[2][2][2], vh[2][2][2];
#pragma unroll
        for (int uu = 0; uu < 2; ++uu)
#pragma unroll
            for (int sp = 0; sp < 2; ++sp)
#pragma unroll
                for (int dt = 0; dt < 2; ++dt) { const bf16* vp = vbase + (size_t)(dt * 32 + r32) * T + s0 + 32 * uu + 16 * sp + 4 * hf;
                    vl[uu][sp][dt] = *(const GAS s16x4*)vp; vh[uu][sp][dt] = *(const GAS s16x4*)(vp + 8); }
        f32x16 a0 = {0.f, 0.f, 0.f, 0.f, 0.f, 0.f, 0.f, 0.f, 0.f, 0.f, 0.f, 0.f, 0.f, 0.f, 0.f, 0.f}, a1 = a0;
#pragma unroll
        for (int k = 0; k < 4; ++k) { a0 = __builtin_amdgcn_mfma_f32_32x32x16_bf16(kf[0][k], qf[k], a0, 0, 0, 0); a1 = __builtin_amdgcn_mfma_f32_32x32x16_bf16(kf[1][k], qf[k], a1, 0, 0, 0); }
        const float dist0 = (float)(t0 + r32 - s0 - 4 * hf);
        const unsigned m0 = mw.x >> (4 * hf), m1 = mw.y >> (4 * hf);
        float mx = -1e30f;
#pragma unroll
        for (int r = 0; r < 16; ++r) { const int ko = (r & 3) + 8 * (r >> 2);
            const float d0 = dist0 - (float)ko;
            a0[r] = ((m0 >> ko) & 1u) ? (a0[r] * c1 - sl2 * d0) : -1e30f;
            a1[r] = ((m1 >> ko) & 1u) ? (a1[r] * c1 - sl2 * (d0 - 32.f)) : -1e30f;
            mx = fmaxf(mx, fmaxf(a0[r], a1[r])); }
        mx = fmaxf(mx, __shfl_xor(mx, 32));
        const float m_new = fmaxf(m_run, mx); const float alpha = __builtin_amdgcn_exp2f(m_run - m_new); m_run = m_new;
        float ps = 0.f;
#pragma unroll
        for (int r = 0; r < 16; ++r) { const int ko = (r & 3) + 8 * (r >> 2);
            const float p0 = ((m0 >> ko) & 1u) ? __builtin_amdgcn_exp2f(a0[r] - m_new) : 0.f;
            const float p1 = ((m1 >> ko) & 1u) ? __builtin_amdgcn_exp2f(a1[r] - m_new) : 0.f;
            a0[r] = p0; a1[r] = p1; ps += p0 + p1; }
        l = l * alpha + ps;
#pragma unroll
        for (int r = 0; r < 16; ++r) { O0[r] *= alpha; O1[r] *= alpha; }
#pragma unroll
        for (int sp = 0; sp < 2; ++sp) {
            const bf16x8 pb0 = pack8(a0, 8 * sp), pb1 = pack8(a1, 8 * sp);
#define VFR(uu, dt) ((bf16x8){vl[uu][sp][dt][0], vl[uu][sp][dt][1], vl[uu][sp][dt][2], vl[uu][sp][dt][3], vh[uu][sp][dt][0], vh[uu][sp][dt][1], vh[uu][sp][dt][2], vh[uu][sp][dt][3]})
            O0 = __builtin_amdgcn_mfma_f32_32x32x16_bf16(VFR(0, 0), pb0, O0, 0, 0, 0);
            O1 = __builtin_amdgcn_mfma_f32_32x32x16_bf16(VFR(0, 1), pb0, O1, 0, 0, 0);
            O0 = __builtin_amdgcn_mfma_f32_32x32x16_bf16(VFR(1, 0), pb1, O0, 0, 0, 0);
            O1 = __builtin_amdgcn_mfma_f32_32x32x16_bf16(VFR(1, 1), pb1, O1, 0, 0, 0);
#undef VFR
        }
    }
    l += __shfl_xor(l, 32);
    const float inv = 1.f / l;
    bf16* yp = YM + (mb + t0 + r32) * D + hh * 64 + 4 * hf;
#pragma unroll
    for (int rq = 0; rq < 4; ++rq) {
        v2u o; o.x = cvtpk(O0[4 * rq] * inv, O0[4 * rq + 1] * inv); o.y = cvtpk(O0[4 * rq + 2] * inv, O0[4 * rq + 3] * inv); *(GAS v2u*)(yp + 8 * rq) = o;
        v2u o2; o2.x = cvtpk(O1[4 * rq] * inv, O1[4 * rq + 1] * inv); o2.y = cvtpk(O1[4 * rq + 2] * inv, O1[4 * rq + 3] * inv); *(GAS v2u*)(yp + 32 + 8 * rq) = o2; }
}
__device__ __forceinline__ void p4_attention(const Params& P, const Ctx& C) {
    unsigned char* ws = P.ws;
    const bf16* H = (const bf16*)(ws + WS_H); const bf16* KH = (const bf16*)(ws + WS_K); const bf16* VT = (const bf16*)(ws + WS_VT); const unsigned* MASK = (const unsigned*)(ws + WS_MASK); bf16* YM = (bf16*)(ws + WS_YMIX);
    for (int p = blockIdx.x; p < 512; p += C.G) {
        const int bh = p >> 3, j = p & 7; const int b = bh >> 3, hh = bh & 7;
        attn_task(H, KH, VT, MASK, YM, b, hh, j * 256 + C.wave * 32, C.lane);
        attn_task(H, KH, VT, MASK, YM, b, hh, (15 - j) * 256 + (7 - C.wave) * 32, C.lane);
    }
}

constexpr int AT_KB = 64 * 144, AT_VB = 64 * 136, AT_VOFF = 2 * AT_KB;
__device__ __forceinline__ void attn_block(const Ctx& C, const bf16* H, const bf16* KH, const bf16* VT, const unsigned* MASK, bf16* YM, int b, int hh, int qb) {
    const int lane = C.lane, r32 = lane & 31, hf = lane >> 5, tid = C.tid;
    const float LOG2E = 1.4426950408889634f; const float c1 = 0.125f * LOG2E; const float sl2 = exp2f(-(float)(hh + 1)) * LOG2E;
    const size_t mb = (size_t)b * T; const int t0 = qb * 256 + C.wave * 32;
    bf16x8 qf[4];
#pragma unroll
    for (int k = 0; k < 4; ++k) { const v4u w = *(const GAS v4u*)(H + (mb + t0 + r32) * D_INP + C_AQ + hh * 64 + 16 * k + 8 * hf);
        v4u o; o.x = cvtpk(bflo(w.x) * c1, bfhi(w.x) * c1); o.y = cvtpk(bflo(w.y) * c1, bfhi(w.y) * c1); o.z = cvtpk(bflo(w.z) * c1, bfhi(w.z) * c1); o.w = cvtpk(bflo(w.w) * c1, bfhi(w.w) * c1);
        qf[k] = __builtin_bit_cast(bf16x8, o); }
    const bf16* kbase = KH + ((size_t)(b * 8 + hh) * T) * 64; const bf16* vbase = VT + ((size_t)(b * 512 + hh * 64)) * T; const unsigned* mrow = MASK + (mb + t0 + r32) * 128;
    const int srow = tid >> 3, sch = tid & 7;
    const bf16* kst = kbase + (size_t)srow * 64 + 8 * sch; const bf16* vst = vbase + (size_t)srow * T + 8 * sch;
    LAS unsigned char* kw = C.lds + srow * 144 + 16 * sch; LAS unsigned char* vw = C.lds + AT_VOFF + srow * 136 + 16 * sch;
    const LAS unsigned char* kr = C.lds + r32 * 144 + 16 * hf; const LAS unsigned char* vr = C.lds + AT_VOFF + r32 * 136 + 8 * hf;
    float m_run = -1e30f, l = 0.f;
    f32x16 O0 = {0.f, 0.f, 0.f, 0.f, 0.f, 0.f, 0.f, 0.f, 0.f, 0.f, 0.f, 0.f, 0.f, 0.f, 0.f, 0.f}, O1 = O0;
    const int nkt = 4 * (qb + 1), ktw = (t0 + 31) >> 6;
    v4u kn = *(const GAS v4u*)kst, vn = *(const GAS v4u*)vst; v2u mwn = *(const GAS v2u*)mrow;
    *(LAS v4u*)kw = kn; *(LAS v2u*)vw = (v2u){vn.x, vn.y}; *(LAS v2u*)(vw + 8) = (v2u){vn.z, vn.w};
    __syncthreads();
    for (int kt = 0; kt < nkt; ++kt) {
        const int s0 = kt * 64; const int cur = kt & 1; const v2u mw = mwn;
        if (kt + 1 < nkt) { kn = *(const GAS v4u*)(kst + (size_t)(s0 + 64) * 64); vn = *(const GAS v4u*)(vst + s0 + 64); mwn = *(const GAS v2u*)(mrow + 2 * kt + 2); }
        if (kt <= ktw) {
            const LAS unsigned char* kc = kr + cur * AT_KB; const LAS unsigned char* vc = vr + cur * AT_VB;
            const float B0 = -sl2 * (float)(t0 + r32 - s0 - 4 * hf);
            f32x16 a0, a1;
#pragma unroll
            for (int r = 0; r < 16; ++r) { const float ko = (float)((r & 3) + 8 * (r >> 2)); a0[r] = B0 + sl2 * ko; a1[r] = B0 + sl2 * (ko + 32.f); }
#pragma unroll
            for (int k = 0; k < 4; ++k) { const bf16x8 k0 = *(const LAS bf16x8*)(kc + 32 * k), k1 = *(const LAS bf16x8*)(kc + 32 * 144 + 32 * k);
                a0 = __builtin_amdgcn_mfma_f32_32x32x16_bf16(k0, qf[k], a0, 0, 0, 0); a1 = __builtin_amdgcn_mfma_f32_32x32x16_bf16(k1, qf[k], a1, 0, 0, 0); }
            const unsigned m0 = mw.x >> (4 * hf), m1 = mw.y >> (4 * hf);
            float mx = -1e30f;
#pragma unroll
            for (int r = 0; r < 16; ++r) { const int ko = (r & 3) + 8 * (r >> 2);
                a0[r] = (m0 & (1u << ko)) ? a0[r] : -1e30f; a1[r] = (m1 & (1u << ko)) ? a1[r] : -1e30f;
                mx = fmaxf(mx, fmaxf(a0[r], a1[r])); }
            mx = fmaxf(mx, __shfl_xor(mx, 32));
            const float m_new = fmaxf(m_run, mx); const float alpha = __builtin_amdgcn_exp2f(m_run - m_new); m_run = m_new;
            float ps = 0.f;
#pragma unroll
            for (int r = 0; r < 16; ++r) { const int ko = (r & 3) + 8 * (r >> 2);
                const float p0 = (m0 & (1u << ko)) ? __builtin_amdgcn_exp2f(a0[r] - m_new) : 0.f;
                const float p1 = (m1 & (1u << ko)) ? __builtin_amdgcn_exp2f(a1[r] - m_new) : 0.f;
                a0[r] = p0; a1[r] = p1; ps += p0 + p1; }
            l = l * alpha + ps;
#pragma unroll
            for (int r = 0; r < 16; ++r) { O0[r] *= alpha; O1[r] *= alpha; }
#pragma unroll
            for (int sp = 0; sp < 2; ++sp) {
                const bf16x8 pb0 = pack8(a0, 8 * sp), pb1 = pack8(a1, 8 * sp);
#define VLD(uu, dt) ({ const s16x4 lo_ = *(const LAS s16x4*)(vc + (dt) * 32 * 136 + 2 * (32 * (uu) + 16 * sp)), hi_ = *(const LAS s16x4*)(vc + (dt) * 32 * 136 + 2 * (32 * (uu) + 16 * sp + 8)); (bf16x8){lo_[0], lo_[1], lo_[2], lo_[3], hi_[0], hi_[1], hi_[2], hi_[3]}; })
                O0 = __builtin_amdgcn_mfma_f32_32x32x16_bf16(VLD(0, 0), pb0, O0, 0, 0, 0);
                O1 = __builtin_amdgcn_mfma_f32_32x32x16_bf16(VLD(0, 1), pb0, O1, 0, 0, 0);
                O0 = __builtin_amdgcn_mfma_f32_32x32x16_bf16(VLD(1, 0), pb1, O0, 0, 0, 0);
                O1 = __builtin_amdgcn_mfma_f32_32x32x16_bf16(VLD(1, 1), pb1, O1, 0, 0, 0);
#undef VLD
            }
        }
        if (kt + 1 < nkt) { const int nx = cur ^ 1; *(LAS v4u*)(kw + nx * AT_KB) = kn; *(LAS v2u*)(vw + nx * AT_VB) = (v2u){vn.x, vn.y}; *(LAS v2u*)(vw + nx * AT_VB + 8) = (v2u){vn.z, vn.w}; }
        __syncthreads();
    }
    l += __shfl_xor(l, 32);
    const float inv = 1.f / l;
    bf16* yp = YM + (mb + t0 + r32) * D + hh * 64 + 4 * hf;
#pragma unroll
    for (int rq = 0; rq < 4; ++rq) {
        v2u o; o.x = cvtpk(O0[4 * rq] * inv, O0[4 * rq + 1] * inv); o.y = cvtpk(O0[4 * rq + 2] * inv, O0[4 * rq + 3] * inv); *(GAS v2u*)(yp + 8 * rq) = o;
        v2u o2; o2.x = cvtpk(O1[4 * rq] * inv, O1[4 * rq + 1] * inv); o2.y = cvtpk(O1[4 * rq + 2] * inv, O1[4 * rq + 3] * inv); *(GAS v2u*)(yp + 32 + 8 * rq) = o2; }
}
__device__ __forceinline__ void p4_attention2(const Params& P, const Ctx& C) {
    unsigned char* ws = P.ws;
    const bf16* H = (const bf16*)(ws + WS_H); const bf16* KH = (const bf16*)(ws + WS_K); const bf16* VT = (const bf16*)(ws + WS_VT); const unsigned* MASK = (const unsigned*)(ws + WS_MASK); bf16* YM = (bf16*)(ws + WS_YMIX);
    for (int p = blockIdx.x; p < 512; p += C.G) {
        const int b = p & 7, q = p >> 3; const int hh = q >> 3, j = q & 7;
        attn_block(C, H, KH, VT, MASK, YM, b, hh, j);
        attn_block(C, H, KH, VT, MASK, YM, b, hh, 15 - j);
    }
}

#ifndef FEAT_MIX
#define FEAT_MIX 1
#endif
#ifndef FEAT_MOE
#define FEAT_MOE 1
#endif
#ifndef FEAT_PLE
#define FEAT_PLE 1
#endif
#ifndef FEAT_ATT
#define FEAT_ATT 1
#endif

__device__ __forceinline__ void p6_ln1_router(const Params& P, const Ctx& C) {
    unsigned char* ws = P.ws;
    float* X1 = (float*)(ws + WS_X1); bf16* XB = (bf16*)(ws + WS_XB);
    LAS float* wl = (LAS float*)C.lds;
    LAS int* hist = (LAS int*)(C.lds + MISC_OFF);
#if FEAT_MOE
    { const float* wr = P.in[I_WR];
      for (int i = C.tid; i < 32 * 1024; i += NTHR) { const int e = i >> 10, k = i & 1023; wl[i] = wr[k * 32 + e]; }
      if (C.tid < 32) hist[C.tid] = 0; }
    __syncthreads();
    int* tope = (int*)(ws + WS_TOPE); float* gate = (float*)(ws + WS_GATE); int* lrank = (int*)(ws + WS_LRANK);
    const float* br = P.in[I_BR];
#endif
#if FEAT_MIX
    const float* src = P.out; const float sc = 1.0f;
#else
    const float* src = P.in[I_X]; const float sc = ALPHA;
#endif
    for (int m = C.gw; m < NTOK; m += C.ngw) {
        f32x4 v[4]; load_row_f32(v, src + (size_t)m * D, C.lane);
#pragma unroll
        for (int j = 0; j < 4; ++j) v[j] = v[j] * sc;
        ln_row(v, P.in[I_LNMG], P.in[I_LNMB], C.lane);
        store_row_f32(X1 + (size_t)m * D, v, C.lane);
        store_row_bf16(XB + (size_t)m * D, v, C.lane);
#if FEAT_MOE
        float lv[32];
#pragma unroll
        for (int e = 0; e < 32; ++e) { float a = 0.f;
#pragma unroll
            for (int j = 0; j < 4; ++j) { const f32x4 w = *(const LAS f32x4*)(wl + e * 1024 + 4 * C.lane + 256 * j); a += (v[j][0] * w[0] + v[j][1] * w[1]) + (v[j][2] * w[2] + v[j][3] * w[3]); }
            lv[e] = wave_sum(a) + br[e]; }
        int se[4]; float sv[4];
#pragma unroll
        for (int k = 0; k < 4; ++k) { float best = -INFINITY; int bi = 0;
#pragma unroll
            for (int e = 0; e < 32; ++e) if (lv[e] > best) { best = lv[e]; bi = e; }
            se[k] = bi; sv[k] = best;
#pragma unroll
            for (int e = 0; e < 32; ++e) lv[e] = (e == bi) ? -INFINITY : lv[e]; }
        float ex[4], sum = 0.f;
#pragma unroll
        for (int k = 0; k < 4; ++k) { ex[k] = __expf(sv[k] - sv[0]); sum += ex[k]; }
        const float inv = 1.f / sum;
        if (C.lane == 0) {
#pragma unroll
            for (int k = 0; k < 4; ++k) { const int lr = atomicAdd((int*)&hist[se[k]], 1); tope[m * 4 + k] = se[k]; gate[m * 4 + k] = ex[k] * inv; lrank[m * 4 + k] = lr; } }
#endif
    }
#if FEAT_MOE
    __syncthreads();
    if (C.tid < 32) { unsigned* cnt = (unsigned*)(ws + WS_CTL) + CW_CNT; const int base = (int)atomicAdd(cnt + C.tid, (unsigned)hist[C.tid]); ((int*)(ws + WS_WGBASE))[blockIdx.x * 32 + C.tid] = base; }
#endif
}

__device__ __forceinline__ void p7_dispatch(const Params& P, const Ctx& C) {
    unsigned char* ws = P.ws;
    LAS int* ps = (LAS int*)(C.lds + MISC_OFF + 256);
    const unsigned* cnt = (const unsigned*)(ws + WS_CTL) + CW_CNT;
    int* tile_e = (int*)(ws + WS_TILEE);
    if (C.tid == 0) { int run = 0;
        for (int e = 0; e < NE; ++e) { const int c = (int)__hip_atomic_load(cnt + e, __ATOMIC_RELAXED, __HIP_MEMORY_SCOPE_AGENT); ps[e] = run; const int nt = (c + 255) >> 8;
            if (blockIdx.x == 0) for (int t = 0; t < nt; ++t) tile_e[(run >> 8) + t] = e;
            run += nt << 8; }
        if (blockIdx.x == 0) tile_e[MAXTILES] = run >> 8; }
    __syncthreads();
    const int* tope = (const int*)(ws + WS_TOPE); const float* gate = (const float*)(ws + WS_GATE); const int* lrank = (const int*)(ws + WS_LRANK);
    const int* wgb = (const int*)(ws + WS_WGBASE);
    int* tokslot = (int*)(ws + WS_TOKSLOT); float* slotgate = (float*)(ws + WS_SLOTGATE);
    const bf16* XB = (const bf16*)(ws + WS_XB); bf16* xs = (bf16*)(ws + WS_XS);
    for (int m = C.gw; m < NTOK; m += C.ngw) {
        const int wgm = (m % C.ngw) >> 3;
        const v4u r0 = *(const GAS v4u*)(XB + (size_t)m * D + 8 * C.lane), r1 = *(const GAS v4u*)(XB + (size_t)m * D + 512 + 8 * C.lane);
#pragma unroll
        for (int k = 0; k < 4; ++k) { const int e = tope[m * 4 + k]; const int slot = ps[e] + wgb[wgm * 32 + e] + lrank[m * 4 + k];
            bf16* dst = xs + (size_t)slot * D; *(GAS v4u*)(dst + 8 * C.lane) = r0; *(GAS v4u*)(dst + 512 + 8 * C.lane) = r1;
            if (C.lane == 0) { slotgate[slot] = gate[m * 4 + k]; tokslot[m * 4 + k] = slot; } }
    }
}

__device__ __forceinline__ void p10_combine_ln2(const Params& P, const Ctx& C) {
    unsigned char* ws = P.ws;
    float* X1 = (float*)(ws + WS_X1); bf16* XB = (bf16*)(ws + WS_XB);
    const int* tokslot = (const int*)(ws + WS_TOKSLOT); const bf16* ys = (const bf16*)(ws + WS_YSLOT);
    for (int m = C.gw; m < NTOK; m += C.ngw) {
        f32x4 v[4]; load_row_f32(v, X1 + (size_t)m * D, C.lane);
#pragma unroll
        for (int j = 0; j < 4; ++j) v[j] = v[j] * ALPHA;
#if FEAT_MOE
#pragma unroll
        for (int k = 0; k < 4; ++k) { const int slot = tokslot[m * 4 + k]; const bf16* yr = ys + (size_t)slot * D;
#pragma unroll
            for (int j = 0; j < 4; ++j) { const v2u w = *(const GAS v2u*)(yr + 4 * C.lane + 256 * j); v[j][0] += bflo(w.x); v[j][1] += bfhi(w.x); v[j][2] += bflo(w.y); v[j][3] += bfhi(w.y); } }
#endif
        ln_row(v, P.in[I_LNFG], P.in[I_LNFB], C.lane);
        store_row_f32(P.out + (size_t)m * D, v, C.lane);
        store_row_bf16(XB + (size_t)m * D, v, C.lane);
    }
}

__device__ __forceinline__ void p12_final_ln(const Params& P, const Ctx& C) {
#if FEAT_PLE
    const float* src = (const float*)(P.ws + WS_X1); const float sc = 1.0f;
#else
    const float* src = P.out; const float sc = ALPHA;
#endif
    for (int m = C.gw; m < NTOK; m += C.ngw) {
        f32x4 v[4]; load_row_f32(v, src + (size_t)m * D, C.lane);
#pragma unroll
        for (int j = 0; j < 4; ++j) v[j] = v[j] * sc;
        ln_row(v, P.in[I_LNPG], P.in[I_LNPB], C.lane);
        store_row_f32(P.out + (size_t)m * D, v, C.lane);
    }
}
#define XB_TMO      128
#define XB_XCNT(j)  (256  + 64 * (j))
#define XB_XSUB(j)  (1280 + 64 * (j))
#define XB_XGEN(j)  (2304 + 64 * (j))
#define XB_TOP      3328
#define XB_TOPGEN   3392
#define XCD_BAR_WORDS 3456
#define XB_SPIN_CAP (1u << 18)
#define LAS __attribute__((address_space(3)))

__device__ __forceinline__ unsigned xb_ld(unsigned* p)              { return __hip_atomic_load(p, __ATOMIC_RELAXED, __HIP_MEMORY_SCOPE_AGENT); }
__device__ __forceinline__ unsigned xb_add(unsigned* p, unsigned v) { return __hip_atomic_fetch_add(p, v, __ATOMIC_RELAXED, __HIP_MEMORY_SCOPE_AGENT); }
__device__ __forceinline__ unsigned xb_xcc_id() { return (unsigned)__builtin_amdgcn_s_getreg((3 << 11) | 20) & 0xFu; }
#define XB_SPIN(cond, bar) do { unsigned _sp = 0; while (cond) { __builtin_amdgcn_s_sleep(1); \
    if ((++_sp & 255u) == 0u) { if (xb_ld(&(bar)[XB_TMO])) break; if (_sp > XB_SPIN_CAP) { atomicAdd(&(bar)[XB_TMO], 1u); break; } } } } while (0)

struct XcdBarrier {
    unsigned* bar; unsigned x;
    volatile LAS unsigned* st;
};

__device__ __forceinline__ XcdBarrier xcd_barrier_post(unsigned* bar, volatile LAS unsigned* st) {
    XcdBarrier b; b.bar = bar; b.x = xb_xcc_id(); b.st = st;
    if (threadIdx.x == 0) (void)xb_add(&bar[XB_XCNT(b.x)], 1u);
    return b;
}
__device__ __forceinline__ void xcd_barrier_complete(unsigned* bar, unsigned x, unsigned& nloc, unsigned& nx) {
    const unsigned G = gridDim.x * gridDim.y * gridDim.z;
    unsigned sum, cnt, mine, sp = 0u;
    for (;;) {
        sum = 0u; cnt = 0u; mine = 0u;
#pragma unroll
        for (unsigned j = 0; j < 16; ++j) { const unsigned c = xb_ld(&bar[XB_XCNT(j)]); sum += c; cnt += (c > 0u) ? 1u : 0u; mine = (j == x) ? c : mine; }
        if (sum == G) break;
        __builtin_amdgcn_s_sleep(1);
        if ((++sp & 255u) == 0u) { if (xb_ld(&bar[XB_TMO])) break; if (sp > XB_SPIN_CAP) { atomicAdd(&bar[XB_TMO], 1u); break; } }
    }
    nloc = mine > 0u ? mine : 1u; nx = cnt > 0u ? cnt : 1u;
}

__device__ __forceinline__ void xcd_barrier(const XcdBarrier& b) {
    asm volatile("s_waitcnt vmcnt(0)" ::: "memory");
    __syncthreads();
    if (threadIdx.x == 0) {
        unsigned* bar = b.bar;
        __builtin_amdgcn_s_waitcnt(0);
        unsigned nloc = b.st[0], nx = b.st[1];
        if (nloc == 0u) { xcd_barrier_complete(bar, b.x, nloc, nx); b.st[0] = nloc; b.st[1] = nx; }
        const unsigned old = xb_add(&bar[XB_XSUB(b.x)], 1u);
        const unsigned gen = old / nloc;
        if (old + 1u == (gen + 1u) * nloc) {
            __builtin_amdgcn_fence(__ATOMIC_RELEASE, "agent");
            asm volatile("s_waitcnt vmcnt(0)" ::: "memory");
            const unsigned og = xb_add(&bar[XB_TOP], 1u);
            const unsigned tg = og / nx;
            if (og + 1u == (tg + 1u) * nx) xb_add(&bar[XB_TOPGEN], 1u);
            else XB_SPIN(xb_ld(&bar[XB_TOPGEN]) == tg, bar);
            __builtin_amdgcn_fence(__ATOMIC_ACQUIRE, "agent");
            xb_add(&bar[XB_XGEN(b.x)], 1u);
            asm volatile("s_waitcnt vmcnt(0)" ::: "memory");
        } else {
            XB_SPIN(xb_ld(&bar[XB_XGEN(b.x)]) == gen, bar);
            __builtin_amdgcn_fence(__ATOMIC_ACQUIRE, "agent");
            asm volatile("s_waitcnt vmcnt(0)" ::: "memory");
        }
    }
    __syncthreads();
}


template <int PH> __device__ __forceinline__ void run_phase(const Params& P, const Ctx& C) {
    unsigned char* ws = P.ws;
    typedef pg8::bf16_t pbf;
    if constexpr (PH == 0) { p0_prologue(P, C); }
    else if constexpr (PH == 10) {
        pg8::Gemm g{(const pbf*)(ws + WS_XBF), (const pbf*)(ws + WS_WIN_T), NTOK, D_INP, D}; pg8::StaticOrder S; S.init(NTOK, D_INP, C.G, (int)blockIdx.x);
        pg8::EpiBf16s E{(pbf*)(ws + WS_H), D_INP};
        pg8::gemm_phase<pg8::EpiBf16s, pg8::StaticOrder, true, true>(C.lds, g, S, E); }
    else if constexpr (PH == 11) {
        pg8::Gemm g{(const pbf*)(ws + WS_PB), (const pbf*)(ws + WS_WPROJ_T), NTOK, D, PLE}; pg8::StaticOrder S; S.init(NTOK, D, C.G, (int)blockIdx.x);
        pg8::EpiBf16s E{(pbf*)(ws + WS_PROJ), D};
        pg8::gemm_phase<pg8::EpiBf16s, pg8::StaticOrder, true, true>(C.lds, g, S, E); }
    else if constexpr (PH == 20) { p2_post(P, C); }
    else if constexpr (PH == 21) { p2_hgrn_prep(P, C); }
    else if constexpr (PH == 30) {
        { pg8::Gemm g{(const pbf*)(ws + WS_CN), (const pbf*)(ws + WS_WUK_T), NTOK, 512, 256}; pg8::StaticOrder S; S.init(NTOK, 512, C.G, (int)blockIdx.x);
          pg8::EpiKhead E{(pbf*)(ws + WS_K)};
          pg8::gemm_phase<pg8::EpiKhead, pg8::StaticOrder, true, true>(C.lds, g, S, E); }
        { pg8::Gemm g{(const pbf*)(ws + WS_WUV_T), (const pbf*)(ws + WS_CN), 512, NTOK, 256}; pg8::StaticOrder S; S.init(512, NTOK, C.G, (int)blockIdx.x);
          pg8::EpiVt E{(pbf*)(ws + WS_VT)};
          pg8::gemm_phase<pg8::EpiVt, pg8::StaticOrder, true, true>(C.lds, g, S, E); }
    }
    else if constexpr (PH == 31) { p3_indexer(P, C); }
    else if constexpr (PH == 32) { p3_hgrn_scan(P, C); }
    else if constexpr (PH == 40) { p4_attention2(P, C); }
    else if constexpr (PH == 41) { p4_yrec(P, C); }
    else if constexpr (PH == 5) {
        pg8::Gemm g{(const pbf*)(ws + WS_YMIX), (const pbf*)(ws + WS_WO_T), NTOK, D, D}; pg8::StaticOrder S; S.init(NTOK, D, C.G, (int)blockIdx.x);
        pg8::EpiResid E{P.in[I_X], P.out, D, ALPHA};
        pg8::gemm_phase<pg8::EpiResid, pg8::StaticOrder, true, true>(C.lds, g, S, E);
    }
    else if constexpr (PH == 6) { p6_ln1_router(P, C); }
    else if constexpr (PH == 7) { p7_dispatch(P, C); }
    else if constexpr (PH == 8) {
        const int* tile_e = (const int*)(ws + WS_TILEE);
        pg8::Gemm g{(const pbf*)(ws + WS_XS), (const pbf*)(ws + WS_WUP_T), CAP, NE * 2048, D};
        pg8::MoeOrder S{tile_e, tile_e[MAXTILES], 8, C.G, (int)blockIdx.x};
        pg8::EpiSwiglu E{(pbf*)(ws + WS_HH), P.in[I_BUP]};
        pg8::gemm_phase<pg8::EpiSwiglu, pg8::MoeOrder, true, true>(C.lds, g, S, E);
    }
    else if constexpr (PH == 9) {
        const int* tile_e = (const int*)(ws + WS_TILEE);
        pg8::Gemm g{(const pbf*)(ws + WS_HH), (const pbf*)(ws + WS_WDN_T), CAP, NE * 1024, DFF};
        pg8::MoeOrder S{tile_e, tile_e[MAXTILES], 4, C.G, (int)blockIdx.x};
        pg8::EpiDown E{(pbf*)(ws + WS_YSLOT), P.in[I_BDN], (const float*)(ws + WS_SLOTGATE)};
        pg8::gemm_phase<pg8::EpiDown, pg8::MoeOrder, true, true>(C.lds, g, S, E);
    }
    else if constexpr (PH == 100) { p10_combine_ln2(P, C); }
    else if constexpr (PH == 110) {
        pg8::Gemm g{(const pbf*)(ws + WS_XB), (const pbf*)(ws + WS_WGATE_T), NTOK, D, D}; pg8::StaticOrder S; S.init(NTOK, D, C.G, (int)blockIdx.x);
        pg8::EpiPle E{P.out, (const pbf*)(ws + WS_PROJ), (float*)(ws + WS_X1), ALPHA};
        pg8::gemm_phase<pg8::EpiPle, pg8::StaticOrder, true, true>(C.lds, g, S, E);
    }
    else { p12_final_ln(P, C); }
}
__global__ void __launch_bounds__(NTHR, 2) mega_fwd(Params P) {
    extern __shared__ __attribute__((aligned(16))) unsigned char lds_raw[];
    cg::grid_group grid = cg::this_grid();
    Ctx C;
    C.lds = (LAS unsigned char*)lds_raw;
    C.tid = threadIdx.x; C.lane = C.tid & 63; C.wave = __builtin_amdgcn_readfirstlane(C.tid >> 6);
    C.G = gridDim.x; C.gw = blockIdx.x * NWAVES + C.wave; C.ngw = C.G * NWAVES;
#if SYNC_MODE != 0
    if (C.tid < 4) ((LAS unsigned*)(C.lds + XBW_OFF))[C.tid] = 0u;
    __syncthreads();
    XcdBarrier bar = xcd_barrier_post((unsigned*)(P.ws + WS_CTL) + CW_BAR, (volatile LAS unsigned*)(C.lds + XBW_OFF));
#define SY xcd_barrier(bar);
#else
#define SY grid.sync();
#endif
#define GS grid.sync();
#define BS __syncthreads();
#define X(k) run_phase<k>(P, C);
    PROGRAM
#undef X
#undef SY
#undef GS
#undef BS
}

extern "C" void kernel_launch(void* const* d_in, const int* in_sizes, int n_in, void* d_out, int out_size, void* d_ws, size_t ws_size, hipStream_t stream) {
    static int grid = 0;
    if (grid == 0) {
        if (n_in != 25 || out_size != NTOK * D || ws_size < WS_END) { fprintf(stderr, "kernel_launch: unexpected shapes (n_in %d out %d ws %zu)\n", n_in, out_size, ws_size); grid = -1; return; }
        int dev = 0, cus = 0, per_cu = 0;
        if (hipGetDevice(&dev) != hipSuccess || hipDeviceGetAttribute(&cus, hipDeviceAttributeMultiprocessorCount, dev) != hipSuccess) { grid = -1; return; }
        if (hipFuncSetAttribute((const void*)mega_fwd, hipFuncAttributeMaxDynamicSharedMemorySize, LDS_BYTES) != hipSuccess) { fprintf(stderr, "kernel_launch: hipFuncSetAttribute failed\n"); grid = -1; return; }
        if (hipOccupancyMaxActiveBlocksPerMultiprocessor(&per_cu, (const void*)mega_fwd, NTHR, LDS_BYTES) != hipSuccess || per_cu < 1) { fprintf(stderr, "kernel_launch: occupancy query failed (%d)\n", per_cu); (void)hipGetLastError(); grid = -1; return; }
        grid = cus * per_cu;
        fprintf(stderr, "kernel_launch: grid %d (%d CUs x %d)\n", grid, cus, per_cu);
    }
    if (grid < 0) return;
    (void)hipMemsetAsync((char*)d_ws + WS_CTL, 0, CTL_ZERO_BYTES, stream);
    Params p{};
    for (int i = 0; i < 25; ++i) p.in[i] = (const float*)d_in[i];
    p.out = (float*)d_out; p.ws = (unsigned char*)d_ws;

    void* args[] = {&p};
    hipError_t e = hipLaunchCooperativeKernel((const void*)mega_fwd, dim3(grid), dim3(NTHR), args, LDS_BYTES, stream);
    if (e != hipSuccess) fprintf(stderr, "kernel_launch: cooperative launch failed: %s (grid %d)\n", hipGetErrorString(e), grid);
}
```

```cpp
#define SYNC_MODE 1
#include <hip/hip_runtime.h>
#include <hip/hip_cooperative_groups.h>
#include <cstdio>
#include <cstdint>
namespace cg = cooperative_groups;

namespace pg8 {
#define PG8_LAS __attribute__((address_space(3)))
typedef unsigned short bf16_t;
typedef short bf16x8 __attribute__((ext_vector_type(8)));
typedef float f32x4 __attribute__((ext_vector_type(4)));
typedef unsigned u32x4 __attribute__((ext_vector_type(4)));
typedef int i32x4 __attribute__((ext_vector_type(4)));
typedef int i32x8 __attribute__((ext_vector_type(8)));
constexpr int BM = 256, BK = 64, HALF = 128, HTB = HALF * BK * 2  , STAGE_BYTES = 8 * HTB, NXCD = 8, WGM = 8;

__host__ __device__ __forceinline__ int lds_byte(int r, int c) { const int st = (r >> 4) * 2 + (c >> 5), rr = r & 15, cc = c & 31, ob = rr * 64 + cc * 2; return st * 1024 + (ob ^ (((ob >> 9) & 1) << 5)); }
__host__ __device__ __forceinline__ void stage_rc(int b, int& R, int& C) { const int st = b / 1024, sb = b % 1024, swz = sb ^ (((sb >> 9) & 1) << 5); R = (st >> 1) * 16 + swz / 64; C = (st & 1) * 32 + (swz % 64) / 2; }
__host__ __device__ __forceinline__ int perm32(int rho) { const int n = rho >> 4, i = rho & 15; return 8 * (i >> 2) + 4 * n + (i & 3); }

struct Unit { int pm, pn; };
struct Gemm { const bf16_t* A; const bf16_t* Bt; int M, N, K; };

struct StaticOrder {
    int nM, nN, nwg, G, c;
    __host__ __device__ void init(int M, int N, int G_, int c_) { nM = M / BM; nN = N / BM; nwg = nM * nN; G = G_; c = c_; }
    __host__ __device__ bool next(int i, Unit& u) const {
        const long L = (long)i * G + c; if (L >= nwg) return false;
        int wgid = (int)L; { const int q = nwg / NXCD, r = nwg % NXCD, xcd = wgid % NXCD, off = wgid / NXCD; wgid = (xcd < r ? xcd * (q + 1) : r * (q + 1) + (xcd - r) * q) + off; }
        const int nig = WGM * nN, gid = wgid / nig, fm = gid * WGM, gsz = (nM - fm) < WGM ? (nM - fm) : WGM;
        u.pm = fm + ((wgid % nig) % gsz); u.pn = (wgid % nig) / gsz; return true;
    }
    __device__ __forceinline__ void a_ready(const Unit&) const {}
    __device__ __forceinline__ void done(const Unit&) const {}
};

__device__ __forceinline__ unsigned cvt_pk_bf16(float lo, float hi) { unsigned r; asm volatile("v_cvt_pk_bf16_f32 %0, %1, %2" : "=v"(r) : "v"(lo), "v"(hi)); return r; }
typedef float f32x2 __attribute__((ext_vector_type(2)));
template <class Epi, class Sched, bool ALIGN_EPI = false, bool SP2 = false, int F8 = 0, int F8SA = 127, int F8SB = 127>
__device__ __forceinline__ void gemm_phase(PG8_LAS unsigned char* lds, const Gemm g, const Sched& S, const Epi& E) {
    const int tid = threadIdx.x, wid = __builtin_amdgcn_readfirstlane(tid >> 6), lane = tid & 63, wr = wid >> 2, wc = wid & 3, fr = lane & 15, fq = lane >> 4;
    const int K = g.K, nt = K / BK;
    unsigned voffA[2], voffB[2];
#pragma unroll
    for (int i = 0; i < 2; ++i) { int R, C; stage_rc(tid * 16 + i * 8192, R, C); const int Rb = Epi::PERM ? ((R & ~31) + perm32(R & 31)) : R;
        voffA[i] = (unsigned)(R * K + C) * 2u; voffB[i] = (unsigned)(Rb * K + C) * 2u; }
    const size_t kstep = (size_t)(BK * 2);
    const size_t hstep = (size_t)HALF * K * 2;
    const size_t tstep = 2 * hstep;
    const unsigned ldsw = (unsigned)wid * 1024u;
    const int aoff = lds_byte(wr * 64 + fr, fq * 8), boff = lds_byte(wc * 32 + fr, fq * 8);
#define PG8_SA(b, h) (((b) * 2 + (h)) * HTB)
#define PG8_SB(b, h) ((4 + (b) * 2 + (h)) * HTB)
#define PG8_STAGE(bufoff, gbase, voff) do { _Pragma("unroll") for (int _i = 0; _i < 2; ++_i) \
        __builtin_amdgcn_global_load_lds((const unsigned*)((const char*)(gbase) + (voff)[_i]), (PG8_LAS unsigned*)(lds + (bufoff) + ldsw + _i * 8192), 16, 0, 0); } while (0)
#define PG8_LDA(dst, b, h) do { _Pragma("unroll") for (int m = 0; m < 4; ++m) { dst[m].lo = *(const PG8_LAS i32x4*)(lds + PG8_SA(b, h) + aoff + m * 2048); dst[m].hi = *(const PG8_LAS i32x4*)(lds + PG8_SA(b, h) + aoff + m * 2048 + 1024); } } while (0)
#define PG8_LDB(dst, b, h) do { _Pragma("unroll") for (int n = 0; n < 2; ++n) { dst[n].lo = *(const PG8_LAS i32x4*)(lds + PG8_SB(b, h) + boff + n * 2048); dst[n].hi = *(const PG8_LAS i32x4*)(lds + PG8_SB(b, h) + boff + n * 2048 + 1024); } } while (0)
#define PG8_MMA(ai, bj, At, Bt) do { __builtin_amdgcn_s_setprio(1); \
        if constexpr (F8 == 0) { _Pragma("unroll") for (int m = 0; m < 4; ++m) _Pragma("unroll") for (int n = 0; n < 2; ++n) { \
            const i32x4 bl_ = Bt[n].lo, bh_ = Bt[n].hi, al_ = At[m].lo, ah_ = At[m].hi;     \
            acc[ai][bj][m][n] = __builtin_amdgcn_mfma_f32_16x16x32_bf16(__builtin_bit_cast(bf16x8, bl_), __builtin_bit_cast(bf16x8, al_), acc[ai][bj][m][n], 0, 0, 0); \
            acc[ai][bj][m][n] = __builtin_amdgcn_mfma_f32_16x16x32_bf16(__builtin_bit_cast(bf16x8, bh_), __builtin_bit_cast(bf16x8, ah_), acc[ai][bj][m][n], 0, 0, 0); } } \
        else { _Pragma("unroll") for (int m = 0; m < 4; ++m) _Pragma("unroll") for (int n = 0; n < 2; ++n) \
            asm volatile("v_mfma_f32_16x16x128_f8f6f4 %0, %1, %2, %0" : "+v"(acc[ai][bj][m][n]) : "v"(Bt[n]), "v"(At[m])); } \
        __builtin_amdgcn_s_setprio(0); } while (0)
#define PG8_WAIT_V(n) asm volatile("s_waitcnt vmcnt(" #n ")" ::: "memory")
#define PG8_WAIT_L(n) asm volatile("s_waitcnt lgkmcnt(" #n ")" ::: "memory")
#define PG8_BAR __builtin_amdgcn_s_barrier()
#define PG8_SCHED __builtin_amdgcn_sched_barrier(0)
    Unit cur, nxt; int ui = 0;
    if (!S.next(0, cur)) return;
    f32x4 acc[2][2][4][2];
#pragma unroll
    for (int a = 0; a < 2; ++a)
#pragma unroll
        for (int b = 0; b < 2; ++b)
#pragma unroll
            for (int m = 0; m < 4; ++m)
#pragma unroll
                for (int n = 0; n < 2; ++n) acc[a][b][m][n] = (f32x4){0.f, 0.f, 0.f, 0.f};
    i32x8 At[4], B0[2], B1[2];
    const char* cA = (const char*)g.A + (size_t)cur.pm * tstep; const char* cB = (const char*)g.Bt + (size_t)cur.pn * tstep;
    S.a_ready(cur);
    if constexpr (SP2) {
        PG8_STAGE(PG8_SB(0, 0), cB, voffB); PG8_STAGE(PG8_SB(0, 1), cB + hstep, voffB); PG8_STAGE(PG8_SA(0, 0), cA, voffA); PG8_STAGE(PG8_SA(0, 1), cA + hstep, voffA);
        if (wr == 1) PG8_BAR;
        PG8_WAIT_V(2); PG8_BAR;
        PG8_STAGE(PG8_SB(1, 0), cB + kstep, voffB); PG8_STAGE(PG8_SA(1, 0), cA + kstep, voffA); PG8_STAGE(PG8_SB(1, 1), cB + hstep + kstep, voffB);
        PG8_WAIT_V(6); PG8_BAR;
    } else {
        PG8_STAGE(PG8_SB(0, 0), cB, voffB); PG8_STAGE(PG8_SA(0, 0), cA, voffA); PG8_STAGE(PG8_SB(0, 1), cB + hstep, voffB); PG8_STAGE(PG8_SA(0, 1), cA + hstep, voffA);
        if (wr == 1) PG8_BAR;
        PG8_WAIT_V(4); PG8_BAR;
        PG8_STAGE(PG8_SB(1, 0), cB + kstep, voffB); PG8_STAGE(PG8_SA(1, 0), cA + kstep, voffA); PG8_STAGE(PG8_SB(1, 1), cB + hstep + kstep, voffB);
        PG8_WAIT_V(6); PG8_BAR;
    }
    for (;;) {
        const bool has_next = S.next(ui + 1, nxt);
        const char* nA = has_next ? (const char*)g.A + (size_t)nxt.pm * tstep : cA; const char* nB = has_next ? (const char*)g.Bt + (size_t)nxt.pn * tstep : cB;
_Pragma("nounroll")
        for (int t = 0; t < nt; t += 2) {
            const bool last = (t == nt - 2);
            const char* a1 = cA + (size_t)(t + 1) * kstep;
            const char* a2 = last ? nA : cA + (size_t)(t + 2) * kstep; const char* b2 = last ? nB : cB + (size_t)(t + 2) * kstep;
            const char* a3 = a2 + kstep; const char* b3 = b2 + kstep;
            if (last && has_next) S.a_ready(nxt);
            if constexpr (SP2) {
            PG8_LDB(B0, 0, 0); PG8_LDB(B1, 0, 1); PG8_SCHED; PG8_LDA(At, 0, 0); PG8_STAGE(PG8_SA(1, 1), a1 + hstep, voffA);
            PG8_WAIT_V(8); PG8_WAIT_L(0); PG8_BAR; PG8_MMA(0, 0, At, B0); PG8_MMA(0, 1, At, B1); PG8_BAR; PG8_SCHED;
            PG8_LDA(At, 0, 1); PG8_STAGE(PG8_SB(0, 0), b2, voffB); PG8_STAGE(PG8_SB(0, 1), b2 + hstep, voffB); PG8_STAGE(PG8_SA(0, 0), a2, voffA);
            PG8_WAIT_V(8); PG8_WAIT_L(0); PG8_BAR; PG8_MMA(1, 0, At, B0); PG8_MMA(1, 1, At, B1); PG8_BAR; PG8_SCHED;
            PG8_LDB(B0, 1, 0); PG8_LDB(B1, 1, 1); PG8_SCHED; PG8_LDA(At, 1, 0); PG8_STAGE(PG8_SA(0, 1), a2 + hstep, voffA);
            PG8_WAIT_V(8); PG8_WAIT_L(0); PG8_BAR; PG8_MMA(0, 0, At, B0); PG8_MMA(0, 1, At, B1); PG8_BAR; PG8_SCHED;
            PG8_LDA(At, 1, 1); PG8_STAGE(PG8_SB(1, 0), b3, voffB); PG8_STAGE(PG8_SB(1, 1), b3 + hstep, voffB); PG8_STAGE(PG8_SA(1, 0), a3, voffA);
            PG8_WAIT_V(8); PG8_WAIT_L(0); PG8_BAR; PG8_MMA(1, 0, At, B0); PG8_MMA(1, 1, At, B1); PG8_BAR; PG8_SCHED;
            } else {
            PG8_LDB(B0, 0, 0); PG8_SCHED; PG8_LDA(At, 0, 0); PG8_STAGE(PG8_SA(1, 1), a1 + hstep, voffA);
            PG8_WAIT_L(8); PG8_BAR; PG8_WAIT_L(0); PG8_MMA(0, 0, At, B0); PG8_BAR; PG8_SCHED;
            PG8_LDB(B1, 0, 1); PG8_STAGE(PG8_SB(0, 0), b2, voffB);
            PG8_BAR; PG8_WAIT_L(0); PG8_MMA(0, 1, At, B1); PG8_BAR;
            PG8_LDA(At, 0, 1); PG8_STAGE(PG8_SA(0, 0), a2, voffA);
            PG8_BAR; PG8_WAIT_L(0); PG8_MMA(1, 0, At, B0); PG8_BAR; PG8_SCHED;
            PG8_STAGE(PG8_SB(0, 1), b2 + hstep, voffB);
            PG8_WAIT_V(6); PG8_BAR; PG8_MMA(1, 1, At, B1); PG8_BAR;
            PG8_LDB(B0, 1, 0); PG8_SCHED; PG8_LDA(At, 1, 0); PG8_STAGE(PG8_SA(0, 1), a2 + hstep, voffA);
            PG8_WAIT_L(8); PG8_BAR; PG8_WAIT_L(0); PG8_MMA(0, 0, At, B0); PG8_BAR; PG8_SCHED;
            PG8_LDB(B1, 1, 1); PG8_STAGE(PG8_SB(1, 0), b3, voffB);
            PG8_BAR; PG8_WAIT_L(0); PG8_MMA(0, 1, At, B1); PG8_BAR;
            PG8_LDA(At, 1, 1); PG8_STAGE(PG8_SA(1, 0), a3, voffA);
            PG8_BAR; PG8_WAIT_L(0); PG8_MMA(1, 0, At, B0); PG8_BAR; PG8_SCHED;
            PG8_STAGE(PG8_SB(1, 1), b3 + hstep, voffB);
            PG8_WAIT_V(6); PG8_BAR; PG8_MMA(1, 1, At, B1); PG8_BAR;
            }
        }
        if constexpr (ALIGN_EPI) { if (wr == 0) PG8_BAR; }
        if constexpr (F8 != 0) asm volatile("s_nop 15\n\ts_nop 15" ::: "memory");
        if constexpr (!Epi::AFTER_DRAIN) { E(acc, cur, wr, wc, fr, fq); S.done(cur); }
        if (!has_next) break;
#pragma unroll
        for (int a = 0; a < 2; ++a)
#pragma unroll
            for (int b = 0; b < 2; ++b)
#pragma unroll
                for (int m = 0; m < 4; ++m)
#pragma unroll
                    for (int n = 0; n < 2; ++n) acc[a][b][m][n] = (f32x4){0.f, 0.f, 0.f, 0.f};
        cur = nxt; cA = nA; cB = nB; ++ui;
        if constexpr (ALIGN_EPI) { if (wr == 1) PG8_BAR; }
    }
    PG8_WAIT_V(0);
    if constexpr (!ALIGN_EPI) { if (wr == 0) PG8_BAR; }
    PG8_BAR;
    if constexpr (Epi::AFTER_DRAIN) { E.fused(acc, cur, wr, wc, fr, fq, lds, wid, lane); S.done(cur); }
#undef PG8_SA
#undef PG8_SB
#undef PG8_STAGE
#undef PG8_LDA
#undef PG8_LDB
#undef PG8_MMA
#undef PG8_WAIT_V
#undef PG8_WAIT_L
#undef PG8_BAR
#undef PG8_SCHED
}
}

constexpr int NB = 8, T = 4096, D = 1024, NTOK = NB * T;
constexpr int ATT_H = 8, ATT_D = 64, ATT_W = 512, KV_LAT = 256, IDX_H = 8, IDX_D = 64, TOPK = 256;
constexpr int HG_H = 4, HG_DK = 128, HG_DV = 128, HG_W = 512, HG_C = 32;
constexpr int D_IN = 3400, D_INP = 3584;
constexpr int C_AQ = 0, C_AC = 512, C_IQ = 768, C_IK = 1280, C_IW = 1344, C_GQ = 1352, C_GF = 1864, C_GI = 2376, C_GG = 2888;
constexpr int NE = 32, TOPE = 4, DFF = 1024, PLE = 256;
constexpr int NASSIGN = NTOK * TOPE, CAP = NASSIGN + NE * 256;
constexpr int MAXTILES = CAP / 256;
constexpr float LN_EPS = 1e-5f, RMS_EPS = 1e-6f, ALPHA = 1.189207115002721f;

constexpr size_t MiB = 1u << 20;
constexpr size_t WS_CTL = 0, CTL_ZERO_BYTES = 64 * 1024;
constexpr size_t WS_WIN_T = 1 * MiB, WS_WO_T = 8 * MiB, WS_WUP_T = 10 * MiB, WS_WDN_T = 138 * MiB, WS_WPROJ_T = 202 * MiB, WS_WGATE_T = 203 * MiB;
constexpr size_t WS_WUK_T = 205 * MiB, WS_WUV_T = 205 * MiB + 512 * 1024;
constexpr size_t WS_SMALL = 206 * MiB;
constexpr size_t WS_A = 208 * MiB;
constexpr size_t WS_B = 480 * MiB;
constexpr size_t WS_X1 = 752 * MiB;
constexpr size_t WS_XB = 880 * MiB;
constexpr size_t WS_PROJ = 944 * MiB;
constexpr size_t WS_SM2 = 1008 * MiB;
constexpr size_t WS_END = 1016 * MiB;
constexpr size_t WS_H = WS_A, WS_XS = WS_A, WS_YSLOT = WS_A;
constexpr size_t WS_XBF = WS_B, WS_U = WS_B, WS_YMIX = WS_B, WS_HH = WS_B;
constexpr size_t WS_QDEC = WS_B + 128 * MiB, WS_PB = WS_B + 128 * MiB, WS_OREC = WS_B + 160 * MiB, WS_CN = WS_B + 224 * MiB, WS_IKN = WS_B + 240 * MiB, WS_MASK = WS_B + 244 * MiB;
constexpr size_t WS_K = WS_XB, WS_VT = WS_XB + 32 * MiB;
constexpr size_t WS_TOPE = WS_SM2, WS_GATE = WS_SM2 + 512 * 1024, WS_LRANK = WS_SM2 + 1024 * 1024, WS_TOKSLOT = WS_SM2 + 1536 * 1024, WS_SLOTGATE = WS_SM2 + 2 * MiB, WS_DECAY = WS_SM2 + 3 * MiB;
constexpr size_t WS_WGBASE = WS_SMALL, WS_TILEE = WS_SMALL + 64 * 1024;
constexpr int CW_CNT = 64;
constexpr int CW_BAR = 1024;
constexpr int XBW_OFF = 147456 - 16;

constexpr int RING_BYTES = 131072, MISC_OFF = RING_BYTES, LDS_BYTES = 147456;
constexpr int NWAVES = 8, NTHR = 512;

#define GAS __attribute__((address_space(1)))
#define LAS __attribute__((address_space(3)))
typedef unsigned short bf16;
typedef unsigned v4u __attribute__((ext_vector_type(4)));
typedef unsigned v2u __attribute__((ext_vector_type(2)));
typedef float f32x4 __attribute__((ext_vector_type(4)));
typedef short bf16x8 __attribute__((ext_vector_type(8)));
#define LDS_WAIT() asm volatile("s_waitcnt lgkmcnt(0)" ::: "memory")
#define VM_WAIT() asm volatile("s_waitcnt vmcnt(0)" ::: "memory")
__device__ __forceinline__ unsigned f2bf(float f) { unsigned u = __builtin_bit_cast(unsigned, f); return (u + 0x7fffu + ((u >> 16) & 1u)) >> 16; }
__device__ __forceinline__ unsigned pk2(float lo, float hi) { return f2bf(lo) | (f2bf(hi) << 16); }
__device__ __forceinline__ float bf2f(unsigned short b) { return __builtin_bit_cast(float, (unsigned)b << 16); }
__device__ __forceinline__ float bflo(unsigned w) { return __builtin_bit_cast(float, w << 16); }
__device__ __forceinline__ float bfhi(unsigned w) { return __builtin_bit_cast(float, w & 0xffff0000u); }
__device__ __forceinline__ float wave_sum(float v) {
#pragma unroll
    for (int o = 1; o < 64; o <<= 1) v += __shfl_xor(v, o);
    return v;
}
__device__ __forceinline__ float sigmoidf_(float x) { return 1.f / (1.f + __expf(-x)); }

__device__ __forceinline__ unsigned pk4_fp8(float a, float b, float c, float d);
struct Params { const float* in[25]; float* out; unsigned char* ws; };
enum { I_X = 0, I_P, I_WIN, I_KVG, I_IKG, I_IKB, I_WUK, I_WUV, I_HGLB, I_HGNG, I_WO, I_LNMG, I_LNMB, I_WR, I_BR, I_WUP, I_BUP, I_WDN, I_BDN, I_LNFG, I_LNFB, I_WPP, I_WPG, I_LNPG, I_LNPB };

struct Ctx { LAS unsigned char* lds; int tid, lane, wave, G, gw, ngw; };

namespace pg8 {
struct EpiBf16s {
    static constexpr bool PERM = true, AFTER_DRAIN = false;
    bf16_t* O; int ldc;
    __device__ __forceinline__ void operator()(const f32x4 (&acc)[2][2][4][2], const Unit& u, int wr, int wc, int fr, int fq) const {
        const int row0 = u.pm * BM + wr * 64 + fr, col0 = u.pn * BM + wc * 32 + 8 * fq;
#pragma unroll
        for (int ai = 0; ai < 2; ++ai)
#pragma unroll
            for (int m = 0; m < 4; ++m) { bf16_t* rowp = O + (size_t)(row0 + ai * HALF + m * 16) * ldc + col0;
#pragma unroll
                for (int bj = 0; bj < 2; ++bj) { const f32x4 v0 = acc[ai][bj][m][0], v1 = acc[ai][bj][m][1];
                    u32x4 w; w.x = cvt_pk_bf16(v0[0], v0[1]); w.y = cvt_pk_bf16(v0[2], v0[3]); w.z = cvt_pk_bf16(v1[0], v1[1]); w.w = cvt_pk_bf16(v1[2], v1[3]);
                    *(u32x4*)(rowp + bj * HALF) = w; } }
    }
};
struct EpiResid {
    static constexpr bool PERM = false, AFTER_DRAIN = false;
    const float* res; float* out; int ldc; float alpha;
    __device__ __forceinline__ void operator()(const f32x4 (&acc)[2][2][4][2], const Unit& u, int wr, int wc, int fr, int fq) const {
        const int row0 = u.pm * BM + wr * 64 + fr, col0 = u.pn * BM + wc * 32 + 4 * fq;
#pragma unroll
        for (int ai = 0; ai < 2; ++ai)
#pragma unroll
            for (int m = 0; m < 4; ++m) { const size_t off = (size_t)(row0 + ai * HALF + m * 16) * ldc + col0;
#pragma unroll
                for (int bj = 0; bj < 2; ++bj)
#pragma unroll
                    for (int n = 0; n < 2; ++n) { const f32x4 r = *(const f32x4*)(res + off + bj * HALF + n * 16); *(f32x4*)(out + off + bj * HALF + n * 16) = r * alpha + acc[ai][bj][m][n]; }
                asm volatile("" ::: "memory"); }
    }
};
struct EpiPle {
    static constexpr bool PERM = false, AFTER_DRAIN = false;
    const float* x2; const bf16_t* proj; float* out; float alpha;
    __device__ __forceinline__ void operator()(const f32x4 (&acc)[2][2][4][2], const Unit& u, int wr, int wc, int fr, int fq) const {
        const int row0 = u.pm * BM + wr * 64 + fr, col0 = u.pn * BM + wc * 32 + 4 * fq;
#pragma unroll
        for (int ai = 0; ai < 2; ++ai)
#pragma unroll
            for (int m = 0; m < 4; ++m) { const size_t off = (size_t)(row0 + ai * HALF + m * 16) * 1024 + col0;
#pragma unroll
                for (int bj = 0; bj < 2; ++bj)
#pragma unroll
                    for (int n = 0; n < 2; ++n) { const size_t o2 = off + bj * HALF + n * 16; const f32x4 r = *(const f32x4*)(x2 + o2); const v2u pw = *(const v2u*)(proj + o2);
                        const f32x4 a = acc[ai][bj][m][n]; f32x4 o;
                        o[0] = r[0] * alpha + bflo(pw.x) * sigmoidf_(a[0]); o[1] = r[1] * alpha + bfhi(pw.x) * sigmoidf_(a[1]);
                        o[2] = r[2] * alpha + bflo(pw.y) * sigmoidf_(a[2]); o[3] = r[3] * alpha + bfhi(pw.y) * sigmoidf_(a[3]);
                        *(f32x4*)(out + o2) = o; }
                asm volatile("" ::: "memory"); }
    }
};
struct EpiSwiglu {
    static constexpr bool PERM = true, AFTER_DRAIN = false;
    unsigned char* H; const float* b_up;
    __device__ __forceinline__ void operator()(const f32x4 (&acc)[2][2][4][2], const Unit& u, int wr, int wc, int fr, int fq) const {
        const int e = u.pn >> 3, pnT = u.pn & 7;
        const int row0 = u.pm * BM + wr * 64 + fr, col0 = pnT * 128 + wc * 32 + 8 * fq;
        const float* bg = b_up + (size_t)e * 2048 + col0; const float* bl = bg + 1024;
        float bgv[8], blv[8];
#pragma unroll
        for (int j = 0; j < 8; ++j) { bgv[j] = bg[j]; blv[j] = bl[j]; }
#pragma unroll
        for (int ai = 0; ai < 2; ++ai)
#pragma unroll
            for (int m = 0; m < 4; ++m) { unsigned char* rowp = H + (size_t)(row0 + ai * HALF + m * 16) * 1024 + col0; float a[8];
#pragma unroll
                for (int n = 0; n < 2; ++n)
#pragma unroll
                    for (int j = 0; j < 4; ++j) { float g = acc[ai][0][m][n][j] * (1.f / 512.f) + bgv[4 * n + j], l = acc[ai][1][m][n][j] * (1.f / 512.f) + blv[4 * n + j];
                        g = fminf(g, 7.0f); l = fminf(fmaxf(l, -7.0f), 7.0f); a[4 * n + j] = g * sigmoidf_(1.702f * g) * (l + 1.0f); }
                v2u w; w.x = pk4_fp8(a[0] * 4.f, a[1] * 4.f, a[2] * 4.f, a[3] * 4.f); w.y = pk4_fp8(a[4] * 4.f, a[5] * 4.f, a[6] * 4.f, a[7] * 4.f);
                *(v2u*)rowp = w; }
    }
};
struct EpiDown {
    static constexpr bool PERM = true, AFTER_DRAIN = false;
    bf16_t* Y; const float* b_dn; const float* gate;
    __device__ __forceinline__ void operator()(const f32x4 (&acc)[2][2][4][2], const Unit& u, int wr, int wc, int fr, int fq) const {
        const int e = u.pn >> 2, pnT = u.pn & 3;
        const int row0 = u.pm * BM + wr * 64 + fr, col0 = pnT * 256 + wc * 32 + 8 * fq;
        const float* bb = b_dn + (size_t)e * 1024 + col0;
        float bv[2][8];
#pragma unroll
        for (int bj = 0; bj < 2; ++bj)
#pragma unroll
            for (int j = 0; j < 8; ++j) bv[bj][j] = bb[bj * HALF + j];
#pragma unroll
        for (int ai = 0; ai < 2; ++ai)
#pragma unroll
            for (int m = 0; m < 4; ++m) { const int row = row0 + ai * HALF + m * 16; const float gt = gate[row]; bf16_t* rowp = Y + (size_t)row * 1024 + col0;
#pragma unroll
                for (int bj = 0; bj < 2; ++bj) { const f32x4 v0 = acc[ai][bj][m][0], v1 = acc[ai][bj][m][1];
                    const float as = 1.f / 256.f;
                    u32x4 w; w.x = cvt_pk_bf16((v0[0] * as + bv[bj][0]) * gt, (v0[1] * as + bv[bj][1]) * gt); w.y = cvt_pk_bf16((v0[2] * as + bv[bj][2]) * gt, (v0[3] * as + bv[bj][3]) * gt);
                    w.z = cvt_pk_bf16((v1[0] * as + bv[bj][4]) * gt, (v1[1] * as + bv[bj][5]) * gt); w.w = cvt_pk_bf16((v1[2] * as + bv[bj][6]) * gt, (v1[3] * as + bv[bj][7]) * gt);
                    *(u32x4*)(rowp + bj * HALF) = w; } }
    }
};
struct MoeOrder {
    const int* tile_e; int ntiles, nN, G, c;
    __device__ __forceinline__ bool next(int i, Unit& u) const {
        const int L = i * G + c; if (L >= ntiles * nN) return false;
        const int pm = L / nN, pl = L - pm * nN; u.pm = pm; u.pn = tile_e[pm] * nN + pl; return true;
    }
    __device__ __forceinline__ void a_ready(const Unit&) const {}
    __device__ __forceinline__ void done(const Unit&) const {}
};
}

template <class RowMap>
__device__ __forceinline__ void transpose_item(const float* W, int ldw, int Nvalid, bf16* WT, int Kdim, RowMap rm, LAS float* scr, int kb, int nb, int lane) {
    const int k0 = 64 * kb, n0 = 32 * nb; const int nl0 = lane & 31, nn = n0 + nl0;
#pragma unroll 8
    for (int i = 0; i < 32; ++i) { const int kk = 2 * i + (lane >> 5); scr[kk * 33 + nl0] = (nn < Nvalid) ? W[(size_t)(k0 + kk) * ldw + nn] : 0.f; }
    LDS_WAIT(); asm volatile("" ::: "memory");
    const int c = lane & 7;
#pragma unroll
    for (int j = 0; j < 4; ++j) { const int n = (lane >> 3) + 8 * j; const LAS float* s = scr + (8 * c) * 33 + n;
        v4u o; o.x = pk2(s[0 * 33], s[1 * 33]); o.y = pk2(s[2 * 33], s[3 * 33]); o.z = pk2(s[4 * 33], s[5 * 33]); o.w = pk2(s[6 * 33], s[7 * 33]);
        *(GAS v4u*)(WT + (size_t)rm(n0 + n) * Kdim + k0 + 8 * c) = o; }
    LDS_WAIT(); asm volatile("" ::: "memory");
}
__device__ __forceinline__ unsigned pk4_fp8(float a, float b, float c, float d) { int r = 0; r = __builtin_amdgcn_cvt_pk_fp8_f32(a, b, r, false); r = __builtin_amdgcn_cvt_pk_fp8_f32(c, d, r, true); return (unsigned)r; }
template <class RowMap>
__device__ __forceinline__ void transpose_item_f8(const float* W, int ldw, unsigned char* WT, int Kdim, RowMap rm, LAS float* scr, int kb, int nb, int lane, float mul) {
    const int k0 = 64 * kb, n0 = 32 * nb; const int nl0 = lane & 31, nn = n0 + nl0;
#pragma unroll 8
    for (int i = 0; i < 32; ++i) { const int kk = 2 * i + (lane >> 5); scr[kk * 33 + nl0] = W[(size_t)(k0 + kk) * ldw + nn] * mul; }
    LDS_WAIT(); asm volatile("" ::: "memory");
    const int c = lane & 7;
#pragma unroll
    for (int j = 0; j < 4; ++j) { const int n = (lane >> 3) + 8 * j; const LAS float* s = scr + (8 * c) * 33 + n;
        v2u o; o.x = pk4_fp8(s[0 * 33], s[1 * 33], s[2 * 33], s[3 * 33]); o.y = pk4_fp8(s[4 * 33], s[5 * 33], s[6 * 33], s[7 * 33]);
        *(GAS v2u*)(WT + (size_t)rm(n0 + n) * Kdim + k0 + 8 * c) = o; }
    LDS_WAIT(); asm volatile("" ::: "memory");
}
struct RmId { __device__ __forceinline__ int operator()(int n) const { return n; } };
struct RmUp { int e; __device__ __forceinline__ int operator()(int n) const { return e * 2048 + ((n & 1023) >> 7) * 256 + (n >> 10) * 128 + (n & 127); } };
struct RmOff { int off; __device__ __forceinline__ int operator()(int n) const { return off + n; } };

__device__ __forceinline__ void p0_prologue(const Params& P, const Ctx& C) {
    LAS float* scr = (LAS float*)(C.lds + C.wave * 16384);
    unsigned char* ws = P.ws;
    constexpr int I_IN = 16 * (D_INP / 32), I_O = 16 * 32, I_UP = 16 * 64, I_DN = 16 * 32, I_PP = 4 * 32, I_PG = 16 * 32, I_UK = 4 * 16, I_UV = 4 * 16;
    constexpr int NITEMS = I_IN + I_O + NE * I_UP + NE * I_DN + I_PP + I_PG + I_UK + I_UV;
    for (int it = C.gw; it < NITEMS; it += C.ngw) {
        int r = it;
        if (r < I_IN) { transpose_item(P.in[I_WIN], D_IN, D_IN, (bf16*)(ws + WS_WIN_T), 1024, RmId{}, scr, r / (D_INP / 32), r % (D_INP / 32), C.lane); continue; } r -= I_IN;
        if (r < I_O) { transpose_item(P.in[I_WO], 1024, 1024, (bf16*)(ws + WS_WO_T), 1024, RmId{}, scr, r / 32, r % 32, C.lane); continue; } r -= I_O;
        if (r < NE * I_UP) { const int e = r / I_UP, q = r % I_UP; transpose_item_f8(P.in[I_WUP] + (size_t)e * 1024 * 2048, 2048, ws + WS_WUP_T, 1024, RmUp{e}, scr, q / 64, q % 64, C.lane, 64.f); continue; } r -= NE * I_UP;
        if (r < NE * I_DN) { const int e = r / I_DN, q = r % I_DN; transpose_item_f8(P.in[I_WDN] + (size_t)e * 1024 * 1024, 1024, ws + WS_WDN_T, 1024, RmOff{e * 1024}, scr, q / 32, q % 32, C.lane, 64.f); continue; } r -= NE * I_DN;
        if (r < I_PP) { transpose_item(P.in[I_WPP], 1024, 1024, (bf16*)(ws + WS_WPROJ_T), 256, RmId{}, scr, r / 32, r % 32, C.lane); continue; } r -= I_PP;
        if (r < I_PG) { transpose_item(P.in[I_WPG], 1024, 1024, (bf16*)(ws + WS_WGATE_T), 1024, RmId{}, scr, r / 32, r % 32, C.lane); continue; } r -= I_PG;
        if (r < I_UK) { transpose_item(P.in[I_WUK], 512, 512, (bf16*)(ws + WS_WUK_T), 256, RmId{}, scr, r / 16, r % 16, C.lane); continue; } r -= I_UK;
        transpose_item(P.in[I_WUV], 512, 512, (bf16*)(ws + WS_WUV_T), 256, RmId{}, scr, r / 16, r % 16, C.lane);
    }
    {
        const float* x = P.in[I_X]; bf16* xb = (bf16*)(ws + WS_XBF);
        const size_t n8 = (size_t)NTOK * D / 8, stride = (size_t)C.ngw * 64;
        for (size_t i = (size_t)C.gw * 64 + C.lane; i < n8; i += stride) { const f32x4 a = *(const GAS f32x4*)(x + i * 8), b = *(const GAS f32x4*)(x + i * 8 + 4);
            v4u o; o.x = pk2(a[0], a[1]); o.y = pk2(a[2], a[3]); o.z = pk2(b[0], b[1]); o.w = pk2(b[2], b[3]); *(GAS v4u*)(xb + i * 8) = o; }
        const float* p = P.in[I_P]; bf16* pb = (bf16*)(ws + WS_PB);
        const size_t m8 = (size_t)NTOK * PLE / 8;
        for (size_t i = (size_t)C.gw * 64 + C.lane; i < m8; i += stride) { const f32x4 a = *(const GAS f32x4*)(p + i * 8), b = *(const GAS f32x4*)(p + i * 8 + 4);
            v4u o; o.x = pk2(a[0], a[1]); o.y = pk2(a[2], a[3]); o.z = pk2(b[0], b[1]); o.w = pk2(b[2], b[3]); *(GAS v4u*)(pb + i * 8) = o; }
    }
}

__device__ __forceinline__ void ln_row(f32x4 (&v)[4], const float* g, const float* b, int lane) {
    float s = 0.f;
#pragma unroll
    for (int j = 0; j < 4; ++j) s += (v[j][0] + v[j][1]) + (v[j][2] + v[j][3]);
    const float mean = wave_sum(s) * (1.f / D); float s2 = 0.f;
#pragma unroll
    for (int j = 0; j < 4; ++j) { v[j] = v[j] - mean; s2 += (v[j][0] * v[j][0] + v[j][1] * v[j][1]) + (v[j][2] * v[j][2] + v[j][3] * v[j][3]); }
    const float rstd = 1.f / sqrtf(wave_sum(s2) * (1.f / D) + LN_EPS);
#pragma unroll
    for (int j = 0; j < 4; ++j) { const f32x4 gg = *(const f32x4*)(g + 4 * lane + 256 * j), bb = *(const f32x4*)(b + 4 * lane + 256 * j); v[j] = v[j] * rstd * gg + bb; }
}
__device__ __forceinline__ void store_row_f32(float* row, const f32x4 (&v)[4], int lane) {
#pragma unroll
    for (int j = 0; j < 4; ++j) *(GAS f32x4*)(row + 4 * lane + 256 * j) = v[j];
}
__device__ __forceinline__ void store_row_bf16(bf16* row, const f32x4 (&v)[4], int lane) {
#pragma unroll
    for (int j = 0; j < 4; ++j) { v2u o; o.x = pk2(v[j][0], v[j][1]); o.y = pk2(v[j][2], v[j][3]); *(GAS v2u*)(row + 4 * lane + 256 * j) = o; }
}
__device__ __forceinline__ void load_row_f32(f32x4 (&v)[4], const float* row, int lane) {
#pragma unroll
    for (int j = 0; j < 4; ++j) v[j] = *(const GAS f32x4*)(row + 4 * lane + 256 * j);
}
#ifndef FEAT_MIX
#define FEAT_MIX 1
#endif
#ifndef FEAT_MOE
#define FEAT_MOE 1
#endif
#ifndef FEAT_PLE
#define FEAT_PLE 1
#endif
#ifndef FEAT_ATT
#define FEAT_ATT 1
#endif
#ifndef SYNC_MODE
#define SYNC_MODE 0
#endif
#ifndef PROGRAM
#define PROGRAM X(0) GS X(10) X(11) SY X(20) X(21) SY X(30) X(31) BS X(32) SY X(40) X(41) SY X(5) SY X(6) SY X(7) SY X(8) SY X(9) SY X(100) SY X(110) SY X(120)
#endif

typedef float f32x16 __attribute__((ext_vector_type(16)));
typedef short s16x4 __attribute__((ext_vector_type(4)));
__device__ __forceinline__ unsigned cvtpk(float lo, float hi) { typedef float f2 __attribute__((ext_vector_type(2))); typedef __bf16 b2 __attribute__((ext_vector_type(2))); f2 v = {lo, hi}; b2 b = __builtin_convertvector(v, b2); return __builtin_bit_cast(unsigned, b); }
__device__ __forceinline__ bf16x8 pack8(const f32x16& x, int base) {
    v4u w; w.x = cvtpk(x[base + 0], x[base + 1]); w.y = cvtpk(x[base + 2], x[base + 3]); w.z = cvtpk(x[base + 4], x[base + 5]); w.w = cvtpk(x[base + 6], x[base + 7]);
    return __builtin_bit_cast(bf16x8, w);
}

__device__ __forceinline__ void p2_post(const Params& P, const Ctx& C) {
    unsigned char* ws = P.ws;
    const bf16* H = (const bf16*)(ws + WS_H); bf16* CN = (bf16*)(ws + WS_CN); bf16* IKN = (bf16*)(ws + WS_IKN);
    const float* kvg = P.in[I_KVG]; const float* ikg = P.in[I_IKG]; const float* ikb = P.in[I_IKB];
    const f32x4 g4 = *(const f32x4*)(kvg + 4 * C.lane); const float ig = ikg[C.lane], ib = ikb[C.lane];
    for (int m = C.gw; m < NTOK; m += C.ngw) {
        const bf16* hr = H + (size_t)m * D_INP;
        const v2u w = *(const GAS v2u*)(hr + C_AC + 4 * C.lane);
        float a0 = bflo(w.x), a1 = bfhi(w.x), a2 = bflo(w.y), a3 = bfhi(w.y);
        const float ss = wave_sum((a0 * a0 + a1 * a1) + (a2 * a2 + a3 * a3));
        const float rs = 1.f / sqrtf(ss * (1.f / 256.f) + RMS_EPS);
        v2u o; o.x = pk2(a0 * rs * g4[0], a1 * rs * g4[1]); o.y = pk2(a2 * rs * g4[2], a3 * rs * g4[3]);
        *(GAS v2u*)(CN + (size_t)m * 256 + 4 * C.lane) = o;
        const float k = bf2f(hr[C_IK + C.lane]);
        const float mu = wave_sum(k) * (1.f / 64.f); const float dk = k - mu;
        const float var = wave_sum(dk * dk) * (1.f / 64.f);
        IKN[(size_t)m * 64 + C.lane] = (bf16)f2bf(dk * (1.f / sqrtf(var + LN_EPS)) * ig + ib);
    }
}

constexpr int HP_QD = 0, HP_KI = 8704, HP_KET = 17408, HP_VT = 27648, HP_GS = 37888, HP_RAW = 40960;
__device__ __forceinline__ void p2_hgrn_prep(const Params& P, const Ctx& C) {
    unsigned char* ws = P.ws;
    const bf16* H = (const bf16*)(ws + WS_H);
    bf16* UT = (bf16*)(ws + WS_U); bf16* QDEC = (bf16*)(ws + WS_QDEC); float* OREC = (float*)(ws + WS_OREC); float* DEC = (float*)(ws + WS_DECAY);
    LAS bf16* QD = (LAS bf16*)(C.lds + HP_QD); LAS bf16* KI = (LAS bf16*)(C.lds + HP_KI); LAS bf16* KET = (LAS bf16*)(C.lds + HP_KET); LAS bf16* VT = (LAS bf16*)(C.lds + HP_VT);
    LAS float* GS = (LAS float*)(C.lds + HP_GS); LAS bf16* RAW = (LAS bf16*)(C.lds + HP_RAW);
    const int d = C.tid & 127, tg = C.tid >> 7;
    const int lane = C.lane, r32 = lane & 31, hf = lane >> 5;
    const int lc = C.tid >> 4, lg = C.tid & 15;
    const int NU = NB * HG_H * (T / HG_C);
    v4u rf, rq, ri;
    { const int unit = blockIdx.x; if (unit < NU) { const int n = unit & 127, hh = (unit >> 7) & 3, b = unit >> 9; const bf16* hr = H + (size_t)(b * T + n * HG_C + lc) * D_INP + hh * 128 + 8 * lg;
        rf = *(const GAS v4u*)(hr + C_GF); rq = *(const GAS v4u*)(hr + C_GQ); ri = *(const GAS v4u*)(hr + C_GI); } }
    for (int unit = blockIdx.x; unit < NU; unit += C.G) {
        const int n = unit & 127, hh = (unit >> 7) & 3, b = unit >> 9;
        const int m0 = b * T + n * HG_C;
        *(LAS v4u*)(RAW + lc * 128 + 8 * lg) = rf; *(LAS v4u*)(RAW + 4096 + lc * 128 + 8 * lg) = rq; *(LAS v4u*)(RAW + 8192 + lc * 128 + 8 * lg) = ri;
        __syncthreads();
        { const int un = unit + C.G; if (un < NU) { const int n2 = un & 127, h2 = (un >> 7) & 3, b2 = un >> 9; const bf16* hr = H + (size_t)(b2 * T + n2 * HG_C + lc) * D_INP + h2 * 128 + 8 * lg;
            rf = *(const GAS v4u*)(hr + C_GF); rq = *(const GAS v4u*)(hr + C_GQ); ri = *(const GAS v4u*)(hr + C_GI); } }
        const float l0 = P.in[I_HGLB][hh * 128 + d], l1 = P.in[I_HGLB][512 + hh * 128 + d];
        const float lb = 1.f / (1.f + __expf(l1 - l0));
        float fg[8], bl[8], qv[8]; float run = 0.f; unsigned vv[4];
#pragma unroll
        for (int c = 0; c < 8; ++c) { const int tok = tg * 8 + c;
            const float f = bf2f(RAW[tok * 128 + d]), q = bf2f(RAW[4096 + tok * 128 + d]); const unsigned iv = RAW[8192 + tok * 128 + d];
            fg[c] = lb + (1.f - lb) * sigmoidf_(f); run += __logf(fg[c]); bl[c] = run; qv[c] = q * sigmoidf_(q);
            if (c & 1) vv[c >> 1] |= iv << 16; else vv[c >> 1] = iv; }
        GS[tg * 128 + d] = run;
        *(LAS v4u*)(VT + d * 40 + tg * 8) = (v4u){vv[0], vv[1], vv[2], vv[3]};
        __syncthreads();
        float pre = 0.f, tot = 0.f;
#pragma unroll
        for (int g = 0; g < 4; ++g) { const float sg = GS[g * 128 + d]; tot += sg; if (g < tg) pre += sg; }
        unsigned ke[4];
#pragma unroll
        for (int c = 0; c < 8; ++c) { const float bc = pre + bl[c]; const float kc = 1.f - fg[c];
            const float qd = qv[c] * __expf(bc), ki = kc * __expf(-bc), kend = kc * __expf(tot - bc);
            const unsigned qb = f2bf(qd);
            QD[(tg * 8 + c) * 136 + d] = (bf16)qb; KI[(tg * 8 + c) * 136 + d] = (bf16)f2bf(ki);
            if (c & 1) ke[c >> 1] |= f2bf(kend) << 16; else ke[c >> 1] = f2bf(kend); }
        *(LAS v4u*)(KET + d * 40 + tg * 8) = (v4u){ke[0], ke[1], ke[2], ke[3]};
        if (tg == 0) DEC[(size_t)unit * 128 + d] = __expf(tot);
        __syncthreads();
        *(GAS v4u*)(QDEC + (size_t)(m0 + lc) * 512 + hh * 128 + 8 * lg) = *(const LAS v4u*)(QD + lc * 136 + 8 * lg);
        if (C.wave < 4) {
            f32x16 X = {0.f, 0.f, 0.f, 0.f, 0.f, 0.f, 0.f, 0.f, 0.f, 0.f, 0.f, 0.f, 0.f, 0.f, 0.f, 0.f};
#pragma unroll
            for (int k = 0; k < 8; ++k) { const bf16x8 a = *(const LAS bf16x8*)(KI + r32 * 136 + 16 * k + 8 * hf), bq = *(const LAS bf16x8*)(QD + r32 * 136 + 16 * k + 8 * hf);
                X = __builtin_amdgcn_mfma_f32_32x32x16_bf16(a, bq, X, 0, 0, 0); }
#pragma unroll
            for (int r = 0; r < 16; ++r) { const int sidx = (r & 3) + 8 * (r >> 2) + 4 * hf; if (sidx > r32) X[r] = 0.f; }
            f32x16 Z = {0.f, 0.f, 0.f, 0.f, 0.f, 0.f, 0.f, 0.f, 0.f, 0.f, 0.f, 0.f, 0.f, 0.f, 0.f, 0.f};
            const int e = C.wave * 32 + r32;
#pragma unroll
            for (int sp = 0; sp < 2; ++sp) { const bf16x8 a = pack8(X, 8 * sp);
                const s16x4 lo = *(const LAS s16x4*)(VT + e * 40 + 16 * sp + 4 * hf), hi = *(const LAS s16x4*)(VT + e * 40 + 16 * sp + 8 + 4 * hf);
                const bf16x8 bv = (bf16x8){lo[0], lo[1], lo[2], lo[3], hi[0], hi[1], hi[2], hi[3]};
                Z = __builtin_amdgcn_mfma_f32_32x32x16_bf16(a, bv, Z, 0, 0, 0); }
#pragma unroll
            for (int r = 0; r < 16; ++r) { const int c = (r & 3) + 8 * (r >> 2) + 4 * hf; OREC[(size_t)(m0 + c) * 512 + hh * 128 + e] = Z[r]; }
        }
        {
            const int dt = C.wave >> 1;
            const bf16x8 a0 = *(const LAS bf16x8*)(KET + (dt * 32 + r32) * 40 + 8 * hf), a1 = *(const LAS bf16x8*)(KET + (dt * 32 + r32) * 40 + 16 + 8 * hf);
#pragma unroll
            for (int ei = 0; ei < 2; ++ei) { const int et = 2 * (C.wave & 1) + ei;
                const bf16x8 b0 = *(const LAS bf16x8*)(VT + (et * 32 + r32) * 40 + 8 * hf), b1 = *(const LAS bf16x8*)(VT + (et * 32 + r32) * 40 + 16 + 8 * hf);
                f32x16 U = {0.f, 0.f, 0.f, 0.f, 0.f, 0.f, 0.f, 0.f, 0.f, 0.f, 0.f, 0.f, 0.f, 0.f, 0.f, 0.f};
                U = __builtin_amdgcn_mfma_f32_32x32x16_bf16(a0, b0, U, 0, 0, 0); U = __builtin_amdgcn_mfma_f32_32x32x16_bf16(a1, b1, U, 0, 0, 0);
                bf16* up = UT + (size_t)unit * 16384 + (size_t)(et * 32 + r32) * 128 + dt * 32 + 4 * hf;
#pragma unroll
                for (int q = 0; q < 4; ++q) { v2u o; o.x = cvtpk(U[4 * q], U[4 * q + 1]); o.y = cvtpk(U[4 * q + 2], U[4 * q + 3]); *(GAS v2u*)(up + 8 * q) = o; } }
        }
        __syncthreads();
    }
}

__device__ __forceinline__ void p3_hgrn_scan(const Params& P, const Ctx& C) {
    unsigned char* ws = P.ws;
    const bf16* UT = (const bf16*)(ws + WS_U); const bf16* QDEC = (const bf16*)(ws + WS_QDEC); float* OREC = (float*)(ws + WS_OREC); const float* DEC = (const float*)(ws + WS_DECAY);
    LAS bf16* ST = (LAS bf16*)C.lds;
    typedef float f32x4v __attribute__((ext_vector_type(4)));
    for (int unit = blockIdx.x; unit < NB * HG_H * 8; unit += C.G) {
        const int sl = unit & 7, hh = (unit >> 3) & 3, b = unit >> 5; const int e0 = sl * 16;
        const int e = C.tid & 15, dq = C.tid >> 4;
        float S[4] = {0.f, 0.f, 0.f, 0.f};
        *(LAS v2u*)(ST + e * 136 + 4 * dq) = (v2u){0u, 0u};
        const int cu0 = (b * HG_H + hh) * 128;
        const int lane = C.lane, fr = lane & 15, fq = lane >> 4;
        const bool mw = C.wave < 2;
        const bf16* up = UT + (size_t)cu0 * 16384 + (size_t)(e0 + e) * 128 + 4 * dq;
        const float* dp = DEC + (size_t)cu0 * 128 + 4 * dq;
        const bf16* qp = QDEC + (size_t)(b * T + C.wave * 16 + fr) * 512 + hh * 128 + 8 * fq;
        float* op = OREC + (size_t)(b * T + C.wave * 16 + 4 * fq) * 512 + hh * 128 + e0 + fr;
        v2u un[4]; f32x4 dn[4]; bf16x8 qa[4][4]; float oi[4][4];
#pragma unroll
        for (int s = 0; s < 4; ++s) { un[s] = *(const GAS v2u*)(up + (size_t)s * 16384); dn[s] = *(const GAS f32x4*)(dp + (size_t)s * 128);
            if (mw) {
#pragma unroll
                for (int k = 0; k < 4; ++k) qa[s][k] = *(const GAS bf16x8*)(qp + (size_t)s * 32 * 512 + 32 * k);
#pragma unroll
                for (int j = 0; j < 4; ++j) oi[s][j] = op[(size_t)(s * 32 + j) * 512]; } }
        __syncthreads();
        for (int nb = 0; nb < 32; ++nb) {
#pragma unroll
            for (int s = 0; s < 4; ++s) {
                const int n = 4 * nb + s;
                const LAS bf16* stc = ST + (n & 1) * (16 * 136); LAS bf16* stn = ST + ((n + 1) & 1) * (16 * 136);
                if (mw) {
                    f32x4v acc = {oi[s][0], oi[s][1], oi[s][2], oi[s][3]};
#pragma unroll
                    for (int k = 0; k < 4; ++k) { const bf16x8 bs = *(const LAS bf16x8*)(stc + fr * 136 + 32 * k + 8 * fq); acc = __builtin_amdgcn_mfma_f32_16x16x32_bf16(qa[s][k], bs, acc, 0, 0, 0); }
#pragma unroll
                    for (int j = 0; j < 4; ++j) op[(size_t)(n * 32 + j) * 512] = acc[j];
                }
                S[0] = dn[s][0] * S[0] + bflo(un[s].x); S[1] = dn[s][1] * S[1] + bfhi(un[s].x); S[2] = dn[s][2] * S[2] + bflo(un[s].y); S[3] = dn[s][3] * S[3] + bfhi(un[s].y);
                *(LAS v2u*)(stn + e * 136 + 4 * dq) = (v2u){cvtpk(S[0], S[1]), cvtpk(S[2], S[3])};
                if (nb + 1 < 32) {
                    const int n2 = n + 4; un[s] = *(const GAS v2u*)(up + (size_t)n2 * 16384); dn[s] = *(const GAS f32x4*)(dp + (size_t)n2 * 128);
                    if (mw) {
#pragma unroll
                        for (int k = 0; k < 4; ++k) qa[s][k] = *(const GAS bf16x8*)(qp + (size_t)n2 * 32 * 512 + 32 * k);
#pragma unroll
                        for (int j = 0; j < 4; ++j) oi[s][j] = op[(size_t)(n2 * 32 + j) * 512]; }
                }
                __syncthreads();
            }
        }
    }
}

__device__ __forceinline__ void p4_yrec(const Params& P, const Ctx& C) {
    unsigned char* ws = P.ws;
    const float* OREC = (const float*)(ws + WS_OREC); const bf16* H = (const bf16*)(ws + WS_H); bf16* YM = (bf16*)(ws + WS_YMIX);
    const float* ng = P.in[I_HGNG];
    const f32x4 g0 = *(const f32x4*)(ng + 8 * C.lane), g1 = *(const f32x4*)(ng + 8 * C.lane + 4);
    for (int m = C.gw; m < NTOK; m += C.ngw) {
        const f32x4 a = *(const GAS f32x4*)(OREC + (size_t)m * 512 + 8 * C.lane), bq = *(const GAS f32x4*)(OREC + (size_t)m * 512 + 8 * C.lane + 4);
        float ss = (a[0] * a[0] + a[1] * a[1]) + (a[2] * a[2] + a[3] * a[3]) + (bq[0] * bq[0] + bq[1] * bq[1]) + (bq[2] * bq[2] + bq[3] * bq[3]);
        ss += __shfl_xor(ss, 1); ss += __shfl_xor(ss, 2); ss += __shfl_xor(ss, 4); ss += __shfl_xor(ss, 8);
        const float rs = 1.f / sqrtf(ss * (1.f / 128.f) + RMS_EPS);
        const v4u gw = *(const GAS v4u*)(H + (size_t)m * D_INP + C_GG + 8 * C.lane);
        float gv[8] = {bflo(gw.x), bfhi(gw.x), bflo(gw.y), bfhi(gw.y), bflo(gw.z), bfhi(gw.z), bflo(gw.w), bfhi(gw.w)};
        float o[8];
#pragma unroll
        for (int j = 0; j < 4; ++j) { o[j] = a[j] * rs * g0[j] * (gv[j] * sigmoidf_(gv[j])); o[4 + j] = bq[j] * rs * g1[j] * (gv[4 + j] * sigmoidf_(gv[4 + j])); }
        v4u w; w.x = pk2(o[0], o[1]); w.y = pk2(o[2], o[3]); w.z = pk2(o[4], o[5]); w.w = pk2(o[6], o[7]);
        *(GAS v4u*)(YM + (size_t)m * D + 512 + 8 * C.lane) = w;
#if !FEAT_ATT
        *(GAS v4u*)(YM + (size_t)m * D + 8 * C.lane) = (v4u){0u, 0u, 0u, 0u};
#endif
    }
}

namespace pg8 {
struct EpiKhead {
    static constexpr bool PERM = true, AFTER_DRAIN = false;
    bf16_t* O;
    __device__ __forceinline__ void operator()(const f32x4 (&acc)[2][2][4][2], const Unit& u, int wr, int wc, int fr, int fq) const {
        const int row0 = u.pm * BM + wr * 64 + fr, col0 = u.pn * BM + wc * 32 + 8 * fq;
#pragma unroll
        for (int ai = 0; ai < 2; ++ai)
#pragma unroll
            for (int m = 0; m < 4; ++m) { const int row = row0 + ai * HALF + m * 16; const int b = row >> 12, t = row & 4095;
#pragma unroll
                for (int bj = 0; bj < 2; ++bj) { const int col = col0 + bj * HALF; const f32x4 v0 = acc[ai][bj][m][0], v1 = acc[ai][bj][m][1];
                    u32x4 w; w.x = cvt_pk_bf16(v0[0], v0[1]); w.y = cvt_pk_bf16(v0[2], v0[3]); w.z = cvt_pk_bf16(v1[0], v1[1]); w.w = cvt_pk_bf16(v1[2], v1[3]);
                    *(u32x4*)(O + ((size_t)((b * 8 + (col >> 6)) * 4096 + t)) * 64 + (col & 63)) = w; } }
    }
};
struct EpiVt {
    static constexpr bool PERM = true, AFTER_DRAIN = false;
    bf16_t* O;
    __device__ __forceinline__ void operator()(const f32x4 (&acc)[2][2][4][2], const Unit& u, int wr, int wc, int fr, int fq) const {
        const int row0 = u.pm * BM + wr * 64 + fr, col0 = u.pn * BM + wc * 32 + 8 * fq;
#pragma unroll
        for (int ai = 0; ai < 2; ++ai)
#pragma unroll
            for (int m = 0; m < 4; ++m) { const int row = row0 + ai * HALF + m * 16;
#pragma unroll
                for (int bj = 0; bj < 2; ++bj) { const int col = col0 + bj * HALF; const int b = col >> 12, t = col & 4095; const f32x4 v0 = acc[ai][bj][m][0], v1 = acc[ai][bj][m][1];
                    u32x4 w; w.x = cvt_pk_bf16(v0[0], v0[1]); w.y = cvt_pk_bf16(v0[2], v0[3]); w.z = cvt_pk_bf16(v1[0], v1[1]); w.w = cvt_pk_bf16(v1[2], v1[3]);
                    *(u32x4*)(O + ((size_t)(b * 512 + row)) * 4096 + t) = w; } }
    }
};
}

__device__ __forceinline__ unsigned f2ord(float x) { const unsigned b = __builtin_bit_cast(unsigned, x); return b ^ ((unsigned)((int)b >> 31) | 0x80000000u); }
typedef _Float16 h16;
typedef _Float16 h16x8 __attribute__((ext_vector_type(8)));
__device__ __forceinline__ float relu_i(float x) { const int b = __builtin_bit_cast(int, x); return __builtin_bit_cast(float, b > 0 ? b : 0); }
__device__ __forceinline__ unsigned h2ord(unsigned hb) { return (hb ^ ((hb & 0x8000u) ? 0xffffu : 0x8000u)) & 0xffffu; }
__device__ __forceinline__ int isc_bucket(float x, float mu, float scale) { const float t = fminf(fmaxf(fmaf(x - mu, scale, 128.f), 0.f), 255.f); return (int)t; }
__device__ __forceinline__ void p3_indexer(const Params& P, const Ctx& C) {
    unsigned char* ws = P.ws;
    const bf16* H = (const bf16*)(ws + WS_H); const bf16* IKN = (const bf16*)(ws + WS_IKN); unsigned* MASK = (unsigned*)(ws + WS_MASK);
    LAS h16* ISC = (LAS h16*)C.lds; LAS unsigned* HIST = (LAS unsigned*)(C.lds + 131072) + C.wave * 256; LAS float* STAT = (LAS float*)(C.lds + 139264); LAS float* W16 = (LAS float*)(C.lds + 140288);
    const int lane = C.lane, r32 = lane & 31, hf = lane >> 5;
    const int ql = 2 * (r32 >> 4) + ((r32 >> 2) & 1), hd = 4 * ((r32 >> 3) & 1) + (r32 & 3);
    constexpr int CAND_CAP = 120, QU = 16;
    for (int u = blockIdx.x; u < NTOK / QU; u += C.G) {
        const int b = u & 7, j = (u >> 3) & 31, i = u >> 8; const int pi = i >> 1; const int blk = (i & 1) ? (255 - (j + 32 * pi)) : (j + 32 * pi);
        const int t0 = blk * QU; const size_t mb = (size_t)b * T;
        const int nkt = (t0 + QU + 31) >> 5;
        bf16x8 af[4][4];
#pragma unroll
        for (int a = 0; a < 4; ++a) {
            const bf16* qp = H + (mb + t0 + 4 * a + ql) * D_INP + C_IQ + hd * 64 + 8 * hf;
#pragma unroll
            for (int k = 0; k < 4; ++k) af[a][k] = *(const GAS bf16x8*)(qp + 16 * k);
        }
        if (C.tid < 128) { const int q = C.tid >> 3, h8 = C.tid & 7; W16[C.tid] = bf2f(H[(mb + t0 + q) * D_INP + C_IW + h8]) * (0.125f * 0.35355339059327373f); }
        __syncthreads();
        {
            int kt = C.wave; bf16x8 bk[4], bn[4];
            if (kt < nkt) { const bf16* kp = IKN + (mb + kt * 32 + r32) * 64 + 8 * hf;
#pragma unroll
                for (int k = 0; k < 4; ++k) bk[k] = *(const GAS bf16x8*)(kp + 16 * k); }
            for (; kt < nkt; kt += NWAVES) {
                const int s0 = kt * 32;
                if (kt + NWAVES < nkt) { const bf16* kp = IKN + (mb + s0 + 32 * NWAVES + r32) * 64 + 8 * hf;
#pragma unroll
                    for (int k = 0; k < 4; ++k) bn[k] = *(const GAS bf16x8*)(kp + 16 * k); }
#pragma unroll
                for (int a = 0; a < 4; ++a) {
                    f32x16 acc = {0.f, 0.f, 0.f, 0.f, 0.f, 0.f, 0.f, 0.f, 0.f, 0.f, 0.f, 0.f, 0.f, 0.f, 0.f, 0.f};
#pragma unroll
                    for (int k = 0; k < 4; ++k) acc = __builtin_amdgcn_mfma_f32_32x32x16_bf16(af[a][k], bk[k], acc, 0, 0, 0);
#pragma unroll
                    for (int qh = 0; qh < 2; ++qh) { float sa = 0.f, sb = 0.f;
                        const int q = 4 * a + 2 * qh + hf, key = s0 + r32;
                        const f32x4 wl = *(const LAS f32x4*)(W16 + q * 8), wh = *(const LAS f32x4*)(W16 + q * 8 + 4);
                        sa = fmaf(wl[0], relu_i(acc[8 * qh + 0]), sa); sb = fmaf(wl[1], relu_i(acc[8 * qh + 1]), sb); sa = fmaf(wl[2], relu_i(acc[8 * qh + 2]), sa); sb = fmaf(wl[3], relu_i(acc[8 * qh + 3]), sb);
                        sa = fmaf(wh[0], relu_i(acc[8 * qh + 4]), sa); sb = fmaf(wh[1], relu_i(acc[8 * qh + 5]), sb); sa = fmaf(wh[2], relu_i(acc[8 * qh + 6]), sa); sb = fmaf(wh[3], relu_i(acc[8 * qh + 7]), sb);
                        float sv = sa + sb; const bool valid = key <= t0 + q; sv += 0.0f;
                        ISC[q * 4096 + key] = valid ? (h16)sv : (h16)(-INFINITY);
                    }
                }
#pragma unroll
                for (int k = 0; k < 4; ++k) bk[k] = bn[k];
            }
        }
        __syncthreads();
        for (int q = C.wave; q < QU; q += NWAVES) {
            const int t = t0 + q, n = t + 1; const LAS unsigned short* row = (const LAS unsigned short*)(ISC + q * 4096);
            unsigned* mrow = MASK + (mb + t) * 128;
            if (n <= TOPK) {
#pragma unroll
                for (int w2 = 0; w2 < 2; ++w2) { const int wi = lane + 64 * w2; const int lo = 32 * wi; unsigned bits;
                    if (lo + 31 <= t) bits = 0xffffffffu; else if (lo > t) bits = 0u; else bits = (1u << (t - lo + 1)) - 1u;
                    mrow[wi] = bits; }
            } else {
                unsigned dhi = 0u; int need = TOPK;
#pragma unroll
                for (int pass = 1; pass >= 0; --pass) {
                    LDS_WAIT();
#pragma unroll
                    for (int z = 0; z < 4; ++z) HIST[lane + 64 * z] = 0u;
#pragma unroll 2
                    for (int e0 = 8 * lane; e0 < n; e0 += 512) { const v4u v = *(const LAS v4u*)(row + e0);
#pragma unroll
                        for (int jj = 0; jj < 8; ++jj) { const unsigned w = (jj < 2) ? v.x : (jj < 4) ? v.y : (jj < 6) ? v.z : v.w; const unsigned hb = (jj & 1) ? (w >> 16) : (w & 0xffffu);
                            const unsigned key = h2ord(hb);
                            const bool ok = (e0 + jj < n) && (pass == 1 || (key >> 8) == dhi);
                            if (ok) atomicAdd((unsigned*)&HIST[pass == 1 ? (key >> 8) : (key & 255u)], 1u); } }
                    LDS_WAIT();
                    const v4u c4 = *(const LAS v4u*)(HIST + 4 * lane);
                    const unsigned c0 = c4.x, c1 = c4.y, c2 = c4.z, c3 = c4.w; const unsigned s4 = c0 + c1 + c2 + c3;
                    unsigned suf = s4;
#pragma unroll
                    for (int o = 1; o < 64; o <<= 1) { const unsigned v2 = __shfl_down(suf, o); if (lane + o < 64) suf += v2; }
                    unsigned cum = suf - s4; int dsel = -1; int nnew = 0; const unsigned nd = (unsigned)need;
                    if (cum < nd && nd <= cum + c3) { dsel = 4 * lane + 3; nnew = (int)(nd - cum); } cum += c3;
                    if (dsel < 0 && cum < nd && nd <= cum + c2) { dsel = 4 * lane + 2; nnew = (int)(nd - cum); } cum += c2;
                    if (dsel < 0 && cum < nd && nd <= cum + c1) { dsel = 4 * lane + 1; nnew = (int)(nd - cum); } cum += c1;
                    if (dsel < 0 && cum < nd && nd <= cum + c0) { dsel = 4 * lane + 0; nnew = (int)(nd - cum); }
                    const unsigned long long bal = __ballot(dsel >= 0);
                    const int src = (bal != 0ull) ? (int)__builtin_ctzll(bal) : 0;
                    const int dd = __shfl(dsel, src); need = __shfl(nnew, src);
                    if (pass == 1) dhi = (unsigned)dd; else dhi = (dhi << 8) | (unsigned)dd;
                }
                const unsigned Tk = dhi;
                int run_eq = 0; unsigned long long mine = 0ull; const int nit = (t >> 6) + 1;
#pragma unroll 4
                for (int it = 0; it < nit; ++it) { const int e = it * 64 + lane; const unsigned key = h2ord(row[e]); const bool valid = e <= t;
                    const bool eq = valid && (key == Tk); const unsigned long long beq = __ballot(eq);
                    const int rk = run_eq + __builtin_popcountll(beq & ((1ull << lane) - 1ull));
                    const bool sel = valid && ((key > Tk) || (eq && rk < need)); run_eq += __builtin_popcountll(beq);
                    const unsigned long long bs = __ballot(sel);
                    if (lane == it) mine = bs; }
                *(GAS v2u*)(mrow + 2 * lane) = (v2u){(unsigned)mine, (unsigned)(mine >> 32)};
            }
        }
        __syncthreads();
    }
}

__device__ __forceinline__ void attn_task(const bf16* H, const bf16* KH, const bf16* VT, const unsigned* MASK, bf16* YM, int b, int hh, int t0, int lane) {
    const int r32 = lane & 31, hf = lane >> 5;
    const float LOG2E = 1.4426950408889634f; const float c1 = 0.125f * LOG2E; const float sl2 = exp2f(-(float)(hh + 1)) * LOG2E;
    const size_t mb = (size_t)b * T;
    bf16x8 qf[4];
#pragma unroll
    for (int k = 0; k < 4; ++k) qf[k] = *(const GAS bf16x8*)(H + (mb + t0 + r32) * D_INP + C_AQ + hh * 64 + 16 * k + 8 * hf);
    const bf16* kbase = KH + ((size_t)(b * 8 + hh) * T) * 64; const bf16* vbase = VT + ((size_t)(b * 512 + hh * 64)) * T; const unsigned* mrow = MASK + (mb + t0 + r32) * 128;
    float m_run = -1e30f, l = 0.f;
    f32x16 O0 = {0.f, 0.f, 0.f, 0.f, 0.f, 0.f, 0.f, 0.f, 0.f, 0.f, 0.f, 0.f, 0.f, 0.f, 0.f, 0.f}, O1 = O0;
    const int nkt = (t0 + 32 + 63) >> 6;
    for (int kt = 0; kt < nkt; ++kt) {
        const int s0 = kt * 64;
        bf16x8 kf[2][4];
#pragma unroll
        for (int uu = 0; uu < 2; ++uu)
#pragma unroll
            for (int k = 0; k < 4; ++k) kf[uu][k] = *(const GAS bf16x8*)(kbase + (size_t)(s0 + 32 * uu + r32) * 64 + 16 * k + 8 * hf);
        const v2u mw = *(const GAS v2u*)(mrow + 2 * kt);
        s16x4 vl[2][2][2], vh[2][2][2];
#pragma unroll
        for (int uu = 0; uu < 2; ++uu)
#pragma unroll
            for (int sp = 0; sp < 2; ++sp)
#pragma unroll
                for (int dt = 0; dt < 2; ++dt) { const bf16* vp = vbase + (size_t)(dt * 32 + r32) * T + s0 + 32 * uu + 16 * sp + 4 * hf;
                    vl[uu][sp][dt] = *(const GAS s16x4*)vp; vh[uu][sp][dt] = *(const GAS s16x4*)(vp + 8); }
        f32x16 a0 = {0.f, 0.f, 0.f, 0.f, 0.f, 0.f, 0.f, 0.f, 0.f, 0.f, 0.f, 0.f, 0.f, 0.f, 0.f, 0.f}, a1 = a0;
#pragma unroll
        for (int k = 0; k < 4; ++k) { a0 = __builtin_amdgcn_mfma_f32_32x32x16_bf16(kf[0][k], qf[k], a0, 0, 0, 0); a1 = __builtin_amdgcn_mfma_f32_32x32x16_bf16(kf[1][k], qf[k], a1, 0, 0, 0); }
        const float dist0 = (float)(t0 + r32 - s0 - 4 * hf);
        const unsigned m0 = mw.x >> (4 * hf), m1 = mw.y >> (4 * hf);
        float mx = -1e30f;
#pragma unroll
        for (int r = 0; r < 16; ++r) { const int ko = (r & 3) + 8 * (r >> 2);
            const float d0 = dist0 - (float)ko;
            a0[r] = ((m0 >> ko) & 1u) ? (a0[r] * c1 - sl2 * d0) : -1e30f;
            a1[r] = ((m1 >> ko) & 1u) ? (a1[r] * c1 - sl2 * (d0 - 32.f)) : -1e30f;
            mx = fmaxf(mx, fmaxf(a0[r], a1[r])); }
        mx = fmaxf(mx, __shfl_xor(mx, 32));
        const float m_new = fmaxf(m_run, mx); const float alpha = __builtin_amdgcn_exp2f(m_run - m_new); m_run = m_new;
        float ps = 0.f;
#pragma unroll
        for (int r = 0; r < 16; ++r) { const int ko = (r & 3) + 8 * (r >> 2);
            const float p0 = ((m0 >> ko) & 1u) ? __builtin_amdgcn_exp2f(a0[r] - m_new) : 0.f;
            const float p1 = ((m1 >> ko) & 1u) ? __builtin_amdgcn_exp2f(a1[r] - m_new) : 0.f;
            a0[r] = p0; a1[r] = p1; ps += p0 + p1; }
        l = l * alpha + ps;
#pragma unroll
        for (int r = 0; r < 16; ++r) { O0[r] *= alpha; O1[r] *= alpha; }
#pragma unroll
        for (int sp = 0; sp < 2; ++sp) {
            const bf16x8 pb0 = pack8(a0, 8 * sp), pb1 = pack8(a1, 8 * sp);
#define VFR(uu, dt) ((bf16x8){vl[uu][sp][dt][0], vl[uu][sp][dt][1], vl[uu][sp][dt][2], vl[uu][sp][dt][3], vh[uu][sp][dt][0], vh[uu][sp][dt][1], vh[uu][sp][dt][2], vh[uu][sp][dt][3]})
            O0 = __builtin_amdgcn_mfma_f32_32x32x16_bf16(VFR(0, 0), pb0, O0, 0, 0, 0);
            O1 = __builtin_amdgcn_mfma_f32_32x32x16_bf16(VFR(0, 1), pb0, O1, 0, 0, 0);
            O0 = __builtin_amdgcn_mfma_f32_32x32x16_bf16(VFR(1, 0), pb1, O0, 0, 0, 0);
            O1 = __builtin_amdgcn_mfma_f32_32x32x16_bf16(VFR(1, 1), pb1, O1, 0, 0, 0);
#undef VFR
        }
    }
    l += __shfl_xor(l, 32);
    const float inv = 1.f / l;
    bf16* yp = YM + (mb + t0 + r32) * D + hh * 64 + 4 * hf;
#pragma unroll
    for (int rq = 0; rq < 4; ++rq) {
        v2u o; o.x = cvtpk(O0[4 * rq] * inv, O0[4 * rq + 1] * inv); o.y = cvtpk(O0[4 * rq + 2] * inv, O0[4 * rq + 3] * inv); *(GAS v2u*)(yp + 8 * rq) = o;
        v2u o2; o2.x = cvtpk(O1[4 * rq] * inv, O1[4 * rq + 1] * inv); o2.y = cvtpk(O1[4 * rq + 2] * inv, O1[4 * rq + 3] * inv); *(GAS v2u*)(yp + 32 + 8 * rq) = o2; }
}
__device__ __forceinline__ void p4_attention(const Params& P, const Ctx& C) {
    unsigned char* ws = P.ws;
    const bf16* H = (const bf16*)(ws + WS_H); const bf16* KH = (const bf16*)(ws + WS_K); const bf16* VT = (const bf16*)(ws + WS_VT); const unsigned* MASK = (const unsigned*)(ws + WS_MASK); bf16* YM = (bf16*)(ws + WS_YMIX);
    for (int p = blockIdx.x; p < 512; p += C.G) {
        const int bh = p >> 3, j = p & 7; const int b = bh >> 3, hh = bh & 7;
        attn_task(H, KH, VT, MASK, YM, b, hh, j * 256 + C.wave * 32, C.lane);
        attn_task(H, KH, VT, MASK, YM, b, hh, (15 - j) * 256 + (7 - C.wave) * 32, C.lane);
    }
}

constexpr int AT_KB = 64 * 144, AT_VB = 64 * 136, AT_VOFF = 2 * AT_KB;
__device__ __forceinline__ void attn_block(const Ctx& C, const bf16* H, const bf16* KH, const bf16* VT, const unsigned* MASK, bf16* YM, int b, int hh, int qb) {
    const int lane = C.lane, r32 = lane & 31, hf = lane >> 5, tid = C.tid;
    const float LOG2E = 1.4426950408889634f; const float c1 = 0.125f * LOG2E; const float sl2 = exp2f(-(float)(hh + 1)) * LOG2E;
    const size_t mb = (size_t)b * T; const int t0 = qb * 256 + C.wave * 32;
    bf16x8 qf[4];
#pragma unroll
    for (int k = 0; k < 4; ++k) { const v4u w = *(const GAS v4u*)(H + (mb + t0 + r32) * D_INP + C_AQ + hh * 64 + 16 * k + 8 * hf);
        v4u o; o.x = cvtpk(bflo(w.x) * c1, bfhi(w.x) * c1); o.y = cvtpk(bflo(w.y) * c1, bfhi(w.y) * c1); o.z = cvtpk(bflo(w.z) * c1, bfhi(w.z) * c1); o.w = cvtpk(bflo(w.w) * c1, bfhi(w.w) * c1);
        qf[k] = __builtin_bit_cast(bf16x8, o); }
    const bf16* kbase = KH + ((size_t)(b * 8 + hh) * T) * 64; const bf16* vbase = VT + ((size_t)(b * 512 + hh * 64)) * T; const unsigned* mrow = MASK + (mb + t0 + r32) * 128;
    const int srow = tid >> 3, sch = tid & 7;
    const bf16* kst = kbase + (size_t)srow * 64 + 8 * sch; const bf16* vst = vbase + (size_t)srow * T + 8 * sch;
    LAS unsigned char* kw = C.lds + srow * 144 + 16 * sch; LAS unsigned char* vw = C.lds + AT_VOFF + srow * 136 + 16 * sch;
    const LAS unsigned char* kr = C.lds + r32 * 144 + 16 * hf; const LAS unsigned char* vr = C.lds + AT_VOFF + r32 * 136 + 8 * hf;
    float m_run = -1e30f, l = 0.f;
    f32x16 O0 = {0.f, 0.f, 0.f, 0.f, 0.f, 0.f, 0.f, 0.f, 0.f, 0.f, 0.f, 0.f, 0.f, 0.f, 0.f, 0.f}, O1 = O0;
    const int nkt = 4 * (qb + 1), ktw = (t0 + 31) >> 6;
    v4u kn = *(const GAS v4u*)kst, vn = *(const GAS v4u*)vst; v2u mwn = *(const GAS v2u*)mrow;
    *(LAS v4u*)kw = kn; *(LAS v2u*)vw = (v2u){vn.x, vn.y}; *(LAS v2u*)(vw + 8) = (v2u){vn.z, vn.w};
    __syncthreads();
    for (int kt = 0; kt < nkt; ++kt) {
        const int s0 = kt * 64; const int cur = kt & 1; const v2u mw = mwn;
        if (kt + 1 < nkt) { kn = *(const GAS v4u*)(kst + (size_t)(s0 + 64) * 64); vn = *(const GAS v4u*)(vst + s0 + 64); mwn = *(const GAS v2u*)(mrow + 2 * kt + 2); }
        if (kt <= ktw) {
            const LAS unsigned char* kc = kr + cur * AT_KB; const LAS unsigned char* vc = vr + cur * AT_VB;
            const float B0 = -sl2 * (float)(t0 + r32 - s0 - 4 * hf);
            f32x16 a0, a1;
#pragma unroll
            for (int r = 0; r < 16; ++r) { const float ko = (float)((r & 3) + 8 * (r >> 2)); a0[r] = B0 + sl2 * ko; a1[r] = B0 + sl2 * (ko + 32.f); }
#pragma unroll
            for (int k = 0; k < 4; ++k) { const bf16x8 k0 = *(const LAS bf16x8*)(kc + 32 * k), k1 = *(const LAS bf16x8*)(kc + 32 * 144 + 32 * k);
                a0 = __builtin_amdgcn_mfma_f32_32x32x16_bf16(k0, qf[k], a0, 0, 0, 0); a1 = __builtin_amdgcn_mfma_f32_32x32x16_bf16(k1, qf[k], a1, 0, 0, 0); }
            const unsigned m0 = mw.x >> (4 * hf), m1 = mw.y >> (4 * hf);
            float mx = -1e30f;
#pragma unroll
            for (int r = 0; r < 16; ++r) { const int ko = (r & 3) + 8 * (r >> 2);
                a0[r] = (m0 & (1u << ko)) ? a0[r] : -1e30f; a1[r] = (m1 & (1u << ko)) ? a1[r] : -1e30f;
                mx = fmaxf(mx, fmaxf(a0[r], a1[r])); }
            mx = fmaxf(mx, __shfl_xor(mx, 32));
            const float m_new = fmaxf(m_run, mx); const float alpha = __builtin_amdgcn_exp2f(m_run - m_new); m_run = m_new;
            float ps = 0.f;
#pragma unroll
            for (int r = 0; r < 16; ++r) { const int ko = (r & 3) + 8 * (r >> 2);
                const float p0 = (m0 & (1u << ko)) ? __builtin_amdgcn_exp2f(a0[r] - m_new) : 0.f;
                const float p1 = (m1 & (1u << ko)) ? __builtin_amdgcn_exp2f(a1[r] - m_new) : 0.f;
                a0[r] = p0; a1[r] = p1; ps += p0 + p1; }
            l = l * alpha + ps;
#pragma unroll
            for (int r = 0; r < 16; ++r) { O0[r] *= alpha; O1[r] *= alpha; }
#pragma unroll
            for (int sp = 0; sp < 2; ++sp) {
                const bf16x8 pb0 = pack8(a0, 8 * sp), pb1 = pack8(a1, 8 * sp);
#define VLD(uu, dt) ({ const s16x4 lo_ = *(const LAS s16x4*)(vc + (dt) * 32 * 136 + 2 * (32 * (uu) + 16 * sp)), hi_ = *(const LAS s16x4*)(vc + (dt) * 32 * 136 + 2 * (32 * (uu) + 16 * sp + 8)); (bf16x8){lo_[0], lo_[1], lo_[2], lo_[3], hi_[0], hi_[1], hi_[2], hi_[3]}; })
                O0 = __builtin_amdgcn_mfma_f32_32x32x16_bf16(VLD(0, 0), pb0, O0, 0, 0, 0);
                O1 = __builtin_amdgcn_mfma_f32_32x32x16_bf16(VLD(0, 1), pb0, O1, 0, 0, 0);
                O0 = __builtin_amdgcn_mfma_f32_32x32x16_bf16(VLD(1, 0), pb1, O0, 0, 0, 0);
                O1 = __builtin_amdgcn_mfma_f32_32x32x16_bf16(VLD(1, 1), pb1, O1, 0, 0, 0);
#undef VLD
            }
        }
        if (kt + 1 < nkt) { const int nx = cur ^ 1; *(LAS v4u*)(kw + nx * AT_KB) = kn; *(LAS v2u*)(vw + nx * AT_VB) = (v2u){vn.x, vn.y}; *(LAS v2u*)(vw + nx * AT_VB + 8) = (v2u){vn.z, vn.w}; }
        __syncthreads();
    }
    l += __shfl_xor(l, 32);
    const float inv = 1.f / l;
    bf16* yp = YM + (mb + t0 + r32) * D + hh * 64 + 4 * hf;
#pragma unroll
    for (int rq = 0; rq < 4; ++rq) {
        v2u o; o.x = cvtpk(O0[4 * rq] * inv, O0[4 * rq + 1] * inv); o.y = cvtpk(O0[4 * rq + 2] * inv, O0[4 * rq + 3] * inv); *(GAS v2u*)(yp + 8 * rq) = o;
        v2u o2; o2.x = cvtpk(O1[4 * rq] * inv, O1[4 * rq + 1] * inv); o2.y = cvtpk(O1[4 * rq + 2] * inv, O1[4 * rq + 3] * inv); *(GAS v2u*)(yp + 32 + 8 * rq) = o2; }
}
__device__ __forceinline__ void p4_attention2(const Params& P, const Ctx& C) {
    unsigned char* ws = P.ws;
    const bf16* H = (const bf16*)(ws + WS_H); const bf16* KH = (const bf16*)(ws + WS_K); const bf16* VT = (const bf16*)(ws + WS_VT); const unsigned* MASK = (const unsigned*)(ws + WS_MASK); bf16* YM = (bf16*)(ws + WS_YMIX);
    for (int p = blockIdx.x; p < 512; p += C.G) {
        const int b = p & 7, q = p >> 3; const int hh = q >> 3, j = q & 7;
        attn_block(C, H, KH, VT, MASK, YM, b, hh, j);
        attn_block(C, H, KH, VT, MASK, YM, b, hh, 15 - j);
    }
}

#ifndef FEAT_MIX
#define FEAT_MIX 1
#endif
#ifndef FEAT_MOE
#define FEAT_MOE 1
#endif
#ifndef FEAT_PLE
#define FEAT_PLE 1
#endif
#ifndef FEAT_ATT
#define FEAT_ATT 1
#endif

__device__ __forceinline__ void p6_ln1_router(const Params& P, const Ctx& C) {
    unsigned char* ws = P.ws;
    float* X1 = (float*)(ws + WS_X1); bf16* XB = (bf16*)(ws + WS_XB);
    LAS float* wl = (LAS float*)C.lds;
    LAS int* hist = (LAS int*)(C.lds + MISC_OFF);
#if FEAT_MOE
    { const float* wr = P.in[I_WR];
      for (int i = C.tid; i < 32 * 1024; i += NTHR) { const int e = i >> 10, k = i & 1023; wl[i] = wr[k * 32 + e]; }
      if (C.tid < 32) hist[C.tid] = 0; }
    __syncthreads();
    int* tope = (int*)(ws + WS_TOPE); float* gate = (float*)(ws + WS_GATE); int* lrank = (int*)(ws + WS_LRANK);
    const float* br = P.in[I_BR];
#endif
#if FEAT_MIX
    const float* src = P.out; const float sc = 1.0f;
#else
    const float* src = P.in[I_X]; const float sc = ALPHA;
#endif
    for (int m = C.gw; m < NTOK; m += C.ngw) {
        f32x4 v[4]; load_row_f32(v, src + (size_t)m * D, C.lane);
#pragma unroll
        for (int j = 0; j < 4; ++j) v[j] = v[j] * sc;
        ln_row(v, P.in[I_LNMG], P.in[I_LNMB], C.lane);
        store_row_f32(X1 + (size_t)m * D, v, C.lane);
        store_row_bf16(XB + (size_t)m * D, v, C.lane);
#if FEAT_MOE
        float lv[32];
#pragma unroll
        for (int e = 0; e < 32; ++e) { float a = 0.f;
#pragma unroll
            for (int j = 0; j < 4; ++j) { const f32x4 w = *(const LAS f32x4*)(wl + e * 1024 + 4 * C.lane + 256 * j); a += (v[j][0] * w[0] + v[j][1] * w[1]) + (v[j][2] * w[2] + v[j][3] * w[3]); }
            lv[e] = wave_sum(a) + br[e]; }
        int se[4]; float sv[4];
#pragma unroll
        for (int k = 0; k < 4; ++k) { float best = -INFINITY; int bi = 0;
#pragma unroll
            for (int e = 0; e < 32; ++e) if (lv[e] > best) { best = lv[e]; bi = e; }
            se[k] = bi; sv[k] = best;
#pragma unroll
            for (int e = 0; e < 32; ++e) lv[e] = (e == bi) ? -INFINITY : lv[e]; }
        float ex[4], sum = 0.f;
#pragma unroll
        for (int k = 0; k < 4; ++k) { ex[k] = __expf(sv[k] - sv[0]); sum += ex[k]; }
        const float inv = 1.f / sum;
        if (C.lane == 0) {
#pragma unroll
            for (int k = 0; k < 4; ++k) { const int lr = atomicAdd((int*)&hist[se[k]], 1); tope[m * 4 + k] = se[k]; gate[m * 4 + k] = ex[k] * inv; lrank[m * 4 + k] = lr; } }
#endif
    }
#if FEAT_MOE
    __syncthreads();
    if (C.tid < 32) { unsigned* cnt = (unsigned*)(ws + WS_CTL) + CW_CNT; const int base = (int)atomicAdd(cnt + C.tid, (unsigned)hist[C.tid]); ((int*)(ws + WS_WGBASE))[blockIdx.x * 32 + C.tid] = base; }
#endif
}

__device__ __forceinline__ void p7_dispatch(const Params& P, const Ctx& C) {
    unsigned char* ws = P.ws;
    LAS int* ps = (LAS int*)(C.lds + MISC_OFF + 256);
    const unsigned* cnt = (const unsigned*)(ws + WS_CTL) + CW_CNT;
    int* tile_e = (int*)(ws + WS_TILEE);
    if (C.tid == 0) { int run = 0;
        for (int e = 0; e < NE; ++e) { const int c = (int)__hip_atomic_load(cnt + e, __ATOMIC_RELAXED, __HIP_MEMORY_SCOPE_AGENT); ps[e] = run; const int nt = (c + 255) >> 8;
            if (blockIdx.x == 0) for (int t = 0; t < nt; ++t) tile_e[(run >> 8) + t] = e;
            run += nt << 8; }
        if (blockIdx.x == 0) tile_e[MAXTILES] = run >> 8; }
    __syncthreads();
    const int* tope = (const int*)(ws + WS_TOPE); const float* gate = (const float*)(ws + WS_GATE); const int* lrank = (const int*)(ws + WS_LRANK);
    const int* wgb = (const int*)(ws + WS_WGBASE);
    int* tokslot = (int*)(ws + WS_TOKSLOT); float* slotgate = (float*)(ws + WS_SLOTGATE);
    const bf16* XB = (const bf16*)(ws + WS_XB); unsigned char* xs = ws + WS_XS;
    for (int m = C.gw; m < NTOK; m += C.ngw) {
        const int wgm = (m % C.ngw) >> 3;
        const v4u r0 = *(const GAS v4u*)(XB + (size_t)m * D + 16 * C.lane), r1 = *(const GAS v4u*)(XB + (size_t)m * D + 16 * C.lane + 8);
        v4u f8;
        f8.x = pk4_fp8(bflo(r0.x) * 8.f, bfhi(r0.x) * 8.f, bflo(r0.y) * 8.f, bfhi(r0.y) * 8.f); f8.y = pk4_fp8(bflo(r0.z) * 8.f, bfhi(r0.z) * 8.f, bflo(r0.w) * 8.f, bfhi(r0.w) * 8.f);
        f8.z = pk4_fp8(bflo(r1.x) * 8.f, bfhi(r1.x) * 8.f, bflo(r1.y) * 8.f, bfhi(r1.y) * 8.f); f8.w = pk4_fp8(bflo(r1.z) * 8.f, bfhi(r1.z) * 8.f, bflo(r1.w) * 8.f, bfhi(r1.w) * 8.f);
#pragma unroll
        for (int k = 0; k < 4; ++k) { const int e = tope[m * 4 + k]; const int slot = ps[e] + wgb[wgm * 32 + e] + lrank[m * 4 + k];
            *(GAS v4u*)(xs + (size_t)slot * D + 16 * C.lane) = f8;
            if (C.lane == 0) { slotgate[slot] = gate[m * 4 + k]; tokslot[m * 4 + k] = slot; } }
    }
}

__device__ __forceinline__ void p10_combine_ln2(const Params& P, const Ctx& C) {
    unsigned char* ws = P.ws;
    float* X1 = (float*)(ws + WS_X1); bf16* XB = (bf16*)(ws + WS_XB);
    const int* tokslot = (const int*)(ws + WS_TOKSLOT); const bf16* ys = (const bf16*)(ws + WS_YSLOT);
    for (int m = C.gw; m < NTOK; m += C.ngw) {
        f32x4 v[4]; load_row_f32(v, X1 + (size_t)m * D, C.lane);
#pragma unroll
        for (int j = 0; j < 4; ++j) v[j] = v[j] * ALPHA;
#if FEAT_MOE
#pragma unroll
        for (int k = 0; k < 4; ++k) { const int slot = tokslot[m * 4 + k]; const bf16* yr = ys + (size_t)slot * D;
#pragma unroll
            for (int j = 0; j < 4; ++j) { const v2u w = *(const GAS v2u*)(yr + 4 * C.lane + 256 * j); v[j][0] += bflo(w.x); v[j][1] += bfhi(w.x); v[j][2] += bflo(w.y); v[j][3] += bfhi(w.y); } }
#endif
        ln_row(v, P.in[I_LNFG], P.in[I_LNFB], C.lane);
        store_row_f32(P.out + (size_t)m * D, v, C.lane);
        store_row_bf16(XB + (size_t)m * D, v, C.lane);
    }
}

__device__ __forceinline__ void p12_final_ln(const Params& P, const Ctx& C) {
#if FEAT_PLE
    const float* src = (const float*)(P.ws + WS_X1); const float sc = 1.0f;
#else
    const float* src = P.out; const float sc = ALPHA;
#endif
    for (int m = C.gw; m < NTOK; m += C.ngw) {
        f32x4 v[4]; load_row_f32(v, src + (size_t)m * D, C.lane);
#pragma unroll
        for (int j = 0; j < 4; ++j) v[j] = v[j] * sc;
        ln_row(v, P.in[I_LNPG], P.in[I_LNPB], C.lane);
        store_row_f32(P.out + (size_t)m * D, v, C.lane);
    }
}
#define XB_TMO      128
#define XB_XCNT(j)  (256  + 64 * (j))
#define XB_XSUB(j)  (1280 + 64 * (j))
#define XB_XGEN(j)  (2304 + 64 * (j))
#define XB_TOP      3328
#define XB_TOPGEN   3392
#define XCD_BAR_WORDS 3456
#define XB_SPIN_CAP (1u << 18)
#define LAS __attribute__((address_space(3)))

__device__ __forceinline__ unsigned xb_ld(unsigned* p)              { return __hip_atomic_load(p, __ATOMIC_RELAXED, __HIP_MEMORY_SCOPE_AGENT); }
__device__ __forceinline__ unsigned xb_add(unsigned* p, unsigned v) { return __hip_atomic_fetch_add(p, v, __ATOMIC_RELAXED, __HIP_MEMORY_SCOPE_AGENT); }
__device__ __forceinline__ unsigned xb_xcc_id() { return (unsigned)__builtin_amdgcn_s_getreg((3 << 11) | 20) & 0xFu; }
#define XB_SPIN(cond, bar) do { unsigned _sp = 0; while (cond) { __builtin_amdgcn_s_sleep(1); \
    if ((++_sp & 255u) == 0u) { if (xb_ld(&(bar)[XB_TMO])) break; if (_sp > XB_SPIN_CAP) { atomicAdd(&(bar)[XB_TMO], 1u); break; } } } } while (0)

struct XcdBarrier {
    unsigned* bar; unsigned x;
    volatile LAS unsigned* st;
};

__device__ __forceinline__ XcdBarrier xcd_barrier_post(unsigned* bar, volatile LAS unsigned* st) {
    XcdBarrier b; b.bar = bar; b.x = xb_xcc_id(); b.st = st;
    if (threadIdx.x == 0) (void)xb_add(&bar[XB_XCNT(b.x)], 1u);
    return b;
}
__device__ __forceinline__ void xcd_barrier_complete(unsigned* bar, unsigned x, unsigned& nloc, unsigned& nx) {
    const unsigned G = gridDim.x * gridDim.y * gridDim.z;
    unsigned sum, cnt, mine, sp = 0u;
    for (;;) {
        sum = 0u; cnt = 0u; mine = 0u;
#pragma unroll
        for (unsigned j = 0; j < 16; ++j) { const unsigned c = xb_ld(&bar[XB_XCNT(j)]); sum += c; cnt += (c > 0u) ? 1u : 0u; mine = (j == x) ? c : mine; }
        if (sum == G) break;
        __builtin_amdgcn_s_sleep(1);
        if ((++sp & 255u) == 0u) { if (xb_ld(&bar[XB_TMO])) break; if (sp > XB_SPIN_CAP) { atomicAdd(&bar[XB_TMO], 1u); break; } }
    }
    nloc = mine > 0u ? mine : 1u; nx = cnt > 0u ? cnt : 1u;
}

__device__ __forceinline__ void xcd_barrier(const XcdBarrier& b) {
    asm volatile("s_waitcnt vmcnt(0)" ::: "memory");
    __syncthreads();
    if (threadIdx.x == 0) {
        unsigned* bar = b.bar;
        __builtin_amdgcn_s_waitcnt(0);
        unsigned nloc = b.st[0], nx = b.st[1];
        if (nloc == 0u) { xcd_barrier_complete(bar, b.x, nloc, nx); b.st[0] = nloc; b.st[1] = nx; }
        const unsigned old = xb_add(&bar[XB_XSUB(b.x)], 1u);
        const unsigned gen = old / nloc;
        if (old + 1u == (gen + 1u) * nloc) {
            __builtin_amdgcn_fence(__ATOMIC_RELEASE, "agent");
            asm volatile("s_waitcnt vmcnt(0)" ::: "memory");
            const unsigned og = xb_add(&bar[XB_TOP], 1u);
            const unsigned tg = og / nx;
            if (og + 1u == (tg + 1u) * nx) xb_add(&bar[XB_TOPGEN], 1u);
            else XB_SPIN(xb_ld(&bar[XB_TOPGEN]) == tg, bar);
            __builtin_amdgcn_fence(__ATOMIC_ACQUIRE, "agent");
            xb_add(&bar[XB_XGEN(b.x)], 1u);
            asm volatile("s_waitcnt vmcnt(0)" ::: "memory");
        } else {
            XB_SPIN(xb_ld(&bar[XB_XGEN(b.x)]) == gen, bar);
            __builtin_amdgcn_fence(__ATOMIC_ACQUIRE, "agent");
            asm volatile("s_waitcnt vmcnt(0)" ::: "memory");
        }
    }
    __syncthreads();
}


template <int PH> __device__ __forceinline__ void run_phase(const Params& P, const Ctx& C) {
    unsigned char* ws = P.ws;
    typedef pg8::bf16_t pbf;
    if constexpr (PH == 0) { p0_prologue(P, C); }
    else if constexpr (PH == 10) {
        pg8::Gemm g{(const pbf*)(ws + WS_XBF), (const pbf*)(ws + WS_WIN_T), NTOK, D_INP, D}; pg8::StaticOrder S; S.init(NTOK, D_INP, C.G, (int)blockIdx.x);
        pg8::EpiBf16s E{(pbf*)(ws + WS_H), D_INP};
        pg8::gemm_phase<pg8::EpiBf16s, pg8::StaticOrder, true, true>(C.lds, g, S, E); }
    else if constexpr (PH == 11) {
        pg8::Gemm g{(const pbf*)(ws + WS_PB), (const pbf*)(ws + WS_WPROJ_T), NTOK, D, PLE}; pg8::StaticOrder S; S.init(NTOK, D, C.G, (int)blockIdx.x);
        pg8::EpiBf16s E{(pbf*)(ws + WS_PROJ), D};
        pg8::gemm_phase<pg8::EpiBf16s, pg8::StaticOrder, true, true>(C.lds, g, S, E); }
    else if constexpr (PH == 20) { p2_post(P, C); }
    else if constexpr (PH == 21) { p2_hgrn_prep(P, C); }
    else if constexpr (PH == 30) {
        { pg8::Gemm g{(const pbf*)(ws + WS_CN), (const pbf*)(ws + WS_WUK_T), NTOK, 512, 256}; pg8::StaticOrder S; S.init(NTOK, 512, C.G, (int)blockIdx.x);
          pg8::EpiKhead E{(pbf*)(ws + WS_K)};
          pg8::gemm_phase<pg8::EpiKhead, pg8::StaticOrder, true, true>(C.lds, g, S, E); }
        { pg8::Gemm g{(const pbf*)(ws + WS_WUV_T), (const pbf*)(ws + WS_CN), 512, NTOK, 256}; pg8::StaticOrder S; S.init(512, NTOK, C.G, (int)blockIdx.x);
          pg8::EpiVt E{(pbf*)(ws + WS_VT)};
          pg8::gemm_phase<pg8::EpiVt, pg8::StaticOrder, true, true>(C.lds, g, S, E); }
    }
    else if constexpr (PH == 31) { p3_indexer(P, C); }
    else if constexpr (PH == 32) { p3_hgrn_scan(P, C); }
    else if constexpr (PH == 40) { p4_attention2(P, C); }
    else if constexpr (PH == 41) { p4_yrec(P, C); }
    else if constexpr (PH == 5) {
        pg8::Gemm g{(const pbf*)(ws + WS_YMIX), (const pbf*)(ws + WS_WO_T), NTOK, D, D}; pg8::StaticOrder S; S.init(NTOK, D, C.G, (int)blockIdx.x);
        pg8::EpiResid E{P.in[I_X], P.out, D, ALPHA};
        pg8::gemm_phase<pg8::EpiResid, pg8::StaticOrder, true, true>(C.lds, g, S, E);
    }
    else if constexpr (PH == 6) { p6_ln1_router(P, C); }
    else if constexpr (PH == 7) { p7_dispatch(P, C); }
    else if constexpr (PH == 8) {
        const int* tile_e = (const int*)(ws + WS_TILEE);
        pg8::Gemm g{(const pbf*)(ws + WS_XS), (const pbf*)(ws + WS_WUP_T), CAP, NE * 2048, D / 2};
        pg8::MoeOrder S{tile_e, tile_e[MAXTILES], 8, C.G, (int)blockIdx.x};
        pg8::EpiSwiglu E{ws + WS_HH, P.in[I_BUP]};
        pg8::gemm_phase<pg8::EpiSwiglu, pg8::MoeOrder, true, true, 1, 124, 121>(C.lds, g, S, E);
    }
    else if constexpr (PH == 9) {
        const int* tile_e = (const int*)(ws + WS_TILEE);
        pg8::Gemm g{(const pbf*)(ws + WS_HH), (const pbf*)(ws + WS_WDN_T), CAP, NE * 1024, DFF / 2};
        pg8::MoeOrder S{tile_e, tile_e[MAXTILES], 4, C.G, (int)blockIdx.x};
        pg8::EpiDown E{(pbf*)(ws + WS_YSLOT), P.in[I_BDN], (const float*)(ws + WS_SLOTGATE)};
        pg8::gemm_phase<pg8::EpiDown, pg8::MoeOrder, true, true, 1, 125, 121>(C.lds, g, S, E);
    }
    else if constexpr (PH == 100) { p10_combine_ln2(P, C); }
    else if constexpr (PH == 110) {
        pg8::Gemm g{(const pbf*)(ws + WS_XB), (const pbf*)(ws + WS_WGATE_T), NTOK, D, D}; pg8::StaticOrder S; S.init(NTOK, D, C.G, (int)blockIdx.x);
        pg8::EpiPle E{P.out, (const pbf*)(ws + WS_PROJ), (float*)(ws + WS_X1), ALPHA};
        pg8::gemm_phase<pg8::EpiPle, pg8::StaticOrder, true, true>(C.lds, g, S, E);
    }
    else { p12_final_ln(P, C); }
}
__global__ void __launch_bounds__(NTHR, 2) mega_fwd(Params P) {
    extern __shared__ __attribute__((aligned(16))) unsigned char lds_raw[];
    cg::grid_group grid = cg::this_grid();
#define MKCTX Ctx C; { int tid_ = threadIdx.x; asm volatile("" : "+v"(tid_)); C.lds = (LAS unsigned char*)lds_raw; C.tid = tid_; C.lane = tid_ & 63; C.wave = __builtin_amdgcn_readfirstlane(tid_ >> 6); \
      C.G = gridDim.x; C.gw = blockIdx.x * NWAVES + C.wave; C.ngw = C.G * NWAVES; }
#if SYNC_MODE != 0
    if (threadIdx.x < 4) ((LAS unsigned*)((LAS unsigned char*)lds_raw + XBW_OFF))[threadIdx.x] = 0u;
    __syncthreads();
    XcdBarrier bar = xcd_barrier_post((unsigned*)(P.ws + WS_CTL) + CW_BAR, (volatile LAS unsigned*)((LAS unsigned char*)lds_raw + XBW_OFF));
#define SY xcd_barrier(bar);
#else
#define SY grid.sync();
#endif
#define GS grid.sync();
#define BS __syncthreads();
#define X(k) { MKCTX run_phase<k>(P, C); }
    PROGRAM
#undef X
#undef MKCTX
#undef SY
#undef GS
#undef BS
}

extern "C" void kernel_launch(void* const* d_in, const int* in_sizes, int n_in, void* d_out, int out_size, void* d_ws, size_t ws_size, hipStream_t stream) {
    static int grid = 0;
    if (grid == 0) {
        if (n_in != 25 || out_size != NTOK * D || ws_size < WS_END) { fprintf(stderr, "kernel_launch: unexpected shapes (n_in %d out %d ws %zu)\n", n_in, out_size, ws_size); grid = -1; return; }
        int dev = 0, cus = 0, per_cu = 0;
        if (hipGetDevice(&dev) != hipSuccess || hipDeviceGetAttribute(&cus, hipDeviceAttributeMultiprocessorCount, dev) != hipSuccess) { grid = -1; return; }
        if (hipFuncSetAttribute((const void*)mega_fwd, hipFuncAttributeMaxDynamicSharedMemorySize, LDS_BYTES) != hipSuccess) { fprintf(stderr, "kernel_launch: hipFuncSetAttribute failed\n"); grid = -1; return; }
        if (hipOccupancyMaxActiveBlocksPerMultiprocessor(&per_cu, (const void*)mega_fwd, NTHR, LDS_BYTES) != hipSuccess || per_cu < 1) { fprintf(stderr, "kernel_launch: occupancy query failed (%d)\n", per_cu); (void)hipGetLastError(); grid = -1; return; }
        grid = cus * per_cu;
        fprintf(stderr, "kernel_launch: grid %d (%d CUs x %d)\n", grid, cus, per_cu);
    }
    if (grid < 0) return;
    (void)hipMemsetAsync((char*)d_ws + WS_CTL, 0, CTL_ZERO_BYTES, stream);
    Params p{};
    for (int i = 0; i < 25; ++i) p.in[i] = (const float*)d_in[i];
    p.out = (float*)d_out; p.ws = (unsigned char*)d_ws;

    void* args[] = {&p};
    hipError_t e = hipLaunchCooperativeKernel((const void*)mega_fwd, dim3(grid), dim3(NTHR), args, LDS_BYTES, stream);
    if (e != hipSuccess) fprintf(stderr, "kernel_launch: cooperative launch failed: %s (grid %d)\n", hipGetErrorString(e), grid);
}
```

```cpp
#define SYNC_MODE 1
#include <hip/hip_runtime.h>
#include <hip/hip_cooperative_groups.h>
#include <cstdio>
#include <cstdint>
namespace cg = cooperative_groups;

namespace pg8 {
#define PG8_LAS __attribute__((address_space(3)))
typedef unsigned short bf16_t;
typedef short bf16x8 __attribute__((ext_vector_type(8)));
typedef float f32x4 __attribute__((ext_vector_type(4)));
typedef unsigned u32x4 __attribute__((ext_vector_type(4)));
typedef int i32x4 __attribute__((ext_vector_type(4)));
typedef int i32x8 __attribute__((ext_vector_type(8)));
constexpr int BM = 256, BK = 64, HALF = 128, HTB = HALF * BK * 2  , STAGE_BYTES = 8 * HTB, NXCD = 8, WGM = 8;

__host__ __device__ __forceinline__ int lds_byte(int r, int c) { const int st = (r >> 4) * 2 + (c >> 5), rr = r & 15, cc = c & 31, ob = rr * 64 + cc * 2; return st * 1024 + (ob ^ (((ob >> 9) & 1) << 5)); }
__host__ __device__ __forceinline__ void stage_rc(int b, int& R, int& C) { const int st = b / 1024, sb = b % 1024, swz = sb ^ (((sb >> 9) & 1) << 5); R = (st >> 1) * 16 + swz / 64; C = (st & 1) * 32 + (swz % 64) / 2; }
__host__ __device__ __forceinline__ int perm32(int rho) { const int n = rho >> 4, i = rho & 15; return 8 * (i >> 2) + 4 * n + (i & 3); }

struct Unit { int pm, pn; };
struct Gemm { const bf16_t* A; const bf16_t* Bt; int M, N, K; };

struct StaticOrder {
    int nM, nN, nwg, G, c;
    __host__ __device__ void init(int M, int N, int G_, int c_) { nM = M / BM; nN = N / BM; nwg = nM * nN; G = G_; c = c_; }
    __host__ __device__ bool next(int i, Unit& u) const {
        const long L = (long)i * G + c; if (L >= nwg) return false;
        int wgid = (int)L; { const int q = nwg / NXCD, r = nwg % NXCD, xcd = wgid % NXCD, off = wgid / NXCD; wgid = (xcd < r ? xcd * (q + 1) : r * (q + 1) + (xcd - r) * q) + off; }
        const int nig = WGM * nN, gid = wgid / nig, fm = gid * WGM, gsz = (nM - fm) < WGM ? (nM - fm) : WGM;
        u.pm = fm + ((wgid % nig) % gsz); u.pn = (wgid % nig) / gsz; return true;
    }
    __device__ __forceinline__ void a_ready(const Unit&) const {}
    __device__ __forceinline__ void done(const Unit&) const {}
};

__device__ __forceinline__ unsigned cvt_pk_bf16(float lo, float hi) { unsigned r; asm volatile("v_cvt_pk_bf16_f32 %0, %1, %2" : "=v"(r) : "v"(lo), "v"(hi)); return r; }
typedef float f32x2 __attribute__((ext_vector_type(2)));
template <class Epi, class Sched, bool ALIGN_EPI = false, bool SP2 = false, int F8 = 0, int F8SA = 127, int F8SB = 127>
__device__ __forceinline__ void gemm_phase(PG8_LAS unsigned char* lds, const Gemm g, const Sched& S, const Epi& E) {
    const int tid = threadIdx.x, wid = __builtin_amdgcn_readfirstlane(tid >> 6), lane = tid & 63, wr = wid >> 2, wc = wid & 3, fr = lane & 15, fq = lane >> 4;
    const int K = g.K, nt = K / BK;
    unsigned voffA[2], voffB[2];
#pragma unroll
    for (int i = 0; i < 2; ++i) { int R, C; stage_rc(tid * 16 + i * 8192, R, C); const int Rb = Epi::PERM ? ((R & ~31) + perm32(R & 31)) : R;
        voffA[i] = (unsigned)(R * K + C) * 2u; voffB[i] = (unsigned)(Rb * K + C) * 2u; }
    const size_t kstep = (size_t)(BK * 2);
    const size_t hstep = (size_t)HALF * K * 2;
    const size_t tstep = 2 * hstep;
    const unsigned ldsw = (unsigned)wid * 1024u;
    const int aoff = lds_byte(wr * 64 + fr, fq * 8), boff = lds_byte(wc * 32 + fr, fq * 8);
#define PG8_SA(b, h) (((b) * 2 + (h)) * HTB)
#define PG8_SB(b, h) ((4 + (b) * 2 + (h)) * HTB)
#define PG8_STAGE(bufoff, gbase, voff) do { _Pragma("unroll") for (int _i = 0; _i < 2; ++_i) \
        __builtin_amdgcn_global_load_lds((const unsigned*)((const char*)(gbase) + (voff)[_i]), (PG8_LAS unsigned*)(lds + (bufoff) + ldsw + _i * 8192), 16, 0, 0); } while (0)
#define PG8_LDA(dst, b, h) do { _Pragma("unroll") for (int m = 0; m < 4; ++m) { dst[m].lo = *(const PG8_LAS i32x4*)(lds + PG8_SA(b, h) + aoff + m * 2048); dst[m].hi = *(const PG8_LAS i32x4*)(lds + PG8_SA(b, h) + aoff + m * 2048 + 1024); } } while (0)
#define PG8_LDB(dst, b, h) do { _Pragma("unroll") for (int n = 0; n < 2; ++n) { dst[n].lo = *(const PG8_LAS i32x4*)(lds + PG8_SB(b, h) + boff + n * 2048); dst[n].hi = *(const PG8_LAS i32x4*)(lds + PG8_SB(b, h) + boff + n * 2048 + 1024); } } while (0)
#define PG8_MMA(ai, bj, At, Bt) do { __builtin_amdgcn_s_setprio(1); \
        if constexpr (F8 == 0) { _Pragma("unroll") for (int m = 0; m < 4; ++m) _Pragma("unroll") for (int n = 0; n < 2; ++n) { \
            const i32x4 bl_ = Bt[n].lo, bh_ = Bt[n].hi, al_ = At[m].lo, ah_ = At[m].hi;     \
            acc[ai][bj][m][n] = __builtin_amdgcn_mfma_f32_16x16x32_bf16(__builtin_bit_cast(bf16x8, bl_), __builtin_bit_cast(bf16x8, al_), acc[ai][bj][m][n], 0, 0, 0); \
            acc[ai][bj][m][n] = __builtin_amdgcn_mfma_f32_16x16x32_bf16(__builtin_bit_cast(bf16x8, bh_), __builtin_bit_cast(bf16x8, ah_), acc[ai][bj][m][n], 0, 0, 0); } } \
        else { _Pragma("unroll") for (int m = 0; m < 4; ++m) _Pragma("unroll") for (int n = 0; n < 2; ++n) \
            asm volatile("v_mfma_f32_16x16x128_f8f6f4 %0, %1, %2, %0" : "+v"(acc[ai][bj][m][n]) : "v"(Bt[n]), "v"(At[m])); } \
        __builtin_amdgcn_s_setprio(0); } while (0)
#define PG8_WAIT_V(n) asm volatile("s_waitcnt vmcnt(" #n ")" ::: "memory")
#define PG8_WAIT_L(n) asm volatile("s_waitcnt lgkmcnt(" #n ")" ::: "memory")
#define PG8_BAR __builtin_amdgcn_s_barrier()
#define PG8_SCHED __builtin_amdgcn_sched_barrier(0)
    Unit cur, nxt; int ui = 0;
    if (!S.next(0, cur)) return;
    f32x4 acc[2][2][4][2];
#pragma unroll
    for (int a = 0; a < 2; ++a)
#pragma unroll
        for (int b = 0; b < 2; ++b)
#pragma unroll
            for (int m = 0; m < 4; ++m)
#pragma unroll
                for (int n = 0; n < 2; ++n) acc[a][b][m][n] = (f32x4){0.f, 0.f, 0.f, 0.f};
    i32x8 At[4], B0[2], B1[2];
    const char* cA = (const char*)g.A + (size_t)cur.pm * tstep; const char* cB = (const char*)g.Bt + (size_t)cur.pn * tstep;
    S.a_ready(cur);
    if constexpr (SP2) {
        PG8_STAGE(PG8_SB(0, 0), cB, voffB); PG8_STAGE(PG8_SB(0, 1), cB + hstep, voffB); PG8_STAGE(PG8_SA(0, 0), cA, voffA); PG8_STAGE(PG8_SA(0, 1), cA + hstep, voffA);
        if (wr == 1) PG8_BAR;
        PG8_WAIT_V(2); PG8_BAR;
        PG8_STAGE(PG8_SB(1, 0), cB + kstep, voffB); PG8_STAGE(PG8_SA(1, 0), cA + kstep, voffA); PG8_STAGE(PG8_SB(1, 1), cB + hstep + kstep, voffB);
        PG8_WAIT_V(6); PG8_BAR;
    } else {
        PG8_STAGE(PG8_SB(0, 0), cB, voffB); PG8_STAGE(PG8_SA(0, 0), cA, voffA); PG8_STAGE(PG8_SB(0, 1), cB + hstep, voffB); PG8_STAGE(PG8_SA(0, 1), cA + hstep, voffA);
        if (wr == 1) PG8_BAR;
        PG8_WAIT_V(4); PG8_BAR;
        PG8_STAGE(PG8_SB(1, 0), cB + kstep, voffB); PG8_STAGE(PG8_SA(1, 0), cA + kstep, voffA); PG8_STAGE(PG8_SB(1, 1), cB + hstep + kstep, voffB);
        PG8_WAIT_V(6); PG8_BAR;
    }
    for (;;) {
        const bool has_next = S.next(ui + 1, nxt);
        const char* nA = has_next ? (const char*)g.A + (size_t)nxt.pm * tstep : cA; const char* nB = has_next ? (const char*)g.Bt + (size_t)nxt.pn * tstep : cB;
_Pragma("nounroll")
        for (int t = 0; t < nt; t += 2) {
            const bool last = (t == nt - 2);
            const char* a1 = cA + (size_t)(t + 1) * kstep;
            const char* a2 = last ? nA : cA + (size_t)(t + 2) * kstep; const char* b2 = last ? nB : cB + (size_t)(t + 2) * kstep;
            const char* a3 = a2 + kstep; const char* b3 = b2 + kstep;
            if (last && has_next) S.a_ready(nxt);
            if constexpr (SP2) {
            PG8_LDB(B0, 0, 0); PG8_LDB(B1, 0, 1); PG8_SCHED; PG8_LDA(At, 0, 0); PG8_STAGE(PG8_SA(1, 1), a1 + hstep, voffA);
            PG8_WAIT_V(8); PG8_WAIT_L(0); PG8_BAR; PG8_MMA(0, 0, At, B0); PG8_MMA(0, 1, At, B1); PG8_BAR; PG8_SCHED;
            PG8_LDA(At, 0, 1); PG8_STAGE(PG8_SB(0, 0), b2, voffB); PG8_STAGE(PG8_SB(0, 1), b2 + hstep, voffB); PG8_STAGE(PG8_SA(0, 0), a2, voffA);
            PG8_WAIT_V(8); PG8_WAIT_L(0); PG8_BAR; PG8_MMA(1, 0, At, B0); PG8_MMA(1, 1, At, B1); PG8_BAR; PG8_SCHED;
            PG8_LDB(B0, 1, 0); PG8_LDB(B1, 1, 1); PG8_SCHED; PG8_LDA(At, 1, 0); PG8_STAGE(PG8_SA(0, 1), a2 + hstep, voffA);
            PG8_WAIT_V(8); PG8_WAIT_L(0); PG8_BAR; PG8_MMA(0, 0, At, B0); PG8_MMA(0, 1, At, B1); PG8_BAR; PG8_SCHED;
            PG8_LDA(At, 1, 1); PG8_STAGE(PG8_SB(1, 0), b3, voffB); PG8_STAGE(PG8_SB(1, 1), b3 + hstep, voffB); PG8_STAGE(PG8_SA(1, 0), a3, voffA);
            PG8_WAIT_V(8); PG8_WAIT_L(0); PG8_BAR; PG8_MMA(1, 0, At, B0); PG8_MMA(1, 1, At, B1); PG8_BAR; PG8_SCHED;
            } else {
            PG8_LDB(B0, 0, 0); PG8_SCHED; PG8_LDA(At, 0, 0); PG8_STAGE(PG8_SA(1, 1), a1 + hstep, voffA);
            PG8_WAIT_L(8); PG8_BAR; PG8_WAIT_L(0); PG8_MMA(0, 0, At, B0); PG8_BAR; PG8_SCHED;
            PG8_LDB(B1, 0, 1); PG8_STAGE(PG8_SB(0, 0), b2, voffB);
            PG8_BAR; PG8_WAIT_L(0); PG8_MMA(0, 1, At, B1); PG8_BAR;
            PG8_LDA(At, 0, 1); PG8_STAGE(PG8_SA(0, 0), a2, voffA);
            PG8_BAR; PG8_WAIT_L(0); PG8_MMA(1, 0, At, B0); PG8_BAR; PG8_SCHED;
            PG8_STAGE(PG8_SB(0, 1), b2 + hstep, voffB);
            PG8_WAIT_V(6); PG8_BAR; PG8_MMA(1, 1, At, B1); PG8_BAR;
            PG8_LDB(B0, 1, 0); PG8_SCHED; PG8_LDA(At, 1, 0); PG8_STAGE(PG8_SA(0, 1), a2 + hstep, voffA);
            PG8_WAIT_L(8); PG8_BAR; PG8_WAIT_L(0); PG8_MMA(0, 0, At, B0); PG8_BAR; PG8_SCHED;
            PG8_LDB(B1, 1, 1); PG8_STAGE(PG8_SB(1, 0), b3, voffB);
            PG8_BAR; PG8_WAIT_L(0); PG8_MMA(0, 1, At, B1); PG8_BAR;
            PG8_LDA(At, 1, 1); PG8_STAGE(PG8_SA(1, 0), a3, voffA);
            PG8_BAR; PG8_WAIT_L(0); PG8_MMA(1, 0, At, B0); PG8_BAR; PG8_SCHED;
            PG8_STAGE(PG8_SB(1, 1), b3 + hstep, voffB);
            PG8_WAIT_V(6); PG8_BAR; PG8_MMA(1, 1, At, B1); PG8_BAR;
            }
        }
        if constexpr (ALIGN_EPI) { if (wr == 0) PG8_BAR; }
        if constexpr (F8 != 0) asm volatile("s_nop 15\n\ts_nop 15" ::: "memory");
        if constexpr (!Epi::AFTER_DRAIN) { E(acc, cur, wr, wc, fr, fq); S.done(cur); }
        if (!has_next) break;
#pragma unroll
        for (int a = 0; a < 2; ++a)
#pragma unroll
            for (int b = 0; b < 2; ++b)
#pragma unroll
                for (int m = 0; m < 4; ++m)
#pragma unroll
                    for (int n = 0; n < 2; ++n) acc[a][b][m][n] = (f32x4){0.f, 0.f, 0.f, 0.f};
        cur = nxt; cA = nA; cB = nB; ++ui;
        if constexpr (ALIGN_EPI) { if (wr == 1) PG8_BAR; }
    }
    PG8_WAIT_V(0);
    if constexpr (!ALIGN_EPI) { if (wr == 0) PG8_BAR; }
    PG8_BAR;
    if constexpr (Epi::AFTER_DRAIN) { E.fused(acc, cur, wr, wc, fr, fq, lds, wid, lane); S.done(cur); }
#undef PG8_SA
#undef PG8_SB
#undef PG8_STAGE
#undef PG8_LDA
#undef PG8_LDB
#undef PG8_MMA
#undef PG8_WAIT_V
#undef PG8_WAIT_L
#undef PG8_BAR
#undef PG8_SCHED
}
}

constexpr int NB = 8, T = 4096, D = 1024, NTOK = NB * T;
constexpr int ATT_H = 8, ATT_D = 64, ATT_W = 512, KV_LAT = 256, IDX_H = 8, IDX_D = 64, TOPK = 256;
constexpr int HG_H = 4, HG_DK = 128, HG_DV = 128, HG_W = 512, HG_C = 32;
constexpr int D_IN = 3400, D_INP = 3584;
constexpr int C_AQ = 0, C_AC = 512, C_IQ = 768, C_IK = 1280, C_IW = 1344, C_GQ = 1352, C_GF = 1864, C_GI = 2376, C_GG = 2888;
constexpr int NE = 32, TOPE = 4, DFF = 1024, PLE = 256;
constexpr int NASSIGN = NTOK * TOPE, CAP = NASSIGN + NE * 256;
constexpr int MAXTILES = CAP / 256;
constexpr float LN_EPS = 1e-5f, RMS_EPS = 1e-6f, ALPHA = 1.189207115002721f;

constexpr size_t MiB = 1u << 20;
constexpr size_t WS_CTL = 0, CTL_ZERO_BYTES = 64 * 1024;
constexpr size_t WS_WIN_T = 1 * MiB, WS_WO_T = 8 * MiB, WS_WUP_T = 10 * MiB, WS_WDN_T = 138 * MiB, WS_WPROJ_T = 202 * MiB, WS_WGATE_T = 203 * MiB;
constexpr size_t WS_WUK_T = 205 * MiB, WS_WUV_T = 205 * MiB + 512 * 1024;
constexpr size_t WS_SMALL = 206 * MiB;
constexpr size_t WS_A = 208 * MiB;
constexpr size_t WS_B = 480 * MiB;
constexpr size_t WS_X1 = 752 * MiB;
constexpr size_t WS_XB = 880 * MiB;
constexpr size_t WS_PROJ = 944 * MiB;
constexpr size_t WS_SM2 = 1008 * MiB;
constexpr size_t WS_END = 1016 * MiB;
constexpr size_t WS_H = WS_A, WS_XS = WS_A, WS_YSLOT = WS_A;
constexpr size_t WS_XBF = WS_B, WS_U = WS_B, WS_YMIX = WS_B, WS_HH = WS_B;
constexpr size_t WS_QDEC = WS_B + 128 * MiB, WS_PB = WS_B + 128 * MiB, WS_OREC = WS_B + 160 * MiB, WS_CN = WS_B + 224 * MiB, WS_IKN = WS_B + 240 * MiB, WS_MASK = WS_B + 244 * MiB;
constexpr size_t WS_K = WS_XB, WS_VT = WS_XB + 32 * MiB;
constexpr size_t WS_TOPE = WS_SM2, WS_GATE = WS_SM2 + 512 * 1024, WS_LRANK = WS_SM2 + 1024 * 1024, WS_TOKSLOT = WS_SM2 + 1536 * 1024, WS_SLOTGATE = WS_SM2 + 2 * MiB, WS_DECAY = WS_SM2 + 3 * MiB;
constexpr size_t WS_WGBASE = WS_SMALL, WS_TILEE = WS_SMALL + 64 * 1024;
constexpr int CW_CNT = 64;
constexpr int CW_BAR = 1024;
constexpr int XBW_OFF = 147456 - 16;

constexpr int RING_BYTES = 131072, MISC_OFF = RING_BYTES, LDS_BYTES = 147456;
constexpr int NWAVES = 8, NTHR = 512;

#define GAS __attribute__((address_space(1)))
#define LAS __attribute__((address_space(3)))
typedef unsigned short bf16;
typedef unsigned v4u __attribute__((ext_vector_type(4)));
typedef unsigned v2u __attribute__((ext_vector_type(2)));
typedef float f32x4 __attribute__((ext_vector_type(4)));
typedef short bf16x8 __attribute__((ext_vector_type(8)));
#define LDS_WAIT() asm volatile("s_waitcnt lgkmcnt(0)" ::: "memory")
#define VM_WAIT() asm volatile("s_waitcnt vmcnt(0)" ::: "memory")
__device__ __forceinline__ unsigned f2bf(float f) { unsigned u = __builtin_bit_cast(unsigned, f); return (u + 0x7fffu + ((u >> 16) & 1u)) >> 16; }
__device__ __forceinline__ unsigned pk2(float lo, float hi) { return f2bf(lo) | (f2bf(hi) << 16); }
__device__ __forceinline__ float bf2f(unsigned short b) { return __builtin_bit_cast(float, (unsigned)b << 16); }
__device__ __forceinline__ float bflo(unsigned w) { return __builtin_bit_cast(float, w << 16); }
__device__ __forceinline__ float bfhi(unsigned w) { return __builtin_bit_cast(float, w & 0xffff0000u); }
__device__ __forceinline__ float wave_sum(float v) {
#pragma unroll
    for (int o = 1; o < 64; o <<= 1) v += __shfl_xor(v, o);
    return v;
}
__device__ __forceinline__ float sigmoidf_(float x) { return 1.f / (1.f + __expf(-x)); }

__device__ __forceinline__ unsigned pk4_fp8(float a, float b, float c, float d);
struct Params { const float* in[25]; float* out; unsigned char* ws; };
enum { I_X = 0, I_P, I_WIN, I_KVG, I_IKG, I_IKB, I_WUK, I_WUV, I_HGLB, I_HGNG, I_WO, I_LNMG, I_LNMB, I_WR, I_BR, I_WUP, I_BUP, I_WDN, I_BDN, I_LNFG, I_LNFB, I_WPP, I_WPG, I_LNPG, I_LNPB };

struct Ctx { LAS unsigned char* lds; int tid, lane, wave, G, gw, ngw; };

namespace pg8 {
struct EpiBf16s {
    static constexpr bool PERM = true, AFTER_DRAIN = false;
    bf16_t* O; int ldc;
    __device__ __forceinline__ void operator()(const f32x4 (&acc)[2][2][4][2], const Unit& u, int wr, int wc, int fr, int fq) const {
        const int row0 = u.pm * BM + wr * 64 + fr, col0 = u.pn * BM + wc * 32 + 8 * fq;
#pragma unroll
        for (int ai = 0; ai < 2; ++ai)
#pragma unroll
            for (int m = 0; m < 4; ++m) { bf16_t* rowp = O + (size_t)(row0 + ai * HALF + m * 16) * ldc + col0;
#pragma unroll
                for (int bj = 0; bj < 2; ++bj) { const f32x4 v0 = acc[ai][bj][m][0], v1 = acc[ai][bj][m][1];
                    u32x4 w; w.x = cvt_pk_bf16(v0[0], v0[1]); w.y = cvt_pk_bf16(v0[2], v0[3]); w.z = cvt_pk_bf16(v1[0], v1[1]); w.w = cvt_pk_bf16(v1[2], v1[3]);
                    *(u32x4*)(rowp + bj * HALF) = w; } }
    }
};
struct EpiResid {
    static constexpr bool PERM = false, AFTER_DRAIN = false;
    const float* res; float* out; int ldc; float alpha, as;
    __device__ __forceinline__ void operator()(const f32x4 (&acc)[2][2][4][2], const Unit& u, int wr, int wc, int fr, int fq) const {
        const int row0 = u.pm * BM + wr * 64 + fr, col0 = u.pn * BM + wc * 32 + 4 * fq;
#pragma unroll
        for (int ai = 0; ai < 2; ++ai)
#pragma unroll
            for (int m = 0; m < 4; ++m) { const size_t off = (size_t)(row0 + ai * HALF + m * 16) * ldc + col0;
#pragma unroll
                for (int bj = 0; bj < 2; ++bj)
#pragma unroll
                    for (int n = 0; n < 2; ++n) { const f32x4 r = *(const f32x4*)(res + off + bj * HALF + n * 16); *(f32x4*)(out + off + bj * HALF + n * 16) = r * alpha + acc[ai][bj][m][n] * as; }
                asm volatile("" ::: "memory"); }
    }
};
struct EpiPle {
    static constexpr bool PERM = false, AFTER_DRAIN = false;
    const float* x2; const bf16_t* proj; float* out; float alpha, as;
    __device__ __forceinline__ void operator()(const f32x4 (&acc)[2][2][4][2], const Unit& u, int wr, int wc, int fr, int fq) const {
        const int row0 = u.pm * BM + wr * 64 + fr, col0 = u.pn * BM + wc * 32 + 4 * fq;
#pragma unroll
        for (int ai = 0; ai < 2; ++ai)
#pragma unroll
            for (int m = 0; m < 4; ++m) { const size_t off = (size_t)(row0 + ai * HALF + m * 16) * 1024 + col0;
#pragma unroll
                for (int bj = 0; bj < 2; ++bj)
#pragma unroll
                    for (int n = 0; n < 2; ++n) { const size_t o2 = off + bj * HALF + n * 16; const f32x4 r = *(const f32x4*)(x2 + o2); const v2u pw = *(const v2u*)(proj + o2);
                        const f32x4 a = acc[ai][bj][m][n] * as; f32x4 o;
                        o[0] = r[0] * alpha + bflo(pw.x) * sigmoidf_(a[0]); o[1] = r[1] * alpha + bfhi(pw.x) * sigmoidf_(a[1]);
                        o[2] = r[2] * alpha + bflo(pw.y) * sigmoidf_(a[2]); o[3] = r[3] * alpha + bfhi(pw.y) * sigmoidf_(a[3]);
                        *(f32x4*)(out + o2) = o; }
                asm volatile("" ::: "memory"); }
    }
};
struct EpiSwiglu {
    static constexpr bool PERM = true, AFTER_DRAIN = false;
    unsigned char* H; const float* b_up;
    __device__ __forceinline__ void operator()(const f32x4 (&acc)[2][2][4][2], const Unit& u, int wr, int wc, int fr, int fq) const {
        const int e = u.pn >> 3, pnT = u.pn & 7;
        const int row0 = u.pm * BM + wr * 64 + fr, col0 = pnT * 128 + wc * 32 + 8 * fq;
        const float* bg = b_up + (size_t)e * 2048 + col0; const float* bl = bg + 1024;
        float bgv[8], blv[8];
#pragma unroll
        for (int j = 0; j < 8; ++j) { bgv[j] = bg[j]; blv[j] = bl[j]; }
#pragma unroll
        for (int ai = 0; ai < 2; ++ai)
#pragma unroll
            for (int m = 0; m < 4; ++m) { unsigned char* rowp = H + (size_t)(row0 + ai * HALF + m * 16) * 1024 + col0; float a[8];
#pragma unroll
                for (int n = 0; n < 2; ++n)
#pragma unroll
                    for (int j = 0; j < 4; ++j) { float g = acc[ai][0][m][n][j] * (1.f / 512.f) + bgv[4 * n + j], l = acc[ai][1][m][n][j] * (1.f / 512.f) + blv[4 * n + j];
                        g = fminf(g, 7.0f); l = fminf(fmaxf(l, -7.0f), 7.0f); a[4 * n + j] = g * sigmoidf_(1.702f * g) * (l + 1.0f); }
                v2u w; w.x = pk4_fp8(a[0] * 4.f, a[1] * 4.f, a[2] * 4.f, a[3] * 4.f); w.y = pk4_fp8(a[4] * 4.f, a[5] * 4.f, a[6] * 4.f, a[7] * 4.f);
                *(v2u*)rowp = w; }
    }
};
struct EpiDown {
    static constexpr bool PERM = true, AFTER_DRAIN = false;
    bf16_t* Y; const float* b_dn; const float* gate;
    __device__ __forceinline__ void operator()(const f32x4 (&acc)[2][2][4][2], const Unit& u, int wr, int wc, int fr, int fq) const {
        const int e = u.pn >> 2, pnT = u.pn & 3;
        const int row0 = u.pm * BM + wr * 64 + fr, col0 = pnT * 256 + wc * 32 + 8 * fq;
        const float* bb = b_dn + (size_t)e * 1024 + col0;
        float bv[2][8];
#pragma unroll
        for (int bj = 0; bj < 2; ++bj)
#pragma unroll
            for (int j = 0; j < 8; ++j) bv[bj][j] = bb[bj * HALF + j];
#pragma unroll
        for (int ai = 0; ai < 2; ++ai)
#pragma unroll
            for (int m = 0; m < 4; ++m) { const int row = row0 + ai * HALF + m * 16; const float gt = gate[row]; bf16_t* rowp = Y + (size_t)row * 1024 + col0;
#pragma unroll
                for (int bj = 0; bj < 2; ++bj) { const f32x4 v0 = acc[ai][bj][m][0], v1 = acc[ai][bj][m][1];
                    const float as = 1.f / 256.f;
                    u32x4 w; w.x = cvt_pk_bf16((v0[0] * as + bv[bj][0]) * gt, (v0[1] * as + bv[bj][1]) * gt); w.y = cvt_pk_bf16((v0[2] * as + bv[bj][2]) * gt, (v0[3] * as + bv[bj][3]) * gt);
                    w.z = cvt_pk_bf16((v1[0] * as + bv[bj][4]) * gt, (v1[1] * as + bv[bj][5]) * gt); w.w = cvt_pk_bf16((v1[2] * as + bv[bj][6]) * gt, (v1[3] * as + bv[bj][7]) * gt);
                    *(u32x4*)(rowp + bj * HALF) = w; } }
    }
};
struct MoeOrder {
    const int* tile_e; int ntiles, nN, G, c;
    __device__ __forceinline__ bool next(int i, Unit& u) const {
        const int L = i * G + c; if (L >= ntiles * nN) return false;
        const int pm = L / nN, pl = L - pm * nN; u.pm = pm; u.pn = tile_e[pm] * nN + pl; return true;
    }
    __device__ __forceinline__ void a_ready(const Unit&) const {}
    __device__ __forceinline__ void done(const Unit&) const {}
};
}

template <class RowMap>
__device__ __forceinline__ void transpose_item(const float* W, int ldw, int Nvalid, bf16* WT, int Kdim, RowMap rm, LAS float* scr, int kb, int nb, int lane) {
    const int k0 = 64 * kb, n0 = 32 * nb; const int nl0 = lane & 31, nn = n0 + nl0;
#pragma unroll 8
    for (int i = 0; i < 32; ++i) { const int kk = 2 * i + (lane >> 5); scr[kk * 33 + nl0] = (nn < Nvalid) ? W[(size_t)(k0 + kk) * ldw + nn] : 0.f; }
    LDS_WAIT(); asm volatile("" ::: "memory");
    const int c = lane & 7;
#pragma unroll
    for (int j = 0; j < 4; ++j) { const int n = (lane >> 3) + 8 * j; const LAS float* s = scr + (8 * c) * 33 + n;
        v4u o; o.x = pk2(s[0 * 33], s[1 * 33]); o.y = pk2(s[2 * 33], s[3 * 33]); o.z = pk2(s[4 * 33], s[5 * 33]); o.w = pk2(s[6 * 33], s[7 * 33]);
        *(GAS v4u*)(WT + (size_t)rm(n0 + n) * Kdim + k0 + 8 * c) = o; }
    LDS_WAIT(); asm volatile("" ::: "memory");
}
__device__ __forceinline__ unsigned pk4_fp8(float a, float b, float c, float d) { int r = 0; r = __builtin_amdgcn_cvt_pk_fp8_f32(a, b, r, false); r = __builtin_amdgcn_cvt_pk_fp8_f32(c, d, r, true); return (unsigned)r; }
template <class RowMap>
__device__ __forceinline__ void transpose_item_f8(const float* W, int ldw, unsigned char* WT, int Kdim, RowMap rm, LAS float* scr, int kb, int nb, int lane, float mul) {
    const int k0 = 64 * kb, n0 = 32 * nb; const int nl0 = lane & 31, nn = n0 + nl0;
#pragma unroll 8
    for (int i = 0; i < 32; ++i) { const int kk = 2 * i + (lane >> 5); scr[kk * 33 + nl0] = W[(size_t)(k0 + kk) * ldw + nn] * mul; }
    LDS_WAIT(); asm volatile("" ::: "memory");
    const int c = lane & 7;
#pragma unroll
    for (int j = 0; j < 4; ++j) { const int n = (lane >> 3) + 8 * j; const LAS float* s = scr + (8 * c) * 33 + n;
        v2u o; o.x = pk4_fp8(s[0 * 33], s[1 * 33], s[2 * 33], s[3 * 33]); o.y = pk4_fp8(s[4 * 33], s[5 * 33], s[6 * 33], s[7 * 33]);
        *(GAS v2u*)(WT + (size_t)rm(n0 + n) * Kdim + k0 + 8 * c) = o; }
    LDS_WAIT(); asm volatile("" ::: "memory");
}
struct RmId { __device__ __forceinline__ int operator()(int n) const { return n; } };
struct RmUp { int e; __device__ __forceinline__ int operator()(int n) const { return e * 2048 + ((n & 1023) >> 7) * 256 + (n >> 10) * 128 + (n & 127); } };
struct RmOff { int off; __device__ __forceinline__ int operator()(int n) const { return off + n; } };

__device__ __forceinline__ void p0_prologue(const Params& P, const Ctx& C) {
    LAS float* scr = (LAS float*)(C.lds + C.wave * 16384);
    unsigned char* ws = P.ws;
    constexpr int I_IN = 16 * (D_INP / 32), I_O = 16 * 32, I_UP = 16 * 64, I_DN = 16 * 32, I_PP = 4 * 32, I_PG = 16 * 32, I_UK = 4 * 16, I_UV = 4 * 16;
    constexpr int NITEMS = I_IN + I_O + NE * I_UP + NE * I_DN + I_PP + I_PG + I_UK + I_UV;
    for (int it = C.gw; it < NITEMS; it += C.ngw) {
        int r = it;
        if (r < I_IN) { transpose_item(P.in[I_WIN], D_IN, D_IN, (bf16*)(ws + WS_WIN_T), 1024, RmId{}, scr, r / (D_INP / 32), r % (D_INP / 32), C.lane); continue; } r -= I_IN;
        if (r < I_O) { transpose_item_f8(P.in[I_WO], 1024, ws + WS_WO_T, 1024, RmId{}, scr, r / 32, r % 32, C.lane, 64.f); continue; } r -= I_O;
        if (r < NE * I_UP) { const int e = r / I_UP, q = r % I_UP; transpose_item_f8(P.in[I_WUP] + (size_t)e * 1024 * 2048, 2048, ws + WS_WUP_T, 1024, RmUp{e}, scr, q / 64, q % 64, C.lane, 64.f); continue; } r -= NE * I_UP;
        if (r < NE * I_DN) { const int e = r / I_DN, q = r % I_DN; transpose_item_f8(P.in[I_WDN] + (size_t)e * 1024 * 1024, 1024, ws + WS_WDN_T, 1024, RmOff{e * 1024}, scr, q / 32, q % 32, C.lane, 64.f); continue; } r -= NE * I_DN;
        if (r < I_PP) { transpose_item(P.in[I_WPP], 1024, 1024, (bf16*)(ws + WS_WPROJ_T), 256, RmId{}, scr, r / 32, r % 32, C.lane); continue; } r -= I_PP;
        if (r < I_PG) { transpose_item_f8(P.in[I_WPG], 1024, ws + WS_WGATE_T, 1024, RmId{}, scr, r / 32, r % 32, C.lane, 64.f); continue; } r -= I_PG;
        if (r < I_UK) { transpose_item(P.in[I_WUK], 512, 512, (bf16*)(ws + WS_WUK_T), 256, RmId{}, scr, r / 16, r % 16, C.lane); continue; } r -= I_UK;
        transpose_item(P.in[I_WUV], 512, 512, (bf16*)(ws + WS_WUV_T), 256, RmId{}, scr, r / 16, r % 16, C.lane);
    }
    {
        const float* x = P.in[I_X]; bf16* xb = (bf16*)(ws + WS_XBF);
        const size_t n8 = (size_t)NTOK * D / 8, stride = (size_t)C.ngw * 64;
        for (size_t i = (size_t)C.gw * 64 + C.lane; i < n8; i += stride) { const f32x4 a = *(const GAS f32x4*)(x + i * 8), b = *(const GAS f32x4*)(x + i * 8 + 4);
            v4u o; o.x = pk2(a[0], a[1]); o.y = pk2(a[2], a[3]); o.z = pk2(b[0], b[1]); o.w = pk2(b[2], b[3]); *(GAS v4u*)(xb + i * 8) = o; }
        const float* p = P.in[I_P]; bf16* pb = (bf16*)(ws + WS_PB);
        const size_t m8 = (size_t)NTOK * PLE / 8;
        for (size_t i = (size_t)C.gw * 64 + C.lane; i < m8; i += stride) { const f32x4 a = *(const GAS f32x4*)(p + i * 8), b = *(const GAS f32x4*)(p + i * 8 + 4);
            v4u o; o.x = pk2(a[0], a[1]); o.y = pk2(a[2], a[3]); o.z = pk2(b[0], b[1]); o.w = pk2(b[2], b[3]); *(GAS v4u*)(pb + i * 8) = o; }
    }
}

__device__ __forceinline__ void ln_row(f32x4 (&v)[4], const float* g, const float* b, int lane) {
    float s = 0.f;
#pragma unroll
    for (int j = 0; j < 4; ++j) s += (v[j][0] + v[j][1]) + (v[j][2] + v[j][3]);
    const float mean = wave_sum(s) * (1.f / D); float s2 = 0.f;
#pragma unroll
    for (int j = 0; j < 4; ++j) { v[j] = v[j] - mean; s2 += (v[j][0] * v[j][0] + v[j][1] * v[j][1]) + (v[j][2] * v[j][2] + v[j][3] * v[j][3]); }
    const float rstd = 1.f / sqrtf(wave_sum(s2) * (1.f / D) + LN_EPS);
#pragma unroll
    for (int j = 0; j < 4; ++j) { const f32x4 gg = *(const f32x4*)(g + 4 * lane + 256 * j), bb = *(const f32x4*)(b + 4 * lane + 256 * j); v[j] = v[j] * rstd * gg + bb; }
}
__device__ __forceinline__ void store_row_f32(float* row, const f32x4 (&v)[4], int lane) {
#pragma unroll
    for (int j = 0; j < 4; ++j) *(GAS f32x4*)(row + 4 * lane + 256 * j) = v[j];
}
__device__ __forceinline__ void store_row_bf16(bf16* row, const f32x4 (&v)[4], int lane) {
#pragma unroll
    for (int j = 0; j < 4; ++j) { v2u o; o.x = pk2(v[j][0], v[j][1]); o.y = pk2(v[j][2], v[j][3]); *(GAS v2u*)(row + 4 * lane + 256 * j) = o; }
}
__device__ __forceinline__ void store_row_fp8x8(unsigned char* row, const f32x4 (&v)[4], int lane) {
#pragma unroll
    for (int j = 0; j < 4; ++j) *(GAS unsigned*)(row + 4 * lane + 256 * j) = pk4_fp8(v[j][0] * 8.f, v[j][1] * 8.f, v[j][2] * 8.f, v[j][3] * 8.f);
}
__device__ __forceinline__ void load_row_f32(f32x4 (&v)[4], const float* row, int lane) {
#pragma unroll
    for (int j = 0; j < 4; ++j) v[j] = *(const GAS f32x4*)(row + 4 * lane + 256 * j);
}
#ifndef FEAT_MIX
#define FEAT_MIX 1
#endif
#ifndef FEAT_MOE
#define FEAT_MOE 1
#endif
#ifndef FEAT_PLE
#define FEAT_PLE 1
#endif
#ifndef FEAT_ATT
#define FEAT_ATT 1
#endif
#ifndef SYNC_MODE
#define SYNC_MODE 0
#endif
#ifndef PROGRAM
#define PROGRAM X(0) GS X(10) X(11) SY X(20) X(21) SY X(30) X(31) BS X(32) SY X(40) X(41) SY X(5) SY X(6) SY X(7) SY X(8) SY X(9) SY X(100) SY X(110) SY X(120)
#endif

typedef float f32x16 __attribute__((ext_vector_type(16)));
typedef short s16x4 __attribute__((ext_vector_type(4)));
__device__ __forceinline__ unsigned cvtpk(float lo, float hi) { typedef float f2 __attribute__((ext_vector_type(2))); typedef __bf16 b2 __attribute__((ext_vector_type(2))); f2 v = {lo, hi}; b2 b = __builtin_convertvector(v, b2); return __builtin_bit_cast(unsigned, b); }
__device__ __forceinline__ bf16x8 pack8(const f32x16& x, int base) {
    v4u w; w.x = cvtpk(x[base + 0], x[base + 1]); w.y = cvtpk(x[base + 2], x[base + 3]); w.z = cvtpk(x[base + 4], x[base + 5]); w.w = cvtpk(x[base + 6], x[base + 7]);
    return __builtin_bit_cast(bf16x8, w);
}

__device__ __forceinline__ void p2_post(const Params& P, const Ctx& C) {
    unsigned char* ws = P.ws;
    const bf16* H = (const bf16*)(ws + WS_H); bf16* CN = (bf16*)(ws + WS_CN); bf16* IKN = (bf16*)(ws + WS_IKN);
    const float* kvg = P.in[I_KVG]; const float* ikg = P.in[I_IKG]; const float* ikb = P.in[I_IKB];
    const f32x4 g4 = *(const f32x4*)(kvg + 4 * C.lane); const float ig = ikg[C.lane], ib = ikb[C.lane];
    for (int m = C.gw; m < NTOK; m += C.ngw) {
        const bf16* hr = H + (size_t)m * D_INP;
        const v2u w = *(const GAS v2u*)(hr + C_AC + 4 * C.lane);
        float a0 = bflo(w.x), a1 = bfhi(w.x), a2 = bflo(w.y), a3 = bfhi(w.y);
        const float ss = wave_sum((a0 * a0 + a1 * a1) + (a2 * a2 + a3 * a3));
        const float rs = 1.f / sqrtf(ss * (1.f / 256.f) + RMS_EPS);
        v2u o; o.x = pk2(a0 * rs * g4[0], a1 * rs * g4[1]); o.y = pk2(a2 * rs * g4[2], a3 * rs * g4[3]);
        *(GAS v2u*)(CN + (size_t)m * 256 + 4 * C.lane) = o;
        const float k = bf2f(hr[C_IK + C.lane]);
        const float mu = wave_sum(k) * (1.f / 64.f); const float dk = k - mu;
        const float var = wave_sum(dk * dk) * (1.f / 64.f);
        IKN[(size_t)m * 64 + C.lane] = (bf16)f2bf(dk * (1.f / sqrtf(var + LN_EPS)) * ig + ib);
    }
}

constexpr int HP_QD = 0, HP_KI = 8704, HP_KET = 17408, HP_VT = 27648, HP_GS = 37888, HP_RAW = 40960;
__device__ __forceinline__ void p2_hgrn_prep(const Params& P, const Ctx& C) {
    unsigned char* ws = P.ws;
    const bf16* H = (const bf16*)(ws + WS_H);
    bf16* UT = (bf16*)(ws + WS_U); bf16* QDEC = (bf16*)(ws + WS_QDEC); float* OREC = (float*)(ws + WS_OREC); float* DEC = (float*)(ws + WS_DECAY);
    LAS bf16* QD = (LAS bf16*)(C.lds + HP_QD); LAS bf16* KI = (LAS bf16*)(C.lds + HP_KI); LAS bf16* KET = (LAS bf16*)(C.lds + HP_KET); LAS bf16* VT = (LAS bf16*)(C.lds + HP_VT);
    LAS float* GS = (LAS float*)(C.lds + HP_GS); LAS bf16* RAW = (LAS bf16*)(C.lds + HP_RAW);
    const int d = C.tid & 127, tg = C.tid >> 7;
    const int lane = C.lane, r32 = lane & 31, hf = lane >> 5;
    const int lc = C.tid >> 4, lg = C.tid & 15;
    const int NU = NB * HG_H * (T / HG_C);
    v4u rf, rq, ri;
    { const int unit = blockIdx.x; if (unit < NU) { const int n = unit & 127, hh = (unit >> 7) & 3, b = unit >> 9; const bf16* hr = H + (size_t)(b * T + n * HG_C + lc) * D_INP + hh * 128 + 8 * lg;
        rf = *(const GAS v4u*)(hr + C_GF); rq = *(const GAS v4u*)(hr + C_GQ); ri = *(const GAS v4u*)(hr + C_GI); } }
    for (int unit = blockIdx.x; unit < NU; unit += C.G) {
        const int n = unit & 127, hh = (unit >> 7) & 3, b = unit >> 9;
        const int m0 = b * T + n * HG_C;
        *(LAS v4u*)(RAW + lc * 128 + 8 * lg) = rf; *(LAS v4u*)(RAW + 4096 + lc * 128 + 8 * lg) = rq; *(LAS v4u*)(RAW + 8192 + lc * 128 + 8 * lg) = ri;
        __syncthreads();
        { const int un = unit + C.G; if (un < NU) { const int n2 = un & 127, h2 = (un >> 7) & 3, b2 = un >> 9; const bf16* hr = H + (size_t)(b2 * T + n2 * HG_C + lc) * D_INP + h2 * 128 + 8 * lg;
            rf = *(const GAS v4u*)(hr + C_GF); rq = *(const GAS v4u*)(hr + C_GQ); ri = *(const GAS v4u*)(hr + C_GI); } }
        const float l0 = P.in[I_HGLB][hh * 128 + d], l1 = P.in[I_HGLB][512 + hh * 128 + d];
        const float lb = 1.f / (1.f + __expf(l1 - l0));
        float fg[8], bl[8], qv[8]; float run = 0.f; unsigned vv[4];
#pragma unroll
        for (int c = 0; c < 8; ++c) { const int tok = tg * 8 + c;
            const float f = bf2f(RAW[tok * 128 + d]), q = bf2f(RAW[4096 + tok * 128 + d]); const unsigned iv = RAW[8192 + tok * 128 + d];
            fg[c] = lb + (1.f - lb) * sigmoidf_(f); run += __logf(fg[c]); bl[c] = run; qv[c] = q * sigmoidf_(q);
            if (c & 1) vv[c >> 1] |= iv << 16; else vv[c >> 1] = iv; }
        GS[tg * 128 + d] = run;
        *(LAS v4u*)(VT + d * 40 + tg * 8) = (v4u){vv[0], vv[1], vv[2], vv[3]};
        __syncthreads();
        float pre = 0.f, tot = 0.f;
#pragma unroll
        for (int g = 0; g < 4; ++g) { const float sg = GS[g * 128 + d]; tot += sg; if (g < tg) pre += sg; }
        unsigned ke[4];
#pragma unroll
        for (int c = 0; c < 8; ++c) { const float bc = pre + bl[c]; const float kc = 1.f - fg[c];
            const float qd = qv[c] * __expf(bc), ki = kc * __expf(-bc), kend = kc * __expf(tot - bc);
            const unsigned qb = f2bf(qd);
            QD[(tg * 8 + c) * 136 + d] = (bf16)qb; KI[(tg * 8 + c) * 136 + d] = (bf16)f2bf(ki);
            if (c & 1) ke[c >> 1] |= f2bf(kend) << 16; else ke[c >> 1] = f2bf(kend); }
        *(LAS v4u*)(KET + d * 40 + tg * 8) = (v4u){ke[0], ke[1], ke[2], ke[3]};
        if (tg == 0) DEC[(size_t)unit * 128 + d] = __expf(tot);
        __syncthreads();
        *(GAS v4u*)(QDEC + (size_t)(m0 + lc) * 512 + hh * 128 + 8 * lg) = *(const LAS v4u*)(QD + lc * 136 + 8 * lg);
        if (C.wave < 4) {
            f32x16 X = {0.f, 0.f, 0.f, 0.f, 0.f, 0.f, 0.f, 0.f, 0.f, 0.f, 0.f, 0.f, 0.f, 0.f, 0.f, 0.f};
#pragma unroll
            for (int k = 0; k < 8; ++k) { const bf16x8 a = *(const LAS bf16x8*)(KI + r32 * 136 + 16 * k + 8 * hf), bq = *(const LAS bf16x8*)(QD + r32 * 136 + 16 * k + 8 * hf);
                X = __builtin_amdgcn_mfma_f32_32x32x16_bf16(a, bq, X, 0, 0, 0); }
#pragma unroll
            for (int r = 0; r < 16; ++r) { const int sidx = (r & 3) + 8 * (r >> 2) + 4 * hf; if (sidx > r32) X[r] = 0.f; }
            f32x16 Z = {0.f, 0.f, 0.f, 0.f, 0.f, 0.f, 0.f, 0.f, 0.f, 0.f, 0.f, 0.f, 0.f, 0.f, 0.f, 0.f};
            const int e = C.wave * 32 + r32;
#pragma unroll
            for (int sp = 0; sp < 2; ++sp) { const bf16x8 a = pack8(X, 8 * sp);
                const s16x4 lo = *(const LAS s16x4*)(VT + e * 40 + 16 * sp + 4 * hf), hi = *(const LAS s16x4*)(VT + e * 40 + 16 * sp + 8 + 4 * hf);
                const bf16x8 bv = (bf16x8){lo[0], lo[1], lo[2], lo[3], hi[0], hi[1], hi[2], hi[3]};
                Z = __builtin_amdgcn_mfma_f32_32x32x16_bf16(a, bv, Z, 0, 0, 0); }
#pragma unroll
            for (int r = 0; r < 16; ++r) { const int c = (r & 3) + 8 * (r >> 2) + 4 * hf; OREC[(size_t)(m0 + c) * 512 + hh * 128 + e] = Z[r]; }
        }
        {
            const int dt = C.wave >> 1;
            const bf16x8 a0 = *(const LAS bf16x8*)(KET + (dt * 32 + r32) * 40 + 8 * hf), a1 = *(const LAS bf16x8*)(KET + (dt * 32 + r32) * 40 + 16 + 8 * hf);
#pragma unroll
            for (int ei = 0; ei < 2; ++ei) { const int et = 2 * (C.wave & 1) + ei;
                const bf16x8 b0 = *(const LAS bf16x8*)(VT + (et * 32 + r32) * 40 + 8 * hf), b1 = *(const LAS bf16x8*)(VT + (et * 32 + r32) * 40 + 16 + 8 * hf);
                f32x16 U = {0.f, 0.f, 0.f, 0.f, 0.f, 0.f, 0.f, 0.f, 0.f, 0.f, 0.f, 0.f, 0.f, 0.f, 0.f, 0.f};
                U = __builtin_amdgcn_mfma_f32_32x32x16_bf16(a0, b0, U, 0, 0, 0); U = __builtin_amdgcn_mfma_f32_32x32x16_bf16(a1, b1, U, 0, 0, 0);
                bf16* up = UT + (size_t)unit * 16384 + (size_t)(et * 32 + r32) * 128 + dt * 32 + 4 * hf;
#pragma unroll
                for (int q = 0; q < 4; ++q) { v2u o; o.x = cvtpk(U[4 * q], U[4 * q + 1]); o.y = cvtpk(U[4 * q + 2], U[4 * q + 3]); *(GAS v2u*)(up + 8 * q) = o; } }
        }
        __syncthreads();
    }
}

__device__ __forceinline__ void p3_hgrn_scan(const Params& P, const Ctx& C) {
    unsigned char* ws = P.ws;
    const bf16* UT = (const bf16*)(ws + WS_U); const bf16* QDEC = (const bf16*)(ws + WS_QDEC); float* OREC = (float*)(ws + WS_OREC); const float* DEC = (const float*)(ws + WS_DECAY);
    LAS bf16* ST = (LAS bf16*)C.lds;
    typedef float f32x4v __attribute__((ext_vector_type(4)));
    for (int unit = blockIdx.x; unit < NB * HG_H * 8; unit += C.G) {
        const int sl = unit & 7, hh = (unit >> 3) & 3, b = unit >> 5; const int e0 = sl * 16;
        const int e = C.tid & 15, dq = C.tid >> 4;
        float S[4] = {0.f, 0.f, 0.f, 0.f};
        *(LAS v2u*)(ST + e * 136 + 4 * dq) = (v2u){0u, 0u};
        const int cu0 = (b * HG_H + hh) * 128;
        const int lane = C.lane, fr = lane & 15, fq = lane >> 4;
        const bool mw = C.wave < 2;
        const bf16* up = UT + (size_t)cu0 * 16384 + (size_t)(e0 + e) * 128 + 4 * dq;
        const float* dp = DEC + (size_t)cu0 * 128 + 4 * dq;
        const bf16* qp = QDEC + (size_t)(b * T + C.wave * 16 + fr) * 512 + hh * 128 + 8 * fq;
        float* op = OREC + (size_t)(b * T + C.wave * 16 + 4 * fq) * 512 + hh * 128 + e0 + fr;
        v2u un[4]; f32x4 dn[4]; bf16x8 qa[4][4]; float oi[4][4];
#pragma unroll
        for (int s = 0; s < 4; ++s) { un[s] = *(const GAS v2u*)(up + (size_t)s * 16384); dn[s] = *(const GAS f32x4*)(dp + (size_t)s * 128);
            if (mw) {
#pragma unroll
                for (int k = 0; k < 4; ++k) qa[s][k] = *(const GAS bf16x8*)(qp + (size_t)s * 32 * 512 + 32 * k);
#pragma unroll
                for (int j = 0; j < 4; ++j) oi[s][j] = op[(size_t)(s * 32 + j) * 512]; } }
        __syncthreads();
        for (int nb = 0; nb < 32; ++nb) {
#pragma unroll
            for (int s = 0; s < 4; ++s) {
                const int n = 4 * nb + s;
                const LAS bf16* stc = ST + (n & 1) * (16 * 136); LAS bf16* stn = ST + ((n + 1) & 1) * (16 * 136);
                if (mw) {
                    f32x4v acc = {oi[s][0], oi[s][1], oi[s][2], oi[s][3]};
#pragma unroll
                    for (int k = 0; k < 4; ++k) { const bf16x8 bs = *(const LAS bf16x8*)(stc + fr * 136 + 32 * k + 8 * fq); acc = __builtin_amdgcn_mfma_f32_16x16x32_bf16(qa[s][k], bs, acc, 0, 0, 0); }
#pragma unroll
                    for (int j = 0; j < 4; ++j) op[(size_t)(n * 32 + j) * 512] = acc[j];
                }
                S[0] = dn[s][0] * S[0] + bflo(un[s].x); S[1] = dn[s][1] * S[1] + bfhi(un[s].x); S[2] = dn[s][2] * S[2] + bflo(un[s].y); S[3] = dn[s][3] * S[3] + bfhi(un[s].y);
                *(LAS v2u*)(stn + e * 136 + 4 * dq) = (v2u){cvtpk(S[0], S[1]), cvtpk(S[2], S[3])};
                if (nb + 1 < 32) {
                    const int n2 = n + 4; un[s] = *(const GAS v2u*)(up + (size_t)n2 * 16384); dn[s] = *(const GAS f32x4*)(dp + (size_t)n2 * 128);
                    if (mw) {
#pragma unroll
                        for (int k = 0; k < 4; ++k) qa[s][k] = *(const GAS bf16x8*)(qp + (size_t)n2 * 32 * 512 + 32 * k);
#pragma unroll
                        for (int j = 0; j < 4; ++j) oi[s][j] = op[(size_t)(n2 * 32 + j) * 512]; }
                }
                __syncthreads();
            }
        }
    }
}

__device__ __forceinline__ void p4_yrec(const Params& P, const Ctx& C) {
    unsigned char* ws = P.ws;
    const float* OREC = (const float*)(ws + WS_OREC); const bf16* H = (const bf16*)(ws + WS_H); bf16* YM = (bf16*)(ws + WS_YMIX);
    const float* ng = P.in[I_HGNG];
    const f32x4 g0 = *(const f32x4*)(ng + 8 * C.lane), g1 = *(const f32x4*)(ng + 8 * C.lane + 4);
    for (int m = C.gw; m < NTOK; m += C.ngw) {
        const f32x4 a = *(const GAS f32x4*)(OREC + (size_t)m * 512 + 8 * C.lane), bq = *(const GAS f32x4*)(OREC + (size_t)m * 512 + 8 * C.lane + 4);
        float ss = (a[0] * a[0] + a[1] * a[1]) + (a[2] * a[2] + a[3] * a[3]) + (bq[0] * bq[0] + bq[1] * bq[1]) + (bq[2] * bq[2] + bq[3] * bq[3]);
        ss += __shfl_xor(ss, 1); ss += __shfl_xor(ss, 2); ss += __shfl_xor(ss, 4); ss += __shfl_xor(ss, 8);
        const float rs = 1.f / sqrtf(ss * (1.f / 128.f) + RMS_EPS);
        const v4u gw = *(const GAS v4u*)(H + (size_t)m * D_INP + C_GG + 8 * C.lane);
        float gv[8] = {bflo(gw.x), bfhi(gw.x), bflo(gw.y), bfhi(gw.y), bflo(gw.z), bfhi(gw.z), bflo(gw.w), bfhi(gw.w)};
        float o[8];
#pragma unroll
        for (int j = 0; j < 4; ++j) { o[j] = a[j] * rs * g0[j] * (gv[j] * sigmoidf_(gv[j])); o[4 + j] = bq[j] * rs * g1[j] * (gv[4 + j] * sigmoidf_(gv[4 + j])); }
        v2u w; w.x = pk4_fp8(o[0] * 8.f, o[1] * 8.f, o[2] * 8.f, o[3] * 8.f); w.y = pk4_fp8(o[4] * 8.f, o[5] * 8.f, o[6] * 8.f, o[7] * 8.f);
        *(GAS v2u*)((unsigned char*)YM + (size_t)m * D + 512 + 8 * C.lane) = w;
#if !FEAT_ATT
        *(GAS v4u*)(YM + (size_t)m * D + 8 * C.lane) = (v4u){0u, 0u, 0u, 0u};
#endif
    }
}

namespace pg8 {
struct EpiKhead {
    static constexpr bool PERM = true, AFTER_DRAIN = false;
    bf16_t* O;
    __device__ __forceinline__ void operator()(const f32x4 (&acc)[2][2][4][2], const Unit& u, int wr, int wc, int fr, int fq) const {
        const int row0 = u.pm * BM + wr * 64 + fr, col0 = u.pn * BM + wc * 32 + 8 * fq;
#pragma unroll
        for (int ai = 0; ai < 2; ++ai)
#pragma unroll
            for (int m = 0; m < 4; ++m) { const int row = row0 + ai * HALF + m * 16; const int b = row >> 12, t = row & 4095;
#pragma unroll
                for (int bj = 0; bj < 2; ++bj) { const int col = col0 + bj * HALF; const f32x4 v0 = acc[ai][bj][m][0], v1 = acc[ai][bj][m][1];
                    u32x4 w; w.x = cvt_pk_bf16(v0[0], v0[1]); w.y = cvt_pk_bf16(v0[2], v0[3]); w.z = cvt_pk_bf16(v1[0], v1[1]); w.w = cvt_pk_bf16(v1[2], v1[3]);
                    *(u32x4*)(O + ((size_t)((b * 8 + (col >> 6)) * 4096 + t)) * 64 + (col & 63)) = w; } }
    }
};
struct EpiVt {
    static constexpr bool PERM = true, AFTER_DRAIN = false;
    bf16_t* O;
    __device__ __forceinline__ void operator()(const f32x4 (&acc)[2][2][4][2], const Unit& u, int wr, int wc, int fr, int fq) const {
        const int row0 = u.pm * BM + wr * 64 + fr, col0 = u.pn * BM + wc * 32 + 8 * fq;
#pragma unroll
        for (int ai = 0; ai < 2; ++ai)
#pragma unroll
            for (int m = 0; m < 4; ++m) { const int row = row0 + ai * HALF + m * 16;
#pragma unroll
                for (int bj = 0; bj < 2; ++bj) { const int col = col0 + bj * HALF; const int b = col >> 12, t = col & 4095; const f32x4 v0 = acc[ai][bj][m][0], v1 = acc[ai][bj][m][1];
                    u32x4 w; w.x = cvt_pk_bf16(v0[0], v0[1]); w.y = cvt_pk_bf16(v0[2], v0[3]); w.z = cvt_pk_bf16(v1[0], v1[1]); w.w = cvt_pk_bf16(v1[2], v1[3]);
                    *(u32x4*)(O + ((size_t)(b * 512 + row)) * 4096 + t) = w; } }
    }
};
}

__device__ __forceinline__ unsigned f2ord(float x) { const unsigned b = __builtin_bit_cast(unsigned, x); return b ^ ((unsigned)((int)b >> 31) | 0x80000000u); }
typedef _Float16 h16;
typedef _Float16 h16x8 __attribute__((ext_vector_type(8)));
__device__ __forceinline__ float relu_i(float x) { const int b = __builtin_bit_cast(int, x); return __builtin_bit_cast(float, b > 0 ? b : 0); }
__device__ __forceinline__ unsigned h2ord(unsigned hb) { return (hb ^ ((hb & 0x8000u) ? 0xffffu : 0x8000u)) & 0xffffu; }
__device__ __forceinline__ int isc_bucket(float x, float mu, float scale) { const float t = fminf(fmaxf(fmaf(x - mu, scale, 128.f), 0.f), 255.f); return (int)t; }
__device__ __forceinline__ void p3_indexer(const Params& P, const Ctx& C) {
    unsigned char* ws = P.ws;
    const bf16* H = (const bf16*)(ws + WS_H); const bf16* IKN = (const bf16*)(ws + WS_IKN); unsigned* MASK = (unsigned*)(ws + WS_MASK);
    LAS h16* ISC = (LAS h16*)C.lds; LAS unsigned* HIST = (LAS unsigned*)(C.lds + 131072) + C.wave * 256; LAS float* STAT = (LAS float*)(C.lds + 139264); LAS float* W16 = (LAS float*)(C.lds + 140288);
    const int lane = C.lane, r32 = lane & 31, hf = lane >> 5;
    const int ql = 2 * (r32 >> 4) + ((r32 >> 2) & 1), hd = 4 * ((r32 >> 3) & 1) + (r32 & 3);
    constexpr int CAND_CAP = 120, QU = 16;
    for (int u = blockIdx.x; u < NTOK / QU; u += C.G) {
        const int b = u & 7, j = (u >> 3) & 31, i = u >> 8; const int pi = i >> 1; const int blk = (i & 1) ? (255 - (j + 32 * pi)) : (j + 32 * pi);
        const int t0 = blk * QU; const size_t mb = (size_t)b * T;
        const int nkt = (t0 + QU + 31) >> 5;
        bf16x8 af[4][4];
#pragma unroll
        for (int a = 0; a < 4; ++a) {
            const bf16* qp = H + (mb + t0 + 4 * a + ql) * D_INP + C_IQ + hd * 64 + 8 * hf;
#pragma unroll
            for (int k = 0; k < 4; ++k) af[a][k] = *(const GAS bf16x8*)(qp + 16 * k);
        }
        if (C.tid < 128) { const int q = C.tid >> 3, h8 = C.tid & 7; W16[C.tid] = bf2f(H[(mb + t0 + q) * D_INP + C_IW + h8]) * (0.125f * 0.35355339059327373f); }
        __syncthreads();
        {
            int kt = C.wave; bf16x8 bk[4], bn[4];
            if (kt < nkt) { const bf16* kp = IKN + (mb + kt * 32 + r32) * 64 + 8 * hf;
#pragma unroll
                for (int k = 0; k < 4; ++k) bk[k] = *(const GAS bf16x8*)(kp + 16 * k); }
            for (; kt < nkt; kt += NWAVES) {
                const int s0 = kt * 32;
                if (kt + NWAVES < nkt) { const bf16* kp = IKN + (mb + s0 + 32 * NWAVES + r32) * 64 + 8 * hf;
#pragma unroll
                    for (int k = 0; k < 4; ++k) bn[k] = *(const GAS bf16x8*)(kp + 16 * k); }
#pragma unroll
                for (int a = 0; a < 4; ++a) {
                    f32x16 acc = {0.f, 0.f, 0.f, 0.f, 0.f, 0.f, 0.f, 0.f, 0.f, 0.f, 0.f, 0.f, 0.f, 0.f, 0.f, 0.f};
#pragma unroll
                    for (int k = 0; k < 4; ++k) acc = __builtin_amdgcn_mfma_f32_32x32x16_bf16(af[a][k], bk[k], acc, 0, 0, 0);
#pragma unroll
                    for (int qh = 0; qh < 2; ++qh) { float sa = 0.f, sb = 0.f;
                        const int q = 4 * a + 2 * qh + hf, key = s0 + r32;
                        const f32x4 wl = *(const LAS f32x4*)(W16 + q * 8), wh = *(const LAS f32x4*)(W16 + q * 8 + 4);
                        sa = fmaf(wl[0], relu_i(acc[8 * qh + 0]), sa); sb = fmaf(wl[1], relu_i(acc[8 * qh + 1]), sb); sa = fmaf(wl[2], relu_i(acc[8 * qh + 2]), sa); sb = fmaf(wl[3], relu_i(acc[8 * qh + 3]), sb);
                        sa = fmaf(wh[0], relu_i(acc[8 * qh + 4]), sa); sb = fmaf(wh[1], relu_i(acc[8 * qh + 5]), sb); sa = fmaf(wh[2], relu_i(acc[8 * qh + 6]), sa); sb = fmaf(wh[3], relu_i(acc[8 * qh + 7]), sb);
                        float sv = sa + sb; const bool valid = key <= t0 + q; sv += 0.0f;
                        ISC[q * 4096 + key] = valid ? (h16)sv : (h16)(-INFINITY);
                    }
                }
#pragma unroll
                for (int k = 0; k < 4; ++k) bk[k] = bn[k];
            }
        }
        __syncthreads();
        for (int q = C.wave; q < QU; q += NWAVES) {
            const int t = t0 + q, n = t + 1; const LAS unsigned short* row = (const LAS unsigned short*)(ISC + q * 4096);
            unsigned* mrow = MASK + (mb + t) * 128;
            if (n <= TOPK) {
#pragma unroll
                for (int w2 = 0; w2 < 2; ++w2) { const int wi = lane + 64 * w2; const int lo = 32 * wi; unsigned bits;
                    if (lo + 31 <= t) bits = 0xffffffffu; else if (lo > t) bits = 0u; else bits = (1u << (t - lo + 1)) - 1u;
                    mrow[wi] = bits; }
            } else {
                unsigned dhi = 0u; int need = TOPK;
#pragma unroll
                for (int pass = 1; pass >= 0; --pass) {
                    LDS_WAIT();
#pragma unroll
                    for (int z = 0; z < 4; ++z) HIST[lane + 64 * z] = 0u;
#pragma unroll 2
                    for (int e0 = 8 * lane; e0 < n; e0 += 512) { const v4u v = *(const LAS v4u*)(row + e0);
#pragma unroll
                        for (int jj = 0; jj < 8; ++jj) { const unsigned w = (jj < 2) ? v.x : (jj < 4) ? v.y : (jj < 6) ? v.z : v.w; const unsigned hb = (jj & 1) ? (w >> 16) : (w & 0xffffu);
                            const unsigned key = h2ord(hb);
                            const bool ok = (e0 + jj < n) && (pass == 1 || (key >> 8) == dhi);
                            if (ok) atomicAdd((unsigned*)&HIST[pass == 1 ? (key >> 8) : (key & 255u)], 1u); } }
                    LDS_WAIT();
                    const v4u c4 = *(const LAS v4u*)(HIST + 4 * lane);
                    const unsigned c0 = c4.x, c1 = c4.y, c2 = c4.z, c3 = c4.w; const unsigned s4 = c0 + c1 + c2 + c3;
                    unsigned suf = s4;
#pragma unroll
                    for (int o = 1; o < 64; o <<= 1) { const unsigned v2 = __shfl_down(suf, o); if (lane + o < 64) suf += v2; }
                    unsigned cum = suf - s4; int dsel = -1; int nnew = 0; const unsigned nd = (unsigned)need;
                    if (cum < nd && nd <= cum + c3) { dsel = 4 * lane + 3; nnew = (int)(nd - cum); } cum += c3;
                    if (dsel < 0 && cum < nd && nd <= cum + c2) { dsel = 4 * lane + 2; nnew = (int)(nd - cum); } cum += c2;
                    if (dsel < 0 && cum < nd && nd <= cum + c1) { dsel = 4 * lane + 1; nnew = (int)(nd - cum); } cum += c1;
                    if (dsel < 0 && cum < nd && nd <= cum + c0) { dsel = 4 * lane + 0; nnew = (int)(nd - cum); }
                    const unsigned long long bal = __ballot(dsel >= 0);
                    const int src = (bal != 0ull) ? (int)__builtin_ctzll(bal) : 0;
                    const int dd = __shfl(dsel, src); need = __shfl(nnew, src);
                    if (pass == 1) dhi = (unsigned)dd; else dhi = (dhi << 8) | (unsigned)dd;
                }
                const unsigned Tk = dhi;
                int run_eq = 0; unsigned long long mine = 0ull; const int nit = (t >> 6) + 1;
#pragma unroll 4
                for (int it = 0; it < nit; ++it) { const int e = it * 64 + lane; const unsigned key = h2ord(row[e]); const bool valid = e <= t;
                    const bool eq = valid && (key == Tk); const unsigned long long beq = __ballot(eq);
                    const int rk = run_eq + __builtin_popcountll(beq & ((1ull << lane) - 1ull));
                    const bool sel = valid && ((key > Tk) || (eq && rk < need)); run_eq += __builtin_popcountll(beq);
                    const unsigned long long bs = __ballot(sel);
                    if (lane == it) mine = bs; }
                *(GAS v2u*)(mrow + 2 * lane) = (v2u){(unsigned)mine, (unsigned)(mine >> 32)};
            }
        }
        __syncthreads();
    }
}

__device__ __forceinline__ void attn_task(const bf16* H, const bf16* KH, const bf16* VT, const unsigned* MASK, bf16* YM, int b, int hh, int t0, int lane) {
    const int r32 = lane & 31, hf = lane >> 5;
    const float LOG2E = 1.4426950408889634f; const float c1 = 0.125f * LOG2E; const float sl2 = exp2f(-(float)(hh + 1)) * LOG2E;
    const size_t mb = (size_t)b * T;
    bf16x8 qf[4];
#pragma unroll
    for (int k = 0; k < 4; ++k) qf[k] = *(const GAS bf16x8*)(H + (mb + t0 + r32) * D_INP + C_AQ + hh * 64 + 16 * k + 8 * hf);
    const bf16* kbase = KH + ((size_t)(b * 8 + hh) * T) * 64; const bf16* vbase = VT + ((size_t)(b * 512 + hh * 64)) * T; const unsigned* mrow = MASK + (mb + t0 + r32) * 128;
    float m_run = -1e30f, l = 0.f;
    f32x16 O0 = {0.f, 0.f, 0.f, 0.f, 0.f, 0.f, 0.f, 0.f, 0.f, 0.f, 0.f, 0.f, 0.f, 0.f, 0.f, 0.f}, O1 = O0;
    const int nkt = (t0 + 32 + 63) >> 6;
    for (int kt = 0; kt < nkt; ++kt) {
        const int s0 = kt * 64;
        bf16x8 kf[2][4];
#pragma unroll
        for (int uu = 0; uu < 2; ++uu)
#pragma unroll
            for (int k = 0; k < 4; ++k) kf[uu][k] = *(const GAS bf16x8*)(kbase + (size_t)(s0 + 32 * uu + r32) * 64 + 16 * k + 8 * hf);
        const v2u mw = *(const GAS v2u*)(mrow + 2 * kt);
        s16x4 vl[2][2][2], vh[2][2][2];
#pragma unroll
        for (int uu = 0; uu < 2; ++uu)
#pragma unroll
            for (int sp = 0; sp < 2; ++sp)
#pragma unroll
                for (int dt = 0; dt < 2; ++dt) { const bf16* vp = vbase + (size_t)(dt * 32 + r32) * T + s0 + 32 * uu + 16 * sp + 4 * hf;
                    vl[uu][sp][dt] = *(const GAS s16x4*)vp; vh[uu][sp][dt] = *(const GAS s16x4*)(vp + 8); }
        f32x16 a0 = {0.f, 0.f, 0.f, 0.f, 0.f, 0.f, 0.f, 0.f, 0.f, 0.f, 0.f, 0.f, 0.f, 0.f, 0.f, 0.f}, a1 = a0;
#pragma unroll
        for (int k = 0; k < 4; ++k) { a0 = __builtin_amdgcn_mfma_f32_32x32x16_bf16(kf[0][k], qf[k], a0, 0, 0, 0); a1 = __builtin_amdgcn_mfma_f32_32x32x16_bf16(kf[1][k], qf[k], a1, 0, 0, 0); }
        const float dist0 = (float)(t0 + r32 - s0 - 4 * hf);
        const unsigned m0 = mw.x >> (4 * hf), m1 = mw.y >> (4 * hf);
        float mx = -1e30f;
#pragma unroll
        for (int r = 0; r < 16; ++r) { const int ko = (r & 3) + 8 * (r >> 2);
            const float d0 = dist0 - (float)ko;
            a0[r] = ((m0 >> ko) & 1u) ? (a0[r] * c1 - sl2 * d0) : -1e30f;
            a1[r] = ((m1 >> ko) & 1u) ? (a1[r] * c1 - sl2 * (d0 - 32.f)) : -1e30f;
            mx = fmaxf(mx, fmaxf(a0[r], a1[r])); }
        mx = fmaxf(mx, __shfl_xor(mx, 32));
        const float m_new = fmaxf(m_run, mx); const float alpha = __builtin_amdgcn_exp2f(m_run - m_new); m_run = m_new;
        float ps = 0.f;
#pragma unroll
        for (int r = 0; r < 16; ++r) { const int ko = (r & 3) + 8 * (r >> 2);
            const float p0 = ((m0 >> ko) & 1u) ? __builtin_amdgcn_exp2f(a0[r] - m_new) : 0.f;
            const float p1 = ((m1 >> ko) & 1u) ? __builtin_amdgcn_exp2f(a1[r] - m_new) : 0.f;
            a0[r] = p0; a1[r] = p1; ps += p0 + p1; }
        l = l * alpha + ps;
#pragma unroll
        for (int r = 0; r < 16; ++r) { O0[r] *= alpha; O1[r] *= alpha; }
#pragma unroll
        for (int sp = 0; sp < 2; ++sp) {
            const bf16x8 pb0 = pack8(a0, 8 * sp), pb1 = pack8(a1, 8 * sp);
#define VFR(uu, dt) ((bf16x8){vl[uu][sp][dt][0], vl[uu][sp][dt][1], vl[uu][sp][dt][2], vl[uu][sp][dt][3], vh[uu][sp][dt][0], vh[uu][sp][dt][1], vh[uu][sp][dt][2], vh[uu][sp][dt][3]})
            O0 = __builtin_amdgcn_mfma_f32_32x32x16_bf16(VFR(0, 0), pb0, O0, 0, 0, 0);
            O1 = __builtin_amdgcn_mfma_f32_32x32x16_bf16(VFR(0, 1), pb0, O1, 0, 0, 0);
            O0 = __builtin_amdgcn_mfma_f32_32x32x16_bf16(VFR(1, 0), pb1, O0, 0, 0, 0);
            O1 = __builtin_amdgcn_mfma_f32_32x32x16_bf16(VFR(1, 1), pb1, O1, 0, 0, 0);
#undef VFR
        }
    }
    l += __shfl_xor(l, 32);
    const float inv = 1.f / l;
    bf16* yp = YM + (mb + t0 + r32) * D + hh * 64 + 4 * hf;
#pragma unroll
    for (int rq = 0; rq < 4; ++rq) {
        v2u o; o.x = cvtpk(O0[4 * rq] * inv, O0[4 * rq + 1] * inv); o.y = cvtpk(O0[4 * rq + 2] * inv, O0[4 * rq + 3] * inv); *(GAS v2u*)(yp + 8 * rq) = o;
        v2u o2; o2.x = cvtpk(O1[4 * rq] * inv, O1[4 * rq + 1] * inv); o2.y = cvtpk(O1[4 * rq + 2] * inv, O1[4 * rq + 3] * inv); *(GAS v2u*)(yp + 32 + 8 * rq) = o2; }
}
__device__ __forceinline__ void p4_attention(const Params& P, const Ctx& C) {
    unsigned char* ws = P.ws;
    const bf16* H = (const bf16*)(ws + WS_H); const bf16* KH = (const bf16*)(ws + WS_K); const bf16* VT = (const bf16*)(ws + WS_VT); const unsigned* MASK = (const unsigned*)(ws + WS_MASK); bf16* YM = (bf16*)(ws + WS_YMIX);
    for (int p = blockIdx.x; p < 512; p += C.G) {
        const int bh = p >> 3, j = p & 7; const int b = bh >> 3, hh = bh & 7;
        attn_task(H, KH, VT, MASK, YM, b, hh, j * 256 + C.wave * 32, C.lane);
        attn_task(H, KH, VT, MASK, YM, b, hh, (15 - j) * 256 + (7 - C.wave) * 32, C.lane);
    }
}

constexpr int AT_KB = 64 * 144, AT_VB = 64 * 136, AT_VOFF = 2 * AT_KB;
__device__ __forceinline__ void attn_block(const Ctx& C, const bf16* H, const bf16* KH, const bf16* VT, const unsigned* MASK, bf16* YM, int b, int hh, int qb) {
    const int lane = C.lane, r32 = lane & 31, hf = lane >> 5, tid = C.tid;
    const float LOG2E = 1.4426950408889634f; const float c1 = 0.125f * LOG2E; const float sl2 = exp2f(-(float)(hh + 1)) * LOG2E;
    const size_t mb = (size_t)b * T; const int t0 = qb * 256 + C.wave * 32;
    bf16x8 qf[4];
#pragma unroll
    for (int k = 0; k < 4; ++k) { const v4u w = *(const GAS v4u*)(H + (mb + t0 + r32) * D_INP + C_AQ + hh * 64 + 16 * k + 8 * hf);
        v4u o; o.x = cvtpk(bflo(w.x) * c1, bfhi(w.x) * c1); o.y = cvtpk(bflo(w.y) * c1, bfhi(w.y) * c1); o.z = cvtpk(bflo(w.z) * c1, bfhi(w.z) * c1); o.w = cvtpk(bflo(w.w) * c1, bfhi(w.w) * c1);
        qf[k] = __builtin_bit_cast(bf16x8, o); }
    const bf16* kbase = KH + ((size_t)(b * 8 + hh) * T) * 64; const bf16* vbase = VT + ((size_t)(b * 512 + hh * 64)) * T; const unsigned* mrow = MASK + (mb + t0 + r32) * 128;
    const int srow = tid >> 3, sch = tid & 7;
    const bf16* kst = kbase + (size_t)srow * 64 + 8 * sch; const bf16* vst = vbase + (size_t)srow * T + 8 * sch;
    LAS unsigned char* kw = C.lds + srow * 144 + 16 * sch; LAS unsigned char* vw = C.lds + AT_VOFF + srow * 136 + 16 * sch;
    const LAS unsigned char* kr = C.lds + r32 * 144 + 16 * hf; const LAS unsigned char* vr = C.lds + AT_VOFF + r32 * 136 + 8 * hf;
    float m_run = -1e30f, l = 0.f;
    f32x16 O0 = {0.f, 0.f, 0.f, 0.f, 0.f, 0.f, 0.f, 0.f, 0.f, 0.f, 0.f, 0.f, 0.f, 0.f, 0.f, 0.f}, O1 = O0;
    const int nkt = 4 * (qb + 1), ktw = (t0 + 31) >> 6;
    v4u kn = *(const GAS v4u*)kst, vn = *(const GAS v4u*)vst; v2u mwn = *(const GAS v2u*)mrow;
    *(LAS v4u*)kw = kn; *(LAS v2u*)vw = (v2u){vn.x, vn.y}; *(LAS v2u*)(vw + 8) = (v2u){vn.z, vn.w};
    __syncthreads();
    for (int kt = 0; kt < nkt; ++kt) {
        const int s0 = kt * 64; const int cur = kt & 1; const v2u mw = mwn;
        if (kt + 1 < nkt) { kn = *(const GAS v4u*)(kst + (size_t)(s0 + 64) * 64); vn = *(const GAS v4u*)(vst + s0 + 64); mwn = *(const GAS v2u*)(mrow + 2 * kt + 2); }
        if (kt <= ktw) {
            const LAS unsigned char* kc = kr + cur * AT_KB; const LAS unsigned char* vc = vr + cur * AT_VB;
            const float B0 = -sl2 * (float)(t0 + r32 - s0 - 4 * hf);
            f32x16 a0, a1;
#pragma unroll
            for (int r = 0; r < 16; ++r) { const float ko = (float)((r & 3) + 8 * (r >> 2)); a0[r] = B0 + sl2 * ko; a1[r] = B0 + sl2 * (ko + 32.f); }
#pragma unroll
            for (int k = 0; k < 4; ++k) { const bf16x8 k0 = *(const LAS bf16x8*)(kc + 32 * k), k1 = *(const LAS bf16x8*)(kc + 32 * 144 + 32 * k);
                a0 = __builtin_amdgcn_mfma_f32_32x32x16_bf16(k0, qf[k], a0, 0, 0, 0); a1 = __builtin_amdgcn_mfma_f32_32x32x16_bf16(k1, qf[k], a1, 0, 0, 0); }
            const unsigned m0 = mw.x >> (4 * hf), m1 = mw.y >> (4 * hf);
            float mx = -1e30f;
#pragma unroll
            for (int r = 0; r < 16; ++r) { const int ko = (r & 3) + 8 * (r >> 2);
                const unsigned k0m = (unsigned)__builtin_amdgcn_sbfe((int)m0, ko, 1), k1m = (unsigned)__builtin_amdgcn_sbfe((int)m1, ko, 1);
                const float x0 = a0[r], x1 = a1[r];
                a0[r] = __builtin_bit_cast(float, (__builtin_bit_cast(unsigned, x0) & k0m) | (0xf149f2cau & ~k0m));
                a1[r] = __builtin_bit_cast(float, (__builtin_bit_cast(unsigned, x1) & k1m) | (0xf149f2cau & ~k1m));
                mx = fmaxf(mx, fmaxf(a0[r], a1[r])); }
            mx = fmaxf(mx, __shfl_xor(mx, 32));
            const float m_new = fmaxf(m_run, mx);
            const float m_use = fmaxf(m_new, -1e20f);
            float ps = 0.f;
#pragma unroll
            for (int r = 0; r < 16; ++r) { const float p0 = __builtin_amdgcn_exp2f(a0[r] - m_use), p1 = __builtin_amdgcn_exp2f(a1[r] - m_use); a0[r] = p0; a1[r] = p1; ps += p0 + p1; }
            if (__builtin_amdgcn_ballot_w64(m_new != m_run) != 0ull) {
                const float alpha = __builtin_amdgcn_exp2f(m_run - m_new); m_run = m_new;
                l *= alpha;
#pragma unroll
                for (int r = 0; r < 16; ++r) { O0[r] *= alpha; O1[r] *= alpha; }
            }
            l += ps;
#pragma unroll
            for (int sp = 0; sp < 2; ++sp) {
                const bf16x8 pb0 = pack8(a0, 8 * sp), pb1 = pack8(a1, 8 * sp);
#define VLD(uu, dt) ({ const s16x4 lo_ = *(const LAS s16x4*)(vc + (dt) * 32 * 136 + 2 * (32 * (uu) + 16 * sp)), hi_ = *(const LAS s16x4*)(vc + (dt) * 32 * 136 + 2 * (32 * (uu) + 16 * sp + 8)); (bf16x8){lo_[0], lo_[1], lo_[2], lo_[3], hi_[0], hi_[1], hi_[2], hi_[3]}; })
                O0 = __builtin_amdgcn_mfma_f32_32x32x16_bf16(VLD(0, 0), pb0, O0, 0, 0, 0);
                O1 = __builtin_amdgcn_mfma_f32_32x32x16_bf16(VLD(0, 1), pb0, O1, 0, 0, 0);
                O0 = __builtin_amdgcn_mfma_f32_32x32x16_bf16(VLD(1, 0), pb1, O0, 0, 0, 0);
                O1 = __builtin_amdgcn_mfma_f32_32x32x16_bf16(VLD(1, 1), pb1, O1, 0, 0, 0);
#undef VLD
            }
        }
        if (kt + 1 < nkt) { const int nx = cur ^ 1; *(LAS v4u*)(kw + nx * AT_KB) = kn; *(LAS v2u*)(vw + nx * AT_VB) = (v2u){vn.x, vn.y}; *(LAS v2u*)(vw + nx * AT_VB + 8) = (v2u){vn.z, vn.w}; }
        __syncthreads();
    }
    l += __shfl_xor(l, 32);
    const float inv = 1.f / l;
    unsigned char* yp = (unsigned char*)YM + (mb + t0 + r32) * D + hh * 64 + 4 * hf;
    const float i8 = inv * 8.f;
#pragma unroll
    for (int rq = 0; rq < 4; ++rq) {
        *(GAS unsigned*)(yp + 8 * rq) = pk4_fp8(O0[4 * rq] * i8, O0[4 * rq + 1] * i8, O0[4 * rq + 2] * i8, O0[4 * rq + 3] * i8);
        *(GAS unsigned*)(yp + 32 + 8 * rq) = pk4_fp8(O1[4 * rq] * i8, O1[4 * rq + 1] * i8, O1[4 * rq + 2] * i8, O1[4 * rq + 3] * i8); }
}
__device__ __forceinline__ void p4_attention2(const Params& P, const Ctx& C) {
    unsigned char* ws = P.ws;
    const bf16* H = (const bf16*)(ws + WS_H); const bf16* KH = (const bf16*)(ws + WS_K); const bf16* VT = (const bf16*)(ws + WS_VT); const unsigned* MASK = (const unsigned*)(ws + WS_MASK); bf16* YM = (bf16*)(ws + WS_YMIX);
    for (int p = blockIdx.x; p < 512; p += C.G) {
        const int b = p & 7, q = p >> 3; const int hh = q >> 3, j = q & 7;
        attn_block(C, H, KH, VT, MASK, YM, b, hh, j);
        attn_block(C, H, KH, VT, MASK, YM, b, hh, 15 - j);
    }
}

#ifndef FEAT_MIX
#define FEAT_MIX 1
#endif
#ifndef FEAT_MOE
#define FEAT_MOE 1
#endif
#ifndef FEAT_PLE
#define FEAT_PLE 1
#endif
#ifndef FEAT_ATT
#define FEAT_ATT 1
#endif

__device__ __forceinline__ void p6_ln1_router(const Params& P, const Ctx& C) {
    unsigned char* ws = P.ws;
    float* X1 = (float*)(ws + WS_X1); bf16* XB = (bf16*)(ws + WS_XB);
    LAS float* wl = (LAS float*)C.lds;
    LAS int* hist = (LAS int*)(C.lds + MISC_OFF);
#if FEAT_MOE
    { const float* wr = P.in[I_WR];
      for (int i = C.tid; i < 32 * 1024; i += NTHR) { const int e = i >> 10, k = i & 1023; wl[i] = wr[k * 32 + e]; }
      if (C.tid < 32) hist[C.tid] = 0; }
    __syncthreads();
    int* tope = (int*)(ws + WS_TOPE); float* gate = (float*)(ws + WS_GATE); int* lrank = (int*)(ws + WS_LRANK);
    const float* br = P.in[I_BR];
#endif
#if FEAT_MIX
    const float* src = P.out; const float sc = 1.0f;
#else
    const float* src = P.in[I_X]; const float sc = ALPHA;
#endif
    for (int m = C.gw; m < NTOK; m += C.ngw) {
        f32x4 v[4]; load_row_f32(v, src + (size_t)m * D, C.lane);
#pragma unroll
        for (int j = 0; j < 4; ++j) v[j] = v[j] * sc;
        ln_row(v, P.in[I_LNMG], P.in[I_LNMB], C.lane);
        store_row_f32(X1 + (size_t)m * D, v, C.lane);
        store_row_fp8x8((unsigned char*)XB + (size_t)m * D, v, C.lane);
#if FEAT_MOE
        float lv[32];
#pragma unroll
        for (int e = 0; e < 32; ++e) { float a = 0.f;
#pragma unroll
            for (int j = 0; j < 4; ++j) { const f32x4 w = *(const LAS f32x4*)(wl + e * 1024 + 4 * C.lane + 256 * j); a += (v[j][0] * w[0] + v[j][1] * w[1]) + (v[j][2] * w[2] + v[j][3] * w[3]); }
            lv[e] = wave_sum(a) + br[e]; }
        int se[4]; float sv[4];
#pragma unroll
        for (int k = 0; k < 4; ++k) { float best = -INFINITY; int bi = 0;
#pragma unroll
            for (int e = 0; e < 32; ++e) if (lv[e] > best) { best = lv[e]; bi = e; }
            se[k] = bi; sv[k] = best;
#pragma unroll
            for (int e = 0; e < 32; ++e) lv[e] = (e == bi) ? -INFINITY : lv[e]; }
        float ex[4], sum = 0.f;
#pragma unroll
        for (int k = 0; k < 4; ++k) { ex[k] = __expf(sv[k] - sv[0]); sum += ex[k]; }
        const float inv = 1.f / sum;
        if (C.lane == 0) {
#pragma unroll
            for (int k = 0; k < 4; ++k) { const int lr = atomicAdd((int*)&hist[se[k]], 1); tope[m * 4 + k] = se[k]; gate[m * 4 + k] = ex[k] * inv; lrank[m * 4 + k] = lr; } }
#endif
    }
#if FEAT_MOE
    __syncthreads();
    if (C.tid < 32) { unsigned* cnt = (unsigned*)(ws + WS_CTL) + CW_CNT; const int base = (int)atomicAdd(cnt + C.tid, (unsigned)hist[C.tid]); ((int*)(ws + WS_WGBASE))[blockIdx.x * 32 + C.tid] = base; }
#endif
}

__device__ __forceinline__ void p7_dispatch(const Params& P, const Ctx& C) {
    unsigned char* ws = P.ws;
    LAS int* ps = (LAS int*)(C.lds + MISC_OFF + 256);
    const unsigned* cnt = (const unsigned*)(ws + WS_CTL) + CW_CNT;
    int* tile_e = (int*)(ws + WS_TILEE);
    if (C.tid == 0) { int run = 0;
        for (int e = 0; e < NE; ++e) { const int c = (int)__hip_atomic_load(cnt + e, __ATOMIC_RELAXED, __HIP_MEMORY_SCOPE_AGENT); ps[e] = run; const int nt = (c + 255) >> 8;
            if (blockIdx.x == 0) for (int t = 0; t < nt; ++t) tile_e[(run >> 8) + t] = e;
            run += nt << 8; }
        if (blockIdx.x == 0) tile_e[MAXTILES] = run >> 8; }
    __syncthreads();
    const int* tope = (const int*)(ws + WS_TOPE); const float* gate = (const float*)(ws + WS_GATE); const int* lrank = (const int*)(ws + WS_LRANK);
    const int* wgb = (const int*)(ws + WS_WGBASE);
    int* tokslot = (int*)(ws + WS_TOKSLOT); float* slotgate = (float*)(ws + WS_SLOTGATE);
    const bf16* XB = (const bf16*)(ws + WS_XB); unsigned char* xs = ws + WS_XS;
    for (int m = C.gw; m < NTOK; m += C.ngw) {
        const int wgm = (m % C.ngw) >> 3;
        const v4u f8 = *(const GAS v4u*)((const unsigned char*)XB + (size_t)m * D + 16 * C.lane);
#pragma unroll
        for (int k = 0; k < 4; ++k) { const int e = tope[m * 4 + k]; const int slot = ps[e] + wgb[wgm * 32 + e] + lrank[m * 4 + k];
            *(GAS v4u*)(xs + (size_t)slot * D + 16 * C.lane) = f8;
            if (C.lane == 0) { slotgate[slot] = gate[m * 4 + k]; tokslot[m * 4 + k] = slot; } }
    }
}

__device__ __forceinline__ void p10_combine_ln2(const Params& P, const Ctx& C) {
    unsigned char* ws = P.ws;
    float* X1 = (float*)(ws + WS_X1); bf16* XB = (bf16*)(ws + WS_XB);
    const int* tokslot = (const int*)(ws + WS_TOKSLOT); const bf16* ys = (const bf16*)(ws + WS_YSLOT);
    for (int m = C.gw; m < NTOK; m += C.ngw) {
        f32x4 v[4]; load_row_f32(v, X1 + (size_t)m * D, C.lane);
#pragma unroll
        for (int j = 0; j < 4; ++j) v[j] = v[j] * ALPHA;
#if FEAT_MOE
#pragma unroll
        for (int k = 0; k < 4; ++k) { const int slot = tokslot[m * 4 + k]; const bf16* yr = ys + (size_t)slot * D;
#pragma unroll
            for (int j = 0; j < 4; ++j) { const v2u w = *(const GAS v2u*)(yr + 4 * C.lane + 256 * j); v[j][0] += bflo(w.x); v[j][1] += bfhi(w.x); v[j][2] += bflo(w.y); v[j][3] += bfhi(w.y); } }
#endif
        ln_row(v, P.in[I_LNFG], P.in[I_LNFB], C.lane);
        store_row_f32(P.out + (size_t)m * D, v, C.lane);
        store_row_fp8x8((unsigned char*)XB + (size_t)m * D, v, C.lane);
    }
}

__device__ __forceinline__ void p12_final_ln(const Params& P, const Ctx& C) {
#if FEAT_PLE
    const float* src = (const float*)(P.ws + WS_X1); const float sc = 1.0f;
#else
    const float* src = P.out; const float sc = ALPHA;
#endif
    for (int m = C.gw; m < NTOK; m += C.ngw) {
        f32x4 v[4]; load_row_f32(v, src + (size_t)m * D, C.lane);
#pragma unroll
        for (int j = 0; j < 4; ++j) v[j] = v[j] * sc;
        ln_row(v, P.in[I_LNPG], P.in[I_LNPB], C.lane);
        store_row_f32(P.out + (size_t)m * D, v, C.lane);
    }
}
#define XB_TMO      128
#define XB_XCNT(j)  (256  + 64 * (j))
#define XB_XSUB(j)  (1280 + 64 * (j))
#define XB_XGEN(j)  (2304 + 64 * (j))
#define XB_TOP      3328
#define XB_TOPGEN   3392
#define XCD_BAR_WORDS 3456
#define XB_SPIN_CAP (1u << 18)
#define LAS __attribute__((address_space(3)))

__device__ __forceinline__ unsigned xb_ld(unsigned* p)              { return __hip_atomic_load(p, __ATOMIC_RELAXED, __HIP_MEMORY_SCOPE_AGENT); }
__device__ __forceinline__ unsigned xb_add(unsigned* p, unsigned v) { return __hip_atomic_fetch_add(p, v, __ATOMIC_RELAXED, __HIP_MEMORY_SCOPE_AGENT); }
__device__ __forceinline__ unsigned xb_xcc_id() { return (unsigned)__builtin_amdgcn_s_getreg((3 << 11) | 20) & 0xFu; }
#define XB_SPIN(cond, bar) do { unsigned _sp = 0; while (cond) { __builtin_amdgcn_s_sleep(1); \
    if ((++_sp & 255u) == 0u) { if (xb_ld(&(bar)[XB_TMO])) break; if (_sp > XB_SPIN_CAP) { atomicAdd(&(bar)[XB_TMO], 1u); break; } } } } while (0)

struct XcdBarrier {
    unsigned* bar; unsigned x;
    volatile LAS unsigned* st;
};

__device__ __forceinline__ XcdBarrier xcd_barrier_post(unsigned* bar, volatile LAS unsigned* st) {
    XcdBarrier b; b.bar = bar; b.x = xb_xcc_id(); b.st = st;
    if (threadIdx.x == 0) (void)xb_add(&bar[XB_XCNT(b.x)], 1u);
    return b;
}
__device__ __forceinline__ void xcd_barrier_complete(unsigned* bar, unsigned x, unsigned& nloc, unsigned& nx) {
    const unsigned G = gridDim.x * gridDim.y * gridDim.z;
    unsigned sum, cnt, mine, sp = 0u;
    for (;;) {
        sum = 0u; cnt = 0u; mine = 0u;
#pragma unroll
        for (unsigned j = 0; j < 16; ++j) { const unsigned c = xb_ld(&bar[XB_XCNT(j)]); sum += c; cnt += (c > 0u) ? 1u : 0u; mine = (j == x) ? c : mine; }
        if (sum == G) break;
        __builtin_amdgcn_s_sleep(1);
        if ((++sp & 255u) == 0u) { if (xb_ld(&bar[XB_TMO])) break; if (sp > XB_SPIN_CAP) { atomicAdd(&bar[XB_TMO], 1u); break; } }
    }
    nloc = mine > 0u ? mine : 1u; nx = cnt > 0u ? cnt : 1u;
}

__device__ __forceinline__ void xcd_barrier(const XcdBarrier& b) {
    asm volatile("s_waitcnt vmcnt(0)" ::: "memory");
    __syncthreads();
    if (threadIdx.x == 0) {
        unsigned* bar = b.bar;
        __builtin_amdgcn_s_waitcnt(0);
        unsigned nloc = b.st[0], nx = b.st[1];
        if (nloc == 0u) { xcd_barrier_complete(bar, b.x, nloc, nx); b.st[0] = nloc; b.st[1] = nx; }
        const unsigned old = xb_add(&bar[XB_XSUB(b.x)], 1u);
        const unsigned gen = old / nloc;
        if (old + 1u == (gen + 1u) * nloc) {
            __builtin_amdgcn_fence(__ATOMIC_RELEASE, "agent");
            asm volatile("s_waitcnt vmcnt(0)" ::: "memory");
            const unsigned og = xb_add(&bar[XB_TOP], 1u);
            const unsigned tg = og / nx;
            if (og + 1u == (tg + 1u) * nx) xb_add(&bar[XB_TOPGEN], 1u);
            else XB_SPIN(xb_ld(&bar[XB_TOPGEN]) == tg, bar);
            __builtin_amdgcn_fence(__ATOMIC_ACQUIRE, "agent");
            xb_add(&bar[XB_XGEN(b.x)], 1u);
            asm volatile("s_waitcnt vmcnt(0)" ::: "memory");
        } else {
            XB_SPIN(xb_ld(&bar[XB_XGEN(b.x)]) == gen, bar);
            __builtin_amdgcn_fence(__ATOMIC_ACQUIRE, "agent");
            asm volatile("s_waitcnt vmcnt(0)" ::: "memory");
        }
    }
    __syncthreads();
}


template <int PH> __device__ __forceinline__ void run_phase(const Params& P, const Ctx& C) {
    unsigned char* ws = P.ws;
    typedef pg8::bf16_t pbf;
    if constexpr (PH == 0) { p0_prologue(P, C); }
    else if constexpr (PH == 10) {
        pg8::Gemm g{(const pbf*)(ws + WS_XBF), (const pbf*)(ws + WS_WIN_T), NTOK, D_INP, D}; pg8::StaticOrder S; S.init(NTOK, D_INP, C.G, (int)blockIdx.x);
        pg8::EpiBf16s E{(pbf*)(ws + WS_H), D_INP};
        pg8::gemm_phase<pg8::EpiBf16s, pg8::StaticOrder, true, true>(C.lds, g, S, E); }
    else if constexpr (PH == 11) {
        pg8::Gemm g{(const pbf*)(ws + WS_PB), (const pbf*)(ws + WS_WPROJ_T), NTOK, D, PLE}; pg8::StaticOrder S; S.init(NTOK, D, C.G, (int)blockIdx.x);
        pg8::EpiBf16s E{(pbf*)(ws + WS_PROJ), D};
        pg8::gemm_phase<pg8::EpiBf16s, pg8::StaticOrder, true, true>(C.lds, g, S, E); }
    else if constexpr (PH == 20) { p2_post(P, C); }
    else if constexpr (PH == 21) { p2_hgrn_prep(P, C); }
    else if constexpr (PH == 30) {
        { pg8::Gemm g{(const pbf*)(ws + WS_CN), (const pbf*)(ws + WS_WUK_T), NTOK, 512, 256}; pg8::StaticOrder S; S.init(NTOK, 512, C.G, (int)blockIdx.x);
          pg8::EpiKhead E{(pbf*)(ws + WS_K)};
          pg8::gemm_phase<pg8::EpiKhead, pg8::StaticOrder, true, true>(C.lds, g, S, E); }
        { pg8::Gemm g{(const pbf*)(ws + WS_WUV_T), (const pbf*)(ws + WS_CN), 512, NTOK, 256}; pg8::StaticOrder S; S.init(512, NTOK, C.G, (int)blockIdx.x);
          pg8::EpiVt E{(pbf*)(ws + WS_VT)};
          pg8::gemm_phase<pg8::EpiVt, pg8::StaticOrder, true, true>(C.lds, g, S, E); }
    }
    else if constexpr (PH == 31) { p3_indexer(P, C); }
    else if constexpr (PH == 32) { p3_hgrn_scan(P, C); }
    else if constexpr (PH == 40) { p4_attention2(P, C); }
    else if constexpr (PH == 41) { p4_yrec(P, C); }
    else if constexpr (PH == 5) {
        pg8::Gemm g{(const pbf*)(ws + WS_YMIX), (const pbf*)(ws + WS_WO_T), NTOK, D, D / 2}; pg8::StaticOrder S; S.init(NTOK, D, C.G, (int)blockIdx.x);
        pg8::EpiResid E{P.in[I_X], P.out, D, ALPHA, 1.f / 512.f};
        pg8::gemm_phase<pg8::EpiResid, pg8::StaticOrder, true, true, 1>(C.lds, g, S, E);
    }
    else if constexpr (PH == 6) { p6_ln1_router(P, C); }
    else if constexpr (PH == 7) { p7_dispatch(P, C); }
    else if constexpr (PH == 8) {
        const int* tile_e = (const int*)(ws + WS_TILEE);
        pg8::Gemm g{(const pbf*)(ws + WS_XS), (const pbf*)(ws + WS_WUP_T), CAP, NE * 2048, D / 2};
        pg8::MoeOrder S{tile_e, tile_e[MAXTILES], 8, C.G, (int)blockIdx.x};
        pg8::EpiSwiglu E{ws + WS_HH, P.in[I_BUP]};
        pg8::gemm_phase<pg8::EpiSwiglu, pg8::MoeOrder, true, true, 1, 124, 121>(C.lds, g, S, E);
    }
    else if constexpr (PH == 9) {
        const int* tile_e = (const int*)(ws + WS_TILEE);
        pg8::Gemm g{(const pbf*)(ws + WS_HH), (const pbf*)(ws + WS_WDN_T), CAP, NE * 1024, DFF / 2};
        pg8::MoeOrder S{tile_e, tile_e[MAXTILES], 4, C.G, (int)blockIdx.x};
        pg8::EpiDown E{(pbf*)(ws + WS_YSLOT), P.in[I_BDN], (const float*)(ws + WS_SLOTGATE)};
        pg8::gemm_phase<pg8::EpiDown, pg8::MoeOrder, true, true, 1, 125, 121>(C.lds, g, S, E);
    }
    else if constexpr (PH == 100) { p10_combine_ln2(P, C); }
    else if constexpr (PH == 110) {
        pg8::Gemm g{(const pbf*)(ws + WS_XB), (const pbf*)(ws + WS_WGATE_T), NTOK, D, D / 2}; pg8::StaticOrder S; S.init(NTOK, D, C.G, (int)blockIdx.x);
        pg8::EpiPle E{P.out, (const pbf*)(ws + WS_PROJ), (float*)(ws + WS_X1), ALPHA, 1.f / 512.f};
        pg8::gemm_phase<pg8::EpiPle, pg8::StaticOrder, true, true, 1>(C.lds, g, S, E);
    }
    else { p12_final_ln(P, C); }
}
__global__ void __launch_bounds__(NTHR, 2) mega_fwd(Params P) {
    extern __shared__ __attribute__((aligned(16))) unsigned char lds_raw[];
    cg::grid_group grid = cg::this_grid();
#define MKCTX Ctx C; { int tid_ = threadIdx.x; asm volatile("" : "+v"(tid_)); C.lds = (LAS unsigned char*)lds_raw; C.tid = tid_; C.lane = tid_ & 63; C.wave = __builtin_amdgcn_readfirstlane(tid_ >> 6); \
      C.G = gridDim.x; C.gw = blockIdx.x * NWAVES + C.wave; C.ngw = C.G * NWAVES; }
#if SYNC_MODE != 0
    if (threadIdx.x < 4) ((LAS unsigned*)((LAS unsigned char*)lds_raw + XBW_OFF))[threadIdx.x] = 0u;
    __syncthreads();
    XcdBarrier bar = xcd_barrier_post((unsigned*)(P.ws + WS_CTL) + CW_BAR, (volatile LAS unsigned*)((LAS unsigned char*)lds_raw + XBW_OFF));
#define SY xcd_barrier(bar);
#else
#define SY grid.sync();
#endif
#define GS grid.sync();
#define BS __syncthreads();
#define X(k) { MKCTX run_phase<k>(P, C); }
    PROGRAM
#undef X
#undef MKCTX
#undef SY
#undef GS
#undef BS
}

extern "C" void kernel_launch(void* const* d_in, const int* in_sizes, int n_in, void* d_out, int out_size, void* d_ws, size_t ws_size, hipStream_t stream) {
    static int grid = 0;
    if (grid == 0) {
        if (n_in != 25 || out_size != NTOK * D || ws_size < WS_END) { fprintf(stderr, "kernel_launch: unexpected shapes (n_in %d out %d ws %zu)\n", n_in, out_size, ws_size); grid = -1; return; }
        int dev = 0, cus = 0, per_cu = 0;
        if (hipGetDevice(&dev) != hipSuccess || hipDeviceGetAttribute(&cus, hipDeviceAttributeMultiprocessorCount, dev) != hipSuccess) { grid = -1; return; }
        if (hipFuncSetAttribute((const void*)mega_fwd, hipFuncAttributeMaxDynamicSharedMemorySize, LDS_BYTES) != hipSuccess) { fprintf(stderr, "kernel_launch: hipFuncSetAttribute failed\n"); grid = -1; return; }
        if (hipOccupancyMaxActiveBlocksPerMultiprocessor(&per_cu, (const void*)mega_fwd, NTHR, LDS_BYTES) != hipSuccess || per_cu < 1) { fprintf(stderr, "kernel_launch: occupancy query failed (%d)\n", per_cu); (void)hipGetLastError(); grid = -1; return; }
        grid = cus * per_cu;
        fprintf(stderr, "kernel_launch: grid %d (%d CUs x %d)\n", grid, cus, per_cu);
    }
    if (grid < 0) return;
    (void)hipMemsetAsync((char*)d_ws + WS_CTL, 0, CTL_ZERO_BYTES, stream);
    Params p{};
    for (int i = 0; i < 25; ++i) p.in[i] = (const float*)d_in[i];
    p.out = (float*)d_out; p.ws = (unsigned char*)d_ws;

    void* args[] = {&p};
    hipError_t e = hipLaunchCooperativeKernel((const void*)mega_fwd, dim3(grid), dim3(NTHR), args, LDS_BYTES, stream);
    if (e != hipSuccess) fprintf(stderr, "kernel_launch: cooperative launch failed: %s (grid %d)\n", hipGetErrorString(e), grid);
}
```

```cpp
#define SYNC_MODE 1
#include <hip/hip_runtime.h>
#include <hip/hip_cooperative_groups.h>
#include <cstdio>
#include <cstdint>
namespace cg = cooperative_groups;

namespace pg8 {
#define PG8_LAS __attribute__((address_space(3)))
typedef unsigned short bf16_t;
typedef short bf16x8 __attribute__((ext_vector_type(8)));
typedef float f32x4 __attribute__((ext_vector_type(4)));
typedef unsigned u32x4 __attribute__((ext_vector_type(4)));
typedef int i32x4 __attribute__((ext_vector_type(4)));
typedef int i32x8 __attribute__((ext_vector_type(8)));
constexpr int BM = 256, BK = 64, HALF = 128, HTB = HALF * BK * 2  , STAGE_BYTES = 8 * HTB, NXCD = 8, WGM = 8;

__host__ __device__ __forceinline__ int lds_byte(int r, int c) { const int st = (r >> 4) * 2 + (c >> 5), rr = r & 15, cc = c & 31, ob = rr * 64 + cc * 2; return st * 1024 + (ob ^ (((ob >> 9) & 1) << 5)); }
__host__ __device__ __forceinline__ void stage_rc(int b, int& R, int& C) { const int st = b / 1024, sb = b % 1024, swz = sb ^ (((sb >> 9) & 1) << 5); R = (st >> 1) * 16 + swz / 64; C = (st & 1) * 32 + (swz % 64) / 2; }
__host__ __device__ __forceinline__ int perm32(int rho) { const int n = rho >> 4, i = rho & 15; return 8 * (i >> 2) + 4 * n + (i & 3); }

struct Unit { int pm, pn; };
struct Gemm { const bf16_t* A; const bf16_t* Bt; int M, N, K; };

struct StaticOrder {
    int nM, nN, nwg, G, c;
    __host__ __device__ void init(int M, int N, int G_, int c_) { nM = M / BM; nN = N / BM; nwg = nM * nN; G = G_; c = c_; }
    __host__ __device__ bool next(int i, Unit& u) const {
        const long L = (long)i * G + c; if (L >= nwg) return false;
        int wgid = (int)L; { const int q = nwg / NXCD, r = nwg % NXCD, xcd = wgid % NXCD, off = wgid / NXCD; wgid = (xcd < r ? xcd * (q + 1) : r * (q + 1) + (xcd - r) * q) + off; }
        const int nig = WGM * nN, gid = wgid / nig, fm = gid * WGM, gsz = (nM - fm) < WGM ? (nM - fm) : WGM;
        u.pm = fm + ((wgid % nig) % gsz); u.pn = (wgid % nig) / gsz; return true;
    }
    __device__ __forceinline__ void a_ready(const Unit&) const {}
    __device__ __forceinline__ void done(const Unit&) const {}
};

__device__ __forceinline__ unsigned cvt_pk_bf16(float lo, float hi) { unsigned r; asm volatile("v_cvt_pk_bf16_f32 %0, %1, %2" : "=v"(r) : "v"(lo), "v"(hi)); return r; }
typedef float f32x2 __attribute__((ext_vector_type(2)));
template <class Epi, class Sched, bool ALIGN_EPI = false, bool SP2 = false, int F8 = 0, int F8SA = 127, int F8SB = 127>
__device__ __forceinline__ void gemm_phase(PG8_LAS unsigned char* lds, const Gemm g, const Sched& S, const Epi& E) {
    const int tid = threadIdx.x, wid = __builtin_amdgcn_readfirstlane(tid >> 6), lane = tid & 63, wr = wid >> 2, wc = wid & 3, fr = lane & 15, fq = lane >> 4;
    const int K = g.K, nt = K / BK;
    unsigned voffA[2], voffB[2];
#pragma unroll
    for (int i = 0; i < 2; ++i) { int R, C; stage_rc(tid * 16 + i * 8192, R, C); const int Rb = Epi::PERM ? ((R & ~31) + perm32(R & 31)) : R;
        voffA[i] = (unsigned)(R * K + C) * 2u; voffB[i] = (unsigned)(Rb * K + C) * 2u; }
    const size_t kstep = (size_t)(BK * 2);
    const size_t hstep = (size_t)HALF * K * 2;
    const size_t tstep = 2 * hstep;
    const unsigned ldsw = (unsigned)wid * 1024u;
    const int aoff = lds_byte(wr * 64 + fr, fq * 8), boff = lds_byte(wc * 32 + fr, fq * 8);
#define PG8_SA(b, h) (((b) * 2 + (h)) * HTB)
#define PG8_SB(b, h) ((4 + (b) * 2 + (h)) * HTB)
#define PG8_STAGE(bufoff, gbase, voff) do { _Pragma("unroll") for (int _i = 0; _i < 2; ++_i) \
        __builtin_amdgcn_global_load_lds((const unsigned*)((const char*)(gbase) + (voff)[_i]), (PG8_LAS unsigned*)(lds + (bufoff) + ldsw + _i * 8192), 16, 0, 0); } while (0)
#define PG8_LDA(dst, b, h) do { _Pragma("unroll") for (int m = 0; m < 4; ++m) { dst[m].lo = *(const PG8_LAS i32x4*)(lds + PG8_SA(b, h) + aoff + m * 2048); dst[m].hi = *(const PG8_LAS i32x4*)(lds + PG8_SA(b, h) + aoff + m * 2048 + 1024); } } while (0)
#define PG8_LDB(dst, b, h) do { _Pragma("unroll") for (int n = 0; n < 2; ++n) { dst[n].lo = *(const PG8_LAS i32x4*)(lds + PG8_SB(b, h) + boff + n * 2048); dst[n].hi = *(const PG8_LAS i32x4*)(lds + PG8_SB(b, h) + boff + n * 2048 + 1024); } } while (0)
#define PG8_MMA(ai, bj, At, Bt) do { __builtin_amdgcn_s_setprio(1); \
        if constexpr (F8 == 0) { _Pragma("unroll") for (int m = 0; m < 4; ++m) _Pragma("unroll") for (int n = 0; n < 2; ++n) { \
            const i32x4 bl_ = Bt[n].lo, bh_ = Bt[n].hi, al_ = At[m].lo, ah_ = At[m].hi;     \
            acc[ai][bj][m][n] = __builtin_amdgcn_mfma_f32_16x16x32_bf16(__builtin_bit_cast(bf16x8, bl_), __builtin_bit_cast(bf16x8, al_), acc[ai][bj][m][n], 0, 0, 0); \
            acc[ai][bj][m][n] = __builtin_amdgcn_mfma_f32_16x16x32_bf16(__builtin_bit_cast(bf16x8, bh_), __builtin_bit_cast(bf16x8, ah_), acc[ai][bj][m][n], 0, 0, 0); } } \
        else { _Pragma("unroll") for (int m = 0; m < 4; ++m) _Pragma("unroll") for (int n = 0; n < 2; ++n) \
            asm volatile("v_mfma_f32_16x16x128_f8f6f4 %0, %1, %2, %0" : "+v"(acc[ai][bj][m][n]) : "v"(Bt[n]), "v"(At[m])); } \
        __builtin_amdgcn_s_setprio(0); } while (0)
#define PG8_WAIT_V(n) asm volatile("s_waitcnt vmcnt(" #n ")" ::: "memory")
#define PG8_WAIT_L(n) asm volatile("s_waitcnt lgkmcnt(" #n ")" ::: "memory")
#define PG8_BAR __builtin_amdgcn_s_barrier()
#define PG8_SCHED __builtin_amdgcn_sched_barrier(0)
    Unit cur, nxt; int ui = 0;
    if (!S.next(0, cur)) return;
    f32x4 acc[2][2][4][2];
#pragma unroll
    for (int a = 0; a < 2; ++a)
#pragma unroll
        for (int b = 0; b < 2; ++b)
#pragma unroll
            for (int m = 0; m < 4; ++m)
#pragma unroll
                for (int n = 0; n < 2; ++n) acc[a][b][m][n] = (f32x4){0.f, 0.f, 0.f, 0.f};
    i32x8 At[4], B0[2], B1[2];
    const char* cA = (const char*)g.A + (size_t)cur.pm * tstep; const char* cB = (const char*)g.Bt + (size_t)cur.pn * tstep;
    S.a_ready(cur);
    if constexpr (SP2) {
        PG8_STAGE(PG8_SB(0, 0), cB, voffB); PG8_STAGE(PG8_SB(0, 1), cB + hstep, voffB); PG8_STAGE(PG8_SA(0, 0), cA, voffA); PG8_STAGE(PG8_SA(0, 1), cA + hstep, voffA);
        if (wr == 1) PG8_BAR;
        PG8_WAIT_V(2); PG8_BAR;
        PG8_STAGE(PG8_SB(1, 0), cB + kstep, voffB); PG8_STAGE(PG8_SA(1, 0), cA + kstep, voffA); PG8_STAGE(PG8_SB(1, 1), cB + hstep + kstep, voffB);
        PG8_WAIT_V(6); PG8_BAR;
    } else {
        PG8_STAGE(PG8_SB(0, 0), cB, voffB); PG8_STAGE(PG8_SA(0, 0), cA, voffA); PG8_STAGE(PG8_SB(0, 1), cB + hstep, voffB); PG8_STAGE(PG8_SA(0, 1), cA + hstep, voffA);
        if (wr == 1) PG8_BAR;
        PG8_WAIT_V(4); PG8_BAR;
        PG8_STAGE(PG8_SB(1, 0), cB + kstep, voffB); PG8_STAGE(PG8_SA(1, 0), cA + kstep, voffA); PG8_STAGE(PG8_SB(1, 1), cB + hstep + kstep, voffB);
        PG8_WAIT_V(6); PG8_BAR;
    }
    for (;;) {
        const bool has_next = S.next(ui + 1, nxt);
        const char* nA = has_next ? (const char*)g.A + (size_t)nxt.pm * tstep : cA; const char* nB = has_next ? (const char*)g.Bt + (size_t)nxt.pn * tstep : cB;
_Pragma("nounroll")
        for (int t = 0; t < nt; t += 2) {
            const bool last = (t == nt - 2);
            const char* a1 = cA + (size_t)(t + 1) * kstep;
            const char* a2 = last ? nA : cA + (size_t)(t + 2) * kstep; const char* b2 = last ? nB : cB + (size_t)(t + 2) * kstep;
            const char* a3 = a2 + kstep; const char* b3 = b2 + kstep;
            if (last && has_next) S.a_ready(nxt);
            if constexpr (SP2) {
            PG8_LDB(B0, 0, 0); PG8_LDB(B1, 0, 1); PG8_SCHED; PG8_LDA(At, 0, 0); PG8_STAGE(PG8_SA(1, 1), a1 + hstep, voffA);
            PG8_WAIT_V(8); PG8_WAIT_L(0); PG8_BAR; PG8_MMA(0, 0, At, B0); PG8_MMA(0, 1, At, B1); PG8_BAR; PG8_SCHED;
            PG8_LDA(At, 0, 1); PG8_STAGE(PG8_SB(0, 0), b2, voffB); PG8_STAGE(PG8_SB(0, 1), b2 + hstep, voffB); PG8_STAGE(PG8_SA(0, 0), a2, voffA);
            PG8_WAIT_V(8); PG8_WAIT_L(0); PG8_BAR; PG8_MMA(1, 0, At, B0); PG8_MMA(1, 1, At, B1); PG8_BAR; PG8_SCHED;
            PG8_LDB(B0, 1, 0); PG8_LDB(B1, 1, 1); PG8_SCHED; PG8_LDA(At, 1, 0); PG8_STAGE(PG8_SA(0, 1), a2 + hstep, voffA);
            PG8_WAIT_V(8); PG8_WAIT_L(0); PG8_BAR; PG8_MMA(0, 0, At, B0); PG8_MMA(0, 1, At, B1); PG8_BAR; PG8_SCHED;
            PG8_LDA(At, 1, 1); PG8_STAGE(PG8_SB(1, 0), b3, voffB); PG8_STAGE(PG8_SB(1, 1), b3 + hstep, voffB); PG8_STAGE(PG8_SA(1, 0), a3, voffA);
            PG8_WAIT_V(8); PG8_WAIT_L(0); PG8_BAR; PG8_MMA(1, 0, At, B0); PG8_MMA(1, 1, At, B1); PG8_BAR; PG8_SCHED;
            } else {
            PG8_LDB(B0, 0, 0); PG8_SCHED; PG8_LDA(At, 0, 0); PG8_STAGE(PG8_SA(1, 1), a1 + hstep, voffA);
            PG8_WAIT_L(8); PG8_BAR; PG8_WAIT_L(0); PG8_MMA(0, 0, At, B0); PG8_BAR; PG8_SCHED;
            PG8_LDB(B1, 0, 1); PG8_STAGE(PG8_SB(0, 0), b2, voffB);
            PG8_BAR; PG8_WAIT_L(0); PG8_MMA(0, 1, At, B1); PG8_BAR;
            PG8_LDA(At, 0, 1); PG8_STAGE(PG8_SA(0, 0), a2, voffA);
            PG8_BAR; PG8_WAIT_L(0); PG8_MMA(1, 0, At, B0); PG8_BAR; PG8_SCHED;
            PG8_STAGE(PG8_SB(0, 1), b2 + hstep, voffB);
            PG8_WAIT_V(6); PG8_BAR; PG8_MMA(1, 1, At, B1); PG8_BAR;
            PG8_LDB(B0, 1, 0); PG8_SCHED; PG8_LDA(At, 1, 0); PG8_STAGE(PG8_SA(0, 1), a2 + hstep, voffA);
            PG8_WAIT_L(8); PG8_BAR; PG8_WAIT_L(0); PG8_MMA(0, 0, At, B0); PG8_BAR; PG8_SCHED;
            PG8_LDB(B1, 1, 1); PG8_STAGE(PG8_SB(1, 0), b3, voffB);
            PG8_BAR; PG8_WAIT_L(0); PG8_MMA(0, 1, At, B1); PG8_BAR;
            PG8_LDA(At, 1, 1); PG8_STAGE(PG8_SA(1, 0), a3, voffA);
            PG8_BAR; PG8_WAIT_L(0); PG8_MMA(1, 0, At, B0); PG8_BAR; PG8_SCHED;
            PG8_STAGE(PG8_SB(1, 1), b3 + hstep, voffB);
            PG8_WAIT_V(6); PG8_BAR; PG8_MMA(1, 1, At, B1); PG8_BAR;
            }
        }
        if constexpr (ALIGN_EPI) { if (wr == 0) PG8_BAR; }
        if constexpr (F8 != 0) asm volatile("s_nop 15\n\ts_nop 15" ::: "memory");
        if constexpr (!Epi::AFTER_DRAIN) { E(acc, cur, wr, wc, fr, fq); S.done(cur); }
        if (!has_next) break;
#pragma unroll
        for (int a = 0; a < 2; ++a)
#pragma unroll
            for (int b = 0; b < 2; ++b)
#pragma unroll
                for (int m = 0; m < 4; ++m)
#pragma unroll
                    for (int n = 0; n < 2; ++n) acc[a][b][m][n] = (f32x4){0.f, 0.f, 0.f, 0.f};
        cur = nxt; cA = nA; cB = nB; ++ui;
        if constexpr (ALIGN_EPI) { if (wr == 1) PG8_BAR; }
    }
    PG8_WAIT_V(0);
    if constexpr (!ALIGN_EPI) { if (wr == 0) PG8_BAR; }
    PG8_BAR;
    if constexpr (Epi::AFTER_DRAIN) { E.fused(acc, cur, wr, wc, fr, fq, lds, wid, lane); S.done(cur); }
#undef PG8_SA
#undef PG8_SB
#undef PG8_STAGE
#undef PG8_LDA
#undef PG8_LDB
#undef PG8_MMA
#undef PG8_WAIT_V
#undef PG8_WAIT_L
#undef PG8_BAR
#undef PG8_SCHED
}
}

constexpr int NB = 8, T = 4096, D = 1024, NTOK = NB * T;
constexpr int ATT_H = 8, ATT_D = 64, ATT_W = 512, KV_LAT = 256, IDX_H = 8, IDX_D = 64, TOPK = 256;
constexpr int HG_H = 4, HG_DK = 128, HG_DV = 128, HG_W = 512, HG_C = 32;
constexpr int D_IN = 3400, D_INP = 3584;
constexpr int C_AQ = 0, C_AC = 512, C_IQ = 768, C_IK = 1280, C_IW = 1344, C_GQ = 1352, C_GF = 1864, C_GI = 2376, C_GG = 2888;
constexpr int NE = 32, TOPE = 4, DFF = 1024, PLE = 256;
constexpr int NASSIGN = NTOK * TOPE, CAP = NASSIGN + NE * 256;
constexpr int MAXTILES = CAP / 256;
constexpr float LN_EPS = 1e-5f, RMS_EPS = 1e-6f, ALPHA = 1.189207115002721f;

constexpr size_t MiB = 1u << 20;
constexpr size_t WS_CTL = 0, CTL_ZERO_BYTES = 64 * 1024;
constexpr size_t WS_WIN_T = 1 * MiB, WS_WO_T = 8 * MiB, WS_WUP_T = 10 * MiB, WS_WDN_T = 138 * MiB, WS_WPROJ_T = 202 * MiB, WS_WGATE_T = 203 * MiB;
constexpr size_t WS_WUK_T = 205 * MiB, WS_WUV_T = 205 * MiB + 512 * 1024;
constexpr size_t WS_SMALL = 206 * MiB;
constexpr size_t WS_A = 208 * MiB;
constexpr size_t WS_B = 480 * MiB;
constexpr size_t WS_X1 = 752 * MiB;
constexpr size_t WS_XB = 880 * MiB;
constexpr size_t WS_PROJ = 944 * MiB;
constexpr size_t WS_SM2 = 1008 * MiB;
constexpr size_t WS_END = 1016 * MiB;
constexpr size_t WS_H = WS_A, WS_XS = WS_A, WS_YSLOT = WS_A;
constexpr size_t WS_XBF = WS_B, WS_U = WS_B, WS_YMIX = WS_B, WS_HH = WS_B;
constexpr size_t WS_QDEC = WS_B + 128 * MiB, WS_PB = WS_B + 128 * MiB, WS_OREC = WS_B + 160 * MiB, WS_CN = WS_B + 224 * MiB, WS_IKN = WS_B + 240 * MiB, WS_MASK = WS_B + 244 * MiB;
constexpr size_t WS_K = WS_XB, WS_VT = WS_XB + 32 * MiB;
constexpr size_t WS_TOPE = WS_SM2, WS_GATE = WS_SM2 + 512 * 1024, WS_LRANK = WS_SM2 + 1024 * 1024, WS_TOKSLOT = WS_SM2 + 1536 * 1024, WS_SLOTGATE = WS_SM2 + 2 * MiB, WS_DECAY = WS_SM2 + 3 * MiB;
constexpr size_t WS_WRT = WS_SMALL + 256 * 1024;
constexpr size_t WS_WGBASE = WS_SMALL, WS_TILEE = WS_SMALL + 64 * 1024;
constexpr int CW_CNT = 64;
constexpr int CW_BAR = 1024;
constexpr int XBW_OFF = 147456 - 16;

constexpr int RING_BYTES = 131072, MISC_OFF = RING_BYTES, LDS_BYTES = 147456;
constexpr int NWAVES = 8, NTHR = 512;

#define GAS __attribute__((address_space(1)))
#define LAS __attribute__((address_space(3)))
typedef unsigned short bf16;
typedef unsigned v4u __attribute__((ext_vector_type(4)));
typedef unsigned v2u __attribute__((ext_vector_type(2)));
typedef float f32x4 __attribute__((ext_vector_type(4)));
typedef short bf16x8 __attribute__((ext_vector_type(8)));
#define LDS_WAIT() asm volatile("s_waitcnt lgkmcnt(0)" ::: "memory")
#define VM_WAIT() asm volatile("s_waitcnt vmcnt(0)" ::: "memory")
__device__ __forceinline__ unsigned f2bf(float f) { unsigned u = __builtin_bit_cast(unsigned, f); return (u + 0x7fffu + ((u >> 16) & 1u)) >> 16; }
__device__ __forceinline__ unsigned pk2(float lo, float hi) { return f2bf(lo) | (f2bf(hi) << 16); }
__device__ __forceinline__ float bf2f(unsigned short b) { return __builtin_bit_cast(float, (unsigned)b << 16); }
__device__ __forceinline__ float bflo(unsigned w) { return __builtin_bit_cast(float, w << 16); }
__device__ __forceinline__ float bfhi(unsigned w) { return __builtin_bit_cast(float, w & 0xffff0000u); }
__device__ __forceinline__ float wave_sum(float v) {
#pragma unroll
    for (int o = 1; o < 64; o <<= 1) v += __shfl_xor(v, o);
    return v;
}
__device__ __forceinline__ float sigmoidf_(float x) { return 1.f / (1.f + __expf(-x)); }

__device__ __forceinline__ unsigned pk4_fp8(float a, float b, float c, float d);
struct Params { const float* in[25]; float* out; unsigned char* ws; };
enum { I_X = 0, I_P, I_WIN, I_KVG, I_IKG, I_IKB, I_WUK, I_WUV, I_HGLB, I_HGNG, I_WO, I_LNMG, I_LNMB, I_WR, I_BR, I_WUP, I_BUP, I_WDN, I_BDN, I_LNFG, I_LNFB, I_WPP, I_WPG, I_LNPG, I_LNPB };

struct Ctx { LAS unsigned char* lds; int tid, lane, wave, G, gw, ngw; };

namespace pg8 {
struct EpiBf16s {
    static constexpr bool PERM = true, AFTER_DRAIN = false;
    bf16_t* O; int ldc;
    __device__ __forceinline__ void operator()(const f32x4 (&acc)[2][2][4][2], const Unit& u, int wr, int wc, int fr, int fq) const {
        const int row0 = u.pm * BM + wr * 64 + fr, col0 = u.pn * BM + wc * 32 + 8 * fq;
#pragma unroll
        for (int ai = 0; ai < 2; ++ai)
#pragma unroll
            for (int m = 0; m < 4; ++m) { bf16_t* rowp = O + (size_t)(row0 + ai * HALF + m * 16) * ldc + col0;
#pragma unroll
                for (int bj = 0; bj < 2; ++bj) { const f32x4 v0 = acc[ai][bj][m][0], v1 = acc[ai][bj][m][1];
                    u32x4 w; w.x = cvt_pk_bf16(v0[0], v0[1]); w.y = cvt_pk_bf16(v0[2], v0[3]); w.z = cvt_pk_bf16(v1[0], v1[1]); w.w = cvt_pk_bf16(v1[2], v1[3]);
                    *(u32x4*)(rowp + bj * HALF) = w; } }
    }
};
struct EpiResid {
    static constexpr bool PERM = false, AFTER_DRAIN = false;
    const float* res; float* out; int ldc; float alpha, as;
    __device__ __forceinline__ void operator()(const f32x4 (&acc)[2][2][4][2], const Unit& u, int wr, int wc, int fr, int fq) const {
        const int row0 = u.pm * BM + wr * 64 + fr, col0 = u.pn * BM + wc * 32 + 4 * fq;
#pragma unroll
        for (int ai = 0; ai < 2; ++ai)
#pragma unroll
            for (int m = 0; m < 4; ++m) { const size_t off = (size_t)(row0 + ai * HALF + m * 16) * ldc + col0;
#pragma unroll
                for (int bj = 0; bj < 2; ++bj)
#pragma unroll
                    for (int n = 0; n < 2; ++n) { const f32x4 r = *(const f32x4*)(res + off + bj * HALF + n * 16); *(f32x4*)(out + off + bj * HALF + n * 16) = r * alpha + acc[ai][bj][m][n] * as; }
                asm volatile("" ::: "memory"); }
    }
};
struct EpiPle {
    static constexpr bool PERM = false, AFTER_DRAIN = false;
    const float* x2; const bf16_t* proj; float* out; float alpha, as;
    __device__ __forceinline__ void operator()(const f32x4 (&acc)[2][2][4][2], const Unit& u, int wr, int wc, int fr, int fq) const {
        const int row0 = u.pm * BM + wr * 64 + fr, col0 = u.pn * BM + wc * 32 + 4 * fq;
#pragma unroll
        for (int ai = 0; ai < 2; ++ai)
#pragma unroll
            for (int m = 0; m < 4; ++m) { const size_t off = (size_t)(row0 + ai * HALF + m * 16) * 1024 + col0;
#pragma unroll
                for (int bj = 0; bj < 2; ++bj)
#pragma unroll
                    for (int n = 0; n < 2; ++n) { const size_t o2 = off + bj * HALF + n * 16; const f32x4 r = *(const f32x4*)(x2 + o2); const v2u pw = *(const v2u*)(proj + o2);
                        const f32x4 a = acc[ai][bj][m][n] * as; f32x4 o;
                        o[0] = r[0] * alpha + bflo(pw.x) * sigmoidf_(a[0]); o[1] = r[1] * alpha + bfhi(pw.x) * sigmoidf_(a[1]);
                        o[2] = r[2] * alpha + bflo(pw.y) * sigmoidf_(a[2]); o[3] = r[3] * alpha + bfhi(pw.y) * sigmoidf_(a[3]);
                        *(f32x4*)(out + o2) = o; }
                asm volatile("" ::: "memory"); }
    }
};
struct EpiSwiglu {
    static constexpr bool PERM = true, AFTER_DRAIN = false;
    unsigned char* H; const float* b_up;
    __device__ __forceinline__ void operator()(const f32x4 (&acc)[2][2][4][2], const Unit& u, int wr, int wc, int fr, int fq) const {
        const int e = u.pn >> 3, pnT = u.pn & 7;
        const int row0 = u.pm * BM + wr * 64 + fr, col0 = pnT * 128 + wc * 32 + 8 * fq;
        const float* bg = b_up + (size_t)e * 2048 + col0; const float* bl = bg + 1024;
        float bgv[8], blv[8];
#pragma unroll
        for (int j = 0; j < 8; ++j) { bgv[j] = bg[j]; blv[j] = bl[j]; }
#pragma unroll
        for (int ai = 0; ai < 2; ++ai)
#pragma unroll
            for (int m = 0; m < 4; ++m) { unsigned char* rowp = H + (size_t)(row0 + ai * HALF + m * 16) * 1024 + col0; float a[8];
#pragma unroll
                for (int n = 0; n < 2; ++n)
#pragma unroll
                    for (int j = 0; j < 4; ++j) { float g = acc[ai][0][m][n][j] * (1.f / 512.f) + bgv[4 * n + j], l = acc[ai][1][m][n][j] * (1.f / 512.f) + blv[4 * n + j];
                        g = fminf(g, 7.0f); l = fminf(fmaxf(l, -7.0f), 7.0f); a[4 * n + j] = g * sigmoidf_(1.702f * g) * (l + 1.0f); }
                v2u w; w.x = pk4_fp8(a[0] * 4.f, a[1] * 4.f, a[2] * 4.f, a[3] * 4.f); w.y = pk4_fp8(a[4] * 4.f, a[5] * 4.f, a[6] * 4.f, a[7] * 4.f);
                *(v2u*)rowp = w; }
    }
};
struct EpiDown {
    static constexpr bool PERM = true, AFTER_DRAIN = false;
    bf16_t* Y; const float* b_dn; const float* gate;
    __device__ __forceinline__ void operator()(const f32x4 (&acc)[2][2][4][2], const Unit& u, int wr, int wc, int fr, int fq) const {
        const int e = u.pn >> 2, pnT = u.pn & 3;
        const int row0 = u.pm * BM + wr * 64 + fr, col0 = pnT * 256 + wc * 32 + 8 * fq;
        const float* bb = b_dn + (size_t)e * 1024 + col0;
        float bv[2][8];
#pragma unroll
        for (int bj = 0; bj < 2; ++bj)
#pragma unroll
            for (int j = 0; j < 8; ++j) bv[bj][j] = bb[bj * HALF + j];
#pragma unroll
        for (int ai = 0; ai < 2; ++ai)
#pragma unroll
            for (int m = 0; m < 4; ++m) { const int row = row0 + ai * HALF + m * 16; const float gt = gate[row]; bf16_t* rowp = Y + (size_t)row * 1024 + col0;
#pragma unroll
                for (int bj = 0; bj < 2; ++bj) { const f32x4 v0 = acc[ai][bj][m][0], v1 = acc[ai][bj][m][1];
                    const float as = 1.f / 256.f;
                    u32x4 w; w.x = cvt_pk_bf16((v0[0] * as + bv[bj][0]) * gt, (v0[1] * as + bv[bj][1]) * gt); w.y = cvt_pk_bf16((v0[2] * as + bv[bj][2]) * gt, (v0[3] * as + bv[bj][3]) * gt);
                    w.z = cvt_pk_bf16((v1[0] * as + bv[bj][4]) * gt, (v1[1] * as + bv[bj][5]) * gt); w.w = cvt_pk_bf16((v1[2] * as + bv[bj][6]) * gt, (v1[3] * as + bv[bj][7]) * gt);
                    *(u32x4*)(rowp + bj * HALF) = w; } }
    }
};
struct MoeOrder {
    const int* tile_e; int ntiles, nN, G, c;
    __device__ __forceinline__ bool next(int i, Unit& u) const {
        if ((G & 7) == 0) {
            const int x = c & 7, s = i * (G >> 3) + (c >> 3);
            const int cg = nN >> 2, rg = 8 / cg;
            const int ch = x % cg, rc = x / cg;
            const int lr = s >> 2, pl = 4 * ch + (s & 3), pm = rc + rg * lr;
            if (pm >= ntiles) return false;
            u.pm = pm; u.pn = tile_e[pm] * nN + pl; return true;
        }
        const int L = i * G + c; if (L >= ntiles * nN) return false;
        const int pm = L / nN, pl = L - pm * nN; u.pm = pm; u.pn = tile_e[pm] * nN + pl; return true;
    }
    __device__ __forceinline__ void a_ready(const Unit&) const {}
    __device__ __forceinline__ void done(const Unit&) const {}
};
}

template <class RowMap>
__device__ __forceinline__ void transpose_item(const float* W, int ldw, int Nvalid, bf16* WT, int Kdim, RowMap rm, LAS float* scr, int kb, int nb, int lane) {
    const int k0 = 64 * kb, n0 = 32 * nb; const int nl0 = lane & 31, nn = n0 + nl0;
#pragma unroll 8
    for (int i = 0; i < 32; ++i) { const int kk = 2 * i + (lane >> 5); scr[kk * 33 + nl0] = (nn < Nvalid) ? W[(size_t)(k0 + kk) * ldw + nn] : 0.f; }
    LDS_WAIT(); asm volatile("" ::: "memory");
    const int c = lane & 7;
#pragma unroll
    for (int j = 0; j < 4; ++j) { const int n = (lane >> 3) + 8 * j; const LAS float* s = scr + (8 * c) * 33 + n;
        v4u o; o.x = pk2(s[0 * 33], s[1 * 33]); o.y = pk2(s[2 * 33], s[3 * 33]); o.z = pk2(s[4 * 33], s[5 * 33]); o.w = pk2(s[6 * 33], s[7 * 33]);
        *(GAS v4u*)(WT + (size_t)rm(n0 + n) * Kdim + k0 + 8 * c) = o; }
    LDS_WAIT(); asm volatile("" ::: "memory");
}
__device__ __forceinline__ unsigned pk4_fp8(float a, float b, float c, float d) { int r = 0; r = __builtin_amdgcn_cvt_pk_fp8_f32(a, b, r, false); r = __builtin_amdgcn_cvt_pk_fp8_f32(c, d, r, true); return (unsigned)r; }
template <class RowMap>
__device__ __forceinline__ void transpose_item_f8(const float* W, int ldw, unsigned char* WT, int Kdim, RowMap rm, LAS float* scr, int kb, int nb, int lane, float mul) {
    const int k0 = 64 * kb, n0 = 32 * nb; const int nl0 = lane & 31, nn = n0 + nl0;
#pragma unroll 8
    for (int i = 0; i < 32; ++i) { const int kk = 2 * i + (lane >> 5); scr[kk * 33 + nl0] = W[(size_t)(k0 + kk) * ldw + nn] * mul; }
    LDS_WAIT(); asm volatile("" ::: "memory");
    const int c = lane & 7;
#pragma unroll
    for (int j = 0; j < 4; ++j) { const int n = (lane >> 3) + 8 * j; const LAS float* s = scr + (8 * c) * 33 + n;
        v2u o; o.x = pk4_fp8(s[0 * 33], s[1 * 33], s[2 * 33], s[3 * 33]); o.y = pk4_fp8(s[4 * 33], s[5 * 33], s[6 * 33], s[7 * 33]);
        *(GAS v2u*)(WT + (size_t)rm(n0 + n) * Kdim + k0 + 8 * c) = o; }
    LDS_WAIT(); asm volatile("" ::: "memory");
}
struct RmId { __device__ __forceinline__ int operator()(int n) const { return n; } };
struct RmUp { int e; __device__ __forceinline__ int operator()(int n) const { return e * 2048 + ((n & 1023) >> 7) * 256 + (n >> 10) * 128 + (n & 127); } };
struct RmOff { int off; __device__ __forceinline__ int operator()(int n) const { return off + n; } };

__device__ __forceinline__ void p0_prologue(const Params& P, const Ctx& C) {
    LAS float* scr = (LAS float*)(C.lds + C.wave * 16384);
    unsigned char* ws = P.ws;
    constexpr int I_IN = 16 * (D_INP / 32), I_O = 16 * 32, I_UP = 16 * 64, I_DN = 16 * 32, I_PP = 4 * 32, I_PG = 16 * 32, I_UK = 4 * 16, I_UV = 4 * 16;
    constexpr int NITEMS = I_IN + I_O + NE * I_UP + NE * I_DN + I_PP + I_PG + I_UK + I_UV;
    for (int it = C.gw; it < NITEMS; it += C.ngw) {
        int r = it;
        if (r < I_IN) { transpose_item(P.in[I_WIN], D_IN, D_IN, (bf16*)(ws + WS_WIN_T), 1024, RmId{}, scr, r / (D_INP / 32), r % (D_INP / 32), C.lane); continue; } r -= I_IN;
        if (r < I_O) { transpose_item_f8(P.in[I_WO], 1024, ws + WS_WO_T, 1024, RmId{}, scr, r / 32, r % 32, C.lane, 64.f); continue; } r -= I_O;
        if (r < NE * I_UP) { const int e = r / I_UP, q = r % I_UP; transpose_item_f8(P.in[I_WUP] + (size_t)e * 1024 * 2048, 2048, ws + WS_WUP_T, 1024, RmUp{e}, scr, q / 64, q % 64, C.lane, 64.f); continue; } r -= NE * I_UP;
        if (r < NE * I_DN) { const int e = r / I_DN, q = r % I_DN; transpose_item_f8(P.in[I_WDN] + (size_t)e * 1024 * 1024, 1024, ws + WS_WDN_T, 1024, RmOff{e * 1024}, scr, q / 32, q % 32, C.lane, 64.f); continue; } r -= NE * I_DN;
        if (r < I_PP) { transpose_item(P.in[I_WPP], 1024, 1024, (bf16*)(ws + WS_WPROJ_T), 256, RmId{}, scr, r / 32, r % 32, C.lane); continue; } r -= I_PP;
        if (r < I_PG) { transpose_item_f8(P.in[I_WPG], 1024, ws + WS_WGATE_T, 1024, RmId{}, scr, r / 32, r % 32, C.lane, 64.f); continue; } r -= I_PG;
        if (r < I_UK) { transpose_item(P.in[I_WUK], 512, 512, (bf16*)(ws + WS_WUK_T), 256, RmId{}, scr, r / 16, r % 16, C.lane); continue; } r -= I_UK;
        transpose_item(P.in[I_WUV], 512, 512, (bf16*)(ws + WS_WUV_T), 256, RmId{}, scr, r / 16, r % 16, C.lane);
    }
    { const float* wr = P.in[I_WR]; float* wrt = (float*)(ws + WS_WRT);
      for (int i = C.gw * 64 + C.lane; i < 32 * 1024; i += C.ngw * 64) { const int e = i >> 10, k = i & 1023; wrt[i] = wr[k * 32 + e]; } }
    {
        const float* x = P.in[I_X]; bf16* xb = (bf16*)(ws + WS_XBF);
        const size_t n8 = (size_t)NTOK * D / 8, stride = (size_t)C.ngw * 64;
        for (size_t i = (size_t)C.gw * 64 + C.lane; i < n8; i += stride) { const f32x4 a = *(const GAS f32x4*)(x + i * 8), b = *(const GAS f32x4*)(x + i * 8 + 4);
            v4u o; o.x = pk2(a[0], a[1]); o.y = pk2(a[2], a[3]); o.z = pk2(b[0], b[1]); o.w = pk2(b[2], b[3]); *(GAS v4u*)(xb + i * 8) = o; }
        const float* p = P.in[I_P]; bf16* pb = (bf16*)(ws + WS_PB);
        const size_t m8 = (size_t)NTOK * PLE / 8;
        for (size_t i = (size_t)C.gw * 64 + C.lane; i < m8; i += stride) { const f32x4 a = *(const GAS f32x4*)(p + i * 8), b = *(const GAS f32x4*)(p + i * 8 + 4);
            v4u o; o.x = pk2(a[0], a[1]); o.y = pk2(a[2], a[3]); o.z = pk2(b[0], b[1]); o.w = pk2(b[2], b[3]); *(GAS v4u*)(pb + i * 8) = o; }
    }
}

__device__ __forceinline__ void ln_row(f32x4 (&v)[4], const float* g, const float* b, int lane) {
    float s = 0.f;
#pragma unroll
    for (int j = 0; j < 4; ++j) s += (v[j][0] + v[j][1]) + (v[j][2] + v[j][3]);
    const float mean = wave_sum(s) * (1.f / D); float s2 = 0.f;
#pragma unroll
    for (int j = 0; j < 4; ++j) { v[j] = v[j] - mean; s2 += (v[j][0] * v[j][0] + v[j][1] * v[j][1]) + (v[j][2] * v[j][2] + v[j][3] * v[j][3]); }
    const float rstd = 1.f / sqrtf(wave_sum(s2) * (1.f / D) + LN_EPS);
#pragma unroll
    for (int j = 0; j < 4; ++j) { const f32x4 gg = *(const f32x4*)(g + 4 * lane + 256 * j), bb = *(const f32x4*)(b + 4 * lane + 256 * j); v[j] = v[j] * rstd * gg + bb; }
}
__device__ __forceinline__ void store_row_f32(float* row, const f32x4 (&v)[4], int lane) {
#pragma unroll
    for (int j = 0; j < 4; ++j) *(GAS f32x4*)(row + 4 * lane + 256 * j) = v[j];
}
__device__ __forceinline__ void store_row_bf16(bf16* row, const f32x4 (&v)[4], int lane) {
#pragma unroll
    for (int j = 0; j < 4; ++j) { v2u o; o.x = pk2(v[j][0], v[j][1]); o.y = pk2(v[j][2], v[j][3]); *(GAS v2u*)(row + 4 * lane + 256 * j) = o; }
}
__device__ __forceinline__ void store_row_fp8x8(unsigned char* row, const f32x4 (&v)[4], int lane) {
#pragma unroll
    for (int j = 0; j < 4; ++j) *(GAS unsigned*)(row + 4 * lane + 256 * j) = pk4_fp8(v[j][0] * 8.f, v[j][1] * 8.f, v[j][2] * 8.f, v[j][3] * 8.f);
}
__device__ __forceinline__ void load_row_f32(f32x4 (&v)[4], const float* row, int lane) {
#pragma unroll
    for (int j = 0; j < 4; ++j) v[j] = *(const GAS f32x4*)(row + 4 * lane + 256 * j);
}
#ifndef FEAT_MIX
#define FEAT_MIX 1
#endif
#ifndef FEAT_MOE
#define FEAT_MOE 1
#endif
#ifndef FEAT_PLE
#define FEAT_PLE 1
#endif
#ifndef FEAT_ATT
#define FEAT_ATT 1
#endif
#ifndef SYNC_MODE
#define SYNC_MODE 0
#endif
#ifndef PROGRAM
#define PROGRAM X(0) GS X(10) X(11) SY X(20) X(21) SY X(30) X(31) BS X(32) SY X(40) X(41) SY X(5) SY X(6) SY X(7) SY X(8) SY X(9) SY X(100) SY X(110) SY X(120)
#endif

typedef float f32x16 __attribute__((ext_vector_type(16)));
typedef short s16x4 __attribute__((ext_vector_type(4)));
__device__ __forceinline__ unsigned cvtpk(float lo, float hi) { typedef float f2 __attribute__((ext_vector_type(2))); typedef __bf16 b2 __attribute__((ext_vector_type(2))); f2 v = {lo, hi}; b2 b = __builtin_convertvector(v, b2); return __builtin_bit_cast(unsigned, b); }
__device__ __forceinline__ bf16x8 pack8(const f32x16& x, int base) {
    v4u w; w.x = cvtpk(x[base + 0], x[base + 1]); w.y = cvtpk(x[base + 2], x[base + 3]); w.z = cvtpk(x[base + 4], x[base + 5]); w.w = cvtpk(x[base + 6], x[base + 7]);
    return __builtin_bit_cast(bf16x8, w);
}

__device__ __forceinline__ void p2_post(const Params& P, const Ctx& C) {
    unsigned char* ws = P.ws;
    const bf16* H = (const bf16*)(ws + WS_H); bf16* CN = (bf16*)(ws + WS_CN); bf16* IKN = (bf16*)(ws + WS_IKN);
    const float* kvg = P.in[I_KVG]; const float* ikg = P.in[I_IKG]; const float* ikb = P.in[I_IKB];
    const f32x4 g4 = *(const f32x4*)(kvg + 4 * C.lane); const float ig = ikg[C.lane], ib = ikb[C.lane];
    for (int m = C.gw; m < NTOK; m += C.ngw) {
        const bf16* hr = H + (size_t)m * D_INP;
        const v2u w = *(const GAS v2u*)(hr + C_AC + 4 * C.lane);
        float a0 = bflo(w.x), a1 = bfhi(w.x), a2 = bflo(w.y), a3 = bfhi(w.y);
        const float ss = wave_sum((a0 * a0 + a1 * a1) + (a2 * a2 + a3 * a3));
        const float rs = 1.f / sqrtf(ss * (1.f / 256.f) + RMS_EPS);
        v2u o; o.x = pk2(a0 * rs * g4[0], a1 * rs * g4[1]); o.y = pk2(a2 * rs * g4[2], a3 * rs * g4[3]);
        *(GAS v2u*)(CN + (size_t)m * 256 + 4 * C.lane) = o;
        const float k = bf2f(hr[C_IK + C.lane]);
        const float mu = wave_sum(k) * (1.f / 64.f); const float dk = k - mu;
        const float var = wave_sum(dk * dk) * (1.f / 64.f);
        IKN[(size_t)m * 64 + C.lane] = (bf16)f2bf(dk * (1.f / sqrtf(var + LN_EPS)) * ig + ib);
    }
}

constexpr int HP_QD = 0, HP_KI = 8704, HP_KET = 17408, HP_VT = 27648, HP_GS = 37888, HP_RAW = 40960;
__device__ __forceinline__ void p2_hgrn_prep(const Params& P, const Ctx& C) {
    unsigned char* ws = P.ws;
    const bf16* H = (const bf16*)(ws + WS_H);
    bf16* UT = (bf16*)(ws + WS_U); bf16* QDEC = (bf16*)(ws + WS_QDEC); float* OREC = (float*)(ws + WS_OREC); float* DEC = (float*)(ws + WS_DECAY);
    LAS bf16* QD = (LAS bf16*)(C.lds + HP_QD); LAS bf16* KI = (LAS bf16*)(C.lds + HP_KI); LAS bf16* KET = (LAS bf16*)(C.lds + HP_KET); LAS bf16* VT = (LAS bf16*)(C.lds + HP_VT);
    LAS float* GS = (LAS float*)(C.lds + HP_GS); LAS bf16* RAW = (LAS bf16*)(C.lds + HP_RAW);
    const int d = C.tid & 127, tg = C.tid >> 7;
    const int lane = C.lane, r32 = lane & 31, hf = lane >> 5;
    const int lc = C.tid >> 4, lg = C.tid & 15;
    const int NU = NB * HG_H * (T / HG_C);
    v4u rf, rq, ri;
    { const int unit = blockIdx.x; if (unit < NU) { const int n = unit & 127, hh = (unit >> 7) & 3, b = unit >> 9; const bf16* hr = H + (size_t)(b * T + n * HG_C + lc) * D_INP + hh * 128 + 8 * lg;
        rf = *(const GAS v4u*)(hr + C_GF); rq = *(const GAS v4u*)(hr + C_GQ); ri = *(const GAS v4u*)(hr + C_GI); } }
    for (int unit = blockIdx.x; unit < NU; unit += C.G) {
        const int n = unit & 127, hh = (unit >> 7) & 3, b = unit >> 9;
        const int m0 = b * T + n * HG_C;
        *(LAS v4u*)(RAW + lc * 128 + 8 * lg) = rf; *(LAS v4u*)(RAW + 4096 + lc * 128 + 8 * lg) = rq; *(LAS v4u*)(RAW + 8192 + lc * 128 + 8 * lg) = ri;
        __syncthreads();
        { const int un = unit + C.G; if (un < NU) { const int n2 = un & 127, h2 = (un >> 7) & 3, b2 = un >> 9; const bf16* hr = H + (size_t)(b2 * T + n2 * HG_C + lc) * D_INP + h2 * 128 + 8 * lg;
            rf = *(const GAS v4u*)(hr + C_GF); rq = *(const GAS v4u*)(hr + C_GQ); ri = *(const GAS v4u*)(hr + C_GI); } }
        const float l0 = P.in[I_HGLB][hh * 128 + d], l1 = P.in[I_HGLB][512 + hh * 128 + d];
        const float lb = 1.f / (1.f + __expf(l1 - l0));
        float fg[8], bl[8], qv[8]; float run = 0.f; unsigned vv[4];
#pragma unroll
        for (int c = 0; c < 8; ++c) { const int tok = tg * 8 + c;
            const float f = bf2f(RAW[tok * 128 + d]), q = bf2f(RAW[4096 + tok * 128 + d]); const unsigned iv = RAW[8192 + tok * 128 + d];
            fg[c] = lb + (1.f - lb) * sigmoidf_(f); run += __logf(fg[c]); bl[c] = run; qv[c] = q * sigmoidf_(q);
            if (c & 1) vv[c >> 1] |= iv << 16; else vv[c >> 1] = iv; }
        GS[tg * 128 + d] = run;
        *(LAS v4u*)(VT + d * 40 + tg * 8) = (v4u){vv[0], vv[1], vv[2], vv[3]};
        __syncthreads();
        float pre = 0.f, tot = 0.f;
#pragma unroll
        for (int g = 0; g < 4; ++g) { const float sg = GS[g * 128 + d]; tot += sg; if (g < tg) pre += sg; }
        unsigned ke[4];
#pragma unroll
        for (int c = 0; c < 8; ++c) { const float bc = pre + bl[c]; const float kc = 1.f - fg[c];
            const float qd = qv[c] * __expf(bc), ki = kc * __expf(-bc), kend = kc * __expf(tot - bc);
            const unsigned qb = f2bf(qd);
            QD[(tg * 8 + c) * 136 + d] = (bf16)qb; KI[(tg * 8 + c) * 136 + d] = (bf16)f2bf(ki);
            if (c & 1) ke[c >> 1] |= f2bf(kend) << 16; else ke[c >> 1] = f2bf(kend); }
        *(LAS v4u*)(KET + d * 40 + tg * 8) = (v4u){ke[0], ke[1], ke[2], ke[3]};
        if (tg == 0) DEC[(size_t)unit * 128 + d] = __expf(tot);
        __syncthreads();
        *(GAS v4u*)(QDEC + (size_t)(m0 + lc) * 512 + hh * 128 + 8 * lg) = *(const LAS v4u*)(QD + lc * 136 + 8 * lg);
        if (C.wave < 4) {
            f32x16 X = {0.f, 0.f, 0.f, 0.f, 0.f, 0.f, 0.f, 0.f, 0.f, 0.f, 0.f, 0.f, 0.f, 0.f, 0.f, 0.f};
#pragma unroll
            for (int k = 0; k < 8; ++k) { const bf16x8 a = *(const LAS bf16x8*)(KI + r32 * 136 + 16 * k + 8 * hf), bq = *(const LAS bf16x8*)(QD + r32 * 136 + 16 * k + 8 * hf);
                X = __builtin_amdgcn_mfma_f32_32x32x16_bf16(a, bq, X, 0, 0, 0); }
#pragma unroll
            for (int r = 0; r < 16; ++r) { const int sidx = (r & 3) + 8 * (r >> 2) + 4 * hf; if (sidx > r32) X[r] = 0.f; }
            f32x16 Z = {0.f, 0.f, 0.f, 0.f, 0.f, 0.f, 0.f, 0.f, 0.f, 0.f, 0.f, 0.f, 0.f, 0.f, 0.f, 0.f};
            const int e = C.wave * 32 + r32;
#pragma unroll
            for (int sp = 0; sp < 2; ++sp) { const bf16x8 a = pack8(X, 8 * sp);
                const s16x4 lo = *(const LAS s16x4*)(VT + e * 40 + 16 * sp + 4 * hf), hi = *(const LAS s16x4*)(VT + e * 40 + 16 * sp + 8 + 4 * hf);
                const bf16x8 bv = (bf16x8){lo[0], lo[1], lo[2], lo[3], hi[0], hi[1], hi[2], hi[3]};
                Z = __builtin_amdgcn_mfma_f32_32x32x16_bf16(a, bv, Z, 0, 0, 0); }
#pragma unroll
            for (int r = 0; r < 16; ++r) { const int c = (r & 3) + 8 * (r >> 2) + 4 * hf; OREC[(size_t)(m0 + c) * 512 + hh * 128 + e] = Z[r]; }
        }
        {
            const int dt = C.wave >> 1;
            const bf16x8 a0 = *(const LAS bf16x8*)(KET + (dt * 32 + r32) * 40 + 8 * hf), a1 = *(const LAS bf16x8*)(KET + (dt * 32 + r32) * 40 + 16 + 8 * hf);
#pragma unroll
            for (int ei = 0; ei < 2; ++ei) { const int et = 2 * (C.wave & 1) + ei;
                const bf16x8 b0 = *(const LAS bf16x8*)(VT + (et * 32 + r32) * 40 + 8 * hf), b1 = *(const LAS bf16x8*)(VT + (et * 32 + r32) * 40 + 16 + 8 * hf);
                f32x16 U = {0.f, 0.f, 0.f, 0.f, 0.f, 0.f, 0.f, 0.f, 0.f, 0.f, 0.f, 0.f, 0.f, 0.f, 0.f, 0.f};
                U = __builtin_amdgcn_mfma_f32_32x32x16_bf16(a0, b0, U, 0, 0, 0); U = __builtin_amdgcn_mfma_f32_32x32x16_bf16(a1, b1, U, 0, 0, 0);
                bf16* up = UT + (size_t)unit * 16384 + (size_t)(et * 32 + r32) * 128 + dt * 32 + 4 * hf;
#pragma unroll
                for (int q = 0; q < 4; ++q) { v2u o; o.x = cvtpk(U[4 * q], U[4 * q + 1]); o.y = cvtpk(U[4 * q + 2], U[4 * q + 3]); *(GAS v2u*)(up + 8 * q) = o; } }
        }
        __syncthreads();
    }
}

__device__ __forceinline__ void p3_hgrn_scan(const Params& P, const Ctx& C) {
    unsigned char* ws = P.ws;
    const bf16* UT = (const bf16*)(ws + WS_U); const bf16* QDEC = (const bf16*)(ws + WS_QDEC); float* OREC = (float*)(ws + WS_OREC); const float* DEC = (const float*)(ws + WS_DECAY);
    LAS bf16* ST = (LAS bf16*)C.lds;
    typedef float f32x4v __attribute__((ext_vector_type(4)));
    for (int unit = blockIdx.x; unit < NB * HG_H * 8; unit += C.G) {
        const int xcd_ = unit & 7, idx_ = unit >> 3; const int sl = idx_ & 7, bh_ = xcd_ + 8 * (idx_ >> 3); const int hh = bh_ & 3, b = bh_ >> 2; const int e0 = sl * 16;
        const int e = C.tid & 15, dq = C.tid >> 4;
        float S[4] = {0.f, 0.f, 0.f, 0.f};
        *(LAS v2u*)(ST + e * 136 + 4 * dq) = (v2u){0u, 0u};
        const int cu0 = (b * HG_H + hh) * 128;
        const int lane = C.lane, fr = lane & 15, fq = lane >> 4;
        const bool mw = C.wave < 2;
        const bf16* up = UT + (size_t)cu0 * 16384 + (size_t)(e0 + e) * 128 + 4 * dq;
        const float* dp = DEC + (size_t)cu0 * 128 + 4 * dq;
        const bf16* qp = QDEC + (size_t)(b * T + C.wave * 16 + fr) * 512 + hh * 128 + 8 * fq;
        float* op = OREC + (size_t)(b * T + C.wave * 16 + 4 * fq) * 512 + hh * 128 + e0 + fr;
        v2u un[4]; f32x4 dn[4]; bf16x8 qa[4][4]; float oi[4][4];
#pragma unroll
        for (int s = 0; s < 4; ++s) { un[s] = *(const GAS v2u*)(up + (size_t)s * 16384); dn[s] = *(const GAS f32x4*)(dp + (size_t)s * 128);
            if (mw) {
#pragma unroll
                for (int k = 0; k < 4; ++k) qa[s][k] = *(const GAS bf16x8*)(qp + (size_t)s * 32 * 512 + 32 * k);
#pragma unroll
                for (int j = 0; j < 4; ++j) oi[s][j] = op[(size_t)(s * 32 + j) * 512]; } }
        __syncthreads();
        for (int nb = 0; nb < 32; ++nb) {
#pragma unroll
            for (int s = 0; s < 4; ++s) {
                const int n = 4 * nb + s;
                const LAS bf16* stc = ST + (n & 1) * (16 * 136); LAS bf16* stn = ST + ((n + 1) & 1) * (16 * 136);
                if (mw) {
                    f32x4v acc = {oi[s][0], oi[s][1], oi[s][2], oi[s][3]};
#pragma unroll
                    for (int k = 0; k < 4; ++k) { const bf16x8 bs = *(const LAS bf16x8*)(stc + fr * 136 + 32 * k + 8 * fq); acc = __builtin_amdgcn_mfma_f32_16x16x32_bf16(qa[s][k], bs, acc, 0, 0, 0); }
#pragma unroll
                    for (int j = 0; j < 4; ++j) op[(size_t)(n * 32 + j) * 512] = acc[j];
                }
                S[0] = dn[s][0] * S[0] + bflo(un[s].x); S[1] = dn[s][1] * S[1] + bfhi(un[s].x); S[2] = dn[s][2] * S[2] + bflo(un[s].y); S[3] = dn[s][3] * S[3] + bfhi(un[s].y);
                *(LAS v2u*)(stn + e * 136 + 4 * dq) = (v2u){cvtpk(S[0], S[1]), cvtpk(S[2], S[3])};
                if (nb + 1 < 32) {
                    const int n2 = n + 4; un[s] = *(const GAS v2u*)(up + (size_t)n2 * 16384); dn[s] = *(const GAS f32x4*)(dp + (size_t)n2 * 128);
                    if (mw) {
#pragma unroll
                        for (int k = 0; k < 4; ++k) qa[s][k] = *(const GAS bf16x8*)(qp + (size_t)n2 * 32 * 512 + 32 * k);
#pragma unroll
                        for (int j = 0; j < 4; ++j) oi[s][j] = op[(size_t)(n2 * 32 + j) * 512]; }
                }
                __syncthreads();
            }
        }
    }
}

__device__ __forceinline__ void p4_yrec(const Params& P, const Ctx& C) {
    unsigned char* ws = P.ws;
    const float* OREC = (const float*)(ws + WS_OREC); const bf16* H = (const bf16*)(ws + WS_H); bf16* YM = (bf16*)(ws + WS_YMIX);
    const float* ng = P.in[I_HGNG];
    const f32x4 g0 = *(const f32x4*)(ng + 8 * C.lane), g1 = *(const f32x4*)(ng + 8 * C.lane + 4);
    for (int m = C.gw; m < NTOK; m += C.ngw) {
        const f32x4 a = *(const GAS f32x4*)(OREC + (size_t)m * 512 + 8 * C.lane), bq = *(const GAS f32x4*)(OREC + (size_t)m * 512 + 8 * C.lane + 4);
        float ss = (a[0] * a[0] + a[1] * a[1]) + (a[2] * a[2] + a[3] * a[3]) + (bq[0] * bq[0] + bq[1] * bq[1]) + (bq[2] * bq[2] + bq[3] * bq[3]);
        ss += __shfl_xor(ss, 1); ss += __shfl_xor(ss, 2); ss += __shfl_xor(ss, 4); ss += __shfl_xor(ss, 8);
        const float rs = 1.f / sqrtf(ss * (1.f / 128.f) + RMS_EPS);
        const v4u gw = *(const GAS v4u*)(H + (size_t)m * D_INP + C_GG + 8 * C.lane);
        float gv[8] = {bflo(gw.x), bfhi(gw.x), bflo(gw.y), bfhi(gw.y), bflo(gw.z), bfhi(gw.z), bflo(gw.w), bfhi(gw.w)};
        float o[8];
#pragma unroll
        for (int j = 0; j < 4; ++j) { o[j] = a[j] * rs * g0[j] * (gv[j] * sigmoidf_(gv[j])); o[4 + j] = bq[j] * rs * g1[j] * (gv[4 + j] * sigmoidf_(gv[4 + j])); }
        v2u w; w.x = pk4_fp8(o[0] * 8.f, o[1] * 8.f, o[2] * 8.f, o[3] * 8.f); w.y = pk4_fp8(o[4] * 8.f, o[5] * 8.f, o[6] * 8.f, o[7] * 8.f);
        *(GAS v2u*)((unsigned char*)YM + (size_t)m * D + 512 + 8 * C.lane) = w;
#if !FEAT_ATT
        *(GAS v4u*)(YM + (size_t)m * D + 8 * C.lane) = (v4u){0u, 0u, 0u, 0u};
#endif
    }
}

namespace pg8 {
struct EpiKhead {
    static constexpr bool PERM = true, AFTER_DRAIN = false;
    bf16_t* O;
    __device__ __forceinline__ void operator()(const f32x4 (&acc)[2][2][4][2], const Unit& u, int wr, int wc, int fr, int fq) const {
        const int row0 = u.pm * BM + wr * 64 + fr, col0 = u.pn * BM + wc * 32 + 8 * fq;
#pragma unroll
        for (int ai = 0; ai < 2; ++ai)
#pragma unroll
            for (int m = 0; m < 4; ++m) { const int row = row0 + ai * HALF + m * 16; const int b = row >> 12, t = row & 4095;
#pragma unroll
                for (int bj = 0; bj < 2; ++bj) { const int col = col0 + bj * HALF; const f32x4 v0 = acc[ai][bj][m][0], v1 = acc[ai][bj][m][1];
                    u32x4 w; w.x = cvt_pk_bf16(v0[0], v0[1]); w.y = cvt_pk_bf16(v0[2], v0[3]); w.z = cvt_pk_bf16(v1[0], v1[1]); w.w = cvt_pk_bf16(v1[2], v1[3]);
                    *(u32x4*)(O + ((size_t)((b * 8 + (col >> 6)) * 4096 + t)) * 64 + (col & 63)) = w; } }
    }
};
struct EpiVt {
    static constexpr bool PERM = true, AFTER_DRAIN = false;
    bf16_t* O;
    __device__ __forceinline__ void operator()(const f32x4 (&acc)[2][2][4][2], const Unit& u, int wr, int wc, int fr, int fq) const {
        const int row0 = u.pm * BM + wr * 64 + fr, col0 = u.pn * BM + wc * 32 + 8 * fq;
#pragma unroll
        for (int ai = 0; ai < 2; ++ai)
#pragma unroll
            for (int m = 0; m < 4; ++m) { const int row = row0 + ai * HALF + m * 16;
#pragma unroll
                for (int bj = 0; bj < 2; ++bj) { const int col = col0 + bj * HALF; const int b = col >> 12, t = col & 4095; const f32x4 v0 = acc[ai][bj][m][0], v1 = acc[ai][bj][m][1];
                    u32x4 w; w.x = cvt_pk_bf16(v0[0], v0[1]); w.y = cvt_pk_bf16(v0[2], v0[3]); w.z = cvt_pk_bf16(v1[0], v1[1]); w.w = cvt_pk_bf16(v1[2], v1[3]);
                    *(u32x4*)(O + ((size_t)(b * 512 + row)) * 4096 + t) = w; } }
    }
};
}

__device__ __forceinline__ unsigned f2ord(float x) { const unsigned b = __builtin_bit_cast(unsigned, x); return b ^ ((unsigned)((int)b >> 31) | 0x80000000u); }
typedef _Float16 h16;
typedef _Float16 h16x8 __attribute__((ext_vector_type(8)));
__device__ __forceinline__ float relu_i(float x) { const int b = __builtin_bit_cast(int, x); return __builtin_bit_cast(float, b > 0 ? b : 0); }
__device__ __forceinline__ unsigned h2ord(unsigned hb) { return (hb ^ ((hb & 0x8000u) ? 0xffffu : 0x8000u)) & 0xffffu; }
__device__ __forceinline__ int isc_bucket(float x, float mu, float scale) { const float t = fminf(fmaxf(fmaf(x - mu, scale, 128.f), 0.f), 255.f); return (int)t; }
__device__ __forceinline__ void p3_indexer(const Params& P, const Ctx& C) {
    unsigned char* ws = P.ws;
    const bf16* H = (const bf16*)(ws + WS_H); const bf16* IKN = (const bf16*)(ws + WS_IKN); unsigned* MASK = (unsigned*)(ws + WS_MASK);
    LAS h16* ISC = (LAS h16*)C.lds; LAS unsigned* HIST = (LAS unsigned*)(C.lds + 131072) + C.wave * 256; LAS float* STAT = (LAS float*)(C.lds + 139264); LAS float* W16 = (LAS float*)(C.lds + 140288);
    const int lane = C.lane, r32 = lane & 31, hf = lane >> 5;
    const int ql = 2 * (r32 >> 4) + ((r32 >> 2) & 1), hd = 4 * ((r32 >> 3) & 1) + (r32 & 3);
    constexpr int CAND_CAP = 120, QU = 16;
    for (int u = blockIdx.x; u < NTOK / QU; u += C.G) {
        const int b = u & 7, j = (u >> 3) & 31, i = u >> 8; const int pi = i >> 1; const int blk = (i & 1) ? (255 - (j + 32 * pi)) : (j + 32 * pi);
        const int t0 = blk * QU; const size_t mb = (size_t)b * T;
        const int nkt = (t0 + QU + 31) >> 5;
        bf16x8 af[4][4];
#pragma unroll
        for (int a = 0; a < 4; ++a) {
            const bf16* qp = H + (mb + t0 + 4 * a + ql) * D_INP + C_IQ + hd * 64 + 8 * hf;
#pragma unroll
            for (int k = 0; k < 4; ++k) af[a][k] = *(const GAS bf16x8*)(qp + 16 * k);
        }
        if (C.tid < 128) { const int q = C.tid >> 3, h8 = C.tid & 7; W16[C.tid] = bf2f(H[(mb + t0 + q) * D_INP + C_IW + h8]) * (0.125f * 0.35355339059327373f); }
        __syncthreads();
        {
            int kt = C.wave; bf16x8 bk[4], bn[4];
            if (kt < nkt) { const bf16* kp = IKN + (mb + kt * 32 + r32) * 64 + 8 * hf;
#pragma unroll
                for (int k = 0; k < 4; ++k) bk[k] = *(const GAS bf16x8*)(kp + 16 * k); }
            for (; kt < nkt; kt += NWAVES) {
                const int s0 = kt * 32;
                if (kt + NWAVES < nkt) { const bf16* kp = IKN + (mb + s0 + 32 * NWAVES + r32) * 64 + 8 * hf;
#pragma unroll
                    for (int k = 0; k < 4; ++k) bn[k] = *(const GAS bf16x8*)(kp + 16 * k); }
#pragma unroll
                for (int a = 0; a < 4; ++a) {
                    f32x16 acc = {0.f, 0.f, 0.f, 0.f, 0.f, 0.f, 0.f, 0.f, 0.f, 0.f, 0.f, 0.f, 0.f, 0.f, 0.f, 0.f};
#pragma unroll
                    for (int k = 0; k < 4; ++k) acc = __builtin_amdgcn_mfma_f32_32x32x16_bf16(af[a][k], bk[k], acc, 0, 0, 0);
#pragma unroll
                    for (int qh = 0; qh < 2; ++qh) { float sa = 0.f, sb = 0.f;
                        const int q = 4 * a + 2 * qh + hf, key = s0 + r32;
                        const f32x4 wl = *(const LAS f32x4*)(W16 + q * 8), wh = *(const LAS f32x4*)(W16 + q * 8 + 4);
                        sa = fmaf(wl[0], relu_i(acc[8 * qh + 0]), sa); sb = fmaf(wl[1], relu_i(acc[8 * qh + 1]), sb); sa = fmaf(wl[2], relu_i(acc[8 * qh + 2]), sa); sb = fmaf(wl[3], relu_i(acc[8 * qh + 3]), sb);
                        sa = fmaf(wh[0], relu_i(acc[8 * qh + 4]), sa); sb = fmaf(wh[1], relu_i(acc[8 * qh + 5]), sb); sa = fmaf(wh[2], relu_i(acc[8 * qh + 6]), sa); sb = fmaf(wh[3], relu_i(acc[8 * qh + 7]), sb);
                        float sv = sa + sb; const bool valid = key <= t0 + q; sv += 0.0f;
                        ISC[q * 4096 + key] = valid ? (h16)sv : (h16)(-INFINITY);
                    }
                }
#pragma unroll
                for (int k = 0; k < 4; ++k) bk[k] = bn[k];
            }
        }
        __syncthreads();
        for (int q = C.wave; q < QU; q += NWAVES) {
            const int t = t0 + q, n = t + 1; const LAS unsigned short* row = (const LAS unsigned short*)(ISC + q * 4096);
            unsigned* mrow = MASK + (mb + t) * 128;
            if (n <= TOPK) {
#pragma unroll
                for (int w2 = 0; w2 < 2; ++w2) { const int wi = lane + 64 * w2; const int lo = 32 * wi; unsigned bits;
                    if (lo + 31 <= t) bits = 0xffffffffu; else if (lo > t) bits = 0u; else bits = (1u << (t - lo + 1)) - 1u;
                    mrow[wi] = bits; }
            } else {
                unsigned dhi = 0u; int need = TOPK;
#pragma unroll
                for (int pass = 1; pass >= 0; --pass) {
                    LDS_WAIT();
#pragma unroll
                    for (int z = 0; z < 4; ++z) HIST[lane + 64 * z] = 0u;
#pragma unroll 2
                    for (int e0 = 8 * lane; e0 < n; e0 += 512) { const v4u v = *(const LAS v4u*)(row + e0);
#pragma unroll
                        for (int jj = 0; jj < 8; ++jj) { const unsigned w = (jj < 2) ? v.x : (jj < 4) ? v.y : (jj < 6) ? v.z : v.w; const unsigned hb = (jj & 1) ? (w >> 16) : (w & 0xffffu);
                            const unsigned key = h2ord(hb);
                            const bool ok = (e0 + jj < n) && (pass == 1 || (key >> 8) == dhi);
                            if (ok) atomicAdd((unsigned*)&HIST[pass == 1 ? (key >> 8) : (key & 255u)], 1u); } }
                    LDS_WAIT();
                    const v4u c4 = *(const LAS v4u*)(HIST + 4 * lane);
                    const unsigned c0 = c4.x, c1 = c4.y, c2 = c4.z, c3 = c4.w; const unsigned s4 = c0 + c1 + c2 + c3;
                    unsigned suf = s4;
#pragma unroll
                    for (int o = 1; o < 64; o <<= 1) { const unsigned v2 = __shfl_down(suf, o); if (lane + o < 64) suf += v2; }
                    unsigned cum = suf - s4; int dsel = -1; int nnew = 0; const unsigned nd = (unsigned)need;
                    if (cum < nd && nd <= cum + c3) { dsel = 4 * lane + 3; nnew = (int)(nd - cum); } cum += c3;
                    if (dsel < 0 && cum < nd && nd <= cum + c2) { dsel = 4 * lane + 2; nnew = (int)(nd - cum); } cum += c2;
                    if (dsel < 0 && cum < nd && nd <= cum + c1) { dsel = 4 * lane + 1; nnew = (int)(nd - cum); } cum += c1;
                    if (dsel < 0 && cum < nd && nd <= cum + c0) { dsel = 4 * lane + 0; nnew = (int)(nd - cum); }
                    const unsigned long long bal = __ballot(dsel >= 0);
                    const int src = (bal != 0ull) ? (int)__builtin_ctzll(bal) : 0;
                    const int dd = __shfl(dsel, src); need = __shfl(nnew, src);
                    if (pass == 1) dhi = (unsigned)dd; else dhi = (dhi << 8) | (unsigned)dd;
                }
                const unsigned Tk = dhi;
                int run_eq = 0; unsigned long long mine = 0ull; const int nit = (t >> 6) + 1;
#pragma unroll 4
                for (int it = 0; it < nit; ++it) { const int e = it * 64 + lane; const unsigned key = h2ord(row[e]); const bool valid = e <= t;
                    const bool eq = valid && (key == Tk); const unsigned long long beq = __ballot(eq);
                    const int rk = run_eq + __builtin_popcountll(beq & ((1ull << lane) - 1ull));
                    const bool sel = valid && ((key > Tk) || (eq && rk < need)); run_eq += __builtin_popcountll(beq);
                    const unsigned long long bs = __ballot(sel);
                    if (lane == it) mine = bs; }
                *(GAS v2u*)(mrow + 2 * lane) = (v2u){(unsigned)mine, (unsigned)(mine >> 32)};
            }
        }
        __syncthreads();
    }
}

__device__ __forceinline__ void attn_task(const bf16* H, const bf16* KH, const bf16* VT, const unsigned* MASK, bf16* YM, int b, int hh, int t0, int lane) {
    const int r32 = lane & 31, hf = lane >> 5;
    const float LOG2E = 1.4426950408889634f; const float c1 = 0.125f * LOG2E; const float sl2 = exp2f(-(float)(hh + 1)) * LOG2E;
    const size_t mb = (size_t)b * T;
    bf16x8 qf[4];
#pragma unroll
    for (int k = 0; k < 4; ++k) qf[k] = *(const GAS bf16x8*)(H + (mb + t0 + r32) * D_INP + C_AQ + hh * 64 + 16 * k + 8 * hf);
    const bf16* kbase = KH + ((size_t)(b * 8 + hh) * T) * 64; const bf16* vbase = VT + ((size_t)(b * 512 + hh * 64)) * T; const unsigned* mrow = MASK + (mb + t0 + r32) * 128;
    float m_run = -1e30f, l = 0.f;
    f32x16 O0 = {0.f, 0.f, 0.f, 0.f, 0.f, 0.f, 0.f, 0.f, 0.f, 0.f, 0.f, 0.f, 0.f, 0.f, 0.f, 0.f}, O1 = O0;
    const int nkt = (t0 + 32 + 63) >> 6;
    for (int kt = 0; kt < nkt; ++kt) {
        const int s0 = kt * 64;
        bf16x8 kf[2][4];
#pragma unroll
        for (int uu = 0; uu < 2; ++uu)
#pragma unroll
            for (int k = 0; k < 4; ++k) kf[uu][k] = *(const GAS bf16x8*)(kbase + (size_t)(s0 + 32 * uu + r32) * 64 + 16 * k + 8 * hf);
        const v2u mw = *(const GAS v2u*)(mrow + 2 * kt);
        s16x4 vl[2][2][2], vh[2][2][2];
#pragma unroll
        for (int uu = 0; uu < 2; ++uu)
#pragma unroll
            for (int sp = 0; sp < 2; ++sp)
#pragma unroll
                for (int dt = 0; dt < 2; ++dt) { const bf16* vp = vbase + (size_t)(dt * 32 + r32) * T + s0 + 32 * uu + 16 * sp + 4 * hf;
                    vl[uu][sp][dt] = *(const GAS s16x4*)vp; vh[uu][sp][dt] = *(const GAS s16x4*)(vp + 8); }
        f32x16 a0 = {0.f, 0.f, 0.f, 0.f, 0.f, 0.f, 0.f, 0.f, 0.f, 0.f, 0.f, 0.f, 0.f, 0.f, 0.f, 0.f}, a1 = a0;
#pragma unroll
        for (int k = 0; k < 4; ++k) { a0 = __builtin_amdgcn_mfma_f32_32x32x16_bf16(kf[0][k], qf[k], a0, 0, 0, 0); a1 = __builtin_amdgcn_mfma_f32_32x32x16_bf16(kf[1][k], qf[k], a1, 0, 0, 0); }
        const float dist0 = (float)(t0 + r32 - s0 - 4 * hf);
        const unsigned m0 = mw.x >> (4 * hf), m1 = mw.y >> (4 * hf);
        float mx = -1e30f;
#pragma unroll
        for (int r = 0; r < 16; ++r) { const int ko = (r & 3) + 8 * (r >> 2);
            const float d0 = dist0 - (float)ko;
            a0[r] = ((m0 >> ko) & 1u) ? (a0[r] * c1 - sl2 * d0) : -1e30f;
            a1[r] = ((m1 >> ko) & 1u) ? (a1[r] * c1 - sl2 * (d0 - 32.f)) : -1e30f;
            mx = fmaxf(mx, fmaxf(a0[r], a1[r])); }
        mx = fmaxf(mx, __shfl_xor(mx, 32));
        const float m_new = fmaxf(m_run, mx); const float alpha = __builtin_amdgcn_exp2f(m_run - m_new); m_run = m_new;
        float ps = 0.f;
#pragma unroll
        for (int r = 0; r < 16; ++r) { const int ko = (r & 3) + 8 * (r >> 2);
            const float p0 = ((m0 >> ko) & 1u) ? __builtin_amdgcn_exp2f(a0[r] - m_new) : 0.f;
            const float p1 = ((m1 >> ko) & 1u) ? __builtin_amdgcn_exp2f(a1[r] - m_new) : 0.f;
            a0[r] = p0; a1[r] = p1; ps += p0 + p1; }
        l = l * alpha + ps;
#pragma unroll
        for (int r = 0; r < 16; ++r) { O0[r] *= alpha; O1[r] *= alpha; }
#pragma unroll
        for (int sp = 0; sp < 2; ++sp) {
            const bf16x8 pb0 = pack8(a0, 8 * sp), pb1 = pack8(a1, 8 * sp);
#define VFR(uu, dt) ((bf16x8){vl[uu][sp][dt][0], vl[uu][sp][dt][1], vl[uu][sp][dt][2], vl[uu][sp][dt][3], vh[uu][sp][dt][0], vh[uu][sp][dt][1], vh[uu][sp][dt][2], vh[uu][sp][dt][3]})
            O0 = __builtin_amdgcn_mfma_f32_32x32x16_bf16(VFR(0, 0), pb0, O0, 0, 0, 0);
            O1 = __builtin_amdgcn_mfma_f32_32x32x16_bf16(VFR(0, 1), pb0, O1, 0, 0, 0);
            O0 = __builtin_amdgcn_mfma_f32_32x32x16_bf16(VFR(1, 0), pb1, O0, 0, 0, 0);
            O1 = __builtin_amdgcn_mfma_f32_32x32x16_bf16(VFR(1, 1), pb1, O1, 0, 0, 0);
#undef VFR
        }
    }
    l += __shfl_xor(l, 32);
    const float inv = 1.f / l;
    bf16* yp = YM + (mb + t0 + r32) * D + hh * 64 + 4 * hf;
#pragma unroll
    for (int rq = 0; rq < 4; ++rq) {
        v2u o; o.x = cvtpk(O0[4 * rq] * inv, O0[4 * rq + 1] * inv); o.y = cvtpk(O0[4 * rq + 2] * inv, O0[4 * rq + 3] * inv); *(GAS v2u*)(yp + 8 * rq) = o;
        v2u o2; o2.x = cvtpk(O1[4 * rq] * inv, O1[4 * rq + 1] * inv); o2.y = cvtpk(O1[4 * rq + 2] * inv, O1[4 * rq + 3] * inv); *(GAS v2u*)(yp + 32 + 8 * rq) = o2; }
}
__device__ __forceinline__ void p4_attention(const Params& P, const Ctx& C) {
    unsigned char* ws = P.ws;
    const bf16* H = (const bf16*)(ws + WS_H); const bf16* KH = (const bf16*)(ws + WS_K); const bf16* VT = (const bf16*)(ws + WS_VT); const unsigned* MASK = (const unsigned*)(ws + WS_MASK); bf16* YM = (bf16*)(ws + WS_YMIX);
    for (int p = blockIdx.x; p < 512; p += C.G) {
        const int bh = p >> 3, j = p & 7; const int b = bh >> 3, hh = bh & 7;
        attn_task(H, KH, VT, MASK, YM, b, hh, j * 256 + C.wave * 32, C.lane);
        attn_task(H, KH, VT, MASK, YM, b, hh, (15 - j) * 256 + (7 - C.wave) * 32, C.lane);
    }
}

constexpr int AT_KB = 64 * 144, AT_VB = 64 * 136, AT_VOFF = 2 * AT_KB;
__device__ __forceinline__ void attn_block(const Ctx& C, const bf16* H, const bf16* KH, const bf16* VT, const unsigned* MASK, bf16* YM, int b, int hh, int qb) {
    const int lane = C.lane, r32 = lane & 31, hf = lane >> 5, tid = C.tid;
    const float LOG2E = 1.4426950408889634f; const float c1 = 0.125f * LOG2E; const float sl2 = exp2f(-(float)(hh + 1)) * LOG2E;
    const size_t mb = (size_t)b * T; const int t0 = qb * 256 + C.wave * 32;
    bf16x8 qf[4];
#pragma unroll
    for (int k = 0; k < 4; ++k) { const v4u w = *(const GAS v4u*)(H + (mb + t0 + r32) * D_INP + C_AQ + hh * 64 + 16 * k + 8 * hf);
        v4u o; o.x = cvtpk(bflo(w.x) * c1, bfhi(w.x) * c1); o.y = cvtpk(bflo(w.y) * c1, bfhi(w.y) * c1); o.z = cvtpk(bflo(w.z) * c1, bfhi(w.z) * c1); o.w = cvtpk(bflo(w.w) * c1, bfhi(w.w) * c1);
        qf[k] = __builtin_bit_cast(bf16x8, o); }
    const bf16* kbase = KH + ((size_t)(b * 8 + hh) * T) * 64; const bf16* vbase = VT + ((size_t)(b * 512 + hh * 64)) * T; const unsigned* mrow = MASK + (mb + t0 + r32) * 128;
    const int srow = tid >> 3, sch = tid & 7;
    const bf16* kst = kbase + (size_t)srow * 64 + 8 * sch; const bf16* vst = vbase + (size_t)srow * T + 8 * sch;
    LAS unsigned char* kw = C.lds + srow * 144 + 16 * sch; LAS unsigned char* vw = C.lds + AT_VOFF + srow * 136 + 16 * sch;
    const LAS unsigned char* kr = C.lds + r32 * 144 + 16 * hf; const LAS unsigned char* vr = C.lds + AT_VOFF + r32 * 136 + 8 * hf;
    float m_run = -1e30f, l = 0.f;
    f32x16 O0 = {0.f, 0.f, 0.f, 0.f, 0.f, 0.f, 0.f, 0.f, 0.f, 0.f, 0.f, 0.f, 0.f, 0.f, 0.f, 0.f}, O1 = O0;
    const int nkt = 4 * (qb + 1), ktw = (t0 + 31) >> 6;
    v4u kn = *(const GAS v4u*)kst, vn = *(const GAS v4u*)vst; v2u mwn = *(const GAS v2u*)mrow;
    *(LAS v4u*)kw = kn; *(LAS v2u*)vw = (v2u){vn.x, vn.y}; *(LAS v2u*)(vw + 8) = (v2u){vn.z, vn.w};
    __syncthreads();
    for (int kt = 0; kt < nkt; ++kt) {
        const int s0 = kt * 64; const int cur = kt & 1; const v2u mw = mwn;
        if (kt + 1 < nkt) { kn = *(const GAS v4u*)(kst + (size_t)(s0 + 64) * 64); vn = *(const GAS v4u*)(vst + s0 + 64); mwn = *(const GAS v2u*)(mrow + 2 * kt + 2); }
        if (kt <= ktw) {
            const LAS unsigned char* kc = kr + cur * AT_KB; const LAS unsigned char* vc = vr + cur * AT_VB;
            const float B0 = -sl2 * (float)(t0 + r32 - s0 - 4 * hf);
            f32x16 a0, a1;
#pragma unroll
            for (int r = 0; r < 16; ++r) { const float ko = (float)((r & 3) + 8 * (r >> 2)); a0[r] = B0 + sl2 * ko; a1[r] = B0 + sl2 * (ko + 32.f); }
#pragma unroll
            for (int k = 0; k < 4; ++k) { const bf16x8 k0 = *(const LAS bf16x8*)(kc + 32 * k), k1 = *(const LAS bf16x8*)(kc + 32 * 144 + 32 * k);
                a0 = __builtin_amdgcn_mfma_f32_32x32x16_bf16(k0, qf[k], a0, 0, 0, 0); a1 = __builtin_amdgcn_mfma_f32_32x32x16_bf16(k1, qf[k], a1, 0, 0, 0); }
            const unsigned m0 = mw.x >> (4 * hf), m1 = mw.y >> (4 * hf);
            float mx = -1e30f;
#pragma unroll
            for (int r = 0; r < 16; ++r) { const int ko = (r & 3) + 8 * (r >> 2);
                const unsigned k0m = (unsigned)__builtin_amdgcn_sbfe((int)m0, ko, 1), k1m = (unsigned)__builtin_amdgcn_sbfe((int)m1, ko, 1);
                const float x0 = a0[r], x1 = a1[r];
                a0[r] = __builtin_bit_cast(float, (__builtin_bit_cast(unsigned, x0) & k0m) | (0xf149f2cau & ~k0m));
                a1[r] = __builtin_bit_cast(float, (__builtin_bit_cast(unsigned, x1) & k1m) | (0xf149f2cau & ~k1m));
                mx = fmaxf(mx, fmaxf(a0[r], a1[r])); }
            mx = fmaxf(mx, __shfl_xor(mx, 32));
            const float m_new = fmaxf(m_run, mx);
            const float m_use = fmaxf(m_new, -1e20f);
            float ps = 0.f;
#pragma unroll
            for (int r = 0; r < 16; ++r) { const float p0 = __builtin_amdgcn_exp2f(a0[r] - m_use), p1 = __builtin_amdgcn_exp2f(a1[r] - m_use); a0[r] = p0; a1[r] = p1; ps += p0 + p1; }
            if (__builtin_amdgcn_ballot_w64(m_new != m_run) != 0ull) {
                const float alpha = __builtin_amdgcn_exp2f(m_run - m_new); m_run = m_new;
                l *= alpha;
#pragma unroll
                for (int r = 0; r < 16; ++r) { O0[r] *= alpha; O1[r] *= alpha; }
            }
            l += ps;
#pragma unroll
            for (int sp = 0; sp < 2; ++sp) {
                const bf16x8 pb0 = pack8(a0, 8 * sp), pb1 = pack8(a1, 8 * sp);
#define VLD(uu, dt) ({ const s16x4 lo_ = *(const LAS s16x4*)(vc + (dt) * 32 * 136 + 2 * (32 * (uu) + 16 * sp)), hi_ = *(const LAS s16x4*)(vc + (dt) * 32 * 136 + 2 * (32 * (uu) + 16 * sp + 8)); (bf16x8){lo_[0], lo_[1], lo_[2], lo_[3], hi_[0], hi_[1], hi_[2], hi_[3]}; })
                O0 = __builtin_amdgcn_mfma_f32_32x32x16_bf16(VLD(0, 0), pb0, O0, 0, 0, 0);
                O1 = __builtin_amdgcn_mfma_f32_32x32x16_bf16(VLD(0, 1), pb0, O1, 0, 0, 0);
                O0 = __builtin_amdgcn_mfma_f32_32x32x16_bf16(VLD(1, 0), pb1, O0, 0, 0, 0);
                O1 = __builtin_amdgcn_mfma_f32_32x32x16_bf16(VLD(1, 1), pb1, O1, 0, 0, 0);
#undef VLD
            }
        }
        if (kt + 1 < nkt) { const int nx = cur ^ 1; *(LAS v4u*)(kw + nx * AT_KB) = kn; *(LAS v2u*)(vw + nx * AT_VB) = (v2u){vn.x, vn.y}; *(LAS v2u*)(vw + nx * AT_VB + 8) = (v2u){vn.z, vn.w}; }
        __syncthreads();
    }
    l += __shfl_xor(l, 32);
    const float inv = 1.f / l;
    unsigned char* yp = (unsigned char*)YM + (mb + t0 + r32) * D + hh * 64 + 4 * hf;
    const float i8 = inv * 8.f;
#pragma unroll
    for (int rq = 0; rq < 4; ++rq) {
        *(GAS unsigned*)(yp + 8 * rq) = pk4_fp8(O0[4 * rq] * i8, O0[4 * rq + 1] * i8, O0[4 * rq + 2] * i8, O0[4 * rq + 3] * i8);
        *(GAS unsigned*)(yp + 32 + 8 * rq) = pk4_fp8(O1[4 * rq] * i8, O1[4 * rq + 1] * i8, O1[4 * rq + 2] * i8, O1[4 * rq + 3] * i8); }
}
__device__ __forceinline__ void p4_attention2(const Params& P, const Ctx& C) {
    unsigned char* ws = P.ws;
    const bf16* H = (const bf16*)(ws + WS_H); const bf16* KH = (const bf16*)(ws + WS_K); const bf16* VT = (const bf16*)(ws + WS_VT); const unsigned* MASK = (const unsigned*)(ws + WS_MASK); bf16* YM = (bf16*)(ws + WS_YMIX);
    for (int p = blockIdx.x; p < 512; p += C.G) {
        const int b = p & 7, q = p >> 3; const int hh = q >> 3, j = q & 7;
        attn_block(C, H, KH, VT, MASK, YM, b, hh, j);
        attn_block(C, H, KH, VT, MASK, YM, b, hh, 15 - j);
    }
}

#ifndef FEAT_MIX
#define FEAT_MIX 1
#endif
#ifndef FEAT_MOE
#define FEAT_MOE 1
#endif
#ifndef FEAT_PLE
#define FEAT_PLE 1
#endif
#ifndef FEAT_ATT
#define FEAT_ATT 1
#endif

template <bool PUBLISH = true> __device__ __forceinline__ void p6_ln1_router(const Params& P, const Ctx& C) {
    unsigned char* ws = P.ws;
    float* X1 = (float*)(ws + WS_X1); unsigned char* XB = ws + WS_XB;
    LAS float* wl = (LAS float*)C.lds;
    LAS int* hist = (LAS int*)(C.lds + MISC_OFF);
    { const float* wrt = (const float*)(ws + WS_WRT);
      for (int i = C.tid; i < 32 * 1024 / 4; i += NTHR) *(LAS f32x4*)(wl + 4 * i) = *(const GAS f32x4*)(wrt + 4 * i);
      if (C.tid < 32) hist[C.tid] = 0; }
    __syncthreads();
    int* tope = (int*)(ws + WS_TOPE); float* gate = (float*)(ws + WS_GATE); int* lrank = (int*)(ws + WS_LRANK);
    const float* src = P.out;
    const int lane = C.lane, hf = lane >> 5, ex = lane & 31;
    const float brl = P.in[I_BR][ex];
    for (int m0 = 2 * C.gw; m0 < NTOK; m0 += 2 * C.ngw) {
        f32x4 va[4], vb[4]; load_row_f32(va, src + (size_t)m0 * D, lane); load_row_f32(vb, src + (size_t)(m0 + 1) * D, lane);
        ln_row(va, P.in[I_LNMG], P.in[I_LNMB], lane); ln_row(vb, P.in[I_LNMG], P.in[I_LNMB], lane);
        store_row_f32(X1 + (size_t)m0 * D, va, lane); store_row_f32(X1 + (size_t)(m0 + 1) * D, vb, lane);
        store_row_fp8x8(XB + (size_t)m0 * D, va, lane); store_row_fp8x8(XB + (size_t)(m0 + 1) * D, vb, lane);
        float v[32];
#pragma unroll
        for (int e = 0; e < 32; ++e) { float pa = 0.f, pb = 0.f;
#pragma unroll
            for (int j = 0; j < 4; ++j) { const f32x4 w = *(const LAS f32x4*)(wl + e * 1024 + 4 * lane + 256 * j);
                pa += (va[j][0] * w[0] + va[j][1] * w[1]) + (va[j][2] * w[2] + va[j][3] * w[3]); pb += (vb[j][0] * w[0] + vb[j][1] * w[1]) + (vb[j][2] * w[2] + vb[j][3] * w[3]); }
            const float keep = hf ? pb : pa, send = hf ? pa : pb; v[e] = keep + __shfl_xor(send, 32); }
#define HALVE(M, CNT) { const bool up_ = (lane & (M)) != 0; _Pragma("unroll") for (int i_ = 0; i_ < (CNT) / 2; ++i_) { const float k_ = up_ ? v[i_ + (CNT) / 2] : v[i_], s_ = up_ ? v[i_] : v[i_ + (CNT) / 2]; v[i_] = k_ + __shfl_xor(s_, (M)); } }
        HALVE(16, 32) HALVE(8, 16) HALVE(4, 8) HALVE(2, 4) HALVE(1, 2)
#undef HALVE
        float lg = v[0] + brl;
        int se[4]; float sv[4];
#pragma unroll
        for (int k = 0; k < 4; ++k) { float bv = lg; int bi = ex;
#pragma unroll
            for (int o = 1; o < 32; o <<= 1) { const float ov = __shfl_xor(bv, o); const int oi = __shfl_xor(bi, o); const bool take = (ov > bv) || (ov == bv && oi < bi); bv = take ? ov : bv; bi = take ? oi : bi; }
            se[k] = bi; sv[k] = bv; if (ex == bi) lg = -INFINITY; }
        float exv[4], sum = 0.f;
#pragma unroll
        for (int k = 0; k < 4; ++k) { exv[k] = __expf(sv[k] - sv[0]); sum += exv[k]; }
        const float inv = 1.f / sum;
        if (ex == 0) { const int m = m0 + hf;
#pragma unroll
            for (int k = 0; k < 4; ++k) { const int lr = atomicAdd((int*)&hist[se[k]], 1); tope[m * 4 + k] = se[k]; gate[m * 4 + k] = exv[k] * inv; lrank[m * 4 + k] = lr; } }
    }
    __syncthreads();
    if (PUBLISH && C.tid < 32) { unsigned* cnt = (unsigned*)(ws + WS_CTL) + CW_CNT; const int base = (int)atomicAdd(cnt + C.tid, (unsigned)hist[C.tid]); ((int*)(ws + WS_WGBASE))[blockIdx.x * 32 + C.tid] = base; }
}

__device__ __forceinline__ void p7_dispatch(const Params& P, const Ctx& C) {
    unsigned char* ws = P.ws;
    LAS int* ps = (LAS int*)(C.lds + MISC_OFF + 256);
    const unsigned* cnt = (const unsigned*)(ws + WS_CTL) + CW_CNT;
    int* tile_e = (int*)(ws + WS_TILEE);
    if (C.tid == 0) { int run = 0;
        for (int e = 0; e < NE; ++e) { const int c = (int)__hip_atomic_load(cnt + e, __ATOMIC_RELAXED, __HIP_MEMORY_SCOPE_AGENT); ps[e] = run; const int nt = (c + 255) >> 8;
            if (blockIdx.x == 0) for (int t = 0; t < nt; ++t) tile_e[(run >> 8) + t] = e;
            run += nt << 8; }
        if (blockIdx.x == 0) tile_e[MAXTILES] = run >> 8; }
    __syncthreads();
    const int* tope = (const int*)(ws + WS_TOPE); const float* gate = (const float*)(ws + WS_GATE); const int* lrank = (const int*)(ws + WS_LRANK);
    const int* wgb = (const int*)(ws + WS_WGBASE);
    int* tokslot = (int*)(ws + WS_TOKSLOT); float* slotgate = (float*)(ws + WS_SLOTGATE);
    const bf16* XB = (const bf16*)(ws + WS_XB); unsigned char* xs = ws + WS_XS;
    for (int m = C.gw; m < NTOK; m += C.ngw) {
        const int wgm = ((m >> 1) % C.ngw) >> 3;
        const v4u f8 = *(const GAS v4u*)((const unsigned char*)XB + (size_t)m * D + 16 * C.lane);
#pragma unroll
        for (int k = 0; k < 4; ++k) { const int e = tope[m * 4 + k]; const int slot = ps[e] + wgb[wgm * 32 + e] + lrank[m * 4 + k];
            *(GAS v4u*)(xs + (size_t)slot * D + 16 * C.lane) = f8;
            if (C.lane == 0) { slotgate[slot] = gate[m * 4 + k]; tokslot[m * 4 + k] = slot; } }
    }
}

__device__ __forceinline__ void p10_combine_ln2(const Params& P, const Ctx& C) {
    unsigned char* ws = P.ws;
    float* X1 = (float*)(ws + WS_X1); bf16* XB = (bf16*)(ws + WS_XB);
    const int* tokslot = (const int*)(ws + WS_TOKSLOT); const bf16* ys = (const bf16*)(ws + WS_YSLOT);
    for (int m = C.gw; m < NTOK; m += C.ngw) {
        f32x4 v[4]; load_row_f32(v, X1 + (size_t)m * D, C.lane);
#pragma unroll
        for (int j = 0; j < 4; ++j) v[j] = v[j] * ALPHA;
#if FEAT_MOE
#pragma unroll
        for (int k = 0; k < 4; ++k) { const int slot = tokslot[m * 4 + k]; const bf16* yr = ys + (size_t)slot * D;
#pragma unroll
            for (int j = 0; j < 4; ++j) { const v2u w = *(const GAS v2u*)(yr + 4 * C.lane + 256 * j); v[j][0] += bflo(w.x); v[j][1] += bfhi(w.x); v[j][2] += bflo(w.y); v[j][3] += bfhi(w.y); } }
#endif
        ln_row(v, P.in[I_LNFG], P.in[I_LNFB], C.lane);
        store_row_f32(P.out + (size_t)m * D, v, C.lane);
        store_row_fp8x8((unsigned char*)XB + (size_t)m * D, v, C.lane);
    }
}

__device__ __forceinline__ void p12_final_ln(const Params& P, const Ctx& C) {
#if FEAT_PLE
    const float* src = (const float*)(P.ws + WS_X1); const float sc = 1.0f;
#else
    const float* src = P.out; const float sc = ALPHA;
#endif
    for (int m = C.gw; m < NTOK; m += C.ngw) {
        f32x4 v[4]; load_row_f32(v, src + (size_t)m * D, C.lane);
#pragma unroll
        for (int j = 0; j < 4; ++j) v[j] = v[j] * sc;
        ln_row(v, P.in[I_LNPG], P.in[I_LNPB], C.lane);
        store_row_f32(P.out + (size_t)m * D, v, C.lane);
    }
}
#define XB_TMO      128
#define XB_XCNT(j)  (256  + 64 * (j))
#define XB_XSUB(j)  (1280 + 64 * (j))
#define XB_XGEN(j)  (2304 + 64 * (j))
#define XB_TOP      3328
#define XB_TOPGEN   3392
#define XCD_BAR_WORDS 3456
#define XB_SPIN_CAP (1u << 18)
#define LAS __attribute__((address_space(3)))

__device__ __forceinline__ unsigned xb_ld(unsigned* p)              { return __hip_atomic_load(p, __ATOMIC_RELAXED, __HIP_MEMORY_SCOPE_AGENT); }
__device__ __forceinline__ unsigned xb_add(unsigned* p, unsigned v) { return __hip_atomic_fetch_add(p, v, __ATOMIC_RELAXED, __HIP_MEMORY_SCOPE_AGENT); }
__device__ __forceinline__ unsigned xb_xcc_id() { return (unsigned)__builtin_amdgcn_s_getreg((3 << 11) | 20) & 0xFu; }
#define XB_SPIN(cond, bar) do { unsigned _sp = 0; while (cond) { __builtin_amdgcn_s_sleep(1); \
    if ((++_sp & 255u) == 0u) { if (xb_ld(&(bar)[XB_TMO])) break; if (_sp > XB_SPIN_CAP) { atomicAdd(&(bar)[XB_TMO], 1u); break; } } } } while (0)

struct XcdBarrier {
    unsigned* bar; unsigned x;
    volatile LAS unsigned* st;
};

__device__ __forceinline__ XcdBarrier xcd_barrier_post(unsigned* bar, volatile LAS unsigned* st) {
    XcdBarrier b; b.bar = bar; b.x = xb_xcc_id(); b.st = st;
    if (threadIdx.x == 0) (void)xb_add(&bar[XB_XCNT(b.x)], 1u);
    return b;
}
__device__ __forceinline__ void xcd_barrier_complete(unsigned* bar, unsigned x, unsigned& nloc, unsigned& nx) {
    const unsigned G = gridDim.x * gridDim.y * gridDim.z;
    unsigned sum, cnt, mine, sp = 0u;
    for (;;) {
        sum = 0u; cnt = 0u; mine = 0u;
#pragma unroll
        for (unsigned j = 0; j < 16; ++j) { const unsigned c = xb_ld(&bar[XB_XCNT(j)]); sum += c; cnt += (c > 0u) ? 1u : 0u; mine = (j == x) ? c : mine; }
        if (sum == G) break;
        __builtin_amdgcn_s_sleep(1);
        if ((++sp & 255u) == 0u) { if (xb_ld(&bar[XB_TMO])) break; if (sp > XB_SPIN_CAP) { atomicAdd(&bar[XB_TMO], 1u); break; } }
    }
    nloc = mine > 0u ? mine : 1u; nx = cnt > 0u ? cnt : 1u;
}

__device__ __forceinline__ void xcd_barrier(const XcdBarrier& b) {
    asm volatile("s_waitcnt vmcnt(0)" ::: "memory");
    __syncthreads();
    if (threadIdx.x == 0) {
        unsigned* bar = b.bar;
        __builtin_amdgcn_s_waitcnt(0);
        unsigned nloc = b.st[0], nx = b.st[1];
        if (nloc == 0u) { xcd_barrier_complete(bar, b.x, nloc, nx); b.st[0] = nloc; b.st[1] = nx; }
        const unsigned old = xb_add(&bar[XB_XSUB(b.x)], 1u);
        const unsigned gen = old / nloc;
        if (old + 1u == (gen + 1u) * nloc) {
            __builtin_amdgcn_fence(__ATOMIC_RELEASE, "agent");
            asm volatile("s_waitcnt vmcnt(0)" ::: "memory");
            const unsigned og = xb_add(&bar[XB_TOP], 1u);
            const unsigned tg = og / nx;
            if (og + 1u == (tg + 1u) * nx) xb_add(&bar[XB_TOPGEN], 1u);
            else XB_SPIN(xb_ld(&bar[XB_TOPGEN]) == tg, bar);
            __builtin_amdgcn_fence(__ATOMIC_ACQUIRE, "agent");
            xb_add(&bar[XB_XGEN(b.x)], 1u);
            asm volatile("s_waitcnt vmcnt(0)" ::: "memory");
        } else {
            XB_SPIN(xb_ld(&bar[XB_XGEN(b.x)]) == gen, bar);
            __builtin_amdgcn_fence(__ATOMIC_ACQUIRE, "agent");
            asm volatile("s_waitcnt vmcnt(0)" ::: "memory");
        }
    }
    __syncthreads();
}


template <int PH> __device__ __forceinline__ void run_phase(const Params& P, const Ctx& C) {
    unsigned char* ws = P.ws;
    typedef pg8::bf16_t pbf;
    if constexpr (PH == 0) { p0_prologue(P, C); }
    else if constexpr (PH == 10) {
        pg8::Gemm g{(const pbf*)(ws + WS_XBF), (const pbf*)(ws + WS_WIN_T), NTOK, D_INP, D}; pg8::StaticOrder S; S.init(NTOK, D_INP, C.G, (int)blockIdx.x);
        pg8::EpiBf16s E{(pbf*)(ws + WS_H), D_INP};
        pg8::gemm_phase<pg8::EpiBf16s, pg8::StaticOrder, true, true>(C.lds, g, S, E); }
    else if constexpr (PH == 11) {
        pg8::Gemm g{(const pbf*)(ws + WS_PB), (const pbf*)(ws + WS_WPROJ_T), NTOK, D, PLE}; pg8::StaticOrder S; S.init(NTOK, D, C.G, (int)blockIdx.x);
        pg8::EpiBf16s E{(pbf*)(ws + WS_PROJ), D};
        pg8::gemm_phase<pg8::EpiBf16s, pg8::StaticOrder, true, true>(C.lds, g, S, E); }
    else if constexpr (PH == 20) { p2_post(P, C); }
    else if constexpr (PH == 21) { p2_hgrn_prep(P, C); }
    else if constexpr (PH == 30) {
        { pg8::Gemm g{(const pbf*)(ws + WS_CN), (const pbf*)(ws + WS_WUK_T), NTOK, 512, 256}; pg8::StaticOrder S; S.init(NTOK, 512, C.G, (int)blockIdx.x);
          pg8::EpiKhead E{(pbf*)(ws + WS_K)};
          pg8::gemm_phase<pg8::EpiKhead, pg8::StaticOrder, true, true>(C.lds, g, S, E); }
        { pg8::Gemm g{(const pbf*)(ws + WS_WUV_T), (const pbf*)(ws + WS_CN), 512, NTOK, 256}; pg8::StaticOrder S; S.init(512, NTOK, C.G, (int)blockIdx.x);
          pg8::EpiVt E{(pbf*)(ws + WS_VT)};
          pg8::gemm_phase<pg8::EpiVt, pg8::StaticOrder, true, true>(C.lds, g, S, E); }
    }
    else if constexpr (PH == 31) { p3_indexer(P, C); }
    else if constexpr (PH == 32) { p3_hgrn_scan(P, C); }
    else if constexpr (PH == 40) { p4_attention2(P, C); }
    else if constexpr (PH == 41) { p4_yrec(P, C); }
    else if constexpr (PH == 5) {
        pg8::Gemm g{(const pbf*)(ws + WS_YMIX), (const pbf*)(ws + WS_WO_T), NTOK, D, D / 2}; pg8::StaticOrder S; S.init(NTOK, D, C.G, (int)blockIdx.x);
        pg8::EpiResid E{P.in[I_X], P.out, D, ALPHA, 1.f / 512.f};
        pg8::gemm_phase<pg8::EpiResid, pg8::StaticOrder, true, true, 1>(C.lds, g, S, E);
    }
    else if constexpr (PH == 6) { p6_ln1_router<true>(P, C); }
    else if constexpr (PH == 60) { p6_ln1_router<false>(P, C); }
    else if constexpr (PH == 7) { p7_dispatch(P, C); }
    else if constexpr (PH == 8) {
        const int* tile_e = (const int*)(ws + WS_TILEE);
        pg8::Gemm g{(const pbf*)(ws + WS_XS), (const pbf*)(ws + WS_WUP_T), CAP, NE * 2048, D / 2};
        pg8::MoeOrder S{tile_e, tile_e[MAXTILES], 8, C.G, (int)blockIdx.x};
        pg8::EpiSwiglu E{ws + WS_HH, P.in[I_BUP]};
        pg8::gemm_phase<pg8::EpiSwiglu, pg8::MoeOrder, true, true, 1, 124, 121>(C.lds, g, S, E);
    }
    else if constexpr (PH == 9) {
        const int* tile_e = (const int*)(ws + WS_TILEE);
        pg8::Gemm g{(const pbf*)(ws + WS_HH), (const pbf*)(ws + WS_WDN_T), CAP, NE * 1024, DFF / 2};
        pg8::MoeOrder S{tile_e, tile_e[MAXTILES], 4, C.G, (int)blockIdx.x};
        pg8::EpiDown E{(pbf*)(ws + WS_YSLOT), P.in[I_BDN], (const float*)(ws + WS_SLOTGATE)};
        pg8::gemm_phase<pg8::EpiDown, pg8::MoeOrder, true, true, 1, 125, 121>(C.lds, g, S, E);
    }
    else if constexpr (PH == 100) { p10_combine_ln2(P, C); }
    else if constexpr (PH == 110) {
        pg8::Gemm g{(const pbf*)(ws + WS_XB), (const pbf*)(ws + WS_WGATE_T), NTOK, D, D / 2}; pg8::StaticOrder S; S.init(NTOK, D, C.G, (int)blockIdx.x);
        pg8::EpiPle E{P.out, (const pbf*)(ws + WS_PROJ), (float*)(ws + WS_X1), ALPHA, 1.f / 512.f};
        pg8::gemm_phase<pg8::EpiPle, pg8::StaticOrder, true, true, 1>(C.lds, g, S, E);
    }
    else { p12_final_ln(P, C); }
}
__global__ void __launch_bounds__(NTHR, 2) mega_fwd(Params P) {
    extern __shared__ __attribute__((aligned(16))) unsigned char lds_raw[];
    cg::grid_group grid = cg::this_grid();
#define MKCTX Ctx C; { int tid_ = threadIdx.x; asm volatile("" : "+v"(tid_)); C.lds = (LAS unsigned char*)lds_raw; C.tid = tid_; C.lane = tid_ & 63; C.wave = __builtin_amdgcn_readfirstlane(tid_ >> 6); \
      C.G = gridDim.x; C.gw = blockIdx.x * NWAVES + C.wave; C.ngw = C.G * NWAVES; }
#if SYNC_MODE != 0
    if (threadIdx.x < 4) ((LAS unsigned*)((LAS unsigned char*)lds_raw + XBW_OFF))[threadIdx.x] = 0u;
    __syncthreads();
    XcdBarrier bar = xcd_barrier_post((unsigned*)(P.ws + WS_CTL) + CW_BAR, (volatile LAS unsigned*)((LAS unsigned char*)lds_raw + XBW_OFF));
#define SY xcd_barrier(bar);
#else
#define SY grid.sync();
#endif
#define GS grid.sync();
#define BS __syncthreads();
#define X(k) { MKCTX run_phase<k>(P, C); }
    PROGRAM
#undef X
#undef MKCTX
#undef SY
#undef GS
#undef BS
}

extern "C" void kernel_launch(void* const* d_in, const int* in_sizes, int n_in, void* d_out, int out_size, void* d_ws, size_t ws_size, hipStream_t stream) {
    static int grid = 0;
    if (grid == 0) {
        if (n_in != 25 || out_size != NTOK * D || ws_size < WS_END) { fprintf(stderr, "kernel_launch: unexpected shapes (n_in %d out %d ws %zu)\n", n_in, out_size, ws_size); grid = -1; return; }
        int dev = 0, cus = 0, per_cu = 0;
        if (hipGetDevice(&dev) != hipSuccess || hipDeviceGetAttribute(&cus, hipDeviceAttributeMultiprocessorCount, dev) != hipSuccess) { grid = -1; return; }
        if (hipFuncSetAttribute((const void*)mega_fwd, hipFuncAttributeMaxDynamicSharedMemorySize, LDS_BYTES) != hipSuccess) { fprintf(stderr, "kernel_launch: hipFuncSetAttribute failed\n"); grid = -1; return; }
        if (hipOccupancyMaxActiveBlocksPerMultiprocessor(&per_cu, (const void*)mega_fwd, NTHR, LDS_BYTES) != hipSuccess || per_cu < 1) { fprintf(stderr, "kernel_launch: occupancy query failed (%d)\n", per_cu); (void)hipGetLastError(); grid = -1; return; }
        grid = cus * per_cu;
        fprintf(stderr, "kernel_launch: grid %d (%d CUs x %d)\n", grid, cus, per_cu);
    }
    if (grid < 0) return;
    (void)hipMemsetAsync((char*)d_ws + WS_CTL, 0, CTL_ZERO_BYTES, stream);
    Params p{};
    for (int i = 0; i < 25; ++i) p.in[i] = (const float*)d_in[i];
    p.out = (float*)d_out; p.ws = (unsigned char*)d_ws;

    void* args[] = {&p};
    hipError_t e = hipLaunchCooperativeKernel((const void*)mega_fwd, dim3(grid), dim3(NTHR), args, LDS_BYTES, stream);
    if (e != hipSuccess) fprintf(stderr, "kernel_launch: cooperative launch failed: %s (grid %d)\n", hipGetErrorString(e), grid);
}
```

```cpp
#define SYNC_MODE 1
#include <hip/hip_runtime.h>
#include <hip/hip_cooperative_groups.h>
#include <cstdio>
#include <cstdint>
namespace cg = cooperative_groups;

namespace pg8 {
#define PG8_LAS __attribute__((address_space(3)))
typedef unsigned short bf16_t;
typedef short bf16x8 __attribute__((ext_vector_type(8)));
typedef float f32x4 __attribute__((ext_vector_type(4)));
typedef unsigned u32x4 __attribute__((ext_vector_type(4)));
typedef int i32x4 __attribute__((ext_vector_type(4)));
typedef int i32x8 __attribute__((ext_vector_type(8)));
constexpr int BM = 256, BK = 64, HALF = 128, HTB = HALF * BK * 2  , STAGE_BYTES = 8 * HTB, NXCD = 8, WGM = 8;

__host__ __device__ __forceinline__ int lds_byte(int r, int c) { const int st = (r >> 4) * 2 + (c >> 5), rr = r & 15, cc = c & 31, ob = rr * 64 + cc * 2; return st * 1024 + (ob ^ (((ob >> 9) & 1) << 5)); }
__host__ __device__ __forceinline__ void stage_rc(int b, int& R, int& C) { const int st = b / 1024, sb = b % 1024, swz = sb ^ (((sb >> 9) & 1) << 5); R = (st >> 1) * 16 + swz / 64; C = (st & 1) * 32 + (swz % 64) / 2; }
__host__ __device__ __forceinline__ int perm32(int rho) { const int n = rho >> 4, i = rho & 15; return 8 * (i >> 2) + 4 * n + (i & 3); }

struct Unit { int pm, pn; };
struct Gemm { const bf16_t* A; const bf16_t* Bt; int M, N, K; };

struct StaticOrder {
    int nM, nN, nwg, G, c;
    __host__ __device__ void init(int M, int N, int G_, int c_) { nM = M / BM; nN = N / BM; nwg = nM * nN; G = G_; c = c_; }
    __host__ __device__ bool next(int i, Unit& u) const {
        const long L = (long)i * G + c; if (L >= nwg) return false;
        int wgid = (int)L; { const int q = nwg / NXCD, r = nwg % NXCD, xcd = wgid % NXCD, off = wgid / NXCD; wgid = (xcd < r ? xcd * (q + 1) : r * (q + 1) + (xcd - r) * q) + off; }
        const int nig = WGM * nN, gid = wgid / nig, fm = gid * WGM, gsz = (nM - fm) < WGM ? (nM - fm) : WGM;
        u.pm = fm + ((wgid % nig) % gsz); u.pn = (wgid % nig) / gsz; return true;
    }
    __device__ __forceinline__ void a_ready(const Unit&) const {}
    __device__ __forceinline__ void done(const Unit&) const {}
};

__device__ __forceinline__ unsigned cvt_pk_bf16(float lo, float hi) { unsigned r; asm volatile("v_cvt_pk_bf16_f32 %0, %1, %2" : "=v"(r) : "v"(lo), "v"(hi)); return r; }
typedef float f32x2 __attribute__((ext_vector_type(2)));
template <class Epi, class Sched, bool ALIGN_EPI = false, bool SP2 = false, int F8 = 0, int F8SA = 127, int F8SB = 127>
__device__ __forceinline__ void gemm_phase(PG8_LAS unsigned char* lds, const Gemm g, const Sched& S, const Epi& E) {
    const int tid = threadIdx.x, wid = __builtin_amdgcn_readfirstlane(tid >> 6), lane = tid & 63, wr = wid >> 2, wc = wid & 3, fr = lane & 15, fq = lane >> 4;
    const int K = g.K, nt = K / BK;
    unsigned voffA[2], voffB[2];
#pragma unroll
    for (int i = 0; i < 2; ++i) { int R, C; stage_rc(tid * 16 + i * 8192, R, C); const int Rb = Epi::PERM ? ((R & ~31) + perm32(R & 31)) : R;
        voffA[i] = (unsigned)(R * K + C) * 2u; voffB[i] = (unsigned)(Rb * K + C) * 2u; }
    const size_t kstep = (size_t)(BK * 2);
    const size_t hstep = (size_t)HALF * K * 2;
    const size_t tstep = 2 * hstep;
    const unsigned ldsw = (unsigned)wid * 1024u;
    const int aoff = lds_byte(wr * 64 + fr, fq * 8), boff = lds_byte(wc * 32 + fr, fq * 8);
#define PG8_SA(b, h) (((b) * 2 + (h)) * HTB)
#define PG8_SB(b, h) ((4 + (b) * 2 + (h)) * HTB)
#define PG8_STAGE(bufoff, gbase, voff) do { _Pragma("unroll") for (int _i = 0; _i < 2; ++_i) \
        __builtin_amdgcn_global_load_lds((const unsigned*)((const char*)(gbase) + (voff)[_i]), (PG8_LAS unsigned*)(lds + (bufoff) + ldsw + _i * 8192), 16, 0, 0); } while (0)
#define PG8_LDA(dst, b, h) do { _Pragma("unroll") for (int m = 0; m < 4; ++m) { dst[m].lo = *(const PG8_LAS i32x4*)(lds + PG8_SA(b, h) + aoff + m * 2048); dst[m].hi = *(const PG8_LAS i32x4*)(lds + PG8_SA(b, h) + aoff + m * 2048 + 1024); } } while (0)
#define PG8_LDB(dst, b, h) do { _Pragma("unroll") for (int n = 0; n < 2; ++n) { dst[n].lo = *(const PG8_LAS i32x4*)(lds + PG8_SB(b, h) + boff + n * 2048); dst[n].hi = *(const PG8_LAS i32x4*)(lds + PG8_SB(b, h) + boff + n * 2048 + 1024); } } while (0)
#define PG8_MMA(ai, bj, At, Bt) do { __builtin_amdgcn_s_setprio(1); \
        if constexpr (F8 == 0) { _Pragma("unroll") for (int m = 0; m < 4; ++m) _Pragma("unroll") for (int n = 0; n < 2; ++n) { \
            const i32x4 bl_ = Bt[n].lo, bh_ = Bt[n].hi, al_ = At[m].lo, ah_ = At[m].hi;     \
            acc[ai][bj][m][n] = __builtin_amdgcn_mfma_f32_16x16x32_bf16(__builtin_bit_cast(bf16x8, bl_), __builtin_bit_cast(bf16x8, al_), acc[ai][bj][m][n], 0, 0, 0); \
            acc[ai][bj][m][n] = __builtin_amdgcn_mfma_f32_16x16x32_bf16(__builtin_bit_cast(bf16x8, bh_), __builtin_bit_cast(bf16x8, ah_), acc[ai][bj][m][n], 0, 0, 0); } } \
        else { _Pragma("unroll") for (int m = 0; m < 4; ++m) _Pragma("unroll") for (int n = 0; n < 2; ++n) \
            asm volatile("v_mfma_f32_16x16x128_f8f6f4 %0, %1, %2, %0" : "+v"(acc[ai][bj][m][n]) : "v"(Bt[n]), "v"(At[m])); } \
        __builtin_amdgcn_s_setprio(0); } while (0)
#define PG8_WAIT_V(n) asm volatile("s_waitcnt vmcnt(" #n ")" ::: "memory")
#define PG8_WAIT_L(n) asm volatile("s_waitcnt lgkmcnt(" #n ")" ::: "memory")
#define PG8_BAR __builtin_amdgcn_s_barrier()
#define PG8_SCHED __builtin_amdgcn_sched_barrier(0)
    Unit cur, nxt; int ui = 0;
    if (!S.next(0, cur)) return;
    f32x4 acc[2][2][4][2];
#pragma unroll
    for (int a = 0; a < 2; ++a)
#pragma unroll
        for (int b = 0; b < 2; ++b)
#pragma unroll
            for (int m = 0; m < 4; ++m)
#pragma unroll
                for (int n = 0; n < 2; ++n) acc[a][b][m][n] = (f32x4){0.f, 0.f, 0.f, 0.f};
    i32x8 At[4], B0[2], B1[2];
    const char* cA = (const char*)g.A + (size_t)cur.pm * tstep; const char* cB = (const char*)g.Bt + (size_t)cur.pn * tstep;
    S.a_ready(cur);
    if constexpr (SP2) {
        PG8_STAGE(PG8_SB(0, 0), cB, voffB); PG8_STAGE(PG8_SB(0, 1), cB + hstep, voffB); PG8_STAGE(PG8_SA(0, 0), cA, voffA); PG8_STAGE(PG8_SA(0, 1), cA + hstep, voffA);
        if (wr == 1) PG8_BAR;
        PG8_WAIT_V(2); PG8_BAR;
        PG8_STAGE(PG8_SB(1, 0), cB + kstep, voffB); PG8_STAGE(PG8_SA(1, 0), cA + kstep, voffA); PG8_STAGE(PG8_SB(1, 1), cB + hstep + kstep, voffB);
        PG8_WAIT_V(6); PG8_BAR;
    } else {
        PG8_STAGE(PG8_SB(0, 0), cB, voffB); PG8_STAGE(PG8_SA(0, 0), cA, voffA); PG8_STAGE(PG8_SB(0, 1), cB + hstep, voffB); PG8_STAGE(PG8_SA(0, 1), cA + hstep, voffA);
        if (wr == 1) PG8_BAR;
        PG8_WAIT_V(4); PG8_BAR;
        PG8_STAGE(PG8_SB(1, 0), cB + kstep, voffB); PG8_STAGE(PG8_SA(1, 0), cA + kstep, voffA); PG8_STAGE(PG8_SB(1, 1), cB + hstep + kstep, voffB);
        PG8_WAIT_V(6); PG8_BAR;
    }
    for (;;) {
        const bool has_next = S.next(ui + 1, nxt);
        const char* nA = has_next ? (const char*)g.A + (size_t)nxt.pm * tstep : cA; const char* nB = has_next ? (const char*)g.Bt + (size_t)nxt.pn * tstep : cB;
_Pragma("nounroll")
        for (int t = 0; t < nt; t += 2) {
            const bool last = (t == nt - 2);
            const char* a1 = cA + (size_t)(t + 1) * kstep;
            const char* a2 = last ? nA : cA + (size_t)(t + 2) * kstep; const char* b2 = last ? nB : cB + (size_t)(t + 2) * kstep;
            const char* a3 = a2 + kstep; const char* b3 = b2 + kstep;
            if (last && has_next) S.a_ready(nxt);
            if constexpr (SP2) {
            PG8_LDB(B0, 0, 0); PG8_LDB(B1, 0, 1); PG8_SCHED; PG8_LDA(At, 0, 0); PG8_STAGE(PG8_SA(1, 1), a1 + hstep, voffA);
            PG8_WAIT_V(8); PG8_WAIT_L(0); PG8_BAR; PG8_MMA(0, 0, At, B0); PG8_MMA(0, 1, At, B1); PG8_BAR; PG8_SCHED;
            PG8_LDA(At, 0, 1); PG8_STAGE(PG8_SB(0, 0), b2, voffB); PG8_STAGE(PG8_SB(0, 1), b2 + hstep, voffB); PG8_STAGE(PG8_SA(0, 0), a2, voffA);
            PG8_WAIT_V(8); PG8_WAIT_L(0); PG8_BAR; PG8_MMA(1, 0, At, B0); PG8_MMA(1, 1, At, B1); PG8_BAR; PG8_SCHED;
            PG8_LDB(B0, 1, 0); PG8_LDB(B1, 1, 1); PG8_SCHED; PG8_LDA(At, 1, 0); PG8_STAGE(PG8_SA(0, 1), a2 + hstep, voffA);
            PG8_WAIT_V(8); PG8_WAIT_L(0); PG8_BAR; PG8_MMA(0, 0, At, B0); PG8_MMA(0, 1, At, B1); PG8_BAR; PG8_SCHED;
            PG8_LDA(At, 1, 1); PG8_STAGE(PG8_SB(1, 0), b3, voffB); PG8_STAGE(PG8_SB(1, 1), b3 + hstep, voffB); PG8_STAGE(PG8_SA(1, 0), a3, voffA);
            PG8_WAIT_V(8); PG8_WAIT_L(0); PG8_BAR; PG8_MMA(1, 0, At, B0); PG8_MMA(1, 1, At, B1); PG8_BAR; PG8_SCHED;
            } else {
            PG8_LDB(B0, 0, 0); PG8_SCHED; PG8_LDA(At, 0, 0); PG8_STAGE(PG8_SA(1, 1), a1 + hstep, voffA);
            PG8_WAIT_L(8); PG8_BAR; PG8_WAIT_L(0); PG8_MMA(0, 0, At, B0); PG8_BAR; PG8_SCHED;
            PG8_LDB(B1, 0, 1); PG8_STAGE(PG8_SB(0, 0), b2, voffB);
            PG8_BAR; PG8_WAIT_L(0); PG8_MMA(0, 1, At, B1); PG8_BAR;
            PG8_LDA(At, 0, 1); PG8_STAGE(PG8_SA(0, 0), a2, voffA);
            PG8_BAR; PG8_WAIT_L(0); PG8_MMA(1, 0, At, B0); PG8_BAR; PG8_SCHED;
            PG8_STAGE(PG8_SB(0, 1), b2 + hstep, voffB);
            PG8_WAIT_V(6); PG8_BAR; PG8_MMA(1, 1, At, B1); PG8_BAR;
            PG8_LDB(B0, 1, 0); PG8_SCHED; PG8_LDA(At, 1, 0); PG8_STAGE(PG8_SA(0, 1), a2 + hstep, voffA);
            PG8_WAIT_L(8); PG8_BAR; PG8_WAIT_L(0); PG8_MMA(0, 0, At, B0); PG8_BAR; PG8_SCHED;
            PG8_LDB(B1, 1, 1); PG8_STAGE(PG8_SB(1, 0), b3, voffB);
            PG8_BAR; PG8_WAIT_L(0); PG8_MMA(0, 1, At, B1); PG8_BAR;
            PG8_LDA(At, 1, 1); PG8_STAGE(PG8_SA(1, 0), a3, voffA);
            PG8_BAR; PG8_WAIT_L(0); PG8_MMA(1, 0, At, B0); PG8_BAR; PG8_SCHED;
            PG8_STAGE(PG8_SB(1, 1), b3 + hstep, voffB);
            PG8_WAIT_V(6); PG8_BAR; PG8_MMA(1, 1, At, B1); PG8_BAR;
            }
        }
        if constexpr (ALIGN_EPI) { if (wr == 0) PG8_BAR; }
        if constexpr (F8 != 0) asm volatile("s_nop 15\n\ts_nop 15" ::: "memory");
        if constexpr (!Epi::AFTER_DRAIN) { E(acc, cur, wr, wc, fr, fq); S.done(cur); }
        if (!has_next) break;
#pragma unroll
        for (int a = 0; a < 2; ++a)
#pragma unroll
            for (int b = 0; b < 2; ++b)
#pragma unroll
                for (int m = 0; m < 4; ++m)
#pragma unroll
                    for (int n = 0; n < 2; ++n) acc[a][b][m][n] = (f32x4){0.f, 0.f, 0.f, 0.f};
        cur = nxt; cA = nA; cB = nB; ++ui;
        if constexpr (ALIGN_EPI) { if (wr == 1) PG8_BAR; }
    }
    PG8_WAIT_V(0);
    if constexpr (!ALIGN_EPI) { if (wr == 0) PG8_BAR; }
    PG8_BAR;
    if constexpr (Epi::AFTER_DRAIN) { E.fused(acc, cur, wr, wc, fr, fq, lds, wid, lane); S.done(cur); }
#undef PG8_SA
#undef PG8_SB
#undef PG8_STAGE
#undef PG8_LDA
#undef PG8_LDB
#undef PG8_MMA
#undef PG8_WAIT_V
#undef PG8_WAIT_L
#undef PG8_BAR
#undef PG8_SCHED
}
}

constexpr int NB = 8, T = 4096, D = 1024, NTOK = NB * T;
constexpr int ATT_H = 8, ATT_D = 64, ATT_W = 512, KV_LAT = 256, IDX_H = 8, IDX_D = 64, TOPK = 256;
constexpr int HG_H = 4, HG_DK = 128, HG_DV = 128, HG_W = 512, HG_C = 32;
constexpr int D_IN = 3400, D_INP = 3584;
constexpr int C_AQ = 0, C_AC = 512, C_IQ = 768, C_IK = 1280, C_IW = 1344, C_GQ = 1352, C_GF = 1864, C_GI = 2376, C_GG = 2888;
constexpr int NE = 32, TOPE = 4, DFF = 1024, PLE = 256;
constexpr int NASSIGN = NTOK * TOPE, CAP = NASSIGN + NE * 256;
constexpr int MAXTILES = CAP / 256;
constexpr float LN_EPS = 1e-5f, RMS_EPS = 1e-6f, ALPHA = 1.189207115002721f;

constexpr size_t MiB = 1u << 20;
constexpr size_t WS_CTL = 0, CTL_ZERO_BYTES = 64 * 1024;
constexpr size_t WS_WIN_T = 1 * MiB, WS_WO_T = 8 * MiB, WS_WUP_T = 10 * MiB, WS_WDN_T = 138 * MiB, WS_WPROJ_T = 202 * MiB, WS_WGATE_T = 203 * MiB;
constexpr size_t WS_WUK_T = 205 * MiB, WS_WUV_T = 205 * MiB + 512 * 1024;
constexpr size_t WS_SMALL = 206 * MiB;
constexpr size_t WS_A = 208 * MiB;
constexpr size_t WS_B = 480 * MiB;
constexpr size_t WS_X1 = 752 * MiB;
constexpr size_t WS_XB = 880 * MiB;
constexpr size_t WS_PROJ = 944 * MiB;
constexpr size_t WS_SM2 = 1008 * MiB;
constexpr size_t WS_END = 1016 * MiB;
constexpr size_t WS_H = WS_A, WS_XS = WS_A, WS_YSLOT = WS_A;
constexpr size_t WS_XBF = WS_B, WS_U = WS_B, WS_YMIX = WS_B, WS_HH = WS_B;
constexpr size_t WS_QDEC = WS_B + 128 * MiB, WS_PB = WS_B + 128 * MiB, WS_OREC = WS_B + 160 * MiB, WS_CN = WS_B + 224 * MiB, WS_IKN = WS_B + 240 * MiB, WS_MASK = WS_B + 244 * MiB;
constexpr size_t WS_K = WS_XB, WS_VT = WS_XB + 32 * MiB;
constexpr size_t WS_TOPE = WS_SM2, WS_GATE = WS_SM2 + 512 * 1024, WS_LRANK = WS_SM2 + 1024 * 1024, WS_TOKSLOT = WS_SM2 + 1536 * 1024, WS_SLOTGATE = WS_SM2 + 2 * MiB, WS_DECAY = WS_SM2 + 3 * MiB;
constexpr size_t WS_WRT = WS_SMALL + 256 * 1024;
constexpr size_t WS_WGBASE = WS_SMALL, WS_TILEE = WS_SMALL + 64 * 1024;
constexpr int CW_CNT = 64;
constexpr int CW_BAR = 1024;
constexpr int XBW_OFF = 147456 - 16;

constexpr int RING_BYTES = 131072, MISC_OFF = RING_BYTES, LDS_BYTES = 147456;
constexpr int NWAVES = 8, NTHR = 512;

#define GAS __attribute__((address_space(1)))
#define LAS __attribute__((address_space(3)))
typedef unsigned short bf16;
typedef unsigned v4u __attribute__((ext_vector_type(4)));
typedef unsigned v2u __attribute__((ext_vector_type(2)));
typedef float f32x4 __attribute__((ext_vector_type(4)));
typedef short bf16x8 __attribute__((ext_vector_type(8)));
#define LDS_WAIT() asm volatile("s_waitcnt lgkmcnt(0)" ::: "memory")
#define VM_WAIT() asm volatile("s_waitcnt vmcnt(0)" ::: "memory")
__device__ __forceinline__ unsigned f2bf(float f) { unsigned u = __builtin_bit_cast(unsigned, f); return (u + 0x7fffu + ((u >> 16) & 1u)) >> 16; }
__device__ __forceinline__ unsigned pk2(float lo, float hi) { return f2bf(lo) | (f2bf(hi) << 16); }
__device__ __forceinline__ float bf2f(unsigned short b) { return __builtin_bit_cast(float, (unsigned)b << 16); }
__device__ __forceinline__ float bflo(unsigned w) { return __builtin_bit_cast(float, w << 16); }
__device__ __forceinline__ float bfhi(unsigned w) { return __builtin_bit_cast(float, w & 0xffff0000u); }
__device__ __forceinline__ float wave_sum(float v) {
#pragma unroll
    for (int o = 1; o < 64; o <<= 1) v += __shfl_xor(v, o);
    return v;
}
__device__ __forceinline__ float sigmoidf_(float x) { return 1.f / (1.f + __expf(-x)); }

__device__ __forceinline__ unsigned pk4_fp8(float a, float b, float c, float d);
struct Params { const float* in[25]; float* out; unsigned char* ws; };
enum { I_X = 0, I_P, I_WIN, I_KVG, I_IKG, I_IKB, I_WUK, I_WUV, I_HGLB, I_HGNG, I_WO, I_LNMG, I_LNMB, I_WR, I_BR, I_WUP, I_BUP, I_WDN, I_BDN, I_LNFG, I_LNFB, I_WPP, I_WPG, I_LNPG, I_LNPB };

struct Ctx { LAS unsigned char* lds; int tid, lane, wave, G, gw, ngw; };

namespace pg8 {
struct EpiBf16s {
    static constexpr bool PERM = true, AFTER_DRAIN = false;
    bf16_t* O; int ldc;
    __device__ __forceinline__ void operator()(const f32x4 (&acc)[2][2][4][2], const Unit& u, int wr, int wc, int fr, int fq) const {
        const int row0 = u.pm * BM + wr * 64 + fr, col0 = u.pn * BM + wc * 32 + 8 * fq;
#pragma unroll
        for (int ai = 0; ai < 2; ++ai)
#pragma unroll
            for (int m = 0; m < 4; ++m) { bf16_t* rowp = O + (size_t)(row0 + ai * HALF + m * 16) * ldc + col0;
#pragma unroll
                for (int bj = 0; bj < 2; ++bj) { const f32x4 v0 = acc[ai][bj][m][0], v1 = acc[ai][bj][m][1];
                    u32x4 w; w.x = cvt_pk_bf16(v0[0], v0[1]); w.y = cvt_pk_bf16(v0[2], v0[3]); w.z = cvt_pk_bf16(v1[0], v1[1]); w.w = cvt_pk_bf16(v1[2], v1[3]);
                    *(u32x4*)(rowp + bj * HALF) = w; } }
    }
};
struct EpiResid {
    static constexpr bool PERM = false, AFTER_DRAIN = false;
    const float* res; bf16_t* out; int ldc; float alpha, as;
    __device__ __forceinline__ void operator()(const f32x4 (&acc)[2][2][4][2], const Unit& u, int wr, int wc, int fr, int fq) const {
        const int row0 = u.pm * BM + wr * 64 + fr, col0 = u.pn * BM + wc * 32 + 4 * fq;
#pragma unroll
        for (int ai = 0; ai < 2; ++ai)
#pragma unroll
            for (int m = 0; m < 4; ++m) { const size_t off = (size_t)(row0 + ai * HALF + m * 16) * ldc + col0;
#pragma unroll
                for (int bj = 0; bj < 2; ++bj)
#pragma unroll
                    for (int n = 0; n < 2; ++n) { const f32x4 r = *(const f32x4*)(res + off + bj * HALF + n * 16); const f32x4 o = r * alpha + acc[ai][bj][m][n] * as; v2u w; w.x = cvt_pk_bf16(o[0], o[1]); w.y = cvt_pk_bf16(o[2], o[3]); *(v2u*)(out + off + bj * HALF + n * 16) = w; }
                asm volatile("" ::: "memory"); }
    }
};
struct EpiPle {
    static constexpr bool PERM = false, AFTER_DRAIN = false;
    const bf16_t* x2; const bf16_t* proj; bf16_t* out; float alpha, as;
    __device__ __forceinline__ void operator()(const f32x4 (&acc)[2][2][4][2], const Unit& u, int wr, int wc, int fr, int fq) const {
        const int row0 = u.pm * BM + wr * 64 + fr, col0 = u.pn * BM + wc * 32 + 4 * fq;
#pragma unroll
        for (int ai = 0; ai < 2; ++ai)
#pragma unroll
            for (int m = 0; m < 4; ++m) { const size_t off = (size_t)(row0 + ai * HALF + m * 16) * 1024 + col0;
#pragma unroll
                for (int bj = 0; bj < 2; ++bj)
#pragma unroll
                    for (int n = 0; n < 2; ++n) { const size_t o2 = off + bj * HALF + n * 16; const v2u rw = *(const v2u*)(x2 + o2); const f32x4 r = {bflo(rw.x), bfhi(rw.x), bflo(rw.y), bfhi(rw.y)}; const v2u pw = *(const v2u*)(proj + o2);
                        const f32x4 a = acc[ai][bj][m][n] * as; f32x4 o;
                        o[0] = r[0] * alpha + bflo(pw.x) * sigmoidf_(a[0]); o[1] = r[1] * alpha + bfhi(pw.x) * sigmoidf_(a[1]);
                        o[2] = r[2] * alpha + bflo(pw.y) * sigmoidf_(a[2]); o[3] = r[3] * alpha + bfhi(pw.y) * sigmoidf_(a[3]);
                        v2u ow; ow.x = cvt_pk_bf16(o[0], o[1]); ow.y = cvt_pk_bf16(o[2], o[3]); *(v2u*)(out + o2) = ow; }
                asm volatile("" ::: "memory"); }
    }
};
struct EpiSwiglu {
    static constexpr bool PERM = true, AFTER_DRAIN = false;
    unsigned char* H; const float* b_up;
    __device__ __forceinline__ void operator()(const f32x4 (&acc)[2][2][4][2], const Unit& u, int wr, int wc, int fr, int fq) const {
        const int e = u.pn >> 3, pnT = u.pn & 7;
        const int row0 = u.pm * BM + wr * 64 + fr, col0 = pnT * 128 + wc * 32 + 8 * fq;
        const float* bg = b_up + (size_t)e * 2048 + col0; const float* bl = bg + 1024;
        float bgv[8], blv[8];
#pragma unroll
        for (int j = 0; j < 8; ++j) { bgv[j] = bg[j]; blv[j] = bl[j]; }
#pragma unroll
        for (int ai = 0; ai < 2; ++ai)
#pragma unroll
            for (int m = 0; m < 4; ++m) { unsigned char* rowp = H + (size_t)(row0 + ai * HALF + m * 16) * 1024 + col0; float a[8];
#pragma unroll
                for (int n = 0; n < 2; ++n)
#pragma unroll
                    for (int j = 0; j < 4; ++j) { float g = acc[ai][0][m][n][j] * (1.f / 512.f) + bgv[4 * n + j], l = acc[ai][1][m][n][j] * (1.f / 512.f) + blv[4 * n + j];
                        g = fminf(g, 7.0f); l = fminf(fmaxf(l, -7.0f), 7.0f); a[4 * n + j] = g * sigmoidf_(1.702f * g) * (l + 1.0f); }
                v2u w; w.x = pk4_fp8(a[0] * 4.f, a[1] * 4.f, a[2] * 4.f, a[3] * 4.f); w.y = pk4_fp8(a[4] * 4.f, a[5] * 4.f, a[6] * 4.f, a[7] * 4.f);
                *(v2u*)rowp = w; }
    }
};
struct EpiDown {
    static constexpr bool PERM = true, AFTER_DRAIN = false;
    bf16_t* Y; const float* b_dn; const float* gate;
    __device__ __forceinline__ void operator()(const f32x4 (&acc)[2][2][4][2], const Unit& u, int wr, int wc, int fr, int fq) const {
        const int e = u.pn >> 2, pnT = u.pn & 3;
        const int row0 = u.pm * BM + wr * 64 + fr, col0 = pnT * 256 + wc * 32 + 8 * fq;
        const float* bb = b_dn + (size_t)e * 1024 + col0;
        float bv[2][8];
#pragma unroll
        for (int bj = 0; bj < 2; ++bj)
#pragma unroll
            for (int j = 0; j < 8; ++j) bv[bj][j] = bb[bj * HALF + j];
#pragma unroll
        for (int ai = 0; ai < 2; ++ai)
#pragma unroll
            for (int m = 0; m < 4; ++m) { const int row = row0 + ai * HALF + m * 16; const float gt = gate[row]; bf16_t* rowp = Y + (size_t)row * 1024 + col0;
#pragma unroll
                for (int bj = 0; bj < 2; ++bj) { const f32x4 v0 = acc[ai][bj][m][0], v1 = acc[ai][bj][m][1];
                    const float as = 1.f / 256.f;
                    u32x4 w; w.x = cvt_pk_bf16((v0[0] * as + bv[bj][0]) * gt, (v0[1] * as + bv[bj][1]) * gt); w.y = cvt_pk_bf16((v0[2] * as + bv[bj][2]) * gt, (v0[3] * as + bv[bj][3]) * gt);
                    w.z = cvt_pk_bf16((v1[0] * as + bv[bj][4]) * gt, (v1[1] * as + bv[bj][5]) * gt); w.w = cvt_pk_bf16((v1[2] * as + bv[bj][6]) * gt, (v1[3] * as + bv[bj][7]) * gt);
                    *(u32x4*)(rowp + bj * HALF) = w; } }
    }
};
struct MoeOrder {
    const int* tile_e; int ntiles, nN, G, c;
    __device__ __forceinline__ bool next(int i, Unit& u) const {
        if ((G & 7) == 0) {
            const int x = c & 7, s = i * (G >> 3) + (c >> 3);
            const int cg = nN >> 2, rg = 8 / cg;
            const int ch = x % cg, rc = x / cg;
            const int lr = s >> 2, pl = 4 * ch + (s & 3), pm = rc + rg * lr;
            if (pm >= ntiles) return false;
            u.pm = pm; u.pn = tile_e[pm] * nN + pl; return true;
        }
        const int L = i * G + c; if (L >= ntiles * nN) return false;
        const int pm = L / nN, pl = L - pm * nN; u.pm = pm; u.pn = tile_e[pm] * nN + pl; return true;
    }
    __device__ __forceinline__ void a_ready(const Unit&) const {}
    __device__ __forceinline__ void done(const Unit&) const {}
};
}

template <class RowMap>
__device__ __forceinline__ void transpose_item(const float* W, int ldw, int Nvalid, bf16* WT, int Kdim, RowMap rm, LAS float* scr, int kb, int nb, int lane) {
    const int k0 = 64 * kb, n0 = 32 * nb; const int nl0 = lane & 31, nn = n0 + nl0;
#pragma unroll 8
    for (int i = 0; i < 32; ++i) { const int kk = 2 * i + (lane >> 5); scr[kk * 33 + nl0] = (nn < Nvalid) ? W[(size_t)(k0 + kk) * ldw + nn] : 0.f; }
    LDS_WAIT(); asm volatile("" ::: "memory");
    const int c = lane & 7;
#pragma unroll
    for (int j = 0; j < 4; ++j) { const int n = (lane >> 3) + 8 * j; const LAS float* s = scr + (8 * c) * 33 + n;
        v4u o; o.x = pk2(s[0 * 33], s[1 * 33]); o.y = pk2(s[2 * 33], s[3 * 33]); o.z = pk2(s[4 * 33], s[5 * 33]); o.w = pk2(s[6 * 33], s[7 * 33]);
        *(GAS v4u*)(WT + (size_t)rm(n0 + n) * Kdim + k0 + 8 * c) = o; }
    LDS_WAIT(); asm volatile("" ::: "memory");
}
__device__ __forceinline__ unsigned pk4_fp8(float a, float b, float c, float d) { int r = 0; r = __builtin_amdgcn_cvt_pk_fp8_f32(a, b, r, false); r = __builtin_amdgcn_cvt_pk_fp8_f32(c, d, r, true); return (unsigned)r; }
template <class RowMap>
__device__ __forceinline__ void transpose_item_f8(const float* W, int ldw, unsigned char* WT, int Kdim, RowMap rm, LAS float* scr, int kb, int nb, int lane, float mul) {
    const int k0 = 64 * kb, n0 = 32 * nb; const int nl0 = lane & 31, nn = n0 + nl0;
#pragma unroll 8
    for (int i = 0; i < 32; ++i) { const int kk = 2 * i + (lane >> 5); scr[kk * 33 + nl0] = W[(size_t)(k0 + kk) * ldw + nn] * mul; }
    LDS_WAIT(); asm volatile("" ::: "memory");
    const int c = lane & 7;
#pragma unroll
    for (int j = 0; j < 4; ++j) { const int n = (lane >> 3) + 8 * j; const LAS float* s = scr + (8 * c) * 33 + n;
        v2u o; o.x = pk4_fp8(s[0 * 33], s[1 * 33], s[2 * 33], s[3 * 33]); o.y = pk4_fp8(s[4 * 33], s[5 * 33], s[6 * 33], s[7 * 33]);
        *(GAS v2u*)(WT + (size_t)rm(n0 + n) * Kdim + k0 + 8 * c) = o; }
    LDS_WAIT(); asm volatile("" ::: "memory");
}
struct RmId { __device__ __forceinline__ int operator()(int n) const { return n; } };
struct RmUp { int e; __device__ __forceinline__ int operator()(int n) const { return e * 2048 + ((n & 1023) >> 7) * 256 + (n >> 10) * 128 + (n & 127); } };
struct RmOff { int off; __device__ __forceinline__ int operator()(int n) const { return off + n; } };

__device__ __forceinline__ void p0_prologue(const Params& P, const Ctx& C) {
    LAS float* scr = (LAS float*)(C.lds + C.wave * 16384);
    unsigned char* ws = P.ws;
    constexpr int I_IN = 16 * (D_INP / 32), I_O = 16 * 32, I_UP = 16 * 64, I_DN = 16 * 32, I_PP = 4 * 32, I_PG = 16 * 32, I_UK = 4 * 16, I_UV = 4 * 16;
    constexpr int NITEMS = I_IN + I_O + NE * I_UP + NE * I_DN + I_PP + I_PG + I_UK + I_UV;
    for (int it = C.gw; it < NITEMS; it += C.ngw) {
        int r = it;
        if (r < I_IN) { transpose_item(P.in[I_WIN], D_IN, D_IN, (bf16*)(ws + WS_WIN_T), 1024, RmId{}, scr, r / (D_INP / 32), r % (D_INP / 32), C.lane); continue; } r -= I_IN;
        if (r < I_O) { transpose_item_f8(P.in[I_WO], 1024, ws + WS_WO_T, 1024, RmId{}, scr, r / 32, r % 32, C.lane, 64.f); continue; } r -= I_O;
        if (r < NE * I_UP) { const int e = r / I_UP, q = r % I_UP; transpose_item_f8(P.in[I_WUP] + (size_t)e * 1024 * 2048, 2048, ws + WS_WUP_T, 1024, RmUp{e}, scr, q / 64, q % 64, C.lane, 64.f); continue; } r -= NE * I_UP;
        if (r < NE * I_DN) { const int e = r / I_DN, q = r % I_DN; transpose_item_f8(P.in[I_WDN] + (size_t)e * 1024 * 1024, 1024, ws + WS_WDN_T, 1024, RmOff{e * 1024}, scr, q / 32, q % 32, C.lane, 64.f); continue; } r -= NE * I_DN;
        if (r < I_PP) { transpose_item(P.in[I_WPP], 1024, 1024, (bf16*)(ws + WS_WPROJ_T), 256, RmId{}, scr, r / 32, r % 32, C.lane); continue; } r -= I_PP;
        if (r < I_PG) { transpose_item_f8(P.in[I_WPG], 1024, ws + WS_WGATE_T, 1024, RmId{}, scr, r / 32, r % 32, C.lane, 64.f); continue; } r -= I_PG;
        if (r < I_UK) { transpose_item(P.in[I_WUK], 512, 512, (bf16*)(ws + WS_WUK_T), 256, RmId{}, scr, r / 16, r % 16, C.lane); continue; } r -= I_UK;
        transpose_item(P.in[I_WUV], 512, 512, (bf16*)(ws + WS_WUV_T), 256, RmId{}, scr, r / 16, r % 16, C.lane);
    }
    { const float* wr = P.in[I_WR]; float* wrt = (float*)(ws + WS_WRT);
      for (int i = C.gw * 64 + C.lane; i < 32 * 1024; i += C.ngw * 64) { const int e = i >> 10, k = i & 1023; wrt[i] = wr[k * 32 + e]; } }
    {
        const float* x = P.in[I_X]; bf16* xb = (bf16*)(ws + WS_XBF);
        const size_t n8 = (size_t)NTOK * D / 8, stride = (size_t)C.ngw * 64;
        for (size_t i = (size_t)C.gw * 64 + C.lane; i < n8; i += stride) { const f32x4 a = *(const GAS f32x4*)(x + i * 8), b = *(const GAS f32x4*)(x + i * 8 + 4);
            v4u o; o.x = pk2(a[0], a[1]); o.y = pk2(a[2], a[3]); o.z = pk2(b[0], b[1]); o.w = pk2(b[2], b[3]); *(GAS v4u*)(xb + i * 8) = o; }
        const float* p = P.in[I_P]; bf16* pb = (bf16*)(ws + WS_PB);
        const size_t m8 = (size_t)NTOK * PLE / 8;
        for (size_t i = (size_t)C.gw * 64 + C.lane; i < m8; i += stride) { const f32x4 a = *(const GAS f32x4*)(p + i * 8), b = *(const GAS f32x4*)(p + i * 8 + 4);
            v4u o; o.x = pk2(a[0], a[1]); o.y = pk2(a[2], a[3]); o.z = pk2(b[0], b[1]); o.w = pk2(b[2], b[3]); *(GAS v4u*)(pb + i * 8) = o; }
    }
}

__device__ __forceinline__ void ln_row(f32x4 (&v)[4], const float* g, const float* b, int lane) {
    float s = 0.f;
#pragma unroll
    for (int j = 0; j < 4; ++j) s += (v[j][0] + v[j][1]) + (v[j][2] + v[j][3]);
    const float mean = wave_sum(s) * (1.f / D); float s2 = 0.f;
#pragma unroll
    for (int j = 0; j < 4; ++j) { v[j] = v[j] - mean; s2 += (v[j][0] * v[j][0] + v[j][1] * v[j][1]) + (v[j][2] * v[j][2] + v[j][3] * v[j][3]); }
    const float rstd = 1.f / sqrtf(wave_sum(s2) * (1.f / D) + LN_EPS);
#pragma unroll
    for (int j = 0; j < 4; ++j) { const f32x4 gg = *(const f32x4*)(g + 4 * lane + 256 * j), bb = *(const f32x4*)(b + 4 * lane + 256 * j); v[j] = v[j] * rstd * gg + bb; }
}
__device__ __forceinline__ void store_row_f32(float* row, const f32x4 (&v)[4], int lane) {
#pragma unroll
    for (int j = 0; j < 4; ++j) *(GAS f32x4*)(row + 4 * lane + 256 * j) = v[j];
}
__device__ __forceinline__ void store_row_bf16(bf16* row, const f32x4 (&v)[4], int lane) {
#pragma unroll
    for (int j = 0; j < 4; ++j) { v2u o; o.x = pk2(v[j][0], v[j][1]); o.y = pk2(v[j][2], v[j][3]); *(GAS v2u*)(row + 4 * lane + 256 * j) = o; }
}
__device__ __forceinline__ void store_row_fp8x8(unsigned char* row, const f32x4 (&v)[4], int lane) {
#pragma unroll
    for (int j = 0; j < 4; ++j) *(GAS unsigned*)(row + 4 * lane + 256 * j) = pk4_fp8(v[j][0] * 8.f, v[j][1] * 8.f, v[j][2] * 8.f, v[j][3] * 8.f);
}
__device__ __forceinline__ void load_row_bf16(f32x4 (&v)[4], const bf16* row, int lane) {
#pragma unroll
    for (int j = 0; j < 4; ++j) { const v2u w = *(const GAS v2u*)(row + 4 * lane + 256 * j); v[j] = (f32x4){bflo(w.x), bfhi(w.x), bflo(w.y), bfhi(w.y)}; }
}
__device__ __forceinline__ void load_row_f32(f32x4 (&v)[4], const float* row, int lane) {
#pragma unroll
    for (int j = 0; j < 4; ++j) v[j] = *(const GAS f32x4*)(row + 4 * lane + 256 * j);
}
#ifndef FEAT_MIX
#define FEAT_MIX 1
#endif
#ifndef FEAT_MOE
#define FEAT_MOE 1
#endif
#ifndef FEAT_PLE
#define FEAT_PLE 1
#endif
#ifndef FEAT_ATT
#define FEAT_ATT 1
#endif
#ifndef SYNC_MODE
#define SYNC_MODE 0
#endif
#ifndef PROGRAM
#define PROGRAM X(0) GS X(10) X(11) SY X(20) X(21) SY X(30) X(31) BS X(32) SY X(40) X(41) SY X(5) SY X(6) SY X(7) SY X(8) SY X(9) SY X(100) SY X(110) SY X(120)
#endif

typedef float f32x16 __attribute__((ext_vector_type(16)));
typedef short s16x4 __attribute__((ext_vector_type(4)));
__device__ __forceinline__ unsigned cvtpk(float lo, float hi) { typedef float f2 __attribute__((ext_vector_type(2))); typedef __bf16 b2 __attribute__((ext_vector_type(2))); f2 v = {lo, hi}; b2 b = __builtin_convertvector(v, b2); return __builtin_bit_cast(unsigned, b); }
__device__ __forceinline__ bf16x8 pack8(const f32x16& x, int base) {
    v4u w; w.x = cvtpk(x[base + 0], x[base + 1]); w.y = cvtpk(x[base + 2], x[base + 3]); w.z = cvtpk(x[base + 4], x[base + 5]); w.w = cvtpk(x[base + 6], x[base + 7]);
    return __builtin_bit_cast(bf16x8, w);
}

__device__ __forceinline__ void p2_post(const Params& P, const Ctx& C) {
    unsigned char* ws = P.ws;
    const bf16* H = (const bf16*)(ws + WS_H); bf16* CN = (bf16*)(ws + WS_CN); bf16* IKN = (bf16*)(ws + WS_IKN);
    const float* kvg = P.in[I_KVG]; const float* ikg = P.in[I_IKG]; const float* ikb = P.in[I_IKB];
    const f32x4 g4 = *(const f32x4*)(kvg + 4 * C.lane); const float ig = ikg[C.lane], ib = ikb[C.lane];
    for (int m = C.gw; m < NTOK; m += C.ngw) {
        const bf16* hr = H + (size_t)m * D_INP;
        const v2u w = *(const GAS v2u*)(hr + C_AC + 4 * C.lane);
        float a0 = bflo(w.x), a1 = bfhi(w.x), a2 = bflo(w.y), a3 = bfhi(w.y);
        const float ss = wave_sum((a0 * a0 + a1 * a1) + (a2 * a2 + a3 * a3));
        const float rs = 1.f / sqrtf(ss * (1.f / 256.f) + RMS_EPS);
        v2u o; o.x = pk2(a0 * rs * g4[0], a1 * rs * g4[1]); o.y = pk2(a2 * rs * g4[2], a3 * rs * g4[3]);
        *(GAS v2u*)(CN + (size_t)m * 256 + 4 * C.lane) = o;
        const float k = bf2f(hr[C_IK + C.lane]);
        const float mu = wave_sum(k) * (1.f / 64.f); const float dk = k - mu;
        const float var = wave_sum(dk * dk) * (1.f / 64.f);
        IKN[(size_t)m * 64 + C.lane] = (bf16)f2bf(dk * (1.f / sqrtf(var + LN_EPS)) * ig + ib);
    }
}

constexpr int HP_QD = 0, HP_KI = 8704, HP_KET = 17408, HP_VT = 27648, HP_GS = 37888, HP_RAW = 40960;
__device__ __forceinline__ void p2_hgrn_prep(const Params& P, const Ctx& C) {
    unsigned char* ws = P.ws;
    const bf16* H = (const bf16*)(ws + WS_H);
    bf16* UT = (bf16*)(ws + WS_U); bf16* QDEC = (bf16*)(ws + WS_QDEC); float* OREC = (float*)(ws + WS_OREC); float* DEC = (float*)(ws + WS_DECAY);
    LAS bf16* QD = (LAS bf16*)(C.lds + HP_QD); LAS bf16* KI = (LAS bf16*)(C.lds + HP_KI); LAS bf16* KET = (LAS bf16*)(C.lds + HP_KET); LAS bf16* VT = (LAS bf16*)(C.lds + HP_VT);
    LAS float* GS = (LAS float*)(C.lds + HP_GS); LAS bf16* RAW = (LAS bf16*)(C.lds + HP_RAW);
    const int d = C.tid & 127, tg = C.tid >> 7;
    const int lane = C.lane, r32 = lane & 31, hf = lane >> 5;
    const int lc = C.tid >> 4, lg = C.tid & 15;
    const int NU = NB * HG_H * (T / HG_C);
    v4u rf, rq, ri;
    { const int unit = blockIdx.x; if (unit < NU) { const int n = unit & 127, hh = (unit >> 7) & 3, b = unit >> 9; const bf16* hr = H + (size_t)(b * T + n * HG_C + lc) * D_INP + hh * 128 + 8 * lg;
        rf = *(const GAS v4u*)(hr + C_GF); rq = *(const GAS v4u*)(hr + C_GQ); ri = *(const GAS v4u*)(hr + C_GI); } }
    for (int unit = blockIdx.x; unit < NU; unit += C.G) {
        const int n = unit & 127, hh = (unit >> 7) & 3, b = unit >> 9;
        const int m0 = b * T + n * HG_C;
        *(LAS v4u*)(RAW + lc * 128 + 8 * lg) = rf; *(LAS v4u*)(RAW + 4096 + lc * 128 + 8 * lg) = rq; *(LAS v4u*)(RAW + 8192 + lc * 128 + 8 * lg) = ri;
        __syncthreads();
        { const int un = unit + C.G; if (un < NU) { const int n2 = un & 127, h2 = (un >> 7) & 3, b2 = un >> 9; const bf16* hr = H + (size_t)(b2 * T + n2 * HG_C + lc) * D_INP + h2 * 128 + 8 * lg;
            rf = *(const GAS v4u*)(hr + C_GF); rq = *(const GAS v4u*)(hr + C_GQ); ri = *(const GAS v4u*)(hr + C_GI); } }
        const float l0 = P.in[I_HGLB][hh * 128 + d], l1 = P.in[I_HGLB][512 + hh * 128 + d];
        const float lb = 1.f / (1.f + __expf(l1 - l0));
        float fg[8], bl[8], qv[8]; float run = 0.f; unsigned vv[4];
#pragma unroll
        for (int c = 0; c < 8; ++c) { const int tok = tg * 8 + c;
            const float f = bf2f(RAW[tok * 128 + d]), q = bf2f(RAW[4096 + tok * 128 + d]); const unsigned iv = RAW[8192 + tok * 128 + d];
            fg[c] = lb + (1.f - lb) * sigmoidf_(f); run += __logf(fg[c]); bl[c] = run; qv[c] = q * sigmoidf_(q);
            if (c & 1) vv[c >> 1] |= iv << 16; else vv[c >> 1] = iv; }
        GS[tg * 128 + d] = run;
        *(LAS v4u*)(VT + d * 40 + tg * 8) = (v4u){vv[0], vv[1], vv[2], vv[3]};
        __syncthreads();
        float pre = 0.f, tot = 0.f;
#pragma unroll
        for (int g = 0; g < 4; ++g) { const float sg = GS[g * 128 + d]; tot += sg; if (g < tg) pre += sg; }
        unsigned ke[4];
#pragma unroll
        for (int c = 0; c < 8; ++c) { const float bc = pre + bl[c]; const float kc = 1.f - fg[c];
            const float qd = qv[c] * __expf(bc), ki = kc * __expf(-bc), kend = kc * __expf(tot - bc);
            const unsigned qb = f2bf(qd);
            QD[(tg * 8 + c) * 136 + d] = (bf16)qb; KI[(tg * 8 + c) * 136 + d] = (bf16)f2bf(ki);
            if (c & 1) ke[c >> 1] |= f2bf(kend) << 16; else ke[c >> 1] = f2bf(kend); }
        *(LAS v4u*)(KET + d * 40 + tg * 8) = (v4u){ke[0], ke[1], ke[2], ke[3]};
        if (tg == 0) DEC[(size_t)unit * 128 + d] = __expf(tot);
        __syncthreads();
        *(GAS v4u*)(QDEC + (size_t)(m0 + lc) * 512 + hh * 128 + 8 * lg) = *(const LAS v4u*)(QD + lc * 136 + 8 * lg);
        if (C.wave < 4) {
            f32x16 X = {0.f, 0.f, 0.f, 0.f, 0.f, 0.f, 0.f, 0.f, 0.f, 0.f, 0.f, 0.f, 0.f, 0.f, 0.f, 0.f};
#pragma unroll
            for (int k = 0; k < 8; ++k) { const bf16x8 a = *(const LAS bf16x8*)(KI + r32 * 136 + 16 * k + 8 * hf), bq = *(const LAS bf16x8*)(QD + r32 * 136 + 16 * k + 8 * hf);
                X = __builtin_amdgcn_mfma_f32_32x32x16_bf16(a, bq, X, 0, 0, 0); }
#pragma unroll
            for (int r = 0; r < 16; ++r) { const int sidx = (r & 3) + 8 * (r >> 2) + 4 * hf; if (sidx > r32) X[r] = 0.f; }
            f32x16 Z = {0.f, 0.f, 0.f, 0.f, 0.f, 0.f, 0.f, 0.f, 0.f, 0.f, 0.f, 0.f, 0.f, 0.f, 0.f, 0.f};
            const int e = C.wave * 32 + r32;
#pragma unroll
            for (int sp = 0; sp < 2; ++sp) { const bf16x8 a = pack8(X, 8 * sp);
                const s16x4 lo = *(const LAS s16x4*)(VT + e * 40 + 16 * sp + 4 * hf), hi = *(const LAS s16x4*)(VT + e * 40 + 16 * sp + 8 + 4 * hf);
                const bf16x8 bv = (bf16x8){lo[0], lo[1], lo[2], lo[3], hi[0], hi[1], hi[2], hi[3]};
                Z = __builtin_amdgcn_mfma_f32_32x32x16_bf16(a, bv, Z, 0, 0, 0); }
#pragma unroll
            for (int r = 0; r < 16; ++r) { const int c = (r & 3) + 8 * (r >> 2) + 4 * hf; OREC[(size_t)(m0 + c) * 512 + hh * 128 + e] = Z[r]; }
        }
        {
            const int dt = C.wave >> 1;
            const bf16x8 a0 = *(const LAS bf16x8*)(KET + (dt * 32 + r32) * 40 + 8 * hf), a1 = *(const LAS bf16x8*)(KET + (dt * 32 + r32) * 40 + 16 + 8 * hf);
#pragma unroll
            for (int ei = 0; ei < 2; ++ei) { const int et = 2 * (C.wave & 1) + ei;
                const bf16x8 b0 = *(const LAS bf16x8*)(VT + (et * 32 + r32) * 40 + 8 * hf), b1 = *(const LAS bf16x8*)(VT + (et * 32 + r32) * 40 + 16 + 8 * hf);
                f32x16 U = {0.f, 0.f, 0.f, 0.f, 0.f, 0.f, 0.f, 0.f, 0.f, 0.f, 0.f, 0.f, 0.f, 0.f, 0.f, 0.f};
                U = __builtin_amdgcn_mfma_f32_32x32x16_bf16(a0, b0, U, 0, 0, 0); U = __builtin_amdgcn_mfma_f32_32x32x16_bf16(a1, b1, U, 0, 0, 0);
                bf16* up = UT + (size_t)unit * 16384 + (size_t)(et * 32 + r32) * 128 + dt * 32 + 4 * hf;
#pragma unroll
                for (int q = 0; q < 4; ++q) { v2u o; o.x = cvtpk(U[4 * q], U[4 * q + 1]); o.y = cvtpk(U[4 * q + 2], U[4 * q + 3]); *(GAS v2u*)(up + 8 * q) = o; } }
        }
        __syncthreads();
    }
}

__device__ __forceinline__ void p3_hgrn_scan(const Params& P, const Ctx& C) {
    unsigned char* ws = P.ws;
    const bf16* UT = (const bf16*)(ws + WS_U); const bf16* QDEC = (const bf16*)(ws + WS_QDEC); float* OREC = (float*)(ws + WS_OREC); const float* DEC = (const float*)(ws + WS_DECAY);
    LAS bf16* ST = (LAS bf16*)C.lds;
    typedef float f32x4v __attribute__((ext_vector_type(4)));
    for (int unit = blockIdx.x; unit < NB * HG_H * 8; unit += C.G) {
        const int xcd_ = unit & 7, idx_ = unit >> 3; const int sl = idx_ & 7, bh_ = xcd_ + 8 * (idx_ >> 3); const int hh = bh_ & 3, b = bh_ >> 2; const int e0 = sl * 16;
        const int e = C.tid & 15, dq = C.tid >> 4;
        float S[4] = {0.f, 0.f, 0.f, 0.f};
        *(LAS v2u*)(ST + e * 136 + 4 * dq) = (v2u){0u, 0u};
        const int cu0 = (b * HG_H + hh) * 128;
        const int lane = C.lane, fr = lane & 15, fq = lane >> 4;
        const bool mw = C.wave < 2;
        const bf16* up = UT + (size_t)cu0 * 16384 + (size_t)(e0 + e) * 128 + 4 * dq;
        const float* dp = DEC + (size_t)cu0 * 128 + 4 * dq;
        const bf16* qp = QDEC + (size_t)(b * T + C.wave * 16 + fr) * 512 + hh * 128 + 8 * fq;
        float* op = OREC + (size_t)(b * T + C.wave * 16 + 4 * fq) * 512 + hh * 128 + e0 + fr;
        v2u un[4]; f32x4 dn[4]; bf16x8 qa[4][4]; float oi[4][4];
#pragma unroll
        for (int s = 0; s < 4; ++s) { un[s] = *(const GAS v2u*)(up + (size_t)s * 16384); dn[s] = *(const GAS f32x4*)(dp + (size_t)s * 128);
            if (mw) {
#pragma unroll
                for (int k = 0; k < 4; ++k) qa[s][k] = *(const GAS bf16x8*)(qp + (size_t)s * 32 * 512 + 32 * k);
#pragma unroll
                for (int j = 0; j < 4; ++j) oi[s][j] = op[(size_t)(s * 32 + j) * 512]; } }
        __syncthreads();
        for (int nb = 0; nb < 32; ++nb) {
#pragma unroll
            for (int s = 0; s < 4; ++s) {
                const int n = 4 * nb + s;
                const LAS bf16* stc = ST + (n & 1) * (16 * 136); LAS bf16* stn = ST + ((n + 1) & 1) * (16 * 136);
                if (mw) {
                    f32x4v acc = {oi[s][0], oi[s][1], oi[s][2], oi[s][3]};
#pragma unroll
                    for (int k = 0; k < 4; ++k) { const bf16x8 bs = *(const LAS bf16x8*)(stc + fr * 136 + 32 * k + 8 * fq); acc = __builtin_amdgcn_mfma_f32_16x16x32_bf16(qa[s][k], bs, acc, 0, 0, 0); }
#pragma unroll
                    for (int j = 0; j < 4; ++j) op[(size_t)(n * 32 + j) * 512] = acc[j];
                }
                S[0] = dn[s][0] * S[0] + bflo(un[s].x); S[1] = dn[s][1] * S[1] + bfhi(un[s].x); S[2] = dn[s][2] * S[2] + bflo(un[s].y); S[3] = dn[s][3] * S[3] + bfhi(un[s].y);
                *(LAS v2u*)(stn + e * 136 + 4 * dq) = (v2u){cvtpk(S[0], S[1]), cvtpk(S[2], S[3])};
                if (nb + 1 < 32) {
                    const int n2 = n + 4; un[s] = *(const GAS v2u*)(up + (size_t)n2 * 16384); dn[s] = *(const GAS f32x4*)(dp + (size_t)n2 * 128);
                    if (mw) {
#pragma unroll
                        for (int k = 0; k < 4; ++k) qa[s][k] = *(const GAS bf16x8*)(qp + (size_t)n2 * 32 * 512 + 32 * k);
#pragma unroll
                        for (int j = 0; j < 4; ++j) oi[s][j] = op[(size_t)(n2 * 32 + j) * 512]; }
                }
                __syncthreads();
            }
        }
    }
}

__device__ __forceinline__ void p4_yrec(const Params& P, const Ctx& C) {
    unsigned char* ws = P.ws;
    const float* OREC = (const float*)(ws + WS_OREC); const bf16* H = (const bf16*)(ws + WS_H); bf16* YM = (bf16*)(ws + WS_YMIX);
    const float* ng = P.in[I_HGNG];
    const f32x4 g0 = *(const f32x4*)(ng + 8 * C.lane), g1 = *(const f32x4*)(ng + 8 * C.lane + 4);
    for (int m = C.gw; m < NTOK; m += C.ngw) {
        const f32x4 a = *(const GAS f32x4*)(OREC + (size_t)m * 512 + 8 * C.lane), bq = *(const GAS f32x4*)(OREC + (size_t)m * 512 + 8 * C.lane + 4);
        float ss = (a[0] * a[0] + a[1] * a[1]) + (a[2] * a[2] + a[3] * a[3]) + (bq[0] * bq[0] + bq[1] * bq[1]) + (bq[2] * bq[2] + bq[3] * bq[3]);
        ss += __shfl_xor(ss, 1); ss += __shfl_xor(ss, 2); ss += __shfl_xor(ss, 4); ss += __shfl_xor(ss, 8);
        const float rs = 1.f / sqrtf(ss * (1.f / 128.f) + RMS_EPS);
        const v4u gw = *(const GAS v4u*)(H + (size_t)m * D_INP + C_GG + 8 * C.lane);
        float gv[8] = {bflo(gw.x), bfhi(gw.x), bflo(gw.y), bfhi(gw.y), bflo(gw.z), bfhi(gw.z), bflo(gw.w), bfhi(gw.w)};
        float o[8];
#pragma unroll
        for (int j = 0; j < 4; ++j) { o[j] = a[j] * rs * g0[j] * (gv[j] * sigmoidf_(gv[j])); o[4 + j] = bq[j] * rs * g1[j] * (gv[4 + j] * sigmoidf_(gv[4 + j])); }
        v2u w; w.x = pk4_fp8(o[0] * 8.f, o[1] * 8.f, o[2] * 8.f, o[3] * 8.f); w.y = pk4_fp8(o[4] * 8.f, o[5] * 8.f, o[6] * 8.f, o[7] * 8.f);
        *(GAS v2u*)((unsigned char*)YM + (size_t)m * D + 512 + 8 * C.lane) = w;
#if !FEAT_ATT
        *(GAS v4u*)(YM + (size_t)m * D + 8 * C.lane) = (v4u){0u, 0u, 0u, 0u};
#endif
    }
}

namespace pg8 {
struct EpiKhead {
    static constexpr bool PERM = true, AFTER_DRAIN = false;
    bf16_t* O;
    __device__ __forceinline__ void operator()(const f32x4 (&acc)[2][2][4][2], const Unit& u, int wr, int wc, int fr, int fq) const {
        const int row0 = u.pm * BM + wr * 64 + fr, col0 = u.pn * BM + wc * 32 + 8 * fq;
#pragma unroll
        for (int ai = 0; ai < 2; ++ai)
#pragma unroll
            for (int m = 0; m < 4; ++m) { const int row = row0 + ai * HALF + m * 16; const int b = row >> 12, t = row & 4095;
#pragma unroll
                for (int bj = 0; bj < 2; ++bj) { const int col = col0 + bj * HALF; const f32x4 v0 = acc[ai][bj][m][0], v1 = acc[ai][bj][m][1];
                    u32x4 w; w.x = cvt_pk_bf16(v0[0], v0[1]); w.y = cvt_pk_bf16(v0[2], v0[3]); w.z = cvt_pk_bf16(v1[0], v1[1]); w.w = cvt_pk_bf16(v1[2], v1[3]);
                    *(u32x4*)(O + ((size_t)((b * 8 + (col >> 6)) * 4096 + t)) * 64 + (col & 63)) = w; } }
    }
};
struct EpiVt {
    static constexpr bool PERM = true, AFTER_DRAIN = false;
    bf16_t* O;
    __device__ __forceinline__ void operator()(const f32x4 (&acc)[2][2][4][2], const Unit& u, int wr, int wc, int fr, int fq) const {
        const int row0 = u.pm * BM + wr * 64 + fr, col0 = u.pn * BM + wc * 32 + 8 * fq;
#pragma unroll
        for (int ai = 0; ai < 2; ++ai)
#pragma unroll
            for (int m = 0; m < 4; ++m) { const int row = row0 + ai * HALF + m * 16;
#pragma unroll
                for (int bj = 0; bj < 2; ++bj) { const int col = col0 + bj * HALF; const int b = col >> 12, t = col & 4095; const f32x4 v0 = acc[ai][bj][m][0], v1 = acc[ai][bj][m][1];
                    u32x4 w; w.x = cvt_pk_bf16(v0[0], v0[1]); w.y = cvt_pk_bf16(v0[2], v0[3]); w.z = cvt_pk_bf16(v1[0], v1[1]); w.w = cvt_pk_bf16(v1[2], v1[3]);
                    *(u32x4*)(O + ((size_t)(b * 512 + row)) * 4096 + t) = w; } }
    }
};
}

__device__ __forceinline__ unsigned f2ord(float x) { const unsigned b = __builtin_bit_cast(unsigned, x); return b ^ ((unsigned)((int)b >> 31) | 0x80000000u); }
typedef _Float16 h16;
typedef _Float16 h16x8 __attribute__((ext_vector_type(8)));
__device__ __forceinline__ float relu_i(float x) { const int b = __builtin_bit_cast(int, x); return __builtin_bit_cast(float, b > 0 ? b : 0); }
__device__ __forceinline__ unsigned h2ord(unsigned hb) { return (hb ^ ((hb & 0x8000u) ? 0xffffu : 0x8000u)) & 0xffffu; }
__device__ __forceinline__ int isc_bucket(float x, float mu, float scale) { const float t = fminf(fmaxf(fmaf(x - mu, scale, 128.f), 0.f), 255.f); return (int)t; }
__device__ __forceinline__ void p3_indexer(const Params& P, const Ctx& C) {
    unsigned char* ws = P.ws;
    const bf16* H = (const bf16*)(ws + WS_H); const bf16* IKN = (const bf16*)(ws + WS_IKN); unsigned* MASK = (unsigned*)(ws + WS_MASK);
    LAS h16* ISC = (LAS h16*)C.lds; LAS unsigned* HIST = (LAS unsigned*)(C.lds + 131072) + C.wave * 256; LAS float* STAT = (LAS float*)(C.lds + 139264); LAS float* W16 = (LAS float*)(C.lds + 140288);
    const int lane = C.lane, r32 = lane & 31, hf = lane >> 5;
    const int ql = 2 * (r32 >> 4) + ((r32 >> 2) & 1), hd = 4 * ((r32 >> 3) & 1) + (r32 & 3);
    constexpr int CAND_CAP = 120, QU = 16;
    for (int u = blockIdx.x; u < NTOK / QU; u += C.G) {
        const int b = u & 7, j = (u >> 3) & 31, i = u >> 8; const int pi = i >> 1; const int blk = (i & 1) ? (255 - (j + 32 * pi)) : (j + 32 * pi);
        const int t0 = blk * QU; const size_t mb = (size_t)b * T;
        const int nkt = (t0 + QU + 31) >> 5;
        bf16x8 af[4][4];
#pragma unroll
        for (int a = 0; a < 4; ++a) {
            const bf16* qp = H + (mb + t0 + 4 * a + ql) * D_INP + C_IQ + hd * 64 + 8 * hf;
#pragma unroll
            for (int k = 0; k < 4; ++k) af[a][k] = *(const GAS bf16x8*)(qp + 16 * k);
        }
        if (C.tid < 128) { const int q = C.tid >> 3, h8 = C.tid & 7; W16[C.tid] = bf2f(H[(mb + t0 + q) * D_INP + C_IW + h8]) * (0.125f * 0.35355339059327373f); }
        __syncthreads();
        {
            int kt = C.wave; bf16x8 bk[4], bn[4];
            if (kt < nkt) { const bf16* kp = IKN + (mb + kt * 32 + r32) * 64 + 8 * hf;
#pragma unroll
                for (int k = 0; k < 4; ++k) bk[k] = *(const GAS bf16x8*)(kp + 16 * k); }
            for (; kt < nkt; kt += NWAVES) {
                const int s0 = kt * 32;
                if (kt + NWAVES < nkt) { const bf16* kp = IKN + (mb + s0 + 32 * NWAVES + r32) * 64 + 8 * hf;
#pragma unroll
                    for (int k = 0; k < 4; ++k) bn[k] = *(const GAS bf16x8*)(kp + 16 * k); }
#pragma unroll
                for (int a = 0; a < 4; ++a) {
                    f32x16 acc = {0.f, 0.f, 0.f, 0.f, 0.f, 0.f, 0.f, 0.f, 0.f, 0.f, 0.f, 0.f, 0.f, 0.f, 0.f, 0.f};
#pragma unroll
                    for (int k = 0; k < 4; ++k) acc = __builtin_amdgcn_mfma_f32_32x32x16_bf16(af[a][k], bk[k], acc, 0, 0, 0);
#pragma unroll
                    for (int qh = 0; qh < 2; ++qh) { float sa = 0.f, sb = 0.f;
                        const int q = 4 * a + 2 * qh + hf, key = s0 + r32;
                        const f32x4 wl = *(const LAS f32x4*)(W16 + q * 8), wh = *(const LAS f32x4*)(W16 + q * 8 + 4);
                        sa = fmaf(wl[0], relu_i(acc[8 * qh + 0]), sa); sb = fmaf(wl[1], relu_i(acc[8 * qh + 1]), sb); sa = fmaf(wl[2], relu_i(acc[8 * qh + 2]), sa); sb = fmaf(wl[3], relu_i(acc[8 * qh + 3]), sb);
                        sa = fmaf(wh[0], relu_i(acc[8 * qh + 4]), sa); sb = fmaf(wh[1], relu_i(acc[8 * qh + 5]), sb); sa = fmaf(wh[2], relu_i(acc[8 * qh + 6]), sa); sb = fmaf(wh[3], relu_i(acc[8 * qh + 7]), sb);
                        float sv = sa + sb; const bool valid = key <= t0 + q; sv += 0.0f;
                        ISC[q * 4096 + key] = valid ? (h16)sv : (h16)(-INFINITY);
                    }
                }
#pragma unroll
                for (int k = 0; k < 4; ++k) bk[k] = bn[k];
            }
        }
        __syncthreads();
        for (int q = C.wave; q < QU; q += NWAVES) {
            const int t = t0 + q, n = t + 1; const LAS unsigned short* row = (const LAS unsigned short*)(ISC + q * 4096);
            unsigned* mrow = MASK + (mb + t) * 128;
            if (n <= TOPK) {
#pragma unroll
                for (int w2 = 0; w2 < 2; ++w2) { const int wi = lane + 64 * w2; const int lo = 32 * wi; unsigned bits;
                    if (lo + 31 <= t) bits = 0xffffffffu; else if (lo > t) bits = 0u; else bits = (1u << (t - lo + 1)) - 1u;
                    mrow[wi] = bits; }
            } else {
                unsigned dhi = 0u; int need = TOPK;
#pragma unroll
                for (int pass = 1; pass >= 0; --pass) {
                    LDS_WAIT();
#pragma unroll
                    for (int z = 0; z < 4; ++z) HIST[lane + 64 * z] = 0u;
#pragma unroll 2
                    for (int e0 = 8 * lane; e0 < n; e0 += 512) { const v4u v = *(const LAS v4u*)(row + e0);
#pragma unroll
                        for (int jj = 0; jj < 8; ++jj) { const unsigned w = (jj < 2) ? v.x : (jj < 4) ? v.y : (jj < 6) ? v.z : v.w; const unsigned hb = (jj & 1) ? (w >> 16) : (w & 0xffffu);
                            const unsigned key = h2ord(hb);
                            const bool ok = (e0 + jj < n) && (pass == 1 || (key >> 8) == dhi);
                            if (ok) atomicAdd((unsigned*)&HIST[pass == 1 ? (key >> 8) : (key & 255u)], 1u); } }
                    LDS_WAIT();
                    const v4u c4 = *(const LAS v4u*)(HIST + 4 * lane);
                    const unsigned c0 = c4.x, c1 = c4.y, c2 = c4.z, c3 = c4.w; const unsigned s4 = c0 + c1 + c2 + c3;
                    unsigned suf = s4;
#pragma unroll
                    for (int o = 1; o < 64; o <<= 1) { const unsigned v2 = __shfl_down(suf, o); if (lane + o < 64) suf += v2; }
                    unsigned cum = suf - s4; int dsel = -1; int nnew = 0; const unsigned nd = (unsigned)need;
                    if (cum < nd && nd <= cum + c3) { dsel = 4 * lane + 3; nnew = (int)(nd - cum); } cum += c3;
                    if (dsel < 0 && cum < nd && nd <= cum + c2) { dsel = 4 * lane + 2; nnew = (int)(nd - cum); } cum += c2;
                    if (dsel < 0 && cum < nd && nd <= cum + c1) { dsel = 4 * lane + 1; nnew = (int)(nd - cum); } cum += c1;
                    if (dsel < 0 && cum < nd && nd <= cum + c0) { dsel = 4 * lane + 0; nnew = (int)(nd - cum); }
                    const unsigned long long bal = __ballot(dsel >= 0);
                    const int src = (bal != 0ull) ? (int)__builtin_ctzll(bal) : 0;
                    const int dd = __shfl(dsel, src); need = __shfl(nnew, src);
                    if (pass == 1) dhi = (unsigned)dd; else dhi = (dhi << 8) | (unsigned)dd;
                }
                const unsigned Tk = dhi;
                int run_eq = 0; unsigned long long mine = 0ull; const int nit = (t >> 6) + 1;
#pragma unroll 4
                for (int it = 0; it < nit; ++it) { const int e = it * 64 + lane; const unsigned key = h2ord(row[e]); const bool valid = e <= t;
                    const bool eq = valid && (key == Tk); const unsigned long long beq = __ballot(eq);
                    const int rk = run_eq + __builtin_popcountll(beq & ((1ull << lane) - 1ull));
                    const bool sel = valid && ((key > Tk) || (eq && rk < need)); run_eq += __builtin_popcountll(beq);
                    const unsigned long long bs = __ballot(sel);
                    if (lane == it) mine = bs; }
                *(GAS v2u*)(mrow + 2 * lane) = (v2u){(unsigned)mine, (unsigned)(mine >> 32)};
            }
        }
        __syncthreads();
    }
}

__device__ __forceinline__ void attn_task(const bf16* H, const bf16* KH, const bf16* VT, const unsigned* MASK, bf16* YM, int b, int hh, int t0, int lane) {
    const int r32 = lane & 31, hf = lane >> 5;
    const float LOG2E = 1.4426950408889634f; const float c1 = 0.125f * LOG2E; const float sl2 = exp2f(-(float)(hh + 1)) * LOG2E;
    const size_t mb = (size_t)b * T;
    bf16x8 qf[4];
#pragma unroll
    for (int k = 0; k < 4; ++k) qf[k] = *(const GAS bf16x8*)(H + (mb + t0 + r32) * D_INP + C_AQ + hh * 64 + 16 * k + 8 * hf);
    const bf16* kbase = KH + ((size_t)(b * 8 + hh) * T) * 64; const bf16* vbase = VT + ((size_t)(b * 512 + hh * 64)) * T; const unsigned* mrow = MASK + (mb + t0 + r32) * 128;
    float m_run = -1e30f, l = 0.f;
    f32x16 O0 = {0.f, 0.f, 0.f, 0.f, 0.f, 0.f, 0.f, 0.f, 0.f, 0.f, 0.f, 0.f, 0.f, 0.f, 0.f, 0.f}, O1 = O0;
    const int nkt = (t0 + 32 + 63) >> 6;
    for (int kt = 0; kt < nkt; ++kt) {
        const int s0 = kt * 64;
        bf16x8 kf[2][4];
#pragma unroll
        for (int uu = 0; uu < 2; ++uu)
#pragma unroll
            for (int k = 0; k < 4; ++k) kf[uu][k] = *(const GAS bf16x8*)(kbase + (size_t)(s0 + 32 * uu + r32) * 64 + 16 * k + 8 * hf);
        const v2u mw = *(const GAS v2u*)(mrow + 2 * kt);
        s16x4 vl[2][2][2], vh[2][2][2];
#pragma unroll
        for (int uu = 0; uu < 2; ++uu)
#pragma unroll
            for (int sp = 0; sp < 2; ++sp)
#pragma unroll
                for (int dt = 0; dt < 2; ++dt) { const bf16* vp = vbase + (size_t)(dt * 32 + r32) * T + s0 + 32 * uu + 16 * sp + 4 * hf;
                    vl[uu][sp][dt] = *(const GAS s16x4*)vp; vh[uu][sp][dt] = *(const GAS s16x4*)(vp + 8); }
        f32x16 a0 = {0.f, 0.f, 0.f, 0.f, 0.f, 0.f, 0.f, 0.f, 0.f, 0.f, 0.f, 0.f, 0.f, 0.f, 0.f, 0.f}, a1 = a0;
#pragma unroll
        for (int k = 0; k < 4; ++k) { a0 = __builtin_amdgcn_mfma_f32_32x32x16_bf16(kf[0][k], qf[k], a0, 0, 0, 0); a1 = __builtin_amdgcn_mfma_f32_32x32x16_bf16(kf[1][k], qf[k], a1, 0, 0, 0); }
        const float dist0 = (float)(t0 + r32 - s0 - 4 * hf);
        const unsigned m0 = mw.x >> (4 * hf), m1 = mw.y >> (4 * hf);
        float mx = -1e30f;
#pragma unroll
        for (int r = 0; r < 16; ++r) { const int ko = (r & 3) + 8 * (r >> 2);
            const float d0 = dist0 - (float)ko;
            a0[r] = ((m0 >> ko) & 1u) ? (a0[r] * c1 - sl2 * d0) : -1e30f;
            a1[r] = ((m1 >> ko) & 1u) ? (a1[r] * c1 - sl2 * (d0 - 32.f)) : -1e30f;
            mx = fmaxf(mx, fmaxf(a0[r], a1[r])); }
        mx = fmaxf(mx, __shfl_xor(mx, 32));
        const float m_new = fmaxf(m_run, mx); const float alpha = __builtin_amdgcn_exp2f(m_run - m_new); m_run = m_new;
        float ps = 0.f;
#pragma unroll
        for (int r = 0; r < 16; ++r) { const int ko = (r & 3) + 8 * (r >> 2);
            const float p0 = ((m0 >> ko) & 1u) ? __builtin_amdgcn_exp2f(a0[r] - m_new) : 0.f;
            const float p1 = ((m1 >> ko) & 1u) ? __builtin_amdgcn_exp2f(a1[r] - m_new) : 0.f;
            a0[r] = p0; a1[r] = p1; ps += p0 + p1; }
        l = l * alpha + ps;
#pragma unroll
        for (int r = 0; r < 16; ++r) { O0[r] *= alpha; O1[r] *= alpha; }
#pragma unroll
        for (int sp = 0; sp < 2; ++sp) {
            const bf16x8 pb0 = pack8(a0, 8 * sp), pb1 = pack8(a1, 8 * sp);
#define VFR(uu, dt) ((bf16x8){vl[uu][sp][dt][0], vl[uu][sp][dt][1], vl[uu][sp][dt][2], vl[uu][sp][dt][3], vh[uu][sp][dt][0], vh[uu][sp][dt][1], vh[uu][sp][dt][2], vh[uu][sp][dt][3]})
            O0 = __builtin_amdgcn_mfma_f32_32x32x16_bf16(VFR(0, 0), pb0, O0, 0, 0, 0);
            O1 = __builtin_amdgcn_mfma_f32_32x32x16_bf16(VFR(0, 1), pb0, O1, 0, 0, 0);
            O0 = __builtin_amdgcn_mfma_f32_32x32x16_bf16(VFR(1, 0), pb1, O0, 0, 0, 0);
            O1 = __builtin_amdgcn_mfma_f32_32x32x16_bf16(VFR(1, 1), pb1, O1, 0, 0, 0);
#undef VFR
        }
    }
    l += __shfl_xor(l, 32);
    const float inv = 1.f / l;
    bf16* yp = YM + (mb + t0 + r32) * D + hh * 64 + 4 * hf;
#pragma unroll
    for (int rq = 0; rq < 4; ++rq) {
        v2u o; o.x = cvtpk(O0[4 * rq] * inv, O0[4 * rq + 1] * inv); o.y = cvtpk(O0[4 * rq + 2] * inv, O0[4 * rq + 3] * inv); *(GAS v2u*)(yp + 8 * rq) = o;
        v2u o2; o2.x = cvtpk(O1[4 * rq] * inv, O1[4 * rq + 1] * inv); o2.y = cvtpk(O1[4 * rq + 2] * inv, O1[4 * rq + 3] * inv); *(GAS v2u*)(yp + 32 + 8 * rq) = o2; }
}
__device__ __forceinline__ void p4_attention(const Params& P, const Ctx& C) {
    unsigned char* ws = P.ws;
    const bf16* H = (const bf16*)(ws + WS_H); const bf16* KH = (const bf16*)(ws + WS_K); const bf16* VT = (const bf16*)(ws + WS_VT); const unsigned* MASK = (const unsigned*)(ws + WS_MASK); bf16* YM = (bf16*)(ws + WS_YMIX);
    for (int p = blockIdx.x; p < 512; p += C.G) {
        const int bh = p >> 3, j = p & 7; const int b = bh >> 3, hh = bh & 7;
        attn_task(H, KH, VT, MASK, YM, b, hh, j * 256 + C.wave * 32, C.lane);
        attn_task(H, KH, VT, MASK, YM, b, hh, (15 - j) * 256 + (7 - C.wave) * 32, C.lane);
    }
}

constexpr int AT_KB = 64 * 144, AT_VB = 64 * 136, AT_VOFF = 2 * AT_KB;
__device__ __forceinline__ void attn_block(const Ctx& C, const bf16* H, const bf16* KH, const bf16* VT, const unsigned* MASK, bf16* YM, int b, int hh, int qb) {
    const int lane = C.lane, r32 = lane & 31, hf = lane >> 5, tid = C.tid;
    const float LOG2E = 1.4426950408889634f; const float c1 = 0.125f * LOG2E; const float sl2 = exp2f(-(float)(hh + 1)) * LOG2E;
    const size_t mb = (size_t)b * T; const int t0 = qb * 256 + C.wave * 32;
    bf16x8 qf[4];
#pragma unroll
    for (int k = 0; k < 4; ++k) { const v4u w = *(const GAS v4u*)(H + (mb + t0 + r32) * D_INP + C_AQ + hh * 64 + 16 * k + 8 * hf);
        v4u o; o.x = cvtpk(bflo(w.x) * c1, bfhi(w.x) * c1); o.y = cvtpk(bflo(w.y) * c1, bfhi(w.y) * c1); o.z = cvtpk(bflo(w.z) * c1, bfhi(w.z) * c1); o.w = cvtpk(bflo(w.w) * c1, bfhi(w.w) * c1);
        qf[k] = __builtin_bit_cast(bf16x8, o); }
    const bf16* kbase = KH + ((size_t)(b * 8 + hh) * T) * 64; const bf16* vbase = VT + ((size_t)(b * 512 + hh * 64)) * T; const unsigned* mrow = MASK + (mb + t0 + r32) * 128;
    const int srow = tid >> 3, sch = tid & 7;
    const bf16* kst = kbase + (size_t)srow * 64 + 8 * sch; const bf16* vst = vbase + (size_t)srow * T + 8 * sch;
    LAS unsigned char* kw = C.lds + srow * 144 + 16 * sch; LAS unsigned char* vw = C.lds + AT_VOFF + srow * 136 + 16 * sch;
    const LAS unsigned char* kr = C.lds + r32 * 144 + 16 * hf; const LAS unsigned char* vr = C.lds + AT_VOFF + r32 * 136 + 8 * hf;
    float m_run = -1e30f, l = 0.f;
    f32x16 O0 = {0.f, 0.f, 0.f, 0.f, 0.f, 0.f, 0.f, 0.f, 0.f, 0.f, 0.f, 0.f, 0.f, 0.f, 0.f, 0.f}, O1 = O0;
    const int nkt = 4 * (qb + 1), ktw = (t0 + 31) >> 6;
    v4u kn = *(const GAS v4u*)kst, vn = *(const GAS v4u*)vst; v2u mwn = *(const GAS v2u*)mrow;
    *(LAS v4u*)kw = kn; *(LAS v2u*)vw = (v2u){vn.x, vn.y}; *(LAS v2u*)(vw + 8) = (v2u){vn.z, vn.w};
    __syncthreads();
    for (int kt = 0; kt < nkt; ++kt) {
        const int s0 = kt * 64; const int cur = kt & 1; const v2u mw = mwn;
        if (kt + 1 < nkt) { kn = *(const GAS v4u*)(kst + (size_t)(s0 + 64) * 64); vn = *(const GAS v4u*)(vst + s0 + 64); mwn = *(const GAS v2u*)(mrow + 2 * kt + 2); }
        if (kt <= ktw) {
            const LAS unsigned char* kc = kr + cur * AT_KB; const LAS unsigned char* vc = vr + cur * AT_VB;
            const float B0 = -sl2 * (float)(t0 + r32 - s0 - 4 * hf);
            f32x16 a0, a1;
#pragma unroll
            for (int r = 0; r < 16; ++r) { const float ko = (float)((r & 3) + 8 * (r >> 2)); a0[r] = B0 + sl2 * ko; a1[r] = B0 + sl2 * (ko + 32.f); }
#pragma unroll
            for (int k = 0; k < 4; ++k) { const bf16x8 k0 = *(const LAS bf16x8*)(kc + 32 * k), k1 = *(const LAS bf16x8*)(kc + 32 * 144 + 32 * k);
                a0 = __builtin_amdgcn_mfma_f32_32x32x16_bf16(k0, qf[k], a0, 0, 0, 0); a1 = __builtin_amdgcn_mfma_f32_32x32x16_bf16(k1, qf[k], a1, 0, 0, 0); }
            const unsigned m0 = mw.x >> (4 * hf), m1 = mw.y >> (4 * hf);
            float mx = -1e30f;
#pragma unroll
            for (int r = 0; r < 16; ++r) { const int ko = (r & 3) + 8 * (r >> 2);
                const unsigned k0m = (unsigned)__builtin_amdgcn_sbfe((int)m0, ko, 1), k1m = (unsigned)__builtin_amdgcn_sbfe((int)m1, ko, 1);
                const float x0 = a0[r], x1 = a1[r];
                a0[r] = __builtin_bit_cast(float, (__builtin_bit_cast(unsigned, x0) & k0m) | (0xf149f2cau & ~k0m));
                a1[r] = __builtin_bit_cast(float, (__builtin_bit_cast(unsigned, x1) & k1m) | (0xf149f2cau & ~k1m));
                mx = fmaxf(mx, fmaxf(a0[r], a1[r])); }
            mx = fmaxf(mx, __shfl_xor(mx, 32));
            const float m_new = fmaxf(m_run, mx);
            const float m_use = fmaxf(m_new, -1e20f);
            float ps = 0.f;
#pragma unroll
            for (int r = 0; r < 16; ++r) { const float p0 = __builtin_amdgcn_exp2f(a0[r] - m_use), p1 = __builtin_amdgcn_exp2f(a1[r] - m_use); a0[r] = p0; a1[r] = p1; ps += p0 + p1; }
            if (__builtin_amdgcn_ballot_w64(m_new != m_run) != 0ull) {
                const float alpha = __builtin_amdgcn_exp2f(m_run - m_new); m_run = m_new;
                l *= alpha;
#pragma unroll
                for (int r = 0; r < 16; ++r) { O0[r] *= alpha; O1[r] *= alpha; }
            }
            l += ps;
#pragma unroll
            for (int sp = 0; sp < 2; ++sp) {
                const bf16x8 pb0 = pack8(a0, 8 * sp), pb1 = pack8(a1, 8 * sp);
#define VLD(uu, dt) ({ const s16x4 lo_ = *(const LAS s16x4*)(vc + (dt) * 32 * 136 + 2 * (32 * (uu) + 16 * sp)), hi_ = *(const LAS s16x4*)(vc + (dt) * 32 * 136 + 2 * (32 * (uu) + 16 * sp + 8)); (bf16x8){lo_[0], lo_[1], lo_[2], lo_[3], hi_[0], hi_[1], hi_[2], hi_[3]}; })
                O0 = __builtin_amdgcn_mfma_f32_32x32x16_bf16(VLD(0, 0), pb0, O0, 0, 0, 0);
                O1 = __builtin_amdgcn_mfma_f32_32x32x16_bf16(VLD(0, 1), pb0, O1, 0, 0, 0);
                O0 = __builtin_amdgcn_mfma_f32_32x32x16_bf16(VLD(1, 0), pb1, O0, 0, 0, 0);
                O1 = __builtin_amdgcn_mfma_f32_32x32x16_bf16(VLD(1, 1), pb1, O1, 0, 0, 0);
#undef VLD
            }
        }
        if (kt + 1 < nkt) { const int nx = cur ^ 1; *(LAS v4u*)(kw + nx * AT_KB) = kn; *(LAS v2u*)(vw + nx * AT_VB) = (v2u){vn.x, vn.y}; *(LAS v2u*)(vw + nx * AT_VB + 8) = (v2u){vn.z, vn.w}; }
        __syncthreads();
    }
    l += __shfl_xor(l, 32);
    const float inv = 1.f / l;
    unsigned char* yp = (unsigned char*)YM + (mb + t0 + r32) * D + hh * 64 + 4 * hf;
    const float i8 = inv * 8.f;
#pragma unroll
    for (int rq = 0; rq < 4; ++rq) {
        *(GAS unsigned*)(yp + 8 * rq) = pk4_fp8(O0[4 * rq] * i8, O0[4 * rq + 1] * i8, O0[4 * rq + 2] * i8, O0[4 * rq + 3] * i8);
        *(GAS unsigned*)(yp + 32 + 8 * rq) = pk4_fp8(O1[4 * rq] * i8, O1[4 * rq + 1] * i8, O1[4 * rq + 2] * i8, O1[4 * rq + 3] * i8); }
}
__device__ __forceinline__ void p4_attention2(const Params& P, const Ctx& C) {
    unsigned char* ws = P.ws;
    const bf16* H = (const bf16*)(ws + WS_H); const bf16* KH = (const bf16*)(ws + WS_K); const bf16* VT = (const bf16*)(ws + WS_VT); const unsigned* MASK = (const unsigned*)(ws + WS_MASK); bf16* YM = (bf16*)(ws + WS_YMIX);
    for (int p = blockIdx.x; p < 512; p += C.G) {
        const int b = p & 7, q = p >> 3; const int hh = q >> 3, j = q & 7;
        attn_block(C, H, KH, VT, MASK, YM, b, hh, j);
        attn_block(C, H, KH, VT, MASK, YM, b, hh, 15 - j);
    }
}

#ifndef FEAT_MIX
#define FEAT_MIX 1
#endif
#ifndef FEAT_MOE
#define FEAT_MOE 1
#endif
#ifndef FEAT_PLE
#define FEAT_PLE 1
#endif
#ifndef FEAT_ATT
#define FEAT_ATT 1
#endif

template <bool PUBLISH = true> __device__ __forceinline__ void p6_ln1_router(const Params& P, const Ctx& C) {
    unsigned char* ws = P.ws;
    bf16* X1 = (bf16*)(ws + WS_X1); unsigned char* XB = ws + WS_XB;
    LAS float* wl = (LAS float*)C.lds;
    LAS int* hist = (LAS int*)(C.lds + MISC_OFF);
    { const float* wrt = (const float*)(ws + WS_WRT);
      for (int i = C.tid; i < 32 * 1024 / 4; i += NTHR) *(LAS f32x4*)(wl + 4 * i) = *(const GAS f32x4*)(wrt + 4 * i);
      if (C.tid < 32) hist[C.tid] = 0; }
    __syncthreads();
    int* tope = (int*)(ws + WS_TOPE); float* gate = (float*)(ws + WS_GATE); int* lrank = (int*)(ws + WS_LRANK);
    const bf16* src = (const bf16*)P.out;
    const int lane = C.lane, hf = lane >> 5, ex = lane & 31;
    const float brl = P.in[I_BR][ex];
    for (int m0 = 2 * C.gw; m0 < NTOK; m0 += 2 * C.ngw) {
        f32x4 va[4], vb[4]; load_row_bf16(va, src + (size_t)m0 * D, lane); load_row_bf16(vb, src + (size_t)(m0 + 1) * D, lane);
        ln_row(va, P.in[I_LNMG], P.in[I_LNMB], lane); ln_row(vb, P.in[I_LNMG], P.in[I_LNMB], lane);
        store_row_bf16(X1 + (size_t)m0 * D, va, lane); store_row_bf16(X1 + (size_t)(m0 + 1) * D, vb, lane);
        store_row_fp8x8(XB + (size_t)m0 * D, va, lane); store_row_fp8x8(XB + (size_t)(m0 + 1) * D, vb, lane);
        float v[32];
#pragma unroll
        for (int e = 0; e < 32; ++e) { float pa = 0.f, pb = 0.f;
#pragma unroll
            for (int j = 0; j < 4; ++j) { const f32x4 w = *(const LAS f32x4*)(wl + e * 1024 + 4 * lane + 256 * j);
                pa += (va[j][0] * w[0] + va[j][1] * w[1]) + (va[j][2] * w[2] + va[j][3] * w[3]); pb += (vb[j][0] * w[0] + vb[j][1] * w[1]) + (vb[j][2] * w[2] + vb[j][3] * w[3]); }
            const float keep = hf ? pb : pa, send = hf ? pa : pb; v[e] = keep + __shfl_xor(send, 32); }
#define HALVE(M, CNT) { const bool up_ = (lane & (M)) != 0; _Pragma("unroll") for (int i_ = 0; i_ < (CNT) / 2; ++i_) { const float k_ = up_ ? v[i_ + (CNT) / 2] : v[i_], s_ = up_ ? v[i_] : v[i_ + (CNT) / 2]; v[i_] = k_ + __shfl_xor(s_, (M)); } }
        HALVE(16, 32) HALVE(8, 16) HALVE(4, 8) HALVE(2, 4) HALVE(1, 2)
#undef HALVE
        float lg = v[0] + brl;
        int se[4]; float sv[4];
#pragma unroll
        for (int k = 0; k < 4; ++k) { float bv = lg; int bi = ex;
#pragma unroll
            for (int o = 1; o < 32; o <<= 1) { const float ov = __shfl_xor(bv, o); const int oi = __shfl_xor(bi, o); const bool take = (ov > bv) || (ov == bv && oi < bi); bv = take ? ov : bv; bi = take ? oi : bi; }
            se[k] = bi; sv[k] = bv; if (ex == bi) lg = -INFINITY; }
        float exv[4], sum = 0.f;
#pragma unroll
        for (int k = 0; k < 4; ++k) { exv[k] = __expf(sv[k] - sv[0]); sum += exv[k]; }
        const float inv = 1.f / sum;
        if (ex == 0) { const int m = m0 + hf;
#pragma unroll
            for (int k = 0; k < 4; ++k) { const int lr = atomicAdd((int*)&hist[se[k]], 1); tope[m * 4 + k] = se[k]; gate[m * 4 + k] = exv[k] * inv; lrank[m * 4 + k] = lr; } }
    }
    __syncthreads();
    if (PUBLISH && C.tid < 32) { unsigned* cnt = (unsigned*)(ws + WS_CTL) + CW_CNT; const int base = (int)atomicAdd(cnt + C.tid, (unsigned)hist[C.tid]); ((int*)(ws + WS_WGBASE))[blockIdx.x * 32 + C.tid] = base; }
}

__device__ __forceinline__ void p7_dispatch(const Params& P, const Ctx& C) {
    unsigned char* ws = P.ws;
    LAS int* ps = (LAS int*)(C.lds + MISC_OFF + 256);
    const unsigned* cnt = (const unsigned*)(ws + WS_CTL) + CW_CNT;
    int* tile_e = (int*)(ws + WS_TILEE);
    if (C.tid == 0) { int run = 0;
        for (int e = 0; e < NE; ++e) { const int c = (int)__hip_atomic_load(cnt + e, __ATOMIC_RELAXED, __HIP_MEMORY_SCOPE_AGENT); ps[e] = run; const int nt = (c + 255) >> 8;
            if (blockIdx.x == 0) for (int t = 0; t < nt; ++t) tile_e[(run >> 8) + t] = e;
            run += nt << 8; }
        if (blockIdx.x == 0) tile_e[MAXTILES] = run >> 8; }
    __syncthreads();
    const int* tope = (const int*)(ws + WS_TOPE); const float* gate = (const float*)(ws + WS_GATE); const int* lrank = (const int*)(ws + WS_LRANK);
    const int* wgb = (const int*)(ws + WS_WGBASE);
    int* tokslot = (int*)(ws + WS_TOKSLOT); float* slotgate = (float*)(ws + WS_SLOTGATE);
    const bf16* XB = (const bf16*)(ws + WS_XB); unsigned char* xs = ws + WS_XS;
    for (int m = C.gw; m < NTOK; m += C.ngw) {
        const int wgm = ((m >> 1) % C.ngw) >> 3;
        const v4u f8 = *(const GAS v4u*)((const unsigned char*)XB + (size_t)m * D + 16 * C.lane);
#pragma unroll
        for (int k = 0; k < 4; ++k) { const int e = tope[m * 4 + k]; const int slot = ps[e] + wgb[wgm * 32 + e] + lrank[m * 4 + k];
            *(GAS v4u*)(xs + (size_t)slot * D + 16 * C.lane) = f8;
            if (C.lane == 0) { slotgate[slot] = gate[m * 4 + k]; tokslot[m * 4 + k] = slot; } }
    }
}

__device__ __forceinline__ void p10_combine_ln2(const Params& P, const Ctx& C) {
    unsigned char* ws = P.ws;
    const bf16* X1 = (const bf16*)(ws + WS_X1); bf16* XB = (bf16*)(ws + WS_XB); bf16* X2 = (bf16*)P.out;
    const int* tokslot = (const int*)(ws + WS_TOKSLOT); const bf16* ys = (const bf16*)(ws + WS_YSLOT);
    for (int m = C.gw; m < NTOK; m += C.ngw) {
        f32x4 v[4]; load_row_bf16(v, X1 + (size_t)m * D, C.lane);
#pragma unroll
        for (int j = 0; j < 4; ++j) v[j] = v[j] * ALPHA;
#if FEAT_MOE
#pragma unroll
        for (int k = 0; k < 4; ++k) { const int slot = tokslot[m * 4 + k]; const bf16* yr = ys + (size_t)slot * D;
#pragma unroll
            for (int j = 0; j < 4; ++j) { const v2u w = *(const GAS v2u*)(yr + 4 * C.lane + 256 * j); v[j][0] += bflo(w.x); v[j][1] += bfhi(w.x); v[j][2] += bflo(w.y); v[j][3] += bfhi(w.y); } }
#endif
        ln_row(v, P.in[I_LNFG], P.in[I_LNFB], C.lane);
        store_row_bf16(X2 + (size_t)m * D, v, C.lane);
        store_row_fp8x8((unsigned char*)XB + (size_t)m * D, v, C.lane);
    }
}

__device__ __forceinline__ void p12_final_ln(const Params& P, const Ctx& C) {
    const bf16* src = (const bf16*)(P.ws + WS_X1);
    for (int m = C.gw; m < NTOK; m += C.ngw) {
        f32x4 v[4]; load_row_bf16(v, src + (size_t)m * D, C.lane);
        ln_row(v, P.in[I_LNPG], P.in[I_LNPB], C.lane);
        store_row_f32(P.out + (size_t)m * D, v, C.lane);
    }
}
#define XB_TMO      128
#define XB_XCNT(j)  (256  + 64 * (j))
#define XB_XSUB(j)  (1280 + 64 * (j))
#define XB_XGEN(j)  (2304 + 64 * (j))
#define XB_TOP      3328
#define XB_TOPGEN   3392
#define XCD_BAR_WORDS 3456
#define XB_SPIN_CAP (1u << 18)
#define LAS __attribute__((address_space(3)))

__device__ __forceinline__ unsigned xb_ld(unsigned* p)              { return __hip_atomic_load(p, __ATOMIC_RELAXED, __HIP_MEMORY_SCOPE_AGENT); }
__device__ __forceinline__ unsigned xb_add(unsigned* p, unsigned v) { return __hip_atomic_fetch_add(p, v, __ATOMIC_RELAXED, __HIP_MEMORY_SCOPE_AGENT); }
__device__ __forceinline__ unsigned xb_xcc_id() { return (unsigned)__builtin_amdgcn_s_getreg((3 << 11) | 20) & 0xFu; }
#define XB_SPIN(cond, bar) do { unsigned _sp = 0; while (cond) { __builtin_amdgcn_s_sleep(1); \
    if ((++_sp & 255u) == 0u) { if (xb_ld(&(bar)[XB_TMO])) break; if (_sp > XB_SPIN_CAP) { atomicAdd(&(bar)[XB_TMO], 1u); break; } } } } while (0)

struct XcdBarrier {
    unsigned* bar; unsigned x;
    volatile LAS unsigned* st;
};

__device__ __forceinline__ XcdBarrier xcd_barrier_post(unsigned* bar, volatile LAS unsigned* st) {
    XcdBarrier b; b.bar = bar; b.x = xb_xcc_id(); b.st = st;
    if (threadIdx.x == 0) (void)xb_add(&bar[XB_XCNT(b.x)], 1u);
    return b;
}
__device__ __forceinline__ void xcd_barrier_complete(unsigned* bar, unsigned x, unsigned& nloc, unsigned& nx) {
    const unsigned G = gridDim.x * gridDim.y * gridDim.z;
    unsigned sum, cnt, mine, sp = 0u;
    for (;;) {
        sum = 0u; cnt = 0u; mine = 0u;
#pragma unroll
        for (unsigned j = 0; j < 16; ++j) { const unsigned c = xb_ld(&bar[XB_XCNT(j)]); sum += c; cnt += (c > 0u) ? 1u : 0u; mine = (j == x) ? c : mine; }
        if (sum == G) break;
        __builtin_amdgcn_s_sleep(1);
        if ((++sp & 255u) == 0u) { if (xb_ld(&bar[XB_TMO])) break; if (sp > XB_SPIN_CAP) { atomicAdd(&bar[XB_TMO], 1u); break; } }
    }
    nloc = mine > 0u ? mine : 1u; nx = cnt > 0u ? cnt : 1u;
}

__device__ __forceinline__ void xcd_barrier(const XcdBarrier& b) {
    asm volatile("s_waitcnt vmcnt(0)" ::: "memory");
    __syncthreads();
    if (threadIdx.x == 0) {
        unsigned* bar = b.bar;
        __builtin_amdgcn_s_waitcnt(0);
        unsigned nloc = b.st[0], nx = b.st[1];
        if (nloc == 0u) { xcd_barrier_complete(bar, b.x, nloc, nx); b.st[0] = nloc; b.st[1] = nx; }
        const unsigned old = xb_add(&bar[XB_XSUB(b.x)], 1u);
        const unsigned gen = old / nloc;
        if (old + 1u == (gen + 1u) * nloc) {
            __builtin_amdgcn_fence(__ATOMIC_RELEASE, "agent");
            asm volatile("s_waitcnt vmcnt(0)" ::: "memory");
            const unsigned og = xb_add(&bar[XB_TOP], 1u);
            const unsigned tg = og / nx;
            if (og + 1u == (tg + 1u) * nx) xb_add(&bar[XB_TOPGEN], 1u);
            else XB_SPIN(xb_ld(&bar[XB_TOPGEN]) == tg, bar);
            __builtin_amdgcn_fence(__ATOMIC_ACQUIRE, "agent");
            xb_add(&bar[XB_XGEN(b.x)], 1u);
            asm volatile("s_waitcnt vmcnt(0)" ::: "memory");
        } else {
            XB_SPIN(xb_ld(&bar[XB_XGEN(b.x)]) == gen, bar);
            __builtin_amdgcn_fence(__ATOMIC_ACQUIRE, "agent");
            asm volatile("s_waitcnt vmcnt(0)" ::: "memory");
        }
    }
    __syncthreads();
}


template <int PH> __device__ __forceinline__ void run_phase(const Params& P, const Ctx& C) {
    unsigned char* ws = P.ws;
    typedef pg8::bf16_t pbf;
    if constexpr (PH == 0) { p0_prologue(P, C); }
    else if constexpr (PH == 10) {
        pg8::Gemm g{(const pbf*)(ws + WS_XBF), (const pbf*)(ws + WS_WIN_T), NTOK, D_INP, D}; pg8::StaticOrder S; S.init(NTOK, D_INP, C.G, (int)blockIdx.x);
        pg8::EpiBf16s E{(pbf*)(ws + WS_H), D_INP};
        pg8::gemm_phase<pg8::EpiBf16s, pg8::StaticOrder, true, true>(C.lds, g, S, E); }
    else if constexpr (PH == 11) {
        pg8::Gemm g{(const pbf*)(ws + WS_PB), (const pbf*)(ws + WS_WPROJ_T), NTOK, D, PLE}; pg8::StaticOrder S; S.init(NTOK, D, C.G, (int)blockIdx.x);
        pg8::EpiBf16s E{(pbf*)(ws + WS_PROJ), D};
        pg8::gemm_phase<pg8::EpiBf16s, pg8::StaticOrder, true, true>(C.lds, g, S, E); }
    else if constexpr (PH == 20) { p2_post(P, C); }
    else if constexpr (PH == 21) { p2_hgrn_prep(P, C); }
    else if constexpr (PH == 30) {
        { pg8::Gemm g{(const pbf*)(ws + WS_CN), (const pbf*)(ws + WS_WUK_T), NTOK, 512, 256}; pg8::StaticOrder S; S.init(NTOK, 512, C.G, (int)blockIdx.x);
          pg8::EpiKhead E{(pbf*)(ws + WS_K)};
          pg8::gemm_phase<pg8::EpiKhead, pg8::StaticOrder, true, true>(C.lds, g, S, E); }
        { pg8::Gemm g{(const pbf*)(ws + WS_WUV_T), (const pbf*)(ws + WS_CN), 512, NTOK, 256}; pg8::StaticOrder S; S.init(512, NTOK, C.G, (int)blockIdx.x);
          pg8::EpiVt E{(pbf*)(ws + WS_VT)};
          pg8::gemm_phase<pg8::EpiVt, pg8::StaticOrder, true, true>(C.lds, g, S, E); }
    }
    else if constexpr (PH == 31) { p3_indexer(P, C); }
    else if constexpr (PH == 32) { p3_hgrn_scan(P, C); }
    else if constexpr (PH == 40) { p4_attention2(P, C); }
    else if constexpr (PH == 41) { p4_yrec(P, C); }
    else if constexpr (PH == 5) {
        pg8::Gemm g{(const pbf*)(ws + WS_YMIX), (const pbf*)(ws + WS_WO_T), NTOK, D, D / 2}; pg8::StaticOrder S; S.init(NTOK, D, C.G, (int)blockIdx.x);
        pg8::EpiResid E{P.in[I_X], (pbf*)P.out, D, ALPHA, 1.f / 512.f};
        pg8::gemm_phase<pg8::EpiResid, pg8::StaticOrder, true, true, 1>(C.lds, g, S, E);
    }
    else if constexpr (PH == 6) { p6_ln1_router<true>(P, C); }
    else if constexpr (PH == 60) { p6_ln1_router<false>(P, C); }
    else if constexpr (PH == 7) { p7_dispatch(P, C); }
    else if constexpr (PH == 8) {
        const int* tile_e = (const int*)(ws + WS_TILEE);
        pg8::Gemm g{(const pbf*)(ws + WS_XS), (const pbf*)(ws + WS_WUP_T), CAP, NE * 2048, D / 2};
        pg8::MoeOrder S{tile_e, tile_e[MAXTILES], 8, C.G, (int)blockIdx.x};
        pg8::EpiSwiglu E{ws + WS_HH, P.in[I_BUP]};
        pg8::gemm_phase<pg8::EpiSwiglu, pg8::MoeOrder, true, true, 1, 124, 121>(C.lds, g, S, E);
    }
    else if constexpr (PH == 9) {
        const int* tile_e = (const int*)(ws + WS_TILEE);
        pg8::Gemm g{(const pbf*)(ws + WS_HH), (const pbf*)(ws + WS_WDN_T), CAP, NE * 1024, DFF / 2};
        pg8::MoeOrder S{tile_e, tile_e[MAXTILES], 4, C.G, (int)blockIdx.x};
        pg8::EpiDown E{(pbf*)(ws + WS_YSLOT), P.in[I_BDN], (const float*)(ws + WS_SLOTGATE)};
        pg8::gemm_phase<pg8::EpiDown, pg8::MoeOrder, true, true, 1, 125, 121>(C.lds, g, S, E);
    }
    else if constexpr (PH == 100) { p10_combine_ln2(P, C); }
    else if constexpr (PH == 110) {
        pg8::Gemm g{(const pbf*)(ws + WS_XB), (const pbf*)(ws + WS_WGATE_T), NTOK, D, D / 2}; pg8::StaticOrder S; S.init(NTOK, D, C.G, (int)blockIdx.x);
        pg8::EpiPle E{(const pbf*)P.out, (const pbf*)(ws + WS_PROJ), (pbf*)(ws + WS_X1), ALPHA, 1.f / 512.f};
        pg8::gemm_phase<pg8::EpiPle, pg8::StaticOrder, true, true, 1>(C.lds, g, S, E);
    }
    else { p12_final_ln(P, C); }
}
__global__ void __launch_bounds__(NTHR, 2) mega_fwd(Params P) {
    extern __shared__ __attribute__((aligned(16))) unsigned char lds_raw[];
    cg::grid_group grid = cg::this_grid();
#define MKCTX Ctx C; { int tid_ = threadIdx.x; asm volatile("" : "+v"(tid_)); C.lds = (LAS unsigned char*)lds_raw; C.tid = tid_; C.lane = tid_ & 63; C.wave = __builtin_amdgcn_readfirstlane(tid_ >> 6); \
      C.G = gridDim.x; C.gw = blockIdx.x * NWAVES + C.wave; C.ngw = C.G * NWAVES; }
#if SYNC_MODE != 0
    if (threadIdx.x < 4) ((LAS unsigned*)((LAS unsigned char*)lds_raw + XBW_OFF))[threadIdx.x] = 0u;
    __syncthreads();
    XcdBarrier bar = xcd_barrier_post((unsigned*)(P.ws + WS_CTL) + CW_BAR, (volatile LAS unsigned*)((LAS unsigned char*)lds_raw + XBW_OFF));
#define SY xcd_barrier(bar);
#else
#define SY grid.sync();
#endif
#define GS grid.sync();
#define BS __syncthreads();
#define X(k) { MKCTX run_phase<k>(P, C); }
    PROGRAM
#undef X
#undef MKCTX
#undef SY
#undef GS
#undef BS
}

extern "C" void kernel_launch(void* const* d_in, const int* in_sizes, int n_in, void* d_out, int out_size, void* d_ws, size_t ws_size, hipStream_t stream) {
    static int grid = 0;
    if (grid == 0) {
        if (n_in != 25 || out_size != NTOK * D || ws_size < WS_END) { fprintf(stderr, "kernel_launch: unexpected shapes (n_in %d out %d ws %zu)\n", n_in, out_size, ws_size); grid = -1; return; }
        int dev = 0, cus = 0, per_cu = 0;
        if (hipGetDevice(&dev) != hipSuccess || hipDeviceGetAttribute(&cus, hipDeviceAttributeMultiprocessorCount, dev) != hipSuccess) { grid = -1; return; }
        if (hipFuncSetAttribute((const void*)mega_fwd, hipFuncAttributeMaxDynamicSharedMemorySize, LDS_BYTES) != hipSuccess) { fprintf(stderr, "kernel_launch: hipFuncSetAttribute failed\n"); grid = -1; return; }
        if (hipOccupancyMaxActiveBlocksPerMultiprocessor(&per_cu, (const void*)mega_fwd, NTHR, LDS_BYTES) != hipSuccess || per_cu < 1) { fprintf(stderr, "kernel_launch: occupancy query failed (%d)\n", per_cu); (void)hipGetLastError(); grid = -1; return; }
        grid = cus * per_cu;
        fprintf(stderr, "kernel_launch: grid %d (%d CUs x %d)\n", grid, cus, per_cu);
    }
    if (grid < 0) return;
    (void)hipMemsetAsync((char*)d_ws + WS_CTL, 0, CTL_ZERO_BYTES, stream);
    Params p{};
    for (int i = 0; i < 25; ++i) p.in[i] = (const float*)d_in[i];
    p.out = (float*)d_out; p.ws = (unsigned char*)d_ws;

    void* args[] = {&p};
    hipError_t e = hipLaunchCooperativeKernel((const void*)mega_fwd, dim3(grid), dim3(NTHR), args, LDS_BYTES, stream);
    if (e != hipSuccess) fprintf(stderr, "kernel_launch: cooperative launch failed: %s (grid %d)\n", hipGetErrorString(e), grid);
}
```

```cpp
#define SYNC_MODE 1
#include <hip/hip_runtime.h>
#include <hip/hip_cooperative_groups.h>
#include <cstdio>
#include <cstdint>
namespace cg = cooperative_groups;

namespace pg8 {
#define PG8_LAS __attribute__((address_space(3)))
typedef unsigned short bf16_t;
typedef short bf16x8 __attribute__((ext_vector_type(8)));
typedef float f32x4 __attribute__((ext_vector_type(4)));
typedef unsigned u32x4 __attribute__((ext_vector_type(4)));
typedef int i32x4 __attribute__((ext_vector_type(4)));
typedef int i32x8 __attribute__((ext_vector_type(8)));
constexpr int BM = 256, BK = 64, HALF = 128, HTB = HALF * BK * 2  , STAGE_BYTES = 8 * HTB, NXCD = 8, WGM = 8;

__host__ __device__ __forceinline__ int lds_byte(int r, int c) { const int st = (r >> 4) * 2 + (c >> 5), rr = r & 15, cc = c & 31, ob = rr * 64 + cc * 2; return st * 1024 + (ob ^ (((ob >> 9) & 1) << 5)); }
__host__ __device__ __forceinline__ void stage_rc(int b, int& R, int& C) { const int st = b / 1024, sb = b % 1024, swz = sb ^ (((sb >> 9) & 1) << 5); R = (st >> 1) * 16 + swz / 64; C = (st & 1) * 32 + (swz % 64) / 2; }
__host__ __device__ __forceinline__ int perm32(int rho) { const int n = rho >> 4, i = rho & 15; return 8 * (i >> 2) + 4 * n + (i & 3); }

struct Unit { int pm, pn; };
struct Gemm { const bf16_t* A; const bf16_t* Bt; int M, N, K; };

struct StaticOrder {
    int nM, nN, nwg, G, c;
    __host__ __device__ void init(int M, int N, int G_, int c_) { nM = M / BM; nN = N / BM; nwg = nM * nN; G = G_; c = c_; }
    __host__ __device__ bool next(int i, Unit& u) const {
        const long L = (long)i * G + c; if (L >= nwg) return false;
        int wgid = (int)L; { const int q = nwg / NXCD, r = nwg % NXCD, xcd = wgid % NXCD, off = wgid / NXCD; wgid = (xcd < r ? xcd * (q + 1) : r * (q + 1) + (xcd - r) * q) + off; }
        const int nig = WGM * nN, gid = wgid / nig, fm = gid * WGM, gsz = (nM - fm) < WGM ? (nM - fm) : WGM;
        u.pm = fm + ((wgid % nig) % gsz); u.pn = (wgid % nig) / gsz; return true;
    }
    __device__ __forceinline__ void a_ready(const Unit&) const {}
    __device__ __forceinline__ void done(const Unit&) const {}
};

__device__ __forceinline__ unsigned cvt_pk_bf16(float lo, float hi) { unsigned r; asm volatile("v_cvt_pk_bf16_f32 %0, %1, %2" : "=v"(r) : "v"(lo), "v"(hi)); return r; }
typedef float f32x2 __attribute__((ext_vector_type(2)));
template <class Epi, class Sched, bool ALIGN_EPI = false, bool SP2 = false, int F8 = 0, int F8SA = 127, int F8SB = 127>
__device__ __forceinline__ void gemm_phase(PG8_LAS unsigned char* lds, const Gemm g, const Sched& S, const Epi& E) {
    const int tid = threadIdx.x, wid = __builtin_amdgcn_readfirstlane(tid >> 6), lane = tid & 63, wr = wid >> 2, wc = wid & 3, fr = lane & 15, fq = lane >> 4;
    const int K = g.K, nt = K / BK;
    unsigned voffA[2], voffB[2];
#pragma unroll
    for (int i = 0; i < 2; ++i) { int R, C; stage_rc(tid * 16 + i * 8192, R, C); const int Rb = Epi::PERM ? ((R & ~31) + perm32(R & 31)) : R;
        voffA[i] = (unsigned)(R * K + C) * 2u; voffB[i] = (unsigned)(Rb * K + C) * 2u; }
    const size_t kstep = (size_t)(BK * 2);
    const size_t hstep = (size_t)HALF * K * 2;
    const size_t tstep = 2 * hstep;
    const unsigned ldsw = (unsigned)wid * 1024u;
    const int aoff = lds_byte(wr * 64 + fr, fq * 8), boff = lds_byte(wc * 32 + fr, fq * 8);
#define PG8_SA(b, h) (((b) * 2 + (h)) * HTB)
#define PG8_SB(b, h) ((4 + (b) * 2 + (h)) * HTB)
#define PG8_STAGE(bufoff, gbase, voff) do { _Pragma("unroll") for (int _i = 0; _i < 2; ++_i) \
        __builtin_amdgcn_global_load_lds((const unsigned*)((const char*)(gbase) + (voff)[_i]), (PG8_LAS unsigned*)(lds + (bufoff) + ldsw + _i * 8192), 16, 0, 0); } while (0)
#define PG8_LDA(dst, b, h) do { _Pragma("unroll") for (int m = 0; m < 4; ++m) { dst[m].lo = *(const PG8_LAS i32x4*)(lds + PG8_SA(b, h) + aoff + m * 2048); dst[m].hi = *(const PG8_LAS i32x4*)(lds + PG8_SA(b, h) + aoff + m * 2048 + 1024); } } while (0)
#define PG8_LDB(dst, b, h) do { _Pragma("unroll") for (int n = 0; n < 2; ++n) { dst[n].lo = *(const PG8_LAS i32x4*)(lds + PG8_SB(b, h) + boff + n * 2048); dst[n].hi = *(const PG8_LAS i32x4*)(lds + PG8_SB(b, h) + boff + n * 2048 + 1024); } } while (0)
#define PG8_MMA(ai, bj, At, Bt) do { __builtin_amdgcn_s_setprio(1); \
        if constexpr (F8 == 0) { _Pragma("unroll") for (int m = 0; m < 4; ++m) _Pragma("unroll") for (int n = 0; n < 2; ++n) { \
            const i32x4 bl_ = Bt[n].lo, bh_ = Bt[n].hi, al_ = At[m].lo, ah_ = At[m].hi;     \
            acc[ai][bj][m][n] = __builtin_amdgcn_mfma_f32_16x16x32_bf16(__builtin_bit_cast(bf16x8, bl_), __builtin_bit_cast(bf16x8, al_), acc[ai][bj][m][n], 0, 0, 0); \
            acc[ai][bj][m][n] = __builtin_amdgcn_mfma_f32_16x16x32_bf16(__builtin_bit_cast(bf16x8, bh_), __builtin_bit_cast(bf16x8, ah_), acc[ai][bj][m][n], 0, 0, 0); } } \
        else { _Pragma("unroll") for (int m = 0; m < 4; ++m) _Pragma("unroll") for (int n = 0; n < 2; ++n) \
            asm volatile("v_mfma_f32_16x16x128_f8f6f4 %0, %1, %2, %0" : "+v"(acc[ai][bj][m][n]) : "v"(Bt[n]), "v"(At[m])); } \
        __builtin_amdgcn_s_setprio(0); } while (0)
#define PG8_WAIT_V(n) asm volatile("s_waitcnt vmcnt(" #n ")" ::: "memory")
#define PG8_WAIT_L(n) asm volatile("s_waitcnt lgkmcnt(" #n ")" ::: "memory")
#define PG8_BAR __builtin_amdgcn_s_barrier()
#define PG8_SCHED __builtin_amdgcn_sched_barrier(0)
    Unit cur, nxt; int ui = 0;
    if (!S.next(0, cur)) return;
    f32x4 acc[2][2][4][2];
#pragma unroll
    for (int a = 0; a < 2; ++a)
#pragma unroll
        for (int b = 0; b < 2; ++b)
#pragma unroll
            for (int m = 0; m < 4; ++m)
#pragma unroll
                for (int n = 0; n < 2; ++n) acc[a][b][m][n] = (f32x4){0.f, 0.f, 0.f, 0.f};
    i32x8 At[4], B0[2], B1[2];
    const char* cA = (const char*)g.A + (size_t)cur.pm * tstep; const char* cB = (const char*)g.Bt + (size_t)cur.pn * tstep;
    S.a_ready(cur);
    if constexpr (SP2) {
        PG8_STAGE(PG8_SB(0, 0), cB, voffB); PG8_STAGE(PG8_SB(0, 1), cB + hstep, voffB); PG8_STAGE(PG8_SA(0, 0), cA, voffA); PG8_STAGE(PG8_SA(0, 1), cA + hstep, voffA);
        if (wr == 1) PG8_BAR;
        PG8_WAIT_V(2); PG8_BAR;
        PG8_STAGE(PG8_SB(1, 0), cB + kstep, voffB); PG8_STAGE(PG8_SA(1, 0), cA + kstep, voffA); PG8_STAGE(PG8_SB(1, 1), cB + hstep + kstep, voffB);
        PG8_WAIT_V(6); PG8_BAR;
    } else {
        PG8_STAGE(PG8_SB(0, 0), cB, voffB); PG8_STAGE(PG8_SA(0, 0), cA, voffA); PG8_STAGE(PG8_SB(0, 1), cB + hstep, voffB); PG8_STAGE(PG8_SA(0, 1), cA + hstep, voffA);
        if (wr == 1) PG8_BAR;
        PG8_WAIT_V(4); PG8_BAR;
        PG8_STAGE(PG8_SB(1, 0), cB + kstep, voffB); PG8_STAGE(PG8_SA(1, 0), cA + kstep, voffA); PG8_STAGE(PG8_SB(1, 1), cB + hstep + kstep, voffB);
        PG8_WAIT_V(6); PG8_BAR;
    }
    for (;;) {
        const bool has_next = S.next(ui + 1, nxt);
        const char* nA = has_next ? (const char*)g.A + (size_t)nxt.pm * tstep : cA; const char* nB = has_next ? (const char*)g.Bt + (size_t)nxt.pn * tstep : cB;
_Pragma("nounroll")
        for (int t = 0; t < nt; t += 2) {
            const bool last = (t == nt - 2);
            const char* a1 = cA + (size_t)(t + 1) * kstep;
            const char* a2 = last ? nA : cA + (size_t)(t + 2) * kstep; const char* b2 = last ? nB : cB + (size_t)(t + 2) * kstep;
            const char* a3 = a2 + kstep; const char* b3 = b2 + kstep;
            if (last && has_next) S.a_ready(nxt);
            if constexpr (SP2) {
            PG8_LDB(B0, 0, 0); PG8_LDB(B1, 0, 1); PG8_SCHED; PG8_LDA(At, 0, 0); PG8_STAGE(PG8_SA(1, 1), a1 + hstep, voffA);
            PG8_WAIT_V(8); PG8_WAIT_L(0); PG8_BAR; PG8_MMA(0, 0, At, B0); PG8_MMA(0, 1, At, B1); PG8_BAR; PG8_SCHED;
            PG8_LDA(At, 0, 1); PG8_STAGE(PG8_SB(0, 0), b2, voffB); PG8_STAGE(PG8_SB(0, 1), b2 + hstep, voffB); PG8_STAGE(PG8_SA(0, 0), a2, voffA);
            PG8_WAIT_V(8); PG8_WAIT_L(0); PG8_BAR; PG8_MMA(1, 0, At, B0); PG8_MMA(1, 1, At, B1); PG8_BAR; PG8_SCHED;
            PG8_LDB(B0, 1, 0); PG8_LDB(B1, 1, 1); PG8_SCHED; PG8_LDA(At, 1, 0); PG8_STAGE(PG8_SA(0, 1), a2 + hstep, voffA);
            PG8_WAIT_V(8); PG8_WAIT_L(0); PG8_BAR; PG8_MMA(0, 0, At, B0); PG8_MMA(0, 1, At, B1); PG8_BAR; PG8_SCHED;
            PG8_LDA(At, 1, 1); PG8_STAGE(PG8_SB(1, 0), b3, voffB); PG8_STAGE(PG8_SB(1, 1), b3 + hstep, voffB); PG8_STAGE(PG8_SA(1, 0), a3, voffA);
            PG8_WAIT_V(8); PG8_WAIT_L(0); PG8_BAR; PG8_MMA(1, 0, At, B0); PG8_MMA(1, 1, At, B1); PG8_BAR; PG8_SCHED;
            } else {
            PG8_LDB(B0, 0, 0); PG8_SCHED; PG8_LDA(At, 0, 0); PG8_STAGE(PG8_SA(1, 1), a1 + hstep, voffA);
            PG8_WAIT_L(8); PG8_BAR; PG8_WAIT_L(0); PG8_MMA(0, 0, At, B0); PG8_BAR; PG8_SCHED;
            PG8_LDB(B1, 0, 1); PG8_STAGE(PG8_SB(0, 0), b2, voffB);
            PG8_BAR; PG8_WAIT_L(0); PG8_MMA(0, 1, At, B1); PG8_BAR;
            PG8_LDA(At, 0, 1); PG8_STAGE(PG8_SA(0, 0), a2, voffA);
            PG8_BAR; PG8_WAIT_L(0); PG8_MMA(1, 0, At, B0); PG8_BAR; PG8_SCHED;
            PG8_STAGE(PG8_SB(0, 1), b2 + hstep, voffB);
            PG8_WAIT_V(6); PG8_BAR; PG8_MMA(1, 1, At, B1); PG8_BAR;
            PG8_LDB(B0, 1, 0); PG8_SCHED; PG8_LDA(At, 1, 0); PG8_STAGE(PG8_SA(0, 1), a2 + hstep, voffA);
            PG8_WAIT_L(8); PG8_BAR; PG8_WAIT_L(0); PG8_MMA(0, 0, At, B0); PG8_BAR; PG8_SCHED;
            PG8_LDB(B1, 1, 1); PG8_STAGE(PG8_SB(1, 0), b3, voffB);
            PG8_BAR; PG8_WAIT_L(0); PG8_MMA(0, 1, At, B1); PG8_BAR;
            PG8_LDA(At, 1, 1); PG8_STAGE(PG8_SA(1, 0), a3, voffA);
            PG8_BAR; PG8_WAIT_L(0); PG8_MMA(1, 0, At, B0); PG8_BAR; PG8_SCHED;
            PG8_STAGE(PG8_SB(1, 1), b3 + hstep, voffB);
            PG8_WAIT_V(6); PG8_BAR; PG8_MMA(1, 1, At, B1); PG8_BAR;
            }
        }
        if constexpr (ALIGN_EPI) { if (wr == 0) PG8_BAR; }
        if constexpr (F8 != 0) asm volatile("s_nop 15\n\ts_nop 15" ::: "memory");
        if constexpr (!Epi::AFTER_DRAIN) { E(acc, cur, wr, wc, fr, fq); S.done(cur); }
        if (!has_next) break;
#pragma unroll
        for (int a = 0; a < 2; ++a)
#pragma unroll
            for (int b = 0; b < 2; ++b)
#pragma unroll
                for (int m = 0; m < 4; ++m)
#pragma unroll
                    for (int n = 0; n < 2; ++n) acc[a][b][m][n] = (f32x4){0.f, 0.f, 0.f, 0.f};
        cur = nxt; cA = nA; cB = nB; ++ui;
        if constexpr (ALIGN_EPI) { if (wr == 1) PG8_BAR; }
    }
    PG8_WAIT_V(0);
    if constexpr (!ALIGN_EPI) { if (wr == 0) PG8_BAR; }
    PG8_BAR;
    if constexpr (Epi::AFTER_DRAIN) { E.fused(acc, cur, wr, wc, fr, fq, lds, wid, lane); S.done(cur); }
#undef PG8_SA
#undef PG8_SB
#undef PG8_STAGE
#undef PG8_LDA
#undef PG8_LDB
#undef PG8_MMA
#undef PG8_WAIT_V
#undef PG8_WAIT_L
#undef PG8_BAR
#undef PG8_SCHED
}
}

constexpr int NB = 8, T = 4096, D = 1024, NTOK = NB * T;
constexpr int ATT_H = 8, ATT_D = 64, ATT_W = 512, KV_LAT = 256, IDX_H = 8, IDX_D = 64, TOPK = 256;
constexpr int HG_H = 4, HG_DK = 128, HG_DV = 128, HG_W = 512, HG_C = 32;
constexpr int D_IN = 3400, D_INP = 3584;
constexpr int C_AQ = 0, C_AC = 512, C_IQ = 768, C_IK = 1280, C_IW = 1344, C_GQ = 1352, C_GF = 1864, C_GI = 2376, C_GG = 2888;
constexpr int NE = 32, TOPE = 4, DFF = 1024, PLE = 256;
constexpr int NASSIGN = NTOK * TOPE, CAP = NASSIGN + NE * 256;
constexpr int MAXTILES = CAP / 256;
constexpr float LN_EPS = 1e-5f, RMS_EPS = 1e-6f, ALPHA = 1.189207115002721f;

constexpr size_t MiB = 1u << 20;
constexpr size_t WS_CTL = 0, CTL_ZERO_BYTES = 64 * 1024;
constexpr size_t WS_WIN_T = 1 * MiB, WS_WO_T = 8 * MiB, WS_WUP_T = 10 * MiB, WS_WDN_T = 138 * MiB, WS_WPROJ_T = 202 * MiB, WS_WGATE_T = 203 * MiB;
constexpr size_t WS_WUK_T = 205 * MiB, WS_WUV_T = 205 * MiB + 512 * 1024;
constexpr size_t WS_SMALL = 206 * MiB;
constexpr size_t WS_A = 208 * MiB;
constexpr size_t WS_B = 480 * MiB;
constexpr size_t WS_X1 = 752 * MiB;
constexpr size_t WS_XB = 880 * MiB;
constexpr size_t WS_PROJ = 944 * MiB;
constexpr size_t WS_SM2 = 1008 * MiB;
constexpr size_t WS_END = 1016 * MiB;
constexpr size_t WS_H = WS_A, WS_XS = WS_A, WS_YSLOT = WS_A;
constexpr size_t WS_XBF = WS_B, WS_U = WS_B, WS_YMIX = WS_B, WS_HH = WS_B;
constexpr size_t WS_QDEC = WS_B + 128 * MiB, WS_PB = WS_B + 128 * MiB, WS_OREC = WS_B + 160 * MiB, WS_CN = WS_B + 224 * MiB, WS_IKN = WS_B + 240 * MiB, WS_MASK = WS_B + 244 * MiB;
constexpr size_t WS_K = WS_XB, WS_VT = WS_XB + 32 * MiB;
constexpr size_t WS_TOPE = WS_SM2, WS_GATE = WS_SM2 + 512 * 1024, WS_LRANK = WS_SM2 + 1024 * 1024, WS_TOKSLOT = WS_SM2 + 1536 * 1024, WS_SLOTGATE = WS_SM2 + 2 * MiB, WS_DECAY = WS_SM2 + 3 * MiB;
constexpr size_t WS_WRT = WS_SMALL + 256 * 1024;
constexpr size_t WS_WGBASE = WS_SMALL, WS_TILEE = WS_SMALL + 64 * 1024;
constexpr int CW_CNT = 64;
constexpr int CW_BAR = 1024;
constexpr int XBW_OFF = 147456 - 16;

constexpr int RING_BYTES = 131072, MISC_OFF = RING_BYTES, LDS_BYTES = 147456;
constexpr int NWAVES = 8, NTHR = 512;

#define GAS __attribute__((address_space(1)))
#define LAS __attribute__((address_space(3)))
typedef unsigned short bf16;
typedef unsigned v4u __attribute__((ext_vector_type(4)));
typedef unsigned v2u __attribute__((ext_vector_type(2)));
typedef float f32x4 __attribute__((ext_vector_type(4)));
typedef short bf16x8 __attribute__((ext_vector_type(8)));
#define LDS_WAIT() asm volatile("s_waitcnt lgkmcnt(0)" ::: "memory")
#define VM_WAIT() asm volatile("s_waitcnt vmcnt(0)" ::: "memory")
__device__ __forceinline__ unsigned f2bf(float f) { unsigned u = __builtin_bit_cast(unsigned, f); return (u + 0x7fffu + ((u >> 16) & 1u)) >> 16; }
__device__ __forceinline__ unsigned pk2(float lo, float hi) { return f2bf(lo) | (f2bf(hi) << 16); }
__device__ __forceinline__ float bf2f(unsigned short b) { return __builtin_bit_cast(float, (unsigned)b << 16); }
__device__ __forceinline__ float bflo(unsigned w) { return __builtin_bit_cast(float, w << 16); }
__device__ __forceinline__ float bfhi(unsigned w) { return __builtin_bit_cast(float, w & 0xffff0000u); }
__device__ __forceinline__ float wave_sum(float v) {
#pragma unroll
    for (int o = 1; o < 64; o <<= 1) v += __shfl_xor(v, o);
    return v;
}
__device__ __forceinline__ float sigmoidf_(float x) { return 1.f / (1.f + __expf(-x)); }

__device__ __forceinline__ unsigned pk4_fp8(float a, float b, float c, float d);
struct Params { const float* in[25]; float* out; unsigned char* ws; };
enum { I_X = 0, I_P, I_WIN, I_KVG, I_IKG, I_IKB, I_WUK, I_WUV, I_HGLB, I_HGNG, I_WO, I_LNMG, I_LNMB, I_WR, I_BR, I_WUP, I_BUP, I_WDN, I_BDN, I_LNFG, I_LNFB, I_WPP, I_WPG, I_LNPG, I_LNPB };

struct Ctx { LAS unsigned char* lds; int tid, lane, wave, G, gw, ngw; };

namespace pg8 {
struct EpiBf16s {
    static constexpr bool PERM = true, AFTER_DRAIN = false;
    bf16_t* O; int ldc;
    __device__ __forceinline__ void operator()(const f32x4 (&acc)[2][2][4][2], const Unit& u, int wr, int wc, int fr, int fq) const {
        const int row0 = u.pm * BM + wr * 64 + fr, col0 = u.pn * BM + wc * 32 + 8 * fq;
#pragma unroll
        for (int ai = 0; ai < 2; ++ai)
#pragma unroll
            for (int m = 0; m < 4; ++m) { bf16_t* rowp = O + (size_t)(row0 + ai * HALF + m * 16) * ldc + col0;
#pragma unroll
                for (int bj = 0; bj < 2; ++bj) { const f32x4 v0 = acc[ai][bj][m][0], v1 = acc[ai][bj][m][1];
                    u32x4 w; w.x = cvt_pk_bf16(v0[0], v0[1]); w.y = cvt_pk_bf16(v0[2], v0[3]); w.z = cvt_pk_bf16(v1[0], v1[1]); w.w = cvt_pk_bf16(v1[2], v1[3]);
                    *(u32x4*)(rowp + bj * HALF) = w; } }
    }
};
struct EpiResid {
    static constexpr bool PERM = false, AFTER_DRAIN = false;
    const float* res; bf16_t* out; int ldc; float alpha, as;
    __device__ __forceinline__ void operator()(const f32x4 (&acc)[2][2][4][2], const Unit& u, int wr, int wc, int fr, int fq) const {
        const int row0 = u.pm * BM + wr * 64 + fr, col0 = u.pn * BM + wc * 32 + 4 * fq;
#pragma unroll
        for (int ai = 0; ai < 2; ++ai)
#pragma unroll
            for (int m = 0; m < 4; ++m) { const size_t off = (size_t)(row0 + ai * HALF + m * 16) * ldc + col0;
#pragma unroll
                for (int bj = 0; bj < 2; ++bj)
#pragma unroll
                    for (int n = 0; n < 2; ++n) { const f32x4 r = *(const f32x4*)(res + off + bj * HALF + n * 16); const f32x4 o = r * alpha + acc[ai][bj][m][n] * as; v2u w; w.x = cvt_pk_bf16(o[0], o[1]); w.y = cvt_pk_bf16(o[2], o[3]); *(v2u*)(out + off + bj * HALF + n * 16) = w; }
                asm volatile("" ::: "memory"); }
    }
};
struct EpiPle {
    static constexpr bool PERM = false, AFTER_DRAIN = false;
    const bf16_t* x2; const bf16_t* proj; bf16_t* out; float alpha, as;
    __device__ __forceinline__ void operator()(const f32x4 (&acc)[2][2][4][2], const Unit& u, int wr, int wc, int fr, int fq) const {
        const int row0 = u.pm * BM + wr * 64 + fr, col0 = u.pn * BM + wc * 32 + 4 * fq;
#pragma unroll
        for (int ai = 0; ai < 2; ++ai)
#pragma unroll
            for (int m = 0; m < 4; ++m) { const size_t off = (size_t)(row0 + ai * HALF + m * 16) * 1024 + col0;
#pragma unroll
                for (int bj = 0; bj < 2; ++bj)
#pragma unroll
                    for (int n = 0; n < 2; ++n) { const size_t o2 = off + bj * HALF + n * 16; const v2u rw = *(const v2u*)(x2 + o2); const f32x4 r = {bflo(rw.x), bfhi(rw.x), bflo(rw.y), bfhi(rw.y)}; const v2u pw = *(const v2u*)(proj + o2);
                        const f32x4 a = acc[ai][bj][m][n] * as; f32x4 o;
                        o[0] = r[0] * alpha + bflo(pw.x) * sigmoidf_(a[0]); o[1] = r[1] * alpha + bfhi(pw.x) * sigmoidf_(a[1]);
                        o[2] = r[2] * alpha + bflo(pw.y) * sigmoidf_(a[2]); o[3] = r[3] * alpha + bfhi(pw.y) * sigmoidf_(a[3]);
                        v2u ow; ow.x = cvt_pk_bf16(o[0], o[1]); ow.y = cvt_pk_bf16(o[2], o[3]); *(v2u*)(out + o2) = ow; }
                asm volatile("" ::: "memory"); }
    }
};
struct EpiSwiglu {
    static constexpr bool PERM = true, AFTER_DRAIN = false;
    unsigned char* H; const float* b_up;
    __device__ __forceinline__ void operator()(const f32x4 (&acc)[2][2][4][2], const Unit& u, int wr, int wc, int fr, int fq) const {
        const int e = u.pn >> 3, pnT = u.pn & 7;
        const int row0 = u.pm * BM + wr * 64 + fr, col0 = pnT * 128 + wc * 32 + 8 * fq;
        const float* bg = b_up + (size_t)e * 2048 + col0; const float* bl = bg + 1024;
        float bgv[8], blv[8];
#pragma unroll
        for (int j = 0; j < 8; ++j) { bgv[j] = bg[j]; blv[j] = bl[j]; }
#pragma unroll
        for (int ai = 0; ai < 2; ++ai)
#pragma unroll
            for (int m = 0; m < 4; ++m) { unsigned char* rowp = H + (size_t)(row0 + ai * HALF + m * 16) * 1024 + col0; float a[8];
#pragma unroll
                for (int n = 0; n < 2; ++n)
#pragma unroll
                    for (int j = 0; j < 4; ++j) { float g = acc[ai][0][m][n][j] * (1.f / 512.f) + bgv[4 * n + j], l = acc[ai][1][m][n][j] * (1.f / 512.f) + blv[4 * n + j];
                        g = fminf(g, 7.0f); l = fminf(fmaxf(l, -7.0f), 7.0f); a[4 * n + j] = g * sigmoidf_(1.702f * g) * (l + 1.0f); }
                v2u w; w.x = pk4_fp8(a[0] * 4.f, a[1] * 4.f, a[2] * 4.f, a[3] * 4.f); w.y = pk4_fp8(a[4] * 4.f, a[5] * 4.f, a[6] * 4.f, a[7] * 4.f);
                *(v2u*)rowp = w; }
    }
};
struct EpiDown {
    static constexpr bool PERM = true, AFTER_DRAIN = false;
    bf16_t* Y; const float* b_dn; const float* gate;
    __device__ __forceinline__ void operator()(const f32x4 (&acc)[2][2][4][2], const Unit& u, int wr, int wc, int fr, int fq) const {
        const int e = u.pn >> 2, pnT = u.pn & 3;
        const int row0 = u.pm * BM + wr * 64 + fr, col0 = pnT * 256 + wc * 32 + 8 * fq;
        const float* bb = b_dn + (size_t)e * 1024 + col0;
        float bv[2][8];
#pragma unroll
        for (int bj = 0; bj < 2; ++bj)
#pragma unroll
            for (int j = 0; j < 8; ++j) bv[bj][j] = bb[bj * HALF + j];
#pragma unroll
        for (int ai = 0; ai < 2; ++ai)
#pragma unroll
            for (int m = 0; m < 4; ++m) { const int row = row0 + ai * HALF + m * 16; const float gt = gate[row]; bf16_t* rowp = Y + (size_t)row * 1024 + col0;
#pragma unroll
                for (int bj = 0; bj < 2; ++bj) { const f32x4 v0 = acc[ai][bj][m][0], v1 = acc[ai][bj][m][1];
                    const float as = 1.f / 256.f;
                    u32x4 w; w.x = cvt_pk_bf16((v0[0] * as + bv[bj][0]) * gt, (v0[1] * as + bv[bj][1]) * gt); w.y = cvt_pk_bf16((v0[2] * as + bv[bj][2]) * gt, (v0[3] * as + bv[bj][3]) * gt);
                    w.z = cvt_pk_bf16((v1[0] * as + bv[bj][4]) * gt, (v1[1] * as + bv[bj][5]) * gt); w.w = cvt_pk_bf16((v1[2] * as + bv[bj][6]) * gt, (v1[3] * as + bv[bj][7]) * gt);
                    *(u32x4*)(rowp + bj * HALF) = w; } }
    }
};
struct MoeOrder {
    const int* tile_e; int ntiles, nN, G, c;
    __device__ __forceinline__ bool next(int i, Unit& u) const {
        if ((G & 7) == 0) {
            const int x = c & 7, s = i * (G >> 3) + (c >> 3);
            const int cg = nN >> 2, rg = 8 / cg;
            const int ch = x % cg, rc = x / cg;
            const int lr = s >> 2, pl = 4 * ch + (s & 3), pm = rc + rg * lr;
            if (pm >= ntiles) return false;
            u.pm = pm; u.pn = tile_e[pm] * nN + pl; return true;
        }
        const int L = i * G + c; if (L >= ntiles * nN) return false;
        const int pm = L / nN, pl = L - pm * nN; u.pm = pm; u.pn = tile_e[pm] * nN + pl; return true;
    }
    __device__ __forceinline__ void a_ready(const Unit&) const {}
    __device__ __forceinline__ void done(const Unit&) const {}
};
}

template <class RowMap>
__device__ __forceinline__ void transpose_item(const float* W, int ldw, int Nvalid, bf16* WT, int Kdim, RowMap rm, LAS float* scr, int kb, int nb, int lane) {
    const int k0 = 64 * kb, n0 = 32 * nb; const int nl0 = lane & 31, nn = n0 + nl0;
#pragma unroll 8
    for (int i = 0; i < 32; ++i) { const int kk = 2 * i + (lane >> 5); scr[kk * 33 + nl0] = (nn < Nvalid) ? W[(size_t)(k0 + kk) * ldw + nn] : 0.f; }
    LDS_WAIT(); asm volatile("" ::: "memory");
    const int c = lane & 7;
#pragma unroll
    for (int j = 0; j < 4; ++j) { const int n = (lane >> 3) + 8 * j; const LAS float* s = scr + (8 * c) * 33 + n;
        v4u o; o.x = pk2(s[0 * 33], s[1 * 33]); o.y = pk2(s[2 * 33], s[3 * 33]); o.z = pk2(s[4 * 33], s[5 * 33]); o.w = pk2(s[6 * 33], s[7 * 33]);
        *(GAS v4u*)(WT + (size_t)rm(n0 + n) * Kdim + k0 + 8 * c) = o; }
    LDS_WAIT(); asm volatile("" ::: "memory");
}
__device__ __forceinline__ unsigned pk4_fp8(float a, float b, float c, float d) { int r = 0; r = __builtin_amdgcn_cvt_pk_fp8_f32(a, b, r, false); r = __builtin_amdgcn_cvt_pk_fp8_f32(c, d, r, true); return (unsigned)r; }
template <class RowMap>
__device__ __forceinline__ void transpose_item_f8(const float* W, int ldw, unsigned char* WT, int Kdim, RowMap rm, LAS float* scr, int kb, int nb, int lane, float mul) {
    const int k0 = 64 * kb, n0 = 32 * nb; const int nl0 = lane & 31, nn = n0 + nl0;
#pragma unroll 8
    for (int i = 0; i < 32; ++i) { const int kk = 2 * i + (lane >> 5); scr[kk * 33 + nl0] = W[(size_t)(k0 + kk) * ldw + nn] * mul; }
    LDS_WAIT(); asm volatile("" ::: "memory");
    const int c = lane & 7;
#pragma unroll
    for (int j = 0; j < 4; ++j) { const int n = (lane >> 3) + 8 * j; const LAS float* s = scr + (8 * c) * 33 + n;
        v2u o; o.x = pk4_fp8(s[0 * 33], s[1 * 33], s[2 * 33], s[3 * 33]); o.y = pk4_fp8(s[4 * 33], s[5 * 33], s[6 * 33], s[7 * 33]);
        *(GAS v2u*)(WT + (size_t)rm(n0 + n) * Kdim + k0 + 8 * c) = o; }
    LDS_WAIT(); asm volatile("" ::: "memory");
}
struct RmId { __device__ __forceinline__ int operator()(int n) const { return n; } };
struct RmUp { int e; __device__ __forceinline__ int operator()(int n) const { return e * 2048 + ((n & 1023) >> 7) * 256 + (n >> 10) * 128 + (n & 127); } };
struct RmOff { int off; __device__ __forceinline__ int operator()(int n) const { return off + n; } };

__device__ __forceinline__ void p0_prologue(const Params& P, const Ctx& C) {
    LAS float* scr = (LAS float*)(C.lds + C.wave * 16384);
    unsigned char* ws = P.ws;
    constexpr int I_IN = 16 * (D_INP / 32), I_O = 16 * 32, I_UP = 16 * 64, I_DN = 16 * 32, I_PP = 4 * 32, I_PG = 16 * 32, I_UK = 4 * 16, I_UV = 4 * 16;
    constexpr int NITEMS = I_IN + I_O + NE * I_UP + NE * I_DN + I_PP + I_PG + I_UK + I_UV;
    for (int it = C.gw; it < NITEMS; it += C.ngw) {
        int r = it;
        if (r < I_IN) { transpose_item(P.in[I_WIN], D_IN, D_IN, (bf16*)(ws + WS_WIN_T), 1024, RmId{}, scr, r / (D_INP / 32), r % (D_INP / 32), C.lane); continue; } r -= I_IN;
        if (r < I_O) { transpose_item_f8(P.in[I_WO], 1024, ws + WS_WO_T, 1024, RmId{}, scr, r / 32, r % 32, C.lane, 64.f); continue; } r -= I_O;
        if (r < NE * I_UP) { const int e = r / I_UP, q = r % I_UP; transpose_item_f8(P.in[I_WUP] + (size_t)e * 1024 * 2048, 2048, ws + WS_WUP_T, 1024, RmUp{e}, scr, q / 64, q % 64, C.lane, 64.f); continue; } r -= NE * I_UP;
        if (r < NE * I_DN) { const int e = r / I_DN, q = r % I_DN; transpose_item_f8(P.in[I_WDN] + (size_t)e * 1024 * 1024, 1024, ws + WS_WDN_T, 1024, RmOff{e * 1024}, scr, q / 32, q % 32, C.lane, 64.f); continue; } r -= NE * I_DN;
        if (r < I_PP) { transpose_item(P.in[I_WPP], 1024, 1024, (bf16*)(ws + WS_WPROJ_T), 256, RmId{}, scr, r / 32, r % 32, C.lane); continue; } r -= I_PP;
        if (r < I_PG) { transpose_item_f8(P.in[I_WPG], 1024, ws + WS_WGATE_T, 1024, RmId{}, scr, r / 32, r % 32, C.lane, 64.f); continue; } r -= I_PG;
        if (r < I_UK) { transpose_item(P.in[I_WUK], 512, 512, (bf16*)(ws + WS_WUK_T), 256, RmId{}, scr, r / 16, r % 16, C.lane); continue; } r -= I_UK;
        transpose_item(P.in[I_WUV], 512, 512, (bf16*)(ws + WS_WUV_T), 256, RmId{}, scr, r / 16, r % 16, C.lane);
    }
    { const float* wr = P.in[I_WR]; float* wrt = (float*)(ws + WS_WRT);
      for (int i = C.gw * 64 + C.lane; i < 32 * 1024; i += C.ngw * 64) { const int e = i >> 10, k = i & 1023; wrt[i] = wr[k * 32 + e]; } }
    {
        const float* x = P.in[I_X]; bf16* xb = (bf16*)(ws + WS_XBF);
        const size_t n8 = (size_t)NTOK * D / 8, stride = (size_t)C.ngw * 64;
        for (size_t i = (size_t)C.gw * 64 + C.lane; i < n8; i += stride) { const f32x4 a = *(const GAS f32x4*)(x + i * 8), b = *(const GAS f32x4*)(x + i * 8 + 4);
            v4u o; o.x = pk2(a[0], a[1]); o.y = pk2(a[2], a[3]); o.z = pk2(b[0], b[1]); o.w = pk2(b[2], b[3]); *(GAS v4u*)(xb + i * 8) = o; }
        const float* p = P.in[I_P]; bf16* pb = (bf16*)(ws + WS_PB);
        const size_t m8 = (size_t)NTOK * PLE / 8;
        for (size_t i = (size_t)C.gw * 64 + C.lane; i < m8; i += stride) { const f32x4 a = *(const GAS f32x4*)(p + i * 8), b = *(const GAS f32x4*)(p + i * 8 + 4);
            v4u o; o.x = pk2(a[0], a[1]); o.y = pk2(a[2], a[3]); o.z = pk2(b[0], b[1]); o.w = pk2(b[2], b[3]); *(GAS v4u*)(pb + i * 8) = o; }
    }
}

__device__ __forceinline__ void ln_row(f32x4 (&v)[4], const float* g, const float* b, int lane) {
    float s = 0.f;
#pragma unroll
    for (int j = 0; j < 4; ++j) s += (v[j][0] + v[j][1]) + (v[j][2] + v[j][3]);
    const float mean = wave_sum(s) * (1.f / D); float s2 = 0.f;
#pragma unroll
    for (int j = 0; j < 4; ++j) { v[j] = v[j] - mean; s2 += (v[j][0] * v[j][0] + v[j][1] * v[j][1]) + (v[j][2] * v[j][2] + v[j][3] * v[j][3]); }
    const float rstd = 1.f / sqrtf(wave_sum(s2) * (1.f / D) + LN_EPS);
#pragma unroll
    for (int j = 0; j < 4; ++j) { const f32x4 gg = *(const f32x4*)(g + 4 * lane + 256 * j), bb = *(const f32x4*)(b + 4 * lane + 256 * j); v[j] = v[j] * rstd * gg + bb; }
}
__device__ __forceinline__ void store_row_f32(float* row, const f32x4 (&v)[4], int lane) {
#pragma unroll
    for (int j = 0; j < 4; ++j) *(GAS f32x4*)(row + 4 * lane + 256 * j) = v[j];
}
__device__ __forceinline__ void store_row_bf16(bf16* row, const f32x4 (&v)[4], int lane) {
#pragma unroll
    for (int j = 0; j < 4; ++j) { v2u o; o.x = pk2(v[j][0], v[j][1]); o.y = pk2(v[j][2], v[j][3]); *(GAS v2u*)(row + 4 * lane + 256 * j) = o; }
}
__device__ __forceinline__ void store_row_fp8x8(unsigned char* row, const f32x4 (&v)[4], int lane) {
#pragma unroll
    for (int j = 0; j < 4; ++j) *(GAS unsigned*)(row + 4 * lane + 256 * j) = pk4_fp8(v[j][0] * 8.f, v[j][1] * 8.f, v[j][2] * 8.f, v[j][3] * 8.f);
}
__device__ __forceinline__ void load_row_bf16(f32x4 (&v)[4], const bf16* row, int lane) {
#pragma unroll
    for (int j = 0; j < 4; ++j) { const v2u w = *(const GAS v2u*)(row + 4 * lane + 256 * j); v[j] = (f32x4){bflo(w.x), bfhi(w.x), bflo(w.y), bfhi(w.y)}; }
}
__device__ __forceinline__ void load_row_f32(f32x4 (&v)[4], const float* row, int lane) {
#pragma unroll
    for (int j = 0; j < 4; ++j) v[j] = *(const GAS f32x4*)(row + 4 * lane + 256 * j);
}
#ifndef FEAT_MIX
#define FEAT_MIX 1
#endif
#ifndef FEAT_MOE
#define FEAT_MOE 1
#endif
#ifndef FEAT_PLE
#define FEAT_PLE 1
#endif
#ifndef FEAT_ATT
#define FEAT_ATT 1
#endif
#ifndef SYNC_MODE
#define SYNC_MODE 0
#endif
#ifndef PROGRAM
#define PROGRAM X(0) GS X(10) X(11) SY X(20) X(21) SY X(30) X(31) BS X(32) SY X(40) X(41) SY X(5) SY X(6) SY X(7) SY X(8) SY X(9) SY X(100) SY X(110) SY X(120)
#endif

typedef float f32x16 __attribute__((ext_vector_type(16)));
typedef short s16x4 __attribute__((ext_vector_type(4)));
__device__ __forceinline__ unsigned cvtpk(float lo, float hi) { typedef float f2 __attribute__((ext_vector_type(2))); typedef __bf16 b2 __attribute__((ext_vector_type(2))); f2 v = {lo, hi}; b2 b = __builtin_convertvector(v, b2); return __builtin_bit_cast(unsigned, b); }
__device__ __forceinline__ bf16x8 pack8(const f32x16& x, int base) {
    v4u w; w.x = cvtpk(x[base + 0], x[base + 1]); w.y = cvtpk(x[base + 2], x[base + 3]); w.z = cvtpk(x[base + 4], x[base + 5]); w.w = cvtpk(x[base + 6], x[base + 7]);
    return __builtin_bit_cast(bf16x8, w);
}

__device__ __forceinline__ void p2_post(const Params& P, const Ctx& C) {
    unsigned char* ws = P.ws;
    const bf16* H = (const bf16*)(ws + WS_H); bf16* CN = (bf16*)(ws + WS_CN); bf16* IKN = (bf16*)(ws + WS_IKN);
    const float* kvg = P.in[I_KVG]; const float* ikg = P.in[I_IKG]; const float* ikb = P.in[I_IKB];
    const f32x4 g4 = *(const f32x4*)(kvg + 4 * C.lane); const float ig = ikg[C.lane], ib = ikb[C.lane];
    for (int m = C.gw; m < NTOK; m += C.ngw) {
        const bf16* hr = H + (size_t)m * D_INP;
        const v2u w = *(const GAS v2u*)(hr + C_AC + 4 * C.lane);
        float a0 = bflo(w.x), a1 = bfhi(w.x), a2 = bflo(w.y), a3 = bfhi(w.y);
        const float ss = wave_sum((a0 * a0 + a1 * a1) + (a2 * a2 + a3 * a3));
        const float rs = 1.f / sqrtf(ss * (1.f / 256.f) + RMS_EPS);
        v2u o; o.x = pk2(a0 * rs * g4[0], a1 * rs * g4[1]); o.y = pk2(a2 * rs * g4[2], a3 * rs * g4[3]);
        *(GAS v2u*)(CN + (size_t)m * 256 + 4 * C.lane) = o;
        const float k = bf2f(hr[C_IK + C.lane]);
        const float mu = wave_sum(k) * (1.f / 64.f); const float dk = k - mu;
        const float var = wave_sum(dk * dk) * (1.f / 64.f);
        IKN[(size_t)m * 64 + C.lane] = (bf16)f2bf(dk * (1.f / sqrtf(var + LN_EPS)) * ig + ib);
    }
}

constexpr int HP_QD = 0, HP_KI = 8704, HP_KET = 17408, HP_VT = 27648, HP_GS = 37888, HP_RAW = 40960;
__device__ __forceinline__ void p2_hgrn_prep(const Params& P, const Ctx& C) {
    unsigned char* ws = P.ws;
    const bf16* H = (const bf16*)(ws + WS_H);
    bf16* UT = (bf16*)(ws + WS_U); bf16* QDEC = (bf16*)(ws + WS_QDEC); float* OREC = (float*)(ws + WS_OREC); float* DEC = (float*)(ws + WS_DECAY);
    LAS bf16* QD = (LAS bf16*)(C.lds + HP_QD); LAS bf16* KI = (LAS bf16*)(C.lds + HP_KI); LAS bf16* KET = (LAS bf16*)(C.lds + HP_KET); LAS bf16* VT = (LAS bf16*)(C.lds + HP_VT);
    LAS float* GS = (LAS float*)(C.lds + HP_GS); LAS bf16* RAW = (LAS bf16*)(C.lds + HP_RAW);
    const int d = C.tid & 127, tg = C.tid >> 7;
    const int lane = C.lane, r32 = lane & 31, hf = lane >> 5;
    const int lc = C.tid >> 4, lg = C.tid & 15;
    const int NU = NB * HG_H * (T / HG_C);
    v4u rf, rq, ri;
    { const int unit = blockIdx.x; if (unit < NU) { const int n = unit & 127, hh = (unit >> 7) & 3, b = unit >> 9; const bf16* hr = H + (size_t)(b * T + n * HG_C + lc) * D_INP + hh * 128 + 8 * lg;
        rf = *(const GAS v4u*)(hr + C_GF); rq = *(const GAS v4u*)(hr + C_GQ); ri = *(const GAS v4u*)(hr + C_GI); } }
    for (int unit = blockIdx.x; unit < NU; unit += C.G) {
        const int n = unit & 127, hh = (unit >> 7) & 3, b = unit >> 9;
        const int m0 = b * T + n * HG_C;
        *(LAS v4u*)(RAW + lc * 128 + 8 * lg) = rf; *(LAS v4u*)(RAW + 4096 + lc * 128 + 8 * lg) = rq; *(LAS v4u*)(RAW + 8192 + lc * 128 + 8 * lg) = ri;
        __syncthreads();
        { const int un = unit + C.G; if (un < NU) { const int n2 = un & 127, h2 = (un >> 7) & 3, b2 = un >> 9; const bf16* hr = H + (size_t)(b2 * T + n2 * HG_C + lc) * D_INP + h2 * 128 + 8 * lg;
            rf = *(const GAS v4u*)(hr + C_GF); rq = *(const GAS v4u*)(hr + C_GQ); ri = *(const GAS v4u*)(hr + C_GI); } }
        const float l0 = P.in[I_HGLB][hh * 128 + d], l1 = P.in[I_HGLB][512 + hh * 128 + d];
        const float lb = 1.f / (1.f + __expf(l1 - l0));
        float fg[8], bl[8], qv[8]; float run = 0.f; unsigned vv[4];
#pragma unroll
        for (int c = 0; c < 8; ++c) { const int tok = tg * 8 + c;
            const float f = bf2f(RAW[tok * 128 + d]), q = bf2f(RAW[4096 + tok * 128 + d]); const unsigned iv = RAW[8192 + tok * 128 + d];
            fg[c] = lb + (1.f - lb) * sigmoidf_(f); run += __logf(fg[c]); bl[c] = run; qv[c] = q * sigmoidf_(q);
            if (c & 1) vv[c >> 1] |= iv << 16; else vv[c >> 1] = iv; }
        GS[tg * 128 + d] = run;
        *(LAS v4u*)(VT + d * 40 + tg * 8) = (v4u){vv[0], vv[1], vv[2], vv[3]};
        __syncthreads();
        float pre = 0.f, tot = 0.f;
#pragma unroll
        for (int g = 0; g < 4; ++g) { const float sg = GS[g * 128 + d]; tot += sg; if (g < tg) pre += sg; }
        unsigned ke[4];
#pragma unroll
        for (int c = 0; c < 8; ++c) { const float bc = pre + bl[c]; const float kc = 1.f - fg[c];
            const float qd = qv[c] * __expf(bc), ki = kc * __expf(-bc), kend = kc * __expf(tot - bc);
            const unsigned qb = f2bf(qd);
            QD[(tg * 8 + c) * 136 + d] = (bf16)qb; KI[(tg * 8 + c) * 136 + d] = (bf16)f2bf(ki);
            if (c & 1) ke[c >> 1] |= f2bf(kend) << 16; else ke[c >> 1] = f2bf(kend); }
        *(LAS v4u*)(KET + d * 40 + tg * 8) = (v4u){ke[0], ke[1], ke[2], ke[3]};
        if (tg == 0) DEC[(size_t)unit * 128 + d] = __expf(tot);
        __syncthreads();
        *(GAS v4u*)(QDEC + (size_t)(m0 + lc) * 512 + hh * 128 + 8 * lg) = *(const LAS v4u*)(QD + lc * 136 + 8 * lg);
        if (C.wave < 4) {
            f32x16 X = {0.f, 0.f, 0.f, 0.f, 0.f, 0.f, 0.f, 0.f, 0.f, 0.f, 0.f, 0.f, 0.f, 0.f, 0.f, 0.f};
#pragma unroll
            for (int k = 0; k < 8; ++k) { const bf16x8 a = *(const LAS bf16x8*)(KI + r32 * 136 + 16 * k + 8 * hf), bq = *(const LAS bf16x8*)(QD + r32 * 136 + 16 * k + 8 * hf);
                X = __builtin_amdgcn_mfma_f32_32x32x16_bf16(a, bq, X, 0, 0, 0); }
#pragma unroll
            for (int r = 0; r < 16; ++r) { const int sidx = (r & 3) + 8 * (r >> 2) + 4 * hf; if (sidx > r32) X[r] = 0.f; }
            f32x16 Z = {0.f, 0.f, 0.f, 0.f, 0.f, 0.f, 0.f, 0.f, 0.f, 0.f, 0.f, 0.f, 0.f, 0.f, 0.f, 0.f};
            const int e = C.wave * 32 + r32;
#pragma unroll
            for (int sp = 0; sp < 2; ++sp) { const bf16x8 a = pack8(X, 8 * sp);
                const s16x4 lo = *(const LAS s16x4*)(VT + e * 40 + 16 * sp + 4 * hf), hi = *(const LAS s16x4*)(VT + e * 40 + 16 * sp + 8 + 4 * hf);
                const bf16x8 bv = (bf16x8){lo[0], lo[1], lo[2], lo[3], hi[0], hi[1], hi[2], hi[3]};
                Z = __builtin_amdgcn_mfma_f32_32x32x16_bf16(a, bv, Z, 0, 0, 0); }
#pragma unroll
            for (int r = 0; r < 16; ++r) { const int c = (r & 3) + 8 * (r >> 2) + 4 * hf; OREC[(size_t)(m0 + c) * 512 + hh * 128 + e] = Z[r]; }
        }
        {
            const int dt = C.wave >> 1;
            const bf16x8 a0 = *(const LAS bf16x8*)(KET + (dt * 32 + r32) * 40 + 8 * hf), a1 = *(const LAS bf16x8*)(KET + (dt * 32 + r32) * 40 + 16 + 8 * hf);
#pragma unroll
            for (int ei = 0; ei < 2; ++ei) { const int et = 2 * (C.wave & 1) + ei;
                const bf16x8 b0 = *(const LAS bf16x8*)(VT + (et * 32 + r32) * 40 + 8 * hf), b1 = *(const LAS bf16x8*)(VT + (et * 32 + r32) * 40 + 16 + 8 * hf);
                f32x16 U = {0.f, 0.f, 0.f, 0.f, 0.f, 0.f, 0.f, 0.f, 0.f, 0.f, 0.f, 0.f, 0.f, 0.f, 0.f, 0.f};
                U = __builtin_amdgcn_mfma_f32_32x32x16_bf16(a0, b0, U, 0, 0, 0); U = __builtin_amdgcn_mfma_f32_32x32x16_bf16(a1, b1, U, 0, 0, 0);
                bf16* up = UT + (size_t)unit * 16384 + (size_t)(et * 32 + r32) * 128 + dt * 32 + 4 * hf;
#pragma unroll
                for (int q = 0; q < 4; ++q) { v2u o; o.x = cvtpk(U[4 * q], U[4 * q + 1]); o.y = cvtpk(U[4 * q + 2], U[4 * q + 3]); *(GAS v2u*)(up + 8 * q) = o; } }
        }
        __syncthreads();
    }
}

__device__ __forceinline__ void p3_hgrn_scan(const Params& P, const Ctx& C) {
    unsigned char* ws = P.ws;
    const bf16* UT = (const bf16*)(ws + WS_U); const bf16* QDEC = (const bf16*)(ws + WS_QDEC); float* OREC = (float*)(ws + WS_OREC); const float* DEC = (const float*)(ws + WS_DECAY);
    LAS bf16* ST = (LAS bf16*)C.lds;
    typedef float f32x4v __attribute__((ext_vector_type(4)));
    for (int unit = blockIdx.x; unit < NB * HG_H * 8; unit += C.G) {
        const int xcd_ = unit & 7, idx_ = unit >> 3; const int sl = idx_ & 7, bh_ = xcd_ + 8 * (idx_ >> 3); const int hh = bh_ & 3, b = bh_ >> 2; const int e0 = sl * 16;
        const int e = C.tid & 15, dq = C.tid >> 4;
        float S[4] = {0.f, 0.f, 0.f, 0.f};
        *(LAS v2u*)(ST + e * 136 + 4 * dq) = (v2u){0u, 0u};
        const int cu0 = (b * HG_H + hh) * 128;
        const int lane = C.lane, fr = lane & 15, fq = lane >> 4;
        const bool mw = C.wave < 2;
        const bf16* up = UT + (size_t)cu0 * 16384 + (size_t)(e0 + e) * 128 + 4 * dq;
        const float* dp = DEC + (size_t)cu0 * 128 + 4 * dq;
        const bf16* qp = QDEC + (size_t)(b * T + C.wave * 16 + fr) * 512 + hh * 128 + 8 * fq;
        float* op = OREC + (size_t)(b * T + C.wave * 16 + 4 * fq) * 512 + hh * 128 + e0 + fr;
        v2u un[4]; f32x4 dn[4]; bf16x8 qa[4][4]; float oi[4][4];
#pragma unroll
        for (int s = 0; s < 4; ++s) { un[s] = *(const GAS v2u*)(up + (size_t)s * 16384); dn[s] = *(const GAS f32x4*)(dp + (size_t)s * 128);
            if (mw) {
#pragma unroll
                for (int k = 0; k < 4; ++k) qa[s][k] = *(const GAS bf16x8*)(qp + (size_t)s * 32 * 512 + 32 * k);
#pragma unroll
                for (int j = 0; j < 4; ++j) oi[s][j] = op[(size_t)(s * 32 + j) * 512]; } }
        __syncthreads();
        for (int nb = 0; nb < 32; ++nb) {
#pragma unroll
            for (int s = 0; s < 4; ++s) {
                const int n = 4 * nb + s;
                const LAS bf16* stc = ST + (n & 1) * (16 * 136); LAS bf16* stn = ST + ((n + 1) & 1) * (16 * 136);
                if (mw) {
                    f32x4v acc = {oi[s][0], oi[s][1], oi[s][2], oi[s][3]};
#pragma unroll
                    for (int k = 0; k < 4; ++k) { const bf16x8 bs = *(const LAS bf16x8*)(stc + fr * 136 + 32 * k + 8 * fq); acc = __builtin_amdgcn_mfma_f32_16x16x32_bf16(qa[s][k], bs, acc, 0, 0, 0); }
#pragma unroll
                    for (int j = 0; j < 4; ++j) op[(size_t)(n * 32 + j) * 512] = acc[j];
                }
                S[0] = dn[s][0] * S[0] + bflo(un[s].x); S[1] = dn[s][1] * S[1] + bfhi(un[s].x); S[2] = dn[s][2] * S[2] + bflo(un[s].y); S[3] = dn[s][3] * S[3] + bfhi(un[s].y);
                *(LAS v2u*)(stn + e * 136 + 4 * dq) = (v2u){cvtpk(S[0], S[1]), cvtpk(S[2], S[3])};
                if (nb + 1 < 32) {
                    const int n2 = n + 4; un[s] = *(const GAS v2u*)(up + (size_t)n2 * 16384); dn[s] = *(const GAS f32x4*)(dp + (size_t)n2 * 128);
                    if (mw) {
#pragma unroll
                        for (int k = 0; k < 4; ++k) qa[s][k] = *(const GAS bf16x8*)(qp + (size_t)n2 * 32 * 512 + 32 * k);
#pragma unroll
                        for (int j = 0; j < 4; ++j) oi[s][j] = op[(size_t)(n2 * 32 + j) * 512]; }
                }
                __syncthreads();
            }
        }
    }
}

__device__ __forceinline__ void p4_yrec(const Params& P, const Ctx& C) {
    unsigned char* ws = P.ws;
    const float* OREC = (const float*)(ws + WS_OREC); const bf16* H = (const bf16*)(ws + WS_H); bf16* YM = (bf16*)(ws + WS_YMIX);
    const float* ng = P.in[I_HGNG];
    const f32x4 g0 = *(const f32x4*)(ng + 8 * C.lane), g1 = *(const f32x4*)(ng + 8 * C.lane + 4);
    for (int m = C.gw; m < NTOK; m += C.ngw) {
        const f32x4 a = *(const GAS f32x4*)(OREC + (size_t)m * 512 + 8 * C.lane), bq = *(const GAS f32x4*)(OREC + (size_t)m * 512 + 8 * C.lane + 4);
        float ss = (a[0] * a[0] + a[1] * a[1]) + (a[2] * a[2] + a[3] * a[3]) + (bq[0] * bq[0] + bq[1] * bq[1]) + (bq[2] * bq[2] + bq[3] * bq[3]);
        ss += __shfl_xor(ss, 1); ss += __shfl_xor(ss, 2); ss += __shfl_xor(ss, 4); ss += __shfl_xor(ss, 8);
        const float rs = 1.f / sqrtf(ss * (1.f / 128.f) + RMS_EPS);
        const v4u gw = *(const GAS v4u*)(H + (size_t)m * D_INP + C_GG + 8 * C.lane);
        float gv[8] = {bflo(gw.x), bfhi(gw.x), bflo(gw.y), bfhi(gw.y), bflo(gw.z), bfhi(gw.z), bflo(gw.w), bfhi(gw.w)};
        float o[8];
#pragma unroll
        for (int j = 0; j < 4; ++j) { o[j] = a[j] * rs * g0[j] * (gv[j] * sigmoidf_(gv[j])); o[4 + j] = bq[j] * rs * g1[j] * (gv[4 + j] * sigmoidf_(gv[4 + j])); }
        v2u w; w.x = pk4_fp8(o[0] * 8.f, o[1] * 8.f, o[2] * 8.f, o[3] * 8.f); w.y = pk4_fp8(o[4] * 8.f, o[5] * 8.f, o[6] * 8.f, o[7] * 8.f);
        *(GAS v2u*)((unsigned char*)YM + (size_t)m * D + 512 + 8 * C.lane) = w;
#if !FEAT_ATT
        *(GAS v4u*)(YM + (size_t)m * D + 8 * C.lane) = (v4u){0u, 0u, 0u, 0u};
#endif
    }
}

namespace pg8 {
struct EpiKhead {
    static constexpr bool PERM = true, AFTER_DRAIN = false;
    bf16_t* O;
    __device__ __forceinline__ void operator()(const f32x4 (&acc)[2][2][4][2], const Unit& u, int wr, int wc, int fr, int fq) const {
        const int row0 = u.pm * BM + wr * 64 + fr, col0 = u.pn * BM + wc * 32 + 8 * fq;
#pragma unroll
        for (int ai = 0; ai < 2; ++ai)
#pragma unroll
            for (int m = 0; m < 4; ++m) { const int row = row0 + ai * HALF + m * 16; const int b = row >> 12, t = row & 4095;
#pragma unroll
                for (int bj = 0; bj < 2; ++bj) { const int col = col0 + bj * HALF; const f32x4 v0 = acc[ai][bj][m][0], v1 = acc[ai][bj][m][1];
                    u32x4 w; w.x = cvt_pk_bf16(v0[0], v0[1]); w.y = cvt_pk_bf16(v0[2], v0[3]); w.z = cvt_pk_bf16(v1[0], v1[1]); w.w = cvt_pk_bf16(v1[2], v1[3]);
                    *(u32x4*)(O + ((size_t)((b * 8 + (col >> 6)) * 4096 + t)) * 64 + (col & 63)) = w; } }
    }
};
struct EpiVt {
    static constexpr bool PERM = true, AFTER_DRAIN = false;
    bf16_t* O;
    __device__ __forceinline__ void operator()(const f32x4 (&acc)[2][2][4][2], const Unit& u, int wr, int wc, int fr, int fq) const {
        const int row0 = u.pm * BM + wr * 64 + fr, col0 = u.pn * BM + wc * 32 + 8 * fq;
#pragma unroll
        for (int ai = 0; ai < 2; ++ai)
#pragma unroll
            for (int m = 0; m < 4; ++m) { const int row = row0 + ai * HALF + m * 16;
#pragma unroll
                for (int bj = 0; bj < 2; ++bj) { const int col = col0 + bj * HALF; const int b = col >> 12, t = col & 4095; const f32x4 v0 = acc[ai][bj][m][0], v1 = acc[ai][bj][m][1];
                    u32x4 w; w.x = cvt_pk_bf16(v0[0], v0[1]); w.y = cvt_pk_bf16(v0[2], v0[3]); w.z = cvt_pk_bf16(v1[0], v1[1]); w.w = cvt_pk_bf16(v1[2], v1[3]);
                    *(u32x4*)(O + ((size_t)(b * 512 + row)) * 4096 + t) = w; } }
    }
};
}

__device__ __forceinline__ unsigned f2ord(float x) { const unsigned b = __builtin_bit_cast(unsigned, x); return b ^ ((unsigned)((int)b >> 31) | 0x80000000u); }
typedef _Float16 h16;
typedef _Float16 h16x8 __attribute__((ext_vector_type(8)));
__device__ __forceinline__ float relu_i(float x) { const int b = __builtin_bit_cast(int, x); return __builtin_bit_cast(float, b > 0 ? b : 0); }
__device__ __forceinline__ unsigned h2ord(unsigned hb) { return (hb ^ ((hb & 0x8000u) ? 0xffffu : 0x8000u)) & 0xffffu; }
__device__ __forceinline__ int isc_bucket(float x, float mu, float scale) { const float t = fminf(fmaxf(fmaf(x - mu, scale, 128.f), 0.f), 255.f); return (int)t; }
__device__ __forceinline__ void p3_indexer(const Params& P, const Ctx& C) {
    unsigned char* ws = P.ws;
    const bf16* H = (const bf16*)(ws + WS_H); const bf16* IKN = (const bf16*)(ws + WS_IKN); unsigned* MASK = (unsigned*)(ws + WS_MASK);
    LAS h16* ISC = (LAS h16*)C.lds; LAS unsigned* HIST = (LAS unsigned*)(C.lds + 131072) + C.wave * 256; LAS float* STAT = (LAS float*)(C.lds + 139264); LAS float* W16 = (LAS float*)(C.lds + 140288);
    const int lane = C.lane, r32 = lane & 31, hf = lane >> 5;
    const int ql = 2 * (r32 >> 4) + ((r32 >> 2) & 1), hd = 4 * ((r32 >> 3) & 1) + (r32 & 3);
    constexpr int CAND_CAP = 120, QU = 16;
    for (int u = blockIdx.x; u < NTOK / QU; u += C.G) {
        const int b = u & 7, j = (u >> 3) & 31, i = u >> 8; const int pi = i >> 1; const int blk = (i & 1) ? (255 - (j + 32 * pi)) : (j + 32 * pi);
        const int t0 = blk * QU; const size_t mb = (size_t)b * T;
        const int nkt = (t0 + QU + 31) >> 5;
        bf16x8 af[4][4];
#pragma unroll
        for (int a = 0; a < 4; ++a) {
            const bf16* qp = H + (mb + t0 + 4 * a + ql) * D_INP + C_IQ + hd * 64 + 8 * hf;
#pragma unroll
            for (int k = 0; k < 4; ++k) af[a][k] = *(const GAS bf16x8*)(qp + 16 * k);
        }
        if (C.tid < 128) { const int q = C.tid >> 3, h8 = C.tid & 7; W16[C.tid] = bf2f(H[(mb + t0 + q) * D_INP + C_IW + h8]) * (0.125f * 0.35355339059327373f); }
        __syncthreads();
        {
            int kt = C.wave; bf16x8 bk[4], bn[4];
            if (kt < nkt) { const bf16* kp = IKN + (mb + kt * 32 + r32) * 64 + 8 * hf;
#pragma unroll
                for (int k = 0; k < 4; ++k) bk[k] = *(const GAS bf16x8*)(kp + 16 * k); }
            for (; kt < nkt; kt += NWAVES) {
                const int s0 = kt * 32;
                if (kt + NWAVES < nkt) { const bf16* kp = IKN + (mb + s0 + 32 * NWAVES + r32) * 64 + 8 * hf;
#pragma unroll
                    for (int k = 0; k < 4; ++k) bn[k] = *(const GAS bf16x8*)(kp + 16 * k); }
#pragma unroll
                for (int a = 0; a < 4; ++a) {
                    f32x16 acc = {0.f, 0.f, 0.f, 0.f, 0.f, 0.f, 0.f, 0.f, 0.f, 0.f, 0.f, 0.f, 0.f, 0.f, 0.f, 0.f};
#pragma unroll
                    for (int k = 0; k < 4; ++k) acc = __builtin_amdgcn_mfma_f32_32x32x16_bf16(af[a][k], bk[k], acc, 0, 0, 0);
#pragma unroll
                    for (int qh = 0; qh < 2; ++qh) { float sa = 0.f, sb = 0.f;
                        const int q = 4 * a + 2 * qh + hf, key = s0 + r32;
                        const f32x4 wl = *(const LAS f32x4*)(W16 + q * 8), wh = *(const LAS f32x4*)(W16 + q * 8 + 4);
                        sa = fmaf(wl[0], relu_i(acc[8 * qh + 0]), sa); sb = fmaf(wl[1], relu_i(acc[8 * qh + 1]), sb); sa = fmaf(wl[2], relu_i(acc[8 * qh + 2]), sa); sb = fmaf(wl[3], relu_i(acc[8 * qh + 3]), sb);
                        sa = fmaf(wh[0], relu_i(acc[8 * qh + 4]), sa); sb = fmaf(wh[1], relu_i(acc[8 * qh + 5]), sb); sa = fmaf(wh[2], relu_i(acc[8 * qh + 6]), sa); sb = fmaf(wh[3], relu_i(acc[8 * qh + 7]), sb);
                        float sv = sa + sb; const bool valid = key <= t0 + q; sv += 0.0f;
                        ISC[q * 4096 + key] = valid ? (h16)sv : (h16)(-INFINITY);
                    }
                }
#pragma unroll
                for (int k = 0; k < 4; ++k) bk[k] = bn[k];
            }
        }
        __syncthreads();
        for (int q = C.wave; q < QU; q += NWAVES) {
            const int t = t0 + q, n = t + 1; const LAS unsigned short* row = (const LAS unsigned short*)(ISC + q * 4096);
            unsigned* mrow = MASK + (mb + t) * 128;
            if (n <= TOPK) {
#pragma unroll
                for (int w2 = 0; w2 < 2; ++w2) { const int wi = lane + 64 * w2; const int lo = 32 * wi; unsigned bits;
                    if (lo + 31 <= t) bits = 0xffffffffu; else if (lo > t) bits = 0u; else bits = (1u << (t - lo + 1)) - 1u;
                    mrow[wi] = bits; }
            } else {
                unsigned dhi = 0u; int need = TOPK;
#pragma unroll
                for (int pass = 1; pass >= 0; --pass) {
                    LDS_WAIT();
#pragma unroll
                    for (int z = 0; z < 4; ++z) HIST[lane + 64 * z] = 0u;
#pragma unroll 2
                    for (int e0 = 8 * lane; e0 < n; e0 += 512) { const v4u v = *(const LAS v4u*)(row + e0);
#pragma unroll
                        for (int jj = 0; jj < 8; ++jj) { const unsigned w = (jj < 2) ? v.x : (jj < 4) ? v.y : (jj < 6) ? v.z : v.w; const unsigned hb = (jj & 1) ? (w >> 16) : (w & 0xffffu);
                            const unsigned key = h2ord(hb);
                            const bool ok = (e0 + jj < n) && (pass == 1 || (key >> 8) == dhi);
                            if (ok) atomicAdd((unsigned*)&HIST[pass == 1 ? (key >> 8) : (key & 255u)], 1u); } }
                    LDS_WAIT();
                    const v4u c4 = *(const LAS v4u*)(HIST + 4 * lane);
                    const unsigned c0 = c4.x, c1 = c4.y, c2 = c4.z, c3 = c4.w; const unsigned s4 = c0 + c1 + c2 + c3;
                    unsigned suf = s4;
#pragma unroll
                    for (int o = 1; o < 64; o <<= 1) { const unsigned v2 = __shfl_down(suf, o); if (lane + o < 64) suf += v2; }
                    unsigned cum = suf - s4; int dsel = -1; int nnew = 0; const unsigned nd = (unsigned)need;
                    if (cum < nd && nd <= cum + c3) { dsel = 4 * lane + 3; nnew = (int)(nd - cum); } cum += c3;
                    if (dsel < 0 && cum < nd && nd <= cum + c2) { dsel = 4 * lane + 2; nnew = (int)(nd - cum); } cum += c2;
                    if (dsel < 0 && cum < nd && nd <= cum + c1) { dsel = 4 * lane + 1; nnew = (int)(nd - cum); } cum += c1;
                    if (dsel < 0 && cum < nd && nd <= cum + c0) { dsel = 4 * lane + 0; nnew = (int)(nd - cum); }
                    const unsigned long long bal = __ballot(dsel >= 0);
                    const int src = (bal != 0ull) ? (int)__builtin_ctzll(bal) : 0;
                    const int dd = __shfl(dsel, src); need = __shfl(nnew, src);
                    if (pass == 1) dhi = (unsigned)dd; else dhi = (dhi << 8) | (unsigned)dd;
                }
                const unsigned Tk = dhi;
                int run_eq = 0; unsigned long long mine = 0ull; const int nit = (t >> 6) + 1;
#pragma unroll 4
                for (int it = 0; it < nit; ++it) { const int e = it * 64 + lane; const unsigned key = h2ord(row[e]); const bool valid = e <= t;
                    const bool eq = valid && (key == Tk); const unsigned long long beq = __ballot(eq);
                    const int rk = run_eq + __builtin_popcountll(beq & ((1ull << lane) - 1ull));
                    const bool sel = valid && ((key > Tk) || (eq && rk < need)); run_eq += __builtin_popcountll(beq);
                    const unsigned long long bs = __ballot(sel);
                    if (lane == it) mine = bs; }
                *(GAS v2u*)(mrow + 2 * lane) = (v2u){(unsigned)mine, (unsigned)(mine >> 32)};
            }
        }
        __syncthreads();
    }
}

__device__ __forceinline__ void attn_task(const bf16* H, const bf16* KH, const bf16* VT, const unsigned* MASK, bf16* YM, int b, int hh, int t0, int lane) {
    const int r32 = lane & 31, hf = lane >> 5;
    const float LOG2E = 1.4426950408889634f; const float c1 = 0.125f * LOG2E; const float sl2 = exp2f(-(float)(hh + 1)) * LOG2E;
    const size_t mb = (size_t)b * T;
    bf16x8 qf[4];
#pragma unroll
    for (int k = 0; k < 4; ++k) qf[k] = *(const GAS bf16x8*)(H + (mb + t0 + r32) * D_INP + C_AQ + hh * 64 + 16 * k + 8 * hf);
    const bf16* kbase = KH + ((size_t)(b * 8 + hh) * T) * 64; const bf16* vbase = VT + ((size_t)(b * 512 + hh * 64)) * T; const unsigned* mrow = MASK + (mb + t0 + r32) * 128;
    float m_run = -1e30f, l = 0.f;
    f32x16 O0 = {0.f, 0.f, 0.f, 0.f, 0.f, 0.f, 0.f, 0.f, 0.f, 0.f, 0.f, 0.f, 0.f, 0.f, 0.f, 0.f}, O1 = O0;
    const int nkt = (t0 + 32 + 63) >> 6;
    for (int kt = 0; kt < nkt; ++kt) {
        const int s0 = kt * 64;
        bf16x8 kf[2][4];
#pragma unroll
        for (int uu = 0; uu < 2; ++uu)
#pragma unroll
            for (int k = 0; k < 4; ++k) kf[uu][k] = *(const GAS bf16x8*)(kbase + (size_t)(s0 + 32 * uu + r32) * 64 + 16 * k + 8 * hf);
        const v2u mw = *(const GAS v2u*)(mrow + 2 * kt);
        s16x4 vl[2][2][2], vh[2][2][2];
#pragma unroll
        for (int uu = 0; uu < 2; ++uu)
#pragma unroll
            for (int sp = 0; sp < 2; ++sp)
#pragma unroll
                for (int dt = 0; dt < 2; ++dt) { const bf16* vp = vbase + (size_t)(dt * 32 + r32) * T + s0 + 32 * uu + 16 * sp + 4 * hf;
                    vl[uu][sp][dt] = *(const GAS s16x4*)vp; vh[uu][sp][dt] = *(const GAS s16x4*)(vp + 8); }
        f32x16 a0 = {0.f, 0.f, 0.f, 0.f, 0.f, 0.f, 0.f, 0.f, 0.f, 0.f, 0.f, 0.f, 0.f, 0.f, 0.f, 0.f}, a1 = a0;
#pragma unroll
        for (int k = 0; k < 4; ++k) { a0 = __builtin_amdgcn_mfma_f32_32x32x16_bf16(kf[0][k], qf[k], a0, 0, 0, 0); a1 = __builtin_amdgcn_mfma_f32_32x32x16_bf16(kf[1][k], qf[k], a1, 0, 0, 0); }
        const float dist0 = (float)(t0 + r32 - s0 - 4 * hf);
        const unsigned m0 = mw.x >> (4 * hf), m1 = mw.y >> (4 * hf);
        float mx = -1e30f;
#pragma unroll
        for (int r = 0; r < 16; ++r) { const int ko = (r & 3) + 8 * (r >> 2);
            const float d0 = dist0 - (float)ko;
            a0[r] = ((m0 >> ko) & 1u) ? (a0[r] * c1 - sl2 * d0) : -1e30f;
            a1[r] = ((m1 >> ko) & 1u) ? (a1[r] * c1 - sl2 * (d0 - 32.f)) : -1e30f;
            mx = fmaxf(mx, fmaxf(a0[r], a1[r])); }
        mx = fmaxf(mx, __shfl_xor(mx, 32));
        const float m_new = fmaxf(m_run, mx); const float alpha = __builtin_amdgcn_exp2f(m_run - m_new); m_run = m_new;
        float ps = 0.f;
#pragma unroll
        for (int r = 0; r < 16; ++r) { const int ko = (r & 3) + 8 * (r >> 2);
            const float p0 = ((m0 >> ko) & 1u) ? __builtin_amdgcn_exp2f(a0[r] - m_new) : 0.f;
            const float p1 = ((m1 >> ko) & 1u) ? __builtin_amdgcn_exp2f(a1[r] - m_new) : 0.f;
            a0[r] = p0; a1[r] = p1; ps += p0 + p1; }
        l = l * alpha + ps;
#pragma unroll
        for (int r = 0; r < 16; ++r) { O0[r] *= alpha; O1[r] *= alpha; }
#pragma unroll
        for (int sp = 0; sp < 2; ++sp) {
            const bf16x8 pb0 = pack8(a0, 8 * sp), pb1 = pack8(a1, 8 * sp);
#define VFR(uu, dt) ((bf16x8){vl[uu][sp][dt][0], vl[uu][sp][dt][1], vl[uu][sp][dt][2], vl[uu][sp][dt][3], vh[uu][sp][dt][0], vh[uu][sp][dt][1], vh[uu][sp][dt][2], vh[uu][sp][dt][3]})
            O0 = __builtin_amdgcn_mfma_f32_32x32x16_bf16(VFR(0, 0), pb0, O0, 0, 0, 0);
            O1 = __builtin_amdgcn_mfma_f32_32x32x16_bf16(VFR(0, 1), pb0, O1, 0, 0, 0);
            O0 = __builtin_amdgcn_mfma_f32_32x32x16_bf16(VFR(1, 0), pb1, O0, 0, 0, 0);
            O1 = __builtin_amdgcn_mfma_f32_32x32x16_bf16(VFR(1, 1), pb1, O1, 0, 0, 0);
#undef VFR
        }
    }
    l += __shfl_xor(l, 32);
    const float inv = 1.f / l;
    bf16* yp = YM + (mb + t0 + r32) * D + hh * 64 + 4 * hf;
#pragma unroll
    for (int rq = 0; rq < 4; ++rq) {
        v2u o; o.x = cvtpk(O0[4 * rq] * inv, O0[4 * rq + 1] * inv); o.y = cvtpk(O0[4 * rq + 2] * inv, O0[4 * rq + 3] * inv); *(GAS v2u*)(yp + 8 * rq) = o;
        v2u o2; o2.x = cvtpk(O1[4 * rq] * inv, O1[4 * rq + 1] * inv); o2.y = cvtpk(O1[4 * rq + 2] * inv, O1[4 * rq + 3] * inv); *(GAS v2u*)(yp + 32 + 8 * rq) = o2; }
}
__device__ __forceinline__ void p4_attention(const Params& P, const Ctx& C) {
    unsigned char* ws = P.ws;
    const bf16* H = (const bf16*)(ws + WS_H); const bf16* KH = (const bf16*)(ws + WS_K); const bf16* VT = (const bf16*)(ws + WS_VT); const unsigned* MASK = (const unsigned*)(ws + WS_MASK); bf16* YM = (bf16*)(ws + WS_YMIX);
    for (int p = blockIdx.x; p < 512; p += C.G) {
        const int bh = p >> 3, j = p & 7; const int b = bh >> 3, hh = bh & 7;
        attn_task(H, KH, VT, MASK, YM, b, hh, j * 256 + C.wave * 32, C.lane);
        attn_task(H, KH, VT, MASK, YM, b, hh, (15 - j) * 256 + (7 - C.wave) * 32, C.lane);
    }
}

constexpr int AT_KB = 64 * 144, AT_VB = 64 * 136, AT_VOFF = 2 * AT_KB;
__device__ __forceinline__ void attn_block(const Ctx& C, const bf16* H, const bf16* KH, const bf16* VT, const unsigned* MASK, bf16* YM, int b, int hh, int qb) {
    const int lane = C.lane, r32 = lane & 31, hf = lane >> 5, tid = C.tid;
    const float LOG2E = 1.4426950408889634f; const float c1 = 0.125f * LOG2E; const float sl2 = exp2f(-(float)(hh + 1)) * LOG2E;
    const size_t mb = (size_t)b * T; const int t0 = qb * 256 + C.wave * 32;
    bf16x8 qf[4];
#pragma unroll
    for (int k = 0; k < 4; ++k) { const v4u w = *(const GAS v4u*)(H + (mb + t0 + r32) * D_INP + C_AQ + hh * 64 + 16 * k + 8 * hf);
        v4u o; o.x = cvtpk(bflo(w.x) * c1, bfhi(w.x) * c1); o.y = cvtpk(bflo(w.y) * c1, bfhi(w.y) * c1); o.z = cvtpk(bflo(w.z) * c1, bfhi(w.z) * c1); o.w = cvtpk(bflo(w.w) * c1, bfhi(w.w) * c1);
        qf[k] = __builtin_bit_cast(bf16x8, o); }
    const bf16* kbase = KH + ((size_t)(b * 8 + hh) * T) * 64; const bf16* vbase = VT + ((size_t)(b * 512 + hh * 64)) * T; const unsigned* mrow = MASK + (mb + t0 + r32) * 128;
    const int srow = tid >> 3, sch = tid & 7;
    const bf16* kst = kbase + (size_t)srow * 64 + 8 * sch; const bf16* vst = vbase + (size_t)srow * T + 8 * sch;
    LAS unsigned char* kw = C.lds + srow * 144 + 16 * sch; LAS unsigned char* vw = C.lds + AT_VOFF + srow * 136 + 16 * sch;
    const LAS unsigned char* kr = C.lds + r32 * 144 + 16 * hf; const LAS unsigned char* vr = C.lds + AT_VOFF + r32 * 136 + 8 * hf;
    float m_run = -1e30f, l = 0.f;
    f32x16 O0 = {0.f, 0.f, 0.f, 0.f, 0.f, 0.f, 0.f, 0.f, 0.f, 0.f, 0.f, 0.f, 0.f, 0.f, 0.f, 0.f}, O1 = O0;
    const int nkt = 4 * (qb + 1), ktw = (t0 + 31) >> 6;
    v4u kn = *(const GAS v4u*)kst, vn = *(const GAS v4u*)vst; v2u mwn = *(const GAS v2u*)mrow;
    *(LAS v4u*)kw = kn; *(LAS v2u*)vw = (v2u){vn.x, vn.y}; *(LAS v2u*)(vw + 8) = (v2u){vn.z, vn.w};
    __syncthreads();
    for (int kt = 0; kt < nkt; ++kt) {
        const int s0 = kt * 64; const int cur = kt & 1; const v2u mw = mwn;
        if (kt + 1 < nkt) { kn = *(const GAS v4u*)(kst + (size_t)(s0 + 64) * 64); vn = *(const GAS v4u*)(vst + s0 + 64); mwn = *(const GAS v2u*)(mrow + 2 * kt + 2); }
        if (kt <= ktw) {
            const LAS unsigned char* kc = kr + cur * AT_KB; const LAS unsigned char* vc = vr + cur * AT_VB;
            const float B0 = -sl2 * (float)(t0 + r32 - s0 - 4 * hf);
            f32x16 a0, a1;
#pragma unroll
            for (int r = 0; r < 16; ++r) { const float ko = (float)((r & 3) + 8 * (r >> 2)); a0[r] = B0 + sl2 * ko; a1[r] = B0 + sl2 * (ko + 32.f); }
#pragma unroll
            for (int k = 0; k < 4; ++k) { const bf16x8 k0 = *(const LAS bf16x8*)(kc + 32 * k), k1 = *(const LAS bf16x8*)(kc + 32 * 144 + 32 * k);
                a0 = __builtin_amdgcn_mfma_f32_32x32x16_bf16(k0, qf[k], a0, 0, 0, 0); a1 = __builtin_amdgcn_mfma_f32_32x32x16_bf16(k1, qf[k], a1, 0, 0, 0); }
            const unsigned m0 = mw.x >> (4 * hf), m1 = mw.y >> (4 * hf);
            float mx = -1e30f;
#pragma unroll
            for (int r = 0; r < 16; ++r) { const int ko = (r & 3) + 8 * (r >> 2);
                const unsigned k0m = (unsigned)__builtin_amdgcn_sbfe((int)m0, ko, 1), k1m = (unsigned)__builtin_amdgcn_sbfe((int)m1, ko, 1);
                const float x0 = a0[r], x1 = a1[r];
                a0[r] = __builtin_bit_cast(float, (__builtin_bit_cast(unsigned, x0) & k0m) | (0xf149f2cau & ~k0m));
                a1[r] = __builtin_bit_cast(float, (__builtin_bit_cast(unsigned, x1) & k1m) | (0xf149f2cau & ~k1m));
                mx = fmaxf(mx, fmaxf(a0[r], a1[r])); }
            mx = fmaxf(mx, __shfl_xor(mx, 32));
            const float m_new = fmaxf(m_run, mx);
            const float m_use = fmaxf(m_new, -1e20f);
            float ps = 0.f;
#pragma unroll
            for (int r = 0; r < 16; ++r) { const float p0 = __builtin_amdgcn_exp2f(a0[r] - m_use), p1 = __builtin_amdgcn_exp2f(a1[r] - m_use); a0[r] = p0; a1[r] = p1; ps += p0 + p1; }
            if (__builtin_amdgcn_ballot_w64(m_new != m_run) != 0ull) {
                const float alpha = __builtin_amdgcn_exp2f(m_run - m_new); m_run = m_new;
                l *= alpha;
#pragma unroll
                for (int r = 0; r < 16; ++r) { O0[r] *= alpha; O1[r] *= alpha; }
            }
            l += ps;
#pragma unroll
            for (int sp = 0; sp < 2; ++sp) {
                const bf16x8 pb0 = pack8(a0, 8 * sp), pb1 = pack8(a1, 8 * sp);
#define VLD(uu, dt) ({ const s16x4 lo_ = *(const LAS s16x4*)(vc + (dt) * 32 * 136 + 2 * (32 * (uu) + 16 * sp)), hi_ = *(const LAS s16x4*)(vc + (dt) * 32 * 136 + 2 * (32 * (uu) + 16 * sp + 8)); (bf16x8){lo_[0], lo_[1], lo_[2], lo_[3], hi_[0], hi_[1], hi_[2], hi_[3]}; })
                O0 = __builtin_amdgcn_mfma_f32_32x32x16_bf16(VLD(0, 0), pb0, O0, 0, 0, 0);
                O1 = __builtin_amdgcn_mfma_f32_32x32x16_bf16(VLD(0, 1), pb0, O1, 0, 0, 0);
                O0 = __builtin_amdgcn_mfma_f32_32x32x16_bf16(VLD(1, 0), pb1, O0, 0, 0, 0);
                O1 = __builtin_amdgcn_mfma_f32_32x32x16_bf16(VLD(1, 1), pb1, O1, 0, 0, 0);
#undef VLD
            }
        }
        if (kt + 1 < nkt) { const int nx = cur ^ 1; *(LAS v4u*)(kw + nx * AT_KB) = kn; *(LAS v2u*)(vw + nx * AT_VB) = (v2u){vn.x, vn.y}; *(LAS v2u*)(vw + nx * AT_VB + 8) = (v2u){vn.z, vn.w}; }
        __syncthreads();
    }
    l += __shfl_xor(l, 32);
    const float inv = 1.f / l;
    unsigned char* yp = (unsigned char*)YM + (mb + t0 + r32) * D + hh * 64 + 4 * hf;
    const float i8 = inv * 8.f;
#pragma unroll
    for (int rq = 0; rq < 4; ++rq) {
        *(GAS unsigned*)(yp + 8 * rq) = pk4_fp8(O0[4 * rq] * i8, O0[4 * rq + 1] * i8, O0[4 * rq + 2] * i8, O0[4 * rq + 3] * i8);
        *(GAS unsigned*)(yp + 32 + 8 * rq) = pk4_fp8(O1[4 * rq] * i8, O1[4 * rq + 1] * i8, O1[4 * rq + 2] * i8, O1[4 * rq + 3] * i8); }
}
__device__ __forceinline__ void p4_attention2(const Params& P, const Ctx& C) {
    unsigned char* ws = P.ws;
    const bf16* H = (const bf16*)(ws + WS_H); const bf16* KH = (const bf16*)(ws + WS_K); const bf16* VT = (const bf16*)(ws + WS_VT); const unsigned* MASK = (const unsigned*)(ws + WS_MASK); bf16* YM = (bf16*)(ws + WS_YMIX);
    for (int p = blockIdx.x; p < 512; p += C.G) {
        const int b = p & 7, q = p >> 3; const int hh = q >> 3, j = q & 7;
        attn_block(C, H, KH, VT, MASK, YM, b, hh, j);
        attn_block(C, H, KH, VT, MASK, YM, b, hh, 15 - j);
    }
}

#ifndef FEAT_MIX
#define FEAT_MIX 1
#endif
#ifndef FEAT_MOE
#define FEAT_MOE 1
#endif
#ifndef FEAT_PLE
#define FEAT_PLE 1
#endif
#ifndef FEAT_ATT
#define FEAT_ATT 1
#endif

template <bool PUBLISH = true> __device__ __forceinline__ void p6_ln1_router(const Params& P, const Ctx& C) {
    unsigned char* ws = P.ws;
    bf16* X1 = (bf16*)(ws + WS_X1); unsigned char* XB = ws + WS_XB;
    LAS float* wl = (LAS float*)C.lds;
    LAS int* hist = (LAS int*)(C.lds + MISC_OFF);
    { const float* wrt = (const float*)(ws + WS_WRT);
      for (int i = C.tid; i < 32 * 1024 / 4; i += NTHR) *(LAS f32x4*)(wl + 4 * i) = *(const GAS f32x4*)(wrt + 4 * i);
      if (C.tid < 32) hist[C.tid] = 0; }
    __syncthreads();
    int* tope = (int*)(ws + WS_TOPE); float* gate = (float*)(ws + WS_GATE); int* lrank = (int*)(ws + WS_LRANK);
    const bf16* src = (const bf16*)P.out;
    const int lane = C.lane, hf = lane >> 5, ex = lane & 31;
    const float brl = P.in[I_BR][ex];
    for (int m0 = 2 * C.gw; m0 < NTOK; m0 += 2 * C.ngw) {
        f32x4 va[4], vb[4]; load_row_bf16(va, src + (size_t)m0 * D, lane); load_row_bf16(vb, src + (size_t)(m0 + 1) * D, lane);
        ln_row(va, P.in[I_LNMG], P.in[I_LNMB], lane); ln_row(vb, P.in[I_LNMG], P.in[I_LNMB], lane);
        store_row_bf16(X1 + (size_t)m0 * D, va, lane); store_row_bf16(X1 + (size_t)(m0 + 1) * D, vb, lane);
        store_row_fp8x8(XB + (size_t)m0 * D, va, lane); store_row_fp8x8(XB + (size_t)(m0 + 1) * D, vb, lane);
        float v[32];
#pragma unroll
        for (int e = 0; e < 32; ++e) { float pa = 0.f, pb = 0.f;
#pragma unroll
            for (int j = 0; j < 4; ++j) { const f32x4 w = *(const LAS f32x4*)(wl + e * 1024 + 4 * lane + 256 * j);
                pa += (va[j][0] * w[0] + va[j][1] * w[1]) + (va[j][2] * w[2] + va[j][3] * w[3]); pb += (vb[j][0] * w[0] + vb[j][1] * w[1]) + (vb[j][2] * w[2] + vb[j][3] * w[3]); }
            const float keep = hf ? pb : pa, send = hf ? pa : pb; v[e] = keep + __shfl_xor(send, 32); }
#define HALVE(M, CNT) { const bool up_ = (lane & (M)) != 0; _Pragma("unroll") for (int i_ = 0; i_ < (CNT) / 2; ++i_) { const float k_ = up_ ? v[i_ + (CNT) / 2] : v[i_], s_ = up_ ? v[i_] : v[i_ + (CNT) / 2]; v[i_] = k_ + __shfl_xor(s_, (M)); } }
        HALVE(16, 32) HALVE(8, 16) HALVE(4, 8) HALVE(2, 4) HALVE(1, 2)
#undef HALVE
        float lg = v[0] + brl;
        int se[4]; float sv[4];
#pragma unroll
        for (int k = 0; k < 4; ++k) { float bv = lg; int bi = ex;
#pragma unroll
            for (int o = 1; o < 32; o <<= 1) { const float ov = __shfl_xor(bv, o); const int oi = __shfl_xor(bi, o); const bool take = (ov > bv) || (ov == bv && oi < bi); bv = take ? ov : bv; bi = take ? oi : bi; }
            se[k] = bi; sv[k] = bv; if (ex == bi) lg = -INFINITY; }
        float exv[4], sum = 0.f;
#pragma unroll
        for (int k = 0; k < 4; ++k) { exv[k] = __expf(sv[k] - sv[0]); sum += exv[k]; }
        const float inv = 1.f / sum;
        if (ex == 0) { const int m = m0 + hf;
#pragma unroll
            for (int k = 0; k < 4; ++k) { const int lr = atomicAdd((int*)&hist[se[k]], 1); tope[m * 4 + k] = se[k]; gate[m * 4 + k] = exv[k] * inv; lrank[m * 4 + k] = lr; } }
    }
    __syncthreads();
    if (PUBLISH && C.tid < 32) { unsigned* cnt = (unsigned*)(ws + WS_CTL) + CW_CNT; const int base = (int)atomicAdd(cnt + C.tid, (unsigned)hist[C.tid]); ((int*)(ws + WS_WGBASE))[blockIdx.x * 32 + C.tid] = base; }
}

__device__ __forceinline__ void p7_dispatch(const Params& P, const Ctx& C) {
    unsigned char* ws = P.ws;
    LAS int* ps = (LAS int*)(C.lds + MISC_OFF + 256);
    const unsigned* cnt = (const unsigned*)(ws + WS_CTL) + CW_CNT;
    int* tile_e = (int*)(ws + WS_TILEE);
    LAS int* pe = (LAS int*)(C.lds + MISC_OFF + 512);
    if (C.tid < 64) { const int e = C.tid & 31; const int c = (int)__hip_atomic_load(cnt + e, __ATOMIC_RELAXED, __HIP_MEMORY_SCOPE_AGENT); const int nt = (c + 255) >> 8; int inc = nt;
#pragma unroll
        for (int o = 1; o < 32; o <<= 1) { const int v = __shfl_up(inc, o); if ((C.tid & 31) >= o) inc += v; }
        if (C.tid < 32) { ps[e] = (inc - nt) << 8; pe[e] = inc; } }
    __syncthreads();
    if (blockIdx.x == 0) { const int ntot = pe[31];
        for (int t = C.tid; t < ntot; t += NTHR) { int e = 0;
#pragma unroll
            for (int q = 0; q < 31; ++q) e += (t >= pe[q]) ? 1 : 0;
            tile_e[t] = e; }
        if (C.tid == 0) tile_e[MAXTILES] = ntot; }
    const int* tope = (const int*)(ws + WS_TOPE); const float* gate = (const float*)(ws + WS_GATE); const int* lrank = (const int*)(ws + WS_LRANK);
    const int* wgb = (const int*)(ws + WS_WGBASE);
    int* tokslot = (int*)(ws + WS_TOKSLOT); float* slotgate = (float*)(ws + WS_SLOTGATE);
    const bf16* XB = (const bf16*)(ws + WS_XB); unsigned char* xs = ws + WS_XS;
    int m = C.gw; v4u f8n; int en[4], ln_[4]; float gn[4]; int wgn;
    if (m < NTOK) { f8n = *(const GAS v4u*)((const unsigned char*)XB + (size_t)m * D + 16 * C.lane); wgn = ((m >> 1) % C.ngw) >> 3;
#pragma unroll
        for (int k = 0; k < 4; ++k) { en[k] = tope[m * 4 + k]; ln_[k] = lrank[m * 4 + k]; gn[k] = gate[m * 4 + k]; } }
    for (; m < NTOK; m += C.ngw) {
        const v4u f8 = f8n; int e[4], lr[4]; float g[4]; const int wgm = wgn;
#pragma unroll
        for (int k = 0; k < 4; ++k) { e[k] = en[k]; lr[k] = ln_[k]; g[k] = gn[k]; }
        int wb[4];
#pragma unroll
        for (int k = 0; k < 4; ++k) wb[k] = wgb[wgm * 32 + e[k]];
        const int m2 = m + C.ngw;
        if (m2 < NTOK) { f8n = *(const GAS v4u*)((const unsigned char*)XB + (size_t)m2 * D + 16 * C.lane); wgn = ((m2 >> 1) % C.ngw) >> 3;
#pragma unroll
            for (int k = 0; k < 4; ++k) { en[k] = tope[m2 * 4 + k]; ln_[k] = lrank[m2 * 4 + k]; gn[k] = gate[m2 * 4 + k]; } }
#pragma unroll
        for (int k = 0; k < 4; ++k) { const int slot = ps[e[k]] + wb[k] + lr[k];
            *(GAS v4u*)(xs + (size_t)slot * D + 16 * C.lane) = f8;
            if (C.lane == 0) { slotgate[slot] = g[k]; tokslot[m * 4 + k] = slot; } }
    }
}

__device__ __forceinline__ void p10_combine_ln2(const Params& P, const Ctx& C) {
    unsigned char* ws = P.ws;
    const bf16* X1 = (const bf16*)(ws + WS_X1); bf16* XB = (bf16*)(ws + WS_XB); bf16* X2 = (bf16*)P.out;
    const int* tokslot = (const int*)(ws + WS_TOKSLOT); const bf16* ys = (const bf16*)(ws + WS_YSLOT);
    for (int m = C.gw; m < NTOK; m += C.ngw) {
        f32x4 v[4]; load_row_bf16(v, X1 + (size_t)m * D, C.lane);
#pragma unroll
        for (int j = 0; j < 4; ++j) v[j] = v[j] * ALPHA;
#if FEAT_MOE
#pragma unroll
        for (int k = 0; k < 4; ++k) { const int slot = tokslot[m * 4 + k]; const bf16* yr = ys + (size_t)slot * D;
#pragma unroll
            for (int j = 0; j < 4; ++j) { const v2u w = *(const GAS v2u*)(yr + 4 * C.lane + 256 * j); v[j][0] += bflo(w.x); v[j][1] += bfhi(w.x); v[j][2] += bflo(w.y); v[j][3] += bfhi(w.y); } }
#endif
        ln_row(v, P.in[I_LNFG], P.in[I_LNFB], C.lane);
        store_row_bf16(X2 + (size_t)m * D, v, C.lane);
        store_row_fp8x8((unsigned char*)XB + (size_t)m * D, v, C.lane);
    }
}

__device__ __forceinline__ void p12_final_ln(const Params& P, const Ctx& C) {
    const bf16* src = (const bf16*)(P.ws + WS_X1);
    for (int m = C.gw; m < NTOK; m += C.ngw) {
        f32x4 v[4]; load_row_bf16(v, src + (size_t)m * D, C.lane);
        ln_row(v, P.in[I_LNPG], P.in[I_LNPB], C.lane);
        store_row_f32(P.out + (size_t)m * D, v, C.lane);
    }
}
#define XB_TMO      128
#define XB_XCNT(j)  (256  + 64 * (j))
#define XB_XSUB(j)  (1280 + 64 * (j))
#define XB_XGEN(j)  (2304 + 64 * (j))
#define XB_TOP      3328
#define XB_TOPGEN   3392
#define XCD_BAR_WORDS 3456
#define XB_SPIN_CAP (1u << 18)
#define LAS __attribute__((address_space(3)))

__device__ __forceinline__ unsigned xb_ld(unsigned* p)              { return __hip_atomic_load(p, __ATOMIC_RELAXED, __HIP_MEMORY_SCOPE_AGENT); }
__device__ __forceinline__ unsigned xb_add(unsigned* p, unsigned v) { return __hip_atomic_fetch_add(p, v, __ATOMIC_RELAXED, __HIP_MEMORY_SCOPE_AGENT); }
__device__ __forceinline__ unsigned xb_xcc_id() { return (unsigned)__builtin_amdgcn_s_getreg((3 << 11) | 20) & 0xFu; }
#define XB_SPIN(cond, bar) do { unsigned _sp = 0; while (cond) { __builtin_amdgcn_s_sleep(1); \
    if ((++_sp & 255u) == 0u) { if (xb_ld(&(bar)[XB_TMO])) break; if (_sp > XB_SPIN_CAP) { atomicAdd(&(bar)[XB_TMO], 1u); break; } } } } while (0)

struct XcdBarrier {
    unsigned* bar; unsigned x;
    volatile LAS unsigned* st;
};

__device__ __forceinline__ XcdBarrier xcd_barrier_post(unsigned* bar, volatile LAS unsigned* st) {
    XcdBarrier b; b.bar = bar; b.x = xb_xcc_id(); b.st = st;
    if (threadIdx.x == 0) (void)xb_add(&bar[XB_XCNT(b.x)], 1u);
    return b;
}
__device__ __forceinline__ void xcd_barrier_complete(unsigned* bar, unsigned x, unsigned& nloc, unsigned& nx) {
    const unsigned G = gridDim.x * gridDim.y * gridDim.z;
    unsigned sum, cnt, mine, sp = 0u;
    for (;;) {
        sum = 0u; cnt = 0u; mine = 0u;
#pragma unroll
        for (unsigned j = 0; j < 16; ++j) { const unsigned c = xb_ld(&bar[XB_XCNT(j)]); sum += c; cnt += (c > 0u) ? 1u : 0u; mine = (j == x) ? c : mine; }
        if (sum == G) break;
        __builtin_amdgcn_s_sleep(1);
        if ((++sp & 255u) == 0u) { if (xb_ld(&bar[XB_TMO])) break; if (sp > XB_SPIN_CAP) { atomicAdd(&bar[XB_TMO], 1u); break; } }
    }
    nloc = mine > 0u ? mine : 1u; nx = cnt > 0u ? cnt : 1u;
}

__device__ __forceinline__ void xcd_barrier(const XcdBarrier& b) {
    asm volatile("s_waitcnt vmcnt(0)" ::: "memory");
    __syncthreads();
    if (threadIdx.x == 0) {
        unsigned* bar = b.bar;
        __builtin_amdgcn_s_waitcnt(0);
        unsigned nloc = b.st[0], nx = b.st[1];
        if (nloc == 0u) { xcd_barrier_complete(bar, b.x, nloc, nx); b.st[0] = nloc; b.st[1] = nx; }
        const unsigned old = xb_add(&bar[XB_XSUB(b.x)], 1u);
        const unsigned gen = old / nloc;
        if (old + 1u == (gen + 1u) * nloc) {
            __builtin_amdgcn_fence(__ATOMIC_RELEASE, "agent");
            asm volatile("s_waitcnt vmcnt(0)" ::: "memory");
            const unsigned og = xb_add(&bar[XB_TOP], 1u);
            const unsigned tg = og / nx;
            if (og + 1u == (tg + 1u) * nx) xb_add(&bar[XB_TOPGEN], 1u);
            else XB_SPIN(xb_ld(&bar[XB_TOPGEN]) == tg, bar);
            __builtin_amdgcn_fence(__ATOMIC_ACQUIRE, "agent");
            xb_add(&bar[XB_XGEN(b.x)], 1u);
            asm volatile("s_waitcnt vmcnt(0)" ::: "memory");
        } else {
            XB_SPIN(xb_ld(&bar[XB_XGEN(b.x)]) == gen, bar);
            __builtin_amdgcn_fence(__ATOMIC_ACQUIRE, "agent");
            asm volatile("s_waitcnt vmcnt(0)" ::: "memory");
        }
    }
    __syncthreads();
}


template <int PH> __device__ __forceinline__ void run_phase(const Params& P, const Ctx& C) {
    unsigned char* ws = P.ws;
    typedef pg8::bf16_t pbf;
    if constexpr (PH == 0) { p0_prologue(P, C); }
    else if constexpr (PH == 10) {
        pg8::Gemm g{(const pbf*)(ws + WS_XBF), (const pbf*)(ws + WS_WIN_T), NTOK, D_INP, D}; pg8::StaticOrder S; S.init(NTOK, D_INP, C.G, (int)blockIdx.x);
        pg8::EpiBf16s E{(pbf*)(ws + WS_H), D_INP};
        pg8::gemm_phase<pg8::EpiBf16s, pg8::StaticOrder, true, true>(C.lds, g, S, E); }
    else if constexpr (PH == 11) {
        pg8::Gemm g{(const pbf*)(ws + WS_PB), (const pbf*)(ws + WS_WPROJ_T), NTOK, D, PLE}; pg8::StaticOrder S; S.init(NTOK, D, C.G, (int)blockIdx.x);
        pg8::EpiBf16s E{(pbf*)(ws + WS_PROJ), D};
        pg8::gemm_phase<pg8::EpiBf16s, pg8::StaticOrder, true, true>(C.lds, g, S, E); }
    else if constexpr (PH == 20) { p2_post(P, C); }
    else if constexpr (PH == 21) { p2_hgrn_prep(P, C); }
    else if constexpr (PH == 30) {
        { pg8::Gemm g{(const pbf*)(ws + WS_CN), (const pbf*)(ws + WS_WUK_T), NTOK, 512, 256}; pg8::StaticOrder S; S.init(NTOK, 512, C.G, (int)blockIdx.x);
          pg8::EpiKhead E{(pbf*)(ws + WS_K)};
          pg8::gemm_phase<pg8::EpiKhead, pg8::StaticOrder, true, true>(C.lds, g, S, E); }
        { pg8::Gemm g{(const pbf*)(ws + WS_WUV_T), (const pbf*)(ws + WS_CN), 512, NTOK, 256}; pg8::StaticOrder S; S.init(512, NTOK, C.G, (int)blockIdx.x);
          pg8::EpiVt E{(pbf*)(ws + WS_VT)};
          pg8::gemm_phase<pg8::EpiVt, pg8::StaticOrder, true, true>(C.lds, g, S, E); }
    }
    else if constexpr (PH == 31) { p3_indexer(P, C); }
    else if constexpr (PH == 32) { p3_hgrn_scan(P, C); }
    else if constexpr (PH == 40) { p4_attention2(P, C); }
    else if constexpr (PH == 41) { p4_yrec(P, C); }
    else if constexpr (PH == 5) {
        pg8::Gemm g{(const pbf*)(ws + WS_YMIX), (const pbf*)(ws + WS_WO_T), NTOK, D, D / 2}; pg8::StaticOrder S; S.init(NTOK, D, C.G, (int)blockIdx.x);
        pg8::EpiResid E{P.in[I_X], (pbf*)P.out, D, ALPHA, 1.f / 512.f};
        pg8::gemm_phase<pg8::EpiResid, pg8::StaticOrder, true, true, 1>(C.lds, g, S, E);
    }
    else if constexpr (PH == 6) { p6_ln1_router<true>(P, C); }
    else if constexpr (PH == 60) { p6_ln1_router<false>(P, C); }
    else if constexpr (PH == 7) { p7_dispatch(P, C); }
    else if constexpr (PH == 8) {
        const int* tile_e = (const int*)(ws + WS_TILEE);
        pg8::Gemm g{(const pbf*)(ws + WS_XS), (const pbf*)(ws + WS_WUP_T), CAP, NE * 2048, D / 2};
        pg8::MoeOrder S{tile_e, tile_e[MAXTILES], 8, C.G, (int)blockIdx.x};
        pg8::EpiSwiglu E{ws + WS_HH, P.in[I_BUP]};
        pg8::gemm_phase<pg8::EpiSwiglu, pg8::MoeOrder, true, true, 1, 124, 121>(C.lds, g, S, E);
    }
    else if constexpr (PH == 9) {
        const int* tile_e = (const int*)(ws + WS_TILEE);
        pg8::Gemm g{(const pbf*)(ws + WS_HH), (const pbf*)(ws + WS_WDN_T), CAP, NE * 1024, DFF / 2};
        pg8::MoeOrder S{tile_e, tile_e[MAXTILES], 4, C.G, (int)blockIdx.x};
        pg8::EpiDown E{(pbf*)(ws + WS_YSLOT), P.in[I_BDN], (const float*)(ws + WS_SLOTGATE)};
        pg8::gemm_phase<pg8::EpiDown, pg8::MoeOrder, true, true, 1, 125, 121>(C.lds, g, S, E);
    }
    else if constexpr (PH == 100) { p10_combine_ln2(P, C); }
    else if constexpr (PH == 110) {
        pg8::Gemm g{(const pbf*)(ws + WS_XB), (const pbf*)(ws + WS_WGATE_T), NTOK, D, D / 2}; pg8::StaticOrder S; S.init(NTOK, D, C.G, (int)blockIdx.x);
        pg8::EpiPle E{(const pbf*)P.out, (const pbf*)(ws + WS_PROJ), (pbf*)(ws + WS_X1), ALPHA, 1.f / 512.f};
        pg8::gemm_phase<pg8::EpiPle, pg8::StaticOrder, true, true, 1>(C.lds, g, S, E);
    }
    else { p12_final_ln(P, C); }
}
__global__ void __launch_bounds__(NTHR, 2) mega_fwd(Params P) {
    extern __shared__ __attribute__((aligned(16))) unsigned char lds_raw[];
    cg::grid_group grid = cg::this_grid();
#define MKCTX Ctx C; { int tid_ = threadIdx.x; asm volatile("" : "+v"(tid_)); C.lds = (LAS unsigned char*)lds_raw; C.tid = tid_; C.lane = tid_ & 63; C.wave = __builtin_amdgcn_readfirstlane(tid_ >> 6); \
      C.G = gridDim.x; C.gw = blockIdx.x * NWAVES + C.wave; C.ngw = C.G * NWAVES; }
#if SYNC_MODE != 0
    if (threadIdx.x < 4) ((LAS unsigned*)((LAS unsigned char*)lds_raw + XBW_OFF))[threadIdx.x] = 0u;
    __syncthreads();
    XcdBarrier bar = xcd_barrier_post((unsigned*)(P.ws + WS_CTL) + CW_BAR, (volatile LAS unsigned*)((LAS unsigned char*)lds_raw + XBW_OFF));
#define SY xcd_barrier(bar);
#else
#define SY grid.sync();
#endif
#define GS grid.sync();
#define BS __syncthreads();
#define X(k) { MKCTX run_phase<k>(P, C); }
    PROGRAM
#undef X
#undef MKCTX
#undef SY
#undef GS
#undef BS
}

extern "C" void kernel_launch(void* const* d_in, const int* in_sizes, int n_in, void* d_out, int out_size, void* d_ws, size_t ws_size, hipStream_t stream) {
    static int grid = 0;
    if (grid == 0) {
        if (n_in != 25 || out_size != NTOK * D || ws_size < WS_END) { fprintf(stderr, "kernel_launch: unexpected shapes (n_in %d out %d ws %zu)\n", n_in, out_size, ws_size); grid = -1; return; }
        int dev = 0, cus = 0, per_cu = 0;
        if (hipGetDevice(&dev) != hipSuccess || hipDeviceGetAttribute(&cus, hipDeviceAttributeMultiprocessorCount, dev) != hipSuccess) { grid = -1; return; }
        if (hipFuncSetAttribute((const void*)mega_fwd, hipFuncAttributeMaxDynamicSharedMemorySize, LDS_BYTES) != hipSuccess) { fprintf(stderr, "kernel_launch: hipFuncSetAttribute failed\n"); grid = -1; return; }
        if (hipOccupancyMaxActiveBlocksPerMultiprocessor(&per_cu, (const void*)mega_fwd, NTHR, LDS_BYTES) != hipSuccess || per_cu < 1) { fprintf(stderr, "kernel_launch: occupancy query failed (%d)\n", per_cu); (void)hipGetLastError(); grid = -1; return; }
        grid = cus * per_cu;
        fprintf(stderr, "kernel_launch: grid %d (%d CUs x %d)\n", grid, cus, per_cu);
    }
    if (grid < 0) return;
    (void)hipMemsetAsync((char*)d_ws + WS_CTL, 0, CTL_ZERO_BYTES, stream);
    Params p{};
    for (int i = 0; i < 25; ++i) p.in[i] = (const float*)d_in[i];
    p.out = (float*)d_out; p.ws = (unsigned char*)d_ws;

    void* args[] = {&p};
    hipError_t e = hipLaunchCooperativeKernel((const void*)mega_fwd, dim3(grid), dim3(NTHR), args, LDS_BYTES, stream);
    if (e != hipSuccess) fprintf(stderr, "kernel_launch: cooperative launch failed: %s (grid %d)\n", hipGetErrorString(e), grid);
}
```

```cpp
#define SYNC_MODE 1
#include <hip/hip_runtime.h>
#include <hip/hip_cooperative_groups.h>
#include <cstdio>
#include <cstdint>
namespace cg = cooperative_groups;

namespace pg8 {
#define PG8_LAS __attribute__((address_space(3)))
typedef unsigned short bf16_t;
typedef short bf16x8 __attribute__((ext_vector_type(8)));
typedef float f32x4 __attribute__((ext_vector_type(4)));
typedef unsigned u32x4 __attribute__((ext_vector_type(4)));
typedef int i32x4 __attribute__((ext_vector_type(4)));
typedef int i32x8 __attribute__((ext_vector_type(8)));
constexpr int BM = 256, BK = 64, HALF = 128, HTB = HALF * BK * 2  , STAGE_BYTES = 8 * HTB, NXCD = 8, WGM = 8;

__host__ __device__ __forceinline__ int lds_byte(int r, int c) { const int st = (r >> 4) * 2 + (c >> 5), rr = r & 15, cc = c & 31, ob = rr * 64 + cc * 2; return st * 1024 + (ob ^ (((ob >> 9) & 1) << 5)); }
__host__ __device__ __forceinline__ void stage_rc(int b, int& R, int& C) { const int st = b / 1024, sb = b % 1024, swz = sb ^ (((sb >> 9) & 1) << 5); R = (st >> 1) * 16 + swz / 64; C = (st & 1) * 32 + (swz % 64) / 2; }
__host__ __device__ __forceinline__ int perm32(int rho) { const int n = rho >> 4, i = rho & 15; return 8 * (i >> 2) + 4 * n + (i & 3); }

struct Unit { int pm, pn; };
struct Gemm { const bf16_t* A; const bf16_t* Bt; int M, N, K; };

struct StaticOrder {
    int nM, nN, nwg, G, c;
    __host__ __device__ void init(int M, int N, int G_, int c_) { nM = M / BM; nN = N / BM; nwg = nM * nN; G = G_; c = c_; }
    __host__ __device__ bool next(int i, Unit& u) const {
        const long L = (long)i * G + c; if (L >= nwg) return false;
        int wgid = (int)L; { const int q = nwg / NXCD, r = nwg % NXCD, xcd = wgid % NXCD, off = wgid / NXCD; wgid = (xcd < r ? xcd * (q + 1) : r * (q + 1) + (xcd - r) * q) + off; }
        const int nig = WGM * nN, gid = wgid / nig, fm = gid * WGM, gsz = (nM - fm) < WGM ? (nM - fm) : WGM;
        u.pm = fm + ((wgid % nig) % gsz); u.pn = (wgid % nig) / gsz; return true;
    }
    __device__ __forceinline__ void a_ready(const Unit&) const {}
    __device__ __forceinline__ void done(const Unit&) const {}
};

__device__ __forceinline__ unsigned cvt_pk_bf16(float lo, float hi) { unsigned r; asm volatile("v_cvt_pk_bf16_f32 %0, %1, %2" : "=v"(r) : "v"(lo), "v"(hi)); return r; }
typedef float f32x2 __attribute__((ext_vector_type(2)));
template <class Epi, class Sched, bool ALIGN_EPI = false, bool SP2 = false, int F8 = 0, int F8SA = 127, int F8SB = 127>
__device__ __forceinline__ void gemm_phase(PG8_LAS unsigned char* lds, const Gemm g, const Sched& S, const Epi& E) {
    const int tid = threadIdx.x, wid = __builtin_amdgcn_readfirstlane(tid >> 6), lane = tid & 63, wr = wid >> 2, wc = wid & 3, fr = lane & 15, fq = lane >> 4;
    const int K = g.K, nt = K / BK;
    unsigned voffA[2], voffB[2];
#pragma unroll
    for (int i = 0; i < 2; ++i) { int R, C; stage_rc(tid * 16 + i * 8192, R, C); const int Rb = Epi::PERM ? ((R & ~31) + perm32(R & 31)) : R;
        voffA[i] = (unsigned)(R * K + C) * 2u; voffB[i] = (unsigned)(Rb * K + C) * 2u; }
    const size_t kstep = (size_t)(BK * 2);
    const size_t hstep = (size_t)HALF * K * 2;
    const size_t tstep = 2 * hstep;
    const unsigned ldsw = (unsigned)wid * 1024u;
    const int aoff = lds_byte(wr * 64 + fr, fq * 8), boff = lds_byte(wc * 32 + fr, fq * 8);
#define PG8_SA(b, h) (((b) * 2 + (h)) * HTB)
#define PG8_SB(b, h) ((4 + (b) * 2 + (h)) * HTB)
#define PG8_STAGE(bufoff, gbase, voff) do { _Pragma("unroll") for (int _i = 0; _i < 2; ++_i) \
        __builtin_amdgcn_global_load_lds((const unsigned*)((const char*)(gbase) + (voff)[_i]), (PG8_LAS unsigned*)(lds + (bufoff) + ldsw + _i * 8192), 16, 0, 0); } while (0)
#define PG8_LDA(dst, b, h) do { _Pragma("unroll") for (int m = 0; m < 4; ++m) { dst[m].lo = *(const PG8_LAS i32x4*)(lds + PG8_SA(b, h) + aoff + m * 2048); dst[m].hi = *(const PG8_LAS i32x4*)(lds + PG8_SA(b, h) + aoff + m * 2048 + 1024); } } while (0)
#define PG8_LDB(dst, b, h) do { _Pragma("unroll") for (int n = 0; n < 2; ++n) { dst[n].lo = *(const PG8_LAS i32x4*)(lds + PG8_SB(b, h) + boff + n * 2048); dst[n].hi = *(const PG8_LAS i32x4*)(lds + PG8_SB(b, h) + boff + n * 2048 + 1024); } } while (0)
#define PG8_MMA(ai, bj, At, Bt) do { __builtin_amdgcn_s_setprio(1); \
        if constexpr (F8 == 0) { _Pragma("unroll") for (int m = 0; m < 4; ++m) _Pragma("unroll") for (int n = 0; n < 2; ++n) { \
            const i32x4 bl_ = Bt[n].lo, bh_ = Bt[n].hi, al_ = At[m].lo, ah_ = At[m].hi;     \
            acc[ai][bj][m][n] = __builtin_amdgcn_mfma_f32_16x16x32_bf16(__builtin_bit_cast(bf16x8, bl_), __builtin_bit_cast(bf16x8, al_), acc[ai][bj][m][n], 0, 0, 0); \
            acc[ai][bj][m][n] = __builtin_amdgcn_mfma_f32_16x16x32_bf16(__builtin_bit_cast(bf16x8, bh_), __builtin_bit_cast(bf16x8, ah_), acc[ai][bj][m][n], 0, 0, 0); } } \
        else { _Pragma("unroll") for (int m = 0; m < 4; ++m) _Pragma("unroll") for (int n = 0; n < 2; ++n) \
            asm volatile("v_mfma_f32_16x16x128_f8f6f4 %0, %1, %2, %0" : "+v"(acc[ai][bj][m][n]) : "v"(Bt[n]), "v"(At[m])); } \
        __builtin_amdgcn_s_setprio(0); } while (0)
#define PG8_WAIT_V(n) asm volatile("s_waitcnt vmcnt(" #n ")" ::: "memory")
#define PG8_WAIT_L(n) asm volatile("s_waitcnt lgkmcnt(" #n ")" ::: "memory")
#define PG8_BAR __builtin_amdgcn_s_barrier()
#define PG8_SCHED __builtin_amdgcn_sched_barrier(0)
    Unit cur, nxt; int ui = 0;
    if (!S.next(0, cur)) return;
    f32x4 acc[2][2][4][2];
#pragma unroll
    for (int a = 0; a < 2; ++a)
#pragma unroll
        for (int b = 0; b < 2; ++b)
#pragma unroll
            for (int m = 0; m < 4; ++m)
#pragma unroll
                for (int n = 0; n < 2; ++n) acc[a][b][m][n] = (f32x4){0.f, 0.f, 0.f, 0.f};
    i32x8 At[4], B0[2], B1[2];
    const char* cA = (const char*)g.A + (size_t)cur.pm * tstep; const char* cB = (const char*)g.Bt + (size_t)cur.pn * tstep;
    S.a_ready(cur);
    if constexpr (SP2) {
        PG8_STAGE(PG8_SB(0, 0), cB, voffB); PG8_STAGE(PG8_SB(0, 1), cB + hstep, voffB); PG8_STAGE(PG8_SA(0, 0), cA, voffA); PG8_STAGE(PG8_SA(0, 1), cA + hstep, voffA);
        if (wr == 1) PG8_BAR;
        PG8_WAIT_V(2); PG8_BAR;
        PG8_STAGE(PG8_SB(1, 0), cB + kstep, voffB); PG8_STAGE(PG8_SA(1, 0), cA + kstep, voffA); PG8_STAGE(PG8_SB(1, 1), cB + hstep + kstep, voffB);
        PG8_WAIT_V(6); PG8_BAR;
    } else {
        PG8_STAGE(PG8_SB(0, 0), cB, voffB); PG8_STAGE(PG8_SA(0, 0), cA, voffA); PG8_STAGE(PG8_SB(0, 1), cB + hstep, voffB); PG8_STAGE(PG8_SA(0, 1), cA + hstep, voffA);
        if (wr == 1) PG8_BAR;
        PG8_WAIT_V(4); PG8_BAR;
        PG8_STAGE(PG8_SB(1, 0), cB + kstep, voffB); PG8_STAGE(PG8_SA(1, 0), cA + kstep, voffA); PG8_STAGE(PG8_SB(1, 1), cB + hstep + kstep, voffB);
        PG8_WAIT_V(6); PG8_BAR;
    }
    for (;;) {
        const bool has_next = S.next(ui + 1, nxt);
        const char* nA = has_next ? (const char*)g.A + (size_t)nxt.pm * tstep : cA; const char* nB = has_next ? (const char*)g.Bt + (size_t)nxt.pn * tstep : cB;
_Pragma("nounroll")
        for (int t = 0; t < nt; t += 2) {
            const bool last = (t == nt - 2);
            const char* a1 = cA + (size_t)(t + 1) * kstep;
            const char* a2 = last ? nA : cA + (size_t)(t + 2) * kstep; const char* b2 = last ? nB : cB + (size_t)(t + 2) * kstep;
            const char* a3 = a2 + kstep; const char* b3 = b2 + kstep;
            if (last && has_next) S.a_ready(nxt);
            if constexpr (SP2) {
            PG8_LDB(B0, 0, 0); PG8_LDB(B1, 0, 1); PG8_SCHED; PG8_LDA(At, 0, 0); PG8_STAGE(PG8_SA(1, 1), a1 + hstep, voffA);
            PG8_WAIT_V(8); PG8_WAIT_L(0); PG8_BAR; PG8_MMA(0, 0, At, B0); PG8_MMA(0, 1, At, B1); PG8_BAR; PG8_SCHED;
            PG8_LDA(At, 0, 1); PG8_STAGE(PG8_SB(0, 0), b2, voffB); PG8_STAGE(PG8_SB(0, 1), b2 + hstep, voffB); PG8_STAGE(PG8_SA(0, 0), a2, voffA);
            PG8_WAIT_V(8); PG8_WAIT_L(0); PG8_BAR; PG8_MMA(1, 0, At, B0); PG8_MMA(1, 1, At, B1); PG8_BAR; PG8_SCHED;
            PG8_LDB(B0, 1, 0); PG8_LDB(B1, 1, 1); PG8_SCHED; PG8_LDA(At, 1, 0); PG8_STAGE(PG8_SA(0, 1), a2 + hstep, voffA);
            PG8_WAIT_V(8); PG8_WAIT_L(0); PG8_BAR; PG8_MMA(0, 0, At, B0); PG8_MMA(0, 1, At, B1); PG8_BAR; PG8_SCHED;
            PG8_LDA(At, 1, 1); PG8_STAGE(PG8_SB(1, 0), b3, voffB); PG8_STAGE(PG8_SB(1, 1), b3 + hstep, voffB); PG8_STAGE(PG8_SA(1, 0), a3, voffA);
            PG8_WAIT_V(8); PG8_WAIT_L(0); PG8_BAR; PG8_MMA(1, 0, At, B0); PG8_MMA(1, 1, At, B1); PG8_BAR; PG8_SCHED;
            } else {
            PG8_LDB(B0, 0, 0); PG8_SCHED; PG8_LDA(At, 0, 0); PG8_STAGE(PG8_SA(1, 1), a1 + hstep, voffA);
            PG8_WAIT_L(8); PG8_BAR; PG8_WAIT_L(0); PG8_MMA(0, 0, At, B0); PG8_BAR; PG8_SCHED;
            PG8_LDB(B1, 0, 1); PG8_STAGE(PG8_SB(0, 0), b2, voffB);
            PG8_BAR; PG8_WAIT_L(0); PG8_MMA(0, 1, At, B1); PG8_BAR;
            PG8_LDA(At, 0, 1); PG8_STAGE(PG8_SA(0, 0), a2, voffA);
            PG8_BAR; PG8_WAIT_L(0); PG8_MMA(1, 0, At, B0); PG8_BAR; PG8_SCHED;
            PG8_STAGE(PG8_SB(0, 1), b2 + hstep, voffB);
            PG8_WAIT_V(6); PG8_BAR; PG8_MMA(1, 1, At, B1); PG8_BAR;
            PG8_LDB(B0, 1, 0); PG8_SCHED; PG8_LDA(At, 1, 0); PG8_STAGE(PG8_SA(0, 1), a2 + hstep, voffA);
            PG8_WAIT_L(8); PG8_BAR; PG8_WAIT_L(0); PG8_MMA(0, 0, At, B0); PG8_BAR; PG8_SCHED;
            PG8_LDB(B1, 1, 1); PG8_STAGE(PG8_SB(1, 0), b3, voffB);
            PG8_BAR; PG8_WAIT_L(0); PG8_MMA(0, 1, At, B1); PG8_BAR;
            PG8_LDA(At, 1, 1); PG8_STAGE(PG8_SA(1, 0), a3, voffA);
            PG8_BAR; PG8_WAIT_L(0); PG8_MMA(1, 0, At, B0); PG8_BAR; PG8_SCHED;
            PG8_STAGE(PG8_SB(1, 1), b3 + hstep, voffB);
            PG8_WAIT_V(6); PG8_BAR; PG8_MMA(1, 1, At, B1); PG8_BAR;
            }
        }
        if constexpr (ALIGN_EPI) { if (wr == 0) PG8_BAR; }
        if constexpr (F8 != 0) asm volatile("s_nop 15\n\ts_nop 15" ::: "memory");
        if constexpr (!Epi::AFTER_DRAIN) { E(acc, cur, wr, wc, fr, fq); S.done(cur); }
        if (!has_next) break;
#pragma unroll
        for (int a = 0; a < 2; ++a)
#pragma unroll
            for (int b = 0; b < 2; ++b)
#pragma unroll
                for (int m = 0; m < 4; ++m)
#pragma unroll
                    for (int n = 0; n < 2; ++n) acc[a][b][m][n] = (f32x4){0.f, 0.f, 0.f, 0.f};
        cur = nxt; cA = nA; cB = nB; ++ui;
        if constexpr (ALIGN_EPI) { if (wr == 1) PG8_BAR; }
    }
    PG8_WAIT_V(0);
    if constexpr (!ALIGN_EPI) { if (wr == 0) PG8_BAR; }
    PG8_BAR;
    if constexpr (Epi::AFTER_DRAIN) { E.fused(acc, cur, wr, wc, fr, fq, lds, wid, lane); S.done(cur); }
#undef PG8_SA
#undef PG8_SB
#undef PG8_STAGE
#undef PG8_LDA
#undef PG8_LDB
#undef PG8_MMA
#undef PG8_WAIT_V
#undef PG8_WAIT_L
#undef PG8_BAR
#undef PG8_SCHED
}
}

constexpr int NB = 8, T = 4096, D = 1024, NTOK = NB * T;
constexpr int ATT_H = 8, ATT_D = 64, ATT_W = 512, KV_LAT = 256, IDX_H = 8, IDX_D = 64, TOPK = 256;
constexpr int HG_H = 4, HG_DK = 128, HG_DV = 128, HG_W = 512, HG_C = 32;
constexpr int D_IN = 3400, D_INP = 3584;
constexpr int C_AQ = 0, C_AC = 512, C_IQ = 768, C_IK = 1280, C_IW = 1344, C_GQ = 1352, C_GF = 1864, C_GI = 2376, C_GG = 2888;
constexpr int NE = 32, TOPE = 4, DFF = 1024, PLE = 256;
constexpr int NASSIGN = NTOK * TOPE, CAP = NASSIGN + NE * 256;
constexpr int MAXTILES = CAP / 256;
constexpr float LN_EPS = 1e-5f, RMS_EPS = 1e-6f, ALPHA = 1.189207115002721f;

constexpr size_t MiB = 1u << 20;
constexpr size_t WS_CTL = 0, CTL_ZERO_BYTES = 64 * 1024;
constexpr size_t WS_WIN_T = 1 * MiB, WS_WO_T = 8 * MiB, WS_WUP_T = 10 * MiB, WS_WDN_T = 138 * MiB, WS_WPROJ_T = 202 * MiB, WS_WGATE_T = 203 * MiB;
constexpr size_t WS_WUK_T = 205 * MiB, WS_WUV_T = 205 * MiB + 512 * 1024;
constexpr size_t WS_SMALL = 206 * MiB;
constexpr size_t WS_A = 208 * MiB;
constexpr size_t WS_B = 480 * MiB;
constexpr size_t WS_X1 = 752 * MiB;
constexpr size_t WS_XB = 880 * MiB;
constexpr size_t WS_PROJ = 944 * MiB;
constexpr size_t WS_SM2 = 1008 * MiB;
constexpr size_t WS_END = 1016 * MiB;
constexpr size_t WS_H = WS_A, WS_XS = WS_A, WS_YSLOT = WS_A;
constexpr size_t WS_XBF = WS_B, WS_U = WS_B, WS_YMIX = WS_B, WS_HH = WS_B;
constexpr size_t WS_QDEC = WS_B + 128 * MiB, WS_PB = WS_B + 128 * MiB, WS_OREC = WS_B + 160 * MiB, WS_CN = WS_B + 224 * MiB, WS_IKN = WS_B + 240 * MiB, WS_MASK = WS_B + 244 * MiB;
constexpr size_t WS_K = WS_XB, WS_VT = WS_XB + 32 * MiB;
constexpr size_t WS_TOPE = WS_SM2, WS_GATE = WS_SM2 + 512 * 1024, WS_LRANK = WS_SM2 + 1024 * 1024, WS_TOKSLOT = WS_SM2 + 1536 * 1024, WS_SLOTGATE = WS_SM2 + 2 * MiB, WS_DECAY = WS_SM2 + 3 * MiB;
constexpr size_t WS_WRT = WS_SMALL + 256 * 1024;
constexpr size_t WS_WGBASE = WS_SMALL, WS_TILEE = WS_SMALL + 64 * 1024;
constexpr int CW_CNT = 64;
constexpr int CW_BAR = 1024;
constexpr int XBW_OFF = 147456 - 16;

constexpr int RING_BYTES = 131072, MISC_OFF = RING_BYTES, LDS_BYTES = 147456;
constexpr int NWAVES = 8, NTHR = 512;

#define GAS __attribute__((address_space(1)))
#define LAS __attribute__((address_space(3)))
typedef unsigned short bf16;
typedef unsigned v4u __attribute__((ext_vector_type(4)));
typedef unsigned v2u __attribute__((ext_vector_type(2)));
typedef float f32x4 __attribute__((ext_vector_type(4)));
typedef short bf16x8 __attribute__((ext_vector_type(8)));
#define LDS_WAIT() asm volatile("s_waitcnt lgkmcnt(0)" ::: "memory")
#define VM_WAIT() asm volatile("s_waitcnt vmcnt(0)" ::: "memory")
__device__ __forceinline__ unsigned f2bf(float f) { unsigned u = __builtin_bit_cast(unsigned, f); return (u + 0x7fffu + ((u >> 16) & 1u)) >> 16; }
__device__ __forceinline__ unsigned pk2(float lo, float hi) { return f2bf(lo) | (f2bf(hi) << 16); }
__device__ __forceinline__ float bf2f(unsigned short b) { return __builtin_bit_cast(float, (unsigned)b << 16); }
__device__ __forceinline__ float bflo(unsigned w) { return __builtin_bit_cast(float, w << 16); }
__device__ __forceinline__ float bfhi(unsigned w) { return __builtin_bit_cast(float, w & 0xffff0000u); }
__device__ __forceinline__ float wave_sum(float v) {
#pragma unroll
    for (int o = 1; o < 64; o <<= 1) v += __shfl_xor(v, o);
    return v;
}
__device__ __forceinline__ float sigmoidf_(float x) { return 1.f / (1.f + __expf(-x)); }

__device__ __forceinline__ unsigned pk4_fp8(float a, float b, float c, float d);
struct Params { const float* in[25]; float* out; unsigned char* ws; };
enum { I_X = 0, I_P, I_WIN, I_KVG, I_IKG, I_IKB, I_WUK, I_WUV, I_HGLB, I_HGNG, I_WO, I_LNMG, I_LNMB, I_WR, I_BR, I_WUP, I_BUP, I_WDN, I_BDN, I_LNFG, I_LNFB, I_WPP, I_WPG, I_LNPG, I_LNPB };

struct Ctx { LAS unsigned char* lds; int tid, lane, wave, G, gw, ngw; };

namespace pg8 {
struct EpiBf16s {
    static constexpr bool PERM = true, AFTER_DRAIN = false;
    bf16_t* O; int ldc;
    __device__ __forceinline__ void operator()(const f32x4 (&acc)[2][2][4][2], const Unit& u, int wr, int wc, int fr, int fq) const {
        const int row0 = u.pm * BM + wr * 64 + fr, col0 = u.pn * BM + wc * 32 + 8 * fq;
#pragma unroll
        for (int ai = 0; ai < 2; ++ai)
#pragma unroll
            for (int m = 0; m < 4; ++m) { bf16_t* rowp = O + (size_t)(row0 + ai * HALF + m * 16) * ldc + col0;
#pragma unroll
                for (int bj = 0; bj < 2; ++bj) { const f32x4 v0 = acc[ai][bj][m][0], v1 = acc[ai][bj][m][1];
                    u32x4 w; w.x = cvt_pk_bf16(v0[0], v0[1]); w.y = cvt_pk_bf16(v0[2], v0[3]); w.z = cvt_pk_bf16(v1[0], v1[1]); w.w = cvt_pk_bf16(v1[2], v1[3]);
                    *(u32x4*)(rowp + bj * HALF) = w; } }
    }
};
struct EpiResid {
    static constexpr bool PERM = false, AFTER_DRAIN = false;
    const float* res; bf16_t* out; int ldc; float alpha, as;
    __device__ __forceinline__ void operator()(const f32x4 (&acc)[2][2][4][2], const Unit& u, int wr, int wc, int fr, int fq) const {
        const int row0 = u.pm * BM + wr * 64 + fr, col0 = u.pn * BM + wc * 32 + 4 * fq;
#pragma unroll
        for (int ai = 0; ai < 2; ++ai)
#pragma unroll
            for (int m = 0; m < 4; ++m) { const size_t off = (size_t)(row0 + ai * HALF + m * 16) * ldc + col0;
#pragma unroll
                for (int bj = 0; bj < 2; ++bj)
#pragma unroll
                    for (int n = 0; n < 2; ++n) { const f32x4 r = *(const f32x4*)(res + off + bj * HALF + n * 16); const f32x4 o = r * alpha + acc[ai][bj][m][n] * as; v2u w; w.x = cvt_pk_bf16(o[0], o[1]); w.y = cvt_pk_bf16(o[2], o[3]); *(v2u*)(out + off + bj * HALF + n * 16) = w; }
                asm volatile("" ::: "memory"); }
    }
};
struct EpiPle {
    static constexpr bool PERM = false, AFTER_DRAIN = false;
    const bf16_t* x2; const bf16_t* proj; bf16_t* out; float alpha, as;
    __device__ __forceinline__ void operator()(const f32x4 (&acc)[2][2][4][2], const Unit& u, int wr, int wc, int fr, int fq) const {
        const int row0 = u.pm * BM + wr * 64 + fr, col0 = u.pn * BM + wc * 32 + 4 * fq;
#pragma unroll
        for (int ai = 0; ai < 2; ++ai)
#pragma unroll
            for (int m = 0; m < 4; ++m) { const size_t off = (size_t)(row0 + ai * HALF + m * 16) * 1024 + col0;
#pragma unroll
                for (int bj = 0; bj < 2; ++bj)
#pragma unroll
                    for (int n = 0; n < 2; ++n) { const size_t o2 = off + bj * HALF + n * 16; const v2u rw = *(const v2u*)(x2 + o2); const f32x4 r = {bflo(rw.x), bfhi(rw.x), bflo(rw.y), bfhi(rw.y)}; const v2u pw = *(const v2u*)(proj + o2);
                        const f32x4 a = acc[ai][bj][m][n] * as; f32x4 o;
                        o[0] = r[0] * alpha + bflo(pw.x) * sigmoidf_(a[0]); o[1] = r[1] * alpha + bfhi(pw.x) * sigmoidf_(a[1]);
                        o[2] = r[2] * alpha + bflo(pw.y) * sigmoidf_(a[2]); o[3] = r[3] * alpha + bfhi(pw.y) * sigmoidf_(a[3]);
                        v2u ow; ow.x = cvt_pk_bf16(o[0], o[1]); ow.y = cvt_pk_bf16(o[2], o[3]); *(v2u*)(out + o2) = ow; }
                asm volatile("" ::: "memory"); }
    }
};
struct EpiSwiglu {
    static constexpr bool PERM = true, AFTER_DRAIN = false;
    unsigned char* H; const float* b_up;
    __device__ __forceinline__ void operator()(const f32x4 (&acc)[2][2][4][2], const Unit& u, int wr, int wc, int fr, int fq) const {
        const int e = u.pn >> 3, pnT = u.pn & 7;
        const int row0 = u.pm * BM + wr * 64 + fr, col0 = pnT * 128 + wc * 32 + 8 * fq;
        const float* bg = b_up + (size_t)e * 2048 + col0; const float* bl = bg + 1024;
        float bgv[8], blv[8];
#pragma unroll
        for (int j = 0; j < 8; ++j) { bgv[j] = bg[j]; blv[j] = bl[j]; }
#pragma unroll
        for (int ai = 0; ai < 2; ++ai)
#pragma unroll
            for (int m = 0; m < 4; ++m) { unsigned char* rowp = H + (size_t)(row0 + ai * HALF + m * 16) * 1024 + col0; float a[8];
#pragma unroll
                for (int n = 0; n < 2; ++n)
#pragma unroll
                    for (int j = 0; j < 4; ++j) { float g = acc[ai][0][m][n][j] * (1.f / 512.f) + bgv[4 * n + j], l = acc[ai][1][m][n][j] * (1.f / 512.f) + blv[4 * n + j];
                        g = fminf(g, 7.0f); l = fminf(fmaxf(l, -7.0f), 7.0f); a[4 * n + j] = g * sigmoidf_(1.702f * g) * (l + 1.0f); }
                v2u w; w.x = pk4_fp8(a[0] * 4.f, a[1] * 4.f, a[2] * 4.f, a[3] * 4.f); w.y = pk4_fp8(a[4] * 4.f, a[5] * 4.f, a[6] * 4.f, a[7] * 4.f);
                *(v2u*)rowp = w; }
    }
};
struct EpiDown {
    static constexpr bool PERM = true, AFTER_DRAIN = false;
    bf16_t* Y; const float* b_dn; const float* gate;
    __device__ __forceinline__ void operator()(const f32x4 (&acc)[2][2][4][2], const Unit& u, int wr, int wc, int fr, int fq) const {
        const int e = u.pn >> 2, pnT = u.pn & 3;
        const int row0 = u.pm * BM + wr * 64 + fr, col0 = pnT * 256 + wc * 32 + 8 * fq;
        const float* bb = b_dn + (size_t)e * 1024 + col0;
        float bv[2][8];
#pragma unroll
        for (int bj = 0; bj < 2; ++bj)
#pragma unroll
            for (int j = 0; j < 8; ++j) bv[bj][j] = bb[bj * HALF + j];
#pragma unroll
        for (int ai = 0; ai < 2; ++ai)
#pragma unroll
            for (int m = 0; m < 4; ++m) { const int row = row0 + ai * HALF + m * 16; const float gt = gate[row]; bf16_t* rowp = Y + (size_t)row * 1024 + col0;
#pragma unroll
                for (int bj = 0; bj < 2; ++bj) { const f32x4 v0 = acc[ai][bj][m][0], v1 = acc[ai][bj][m][1];
                    const float as = 1.f / 256.f;
                    u32x4 w; w.x = cvt_pk_bf16((v0[0] * as + bv[bj][0]) * gt, (v0[1] * as + bv[bj][1]) * gt); w.y = cvt_pk_bf16((v0[2] * as + bv[bj][2]) * gt, (v0[3] * as + bv[bj][3]) * gt);
                    w.z = cvt_pk_bf16((v1[0] * as + bv[bj][4]) * gt, (v1[1] * as + bv[bj][5]) * gt); w.w = cvt_pk_bf16((v1[2] * as + bv[bj][6]) * gt, (v1[3] * as + bv[bj][7]) * gt);
                    *(u32x4*)(rowp + bj * HALF) = w; } }
    }
};
struct MoeOrder {
    const int* tile_e; int ntiles, nN, G, c;
    __device__ __forceinline__ bool next(int i, Unit& u) const {
        if ((G & 7) == 0) {
            const int x = c & 7, s = i * (G >> 3) + (c >> 3);
            const int cg = nN >> 2, rg = 8 / cg;
            const int ch = x % cg, rc = x / cg;
            const int lr = s >> 2, pl = 4 * ch + (s & 3), pm = rc + rg * lr;
            if (pm >= ntiles) return false;
            u.pm = pm; u.pn = tile_e[pm] * nN + pl; return true;
        }
        const int L = i * G + c; if (L >= ntiles * nN) return false;
        const int pm = L / nN, pl = L - pm * nN; u.pm = pm; u.pn = tile_e[pm] * nN + pl; return true;
    }
    __device__ __forceinline__ void a_ready(const Unit&) const {}
    __device__ __forceinline__ void done(const Unit&) const {}
};
}

template <class RowMap>
__device__ __forceinline__ void transpose_item(const float* W, int ldw, int Nvalid, bf16* WT, int Kdim, RowMap rm, LAS float* scr, int kb, int nb, int lane) {
    const int k0 = 64 * kb, n0 = 32 * nb; const int nl0 = lane & 31, nn = n0 + nl0;
#pragma unroll 8
    for (int i = 0; i < 32; ++i) { const int kk = 2 * i + (lane >> 5); scr[kk * 33 + nl0] = (nn < Nvalid) ? W[(size_t)(k0 + kk) * ldw + nn] : 0.f; }
    LDS_WAIT(); asm volatile("" ::: "memory");
    const int c = lane & 7;
#pragma unroll
    for (int j = 0; j < 4; ++j) { const int n = (lane >> 3) + 8 * j; const LAS float* s = scr + (8 * c) * 33 + n;
        v4u o; o.x = pk2(s[0 * 33], s[1 * 33]); o.y = pk2(s[2 * 33], s[3 * 33]); o.z = pk2(s[4 * 33], s[5 * 33]); o.w = pk2(s[6 * 33], s[7 * 33]);
        *(GAS v4u*)(WT + (size_t)rm(n0 + n) * Kdim + k0 + 8 * c) = o; }
    LDS_WAIT(); asm volatile("" ::: "memory");
}
__device__ __forceinline__ unsigned pk4_fp8(float a, float b, float c, float d) { int r = 0; r = __builtin_amdgcn_cvt_pk_fp8_f32(a, b, r, false); r = __builtin_amdgcn_cvt_pk_fp8_f32(c, d, r, true); return (unsigned)r; }
template <class RowMap>
__device__ __forceinline__ void transpose_item_f8(const float* W, int ldw, unsigned char* WT, int Kdim, RowMap rm, LAS float* scr, int kb, int nb, int lane, float mul) {
    const int k0 = 64 * kb, n0 = 32 * nb; const int nl0 = lane & 31, nn = n0 + nl0;
#pragma unroll 8
    for (int i = 0; i < 32; ++i) { const int kk = 2 * i + (lane >> 5); scr[kk * 33 + nl0] = W[(size_t)(k0 + kk) * ldw + nn] * mul; }
    LDS_WAIT(); asm volatile("" ::: "memory");
    const int c = lane & 7;
#pragma unroll
    for (int j = 0; j < 4; ++j) { const int n = (lane >> 3) + 8 * j; const LAS float* s = scr + (8 * c) * 33 + n;
        v2u o; o.x = pk4_fp8(s[0 * 33], s[1 * 33], s[2 * 33], s[3 * 33]); o.y = pk4_fp8(s[4 * 33], s[5 * 33], s[6 * 33], s[7 * 33]);
        *(GAS v2u*)(WT + (size_t)rm(n0 + n) * Kdim + k0 + 8 * c) = o; }
    LDS_WAIT(); asm volatile("" ::: "memory");
}
struct RmId { __device__ __forceinline__ int operator()(int n) const { return n; } };
struct RmUp { int e; __device__ __forceinline__ int operator()(int n) const { return e * 2048 + ((n & 1023) >> 7) * 256 + (n >> 10) * 128 + (n & 127); } };
struct RmOff { int off; __device__ __forceinline__ int operator()(int n) const { return off + n; } };

struct CvtItem { const float* src; unsigned char* dst; int ldw; };
__device__ __forceinline__ CvtItem cvt_decode(const Params& P, int r) {
    unsigned char* ws = P.ws; CvtItem c;
    constexpr int I_O = 8 * 32, I_UP = 8 * 64, I_DN = 8 * 32;
    if (r < I_O) { const int kb = r / 32, nb = r % 32; c.src = P.in[I_WO] + (size_t)(128 * kb) * 1024 + 32 * nb; c.ldw = 1024; c.dst = ws + WS_WO_T + (size_t)(32 * nb) * 1024 + 128 * kb; return c; } r -= I_O;
    if (r < NE * I_UP) { const int e = r / I_UP, q = r % I_UP, kb = q / 64, nb = q % 64, n0 = 32 * nb; c.src = P.in[I_WUP] + (size_t)e * 1024 * 2048 + (size_t)(128 * kb) * 2048 + n0; c.ldw = 2048;
        c.dst = ws + WS_WUP_T + (size_t)(e * 2048 + ((n0 & 1023) >> 7) * 256 + (n0 >> 10) * 128 + (n0 & 127)) * 1024 + 128 * kb; return c; } r -= NE * I_UP;
    if (r < NE * I_DN) { const int e = r / I_DN, q = r % I_DN, kb = q / 32, nb = q % 32; c.src = P.in[I_WDN] + (size_t)e * 1024 * 1024 + (size_t)(128 * kb) * 1024 + 32 * nb; c.ldw = 1024;
        c.dst = ws + WS_WDN_T + (size_t)(e * 1024 + 32 * nb) * 1024 + 128 * kb; return c; } r -= NE * I_DN;
    { const int kb = r / 32, nb = r % 32; c.src = P.in[I_WPG] + (size_t)(128 * kb) * 1024 + 32 * nb; c.ldw = 1024; c.dst = ws + WS_WGATE_T + (size_t)(32 * nb) * 1024 + 128 * kb; return c; }
}
__device__ __forceinline__ void cvt_load(const CvtItem& c, float (&v)[64], int lane) {
    const float* p = c.src + (size_t)(lane >> 5) * c.ldw + (lane & 31);
#pragma unroll
    for (int i = 0; i < 64; ++i) v[i] = p[(size_t)(2 * i) * c.ldw];
}
__device__ __forceinline__ void cvt_store(const CvtItem& c, const float (&v)[64], LAS float* scr, int lane) {
#pragma unroll
    for (int i = 0; i < 64; ++i) scr[(2 * i + (lane >> 5)) * 33 + (lane & 31)] = v[i] * 64.f;
    LDS_WAIT(); asm volatile("" ::: "memory");
    const int ch = lane & 15;
#pragma unroll
    for (int j = 0; j < 8; ++j) { const int n = (lane >> 4) + 4 * j; const LAS float* s = scr + (8 * ch) * 33 + n;
        v2u o; o.x = pk4_fp8(s[0 * 33], s[1 * 33], s[2 * 33], s[3 * 33]); o.y = pk4_fp8(s[4 * 33], s[5 * 33], s[6 * 33], s[7 * 33]);
        *(GAS v2u*)(c.dst + (size_t)n * 1024 + 8 * ch) = o; }
    LDS_WAIT(); asm volatile("" ::: "memory");
}
__device__ __forceinline__ void convert_late(const Params& P, LAS float* scr, int gwc, int ngwc, int lane) {
    constexpr int NT = 8 * 32 + NE * 8 * 64 + NE * 8 * 32 + 8 * 32;
    float va[64], vb[64];
    int it = gwc;
    if (it < NT) { const CvtItem c = cvt_decode(P, it); cvt_load(c, va, lane); }
    for (; it < NT; it += 2 * ngwc) {
        const int i1 = it + ngwc, i2 = it + 2 * ngwc;
        if (i1 < NT) { const CvtItem c = cvt_decode(P, i1); cvt_load(c, vb, lane); }
        { const CvtItem c = cvt_decode(P, it); cvt_store(c, va, scr, lane); }
        if (i2 < NT) { const CvtItem c = cvt_decode(P, i2); cvt_load(c, va, lane); }
        if (i1 < NT) { const CvtItem c = cvt_decode(P, i1); cvt_store(c, vb, scr, lane); }
    }
    for (int r = gwc; r < 512; r += ngwc) { const int i = r * 64 + lane; const int e = i >> 10, k = i & 1023; ((float*)(P.ws + WS_WRT))[i] = P.in[I_WR][k * 32 + e]; }
}
__device__ __forceinline__ void p0_prologue(const Params& P, const Ctx& C) {
    LAS float* scr = (LAS float*)(C.lds + C.wave * 16384);
    unsigned char* ws = P.ws;
    constexpr int I_IN = 16 * (D_INP / 32), I_PP = 4 * 32, I_UK = 4 * 16, I_UV = 4 * 16;
    constexpr int NITEMS = I_IN + I_PP + I_UK + I_UV;
    for (int it = C.gw; it < NITEMS; it += C.ngw) {
        int r = it;
        if (r < I_IN) { transpose_item(P.in[I_WIN], D_IN, D_IN, (bf16*)(ws + WS_WIN_T), 1024, RmId{}, scr, r / (D_INP / 32), r % (D_INP / 32), C.lane); continue; } r -= I_IN;
        if (r < I_PP) { transpose_item(P.in[I_WPP], 1024, 1024, (bf16*)(ws + WS_WPROJ_T), 256, RmId{}, scr, r / 32, r % 32, C.lane); continue; } r -= I_PP;
        if (r < I_UK) { transpose_item(P.in[I_WUK], 512, 512, (bf16*)(ws + WS_WUK_T), 256, RmId{}, scr, r / 16, r % 16, C.lane); continue; } r -= I_UK;
        transpose_item(P.in[I_WUV], 512, 512, (bf16*)(ws + WS_WUV_T), 256, RmId{}, scr, r / 16, r % 16, C.lane);
    }
    {
        const float* x = P.in[I_X]; bf16* xb = (bf16*)(ws + WS_XBF);
        const size_t n8 = (size_t)NTOK * D / 8, stride = (size_t)C.ngw * 64;
        for (size_t i = (size_t)C.gw * 64 + C.lane; i < n8; i += stride) { const f32x4 a = *(const GAS f32x4*)(x + i * 8), b = *(const GAS f32x4*)(x + i * 8 + 4);
            v4u o; o.x = pk2(a[0], a[1]); o.y = pk2(a[2], a[3]); o.z = pk2(b[0], b[1]); o.w = pk2(b[2], b[3]); *(GAS v4u*)(xb + i * 8) = o; }
        const float* p = P.in[I_P]; bf16* pb = (bf16*)(ws + WS_PB);
        const size_t m8 = (size_t)NTOK * PLE / 8;
        for (size_t i = (size_t)C.gw * 64 + C.lane; i < m8; i += stride) { const f32x4 a = *(const GAS f32x4*)(p + i * 8), b = *(const GAS f32x4*)(p + i * 8 + 4);
            v4u o; o.x = pk2(a[0], a[1]); o.y = pk2(a[2], a[3]); o.z = pk2(b[0], b[1]); o.w = pk2(b[2], b[3]); *(GAS v4u*)(pb + i * 8) = o; }
    }
}

__device__ __forceinline__ void ln_row(f32x4 (&v)[4], const float* g, const float* b, int lane) {
    float s = 0.f;
#pragma unroll
    for (int j = 0; j < 4; ++j) s += (v[j][0] + v[j][1]) + (v[j][2] + v[j][3]);
    const float mean = wave_sum(s) * (1.f / D); float s2 = 0.f;
#pragma unroll
    for (int j = 0; j < 4; ++j) { v[j] = v[j] - mean; s2 += (v[j][0] * v[j][0] + v[j][1] * v[j][1]) + (v[j][2] * v[j][2] + v[j][3] * v[j][3]); }
    const float rstd = 1.f / sqrtf(wave_sum(s2) * (1.f / D) + LN_EPS);
#pragma unroll
    for (int j = 0; j < 4; ++j) { const f32x4 gg = *(const f32x4*)(g + 4 * lane + 256 * j), bb = *(const f32x4*)(b + 4 * lane + 256 * j); v[j] = v[j] * rstd * gg + bb; }
}
__device__ __forceinline__ void store_row_f32(float* row, const f32x4 (&v)[4], int lane) {
#pragma unroll
    for (int j = 0; j < 4; ++j) *(GAS f32x4*)(row + 4 * lane + 256 * j) = v[j];
}
__device__ __forceinline__ void store_row_bf16(bf16* row, const f32x4 (&v)[4], int lane) {
#pragma unroll
    for (int j = 0; j < 4; ++j) { v2u o; o.x = pk2(v[j][0], v[j][1]); o.y = pk2(v[j][2], v[j][3]); *(GAS v2u*)(row + 4 * lane + 256 * j) = o; }
}
__device__ __forceinline__ void store_row_fp8x8(unsigned char* row, const f32x4 (&v)[4], int lane) {
#pragma unroll
    for (int j = 0; j < 4; ++j) *(GAS unsigned*)(row + 4 * lane + 256 * j) = pk4_fp8(v[j][0] * 8.f, v[j][1] * 8.f, v[j][2] * 8.f, v[j][3] * 8.f);
}
__device__ __forceinline__ void load_row_bf16(f32x4 (&v)[4], const bf16* row, int lane) {
#pragma unroll
    for (int j = 0; j < 4; ++j) { const v2u w = *(const GAS v2u*)(row + 4 * lane + 256 * j); v[j] = (f32x4){bflo(w.x), bfhi(w.x), bflo(w.y), bfhi(w.y)}; }
}
__device__ __forceinline__ void load_row_f32(f32x4 (&v)[4], const float* row, int lane) {
#pragma unroll
    for (int j = 0; j < 4; ++j) v[j] = *(const GAS f32x4*)(row + 4 * lane + 256 * j);
}
#ifndef FEAT_MIX
#define FEAT_MIX 1
#endif
#ifndef FEAT_MOE
#define FEAT_MOE 1
#endif
#ifndef FEAT_PLE
#define FEAT_PLE 1
#endif
#ifndef FEAT_ATT
#define FEAT_ATT 1
#endif
#ifndef SYNC_MODE
#define SYNC_MODE 0
#endif
#ifndef PROGRAM
#define PROGRAM X(0) GS X(10) X(11) SY X(20) X(21) SY X(30) X(31) BS X(32) SY X(40) X(41) SY X(5) SY X(6) SY X(7) SY X(8) SY X(9) SY X(100) SY X(110) SY X(120)
#endif

typedef float f32x16 __attribute__((ext_vector_type(16)));
typedef short s16x4 __attribute__((ext_vector_type(4)));
__device__ __forceinline__ unsigned cvtpk(float lo, float hi) { typedef float f2 __attribute__((ext_vector_type(2))); typedef __bf16 b2 __attribute__((ext_vector_type(2))); f2 v = {lo, hi}; b2 b = __builtin_convertvector(v, b2); return __builtin_bit_cast(unsigned, b); }
__device__ __forceinline__ bf16x8 pack8(const f32x16& x, int base) {
    v4u w; w.x = cvtpk(x[base + 0], x[base + 1]); w.y = cvtpk(x[base + 2], x[base + 3]); w.z = cvtpk(x[base + 4], x[base + 5]); w.w = cvtpk(x[base + 6], x[base + 7]);
    return __builtin_bit_cast(bf16x8, w);
}

__device__ __forceinline__ void p2_post(const Params& P, const Ctx& C) {
    unsigned char* ws = P.ws;
    const bf16* H = (const bf16*)(ws + WS_H); bf16* CN = (bf16*)(ws + WS_CN); bf16* IKN = (bf16*)(ws + WS_IKN);
    const float* kvg = P.in[I_KVG]; const float* ikg = P.in[I_IKG]; const float* ikb = P.in[I_IKB];
    const f32x4 g4 = *(const f32x4*)(kvg + 4 * C.lane); const float ig = ikg[C.lane], ib = ikb[C.lane];
    for (int m = C.gw; m < NTOK; m += C.ngw) {
        const bf16* hr = H + (size_t)m * D_INP;
        const v2u w = *(const GAS v2u*)(hr + C_AC + 4 * C.lane);
        float a0 = bflo(w.x), a1 = bfhi(w.x), a2 = bflo(w.y), a3 = bfhi(w.y);
        const float ss = wave_sum((a0 * a0 + a1 * a1) + (a2 * a2 + a3 * a3));
        const float rs = 1.f / sqrtf(ss * (1.f / 256.f) + RMS_EPS);
        v2u o; o.x = pk2(a0 * rs * g4[0], a1 * rs * g4[1]); o.y = pk2(a2 * rs * g4[2], a3 * rs * g4[3]);
        *(GAS v2u*)(CN + (size_t)m * 256 + 4 * C.lane) = o;
        const float k = bf2f(hr[C_IK + C.lane]);
        const float mu = wave_sum(k) * (1.f / 64.f); const float dk = k - mu;
        const float var = wave_sum(dk * dk) * (1.f / 64.f);
        IKN[(size_t)m * 64 + C.lane] = (bf16)f2bf(dk * (1.f / sqrtf(var + LN_EPS)) * ig + ib);
    }
}

constexpr int HP_QD = 0, HP_KI = 8704, HP_KET = 17408, HP_VT = 27648, HP_GS = 37888, HP_RAW = 40960;
__device__ __forceinline__ void p2_hgrn_prep(const Params& P, const Ctx& C) {
    unsigned char* ws = P.ws;
    const bf16* H = (const bf16*)(ws + WS_H);
    bf16* UT = (bf16*)(ws + WS_U); bf16* QDEC = (bf16*)(ws + WS_QDEC); float* OREC = (float*)(ws + WS_OREC); float* DEC = (float*)(ws + WS_DECAY);
    LAS bf16* QD = (LAS bf16*)(C.lds + HP_QD); LAS bf16* KI = (LAS bf16*)(C.lds + HP_KI); LAS bf16* KET = (LAS bf16*)(C.lds + HP_KET); LAS bf16* VT = (LAS bf16*)(C.lds + HP_VT);
    LAS float* GS = (LAS float*)(C.lds + HP_GS); LAS bf16* RAW = (LAS bf16*)(C.lds + HP_RAW);
    const int d = C.tid & 127, tg = C.tid >> 7;
    const int lane = C.lane, r32 = lane & 31, hf = lane >> 5;
    const int lc = C.tid >> 4, lg = C.tid & 15;
    const int NU = NB * HG_H * (T / HG_C);
    v4u rf, rq, ri;
    { const int unit = blockIdx.x; if (unit < NU) { const int n = unit & 127, hh = (unit >> 7) & 3, b = unit >> 9; const bf16* hr = H + (size_t)(b * T + n * HG_C + lc) * D_INP + hh * 128 + 8 * lg;
        rf = *(const GAS v4u*)(hr + C_GF); rq = *(const GAS v4u*)(hr + C_GQ); ri = *(const GAS v4u*)(hr + C_GI); } }
    for (int unit = blockIdx.x; unit < NU; unit += C.G) {
        const int n = unit & 127, hh = (unit >> 7) & 3, b = unit >> 9;
        const int m0 = b * T + n * HG_C;
        *(LAS v4u*)(RAW + lc * 128 + 8 * lg) = rf; *(LAS v4u*)(RAW + 4096 + lc * 128 + 8 * lg) = rq; *(LAS v4u*)(RAW + 8192 + lc * 128 + 8 * lg) = ri;
        __syncthreads();
        { const int un = unit + C.G; if (un < NU) { const int n2 = un & 127, h2 = (un >> 7) & 3, b2 = un >> 9; const bf16* hr = H + (size_t)(b2 * T + n2 * HG_C + lc) * D_INP + h2 * 128 + 8 * lg;
            rf = *(const GAS v4u*)(hr + C_GF); rq = *(const GAS v4u*)(hr + C_GQ); ri = *(const GAS v4u*)(hr + C_GI); } }
        const float l0 = P.in[I_HGLB][hh * 128 + d], l1 = P.in[I_HGLB][512 + hh * 128 + d];
        const float lb = 1.f / (1.f + __expf(l1 - l0));
        float fg[8], bl[8], qv[8]; float run = 0.f; unsigned vv[4];
#pragma unroll
        for (int c = 0; c < 8; ++c) { const int tok = tg * 8 + c;
            const float f = bf2f(RAW[tok * 128 + d]), q = bf2f(RAW[4096 + tok * 128 + d]); const unsigned iv = RAW[8192 + tok * 128 + d];
            fg[c] = lb + (1.f - lb) * sigmoidf_(f); run += __logf(fg[c]); bl[c] = run; qv[c] = q * sigmoidf_(q);
            if (c & 1) vv[c >> 1] |= iv << 16; else vv[c >> 1] = iv; }
        GS[tg * 128 + d] = run;
        *(LAS v4u*)(VT + d * 40 + tg * 8) = (v4u){vv[0], vv[1], vv[2], vv[3]};
        __syncthreads();
        float pre = 0.f, tot = 0.f;
#pragma unroll
        for (int g = 0; g < 4; ++g) { const float sg = GS[g * 128 + d]; tot += sg; if (g < tg) pre += sg; }
        unsigned ke[4];
#pragma unroll
        for (int c = 0; c < 8; ++c) { const float bc = pre + bl[c]; const float kc = 1.f - fg[c];
            const float qd = qv[c] * __expf(bc), ki = kc * __expf(-bc), kend = kc * __expf(tot - bc);
            const unsigned qb = f2bf(qd);
            QD[(tg * 8 + c) * 136 + d] = (bf16)qb; KI[(tg * 8 + c) * 136 + d] = (bf16)f2bf(ki);
            if (c & 1) ke[c >> 1] |= f2bf(kend) << 16; else ke[c >> 1] = f2bf(kend); }
        *(LAS v4u*)(KET + d * 40 + tg * 8) = (v4u){ke[0], ke[1], ke[2], ke[3]};
        if (tg == 0) DEC[(size_t)unit * 128 + d] = __expf(tot);
        __syncthreads();
        *(GAS v4u*)(QDEC + (size_t)(m0 + lc) * 512 + hh * 128 + 8 * lg) = *(const LAS v4u*)(QD + lc * 136 + 8 * lg);
        if (C.wave < 4) {
            f32x16 X = {0.f, 0.f, 0.f, 0.f, 0.f, 0.f, 0.f, 0.f, 0.f, 0.f, 0.f, 0.f, 0.f, 0.f, 0.f, 0.f};
#pragma unroll
            for (int k = 0; k < 8; ++k) { const bf16x8 a = *(const LAS bf16x8*)(KI + r32 * 136 + 16 * k + 8 * hf), bq = *(const LAS bf16x8*)(QD + r32 * 136 + 16 * k + 8 * hf);
                X = __builtin_amdgcn_mfma_f32_32x32x16_bf16(a, bq, X, 0, 0, 0); }
#pragma unroll
            for (int r = 0; r < 16; ++r) { const int sidx = (r & 3) + 8 * (r >> 2) + 4 * hf; if (sidx > r32) X[r] = 0.f; }
            f32x16 Z = {0.f, 0.f, 0.f, 0.f, 0.f, 0.f, 0.f, 0.f, 0.f, 0.f, 0.f, 0.f, 0.f, 0.f, 0.f, 0.f};
            const int e = C.wave * 32 + r32;
#pragma unroll
            for (int sp = 0; sp < 2; ++sp) { const bf16x8 a = pack8(X, 8 * sp);
                const s16x4 lo = *(const LAS s16x4*)(VT + e * 40 + 16 * sp + 4 * hf), hi = *(const LAS s16x4*)(VT + e * 40 + 16 * sp + 8 + 4 * hf);
                const bf16x8 bv = (bf16x8){lo[0], lo[1], lo[2], lo[3], hi[0], hi[1], hi[2], hi[3]};
                Z = __builtin_amdgcn_mfma_f32_32x32x16_bf16(a, bv, Z, 0, 0, 0); }
#pragma unroll
            for (int r = 0; r < 16; ++r) { const int c = (r & 3) + 8 * (r >> 2) + 4 * hf; OREC[(size_t)(m0 + c) * 512 + hh * 128 + e] = Z[r]; }
        }
        {
            const int dt = C.wave >> 1;
            const bf16x8 a0 = *(const LAS bf16x8*)(KET + (dt * 32 + r32) * 40 + 8 * hf), a1 = *(const LAS bf16x8*)(KET + (dt * 32 + r32) * 40 + 16 + 8 * hf);
#pragma unroll
            for (int ei = 0; ei < 2; ++ei) { const int et = 2 * (C.wave & 1) + ei;
                const bf16x8 b0 = *(const LAS bf16x8*)(VT + (et * 32 + r32) * 40 + 8 * hf), b1 = *(const LAS bf16x8*)(VT + (et * 32 + r32) * 40 + 16 + 8 * hf);
                f32x16 U = {0.f, 0.f, 0.f, 0.f, 0.f, 0.f, 0.f, 0.f, 0.f, 0.f, 0.f, 0.f, 0.f, 0.f, 0.f, 0.f};
                U = __builtin_amdgcn_mfma_f32_32x32x16_bf16(a0, b0, U, 0, 0, 0); U = __builtin_amdgcn_mfma_f32_32x32x16_bf16(a1, b1, U, 0, 0, 0);
                bf16* up = UT + (size_t)unit * 16384 + (size_t)(et * 32 + r32) * 128 + dt * 32 + 4 * hf;
#pragma unroll
                for (int q = 0; q < 4; ++q) { v2u o; o.x = cvtpk(U[4 * q], U[4 * q + 1]); o.y = cvtpk(U[4 * q + 2], U[4 * q + 3]); *(GAS v2u*)(up + 8 * q) = o; } }
        }
        __syncthreads();
    }
}

__device__ __forceinline__ void scan_wave(const Params& P, LAS unsigned char* lds, int unit, int lane) {
    unsigned char* ws = P.ws;
    const bf16* UT = (const bf16*)(ws + WS_U); const bf16* QDEC = (const bf16*)(ws + WS_QDEC); float* OREC = (float*)(ws + WS_OREC); const float* DEC = (const float*)(ws + WS_DECAY);
    typedef float f32x4v __attribute__((ext_vector_type(4)));
    const int xcd = (unit >> 1) & 7, loc = ((unit >> 4) << 1) | (unit & 1);
    const int bh = xcd + 8 * (loc >> 4), sl = loc & 15; const int b = bh >> 2, hh = bh & 3, e0 = 8 * sl;
    LAS bf16* ST = (LAS bf16*)lds;
    const int e = lane & 7, dq = lane >> 3;
    const int fr = lane & 15, fq = lane >> 4;
    float S[16];
#pragma unroll
    for (int i = 0; i < 16; ++i) S[i] = 0.f;
    for (int i = lane; i < 2 * 16 * 136 / 8; i += 64) *(LAS v4u*)(ST + 8 * i) = (v4u){0u, 0u, 0u, 0u};
    const int cu0 = (b * HG_H + hh) * 128;
    const bf16* up = UT + (size_t)cu0 * 16384 + (size_t)(e0 + e) * 128 + 16 * dq;
    const float* dp = DEC + (size_t)cu0 * 128 + 16 * dq;
    const bf16* qp = QDEC + (size_t)(b * T + fr) * 512 + hh * 128 + 8 * fq;
    float* op = OREC + (size_t)(b * T + 4 * fq) * 512 + hh * 128 + e0 + fr;
    const float* opl = OREC + (size_t)(b * T + 4 * fq) * 512 + hh * 128 + e0 + (fr & 7);
    const bool ov = fr < 8;
    v4u un[4][2]; float oi[4][2][4]; f32x4 dn[2][4]; bf16x8 qa[2][2][4];
#define SC_LD_U(slot, n) { un[slot][0] = *(const GAS v4u*)(up + (size_t)(n) * 16384); un[slot][1] = *(const GAS v4u*)(up + (size_t)(n) * 16384 + 8); \
        _Pragma("unroll") for (int t_ = 0; t_ < 2; ++t_) _Pragma("unroll") for (int j_ = 0; j_ < 4; ++j_) oi[slot][t_][j_] = opl[(size_t)((n) * 32 + 16 * t_ + j_) * 512]; }
#define SC_LD_Q(slot, n) { _Pragma("unroll") for (int i_ = 0; i_ < 4; ++i_) dn[slot][i_] = *(const GAS f32x4*)(dp + (size_t)(n) * 128 + 4 * i_); \
        _Pragma("unroll") for (int t_ = 0; t_ < 2; ++t_) _Pragma("unroll") for (int k_ = 0; k_ < 4; ++k_) qa[slot][t_][k_] = *(const GAS bf16x8*)(qp + (size_t)((n) * 32 + 16 * t_) * 512 + 32 * k_); }
    SC_LD_U(0, 0) SC_LD_U(1, 1) SC_LD_U(2, 2) SC_LD_U(3, 3) SC_LD_Q(0, 0) SC_LD_Q(1, 1)
    LDS_WAIT();
    for (int nb = 0; nb < 32; ++nb) {
#pragma unroll
        for (int s = 0; s < 4; ++s) {
            const int n = 4 * nb + s; const int su = s, sq = s & 1;
            const LAS bf16* stc = ST + (n & 1) * (16 * 136); LAS bf16* stn = ST + ((n + 1) & 1) * (16 * 136);
            bf16x8 bs[4];
#pragma unroll
            for (int k = 0; k < 4; ++k) bs[k] = *(const LAS bf16x8*)(stc + fr * 136 + 32 * k + 8 * fq);
#pragma unroll
            for (int t = 0; t < 2; ++t) { f32x4v acc = {oi[su][t][0], oi[su][t][1], oi[su][t][2], oi[su][t][3]};
#pragma unroll
                for (int k = 0; k < 4; ++k) acc = __builtin_amdgcn_mfma_f32_16x16x32_bf16(qa[sq][t][k], bs[k], acc, 0, 0, 0);
                if (ov) {
#pragma unroll
                    for (int j = 0; j < 4; ++j) op[(size_t)(n * 32 + 16 * t + j) * 512] = acc[j]; } }
            {
                const unsigned uw[8] = {un[su][0].x, un[su][0].y, un[su][0].z, un[su][0].w, un[su][1].x, un[su][1].y, un[su][1].z, un[su][1].w};
                unsigned pk[8];
#pragma unroll
                for (int i = 0; i < 8; ++i) { S[2 * i] = dn[sq][i >> 1][(2 * i) & 3] * S[2 * i] + bflo(uw[i]); S[2 * i + 1] = dn[sq][i >> 1][(2 * i + 1) & 3] * S[2 * i + 1] + bfhi(uw[i]); pk[i] = cvtpk(S[2 * i], S[2 * i + 1]); }
                *(LAS v4u*)(stn + e * 136 + 16 * dq) = (v4u){pk[0], pk[1], pk[2], pk[3]}; *(LAS v4u*)(stn + e * 136 + 16 * dq + 8) = (v4u){pk[4], pk[5], pk[6], pk[7]};
            }
            if (n + 4 < 128) SC_LD_U(su, n + 4)
            if (n + 2 < 128) SC_LD_Q(sq, n + 2)
        }
    }
#undef SC_LD_U
#undef SC_LD_Q
}
__device__ __forceinline__ void p3_scan_convert(const Params& P, const Ctx& C) {
    if (C.wave < 2) {
        for (int u = blockIdx.x * 2 + C.wave; u < NB * HG_H * 16; u += C.G * 2) scan_wave(P, C.lds + C.wave * 8704, u, C.lane);
    } else {
        convert_late(P, (LAS float*)(C.lds + 32768 + (C.wave - 2) * 17408), blockIdx.x * 6 + (C.wave - 2), C.G * 6, C.lane);
    }
}

__device__ __forceinline__ void p4_yrec(const Params& P, const Ctx& C) {
    unsigned char* ws = P.ws;
    const float* OREC = (const float*)(ws + WS_OREC); const bf16* H = (const bf16*)(ws + WS_H); bf16* YM = (bf16*)(ws + WS_YMIX);
    const float* ng = P.in[I_HGNG];
    const f32x4 g0 = *(const f32x4*)(ng + 8 * C.lane), g1 = *(const f32x4*)(ng + 8 * C.lane + 4);
    for (int m = C.gw; m < NTOK; m += C.ngw) {
        const f32x4 a = *(const GAS f32x4*)(OREC + (size_t)m * 512 + 8 * C.lane), bq = *(const GAS f32x4*)(OREC + (size_t)m * 512 + 8 * C.lane + 4);
        float ss = (a[0] * a[0] + a[1] * a[1]) + (a[2] * a[2] + a[3] * a[3]) + (bq[0] * bq[0] + bq[1] * bq[1]) + (bq[2] * bq[2] + bq[3] * bq[3]);
        ss += __shfl_xor(ss, 1); ss += __shfl_xor(ss, 2); ss += __shfl_xor(ss, 4); ss += __shfl_xor(ss, 8);
        const float rs = 1.f / sqrtf(ss * (1.f / 128.f) + RMS_EPS);
        const v4u gw = *(const GAS v4u*)(H + (size_t)m * D_INP + C_GG + 8 * C.lane);
        float gv[8] = {bflo(gw.x), bfhi(gw.x), bflo(gw.y), bfhi(gw.y), bflo(gw.z), bfhi(gw.z), bflo(gw.w), bfhi(gw.w)};
        float o[8];
#pragma unroll
        for (int j = 0; j < 4; ++j) { o[j] = a[j] * rs * g0[j] * (gv[j] * sigmoidf_(gv[j])); o[4 + j] = bq[j] * rs * g1[j] * (gv[4 + j] * sigmoidf_(gv[4 + j])); }
        v2u w; w.x = pk4_fp8(o[0] * 8.f, o[1] * 8.f, o[2] * 8.f, o[3] * 8.f); w.y = pk4_fp8(o[4] * 8.f, o[5] * 8.f, o[6] * 8.f, o[7] * 8.f);
        *(GAS v2u*)((unsigned char*)YM + (size_t)m * D + 512 + 8 * C.lane) = w;
#if !FEAT_ATT
        *(GAS v4u*)(YM + (size_t)m * D + 8 * C.lane) = (v4u){0u, 0u, 0u, 0u};
#endif
    }
}

namespace pg8 {
struct EpiKhead {
    static constexpr bool PERM = true, AFTER_DRAIN = false;
    bf16_t* O;
    __device__ __forceinline__ void operator()(const f32x4 (&acc)[2][2][4][2], const Unit& u, int wr, int wc, int fr, int fq) const {
        const int row0 = u.pm * BM + wr * 64 + fr, col0 = u.pn * BM + wc * 32 + 8 * fq;
#pragma unroll
        for (int ai = 0; ai < 2; ++ai)
#pragma unroll
            for (int m = 0; m < 4; ++m) { const int row = row0 + ai * HALF + m * 16; const int b = row >> 12, t = row & 4095;
#pragma unroll
                for (int bj = 0; bj < 2; ++bj) { const int col = col0 + bj * HALF; const f32x4 v0 = acc[ai][bj][m][0], v1 = acc[ai][bj][m][1];
                    u32x4 w; w.x = cvt_pk_bf16(v0[0], v0[1]); w.y = cvt_pk_bf16(v0[2], v0[3]); w.z = cvt_pk_bf16(v1[0], v1[1]); w.w = cvt_pk_bf16(v1[2], v1[3]);
                    *(u32x4*)(O + ((size_t)((b * 8 + (col >> 6)) * 4096 + t)) * 64 + (col & 63)) = w; } }
    }
};
struct EpiVt {
    static constexpr bool PERM = true, AFTER_DRAIN = false;
    bf16_t* O;
    __device__ __forceinline__ void operator()(const f32x4 (&acc)[2][2][4][2], const Unit& u, int wr, int wc, int fr, int fq) const {
        const int row0 = u.pm * BM + wr * 64 + fr, col0 = u.pn * BM + wc * 32 + 8 * fq;
#pragma unroll
        for (int ai = 0; ai < 2; ++ai)
#pragma unroll
            for (int m = 0; m < 4; ++m) { const int row = row0 + ai * HALF + m * 16;
#pragma unroll
                for (int bj = 0; bj < 2; ++bj) { const int col = col0 + bj * HALF; const int b = col >> 12, t = col & 4095; const f32x4 v0 = acc[ai][bj][m][0], v1 = acc[ai][bj][m][1];
                    u32x4 w; w.x = cvt_pk_bf16(v0[0], v0[1]); w.y = cvt_pk_bf16(v0[2], v0[3]); w.z = cvt_pk_bf16(v1[0], v1[1]); w.w = cvt_pk_bf16(v1[2], v1[3]);
                    *(u32x4*)(O + ((size_t)(b * 512 + row)) * 4096 + t) = w; } }
    }
};
}

__device__ __forceinline__ unsigned f2ord(float x) { const unsigned b = __builtin_bit_cast(unsigned, x); return b ^ ((unsigned)((int)b >> 31) | 0x80000000u); }
typedef _Float16 h16;
typedef _Float16 h16x8 __attribute__((ext_vector_type(8)));
__device__ __forceinline__ float relu_i(float x) { const int b = __builtin_bit_cast(int, x); return __builtin_bit_cast(float, b > 0 ? b : 0); }
__device__ __forceinline__ unsigned h2ord(unsigned hb) { return (hb ^ ((hb & 0x8000u) ? 0xffffu : 0x8000u)) & 0xffffu; }
__device__ __forceinline__ int isc_bucket(float x, float mu, float scale) { const float t = fminf(fmaxf(fmaf(x - mu, scale, 128.f), 0.f), 255.f); return (int)t; }
__device__ __forceinline__ void p3_indexer(const Params& P, const Ctx& C) {
    unsigned char* ws = P.ws;
    const bf16* H = (const bf16*)(ws + WS_H); const bf16* IKN = (const bf16*)(ws + WS_IKN); unsigned* MASK = (unsigned*)(ws + WS_MASK);
    LAS h16* ISC = (LAS h16*)C.lds; LAS unsigned* HIST = (LAS unsigned*)(C.lds + 131072) + C.wave * 256; LAS float* STAT = (LAS float*)(C.lds + 139264); LAS float* W16 = (LAS float*)(C.lds + 140288);
    const int lane = C.lane, r32 = lane & 31, hf = lane >> 5;
    const int ql = 2 * (r32 >> 4) + ((r32 >> 2) & 1), hd = 4 * ((r32 >> 3) & 1) + (r32 & 3);
    constexpr int CAND_CAP = 120, QU = 16;
    for (int u = blockIdx.x; u < NTOK / QU; u += C.G) {
        const int b = u & 7, j = (u >> 3) & 31, i = u >> 8; const int pi = i >> 1; const int blk = (i & 1) ? (255 - (j + 32 * pi)) : (j + 32 * pi);
        const int t0 = blk * QU; const size_t mb = (size_t)b * T;
        const int nkt = (t0 + QU + 31) >> 5;
        bf16x8 af[4][4];
#pragma unroll
        for (int a = 0; a < 4; ++a) {
            const bf16* qp = H + (mb + t0 + 4 * a + ql) * D_INP + C_IQ + hd * 64 + 8 * hf;
#pragma unroll
            for (int k = 0; k < 4; ++k) af[a][k] = *(const GAS bf16x8*)(qp + 16 * k);
        }
        if (C.tid < 128) { const int q = C.tid >> 3, h8 = C.tid & 7; W16[C.tid] = bf2f(H[(mb + t0 + q) * D_INP + C_IW + h8]) * (0.125f * 0.35355339059327373f); }
        __syncthreads();
        {
            int kt = C.wave; bf16x8 bk[4], bn[4];
            if (kt < nkt) { const bf16* kp = IKN + (mb + kt * 32 + r32) * 64 + 8 * hf;
#pragma unroll
                for (int k = 0; k < 4; ++k) bk[k] = *(const GAS bf16x8*)(kp + 16 * k); }
            for (; kt < nkt; kt += NWAVES) {
                const int s0 = kt * 32;
                if (kt + NWAVES < nkt) { const bf16* kp = IKN + (mb + s0 + 32 * NWAVES + r32) * 64 + 8 * hf;
#pragma unroll
                    for (int k = 0; k < 4; ++k) bn[k] = *(const GAS bf16x8*)(kp + 16 * k); }
#pragma unroll
                for (int a = 0; a < 4; ++a) {
                    f32x16 acc = {0.f, 0.f, 0.f, 0.f, 0.f, 0.f, 0.f, 0.f, 0.f, 0.f, 0.f, 0.f, 0.f, 0.f, 0.f, 0.f};
#pragma unroll
                    for (int k = 0; k < 4; ++k) acc = __builtin_amdgcn_mfma_f32_32x32x16_bf16(af[a][k], bk[k], acc, 0, 0, 0);
#pragma unroll
                    for (int qh = 0; qh < 2; ++qh) { float sa = 0.f, sb = 0.f;
                        const int q = 4 * a + 2 * qh + hf, key = s0 + r32;
                        const f32x4 wl = *(const LAS f32x4*)(W16 + q * 8), wh = *(const LAS f32x4*)(W16 + q * 8 + 4);
                        sa = fmaf(wl[0], relu_i(acc[8 * qh + 0]), sa); sb = fmaf(wl[1], relu_i(acc[8 * qh + 1]), sb); sa = fmaf(wl[2], relu_i(acc[8 * qh + 2]), sa); sb = fmaf(wl[3], relu_i(acc[8 * qh + 3]), sb);
                        sa = fmaf(wh[0], relu_i(acc[8 * qh + 4]), sa); sb = fmaf(wh[1], relu_i(acc[8 * qh + 5]), sb); sa = fmaf(wh[2], relu_i(acc[8 * qh + 6]), sa); sb = fmaf(wh[3], relu_i(acc[8 * qh + 7]), sb);
                        float sv = sa + sb; const bool valid = key <= t0 + q; sv += 0.0f;
                        ISC[q * 4096 + key] = valid ? (h16)sv : (h16)(-INFINITY);
                    }
                }
#pragma unroll
                for (int k = 0; k < 4; ++k) bk[k] = bn[k];
            }
        }
        __syncthreads();
        for (int q = C.wave; q < QU; q += NWAVES) {
            const int t = t0 + q, n = t + 1; const LAS unsigned short* row = (const LAS unsigned short*)(ISC + q * 4096);
            unsigned* mrow = MASK + (mb + t) * 128;
            if (n <= TOPK) {
#pragma unroll
                for (int w2 = 0; w2 < 2; ++w2) { const int wi = lane + 64 * w2; const int lo = 32 * wi; unsigned bits;
                    if (lo + 31 <= t) bits = 0xffffffffu; else if (lo > t) bits = 0u; else bits = (1u << (t - lo + 1)) - 1u;
                    mrow[wi] = bits; }
            } else {
                unsigned dhi = 0u; int need = TOPK;
#pragma unroll
                for (int pass = 1; pass >= 0; --pass) {
                    LDS_WAIT();
#pragma unroll
                    for (int z = 0; z < 4; ++z) HIST[lane + 64 * z] = 0u;
#pragma unroll 2
                    for (int e0 = 8 * lane; e0 < n; e0 += 512) { const v4u v = *(const LAS v4u*)(row + e0);
#pragma unroll
                        for (int jj = 0; jj < 8; ++jj) { const unsigned w = (jj < 2) ? v.x : (jj < 4) ? v.y : (jj < 6) ? v.z : v.w; const unsigned hb = (jj & 1) ? (w >> 16) : (w & 0xffffu);
                            const unsigned key = h2ord(hb);
                            const bool ok = (e0 + jj < n) && (pass == 1 || (key >> 8) == dhi);
                            if (ok) atomicAdd((unsigned*)&HIST[pass == 1 ? (key >> 8) : (key & 255u)], 1u); } }
                    LDS_WAIT();
                    const v4u c4 = *(const LAS v4u*)(HIST + 4 * lane);
                    const unsigned c0 = c4.x, c1 = c4.y, c2 = c4.z, c3 = c4.w; const unsigned s4 = c0 + c1 + c2 + c3;
                    unsigned suf = s4;
#pragma unroll
                    for (int o = 1; o < 64; o <<= 1) { const unsigned v2 = __shfl_down(suf, o); if (lane + o < 64) suf += v2; }
                    unsigned cum = suf - s4; int dsel = -1; int nnew = 0; const unsigned nd = (unsigned)need;
                    if (cum < nd && nd <= cum + c3) { dsel = 4 * lane + 3; nnew = (int)(nd - cum); } cum += c3;
                    if (dsel < 0 && cum < nd && nd <= cum + c2) { dsel = 4 * lane + 2; nnew = (int)(nd - cum); } cum += c2;
                    if (dsel < 0 && cum < nd && nd <= cum + c1) { dsel = 4 * lane + 1; nnew = (int)(nd - cum); } cum += c1;
                    if (dsel < 0 && cum < nd && nd <= cum + c0) { dsel = 4 * lane + 0; nnew = (int)(nd - cum); }
                    const unsigned long long bal = __ballot(dsel >= 0);
                    const int src = (bal != 0ull) ? (int)__builtin_ctzll(bal) : 0;
                    const int dd = __shfl(dsel, src); need = __shfl(nnew, src);
                    if (pass == 1) dhi = (unsigned)dd; else dhi = (dhi << 8) | (unsigned)dd;
                }
                const unsigned Tk = dhi;
                int run_eq = 0; unsigned long long mine = 0ull; const int nit = (t >> 6) + 1;
#pragma unroll 4
                for (int it = 0; it < nit; ++it) { const int e = it * 64 + lane; const unsigned key = h2ord(row[e]); const bool valid = e <= t;
                    const bool eq = valid && (key == Tk); const unsigned long long beq = __ballot(eq);
                    const int rk = run_eq + __builtin_popcountll(beq & ((1ull << lane) - 1ull));
                    const bool sel = valid && ((key > Tk) || (eq && rk < need)); run_eq += __builtin_popcountll(beq);
                    const unsigned long long bs = __ballot(sel);
                    if (lane == it) mine = bs; }
                *(GAS v2u*)(mrow + 2 * lane) = (v2u){(unsigned)mine, (unsigned)(mine >> 32)};
            }
        }
        __syncthreads();
    }
}

__device__ __forceinline__ void attn_task(const bf16* H, const bf16* KH, const bf16* VT, const unsigned* MASK, bf16* YM, int b, int hh, int t0, int lane) {
    const int r32 = lane & 31, hf = lane >> 5;
    const float LOG2E = 1.4426950408889634f; const float c1 = 0.125f * LOG2E; const float sl2 = exp2f(-(float)(hh + 1)) * LOG2E;
    const size_t mb = (size_t)b * T;
    bf16x8 qf[4];
#pragma unroll
    for (int k = 0; k < 4; ++k) qf[k] = *(const GAS bf16x8*)(H + (mb + t0 + r32) * D_INP + C_AQ + hh * 64 + 16 * k + 8 * hf);
    const bf16* kbase = KH + ((size_t)(b * 8 + hh) * T) * 64; const bf16* vbase = VT + ((size_t)(b * 512 + hh * 64)) * T; const unsigned* mrow = MASK + (mb + t0 + r32) * 128;
    float m_run = -1e30f, l = 0.f;
    f32x16 O0 = {0.f, 0.f, 0.f, 0.f, 0.f, 0.f, 0.f, 0.f, 0.f, 0.f, 0.f, 0.f, 0.f, 0.f, 0.f, 0.f}, O1 = O0;
    const int nkt = (t0 + 32 + 63) >> 6;
    for (int kt = 0; kt < nkt; ++kt) {
        const int s0 = kt * 64;
        bf16x8 kf[2][4];
#pragma unroll
        for (int uu = 0; uu < 2; ++uu)
#pragma unroll
            for (int k = 0; k < 4; ++k) kf[uu][k] = *(const GAS bf16x8*)(kbase + (size_t)(s0 + 32 * uu + r32) * 64 + 16 * k + 8 * hf);
        const v2u mw = *(const GAS v2u*)(mrow + 2 * kt);
        s16x4 vl[2][2][2], vh[2][2][2];
#pragma unroll
        for (int uu = 0; uu < 2; ++uu)
#pragma unroll
            for (int sp = 0; sp < 2; ++sp)
#pragma unroll
                for (int dt = 0; dt < 2; ++dt) { const bf16* vp = vbase + (size_t)(dt * 32 + r32) * T + s0 + 32 * uu + 16 * sp + 4 * hf;
                    vl[uu][sp][dt] = *(const GAS s16x4*)vp; vh[uu][sp][dt] = *(const GAS s16x4*)(vp + 8); }
        f32x16 a0 = {0.f, 0.f, 0.f, 0.f, 0.f, 0.f, 0.f, 0.f, 0.f, 0.f, 0.f, 0.f, 0.f, 0.f, 0.f, 0.f}, a1 = a0;
#pragma unroll
        for (int k = 0; k < 4; ++k) { a0 = __builtin_amdgcn_mfma_f32_32x32x16_bf16(kf[0][k], qf[k], a0, 0, 0, 0); a1 = __builtin_amdgcn_mfma_f32_32x32x16_bf16(kf[1][k], qf[k], a1, 0, 0, 0); }
        const float dist0 = (float)(t0 + r32 - s0 - 4 * hf);
        const unsigned m0 = mw.x >> (4 * hf), m1 = mw.y >> (4 * hf);
        float mx = -1e30f;
#pragma unroll
        for (int r = 0; r < 16; ++r) { const int ko = (r & 3) + 8 * (r >> 2);
            const float d0 = dist0 - (float)ko;
            a0[r] = ((m0 >> ko) & 1u) ? (a0[r] * c1 - sl2 * d0) : -1e30f;
            a1[r] = ((m1 >> ko) & 1u) ? (a1[r] * c1 - sl2 * (d0 - 32.f)) : -1e30f;
            mx = fmaxf(mx, fmaxf(a0[r], a1[r])); }
        mx = fmaxf(mx, __shfl_xor(mx, 32));
        const float m_new = fmaxf(m_run, mx); const float alpha = __builtin_amdgcn_exp2f(m_run - m_new); m_run = m_new;
        float ps = 0.f;
#pragma unroll
        for (int r = 0; r < 16; ++r) { const int ko = (r & 3) + 8 * (r >> 2);
            const float p0 = ((m0 >> ko) & 1u) ? __builtin_amdgcn_exp2f(a0[r] - m_new) : 0.f;
            const float p1 = ((m1 >> ko) & 1u) ? __builtin_amdgcn_exp2f(a1[r] - m_new) : 0.f;
            a0[r] = p0; a1[r] = p1; ps += p0 + p1; }
        l = l * alpha + ps;
#pragma unroll
        for (int r = 0; r < 16; ++r) { O0[r] *= alpha; O1[r] *= alpha; }
#pragma unroll
        for (int sp = 0; sp < 2; ++sp) {
            const bf16x8 pb0 = pack8(a0, 8 * sp), pb1 = pack8(a1, 8 * sp);
#define VFR(uu, dt) ((bf16x8){vl[uu][sp][dt][0], vl[uu][sp][dt][1], vl[uu][sp][dt][2], vl[uu][sp][dt][3], vh[uu][sp][dt][0], vh[uu][sp][dt][1], vh[uu][sp][dt][2], vh[uu][sp][dt][3]})
            O0 = __builtin_amdgcn_mfma_f32_32x32x16_bf16(VFR(0, 0), pb0, O0, 0, 0, 0);
            O1 = __builtin_amdgcn_mfma_f32_32x32x16_bf16(VFR(0, 1), pb0, O1, 0, 0, 0);
            O0 = __builtin_amdgcn_mfma_f32_32x32x16_bf16(VFR(1, 0), pb1, O0, 0, 0, 0);
            O1 = __builtin_amdgcn_mfma_f32_32x32x16_bf16(VFR(1, 1), pb1, O1, 0, 0, 0);
#undef VFR
        }
    }
    l += __shfl_xor(l, 32);
    const float inv = 1.f / l;
    bf16* yp = YM + (mb + t0 + r32) * D + hh * 64 + 4 * hf;
#pragma unroll
    for (int rq = 0; rq < 4; ++rq) {
        v2u o; o.x = cvtpk(O0[4 * rq] * inv, O0[4 * rq + 1] * inv); o.y = cvtpk(O0[4 * rq + 2] * inv, O0[4 * rq + 3] * inv); *(GAS v2u*)(yp + 8 * rq) = o;
        v2u o2; o2.x = cvtpk(O1[4 * rq] * inv, O1[4 * rq + 1] * inv); o2.y = cvtpk(O1[4 * rq + 2] * inv, O1[4 * rq + 3] * inv); *(GAS v2u*)(yp + 32 + 8 * rq) = o2; }
}
__device__ __forceinline__ void p4_attention(const Params& P, const Ctx& C) {
    unsigned char* ws = P.ws;
    const bf16* H = (const bf16*)(ws + WS_H); const bf16* KH = (const bf16*)(ws + WS_K); const bf16* VT = (const bf16*)(ws + WS_VT); const unsigned* MASK = (const unsigned*)(ws + WS_MASK); bf16* YM = (bf16*)(ws + WS_YMIX);
    for (int p = blockIdx.x; p < 512; p += C.G) {
        const int bh = p >> 3, j = p & 7; const int b = bh >> 3, hh = bh & 7;
        attn_task(H, KH, VT, MASK, YM, b, hh, j * 256 + C.wave * 32, C.lane);
        attn_task(H, KH, VT, MASK, YM, b, hh, (15 - j) * 256 + (7 - C.wave) * 32, C.lane);
    }
}

constexpr int AT_KB = 64 * 144, AT_VB = 64 * 136, AT_VOFF = 2 * AT_KB;
__device__ __forceinline__ void attn_block(const Ctx& C, const bf16* H, const bf16* KH, const bf16* VT, const unsigned* MASK, bf16* YM, int b, int hh, int qb) {
    const int lane = C.lane, r32 = lane & 31, hf = lane >> 5, tid = C.tid;
    const float LOG2E = 1.4426950408889634f; const float c1 = 0.125f * LOG2E; const float sl2 = exp2f(-(float)(hh + 1)) * LOG2E;
    const size_t mb = (size_t)b * T; const int t0 = qb * 256 + C.wave * 32;
    bf16x8 qf[4];
#pragma unroll
    for (int k = 0; k < 4; ++k) { const v4u w = *(const GAS v4u*)(H + (mb + t0 + r32) * D_INP + C_AQ + hh * 64 + 16 * k + 8 * hf);
        v4u o; o.x = cvtpk(bflo(w.x) * c1, bfhi(w.x) * c1); o.y = cvtpk(bflo(w.y) * c1, bfhi(w.y) * c1); o.z = cvtpk(bflo(w.z) * c1, bfhi(w.z) * c1); o.w = cvtpk(bflo(w.w) * c1, bfhi(w.w) * c1);
        qf[k] = __builtin_bit_cast(bf16x8, o); }
    const bf16* kbase = KH + ((size_t)(b * 8 + hh) * T) * 64; const bf16* vbase = VT + ((size_t)(b * 512 + hh * 64)) * T; const unsigned* mrow = MASK + (mb + t0 + r32) * 128;
    const int srow = tid >> 3, sch = tid & 7;
    const bf16* kst = kbase + (size_t)srow * 64 + 8 * sch; const bf16* vst = vbase + (size_t)srow * T + 8 * sch;
    LAS unsigned char* kw = C.lds + srow * 144 + 16 * sch; LAS unsigned char* vw = C.lds + AT_VOFF + srow * 136 + 16 * sch;
    const LAS unsigned char* kr = C.lds + r32 * 144 + 16 * hf; const LAS unsigned char* vr = C.lds + AT_VOFF + r32 * 136 + 8 * hf;
    float m_run = -1e30f, l = 0.f;
    f32x16 O0 = {0.f, 0.f, 0.f, 0.f, 0.f, 0.f, 0.f, 0.f, 0.f, 0.f, 0.f, 0.f, 0.f, 0.f, 0.f, 0.f}, O1 = O0;
    const int nkt = 4 * (qb + 1), ktw = (t0 + 31) >> 6;
    v4u kn = *(const GAS v4u*)kst, vn = *(const GAS v4u*)vst; v2u mwn = *(const GAS v2u*)mrow;
    *(LAS v4u*)kw = kn; *(LAS v2u*)vw = (v2u){vn.x, vn.y}; *(LAS v2u*)(vw + 8) = (v2u){vn.z, vn.w};
    __syncthreads();
    for (int kt = 0; kt < nkt; ++kt) {
        const int s0 = kt * 64; const int cur = kt & 1; const v2u mw = mwn;
        if (kt + 1 < nkt) { kn = *(const GAS v4u*)(kst + (size_t)(s0 + 64) * 64); vn = *(const GAS v4u*)(vst + s0 + 64); mwn = *(const GAS v2u*)(mrow + 2 * kt + 2); }
        if (kt <= ktw) {
            const LAS unsigned char* kc = kr + cur * AT_KB; const LAS unsigned char* vc = vr + cur * AT_VB;
            const float B0 = -sl2 * (float)(t0 + r32 - s0 - 4 * hf);
            f32x16 a0, a1;
#pragma unroll
            for (int r = 0; r < 16; ++r) { const float ko = (float)((r & 3) + 8 * (r >> 2)); a0[r] = B0 + sl2 * ko; a1[r] = B0 + sl2 * (ko + 32.f); }
#pragma unroll
            for (int k = 0; k < 4; ++k) { const bf16x8 k0 = *(const LAS bf16x8*)(kc + 32 * k), k1 = *(const LAS bf16x8*)(kc + 32 * 144 + 32 * k);
                a0 = __builtin_amdgcn_mfma_f32_32x32x16_bf16(k0, qf[k], a0, 0, 0, 0); a1 = __builtin_amdgcn_mfma_f32_32x32x16_bf16(k1, qf[k], a1, 0, 0, 0); }
            const unsigned m0 = mw.x >> (4 * hf), m1 = mw.y >> (4 * hf);
            float mx = -1e30f;
#pragma unroll
            for (int r = 0; r < 16; ++r) { const int ko = (r & 3) + 8 * (r >> 2);
                const unsigned k0m = (unsigned)__builtin_amdgcn_sbfe((int)m0, ko, 1), k1m = (unsigned)__builtin_amdgcn_sbfe((int)m1, ko, 1);
                const float x0 = a0[r], x1 = a1[r];
                a0[r] = __builtin_bit_cast(float, (__builtin_bit_cast(unsigned, x0) & k0m) | (0xf149f2cau & ~k0m));
                a1[r] = __builtin_bit_cast(float, (__builtin_bit_cast(unsigned, x1) & k1m) | (0xf149f2cau & ~k1m));
                mx = fmaxf(mx, fmaxf(a0[r], a1[r])); }
            mx = fmaxf(mx, __shfl_xor(mx, 32));
            const float m_new = fmaxf(m_run, mx);
            const float m_use = fmaxf(m_new, -1e20f);
            float ps = 0.f;
#pragma unroll
            for (int r = 0; r < 16; ++r) { const float p0 = __builtin_amdgcn_exp2f(a0[r] - m_use), p1 = __builtin_amdgcn_exp2f(a1[r] - m_use); a0[r] = p0; a1[r] = p1; ps += p0 + p1; }
            if (__builtin_amdgcn_ballot_w64(m_new != m_run) != 0ull) {
                const float alpha = __builtin_amdgcn_exp2f(m_run - m_new); m_run = m_new;
                l *= alpha;
#pragma unroll
                for (int r = 0; r < 16; ++r) { O0[r] *= alpha; O1[r] *= alpha; }
            }
            l += ps;
#pragma unroll
            for (int sp = 0; sp < 2; ++sp) {
                const bf16x8 pb0 = pack8(a0, 8 * sp), pb1 = pack8(a1, 8 * sp);
#define VLD(uu, dt) ({ const s16x4 lo_ = *(const LAS s16x4*)(vc + (dt) * 32 * 136 + 2 * (32 * (uu) + 16 * sp)), hi_ = *(const LAS s16x4*)(vc + (dt) * 32 * 136 + 2 * (32 * (uu) + 16 * sp + 8)); (bf16x8){lo_[0], lo_[1], lo_[2], lo_[3], hi_[0], hi_[1], hi_[2], hi_[3]}; })
                O0 = __builtin_amdgcn_mfma_f32_32x32x16_bf16(VLD(0, 0), pb0, O0, 0, 0, 0);
                O1 = __builtin_amdgcn_mfma_f32_32x32x16_bf16(VLD(0, 1), pb0, O1, 0, 0, 0);
                O0 = __builtin_amdgcn_mfma_f32_32x32x16_bf16(VLD(1, 0), pb1, O0, 0, 0, 0);
                O1 = __builtin_amdgcn_mfma_f32_32x32x16_bf16(VLD(1, 1), pb1, O1, 0, 0, 0);
#undef VLD
            }
        }
        if (kt + 1 < nkt) { const int nx = cur ^ 1; *(LAS v4u*)(kw + nx * AT_KB) = kn; *(LAS v2u*)(vw + nx * AT_VB) = (v2u){vn.x, vn.y}; *(LAS v2u*)(vw + nx * AT_VB + 8) = (v2u){vn.z, vn.w}; }
        __syncthreads();
    }
    l += __shfl_xor(l, 32);
    const float inv = 1.f / l;
    unsigned char* yp = (unsigned char*)YM + (mb + t0 + r32) * D + hh * 64 + 4 * hf;
    const float i8 = inv * 8.f;
#pragma unroll
    for (int rq = 0; rq < 4; ++rq) {
        *(GAS unsigned*)(yp + 8 * rq) = pk4_fp8(O0[4 * rq] * i8, O0[4 * rq + 1] * i8, O0[4 * rq + 2] * i8, O0[4 * rq + 3] * i8);
        *(GAS unsigned*)(yp + 32 + 8 * rq) = pk4_fp8(O1[4 * rq] * i8, O1[4 * rq + 1] * i8, O1[4 * rq + 2] * i8, O1[4 * rq + 3] * i8); }
}
__device__ __forceinline__ void p4_attention2(const Params& P, const Ctx& C) {
    unsigned char* ws = P.ws;
    const bf16* H = (const bf16*)(ws + WS_H); const bf16* KH = (const bf16*)(ws + WS_K); const bf16* VT = (const bf16*)(ws + WS_VT); const unsigned* MASK = (const unsigned*)(ws + WS_MASK); bf16* YM = (bf16*)(ws + WS_YMIX);
    for (int p = blockIdx.x; p < 512; p += C.G) {
        const int b = p & 7, q = p >> 3; const int hh = q >> 3, j = q & 7;
        attn_block(C, H, KH, VT, MASK, YM, b, hh, j);
        attn_block(C, H, KH, VT, MASK, YM, b, hh, 15 - j);
    }
}


#ifndef FEAT_MIX
#define FEAT_MIX 1
#endif
#ifndef FEAT_MOE
#define FEAT_MOE 1
#endif
#ifndef FEAT_PLE
#define FEAT_PLE 1
#endif
#ifndef FEAT_ATT
#define FEAT_ATT 1
#endif

template <bool PUBLISH = true> __device__ __forceinline__ void p6_ln1_router(const Params& P, const Ctx& C) {
    unsigned char* ws = P.ws;
    bf16* X1 = (bf16*)(ws + WS_X1); unsigned char* XB = ws + WS_XB;
    LAS float* wl = (LAS float*)C.lds;
    LAS int* hist = (LAS int*)(C.lds + MISC_OFF);
    { const float* wrt = (const float*)(ws + WS_WRT);
      for (int i = C.tid; i < 32 * 1024 / 4; i += NTHR) *(LAS f32x4*)(wl + 4 * i) = *(const GAS f32x4*)(wrt + 4 * i);
      if (C.tid < 32) hist[C.tid] = 0; }
    __syncthreads();
    int* tope = (int*)(ws + WS_TOPE); float* gate = (float*)(ws + WS_GATE); int* lrank = (int*)(ws + WS_LRANK);
    const bf16* src = (const bf16*)P.out;
    const int lane = C.lane, hf = lane >> 5, ex = lane & 31;
    const float brl = P.in[I_BR][ex];
    for (int m0 = 2 * C.gw; m0 < NTOK; m0 += 2 * C.ngw) {
        f32x4 va[4], vb[4]; load_row_bf16(va, src + (size_t)m0 * D, lane); load_row_bf16(vb, src + (size_t)(m0 + 1) * D, lane);
        ln_row(va, P.in[I_LNMG], P.in[I_LNMB], lane); ln_row(vb, P.in[I_LNMG], P.in[I_LNMB], lane);
        store_row_bf16(X1 + (size_t)m0 * D, va, lane); store_row_bf16(X1 + (size_t)(m0 + 1) * D, vb, lane);
        store_row_fp8x8(XB + (size_t)m0 * D, va, lane); store_row_fp8x8(XB + (size_t)(m0 + 1) * D, vb, lane);
        float v[32];
#pragma unroll
        for (int e = 0; e < 32; ++e) { float pa = 0.f, pb = 0.f;
#pragma unroll
            for (int j = 0; j < 4; ++j) { const f32x4 w = *(const LAS f32x4*)(wl + e * 1024 + 4 * lane + 256 * j);
                pa += (va[j][0] * w[0] + va[j][1] * w[1]) + (va[j][2] * w[2] + va[j][3] * w[3]); pb += (vb[j][0] * w[0] + vb[j][1] * w[1]) + (vb[j][2] * w[2] + vb[j][3] * w[3]); }
            const float keep = hf ? pb : pa, send = hf ? pa : pb; v[e] = keep + __shfl_xor(send, 32); }
#define HALVE(M, CNT) { const bool up_ = (lane & (M)) != 0; _Pragma("unroll") for (int i_ = 0; i_ < (CNT) / 2; ++i_) { const float k_ = up_ ? v[i_ + (CNT) / 2] : v[i_], s_ = up_ ? v[i_] : v[i_ + (CNT) / 2]; v[i_] = k_ + __shfl_xor(s_, (M)); } }
        HALVE(16, 32) HALVE(8, 16) HALVE(4, 8) HALVE(2, 4) HALVE(1, 2)
#undef HALVE
        float lg = v[0] + brl;
        int se[4]; float sv[4];
#pragma unroll
        for (int k = 0; k < 4; ++k) { float bv = lg; int bi = ex;
#pragma unroll
            for (int o = 1; o < 32; o <<= 1) { const float ov = __shfl_xor(bv, o); const int oi = __shfl_xor(bi, o); const bool take = (ov > bv) || (ov == bv && oi < bi); bv = take ? ov : bv; bi = take ? oi : bi; }
            se[k] = bi; sv[k] = bv; if (ex == bi) lg = -INFINITY; }
        float exv[4], sum = 0.f;
#pragma unroll
        for (int k = 0; k < 4; ++k) { exv[k] = __expf(sv[k] - sv[0]); sum += exv[k]; }
        const float inv = 1.f / sum;
        if (ex == 0) { const int m = m0 + hf;
#pragma unroll
            for (int k = 0; k < 4; ++k) { const int lr = atomicAdd((int*)&hist[se[k]], 1); tope[m * 4 + k] = se[k]; gate[m * 4 + k] = exv[k] * inv; lrank[m * 4 + k] = lr; } }
    }
    __syncthreads();
    if (PUBLISH && C.tid < 32) { unsigned* cnt = (unsigned*)(ws + WS_CTL) + CW_CNT; const int base = (int)atomicAdd(cnt + C.tid, (unsigned)hist[C.tid]); ((int*)(ws + WS_WGBASE))[blockIdx.x * 32 + C.tid] = base; }
}

__device__ __forceinline__ void p7_dispatch(const Params& P, const Ctx& C) {
    unsigned char* ws = P.ws;
    LAS int* ps = (LAS int*)(C.lds + MISC_OFF + 256);
    const unsigned* cnt = (const unsigned*)(ws + WS_CTL) + CW_CNT;
    int* tile_e = (int*)(ws + WS_TILEE);
    LAS int* pe = (LAS int*)(C.lds + MISC_OFF + 512);
    if (C.tid < 64) { const int e = C.tid & 31; const int c = (int)__hip_atomic_load(cnt + e, __ATOMIC_RELAXED, __HIP_MEMORY_SCOPE_AGENT); const int nt = (c + 255) >> 8; int inc = nt;
#pragma unroll
        for (int o = 1; o < 32; o <<= 1) { const int v = __shfl_up(inc, o); if ((C.tid & 31) >= o) inc += v; }
        if (C.tid < 32) { ps[e] = (inc - nt) << 8; pe[e] = inc; } }
    __syncthreads();
    if (blockIdx.x == 0) { const int ntot = pe[31];
        for (int t = C.tid; t < ntot; t += NTHR) { int e = 0;
#pragma unroll
            for (int q = 0; q < 31; ++q) e += (t >= pe[q]) ? 1 : 0;
            tile_e[t] = e; }
        if (C.tid == 0) tile_e[MAXTILES] = ntot; }
    const int* tope = (const int*)(ws + WS_TOPE); const float* gate = (const float*)(ws + WS_GATE); const int* lrank = (const int*)(ws + WS_LRANK);
    const int* wgb = (const int*)(ws + WS_WGBASE);
    int* tokslot = (int*)(ws + WS_TOKSLOT); float* slotgate = (float*)(ws + WS_SLOTGATE);
    const bf16* XB = (const bf16*)(ws + WS_XB); unsigned char* xs = ws + WS_XS;
    int m = C.gw; v4u f8n; int en[4], ln_[4]; float gn[4]; int wgn;
    if (m < NTOK) { f8n = *(const GAS v4u*)((const unsigned char*)XB + (size_t)m * D + 16 * C.lane); wgn = ((m >> 1) % C.ngw) >> 3;
#pragma unroll
        for (int k = 0; k < 4; ++k) { en[k] = tope[m * 4 + k]; ln_[k] = lrank[m * 4 + k]; gn[k] = gate[m * 4 + k]; } }
    for (; m < NTOK; m += C.ngw) {
        const v4u f8 = f8n; int e[4], lr[4]; float g[4]; const int wgm = wgn;
#pragma unroll
        for (int k = 0; k < 4; ++k) { e[k] = en[k]; lr[k] = ln_[k]; g[k] = gn[k]; }
        int wb[4];
#pragma unroll
        for (int k = 0; k < 4; ++k) wb[k] = wgb[wgm * 32 + e[k]];
        const int m2 = m + C.ngw;
        if (m2 < NTOK) { f8n = *(const GAS v4u*)((const unsigned char*)XB + (size_t)m2 * D + 16 * C.lane); wgn = ((m2 >> 1) % C.ngw) >> 3;
#pragma unroll
            for (int k = 0; k < 4; ++k) { en[k] = tope[m2 * 4 + k]; ln_[k] = lrank[m2 * 4 + k]; gn[k] = gate[m2 * 4 + k]; } }
#pragma unroll
        for (int k = 0; k < 4; ++k) { const int slot = ps[e[k]] + wb[k] + lr[k];
            *(GAS v4u*)(xs + (size_t)slot * D + 16 * C.lane) = f8;
            if (C.lane == 0) { slotgate[slot] = g[k]; tokslot[m * 4 + k] = slot; } }
    }
}

__device__ __forceinline__ void p10_combine_ln2(const Params& P, const Ctx& C) {
    unsigned char* ws = P.ws;
    const bf16* X1 = (const bf16*)(ws + WS_X1); bf16* XB = (bf16*)(ws + WS_XB); bf16* X2 = (bf16*)P.out;
    const int* tokslot = (const int*)(ws + WS_TOKSLOT); const bf16* ys = (const bf16*)(ws + WS_YSLOT);
    for (int m = C.gw; m < NTOK; m += C.ngw) {
        f32x4 v[4]; load_row_bf16(v, X1 + (size_t)m * D, C.lane);
#pragma unroll
        for (int j = 0; j < 4; ++j) v[j] = v[j] * ALPHA;
#if FEAT_MOE
#pragma unroll
        for (int k = 0; k < 4; ++k) { const int slot = tokslot[m * 4 + k]; const bf16* yr = ys + (size_t)slot * D;
#pragma unroll
            for (int j = 0; j < 4; ++j) { const v2u w = *(const GAS v2u*)(yr + 4 * C.lane + 256 * j); v[j][0] += bflo(w.x); v[j][1] += bfhi(w.x); v[j][2] += bflo(w.y); v[j][3] += bfhi(w.y); } }
#endif
        ln_row(v, P.in[I_LNFG], P.in[I_LNFB], C.lane);
        store_row_bf16(X2 + (size_t)m * D, v, C.lane);
        store_row_fp8x8((unsigned char*)XB + (size_t)m * D, v, C.lane);
    }
}

__device__ __forceinline__ void p12_final_ln(const Params& P, const Ctx& C) {
    const bf16* src = (const bf16*)(P.ws + WS_X1);
    for (int m = C.gw; m < NTOK; m += C.ngw) {
        f32x4 v[4]; load_row_bf16(v, src + (size_t)m * D, C.lane);
        ln_row(v, P.in[I_LNPG], P.in[I_LNPB], C.lane);
        store_row_f32(P.out + (size_t)m * D, v, C.lane);
    }
}
#define XB_TMO      128
#define XB_XCNT(j)  (256  + 64 * (j))
#define XB_XSUB(j)  (1280 + 64 * (j))
#define XB_XGEN(j)  (2304 + 64 * (j))
#define XB_TOP      3328
#define XB_TOPGEN   3392
#define XCD_BAR_WORDS 3456
#define XB_SPIN_CAP (1u << 18)
#define LAS __attribute__((address_space(3)))

__device__ __forceinline__ unsigned xb_ld(unsigned* p)              { return __hip_atomic_load(p, __ATOMIC_RELAXED, __HIP_MEMORY_SCOPE_AGENT); }
__device__ __forceinline__ unsigned xb_add(unsigned* p, unsigned v) { return __hip_atomic_fetch_add(p, v, __ATOMIC_RELAXED, __HIP_MEMORY_SCOPE_AGENT); }
__device__ __forceinline__ unsigned xb_xcc_id() { return (unsigned)__builtin_amdgcn_s_getreg((3 << 11) | 20) & 0xFu; }
#define XB_SPIN(cond, bar) do { unsigned _sp = 0; while (cond) { __builtin_amdgcn_s_sleep(1); \
    if ((++_sp & 255u) == 0u) { if (xb_ld(&(bar)[XB_TMO])) break; if (_sp > XB_SPIN_CAP) { atomicAdd(&(bar)[XB_TMO], 1u); break; } } } } while (0)

struct XcdBarrier {
    unsigned* bar; unsigned x;
    volatile LAS unsigned* st;
};

__device__ __forceinline__ XcdBarrier xcd_barrier_post(unsigned* bar, volatile LAS unsigned* st) {
    XcdBarrier b; b.bar = bar; b.x = xb_xcc_id(); b.st = st;
    if (threadIdx.x == 0) (void)xb_add(&bar[XB_XCNT(b.x)], 1u);
    return b;
}
__device__ __forceinline__ void xcd_barrier_complete(unsigned* bar, unsigned x, unsigned& nloc, unsigned& nx) {
    const unsigned G = gridDim.x * gridDim.y * gridDim.z;
    unsigned sum, cnt, mine, sp = 0u;
    for (;;) {
        sum = 0u; cnt = 0u; mine = 0u;
#pragma unroll
        for (unsigned j = 0; j < 16; ++j) { const unsigned c = xb_ld(&bar[XB_XCNT(j)]); sum += c; cnt += (c > 0u) ? 1u : 0u; mine = (j == x) ? c : mine; }
        if (sum == G) break;
        __builtin_amdgcn_s_sleep(1);
        if ((++sp & 255u) == 0u) { if (xb_ld(&bar[XB_TMO])) break; if (sp > XB_SPIN_CAP) { atomicAdd(&bar[XB_TMO], 1u); break; } }
    }
    nloc = mine > 0u ? mine : 1u; nx = cnt > 0u ? cnt : 1u;
}

__device__ __forceinline__ void xcd_barrier(const XcdBarrier& b) {
    asm volatile("s_waitcnt vmcnt(0)" ::: "memory");
    __syncthreads();
    if (threadIdx.x == 0) {
        unsigned* bar = b.bar;
        __builtin_amdgcn_s_waitcnt(0);
        unsigned nloc = b.st[0], nx = b.st[1];
        if (nloc == 0u) { xcd_barrier_complete(bar, b.x, nloc, nx); b.st[0] = nloc; b.st[1] = nx; }
        const unsigned old = xb_add(&bar[XB_XSUB(b.x)], 1u);
        const unsigned gen = old / nloc;
        if (old + 1u == (gen + 1u) * nloc) {
            __builtin_amdgcn_fence(__ATOMIC_RELEASE, "agent");
            asm volatile("s_waitcnt vmcnt(0)" ::: "memory");
            const unsigned og = xb_add(&bar[XB_TOP], 1u);
            const unsigned tg = og / nx;
            if (og + 1u == (tg + 1u) * nx) xb_add(&bar[XB_TOPGEN], 1u);
            else XB_SPIN(xb_ld(&bar[XB_TOPGEN]) == tg, bar);
            __builtin_amdgcn_fence(__ATOMIC_ACQUIRE, "agent");
            xb_add(&bar[XB_XGEN(b.x)], 1u);
            asm volatile("s_waitcnt vmcnt(0)" ::: "memory");
        } else {
            XB_SPIN(xb_ld(&bar[XB_XGEN(b.x)]) == gen, bar);
            __builtin_amdgcn_fence(__ATOMIC_ACQUIRE, "agent");
            asm volatile("s_waitcnt vmcnt(0)" ::: "memory");
        }
    }
    __syncthreads();
}


template <int PH> __device__ __forceinline__ void run_phase(const Params& P, const Ctx& C) {
    unsigned char* ws = P.ws;
    typedef pg8::bf16_t pbf;
    if constexpr (PH == 0) { p0_prologue(P, C); }
    else if constexpr (PH == 10) {
        pg8::Gemm g{(const pbf*)(ws + WS_XBF), (const pbf*)(ws + WS_WIN_T), NTOK, D_INP, D}; pg8::StaticOrder S; S.init(NTOK, D_INP, C.G, (int)blockIdx.x);
        pg8::EpiBf16s E{(pbf*)(ws + WS_H), D_INP};
        pg8::gemm_phase<pg8::EpiBf16s, pg8::StaticOrder, true, true>(C.lds, g, S, E); }
    else if constexpr (PH == 11) {
        pg8::Gemm g{(const pbf*)(ws + WS_PB), (const pbf*)(ws + WS_WPROJ_T), NTOK, D, PLE}; pg8::StaticOrder S; S.init(NTOK, D, C.G, (int)blockIdx.x);
        pg8::EpiBf16s E{(pbf*)(ws + WS_PROJ), D};
        pg8::gemm_phase<pg8::EpiBf16s, pg8::StaticOrder, true, true>(C.lds, g, S, E); }
    else if constexpr (PH == 20) { p2_post(P, C); }
    else if constexpr (PH == 21) { p2_hgrn_prep(P, C); }
    else if constexpr (PH == 30) {
        { pg8::Gemm g{(const pbf*)(ws + WS_CN), (const pbf*)(ws + WS_WUK_T), NTOK, 512, 256}; pg8::StaticOrder S; S.init(NTOK, 512, C.G, (int)blockIdx.x);
          pg8::EpiKhead E{(pbf*)(ws + WS_K)};
          pg8::gemm_phase<pg8::EpiKhead, pg8::StaticOrder, true, true>(C.lds, g, S, E); }
        { pg8::Gemm g{(const pbf*)(ws + WS_WUV_T), (const pbf*)(ws + WS_CN), 512, NTOK, 256}; pg8::StaticOrder S; S.init(512, NTOK, C.G, (int)blockIdx.x);
          pg8::EpiVt E{(pbf*)(ws + WS_VT)};
          pg8::gemm_phase<pg8::EpiVt, pg8::StaticOrder, true, true>(C.lds, g, S, E); }
    }
    else if constexpr (PH == 31) { p3_indexer(P, C); }
    else if constexpr (PH == 32) { p3_scan_convert(P, C); }
    else if constexpr (PH == 40) { p4_attention2(P, C); }
    else if constexpr (PH == 41) { p4_yrec(P, C); }
    else if constexpr (PH == 5) {
        pg8::Gemm g{(const pbf*)(ws + WS_YMIX), (const pbf*)(ws + WS_WO_T), NTOK, D, D / 2}; pg8::StaticOrder S; S.init(NTOK, D, C.G, (int)blockIdx.x);
        pg8::EpiResid E{P.in[I_X], (pbf*)P.out, D, ALPHA, 1.f / 512.f};
        pg8::gemm_phase<pg8::EpiResid, pg8::StaticOrder, true, true, 1>(C.lds, g, S, E);
    }
    else if constexpr (PH == 6) { p6_ln1_router<true>(P, C); }
    else if constexpr (PH == 60) { p6_ln1_router<false>(P, C); }
    else if constexpr (PH == 7) { p7_dispatch(P, C); }
    else if constexpr (PH == 8) {
        const int* tile_e = (const int*)(ws + WS_TILEE);
        pg8::Gemm g{(const pbf*)(ws + WS_XS), (const pbf*)(ws + WS_WUP_T), CAP, NE * 2048, D / 2};
        pg8::MoeOrder S{tile_e, tile_e[MAXTILES], 8, C.G, (int)blockIdx.x};
        pg8::EpiSwiglu E{ws + WS_HH, P.in[I_BUP]};
        pg8::gemm_phase<pg8::EpiSwiglu, pg8::MoeOrder, true, true, 1, 124, 121>(C.lds, g, S, E);
    }
    else if constexpr (PH == 9) {
        const int* tile_e = (const int*)(ws + WS_TILEE);
        pg8::Gemm g{(const pbf*)(ws + WS_HH), (const pbf*)(ws + WS_WDN_T), CAP, NE * 1024, DFF / 2};
        pg8::MoeOrder S{tile_e, tile_e[MAXTILES], 4, C.G, (int)blockIdx.x};
        pg8::EpiDown E{(pbf*)(ws + WS_YSLOT), P.in[I_BDN], (const float*)(ws + WS_SLOTGATE)};
        pg8::gemm_phase<pg8::EpiDown, pg8::MoeOrder, true, true, 1, 125, 121>(C.lds, g, S, E);
    }
    else if constexpr (PH == 100) { p10_combine_ln2(P, C); }
    else if constexpr (PH == 110) {
        pg8::Gemm g{(const pbf*)(ws + WS_XB), (const pbf*)(ws + WS_WGATE_T), NTOK, D, D / 2}; pg8::StaticOrder S; S.init(NTOK, D, C.G, (int)blockIdx.x);
        pg8::EpiPle E{(const pbf*)P.out, (const pbf*)(ws + WS_PROJ), (pbf*)(ws + WS_X1), ALPHA, 1.f / 512.f};
        pg8::gemm_phase<pg8::EpiPle, pg8::StaticOrder, true, true, 1>(C.lds, g, S, E);
    }
    else { p12_final_ln(P, C); }
}
__global__ void __launch_bounds__(NTHR, 2) mega_fwd(Params P) {
    extern __shared__ __attribute__((aligned(16))) unsigned char lds_raw[];
    cg::grid_group grid = cg::this_grid();
#define MKCTX Ctx C; { int tid_ = threadIdx.x; asm volatile("" : "+v"(tid_)); C.lds = (LAS unsigned char*)lds_raw; C.tid = tid_; C.lane = tid_ & 63; C.wave = __builtin_amdgcn_readfirstlane(tid_ >> 6); \
      C.G = gridDim.x; C.gw = blockIdx.x * NWAVES + C.wave; C.ngw = C.G * NWAVES; }
#if SYNC_MODE != 0
    if (threadIdx.x < 4) ((LAS unsigned*)((LAS unsigned char*)lds_raw + XBW_OFF))[threadIdx.x] = 0u;
    __syncthreads();
    XcdBarrier bar = xcd_barrier_post((unsigned*)(P.ws + WS_CTL) + CW_BAR, (volatile LAS unsigned*)((LAS unsigned char*)lds_raw + XBW_OFF));
#define SY xcd_barrier(bar);
#else
#define SY grid.sync();
#endif
#define GS grid.sync();
#define BS __syncthreads();
#define X(k) { MKCTX run_phase<k>(P, C); }
    PROGRAM
#undef X
#undef MKCTX
#undef SY
#undef GS
#undef BS
}

extern "C" void kernel_launch(void* const* d_in, const int* in_sizes, int n_in, void* d_out, int out_size, void* d_ws, size_t ws_size, hipStream_t stream) {
    static int grid = 0;
    if (grid == 0) {
        if (n_in != 25 || out_size != NTOK * D || ws_size < WS_END) { fprintf(stderr, "kernel_launch: unexpected shapes (n_in %d out %d ws %zu)\n", n_in, out_size, ws_size); grid = -1; return; }
        int dev = 0, cus = 0, per_cu = 0;
        if (hipGetDevice(&dev) != hipSuccess || hipDeviceGetAttribute(&cus, hipDeviceAttributeMultiprocessorCount, dev) != hipSuccess) { grid = -1; return; }
        if (hipFuncSetAttribute((const void*)mega_fwd, hipFuncAttributeMaxDynamicSharedMemorySize, LDS_BYTES) != hipSuccess) { fprintf(stderr, "kernel_launch: hipFuncSetAttribute failed\n"); grid = -1; return; }
        if (hipOccupancyMaxActiveBlocksPerMultiprocessor(&per_cu, (const void*)mega_fwd, NTHR, LDS_BYTES) != hipSuccess || per_cu < 1) { fprintf(stderr, "kernel_launch: occupancy query failed (%d)\n", per_cu); (void)hipGetLastError(); grid = -1; return; }
        grid = cus * per_cu;
        fprintf(stderr, "kernel_launch: grid %d (%d CUs x %d)\n", grid, cus, per_cu);
    }
    if (grid < 0) return;
    (void)hipMemsetAsync((char*)d_ws + WS_CTL, 0, CTL_ZERO_BYTES, stream);
    Params p{};
    for (int i = 0; i < 25; ++i) p.in[i] = (const float*)d_in[i];
    p.out = (float*)d_out; p.ws = (unsigned char*)d_ws;

    void* args[] = {&p};
    hipError_t e = hipLaunchCooperativeKernel((const void*)mega_fwd, dim3(grid), dim3(NTHR), args, LDS_BYTES, stream);
    if (e != hipSuccess) fprintf(stderr, "kernel_launch: cooperative launch failed: %s (grid %d)\n", hipGetErrorString(e), grid);
}
```

```cpp
#define SYNC_MODE 1
#include <hip/hip_runtime.h>
#include <hip/hip_cooperative_groups.h>
#include <cstdio>
#include <cstdint>
namespace cg = cooperative_groups;

namespace pg8 {
#define PG8_LAS __attribute__((address_space(3)))
typedef unsigned short bf16_t;
typedef short bf16x8 __attribute__((ext_vector_type(8)));
typedef float f32x4 __attribute__((ext_vector_type(4)));
typedef unsigned u32x4 __attribute__((ext_vector_type(4)));
typedef int i32x4 __attribute__((ext_vector_type(4)));
typedef int i32x8 __attribute__((ext_vector_type(8)));
constexpr int BM = 256, BK = 64, HALF = 128, HTB = HALF * BK * 2  , STAGE_BYTES = 8 * HTB, NXCD = 8, WGM = 8;

__host__ __device__ __forceinline__ int lds_byte(int r, int c) { const int st = (r >> 4) * 2 + (c >> 5), rr = r & 15, cc = c & 31, ob = rr * 64 + cc * 2; return st * 1024 + (ob ^ (((ob >> 9) & 1) << 5)); }
__host__ __device__ __forceinline__ void stage_rc(int b, int& R, int& C) { const int st = b / 1024, sb = b % 1024, swz = sb ^ (((sb >> 9) & 1) << 5); R = (st >> 1) * 16 + swz / 64; C = (st & 1) * 32 + (swz % 64) / 2; }
__host__ __device__ __forceinline__ int perm32(int rho) { const int n = rho >> 4, i = rho & 15; return 8 * (i >> 2) + 4 * n + (i & 3); }

struct Unit { int pm, pn; };
struct Gemm { const bf16_t* A; const bf16_t* Bt; int M, N, K; };

struct StaticOrder {
    int nM, nN, nwg, G, c;
    __host__ __device__ void init(int M, int N, int G_, int c_) { nM = M / BM; nN = N / BM; nwg = nM * nN; G = G_; c = c_; }
    __host__ __device__ bool next(int i, Unit& u) const {
        const long L = (long)i * G + c; if (L >= nwg) return false;
        int wgid = (int)L; { const int q = nwg / NXCD, r = nwg % NXCD, xcd = wgid % NXCD, off = wgid / NXCD; wgid = (xcd < r ? xcd * (q + 1) : r * (q + 1) + (xcd - r) * q) + off; }
        const int nig = WGM * nN, gid = wgid / nig, fm = gid * WGM, gsz = (nM - fm) < WGM ? (nM - fm) : WGM;
        u.pm = fm + ((wgid % nig) % gsz); u.pn = (wgid % nig) / gsz; return true;
    }
    __device__ __forceinline__ void a_ready(const Unit&) const {}
    __device__ __forceinline__ void done(const Unit&) const {}
};

__device__ __forceinline__ unsigned cvt_pk_bf16(float lo, float hi) { unsigned r; asm volatile("v_cvt_pk_bf16_f32 %0, %1, %2" : "=v"(r) : "v"(lo), "v"(hi)); return r; }
typedef float f32x2 __attribute__((ext_vector_type(2)));
template <class Epi, class Sched, bool ALIGN_EPI = false, bool SP2 = false, int F8 = 0, int F8SA = 127, int F8SB = 127>
__device__ __forceinline__ void gemm_phase(PG8_LAS unsigned char* lds, const Gemm g, const Sched& S, const Epi& E) {
    const int tid = threadIdx.x, wid = __builtin_amdgcn_readfirstlane(tid >> 6), lane = tid & 63, wr = wid >> 2, wc = wid & 3, fr = lane & 15, fq = lane >> 4;
    const int K = g.K, nt = K / BK;
    unsigned voffA[2], voffB[2];
#pragma unroll
    for (int i = 0; i < 2; ++i) { int R, C; stage_rc(tid * 16 + i * 8192, R, C); const int Rb = Epi::PERM ? ((R & ~31) + perm32(R & 31)) : R;
        voffA[i] = (unsigned)(R * K + C) * 2u; voffB[i] = (unsigned)(Rb * K + C) * 2u; }
    const size_t kstep = (size_t)(BK * 2);
    const size_t hstep = (size_t)HALF * K * 2;
    const size_t tstep = 2 * hstep;
    const unsigned ldsw = (unsigned)wid * 1024u;
    const int aoff = lds_byte(wr * 64 + fr, fq * 8), boff = lds_byte(wc * 32 + fr, fq * 8);
#define PG8_SA(b, h) (((b) * 2 + (h)) * HTB)
#define PG8_SB(b, h) ((4 + (b) * 2 + (h)) * HTB)
#define PG8_STAGE(bufoff, gbase, voff) do { _Pragma("unroll") for (int _i = 0; _i < 2; ++_i) \
        __builtin_amdgcn_global_load_lds((const unsigned*)((const char*)(gbase) + (voff)[_i]), (PG8_LAS unsigned*)(lds + (bufoff) + ldsw + _i * 8192), 16, 0, 0); } while (0)
#define PG8_LDA(dst, b, h) do { _Pragma("unroll") for (int m = 0; m < 4; ++m) { dst[m].lo = *(const PG8_LAS i32x4*)(lds + PG8_SA(b, h) + aoff + m * 2048); dst[m].hi = *(const PG8_LAS i32x4*)(lds + PG8_SA(b, h) + aoff + m * 2048 + 1024); } } while (0)
#define PG8_LDB(dst, b, h) do { _Pragma("unroll") for (int n = 0; n < 2; ++n) { dst[n].lo = *(const PG8_LAS i32x4*)(lds + PG8_SB(b, h) + boff + n * 2048); dst[n].hi = *(const PG8_LAS i32x4*)(lds + PG8_SB(b, h) + boff + n * 2048 + 1024); } } while (0)
#define PG8_MMA(ai, bj, At, Bt) do { __builtin_amdgcn_s_setprio(1); \
        if constexpr (F8 == 0) { _Pragma("unroll") for (int m = 0; m < 4; ++m) _Pragma("unroll") for (int n = 0; n < 2; ++n) { \
            const i32x4 bl_ = Bt[n].lo, bh_ = Bt[n].hi, al_ = At[m].lo, ah_ = At[m].hi;     \
            acc[ai][bj][m][n] = __builtin_amdgcn_mfma_f32_16x16x32_bf16(__builtin_bit_cast(bf16x8, bl_), __builtin_bit_cast(bf16x8, al_), acc[ai][bj][m][n], 0, 0, 0); \
            acc[ai][bj][m][n] = __builtin_amdgcn_mfma_f32_16x16x32_bf16(__builtin_bit_cast(bf16x8, bh_), __builtin_bit_cast(bf16x8, ah_), acc[ai][bj][m][n], 0, 0, 0); } } \
        else { _Pragma("unroll") for (int m = 0; m < 4; ++m) _Pragma("unroll") for (int n = 0; n < 2; ++n) \
            asm volatile("v_mfma_f32_16x16x128_f8f6f4 %0, %1, %2, %0" : "+v"(acc[ai][bj][m][n]) : "v"(Bt[n]), "v"(At[m])); } \
        __builtin_amdgcn_s_setprio(0); } while (0)
#define PG8_WAIT_V(n) asm volatile("s_waitcnt vmcnt(" #n ")" ::: "memory")
#define PG8_WAIT_L(n) asm volatile("s_waitcnt lgkmcnt(" #n ")" ::: "memory")
#define PG8_BAR __builtin_amdgcn_s_barrier()
#define PG8_SCHED __builtin_amdgcn_sched_barrier(0)
    Unit cur, nxt; int ui = 0;
    if (!S.next(0, cur)) return;
    f32x4 acc[2][2][4][2];
#pragma unroll
    for (int a = 0; a < 2; ++a)
#pragma unroll
        for (int b = 0; b < 2; ++b)
#pragma unroll
            for (int m = 0; m < 4; ++m)
#pragma unroll
                for (int n = 0; n < 2; ++n) acc[a][b][m][n] = (f32x4){0.f, 0.f, 0.f, 0.f};
    i32x8 At[4], B0[2], B1[2];
    const char* cA = (const char*)g.A + (size_t)cur.pm * tstep; const char* cB = (const char*)g.Bt + (size_t)cur.pn * tstep;
    S.a_ready(cur);
    if constexpr (SP2) {
        PG8_STAGE(PG8_SB(0, 0), cB, voffB); PG8_STAGE(PG8_SB(0, 1), cB + hstep, voffB); PG8_STAGE(PG8_SA(0, 0), cA, voffA); PG8_STAGE(PG8_SA(0, 1), cA + hstep, voffA);
        if (wr == 1) PG8_BAR;
        PG8_WAIT_V(2); PG8_BAR;
        PG8_STAGE(PG8_SB(1, 0), cB + kstep, voffB); PG8_STAGE(PG8_SA(1, 0), cA + kstep, voffA); PG8_STAGE(PG8_SB(1, 1), cB + hstep + kstep, voffB);
        PG8_WAIT_V(6); PG8_BAR;
    } else {
        PG8_STAGE(PG8_SB(0, 0), cB, voffB); PG8_STAGE(PG8_SA(0, 0), cA, voffA); PG8_STAGE(PG8_SB(0, 1), cB + hstep, voffB); PG8_STAGE(PG8_SA(0, 1), cA + hstep, voffA);
        if (wr == 1) PG8_BAR;
        PG8_WAIT_V(4); PG8_BAR;
        PG8_STAGE(PG8_SB(1, 0), cB + kstep, voffB); PG8_STAGE(PG8_SA(1, 0), cA + kstep, voffA); PG8_STAGE(PG8_SB(1, 1), cB + hstep + kstep, voffB);
        PG8_WAIT_V(6); PG8_BAR;
    }
    for (;;) {
        const bool has_next = S.next(ui + 1, nxt);
        const char* nA = has_next ? (const char*)g.A + (size_t)nxt.pm * tstep : cA; const char* nB = has_next ? (const char*)g.Bt + (size_t)nxt.pn * tstep : cB;
_Pragma("nounroll")
        for (int t = 0; t < nt; t += 2) {
            const bool last = (t == nt - 2);
            const char* a1 = cA + (size_t)(t + 1) * kstep;
            const char* a2 = last ? nA : cA + (size_t)(t + 2) * kstep; const char* b2 = last ? nB : cB + (size_t)(t + 2) * kstep;
            const char* a3 = a2 + kstep; const char* b3 = b2 + kstep;
            if (last && has_next) S.a_ready(nxt);
            if constexpr (SP2) {
            PG8_LDB(B0, 0, 0); PG8_LDB(B1, 0, 1); PG8_SCHED; PG8_LDA(At, 0, 0); PG8_STAGE(PG8_SA(1, 1), a1 + hstep, voffA);
            PG8_WAIT_V(8); PG8_WAIT_L(0); PG8_BAR; PG8_MMA(0, 0, At, B0); PG8_MMA(0, 1, At, B1); PG8_BAR; PG8_SCHED;
            PG8_LDA(At, 0, 1); PG8_STAGE(PG8_SB(0, 0), b2, voffB); PG8_STAGE(PG8_SB(0, 1), b2 + hstep, voffB); PG8_STAGE(PG8_SA(0, 0), a2, voffA);
            PG8_WAIT_V(8); PG8_WAIT_L(0); PG8_BAR; PG8_MMA(1, 0, At, B0); PG8_MMA(1, 1, At, B1); PG8_BAR; PG8_SCHED;
            PG8_LDB(B0, 1, 0); PG8_LDB(B1, 1, 1); PG8_SCHED; PG8_LDA(At, 1, 0); PG8_STAGE(PG8_SA(0, 1), a2 + hstep, voffA);
            PG8_WAIT_V(8); PG8_WAIT_L(0); PG8_BAR; PG8_MMA(0, 0, At, B0); PG8_MMA(0, 1, At, B1); PG8_BAR; PG8_SCHED;
            PG8_LDA(At, 1, 1); PG8_STAGE(PG8_SB(1, 0), b3, voffB); PG8_STAGE(PG8_SB(1, 1), b3 + hstep, voffB); PG8_STAGE(PG8_SA(1, 0), a3, voffA);
            PG8_WAIT_V(8); PG8_WAIT_L(0); PG8_BAR; PG8_MMA(1, 0, At, B0); PG8_MMA(1, 1, At, B1); PG8_BAR; PG8_SCHED;
            } else {
            PG8_LDB(B0, 0, 0); PG8_SCHED; PG8_LDA(At, 0, 0); PG8_STAGE(PG8_SA(1, 1), a1 + hstep, voffA);
            PG8_WAIT_L(8); PG8_BAR; PG8_WAIT_L(0); PG8_MMA(0, 0, At, B0); PG8_BAR; PG8_SCHED;
            PG8_LDB(B1, 0, 1); PG8_STAGE(PG8_SB(0, 0), b2, voffB);
            PG8_BAR; PG8_WAIT_L(0); PG8_MMA(0, 1, At, B1); PG8_BAR;
            PG8_LDA(At, 0, 1); PG8_STAGE(PG8_SA(0, 0), a2, voffA);
            PG8_BAR; PG8_WAIT_L(0); PG8_MMA(1, 0, At, B0); PG8_BAR; PG8_SCHED;
            PG8_STAGE(PG8_SB(0, 1), b2 + hstep, voffB);
            PG8_WAIT_V(6); PG8_BAR; PG8_MMA(1, 1, At, B1); PG8_BAR;
            PG8_LDB(B0, 1, 0); PG8_SCHED; PG8_LDA(At, 1, 0); PG8_STAGE(PG8_SA(0, 1), a2 + hstep, voffA);
            PG8_WAIT_L(8); PG8_BAR; PG8_WAIT_L(0); PG8_MMA(0, 0, At, B0); PG8_BAR; PG8_SCHED;
            PG8_LDB(B1, 1, 1); PG8_STAGE(PG8_SB(1, 0), b3, voffB);
            PG8_BAR; PG8_WAIT_L(0); PG8_MMA(0, 1, At, B1); PG8_BAR;
            PG8_LDA(At, 1, 1); PG8_STAGE(PG8_SA(1, 0), a3, voffA);
            PG8_BAR; PG8_WAIT_L(0); PG8_MMA(1, 0, At, B0); PG8_BAR; PG8_SCHED;
            PG8_STAGE(PG8_SB(1, 1), b3 + hstep, voffB);
            PG8_WAIT_V(6); PG8_BAR; PG8_MMA(1, 1, At, B1); PG8_BAR;
            }
        }
        if constexpr (ALIGN_EPI) { if (wr == 0) PG8_BAR; }
        if constexpr (F8 != 0) asm volatile("s_nop 15\n\ts_nop 15" ::: "memory");
        if constexpr (!Epi::AFTER_DRAIN) { E(acc, cur, wr, wc, fr, fq); S.done(cur); }
        if (!has_next) break;
#pragma unroll
        for (int a = 0; a < 2; ++a)
#pragma unroll
            for (int b = 0; b < 2; ++b)
#pragma unroll
                for (int m = 0; m < 4; ++m)
#pragma unroll
                    for (int n = 0; n < 2; ++n) acc[a][b][m][n] = (f32x4){0.f, 0.f, 0.f, 0.f};
        cur = nxt; cA = nA; cB = nB; ++ui;
        if constexpr (ALIGN_EPI) { if (wr == 1) PG8_BAR; }
    }
    PG8_WAIT_V(0);
    if constexpr (!ALIGN_EPI) { if (wr == 0) PG8_BAR; }
    PG8_BAR;
    if constexpr (Epi::AFTER_DRAIN) { E.fused(acc, cur, wr, wc, fr, fq, lds, wid, lane); S.done(cur); }
#undef PG8_SA
#undef PG8_SB
#undef PG8_STAGE
#undef PG8_LDA
#undef PG8_LDB
#undef PG8_MMA
#undef PG8_WAIT_V
#undef PG8_WAIT_L
#undef PG8_BAR
#undef PG8_SCHED
}
}

constexpr int NB = 8, T = 4096, D = 1024, NTOK = NB * T;
constexpr int ATT_H = 8, ATT_D = 64, ATT_W = 512, KV_LAT = 256, IDX_H = 8, IDX_D = 64, TOPK = 256;
constexpr int HG_H = 4, HG_DK = 128, HG_DV = 128, HG_W = 512, HG_C = 32;
constexpr int D_IN = 3400, D_INP = 3584;
constexpr int C_AQ = 0, C_AC = 512, C_IQ = 768, C_IK = 1280, C_IW = 1344, C_GQ = 1352, C_GF = 1864, C_GI = 2376, C_GG = 2888;
constexpr int NE = 32, TOPE = 4, DFF = 1024, PLE = 256;
constexpr int NASSIGN = NTOK * TOPE, CAP = NASSIGN + NE * 256;
constexpr int MAXTILES = CAP / 256;
constexpr float LN_EPS = 1e-5f, RMS_EPS = 1e-6f, ALPHA = 1.189207115002721f;

constexpr size_t MiB = 1u << 20;
constexpr size_t WS_CTL = 0, CTL_ZERO_BYTES = 64 * 1024;
constexpr size_t WS_WIN_T = 1 * MiB, WS_WO_T = 8 * MiB, WS_WUP_T = 10 * MiB, WS_WDN_T = 138 * MiB, WS_WPROJ_T = 202 * MiB, WS_WGATE_T = 203 * MiB;
constexpr size_t WS_WUK_T = 205 * MiB, WS_WUV_T = 205 * MiB + 512 * 1024;
constexpr size_t WS_SMALL = 206 * MiB;
constexpr size_t WS_A = 208 * MiB;
constexpr size_t WS_B = 480 * MiB;
constexpr size_t WS_X1 = 752 * MiB;
constexpr size_t WS_XB = 880 * MiB;
constexpr size_t WS_PROJ = 944 * MiB;
constexpr size_t WS_SM2 = 1008 * MiB;
constexpr size_t WS_END = 1016 * MiB;
constexpr size_t WS_H = WS_A, WS_XS = WS_A, WS_YSLOT = WS_A;
constexpr size_t WS_XBF = WS_B, WS_U = WS_B, WS_YMIX = WS_B, WS_HH = WS_B;
constexpr size_t WS_QDEC = WS_B + 128 * MiB, WS_PB = WS_B + 128 * MiB, WS_OREC = WS_B + 160 * MiB, WS_CN = WS_B + 224 * MiB, WS_IKN = WS_B + 240 * MiB, WS_MASK = WS_B + 244 * MiB;
constexpr size_t WS_K = WS_XB, WS_VT = WS_XB + 32 * MiB;
constexpr size_t WS_TOPE = WS_SM2, WS_GATE = WS_SM2 + 512 * 1024, WS_LRANK = WS_SM2 + 1024 * 1024, WS_TOKSLOT = WS_SM2 + 1536 * 1024, WS_SLOTGATE = WS_SM2 + 2 * MiB, WS_DECAY = WS_SM2 + 3 * MiB;
constexpr size_t WS_WRT = WS_SMALL + 256 * 1024;
constexpr size_t WS_WGBASE = WS_SMALL, WS_TILEE = WS_SMALL + 64 * 1024;
constexpr int CW_CNT = 64;
constexpr int CW_BAR = 1024;
constexpr int XBW_OFF = 147456 - 16;

constexpr int RING_BYTES = 131072, MISC_OFF = RING_BYTES, LDS_BYTES = 147456;
constexpr int NWAVES = 8, NTHR = 512;

#define GAS __attribute__((address_space(1)))
#define LAS __attribute__((address_space(3)))
typedef unsigned short bf16;
typedef unsigned v4u __attribute__((ext_vector_type(4)));
typedef unsigned v2u __attribute__((ext_vector_type(2)));
typedef float f32x4 __attribute__((ext_vector_type(4)));
typedef short bf16x8 __attribute__((ext_vector_type(8)));
#define LDS_WAIT() asm volatile("s_waitcnt lgkmcnt(0)" ::: "memory")
#define VM_WAIT() asm volatile("s_waitcnt vmcnt(0)" ::: "memory")
__device__ __forceinline__ unsigned f2bf(float f) { unsigned u = __builtin_bit_cast(unsigned, f); return (u + 0x7fffu + ((u >> 16) & 1u)) >> 16; }
__device__ __forceinline__ unsigned pk2(float lo, float hi) { return f2bf(lo) | (f2bf(hi) << 16); }
__device__ __forceinline__ float bf2f(unsigned short b) { return __builtin_bit_cast(float, (unsigned)b << 16); }
__device__ __forceinline__ float bflo(unsigned w) { return __builtin_bit_cast(float, w << 16); }
__device__ __forceinline__ float bfhi(unsigned w) { return __builtin_bit_cast(float, w & 0xffff0000u); }
__device__ __forceinline__ float wave_sum(float v) {
#pragma unroll
    for (int o = 1; o < 64; o <<= 1) v += __shfl_xor(v, o);
    return v;
}
__device__ __forceinline__ float sigmoidf_(float x) { return __builtin_amdgcn_rcpf(1.f + __builtin_amdgcn_exp2f(x * -1.4426950408889634f)); }

__device__ __forceinline__ unsigned pk4_fp8(float a, float b, float c, float d);
struct Params { const float* in[25]; float* out; unsigned char* ws; };
enum { I_X = 0, I_P, I_WIN, I_KVG, I_IKG, I_IKB, I_WUK, I_WUV, I_HGLB, I_HGNG, I_WO, I_LNMG, I_LNMB, I_WR, I_BR, I_WUP, I_BUP, I_WDN, I_BDN, I_LNFG, I_LNFB, I_WPP, I_WPG, I_LNPG, I_LNPB };

struct Ctx { LAS unsigned char* lds; int tid, lane, wave, G, gw, ngw; };

namespace pg8 {
struct EpiBf16s {
    static constexpr bool PERM = true, AFTER_DRAIN = false;
    bf16_t* O; int ldc;
    __device__ __forceinline__ void operator()(const f32x4 (&acc)[2][2][4][2], const Unit& u, int wr, int wc, int fr, int fq) const {
        const int row0 = u.pm * BM + wr * 64 + fr, col0 = u.pn * BM + wc * 32 + 8 * fq;
#pragma unroll
        for (int ai = 0; ai < 2; ++ai)
#pragma unroll
            for (int m = 0; m < 4; ++m) { bf16_t* rowp = O + (size_t)(row0 + ai * HALF + m * 16) * ldc + col0;
#pragma unroll
                for (int bj = 0; bj < 2; ++bj) { const f32x4 v0 = acc[ai][bj][m][0], v1 = acc[ai][bj][m][1];
                    u32x4 w; w.x = cvt_pk_bf16(v0[0], v0[1]); w.y = cvt_pk_bf16(v0[2], v0[3]); w.z = cvt_pk_bf16(v1[0], v1[1]); w.w = cvt_pk_bf16(v1[2], v1[3]);
                    *(u32x4*)(rowp + bj * HALF) = w; } }
    }
};
struct EpiResid {
    static constexpr bool PERM = false, AFTER_DRAIN = false;
    const float* res; bf16_t* out; int ldc; float alpha, as;
    __device__ __forceinline__ void operator()(const f32x4 (&acc)[2][2][4][2], const Unit& u, int wr, int wc, int fr, int fq) const {
        const int row0 = u.pm * BM + wr * 64 + fr, col0 = u.pn * BM + wc * 32 + 4 * fq;
#pragma unroll
        for (int ai = 0; ai < 2; ++ai)
#pragma unroll
            for (int m = 0; m < 4; ++m) { const size_t off = (size_t)(row0 + ai * HALF + m * 16) * ldc + col0;
#pragma unroll
                for (int bj = 0; bj < 2; ++bj)
#pragma unroll
                    for (int n = 0; n < 2; ++n) { const f32x4 r = *(const f32x4*)(res + off + bj * HALF + n * 16); const f32x4 o = r * alpha + acc[ai][bj][m][n] * as; v2u w; w.x = cvt_pk_bf16(o[0], o[1]); w.y = cvt_pk_bf16(o[2], o[3]); *(v2u*)(out + off + bj * HALF + n * 16) = w; }
                asm volatile("" ::: "memory"); }
    }
};
struct EpiPle {
    static constexpr bool PERM = false, AFTER_DRAIN = false;
    const bf16_t* x2; const bf16_t* proj; bf16_t* out; float alpha, as;
    __device__ __forceinline__ void operator()(const f32x4 (&acc)[2][2][4][2], const Unit& u, int wr, int wc, int fr, int fq) const {
        const int row0 = u.pm * BM + wr * 64 + fr, col0 = u.pn * BM + wc * 32 + 4 * fq;
#pragma unroll
        for (int ai = 0; ai < 2; ++ai)
#pragma unroll
            for (int m = 0; m < 4; ++m) { const size_t off = (size_t)(row0 + ai * HALF + m * 16) * 1024 + col0;
#pragma unroll
                for (int bj = 0; bj < 2; ++bj)
#pragma unroll
                    for (int n = 0; n < 2; ++n) { const size_t o2 = off + bj * HALF + n * 16; const v2u rw = *(const v2u*)(x2 + o2); const f32x4 r = {bflo(rw.x), bfhi(rw.x), bflo(rw.y), bfhi(rw.y)}; const v2u pw = *(const v2u*)(proj + o2);
                        const f32x4 a = acc[ai][bj][m][n] * as; f32x4 o;
                        o[0] = r[0] * alpha + bflo(pw.x) * sigmoidf_(a[0]); o[1] = r[1] * alpha + bfhi(pw.x) * sigmoidf_(a[1]);
                        o[2] = r[2] * alpha + bflo(pw.y) * sigmoidf_(a[2]); o[3] = r[3] * alpha + bfhi(pw.y) * sigmoidf_(a[3]);
                        v2u ow; ow.x = cvt_pk_bf16(o[0], o[1]); ow.y = cvt_pk_bf16(o[2], o[3]); *(v2u*)(out + o2) = ow; }
                asm volatile("" ::: "memory"); }
    }
};
struct EpiSwiglu {
    static constexpr bool PERM = true, AFTER_DRAIN = false;
    unsigned char* H; const float* b_up;
    __device__ __forceinline__ void operator()(const f32x4 (&acc)[2][2][4][2], const Unit& u, int wr, int wc, int fr, int fq) const {
        const int e = u.pn >> 3, pnT = u.pn & 7;
        const int row0 = u.pm * BM + wr * 64 + fr, col0 = pnT * 128 + wc * 32 + 8 * fq;
        const float* bg = b_up + (size_t)e * 2048 + col0; const float* bl = bg + 1024;
        float bgv[8], blv[8];
#pragma unroll
        for (int j = 0; j < 8; ++j) { bgv[j] = bg[j]; blv[j] = bl[j]; }
#pragma unroll
        for (int ai = 0; ai < 2; ++ai)
#pragma unroll
            for (int m = 0; m < 4; ++m) { unsigned char* rowp = H + (size_t)(row0 + ai * HALF + m * 16) * 1024 + col0; float a[8];
#pragma unroll
                for (int n = 0; n < 2; ++n)
#pragma unroll
                    for (int j = 0; j < 4; ++j) { float g = acc[ai][0][m][n][j] * (1.f / 512.f) + bgv[4 * n + j], l = acc[ai][1][m][n][j] * (1.f / 512.f) + blv[4 * n + j];
                        g = fminf(g, 7.0f); l = fminf(fmaxf(l, -7.0f), 7.0f); a[4 * n + j] = g * sigmoidf_(1.702f * g) * (l + 1.0f); }
                v2u w; w.x = pk4_fp8(a[0] * 4.f, a[1] * 4.f, a[2] * 4.f, a[3] * 4.f); w.y = pk4_fp8(a[4] * 4.f, a[5] * 4.f, a[6] * 4.f, a[7] * 4.f);
                *(v2u*)rowp = w; }
    }
};
struct EpiDown {
    static constexpr bool PERM = true, AFTER_DRAIN = false;
    bf16_t* Y; const float* b_dn; const float* gate;
    __device__ __forceinline__ void operator()(const f32x4 (&acc)[2][2][4][2], const Unit& u, int wr, int wc, int fr, int fq) const {
        const int e = u.pn >> 2, pnT = u.pn & 3;
        const int row0 = u.pm * BM + wr * 64 + fr, col0 = pnT * 256 + wc * 32 + 8 * fq;
        const float* bb = b_dn + (size_t)e * 1024 + col0;
        float bv[2][8];
#pragma unroll
        for (int bj = 0; bj < 2; ++bj)
#pragma unroll
            for (int j = 0; j < 8; ++j) bv[bj][j] = bb[bj * HALF + j];
#pragma unroll
        for (int ai = 0; ai < 2; ++ai)
#pragma unroll
            for (int m = 0; m < 4; ++m) { const int row = row0 + ai * HALF + m * 16; const float gt = gate[row]; bf16_t* rowp = Y + (size_t)row * 1024 + col0;
#pragma unroll
                for (int bj = 0; bj < 2; ++bj) { const f32x4 v0 = acc[ai][bj][m][0], v1 = acc[ai][bj][m][1];
                    const float as = 1.f / 256.f;
                    u32x4 w; w.x = cvt_pk_bf16((v0[0] * as + bv[bj][0]) * gt, (v0[1] * as + bv[bj][1]) * gt); w.y = cvt_pk_bf16((v0[2] * as + bv[bj][2]) * gt, (v0[3] * as + bv[bj][3]) * gt);
                    w.z = cvt_pk_bf16((v1[0] * as + bv[bj][4]) * gt, (v1[1] * as + bv[bj][5]) * gt); w.w = cvt_pk_bf16((v1[2] * as + bv[bj][6]) * gt, (v1[3] * as + bv[bj][7]) * gt);
                    *(u32x4*)(rowp + bj * HALF) = w; } }
    }
};
struct MoeOrder {
    const int* tile_e; int ntiles, nN, G, c;
    __device__ __forceinline__ bool next(int i, Unit& u) const {
        if ((G & 7) == 0) {
            const int x = c & 7, s = i * (G >> 3) + (c >> 3);
            const int cg = nN >> 2, rg = 8 / cg;
            const int ch = x % cg, rc = x / cg;
            const int lr = s >> 2, pl = 4 * ch + (s & 3), pm = rc + rg * lr;
            if (pm >= ntiles) return false;
            u.pm = pm; u.pn = tile_e[pm] * nN + pl; return true;
        }
        const int L = i * G + c; if (L >= ntiles * nN) return false;
        const int pm = L / nN, pl = L - pm * nN; u.pm = pm; u.pn = tile_e[pm] * nN + pl; return true;
    }
    __device__ __forceinline__ void a_ready(const Unit&) const {}
    __device__ __forceinline__ void done(const Unit&) const {}
};
}

template <class RowMap>
__device__ __forceinline__ void transpose_item(const float* W, int ldw, int Nvalid, bf16* WT, int Kdim, RowMap rm, LAS float* scr, int kb, int nb, int lane) {
    const int k0 = 64 * kb, n0 = 32 * nb; const int nl0 = lane & 31, nn = n0 + nl0;
#pragma unroll 8
    for (int i = 0; i < 32; ++i) { const int kk = 2 * i + (lane >> 5); scr[kk * 33 + nl0] = (nn < Nvalid) ? W[(size_t)(k0 + kk) * ldw + nn] : 0.f; }
    LDS_WAIT(); asm volatile("" ::: "memory");
    const int c = lane & 7;
#pragma unroll
    for (int j = 0; j < 4; ++j) { const int n = (lane >> 3) + 8 * j; const LAS float* s = scr + (8 * c) * 33 + n;
        v4u o; o.x = pk2(s[0 * 33], s[1 * 33]); o.y = pk2(s[2 * 33], s[3 * 33]); o.z = pk2(s[4 * 33], s[5 * 33]); o.w = pk2(s[6 * 33], s[7 * 33]);
        *(GAS v4u*)(WT + (size_t)rm(n0 + n) * Kdim + k0 + 8 * c) = o; }
    LDS_WAIT(); asm volatile("" ::: "memory");
}
__device__ __forceinline__ unsigned pk4_fp8(float a, float b, float c, float d) { int r = 0; r = __builtin_amdgcn_cvt_pk_fp8_f32(a, b, r, false); r = __builtin_amdgcn_cvt_pk_fp8_f32(c, d, r, true); return (unsigned)r; }
template <class RowMap>
__device__ __forceinline__ void transpose_item_f8(const float* W, int ldw, unsigned char* WT, int Kdim, RowMap rm, LAS float* scr, int kb, int nb, int lane, float mul) {
    const int k0 = 64 * kb, n0 = 32 * nb; const int nl0 = lane & 31, nn = n0 + nl0;
#pragma unroll 8
    for (int i = 0; i < 32; ++i) { const int kk = 2 * i + (lane >> 5); scr[kk * 33 + nl0] = W[(size_t)(k0 + kk) * ldw + nn] * mul; }
    LDS_WAIT(); asm volatile("" ::: "memory");
    const int c = lane & 7;
#pragma unroll
    for (int j = 0; j < 4; ++j) { const int n = (lane >> 3) + 8 * j; const LAS float* s = scr + (8 * c) * 33 + n;
        v2u o; o.x = pk4_fp8(s[0 * 33], s[1 * 33], s[2 * 33], s[3 * 33]); o.y = pk4_fp8(s[4 * 33], s[5 * 33], s[6 * 33], s[7 * 33]);
        *(GAS v2u*)(WT + (size_t)rm(n0 + n) * Kdim + k0 + 8 * c) = o; }
    LDS_WAIT(); asm volatile("" ::: "memory");
}
struct RmId { __device__ __forceinline__ int operator()(int n) const { return n; } };
struct RmUp { int e; __device__ __forceinline__ int operator()(int n) const { return e * 2048 + ((n & 1023) >> 7) * 256 + (n >> 10) * 128 + (n & 127); } };
struct RmOff { int off; __device__ __forceinline__ int operator()(int n) const { return off + n; } };

struct CvtItem { const float* src; unsigned char* dst; int ldw; };
__device__ __forceinline__ CvtItem cvt_decode(const Params& P, int r) {
    unsigned char* ws = P.ws; CvtItem c;
    constexpr int I_O = 8 * 32, I_UP = 8 * 64, I_DN = 8 * 32;
    if (r < I_O) { const int kb = r / 32, nb = r % 32; c.src = P.in[I_WO] + (size_t)(128 * kb) * 1024 + 32 * nb; c.ldw = 1024; c.dst = ws + WS_WO_T + (size_t)(32 * nb) * 1024 + 128 * kb; return c; } r -= I_O;
    if (r < NE * I_UP) { const int e = r / I_UP, q = r % I_UP, kb = q / 64, nb = q % 64, n0 = 32 * nb; c.src = P.in[I_WUP] + (size_t)e * 1024 * 2048 + (size_t)(128 * kb) * 2048 + n0; c.ldw = 2048;
        c.dst = ws + WS_WUP_T + (size_t)(e * 2048 + ((n0 & 1023) >> 7) * 256 + (n0 >> 10) * 128 + (n0 & 127)) * 1024 + 128 * kb; return c; } r -= NE * I_UP;
    if (r < NE * I_DN) { const int e = r / I_DN, q = r % I_DN, kb = q / 32, nb = q % 32; c.src = P.in[I_WDN] + (size_t)e * 1024 * 1024 + (size_t)(128 * kb) * 1024 + 32 * nb; c.ldw = 1024;
        c.dst = ws + WS_WDN_T + (size_t)(e * 1024 + 32 * nb) * 1024 + 128 * kb; return c; } r -= NE * I_DN;
    { const int kb = r / 32, nb = r % 32; c.src = P.in[I_WPG] + (size_t)(128 * kb) * 1024 + 32 * nb; c.ldw = 1024; c.dst = ws + WS_WGATE_T + (size_t)(32 * nb) * 1024 + 128 * kb; return c; }
}
__device__ __forceinline__ void cvt_load(const CvtItem& c, float (&v)[64], int lane) {
    const float* p = c.src + (size_t)(lane >> 5) * c.ldw + (lane & 31);
#pragma unroll
    for (int i = 0; i < 64; ++i) v[i] = p[(size_t)(2 * i) * c.ldw];
}
__device__ __forceinline__ void cvt_store(const CvtItem& c, const float (&v)[64], LAS float* scr, int lane) {
#pragma unroll
    for (int i = 0; i < 64; ++i) scr[(2 * i + (lane >> 5)) * 33 + (lane & 31)] = v[i] * 64.f;
    LDS_WAIT(); asm volatile("" ::: "memory");
    const int ch = lane & 15;
#pragma unroll
    for (int j = 0; j < 8; ++j) { const int n = (lane >> 4) + 4 * j; const LAS float* s = scr + (8 * ch) * 33 + n;
        v2u o; o.x = pk4_fp8(s[0 * 33], s[1 * 33], s[2 * 33], s[3 * 33]); o.y = pk4_fp8(s[4 * 33], s[5 * 33], s[6 * 33], s[7 * 33]);
        *(GAS v2u*)(c.dst + (size_t)n * 1024 + 8 * ch) = o; }
    LDS_WAIT(); asm volatile("" ::: "memory");
}
__device__ __forceinline__ void convert_late(const Params& P, LAS float* scr, int gwc, int ngwc, int lane) {
    constexpr int NT = 8 * 32 + NE * 8 * 64 + NE * 8 * 32 + 8 * 32;
    float va[64], vb[64];
    int it = gwc;
    if (it < NT) { const CvtItem c = cvt_decode(P, it); cvt_load(c, va, lane); }
    for (; it < NT; it += 2 * ngwc) {
        const int i1 = it + ngwc, i2 = it + 2 * ngwc;
        if (i1 < NT) { const CvtItem c = cvt_decode(P, i1); cvt_load(c, vb, lane); }
        { const CvtItem c = cvt_decode(P, it); cvt_store(c, va, scr, lane); }
        if (i2 < NT) { const CvtItem c = cvt_decode(P, i2); cvt_load(c, va, lane); }
        if (i1 < NT) { const CvtItem c = cvt_decode(P, i1); cvt_store(c, vb, scr, lane); }
    }
    for (int r = gwc; r < 512; r += ngwc) { const int i = r * 64 + lane; const int e = i >> 10, k = i & 1023; ((float*)(P.ws + WS_WRT))[i] = P.in[I_WR][k * 32 + e]; }
}
__device__ __forceinline__ void p0_prologue(const Params& P, const Ctx& C) {
    LAS float* scr = (LAS float*)(C.lds + C.wave * 16384);
    unsigned char* ws = P.ws;
    constexpr int I_IN = 16 * (D_INP / 32), I_PP = 4 * 32, I_UK = 4 * 16, I_UV = 4 * 16;
    constexpr int NITEMS = I_IN + I_PP + I_UK + I_UV;
    for (int it = C.gw; it < NITEMS; it += C.ngw) {
        int r = it;
        if (r < I_IN) { transpose_item(P.in[I_WIN], D_IN, D_IN, (bf16*)(ws + WS_WIN_T), 1024, RmId{}, scr, r / (D_INP / 32), r % (D_INP / 32), C.lane); continue; } r -= I_IN;
        if (r < I_PP) { transpose_item(P.in[I_WPP], 1024, 1024, (bf16*)(ws + WS_WPROJ_T), 256, RmId{}, scr, r / 32, r % 32, C.lane); continue; } r -= I_PP;
        if (r < I_UK) { transpose_item(P.in[I_WUK], 512, 512, (bf16*)(ws + WS_WUK_T), 256, RmId{}, scr, r / 16, r % 16, C.lane); continue; } r -= I_UK;
        transpose_item(P.in[I_WUV], 512, 512, (bf16*)(ws + WS_WUV_T), 256, RmId{}, scr, r / 16, r % 16, C.lane);
    }
    {
        const float* x = P.in[I_X]; bf16* xb = (bf16*)(ws + WS_XBF);
        const size_t n8 = (size_t)NTOK * D / 8, stride = (size_t)C.ngw * 64;
        for (size_t i = (size_t)C.gw * 64 + C.lane; i < n8; i += stride) { const f32x4 a = *(const GAS f32x4*)(x + i * 8), b = *(const GAS f32x4*)(x + i * 8 + 4);
            v4u o; o.x = pk2(a[0], a[1]); o.y = pk2(a[2], a[3]); o.z = pk2(b[0], b[1]); o.w = pk2(b[2], b[3]); *(GAS v4u*)(xb + i * 8) = o; }
        const float* p = P.in[I_P]; bf16* pb = (bf16*)(ws + WS_PB);
        const size_t m8 = (size_t)NTOK * PLE / 8;
        for (size_t i = (size_t)C.gw * 64 + C.lane; i < m8; i += stride) { const f32x4 a = *(const GAS f32x4*)(p + i * 8), b = *(const GAS f32x4*)(p + i * 8 + 4);
            v4u o; o.x = pk2(a[0], a[1]); o.y = pk2(a[2], a[3]); o.z = pk2(b[0], b[1]); o.w = pk2(b[2], b[3]); *(GAS v4u*)(pb + i * 8) = o; }
    }
}

__device__ __forceinline__ void ln_row(f32x4 (&v)[4], const float* g, const float* b, int lane) {
    float s = 0.f;
#pragma unroll
    for (int j = 0; j < 4; ++j) s += (v[j][0] + v[j][1]) + (v[j][2] + v[j][3]);
    const float mean = wave_sum(s) * (1.f / D); float s2 = 0.f;
#pragma unroll
    for (int j = 0; j < 4; ++j) { v[j] = v[j] - mean; s2 += (v[j][0] * v[j][0] + v[j][1] * v[j][1]) + (v[j][2] * v[j][2] + v[j][3] * v[j][3]); }
    const float rstd = 1.f / sqrtf(wave_sum(s2) * (1.f / D) + LN_EPS);
#pragma unroll
    for (int j = 0; j < 4; ++j) { const f32x4 gg = *(const f32x4*)(g + 4 * lane + 256 * j), bb = *(const f32x4*)(b + 4 * lane + 256 * j); v[j] = v[j] * rstd * gg + bb; }
}
__device__ __forceinline__ void store_row_f32(float* row, const f32x4 (&v)[4], int lane) {
#pragma unroll
    for (int j = 0; j < 4; ++j) *(GAS f32x4*)(row + 4 * lane + 256 * j) = v[j];
}
__device__ __forceinline__ void store_row_bf16(bf16* row, const f32x4 (&v)[4], int lane) {
#pragma unroll
    for (int j = 0; j < 4; ++j) { v2u o; o.x = pk2(v[j][0], v[j][1]); o.y = pk2(v[j][2], v[j][3]); *(GAS v2u*)(row + 4 * lane + 256 * j) = o; }
}
__device__ __forceinline__ void store_row_fp8x8(unsigned char* row, const f32x4 (&v)[4], int lane) {
#pragma unroll
    for (int j = 0; j < 4; ++j) *(GAS unsigned*)(row + 4 * lane + 256 * j) = pk4_fp8(v[j][0] * 8.f, v[j][1] * 8.f, v[j][2] * 8.f, v[j][3] * 8.f);
}
__device__ __forceinline__ void load_row_bf16(f32x4 (&v)[4], const bf16* row, int lane) {
#pragma unroll
    for (int j = 0; j < 4; ++j) { const v2u w = *(const GAS v2u*)(row + 4 * lane + 256 * j); v[j] = (f32x4){bflo(w.x), bfhi(w.x), bflo(w.y), bfhi(w.y)}; }
}
__device__ __forceinline__ void load_row_f32(f32x4 (&v)[4], const float* row, int lane) {
#pragma unroll
    for (int j = 0; j < 4; ++j) v[j] = *(const GAS f32x4*)(row + 4 * lane + 256 * j);
}
#ifndef FEAT_MIX
#define FEAT_MIX 1
#endif
#ifndef FEAT_MOE
#define FEAT_MOE 1
#endif
#ifndef FEAT_PLE
#define FEAT_PLE 1
#endif
#ifndef FEAT_ATT
#define FEAT_ATT 1
#endif
#ifndef SYNC_MODE
#define SYNC_MODE 0
#endif
#ifndef PROGRAM
#define PROGRAM X(0) GS X(10) X(11) SY X(20) X(21) SY X(30) X(31) BS X(32) SY X(40) X(41) SY X(5) SY X(6) SY X(7) SY X(8) SY X(9) SY X(100) SY X(110) SY X(120)
#endif

typedef float f32x16 __attribute__((ext_vector_type(16)));
typedef short s16x4 __attribute__((ext_vector_type(4)));
__device__ __forceinline__ unsigned cvtpk(float lo, float hi) { typedef float f2 __attribute__((ext_vector_type(2))); typedef __bf16 b2 __attribute__((ext_vector_type(2))); f2 v = {lo, hi}; b2 b = __builtin_convertvector(v, b2); return __builtin_bit_cast(unsigned, b); }
__device__ __forceinline__ bf16x8 pack8(const f32x16& x, int base) {
    v4u w; w.x = cvtpk(x[base + 0], x[base + 1]); w.y = cvtpk(x[base + 2], x[base + 3]); w.z = cvtpk(x[base + 4], x[base + 5]); w.w = cvtpk(x[base + 6], x[base + 7]);
    return __builtin_bit_cast(bf16x8, w);
}

__device__ __forceinline__ void p2_post(const Params& P, const Ctx& C) {
    unsigned char* ws = P.ws;
    const bf16* H = (const bf16*)(ws + WS_H); bf16* CN = (bf16*)(ws + WS_CN); bf16* IKN = (bf16*)(ws + WS_IKN);
    const float* kvg = P.in[I_KVG]; const float* ikg = P.in[I_IKG]; const float* ikb = P.in[I_IKB];
    const f32x4 g4 = *(const f32x4*)(kvg + 4 * C.lane); const float ig = ikg[C.lane], ib = ikb[C.lane];
    for (int m = C.gw; m < NTOK; m += C.ngw) {
        const bf16* hr = H + (size_t)m * D_INP;
        const v2u w = *(const GAS v2u*)(hr + C_AC + 4 * C.lane);
        float a0 = bflo(w.x), a1 = bfhi(w.x), a2 = bflo(w.y), a3 = bfhi(w.y);
        const float ss = wave_sum((a0 * a0 + a1 * a1) + (a2 * a2 + a3 * a3));
        const float rs = 1.f / sqrtf(ss * (1.f / 256.f) + RMS_EPS);
        v2u o; o.x = pk2(a0 * rs * g4[0], a1 * rs * g4[1]); o.y = pk2(a2 * rs * g4[2], a3 * rs * g4[3]);
        *(GAS v2u*)(CN + (size_t)m * 256 + 4 * C.lane) = o;
        const float k = bf2f(hr[C_IK + C.lane]);
        const float mu = wave_sum(k) * (1.f / 64.f); const float dk = k - mu;
        const float var = wave_sum(dk * dk) * (1.f / 64.f);
        IKN[(size_t)m * 64 + C.lane] = (bf16)f2bf(dk * (1.f / sqrtf(var + LN_EPS)) * ig + ib);
    }
}

constexpr int HP_QD = 0, HP_KI = 8704, HP_KET = 17408, HP_VT = 27648, HP_GS = 37888, HP_RAW = 40960;
__device__ __forceinline__ void p2_hgrn_prep(const Params& P, const Ctx& C) {
    unsigned char* ws = P.ws;
    const bf16* H = (const bf16*)(ws + WS_H);
    bf16* UT = (bf16*)(ws + WS_U); bf16* QDEC = (bf16*)(ws + WS_QDEC); float* OREC = (float*)(ws + WS_OREC); float* DEC = (float*)(ws + WS_DECAY);
    LAS bf16* QD = (LAS bf16*)(C.lds + HP_QD); LAS bf16* KI = (LAS bf16*)(C.lds + HP_KI); LAS bf16* KET = (LAS bf16*)(C.lds + HP_KET); LAS bf16* VT = (LAS bf16*)(C.lds + HP_VT);
    LAS float* GS = (LAS float*)(C.lds + HP_GS); LAS bf16* RAW = (LAS bf16*)(C.lds + HP_RAW);
    const int d = C.tid & 127, tg = C.tid >> 7;
    const int lane = C.lane, r32 = lane & 31, hf = lane >> 5;
    const int lc = C.tid >> 4, lg = C.tid & 15;
    const int NU = NB * HG_H * (T / HG_C);
    v4u rf, rq, ri;
    { const int unit = blockIdx.x; if (unit < NU) { const int n = unit & 127, hh = (unit >> 7) & 3, b = unit >> 9; const bf16* hr = H + (size_t)(b * T + n * HG_C + lc) * D_INP + hh * 128 + 8 * lg;
        rf = *(const GAS v4u*)(hr + C_GF); rq = *(const GAS v4u*)(hr + C_GQ); ri = *(const GAS v4u*)(hr + C_GI); } }
    for (int unit = blockIdx.x; unit < NU; unit += C.G) {
        const int n = unit & 127, hh = (unit >> 7) & 3, b = unit >> 9;
        const int m0 = b * T + n * HG_C;
        *(LAS v4u*)(RAW + lc * 128 + 8 * lg) = rf; *(LAS v4u*)(RAW + 4096 + lc * 128 + 8 * lg) = rq; *(LAS v4u*)(RAW + 8192 + lc * 128 + 8 * lg) = ri;
        __syncthreads();
        { const int un = unit + C.G; if (un < NU) { const int n2 = un & 127, h2 = (un >> 7) & 3, b2 = un >> 9; const bf16* hr = H + (size_t)(b2 * T + n2 * HG_C + lc) * D_INP + h2 * 128 + 8 * lg;
            rf = *(const GAS v4u*)(hr + C_GF); rq = *(const GAS v4u*)(hr + C_GQ); ri = *(const GAS v4u*)(hr + C_GI); } }
        const float l0 = P.in[I_HGLB][hh * 128 + d], l1 = P.in[I_HGLB][512 + hh * 128 + d];
        const float lb = 1.f / (1.f + __expf(l1 - l0));
        float fg[8], bl[8], qv[8]; float run = 0.f; unsigned vv[4];
#pragma unroll
        for (int c = 0; c < 8; ++c) { const int tok = tg * 8 + c;
            const float f = bf2f(RAW[tok * 128 + d]), q = bf2f(RAW[4096 + tok * 128 + d]); const unsigned iv = RAW[8192 + tok * 128 + d];
            fg[c] = lb + (1.f - lb) * sigmoidf_(f); run += __logf(fg[c]); bl[c] = run; qv[c] = q * sigmoidf_(q);
            if (c & 1) vv[c >> 1] |= iv << 16; else vv[c >> 1] = iv; }
        GS[tg * 128 + d] = run;
        *(LAS v4u*)(VT + d * 40 + tg * 8) = (v4u){vv[0], vv[1], vv[2], vv[3]};
        __syncthreads();
        float pre = 0.f, tot = 0.f;
#pragma unroll
        for (int g = 0; g < 4; ++g) { const float sg = GS[g * 128 + d]; tot += sg; if (g < tg) pre += sg; }
        unsigned ke[4];
#pragma unroll
        for (int c = 0; c < 8; ++c) { const float bc = pre + bl[c]; const float kc = 1.f - fg[c];
            const float qd = qv[c] * __expf(bc), ki = kc * __expf(-bc), kend = kc * __expf(tot - bc);
            const unsigned qb = f2bf(qd);
            QD[(tg * 8 + c) * 136 + d] = (bf16)qb; KI[(tg * 8 + c) * 136 + d] = (bf16)f2bf(ki);
            if (c & 1) ke[c >> 1] |= f2bf(kend) << 16; else ke[c >> 1] = f2bf(kend); }
        *(LAS v4u*)(KET + d * 40 + tg * 8) = (v4u){ke[0], ke[1], ke[2], ke[3]};
        if (tg == 0) DEC[(size_t)unit * 128 + d] = __expf(tot);
        __syncthreads();
        *(GAS v4u*)(QDEC + (size_t)(m0 + lc) * 512 + hh * 128 + 8 * lg) = *(const LAS v4u*)(QD + lc * 136 + 8 * lg);
        if (C.wave < 4) {
            f32x16 X = {0.f, 0.f, 0.f, 0.f, 0.f, 0.f, 0.f, 0.f, 0.f, 0.f, 0.f, 0.f, 0.f, 0.f, 0.f, 0.f};
#pragma unroll
            for (int k = 0; k < 8; ++k) { const bf16x8 a = *(const LAS bf16x8*)(KI + r32 * 136 + 16 * k + 8 * hf), bq = *(const LAS bf16x8*)(QD + r32 * 136 + 16 * k + 8 * hf);
                X = __builtin_amdgcn_mfma_f32_32x32x16_bf16(a, bq, X, 0, 0, 0); }
#pragma unroll
            for (int r = 0; r < 16; ++r) { const int sidx = (r & 3) + 8 * (r >> 2) + 4 * hf; if (sidx > r32) X[r] = 0.f; }
            f32x16 Z = {0.f, 0.f, 0.f, 0.f, 0.f, 0.f, 0.f, 0.f, 0.f, 0.f, 0.f, 0.f, 0.f, 0.f, 0.f, 0.f};
            const int e = C.wave * 32 + r32;
#pragma unroll
            for (int sp = 0; sp < 2; ++sp) { const bf16x8 a = pack8(X, 8 * sp);
                const s16x4 lo = *(const LAS s16x4*)(VT + e * 40 + 16 * sp + 4 * hf), hi = *(const LAS s16x4*)(VT + e * 40 + 16 * sp + 8 + 4 * hf);
                const bf16x8 bv = (bf16x8){lo[0], lo[1], lo[2], lo[3], hi[0], hi[1], hi[2], hi[3]};
                Z = __builtin_amdgcn_mfma_f32_32x32x16_bf16(a, bv, Z, 0, 0, 0); }
#pragma unroll
            for (int r = 0; r < 16; ++r) { const int c = (r & 3) + 8 * (r >> 2) + 4 * hf; OREC[(size_t)(m0 + c) * 512 + hh * 128 + e] = Z[r]; }
        }
        {
            const int dt = C.wave >> 1;
            const bf16x8 a0 = *(const LAS bf16x8*)(KET + (dt * 32 + r32) * 40 + 8 * hf), a1 = *(const LAS bf16x8*)(KET + (dt * 32 + r32) * 40 + 16 + 8 * hf);
#pragma unroll
            for (int ei = 0; ei < 2; ++ei) { const int et = 2 * (C.wave & 1) + ei;
                const bf16x8 b0 = *(const LAS bf16x8*)(VT + (et * 32 + r32) * 40 + 8 * hf), b1 = *(const LAS bf16x8*)(VT + (et * 32 + r32) * 40 + 16 + 8 * hf);
                f32x16 U = {0.f, 0.f, 0.f, 0.f, 0.f, 0.f, 0.f, 0.f, 0.f, 0.f, 0.f, 0.f, 0.f, 0.f, 0.f, 0.f};
                U = __builtin_amdgcn_mfma_f32_32x32x16_bf16(a0, b0, U, 0, 0, 0); U = __builtin_amdgcn_mfma_f32_32x32x16_bf16(a1, b1, U, 0, 0, 0);
                bf16* up = UT + (size_t)unit * 16384 + (size_t)(et * 32 + r32) * 128 + dt * 32 + 4 * hf;
#pragma unroll
                for (int q = 0; q < 4; ++q) { v2u o; o.x = cvtpk(U[4 * q], U[4 * q + 1]); o.y = cvtpk(U[4 * q + 2], U[4 * q + 3]); *(GAS v2u*)(up + 8 * q) = o; } }
        }
        __syncthreads();
    }
}

__device__ __forceinline__ void scan_wave(const Params& P, LAS unsigned char* lds, int unit, int lane) {
    unsigned char* ws = P.ws;
    const bf16* UT = (const bf16*)(ws + WS_U); const bf16* QDEC = (const bf16*)(ws + WS_QDEC); float* OREC = (float*)(ws + WS_OREC); const float* DEC = (const float*)(ws + WS_DECAY);
    typedef float f32x4v __attribute__((ext_vector_type(4)));
    const int xcd = (unit >> 1) & 7, loc = ((unit >> 4) << 1) | (unit & 1);
    const int bh = xcd + 8 * (loc >> 4), sl = loc & 15; const int b = bh >> 2, hh = bh & 3, e0 = 8 * sl;
    LAS bf16* ST = (LAS bf16*)lds;
    const int e = lane & 7, dq = lane >> 3;
    const int fr = lane & 15, fq = lane >> 4;
    float S[16];
#pragma unroll
    for (int i = 0; i < 16; ++i) S[i] = 0.f;
    for (int i = lane; i < 2 * 16 * 136 / 8; i += 64) *(LAS v4u*)(ST + 8 * i) = (v4u){0u, 0u, 0u, 0u};
    const int cu0 = (b * HG_H + hh) * 128;
    const bf16* up = UT + (size_t)cu0 * 16384 + (size_t)(e0 + e) * 128 + 16 * dq;
    const float* dp = DEC + (size_t)cu0 * 128 + 16 * dq;
    const bf16* qp = QDEC + (size_t)(b * T + fr) * 512 + hh * 128 + 8 * fq;
    float* op = OREC + (size_t)(b * T + 4 * fq) * 512 + hh * 128 + e0 + fr;
    const float* opl = OREC + (size_t)(b * T + 4 * fq) * 512 + hh * 128 + e0 + (fr & 7);
    const bool ov = fr < 8;
    v4u un[4][2]; float oi[4][2][4]; f32x4 dn[2][4]; bf16x8 qa[2][2][4];
#define SC_LD_U(slot, n) { un[slot][0] = *(const GAS v4u*)(up + (size_t)(n) * 16384); un[slot][1] = *(const GAS v4u*)(up + (size_t)(n) * 16384 + 8); \
        _Pragma("unroll") for (int t_ = 0; t_ < 2; ++t_) _Pragma("unroll") for (int j_ = 0; j_ < 4; ++j_) oi[slot][t_][j_] = opl[(size_t)((n) * 32 + 16 * t_ + j_) * 512]; }
#define SC_LD_Q(slot, n) { _Pragma("unroll") for (int i_ = 0; i_ < 4; ++i_) dn[slot][i_] = *(const GAS f32x4*)(dp + (size_t)(n) * 128 + 4 * i_); \
        _Pragma("unroll") for (int t_ = 0; t_ < 2; ++t_) _Pragma("unroll") for (int k_ = 0; k_ < 4; ++k_) qa[slot][t_][k_] = *(const GAS bf16x8*)(qp + (size_t)((n) * 32 + 16 * t_) * 512 + 32 * k_); }
    SC_LD_U(0, 0) SC_LD_U(1, 1) SC_LD_U(2, 2) SC_LD_U(3, 3) SC_LD_Q(0, 0) SC_LD_Q(1, 1)
    LDS_WAIT();
    for (int nb = 0; nb < 32; ++nb) {
#pragma unroll
        for (int s = 0; s < 4; ++s) {
            const int n = 4 * nb + s; const int su = s, sq = s & 1;
            const LAS bf16* stc = ST + (n & 1) * (16 * 136); LAS bf16* stn = ST + ((n + 1) & 1) * (16 * 136);
            bf16x8 bs[4];
#pragma unroll
            for (int k = 0; k < 4; ++k) bs[k] = *(const LAS bf16x8*)(stc + fr * 136 + 32 * k + 8 * fq);
#pragma unroll
            for (int t = 0; t < 2; ++t) { f32x4v acc = {oi[su][t][0], oi[su][t][1], oi[su][t][2], oi[su][t][3]};
#pragma unroll
                for (int k = 0; k < 4; ++k) acc = __builtin_amdgcn_mfma_f32_16x16x32_bf16(qa[sq][t][k], bs[k], acc, 0, 0, 0);
                if (ov) {
#pragma unroll
                    for (int j = 0; j < 4; ++j) op[(size_t)(n * 32 + 16 * t + j) * 512] = acc[j]; } }
            {
                const unsigned uw[8] = {un[su][0].x, un[su][0].y, un[su][0].z, un[su][0].w, un[su][1].x, un[su][1].y, un[su][1].z, un[su][1].w};
                unsigned pk[8];
#pragma unroll
                for (int i = 0; i < 8; ++i) { S[2 * i] = dn[sq][i >> 1][(2 * i) & 3] * S[2 * i] + bflo(uw[i]); S[2 * i + 1] = dn[sq][i >> 1][(2 * i + 1) & 3] * S[2 * i + 1] + bfhi(uw[i]); pk[i] = cvtpk(S[2 * i], S[2 * i + 1]); }
                *(LAS v4u*)(stn + e * 136 + 16 * dq) = (v4u){pk[0], pk[1], pk[2], pk[3]}; *(LAS v4u*)(stn + e * 136 + 16 * dq + 8) = (v4u){pk[4], pk[5], pk[6], pk[7]};
            }
            if (n + 4 < 128) SC_LD_U(su, n + 4)
            if (n + 2 < 128) SC_LD_Q(sq, n + 2)
        }
    }
#undef SC_LD_U
#undef SC_LD_Q
}
__device__ __forceinline__ void p3_scan_convert(const Params& P, const Ctx& C) {
    if (C.wave < 2) {
        for (int u = blockIdx.x * 2 + C.wave; u < NB * HG_H * 16; u += C.G * 2) scan_wave(P, C.lds + C.wave * 8704, u, C.lane);
    } else {
        convert_late(P, (LAS float*)(C.lds + 32768 + (C.wave - 2) * 17408), blockIdx.x * 6 + (C.wave - 2), C.G * 6, C.lane);
    }
}

__device__ __forceinline__ void p4_yrec(const Params& P, const Ctx& C) {
    unsigned char* ws = P.ws;
    const float* OREC = (const float*)(ws + WS_OREC); const bf16* H = (const bf16*)(ws + WS_H); bf16* YM = (bf16*)(ws + WS_YMIX);
    const float* ng = P.in[I_HGNG];
    const f32x4 g0 = *(const f32x4*)(ng + 8 * C.lane), g1 = *(const f32x4*)(ng + 8 * C.lane + 4);
    for (int m = C.gw; m < NTOK; m += C.ngw) {
        const f32x4 a = *(const GAS f32x4*)(OREC + (size_t)m * 512 + 8 * C.lane), bq = *(const GAS f32x4*)(OREC + (size_t)m * 512 + 8 * C.lane + 4);
        float ss = (a[0] * a[0] + a[1] * a[1]) + (a[2] * a[2] + a[3] * a[3]) + (bq[0] * bq[0] + bq[1] * bq[1]) + (bq[2] * bq[2] + bq[3] * bq[3]);
        ss += __shfl_xor(ss, 1); ss += __shfl_xor(ss, 2); ss += __shfl_xor(ss, 4); ss += __shfl_xor(ss, 8);
        const float rs = 1.f / sqrtf(ss * (1.f / 128.f) + RMS_EPS);
        const v4u gw = *(const GAS v4u*)(H + (size_t)m * D_INP + C_GG + 8 * C.lane);
        float gv[8] = {bflo(gw.x), bfhi(gw.x), bflo(gw.y), bfhi(gw.y), bflo(gw.z), bfhi(gw.z), bflo(gw.w), bfhi(gw.w)};
        float o[8];
#pragma unroll
        for (int j = 0; j < 4; ++j) { o[j] = a[j] * rs * g0[j] * (gv[j] * sigmoidf_(gv[j])); o[4 + j] = bq[j] * rs * g1[j] * (gv[4 + j] * sigmoidf_(gv[4 + j])); }
        v2u w; w.x = pk4_fp8(o[0] * 8.f, o[1] * 8.f, o[2] * 8.f, o[3] * 8.f); w.y = pk4_fp8(o[4] * 8.f, o[5] * 8.f, o[6] * 8.f, o[7] * 8.f);
        *(GAS v2u*)((unsigned char*)YM + (size_t)m * D + 512 + 8 * C.lane) = w;
#if !FEAT_ATT
        *(GAS v4u*)(YM + (size_t)m * D + 8 * C.lane) = (v4u){0u, 0u, 0u, 0u};
#endif
    }
}

namespace pg8 {
struct EpiKhead {
    static constexpr bool PERM = true, AFTER_DRAIN = false;
    bf16_t* O;
    __device__ __forceinline__ void operator()(const f32x4 (&acc)[2][2][4][2], const Unit& u, int wr, int wc, int fr, int fq) const {
        const int row0 = u.pm * BM + wr * 64 + fr, col0 = u.pn * BM + wc * 32 + 8 * fq;
#pragma unroll
        for (int ai = 0; ai < 2; ++ai)
#pragma unroll
            for (int m = 0; m < 4; ++m) { const int row = row0 + ai * HALF + m * 16; const int b = row >> 12, t = row & 4095;
#pragma unroll
                for (int bj = 0; bj < 2; ++bj) { const int col = col0 + bj * HALF; const f32x4 v0 = acc[ai][bj][m][0], v1 = acc[ai][bj][m][1];
                    u32x4 w; w.x = cvt_pk_bf16(v0[0], v0[1]); w.y = cvt_pk_bf16(v0[2], v0[3]); w.z = cvt_pk_bf16(v1[0], v1[1]); w.w = cvt_pk_bf16(v1[2], v1[3]);
                    *(u32x4*)(O + ((size_t)((b * 8 + (col >> 6)) * 4096 + t)) * 64 + (col & 63)) = w; } }
    }
};
struct EpiVt {
    static constexpr bool PERM = true, AFTER_DRAIN = false;
    bf16_t* O;
    __device__ __forceinline__ void operator()(const f32x4 (&acc)[2][2][4][2], const Unit& u, int wr, int wc, int fr, int fq) const {
        const int row0 = u.pm * BM + wr * 64 + fr, col0 = u.pn * BM + wc * 32 + 8 * fq;
#pragma unroll
        for (int ai = 0; ai < 2; ++ai)
#pragma unroll
            for (int m = 0; m < 4; ++m) { const int row = row0 + ai * HALF + m * 16;
#pragma unroll
                for (int bj = 0; bj < 2; ++bj) { const int col = col0 + bj * HALF; const int b = col >> 12, t = col & 4095; const f32x4 v0 = acc[ai][bj][m][0], v1 = acc[ai][bj][m][1];
                    u32x4 w; w.x = cvt_pk_bf16(v0[0], v0[1]); w.y = cvt_pk_bf16(v0[2], v0[3]); w.z = cvt_pk_bf16(v1[0], v1[1]); w.w = cvt_pk_bf16(v1[2], v1[3]);
                    *(u32x4*)(O + ((size_t)(b * 512 + row)) * 4096 + t) = w; } }
    }
};
}

__device__ __forceinline__ unsigned f2ord(float x) { const unsigned b = __builtin_bit_cast(unsigned, x); return b ^ ((unsigned)((int)b >> 31) | 0x80000000u); }
typedef _Float16 h16;
typedef _Float16 h16x8 __attribute__((ext_vector_type(8)));
__device__ __forceinline__ float relu_i(float x) { const int b = __builtin_bit_cast(int, x); return __builtin_bit_cast(float, b > 0 ? b : 0); }
__device__ __forceinline__ unsigned h2ord(unsigned hb) { return (hb ^ ((hb & 0x8000u) ? 0xffffu : 0x8000u)) & 0xffffu; }
__device__ __forceinline__ int isc_bucket(float x, float mu, float scale) { const float t = fminf(fmaxf(fmaf(x - mu, scale, 128.f), 0.f), 255.f); return (int)t; }
__device__ __forceinline__ void p3_indexer(const Params& P, const Ctx& C) {
    unsigned char* ws = P.ws;
    const bf16* H = (const bf16*)(ws + WS_H); const bf16* IKN = (const bf16*)(ws + WS_IKN); unsigned* MASK = (unsigned*)(ws + WS_MASK);
    LAS h16* ISC = (LAS h16*)C.lds; LAS unsigned* HIST = (LAS unsigned*)(C.lds + 131072) + C.wave * 256; LAS float* STAT = (LAS float*)(C.lds + 139264); LAS float* W16 = (LAS float*)(C.lds + 140288);
    const int lane = C.lane, r32 = lane & 31, hf = lane >> 5;
    const int ql = 2 * (r32 >> 4) + ((r32 >> 2) & 1), hd = 4 * ((r32 >> 3) & 1) + (r32 & 3);
    constexpr int CAND_CAP = 120, QU = 16;
    for (int u = blockIdx.x; u < NTOK / QU; u += C.G) {
        const int b = u & 7, j = (u >> 3) & 31, i = u >> 8; const int pi = i >> 1; const int blk = (i & 1) ? (255 - (j + 32 * pi)) : (j + 32 * pi);
        const int t0 = blk * QU; const size_t mb = (size_t)b * T;
        const int nkt = (t0 + QU + 31) >> 5;
        bf16x8 af[4][4];
#pragma unroll
        for (int a = 0; a < 4; ++a) {
            const bf16* qp = H + (mb + t0 + 4 * a + ql) * D_INP + C_IQ + hd * 64 + 8 * hf;
#pragma unroll
            for (int k = 0; k < 4; ++k) af[a][k] = *(const GAS bf16x8*)(qp + 16 * k);
        }
        if (C.tid < 128) { const int q = C.tid >> 3, h8 = C.tid & 7; W16[C.tid] = bf2f(H[(mb + t0 + q) * D_INP + C_IW + h8]) * (0.125f * 0.35355339059327373f); }
        __syncthreads();
        {
            int kt = C.wave; bf16x8 bk[4], bn[4];
            if (kt < nkt) { const bf16* kp = IKN + (mb + kt * 32 + r32) * 64 + 8 * hf;
#pragma unroll
                for (int k = 0; k < 4; ++k) bk[k] = *(const GAS bf16x8*)(kp + 16 * k); }
            for (; kt < nkt; kt += NWAVES) {
                const int s0 = kt * 32;
                if (kt + NWAVES < nkt) { const bf16* kp = IKN + (mb + s0 + 32 * NWAVES + r32) * 64 + 8 * hf;
#pragma unroll
                    for (int k = 0; k < 4; ++k) bn[k] = *(const GAS bf16x8*)(kp + 16 * k); }
#pragma unroll
                for (int a = 0; a < 4; ++a) {
                    f32x16 acc = {0.f, 0.f, 0.f, 0.f, 0.f, 0.f, 0.f, 0.f, 0.f, 0.f, 0.f, 0.f, 0.f, 0.f, 0.f, 0.f};
#pragma unroll
                    for (int k = 0; k < 4; ++k) acc = __builtin_amdgcn_mfma_f32_32x32x16_bf16(af[a][k], bk[k], acc, 0, 0, 0);
#pragma unroll
                    for (int qh = 0; qh < 2; ++qh) { float sa = 0.f, sb = 0.f;
                        const int q = 4 * a + 2 * qh + hf, key = s0 + r32;
                        const f32x4 wl = *(const LAS f32x4*)(W16 + q * 8), wh = *(const LAS f32x4*)(W16 + q * 8 + 4);
                        sa = fmaf(wl[0], relu_i(acc[8 * qh + 0]), sa); sb = fmaf(wl[1], relu_i(acc[8 * qh + 1]), sb); sa = fmaf(wl[2], relu_i(acc[8 * qh + 2]), sa); sb = fmaf(wl[3], relu_i(acc[8 * qh + 3]), sb);
                        sa = fmaf(wh[0], relu_i(acc[8 * qh + 4]), sa); sb = fmaf(wh[1], relu_i(acc[8 * qh + 5]), sb); sa = fmaf(wh[2], relu_i(acc[8 * qh + 6]), sa); sb = fmaf(wh[3], relu_i(acc[8 * qh + 7]), sb);
                        float sv = sa + sb; const bool valid = key <= t0 + q; sv += 0.0f;
                        ISC[q * 4096 + key] = valid ? (h16)sv : (h16)(-INFINITY);
                    }
                }
#pragma unroll
                for (int k = 0; k < 4; ++k) bk[k] = bn[k];
            }
        }
        __syncthreads();
        for (int q = C.wave; q < QU; q += NWAVES) {
            const int t = t0 + q, n = t + 1; const LAS unsigned short* row = (const LAS unsigned short*)(ISC + q * 4096);
            unsigned* mrow = MASK + (mb + t) * 128;
            if (n <= TOPK) {
#pragma unroll
                for (int w2 = 0; w2 < 2; ++w2) { const int wi = lane + 64 * w2; const int lo = 32 * wi; unsigned bits;
                    if (lo + 31 <= t) bits = 0xffffffffu; else if (lo > t) bits = 0u; else bits = (1u << (t - lo + 1)) - 1u;
                    mrow[wi] = bits; }
            } else {
                unsigned dhi = 0u; int need = TOPK;
#pragma unroll
                for (int pass = 1; pass >= 0; --pass) {
                    LDS_WAIT();
#pragma unroll
                    for (int z = 0; z < 4; ++z) HIST[lane + 64 * z] = 0u;
#pragma unroll 2
                    for (int e0 = 8 * lane; e0 < n; e0 += 512) { const v4u v = *(const LAS v4u*)(row + e0);
#pragma unroll
                        for (int jj = 0; jj < 8; ++jj) { const unsigned w = (jj < 2) ? v.x : (jj < 4) ? v.y : (jj < 6) ? v.z : v.w; const unsigned hb = (jj & 1) ? (w >> 16) : (w & 0xffffu);
                            const unsigned key = h2ord(hb);
                            const bool ok = (e0 + jj < n) && (pass == 1 || (key >> 8) == dhi);
                            if (ok) atomicAdd((unsigned*)&HIST[pass == 1 ? (key >> 8) : (key & 255u)], 1u); } }
                    LDS_WAIT();
                    const v4u c4 = *(const LAS v4u*)(HIST + 4 * lane);
                    const unsigned c0 = c4.x, c1 = c4.y, c2 = c4.z, c3 = c4.w; const unsigned s4 = c0 + c1 + c2 + c3;
                    unsigned suf = s4;
#pragma unroll
                    for (int o = 1; o < 64; o <<= 1) { const unsigned v2 = __shfl_down(suf, o); if (lane + o < 64) suf += v2; }
                    unsigned cum = suf - s4; int dsel = -1; int nnew = 0; const unsigned nd = (unsigned)need;
                    if (cum < nd && nd <= cum + c3) { dsel = 4 * lane + 3; nnew = (int)(nd - cum); } cum += c3;
                    if (dsel < 0 && cum < nd && nd <= cum + c2) { dsel = 4 * lane + 2; nnew = (int)(nd - cum); } cum += c2;
                    if (dsel < 0 && cum < nd && nd <= cum + c1) { dsel = 4 * lane + 1; nnew = (int)(nd - cum); } cum += c1;
                    if (dsel < 0 && cum < nd && nd <= cum + c0) { dsel = 4 * lane + 0; nnew = (int)(nd - cum); }
                    const unsigned long long bal = __ballot(dsel >= 0);
                    const int src = (bal != 0ull) ? (int)__builtin_ctzll(bal) : 0;
                    const int dd = __shfl(dsel, src); need = __shfl(nnew, src);
                    if (pass == 1) dhi = (unsigned)dd; else dhi = (dhi << 8) | (unsigned)dd;
                }
                const unsigned Tk = dhi;
                int run_eq = 0; unsigned long long mine = 0ull; const int nit = (t >> 6) + 1;
#pragma unroll 4
                for (int it = 0; it < nit; ++it) { const int e = it * 64 + lane; const unsigned key = h2ord(row[e]); const bool valid = e <= t;
                    const bool eq = valid && (key == Tk); const unsigned long long beq = __ballot(eq);
                    const int rk = run_eq + __builtin_popcountll(beq & ((1ull << lane) - 1ull));
                    const bool sel = valid && ((key > Tk) || (eq && rk < need)); run_eq += __builtin_popcountll(beq);
                    const unsigned long long bs = __ballot(sel);
                    if (lane == it) mine = bs; }
                *(GAS v2u*)(mrow + 2 * lane) = (v2u){(unsigned)mine, (unsigned)(mine >> 32)};
            }
        }
        __syncthreads();
    }
}

__device__ __forceinline__ void attn_task(const bf16* H, const bf16* KH, const bf16* VT, const unsigned* MASK, bf16* YM, int b, int hh, int t0, int lane) {
    const int r32 = lane & 31, hf = lane >> 5;
    const float LOG2E = 1.4426950408889634f; const float c1 = 0.125f * LOG2E; const float sl2 = exp2f(-(float)(hh + 1)) * LOG2E;
    const size_t mb = (size_t)b * T;
    bf16x8 qf[4];
#pragma unroll
    for (int k = 0; k < 4; ++k) qf[k] = *(const GAS bf16x8*)(H + (mb + t0 + r32) * D_INP + C_AQ + hh * 64 + 16 * k + 8 * hf);
    const bf16* kbase = KH + ((size_t)(b * 8 + hh) * T) * 64; const bf16* vbase = VT + ((size_t)(b * 512 + hh * 64)) * T; const unsigned* mrow = MASK + (mb + t0 + r32) * 128;
    float m_run = -1e30f, l = 0.f;
    f32x16 O0 = {0.f, 0.f, 0.f, 0.f, 0.f, 0.f, 0.f, 0.f, 0.f, 0.f, 0.f, 0.f, 0.f, 0.f, 0.f, 0.f}, O1 = O0;
    const int nkt = (t0 + 32 + 63) >> 6;
    for (int kt = 0; kt < nkt; ++kt) {
        const int s0 = kt * 64;
        bf16x8 kf[2][4];
#pragma unroll
        for (int uu = 0; uu < 2; ++uu)
#pragma unroll
            for (int k = 0; k < 4; ++k) kf[uu][k] = *(const GAS bf16x8*)(kbase + (size_t)(s0 + 32 * uu + r32) * 64 + 16 * k + 8 * hf);
        const v2u mw = *(const GAS v2u*)(mrow + 2 * kt);
        s16x4 vl[2][2][2], vh[2][2][2];
#pragma unroll
        for (int uu = 0; uu < 2; ++uu)
#pragma unroll
            for (int sp = 0; sp < 2; ++sp)
#pragma unroll
                for (int dt = 0; dt < 2; ++dt) { const bf16* vp = vbase + (size_t)(dt * 32 + r32) * T + s0 + 32 * uu + 16 * sp + 4 * hf;
                    vl[uu][sp][dt] = *(const GAS s16x4*)vp; vh[uu][sp][dt] = *(const GAS s16x4*)(vp + 8); }
        f32x16 a0 = {0.f, 0.f, 0.f, 0.f, 0.f, 0.f, 0.f, 0.f, 0.f, 0.f, 0.f, 0.f, 0.f, 0.f, 0.f, 0.f}, a1 = a0;
#pragma unroll
        for (int k = 0; k < 4; ++k) { a0 = __builtin_amdgcn_mfma_f32_32x32x16_bf16(kf[0][k], qf[k], a0, 0, 0, 0); a1 = __builtin_amdgcn_mfma_f32_32x32x16_bf16(kf[1][k], qf[k], a1, 0, 0, 0); }
        const float dist0 = (float)(t0 + r32 - s0 - 4 * hf);
        const unsigned m0 = mw.x >> (4 * hf), m1 = mw.y >> (4 * hf);
        float mx = -1e30f;
#pragma unroll
        for (int r = 0; r < 16; ++r) { const int ko = (r & 3) + 8 * (r >> 2);
            const float d0 = dist0 - (float)ko;
            a0[r] = ((m0 >> ko) & 1u) ? (a0[r] * c1 - sl2 * d0) : -1e30f;
            a1[r] = ((m1 >> ko) & 1u) ? (a1[r] * c1 - sl2 * (d0 - 32.f)) : -1e30f;
            mx = fmaxf(mx, fmaxf(a0[r], a1[r])); }
        mx = fmaxf(mx, __shfl_xor(mx, 32));
        const float m_new = fmaxf(m_run, mx); const float alpha = __builtin_amdgcn_exp2f(m_run - m_new); m_run = m_new;
        float ps = 0.f;
#pragma unroll
        for (int r = 0; r < 16; ++r) { const int ko = (r & 3) + 8 * (r >> 2);
            const float p0 = ((m0 >> ko) & 1u) ? __builtin_amdgcn_exp2f(a0[r] - m_new) : 0.f;
            const float p1 = ((m1 >> ko) & 1u) ? __builtin_amdgcn_exp2f(a1[r] - m_new) : 0.f;
            a0[r] = p0; a1[r] = p1; ps += p0 + p1; }
        l = l * alpha + ps;
#pragma unroll
        for (int r = 0; r < 16; ++r) { O0[r] *= alpha; O1[r] *= alpha; }
#pragma unroll
        for (int sp = 0; sp < 2; ++sp) {
            const bf16x8 pb0 = pack8(a0, 8 * sp), pb1 = pack8(a1, 8 * sp);
#define VFR(uu, dt) ((bf16x8){vl[uu][sp][dt][0], vl[uu][sp][dt][1], vl[uu][sp][dt][2], vl[uu][sp][dt][3], vh[uu][sp][dt][0], vh[uu][sp][dt][1], vh[uu][sp][dt][2], vh[uu][sp][dt][3]})
            O0 = __builtin_amdgcn_mfma_f32_32x32x16_bf16(VFR(0, 0), pb0, O0, 0, 0, 0);
            O1 = __builtin_amdgcn_mfma_f32_32x32x16_bf16(VFR(0, 1), pb0, O1, 0, 0, 0);
            O0 = __builtin_amdgcn_mfma_f32_32x32x16_bf16(VFR(1, 0), pb1, O0, 0, 0, 0);
            O1 = __builtin_amdgcn_mfma_f32_32x32x16_bf16(VFR(1, 1), pb1, O1, 0, 0, 0);
#undef VFR
        }
    }
    l += __shfl_xor(l, 32);
    const float inv = 1.f / l;
    bf16* yp = YM + (mb + t0 + r32) * D + hh * 64 + 4 * hf;
#pragma unroll
    for (int rq = 0; rq < 4; ++rq) {
        v2u o; o.x = cvtpk(O0[4 * rq] * inv, O0[4 * rq + 1] * inv); o.y = cvtpk(O0[4 * rq + 2] * inv, O0[4 * rq + 3] * inv); *(GAS v2u*)(yp + 8 * rq) = o;
        v2u o2; o2.x = cvtpk(O1[4 * rq] * inv, O1[4 * rq + 1] * inv); o2.y = cvtpk(O1[4 * rq + 2] * inv, O1[4 * rq + 3] * inv); *(GAS v2u*)(yp + 32 + 8 * rq) = o2; }
}
__device__ __forceinline__ void p4_attention(const Params& P, const Ctx& C) {
    unsigned char* ws = P.ws;
    const bf16* H = (const bf16*)(ws + WS_H); const bf16* KH = (const bf16*)(ws + WS_K); const bf16* VT = (const bf16*)(ws + WS_VT); const unsigned* MASK = (const unsigned*)(ws + WS_MASK); bf16* YM = (bf16*)(ws + WS_YMIX);
    for (int p = blockIdx.x; p < 512; p += C.G) {
        const int bh = p >> 3, j = p & 7; const int b = bh >> 3, hh = bh & 7;
        attn_task(H, KH, VT, MASK, YM, b, hh, j * 256 + C.wave * 32, C.lane);
        attn_task(H, KH, VT, MASK, YM, b, hh, (15 - j) * 256 + (7 - C.wave) * 32, C.lane);
    }
}

constexpr int AT_KB = 64 * 144, AT_VB = 64 * 136, AT_VOFF = 2 * AT_KB;
__device__ __forceinline__ void attn_block(const Ctx& C, const bf16* H, const bf16* KH, const bf16* VT, const unsigned* MASK, bf16* YM, int b, int hh, int qb) {
    const int lane = C.lane, r32 = lane & 31, hf = lane >> 5, tid = C.tid;
    const float LOG2E = 1.4426950408889634f; const float c1 = 0.125f * LOG2E; const float sl2 = exp2f(-(float)(hh + 1)) * LOG2E;
    const size_t mb = (size_t)b * T; const int t0 = qb * 256 + C.wave * 32;
    bf16x8 qf[4];
#pragma unroll
    for (int k = 0; k < 4; ++k) { const v4u w = *(const GAS v4u*)(H + (mb + t0 + r32) * D_INP + C_AQ + hh * 64 + 16 * k + 8 * hf);
        v4u o; o.x = cvtpk(bflo(w.x) * c1, bfhi(w.x) * c1); o.y = cvtpk(bflo(w.y) * c1, bfhi(w.y) * c1); o.z = cvtpk(bflo(w.z) * c1, bfhi(w.z) * c1); o.w = cvtpk(bflo(w.w) * c1, bfhi(w.w) * c1);
        qf[k] = __builtin_bit_cast(bf16x8, o); }
    const bf16* kbase = KH + ((size_t)(b * 8 + hh) * T) * 64; const bf16* vbase = VT + ((size_t)(b * 512 + hh * 64)) * T; const unsigned* mrow = MASK + (mb + t0 + r32) * 128;
    const int srow = tid >> 3, sch = tid & 7;
    const bf16* kst = kbase + (size_t)srow * 64 + 8 * sch; const bf16* vst = vbase + (size_t)srow * T + 8 * sch;
    LAS unsigned char* kw = C.lds + srow * 144 + 16 * sch; LAS unsigned char* vw = C.lds + AT_VOFF + srow * 136 + 16 * sch;
    const LAS unsigned char* kr = C.lds + r32 * 144 + 16 * hf; const LAS unsigned char* vr = C.lds + AT_VOFF + r32 * 136 + 8 * hf;
    float m_run = -1e30f, l = 0.f;
    f32x16 O0 = {0.f, 0.f, 0.f, 0.f, 0.f, 0.f, 0.f, 0.f, 0.f, 0.f, 0.f, 0.f, 0.f, 0.f, 0.f, 0.f}, O1 = O0;
    const int nkt = 4 * (qb + 1), ktw = (t0 + 31) >> 6;
    v4u kn = *(const GAS v4u*)kst, vn = *(const GAS v4u*)vst; v2u mwn = *(const GAS v2u*)mrow;
    *(LAS v4u*)kw = kn; *(LAS v2u*)vw = (v2u){vn.x, vn.y}; *(LAS v2u*)(vw + 8) = (v2u){vn.z, vn.w};
    __syncthreads();
    for (int kt = 0; kt < nkt; ++kt) {
        const int s0 = kt * 64; const int cur = kt & 1; const v2u mw = mwn;
        if (kt + 1 < nkt) { kn = *(const GAS v4u*)(kst + (size_t)(s0 + 64) * 64); vn = *(const GAS v4u*)(vst + s0 + 64); mwn = *(const GAS v2u*)(mrow + 2 * kt + 2); }
        if (kt <= ktw) {
            const LAS unsigned char* kc = kr + cur * AT_KB; const LAS unsigned char* vc = vr + cur * AT_VB;
            const float B0 = -sl2 * (float)(t0 + r32 - s0 - 4 * hf);
            f32x16 a0, a1;
#pragma unroll
            for (int r = 0; r < 16; ++r) { const float ko = (float)((r & 3) + 8 * (r >> 2)); a0[r] = B0 + sl2 * ko; a1[r] = B0 + sl2 * (ko + 32.f); }
#pragma unroll
            for (int k = 0; k < 4; ++k) { const bf16x8 k0 = *(const LAS bf16x8*)(kc + 32 * k), k1 = *(const LAS bf16x8*)(kc + 32 * 144 + 32 * k);
                a0 = __builtin_amdgcn_mfma_f32_32x32x16_bf16(k0, qf[k], a0, 0, 0, 0); a1 = __builtin_amdgcn_mfma_f32_32x32x16_bf16(k1, qf[k], a1, 0, 0, 0); }
            const unsigned m0 = mw.x >> (4 * hf), m1 = mw.y >> (4 * hf);
            float mx = -1e30f;
#pragma unroll
            for (int r = 0; r < 16; ++r) { const int ko = (r & 3) + 8 * (r >> 2);
                const unsigned k0m = (unsigned)__builtin_amdgcn_sbfe((int)m0, ko, 1), k1m = (unsigned)__builtin_amdgcn_sbfe((int)m1, ko, 1);
                const float x0 = a0[r], x1 = a1[r];
                a0[r] = __builtin_bit_cast(float, (__builtin_bit_cast(unsigned, x0) & k0m) | (0xf149f2cau & ~k0m));
                a1[r] = __builtin_bit_cast(float, (__builtin_bit_cast(unsigned, x1) & k1m) | (0xf149f2cau & ~k1m));
                mx = fmaxf(mx, fmaxf(a0[r], a1[r])); }
            mx = fmaxf(mx, __shfl_xor(mx, 32));
            const float m_new = fmaxf(m_run, mx);
            const float m_use = fmaxf(m_new, -1e20f);
            float ps = 0.f;
#pragma unroll
            for (int r = 0; r < 16; ++r) { const float p0 = __builtin_amdgcn_exp2f(a0[r] - m_use), p1 = __builtin_amdgcn_exp2f(a1[r] - m_use); a0[r] = p0; a1[r] = p1; ps += p0 + p1; }
            if (__builtin_amdgcn_ballot_w64(m_new != m_run) != 0ull) {
                const float alpha = __builtin_amdgcn_exp2f(m_run - m_new); m_run = m_new;
                l *= alpha;
#pragma unroll
                for (int r = 0; r < 16; ++r) { O0[r] *= alpha; O1[r] *= alpha; }
            }
            l += ps;
#pragma unroll
            for (int sp = 0; sp < 2; ++sp) {
                const bf16x8 pb0 = pack8(a0, 8 * sp), pb1 = pack8(a1, 8 * sp);
#define VLD(uu, dt) ({ const s16x4 lo_ = *(const LAS s16x4*)(vc + (dt) * 32 * 136 + 2 * (32 * (uu) + 16 * sp)), hi_ = *(const LAS s16x4*)(vc + (dt) * 32 * 136 + 2 * (32 * (uu) + 16 * sp + 8)); (bf16x8){lo_[0], lo_[1], lo_[2], lo_[3], hi_[0], hi_[1], hi_[2], hi_[3]}; })
                O0 = __builtin_amdgcn_mfma_f32_32x32x16_bf16(VLD(0, 0), pb0, O0, 0, 0, 0);
                O1 = __builtin_amdgcn_mfma_f32_32x32x16_bf16(VLD(0, 1), pb0, O1, 0, 0, 0);
                O0 = __builtin_amdgcn_mfma_f32_32x32x16_bf16(VLD(1, 0), pb1, O0, 0, 0, 0);
                O1 = __builtin_amdgcn_mfma_f32_32x32x16_bf16(VLD(1, 1), pb1, O1, 0, 0, 0);
#undef VLD
            }
        }
        if (kt + 1 < nkt) { const int nx = cur ^ 1; *(LAS v4u*)(kw + nx * AT_KB) = kn; *(LAS v2u*)(vw + nx * AT_VB) = (v2u){vn.x, vn.y}; *(LAS v2u*)(vw + nx * AT_VB + 8) = (v2u){vn.z, vn.w}; }
        __syncthreads();
    }
    l += __shfl_xor(l, 32);
    const float inv = 1.f / l;
    unsigned char* yp = (unsigned char*)YM + (mb + t0 + r32) * D + hh * 64 + 4 * hf;
    const float i8 = inv * 8.f;
#pragma unroll
    for (int rq = 0; rq < 4; ++rq) {
        *(GAS unsigned*)(yp + 8 * rq) = pk4_fp8(O0[4 * rq] * i8, O0[4 * rq + 1] * i8, O0[4 * rq + 2] * i8, O0[4 * rq + 3] * i8);
        *(GAS unsigned*)(yp + 32 + 8 * rq) = pk4_fp8(O1[4 * rq] * i8, O1[4 * rq + 1] * i8, O1[4 * rq + 2] * i8, O1[4 * rq + 3] * i8); }
}
__device__ __forceinline__ void p4_attention2(const Params& P, const Ctx& C) {
    unsigned char* ws = P.ws;
    const bf16* H = (const bf16*)(ws + WS_H); const bf16* KH = (const bf16*)(ws + WS_K); const bf16* VT = (const bf16*)(ws + WS_VT); const unsigned* MASK = (const unsigned*)(ws + WS_MASK); bf16* YM = (bf16*)(ws + WS_YMIX);
    for (int p = blockIdx.x; p < 512; p += C.G) {
        const int b = p & 7, q = p >> 3; const int hh = q >> 3, j = q & 7;
        attn_block(C, H, KH, VT, MASK, YM, b, hh, j);
        attn_block(C, H, KH, VT, MASK, YM, b, hh, 15 - j);
    }
}


#ifndef FEAT_MIX
#define FEAT_MIX 1
#endif
#ifndef FEAT_MOE
#define FEAT_MOE 1
#endif
#ifndef FEAT_PLE
#define FEAT_PLE 1
#endif
#ifndef FEAT_ATT
#define FEAT_ATT 1
#endif

template <bool PUBLISH = true> __device__ __forceinline__ void p6_ln1_router(const Params& P, const Ctx& C) {
    unsigned char* ws = P.ws;
    bf16* X1 = (bf16*)(ws + WS_X1); unsigned char* XB = ws + WS_XB;
    LAS float* wl = (LAS float*)C.lds;
    LAS int* hist = (LAS int*)(C.lds + MISC_OFF);
    { const float* wrt = (const float*)(ws + WS_WRT);
      for (int i = C.tid; i < 32 * 1024 / 4; i += NTHR) *(LAS f32x4*)(wl + 4 * i) = *(const GAS f32x4*)(wrt + 4 * i);
      if (C.tid < 32) hist[C.tid] = 0; }
    __syncthreads();
    int* tope = (int*)(ws + WS_TOPE); float* gate = (float*)(ws + WS_GATE); int* lrank = (int*)(ws + WS_LRANK);
    const bf16* src = (const bf16*)P.out;
    const int lane = C.lane, hf = lane >> 5, ex = lane & 31;
    const float brl = P.in[I_BR][ex];
    for (int m0 = 2 * C.gw; m0 < NTOK; m0 += 2 * C.ngw) {
        f32x4 va[4], vb[4]; load_row_bf16(va, src + (size_t)m0 * D, lane); load_row_bf16(vb, src + (size_t)(m0 + 1) * D, lane);
        ln_row(va, P.in[I_LNMG], P.in[I_LNMB], lane); ln_row(vb, P.in[I_LNMG], P.in[I_LNMB], lane);
        store_row_bf16(X1 + (size_t)m0 * D, va, lane); store_row_bf16(X1 + (size_t)(m0 + 1) * D, vb, lane);
        store_row_fp8x8(XB + (size_t)m0 * D, va, lane); store_row_fp8x8(XB + (size_t)(m0 + 1) * D, vb, lane);
        float v[32];
#pragma unroll
        for (int e = 0; e < 32; ++e) { float pa = 0.f, pb = 0.f;
#pragma unroll
            for (int j = 0; j < 4; ++j) { const f32x4 w = *(const LAS f32x4*)(wl + e * 1024 + 4 * lane + 256 * j);
                pa += (va[j][0] * w[0] + va[j][1] * w[1]) + (va[j][2] * w[2] + va[j][3] * w[3]); pb += (vb[j][0] * w[0] + vb[j][1] * w[1]) + (vb[j][2] * w[2] + vb[j][3] * w[3]); }
            const float keep = hf ? pb : pa, send = hf ? pa : pb; v[e] = keep + __shfl_xor(send, 32); }
#define HALVE(M, CNT) { const bool up_ = (lane & (M)) != 0; _Pragma("unroll") for (int i_ = 0; i_ < (CNT) / 2; ++i_) { const float k_ = up_ ? v[i_ + (CNT) / 2] : v[i_], s_ = up_ ? v[i_] : v[i_ + (CNT) / 2]; v[i_] = k_ + __shfl_xor(s_, (M)); } }
        HALVE(16, 32) HALVE(8, 16) HALVE(4, 8) HALVE(2, 4) HALVE(1, 2)
#undef HALVE
        float lg = v[0] + brl;
        int se[4]; float sv[4];
#pragma unroll
        for (int k = 0; k < 4; ++k) { float bv = lg; int bi = ex;
#pragma unroll
            for (int o = 1; o < 32; o <<= 1) { const float ov = __shfl_xor(bv, o); const int oi = __shfl_xor(bi, o); const bool take = (ov > bv) || (ov == bv && oi < bi); bv = take ? ov : bv; bi = take ? oi : bi; }
            se[k] = bi; sv[k] = bv; if (ex == bi) lg = -INFINITY; }
        float exv[4], sum = 0.f;
#pragma unroll
        for (int k = 0; k < 4; ++k) { exv[k] = __expf(sv[k] - sv[0]); sum += exv[k]; }
        const float inv = 1.f / sum;
        if (ex == 0) { const int m = m0 + hf;
#pragma unroll
            for (int k = 0; k < 4; ++k) { const int lr = atomicAdd((int*)&hist[se[k]], 1); tope[m * 4 + k] = se[k]; gate[m * 4 + k] = exv[k] * inv; lrank[m * 4 + k] = lr; } }
    }
    __syncthreads();
    if (PUBLISH && C.tid < 32) { unsigned* cnt = (unsigned*)(ws + WS_CTL) + CW_CNT; const int base = (int)atomicAdd(cnt + C.tid, (unsigned)hist[C.tid]); ((int*)(ws + WS_WGBASE))[blockIdx.x * 32 + C.tid] = base; }
}

__device__ __forceinline__ void p7_dispatch(const Params& P, const Ctx& C) {
    unsigned char* ws = P.ws;
    LAS int* ps = (LAS int*)(C.lds + MISC_OFF + 256);
    const unsigned* cnt = (const unsigned*)(ws + WS_CTL) + CW_CNT;
    int* tile_e = (int*)(ws + WS_TILEE);
    LAS int* pe = (LAS int*)(C.lds + MISC_OFF + 512);
    if (C.tid < 64) { const int e = C.tid & 31; const int c = (int)__hip_atomic_load(cnt + e, __ATOMIC_RELAXED, __HIP_MEMORY_SCOPE_AGENT); const int nt = (c + 255) >> 8; int inc = nt;
#pragma unroll
        for (int o = 1; o < 32; o <<= 1) { const int v = __shfl_up(inc, o); if ((C.tid & 31) >= o) inc += v; }
        if (C.tid < 32) { ps[e] = (inc - nt) << 8; pe[e] = inc; } }
    __syncthreads();
    if (blockIdx.x == 0) { const int ntot = pe[31];
        for (int t = C.tid; t < ntot; t += NTHR) { int e = 0;
#pragma unroll
            for (int q = 0; q < 31; ++q) e += (t >= pe[q]) ? 1 : 0;
            tile_e[t] = e; }
        if (C.tid == 0) tile_e[MAXTILES] = ntot; }
    const int* tope = (const int*)(ws + WS_TOPE); const float* gate = (const float*)(ws + WS_GATE); const int* lrank = (const int*)(ws + WS_LRANK);
    const int* wgb = (const int*)(ws + WS_WGBASE);
    int* tokslot = (int*)(ws + WS_TOKSLOT); float* slotgate = (float*)(ws + WS_SLOTGATE);
    const bf16* XB = (const bf16*)(ws + WS_XB); unsigned char* xs = ws + WS_XS;
    int m = C.gw; v4u f8n; int en[4], ln_[4]; float gn[4]; int wgn;
    if (m < NTOK) { f8n = *(const GAS v4u*)((const unsigned char*)XB + (size_t)m * D + 16 * C.lane); wgn = ((m >> 1) % C.ngw) >> 3;
#pragma unroll
        for (int k = 0; k < 4; ++k) { en[k] = tope[m * 4 + k]; ln_[k] = lrank[m * 4 + k]; gn[k] = gate[m * 4 + k]; } }
    for (; m < NTOK; m += C.ngw) {
        const v4u f8 = f8n; int e[4], lr[4]; float g[4]; const int wgm = wgn;
#pragma unroll
        for (int k = 0; k < 4; ++k) { e[k] = en[k]; lr[k] = ln_[k]; g[k] = gn[k]; }
        int wb[4];
#pragma unroll
        for (int k = 0; k < 4; ++k) wb[k] = wgb[wgm * 32 + e[k]];
        const int m2 = m + C.ngw;
        if (m2 < NTOK) { f8n = *(const GAS v4u*)((const unsigned char*)XB + (size_t)m2 * D + 16 * C.lane); wgn = ((m2 >> 1) % C.ngw) >> 3;
#pragma unroll
            for (int k = 0; k < 4; ++k) { en[k] = tope[m2 * 4 + k]; ln_[k] = lrank[m2 * 4 + k]; gn[k] = gate[m2 * 4 + k]; } }
#pragma unroll
        for (int k = 0; k < 4; ++k) { const int slot = ps[e[k]] + wb[k] + lr[k];
            *(GAS v4u*)(xs + (size_t)slot * D + 16 * C.lane) = f8;
            if (C.lane == 0) { slotgate[slot] = g[k]; tokslot[m * 4 + k] = slot; } }
    }
}

__device__ __forceinline__ void p10_combine_ln2(const Params& P, const Ctx& C) {
    unsigned char* ws = P.ws;
    const bf16* X1 = (const bf16*)(ws + WS_X1); bf16* XB = (bf16*)(ws + WS_XB); bf16* X2 = (bf16*)P.out;
    const int* tokslot = (const int*)(ws + WS_TOKSLOT); const bf16* ys = (const bf16*)(ws + WS_YSLOT);
    for (int m = C.gw; m < NTOK; m += C.ngw) {
        f32x4 v[4]; load_row_bf16(v, X1 + (size_t)m * D, C.lane);
#pragma unroll
        for (int j = 0; j < 4; ++j) v[j] = v[j] * ALPHA;
#if FEAT_MOE
#pragma unroll
        for (int k = 0; k < 4; ++k) { const int slot = tokslot[m * 4 + k]; const bf16* yr = ys + (size_t)slot * D;
#pragma unroll
            for (int j = 0; j < 4; ++j) { const v2u w = *(const GAS v2u*)(yr + 4 * C.lane + 256 * j); v[j][0] += bflo(w.x); v[j][1] += bfhi(w.x); v[j][2] += bflo(w.y); v[j][3] += bfhi(w.y); } }
#endif
        ln_row(v, P.in[I_LNFG], P.in[I_LNFB], C.lane);
        store_row_bf16(X2 + (size_t)m * D, v, C.lane);
        store_row_fp8x8((unsigned char*)XB + (size_t)m * D, v, C.lane);
    }
}

__device__ __forceinline__ void p12_final_ln(const Params& P, const Ctx& C) {
    const bf16* src = (const bf16*)(P.ws + WS_X1);
    for (int m = C.gw; m < NTOK; m += C.ngw) {
        f32x4 v[4]; load_row_bf16(v, src + (size_t)m * D, C.lane);
        ln_row(v, P.in[I_LNPG], P.in[I_LNPB], C.lane);
        store_row_f32(P.out + (size_t)m * D, v, C.lane);
    }
}
#define XB_TMO      128
#define XB_XCNT(j)  (256  + 64 * (j))
#define XB_XSUB(j)  (1280 + 64 * (j))
#define XB_XGEN(j)  (2304 + 64 * (j))
#define XB_TOP      3328
#define XB_TOPGEN   3392
#define XCD_BAR_WORDS 3456
#define XB_SPIN_CAP (1u << 18)
#define LAS __attribute__((address_space(3)))

__device__ __forceinline__ unsigned xb_ld(unsigned* p)              { return __hip_atomic_load(p, __ATOMIC_RELAXED, __HIP_MEMORY_SCOPE_AGENT); }
__device__ __forceinline__ unsigned xb_add(unsigned* p, unsigned v) { return __hip_atomic_fetch_add(p, v, __ATOMIC_RELAXED, __HIP_MEMORY_SCOPE_AGENT); }
__device__ __forceinline__ unsigned xb_xcc_id() { return (unsigned)__builtin_amdgcn_s_getreg((3 << 11) | 20) & 0xFu; }
#define XB_SPIN(cond, bar) do { unsigned _sp = 0; while (cond) { __builtin_amdgcn_s_sleep(1); \
    if ((++_sp & 255u) == 0u) { if (xb_ld(&(bar)[XB_TMO])) break; if (_sp > XB_SPIN_CAP) { atomicAdd(&(bar)[XB_TMO], 1u); break; } } } } while (0)

struct XcdBarrier {
    unsigned* bar; unsigned x;
    volatile LAS unsigned* st;
};

__device__ __forceinline__ XcdBarrier xcd_barrier_post(unsigned* bar, volatile LAS unsigned* st) {
    XcdBarrier b; b.bar = bar; b.x = xb_xcc_id(); b.st = st;
    if (threadIdx.x == 0) (void)xb_add(&bar[XB_XCNT(b.x)], 1u);
    return b;
}
__device__ __forceinline__ void xcd_barrier_complete(unsigned* bar, unsigned x, unsigned& nloc, unsigned& nx) {
    const unsigned G = gridDim.x * gridDim.y * gridDim.z;
    unsigned sum, cnt, mine, sp = 0u;
    for (;;) {
        sum = 0u; cnt = 0u; mine = 0u;
#pragma unroll
        for (unsigned j = 0; j < 16; ++j) { const unsigned c = xb_ld(&bar[XB_XCNT(j)]); sum += c; cnt += (c > 0u) ? 1u : 0u; mine = (j == x) ? c : mine; }
        if (sum == G) break;
        __builtin_amdgcn_s_sleep(1);
        if ((++sp & 255u) == 0u) { if (xb_ld(&bar[XB_TMO])) break; if (sp > XB_SPIN_CAP) { atomicAdd(&bar[XB_TMO], 1u); break; } }
    }
    nloc = mine > 0u ? mine : 1u; nx = cnt > 0u ? cnt : 1u;
}

__device__ __forceinline__ void xcd_barrier(const XcdBarrier& b) {
    asm volatile("s_waitcnt vmcnt(0)" ::: "memory");
    __syncthreads();
    if (threadIdx.x == 0) {
        unsigned* bar = b.bar;
        __builtin_amdgcn_s_waitcnt(0);
        unsigned nloc = b.st[0], nx = b.st[1];
        if (nloc == 0u) { xcd_barrier_complete(bar, b.x, nloc, nx); b.st[0] = nloc; b.st[1] = nx; }
        const unsigned old = xb_add(&bar[XB_XSUB(b.x)], 1u);
        const unsigned gen = old / nloc;
        if (old + 1u == (gen + 1u) * nloc) {
            __builtin_amdgcn_fence(__ATOMIC_RELEASE, "agent");
            asm volatile("s_waitcnt vmcnt(0)" ::: "memory");
            const unsigned og = xb_add(&bar[XB_TOP], 1u);
            const unsigned tg = og / nx;
            if (og + 1u == (tg + 1u) * nx) xb_add(&bar[XB_TOPGEN], 1u);
            else XB_SPIN(xb_ld(&bar[XB_TOPGEN]) == tg, bar);
            __builtin_amdgcn_fence(__ATOMIC_ACQUIRE, "agent");
            xb_add(&bar[XB_XGEN(b.x)], 1u);
            asm volatile("s_waitcnt vmcnt(0)" ::: "memory");
        } else {
            XB_SPIN(xb_ld(&bar[XB_XGEN(b.x)]) == gen, bar);
            __builtin_amdgcn_fence(__ATOMIC_ACQUIRE, "agent");
            asm volatile("s_waitcnt vmcnt(0)" ::: "memory");
        }
    }
    __syncthreads();
}


template <int PH> __device__ __forceinline__ void run_phase(const Params& P, const Ctx& C) {
    unsigned char* ws = P.ws;
    typedef pg8::bf16_t pbf;
    if constexpr (PH == 0) { p0_prologue(P, C); }
    else if constexpr (PH == 10) {
        pg8::Gemm g{(const pbf*)(ws + WS_XBF), (const pbf*)(ws + WS_WIN_T), NTOK, D_INP, D}; pg8::StaticOrder S; S.init(NTOK, D_INP, C.G, (int)blockIdx.x);
        pg8::EpiBf16s E{(pbf*)(ws + WS_H), D_INP};
        pg8::gemm_phase<pg8::EpiBf16s, pg8::StaticOrder, true, true>(C.lds, g, S, E); }
    else if constexpr (PH == 11) {
        pg8::Gemm g{(const pbf*)(ws + WS_PB), (const pbf*)(ws + WS_WPROJ_T), NTOK, D, PLE}; pg8::StaticOrder S; S.init(NTOK, D, C.G, (int)blockIdx.x);
        pg8::EpiBf16s E{(pbf*)(ws + WS_PROJ), D};
        pg8::gemm_phase<pg8::EpiBf16s, pg8::StaticOrder, true, true>(C.lds, g, S, E); }
    else if constexpr (PH == 20) { p2_post(P, C); }
    else if constexpr (PH == 21) { p2_hgrn_prep(P, C); }
    else if constexpr (PH == 30) {
        { pg8::Gemm g{(const pbf*)(ws + WS_CN), (const pbf*)(ws + WS_WUK_T), NTOK, 512, 256}; pg8::StaticOrder S; S.init(NTOK, 512, C.G, (int)blockIdx.x);
          pg8::EpiKhead E{(pbf*)(ws + WS_K)};
          pg8::gemm_phase<pg8::EpiKhead, pg8::StaticOrder, true, true>(C.lds, g, S, E); }
        { pg8::Gemm g{(const pbf*)(ws + WS_WUV_T), (const pbf*)(ws + WS_CN), 512, NTOK, 256}; pg8::StaticOrder S; S.init(512, NTOK, C.G, (int)blockIdx.x);
          pg8::EpiVt E{(pbf*)(ws + WS_VT)};
          pg8::gemm_phase<pg8::EpiVt, pg8::StaticOrder, true, true>(C.lds, g, S, E); }
    }
    else if constexpr (PH == 31) { p3_indexer(P, C); }
    else if constexpr (PH == 32) { p3_scan_convert(P, C); }
    else if constexpr (PH == 40) { p4_attention2(P, C); }
    else if constexpr (PH == 41) { p4_yrec(P, C); }
    else if constexpr (PH == 5) {
        pg8::Gemm g{(const pbf*)(ws + WS_YMIX), (const pbf*)(ws + WS_WO_T), NTOK, D, D / 2}; pg8::StaticOrder S; S.init(NTOK, D, C.G, (int)blockIdx.x);
        pg8::EpiResid E{P.in[I_X], (pbf*)P.out, D, ALPHA, 1.f / 512.f};
        pg8::gemm_phase<pg8::EpiResid, pg8::StaticOrder, true, true, 1>(C.lds, g, S, E);
    }
    else if constexpr (PH == 6) { p6_ln1_router<true>(P, C); }
    else if constexpr (PH == 60) { p6_ln1_router<false>(P, C); }
    else if constexpr (PH == 7) { p7_dispatch(P, C); }
    else if constexpr (PH == 8) {
        const int* tile_e = (const int*)(ws + WS_TILEE);
        pg8::Gemm g{(const pbf*)(ws + WS_XS), (const pbf*)(ws + WS_WUP_T), CAP, NE * 2048, D / 2};
        pg8::MoeOrder S{tile_e, tile_e[MAXTILES], 8, C.G, (int)blockIdx.x};
        pg8::EpiSwiglu E{ws + WS_HH, P.in[I_BUP]};
        pg8::gemm_phase<pg8::EpiSwiglu, pg8::MoeOrder, true, true, 1, 124, 121>(C.lds, g, S, E);
    }
    else if constexpr (PH == 9) {
        const int* tile_e = (const int*)(ws + WS_TILEE);
        pg8::Gemm g{(const pbf*)(ws + WS_HH), (const pbf*)(ws + WS_WDN_T), CAP, NE * 1024, DFF / 2};
        pg8::MoeOrder S{tile_e, tile_e[MAXTILES], 4, C.G, (int)blockIdx.x};
        pg8::EpiDown E{(pbf*)(ws + WS_YSLOT), P.in[I_BDN], (const float*)(ws + WS_SLOTGATE)};
        pg8::gemm_phase<pg8::EpiDown, pg8::MoeOrder, true, true, 1, 125, 121>(C.lds, g, S, E);
    }
    else if constexpr (PH == 100) { p10_combine_ln2(P, C); }
    else if constexpr (PH == 110) {
        pg8::Gemm g{(const pbf*)(ws + WS_XB), (const pbf*)(ws + WS_WGATE_T), NTOK, D, D / 2}; pg8::StaticOrder S; S.init(NTOK, D, C.G, (int)blockIdx.x);
        pg8::EpiPle E{(const pbf*)P.out, (const pbf*)(ws + WS_PROJ), (pbf*)(ws + WS_X1), ALPHA, 1.f / 512.f};
        pg8::gemm_phase<pg8::EpiPle, pg8::StaticOrder, true, true, 1>(C.lds, g, S, E);
    }
    else { p12_final_ln(P, C); }
}
__global__ void __launch_bounds__(NTHR, 2) mega_fwd(Params P) {
    extern __shared__ __attribute__((aligned(16))) unsigned char lds_raw[];
    cg::grid_group grid = cg::this_grid();
#define MKCTX Ctx C; { int tid_ = threadIdx.x; asm volatile("" : "+v"(tid_)); C.lds = (LAS unsigned char*)lds_raw; C.tid = tid_; C.lane = tid_ & 63; C.wave = __builtin_amdgcn_readfirstlane(tid_ >> 6); \
      C.G = gridDim.x; C.gw = blockIdx.x * NWAVES + C.wave; C.ngw = C.G * NWAVES; }
#if SYNC_MODE != 0
    if (threadIdx.x < 4) ((LAS unsigned*)((LAS unsigned char*)lds_raw + XBW_OFF))[threadIdx.x] = 0u;
    __syncthreads();
    XcdBarrier bar = xcd_barrier_post((unsigned*)(P.ws + WS_CTL) + CW_BAR, (volatile LAS unsigned*)((LAS unsigned char*)lds_raw + XBW_OFF));
#define SY xcd_barrier(bar);
#else
#define SY grid.sync();
#endif
#define GS grid.sync();
#define BS __syncthreads();
#define X(k) { MKCTX run_phase<k>(P, C); }
    PROGRAM
#undef X
#undef MKCTX
#undef SY
#undef GS
#undef BS
}

extern "C" void kernel_launch(void* const* d_in, const int* in_sizes, int n_in, void* d_out, int out_size, void* d_ws, size_t ws_size, hipStream_t stream) {
    static int grid = 0;
    if (grid == 0) {
        if (n_in != 25 || out_size != NTOK * D || ws_size < WS_END) { fprintf(stderr, "kernel_launch: unexpected shapes (n_in %d out %d ws %zu)\n", n_in, out_size, ws_size); grid = -1; return; }
        int dev = 0, cus = 0, per_cu = 0;
        if (hipGetDevice(&dev) != hipSuccess || hipDeviceGetAttribute(&cus, hipDeviceAttributeMultiprocessorCount, dev) != hipSuccess) { grid = -1; return; }
        if (hipFuncSetAttribute((const void*)mega_fwd, hipFuncAttributeMaxDynamicSharedMemorySize, LDS_BYTES) != hipSuccess) { fprintf(stderr, "kernel_launch: hipFuncSetAttribute failed\n"); grid = -1; return; }
        if (hipOccupancyMaxActiveBlocksPerMultiprocessor(&per_cu, (const void*)mega_fwd, NTHR, LDS_BYTES) != hipSuccess || per_cu < 1) { fprintf(stderr, "kernel_launch: occupancy query failed (%d)\n", per_cu); (void)hipGetLastError(); grid = -1; return; }
        grid = cus * per_cu;
        fprintf(stderr, "kernel_launch: grid %d (%d CUs x %d)\n", grid, cus, per_cu);
    }
    if (grid < 0) return;
    (void)hipMemsetAsync((char*)d_ws + WS_CTL, 0, CTL_ZERO_BYTES, stream);
    Params p{};
    for (int i = 0; i < 25; ++i) p.in[i] = (const float*)d_in[i];
    p.out = (float*)d_out; p.ws = (unsigned char*)d_ws;

    void* args[] = {&p};
    hipError_t e = hipLaunchCooperativeKernel((const void*)mega_fwd, dim3(grid), dim3(NTHR), args, LDS_BYTES, stream);
    if (e != hipSuccess) fprintf(stderr, "kernel_launch: cooperative launch failed: %s (grid %d)\n", hipGetErrorString(e), grid);
}
```

```cpp
#define SYNC_MODE 1
#include <hip/hip_runtime.h>
#include <hip/hip_cooperative_groups.h>
#include <cstdio>
#include <cstdint>
namespace cg = cooperative_groups;

namespace pg8 {
#define PG8_LAS __attribute__((address_space(3)))
typedef unsigned short bf16_t;
typedef short bf16x8 __attribute__((ext_vector_type(8)));
typedef float f32x4 __attribute__((ext_vector_type(4)));
typedef unsigned u32x4 __attribute__((ext_vector_type(4)));
typedef int i32x4 __attribute__((ext_vector_type(4)));
typedef int i32x8 __attribute__((ext_vector_type(8)));
constexpr int BM = 256, BK = 64, HALF = 128, HTB = HALF * BK * 2  , STAGE_BYTES = 8 * HTB, NXCD = 8, WGM = 8;

__host__ __device__ __forceinline__ int lds_byte(int r, int c) { const int st = (r >> 4) * 2 + (c >> 5), rr = r & 15, cc = c & 31, ob = rr * 64 + cc * 2; return st * 1024 + (ob ^ (((ob >> 9) & 1) << 5)); }
__host__ __device__ __forceinline__ void stage_rc(int b, int& R, int& C) { const int st = b / 1024, sb = b % 1024, swz = sb ^ (((sb >> 9) & 1) << 5); R = (st >> 1) * 16 + swz / 64; C = (st & 1) * 32 + (swz % 64) / 2; }
__host__ __device__ __forceinline__ int perm32(int rho) { const int n = rho >> 4, i = rho & 15; return 8 * (i >> 2) + 4 * n + (i & 3); }

struct Unit { int pm, pn; };
struct Gemm { const bf16_t* A; const bf16_t* Bt; int M, N, K; };

struct StaticOrder {
    int nM, nN, nwg, G, c;
    __host__ __device__ void init(int M, int N, int G_, int c_) { nM = M / BM; nN = N / BM; nwg = nM * nN; G = G_; c = c_; }
    __host__ __device__ bool next(int i, Unit& u) const {
        const long L = (long)i * G + c; if (L >= nwg) return false;
        int wgid = (int)L; { const int q = nwg / NXCD, r = nwg % NXCD, xcd = wgid % NXCD, off = wgid / NXCD; wgid = (xcd < r ? xcd * (q + 1) : r * (q + 1) + (xcd - r) * q) + off; }
        const int nig = WGM * nN, gid = wgid / nig, fm = gid * WGM, gsz = (nM - fm) < WGM ? (nM - fm) : WGM;
        u.pm = fm + ((wgid % nig) % gsz); u.pn = (wgid % nig) / gsz; return true;
    }
    __device__ __forceinline__ void a_ready(const Unit&) const {}
    __device__ __forceinline__ void done(const Unit&) const {}
};

__device__ __forceinline__ unsigned cvt_pk_bf16(float lo, float hi) { unsigned r; asm volatile("v_cvt_pk_bf16_f32 %0, %1, %2" : "=v"(r) : "v"(lo), "v"(hi)); return r; }
typedef float f32x2 __attribute__((ext_vector_type(2)));
template <class Epi, class Sched, bool ALIGN_EPI = false, bool SP2 = false, int F8 = 0, int F8SA = 127, int F8SB = 127>
__device__ __forceinline__ void gemm_phase(PG8_LAS unsigned char* lds, const Gemm g, const Sched& S, const Epi& E) {
    const int tid = threadIdx.x, wid = __builtin_amdgcn_readfirstlane(tid >> 6), lane = tid & 63, wr = wid >> 2, wc = wid & 3, fr = lane & 15, fq = lane >> 4;
    const int K = g.K, nt = K / BK;
    unsigned voffA[2], voffB[2];
#pragma unroll
    for (int i = 0; i < 2; ++i) { int R, C; stage_rc(tid * 16 + i * 8192, R, C); const int Rb = Epi::PERM ? ((R & ~31) + perm32(R & 31)) : R;
        voffA[i] = (unsigned)(R * K + C) * 2u; voffB[i] = (unsigned)(Rb * K + C) * 2u; }
    const size_t kstep = (size_t)(BK * 2);
    const size_t hstep = (size_t)HALF * K * 2;
    const size_t tstep = 2 * hstep;
    const unsigned ldsw = (unsigned)wid * 1024u;
    const int aoff = lds_byte(wr * 64 + fr, fq * 8), boff = lds_byte(wc * 32 + fr, fq * 8);
#define PG8_SA(b, h) (((b) * 2 + (h)) * HTB)
#define PG8_SB(b, h) ((4 + (b) * 2 + (h)) * HTB)
#define PG8_STAGE(bufoff, gbase, voff) do { _Pragma("unroll") for (int _i = 0; _i < 2; ++_i) \
        __builtin_amdgcn_global_load_lds((const unsigned*)((const char*)(gbase) + (voff)[_i]), (PG8_LAS unsigned*)(lds + (bufoff) + ldsw + _i * 8192), 16, 0, 0); } while (0)
#define PG8_LDA(dst, b, h) do { _Pragma("unroll") for (int m = 0; m < 4; ++m) { dst[m].lo = *(const PG8_LAS i32x4*)(lds + PG8_SA(b, h) + aoff + m * 2048); dst[m].hi = *(const PG8_LAS i32x4*)(lds + PG8_SA(b, h) + aoff + m * 2048 + 1024); } } while (0)
#define PG8_LDB(dst, b, h) do { _Pragma("unroll") for (int n = 0; n < 2; ++n) { dst[n].lo = *(const PG8_LAS i32x4*)(lds + PG8_SB(b, h) + boff + n * 2048); dst[n].hi = *(const PG8_LAS i32x4*)(lds + PG8_SB(b, h) + boff + n * 2048 + 1024); } } while (0)
#define PG8_MMA(ai, bj, At, Bt) do { __builtin_amdgcn_s_setprio(1); \
        if constexpr (F8 == 0) { _Pragma("unroll") for (int m = 0; m < 4; ++m) _Pragma("unroll") for (int n = 0; n < 2; ++n) { \
            const i32x4 bl_ = Bt[n].lo, bh_ = Bt[n].hi, al_ = At[m].lo, ah_ = At[m].hi;     \
            acc[ai][bj][m][n] = __builtin_amdgcn_mfma_f32_16x16x32_bf16(__builtin_bit_cast(bf16x8, bl_), __builtin_bit_cast(bf16x8, al_), acc[ai][bj][m][n], 0, 0, 0); \
            acc[ai][bj][m][n] = __builtin_amdgcn_mfma_f32_16x16x32_bf16(__builtin_bit_cast(bf16x8, bh_), __builtin_bit_cast(bf16x8, ah_), acc[ai][bj][m][n], 0, 0, 0); } } \
        else { _Pragma("unroll") for (int m = 0; m < 4; ++m) _Pragma("unroll") for (int n = 0; n < 2; ++n) \
            asm volatile("v_mfma_f32_16x16x128_f8f6f4 %0, %1, %2, %0" : "+v"(acc[ai][bj][m][n]) : "v"(Bt[n]), "v"(At[m])); } \
        __builtin_amdgcn_s_setprio(0); } while (0)
#define PG8_WAIT_V(n) asm volatile("s_waitcnt vmcnt(" #n ")" ::: "memory")
#define PG8_WAIT_L(n) asm volatile("s_waitcnt lgkmcnt(" #n ")" ::: "memory")
#define PG8_BAR __builtin_amdgcn_s_barrier()
#define PG8_SCHED __builtin_amdgcn_sched_barrier(0)
    Unit cur, nxt; int ui = 0;
    if (!S.next(0, cur)) return;
    f32x4 acc[2][2][4][2];
#pragma unroll
    for (int a = 0; a < 2; ++a)
#pragma unroll
        for (int b = 0; b < 2; ++b)
#pragma unroll
            for (int m = 0; m < 4; ++m)
#pragma unroll
                for (int n = 0; n < 2; ++n) acc[a][b][m][n] = (f32x4){0.f, 0.f, 0.f, 0.f};
    i32x8 At[4], B0[2], B1[2];
    const char* cA = (const char*)g.A + (size_t)cur.pm * tstep; const char* cB = (const char*)g.Bt + (size_t)cur.pn * tstep;
    S.a_ready(cur);
    if constexpr (SP2) {
        PG8_STAGE(PG8_SB(0, 0), cB, voffB); PG8_STAGE(PG8_SB(0, 1), cB + hstep, voffB); PG8_STAGE(PG8_SA(0, 0), cA, voffA); PG8_STAGE(PG8_SA(0, 1), cA + hstep, voffA);
        if (wr == 1) PG8_BAR;
        PG8_WAIT_V(2); PG8_BAR;
        PG8_STAGE(PG8_SB(1, 0), cB + kstep, voffB); PG8_STAGE(PG8_SA(1, 0), cA + kstep, voffA); PG8_STAGE(PG8_SB(1, 1), cB + hstep + kstep, voffB);
        PG8_WAIT_V(6); PG8_BAR;
    } else {
        PG8_STAGE(PG8_SB(0, 0), cB, voffB); PG8_STAGE(PG8_SA(0, 0), cA, voffA); PG8_STAGE(PG8_SB(0, 1), cB + hstep, voffB); PG8_STAGE(PG8_SA(0, 1), cA + hstep, voffA);
        if (wr == 1) PG8_BAR;
        PG8_WAIT_V(4); PG8_BAR;
        PG8_STAGE(PG8_SB(1, 0), cB + kstep, voffB); PG8_STAGE(PG8_SA(1, 0), cA + kstep, voffA); PG8_STAGE(PG8_SB(1, 1), cB + hstep + kstep, voffB);
        PG8_WAIT_V(6); PG8_BAR;
    }
    for (;;) {
        const bool has_next = S.next(ui + 1, nxt);
        const char* nA = has_next ? (const char*)g.A + (size_t)nxt.pm * tstep : cA; const char* nB = has_next ? (const char*)g.Bt + (size_t)nxt.pn * tstep : cB;
_Pragma("nounroll")
        for (int t = 0; t < nt; t += 2) {
            const bool last = (t == nt - 2);
            const char* a1 = cA + (size_t)(t + 1) * kstep;
            const char* a2 = last ? nA : cA + (size_t)(t + 2) * kstep; const char* b2 = last ? nB : cB + (size_t)(t + 2) * kstep;
            const char* a3 = a2 + kstep; const char* b3 = b2 + kstep;
            if (last && has_next) S.a_ready(nxt);
            if constexpr (SP2) {
            PG8_LDB(B0, 0, 0); PG8_LDB(B1, 0, 1); PG8_SCHED; PG8_LDA(At, 0, 0); PG8_STAGE(PG8_SA(1, 1), a1 + hstep, voffA);
            PG8_WAIT_V(8); PG8_WAIT_L(0); PG8_BAR; PG8_MMA(0, 0, At, B0); PG8_MMA(0, 1, At, B1); PG8_BAR; PG8_SCHED;
            PG8_LDA(At, 0, 1); PG8_STAGE(PG8_SB(0, 0), b2, voffB); PG8_STAGE(PG8_SB(0, 1), b2 + hstep, voffB); PG8_STAGE(PG8_SA(0, 0), a2, voffA);
            PG8_WAIT_V(8); PG8_WAIT_L(0); PG8_BAR; PG8_MMA(1, 0, At, B0); PG8_MMA(1, 1, At, B1); PG8_BAR; PG8_SCHED;
            PG8_LDB(B0, 1, 0); PG8_LDB(B1, 1, 1); PG8_SCHED; PG8_LDA(At, 1, 0); PG8_STAGE(PG8_SA(0, 1), a2 + hstep, voffA);
            PG8_WAIT_V(8); PG8_WAIT_L(0); PG8_BAR; PG8_MMA(0, 0, At, B0); PG8_MMA(0, 1, At, B1); PG8_BAR; PG8_SCHED;
            PG8_LDA(At, 1, 1); PG8_STAGE(PG8_SB(1, 0), b3, voffB); PG8_STAGE(PG8_SB(1, 1), b3 + hstep, voffB); PG8_STAGE(PG8_SA(1, 0), a3, voffA);
            PG8_WAIT_V(8); PG8_WAIT_L(0); PG8_BAR; PG8_MMA(1, 0, At, B0); PG8_MMA(1, 1, At, B1); PG8_BAR; PG8_SCHED;
            } else {
            PG8_LDB(B0, 0, 0); PG8_SCHED; PG8_LDA(At, 0, 0); PG8_STAGE(PG8_SA(1, 1), a1 + hstep, voffA);
            PG8_WAIT_L(8); PG8_BAR; PG8_WAIT_L(0); PG8_MMA(0, 0, At, B0); PG8_BAR; PG8_SCHED;
            PG8_LDB(B1, 0, 1); PG8_STAGE(PG8_SB(0, 0), b2, voffB);
            PG8_BAR; PG8_WAIT_L(0); PG8_MMA(0, 1, At, B1); PG8_BAR;
            PG8_LDA(At, 0, 1); PG8_STAGE(PG8_SA(0, 0), a2, voffA);
            PG8_BAR; PG8_WAIT_L(0); PG8_MMA(1, 0, At, B0); PG8_BAR; PG8_SCHED;
            PG8_STAGE(PG8_SB(0, 1), b2 + hstep, voffB);
            PG8_WAIT_V(6); PG8_BAR; PG8_MMA(1, 1, At, B1); PG8_BAR;
            PG8_LDB(B0, 1, 0); PG8_SCHED; PG8_LDA(At, 1, 0); PG8_STAGE(PG8_SA(0, 1), a2 + hstep, voffA);
            PG8_WAIT_L(8); PG8_BAR; PG8_WAIT_L(0); PG8_MMA(0, 0, At, B0); PG8_BAR; PG8_SCHED;
            PG8_LDB(B1, 1, 1); PG8_STAGE(PG8_SB(1, 0), b3, voffB);
            PG8_BAR; PG8_WAIT_L(0); PG8_MMA(0, 1, At, B1); PG8_BAR;
            PG8_LDA(At, 1, 1); PG8_STAGE(PG8_SA(1, 0), a3, voffA);
            PG8_BAR; PG8_WAIT_L(0); PG8_MMA(1, 0, At, B0); PG8_BAR; PG8_SCHED;
            PG8_STAGE(PG8_SB(1, 1), b3 + hstep, voffB);
            PG8_WAIT_V(6); PG8_BAR; PG8_MMA(1, 1, At, B1); PG8_BAR;
            }
        }
        if constexpr (ALIGN_EPI) { if (wr == 0) PG8_BAR; }
        if constexpr (F8 != 0) asm volatile("s_nop 15\n\ts_nop 15" ::: "memory");
        if constexpr (!Epi::AFTER_DRAIN) { E(acc, cur, wr, wc, fr, fq); S.done(cur); }
        if (!has_next) break;
#pragma unroll
        for (int a = 0; a < 2; ++a)
#pragma unroll
            for (int b = 0; b < 2; ++b)
#pragma unroll
                for (int m = 0; m < 4; ++m)
#pragma unroll
                    for (int n = 0; n < 2; ++n) acc[a][b][m][n] = (f32x4){0.f, 0.f, 0.f, 0.f};
        cur = nxt; cA = nA; cB = nB; ++ui;
        if constexpr (ALIGN_EPI) { if (wr == 1) PG8_BAR; }
    }
    PG8_WAIT_V(0);
    if constexpr (!ALIGN_EPI) { if (wr == 0) PG8_BAR; }
    PG8_BAR;
    if constexpr (Epi::AFTER_DRAIN) { E.fused(acc, cur, wr, wc, fr, fq, lds, wid, lane); S.done(cur); }
#undef PG8_SA
#undef PG8_SB
#undef PG8_STAGE
#undef PG8_LDA
#undef PG8_LDB
#undef PG8_MMA
#undef PG8_WAIT_V
#undef PG8_WAIT_L
#undef PG8_BAR
#undef PG8_SCHED
}
}

constexpr int NB = 8, T = 4096, D = 1024, NTOK = NB * T;
constexpr int ATT_H = 8, ATT_D = 64, ATT_W = 512, KV_LAT = 256, IDX_H = 8, IDX_D = 64, TOPK = 256;
constexpr int HG_H = 4, HG_DK = 128, HG_DV = 128, HG_W = 512, HG_C = 32;
constexpr int D_IN = 3400, D_INP = 3584;
constexpr int C_AQ = 0, C_AC = 512, C_IQ = 768, C_IK = 1280, C_IW = 1344, C_GQ = 1352, C_GF = 1864, C_GI = 2376, C_GG = 2888;
constexpr int NE = 32, TOPE = 4, DFF = 1024, PLE = 256;
constexpr int NASSIGN = NTOK * TOPE, CAP = NASSIGN + NE * 256;
constexpr int MAXTILES = CAP / 256;
constexpr float LN_EPS = 1e-5f, RMS_EPS = 1e-6f, ALPHA = 1.189207115002721f;

constexpr size_t MiB = 1u << 20;
constexpr size_t WS_CTL = 0, CTL_ZERO_BYTES = 64 * 1024;
constexpr size_t WS_WIN_T = 1 * MiB, WS_WO_T = 8 * MiB, WS_WUP_T = 10 * MiB, WS_WDN_T = 138 * MiB, WS_WPROJ_T = 202 * MiB, WS_WGATE_T = 203 * MiB;
constexpr size_t WS_WUK_T = 205 * MiB, WS_WUV_T = 205 * MiB + 512 * 1024;
constexpr size_t WS_SMALL = 206 * MiB;
constexpr size_t WS_A = 208 * MiB;
constexpr size_t WS_B = 480 * MiB;
constexpr size_t WS_X1 = 752 * MiB;
constexpr size_t WS_XB = 880 * MiB;
constexpr size_t WS_PROJ = 944 * MiB;
constexpr size_t WS_SM2 = 1008 * MiB;
constexpr size_t WS_END = 1016 * MiB;
constexpr size_t WS_H = WS_A, WS_XS = WS_A, WS_YSLOT = WS_A;
constexpr size_t WS_XBF = WS_B, WS_U = WS_B, WS_YMIX = WS_B, WS_HH = WS_B;
constexpr size_t WS_QDEC = WS_B + 128 * MiB, WS_PB = WS_B + 128 * MiB, WS_OREC = WS_B + 160 * MiB, WS_CN = WS_B + 224 * MiB, WS_IKN = WS_B + 240 * MiB, WS_MASK = WS_B + 244 * MiB;
constexpr size_t WS_K = WS_XB, WS_VT = WS_XB + 32 * MiB;
constexpr size_t WS_TOPE = WS_SM2, WS_GATE = WS_SM2 + 512 * 1024, WS_LRANK = WS_SM2 + 1024 * 1024, WS_TOKSLOT = WS_SM2 + 1536 * 1024, WS_SLOTGATE = WS_SM2 + 2 * MiB, WS_DECAY = WS_SM2 + 3 * MiB;
constexpr size_t WS_WRT = WS_SMALL + 256 * 1024;
constexpr size_t WS_WGBASE = WS_SMALL, WS_TILEE = WS_SMALL + 64 * 1024;
constexpr int CW_CNT = 64;
constexpr int CW_BAR = 1024;
constexpr int XBW_OFF = 147456 - 16;

constexpr int RING_BYTES = 131072, MISC_OFF = RING_BYTES, LDS_BYTES = 147456;
constexpr int NWAVES = 8, NTHR = 512;

#define GAS __attribute__((address_space(1)))
#define LAS __attribute__((address_space(3)))
typedef unsigned short bf16;
typedef unsigned v4u __attribute__((ext_vector_type(4)));
typedef unsigned v2u __attribute__((ext_vector_type(2)));
typedef float f32x4 __attribute__((ext_vector_type(4)));
typedef short bf16x8 __attribute__((ext_vector_type(8)));
#define LDS_WAIT() asm volatile("s_waitcnt lgkmcnt(0)" ::: "memory")
#define VM_WAIT() asm volatile("s_waitcnt vmcnt(0)" ::: "memory")
__device__ __forceinline__ unsigned f2bf(float f) { unsigned u = __builtin_bit_cast(unsigned, f); return (u + 0x7fffu + ((u >> 16) & 1u)) >> 16; }
__device__ __forceinline__ unsigned pk2(float lo, float hi) { return f2bf(lo) | (f2bf(hi) << 16); }
__device__ __forceinline__ float bf2f(unsigned short b) { return __builtin_bit_cast(float, (unsigned)b << 16); }
__device__ __forceinline__ float bflo(unsigned w) { return __builtin_bit_cast(float, w << 16); }
__device__ __forceinline__ float bfhi(unsigned w) { return __builtin_bit_cast(float, w & 0xffff0000u); }
__device__ __forceinline__ float wave_sum(float v) {
#pragma unroll
    for (int o = 1; o < 64; o <<= 1) v += __shfl_xor(v, o);
    return v;
}
__device__ __forceinline__ float sigmoidf_(float x) { return __builtin_amdgcn_rcpf(1.f + __builtin_amdgcn_exp2f(x * -1.4426950408889634f)); }

__device__ __forceinline__ unsigned pk4_fp8(float a, float b, float c, float d);
struct Params { const float* in[25]; float* out; unsigned char* ws; };
enum { I_X = 0, I_P, I_WIN, I_KVG, I_IKG, I_IKB, I_WUK, I_WUV, I_HGLB, I_HGNG, I_WO, I_LNMG, I_LNMB, I_WR, I_BR, I_WUP, I_BUP, I_WDN, I_BDN, I_LNFG, I_LNFB, I_WPP, I_WPG, I_LNPG, I_LNPB };

struct Ctx { LAS unsigned char* lds; int tid, lane, wave, G, gw, ngw; };

namespace pg8 {
struct EpiBf16s {
    static constexpr bool PERM = true, AFTER_DRAIN = false;
    bf16_t* O; int ldc;
    __device__ __forceinline__ void operator()(const f32x4 (&acc)[2][2][4][2], const Unit& u, int wr, int wc, int fr, int fq) const {
        const int row0 = u.pm * BM + wr * 64 + fr, col0 = u.pn * BM + wc * 32 + 8 * fq;
#pragma unroll
        for (int ai = 0; ai < 2; ++ai)
#pragma unroll
            for (int m = 0; m < 4; ++m) { bf16_t* rowp = O + (size_t)(row0 + ai * HALF + m * 16) * ldc + col0;
#pragma unroll
                for (int bj = 0; bj < 2; ++bj) { const f32x4 v0 = acc[ai][bj][m][0], v1 = acc[ai][bj][m][1];
                    u32x4 w; w.x = cvt_pk_bf16(v0[0], v0[1]); w.y = cvt_pk_bf16(v0[2], v0[3]); w.z = cvt_pk_bf16(v1[0], v1[1]); w.w = cvt_pk_bf16(v1[2], v1[3]);
                    *(u32x4*)(rowp + bj * HALF) = w; } }
    }
};
struct EpiResid {
    static constexpr bool PERM = false, AFTER_DRAIN = false;
    const float* res; bf16_t* out; int ldc; float alpha, as;
    __device__ __forceinline__ void operator()(const f32x4 (&acc)[2][2][4][2], const Unit& u, int wr, int wc, int fr, int fq) const {
        const int row0 = u.pm * BM + wr * 64 + fr, col0 = u.pn * BM + wc * 32 + 4 * fq;
#pragma unroll
        for (int ai = 0; ai < 2; ++ai)
#pragma unroll
            for (int m = 0; m < 4; ++m) { const size_t off = (size_t)(row0 + ai * HALF + m * 16) * ldc + col0;
#pragma unroll
                for (int bj = 0; bj < 2; ++bj)
#pragma unroll
                    for (int n = 0; n < 2; ++n) { const f32x4 r = *(const f32x4*)(res + off + bj * HALF + n * 16); const f32x4 o = r * alpha + acc[ai][bj][m][n] * as; v2u w; w.x = cvt_pk_bf16(o[0], o[1]); w.y = cvt_pk_bf16(o[2], o[3]); *(v2u*)(out + off + bj * HALF + n * 16) = w; }
                asm volatile("" ::: "memory"); }
    }
};
struct EpiPle {
    static constexpr bool PERM = false, AFTER_DRAIN = false;
    const bf16_t* x2; const bf16_t* proj; bf16_t* out; float alpha, as;
    __device__ __forceinline__ void operator()(const f32x4 (&acc)[2][2][4][2], const Unit& u, int wr, int wc, int fr, int fq) const {
        const int row0 = u.pm * BM + wr * 64 + fr, col0 = u.pn * BM + wc * 32 + 4 * fq;
#pragma unroll
        for (int ai = 0; ai < 2; ++ai)
#pragma unroll
            for (int m = 0; m < 4; ++m) { const size_t off = (size_t)(row0 + ai * HALF + m * 16) * 1024 + col0;
#pragma unroll
                for (int bj = 0; bj < 2; ++bj)
#pragma unroll
                    for (int n = 0; n < 2; ++n) { const size_t o2 = off + bj * HALF + n * 16; const v2u rw = *(const v2u*)(x2 + o2); const f32x4 r = {bflo(rw.x), bfhi(rw.x), bflo(rw.y), bfhi(rw.y)}; const v2u pw = *(const v2u*)(proj + o2);
                        const f32x4 a = acc[ai][bj][m][n] * as; f32x4 o;
                        o[0] = r[0] * alpha + bflo(pw.x) * sigmoidf_(a[0]); o[1] = r[1] * alpha + bfhi(pw.x) * sigmoidf_(a[1]);
                        o[2] = r[2] * alpha + bflo(pw.y) * sigmoidf_(a[2]); o[3] = r[3] * alpha + bfhi(pw.y) * sigmoidf_(a[3]);
                        v2u ow; ow.x = cvt_pk_bf16(o[0], o[1]); ow.y = cvt_pk_bf16(o[2], o[3]); *(v2u*)(out + o2) = ow; }
                asm volatile("" ::: "memory"); }
    }
};
struct EpiSwiglu {
    static constexpr bool PERM = true, AFTER_DRAIN = false;
    unsigned char* H; const float* b_up;
    __device__ __forceinline__ void operator()(const f32x4 (&acc)[2][2][4][2], const Unit& u, int wr, int wc, int fr, int fq) const {
        const int e = u.pn >> 3, pnT = u.pn & 7;
        const int row0 = u.pm * BM + wr * 64 + fr, col0 = pnT * 128 + wc * 32 + 8 * fq;
        const float* bg = b_up + (size_t)e * 2048 + col0; const float* bl = bg + 1024;
        float bgv[8], blv[8];
#pragma unroll
        for (int j = 0; j < 8; ++j) { bgv[j] = bg[j]; blv[j] = bl[j]; }
#pragma unroll
        for (int ai = 0; ai < 2; ++ai)
#pragma unroll
            for (int m = 0; m < 4; ++m) { unsigned char* rowp = H + (size_t)(row0 + ai * HALF + m * 16) * 1024 + col0; float a[8];
#pragma unroll
                for (int n = 0; n < 2; ++n)
#pragma unroll
                    for (int j = 0; j < 4; ++j) { float g = acc[ai][0][m][n][j] * (1.f / 512.f) + bgv[4 * n + j], l = acc[ai][1][m][n][j] * (1.f / 512.f) + blv[4 * n + j];
                        g = fminf(g, 7.0f); l = fminf(fmaxf(l, -7.0f), 7.0f); a[4 * n + j] = g * sigmoidf_(1.702f * g) * (l + 1.0f); }
                v2u w; w.x = pk4_fp8(a[0] * 4.f, a[1] * 4.f, a[2] * 4.f, a[3] * 4.f); w.y = pk4_fp8(a[4] * 4.f, a[5] * 4.f, a[6] * 4.f, a[7] * 4.f);
                *(v2u*)rowp = w; }
    }
};
struct EpiDown {
    static constexpr bool PERM = true, AFTER_DRAIN = false;
    unsigned char* Y; const float* b_dn; const float* gate;
    __device__ __forceinline__ void operator()(const f32x4 (&acc)[2][2][4][2], const Unit& u, int wr, int wc, int fr, int fq) const {
        const int e = u.pn >> 2, pnT = u.pn & 3;
        const int row0 = u.pm * BM + wr * 64 + fr, col0 = pnT * 256 + wc * 32 + 8 * fq;
        const float* bb = b_dn + (size_t)e * 1024 + col0;
        float bv[2][8];
#pragma unroll
        for (int bj = 0; bj < 2; ++bj)
#pragma unroll
            for (int j = 0; j < 8; ++j) bv[bj][j] = bb[bj * HALF + j];
#pragma unroll
        for (int ai = 0; ai < 2; ++ai)
#pragma unroll
            for (int m = 0; m < 4; ++m) { const int row = row0 + ai * HALF + m * 16; const float gt = gate[row] * 64.f; unsigned char* rowp = Y + (size_t)row * 1024 + col0;
#pragma unroll
                for (int bj = 0; bj < 2; ++bj) { const f32x4 v0 = acc[ai][bj][m][0], v1 = acc[ai][bj][m][1];
                    const float as = 1.f / 256.f;
                    v2u w; w.x = pk4_fp8((v0[0] * as + bv[bj][0]) * gt, (v0[1] * as + bv[bj][1]) * gt, (v0[2] * as + bv[bj][2]) * gt, (v0[3] * as + bv[bj][3]) * gt);
                    w.y = pk4_fp8((v1[0] * as + bv[bj][4]) * gt, (v1[1] * as + bv[bj][5]) * gt, (v1[2] * as + bv[bj][6]) * gt, (v1[3] * as + bv[bj][7]) * gt);
                    *(v2u*)(rowp + bj * HALF) = w; } }
    }
};
struct MoeOrder {
    const int* tile_e; int ntiles, nN, G, c;
    __device__ __forceinline__ bool next(int i, Unit& u) const {
        if ((G & 7) == 0) {
            const int x = c & 7, s = i * (G >> 3) + (c >> 3);
            const int cg = nN >> 2, rg = 8 / cg;
            const int ch = x % cg, rc = x / cg;
            const int lr = s >> 2, pl = 4 * ch + (s & 3), pm = rc + rg * lr;
            if (pm >= ntiles) return false;
            u.pm = pm; u.pn = tile_e[pm] * nN + pl; return true;
        }
        const int L = i * G + c; if (L >= ntiles * nN) return false;
        const int pm = L / nN, pl = L - pm * nN; u.pm = pm; u.pn = tile_e[pm] * nN + pl; return true;
    }
    __device__ __forceinline__ void a_ready(const Unit&) const {}
    __device__ __forceinline__ void done(const Unit&) const {}
};
}

template <class RowMap>
__device__ __forceinline__ void transpose_item(const float* W, int ldw, int Nvalid, bf16* WT, int Kdim, RowMap rm, LAS float* scr, int kb, int nb, int lane) {
    const int k0 = 64 * kb, n0 = 32 * nb; const int nl0 = lane & 31, nn = n0 + nl0;
#pragma unroll 8
    for (int i = 0; i < 32; ++i) { const int kk = 2 * i + (lane >> 5); scr[kk * 33 + nl0] = (nn < Nvalid) ? W[(size_t)(k0 + kk) * ldw + nn] : 0.f; }
    LDS_WAIT(); asm volatile("" ::: "memory");
    const int c = lane & 7;
#pragma unroll
    for (int j = 0; j < 4; ++j) { const int n = (lane >> 3) + 8 * j; const LAS float* s = scr + (8 * c) * 33 + n;
        v4u o; o.x = pk2(s[0 * 33], s[1 * 33]); o.y = pk2(s[2 * 33], s[3 * 33]); o.z = pk2(s[4 * 33], s[5 * 33]); o.w = pk2(s[6 * 33], s[7 * 33]);
        *(GAS v4u*)(WT + (size_t)rm(n0 + n) * Kdim + k0 + 8 * c) = o; }
    LDS_WAIT(); asm volatile("" ::: "memory");
}
__device__ __forceinline__ unsigned pk4_fp8(float a, float b, float c, float d) { int r = 0; r = __builtin_amdgcn_cvt_pk_fp8_f32(a, b, r, false); r = __builtin_amdgcn_cvt_pk_fp8_f32(c, d, r, true); return (unsigned)r; }
template <class RowMap>
__device__ __forceinline__ void transpose_item_f8(const float* W, int ldw, unsigned char* WT, int Kdim, RowMap rm, LAS float* scr, int kb, int nb, int lane, float mul) {
    const int k0 = 64 * kb, n0 = 32 * nb; const int nl0 = lane & 31, nn = n0 + nl0;
#pragma unroll 8
    for (int i = 0; i < 32; ++i) { const int kk = 2 * i + (lane >> 5); scr[kk * 33 + nl0] = W[(size_t)(k0 + kk) * ldw + nn] * mul; }
    LDS_WAIT(); asm volatile("" ::: "memory");
    const int c = lane & 7;
#pragma unroll
    for (int j = 0; j < 4; ++j) { const int n = (lane >> 3) + 8 * j; const LAS float* s = scr + (8 * c) * 33 + n;
        v2u o; o.x = pk4_fp8(s[0 * 33], s[1 * 33], s[2 * 33], s[3 * 33]); o.y = pk4_fp8(s[4 * 33], s[5 * 33], s[6 * 33], s[7 * 33]);
        *(GAS v2u*)(WT + (size_t)rm(n0 + n) * Kdim + k0 + 8 * c) = o; }
    LDS_WAIT(); asm volatile("" ::: "memory");
}
struct RmId { __device__ __forceinline__ int operator()(int n) const { return n; } };
struct RmUp { int e; __device__ __forceinline__ int operator()(int n) const { return e * 2048 + ((n & 1023) >> 7) * 256 + (n >> 10) * 128 + (n & 127); } };
struct RmOff { int off; __device__ __forceinline__ int operator()(int n) const { return off + n; } };

struct CvtItem { const float* src; unsigned char* dst; int ldw; };
__device__ __forceinline__ CvtItem cvt_decode(const Params& P, int r) {
    unsigned char* ws = P.ws; CvtItem c;
    constexpr int I_O = 8 * 32, I_UP = 8 * 64, I_DN = 8 * 32;
    if (r < I_O) { const int kb = r / 32, nb = r % 32; c.src = P.in[I_WO] + (size_t)(128 * kb) * 1024 + 32 * nb; c.ldw = 1024; c.dst = ws + WS_WO_T + (size_t)(32 * nb) * 1024 + 128 * kb; return c; } r -= I_O;
    if (r < NE * I_UP) { const int e = r / I_UP, q = r % I_UP, kb = q / 64, nb = q % 64, n0 = 32 * nb; c.src = P.in[I_WUP] + (size_t)e * 1024 * 2048 + (size_t)(128 * kb) * 2048 + n0; c.ldw = 2048;
        c.dst = ws + WS_WUP_T + (size_t)(e * 2048 + ((n0 & 1023) >> 7) * 256 + (n0 >> 10) * 128 + (n0 & 127)) * 1024 + 128 * kb; return c; } r -= NE * I_UP;
    if (r < NE * I_DN) { const int e = r / I_DN, q = r % I_DN, kb = q / 32, nb = q % 32; c.src = P.in[I_WDN] + (size_t)e * 1024 * 1024 + (size_t)(128 * kb) * 1024 + 32 * nb; c.ldw = 1024;
        c.dst = ws + WS_WDN_T + (size_t)(e * 1024 + 32 * nb) * 1024 + 128 * kb; return c; } r -= NE * I_DN;
    { const int kb = r / 32, nb = r % 32; c.src = P.in[I_WPG] + (size_t)(128 * kb) * 1024 + 32 * nb; c.ldw = 1024; c.dst = ws + WS_WGATE_T + (size_t)(32 * nb) * 1024 + 128 * kb; return c; }
}
__device__ __forceinline__ void cvt_load(const CvtItem& c, float (&v)[64], int lane) {
    const float* p = c.src + (size_t)(lane >> 5) * c.ldw + (lane & 31);
#pragma unroll
    for (int i = 0; i < 64; ++i) v[i] = p[(size_t)(2 * i) * c.ldw];
}
__device__ __forceinline__ void cvt_store(const CvtItem& c, const float (&v)[64], LAS float* scr, int lane) {
#pragma unroll
    for (int i = 0; i < 64; ++i) scr[(2 * i + (lane >> 5)) * 33 + (lane & 31)] = v[i] * 64.f;
    LDS_WAIT(); asm volatile("" ::: "memory");
    const int ch = lane & 15;
#pragma unroll
    for (int j = 0; j < 8; ++j) { const int n = (lane >> 4) + 4 * j; const LAS float* s = scr + (8 * ch) * 33 + n;
        v2u o; o.x = pk4_fp8(s[0 * 33], s[1 * 33], s[2 * 33], s[3 * 33]); o.y = pk4_fp8(s[4 * 33], s[5 * 33], s[6 * 33], s[7 * 33]);
        *(GAS v2u*)(c.dst + (size_t)n * 1024 + 8 * ch) = o; }
    LDS_WAIT(); asm volatile("" ::: "memory");
}
__device__ __forceinline__ void convert_late(const Params& P, LAS float* scr, int gwc, int ngwc, int lane) {
    constexpr int NT = 8 * 32 + NE * 8 * 64 + NE * 8 * 32 + 8 * 32;
    float va[64], vb[64];
    int it = gwc;
    if (it < NT) { const CvtItem c = cvt_decode(P, it); cvt_load(c, va, lane); }
    for (; it < NT; it += 2 * ngwc) {
        const int i1 = it + ngwc, i2 = it + 2 * ngwc;
        if (i1 < NT) { const CvtItem c = cvt_decode(P, i1); cvt_load(c, vb, lane); }
        { const CvtItem c = cvt_decode(P, it); cvt_store(c, va, scr, lane); }
        if (i2 < NT) { const CvtItem c = cvt_decode(P, i2); cvt_load(c, va, lane); }
        if (i1 < NT) { const CvtItem c = cvt_decode(P, i1); cvt_store(c, vb, scr, lane); }
    }
    for (int r = gwc; r < 512; r += ngwc) { const int i = r * 64 + lane; const int e = i >> 10, k = i & 1023; ((float*)(P.ws + WS_WRT))[i] = P.in[I_WR][k * 32 + e]; }
}
__device__ __forceinline__ void p0_prologue(const Params& P, const Ctx& C) {
    LAS float* scr = (LAS float*)(C.lds + C.wave * 16384);
    unsigned char* ws = P.ws;
    constexpr int I_IN = 16 * (D_INP / 32), I_PP = 4 * 32, I_UK = 4 * 16, I_UV = 4 * 16;
    constexpr int NITEMS = I_IN + I_PP + I_UK + I_UV;
    for (int it = C.gw; it < NITEMS; it += C.ngw) {
        int r = it;
        if (r < I_IN) { transpose_item(P.in[I_WIN], D_IN, D_IN, (bf16*)(ws + WS_WIN_T), 1024, RmId{}, scr, r / (D_INP / 32), r % (D_INP / 32), C.lane); continue; } r -= I_IN;
        if (r < I_PP) { transpose_item(P.in[I_WPP], 1024, 1024, (bf16*)(ws + WS_WPROJ_T), 256, RmId{}, scr, r / 32, r % 32, C.lane); continue; } r -= I_PP;
        if (r < I_UK) { transpose_item(P.in[I_WUK], 512, 512, (bf16*)(ws + WS_WUK_T), 256, RmId{}, scr, r / 16, r % 16, C.lane); continue; } r -= I_UK;
        transpose_item(P.in[I_WUV], 512, 512, (bf16*)(ws + WS_WUV_T), 256, RmId{}, scr, r / 16, r % 16, C.lane);
    }
    {
        const float* x = P.in[I_X]; bf16* xb = (bf16*)(ws + WS_XBF);
        const size_t n8 = (size_t)NTOK * D / 8, stride = (size_t)C.ngw * 64;
        for (size_t i = (size_t)C.gw * 64 + C.lane; i < n8; i += stride) { const f32x4 a = *(const GAS f32x4*)(x + i * 8), b = *(const GAS f32x4*)(x + i * 8 + 4);
            v4u o; o.x = pk2(a[0], a[1]); o.y = pk2(a[2], a[3]); o.z = pk2(b[0], b[1]); o.w = pk2(b[2], b[3]); *(GAS v4u*)(xb + i * 8) = o; }
        const float* p = P.in[I_P]; bf16* pb = (bf16*)(ws + WS_PB);
        const size_t m8 = (size_t)NTOK * PLE / 8;
        for (size_t i = (size_t)C.gw * 64 + C.lane; i < m8; i += stride) { const f32x4 a = *(const GAS f32x4*)(p + i * 8), b = *(const GAS f32x4*)(p + i * 8 + 4);
            v4u o; o.x = pk2(a[0], a[1]); o.y = pk2(a[2], a[3]); o.z = pk2(b[0], b[1]); o.w = pk2(b[2], b[3]); *(GAS v4u*)(pb + i * 8) = o; }
    }
}

__device__ __forceinline__ void ln_row(f32x4 (&v)[4], const float* g, const float* b, int lane) {
    float s = 0.f;
#pragma unroll
    for (int j = 0; j < 4; ++j) s += (v[j][0] + v[j][1]) + (v[j][2] + v[j][3]);
    const float mean = wave_sum(s) * (1.f / D); float s2 = 0.f;
#pragma unroll
    for (int j = 0; j < 4; ++j) { v[j] = v[j] - mean; s2 += (v[j][0] * v[j][0] + v[j][1] * v[j][1]) + (v[j][2] * v[j][2] + v[j][3] * v[j][3]); }
    const float rstd = __builtin_amdgcn_rsqf(wave_sum(s2) * (1.f / D) + LN_EPS);
#pragma unroll
    for (int j = 0; j < 4; ++j) { const f32x4 gg = *(const f32x4*)(g + 4 * lane + 256 * j), bb = *(const f32x4*)(b + 4 * lane + 256 * j); v[j] = v[j] * rstd * gg + bb; }
}
__device__ __forceinline__ void store_row_f32(float* row, const f32x4 (&v)[4], int lane) {
#pragma unroll
    for (int j = 0; j < 4; ++j) *(GAS f32x4*)(row + 4 * lane + 256 * j) = v[j];
}
__device__ __forceinline__ void store_row_bf16(bf16* row, const f32x4 (&v)[4], int lane) {
#pragma unroll
    for (int j = 0; j < 4; ++j) { v2u o; o.x = pk2(v[j][0], v[j][1]); o.y = pk2(v[j][2], v[j][3]); *(GAS v2u*)(row + 4 * lane + 256 * j) = o; }
}
__device__ __forceinline__ void store_row_fp8x8(unsigned char* row, const f32x4 (&v)[4], int lane) {
#pragma unroll
    for (int j = 0; j < 4; ++j) *(GAS unsigned*)(row + 4 * lane + 256 * j) = pk4_fp8(v[j][0] * 8.f, v[j][1] * 8.f, v[j][2] * 8.f, v[j][3] * 8.f);
}
__device__ __forceinline__ f32x4 fp8x4_to_f32(unsigned w) {
    typedef float f2 __attribute__((ext_vector_type(2)));
    const f2 lo = __builtin_amdgcn_cvt_pk_f32_fp8((int)w, false), hi = __builtin_amdgcn_cvt_pk_f32_fp8((int)w, true);
    return (f32x4){lo[0], lo[1], hi[0], hi[1]};
}
__device__ __forceinline__ void load_row_bf16(f32x4 (&v)[4], const bf16* row, int lane) {
#pragma unroll
    for (int j = 0; j < 4; ++j) { const v2u w = *(const GAS v2u*)(row + 4 * lane + 256 * j); v[j] = (f32x4){bflo(w.x), bfhi(w.x), bflo(w.y), bfhi(w.y)}; }
}
__device__ __forceinline__ void load_row_f32(f32x4 (&v)[4], const float* row, int lane) {
#pragma unroll
    for (int j = 0; j < 4; ++j) v[j] = *(const GAS f32x4*)(row + 4 * lane + 256 * j);
}
#ifndef FEAT_MIX
#define FEAT_MIX 1
#endif
#ifndef FEAT_MOE
#define FEAT_MOE 1
#endif
#ifndef FEAT_PLE
#define FEAT_PLE 1
#endif
#ifndef FEAT_ATT
#define FEAT_ATT 1
#endif
#ifndef SYNC_MODE
#define SYNC_MODE 0
#endif
#ifndef PROGRAM
#define PROGRAM X(0) GS X(10) X(11) SY X(20) X(21) SY X(30) X(31) BS X(32) SY X(40) X(41) SY X(5) SY X(6) SY X(7) SY X(8) SY X(9) SY X(100) SY X(110) SY X(120)
#endif

typedef float f32x16 __attribute__((ext_vector_type(16)));
typedef short s16x4 __attribute__((ext_vector_type(4)));
__device__ __forceinline__ unsigned cvtpk(float lo, float hi) { typedef float f2 __attribute__((ext_vector_type(2))); typedef __bf16 b2 __attribute__((ext_vector_type(2))); f2 v = {lo, hi}; b2 b = __builtin_convertvector(v, b2); return __builtin_bit_cast(unsigned, b); }
__device__ __forceinline__ bf16x8 pack8(const f32x16& x, int base) {
    v4u w; w.x = cvtpk(x[base + 0], x[base + 1]); w.y = cvtpk(x[base + 2], x[base + 3]); w.z = cvtpk(x[base + 4], x[base + 5]); w.w = cvtpk(x[base + 6], x[base + 7]);
    return __builtin_bit_cast(bf16x8, w);
}

__device__ __forceinline__ void p2_post(const Params& P, const Ctx& C) {
    unsigned char* ws = P.ws;
    const bf16* H = (const bf16*)(ws + WS_H); bf16* CN = (bf16*)(ws + WS_CN); bf16* IKN = (bf16*)(ws + WS_IKN);
    const float* kvg = P.in[I_KVG]; const float* ikg = P.in[I_IKG]; const float* ikb = P.in[I_IKB];
    const f32x4 g4 = *(const f32x4*)(kvg + 4 * C.lane); const float ig = ikg[C.lane], ib = ikb[C.lane];
    for (int m = C.gw; m < NTOK; m += C.ngw) {
        const bf16* hr = H + (size_t)m * D_INP;
        const v2u w = *(const GAS v2u*)(hr + C_AC + 4 * C.lane);
        float a0 = bflo(w.x), a1 = bfhi(w.x), a2 = bflo(w.y), a3 = bfhi(w.y);
        const float ss = wave_sum((a0 * a0 + a1 * a1) + (a2 * a2 + a3 * a3));
        const float rs = __builtin_amdgcn_rsqf(ss * (1.f / 256.f) + RMS_EPS);
        v2u o; o.x = pk2(a0 * rs * g4[0], a1 * rs * g4[1]); o.y = pk2(a2 * rs * g4[2], a3 * rs * g4[3]);
        *(GAS v2u*)(CN + (size_t)m * 256 + 4 * C.lane) = o;
        const float k = bf2f(hr[C_IK + C.lane]);
        const float mu = wave_sum(k) * (1.f / 64.f); const float dk = k - mu;
        const float var = wave_sum(dk * dk) * (1.f / 64.f);
        IKN[(size_t)m * 64 + C.lane] = (bf16)f2bf(dk * __builtin_amdgcn_rsqf(var + LN_EPS) * ig + ib);
    }
}

constexpr int HP_QD = 0, HP_KI = 8704, HP_KET = 17408, HP_VT = 27648, HP_GS = 37888, HP_RAW = 40960;
__device__ __forceinline__ void p2_hgrn_prep(const Params& P, const Ctx& C) {
    unsigned char* ws = P.ws;
    const bf16* H = (const bf16*)(ws + WS_H);
    bf16* UT = (bf16*)(ws + WS_U); bf16* QDEC = (bf16*)(ws + WS_QDEC); float* OREC = (float*)(ws + WS_OREC); float* DEC = (float*)(ws + WS_DECAY);
    LAS bf16* QD = (LAS bf16*)(C.lds + HP_QD); LAS bf16* KI = (LAS bf16*)(C.lds + HP_KI); LAS bf16* KET = (LAS bf16*)(C.lds + HP_KET); LAS bf16* VT = (LAS bf16*)(C.lds + HP_VT);
    LAS float* GS = (LAS float*)(C.lds + HP_GS); LAS bf16* RAW = (LAS bf16*)(C.lds + HP_RAW);
    const int d = C.tid & 127, tg = C.tid >> 7;
    const int lane = C.lane, r32 = lane & 31, hf = lane >> 5;
    const int lc = C.tid >> 4, lg = C.tid & 15;
    const int NU = NB * HG_H * (T / HG_C);
    v4u rf, rq, ri;
    { const int unit = blockIdx.x; if (unit < NU) { const int n = unit & 127, hh = (unit >> 7) & 3, b = unit >> 9; const bf16* hr = H + (size_t)(b * T + n * HG_C + lc) * D_INP + hh * 128 + 8 * lg;
        rf = *(const GAS v4u*)(hr + C_GF); rq = *(const GAS v4u*)(hr + C_GQ); ri = *(const GAS v4u*)(hr + C_GI); } }
    for (int unit = blockIdx.x; unit < NU; unit += C.G) {
        const int n = unit & 127, hh = (unit >> 7) & 3, b = unit >> 9;
        const int m0 = b * T + n * HG_C;
        *(LAS v4u*)(RAW + lc * 128 + 8 * lg) = rf; *(LAS v4u*)(RAW + 4096 + lc * 128 + 8 * lg) = rq; *(LAS v4u*)(RAW + 8192 + lc * 128 + 8 * lg) = ri;
        __syncthreads();
        { const int un = unit + C.G; if (un < NU) { const int n2 = un & 127, h2 = (un >> 7) & 3, b2 = un >> 9; const bf16* hr = H + (size_t)(b2 * T + n2 * HG_C + lc) * D_INP + h2 * 128 + 8 * lg;
            rf = *(const GAS v4u*)(hr + C_GF); rq = *(const GAS v4u*)(hr + C_GQ); ri = *(const GAS v4u*)(hr + C_GI); } }
        const float l0 = P.in[I_HGLB][hh * 128 + d], l1 = P.in[I_HGLB][512 + hh * 128 + d];
        const float lb = sigmoidf_(l0 - l1);
        float fg[8], bl[8], qv[8]; float run = 0.f; unsigned vv[4];
#pragma unroll
        for (int c = 0; c < 8; ++c) { const int tok = tg * 8 + c;
            const float f = bf2f(RAW[tok * 128 + d]), q = bf2f(RAW[4096 + tok * 128 + d]); const unsigned iv = RAW[8192 + tok * 128 + d];
            fg[c] = lb + (1.f - lb) * sigmoidf_(f); run += __logf(fg[c]); bl[c] = run; qv[c] = q * sigmoidf_(q);
            if (c & 1) vv[c >> 1] |= iv << 16; else vv[c >> 1] = iv; }
        GS[tg * 128 + d] = run;
        *(LAS v4u*)(VT + d * 40 + tg * 8) = (v4u){vv[0], vv[1], vv[2], vv[3]};
        __syncthreads();
        float pre = 0.f, tot = 0.f;
#pragma unroll
        for (int g = 0; g < 4; ++g) { const float sg = GS[g * 128 + d]; tot += sg; if (g < tg) pre += sg; }
        unsigned ke[4];
#pragma unroll
        for (int c = 0; c < 8; ++c) { const float bc = pre + bl[c]; const float kc = 1.f - fg[c];
            const float qd = qv[c] * __expf(bc), ki = kc * __expf(-bc), kend = kc * __expf(tot - bc);
            const unsigned qb = f2bf(qd);
            QD[(tg * 8 + c) * 136 + d] = (bf16)qb; KI[(tg * 8 + c) * 136 + d] = (bf16)f2bf(ki);
            if (c & 1) ke[c >> 1] |= f2bf(kend) << 16; else ke[c >> 1] = f2bf(kend); }
        *(LAS v4u*)(KET + d * 40 + tg * 8) = (v4u){ke[0], ke[1], ke[2], ke[3]};
        if (tg == 0) DEC[(size_t)unit * 128 + d] = __expf(tot);
        __syncthreads();
        *(GAS v4u*)(QDEC + (size_t)(m0 + lc) * 512 + hh * 128 + 8 * lg) = *(const LAS v4u*)(QD + lc * 136 + 8 * lg);
        if (C.wave < 4) {
            f32x16 X = {0.f, 0.f, 0.f, 0.f, 0.f, 0.f, 0.f, 0.f, 0.f, 0.f, 0.f, 0.f, 0.f, 0.f, 0.f, 0.f};
#pragma unroll
            for (int k = 0; k < 8; ++k) { const bf16x8 a = *(const LAS bf16x8*)(KI + r32 * 136 + 16 * k + 8 * hf), bq = *(const LAS bf16x8*)(QD + r32 * 136 + 16 * k + 8 * hf);
                X = __builtin_amdgcn_mfma_f32_32x32x16_bf16(a, bq, X, 0, 0, 0); }
#pragma unroll
            for (int r = 0; r < 16; ++r) { const int sidx = (r & 3) + 8 * (r >> 2) + 4 * hf; if (sidx > r32) X[r] = 0.f; }
            f32x16 Z = {0.f, 0.f, 0.f, 0.f, 0.f, 0.f, 0.f, 0.f, 0.f, 0.f, 0.f, 0.f, 0.f, 0.f, 0.f, 0.f};
            const int e = C.wave * 32 + r32;
#pragma unroll
            for (int sp = 0; sp < 2; ++sp) { const bf16x8 a = pack8(X, 8 * sp);
                const s16x4 lo = *(const LAS s16x4*)(VT + e * 40 + 16 * sp + 4 * hf), hi = *(const LAS s16x4*)(VT + e * 40 + 16 * sp + 8 + 4 * hf);
                const bf16x8 bv = (bf16x8){lo[0], lo[1], lo[2], lo[3], hi[0], hi[1], hi[2], hi[3]};
                Z = __builtin_amdgcn_mfma_f32_32x32x16_bf16(a, bv, Z, 0, 0, 0); }
#pragma unroll
            for (int r = 0; r < 16; ++r) { const int c = (r & 3) + 8 * (r >> 2) + 4 * hf; OREC[(size_t)(m0 + c) * 512 + hh * 128 + e] = Z[r]; }
        }
        {
            const int dt = C.wave >> 1;
            const bf16x8 a0 = *(const LAS bf16x8*)(KET + (dt * 32 + r32) * 40 + 8 * hf), a1 = *(const LAS bf16x8*)(KET + (dt * 32 + r32) * 40 + 16 + 8 * hf);
#pragma unroll
            for (int ei = 0; ei < 2; ++ei) { const int et = 2 * (C.wave & 1) + ei;
                const bf16x8 b0 = *(const LAS bf16x8*)(VT + (et * 32 + r32) * 40 + 8 * hf), b1 = *(const LAS bf16x8*)(VT + (et * 32 + r32) * 40 + 16 + 8 * hf);
                f32x16 U = {0.f, 0.f, 0.f, 0.f, 0.f, 0.f, 0.f, 0.f, 0.f, 0.f, 0.f, 0.f, 0.f, 0.f, 0.f, 0.f};
                U = __builtin_amdgcn_mfma_f32_32x32x16_bf16(a0, b0, U, 0, 0, 0); U = __builtin_amdgcn_mfma_f32_32x32x16_bf16(a1, b1, U, 0, 0, 0);
                bf16* up = UT + (size_t)unit * 16384 + (size_t)(et * 32 + r32) * 128 + dt * 32 + 4 * hf;
#pragma unroll
                for (int q = 0; q < 4; ++q) { v2u o; o.x = cvtpk(U[4 * q], U[4 * q + 1]); o.y = cvtpk(U[4 * q + 2], U[4 * q + 3]); *(GAS v2u*)(up + 8 * q) = o; } }
        }
        __syncthreads();
    }
}

__device__ __forceinline__ void scan_wave(const Params& P, LAS unsigned char* lds, int unit, int lane) {
    unsigned char* ws = P.ws;
    const bf16* UT = (const bf16*)(ws + WS_U); const bf16* QDEC = (const bf16*)(ws + WS_QDEC); float* OREC = (float*)(ws + WS_OREC); const float* DEC = (const float*)(ws + WS_DECAY);
    typedef float f32x4v __attribute__((ext_vector_type(4)));
    const int xcd = (unit >> 1) & 7, loc = ((unit >> 4) << 1) | (unit & 1);
    const int bh = xcd + 8 * (loc >> 4), sl = loc & 15; const int b = bh >> 2, hh = bh & 3, e0 = 8 * sl;
    LAS bf16* ST = (LAS bf16*)lds;
    const int e = lane & 7, dq = lane >> 3;
    const int fr = lane & 15, fq = lane >> 4;
    float S[16];
#pragma unroll
    for (int i = 0; i < 16; ++i) S[i] = 0.f;
    for (int i = lane; i < 2 * 16 * 136 / 8; i += 64) *(LAS v4u*)(ST + 8 * i) = (v4u){0u, 0u, 0u, 0u};
    const int cu0 = (b * HG_H + hh) * 128;
    const bf16* up = UT + (size_t)cu0 * 16384 + (size_t)(e0 + e) * 128 + 16 * dq;
    const float* dp = DEC + (size_t)cu0 * 128 + 16 * dq;
    const bf16* qp = QDEC + (size_t)(b * T + fr) * 512 + hh * 128 + 8 * fq;
    float* op = OREC + (size_t)(b * T + 4 * fq) * 512 + hh * 128 + e0 + fr;
    const float* opl = OREC + (size_t)(b * T + 4 * fq) * 512 + hh * 128 + e0 + (fr & 7);
    const bool ov = fr < 8;
    v4u un[4][2]; float oi[4][2][4]; f32x4 dn[2][4]; bf16x8 qa[2][2][4];
#define SC_LD_U(slot, n) { un[slot][0] = *(const GAS v4u*)(up + (size_t)(n) * 16384); un[slot][1] = *(const GAS v4u*)(up + (size_t)(n) * 16384 + 8); \
        _Pragma("unroll") for (int t_ = 0; t_ < 2; ++t_) _Pragma("unroll") for (int j_ = 0; j_ < 4; ++j_) oi[slot][t_][j_] = opl[(size_t)((n) * 32 + 16 * t_ + j_) * 512]; }
#define SC_LD_Q(slot, n) { _Pragma("unroll") for (int i_ = 0; i_ < 4; ++i_) dn[slot][i_] = *(const GAS f32x4*)(dp + (size_t)(n) * 128 + 4 * i_); \
        _Pragma("unroll") for (int t_ = 0; t_ < 2; ++t_) _Pragma("unroll") for (int k_ = 0; k_ < 4; ++k_) qa[slot][t_][k_] = *(const GAS bf16x8*)(qp + (size_t)((n) * 32 + 16 * t_) * 512 + 32 * k_); }
    SC_LD_U(0, 0) SC_LD_U(1, 1) SC_LD_U(2, 2) SC_LD_U(3, 3) SC_LD_Q(0, 0) SC_LD_Q(1, 1)
    LDS_WAIT();
    for (int nb = 0; nb < 32; ++nb) {
#pragma unroll
        for (int s = 0; s < 4; ++s) {
            const int n = 4 * nb + s; const int su = s, sq = s & 1;
            const LAS bf16* stc = ST + (n & 1) * (16 * 136); LAS bf16* stn = ST + ((n + 1) & 1) * (16 * 136);
            bf16x8 bs[4];
#pragma unroll
            for (int k = 0; k < 4; ++k) bs[k] = *(const LAS bf16x8*)(stc + fr * 136 + 32 * k + 8 * fq);
#pragma unroll
            for (int t = 0; t < 2; ++t) { f32x4v acc = {oi[su][t][0], oi[su][t][1], oi[su][t][2], oi[su][t][3]};
#pragma unroll
                for (int k = 0; k < 4; ++k) acc = __builtin_amdgcn_mfma_f32_16x16x32_bf16(qa[sq][t][k], bs[k], acc, 0, 0, 0);
                if (ov) {
#pragma unroll
                    for (int j = 0; j < 4; ++j) op[(size_t)(n * 32 + 16 * t + j) * 512] = acc[j]; } }
            {
                const unsigned uw[8] = {un[su][0].x, un[su][0].y, un[su][0].z, un[su][0].w, un[su][1].x, un[su][1].y, un[su][1].z, un[su][1].w};
                unsigned pk[8];
#pragma unroll
                for (int i = 0; i < 8; ++i) { S[2 * i] = dn[sq][i >> 1][(2 * i) & 3] * S[2 * i] + bflo(uw[i]); S[2 * i + 1] = dn[sq][i >> 1][(2 * i + 1) & 3] * S[2 * i + 1] + bfhi(uw[i]); pk[i] = cvtpk(S[2 * i], S[2 * i + 1]); }
                *(LAS v4u*)(stn + e * 136 + 16 * dq) = (v4u){pk[0], pk[1], pk[2], pk[3]}; *(LAS v4u*)(stn + e * 136 + 16 * dq + 8) = (v4u){pk[4], pk[5], pk[6], pk[7]};
            }
            if (n + 4 < 128) SC_LD_U(su, n + 4)
            if (n + 2 < 128) SC_LD_Q(sq, n + 2)
        }
    }
#undef SC_LD_U
#undef SC_LD_Q
}
__device__ __forceinline__ void p3_scan_convert(const Params& P, const Ctx& C) {
    if (C.wave < 2) {
        for (int u = blockIdx.x * 2 + C.wave; u < NB * HG_H * 16; u += C.G * 2) scan_wave(P, C.lds + C.wave * 8704, u, C.lane);
    } else {
        convert_late(P, (LAS float*)(C.lds + 32768 + (C.wave - 2) * 17408), blockIdx.x * 6 + (C.wave - 2), C.G * 6, C.lane);
    }
}

__device__ __forceinline__ void p4_yrec(const Params& P, const Ctx& C) {
    unsigned char* ws = P.ws;
    const float* OREC = (const float*)(ws + WS_OREC); const bf16* H = (const bf16*)(ws + WS_H); bf16* YM = (bf16*)(ws + WS_YMIX);
    const float* ng = P.in[I_HGNG];
    const f32x4 g0 = *(const f32x4*)(ng + 8 * C.lane), g1 = *(const f32x4*)(ng + 8 * C.lane + 4);
    for (int m = C.gw; m < NTOK; m += C.ngw) {
        const f32x4 a = *(const GAS f32x4*)(OREC + (size_t)m * 512 + 8 * C.lane), bq = *(const GAS f32x4*)(OREC + (size_t)m * 512 + 8 * C.lane + 4);
        float ss = (a[0] * a[0] + a[1] * a[1]) + (a[2] * a[2] + a[3] * a[3]) + (bq[0] * bq[0] + bq[1] * bq[1]) + (bq[2] * bq[2] + bq[3] * bq[3]);
        ss += __shfl_xor(ss, 1); ss += __shfl_xor(ss, 2); ss += __shfl_xor(ss, 4); ss += __shfl_xor(ss, 8);
        const float rs = __builtin_amdgcn_rsqf(ss * (1.f / 128.f) + RMS_EPS);
        const v4u gw = *(const GAS v4u*)(H + (size_t)m * D_INP + C_GG + 8 * C.lane);
        float gv[8] = {bflo(gw.x), bfhi(gw.x), bflo(gw.y), bfhi(gw.y), bflo(gw.z), bfhi(gw.z), bflo(gw.w), bfhi(gw.w)};
        float o[8];
#pragma unroll
        for (int j = 0; j < 4; ++j) { o[j] = a[j] * rs * g0[j] * (gv[j] * sigmoidf_(gv[j])); o[4 + j] = bq[j] * rs * g1[j] * (gv[4 + j] * sigmoidf_(gv[4 + j])); }
        v2u w; w.x = pk4_fp8(o[0] * 8.f, o[1] * 8.f, o[2] * 8.f, o[3] * 8.f); w.y = pk4_fp8(o[4] * 8.f, o[5] * 8.f, o[6] * 8.f, o[7] * 8.f);
        *(GAS v2u*)((unsigned char*)YM + (size_t)m * D + 512 + 8 * C.lane) = w;
#if !FEAT_ATT
        *(GAS v4u*)(YM + (size_t)m * D + 8 * C.lane) = (v4u){0u, 0u, 0u, 0u};
#endif
    }
}

namespace pg8 {
struct EpiKhead {
    static constexpr bool PERM = true, AFTER_DRAIN = false;
    bf16_t* O;
    __device__ __forceinline__ void operator()(const f32x4 (&acc)[2][2][4][2], const Unit& u, int wr, int wc, int fr, int fq) const {
        const int row0 = u.pm * BM + wr * 64 + fr, col0 = u.pn * BM + wc * 32 + 8 * fq;
#pragma unroll
        for (int ai = 0; ai < 2; ++ai)
#pragma unroll
            for (int m = 0; m < 4; ++m) { const int row = row0 + ai * HALF + m * 16; const int b = row >> 12, t = row & 4095;
#pragma unroll
                for (int bj = 0; bj < 2; ++bj) { const int col = col0 + bj * HALF; const f32x4 v0 = acc[ai][bj][m][0], v1 = acc[ai][bj][m][1];
                    u32x4 w; w.x = cvt_pk_bf16(v0[0], v0[1]); w.y = cvt_pk_bf16(v0[2], v0[3]); w.z = cvt_pk_bf16(v1[0], v1[1]); w.w = cvt_pk_bf16(v1[2], v1[3]);
                    *(u32x4*)(O + ((size_t)((b * 8 + (col >> 6)) * 4096 + t)) * 64 + (col & 63)) = w; } }
    }
};
struct EpiVt {
    static constexpr bool PERM = true, AFTER_DRAIN = false;
    bf16_t* O;
    __device__ __forceinline__ void operator()(const f32x4 (&acc)[2][2][4][2], const Unit& u, int wr, int wc, int fr, int fq) const {
        const int row0 = u.pm * BM + wr * 64 + fr, col0 = u.pn * BM + wc * 32 + 8 * fq;
#pragma unroll
        for (int ai = 0; ai < 2; ++ai)
#pragma unroll
            for (int m = 0; m < 4; ++m) { const int row = row0 + ai * HALF + m * 16;
#pragma unroll
                for (int bj = 0; bj < 2; ++bj) { const int col = col0 + bj * HALF; const int b = col >> 12, t = col & 4095; const f32x4 v0 = acc[ai][bj][m][0], v1 = acc[ai][bj][m][1];
                    u32x4 w; w.x = cvt_pk_bf16(v0[0], v0[1]); w.y = cvt_pk_bf16(v0[2], v0[3]); w.z = cvt_pk_bf16(v1[0], v1[1]); w.w = cvt_pk_bf16(v1[2], v1[3]);
                    *(u32x4*)(O + ((size_t)(b * 512 + row)) * 4096 + t) = w; } }
    }
};
}

__device__ __forceinline__ unsigned f2ord(float x) { const unsigned b = __builtin_bit_cast(unsigned, x); return b ^ ((unsigned)((int)b >> 31) | 0x80000000u); }
typedef _Float16 h16;
typedef _Float16 h16x8 __attribute__((ext_vector_type(8)));
__device__ __forceinline__ float relu_i(float x) { const int b = __builtin_bit_cast(int, x); return __builtin_bit_cast(float, b > 0 ? b : 0); }
__device__ __forceinline__ unsigned h2ord(unsigned hb) { return (hb ^ ((hb & 0x8000u) ? 0xffffu : 0x8000u)) & 0xffffu; }
__device__ __forceinline__ int isc_bucket(float x, float mu, float scale) { const float t = fminf(fmaxf(fmaf(x - mu, scale, 128.f), 0.f), 255.f); return (int)t; }
__device__ __forceinline__ void p3_indexer(const Params& P, const Ctx& C) {
    unsigned char* ws = P.ws;
    const bf16* H = (const bf16*)(ws + WS_H); const bf16* IKN = (const bf16*)(ws + WS_IKN); unsigned* MASK = (unsigned*)(ws + WS_MASK);
    LAS h16* ISC = (LAS h16*)C.lds; LAS unsigned* HIST = (LAS unsigned*)(C.lds + 131072) + C.wave * 256; LAS float* STAT = (LAS float*)(C.lds + 139264); LAS float* W16 = (LAS float*)(C.lds + 140288);
    const int lane = C.lane, r32 = lane & 31, hf = lane >> 5;
    const int ql = 2 * (r32 >> 4) + ((r32 >> 2) & 1), hd = 4 * ((r32 >> 3) & 1) + (r32 & 3);
    constexpr int CAND_CAP = 120, QU = 16;
    for (int u = blockIdx.x; u < NTOK / QU; u += C.G) {
        const int b = u & 7, j = (u >> 3) & 31, i = u >> 8; const int pi = i >> 1; const int blk = (i & 1) ? (255 - (j + 32 * pi)) : (j + 32 * pi);
        const int t0 = blk * QU; const size_t mb = (size_t)b * T;
        const int nkt = (t0 + QU + 31) >> 5;
        bf16x8 af[4][4];
#pragma unroll
        for (int a = 0; a < 4; ++a) {
            const bf16* qp = H + (mb + t0 + 4 * a + ql) * D_INP + C_IQ + hd * 64 + 8 * hf;
#pragma unroll
            for (int k = 0; k < 4; ++k) af[a][k] = *(const GAS bf16x8*)(qp + 16 * k);
        }
        if (C.tid < 128) { const int q = C.tid >> 3, h8 = C.tid & 7; W16[C.tid] = bf2f(H[(mb + t0 + q) * D_INP + C_IW + h8]) * (0.125f * 0.35355339059327373f); }
        __syncthreads();
        {
            int kt = C.wave; bf16x8 bk[4], bn[4];
            if (kt < nkt) { const bf16* kp = IKN + (mb + kt * 32 + r32) * 64 + 8 * hf;
#pragma unroll
                for (int k = 0; k < 4; ++k) bk[k] = *(const GAS bf16x8*)(kp + 16 * k); }
            for (; kt < nkt; kt += NWAVES) {
                const int s0 = kt * 32;
                if (kt + NWAVES < nkt) { const bf16* kp = IKN + (mb + s0 + 32 * NWAVES + r32) * 64 + 8 * hf;
#pragma unroll
                    for (int k = 0; k < 4; ++k) bn[k] = *(const GAS bf16x8*)(kp + 16 * k); }
#pragma unroll
                for (int a = 0; a < 4; ++a) {
                    f32x16 acc = {0.f, 0.f, 0.f, 0.f, 0.f, 0.f, 0.f, 0.f, 0.f, 0.f, 0.f, 0.f, 0.f, 0.f, 0.f, 0.f};
#pragma unroll
                    for (int k = 0; k < 4; ++k) acc = __builtin_amdgcn_mfma_f32_32x32x16_bf16(af[a][k], bk[k], acc, 0, 0, 0);
#pragma unroll
                    for (int qh = 0; qh < 2; ++qh) { float sa = 0.f, sb = 0.f;
                        const int q = 4 * a + 2 * qh + hf, key = s0 + r32;
                        const f32x4 wl = *(const LAS f32x4*)(W16 + q * 8), wh = *(const LAS f32x4*)(W16 + q * 8 + 4);
                        sa = fmaf(wl[0], relu_i(acc[8 * qh + 0]), sa); sb = fmaf(wl[1], relu_i(acc[8 * qh + 1]), sb); sa = fmaf(wl[2], relu_i(acc[8 * qh + 2]), sa); sb = fmaf(wl[3], relu_i(acc[8 * qh + 3]), sb);
                        sa = fmaf(wh[0], relu_i(acc[8 * qh + 4]), sa); sb = fmaf(wh[1], relu_i(acc[8 * qh + 5]), sb); sa = fmaf(wh[2], relu_i(acc[8 * qh + 6]), sa); sb = fmaf(wh[3], relu_i(acc[8 * qh + 7]), sb);
                        float sv = sa + sb; const bool valid = key <= t0 + q; sv += 0.0f;
                        ISC[q * 4096 + key] = valid ? (h16)sv : (h16)(-INFINITY);
                    }
                }
#pragma unroll
                for (int k = 0; k < 4; ++k) bk[k] = bn[k];
            }
        }
        __syncthreads();
        for (int q = C.wave; q < QU; q += NWAVES) {
            const int t = t0 + q, n = t + 1; const LAS unsigned short* row = (const LAS unsigned short*)(ISC + q * 4096);
            unsigned* mrow = MASK + (mb + t) * 128;
            if (n <= TOPK) {
#pragma unroll
                for (int w2 = 0; w2 < 2; ++w2) { const int wi = lane + 64 * w2; const int lo = 32 * wi; unsigned bits;
                    if (lo + 31 <= t) bits = 0xffffffffu; else if (lo > t) bits = 0u; else bits = (1u << (t - lo + 1)) - 1u;
                    mrow[wi] = bits; }
            } else {
                unsigned dhi = 0u; int need = TOPK;
#pragma unroll
                for (int pass = 1; pass >= 0; --pass) {
                    LDS_WAIT();
#pragma unroll
                    for (int z = 0; z < 4; ++z) HIST[lane + 64 * z] = 0u;
#pragma unroll 2
                    for (int e0 = 8 * lane; e0 < n; e0 += 512) { const v4u v = *(const LAS v4u*)(row + e0);
#pragma unroll
                        for (int jj = 0; jj < 8; ++jj) { const unsigned w = (jj < 2) ? v.x : (jj < 4) ? v.y : (jj < 6) ? v.z : v.w; const unsigned hb = (jj & 1) ? (w >> 16) : (w & 0xffffu);
                            const unsigned key = h2ord(hb);
                            const bool ok = (e0 + jj < n) && (pass == 1 || (key >> 8) == dhi);
                            if (ok) atomicAdd((unsigned*)&HIST[pass == 1 ? (key >> 8) : (key & 255u)], 1u); } }
                    LDS_WAIT();
                    const v4u c4 = *(const LAS v4u*)(HIST + 4 * lane);
                    const unsigned c0 = c4.x, c1 = c4.y, c2 = c4.z, c3 = c4.w; const unsigned s4 = c0 + c1 + c2 + c3;
                    unsigned suf = s4;
#pragma unroll
                    for (int o = 1; o < 64; o <<= 1) { const unsigned v2 = __shfl_down(suf, o); if (lane + o < 64) suf += v2; }
                    unsigned cum = suf - s4; int dsel = -1; int nnew = 0; const unsigned nd = (unsigned)need;
                    if (cum < nd && nd <= cum + c3) { dsel = 4 * lane + 3; nnew = (int)(nd - cum); } cum += c3;
                    if (dsel < 0 && cum < nd && nd <= cum + c2) { dsel = 4 * lane + 2; nnew = (int)(nd - cum); } cum += c2;
                    if (dsel < 0 && cum < nd && nd <= cum + c1) { dsel = 4 * lane + 1; nnew = (int)(nd - cum); } cum += c1;
                    if (dsel < 0 && cum < nd && nd <= cum + c0) { dsel = 4 * lane + 0; nnew = (int)(nd - cum); }
                    const unsigned long long bal = __ballot(dsel >= 0);
                    const int src = (bal != 0ull) ? (int)__builtin_ctzll(bal) : 0;
                    const int dd = __shfl(dsel, src); need = __shfl(nnew, src);
                    if (pass == 1) dhi = (unsigned)dd; else dhi = (dhi << 8) | (unsigned)dd;
                }
                const unsigned Tk = dhi;
                int run_eq = 0; unsigned long long mine = 0ull; const int nit = (t >> 6) + 1;
#pragma unroll 4
                for (int it = 0; it < nit; ++it) { const int e = it * 64 + lane; const unsigned key = h2ord(row[e]); const bool valid = e <= t;
                    const bool eq = valid && (key == Tk); const unsigned long long beq = __ballot(eq);
                    const int rk = run_eq + __builtin_popcountll(beq & ((1ull << lane) - 1ull));
                    const bool sel = valid && ((key > Tk) || (eq && rk < need)); run_eq += __builtin_popcountll(beq);
                    const unsigned long long bs = __ballot(sel);
                    if (lane == it) mine = bs; }
                *(GAS v2u*)(mrow + 2 * lane) = (v2u){(unsigned)mine, (unsigned)(mine >> 32)};
            }
        }
        __syncthreads();
    }
}

__device__ __forceinline__ void attn_task(const bf16* H, const bf16* KH, const bf16* VT, const unsigned* MASK, bf16* YM, int b, int hh, int t0, int lane) {
    const int r32 = lane & 31, hf = lane >> 5;
    const float LOG2E = 1.4426950408889634f; const float c1 = 0.125f * LOG2E; const float sl2 = exp2f(-(float)(hh + 1)) * LOG2E;
    const size_t mb = (size_t)b * T;
    bf16x8 qf[4];
#pragma unroll
    for (int k = 0; k < 4; ++k) qf[k] = *(const GAS bf16x8*)(H + (mb + t0 + r32) * D_INP + C_AQ + hh * 64 + 16 * k + 8 * hf);
    const bf16* kbase = KH + ((size_t)(b * 8 + hh) * T) * 64; const bf16* vbase = VT + ((size_t)(b * 512 + hh * 64)) * T; const unsigned* mrow = MASK + (mb + t0 + r32) * 128;
    float m_run = -1e30f, l = 0.f;
    f32x16 O0 = {0.f, 0.f, 0.f, 0.f, 0.f, 0.f, 0.f, 0.f, 0.f, 0.f, 0.f, 0.f, 0.f, 0.f, 0.f, 0.f}, O1 = O0;
    const int nkt = (t0 + 32 + 63) >> 6;
    for (int kt = 0; kt < nkt; ++kt) {
        const int s0 = kt * 64;
        bf16x8 kf[2][4];
#pragma unroll
        for (int uu = 0; uu < 2; ++uu)
#pragma unroll
            for (int k = 0; k < 4; ++k) kf[uu][k] = *(const GAS bf16x8*)(kbase + (size_t)(s0 + 32 * uu + r32) * 64 + 16 * k + 8 * hf);
        const v2u mw = *(const GAS v2u*)(mrow + 2 * kt);
        s16x4 vl[2][2][2], vh[2][2][2];
#pragma unroll
        for (int uu = 0; uu < 2; ++uu)
#pragma unroll
            for (int sp = 0; sp < 2; ++sp)
#pragma unroll
                for (int dt = 0; dt < 2; ++dt) { const bf16* vp = vbase + (size_t)(dt * 32 + r32) * T + s0 + 32 * uu + 16 * sp + 4 * hf;
                    vl[uu][sp][dt] = *(const GAS s16x4*)vp; vh[uu][sp][dt] = *(const GAS s16x4*)(vp + 8); }
        f32x16 a0 = {0.f, 0.f, 0.f, 0.f, 0.f, 0.f, 0.f, 0.f, 0.f, 0.f, 0.f, 0.f, 0.f, 0.f, 0.f, 0.f}, a1 = a0;
#pragma unroll
        for (int k = 0; k < 4; ++k) { a0 = __builtin_amdgcn_mfma_f32_32x32x16_bf16(kf[0][k], qf[k], a0, 0, 0, 0); a1 = __builtin_amdgcn_mfma_f32_32x32x16_bf16(kf[1][k], qf[k], a1, 0, 0, 0); }
        const float dist0 = (float)(t0 + r32 - s0 - 4 * hf);
        const unsigned m0 = mw.x >> (4 * hf), m1 = mw.y >> (4 * hf);
        float mx = -1e30f;
#pragma unroll
        for (int r = 0; r < 16; ++r) { const int ko = (r & 3) + 8 * (r >> 2);
            const float d0 = dist0 - (float)ko;
            a0[r] = ((m0 >> ko) & 1u) ? (a0[r] * c1 - sl2 * d0) : -1e30f;
            a1[r] = ((m1 >> ko) & 1u) ? (a1[r] * c1 - sl2 * (d0 - 32.f)) : -1e30f;
            mx = fmaxf(mx, fmaxf(a0[r], a1[r])); }
        mx = fmaxf(mx, __shfl_xor(mx, 32));
        const float m_new = fmaxf(m_run, mx); const float alpha = __builtin_amdgcn_exp2f(m_run - m_new); m_run = m_new;
        float ps = 0.f;
#pragma unroll
        for (int r = 0; r < 16; ++r) { const int ko = (r & 3) + 8 * (r >> 2);
            const float p0 = ((m0 >> ko) & 1u) ? __builtin_amdgcn_exp2f(a0[r] - m_new) : 0.f;
            const float p1 = ((m1 >> ko) & 1u) ? __builtin_amdgcn_exp2f(a1[r] - m_new) : 0.f;
            a0[r] = p0; a1[r] = p1; ps += p0 + p1; }
        l = l * alpha + ps;
#pragma unroll
        for (int r = 0; r < 16; ++r) { O0[r] *= alpha; O1[r] *= alpha; }
#pragma unroll
        for (int sp = 0; sp < 2; ++sp) {
            const bf16x8 pb0 = pack8(a0, 8 * sp), pb1 = pack8(a1, 8 * sp);
#define VFR(uu, dt) ((bf16x8){vl[uu][sp][dt][0], vl[uu][sp][dt][1], vl[uu][sp][dt][2], vl[uu][sp][dt][3], vh[uu][sp][dt][0], vh[uu][sp][dt][1], vh[uu][sp][dt][2], vh[uu][sp][dt][3]})
            O0 = __builtin_amdgcn_mfma_f32_32x32x16_bf16(VFR(0, 0), pb0, O0, 0, 0, 0);
            O1 = __builtin_amdgcn_mfma_f32_32x32x16_bf16(VFR(0, 1), pb0, O1, 0, 0, 0);
            O0 = __builtin_amdgcn_mfma_f32_32x32x16_bf16(VFR(1, 0), pb1, O0, 0, 0, 0);
            O1 = __builtin_amdgcn_mfma_f32_32x32x16_bf16(VFR(1, 1), pb1, O1, 0, 0, 0);
#undef VFR
        }
    }
    l += __shfl_xor(l, 32);
    const float inv = 1.f / l;
    bf16* yp = YM + (mb + t0 + r32) * D + hh * 64 + 4 * hf;
#pragma unroll
    for (int rq = 0; rq < 4; ++rq) {
        v2u o; o.x = cvtpk(O0[4 * rq] * inv, O0[4 * rq + 1] * inv); o.y = cvtpk(O0[4 * rq + 2] * inv, O0[4 * rq + 3] * inv); *(GAS v2u*)(yp + 8 * rq) = o;
        v2u o2; o2.x = cvtpk(O1[4 * rq] * inv, O1[4 * rq + 1] * inv); o2.y = cvtpk(O1[4 * rq + 2] * inv, O1[4 * rq + 3] * inv); *(GAS v2u*)(yp + 32 + 8 * rq) = o2; }
}
__device__ __forceinline__ void p4_attention(const Params& P, const Ctx& C) {
    unsigned char* ws = P.ws;
    const bf16* H = (const bf16*)(ws + WS_H); const bf16* KH = (const bf16*)(ws + WS_K); const bf16* VT = (const bf16*)(ws + WS_VT); const unsigned* MASK = (const unsigned*)(ws + WS_MASK); bf16* YM = (bf16*)(ws + WS_YMIX);
    for (int p = blockIdx.x; p < 512; p += C.G) {
        const int bh = p >> 3, j = p & 7; const int b = bh >> 3, hh = bh & 7;
        attn_task(H, KH, VT, MASK, YM, b, hh, j * 256 + C.wave * 32, C.lane);
        attn_task(H, KH, VT, MASK, YM, b, hh, (15 - j) * 256 + (7 - C.wave) * 32, C.lane);
    }
}

constexpr int AT_KB = 64 * 144, AT_VB = 64 * 136, AT_VOFF = 2 * AT_KB;
__device__ __forceinline__ void attn_block(const Ctx& C, const bf16* H, const bf16* KH, const bf16* VT, const unsigned* MASK, bf16* YM, int b, int hh, int qb) {
    const int lane = C.lane, r32 = lane & 31, hf = lane >> 5, tid = C.tid;
    const float LOG2E = 1.4426950408889634f; const float c1 = 0.125f * LOG2E; const float sl2 = exp2f(-(float)(hh + 1)) * LOG2E;
    const size_t mb = (size_t)b * T; const int t0 = qb * 256 + C.wave * 32;
    bf16x8 qf[4];
#pragma unroll
    for (int k = 0; k < 4; ++k) { const v4u w = *(const GAS v4u*)(H + (mb + t0 + r32) * D_INP + C_AQ + hh * 64 + 16 * k + 8 * hf);
        v4u o; o.x = cvtpk(bflo(w.x) * c1, bfhi(w.x) * c1); o.y = cvtpk(bflo(w.y) * c1, bfhi(w.y) * c1); o.z = cvtpk(bflo(w.z) * c1, bfhi(w.z) * c1); o.w = cvtpk(bflo(w.w) * c1, bfhi(w.w) * c1);
        qf[k] = __builtin_bit_cast(bf16x8, o); }
    const bf16* kbase = KH + ((size_t)(b * 8 + hh) * T) * 64; const bf16* vbase = VT + ((size_t)(b * 512 + hh * 64)) * T; const unsigned* mrow = MASK + (mb + t0 + r32) * 128;
    const int srow = tid >> 3, sch = tid & 7;
    const bf16* kst = kbase + (size_t)srow * 64 + 8 * sch; const bf16* vst = vbase + (size_t)srow * T + 8 * sch;
    LAS unsigned char* kw = C.lds + srow * 144 + 16 * sch; LAS unsigned char* vw = C.lds + AT_VOFF + srow * 136 + 16 * sch;
    const LAS unsigned char* kr = C.lds + r32 * 144 + 16 * hf; const LAS unsigned char* vr = C.lds + AT_VOFF + r32 * 136 + 8 * hf;
    float m_run = -1e30f, l = 0.f;
    f32x16 O0 = {0.f, 0.f, 0.f, 0.f, 0.f, 0.f, 0.f, 0.f, 0.f, 0.f, 0.f, 0.f, 0.f, 0.f, 0.f, 0.f}, O1 = O0;
    const int nkt = 4 * (qb + 1), ktw = (t0 + 31) >> 6;
    v4u kn = *(const GAS v4u*)kst, vn = *(const GAS v4u*)vst; v2u mwn = *(const GAS v2u*)mrow;
    *(LAS v4u*)kw = kn; *(LAS v2u*)vw = (v2u){vn.x, vn.y}; *(LAS v2u*)(vw + 8) = (v2u){vn.z, vn.w};
    __syncthreads();
    for (int kt = 0; kt < nkt; ++kt) {
        const int s0 = kt * 64; const int cur = kt & 1; const v2u mw = mwn;
        if (kt + 1 < nkt) { kn = *(const GAS v4u*)(kst + (size_t)(s0 + 64) * 64); vn = *(const GAS v4u*)(vst + s0 + 64); mwn = *(const GAS v2u*)(mrow + 2 * kt + 2); }
        if (kt <= ktw) {
            const LAS unsigned char* kc = kr + cur * AT_KB; const LAS unsigned char* vc = vr + cur * AT_VB;
            const float B0 = -sl2 * (float)(t0 + r32 - s0 - 4 * hf);
            f32x16 a0, a1;
#pragma unroll
            for (int r = 0; r < 16; ++r) { const float ko = (float)((r & 3) + 8 * (r >> 2)); a0[r] = B0 + sl2 * ko; a1[r] = B0 + sl2 * (ko + 32.f); }
#pragma unroll
            for (int k = 0; k < 4; ++k) { const bf16x8 k0 = *(const LAS bf16x8*)(kc + 32 * k), k1 = *(const LAS bf16x8*)(kc + 32 * 144 + 32 * k);
                a0 = __builtin_amdgcn_mfma_f32_32x32x16_bf16(k0, qf[k], a0, 0, 0, 0); a1 = __builtin_amdgcn_mfma_f32_32x32x16_bf16(k1, qf[k], a1, 0, 0, 0); }
            const unsigned m0 = mw.x >> (4 * hf), m1 = mw.y >> (4 * hf);
            float mx = -1e30f;
#pragma unroll
            for (int r = 0; r < 16; ++r) { const int ko = (r & 3) + 8 * (r >> 2);
                const unsigned k0m = (unsigned)__builtin_amdgcn_sbfe((int)m0, ko, 1), k1m = (unsigned)__builtin_amdgcn_sbfe((int)m1, ko, 1);
                const float x0 = a0[r], x1 = a1[r];
                a0[r] = __builtin_bit_cast(float, (__builtin_bit_cast(unsigned, x0) & k0m) | (0xf149f2cau & ~k0m));
                a1[r] = __builtin_bit_cast(float, (__builtin_bit_cast(unsigned, x1) & k1m) | (0xf149f2cau & ~k1m));
                mx = fmaxf(mx, fmaxf(a0[r], a1[r])); }
            mx = fmaxf(mx, __shfl_xor(mx, 32));
            const float m_new = fmaxf(m_run, mx);
            const float m_use = fmaxf(m_new, -1e20f);
            float ps = 0.f;
#pragma unroll
            for (int r = 0; r < 16; ++r) { const float p0 = __builtin_amdgcn_exp2f(a0[r] - m_use), p1 = __builtin_amdgcn_exp2f(a1[r] - m_use); a0[r] = p0; a1[r] = p1; ps += p0 + p1; }
            if (__builtin_amdgcn_ballot_w64(m_new != m_run) != 0ull) {
                const float alpha = __builtin_amdgcn_exp2f(m_run - m_new); m_run = m_new;
                l *= alpha;
#pragma unroll
                for (int r = 0; r < 16; ++r) { O0[r] *= alpha; O1[r] *= alpha; }
            }
            l += ps;
#pragma unroll
            for (int sp = 0; sp < 2; ++sp) {
                const bf16x8 pb0 = pack8(a0, 8 * sp), pb1 = pack8(a1, 8 * sp);
#define VLD(uu, dt) ({ const s16x4 lo_ = *(const LAS s16x4*)(vc + (dt) * 32 * 136 + 2 * (32 * (uu) + 16 * sp)), hi_ = *(const LAS s16x4*)(vc + (dt) * 32 * 136 + 2 * (32 * (uu) + 16 * sp + 8)); (bf16x8){lo_[0], lo_[1], lo_[2], lo_[3], hi_[0], hi_[1], hi_[2], hi_[3]}; })
                O0 = __builtin_amdgcn_mfma_f32_32x32x16_bf16(VLD(0, 0), pb0, O0, 0, 0, 0);
                O1 = __builtin_amdgcn_mfma_f32_32x32x16_bf16(VLD(0, 1), pb0, O1, 0, 0, 0);
                O0 = __builtin_amdgcn_mfma_f32_32x32x16_bf16(VLD(1, 0), pb1, O0, 0, 0, 0);
                O1 = __builtin_amdgcn_mfma_f32_32x32x16_bf16(VLD(1, 1), pb1, O1, 0, 0, 0);
#undef VLD
            }
        }
        if (kt + 1 < nkt) { const int nx = cur ^ 1; *(LAS v4u*)(kw + nx * AT_KB) = kn; *(LAS v2u*)(vw + nx * AT_VB) = (v2u){vn.x, vn.y}; *(LAS v2u*)(vw + nx * AT_VB + 8) = (v2u){vn.z, vn.w}; }
        __syncthreads();
    }
    l += __shfl_xor(l, 32);
    const float inv = __builtin_amdgcn_rcpf(l);
    unsigned char* yp = (unsigned char*)YM + (mb + t0 + r32) * D + hh * 64 + 4 * hf;
    const float i8 = inv * 8.f;
#pragma unroll
    for (int rq = 0; rq < 4; ++rq) {
        *(GAS unsigned*)(yp + 8 * rq) = pk4_fp8(O0[4 * rq] * i8, O0[4 * rq + 1] * i8, O0[4 * rq + 2] * i8, O0[4 * rq + 3] * i8);
        *(GAS unsigned*)(yp + 32 + 8 * rq) = pk4_fp8(O1[4 * rq] * i8, O1[4 * rq + 1] * i8, O1[4 * rq + 2] * i8, O1[4 * rq + 3] * i8); }
}
__device__ __forceinline__ void p4_attention2(const Params& P, const Ctx& C) {
    unsigned char* ws = P.ws;
    const bf16* H = (const bf16*)(ws + WS_H); const bf16* KH = (const bf16*)(ws + WS_K); const bf16* VT = (const bf16*)(ws + WS_VT); const unsigned* MASK = (const unsigned*)(ws + WS_MASK); bf16* YM = (bf16*)(ws + WS_YMIX);
    for (int p = blockIdx.x; p < 512; p += C.G) {
        const int b = p & 7, q = p >> 3; const int hh = q >> 3, j = q & 7;
        attn_block(C, H, KH, VT, MASK, YM, b, hh, j);
        attn_block(C, H, KH, VT, MASK, YM, b, hh, 15 - j);
    }
}


#ifndef FEAT_MIX
#define FEAT_MIX 1
#endif
#ifndef FEAT_MOE
#define FEAT_MOE 1
#endif
#ifndef FEAT_PLE
#define FEAT_PLE 1
#endif
#ifndef FEAT_ATT
#define FEAT_ATT 1
#endif

template <bool PUBLISH = true> __device__ __forceinline__ void p6_ln1_router(const Params& P, const Ctx& C) {
    unsigned char* ws = P.ws;
    bf16* X1 = (bf16*)(ws + WS_X1); unsigned char* XB = ws + WS_XB;
    LAS float* wl = (LAS float*)C.lds;
    LAS int* hist = (LAS int*)(C.lds + MISC_OFF);
    { const float* wrt = (const float*)(ws + WS_WRT);
      for (int i = C.tid; i < 32 * 1024 / 4; i += NTHR) *(LAS f32x4*)(wl + 4 * i) = *(const GAS f32x4*)(wrt + 4 * i);
      if (C.tid < 32) hist[C.tid] = 0; }
    __syncthreads();
    int* tope = (int*)(ws + WS_TOPE); float* gate = (float*)(ws + WS_GATE); int* lrank = (int*)(ws + WS_LRANK);
    const bf16* src = (const bf16*)P.out;
    const int lane = C.lane, hf = lane >> 5, ex = lane & 31;
    const float brl = P.in[I_BR][ex];
    for (int m0 = 2 * C.gw; m0 < NTOK; m0 += 2 * C.ngw) {
        f32x4 va[4], vb[4]; load_row_bf16(va, src + (size_t)m0 * D, lane); load_row_bf16(vb, src + (size_t)(m0 + 1) * D, lane);
        ln_row(va, P.in[I_LNMG], P.in[I_LNMB], lane); ln_row(vb, P.in[I_LNMG], P.in[I_LNMB], lane);
        store_row_bf16(X1 + (size_t)m0 * D, va, lane); store_row_bf16(X1 + (size_t)(m0 + 1) * D, vb, lane);
        store_row_fp8x8(XB + (size_t)m0 * D, va, lane); store_row_fp8x8(XB + (size_t)(m0 + 1) * D, vb, lane);
        float v[32];
#pragma unroll
        for (int e = 0; e < 32; ++e) { float pa = 0.f, pb = 0.f;
#pragma unroll
            for (int j = 0; j < 4; ++j) { const f32x4 w = *(const LAS f32x4*)(wl + e * 1024 + 4 * lane + 256 * j);
                pa += (va[j][0] * w[0] + va[j][1] * w[1]) + (va[j][2] * w[2] + va[j][3] * w[3]); pb += (vb[j][0] * w[0] + vb[j][1] * w[1]) + (vb[j][2] * w[2] + vb[j][3] * w[3]); }
            const float keep = hf ? pb : pa, send = hf ? pa : pb; v[e] = keep + __shfl_xor(send, 32); }
#define HALVE(M, CNT) { const bool up_ = (lane & (M)) != 0; _Pragma("unroll") for (int i_ = 0; i_ < (CNT) / 2; ++i_) { const float k_ = up_ ? v[i_ + (CNT) / 2] : v[i_], s_ = up_ ? v[i_] : v[i_ + (CNT) / 2]; v[i_] = k_ + __shfl_xor(s_, (M)); } }
        HALVE(16, 32) HALVE(8, 16) HALVE(4, 8) HALVE(2, 4) HALVE(1, 2)
#undef HALVE
        float lg = v[0] + brl;
        int se[4]; float sv[4];
#pragma unroll
        for (int k = 0; k < 4; ++k) { float bv = lg; int bi = ex;
#pragma unroll
            for (int o = 1; o < 32; o <<= 1) { const float ov = __shfl_xor(bv, o); const int oi = __shfl_xor(bi, o); const bool take = (ov > bv) || (ov == bv && oi < bi); bv = take ? ov : bv; bi = take ? oi : bi; }
            se[k] = bi; sv[k] = bv; if (ex == bi) lg = -INFINITY; }
        float exv[4], sum = 0.f;
#pragma unroll
        for (int k = 0; k < 4; ++k) { exv[k] = __expf(sv[k] - sv[0]); sum += exv[k]; }
        const float inv = 1.f / sum;
        if (ex == 0) { const int m = m0 + hf;
#pragma unroll
            for (int k = 0; k < 4; ++k) { const int lr = atomicAdd((int*)&hist[se[k]], 1); tope[m * 4 + k] = se[k]; gate[m * 4 + k] = exv[k] * inv; lrank[m * 4 + k] = lr; } }
    }
    __syncthreads();
    if (PUBLISH && C.tid < 32) { unsigned* cnt = (unsigned*)(ws + WS_CTL) + CW_CNT; const int base = (int)atomicAdd(cnt + C.tid, (unsigned)hist[C.tid]); ((int*)(ws + WS_WGBASE))[blockIdx.x * 32 + C.tid] = base; }
}

__device__ __forceinline__ void p7_dispatch(const Params& P, const Ctx& C) {
    unsigned char* ws = P.ws;
    LAS int* ps = (LAS int*)(C.lds + MISC_OFF + 256);
    const unsigned* cnt = (const unsigned*)(ws + WS_CTL) + CW_CNT;
    int* tile_e = (int*)(ws + WS_TILEE);
    LAS int* pe = (LAS int*)(C.lds + MISC_OFF + 512);
    if (C.tid < 64) { const int e = C.tid & 31; const int c = (int)__hip_atomic_load(cnt + e, __ATOMIC_RELAXED, __HIP_MEMORY_SCOPE_AGENT); const int nt = (c + 255) >> 8; int inc = nt;
#pragma unroll
        for (int o = 1; o < 32; o <<= 1) { const int v = __shfl_up(inc, o); if ((C.tid & 31) >= o) inc += v; }
        if (C.tid < 32) { ps[e] = (inc - nt) << 8; pe[e] = inc; } }
    __syncthreads();
    if (blockIdx.x == 0) { const int ntot = pe[31];
        for (int t = C.tid; t < ntot; t += NTHR) { int e = 0;
#pragma unroll
            for (int q = 0; q < 31; ++q) e += (t >= pe[q]) ? 1 : 0;
            tile_e[t] = e; }
        if (C.tid == 0) tile_e[MAXTILES] = ntot; }
    const int* tope = (const int*)(ws + WS_TOPE); const float* gate = (const float*)(ws + WS_GATE); const int* lrank = (const int*)(ws + WS_LRANK);
    const int* wgb = (const int*)(ws + WS_WGBASE);
    int* tokslot = (int*)(ws + WS_TOKSLOT); float* slotgate = (float*)(ws + WS_SLOTGATE);
    const bf16* XB = (const bf16*)(ws + WS_XB); unsigned char* xs = ws + WS_XS;
    int m = C.gw; v4u f8n; int en[4], ln_[4]; float gn[4]; int wgn;
    if (m < NTOK) { f8n = *(const GAS v4u*)((const unsigned char*)XB + (size_t)m * D + 16 * C.lane); wgn = ((m >> 1) % C.ngw) >> 3;
#pragma unroll
        for (int k = 0; k < 4; ++k) { en[k] = tope[m * 4 + k]; ln_[k] = lrank[m * 4 + k]; gn[k] = gate[m * 4 + k]; } }
    for (; m < NTOK; m += C.ngw) {
        const v4u f8 = f8n; int e[4], lr[4]; float g[4]; const int wgm = wgn;
#pragma unroll
        for (int k = 0; k < 4; ++k) { e[k] = en[k]; lr[k] = ln_[k]; g[k] = gn[k]; }
        int wb[4];
#pragma unroll
        for (int k = 0; k < 4; ++k) wb[k] = wgb[wgm * 32 + e[k]];
        const int m2 = m + C.ngw;
        if (m2 < NTOK) { f8n = *(const GAS v4u*)((const unsigned char*)XB + (size_t)m2 * D + 16 * C.lane); wgn = ((m2 >> 1) % C.ngw) >> 3;
#pragma unroll
            for (int k = 0; k < 4; ++k) { en[k] = tope[m2 * 4 + k]; ln_[k] = lrank[m2 * 4 + k]; gn[k] = gate[m2 * 4 + k]; } }
#pragma unroll
        for (int k = 0; k < 4; ++k) { const int slot = ps[e[k]] + wb[k] + lr[k];
            *(GAS v4u*)(xs + (size_t)slot * D + 16 * C.lane) = f8;
            if (C.lane == 0) { slotgate[slot] = g[k]; tokslot[m * 4 + k] = slot; } }
    }
}

__device__ __forceinline__ void p10_combine_ln2(const Params& P, const Ctx& C) {
    unsigned char* ws = P.ws;
    const bf16* X1 = (const bf16*)(ws + WS_X1); bf16* XB = (bf16*)(ws + WS_XB); bf16* X2 = (bf16*)P.out;
    const int* tokslot = (const int*)(ws + WS_TOKSLOT); const unsigned char* ys = ws + WS_YSLOT;
    for (int m = C.gw; m < NTOK; m += C.ngw) {
        f32x4 v[4]; load_row_bf16(v, X1 + (size_t)m * D, C.lane);
#pragma unroll
        for (int j = 0; j < 4; ++j) v[j] = v[j] * ALPHA;
#if FEAT_MOE
        f32x4 fs[4] = {{0.f, 0.f, 0.f, 0.f}, {0.f, 0.f, 0.f, 0.f}, {0.f, 0.f, 0.f, 0.f}, {0.f, 0.f, 0.f, 0.f}};
#pragma unroll
        for (int k = 0; k < 4; ++k) { const int slot = tokslot[m * 4 + k]; const unsigned char* yr = ys + (size_t)slot * D;
#pragma unroll
            for (int j = 0; j < 4; ++j) fs[j] = fs[j] + fp8x4_to_f32(*(const GAS unsigned*)(yr + 4 * C.lane + 256 * j)); }
#pragma unroll
        for (int j = 0; j < 4; ++j) v[j] = v[j] + fs[j] * (1.f / 64.f);
#endif
        ln_row(v, P.in[I_LNFG], P.in[I_LNFB], C.lane);
        store_row_bf16(X2 + (size_t)m * D, v, C.lane);
        store_row_fp8x8((unsigned char*)XB + (size_t)m * D, v, C.lane);
    }
}

__device__ __forceinline__ void p12_final_ln(const Params& P, const Ctx& C) {
    const bf16* src = (const bf16*)(P.ws + WS_X1);
    for (int m = C.gw; m < NTOK; m += C.ngw) {
        f32x4 v[4]; load_row_bf16(v, src + (size_t)m * D, C.lane);
        ln_row(v, P.in[I_LNPG], P.in[I_LNPB], C.lane);
        store_row_f32(P.out + (size_t)m * D, v, C.lane);
    }
}
#define XB_TMO      128
#define XB_XCNT(j)  (256  + 64 * (j))
#define XB_XSUB(j)  (1280 + 64 * (j))
#define XB_XGEN(j)  (2304 + 64 * (j))
#define XB_TOP      3328
#define XB_TOPGEN   3392
#define XCD_BAR_WORDS 3456
#define XB_SPIN_CAP (1u << 18)
#define LAS __attribute__((address_space(3)))

__device__ __forceinline__ unsigned xb_ld(unsigned* p)              { return __hip_atomic_load(p, __ATOMIC_RELAXED, __HIP_MEMORY_SCOPE_AGENT); }
__device__ __forceinline__ unsigned xb_add(unsigned* p, unsigned v) { return __hip_atomic_fetch_add(p, v, __ATOMIC_RELAXED, __HIP_MEMORY_SCOPE_AGENT); }
__device__ __forceinline__ unsigned xb_xcc_id() { return (unsigned)__builtin_amdgcn_s_getreg((3 << 11) | 20) & 0xFu; }
#define XB_SPIN(cond, bar) do { unsigned _sp = 0; while (cond) { __builtin_amdgcn_s_sleep(1); \
    if ((++_sp & 255u) == 0u) { if (xb_ld(&(bar)[XB_TMO])) break; if (_sp > XB_SPIN_CAP) { atomicAdd(&(bar)[XB_TMO], 1u); break; } } } } while (0)

struct XcdBarrier {
    unsigned* bar; unsigned x;
    volatile LAS unsigned* st;
};

__device__ __forceinline__ XcdBarrier xcd_barrier_post(unsigned* bar, volatile LAS unsigned* st) {
    XcdBarrier b; b.bar = bar; b.x = xb_xcc_id(); b.st = st;
    if (threadIdx.x == 0) (void)xb_add(&bar[XB_XCNT(b.x)], 1u);
    return b;
}
__device__ __forceinline__ void xcd_barrier_complete(unsigned* bar, unsigned x, unsigned& nloc, unsigned& nx) {
    const unsigned G = gridDim.x * gridDim.y * gridDim.z;
    unsigned sum, cnt, mine, sp = 0u;
    for (;;) {
        sum = 0u; cnt = 0u; mine = 0u;
#pragma unroll
        for (unsigned j = 0; j < 16; ++j) { const unsigned c = xb_ld(&bar[XB_XCNT(j)]); sum += c; cnt += (c > 0u) ? 1u : 0u; mine = (j == x) ? c : mine; }
        if (sum == G) break;
        __builtin_amdgcn_s_sleep(1);
        if ((++sp & 255u) == 0u) { if (xb_ld(&bar[XB_TMO])) break; if (sp > XB_SPIN_CAP) { atomicAdd(&bar[XB_TMO], 1u); break; } }
    }
    nloc = mine > 0u ? mine : 1u; nx = cnt > 0u ? cnt : 1u;
}

__device__ __forceinline__ void xcd_barrier(const XcdBarrier& b) {
    asm volatile("s_waitcnt vmcnt(0)" ::: "memory");
    __syncthreads();
    if (threadIdx.x == 0) {
        unsigned* bar = b.bar;
        __builtin_amdgcn_s_waitcnt(0);
        unsigned nloc = b.st[0], nx = b.st[1];
        if (nloc == 0u) { xcd_barrier_complete(bar, b.x, nloc, nx); b.st[0] = nloc; b.st[1] = nx; }
        const unsigned old = xb_add(&bar[XB_XSUB(b.x)], 1u);
        const unsigned gen = old / nloc;
        if (old + 1u == (gen + 1u) * nloc) {
            __builtin_amdgcn_fence(__ATOMIC_RELEASE, "agent");
            asm volatile("s_waitcnt vmcnt(0)" ::: "memory");
            const unsigned og = xb_add(&bar[XB_TOP], 1u);
            const unsigned tg = og / nx;
            if (og + 1u == (tg + 1u) * nx) xb_add(&bar[XB_TOPGEN], 1u);
            else XB_SPIN(xb_ld(&bar[XB_TOPGEN]) == tg, bar);
            __builtin_amdgcn_fence(__ATOMIC_ACQUIRE, "agent");
            xb_add(&bar[XB_XGEN(b.x)], 1u);
            asm volatile("s_waitcnt vmcnt(0)" ::: "memory");
        } else {
            XB_SPIN(xb_ld(&bar[XB_XGEN(b.x)]) == gen, bar);
            __builtin_amdgcn_fence(__ATOMIC_ACQUIRE, "agent");
            asm volatile("s_waitcnt vmcnt(0)" ::: "memory");
        }
    }
    __syncthreads();
}


template <int PH> __device__ __forceinline__ void run_phase(const Params& P, const Ctx& C) {
    unsigned char* ws = P.ws;
    typedef pg8::bf16_t pbf;
    if constexpr (PH == 0) { p0_prologue(P, C); }
    else if constexpr (PH == 10) {
        pg8::Gemm g{(const pbf*)(ws + WS_XBF), (const pbf*)(ws + WS_WIN_T), NTOK, D_INP, D}; pg8::StaticOrder S; S.init(NTOK, D_INP, C.G, (int)blockIdx.x);
        pg8::EpiBf16s E{(pbf*)(ws + WS_H), D_INP};
        pg8::gemm_phase<pg8::EpiBf16s, pg8::StaticOrder, true, true>(C.lds, g, S, E); }
    else if constexpr (PH == 11) {
        pg8::Gemm g{(const pbf*)(ws + WS_PB), (const pbf*)(ws + WS_WPROJ_T), NTOK, D, PLE}; pg8::StaticOrder S; S.init(NTOK, D, C.G, (int)blockIdx.x);
        pg8::EpiBf16s E{(pbf*)(ws + WS_PROJ), D};
        pg8::gemm_phase<pg8::EpiBf16s, pg8::StaticOrder, true, true>(C.lds, g, S, E); }
    else if constexpr (PH == 20) { p2_post(P, C); }
    else if constexpr (PH == 21) { p2_hgrn_prep(P, C); }
    else if constexpr (PH == 30) {
        { pg8::Gemm g{(const pbf*)(ws + WS_CN), (const pbf*)(ws + WS_WUK_T), NTOK, 512, 256}; pg8::StaticOrder S; S.init(NTOK, 512, C.G, (int)blockIdx.x);
          pg8::EpiKhead E{(pbf*)(ws + WS_K)};
          pg8::gemm_phase<pg8::EpiKhead, pg8::StaticOrder, true, true>(C.lds, g, S, E); }
        { pg8::Gemm g{(const pbf*)(ws + WS_WUV_T), (const pbf*)(ws + WS_CN), 512, NTOK, 256}; pg8::StaticOrder S; S.init(512, NTOK, C.G, (int)blockIdx.x);
          pg8::EpiVt E{(pbf*)(ws + WS_VT)};
          pg8::gemm_phase<pg8::EpiVt, pg8::StaticOrder, true, true>(C.lds, g, S, E); }
    }
    else if constexpr (PH == 31) { p3_indexer(P, C); }
    else if constexpr (PH == 32) { p3_scan_convert(P, C); }
    else if constexpr (PH == 40) { p4_attention2(P, C); }
    else if constexpr (PH == 41) { p4_yrec(P, C); }
    else if constexpr (PH == 5) {
        pg8::Gemm g{(const pbf*)(ws + WS_YMIX), (const pbf*)(ws + WS_WO_T), NTOK, D, D / 2}; pg8::StaticOrder S; S.init(NTOK, D, C.G, (int)blockIdx.x);
        pg8::EpiResid E{P.in[I_X], (pbf*)P.out, D, ALPHA, 1.f / 512.f};
        pg8::gemm_phase<pg8::EpiResid, pg8::StaticOrder, true, true, 1>(C.lds, g, S, E);
    }
    else if constexpr (PH == 6) { p6_ln1_router<true>(P, C); }
    else if constexpr (PH == 60) { p6_ln1_router<false>(P, C); }
    else if constexpr (PH == 7) { p7_dispatch(P, C); }
    else if constexpr (PH == 8) {
        const int* tile_e = (const int*)(ws + WS_TILEE);
        pg8::Gemm g{(const pbf*)(ws + WS_XS), (const pbf*)(ws + WS_WUP_T), CAP, NE * 2048, D / 2};
        pg8::MoeOrder S{tile_e, tile_e[MAXTILES], 8, C.G, (int)blockIdx.x};
        pg8::EpiSwiglu E{ws + WS_HH, P.in[I_BUP]};
        pg8::gemm_phase<pg8::EpiSwiglu, pg8::MoeOrder, true, true, 1, 124, 121>(C.lds, g, S, E);
    }
    else if constexpr (PH == 9) {
        const int* tile_e = (const int*)(ws + WS_TILEE);
        pg8::Gemm g{(const pbf*)(ws + WS_HH), (const pbf*)(ws + WS_WDN_T), CAP, NE * 1024, DFF / 2};
        pg8::MoeOrder S{tile_e, tile_e[MAXTILES], 4, C.G, (int)blockIdx.x};
        pg8::EpiDown E{ws + WS_YSLOT, P.in[I_BDN], (const float*)(ws + WS_SLOTGATE)};
        pg8::gemm_phase<pg8::EpiDown, pg8::MoeOrder, true, true, 1, 125, 121>(C.lds, g, S, E);
    }
    else if constexpr (PH == 100) { p10_combine_ln2(P, C); }
    else if constexpr (PH == 110) {
        pg8::Gemm g{(const pbf*)(ws + WS_XB), (const pbf*)(ws + WS_WGATE_T), NTOK, D, D / 2}; pg8::StaticOrder S; S.init(NTOK, D, C.G, (int)blockIdx.x);
        pg8::EpiPle E{(const pbf*)P.out, (const pbf*)(ws + WS_PROJ), (pbf*)(ws + WS_X1), ALPHA, 1.f / 512.f};
        pg8::gemm_phase<pg8::EpiPle, pg8::StaticOrder, true, true, 1>(C.lds, g, S, E);
    }
    else { p12_final_ln(P, C); }
}
__global__ void __launch_bounds__(NTHR, 2) mega_fwd(Params P) {
    extern __shared__ __attribute__((aligned(16))) unsigned char lds_raw[];
    cg::grid_group grid = cg::this_grid();
#define MKCTX Ctx C; { int tid_ = threadIdx.x; asm volatile("" : "+v"(tid_)); C.lds = (LAS unsigned char*)lds_raw; C.tid = tid_; C.lane = tid_ & 63; C.wave = __builtin_amdgcn_readfirstlane(tid_ >> 6); \
      C.G = gridDim.x; C.gw = blockIdx.x * NWAVES + C.wave; C.ngw = C.G * NWAVES; }
#if SYNC_MODE != 0
    if (threadIdx.x < 4) ((LAS unsigned*)((LAS unsigned char*)lds_raw + XBW_OFF))[threadIdx.x] = 0u;
    __syncthreads();
    XcdBarrier bar = xcd_barrier_post((unsigned*)(P.ws + WS_CTL) + CW_BAR, (volatile LAS unsigned*)((LAS unsigned char*)lds_raw + XBW_OFF));
#define SY xcd_barrier(bar);
#else
#define SY grid.sync();
#endif
#define GS grid.sync();
#define BS __syncthreads();
#define X(k) { MKCTX run_phase<k>(P, C); }
    PROGRAM
#undef X
#undef MKCTX
#undef SY
#undef GS
#undef BS
}

extern "C" void kernel_launch(void* const* d_in, const int* in_sizes, int n_in, void* d_out, int out_size, void* d_ws, size_t ws_size, hipStream_t stream) {
    static int grid = 0;
    if (grid == 0) {
        if (n_in != 25 || out_size != NTOK * D || ws_size < WS_END) { fprintf(stderr, "kernel_launch: unexpected shapes (n_in %d out %d ws %zu)\n", n_in, out_size, ws_size); grid = -1; return; }
        int dev = 0, cus = 0, per_cu = 0;
        if (hipGetDevice(&dev) != hipSuccess || hipDeviceGetAttribute(&cus, hipDeviceAttributeMultiprocessorCount, dev) != hipSuccess) { grid = -1; return; }
        if (hipFuncSetAttribute((const void*)mega_fwd, hipFuncAttributeMaxDynamicSharedMemorySize, LDS_BYTES) != hipSuccess) { fprintf(stderr, "kernel_launch: hipFuncSetAttribute failed\n"); grid = -1; return; }
        if (hipOccupancyMaxActiveBlocksPerMultiprocessor(&per_cu, (const void*)mega_fwd, NTHR, LDS_BYTES) != hipSuccess || per_cu < 1) { fprintf(stderr, "kernel_launch: occupancy query failed (%d)\n", per_cu); (void)hipGetLastError(); grid = -1; return; }
        grid = cus * per_cu;
        fprintf(stderr, "kernel_launch: grid %d (%d CUs x %d)\n", grid, cus, per_cu);
    }
    if (grid < 0) return;
    (void)hipMemsetAsync((char*)d_ws + WS_CTL, 0, CTL_ZERO_BYTES, stream);
    Params p{};
    for (int i = 0; i < 25; ++i) p.in[i] = (const float*)d_in[i];
    p.out = (float*)d_out; p.ws = (unsigned char*)d_ws;

    void* args[] = {&p};
    hipError_t e = hipLaunchCooperativeKernel((const void*)mega_fwd, dim3(grid), dim3(NTHR), args, LDS_BYTES, stream);
    if (e != hipSuccess) fprintf(stderr, "kernel_launch: cooperative launch failed: %s (grid %d)\n", hipGetErrorString(e), grid);
}
```

```cpp
#define SYNC_MODE 1
#include <hip/hip_runtime.h>
#include <hip/hip_cooperative_groups.h>
#include <cstdio>
#include <cstdint>
namespace cg = cooperative_groups;

namespace pg8 {
#define PG8_LAS __attribute__((address_space(3)))
typedef unsigned short bf16_t;
typedef short bf16x8 __attribute__((ext_vector_type(8)));
typedef float f32x4 __attribute__((ext_vector_type(4)));
typedef unsigned u32x4 __attribute__((ext_vector_type(4)));
typedef int i32x4 __attribute__((ext_vector_type(4)));
typedef int i32x8 __attribute__((ext_vector_type(8)));
constexpr int BM = 256, BK = 64, HALF = 128, HTB = HALF * BK * 2  , STAGE_BYTES = 8 * HTB, NXCD = 8, WGM = 8;

__host__ __device__ __forceinline__ int lds_byte(int r, int c) { const int st = (r >> 4) * 2 + (c >> 5), rr = r & 15, cc = c & 31, ob = rr * 64 + cc * 2; return st * 1024 + (ob ^ (((ob >> 9) & 1) << 5)); }
__host__ __device__ __forceinline__ void stage_rc(int b, int& R, int& C) { const int st = b / 1024, sb = b % 1024, swz = sb ^ (((sb >> 9) & 1) << 5); R = (st >> 1) * 16 + swz / 64; C = (st & 1) * 32 + (swz % 64) / 2; }
__host__ __device__ __forceinline__ int perm32(int rho) { const int n = rho >> 4, i = rho & 15; return 8 * (i >> 2) + 4 * n + (i & 3); }

struct Unit { int pm, pn; };
struct Gemm { const bf16_t* A; const bf16_t* Bt; int M, N, K; };

struct StaticOrder {
    int nM, nN, nwg, G, c;
    __host__ __device__ void init(int M, int N, int G_, int c_) { nM = M / BM; nN = N / BM; nwg = nM * nN; G = G_; c = c_; }
    __host__ __device__ bool next(int i, Unit& u) const {
        const long L = (long)i * G + c; if (L >= nwg) return false;
        int wgid = (int)L; { const int q = nwg / NXCD, r = nwg % NXCD, xcd = wgid % NXCD, off = wgid / NXCD; wgid = (xcd < r ? xcd * (q + 1) : r * (q + 1) + (xcd - r) * q) + off; }
        const int nig = WGM * nN, gid = wgid / nig, fm = gid * WGM, gsz = (nM - fm) < WGM ? (nM - fm) : WGM;
        u.pm = fm + ((wgid % nig) % gsz); u.pn = (wgid % nig) / gsz; return true;
    }
    __device__ __forceinline__ void a_ready(const Unit&) const {}
    __device__ __forceinline__ void done(const Unit&) const {}
};

__device__ __forceinline__ unsigned cvt_pk_bf16(float lo, float hi) { unsigned r; asm volatile("v_cvt_pk_bf16_f32 %0, %1, %2" : "=v"(r) : "v"(lo), "v"(hi)); return r; }
typedef float f32x2 __attribute__((ext_vector_type(2)));
template <class Epi, class Sched, bool ALIGN_EPI = false, bool SP2 = false, int F8 = 0, int F8SA = 127, int F8SB = 127>
__device__ __forceinline__ void gemm_phase(PG8_LAS unsigned char* lds, const Gemm g, const Sched& S, const Epi& E) {
    const int tid = threadIdx.x, wid = __builtin_amdgcn_readfirstlane(tid >> 6), lane = tid & 63, wr = wid >> 2, wc = wid & 3, fr = lane & 15, fq = lane >> 4;
    const int K = g.K, nt = K / BK;
    unsigned voffA[2], voffB[2];
#pragma unroll
    for (int i = 0; i < 2; ++i) { int R, C; stage_rc(tid * 16 + i * 8192, R, C); const int Rb = Epi::PERM ? ((R & ~31) + perm32(R & 31)) : R;
        voffA[i] = (unsigned)(R * K + C) * 2u; voffB[i] = (unsigned)(Rb * K + C) * 2u; }
    const size_t kstep = (size_t)(BK * 2);
    const size_t hstep = (size_t)HALF * K * 2;
    const size_t tstep = 2 * hstep;
    const unsigned ldsw = (unsigned)wid * 1024u;
    const int aoff = lds_byte(wr * 64 + fr, fq * 8), boff = lds_byte(wc * 32 + fr, fq * 8);
#define PG8_SA(b, h) (((b) * 2 + (h)) * HTB)
#define PG8_SB(b, h) ((4 + (b) * 2 + (h)) * HTB)
#define PG8_STAGE(bufoff, gbase, voff) do { _Pragma("unroll") for (int _i = 0; _i < 2; ++_i) \
        __builtin_amdgcn_global_load_lds((const unsigned*)((const char*)(gbase) + (voff)[_i]), (PG8_LAS unsigned*)(lds + (bufoff) + ldsw + _i * 8192), 16, 0, 0); } while (0)
#define PG8_LDA(dst, b, h) do { _Pragma("unroll") for (int m = 0; m < 4; ++m) { dst[m].lo = *(const PG8_LAS i32x4*)(lds + PG8_SA(b, h) + aoff + m * 2048); dst[m].hi = *(const PG8_LAS i32x4*)(lds + PG8_SA(b, h) + aoff + m * 2048 + 1024); } } while (0)
#define PG8_LDB(dst, b, h) do { _Pragma("unroll") for (int n = 0; n < 2; ++n) { dst[n].lo = *(const PG8_LAS i32x4*)(lds + PG8_SB(b, h) + boff + n * 2048); dst[n].hi = *(const PG8_LAS i32x4*)(lds + PG8_SB(b, h) + boff + n * 2048 + 1024); } } while (0)
#define PG8_MMA(ai, bj, At, Bt) do { __builtin_amdgcn_s_setprio(1); \
        if constexpr (F8 == 0) { _Pragma("unroll") for (int m = 0; m < 4; ++m) _Pragma("unroll") for (int n = 0; n < 2; ++n) { \
            const i32x4 bl_ = Bt[n].lo, bh_ = Bt[n].hi, al_ = At[m].lo, ah_ = At[m].hi;     \
            acc[ai][bj][m][n] = __builtin_amdgcn_mfma_f32_16x16x32_bf16(__builtin_bit_cast(bf16x8, bl_), __builtin_bit_cast(bf16x8, al_), acc[ai][bj][m][n], 0, 0, 0); \
            acc[ai][bj][m][n] = __builtin_amdgcn_mfma_f32_16x16x32_bf16(__builtin_bit_cast(bf16x8, bh_), __builtin_bit_cast(bf16x8, ah_), acc[ai][bj][m][n], 0, 0, 0); } } \
        else { _Pragma("unroll") for (int m = 0; m < 4; ++m) _Pragma("unroll") for (int n = 0; n < 2; ++n) \
            asm volatile("v_mfma_f32_16x16x128_f8f6f4 %0, %1, %2, %0" : "+v"(acc[ai][bj][m][n]) : "v"(Bt[n]), "v"(At[m])); } \
        __builtin_amdgcn_s_setprio(0); } while (0)
#define PG8_WAIT_V(n) asm volatile("s_waitcnt vmcnt(" #n ")" ::: "memory")
#define PG8_WAIT_L(n) asm volatile("s_waitcnt lgkmcnt(" #n ")" ::: "memory")
#define PG8_BAR __builtin_amdgcn_s_barrier()
#define PG8_SCHED __builtin_amdgcn_sched_barrier(0)
    Unit cur, nxt; int ui = 0;
    if (!S.next(0, cur)) return;
    f32x4 acc[2][2][4][2];
#pragma unroll
    for (int a = 0; a < 2; ++a)
#pragma unroll
        for (int b = 0; b < 2; ++b)
#pragma unroll
            for (int m = 0; m < 4; ++m)
#pragma unroll
                for (int n = 0; n < 2; ++n) acc[a][b][m][n] = (f32x4){0.f, 0.f, 0.f, 0.f};
    i32x8 At[4], B0[2], B1[2];
    const char* cA = (const char*)g.A + (size_t)cur.pm * tstep; const char* cB = (const char*)g.Bt + (size_t)cur.pn * tstep;
    S.a_ready(cur);
    if constexpr (SP2) {
        PG8_STAGE(PG8_SB(0, 0), cB, voffB); PG8_STAGE(PG8_SB(0, 1), cB + hstep, voffB); PG8_STAGE(PG8_SA(0, 0), cA, voffA); PG8_STAGE(PG8_SA(0, 1), cA + hstep, voffA);
        if (wr == 1) PG8_BAR;
        PG8_WAIT_V(2); PG8_BAR;
        PG8_STAGE(PG8_SB(1, 0), cB + kstep, voffB); PG8_STAGE(PG8_SA(1, 0), cA + kstep, voffA); PG8_STAGE(PG8_SB(1, 1), cB + hstep + kstep, voffB);
        PG8_WAIT_V(6); PG8_BAR;
    } else {
        PG8_STAGE(PG8_SB(0, 0), cB, voffB); PG8_STAGE(PG8_SA(0, 0), cA, voffA); PG8_STAGE(PG8_SB(0, 1), cB + hstep, voffB); PG8_STAGE(PG8_SA(0, 1), cA + hstep, voffA);
        if (wr == 1) PG8_BAR;
        PG8_WAIT_V(4); PG8_BAR;
        PG8_STAGE(PG8_SB(1, 0), cB + kstep, voffB); PG8_STAGE(PG8_SA(1, 0), cA + kstep, voffA); PG8_STAGE(PG8_SB(1, 1), cB + hstep + kstep, voffB);
        PG8_WAIT_V(6); PG8_BAR;
    }
    for (;;) {
        const bool has_next = S.next(ui + 1, nxt);
        const char* nA = has_next ? (const char*)g.A + (size_t)nxt.pm * tstep : cA; const char* nB = has_next ? (const char*)g.Bt + (size_t)nxt.pn * tstep : cB;
_Pragma("nounroll")
        for (int t = 0; t < nt; t += 2) {
            const bool last = (t == nt - 2);
            const char* a1 = cA + (size_t)(t + 1) * kstep;
            const char* a2 = last ? nA : cA + (size_t)(t + 2) * kstep; const char* b2 = last ? nB : cB + (size_t)(t + 2) * kstep;
            const char* a3 = a2 + kstep; const char* b3 = b2 + kstep;
            if (last && has_next) S.a_ready(nxt);
            if constexpr (SP2) {
            PG8_LDB(B0, 0, 0); PG8_LDB(B1, 0, 1); PG8_SCHED; PG8_LDA(At, 0, 0); PG8_STAGE(PG8_SA(1, 1), a1 + hstep, voffA);
            PG8_WAIT_V(8); PG8_WAIT_L(0); PG8_BAR; PG8_MMA(0, 0, At, B0); PG8_MMA(0, 1, At, B1); PG8_BAR; PG8_SCHED;
            PG8_LDA(At, 0, 1); PG8_STAGE(PG8_SB(0, 0), b2, voffB); PG8_STAGE(PG8_SB(0, 1), b2 + hstep, voffB); PG8_STAGE(PG8_SA(0, 0), a2, voffA);
            PG8_WAIT_V(8); PG8_WAIT_L(0); PG8_BAR; PG8_MMA(1, 0, At, B0); PG8_MMA(1, 1, At, B1); PG8_BAR; PG8_SCHED;
            PG8_LDB(B0, 1, 0); PG8_LDB(B1, 1, 1); PG8_SCHED; PG8_LDA(At, 1, 0); PG8_STAGE(PG8_SA(0, 1), a2 + hstep, voffA);
            PG8_WAIT_V(8); PG8_WAIT_L(0); PG8_BAR; PG8_MMA(0, 0, At, B0); PG8_MMA(0, 1, At, B1); PG8_BAR; PG8_SCHED;
            PG8_LDA(At, 1, 1); PG8_STAGE(PG8_SB(1, 0), b3, voffB); PG8_STAGE(PG8_SB(1, 1), b3 + hstep, voffB); PG8_STAGE(PG8_SA(1, 0), a3, voffA);
            PG8_WAIT_V(8); PG8_WAIT_L(0); PG8_BAR; PG8_MMA(1, 0, At, B0); PG8_MMA(1, 1, At, B1); PG8_BAR; PG8_SCHED;
            } else {
            PG8_LDB(B0, 0, 0); PG8_SCHED; PG8_LDA(At, 0, 0); PG8_STAGE(PG8_SA(1, 1), a1 + hstep, voffA);
            PG8_WAIT_L(8); PG8_BAR; PG8_WAIT_L(0); PG8_MMA(0, 0, At, B0); PG8_BAR; PG8_SCHED;
            PG8_LDB(B1, 0, 1); PG8_STAGE(PG8_SB(0, 0), b2, voffB);
            PG8_BAR; PG8_WAIT_L(0); PG8_MMA(0, 1, At, B1); PG8_BAR;
            PG8_LDA(At, 0, 1); PG8_STAGE(PG8_SA(0, 0), a2, voffA);
            PG8_BAR; PG8_WAIT_L(0); PG8_MMA(1, 0, At, B0); PG8_BAR; PG8_SCHED;
            PG8_STAGE(PG8_SB(0, 1), b2 + hstep, voffB);
            PG8_WAIT_V(6); PG8_BAR; PG8_MMA(1, 1, At, B1); PG8_BAR;
            PG8_LDB(B0, 1, 0); PG8_SCHED; PG8_LDA(At, 1, 0); PG8_STAGE(PG8_SA(0, 1), a2 + hstep, voffA);
            PG8_WAIT_L(8); PG8_BAR; PG8_WAIT_L(0); PG8_MMA(0, 0, At, B0); PG8_BAR; PG8_SCHED;
            PG8_LDB(B1, 1, 1); PG8_STAGE(PG8_SB(1, 0), b3, voffB);
            PG8_BAR; PG8_WAIT_L(0); PG8_MMA(0, 1, At, B1); PG8_BAR;
            PG8_LDA(At, 1, 1); PG8_STAGE(PG8_SA(1, 0), a3, voffA);
            PG8_BAR; PG8_WAIT_L(0); PG8_MMA(1, 0, At, B0); PG8_BAR; PG8_SCHED;
            PG8_STAGE(PG8_SB(1, 1), b3 + hstep, voffB);
            PG8_WAIT_V(6); PG8_BAR; PG8_MMA(1, 1, At, B1); PG8_BAR;
            }
        }
        if constexpr (ALIGN_EPI) { if (wr == 0) PG8_BAR; }
        if constexpr (F8 != 0) asm volatile("s_nop 15\n\ts_nop 15" ::: "memory");
        if constexpr (!Epi::AFTER_DRAIN) { E(acc, cur, wr, wc, fr, fq); S.done(cur); }
        if (!has_next) break;
#pragma unroll
        for (int a = 0; a < 2; ++a)
#pragma unroll
            for (int b = 0; b < 2; ++b)
#pragma unroll
                for (int m = 0; m < 4; ++m)
#pragma unroll
                    for (int n = 0; n < 2; ++n) acc[a][b][m][n] = (f32x4){0.f, 0.f, 0.f, 0.f};
        cur = nxt; cA = nA; cB = nB; ++ui;
        if constexpr (ALIGN_EPI) { if (wr == 1) PG8_BAR; }
    }
    PG8_WAIT_V(0);
    if constexpr (!ALIGN_EPI) { if (wr == 0) PG8_BAR; }
    PG8_BAR;
    if constexpr (Epi::AFTER_DRAIN) { E.fused(acc, cur, wr, wc, fr, fq, lds, wid, lane); S.done(cur); }
#undef PG8_SA
#undef PG8_SB
#undef PG8_STAGE
#undef PG8_LDA
#undef PG8_LDB
#undef PG8_MMA
#undef PG8_WAIT_V
#undef PG8_WAIT_L
#undef PG8_BAR
#undef PG8_SCHED
}
}

constexpr int NB = 8, T = 4096, D = 1024, NTOK = NB * T;
constexpr int ATT_H = 8, ATT_D = 64, ATT_W = 512, KV_LAT = 256, IDX_H = 8, IDX_D = 64, TOPK = 256;
constexpr int HG_H = 4, HG_DK = 128, HG_DV = 128, HG_W = 512, HG_C = 32;
constexpr int D_IN = 3400, D_INP = 3584;
constexpr int C_AQ = 0, C_AC = 512, C_IQ = 768, C_IK = 1280, C_IW = 1344, C_GQ = 1352, C_GF = 1864, C_GI = 2376, C_GG = 2888;
constexpr int NE = 32, TOPE = 4, DFF = 1024, PLE = 256;
constexpr int NASSIGN = NTOK * TOPE, CAP = NASSIGN + NE * 256;
constexpr int MAXTILES = CAP / 256;
constexpr float LN_EPS = 1e-5f, RMS_EPS = 1e-6f, ALPHA = 1.189207115002721f;

constexpr size_t MiB = 1u << 20;
constexpr size_t WS_CTL = 0, CTL_ZERO_BYTES = 64 * 1024;
constexpr size_t WS_WIN_T = 1 * MiB, WS_WO_T = 8 * MiB, WS_WUP_T = 10 * MiB, WS_WDN_T = 138 * MiB, WS_WPROJ_T = 202 * MiB, WS_WGATE_T = 203 * MiB;
constexpr size_t WS_WUK_T = 205 * MiB, WS_WUV_T = 205 * MiB + 512 * 1024;
constexpr size_t WS_SMALL = 206 * MiB;
constexpr size_t WS_A = 208 * MiB;
constexpr size_t WS_B = 480 * MiB;
constexpr size_t WS_X1 = 752 * MiB;
constexpr size_t WS_XB = 880 * MiB;
constexpr size_t WS_PROJ = 944 * MiB;
constexpr size_t WS_SM2 = 1008 * MiB;
constexpr size_t WS_END = 1016 * MiB;
constexpr size_t WS_H = WS_A, WS_XS = WS_A, WS_YSLOT = WS_A;
constexpr size_t WS_XBF = WS_X1 + 64 * MiB, WS_U = WS_B, WS_YMIX = WS_B, WS_HH = WS_B;
constexpr size_t WS_QDEC = WS_B + 128 * MiB, WS_PB = WS_B + 128 * MiB, WS_OREC = WS_B + 160 * MiB, WS_CN = WS_B + 224 * MiB, WS_IKN = WS_B + 240 * MiB, WS_MASK = WS_B + 244 * MiB;
constexpr size_t WS_K = WS_XB, WS_VT = WS_XB + 32 * MiB;
constexpr size_t WS_TOPE = WS_SM2, WS_GATE = WS_SM2 + 512 * 1024, WS_LRANK = WS_SM2 + 1024 * 1024, WS_TOKSLOT = WS_SM2 + 1536 * 1024, WS_SLOTGATE = WS_SM2 + 2 * MiB, WS_DECAY = WS_SM2 + 3 * MiB;
constexpr size_t WS_WRT = WS_SMALL + 256 * 1024;
constexpr size_t WS_WGBASE = WS_SMALL, WS_TILEE = WS_SMALL + 64 * 1024;
constexpr int CW_CNT = 64;
constexpr int CW_BAR = 1024;
constexpr int XBW_OFF = 147456 - 16;

constexpr int RING_BYTES = 131072, MISC_OFF = RING_BYTES, LDS_BYTES = 147456;
constexpr int NWAVES = 8, NTHR = 512;

#define GAS __attribute__((address_space(1)))
#define LAS __attribute__((address_space(3)))
typedef unsigned short bf16;
typedef unsigned v4u __attribute__((ext_vector_type(4)));
typedef unsigned v2u __attribute__((ext_vector_type(2)));
typedef float f32x4 __attribute__((ext_vector_type(4)));
typedef short bf16x8 __attribute__((ext_vector_type(8)));
#define LDS_WAIT() asm volatile("s_waitcnt lgkmcnt(0)" ::: "memory")
#define VM_WAIT() asm volatile("s_waitcnt vmcnt(0)" ::: "memory")
__device__ __forceinline__ unsigned f2bf(float f) { unsigned u = __builtin_bit_cast(unsigned, f); return (u + 0x7fffu + ((u >> 16) & 1u)) >> 16; }
__device__ __forceinline__ unsigned pk2(float lo, float hi) { return f2bf(lo) | (f2bf(hi) << 16); }
__device__ __forceinline__ float bf2f(unsigned short b) { return __builtin_bit_cast(float, (unsigned)b << 16); }
__device__ __forceinline__ float bflo(unsigned w) { return __builtin_bit_cast(float, w << 16); }
__device__ __forceinline__ float bfhi(unsigned w) { return __builtin_bit_cast(float, w & 0xffff0000u); }
__device__ __forceinline__ float wave_sum(float v) {
#pragma unroll
    for (int o = 1; o < 64; o <<= 1) v += __shfl_xor(v, o);
    return v;
}
__device__ __forceinline__ float sigmoidf_(float x) { return __builtin_amdgcn_rcpf(1.f + __builtin_amdgcn_exp2f(x * -1.4426950408889634f)); }

__device__ __forceinline__ unsigned pk4_fp8(float a, float b, float c, float d);
struct Params { const float* in[25]; float* out; unsigned char* ws; };
enum { I_X = 0, I_P, I_WIN, I_KVG, I_IKG, I_IKB, I_WUK, I_WUV, I_HGLB, I_HGNG, I_WO, I_LNMG, I_LNMB, I_WR, I_BR, I_WUP, I_BUP, I_WDN, I_BDN, I_LNFG, I_LNFB, I_WPP, I_WPG, I_LNPG, I_LNPB };

struct Ctx { LAS unsigned char* lds; int tid, lane, wave, G, gw, ngw; };

namespace pg8 {
struct EpiBf16s {
    static constexpr bool PERM = true, AFTER_DRAIN = false;
    bf16_t* O; int ldc;
    __device__ __forceinline__ void operator()(const f32x4 (&acc)[2][2][4][2], const Unit& u, int wr, int wc, int fr, int fq) const {
        const int row0 = u.pm * BM + wr * 64 + fr, col0 = u.pn * BM + wc * 32 + 8 * fq;
#pragma unroll
        for (int ai = 0; ai < 2; ++ai)
#pragma unroll
            for (int m = 0; m < 4; ++m) { bf16_t* rowp = O + (size_t)(row0 + ai * HALF + m * 16) * ldc + col0;
#pragma unroll
                for (int bj = 0; bj < 2; ++bj) { const f32x4 v0 = acc[ai][bj][m][0], v1 = acc[ai][bj][m][1];
                    u32x4 w; w.x = cvt_pk_bf16(v0[0], v0[1]); w.y = cvt_pk_bf16(v0[2], v0[3]); w.z = cvt_pk_bf16(v1[0], v1[1]); w.w = cvt_pk_bf16(v1[2], v1[3]);
                    *(u32x4*)(rowp + bj * HALF) = w; } }
    }
};
struct EpiResid {
    static constexpr bool PERM = false, AFTER_DRAIN = false;
    const bf16_t* res; bf16_t* out; int ldc; float alpha, as;
    __device__ __forceinline__ void operator()(const f32x4 (&acc)[2][2][4][2], const Unit& u, int wr, int wc, int fr, int fq) const {
        const int row0 = u.pm * BM + wr * 64 + fr, col0 = u.pn * BM + wc * 32 + 4 * fq;
#pragma unroll
        for (int ai = 0; ai < 2; ++ai)
#pragma unroll
            for (int m = 0; m < 4; ++m) { const size_t off = (size_t)(row0 + ai * HALF + m * 16) * ldc + col0;
#pragma unroll
                for (int bj = 0; bj < 2; ++bj)
#pragma unroll
                    for (int n = 0; n < 2; ++n) { const v2u rw = *(const v2u*)(res + off + bj * HALF + n * 16); const f32x4 r = {bflo(rw.x), bfhi(rw.x), bflo(rw.y), bfhi(rw.y)}; const f32x4 o = r * alpha + acc[ai][bj][m][n] * as; v2u w; w.x = cvt_pk_bf16(o[0], o[1]); w.y = cvt_pk_bf16(o[2], o[3]); *(v2u*)(out + off + bj * HALF + n * 16) = w; }
                asm volatile("" ::: "memory"); }
    }
};
struct EpiPle {
    static constexpr bool PERM = false, AFTER_DRAIN = false;
    const bf16_t* x2; const bf16_t* proj; bf16_t* out; float alpha, as;
    __device__ __forceinline__ void operator()(const f32x4 (&acc)[2][2][4][2], const Unit& u, int wr, int wc, int fr, int fq) const {
        const int row0 = u.pm * BM + wr * 64 + fr, col0 = u.pn * BM + wc * 32 + 4 * fq;
#pragma unroll
        for (int ai = 0; ai < 2; ++ai)
#pragma unroll
            for (int m = 0; m < 4; ++m) { const size_t off = (size_t)(row0 + ai * HALF + m * 16) * 1024 + col0;
#pragma unroll
                for (int bj = 0; bj < 2; ++bj)
#pragma unroll
                    for (int n = 0; n < 2; ++n) { const size_t o2 = off + bj * HALF + n * 16; const v2u rw = *(const v2u*)(x2 + o2); const f32x4 r = {bflo(rw.x), bfhi(rw.x), bflo(rw.y), bfhi(rw.y)}; const v2u pw = *(const v2u*)(proj + o2);
                        const f32x4 a = acc[ai][bj][m][n] * as; f32x4 o;
                        o[0] = r[0] * alpha + bflo(pw.x) * sigmoidf_(a[0]); o[1] = r[1] * alpha + bfhi(pw.x) * sigmoidf_(a[1]);
                        o[2] = r[2] * alpha + bflo(pw.y) * sigmoidf_(a[2]); o[3] = r[3] * alpha + bfhi(pw.y) * sigmoidf_(a[3]);
                        v2u ow; ow.x = cvt_pk_bf16(o[0], o[1]); ow.y = cvt_pk_bf16(o[2], o[3]); *(v2u*)(out + o2) = ow; }
                asm volatile("" ::: "memory"); }
    }
};
struct EpiSwiglu {
    static constexpr bool PERM = true, AFTER_DRAIN = false;
    unsigned char* H; const float* b_up;
    __device__ __forceinline__ void operator()(const f32x4 (&acc)[2][2][4][2], const Unit& u, int wr, int wc, int fr, int fq) const {
        const int e = u.pn >> 3, pnT = u.pn & 7;
        const int row0 = u.pm * BM + wr * 64 + fr, col0 = pnT * 128 + wc * 32 + 8 * fq;
        const float* bg = b_up + (size_t)e * 2048 + col0; const float* bl = bg + 1024;
        float bgv[8], blv[8];
#pragma unroll
        for (int j = 0; j < 8; ++j) { bgv[j] = bg[j]; blv[j] = bl[j]; }
#pragma unroll
        for (int ai = 0; ai < 2; ++ai)
#pragma unroll
            for (int m = 0; m < 4; ++m) { unsigned char* rowp = H + (size_t)(row0 + ai * HALF + m * 16) * 1024 + col0; float a[8];
#pragma unroll
                for (int n = 0; n < 2; ++n)
#pragma unroll
                    for (int j = 0; j < 4; ++j) { float g = acc[ai][0][m][n][j] * (1.f / 512.f) + bgv[4 * n + j], l = acc[ai][1][m][n][j] * (1.f / 512.f) + blv[4 * n + j];
                        g = fminf(g, 7.0f); l = fminf(fmaxf(l, -7.0f), 7.0f); a[4 * n + j] = g * sigmoidf_(1.702f * g) * (l + 1.0f); }
                v2u w; w.x = pk4_fp8(a[0] * 4.f, a[1] * 4.f, a[2] * 4.f, a[3] * 4.f); w.y = pk4_fp8(a[4] * 4.f, a[5] * 4.f, a[6] * 4.f, a[7] * 4.f);
                *(v2u*)rowp = w; }
    }
};
struct EpiDown {
    static constexpr bool PERM = true, AFTER_DRAIN = false;
    unsigned char* Y; const float* b_dn; const float* gate;
    __device__ __forceinline__ void operator()(const f32x4 (&acc)[2][2][4][2], const Unit& u, int wr, int wc, int fr, int fq) const {
        const int e = u.pn >> 2, pnT = u.pn & 3;
        const int row0 = u.pm * BM + wr * 64 + fr, col0 = pnT * 256 + wc * 32 + 8 * fq;
        const float* bb = b_dn + (size_t)e * 1024 + col0;
        float bv[2][8];
#pragma unroll
        for (int bj = 0; bj < 2; ++bj)
#pragma unroll
            for (int j = 0; j < 8; ++j) bv[bj][j] = bb[bj * HALF + j];
#pragma unroll
        for (int ai = 0; ai < 2; ++ai)
#pragma unroll
            for (int m = 0; m < 4; ++m) { const int row = row0 + ai * HALF + m * 16; const float gt = gate[row] * 64.f; unsigned char* rowp = Y + (size_t)row * 1024 + col0;
#pragma unroll
                for (int bj = 0; bj < 2; ++bj) { const f32x4 v0 = acc[ai][bj][m][0], v1 = acc[ai][bj][m][1];
                    const float as = 1.f / 256.f;
                    v2u w; w.x = pk4_fp8((v0[0] * as + bv[bj][0]) * gt, (v0[1] * as + bv[bj][1]) * gt, (v0[2] * as + bv[bj][2]) * gt, (v0[3] * as + bv[bj][3]) * gt);
                    w.y = pk4_fp8((v1[0] * as + bv[bj][4]) * gt, (v1[1] * as + bv[bj][5]) * gt, (v1[2] * as + bv[bj][6]) * gt, (v1[3] * as + bv[bj][7]) * gt);
                    *(v2u*)(rowp + bj * HALF) = w; } }
    }
};
struct MoeOrder {
    const int* tile_e; int ntiles, nN, G, c;
    __device__ __forceinline__ bool next(int i, Unit& u) const {
        if ((G & 7) == 0) {
            const int x = c & 7, s = i * (G >> 3) + (c >> 3);
            const int cg = nN >> 2, rg = 8 / cg;
            const int ch = x % cg, rc = x / cg;
            const int lr = s >> 2, pl = 4 * ch + (s & 3), pm = rc + rg * lr;
            if (pm >= ntiles) return false;
            u.pm = pm; u.pn = tile_e[pm] * nN + pl; return true;
        }
        const int L = i * G + c; if (L >= ntiles * nN) return false;
        const int pm = L / nN, pl = L - pm * nN; u.pm = pm; u.pn = tile_e[pm] * nN + pl; return true;
    }
    __device__ __forceinline__ void a_ready(const Unit&) const {}
    __device__ __forceinline__ void done(const Unit&) const {}
};
}

template <class RowMap>
__device__ __forceinline__ void transpose_item(const float* W, int ldw, int Nvalid, bf16* WT, int Kdim, RowMap rm, LAS float* scr, int kb, int nb, int lane) {
    const int k0 = 64 * kb, n0 = 32 * nb; const int nl0 = lane & 31, nn = n0 + nl0;
#pragma unroll 8
    for (int i = 0; i < 32; ++i) { const int kk = 2 * i + (lane >> 5); scr[kk * 33 + nl0] = (nn < Nvalid) ? W[(size_t)(k0 + kk) * ldw + nn] : 0.f; }
    LDS_WAIT(); asm volatile("" ::: "memory");
    const int c = lane & 7;
#pragma unroll
    for (int j = 0; j < 4; ++j) { const int n = (lane >> 3) + 8 * j; const LAS float* s = scr + (8 * c) * 33 + n;
        v4u o; o.x = pk2(s[0 * 33], s[1 * 33]); o.y = pk2(s[2 * 33], s[3 * 33]); o.z = pk2(s[4 * 33], s[5 * 33]); o.w = pk2(s[6 * 33], s[7 * 33]);
        *(GAS v4u*)(WT + (size_t)rm(n0 + n) * Kdim + k0 + 8 * c) = o; }
    LDS_WAIT(); asm volatile("" ::: "memory");
}
__device__ __forceinline__ unsigned pk4_fp8(float a, float b, float c, float d) { int r = 0; r = __builtin_amdgcn_cvt_pk_fp8_f32(a, b, r, false); r = __builtin_amdgcn_cvt_pk_fp8_f32(c, d, r, true); return (unsigned)r; }
template <class RowMap>
__device__ __forceinline__ void transpose_item_f8(const float* W, int ldw, unsigned char* WT, int Kdim, RowMap rm, LAS float* scr, int kb, int nb, int lane, float mul) {
    const int k0 = 64 * kb, n0 = 32 * nb; const int nl0 = lane & 31, nn = n0 + nl0;
#pragma unroll 8
    for (int i = 0; i < 32; ++i) { const int kk = 2 * i + (lane >> 5); scr[kk * 33 + nl0] = W[(size_t)(k0 + kk) * ldw + nn] * mul; }
    LDS_WAIT(); asm volatile("" ::: "memory");
    const int c = lane & 7;
#pragma unroll
    for (int j = 0; j < 4; ++j) { const int n = (lane >> 3) + 8 * j; const LAS float* s = scr + (8 * c) * 33 + n;
        v2u o; o.x = pk4_fp8(s[0 * 33], s[1 * 33], s[2 * 33], s[3 * 33]); o.y = pk4_fp8(s[4 * 33], s[5 * 33], s[6 * 33], s[7 * 33]);
        *(GAS v2u*)(WT + (size_t)rm(n0 + n) * Kdim + k0 + 8 * c) = o; }
    LDS_WAIT(); asm volatile("" ::: "memory");
}
struct RmId { __device__ __forceinline__ int operator()(int n) const { return n; } };
struct RmUp { int e; __device__ __forceinline__ int operator()(int n) const { return e * 2048 + ((n & 1023) >> 7) * 256 + (n >> 10) * 128 + (n & 127); } };
struct RmOff { int off; __device__ __forceinline__ int operator()(int n) const { return off + n; } };

struct CvtItem { const float* src; unsigned char* dst; int ldw; };
__device__ __forceinline__ CvtItem cvt_decode(const Params& P, int r) {
    unsigned char* ws = P.ws; CvtItem c;
    constexpr int I_O = 8 * 32, I_UP = 8 * 64, I_DN = 8 * 32;
    if (r < I_O) { const int kb = r / 32, nb = r % 32; c.src = P.in[I_WO] + (size_t)(128 * kb) * 1024 + 32 * nb; c.ldw = 1024; c.dst = ws + WS_WO_T + (size_t)(32 * nb) * 1024 + 128 * kb; return c; } r -= I_O;
    if (r < NE * I_UP) { const int e = r / I_UP, q = r % I_UP, kb = q / 64, nb = q % 64, n0 = 32 * nb; c.src = P.in[I_WUP] + (size_t)e * 1024 * 2048 + (size_t)(128 * kb) * 2048 + n0; c.ldw = 2048;
        c.dst = ws + WS_WUP_T + (size_t)(e * 2048 + ((n0 & 1023) >> 7) * 256 + (n0 >> 10) * 128 + (n0 & 127)) * 1024 + 128 * kb; return c; } r -= NE * I_UP;
    if (r < NE * I_DN) { const int e = r / I_DN, q = r % I_DN, kb = q / 32, nb = q % 32; c.src = P.in[I_WDN] + (size_t)e * 1024 * 1024 + (size_t)(128 * kb) * 1024 + 32 * nb; c.ldw = 1024;
        c.dst = ws + WS_WDN_T + (size_t)(e * 1024 + 32 * nb) * 1024 + 128 * kb; return c; } r -= NE * I_DN;
    { const int kb = r / 32, nb = r % 32; c.src = P.in[I_WPG] + (size_t)(128 * kb) * 1024 + 32 * nb; c.ldw = 1024; c.dst = ws + WS_WGATE_T + (size_t)(32 * nb) * 1024 + 128 * kb; return c; }
}
__device__ __forceinline__ void cvt_load(const CvtItem& c, float (&v)[64], int lane) {
    const float* p = c.src + (size_t)(lane >> 5) * c.ldw + (lane & 31);
#pragma unroll
    for (int i = 0; i < 64; ++i) v[i] = p[(size_t)(2 * i) * c.ldw];
}
__device__ __forceinline__ void cvt_store(const CvtItem& c, const float (&v)[64], LAS float* scr, int lane) {
#pragma unroll
    for (int i = 0; i < 64; ++i) scr[(2 * i + (lane >> 5)) * 33 + (lane & 31)] = v[i] * 64.f;
    LDS_WAIT(); asm volatile("" ::: "memory");
    const int ch = lane & 15;
#pragma unroll
    for (int j = 0; j < 8; ++j) { const int n = (lane >> 4) + 4 * j; const LAS float* s = scr + (8 * ch) * 33 + n;
        v2u o; o.x = pk4_fp8(s[0 * 33], s[1 * 33], s[2 * 33], s[3 * 33]); o.y = pk4_fp8(s[4 * 33], s[5 * 33], s[6 * 33], s[7 * 33]);
        *(GAS v2u*)(c.dst + (size_t)n * 1024 + 8 * ch) = o; }
    LDS_WAIT(); asm volatile("" ::: "memory");
}
__device__ __forceinline__ void convert_late(const Params& P, LAS float* scr, int gwc, int ngwc, int lane) {
    constexpr int NT = 8 * 32 + NE * 8 * 64 + NE * 8 * 32 + 8 * 32;
    float va[64], vb[64];
    int it = gwc;
    if (it < NT) { const CvtItem c = cvt_decode(P, it); cvt_load(c, va, lane); }
    for (; it < NT; it += 2 * ngwc) {
        const int i1 = it + ngwc, i2 = it + 2 * ngwc;
        if (i1 < NT) { const CvtItem c = cvt_decode(P, i1); cvt_load(c, vb, lane); }
        { const CvtItem c = cvt_decode(P, it); cvt_store(c, va, scr, lane); }
        if (i2 < NT) { const CvtItem c = cvt_decode(P, i2); cvt_load(c, va, lane); }
        if (i1 < NT) { const CvtItem c = cvt_decode(P, i1); cvt_store(c, vb, scr, lane); }
    }
    for (int r = gwc; r < 512; r += ngwc) { const int i = r * 64 + lane; const int e = i >> 10, k = i & 1023; ((float*)(P.ws + WS_WRT))[i] = P.in[I_WR][k * 32 + e]; }
}
__device__ __forceinline__ void p0_prologue(const Params& P, const Ctx& C) {
    LAS float* scr = (LAS float*)(C.lds + C.wave * 16384);
    unsigned char* ws = P.ws;
    constexpr int I_IN = 16 * (D_INP / 32), I_PP = 4 * 32, I_UK = 4 * 16, I_UV = 4 * 16;
    constexpr int NITEMS = I_IN + I_PP + I_UK + I_UV;
    for (int it = C.gw; it < NITEMS; it += C.ngw) {
        int r = it;
        if (r < I_IN) { transpose_item(P.in[I_WIN], D_IN, D_IN, (bf16*)(ws + WS_WIN_T), 1024, RmId{}, scr, r / (D_INP / 32), r % (D_INP / 32), C.lane); continue; } r -= I_IN;
        if (r < I_PP) { transpose_item(P.in[I_WPP], 1024, 1024, (bf16*)(ws + WS_WPROJ_T), 256, RmId{}, scr, r / 32, r % 32, C.lane); continue; } r -= I_PP;
        if (r < I_UK) { transpose_item(P.in[I_WUK], 512, 512, (bf16*)(ws + WS_WUK_T), 256, RmId{}, scr, r / 16, r % 16, C.lane); continue; } r -= I_UK;
        transpose_item(P.in[I_WUV], 512, 512, (bf16*)(ws + WS_WUV_T), 256, RmId{}, scr, r / 16, r % 16, C.lane);
    }
    {
        const float* x = P.in[I_X]; bf16* xb = (bf16*)(ws + WS_XBF);
        const size_t n8 = (size_t)NTOK * D / 8, stride = (size_t)C.ngw * 64;
        for (size_t i = (size_t)C.gw * 64 + C.lane; i < n8; i += stride) { const f32x4 a = *(const GAS f32x4*)(x + i * 8), b = *(const GAS f32x4*)(x + i * 8 + 4);
            v4u o; o.x = pk2(a[0], a[1]); o.y = pk2(a[2], a[3]); o.z = pk2(b[0], b[1]); o.w = pk2(b[2], b[3]); *(GAS v4u*)(xb + i * 8) = o; }
        const float* p = P.in[I_P]; bf16* pb = (bf16*)(ws + WS_PB);
        const size_t m8 = (size_t)NTOK * PLE / 8;
        for (size_t i = (size_t)C.gw * 64 + C.lane; i < m8; i += stride) { const f32x4 a = *(const GAS f32x4*)(p + i * 8), b = *(const GAS f32x4*)(p + i * 8 + 4);
            v4u o; o.x = pk2(a[0], a[1]); o.y = pk2(a[2], a[3]); o.z = pk2(b[0], b[1]); o.w = pk2(b[2], b[3]); *(GAS v4u*)(pb + i * 8) = o; }
    }
}

__device__ __forceinline__ void ln_row(f32x4 (&v)[4], const float* g, const float* b, int lane) {
    float s = 0.f;
#pragma unroll
    for (int j = 0; j < 4; ++j) s += (v[j][0] + v[j][1]) + (v[j][2] + v[j][3]);
    const float mean = wave_sum(s) * (1.f / D); float s2 = 0.f;
#pragma unroll
    for (int j = 0; j < 4; ++j) { v[j] = v[j] - mean; s2 += (v[j][0] * v[j][0] + v[j][1] * v[j][1]) + (v[j][2] * v[j][2] + v[j][3] * v[j][3]); }
    const float rstd = __builtin_amdgcn_rsqf(wave_sum(s2) * (1.f / D) + LN_EPS);
#pragma unroll
    for (int j = 0; j < 4; ++j) { const f32x4 gg = *(const f32x4*)(g + 4 * lane + 256 * j), bb = *(const f32x4*)(b + 4 * lane + 256 * j); v[j] = v[j] * rstd * gg + bb; }
}
__device__ __forceinline__ void store_row_f32(float* row, const f32x4 (&v)[4], int lane) {
#pragma unroll
    for (int j = 0; j < 4; ++j) *(GAS f32x4*)(row + 4 * lane + 256 * j) = v[j];
}
__device__ __forceinline__ void store_row_bf16(bf16* row, const f32x4 (&v)[4], int lane) {
#pragma unroll
    for (int j = 0; j < 4; ++j) { v2u o; o.x = pk2(v[j][0], v[j][1]); o.y = pk2(v[j][2], v[j][3]); *(GAS v2u*)(row + 4 * lane + 256 * j) = o; }
}
__device__ __forceinline__ void store_row_fp8x8(unsigned char* row, const f32x4 (&v)[4], int lane) {
#pragma unroll
    for (int j = 0; j < 4; ++j) *(GAS unsigned*)(row + 4 * lane + 256 * j) = pk4_fp8(v[j][0] * 8.f, v[j][1] * 8.f, v[j][2] * 8.f, v[j][3] * 8.f);
}
__device__ __forceinline__ f32x4 fp8x4_to_f32(unsigned w) {
    typedef float f2 __attribute__((ext_vector_type(2)));
    const f2 lo = __builtin_amdgcn_cvt_pk_f32_fp8((int)w, false), hi = __builtin_amdgcn_cvt_pk_f32_fp8((int)w, true);
    return (f32x4){lo[0], lo[1], hi[0], hi[1]};
}
__device__ __forceinline__ void load_row_bf16(f32x4 (&v)[4], const bf16* row, int lane) {
#pragma unroll
    for (int j = 0; j < 4; ++j) { const v2u w = *(const GAS v2u*)(row + 4 * lane + 256 * j); v[j] = (f32x4){bflo(w.x), bfhi(w.x), bflo(w.y), bfhi(w.y)}; }
}
__device__ __forceinline__ void load_row_f32(f32x4 (&v)[4], const float* row, int lane) {
#pragma unroll
    for (int j = 0; j < 4; ++j) v[j] = *(const GAS f32x4*)(row + 4 * lane + 256 * j);
}
#ifndef FEAT_MIX
#define FEAT_MIX 1
#endif
#ifndef FEAT_MOE
#define FEAT_MOE 1
#endif
#ifndef FEAT_PLE
#define FEAT_PLE 1
#endif
#ifndef FEAT_ATT
#define FEAT_ATT 1
#endif
#ifndef SYNC_MODE
#define SYNC_MODE 0
#endif
#ifndef PROGRAM
#define PROGRAM X(0) GS X(10) X(11) SY X(20) X(21) SY X(30) X(31) BS X(32) SY X(40) X(41) SY X(5) SY X(6) SY X(7) SY X(8) SY X(9) SY X(100) SY X(110) SY X(120)
#endif

typedef float f32x16 __attribute__((ext_vector_type(16)));
typedef short s16x4 __attribute__((ext_vector_type(4)));
__device__ __forceinline__ unsigned cvtpk(float lo, float hi) { typedef float f2 __attribute__((ext_vector_type(2))); typedef __bf16 b2 __attribute__((ext_vector_type(2))); f2 v = {lo, hi}; b2 b = __builtin_convertvector(v, b2); return __builtin_bit_cast(unsigned, b); }
__device__ __forceinline__ bf16x8 pack8(const f32x16& x, int base) {
    v4u w; w.x = cvtpk(x[base + 0], x[base + 1]); w.y = cvtpk(x[base + 2], x[base + 3]); w.z = cvtpk(x[base + 4], x[base + 5]); w.w = cvtpk(x[base + 6], x[base + 7]);
    return __builtin_bit_cast(bf16x8, w);
}

__device__ __forceinline__ void p2_post(const Params& P, const Ctx& C) {
    unsigned char* ws = P.ws;
    const bf16* H = (const bf16*)(ws + WS_H); bf16* CN = (bf16*)(ws + WS_CN); bf16* IKN = (bf16*)(ws + WS_IKN);
    const float* kvg = P.in[I_KVG]; const float* ikg = P.in[I_IKG]; const float* ikb = P.in[I_IKB];
    const f32x4 g4 = *(const f32x4*)(kvg + 4 * C.lane); const float ig = ikg[C.lane], ib = ikb[C.lane];
    for (int m = C.gw; m < NTOK; m += C.ngw) {
        const bf16* hr = H + (size_t)m * D_INP;
        const v2u w = *(const GAS v2u*)(hr + C_AC + 4 * C.lane);
        float a0 = bflo(w.x), a1 = bfhi(w.x), a2 = bflo(w.y), a3 = bfhi(w.y);
        const float ss = wave_sum((a0 * a0 + a1 * a1) + (a2 * a2 + a3 * a3));
        const float rs = __builtin_amdgcn_rsqf(ss * (1.f / 256.f) + RMS_EPS);
        v2u o; o.x = pk2(a0 * rs * g4[0], a1 * rs * g4[1]); o.y = pk2(a2 * rs * g4[2], a3 * rs * g4[3]);
        *(GAS v2u*)(CN + (size_t)m * 256 + 4 * C.lane) = o;
        const float k = bf2f(hr[C_IK + C.lane]);
        const float mu = wave_sum(k) * (1.f / 64.f); const float dk = k - mu;
        const float var = wave_sum(dk * dk) * (1.f / 64.f);
        IKN[(size_t)m * 64 + C.lane] = (bf16)f2bf(dk * __builtin_amdgcn_rsqf(var + LN_EPS) * ig + ib);
    }
}

constexpr int HP_QD = 0, HP_KI = 8704, HP_KET = 17408, HP_VT = 27648, HP_GS = 37888, HP_RAW = 40960;
__device__ __forceinline__ void p2_hgrn_prep(const Params& P, const Ctx& C) {
    unsigned char* ws = P.ws;
    const bf16* H = (const bf16*)(ws + WS_H);
    bf16* UT = (bf16*)(ws + WS_U); bf16* QDEC = (bf16*)(ws + WS_QDEC); float* OREC = (float*)(ws + WS_OREC); float* DEC = (float*)(ws + WS_DECAY);
    LAS bf16* QD = (LAS bf16*)(C.lds + HP_QD); LAS bf16* KI = (LAS bf16*)(C.lds + HP_KI); LAS bf16* KET = (LAS bf16*)(C.lds + HP_KET); LAS bf16* VT = (LAS bf16*)(C.lds + HP_VT);
    LAS float* GS = (LAS float*)(C.lds + HP_GS); LAS bf16* RAW = (LAS bf16*)(C.lds + HP_RAW);
    const int d = C.tid & 127, tg = C.tid >> 7;
    const int lane = C.lane, r32 = lane & 31, hf = lane >> 5;
    const int lc = C.tid >> 4, lg = C.tid & 15;
    const int NU = NB * HG_H * (T / HG_C);
    v4u rf, rq, ri;
    { const int unit = blockIdx.x; if (unit < NU) { const int n = unit & 127, hh = (unit >> 7) & 3, b = unit >> 9; const bf16* hr = H + (size_t)(b * T + n * HG_C + lc) * D_INP + hh * 128 + 8 * lg;
        rf = *(const GAS v4u*)(hr + C_GF); rq = *(const GAS v4u*)(hr + C_GQ); ri = *(const GAS v4u*)(hr + C_GI); } }
    for (int unit = blockIdx.x; unit < NU; unit += C.G) {
        const int n = unit & 127, hh = (unit >> 7) & 3, b = unit >> 9;
        const int m0 = b * T + n * HG_C;
        *(LAS v4u*)(RAW + lc * 128 + 8 * lg) = rf; *(LAS v4u*)(RAW + 4096 + lc * 128 + 8 * lg) = rq; *(LAS v4u*)(RAW + 8192 + lc * 128 + 8 * lg) = ri;
        __syncthreads();
        { const int un = unit + C.G; if (un < NU) { const int n2 = un & 127, h2 = (un >> 7) & 3, b2 = un >> 9; const bf16* hr = H + (size_t)(b2 * T + n2 * HG_C + lc) * D_INP + h2 * 128 + 8 * lg;
            rf = *(const GAS v4u*)(hr + C_GF); rq = *(const GAS v4u*)(hr + C_GQ); ri = *(const GAS v4u*)(hr + C_GI); } }
        const float l0 = P.in[I_HGLB][hh * 128 + d], l1 = P.in[I_HGLB][512 + hh * 128 + d];
        const float lb = sigmoidf_(l0 - l1);
        float fg[8], bl[8], qv[8]; float run = 0.f; unsigned vv[4];
#pragma unroll
        for (int c = 0; c < 8; ++c) { const int tok = tg * 8 + c;
            const float f = bf2f(RAW[tok * 128 + d]), q = bf2f(RAW[4096 + tok * 128 + d]); const unsigned iv = RAW[8192 + tok * 128 + d];
            fg[c] = lb + (1.f - lb) * sigmoidf_(f); run += __logf(fg[c]); bl[c] = run; qv[c] = q * sigmoidf_(q);
            if (c & 1) vv[c >> 1] |= iv << 16; else vv[c >> 1] = iv; }
        GS[tg * 128 + d] = run;
        *(LAS v4u*)(VT + d * 40 + tg * 8) = (v4u){vv[0], vv[1], vv[2], vv[3]};
        __syncthreads();
        float pre = 0.f, tot = 0.f;
#pragma unroll
        for (int g = 0; g < 4; ++g) { const float sg = GS[g * 128 + d]; tot += sg; if (g < tg) pre += sg; }
        unsigned ke[4];
#pragma unroll
        for (int c = 0; c < 8; ++c) { const float bc = pre + bl[c]; const float kc = 1.f - fg[c];
            const float qd = qv[c] * __expf(bc), ki = kc * __expf(-bc), kend = kc * __expf(tot - bc);
            const unsigned qb = f2bf(qd);
            QD[(tg * 8 + c) * 136 + d] = (bf16)qb; KI[(tg * 8 + c) * 136 + d] = (bf16)f2bf(ki);
            if (c & 1) ke[c >> 1] |= f2bf(kend) << 16; else ke[c >> 1] = f2bf(kend); }
        *(LAS v4u*)(KET + d * 40 + tg * 8) = (v4u){ke[0], ke[1], ke[2], ke[3]};
        if (tg == 0) DEC[(size_t)unit * 128 + d] = __expf(tot);
        __syncthreads();
        *(GAS v4u*)(QDEC + (size_t)(m0 + lc) * 512 + hh * 128 + 8 * lg) = *(const LAS v4u*)(QD + lc * 136 + 8 * lg);
        if (C.wave < 4) {
            f32x16 X = {0.f, 0.f, 0.f, 0.f, 0.f, 0.f, 0.f, 0.f, 0.f, 0.f, 0.f, 0.f, 0.f, 0.f, 0.f, 0.f};
#pragma unroll
            for (int k = 0; k < 8; ++k) { const bf16x8 a = *(const LAS bf16x8*)(KI + r32 * 136 + 16 * k + 8 * hf), bq = *(const LAS bf16x8*)(QD + r32 * 136 + 16 * k + 8 * hf);
                X = __builtin_amdgcn_mfma_f32_32x32x16_bf16(a, bq, X, 0, 0, 0); }
#pragma unroll
            for (int r = 0; r < 16; ++r) { const int sidx = (r & 3) + 8 * (r >> 2) + 4 * hf; if (sidx > r32) X[r] = 0.f; }
            f32x16 Z = {0.f, 0.f, 0.f, 0.f, 0.f, 0.f, 0.f, 0.f, 0.f, 0.f, 0.f, 0.f, 0.f, 0.f, 0.f, 0.f};
            const int e = C.wave * 32 + r32;
#pragma unroll
            for (int sp = 0; sp < 2; ++sp) { const bf16x8 a = pack8(X, 8 * sp);
                const s16x4 lo = *(const LAS s16x4*)(VT + e * 40 + 16 * sp + 4 * hf), hi = *(const LAS s16x4*)(VT + e * 40 + 16 * sp + 8 + 4 * hf);
                const bf16x8 bv = (bf16x8){lo[0], lo[1], lo[2], lo[3], hi[0], hi[1], hi[2], hi[3]};
                Z = __builtin_amdgcn_mfma_f32_32x32x16_bf16(a, bv, Z, 0, 0, 0); }
#pragma unroll
            for (int r = 0; r < 16; ++r) { const int c = (r & 3) + 8 * (r >> 2) + 4 * hf; OREC[(size_t)(m0 + c) * 512 + hh * 128 + e] = Z[r]; }
        }
        {
            const int dt = C.wave >> 1;
            const bf16x8 a0 = *(const LAS bf16x8*)(KET + (dt * 32 + r32) * 40 + 8 * hf), a1 = *(const LAS bf16x8*)(KET + (dt * 32 + r32) * 40 + 16 + 8 * hf);
#pragma unroll
            for (int ei = 0; ei < 2; ++ei) { const int et = 2 * (C.wave & 1) + ei;
                const bf16x8 b0 = *(const LAS bf16x8*)(VT + (et * 32 + r32) * 40 + 8 * hf), b1 = *(const LAS bf16x8*)(VT + (et * 32 + r32) * 40 + 16 + 8 * hf);
                f32x16 U = {0.f, 0.f, 0.f, 0.f, 0.f, 0.f, 0.f, 0.f, 0.f, 0.f, 0.f, 0.f, 0.f, 0.f, 0.f, 0.f};
                U = __builtin_amdgcn_mfma_f32_32x32x16_bf16(a0, b0, U, 0, 0, 0); U = __builtin_amdgcn_mfma_f32_32x32x16_bf16(a1, b1, U, 0, 0, 0);
                bf16* up = UT + (size_t)unit * 16384 + (size_t)(et * 32 + r32) * 128 + dt * 32 + 4 * hf;
#pragma unroll
                for (int q = 0; q < 4; ++q) { v2u o; o.x = cvtpk(U[4 * q], U[4 * q + 1]); o.y = cvtpk(U[4 * q + 2], U[4 * q + 3]); *(GAS v2u*)(up + 8 * q) = o; } }
        }
        __syncthreads();
    }
}

__device__ __forceinline__ void scan_wave(const Params& P, LAS unsigned char* lds, int unit, int lane) {
    unsigned char* ws = P.ws;
    const bf16* UT = (const bf16*)(ws + WS_U); const bf16* QDEC = (const bf16*)(ws + WS_QDEC); float* OREC = (float*)(ws + WS_OREC); const float* DEC = (const float*)(ws + WS_DECAY);
    typedef float f32x4v __attribute__((ext_vector_type(4)));
    const int xcd = (unit >> 1) & 7, loc = ((unit >> 4) << 1) | (unit & 1);
    const int bh = xcd + 8 * (loc >> 4), sl = loc & 15; const int b = bh >> 2, hh = bh & 3, e0 = 8 * sl;
    LAS bf16* ST = (LAS bf16*)lds;
    const int e = lane & 7, dq = lane >> 3;
    const int fr = lane & 15, fq = lane >> 4;
    float S[16];
#pragma unroll
    for (int i = 0; i < 16; ++i) S[i] = 0.f;
    for (int i = lane; i < 2 * 16 * 136 / 8; i += 64) *(LAS v4u*)(ST + 8 * i) = (v4u){0u, 0u, 0u, 0u};
    const int cu0 = (b * HG_H + hh) * 128;
    const bf16* up = UT + (size_t)cu0 * 16384 + (size_t)(e0 + e) * 128 + 16 * dq;
    const float* dp = DEC + (size_t)cu0 * 128 + 16 * dq;
    const bf16* qp = QDEC + (size_t)(b * T + fr) * 512 + hh * 128 + 8 * fq;
    float* op = OREC + (size_t)(b * T + 4 * fq) * 512 + hh * 128 + e0 + fr;
    const float* opl = OREC + (size_t)(b * T + 4 * fq) * 512 + hh * 128 + e0 + (fr & 7);
    const bool ov = fr < 8;
    v4u un[4][2]; float oi[4][2][4]; f32x4 dn[2][4]; bf16x8 qa[2][2][4];
#define SC_LD_U(slot, n) { un[slot][0] = *(const GAS v4u*)(up + (size_t)(n) * 16384); un[slot][1] = *(const GAS v4u*)(up + (size_t)(n) * 16384 + 8); \
        _Pragma("unroll") for (int t_ = 0; t_ < 2; ++t_) _Pragma("unroll") for (int j_ = 0; j_ < 4; ++j_) oi[slot][t_][j_] = opl[(size_t)((n) * 32 + 16 * t_ + j_) * 512]; }
#define SC_LD_Q(slot, n) { _Pragma("unroll") for (int i_ = 0; i_ < 4; ++i_) dn[slot][i_] = *(const GAS f32x4*)(dp + (size_t)(n) * 128 + 4 * i_); \
        _Pragma("unroll") for (int t_ = 0; t_ < 2; ++t_) _Pragma("unroll") for (int k_ = 0; k_ < 4; ++k_) qa[slot][t_][k_] = *(const GAS bf16x8*)(qp + (size_t)((n) * 32 + 16 * t_) * 512 + 32 * k_); }
    SC_LD_U(0, 0) SC_LD_U(1, 1) SC_LD_U(2, 2) SC_LD_U(3, 3) SC_LD_Q(0, 0) SC_LD_Q(1, 1)
    LDS_WAIT();
    for (int nb = 0; nb < 32; ++nb) {
#pragma unroll
        for (int s = 0; s < 4; ++s) {
            const int n = 4 * nb + s; const int su = s, sq = s & 1;
            const LAS bf16* stc = ST + (n & 1) * (16 * 136); LAS bf16* stn = ST + ((n + 1) & 1) * (16 * 136);
            bf16x8 bs[4];
#pragma unroll
            for (int k = 0; k < 4; ++k) bs[k] = *(const LAS bf16x8*)(stc + fr * 136 + 32 * k + 8 * fq);
#pragma unroll
            for (int t = 0; t < 2; ++t) { f32x4v acc = {oi[su][t][0], oi[su][t][1], oi[su][t][2], oi[su][t][3]};
#pragma unroll
                for (int k = 0; k < 4; ++k) acc = __builtin_amdgcn_mfma_f32_16x16x32_bf16(qa[sq][t][k], bs[k], acc, 0, 0, 0);
                if (ov) {
#pragma unroll
                    for (int j = 0; j < 4; ++j) op[(size_t)(n * 32 + 16 * t + j) * 512] = acc[j]; } }
            {
                const unsigned uw[8] = {un[su][0].x, un[su][0].y, un[su][0].z, un[su][0].w, un[su][1].x, un[su][1].y, un[su][1].z, un[su][1].w};
                unsigned pk[8];
#pragma unroll
                for (int i = 0; i < 8; ++i) { S[2 * i] = dn[sq][i >> 1][(2 * i) & 3] * S[2 * i] + bflo(uw[i]); S[2 * i + 1] = dn[sq][i >> 1][(2 * i + 1) & 3] * S[2 * i + 1] + bfhi(uw[i]); pk[i] = cvtpk(S[2 * i], S[2 * i + 1]); }
                *(LAS v4u*)(stn + e * 136 + 16 * dq) = (v4u){pk[0], pk[1], pk[2], pk[3]}; *(LAS v4u*)(stn + e * 136 + 16 * dq + 8) = (v4u){pk[4], pk[5], pk[6], pk[7]};
            }
            if (n + 4 < 128) SC_LD_U(su, n + 4)
            if (n + 2 < 128) SC_LD_Q(sq, n + 2)
        }
    }
#undef SC_LD_U
#undef SC_LD_Q
}
__device__ __forceinline__ void p3_scan_convert(const Params& P, const Ctx& C) {
    if (C.wave < 2) {
        for (int u = blockIdx.x * 2 + C.wave; u < NB * HG_H * 16; u += C.G * 2) scan_wave(P, C.lds + C.wave * 8704, u, C.lane);
    } else {
        convert_late(P, (LAS float*)(C.lds + 32768 + (C.wave - 2) * 17408), blockIdx.x * 6 + (C.wave - 2), C.G * 6, C.lane);
    }
}

__device__ __forceinline__ void p4_yrec(const Params& P, const Ctx& C) {
    unsigned char* ws = P.ws;
    const float* OREC = (const float*)(ws + WS_OREC); const bf16* H = (const bf16*)(ws + WS_H); bf16* YM = (bf16*)(ws + WS_YMIX);
    const float* ng = P.in[I_HGNG];
    const f32x4 g0 = *(const f32x4*)(ng + 8 * C.lane), g1 = *(const f32x4*)(ng + 8 * C.lane + 4);
    for (int m = C.gw; m < NTOK; m += C.ngw) {
        const f32x4 a = *(const GAS f32x4*)(OREC + (size_t)m * 512 + 8 * C.lane), bq = *(const GAS f32x4*)(OREC + (size_t)m * 512 + 8 * C.lane + 4);
        float ss = (a[0] * a[0] + a[1] * a[1]) + (a[2] * a[2] + a[3] * a[3]) + (bq[0] * bq[0] + bq[1] * bq[1]) + (bq[2] * bq[2] + bq[3] * bq[3]);
        ss += __shfl_xor(ss, 1); ss += __shfl_xor(ss, 2); ss += __shfl_xor(ss, 4); ss += __shfl_xor(ss, 8);
        const float rs = __builtin_amdgcn_rsqf(ss * (1.f / 128.f) + RMS_EPS);
        const v4u gw = *(const GAS v4u*)(H + (size_t)m * D_INP + C_GG + 8 * C.lane);
        float gv[8] = {bflo(gw.x), bfhi(gw.x), bflo(gw.y), bfhi(gw.y), bflo(gw.z), bfhi(gw.z), bflo(gw.w), bfhi(gw.w)};
        float o[8];
#pragma unroll
        for (int j = 0; j < 4; ++j) { o[j] = a[j] * rs * g0[j] * (gv[j] * sigmoidf_(gv[j])); o[4 + j] = bq[j] * rs * g1[j] * (gv[4 + j] * sigmoidf_(gv[4 + j])); }
        v2u w; w.x = pk4_fp8(o[0] * 8.f, o[1] * 8.f, o[2] * 8.f, o[3] * 8.f); w.y = pk4_fp8(o[4] * 8.f, o[5] * 8.f, o[6] * 8.f, o[7] * 8.f);
        *(GAS v2u*)((unsigned char*)YM + (size_t)m * D + 512 + 8 * C.lane) = w;
#if !FEAT_ATT
        *(GAS v4u*)(YM + (size_t)m * D + 8 * C.lane) = (v4u){0u, 0u, 0u, 0u};
#endif
    }
}

namespace pg8 {
struct EpiKhead {
    static constexpr bool PERM = true, AFTER_DRAIN = false;
    bf16_t* O;
    __device__ __forceinline__ void operator()(const f32x4 (&acc)[2][2][4][2], const Unit& u, int wr, int wc, int fr, int fq) const {
        const int row0 = u.pm * BM + wr * 64 + fr, col0 = u.pn * BM + wc * 32 + 8 * fq;
#pragma unroll
        for (int ai = 0; ai < 2; ++ai)
#pragma unroll
            for (int m = 0; m < 4; ++m) { const int row = row0 + ai * HALF + m * 16; const int b = row >> 12, t = row & 4095;
#pragma unroll
                for (int bj = 0; bj < 2; ++bj) { const int col = col0 + bj * HALF; const f32x4 v0 = acc[ai][bj][m][0], v1 = acc[ai][bj][m][1];
                    u32x4 w; w.x = cvt_pk_bf16(v0[0], v0[1]); w.y = cvt_pk_bf16(v0[2], v0[3]); w.z = cvt_pk_bf16(v1[0], v1[1]); w.w = cvt_pk_bf16(v1[2], v1[3]);
                    *(u32x4*)(O + ((size_t)((b * 8 + (col >> 6)) * 4096 + t)) * 64 + (col & 63)) = w; } }
    }
};
struct EpiVt {
    static constexpr bool PERM = true, AFTER_DRAIN = false;
    bf16_t* O;
    __device__ __forceinline__ void operator()(const f32x4 (&acc)[2][2][4][2], const Unit& u, int wr, int wc, int fr, int fq) const {
        const int row0 = u.pm * BM + wr * 64 + fr, col0 = u.pn * BM + wc * 32 + 8 * fq;
#pragma unroll
        for (int ai = 0; ai < 2; ++ai)
#pragma unroll
            for (int m = 0; m < 4; ++m) { const int row = row0 + ai * HALF + m * 16;
#pragma unroll
                for (int bj = 0; bj < 2; ++bj) { const int col = col0 + bj * HALF; const int b = col >> 12, t = col & 4095; const f32x4 v0 = acc[ai][bj][m][0], v1 = acc[ai][bj][m][1];
                    u32x4 w; w.x = cvt_pk_bf16(v0[0], v0[1]); w.y = cvt_pk_bf16(v0[2], v0[3]); w.z = cvt_pk_bf16(v1[0], v1[1]); w.w = cvt_pk_bf16(v1[2], v1[3]);
                    *(u32x4*)(O + ((size_t)(b * 512 + row)) * 4096 + t) = w; } }
    }
};
}

__device__ __forceinline__ unsigned f2ord(float x) { const unsigned b = __builtin_bit_cast(unsigned, x); return b ^ ((unsigned)((int)b >> 31) | 0x80000000u); }
typedef _Float16 h16;
typedef _Float16 h16x8 __attribute__((ext_vector_type(8)));
__device__ __forceinline__ float relu_i(float x) { const int b = __builtin_bit_cast(int, x); return __builtin_bit_cast(float, b > 0 ? b : 0); }
__device__ __forceinline__ unsigned h2ord(unsigned hb) { return (hb ^ ((hb & 0x8000u) ? 0xffffu : 0x8000u)) & 0xffffu; }
__device__ __forceinline__ int isc_bucket(float x, float mu, float scale) { const float t = fminf(fmaxf(fmaf(x - mu, scale, 128.f), 0.f), 255.f); return (int)t; }
__device__ __forceinline__ void p3_indexer(const Params& P, const Ctx& C) {
    unsigned char* ws = P.ws;
    const bf16* H = (const bf16*)(ws + WS_H); const bf16* IKN = (const bf16*)(ws + WS_IKN); unsigned* MASK = (unsigned*)(ws + WS_MASK);
    LAS h16* ISC = (LAS h16*)C.lds; LAS unsigned* HIST = (LAS unsigned*)(C.lds + 131072) + C.wave * 256; LAS float* STAT = (LAS float*)(C.lds + 139264); LAS float* W16 = (LAS float*)(C.lds + 140288);
    const int lane = C.lane, r32 = lane & 31, hf = lane >> 5;
    const int ql = 2 * (r32 >> 4) + ((r32 >> 2) & 1), hd = 4 * ((r32 >> 3) & 1) + (r32 & 3);
    constexpr int CAND_CAP = 120, QU = 16;
    for (int u = blockIdx.x; u < NTOK / QU; u += C.G) {
        const int b = u & 7, j = (u >> 3) & 31, i = u >> 8; const int pi = i >> 1; const int blk = (i & 1) ? (255 - (j + 32 * pi)) : (j + 32 * pi);
        const int t0 = blk * QU; const size_t mb = (size_t)b * T;
        const int nkt = (t0 + QU + 31) >> 5;
        bf16x8 af[4][4];
#pragma unroll
        for (int a = 0; a < 4; ++a) {
            const bf16* qp = H + (mb + t0 + 4 * a + ql) * D_INP + C_IQ + hd * 64 + 8 * hf;
#pragma unroll
            for (int k = 0; k < 4; ++k) af[a][k] = *(const GAS bf16x8*)(qp + 16 * k);
        }
        if (C.tid < 128) { const int q = C.tid >> 3, h8 = C.tid & 7; W16[C.tid] = bf2f(H[(mb + t0 + q) * D_INP + C_IW + h8]) * (0.125f * 0.35355339059327373f); }
        __syncthreads();
        {
            int kt = C.wave; bf16x8 bk[4], bn[4];
            if (kt < nkt) { const bf16* kp = IKN + (mb + kt * 32 + r32) * 64 + 8 * hf;
#pragma unroll
                for (int k = 0; k < 4; ++k) bk[k] = *(const GAS bf16x8*)(kp + 16 * k); }
            for (; kt < nkt; kt += NWAVES) {
                const int s0 = kt * 32;
                if (kt + NWAVES < nkt) { const bf16* kp = IKN + (mb + s0 + 32 * NWAVES + r32) * 64 + 8 * hf;
#pragma unroll
                    for (int k = 0; k < 4; ++k) bn[k] = *(const GAS bf16x8*)(kp + 16 * k); }
#pragma unroll
                for (int a = 0; a < 4; ++a) {
                    f32x16 acc = {0.f, 0.f, 0.f, 0.f, 0.f, 0.f, 0.f, 0.f, 0.f, 0.f, 0.f, 0.f, 0.f, 0.f, 0.f, 0.f};
#pragma unroll
                    for (int k = 0; k < 4; ++k) acc = __builtin_amdgcn_mfma_f32_32x32x16_bf16(af[a][k], bk[k], acc, 0, 0, 0);
#pragma unroll
                    for (int qh = 0; qh < 2; ++qh) { float sa = 0.f, sb = 0.f;
                        const int q = 4 * a + 2 * qh + hf, key = s0 + r32;
                        const f32x4 wl = *(const LAS f32x4*)(W16 + q * 8), wh = *(const LAS f32x4*)(W16 + q * 8 + 4);
                        sa = fmaf(wl[0], relu_i(acc[8 * qh + 0]), sa); sb = fmaf(wl[1], relu_i(acc[8 * qh + 1]), sb); sa = fmaf(wl[2], relu_i(acc[8 * qh + 2]), sa); sb = fmaf(wl[3], relu_i(acc[8 * qh + 3]), sb);
                        sa = fmaf(wh[0], relu_i(acc[8 * qh + 4]), sa); sb = fmaf(wh[1], relu_i(acc[8 * qh + 5]), sb); sa = fmaf(wh[2], relu_i(acc[8 * qh + 6]), sa); sb = fmaf(wh[3], relu_i(acc[8 * qh + 7]), sb);
                        float sv = sa + sb; const bool valid = key <= t0 + q; sv += 0.0f;
                        ISC[q * 4096 + key] = valid ? (h16)sv : (h16)(-INFINITY);
                    }
                }
#pragma unroll
                for (int k = 0; k < 4; ++k) bk[k] = bn[k];
            }
        }
        __syncthreads();
#ifdef PROBE_SEL
        for (int rep_ = 0; rep_ < 2; ++rep_)
#endif
        {
            const LAS unsigned short* row[2]; int tq[2], nq[2]; unsigned* mrow[2];
#pragma unroll
            for (int z = 0; z < 2; ++z) { const int q = C.wave + 8 * z; row[z] = (const LAS unsigned short*)(ISC + q * 4096); tq[z] = t0 + q; nq[z] = tq[z] + 1; mrow[z] = MASK + (mb + tq[z]) * 128; }
            const int nmax = nq[1];
            unsigned dhi[2] = {0u, 0u}; int need[2];
#pragma unroll
            for (int z = 0; z < 2; ++z) need[z] = nq[z] < TOPK ? nq[z] : TOPK;
#pragma unroll
            for (int pass = 1; pass >= 0; --pass) {
                LDS_WAIT();
#pragma unroll
                for (int zz = 0; zz < 4; ++zz) HIST[lane + 64 * zz] = 0u;
                for (int e0 = 8 * lane; e0 < nmax; e0 += 512) {
                    v4u v[2];
#pragma unroll
                    for (int z = 0; z < 2; ++z) v[z] = *(const LAS v4u*)(row[z] + e0);
#pragma unroll
                    for (int z = 0; z < 2; ++z)
#pragma unroll
                        for (int jj = 0; jj < 8; ++jj) { const unsigned w = (jj < 2) ? v[z].x : (jj < 4) ? v[z].y : (jj < 6) ? v[z].z : v[z].w; const unsigned hb = (jj & 1) ? (w >> 16) : (w & 0xffffu);
                            const unsigned key = h2ord(hb); const unsigned bin = pass == 1 ? (key >> 8) : (key & 255u);
                            const bool ok = (e0 + jj < nq[z]) && (pass == 1 || (key >> 8) == dhi[z]);
                            if (ok) atomicAdd((unsigned*)&HIST[128 * z + (bin >> 1)], 1u << (16 * (bin & 1u))); }
                }
                LDS_WAIT();
                unsigned c[2][4], s4[2], suf[2];
#pragma unroll
                for (int z = 0; z < 2; ++z) { const v2u w2 = *(const LAS v2u*)(HIST + 128 * z + 2 * lane); c[z][0] = w2.x & 0xffffu; c[z][1] = w2.x >> 16; c[z][2] = w2.y & 0xffffu; c[z][3] = w2.y >> 16; s4[z] = c[z][0] + c[z][1] + c[z][2] + c[z][3]; suf[z] = s4[z]; }
#pragma unroll
                for (int o = 1; o < 64; o <<= 1) {
#pragma unroll
                    for (int z = 0; z < 2; ++z) { const unsigned v2 = __shfl_down(suf[z], o); if (lane + o < 64) suf[z] += v2; } }
#pragma unroll
                for (int z = 0; z < 2; ++z) { unsigned cum = suf[z] - s4[z]; int dsel = -1; int nnew = 0; const unsigned nd = (unsigned)need[z];
#pragma unroll
                    for (int bb = 3; bb >= 0; --bb) { if (dsel < 0 && cum < nd && nd <= cum + c[z][bb]) { dsel = 4 * lane + bb; nnew = (int)(nd - cum); } cum += c[z][bb]; }
                    const unsigned long long bal = __ballot(dsel >= 0);
                    const int src = (bal != 0ull) ? (int)__builtin_ctzll(bal) : 0;
                    const int dd = __shfl(dsel, src); need[z] = __shfl(nnew, src);
                    if (pass == 1) dhi[z] = (unsigned)dd; else dhi[z] = (dhi[z] << 8) | (unsigned)dd; }
            }
            int run_eq[2] = {0, 0}; unsigned long long mine[2] = {0ull, 0ull}; const int nit = (tq[1] >> 6) + 1;
            const unsigned long long ltm = (1ull << lane) - 1ull;
#pragma unroll 2
            for (int it = 0; it < nit; ++it) { const int e = it * 64 + lane;
#pragma unroll
                for (int z = 0; z < 2; ++z) { const unsigned key = h2ord(row[z][e]); const bool valid = e <= tq[z];
                    const bool eq = valid && (key == dhi[z]); const unsigned long long beq = __ballot(eq);
                    const int rk = run_eq[z] + __builtin_popcountll(beq & ltm);
                    const bool sel = valid && ((key > dhi[z]) || (eq && rk < need[z])); run_eq[z] += __builtin_popcountll(beq);
                    const unsigned long long bs = __ballot(sel);
                    if (lane == it) mine[z] = bs; } }
#pragma unroll
            for (int z = 0; z < 2; ++z) *(GAS v2u*)(mrow[z] + 2 * lane) = (v2u){(unsigned)mine[z], (unsigned)(mine[z] >> 32)};
        }
        __syncthreads();
    }
}

__device__ __forceinline__ void attn_task(const bf16* H, const bf16* KH, const bf16* VT, const unsigned* MASK, bf16* YM, int b, int hh, int t0, int lane) {
    const int r32 = lane & 31, hf = lane >> 5;
    const float LOG2E = 1.4426950408889634f; const float c1 = 0.125f * LOG2E; const float sl2 = exp2f(-(float)(hh + 1)) * LOG2E;
    const size_t mb = (size_t)b * T;
    bf16x8 qf[4];
#pragma unroll
    for (int k = 0; k < 4; ++k) qf[k] = *(const GAS bf16x8*)(H + (mb + t0 + r32) * D_INP + C_AQ + hh * 64 + 16 * k + 8 * hf);
    const bf16* kbase = KH + ((size_t)(b * 8 + hh) * T) * 64; const bf16* vbase = VT + ((size_t)(b * 512 + hh * 64)) * T; const unsigned* mrow = MASK + (mb + t0 + r32) * 128;
    float m_run = -1e30f, l = 0.f;
    f32x16 O0 = {0.f, 0.f, 0.f, 0.f, 0.f, 0.f, 0.f, 0.f, 0.f, 0.f, 0.f, 0.f, 0.f, 0.f, 0.f, 0.f}, O1 = O0;
    const int nkt = (t0 + 32 + 63) >> 6;
    for (int kt = 0; kt < nkt; ++kt) {
        const int s0 = kt * 64;
        bf16x8 kf[2][4];
#pragma unroll
        for (int uu = 0; uu < 2; ++uu)
#pragma unroll
            for (int k = 0; k < 4; ++k) kf[uu][k] = *(const GAS bf16x8*)(kbase + (size_t)(s0 + 32 * uu + r32) * 64 + 16 * k + 8 * hf);
        const v2u mw = *(const GAS v2u*)(mrow + 2 * kt);
        s16x4 vl[2][2][2], vh[2][2][2];
#pragma unroll
        for (int uu = 0; uu < 2; ++uu)
#pragma unroll
            for (int sp = 0; sp < 2; ++sp)
#pragma unroll
                for (int dt = 0; dt < 2; ++dt) { const bf16* vp = vbase + (size_t)(dt * 32 + r32) * T + s0 + 32 * uu + 16 * sp + 4 * hf;
                    vl[uu][sp][dt] = *(const GAS s16x4*)vp; vh[uu][sp][dt] = *(const GAS s16x4*)(vp + 8); }
        f32x16 a0 = {0.f, 0.f, 0.f, 0.f, 0.f, 0.f, 0.f, 0.f, 0.f, 0.f, 0.f, 0.f, 0.f, 0.f, 0.f, 0.f}, a1 = a0;
#pragma unroll
        for (int k = 0; k < 4; ++k) { a0 = __builtin_amdgcn_mfma_f32_32x32x16_bf16(kf[0][k], qf[k], a0, 0, 0, 0); a1 = __builtin_amdgcn_mfma_f32_32x32x16_bf16(kf[1][k], qf[k], a1, 0, 0, 0); }
        const float dist0 = (float)(t0 + r32 - s0 - 4 * hf);
        const unsigned m0 = mw.x >> (4 * hf), m1 = mw.y >> (4 * hf);
        float mx = -1e30f;
#pragma unroll
        for (int r = 0; r < 16; ++r) { const int ko = (r & 3) + 8 * (r >> 2);
            const float d0 = dist0 - (float)ko;
            a0[r] = ((m0 >> ko) & 1u) ? (a0[r] * c1 - sl2 * d0) : -1e30f;
            a1[r] = ((m1 >> ko) & 1u) ? (a1[r] * c1 - sl2 * (d0 - 32.f)) : -1e30f;
            mx = fmaxf(mx, fmaxf(a0[r], a1[r])); }
        mx = fmaxf(mx, __shfl_xor(mx, 32));
        const float m_new = fmaxf(m_run, mx); const float alpha = __builtin_amdgcn_exp2f(m_run - m_new); m_run = m_new;
        float ps = 0.f;
#pragma unroll
        for (int r = 0; r < 16; ++r) { const int ko = (r & 3) + 8 * (r >> 2);
            const float p0 = ((m0 >> ko) & 1u) ? __builtin_amdgcn_exp2f(a0[r] - m_new) : 0.f;
            const float p1 = ((m1 >> ko) & 1u) ? __builtin_amdgcn_exp2f(a1[r] - m_new) : 0.f;
            a0[r] = p0; a1[r] = p1; ps += p0 + p1; }
        l = l * alpha + ps;
#pragma unroll
        for (int r = 0; r < 16; ++r) { O0[r] *= alpha; O1[r] *= alpha; }
#pragma unroll
        for (int sp = 0; sp < 2; ++sp) {
            const bf16x8 pb0 = pack8(a0, 8 * sp), pb1 = pack8(a1, 8 * sp);
#define VFR(uu, dt) ((bf16x8){vl[uu][sp][dt][0], vl[uu][sp][dt][1], vl[uu][sp][dt][2], vl[uu][sp][dt][3], vh[uu][sp][dt][0], vh[uu][sp][dt][1], vh[uu][sp][dt][2], vh[uu][sp][dt][3]})
            O0 = __builtin_amdgcn_mfma_f32_32x32x16_bf16(VFR(0, 0), pb0, O0, 0, 0, 0);
            O1 = __builtin_amdgcn_mfma_f32_32x32x16_bf16(VFR(0, 1), pb0, O1, 0, 0, 0);
            O0 = __builtin_amdgcn_mfma_f32_32x32x16_bf16(VFR(1, 0), pb1, O0, 0, 0, 0);
            O1 = __builtin_amdgcn_mfma_f32_32x32x16_bf16(VFR(1, 1), pb1, O1, 0, 0, 0);
#undef VFR
        }
    }
    l += __shfl_xor(l, 32);
    const float inv = 1.f / l;
    bf16* yp = YM + (mb + t0 + r32) * D + hh * 64 + 4 * hf;
#pragma unroll
    for (int rq = 0; rq < 4; ++rq) {
        v2u o; o.x = cvtpk(O0[4 * rq] * inv, O0[4 * rq + 1] * inv); o.y = cvtpk(O0[4 * rq + 2] * inv, O0[4 * rq + 3] * inv); *(GAS v2u*)(yp + 8 * rq) = o;
        v2u o2; o2.x = cvtpk(O1[4 * rq] * inv, O1[4 * rq + 1] * inv); o2.y = cvtpk(O1[4 * rq + 2] * inv, O1[4 * rq + 3] * inv); *(GAS v2u*)(yp + 32 + 8 * rq) = o2; }
}
__device__ __forceinline__ void p4_attention(const Params& P, const Ctx& C) {
    unsigned char* ws = P.ws;
    const bf16* H = (const bf16*)(ws + WS_H); const bf16* KH = (const bf16*)(ws + WS_K); const bf16* VT = (const bf16*)(ws + WS_VT); const unsigned* MASK = (const unsigned*)(ws + WS_MASK); bf16* YM = (bf16*)(ws + WS_YMIX);
    for (int p = blockIdx.x; p < 512; p += C.G) {
        const int bh = p >> 3, j = p & 7; const int b = bh >> 3, hh = bh & 7;
        attn_task(H, KH, VT, MASK, YM, b, hh, j * 256 + C.wave * 32, C.lane);
        attn_task(H, KH, VT, MASK, YM, b, hh, (15 - j) * 256 + (7 - C.wave) * 32, C.lane);
    }
}

constexpr int AT_KB = 64 * 144, AT_VB = 64 * 136, AT_VOFF = 2 * AT_KB;
__device__ __forceinline__ void attn_block(const Ctx& C, const bf16* H, const bf16* KH, const bf16* VT, const unsigned* MASK, bf16* YM, int b, int hh, int qb) {
    const int lane = C.lane, r32 = lane & 31, hf = lane >> 5, tid = C.tid;
    const float LOG2E = 1.4426950408889634f; const float c1 = 0.125f * LOG2E; const float sl2 = exp2f(-(float)(hh + 1)) * LOG2E;
    const size_t mb = (size_t)b * T; const int t0 = qb * 256 + C.wave * 32;
    bf16x8 qf[4];
#pragma unroll
    for (int k = 0; k < 4; ++k) { const v4u w = *(const GAS v4u*)(H + (mb + t0 + r32) * D_INP + C_AQ + hh * 64 + 16 * k + 8 * hf);
        v4u o; o.x = cvtpk(bflo(w.x) * c1, bfhi(w.x) * c1); o.y = cvtpk(bflo(w.y) * c1, bfhi(w.y) * c1); o.z = cvtpk(bflo(w.z) * c1, bfhi(w.z) * c1); o.w = cvtpk(bflo(w.w) * c1, bfhi(w.w) * c1);
        qf[k] = __builtin_bit_cast(bf16x8, o); }
    const bf16* kbase = KH + ((size_t)(b * 8 + hh) * T) * 64; const bf16* vbase = VT + ((size_t)(b * 512 + hh * 64)) * T; const unsigned* mrow = MASK + (mb + t0 + r32) * 128;
    const int srow = tid >> 3, sch = tid & 7;
    const bf16* kst = kbase + (size_t)srow * 64 + 8 * sch; const bf16* vst = vbase + (size_t)srow * T + 8 * sch;
    LAS unsigned char* kw = C.lds + srow * 144 + 16 * sch; LAS unsigned char* vw = C.lds + AT_VOFF + srow * 136 + 16 * sch;
    const LAS unsigned char* kr = C.lds + r32 * 144 + 16 * hf; const LAS unsigned char* vr = C.lds + AT_VOFF + r32 * 136 + 8 * hf;
    float m_run = -1e30f, l = 0.f;
    f32x16 O0 = {0.f, 0.f, 0.f, 0.f, 0.f, 0.f, 0.f, 0.f, 0.f, 0.f, 0.f, 0.f, 0.f, 0.f, 0.f, 0.f}, O1 = O0;
    const int nkt = 4 * (qb + 1), ktw = (t0 + 31) >> 6;
    v4u kn = *(const GAS v4u*)kst, vn = *(const GAS v4u*)vst; v2u mwn = *(const GAS v2u*)mrow;
    *(LAS v4u*)kw = kn; *(LAS v2u*)vw = (v2u){vn.x, vn.y}; *(LAS v2u*)(vw + 8) = (v2u){vn.z, vn.w};
    __syncthreads();
    for (int kt = 0; kt < nkt; ++kt) {
        const int s0 = kt * 64; const int cur = kt & 1; const v2u mw = mwn;
        if (kt + 1 < nkt) { kn = *(const GAS v4u*)(kst + (size_t)(s0 + 64) * 64); vn = *(const GAS v4u*)(vst + s0 + 64); mwn = *(const GAS v2u*)(mrow + 2 * kt + 2); }
        if (kt <= ktw) {
            const LAS unsigned char* kc = kr + cur * AT_KB; const LAS unsigned char* vc = vr + cur * AT_VB;
            const float B0 = -sl2 * (float)(t0 + r32 - s0 - 4 * hf);
            f32x16 a0, a1;
#pragma unroll
            for (int r = 0; r < 16; ++r) { const float ko = (float)((r & 3) + 8 * (r >> 2)); a0[r] = B0 + sl2 * ko; a1[r] = B0 + sl2 * (ko + 32.f); }
#pragma unroll
            for (int k = 0; k < 4; ++k) { const bf16x8 k0 = *(const LAS bf16x8*)(kc + 32 * k), k1 = *(const LAS bf16x8*)(kc + 32 * 144 + 32 * k);
                a0 = __builtin_amdgcn_mfma_f32_32x32x16_bf16(k0, qf[k], a0, 0, 0, 0); a1 = __builtin_amdgcn_mfma_f32_32x32x16_bf16(k1, qf[k], a1, 0, 0, 0); }
            const unsigned m0 = mw.x >> (4 * hf), m1 = mw.y >> (4 * hf);
            float mx = -1e30f;
#pragma unroll
            for (int r = 0; r < 16; ++r) { const int ko = (r & 3) + 8 * (r >> 2);
                const unsigned k0m = (unsigned)__builtin_amdgcn_sbfe((int)m0, ko, 1), k1m = (unsigned)__builtin_amdgcn_sbfe((int)m1, ko, 1);
                const float x0 = a0[r], x1 = a1[r];
                a0[r] = __builtin_bit_cast(float, (__builtin_bit_cast(unsigned, x0) & k0m) | (0xf149f2cau & ~k0m));
                a1[r] = __builtin_bit_cast(float, (__builtin_bit_cast(unsigned, x1) & k1m) | (0xf149f2cau & ~k1m));
                mx = fmaxf(mx, fmaxf(a0[r], a1[r])); }
            mx = fmaxf(mx, __shfl_xor(mx, 32));
            const float m_new = fmaxf(m_run, mx);
            const float m_use = fmaxf(m_new, -1e20f);
            float ps = 0.f;
#pragma unroll
            for (int r = 0; r < 16; ++r) { const float p0 = __builtin_amdgcn_exp2f(a0[r] - m_use), p1 = __builtin_amdgcn_exp2f(a1[r] - m_use); a0[r] = p0; a1[r] = p1; ps += p0 + p1; }
            if (__builtin_amdgcn_ballot_w64(m_new != m_run) != 0ull) {
                const float alpha = __builtin_amdgcn_exp2f(m_run - m_new); m_run = m_new;
                l *= alpha;
#pragma unroll
                for (int r = 0; r < 16; ++r) { O0[r] *= alpha; O1[r] *= alpha; }
            }
            l += ps;
#pragma unroll
            for (int sp = 0; sp < 2; ++sp) {
                const bf16x8 pb0 = pack8(a0, 8 * sp), pb1 = pack8(a1, 8 * sp);
#define VLD(uu, dt) ({ const s16x4 lo_ = *(const LAS s16x4*)(vc + (dt) * 32 * 136 + 2 * (32 * (uu) + 16 * sp)), hi_ = *(const LAS s16x4*)(vc + (dt) * 32 * 136 + 2 * (32 * (uu) + 16 * sp + 8)); (bf16x8){lo_[0], lo_[1], lo_[2], lo_[3], hi_[0], hi_[1], hi_[2], hi_[3]}; })
                O0 = __builtin_amdgcn_mfma_f32_32x32x16_bf16(VLD(0, 0), pb0, O0, 0, 0, 0);
                O1 = __builtin_amdgcn_mfma_f32_32x32x16_bf16(VLD(0, 1), pb0, O1, 0, 0, 0);
                O0 = __builtin_amdgcn_mfma_f32_32x32x16_bf16(VLD(1, 0), pb1, O0, 0, 0, 0);
                O1 = __builtin_amdgcn_mfma_f32_32x32x16_bf16(VLD(1, 1), pb1, O1, 0, 0, 0);
#undef VLD
            }
        }
        if (kt + 1 < nkt) { const int nx = cur ^ 1; *(LAS v4u*)(kw + nx * AT_KB) = kn; *(LAS v2u*)(vw + nx * AT_VB) = (v2u){vn.x, vn.y}; *(LAS v2u*)(vw + nx * AT_VB + 8) = (v2u){vn.z, vn.w}; }
        __syncthreads();
    }
    l += __shfl_xor(l, 32);
    const float inv = __builtin_amdgcn_rcpf(l);
    unsigned char* yp = (unsigned char*)YM + (mb + t0 + r32) * D + hh * 64 + 4 * hf;
    const float i8 = inv * 8.f;
#pragma unroll
    for (int rq = 0; rq < 4; ++rq) {
        *(GAS unsigned*)(yp + 8 * rq) = pk4_fp8(O0[4 * rq] * i8, O0[4 * rq + 1] * i8, O0[4 * rq + 2] * i8, O0[4 * rq + 3] * i8);
        *(GAS unsigned*)(yp + 32 + 8 * rq) = pk4_fp8(O1[4 * rq] * i8, O1[4 * rq + 1] * i8, O1[4 * rq + 2] * i8, O1[4 * rq + 3] * i8); }
}
__device__ __forceinline__ void p4_attention2(const Params& P, const Ctx& C) {
    unsigned char* ws = P.ws;
    const bf16* H = (const bf16*)(ws + WS_H); const bf16* KH = (const bf16*)(ws + WS_K); const bf16* VT = (const bf16*)(ws + WS_VT); const unsigned* MASK = (const unsigned*)(ws + WS_MASK); bf16* YM = (bf16*)(ws + WS_YMIX);
    for (int p = blockIdx.x; p < 512; p += C.G) {
        const int b = p & 7, q = p >> 3; const int hh = q >> 3, j = q & 7;
        attn_block(C, H, KH, VT, MASK, YM, b, hh, j);
        attn_block(C, H, KH, VT, MASK, YM, b, hh, 15 - j);
    }
}


#ifndef FEAT_MIX
#define FEAT_MIX 1
#endif
#ifndef FEAT_MOE
#define FEAT_MOE 1
#endif
#ifndef FEAT_PLE
#define FEAT_PLE 1
#endif
#ifndef FEAT_ATT
#define FEAT_ATT 1
#endif

template <bool PUBLISH = true> __device__ __forceinline__ void p6_ln1_router(const Params& P, const Ctx& C) {
    unsigned char* ws = P.ws;
    bf16* X1 = (bf16*)(ws + WS_X1); unsigned char* XB = ws + WS_XB;
    LAS float* wl = (LAS float*)C.lds;
    LAS int* hist = (LAS int*)(C.lds + MISC_OFF);
    { const float* wrt = (const float*)(ws + WS_WRT);
      for (int i = C.tid; i < 32 * 1024 / 4; i += NTHR) *(LAS f32x4*)(wl + 4 * i) = *(const GAS f32x4*)(wrt + 4 * i);
      if (C.tid < 32) hist[C.tid] = 0; }
    __syncthreads();
    int* tope = (int*)(ws + WS_TOPE); float* gate = (float*)(ws + WS_GATE); int* lrank = (int*)(ws + WS_LRANK);
    const bf16* src = (const bf16*)P.out;
    const int lane = C.lane, hf = lane >> 5, ex = lane & 31;
    const float brl = P.in[I_BR][ex];
    for (int m0 = 2 * C.gw; m0 < NTOK; m0 += 2 * C.ngw) {
        f32x4 va[4], vb[4]; load_row_bf16(va, src + (size_t)m0 * D, lane); load_row_bf16(vb, src + (size_t)(m0 + 1) * D, lane);
        ln_row(va, P.in[I_LNMG], P.in[I_LNMB], lane); ln_row(vb, P.in[I_LNMG], P.in[I_LNMB], lane);
        store_row_bf16(X1 + (size_t)m0 * D, va, lane); store_row_bf16(X1 + (size_t)(m0 + 1) * D, vb, lane);
        store_row_fp8x8(XB + (size_t)m0 * D, va, lane); store_row_fp8x8(XB + (size_t)(m0 + 1) * D, vb, lane);
        float v[32];
#pragma unroll
        for (int e = 0; e < 32; ++e) { float pa = 0.f, pb = 0.f;
#pragma unroll
            for (int j = 0; j < 4; ++j) { const f32x4 w = *(const LAS f32x4*)(wl + e * 1024 + 4 * lane + 256 * j);
                pa += (va[j][0] * w[0] + va[j][1] * w[1]) + (va[j][2] * w[2] + va[j][3] * w[3]); pb += (vb[j][0] * w[0] + vb[j][1] * w[1]) + (vb[j][2] * w[2] + vb[j][3] * w[3]); }
            const float keep = hf ? pb : pa, send = hf ? pa : pb; v[e] = keep + __shfl_xor(send, 32); }
#define HALVE(M, CNT) { const bool up_ = (lane & (M)) != 0; _Pragma("unroll") for (int i_ = 0; i_ < (CNT) / 2; ++i_) { const float k_ = up_ ? v[i_ + (CNT) / 2] : v[i_], s_ = up_ ? v[i_] : v[i_ + (CNT) / 2]; v[i_] = k_ + __shfl_xor(s_, (M)); } }
        HALVE(16, 32) HALVE(8, 16) HALVE(4, 8) HALVE(2, 4) HALVE(1, 2)
#undef HALVE
        float lg = v[0] + brl;
        int se[4]; float sv[4];
#pragma unroll
        for (int k = 0; k < 4; ++k) { float bv = lg; int bi = ex;
#pragma unroll
            for (int o = 1; o < 32; o <<= 1) { const float ov = __shfl_xor(bv, o); const int oi = __shfl_xor(bi, o); const bool take = (ov > bv) || (ov == bv && oi < bi); bv = take ? ov : bv; bi = take ? oi : bi; }
            se[k] = bi; sv[k] = bv; if (ex == bi) lg = -INFINITY; }
        float exv[4], sum = 0.f;
#pragma unroll
        for (int k = 0; k < 4; ++k) { exv[k] = __expf(sv[k] - sv[0]); sum += exv[k]; }
        const float inv = 1.f / sum;
        if (ex == 0) { const int m = m0 + hf;
#pragma unroll
            for (int k = 0; k < 4; ++k) { const int lr = atomicAdd((int*)&hist[se[k]], 1); tope[m * 4 + k] = se[k]; gate[m * 4 + k] = exv[k] * inv; lrank[m * 4 + k] = lr; } }
    }
    __syncthreads();
    if (PUBLISH && C.tid < 32) { unsigned* cnt = (unsigned*)(ws + WS_CTL) + CW_CNT; const int base = (int)atomicAdd(cnt + C.tid, (unsigned)hist[C.tid]); ((int*)(ws + WS_WGBASE))[blockIdx.x * 32 + C.tid] = base; }
}

__device__ __forceinline__ void p7_dispatch(const Params& P, const Ctx& C) {
    unsigned char* ws = P.ws;
    LAS int* ps = (LAS int*)(C.lds + MISC_OFF + 256);
    const unsigned* cnt = (const unsigned*)(ws + WS_CTL) + CW_CNT;
    int* tile_e = (int*)(ws + WS_TILEE);
    LAS int* pe = (LAS int*)(C.lds + MISC_OFF + 512);
    if (C.tid < 64) { const int e = C.tid & 31; const int c = (int)__hip_atomic_load(cnt + e, __ATOMIC_RELAXED, __HIP_MEMORY_SCOPE_AGENT); const int nt = (c + 255) >> 8; int inc = nt;
#pragma unroll
        for (int o = 1; o < 32; o <<= 1) { const int v = __shfl_up(inc, o); if ((C.tid & 31) >= o) inc += v; }
        if (C.tid < 32) { ps[e] = (inc - nt) << 8; pe[e] = inc; } }
    __syncthreads();
    if (blockIdx.x == 0) { const int ntot = pe[31];
        for (int t = C.tid; t < ntot; t += NTHR) { int e = 0;
#pragma unroll
            for (int q = 0; q < 31; ++q) e += (t >= pe[q]) ? 1 : 0;
            tile_e[t] = e; }
        if (C.tid == 0) tile_e[MAXTILES] = ntot; }
    const int* tope = (const int*)(ws + WS_TOPE); const float* gate = (const float*)(ws + WS_GATE); const int* lrank = (const int*)(ws + WS_LRANK);
    const int* wgb = (const int*)(ws + WS_WGBASE);
    int* tokslot = (int*)(ws + WS_TOKSLOT); float* slotgate = (float*)(ws + WS_SLOTGATE);
    const bf16* XB = (const bf16*)(ws + WS_XB); unsigned char* xs = ws + WS_XS;
    int m = C.gw; v4u f8n; int en[4], ln_[4]; float gn[4]; int wgn;
    if (m < NTOK) { f8n = *(const GAS v4u*)((const unsigned char*)XB + (size_t)m * D + 16 * C.lane); wgn = ((m >> 1) % C.ngw) >> 3;
#pragma unroll
        for (int k = 0; k < 4; ++k) { en[k] = tope[m * 4 + k]; ln_[k] = lrank[m * 4 + k]; gn[k] = gate[m * 4 + k]; } }
    for (; m < NTOK; m += C.ngw) {
        const v4u f8 = f8n; int e[4], lr[4]; float g[4]; const int wgm = wgn;
#pragma unroll
        for (int k = 0; k < 4; ++k) { e[k] = en[k]; lr[k] = ln_[k]; g[k] = gn[k]; }
        int wb[4];
#pragma unroll
        for (int k = 0; k < 4; ++k) wb[k] = wgb[wgm * 32 + e[k]];
        const int m2 = m + C.ngw;
        if (m2 < NTOK) { f8n = *(const GAS v4u*)((const unsigned char*)XB + (size_t)m2 * D + 16 * C.lane); wgn = ((m2 >> 1) % C.ngw) >> 3;
#pragma unroll
            for (int k = 0; k < 4; ++k) { en[k] = tope[m2 * 4 + k]; ln_[k] = lrank[m2 * 4 + k]; gn[k] = gate[m2 * 4 + k]; } }
#pragma unroll
        for (int k = 0; k < 4; ++k) { const int slot = ps[e[k]] + wb[k] + lr[k];
            *(GAS v4u*)(xs + (size_t)slot * D + 16 * C.lane) = f8;
            if (C.lane == 0) { slotgate[slot] = g[k]; tokslot[m * 4 + k] = slot; } }
    }
}

__device__ __forceinline__ void p10_combine_ln2(const Params& P, const Ctx& C) {
    unsigned char* ws = P.ws;
    const bf16* X1 = (const bf16*)(ws + WS_X1); bf16* XB = (bf16*)(ws + WS_XB); bf16* X2 = (bf16*)P.out;
    const int* tokslot = (const int*)(ws + WS_TOKSLOT); const unsigned char* ys = ws + WS_YSLOT;
    for (int m = C.gw; m < NTOK; m += C.ngw) {
        f32x4 v[4]; load_row_bf16(v, X1 + (size_t)m * D, C.lane);
#pragma unroll
        for (int j = 0; j < 4; ++j) v[j] = v[j] * ALPHA;
#if FEAT_MOE
        f32x4 fs[4] = {{0.f, 0.f, 0.f, 0.f}, {0.f, 0.f, 0.f, 0.f}, {0.f, 0.f, 0.f, 0.f}, {0.f, 0.f, 0.f, 0.f}};
#pragma unroll
        for (int k = 0; k < 4; ++k) { const int slot = tokslot[m * 4 + k]; const unsigned char* yr = ys + (size_t)slot * D;
#pragma unroll
            for (int j = 0; j < 4; ++j) fs[j] = fs[j] + fp8x4_to_f32(*(const GAS unsigned*)(yr + 4 * C.lane + 256 * j)); }
#pragma unroll
        for (int j = 0; j < 4; ++j) v[j] = v[j] + fs[j] * (1.f / 64.f);
#endif
        ln_row(v, P.in[I_LNFG], P.in[I_LNFB], C.lane);
        store_row_bf16(X2 + (size_t)m * D, v, C.lane);
        store_row_fp8x8((unsigned char*)XB + (size_t)m * D, v, C.lane);
    }
}

__device__ __forceinline__ void p12_final_ln(const Params& P, const Ctx& C) {
    const bf16* src = (const bf16*)(P.ws + WS_X1);
    for (int m = C.gw; m < NTOK; m += C.ngw) {
        f32x4 v[4]; load_row_bf16(v, src + (size_t)m * D, C.lane);
        ln_row(v, P.in[I_LNPG], P.in[I_LNPB], C.lane);
        store_row_f32(P.out + (size_t)m * D, v, C.lane);
    }
}
#define XB_TMO      128
#define XB_XCNT(j)  (256  + 64 * (j))
#define XB_XSUB(j)  (1280 + 64 * (j))
#define XB_XGEN(j)  (2304 + 64 * (j))
#define XB_TOP      3328
#define XB_TOPGEN   3392
#define XCD_BAR_WORDS 3456
#define XB_SPIN_CAP (1u << 18)
#define LAS __attribute__((address_space(3)))

__device__ __forceinline__ unsigned xb_ld(unsigned* p)              { return __hip_atomic_load(p, __ATOMIC_RELAXED, __HIP_MEMORY_SCOPE_AGENT); }
__device__ __forceinline__ unsigned xb_add(unsigned* p, unsigned v) { return __hip_atomic_fetch_add(p, v, __ATOMIC_RELAXED, __HIP_MEMORY_SCOPE_AGENT); }
__device__ __forceinline__ unsigned xb_xcc_id() { return (unsigned)__builtin_amdgcn_s_getreg((3 << 11) | 20) & 0xFu; }
#define XB_SPIN(cond, bar) do { unsigned _sp = 0; while (cond) { __builtin_amdgcn_s_sleep(1); \
    if ((++_sp & 255u) == 0u) { if (xb_ld(&(bar)[XB_TMO])) break; if (_sp > XB_SPIN_CAP) { atomicAdd(&(bar)[XB_TMO], 1u); break; } } } } while (0)

struct XcdBarrier {
    unsigned* bar; unsigned x;
    volatile LAS unsigned* st;
};

__device__ __forceinline__ XcdBarrier xcd_barrier_post(unsigned* bar, volatile LAS unsigned* st) {
    XcdBarrier b; b.bar = bar; b.x = xb_xcc_id(); b.st = st;
    if (threadIdx.x == 0) (void)xb_add(&bar[XB_XCNT(b.x)], 1u);
    return b;
}
__device__ __forceinline__ void xcd_barrier_complete(unsigned* bar, unsigned x, unsigned& nloc, unsigned& nx) {
    const unsigned G = gridDim.x * gridDim.y * gridDim.z;
    unsigned sum, cnt, mine, sp = 0u;
    for (;;) {
        sum = 0u; cnt = 0u; mine = 0u;
#pragma unroll
        for (unsigned j = 0; j < 16; ++j) { const unsigned c = xb_ld(&bar[XB_XCNT(j)]); sum += c; cnt += (c > 0u) ? 1u : 0u; mine = (j == x) ? c : mine; }
        if (sum == G) break;
        __builtin_amdgcn_s_sleep(1);
        if ((++sp & 255u) == 0u) { if (xb_ld(&bar[XB_TMO])) break; if (sp > XB_SPIN_CAP) { atomicAdd(&bar[XB_TMO], 1u); break; } }
    }
    nloc = mine > 0u ? mine : 1u; nx = cnt > 0u ? cnt : 1u;
}

__device__ __forceinline__ void xcd_barrier(const XcdBarrier& b) {
    asm volatile("s_waitcnt vmcnt(0)" ::: "memory");
    __syncthreads();
    if (threadIdx.x == 0) {
        unsigned* bar = b.bar;
        __builtin_amdgcn_s_waitcnt(0);
        unsigned nloc = b.st[0], nx = b.st[1];
        if (nloc == 0u) { xcd_barrier_complete(bar, b.x, nloc, nx); b.st[0] = nloc; b.st[1] = nx; }
        const unsigned old = xb_add(&bar[XB_XSUB(b.x)], 1u);
        const unsigned gen = old / nloc;
        if (old + 1u == (gen + 1u) * nloc) {
            __builtin_amdgcn_fence(__ATOMIC_RELEASE, "agent");
            asm volatile("s_waitcnt vmcnt(0)" ::: "memory");
            const unsigned og = xb_add(&bar[XB_TOP], 1u);
            const unsigned tg = og / nx;
            if (og + 1u == (tg + 1u) * nx) xb_add(&bar[XB_TOPGEN], 1u);
            else XB_SPIN(xb_ld(&bar[XB_TOPGEN]) == tg, bar);
            __builtin_amdgcn_fence(__ATOMIC_ACQUIRE, "agent");
            xb_add(&bar[XB_XGEN(b.x)], 1u);
            asm volatile("s_waitcnt vmcnt(0)" ::: "memory");
        } else {
            XB_SPIN(xb_ld(&bar[XB_XGEN(b.x)]) == gen, bar);
            __builtin_amdgcn_fence(__ATOMIC_ACQUIRE, "agent");
            asm volatile("s_waitcnt vmcnt(0)" ::: "memory");
        }
    }
    __syncthreads();
}


template <int PH> __device__ __forceinline__ void run_phase(const Params& P, const Ctx& C) {
    unsigned char* ws = P.ws;
    typedef pg8::bf16_t pbf;
    if constexpr (PH == 0) { p0_prologue(P, C); }
    else if constexpr (PH == 10) {
        pg8::Gemm g{(const pbf*)(ws + WS_XBF), (const pbf*)(ws + WS_WIN_T), NTOK, D_INP, D}; pg8::StaticOrder S; S.init(NTOK, D_INP, C.G, (int)blockIdx.x);
        pg8::EpiBf16s E{(pbf*)(ws + WS_H), D_INP};
        pg8::gemm_phase<pg8::EpiBf16s, pg8::StaticOrder, true, true>(C.lds, g, S, E); }
    else if constexpr (PH == 11) {
        pg8::Gemm g{(const pbf*)(ws + WS_PB), (const pbf*)(ws + WS_WPROJ_T), NTOK, D, PLE}; pg8::StaticOrder S; S.init(NTOK, D, C.G, (int)blockIdx.x);
        pg8::EpiBf16s E{(pbf*)(ws + WS_PROJ), D};
        pg8::gemm_phase<pg8::EpiBf16s, pg8::StaticOrder, true, true>(C.lds, g, S, E); }
    else if constexpr (PH == 20) { p2_post(P, C); }
    else if constexpr (PH == 21) { p2_hgrn_prep(P, C); }
    else if constexpr (PH == 30) {
        { pg8::Gemm g{(const pbf*)(ws + WS_CN), (const pbf*)(ws + WS_WUK_T), NTOK, 512, 256}; pg8::StaticOrder S; S.init(NTOK, 512, C.G, (int)blockIdx.x);
          pg8::EpiKhead E{(pbf*)(ws + WS_K)};
          pg8::gemm_phase<pg8::EpiKhead, pg8::StaticOrder, true, true>(C.lds, g, S, E); }
        { pg8::Gemm g{(const pbf*)(ws + WS_WUV_T), (const pbf*)(ws + WS_CN), 512, NTOK, 256}; pg8::StaticOrder S; S.init(512, NTOK, C.G, (int)blockIdx.x);
          pg8::EpiVt E{(pbf*)(ws + WS_VT)};
          pg8::gemm_phase<pg8::EpiVt, pg8::StaticOrder, true, true>(C.lds, g, S, E); }
    }
    else if constexpr (PH == 31) { p3_indexer(P, C); }
    else if constexpr (PH == 32) { p3_scan_convert(P, C); }
    else if constexpr (PH == 40) { p4_attention2(P, C); }
    else if constexpr (PH == 41) { p4_yrec(P, C); }
    else if constexpr (PH == 5) {
        pg8::Gemm g{(const pbf*)(ws + WS_YMIX), (const pbf*)(ws + WS_WO_T), NTOK, D, D / 2}; pg8::StaticOrder S; S.init(NTOK, D, C.G, (int)blockIdx.x);
        pg8::EpiResid E{(const pbf*)(ws + WS_XBF), (pbf*)P.out, D, ALPHA, 1.f / 512.f};
        pg8::gemm_phase<pg8::EpiResid, pg8::StaticOrder, true, true, 1>(C.lds, g, S, E);
    }
    else if constexpr (PH == 6) { p6_ln1_router<true>(P, C); }
    else if constexpr (PH == 60) { p6_ln1_router<false>(P, C); }
    else if constexpr (PH == 7) { p7_dispatch(P, C); }
    else if constexpr (PH == 8) {
        const int* tile_e = (const int*)(ws + WS_TILEE);
        pg8::Gemm g{(const pbf*)(ws + WS_XS), (const pbf*)(ws + WS_WUP_T), CAP, NE * 2048, D / 2};
        pg8::MoeOrder S{tile_e, tile_e[MAXTILES], 8, C.G, (int)blockIdx.x};
        pg8::EpiSwiglu E{ws + WS_HH, P.in[I_BUP]};
        pg8::gemm_phase<pg8::EpiSwiglu, pg8::MoeOrder, true, true, 1, 124, 121>(C.lds, g, S, E);
    }
    else if constexpr (PH == 9) {
        const int* tile_e = (const int*)(ws + WS_TILEE);
        pg8::Gemm g{(const pbf*)(ws + WS_HH), (const pbf*)(ws + WS_WDN_T), CAP, NE * 1024, DFF / 2};
        pg8::MoeOrder S{tile_e, tile_e[MAXTILES], 4, C.G, (int)blockIdx.x};
        pg8::EpiDown E{ws + WS_YSLOT, P.in[I_BDN], (const float*)(ws + WS_SLOTGATE)};
        pg8::gemm_phase<pg8::EpiDown, pg8::MoeOrder, true, true, 1, 125, 121>(C.lds, g, S, E);
    }
    else if constexpr (PH == 100) { p10_combine_ln2(P, C); }
    else if constexpr (PH == 110) {
        pg8::Gemm g{(const pbf*)(ws + WS_XB), (const pbf*)(ws + WS_WGATE_T), NTOK, D, D / 2}; pg8::StaticOrder S; S.init(NTOK, D, C.G, (int)blockIdx.x);
        pg8::EpiPle E{(const pbf*)P.out, (const pbf*)(ws + WS_PROJ), (pbf*)(ws + WS_X1), ALPHA, 1.f / 512.f};
        pg8::gemm_phase<pg8::EpiPle, pg8::StaticOrder, true, true, 1>(C.lds, g, S, E);
    }
    else { p12_final_ln(P, C); }
}
__global__ void __launch_bounds__(NTHR, 2) mega_fwd(Params P) {
    extern __shared__ __attribute__((aligned(16))) unsigned char lds_raw[];
    cg::grid_group grid = cg::this_grid();
#define MKCTX Ctx C; { int tid_ = threadIdx.x; asm volatile("" : "+v"(tid_)); C.lds = (LAS unsigned char*)lds_raw; C.tid = tid_; C.lane = tid_ & 63; C.wave = __builtin_amdgcn_readfirstlane(tid_ >> 6); \
      C.G = gridDim.x; C.gw = blockIdx.x * NWAVES + C.wave; C.ngw = C.G * NWAVES; }
#if SYNC_MODE != 0
    if (threadIdx.x < 4) ((LAS unsigned*)((LAS unsigned char*)lds_raw + XBW_OFF))[threadIdx.x] = 0u;
    __syncthreads();
    XcdBarrier bar = xcd_barrier_post((unsigned*)(P.ws + WS_CTL) + CW_BAR, (volatile LAS unsigned*)((LAS unsigned char*)lds_raw + XBW_OFF));
#define SY xcd_barrier(bar);
#else
#define SY grid.sync();
#endif
#define GS grid.sync();
#define BS __syncthreads();
#define X(k) { MKCTX run_phase<k>(P, C); }
    PROGRAM
#undef X
#undef MKCTX
#undef SY
#undef GS
#undef BS
}

extern "C" void kernel_launch(void* const* d_in, const int* in_sizes, int n_in, void* d_out, int out_size, void* d_ws, size_t ws_size, hipStream_t stream) {
    static int grid = 0;
    if (grid == 0) {
        if (n_in != 25 || out_size != NTOK * D || ws_size < WS_END) { fprintf(stderr, "kernel_launch: unexpected shapes (n_in %d out %d ws %zu)\n", n_in, out_size, ws_size); grid = -1; return; }
        int dev = 0, cus = 0, per_cu = 0;
        if (hipGetDevice(&dev) != hipSuccess || hipDeviceGetAttribute(&cus, hipDeviceAttributeMultiprocessorCount, dev) != hipSuccess) { grid = -1; return; }
        if (hipFuncSetAttribute((const void*)mega_fwd, hipFuncAttributeMaxDynamicSharedMemorySize, LDS_BYTES) != hipSuccess) { fprintf(stderr, "kernel_launch: hipFuncSetAttribute failed\n"); grid = -1; return; }
        if (hipOccupancyMaxActiveBlocksPerMultiprocessor(&per_cu, (const void*)mega_fwd, NTHR, LDS_BYTES) != hipSuccess || per_cu < 1) { fprintf(stderr, "kernel_launch: occupancy query failed (%d)\n", per_cu); (void)hipGetLastError(); grid = -1; return; }
        grid = cus * per_cu;
        fprintf(stderr, "kernel_launch: grid %d (%d CUs x %d)\n", grid, cus, per_cu);
    }
    if (grid < 0) return;
    (void)hipMemsetAsync((char*)d_ws + WS_CTL, 0, CTL_ZERO_BYTES, stream);
    Params p{};
    for (int i = 0; i < 25; ++i) p.in[i] = (const float*)d_in[i];
    p.out = (float*)d_out; p.ws = (unsigned char*)d_ws;

    void* args[] = {&p};
    hipError_t e = hipLaunchCooperativeKernel((const void*)mega_fwd, dim3(grid), dim3(NTHR), args, LDS_BYTES, stream);
    if (e != hipSuccess) fprintf(stderr, "kernel_launch: cooperative launch failed: %s (grid %d)\n", hipGetErrorString(e), grid);
}
```

```cpp
#define SYNC_MODE 1
#include <hip/hip_runtime.h>
#include <hip/hip_cooperative_groups.h>
#include <cstdio>
#include <cstdint>
namespace cg = cooperative_groups;

namespace pg8 {
#define PG8_LAS __attribute__((address_space(3)))
typedef unsigned short bf16_t;
typedef short bf16x8 __attribute__((ext_vector_type(8)));
typedef float f32x4 __attribute__((ext_vector_type(4)));
typedef unsigned u32x4 __attribute__((ext_vector_type(4)));
typedef int i32x4 __attribute__((ext_vector_type(4)));
typedef int i32x8 __attribute__((ext_vector_type(8)));
constexpr int BM = 256, BK = 64, HALF = 128, HTB = HALF * BK * 2  , STAGE_BYTES = 8 * HTB, NXCD = 8, WGM = 8;

__host__ __device__ __forceinline__ int lds_byte(int r, int c) { const int st = (r >> 4) * 2 + (c >> 5), rr = r & 15, cc = c & 31, ob = rr * 64 + cc * 2; return st * 1024 + (ob ^ (((ob >> 9) & 1) << 5)); }
__host__ __device__ __forceinline__ void stage_rc(int b, int& R, int& C) { const int st = b / 1024, sb = b % 1024, swz = sb ^ (((sb >> 9) & 1) << 5); R = (st >> 1) * 16 + swz / 64; C = (st & 1) * 32 + (swz % 64) / 2; }
__host__ __device__ __forceinline__ int perm32(int rho) { const int n = rho >> 4, i = rho & 15; return 8 * (i >> 2) + 4 * n + (i & 3); }

struct Unit { int pm, pn; };
struct Gemm { const bf16_t* A; const bf16_t* Bt; int M, N, K; };

struct StaticOrder {
    int nM, nN, nwg, G, c;
    __host__ __device__ void init(int M, int N, int G_, int c_) { nM = M / BM; nN = N / BM; nwg = nM * nN; G = G_; c = c_; }
    __host__ __device__ bool next(int i, Unit& u) const {
        const long L = (long)i * G + c; if (L >= nwg) return false;
        int wgid = (int)L; { const int q = nwg / NXCD, r = nwg % NXCD, xcd = wgid % NXCD, off = wgid / NXCD; wgid = (xcd < r ? xcd * (q + 1) : r * (q + 1) + (xcd - r) * q) + off; }
        const int nig = WGM * nN, gid = wgid / nig, fm = gid * WGM, gsz = (nM - fm) < WGM ? (nM - fm) : WGM;
        u.pm = fm + ((wgid % nig) % gsz); u.pn = (wgid % nig) / gsz; return true;
    }
    __device__ __forceinline__ void a_ready(const Unit&) const {}
    __device__ __forceinline__ void done(const Unit&) const {}
};

__device__ __forceinline__ unsigned cvt_pk_bf16(float lo, float hi) { unsigned r; asm volatile("v_cvt_pk_bf16_f32 %0, %1, %2" : "=v"(r) : "v"(lo), "v"(hi)); return r; }
typedef float f32x2 __attribute__((ext_vector_type(2)));
template <class Epi, class Sched, bool ALIGN_EPI = false, bool SP2 = false, int F8 = 0, int F8SA = 127, int F8SB = 127>
__device__ __forceinline__ void gemm_phase(PG8_LAS unsigned char* lds, const Gemm g, const Sched& S, const Epi& E) {
    const int tid = threadIdx.x, wid = __builtin_amdgcn_readfirstlane(tid >> 6), lane = tid & 63, wr = wid >> 2, wc = wid & 3, fr = lane & 15, fq = lane >> 4;
    const int K = g.K, nt = K / BK;
    unsigned voffA[2], voffB[2];
#pragma unroll
    for (int i = 0; i < 2; ++i) { int R, C; stage_rc(tid * 16 + i * 8192, R, C); const int Rb = Epi::PERM ? ((R & ~31) + perm32(R & 31)) : R;
        voffA[i] = (unsigned)(R * K + C) * 2u; voffB[i] = (unsigned)(Rb * K + C) * 2u; }
    const size_t kstep = (size_t)(BK * 2);
    const size_t hstep = (size_t)HALF * K * 2;
    const size_t tstep = 2 * hstep;
    const unsigned ldsw = (unsigned)wid * 1024u;
    const int aoff = lds_byte(wr * 64 + fr, fq * 8), boff = lds_byte(wc * 32 + fr, fq * 8);
#define PG8_SA(b, h) (((b) * 2 + (h)) * HTB)
#define PG8_SB(b, h) ((4 + (b) * 2 + (h)) * HTB)
#define PG8_STAGE(bufoff, gbase, voff) do { _Pragma("unroll") for (int _i = 0; _i < 2; ++_i) \
        __builtin_amdgcn_global_load_lds((const unsigned*)((const char*)(gbase) + (voff)[_i]), (PG8_LAS unsigned*)(lds + (bufoff) + ldsw + _i * 8192), 16, 0, 0); } while (0)
#define PG8_LDA(dst, b, h) do { _Pragma("unroll") for (int m = 0; m < 4; ++m) { dst[m].lo = *(const PG8_LAS i32x4*)(lds + PG8_SA(b, h) + aoff + m * 2048); dst[m].hi = *(const PG8_LAS i32x4*)(lds + PG8_SA(b, h) + aoff + m * 2048 + 1024); } } while (0)
#define PG8_LDB(dst, b, h) do { _Pragma("unroll") for (int n = 0; n < 2; ++n) { dst[n].lo = *(const PG8_LAS i32x4*)(lds + PG8_SB(b, h) + boff + n * 2048); dst[n].hi = *(const PG8_LAS i32x4*)(lds + PG8_SB(b, h) + boff + n * 2048 + 1024); } } while (0)
#define PG8_MMA(ai, bj, At, Bt) do { __builtin_amdgcn_s_setprio(1); \
        if constexpr (F8 == 0) { _Pragma("unroll") for (int m = 0; m < 4; ++m) _Pragma("unroll") for (int n = 0; n < 2; ++n) { \
            const i32x4 bl_ = Bt[n].lo, bh_ = Bt[n].hi, al_ = At[m].lo, ah_ = At[m].hi;     \
            acc[ai][bj][m][n] = __builtin_amdgcn_mfma_f32_16x16x32_bf16(__builtin_bit_cast(bf16x8, bl_), __builtin_bit_cast(bf16x8, al_), acc[ai][bj][m][n], 0, 0, 0); \
            acc[ai][bj][m][n] = __builtin_amdgcn_mfma_f32_16x16x32_bf16(__builtin_bit_cast(bf16x8, bh_), __builtin_bit_cast(bf16x8, ah_), acc[ai][bj][m][n], 0, 0, 0); } } \
        else { _Pragma("unroll") for (int m = 0; m < 4; ++m) _Pragma("unroll") for (int n = 0; n < 2; ++n) \
            asm volatile("v_mfma_f32_16x16x128_f8f6f4 %0, %1, %2, %0" : "+v"(acc[ai][bj][m][n]) : "v"(Bt[n]), "v"(At[m])); } \
        __builtin_amdgcn_s_setprio(0); } while (0)
#define PG8_WAIT_V(n) asm volatile("s_waitcnt vmcnt(" #n ")" ::: "memory")
#define PG8_WAIT_L(n) asm volatile("s_waitcnt lgkmcnt(" #n ")" ::: "memory")
#define PG8_BAR __builtin_amdgcn_s_barrier()
#define PG8_SCHED __builtin_amdgcn_sched_barrier(0)
    Unit cur, nxt; int ui = 0;
    if (!S.next(0, cur)) return;
    f32x4 acc[2][2][4][2];
#pragma unroll
    for (int a = 0; a < 2; ++a)
#pragma unroll
        for (int b = 0; b < 2; ++b)
#pragma unroll
            for (int m = 0; m < 4; ++m)
#pragma unroll
                for (int n = 0; n < 2; ++n) acc[a][b][m][n] = (f32x4){0.f, 0.f, 0.f, 0.f};
    i32x8 At[4], B0[2], B1[2];
    const char* cA = (const char*)g.A + (size_t)cur.pm * tstep; const char* cB = (const char*)g.Bt + (size_t)cur.pn * tstep;
    S.a_ready(cur);
    if constexpr (SP2) {
        PG8_STAGE(PG8_SB(0, 0), cB, voffB); PG8_STAGE(PG8_SB(0, 1), cB + hstep, voffB); PG8_STAGE(PG8_SA(0, 0), cA, voffA); PG8_STAGE(PG8_SA(0, 1), cA + hstep, voffA);
        if (wr == 1) PG8_BAR;
        PG8_WAIT_V(2); PG8_BAR;
        PG8_STAGE(PG8_SB(1, 0), cB + kstep, voffB); PG8_STAGE(PG8_SA(1, 0), cA + kstep, voffA); PG8_STAGE(PG8_SB(1, 1), cB + hstep + kstep, voffB);
        PG8_WAIT_V(6); PG8_BAR;
    } else {
        PG8_STAGE(PG8_SB(0, 0), cB, voffB); PG8_STAGE(PG8_SA(0, 0), cA, voffA); PG8_STAGE(PG8_SB(0, 1), cB + hstep, voffB); PG8_STAGE(PG8_SA(0, 1), cA + hstep, voffA);
        if (wr == 1) PG8_BAR;
        PG8_WAIT_V(4); PG8_BAR;
        PG8_STAGE(PG8_SB(1, 0), cB + kstep, voffB); PG8_STAGE(PG8_SA(1, 0), cA + kstep, voffA); PG8_STAGE(PG8_SB(1, 1), cB + hstep + kstep, voffB);
        PG8_WAIT_V(6); PG8_BAR;
    }
    for (;;) {
        const bool has_next = S.next(ui + 1, nxt);
        const char* nA = has_next ? (const char*)g.A + (size_t)nxt.pm * tstep : cA; const char* nB = has_next ? (const char*)g.Bt + (size_t)nxt.pn * tstep : cB;
_Pragma("nounroll")
        for (int t = 0; t < nt; t += 2) {
            const bool last = (t == nt - 2);
            const char* a1 = cA + (size_t)(t + 1) * kstep;
            const char* a2 = last ? nA : cA + (size_t)(t + 2) * kstep; const char* b2 = last ? nB : cB + (size_t)(t + 2) * kstep;
            const char* a3 = a2 + kstep; const char* b3 = b2 + kstep;
            if (last && has_next) S.a_ready(nxt);
            if constexpr (SP2) {
            PG8_LDB(B0, 0, 0); PG8_LDB(B1, 0, 1); PG8_SCHED; PG8_LDA(At, 0, 0); PG8_STAGE(PG8_SA(1, 1), a1 + hstep, voffA);
            PG8_WAIT_V(8); PG8_WAIT_L(0); PG8_BAR; PG8_MMA(0, 0, At, B0); PG8_MMA(0, 1, At, B1); PG8_BAR; PG8_SCHED;
            PG8_LDA(At, 0, 1); PG8_STAGE(PG8_SB(0, 0), b2, voffB); PG8_STAGE(PG8_SB(0, 1), b2 + hstep, voffB); PG8_STAGE(PG8_SA(0, 0), a2, voffA);
            PG8_WAIT_V(8); PG8_WAIT_L(0); PG8_BAR; PG8_MMA(1, 0, At, B0); PG8_MMA(1, 1, At, B1); PG8_BAR; PG8_SCHED;
            PG8_LDB(B0, 1, 0); PG8_LDB(B1, 1, 1); PG8_SCHED; PG8_LDA(At, 1, 0); PG8_STAGE(PG8_SA(0, 1), a2 + hstep, voffA);
            PG8_WAIT_V(8); PG8_WAIT_L(0); PG8_BAR; PG8_MMA(0, 0, At, B0); PG8_MMA(0, 1, At, B1); PG8_BAR; PG8_SCHED;
            PG8_LDA(At, 1, 1); PG8_STAGE(PG8_SB(1, 0), b3, voffB); PG8_STAGE(PG8_SB(1, 1), b3 + hstep, voffB); PG8_STAGE(PG8_SA(1, 0), a3, voffA);
            PG8_WAIT_V(8); PG8_WAIT_L(0); PG8_BAR; PG8_MMA(1, 0, At, B0); PG8_MMA(1, 1, At, B1); PG8_BAR; PG8_SCHED;
            } else {
            PG8_LDB(B0, 0, 0); PG8_SCHED; PG8_LDA(At, 0, 0); PG8_STAGE(PG8_SA(1, 1), a1 + hstep, voffA);
            PG8_WAIT_L(8); PG8_BAR; PG8_WAIT_L(0); PG8_MMA(0, 0, At, B0); PG8_BAR; PG8_SCHED;
            PG8_LDB(B1, 0, 1); PG8_STAGE(PG8_SB(0, 0), b2, voffB);
            PG8_BAR; PG8_WAIT_L(0); PG8_MMA(0, 1, At, B1); PG8_BAR;
            PG8_LDA(At, 0, 1); PG8_STAGE(PG8_SA(0, 0), a2, voffA);
            PG8_BAR; PG8_WAIT_L(0); PG8_MMA(1, 0, At, B0); PG8_BAR; PG8_SCHED;
            PG8_STAGE(PG8_SB(0, 1), b2 + hstep, voffB);
            PG8_WAIT_V(6); PG8_BAR; PG8_MMA(1, 1, At, B1); PG8_BAR;
            PG8_LDB(B0, 1, 0); PG8_SCHED; PG8_LDA(At, 1, 0); PG8_STAGE(PG8_SA(0, 1), a2 + hstep, voffA);
            PG8_WAIT_L(8); PG8_BAR; PG8_WAIT_L(0); PG8_MMA(0, 0, At, B0); PG8_BAR; PG8_SCHED;
            PG8_LDB(B1, 1, 1); PG8_STAGE(PG8_SB(1, 0), b3, voffB);
            PG8_BAR; PG8_WAIT_L(0); PG8_MMA(0, 1, At, B1); PG8_BAR;
            PG8_LDA(At, 1, 1); PG8_STAGE(PG8_SA(1, 0), a3, voffA);
            PG8_BAR; PG8_WAIT_L(0); PG8_MMA(1, 0, At, B0); PG8_BAR; PG8_SCHED;
            PG8_STAGE(PG8_SB(1, 1), b3 + hstep, voffB);
            PG8_WAIT_V(6); PG8_BAR; PG8_MMA(1, 1, At, B1); PG8_BAR;
            }
        }
        if constexpr (ALIGN_EPI) { if (wr == 0) PG8_BAR; }
        if constexpr (F8 != 0) asm volatile("s_nop 15\n\ts_nop 15" ::: "memory");
        if constexpr (!Epi::AFTER_DRAIN) { E(acc, cur, wr, wc, fr, fq); S.done(cur); }
        if (!has_next) break;
#pragma unroll
        for (int a = 0; a < 2; ++a)
#pragma unroll
            for (int b = 0; b < 2; ++b)
#pragma unroll
                for (int m = 0; m < 4; ++m)
#pragma unroll
                    for (int n = 0; n < 2; ++n) acc[a][b][m][n] = (f32x4){0.f, 0.f, 0.f, 0.f};
        cur = nxt; cA = nA; cB = nB; ++ui;
        if constexpr (ALIGN_EPI) { if (wr == 1) PG8_BAR; }
    }
    PG8_WAIT_V(0);
    if constexpr (!ALIGN_EPI) { if (wr == 0) PG8_BAR; }
    PG8_BAR;
    if constexpr (Epi::AFTER_DRAIN) { E.fused(acc, cur, wr, wc, fr, fq, lds, wid, lane); S.done(cur); }
#undef PG8_SA
#undef PG8_SB
#undef PG8_STAGE
#undef PG8_LDA
#undef PG8_LDB
#undef PG8_MMA
#undef PG8_WAIT_V
#undef PG8_WAIT_L
#undef PG8_BAR
#undef PG8_SCHED
}
}

constexpr int NB = 8, T = 4096, D = 1024, NTOK = NB * T;
constexpr int ATT_H = 8, ATT_D = 64, ATT_W = 512, KV_LAT = 256, IDX_H = 8, IDX_D = 64, TOPK = 256;
constexpr int HG_H = 4, HG_DK = 128, HG_DV = 128, HG_W = 512, HG_C = 32;
constexpr int D_IN = 3400, D_INP = 3584;
constexpr int C_AQ = 0, C_AC = 512, C_IQ = 768, C_IK = 1280, C_IW = 1344, C_GQ = 1352, C_GF = 1864, C_GI = 2376, C_GG = 2888;
constexpr int NE = 32, TOPE = 4, DFF = 1024, PLE = 256;
constexpr int NASSIGN = NTOK * TOPE, CAP = NASSIGN + NE * 256;
constexpr int MAXTILES = CAP / 256;
constexpr float LN_EPS = 1e-5f, RMS_EPS = 1e-6f, ALPHA = 1.189207115002721f;

constexpr size_t MiB = 1u << 20;
constexpr size_t WS_CTL = 0, CTL_ZERO_BYTES = 64 * 1024;
constexpr size_t WS_WIN_T = 1 * MiB, WS_WO_T = 8 * MiB, WS_WUP_T = 10 * MiB, WS_WDN_T = 138 * MiB, WS_WPROJ_T = 202 * MiB, WS_WGATE_T = 203 * MiB;
constexpr size_t WS_WUK_T = 205 * MiB, WS_WUV_T = 205 * MiB + 512 * 1024;
constexpr size_t WS_SMALL = 206 * MiB;
constexpr size_t WS_A = 208 * MiB;
constexpr size_t WS_B = 480 * MiB;
constexpr size_t WS_X1 = 752 * MiB;
constexpr size_t WS_XB = 880 * MiB;
constexpr size_t WS_PROJ = 944 * MiB;
constexpr size_t WS_SM2 = 1008 * MiB;
constexpr size_t WS_END = 1016 * MiB;
constexpr size_t WS_H = WS_A, WS_XS = WS_A, WS_YSLOT = WS_A;
constexpr size_t WS_XBF = WS_X1 + 64 * MiB, WS_U = WS_B, WS_YMIX = WS_B, WS_HH = WS_B;
constexpr size_t WS_QDEC = WS_B + 128 * MiB, WS_PB = WS_B + 128 * MiB, WS_OREC = WS_B + 160 * MiB, WS_CN = WS_B + 224 * MiB, WS_IKN = WS_B + 240 * MiB, WS_MASK = WS_B + 244 * MiB;
constexpr size_t WS_K = WS_XB, WS_VT = WS_XB + 32 * MiB;
constexpr size_t WS_TOPE = WS_SM2, WS_GATE = WS_SM2 + 512 * 1024, WS_LRANK = WS_SM2 + 1024 * 1024, WS_TOKSLOT = WS_SM2 + 1536 * 1024, WS_SLOTGATE = WS_SM2 + 2 * MiB, WS_DECAY = WS_SM2 + 3 * MiB;
constexpr size_t WS_WRT = WS_SMALL + 256 * 1024;
constexpr size_t WS_WGBASE = WS_SMALL, WS_TILEE = WS_SMALL + 64 * 1024;
constexpr int CW_CNT = 64;
constexpr int CW_BAR = 1024;
constexpr int XBW_OFF = 147456 - 16;

constexpr int RING_BYTES = 131072, MISC_OFF = RING_BYTES, LDS_BYTES = 147456;
constexpr int NWAVES = 8, NTHR = 512;

#define GAS __attribute__((address_space(1)))
#define LAS __attribute__((address_space(3)))
typedef unsigned short bf16;
typedef unsigned v4u __attribute__((ext_vector_type(4)));
typedef unsigned v2u __attribute__((ext_vector_type(2)));
typedef float f32x4 __attribute__((ext_vector_type(4)));
typedef short bf16x8 __attribute__((ext_vector_type(8)));
#define LDS_WAIT() asm volatile("s_waitcnt lgkmcnt(0)" ::: "memory")
#define VM_WAIT() asm volatile("s_waitcnt vmcnt(0)" ::: "memory")
__device__ __forceinline__ unsigned f2bf(float f) { unsigned u = __builtin_bit_cast(unsigned, f); return (u + 0x7fffu + ((u >> 16) & 1u)) >> 16; }
__device__ __forceinline__ unsigned pk2(float lo, float hi) { return f2bf(lo) | (f2bf(hi) << 16); }
__device__ __forceinline__ float bf2f(unsigned short b) { return __builtin_bit_cast(float, (unsigned)b << 16); }
__device__ __forceinline__ float bflo(unsigned w) { return __builtin_bit_cast(float, w << 16); }
__device__ __forceinline__ float bfhi(unsigned w) { return __builtin_bit_cast(float, w & 0xffff0000u); }
__device__ __forceinline__ float wave_sum(float v) {
#pragma unroll
    for (int o = 1; o < 64; o <<= 1) v += __shfl_xor(v, o);
    return v;
}
__device__ __forceinline__ float sigmoidf_(float x) { return __builtin_amdgcn_rcpf(1.f + __builtin_amdgcn_exp2f(x * -1.4426950408889634f)); }

__device__ __forceinline__ unsigned pk4_fp8(float a, float b, float c, float d);
struct Params { const float* in[25]; float* out; unsigned char* ws; };
enum { I_X = 0, I_P, I_WIN, I_KVG, I_IKG, I_IKB, I_WUK, I_WUV, I_HGLB, I_HGNG, I_WO, I_LNMG, I_LNMB, I_WR, I_BR, I_WUP, I_BUP, I_WDN, I_BDN, I_LNFG, I_LNFB, I_WPP, I_WPG, I_LNPG, I_LNPB };

struct Ctx { LAS unsigned char* lds; int tid, lane, wave, G, gw, ngw; };

namespace pg8 {
struct EpiBf16s {
    static constexpr bool PERM = true, AFTER_DRAIN = false;
    bf16_t* O; int ldc;
    __device__ __forceinline__ void operator()(const f32x4 (&acc)[2][2][4][2], const Unit& u, int wr, int wc, int fr, int fq) const {
        const int row0 = u.pm * BM + wr * 64 + fr, col0 = u.pn * BM + wc * 32 + 8 * fq;
#pragma unroll
        for (int ai = 0; ai < 2; ++ai)
#pragma unroll
            for (int m = 0; m < 4; ++m) { bf16_t* rowp = O + (size_t)(row0 + ai * HALF + m * 16) * ldc + col0;
#pragma unroll
                for (int bj = 0; bj < 2; ++bj) { const f32x4 v0 = acc[ai][bj][m][0], v1 = acc[ai][bj][m][1];
                    u32x4 w; w.x = cvt_pk_bf16(v0[0], v0[1]); w.y = cvt_pk_bf16(v0[2], v0[3]); w.z = cvt_pk_bf16(v1[0], v1[1]); w.w = cvt_pk_bf16(v1[2], v1[3]);
                    *(u32x4*)(rowp + bj * HALF) = w; } }
    }
};
struct EpiResid {
    static constexpr bool PERM = false, AFTER_DRAIN = false;
    const bf16_t* res; bf16_t* out; int ldc; float alpha, as;
    __device__ __forceinline__ void operator()(const f32x4 (&acc)[2][2][4][2], const Unit& u, int wr, int wc, int fr, int fq) const {
        const int row0 = u.pm * BM + wr * 64 + fr, col0 = u.pn * BM + wc * 32 + 4 * fq;
#pragma unroll
        for (int ai = 0; ai < 2; ++ai)
#pragma unroll
            for (int m = 0; m < 4; ++m) { const size_t off = (size_t)(row0 + ai * HALF + m * 16) * ldc + col0;
#pragma unroll
                for (int bj = 0; bj < 2; ++bj)
#pragma unroll
                    for (int n = 0; n < 2; ++n) { const v2u rw = *(const v2u*)(res + off + bj * HALF + n * 16); const f32x4 r = {bflo(rw.x), bfhi(rw.x), bflo(rw.y), bfhi(rw.y)}; const f32x4 o = r * alpha + acc[ai][bj][m][n] * as; v2u w; w.x = cvt_pk_bf16(o[0], o[1]); w.y = cvt_pk_bf16(o[2], o[3]); *(v2u*)(out + off + bj * HALF + n * 16) = w; }
                asm volatile("" ::: "memory"); }
    }
};
struct EpiPle {
    static constexpr bool PERM = false, AFTER_DRAIN = false;
    const bf16_t* x2; const bf16_t* proj; bf16_t* out; float alpha, as;
    __device__ __forceinline__ void operator()(const f32x4 (&acc)[2][2][4][2], const Unit& u, int wr, int wc, int fr, int fq) const {
        const int row0 = u.pm * BM + wr * 64 + fr, col0 = u.pn * BM + wc * 32 + 4 * fq;
#pragma unroll
        for (int ai = 0; ai < 2; ++ai)
#pragma unroll
            for (int m = 0; m < 4; ++m) { const size_t off = (size_t)(row0 + ai * HALF + m * 16) * 1024 + col0;
#pragma unroll
                for (int bj = 0; bj < 2; ++bj)
#pragma unroll
                    for (int n = 0; n < 2; ++n) { const size_t o2 = off + bj * HALF + n * 16; const v2u rw = *(const v2u*)(x2 + o2); const f32x4 r = {bflo(rw.x), bfhi(rw.x), bflo(rw.y), bfhi(rw.y)}; const v2u pw = *(const v2u*)(proj + o2);
                        const f32x4 a = acc[ai][bj][m][n] * as; f32x4 o;
                        o[0] = r[0] * alpha + bflo(pw.x) * sigmoidf_(a[0]); o[1] = r[1] * alpha + bfhi(pw.x) * sigmoidf_(a[1]);
                        o[2] = r[2] * alpha + bflo(pw.y) * sigmoidf_(a[2]); o[3] = r[3] * alpha + bfhi(pw.y) * sigmoidf_(a[3]);
                        v2u ow; ow.x = cvt_pk_bf16(o[0], o[1]); ow.y = cvt_pk_bf16(o[2], o[3]); *(v2u*)(out + o2) = ow; }
                asm volatile("" ::: "memory"); }
    }
};
struct EpiSwiglu {
    static constexpr bool PERM = true, AFTER_DRAIN = false;
    unsigned char* H; const float* b_up;
    __device__ __forceinline__ void operator()(const f32x4 (&acc)[2][2][4][2], const Unit& u, int wr, int wc, int fr, int fq) const {
        const int e = u.pn >> 3, pnT = u.pn & 7;
        const int row0 = u.pm * BM + wr * 64 + fr, col0 = pnT * 128 + wc * 32 + 8 * fq;
        const float* bg = b_up + (size_t)e * 2048 + col0; const float* bl = bg + 1024;
        float bgv[8], blv[8];
#pragma unroll
        for (int j = 0; j < 8; ++j) { bgv[j] = bg[j]; blv[j] = bl[j]; }
#pragma unroll
        for (int ai = 0; ai < 2; ++ai)
#pragma unroll
            for (int m = 0; m < 4; ++m) { unsigned char* rowp = H + (size_t)(row0 + ai * HALF + m * 16) * 1024 + col0; float a[8];
#pragma unroll
                for (int n = 0; n < 2; ++n)
#pragma unroll
                    for (int j = 0; j < 4; ++j) { float g = acc[ai][0][m][n][j] * (1.f / 512.f) + bgv[4 * n + j], l = acc[ai][1][m][n][j] * (1.f / 512.f) + blv[4 * n + j];
                        g = fminf(g, 7.0f); l = fminf(fmaxf(l, -7.0f), 7.0f); a[4 * n + j] = g * sigmoidf_(1.702f * g) * (l + 1.0f); }
                v2u w; w.x = pk4_fp8(a[0] * 4.f, a[1] * 4.f, a[2] * 4.f, a[3] * 4.f); w.y = pk4_fp8(a[4] * 4.f, a[5] * 4.f, a[6] * 4.f, a[7] * 4.f);
                *(v2u*)rowp = w; }
    }
};
struct EpiDown {
    static constexpr bool PERM = true, AFTER_DRAIN = false;
    unsigned char* Y; const float* b_dn; const float* gate;
    __device__ __forceinline__ void operator()(const f32x4 (&acc)[2][2][4][2], const Unit& u, int wr, int wc, int fr, int fq) const {
        const int e = u.pn >> 2, pnT = u.pn & 3;
        const int row0 = u.pm * BM + wr * 64 + fr, col0 = pnT * 256 + wc * 32 + 8 * fq;
        const float* bb = b_dn + (size_t)e * 1024 + col0;
        float bv[2][8];
#pragma unroll
        for (int bj = 0; bj < 2; ++bj)
#pragma unroll
            for (int j = 0; j < 8; ++j) bv[bj][j] = bb[bj * HALF + j];
#pragma unroll
        for (int ai = 0; ai < 2; ++ai)
#pragma unroll
            for (int m = 0; m < 4; ++m) { const int row = row0 + ai * HALF + m * 16; const float gt = gate[row] * 64.f; unsigned char* rowp = Y + (size_t)row * 1024 + col0;
#pragma unroll
                for (int bj = 0; bj < 2; ++bj) { const f32x4 v0 = acc[ai][bj][m][0], v1 = acc[ai][bj][m][1];
                    const float as = 1.f / 256.f;
                    v2u w; w.x = pk4_fp8((v0[0] * as + bv[bj][0]) * gt, (v0[1] * as + bv[bj][1]) * gt, (v0[2] * as + bv[bj][2]) * gt, (v0[3] * as + bv[bj][3]) * gt);
                    w.y = pk4_fp8((v1[0] * as + bv[bj][4]) * gt, (v1[1] * as + bv[bj][5]) * gt, (v1[2] * as + bv[bj][6]) * gt, (v1[3] * as + bv[bj][7]) * gt);
                    *(v2u*)(rowp + bj * HALF) = w; } }
    }
};
struct MoeOrder {
    const int* tile_e; int ntiles, nN, G, c;
    __device__ __forceinline__ bool next(int i, Unit& u) const {
        if ((G & 7) == 0) {
            const int x = c & 7, s = i * (G >> 3) + (c >> 3);
            const int cg = nN >> 2, rg = 8 / cg;
            const int ch = x % cg, rc = x / cg;
            const int lr = s >> 2, pl = 4 * ch + (s & 3), pm = rc + rg * lr;
            if (pm >= ntiles) return false;
            u.pm = pm; u.pn = tile_e[pm] * nN + pl; return true;
        }
        const int L = i * G + c; if (L >= ntiles * nN) return false;
        const int pm = L / nN, pl = L - pm * nN; u.pm = pm; u.pn = tile_e[pm] * nN + pl; return true;
    }
    __device__ __forceinline__ void a_ready(const Unit&) const {}
    __device__ __forceinline__ void done(const Unit&) const {}
};
}

template <class RowMap>
__device__ __forceinline__ void transpose_item(const float* W, int ldw, int Nvalid, bf16* WT, int Kdim, RowMap rm, LAS float* scr, int kb, int nb, int lane) {
    const int k0 = 64 * kb, n0 = 32 * nb; const int nl0 = lane & 31, nn = n0 + nl0;
#pragma unroll 8
    for (int i = 0; i < 32; ++i) { const int kk = 2 * i + (lane >> 5); scr[kk * 33 + nl0] = (nn < Nvalid) ? W[(size_t)(k0 + kk) * ldw + nn] : 0.f; }
    LDS_WAIT(); asm volatile("" ::: "memory");
    const int c = lane & 7;
#pragma unroll
    for (int j = 0; j < 4; ++j) { const int n = (lane >> 3) + 8 * j; const LAS float* s = scr + (8 * c) * 33 + n;
        v4u o; o.x = pk2(s[0 * 33], s[1 * 33]); o.y = pk2(s[2 * 33], s[3 * 33]); o.z = pk2(s[4 * 33], s[5 * 33]); o.w = pk2(s[6 * 33], s[7 * 33]);
        *(GAS v4u*)(WT + (size_t)rm(n0 + n) * Kdim + k0 + 8 * c) = o; }
    LDS_WAIT(); asm volatile("" ::: "memory");
}
__device__ __forceinline__ unsigned pk4_fp8(float a, float b, float c, float d) { int r = 0; r = __builtin_amdgcn_cvt_pk_fp8_f32(a, b, r, false); r = __builtin_amdgcn_cvt_pk_fp8_f32(c, d, r, true); return (unsigned)r; }
template <class RowMap>
__device__ __forceinline__ void transpose_item_f8(const float* W, int ldw, unsigned char* WT, int Kdim, RowMap rm, LAS float* scr, int kb, int nb, int lane, float mul) {
    const int k0 = 64 * kb, n0 = 32 * nb; const int nl0 = lane & 31, nn = n0 + nl0;
#pragma unroll 8
    for (int i = 0; i < 32; ++i) { const int kk = 2 * i + (lane >> 5); scr[kk * 33 + nl0] = W[(size_t)(k0 + kk) * ldw + nn] * mul; }
    LDS_WAIT(); asm volatile("" ::: "memory");
    const int c = lane & 7;
#pragma unroll
    for (int j = 0; j < 4; ++j) { const int n = (lane >> 3) + 8 * j; const LAS float* s = scr + (8 * c) * 33 + n;
        v2u o; o.x = pk4_fp8(s[0 * 33], s[1 * 33], s[2 * 33], s[3 * 33]); o.y = pk4_fp8(s[4 * 33], s[5 * 33], s[6 * 33], s[7 * 33]);
        *(GAS v2u*)(WT + (size_t)rm(n0 + n) * Kdim + k0 + 8 * c) = o; }
    LDS_WAIT(); asm volatile("" ::: "memory");
}
struct RmId { __device__ __forceinline__ int operator()(int n) const { return n; } };
struct RmUp { int e; __device__ __forceinline__ int operator()(int n) const { return e * 2048 + ((n & 1023) >> 7) * 256 + (n >> 10) * 128 + (n & 127); } };
struct RmOff { int off; __device__ __forceinline__ int operator()(int n) const { return off + n; } };

struct CvtItem { const float* src; unsigned char* dst; int ldw; };
__device__ __forceinline__ CvtItem cvt_decode(const Params& P, int r) {
    unsigned char* ws = P.ws; CvtItem c;
    constexpr int I_O = 8 * 32, I_UP = 8 * 64, I_DN = 8 * 32;
    if (r < I_O) { const int kb = r / 32, nb = r % 32; c.src = P.in[I_WO] + (size_t)(128 * kb) * 1024 + 32 * nb; c.ldw = 1024; c.dst = ws + WS_WO_T + (size_t)(32 * nb) * 1024 + 128 * kb; return c; } r -= I_O;
    if (r < NE * I_UP) { const int e = r / I_UP, q = r % I_UP, kb = q / 64, nb = q % 64, n0 = 32 * nb; c.src = P.in[I_WUP] + (size_t)e * 1024 * 2048 + (size_t)(128 * kb) * 2048 + n0; c.ldw = 2048;
        c.dst = ws + WS_WUP_T + (size_t)(e * 2048 + ((n0 & 1023) >> 7) * 256 + (n0 >> 10) * 128 + (n0 & 127)) * 1024 + 128 * kb; return c; } r -= NE * I_UP;
    if (r < NE * I_DN) { const int e = r / I_DN, q = r % I_DN, kb = q / 32, nb = q % 32; c.src = P.in[I_WDN] + (size_t)e * 1024 * 1024 + (size_t)(128 * kb) * 1024 + 32 * nb; c.ldw = 1024;
        c.dst = ws + WS_WDN_T + (size_t)(e * 1024 + 32 * nb) * 1024 + 128 * kb; return c; } r -= NE * I_DN;
    { const int kb = r / 32, nb = r % 32; c.src = P.in[I_WPG] + (size_t)(128 * kb) * 1024 + 32 * nb; c.ldw = 1024; c.dst = ws + WS_WGATE_T + (size_t)(32 * nb) * 1024 + 128 * kb; return c; }
}
__device__ __forceinline__ void cvt_load(const CvtItem& c, float (&v)[64], int lane) {
    const float* p = c.src + (size_t)(lane >> 5) * c.ldw + (lane & 31);
#pragma unroll
    for (int i = 0; i < 64; ++i) v[i] = p[(size_t)(2 * i) * c.ldw];
}
__device__ __forceinline__ void cvt_store(const CvtItem& c, const float (&v)[64], LAS float* scr, int lane) {
#pragma unroll
    for (int i = 0; i < 64; ++i) scr[(2 * i + (lane >> 5)) * 33 + (lane & 31)] = v[i] * 64.f;
    LDS_WAIT(); asm volatile("" ::: "memory");
    const int ch = lane & 15;
#pragma unroll
    for (int j = 0; j < 8; ++j) { const int n = (lane >> 4) + 4 * j; const LAS float* s = scr + (8 * ch) * 33 + n;
        v2u o; o.x = pk4_fp8(s[0 * 33], s[1 * 33], s[2 * 33], s[3 * 33]); o.y = pk4_fp8(s[4 * 33], s[5 * 33], s[6 * 33], s[7 * 33]);
        *(GAS v2u*)(c.dst + (size_t)n * 1024 + 8 * ch) = o; }
    LDS_WAIT(); asm volatile("" ::: "memory");
}
__device__ __forceinline__ void convert_late(const Params& P, LAS float* scr, int gwc, int ngwc, int lane) {
    constexpr int NT = 8 * 32 + NE * 8 * 64 + NE * 8 * 32 + 8 * 32;
    float va[64], vb[64];
    int it = gwc;
    if (it < NT) { const CvtItem c = cvt_decode(P, it); cvt_load(c, va, lane); }
    for (; it < NT; it += 2 * ngwc) {
        const int i1 = it + ngwc, i2 = it + 2 * ngwc;
        if (i1 < NT) { const CvtItem c = cvt_decode(P, i1); cvt_load(c, vb, lane); }
        { const CvtItem c = cvt_decode(P, it); cvt_store(c, va, scr, lane); }
        if (i2 < NT) { const CvtItem c = cvt_decode(P, i2); cvt_load(c, va, lane); }
        if (i1 < NT) { const CvtItem c = cvt_decode(P, i1); cvt_store(c, vb, scr, lane); }
    }
    for (int r = gwc; r < 512; r += ngwc) { const int i = r * 64 + lane; const int e = i >> 10, k = i & 1023; ((float*)(P.ws + WS_WRT))[i] = P.in[I_WR][k * 32 + e]; }
}
__device__ __forceinline__ void p0_prologue(const Params& P, const Ctx& C) {
    LAS float* scr = (LAS float*)(C.lds + C.wave * 16384);
    unsigned char* ws = P.ws;
    constexpr int I_IN = 16 * (D_INP / 32), I_PP = 4 * 32, I_UK = 4 * 16, I_UV = 4 * 16;
    constexpr int NITEMS = I_IN + I_PP + I_UK + I_UV;
    for (int it = C.gw; it < NITEMS; it += C.ngw) {
        int r = it;
        if (r < I_IN) { transpose_item(P.in[I_WIN], D_IN, D_IN, (bf16*)(ws + WS_WIN_T), 1024, RmId{}, scr, r / (D_INP / 32), r % (D_INP / 32), C.lane); continue; } r -= I_IN;
        if (r < I_PP) { transpose_item(P.in[I_WPP], 1024, 1024, (bf16*)(ws + WS_WPROJ_T), 256, RmId{}, scr, r / 32, r % 32, C.lane); continue; } r -= I_PP;
        if (r < I_UK) { transpose_item(P.in[I_WUK], 512, 512, (bf16*)(ws + WS_WUK_T), 256, RmId{}, scr, r / 16, r % 16, C.lane); continue; } r -= I_UK;
        transpose_item(P.in[I_WUV], 512, 512, (bf16*)(ws + WS_WUV_T), 256, RmId{}, scr, r / 16, r % 16, C.lane);
    }
    {
        const float* x = P.in[I_X]; bf16* xb = (bf16*)(ws + WS_XBF);
        const size_t n8 = (size_t)NTOK * D / 8, stride = (size_t)C.ngw * 64;
        for (size_t i = (size_t)C.gw * 64 + C.lane; i < n8; i += stride) { const f32x4 a = *(const GAS f32x4*)(x + i * 8), b = *(const GAS f32x4*)(x + i * 8 + 4);
            v4u o; o.x = pk2(a[0], a[1]); o.y = pk2(a[2], a[3]); o.z = pk2(b[0], b[1]); o.w = pk2(b[2], b[3]); *(GAS v4u*)(xb + i * 8) = o; }
        const float* p = P.in[I_P]; bf16* pb = (bf16*)(ws + WS_PB);
        const size_t m8 = (size_t)NTOK * PLE / 8;
        for (size_t i = (size_t)C.gw * 64 + C.lane; i < m8; i += stride) { const f32x4 a = *(const GAS f32x4*)(p + i * 8), b = *(const GAS f32x4*)(p + i * 8 + 4);
            v4u o; o.x = pk2(a[0], a[1]); o.y = pk2(a[2], a[3]); o.z = pk2(b[0], b[1]); o.w = pk2(b[2], b[3]); *(GAS v4u*)(pb + i * 8) = o; }
    }
}

__device__ __forceinline__ void ln_row(f32x4 (&v)[4], const float* g, const float* b, int lane) {
    float s = 0.f;
#pragma unroll
    for (int j = 0; j < 4; ++j) s += (v[j][0] + v[j][1]) + (v[j][2] + v[j][3]);
    const float mean = wave_sum(s) * (1.f / D); float s2 = 0.f;
#pragma unroll
    for (int j = 0; j < 4; ++j) { v[j] = v[j] - mean; s2 += (v[j][0] * v[j][0] + v[j][1] * v[j][1]) + (v[j][2] * v[j][2] + v[j][3] * v[j][3]); }
    const float rstd = __builtin_amdgcn_rsqf(wave_sum(s2) * (1.f / D) + LN_EPS);
#pragma unroll
    for (int j = 0; j < 4; ++j) { const f32x4 gg = *(const f32x4*)(g + 4 * lane + 256 * j), bb = *(const f32x4*)(b + 4 * lane + 256 * j); v[j] = v[j] * rstd * gg + bb; }
}
__device__ __forceinline__ void store_row_f32(float* row, const f32x4 (&v)[4], int lane) {
#pragma unroll
    for (int j = 0; j < 4; ++j) *(GAS f32x4*)(row + 4 * lane + 256 * j) = v[j];
}
__device__ __forceinline__ void store_row_bf16(bf16* row, const f32x4 (&v)[4], int lane) {
#pragma unroll
    for (int j = 0; j < 4; ++j) { v2u o; o.x = pk2(v[j][0], v[j][1]); o.y = pk2(v[j][2], v[j][3]); *(GAS v2u*)(row + 4 * lane + 256 * j) = o; }
}
__device__ __forceinline__ void store_row_fp8x8(unsigned char* row, const f32x4 (&v)[4], int lane) {
#pragma unroll
    for (int j = 0; j < 4; ++j) *(GAS unsigned*)(row + 4 * lane + 256 * j) = pk4_fp8(v[j][0] * 8.f, v[j][1] * 8.f, v[j][2] * 8.f, v[j][3] * 8.f);
}
__device__ __forceinline__ f32x4 fp8x4_to_f32(unsigned w) {
    typedef float f2 __attribute__((ext_vector_type(2)));
    const f2 lo = __builtin_amdgcn_cvt_pk_f32_fp8((int)w, false), hi = __builtin_amdgcn_cvt_pk_f32_fp8((int)w, true);
    return (f32x4){lo[0], lo[1], hi[0], hi[1]};
}
__device__ __forceinline__ void load_row_bf16(f32x4 (&v)[4], const bf16* row, int lane) {
#pragma unroll
    for (int j = 0; j < 4; ++j) { const v2u w = *(const GAS v2u*)(row + 4 * lane + 256 * j); v[j] = (f32x4){bflo(w.x), bfhi(w.x), bflo(w.y), bfhi(w.y)}; }
}
__device__ __forceinline__ void load_row_f32(f32x4 (&v)[4], const float* row, int lane) {
#pragma unroll
    for (int j = 0; j < 4; ++j) v[j] = *(const GAS f32x4*)(row + 4 * lane + 256 * j);
}
#ifndef FEAT_MIX
#define FEAT_MIX 1
#endif
#ifndef FEAT_MOE
#define FEAT_MOE 1
#endif
#ifndef FEAT_PLE
#define FEAT_PLE 1
#endif
#ifndef FEAT_ATT
#define FEAT_ATT 1
#endif
#ifndef SYNC_MODE
#define SYNC_MODE 0
#endif
#ifndef PROGRAM
#define PROGRAM X(0) GS X(10) X(11) SY X(20) X(21) SY X(30) X(31) BS X(32) SY X(40) X(41) SY X(5) SY X(6) SY X(7) SY X(8) SY X(9) SY X(100) SY X(110) SY X(120)
#endif
#ifndef COOP_LAUNCH
#define PLAIN_LAUNCH 1
#endif

typedef float f32x16 __attribute__((ext_vector_type(16)));
typedef short s16x4 __attribute__((ext_vector_type(4)));
__device__ __forceinline__ unsigned cvtpk(float lo, float hi) { typedef float f2 __attribute__((ext_vector_type(2))); typedef __bf16 b2 __attribute__((ext_vector_type(2))); f2 v = {lo, hi}; b2 b = __builtin_convertvector(v, b2); return __builtin_bit_cast(unsigned, b); }
__device__ __forceinline__ bf16x8 pack8(const f32x16& x, int base) {
    v4u w; w.x = cvtpk(x[base + 0], x[base + 1]); w.y = cvtpk(x[base + 2], x[base + 3]); w.z = cvtpk(x[base + 4], x[base + 5]); w.w = cvtpk(x[base + 6], x[base + 7]);
    return __builtin_bit_cast(bf16x8, w);
}

__device__ __forceinline__ void p2_post(const Params& P, const Ctx& C) {
    unsigned char* ws = P.ws;
    const bf16* H = (const bf16*)(ws + WS_H); bf16* CN = (bf16*)(ws + WS_CN); bf16* IKN = (bf16*)(ws + WS_IKN);
    const float* kvg = P.in[I_KVG]; const float* ikg = P.in[I_IKG]; const float* ikb = P.in[I_IKB];
    const f32x4 g4 = *(const f32x4*)(kvg + 4 * C.lane); const float ig = ikg[C.lane], ib = ikb[C.lane];
    for (int m = C.gw; m < NTOK; m += C.ngw) {
        const bf16* hr = H + (size_t)m * D_INP;
        const v2u w = *(const GAS v2u*)(hr + C_AC + 4 * C.lane);
        float a0 = bflo(w.x), a1 = bfhi(w.x), a2 = bflo(w.y), a3 = bfhi(w.y);
        const float ss = wave_sum((a0 * a0 + a1 * a1) + (a2 * a2 + a3 * a3));
        const float rs = __builtin_amdgcn_rsqf(ss * (1.f / 256.f) + RMS_EPS);
        v2u o; o.x = pk2(a0 * rs * g4[0], a1 * rs * g4[1]); o.y = pk2(a2 * rs * g4[2], a3 * rs * g4[3]);
        *(GAS v2u*)(CN + (size_t)m * 256 + 4 * C.lane) = o;
        const float k = bf2f(hr[C_IK + C.lane]);
        const float mu = wave_sum(k) * (1.f / 64.f); const float dk = k - mu;
        const float var = wave_sum(dk * dk) * (1.f / 64.f);
        IKN[(size_t)m * 64 + C.lane] = (bf16)f2bf(dk * __builtin_amdgcn_rsqf(var + LN_EPS) * ig + ib);
    }
}

constexpr int HP_QD = 0, HP_KI = 8704, HP_KET = 17408, HP_VT = 27648, HP_GS = 37888, HP_RAW = 40960;
__device__ __forceinline__ void p2_hgrn_prep(const Params& P, const Ctx& C) {
    unsigned char* ws = P.ws;
    const bf16* H = (const bf16*)(ws + WS_H);
    bf16* UT = (bf16*)(ws + WS_U); bf16* QDEC = (bf16*)(ws + WS_QDEC); float* OREC = (float*)(ws + WS_OREC); float* DEC = (float*)(ws + WS_DECAY);
    LAS bf16* QD = (LAS bf16*)(C.lds + HP_QD); LAS bf16* KI = (LAS bf16*)(C.lds + HP_KI); LAS bf16* KET = (LAS bf16*)(C.lds + HP_KET); LAS bf16* VT = (LAS bf16*)(C.lds + HP_VT);
    LAS float* GS = (LAS float*)(C.lds + HP_GS); LAS bf16* RAW = (LAS bf16*)(C.lds + HP_RAW);
    const int d = C.tid & 127, tg = C.tid >> 7;
    const int lane = C.lane, r32 = lane & 31, hf = lane >> 5;
    const int lc = C.tid >> 4, lg = C.tid & 15;
    const int NU = NB * HG_H * (T / HG_C);
    v4u rf, rq, ri;
    { const int unit = blockIdx.x; if (unit < NU) { const int n = unit & 127, hh = (unit >> 7) & 3, b = unit >> 9; const bf16* hr = H + (size_t)(b * T + n * HG_C + lc) * D_INP + hh * 128 + 8 * lg;
        rf = *(const GAS v4u*)(hr + C_GF); rq = *(const GAS v4u*)(hr + C_GQ); ri = *(const GAS v4u*)(hr + C_GI); } }
    for (int unit = blockIdx.x; unit < NU; unit += C.G) {
        const int n = unit & 127, hh = (unit >> 7) & 3, b = unit >> 9;
        const int m0 = b * T + n * HG_C;
        *(LAS v4u*)(RAW + lc * 128 + 8 * lg) = rf; *(LAS v4u*)(RAW + 4096 + lc * 128 + 8 * lg) = rq; *(LAS v4u*)(RAW + 8192 + lc * 128 + 8 * lg) = ri;
        __syncthreads();
        { const int un = unit + C.G; if (un < NU) { const int n2 = un & 127, h2 = (un >> 7) & 3, b2 = un >> 9; const bf16* hr = H + (size_t)(b2 * T + n2 * HG_C + lc) * D_INP + h2 * 128 + 8 * lg;
            rf = *(const GAS v4u*)(hr + C_GF); rq = *(const GAS v4u*)(hr + C_GQ); ri = *(const GAS v4u*)(hr + C_GI); } }
        const float l0 = P.in[I_HGLB][hh * 128 + d], l1 = P.in[I_HGLB][512 + hh * 128 + d];
        const float lb = sigmoidf_(l0 - l1);
        float fg[8], bl[8], qv[8]; float run = 0.f; unsigned vv[4];
#pragma unroll
        for (int c = 0; c < 8; ++c) { const int tok = tg * 8 + c;
            const float f = bf2f(RAW[tok * 128 + d]), q = bf2f(RAW[4096 + tok * 128 + d]); const unsigned iv = RAW[8192 + tok * 128 + d];
            fg[c] = lb + (1.f - lb) * sigmoidf_(f); run += __logf(fg[c]); bl[c] = run; qv[c] = q * sigmoidf_(q);
            if (c & 1) vv[c >> 1] |= iv << 16; else vv[c >> 1] = iv; }
        GS[tg * 128 + d] = run;
        *(LAS v4u*)(VT + d * 40 + tg * 8) = (v4u){vv[0], vv[1], vv[2], vv[3]};
        __syncthreads();
        float pre = 0.f, tot = 0.f;
#pragma unroll
        for (int g = 0; g < 4; ++g) { const float sg = GS[g * 128 + d]; tot += sg; if (g < tg) pre += sg; }
        unsigned ke[4];
#pragma unroll
        for (int c = 0; c < 8; ++c) { const float bc = pre + bl[c]; const float kc = 1.f - fg[c];
            const float qd = qv[c] * __expf(bc), ki = kc * __expf(-bc), kend = kc * __expf(tot - bc);
            const unsigned qb = f2bf(qd);
            QD[(tg * 8 + c) * 136 + d] = (bf16)qb; KI[(tg * 8 + c) * 136 + d] = (bf16)f2bf(ki);
            if (c & 1) ke[c >> 1] |= f2bf(kend) << 16; else ke[c >> 1] = f2bf(kend); }
        *(LAS v4u*)(KET + d * 40 + tg * 8) = (v4u){ke[0], ke[1], ke[2], ke[3]};
        if (tg == 0) DEC[(size_t)unit * 128 + d] = __expf(tot);
        __syncthreads();
        *(GAS v4u*)(QDEC + (size_t)(m0 + lc) * 512 + hh * 128 + 8 * lg) = *(const LAS v4u*)(QD + lc * 136 + 8 * lg);
        if (C.wave < 4) {
            f32x16 X = {0.f, 0.f, 0.f, 0.f, 0.f, 0.f, 0.f, 0.f, 0.f, 0.f, 0.f, 0.f, 0.f, 0.f, 0.f, 0.f};
#pragma unroll
            for (int k = 0; k < 8; ++k) { const bf16x8 a = *(const LAS bf16x8*)(KI + r32 * 136 + 16 * k + 8 * hf), bq = *(const LAS bf16x8*)(QD + r32 * 136 + 16 * k + 8 * hf);
                X = __builtin_amdgcn_mfma_f32_32x32x16_bf16(a, bq, X, 0, 0, 0); }
#pragma unroll
            for (int r = 0; r < 16; ++r) { const int sidx = (r & 3) + 8 * (r >> 2) + 4 * hf; if (sidx > r32) X[r] = 0.f; }
            f32x16 Z = {0.f, 0.f, 0.f, 0.f, 0.f, 0.f, 0.f, 0.f, 0.f, 0.f, 0.f, 0.f, 0.f, 0.f, 0.f, 0.f};
            const int e = C.wave * 32 + r32;
#pragma unroll
            for (int sp = 0; sp < 2; ++sp) { const bf16x8 a = pack8(X, 8 * sp);
                const s16x4 lo = *(const LAS s16x4*)(VT + e * 40 + 16 * sp + 4 * hf), hi = *(const LAS s16x4*)(VT + e * 40 + 16 * sp + 8 + 4 * hf);
                const bf16x8 bv = (bf16x8){lo[0], lo[1], lo[2], lo[3], hi[0], hi[1], hi[2], hi[3]};
                Z = __builtin_amdgcn_mfma_f32_32x32x16_bf16(a, bv, Z, 0, 0, 0); }
#pragma unroll
            for (int r = 0; r < 16; ++r) { const int c = (r & 3) + 8 * (r >> 2) + 4 * hf; OREC[(size_t)(m0 + c) * 512 + hh * 128 + e] = Z[r]; }
        }
        {
            const int dt = C.wave >> 1;
            const bf16x8 a0 = *(const LAS bf16x8*)(KET + (dt * 32 + r32) * 40 + 8 * hf), a1 = *(const LAS bf16x8*)(KET + (dt * 32 + r32) * 40 + 16 + 8 * hf);
#pragma unroll
            for (int ei = 0; ei < 2; ++ei) { const int et = 2 * (C.wave & 1) + ei;
                const bf16x8 b0 = *(const LAS bf16x8*)(VT + (et * 32 + r32) * 40 + 8 * hf), b1 = *(const LAS bf16x8*)(VT + (et * 32 + r32) * 40 + 16 + 8 * hf);
                f32x16 U = {0.f, 0.f, 0.f, 0.f, 0.f, 0.f, 0.f, 0.f, 0.f, 0.f, 0.f, 0.f, 0.f, 0.f, 0.f, 0.f};
                U = __builtin_amdgcn_mfma_f32_32x32x16_bf16(a0, b0, U, 0, 0, 0); U = __builtin_amdgcn_mfma_f32_32x32x16_bf16(a1, b1, U, 0, 0, 0);
                bf16* up = UT + (size_t)unit * 16384 + (size_t)(et * 32 + r32) * 128 + dt * 32 + 4 * hf;
#pragma unroll
                for (int q = 0; q < 4; ++q) { v2u o; o.x = cvtpk(U[4 * q], U[4 * q + 1]); o.y = cvtpk(U[4 * q + 2], U[4 * q + 3]); *(GAS v2u*)(up + 8 * q) = o; } }
        }
        __syncthreads();
    }
}

__device__ __forceinline__ void scan_wave(const Params& P, LAS unsigned char* lds, int unit, int lane) {
    unsigned char* ws = P.ws;
    const bf16* UT = (const bf16*)(ws + WS_U); const bf16* QDEC = (const bf16*)(ws + WS_QDEC); float* OREC = (float*)(ws + WS_OREC); const float* DEC = (const float*)(ws + WS_DECAY);
    typedef float f32x4v __attribute__((ext_vector_type(4)));
    const int xcd = (unit >> 1) & 7, loc = ((unit >> 4) << 1) | (unit & 1);
    const int bh = xcd + 8 * (loc >> 4), sl = loc & 15; const int b = bh >> 2, hh = bh & 3, e0 = 8 * sl;
    LAS bf16* ST = (LAS bf16*)lds;
    const int e = lane & 7, dq = lane >> 3;
    const int fr = lane & 15, fq = lane >> 4;
    float S[16];
#pragma unroll
    for (int i = 0; i < 16; ++i) S[i] = 0.f;
    for (int i = lane; i < 2 * 16 * 136 / 8; i += 64) *(LAS v4u*)(ST + 8 * i) = (v4u){0u, 0u, 0u, 0u};
    const int cu0 = (b * HG_H + hh) * 128;
    const bf16* up = UT + (size_t)cu0 * 16384 + (size_t)(e0 + e) * 128 + 16 * dq;
    const float* dp = DEC + (size_t)cu0 * 128 + 16 * dq;
    const bf16* qp = QDEC + (size_t)(b * T + fr) * 512 + hh * 128 + 8 * fq;
    float* op = OREC + (size_t)(b * T + 4 * fq) * 512 + hh * 128 + e0 + fr;
    const float* opl = OREC + (size_t)(b * T + 4 * fq) * 512 + hh * 128 + e0 + (fr & 7);
    const bool ov = fr < 8;
    v4u un[4][2]; float oi[4][2][4]; f32x4 dn[2][4]; bf16x8 qa[2][2][4];
#define SC_LD_U(slot, n) { un[slot][0] = *(const GAS v4u*)(up + (size_t)(n) * 16384); un[slot][1] = *(const GAS v4u*)(up + (size_t)(n) * 16384 + 8); \
        _Pragma("unroll") for (int t_ = 0; t_ < 2; ++t_) _Pragma("unroll") for (int j_ = 0; j_ < 4; ++j_) oi[slot][t_][j_] = opl[(size_t)((n) * 32 + 16 * t_ + j_) * 512]; }
#define SC_LD_Q(slot, n) { _Pragma("unroll") for (int i_ = 0; i_ < 4; ++i_) dn[slot][i_] = *(const GAS f32x4*)(dp + (size_t)(n) * 128 + 4 * i_); \
        _Pragma("unroll") for (int t_ = 0; t_ < 2; ++t_) _Pragma("unroll") for (int k_ = 0; k_ < 4; ++k_) qa[slot][t_][k_] = *(const GAS bf16x8*)(qp + (size_t)((n) * 32 + 16 * t_) * 512 + 32 * k_); }
    SC_LD_U(0, 0) SC_LD_U(1, 1) SC_LD_U(2, 2) SC_LD_U(3, 3) SC_LD_Q(0, 0) SC_LD_Q(1, 1)
    LDS_WAIT();
    for (int nb = 0; nb < 32; ++nb) {
#pragma unroll
        for (int s = 0; s < 4; ++s) {
            const int n = 4 * nb + s; const int su = s, sq = s & 1;
            const LAS bf16* stc = ST + (n & 1) * (16 * 136); LAS bf16* stn = ST + ((n + 1) & 1) * (16 * 136);
            bf16x8 bs[4];
#pragma unroll
            for (int k = 0; k < 4; ++k) bs[k] = *(const LAS bf16x8*)(stc + fr * 136 + 32 * k + 8 * fq);
#pragma unroll
            for (int t = 0; t < 2; ++t) { f32x4v acc = {oi[su][t][0], oi[su][t][1], oi[su][t][2], oi[su][t][3]};
#pragma unroll
                for (int k = 0; k < 4; ++k) acc = __builtin_amdgcn_mfma_f32_16x16x32_bf16(qa[sq][t][k], bs[k], acc, 0, 0, 0);
                if (ov) {
#pragma unroll
                    for (int j = 0; j < 4; ++j) op[(size_t)(n * 32 + 16 * t + j) * 512] = acc[j]; } }
            {
                const unsigned uw[8] = {un[su][0].x, un[su][0].y, un[su][0].z, un[su][0].w, un[su][1].x, un[su][1].y, un[su][1].z, un[su][1].w};
                unsigned pk[8];
#pragma unroll
                for (int i = 0; i < 8; ++i) { S[2 * i] = dn[sq][i >> 1][(2 * i) & 3] * S[2 * i] + bflo(uw[i]); S[2 * i + 1] = dn[sq][i >> 1][(2 * i + 1) & 3] * S[2 * i + 1] + bfhi(uw[i]); pk[i] = cvtpk(S[2 * i], S[2 * i + 1]); }
                *(LAS v4u*)(stn + e * 136 + 16 * dq) = (v4u){pk[0], pk[1], pk[2], pk[3]}; *(LAS v4u*)(stn + e * 136 + 16 * dq + 8) = (v4u){pk[4], pk[5], pk[6], pk[7]};
            }
            if (n + 4 < 128) SC_LD_U(su, n + 4)
            if (n + 2 < 128) SC_LD_Q(sq, n + 2)
        }
    }
#undef SC_LD_U
#undef SC_LD_Q
}
__device__ __forceinline__ void p3_scan_convert(const Params& P, const Ctx& C) {
    if (C.wave < 2) {
        for (int u = blockIdx.x * 2 + C.wave; u < NB * HG_H * 16; u += C.G * 2) scan_wave(P, C.lds + C.wave * 8704, u, C.lane);
    } else {
        convert_late(P, (LAS float*)(C.lds + 32768 + (C.wave - 2) * 17408), blockIdx.x * 6 + (C.wave - 2), C.G * 6, C.lane);
    }
}

__device__ __forceinline__ void p4_yrec(const Params& P, const Ctx& C) {
    unsigned char* ws = P.ws;
    const float* OREC = (const float*)(ws + WS_OREC); const bf16* H = (const bf16*)(ws + WS_H); bf16* YM = (bf16*)(ws + WS_YMIX);
    const float* ng = P.in[I_HGNG];
    const f32x4 g0 = *(const f32x4*)(ng + 8 * C.lane), g1 = *(const f32x4*)(ng + 8 * C.lane + 4);
    for (int m = C.gw; m < NTOK; m += C.ngw) {
        const f32x4 a = *(const GAS f32x4*)(OREC + (size_t)m * 512 + 8 * C.lane), bq = *(const GAS f32x4*)(OREC + (size_t)m * 512 + 8 * C.lane + 4);
        float ss = (a[0] * a[0] + a[1] * a[1]) + (a[2] * a[2] + a[3] * a[3]) + (bq[0] * bq[0] + bq[1] * bq[1]) + (bq[2] * bq[2] + bq[3] * bq[3]);
        ss += __shfl_xor(ss, 1); ss += __shfl_xor(ss, 2); ss += __shfl_xor(ss, 4); ss += __shfl_xor(ss, 8);
        const float rs = __builtin_amdgcn_rsqf(ss * (1.f / 128.f) + RMS_EPS);
        const v4u gw = *(const GAS v4u*)(H + (size_t)m * D_INP + C_GG + 8 * C.lane);
        float gv[8] = {bflo(gw.x), bfhi(gw.x), bflo(gw.y), bfhi(gw.y), bflo(gw.z), bfhi(gw.z), bflo(gw.w), bfhi(gw.w)};
        float o[8];
#pragma unroll
        for (int j = 0; j < 4; ++j) { o[j] = a[j] * rs * g0[j] * (gv[j] * sigmoidf_(gv[j])); o[4 + j] = bq[j] * rs * g1[j] * (gv[4 + j] * sigmoidf_(gv[4 + j])); }
        v2u w; w.x = pk4_fp8(o[0] * 8.f, o[1] * 8.f, o[2] * 8.f, o[3] * 8.f); w.y = pk4_fp8(o[4] * 8.f, o[5] * 8.f, o[6] * 8.f, o[7] * 8.f);
        *(GAS v2u*)((unsigned char*)YM + (size_t)m * D + 512 + 8 * C.lane) = w;
#if !FEAT_ATT
        *(GAS v4u*)(YM + (size_t)m * D + 8 * C.lane) = (v4u){0u, 0u, 0u, 0u};
#endif
    }
}

namespace pg8 {
struct EpiKhead {
    static constexpr bool PERM = true, AFTER_DRAIN = false;
    bf16_t* O;
    __device__ __forceinline__ void operator()(const f32x4 (&acc)[2][2][4][2], const Unit& u, int wr, int wc, int fr, int fq) const {
        const int row0 = u.pm * BM + wr * 64 + fr, col0 = u.pn * BM + wc * 32 + 8 * fq;
#pragma unroll
        for (int ai = 0; ai < 2; ++ai)
#pragma unroll
            for (int m = 0; m < 4; ++m) { const int row = row0 + ai * HALF + m * 16; const int b = row >> 12, t = row & 4095;
#pragma unroll
                for (int bj = 0; bj < 2; ++bj) { const int col = col0 + bj * HALF; const f32x4 v0 = acc[ai][bj][m][0], v1 = acc[ai][bj][m][1];
                    u32x4 w; w.x = cvt_pk_bf16(v0[0], v0[1]); w.y = cvt_pk_bf16(v0[2], v0[3]); w.z = cvt_pk_bf16(v1[0], v1[1]); w.w = cvt_pk_bf16(v1[2], v1[3]);
                    *(u32x4*)(O + ((size_t)((b * 8 + (col >> 6)) * 4096 + t)) * 64 + (col & 63)) = w; } }
    }
};
struct EpiVt {
    static constexpr bool PERM = true, AFTER_DRAIN = false;
    bf16_t* O;
    __device__ __forceinline__ void operator()(const f32x4 (&acc)[2][2][4][2], const Unit& u, int wr, int wc, int fr, int fq) const {
        const int row0 = u.pm * BM + wr * 64 + fr, col0 = u.pn * BM + wc * 32 + 8 * fq;
#pragma unroll
        for (int ai = 0; ai < 2; ++ai)
#pragma unroll
            for (int m = 0; m < 4; ++m) { const int row = row0 + ai * HALF + m * 16;
#pragma unroll
                for (int bj = 0; bj < 2; ++bj) { const int col = col0 + bj * HALF; const int b = col >> 12, t = col & 4095; const f32x4 v0 = acc[ai][bj][m][0], v1 = acc[ai][bj][m][1];
                    u32x4 w; w.x = cvt_pk_bf16(v0[0], v0[1]); w.y = cvt_pk_bf16(v0[2], v0[3]); w.z = cvt_pk_bf16(v1[0], v1[1]); w.w = cvt_pk_bf16(v1[2], v1[3]);
                    *(u32x4*)(O + ((size_t)(b * 512 + row)) * 4096 + t) = w; } }
    }
};
}

__device__ __forceinline__ unsigned f2ord(float x) { const unsigned b = __builtin_bit_cast(unsigned, x); return b ^ ((unsigned)((int)b >> 31) | 0x80000000u); }
typedef _Float16 h16;
typedef _Float16 h16x8 __attribute__((ext_vector_type(8)));
__device__ __forceinline__ float relu_i(float x) { const int b = __builtin_bit_cast(int, x); return __builtin_bit_cast(float, b > 0 ? b : 0); }
__device__ __forceinline__ unsigned h2ord(unsigned hb) { return (hb ^ ((hb & 0x8000u) ? 0xffffu : 0x8000u)) & 0xffffu; }
__device__ __forceinline__ int isc_bucket(float x, float mu, float scale) { const float t = fminf(fmaxf(fmaf(x - mu, scale, 128.f), 0.f), 255.f); return (int)t; }
__device__ __forceinline__ void p3_indexer(const Params& P, const Ctx& C) {
    unsigned char* ws = P.ws;
    const bf16* H = (const bf16*)(ws + WS_H); const bf16* IKN = (const bf16*)(ws + WS_IKN); unsigned* MASK = (unsigned*)(ws + WS_MASK);
    LAS h16* ISC = (LAS h16*)C.lds; LAS unsigned* HIST = (LAS unsigned*)(C.lds + 131072) + C.wave * 256; LAS float* STAT = (LAS float*)(C.lds + 139264); LAS float* W16 = (LAS float*)(C.lds + 140288);
    const int lane = C.lane, r32 = lane & 31, hf = lane >> 5;
    const int ql = 2 * (r32 >> 4) + ((r32 >> 2) & 1), hd = 4 * ((r32 >> 3) & 1) + (r32 & 3);
    constexpr int CAND_CAP = 120, QU = 16;
    for (int u = blockIdx.x; u < NTOK / QU; u += C.G) {
        const int b = u & 7, j = (u >> 3) & 31, i = u >> 8; const int pi = i >> 1; const int blk = (i & 1) ? (255 - (j + 32 * pi)) : (j + 32 * pi);
        const int t0 = blk * QU; const size_t mb = (size_t)b * T;
        const int nkt = (t0 + QU + 31) >> 5;
        bf16x8 af[4][4];
#pragma unroll
        for (int a = 0; a < 4; ++a) {
            const bf16* qp = H + (mb + t0 + 4 * a + ql) * D_INP + C_IQ + hd * 64 + 8 * hf;
#pragma unroll
            for (int k = 0; k < 4; ++k) af[a][k] = *(const GAS bf16x8*)(qp + 16 * k);
        }
        if (C.tid < 128) { const int q = C.tid >> 3, h8 = C.tid & 7; W16[C.tid] = bf2f(H[(mb + t0 + q) * D_INP + C_IW + h8]) * (0.125f * 0.35355339059327373f); }
        __syncthreads();
        {
            int kt = C.wave; bf16x8 bk[4], bn[4];
            if (kt < nkt) { const bf16* kp = IKN + (mb + kt * 32 + r32) * 64 + 8 * hf;
#pragma unroll
                for (int k = 0; k < 4; ++k) bk[k] = *(const GAS bf16x8*)(kp + 16 * k); }
            for (; kt < nkt; kt += NWAVES) {
                const int s0 = kt * 32;
                if (kt + NWAVES < nkt) { const bf16* kp = IKN + (mb + s0 + 32 * NWAVES + r32) * 64 + 8 * hf;
#pragma unroll
                    for (int k = 0; k < 4; ++k) bn[k] = *(const GAS bf16x8*)(kp + 16 * k); }
#pragma unroll
                for (int a = 0; a < 4; ++a) {
                    f32x16 acc = {0.f, 0.f, 0.f, 0.f, 0.f, 0.f, 0.f, 0.f, 0.f, 0.f, 0.f, 0.f, 0.f, 0.f, 0.f, 0.f};
#pragma unroll
                    for (int k = 0; k < 4; ++k) acc = __builtin_amdgcn_mfma_f32_32x32x16_bf16(af[a][k], bk[k], acc, 0, 0, 0);
#pragma unroll
                    for (int qh = 0; qh < 2; ++qh) { float sa = 0.f, sb = 0.f;
                        const int q = 4 * a + 2 * qh + hf, key = s0 + r32;
                        const f32x4 wl = *(const LAS f32x4*)(W16 + q * 8), wh = *(const LAS f32x4*)(W16 + q * 8 + 4);
                        sa = fmaf(wl[0], relu_i(acc[8 * qh + 0]), sa); sb = fmaf(wl[1], relu_i(acc[8 * qh + 1]), sb); sa = fmaf(wl[2], relu_i(acc[8 * qh + 2]), sa); sb = fmaf(wl[3], relu_i(acc[8 * qh + 3]), sb);
                        sa = fmaf(wh[0], relu_i(acc[8 * qh + 4]), sa); sb = fmaf(wh[1], relu_i(acc[8 * qh + 5]), sb); sa = fmaf(wh[2], relu_i(acc[8 * qh + 6]), sa); sb = fmaf(wh[3], relu_i(acc[8 * qh + 7]), sb);
                        float sv = sa + sb; const bool valid = key <= t0 + q; sv += 0.0f;
                        ISC[q * 4096 + key] = valid ? (h16)sv : (h16)(-INFINITY);
                    }
                }
#pragma unroll
                for (int k = 0; k < 4; ++k) bk[k] = bn[k];
            }
        }
        __syncthreads();
#ifdef PROBE_SEL
        for (int rep_ = 0; rep_ < 2; ++rep_)
#endif
        {
            const LAS unsigned short* row[2]; int tq[2], nq[2]; unsigned* mrow[2];
#pragma unroll
            for (int z = 0; z < 2; ++z) { const int q = C.wave + 8 * z; row[z] = (const LAS unsigned short*)(ISC + q * 4096); tq[z] = t0 + q; nq[z] = tq[z] + 1; mrow[z] = MASK + (mb + tq[z]) * 128; }
            const int nmax = nq[1];
            unsigned dhi[2] = {0u, 0u}; int need[2];
#pragma unroll
            for (int z = 0; z < 2; ++z) need[z] = nq[z] < TOPK ? nq[z] : TOPK;
#pragma unroll
            for (int pass = 1; pass >= 0; --pass) {
                LDS_WAIT();
#pragma unroll
                for (int zz = 0; zz < 4; ++zz) HIST[lane + 64 * zz] = 0u;
                for (int e0 = 8 * lane; e0 < nmax; e0 += 512) {
                    v4u v[2];
#pragma unroll
                    for (int z = 0; z < 2; ++z) v[z] = *(const LAS v4u*)(row[z] + e0);
#pragma unroll
                    for (int z = 0; z < 2; ++z)
#pragma unroll
                        for (int jj = 0; jj < 8; ++jj) { const unsigned w = (jj < 2) ? v[z].x : (jj < 4) ? v[z].y : (jj < 6) ? v[z].z : v[z].w; const unsigned hb = (jj & 1) ? (w >> 16) : (w & 0xffffu);
                            const unsigned key = h2ord(hb); const unsigned bin = pass == 1 ? (key >> 8) : (key & 255u);
                            const bool ok = (e0 + jj < nq[z]) && (pass == 1 || (key >> 8) == dhi[z]);
                            if (ok) atomicAdd((unsigned*)&HIST[128 * z + (bin >> 1)], 1u << (16 * (bin & 1u))); }
                }
                LDS_WAIT();
                unsigned c[2][4], s4[2], suf[2];
#pragma unroll
                for (int z = 0; z < 2; ++z) { const v2u w2 = *(const LAS v2u*)(HIST + 128 * z + 2 * lane); c[z][0] = w2.x & 0xffffu; c[z][1] = w2.x >> 16; c[z][2] = w2.y & 0xffffu; c[z][3] = w2.y >> 16; s4[z] = c[z][0] + c[z][1] + c[z][2] + c[z][3]; suf[z] = s4[z]; }
#pragma unroll
                for (int o = 1; o < 64; o <<= 1) {
#pragma unroll
                    for (int z = 0; z < 2; ++z) { const unsigned v2 = __shfl_down(suf[z], o); if (lane + o < 64) suf[z] += v2; } }
#pragma unroll
                for (int z = 0; z < 2; ++z) { unsigned cum = suf[z] - s4[z]; int dsel = -1; int nnew = 0; const unsigned nd = (unsigned)need[z];
#pragma unroll
                    for (int bb = 3; bb >= 0; --bb) { if (dsel < 0 && cum < nd && nd <= cum + c[z][bb]) { dsel = 4 * lane + bb; nnew = (int)(nd - cum); } cum += c[z][bb]; }
                    const unsigned long long bal = __ballot(dsel >= 0);
                    const int src = (bal != 0ull) ? (int)__builtin_ctzll(bal) : 0;
                    const int dd = __shfl(dsel, src); need[z] = __shfl(nnew, src);
                    if (pass == 1) dhi[z] = (unsigned)dd; else dhi[z] = (dhi[z] << 8) | (unsigned)dd; }
            }
            int run_eq[2] = {0, 0}; unsigned long long mine[2] = {0ull, 0ull}; const int nit = (tq[1] >> 6) + 1;
            const unsigned long long ltm = (1ull << lane) - 1ull;
#pragma unroll 2
            for (int it = 0; it < nit; ++it) { const int e = it * 64 + lane;
#pragma unroll
                for (int z = 0; z < 2; ++z) { const unsigned key = h2ord(row[z][e]); const bool valid = e <= tq[z];
                    const bool eq = valid && (key == dhi[z]); const unsigned long long beq = __ballot(eq);
                    const int rk = run_eq[z] + __builtin_popcountll(beq & ltm);
                    const bool sel = valid && ((key > dhi[z]) || (eq && rk < need[z])); run_eq[z] += __builtin_popcountll(beq);
                    const unsigned long long bs = __ballot(sel);
                    if (lane == it) mine[z] = bs; } }
#pragma unroll
            for (int z = 0; z < 2; ++z) *(GAS v2u*)(mrow[z] + 2 * lane) = (v2u){(unsigned)mine[z], (unsigned)(mine[z] >> 32)};
        }
        __syncthreads();
    }
}

__device__ __forceinline__ void attn_task(const bf16* H, const bf16* KH, const bf16* VT, const unsigned* MASK, bf16* YM, int b, int hh, int t0, int lane) {
    const int r32 = lane & 31, hf = lane >> 5;
    const float LOG2E = 1.4426950408889634f; const float c1 = 0.125f * LOG2E; const float sl2 = exp2f(-(float)(hh + 1)) * LOG2E;
    const size_t mb = (size_t)b * T;
    bf16x8 qf[4];
#pragma unroll
    for (int k = 0; k < 4; ++k) qf[k] = *(const GAS bf16x8*)(H + (mb + t0 + r32) * D_INP + C_AQ + hh * 64 + 16 * k + 8 * hf);
    const bf16* kbase = KH + ((size_t)(b * 8 + hh) * T) * 64; const bf16* vbase = VT + ((size_t)(b * 512 + hh * 64)) * T; const unsigned* mrow = MASK + (mb + t0 + r32) * 128;
    float m_run = -1e30f, l = 0.f;
    f32x16 O0 = {0.f, 0.f, 0.f, 0.f, 0.f, 0.f, 0.f, 0.f, 0.f, 0.f, 0.f, 0.f, 0.f, 0.f, 0.f, 0.f}, O1 = O0;
    const int nkt = (t0 + 32 + 63) >> 6;
    for (int kt = 0; kt < nkt; ++kt) {
        const int s0 = kt * 64;
        bf16x8 kf[2][4];
#pragma unroll
        for (int uu = 0; uu < 2; ++uu)
#pragma unroll
            for (int k = 0; k < 4; ++k) kf[uu][k] = *(const GAS bf16x8*)(kbase + (size_t)(s0 + 32 * uu + r32) * 64 + 16 * k + 8 * hf);
        const v2u mw = *(const GAS v2u*)(mrow + 2 * kt);
        s16x4 vl[2][2][2], vh[2][2][2];
#pragma unroll
        for (int uu = 0; uu < 2; ++uu)
#pragma unroll
            for (int sp = 0; sp < 2; ++sp)
#pragma unroll
                for (int dt = 0; dt < 2; ++dt) { const bf16* vp = vbase + (size_t)(dt * 32 + r32) * T + s0 + 32 * uu + 16 * sp + 4 * hf;
                    vl[uu][sp][dt] = *(const GAS s16x4*)vp; vh[uu][sp][dt] = *(const GAS s16x4*)(vp + 8); }
        f32x16 a0 = {0.f, 0.f, 0.f, 0.f, 0.f, 0.f, 0.f, 0.f, 0.f, 0.f, 0.f, 0.f, 0.f, 0.f, 0.f, 0.f}, a1 = a0;
#pragma unroll
        for (int k = 0; k < 4; ++k) { a0 = __builtin_amdgcn_mfma_f32_32x32x16_bf16(kf[0][k], qf[k], a0, 0, 0, 0); a1 = __builtin_amdgcn_mfma_f32_32x32x16_bf16(kf[1][k], qf[k], a1, 0, 0, 0); }
        const float dist0 = (float)(t0 + r32 - s0 - 4 * hf);
        const unsigned m0 = mw.x >> (4 * hf), m1 = mw.y >> (4 * hf);
        float mx = -1e30f;
#pragma unroll
        for (int r = 0; r < 16; ++r) { const int ko = (r & 3) + 8 * (r >> 2);
            const float d0 = dist0 - (float)ko;
            a0[r] = ((m0 >> ko) & 1u) ? (a0[r] * c1 - sl2 * d0) : -1e30f;
            a1[r] = ((m1 >> ko) & 1u) ? (a1[r] * c1 - sl2 * (d0 - 32.f)) : -1e30f;
            mx = fmaxf(mx, fmaxf(a0[r], a1[r])); }
        mx = fmaxf(mx, __shfl_xor(mx, 32));
        const float m_new = fmaxf(m_run, mx); const float alpha = __builtin_amdgcn_exp2f(m_run - m_new); m_run = m_new;
        float ps = 0.f;
#pragma unroll
        for (int r = 0; r < 16; ++r) { const int ko = (r & 3) + 8 * (r >> 2);
            const float p0 = ((m0 >> ko) & 1u) ? __builtin_amdgcn_exp2f(a0[r] - m_new) : 0.f;
            const float p1 = ((m1 >> ko) & 1u) ? __builtin_amdgcn_exp2f(a1[r] - m_new) : 0.f;
            a0[r] = p0; a1[r] = p1; ps += p0 + p1; }
        l = l * alpha + ps;
#pragma unroll
        for (int r = 0; r < 16; ++r) { O0[r] *= alpha; O1[r] *= alpha; }
#pragma unroll
        for (int sp = 0; sp < 2; ++sp) {
            const bf16x8 pb0 = pack8(a0, 8 * sp), pb1 = pack8(a1, 8 * sp);
#define VFR(uu, dt) ((bf16x8){vl[uu][sp][dt][0], vl[uu][sp][dt][1], vl[uu][sp][dt][2], vl[uu][sp][dt][3], vh[uu][sp][dt][0], vh[uu][sp][dt][1], vh[uu][sp][dt][2], vh[uu][sp][dt][3]})
            O0 = __builtin_amdgcn_mfma_f32_32x32x16_bf16(VFR(0, 0), pb0, O0, 0, 0, 0);
            O1 = __builtin_amdgcn_mfma_f32_32x32x16_bf16(VFR(0, 1), pb0, O1, 0, 0, 0);
            O0 = __builtin_amdgcn_mfma_f32_32x32x16_bf16(VFR(1, 0), pb1, O0, 0, 0, 0);
            O1 = __builtin_amdgcn_mfma_f32_32x32x16_bf16(VFR(1, 1), pb1, O1, 0, 0, 0);
#undef VFR
        }
    }
    l += __shfl_xor(l, 32);
    const float inv = 1.f / l;
    bf16* yp = YM + (mb + t0 + r32) * D + hh * 64 + 4 * hf;
#pragma unroll
    for (int rq = 0; rq < 4; ++rq) {
        v2u o; o.x = cvtpk(O0[4 * rq] * inv, O0[4 * rq + 1] * inv); o.y = cvtpk(O0[4 * rq + 2] * inv, O0[4 * rq + 3] * inv); *(GAS v2u*)(yp + 8 * rq) = o;
        v2u o2; o2.x = cvtpk(O1[4 * rq] * inv, O1[4 * rq + 1] * inv); o2.y = cvtpk(O1[4 * rq + 2] * inv, O1[4 * rq + 3] * inv); *(GAS v2u*)(yp + 32 + 8 * rq) = o2; }
}
__device__ __forceinline__ void p4_attention(const Params& P, const Ctx& C) {
    unsigned char* ws = P.ws;
    const bf16* H = (const bf16*)(ws + WS_H); const bf16* KH = (const bf16*)(ws + WS_K); const bf16* VT = (const bf16*)(ws + WS_VT); const unsigned* MASK = (const unsigned*)(ws + WS_MASK); bf16* YM = (bf16*)(ws + WS_YMIX);
    for (int p = blockIdx.x; p < 512; p += C.G) {
        const int bh = p >> 3, j = p & 7; const int b = bh >> 3, hh = bh & 7;
        attn_task(H, KH, VT, MASK, YM, b, hh, j * 256 + C.wave * 32, C.lane);
        attn_task(H, KH, VT, MASK, YM, b, hh, (15 - j) * 256 + (7 - C.wave) * 32, C.lane);
    }
}

constexpr int AT_KB = 64 * 144, AT_VB = 64 * 136, AT_VOFF = 2 * AT_KB;
__device__ __forceinline__ void attn_block(const Ctx& C, const bf16* H, const bf16* KH, const bf16* VT, const unsigned* MASK, bf16* YM, int b, int hh, int qb) {
    const int lane = C.lane, r32 = lane & 31, hf = lane >> 5, tid = C.tid;
    const float LOG2E = 1.4426950408889634f; const float c1 = 0.125f * LOG2E; const float sl2 = exp2f(-(float)(hh + 1)) * LOG2E;
    const size_t mb = (size_t)b * T; const int t0 = qb * 256 + C.wave * 32;
    bf16x8 qf[4];
#pragma unroll
    for (int k = 0; k < 4; ++k) { const v4u w = *(const GAS v4u*)(H + (mb + t0 + r32) * D_INP + C_AQ + hh * 64 + 16 * k + 8 * hf);
        v4u o; o.x = cvtpk(bflo(w.x) * c1, bfhi(w.x) * c1); o.y = cvtpk(bflo(w.y) * c1, bfhi(w.y) * c1); o.z = cvtpk(bflo(w.z) * c1, bfhi(w.z) * c1); o.w = cvtpk(bflo(w.w) * c1, bfhi(w.w) * c1);
        qf[k] = __builtin_bit_cast(bf16x8, o); }
    const bf16* kbase = KH + ((size_t)(b * 8 + hh) * T) * 64; const bf16* vbase = VT + ((size_t)(b * 512 + hh * 64)) * T; const unsigned* mrow = MASK + (mb + t0 + r32) * 128;
    const int srow = tid >> 3, sch = tid & 7;
    const bf16* kst = kbase + (size_t)srow * 64 + 8 * sch; const bf16* vst = vbase + (size_t)srow * T + 8 * sch;
    LAS unsigned char* kw = C.lds + srow * 144 + 16 * sch; LAS unsigned char* vw = C.lds + AT_VOFF + srow * 136 + 16 * sch;
    const LAS unsigned char* kr = C.lds + r32 * 144 + 16 * hf; const LAS unsigned char* vr = C.lds + AT_VOFF + r32 * 136 + 8 * hf;
    float m_run = -1e30f, l = 0.f;
    f32x16 O0 = {0.f, 0.f, 0.f, 0.f, 0.f, 0.f, 0.f, 0.f, 0.f, 0.f, 0.f, 0.f, 0.f, 0.f, 0.f, 0.f}, O1 = O0;
    const int nkt = 4 * (qb + 1), ktw = (t0 + 31) >> 6;
    v4u kn = *(const GAS v4u*)kst, vn = *(const GAS v4u*)vst; v2u mwn = *(const GAS v2u*)mrow;
    *(LAS v4u*)kw = kn; *(LAS v2u*)vw = (v2u){vn.x, vn.y}; *(LAS v2u*)(vw + 8) = (v2u){vn.z, vn.w};
    __syncthreads();
    for (int kt = 0; kt < nkt; ++kt) {
        const int s0 = kt * 64; const int cur = kt & 1; const v2u mw = mwn;
        if (kt + 1 < nkt) { kn = *(const GAS v4u*)(kst + (size_t)(s0 + 64) * 64); vn = *(const GAS v4u*)(vst + s0 + 64); mwn = *(const GAS v2u*)(mrow + 2 * kt + 2); }
        if (kt <= ktw) {
            const LAS unsigned char* kc = kr + cur * AT_KB; const LAS unsigned char* vc = vr + cur * AT_VB;
            const float B0 = -sl2 * (float)(t0 + r32 - s0 - 4 * hf);
            f32x16 a0, a1;
#pragma unroll
            for (int r = 0; r < 16; ++r) { const float ko = (float)((r & 3) + 8 * (r >> 2)); a0[r] = B0 + sl2 * ko; a1[r] = B0 + sl2 * (ko + 32.f); }
#pragma unroll
            for (int k = 0; k < 4; ++k) { const bf16x8 k0 = *(const LAS bf16x8*)(kc + 32 * k), k1 = *(const LAS bf16x8*)(kc + 32 * 144 + 32 * k);
                a0 = __builtin_amdgcn_mfma_f32_32x32x16_bf16(k0, qf[k], a0, 0, 0, 0); a1 = __builtin_amdgcn_mfma_f32_32x32x16_bf16(k1, qf[k], a1, 0, 0, 0); }
            const unsigned m0 = mw.x >> (4 * hf), m1 = mw.y >> (4 * hf);
            float mx = -1e30f;
#pragma unroll
            for (int r = 0; r < 16; ++r) { const int ko = (r & 3) + 8 * (r >> 2);
                const unsigned k0m = (unsigned)__builtin_amdgcn_sbfe((int)m0, ko, 1), k1m = (unsigned)__builtin_amdgcn_sbfe((int)m1, ko, 1);
                const float x0 = a0[r], x1 = a1[r];
                a0[r] = __builtin_bit_cast(float, (__builtin_bit_cast(unsigned, x0) & k0m) | (0xf149f2cau & ~k0m));
                a1[r] = __builtin_bit_cast(float, (__builtin_bit_cast(unsigned, x1) & k1m) | (0xf149f2cau & ~k1m));
                mx = fmaxf(mx, fmaxf(a0[r], a1[r])); }
            mx = fmaxf(mx, __shfl_xor(mx, 32));
            const float m_new = fmaxf(m_run, mx);
            const float m_use = fmaxf(m_new, -1e20f);
            float ps = 0.f;
#pragma unroll
            for (int r = 0; r < 16; ++r) { const float p0 = __builtin_amdgcn_exp2f(a0[r] - m_use), p1 = __builtin_amdgcn_exp2f(a1[r] - m_use); a0[r] = p0; a1[r] = p1; ps += p0 + p1; }
            if (__builtin_amdgcn_ballot_w64(m_new != m_run) != 0ull) {
                const float alpha = __builtin_amdgcn_exp2f(m_run - m_new); m_run = m_new;
                l *= alpha;
#pragma unroll
                for (int r = 0; r < 16; ++r) { O0[r] *= alpha; O1[r] *= alpha; }
            }
            l += ps;
#pragma unroll
            for (int sp = 0; sp < 2; ++sp) {
                const bf16x8 pb0 = pack8(a0, 8 * sp), pb1 = pack8(a1, 8 * sp);
#define VLD(uu, dt) ({ const s16x4 lo_ = *(const LAS s16x4*)(vc + (dt) * 32 * 136 + 2 * (32 * (uu) + 16 * sp)), hi_ = *(const LAS s16x4*)(vc + (dt) * 32 * 136 + 2 * (32 * (uu) + 16 * sp + 8)); (bf16x8){lo_[0], lo_[1], lo_[2], lo_[3], hi_[0], hi_[1], hi_[2], hi_[3]}; })
                O0 = __builtin_amdgcn_mfma_f32_32x32x16_bf16(VLD(0, 0), pb0, O0, 0, 0, 0);
                O1 = __builtin_amdgcn_mfma_f32_32x32x16_bf16(VLD(0, 1), pb0, O1, 0, 0, 0);
                O0 = __builtin_amdgcn_mfma_f32_32x32x16_bf16(VLD(1, 0), pb1, O0, 0, 0, 0);
                O1 = __builtin_amdgcn_mfma_f32_32x32x16_bf16(VLD(1, 1), pb1, O1, 0, 0, 0);
#undef VLD
            }
        }
        if (kt + 1 < nkt) { const int nx = cur ^ 1; *(LAS v4u*)(kw + nx * AT_KB) = kn; *(LAS v2u*)(vw + nx * AT_VB) = (v2u){vn.x, vn.y}; *(LAS v2u*)(vw + nx * AT_VB + 8) = (v2u){vn.z, vn.w}; }
        __syncthreads();
    }
    l += __shfl_xor(l, 32);
    const float inv = __builtin_amdgcn_rcpf(l);
    unsigned char* yp = (unsigned char*)YM + (mb + t0 + r32) * D + hh * 64 + 4 * hf;
    const float i8 = inv * 8.f;
#pragma unroll
    for (int rq = 0; rq < 4; ++rq) {
        *(GAS unsigned*)(yp + 8 * rq) = pk4_fp8(O0[4 * rq] * i8, O0[4 * rq + 1] * i8, O0[4 * rq + 2] * i8, O0[4 * rq + 3] * i8);
        *(GAS unsigned*)(yp + 32 + 8 * rq) = pk4_fp8(O1[4 * rq] * i8, O1[4 * rq + 1] * i8, O1[4 * rq + 2] * i8, O1[4 * rq + 3] * i8); }
}
__device__ __forceinline__ void p4_attention2(const Params& P, const Ctx& C) {
    unsigned char* ws = P.ws;
    const bf16* H = (const bf16*)(ws + WS_H); const bf16* KH = (const bf16*)(ws + WS_K); const bf16* VT = (const bf16*)(ws + WS_VT); const unsigned* MASK = (const unsigned*)(ws + WS_MASK); bf16* YM = (bf16*)(ws + WS_YMIX);
    for (int p = blockIdx.x; p < 512; p += C.G) {
        const int b = p & 7, q = p >> 3; const int hh = q >> 3, j = q & 7;
        attn_block(C, H, KH, VT, MASK, YM, b, hh, j);
        attn_block(C, H, KH, VT, MASK, YM, b, hh, 15 - j);
    }
}


#ifndef FEAT_MIX
#define FEAT_MIX 1
#endif
#ifndef FEAT_MOE
#define FEAT_MOE 1
#endif
#ifndef FEAT_PLE
#define FEAT_PLE 1
#endif
#ifndef FEAT_ATT
#define FEAT_ATT 1
#endif

template <bool PUBLISH = true> __device__ __forceinline__ void p6_ln1_router(const Params& P, const Ctx& C) {
    unsigned char* ws = P.ws;
    bf16* X1 = (bf16*)(ws + WS_X1); unsigned char* XB = ws + WS_XB;
    LAS float* wl = (LAS float*)C.lds;
    LAS int* hist = (LAS int*)(C.lds + MISC_OFF);
    { const float* wrt = (const float*)(ws + WS_WRT);
      for (int i = C.tid; i < 32 * 1024 / 4; i += NTHR) *(LAS f32x4*)(wl + 4 * i) = *(const GAS f32x4*)(wrt + 4 * i);
      if (C.tid < 32) hist[C.tid] = 0; }
    __syncthreads();
    int* tope = (int*)(ws + WS_TOPE); float* gate = (float*)(ws + WS_GATE); int* lrank = (int*)(ws + WS_LRANK);
    const bf16* src = (const bf16*)P.out;
    const int lane = C.lane, hf = lane >> 5, ex = lane & 31;
    const float brl = P.in[I_BR][ex];
    for (int m0 = 2 * C.gw; m0 < NTOK; m0 += 2 * C.ngw) {
        f32x4 va[4], vb[4]; load_row_bf16(va, src + (size_t)m0 * D, lane); load_row_bf16(vb, src + (size_t)(m0 + 1) * D, lane);
        ln_row(va, P.in[I_LNMG], P.in[I_LNMB], lane); ln_row(vb, P.in[I_LNMG], P.in[I_LNMB], lane);
        store_row_bf16(X1 + (size_t)m0 * D, va, lane); store_row_bf16(X1 + (size_t)(m0 + 1) * D, vb, lane);
        store_row_fp8x8(XB + (size_t)m0 * D, va, lane); store_row_fp8x8(XB + (size_t)(m0 + 1) * D, vb, lane);
        float v[32];
#pragma unroll
        for (int e = 0; e < 32; ++e) { float pa = 0.f, pb = 0.f;
#pragma unroll
            for (int j = 0; j < 4; ++j) { const f32x4 w = *(const LAS f32x4*)(wl + e * 1024 + 4 * lane + 256 * j);
                pa += (va[j][0] * w[0] + va[j][1] * w[1]) + (va[j][2] * w[2] + va[j][3] * w[3]); pb += (vb[j][0] * w[0] + vb[j][1] * w[1]) + (vb[j][2] * w[2] + vb[j][3] * w[3]); }
            const float keep = hf ? pb : pa, send = hf ? pa : pb; v[e] = keep + __shfl_xor(send, 32); }
#define HALVE(M, CNT) { const bool up_ = (lane & (M)) != 0; _Pragma("unroll") for (int i_ = 0; i_ < (CNT) / 2; ++i_) { const float k_ = up_ ? v[i_ + (CNT) / 2] : v[i_], s_ = up_ ? v[i_] : v[i_ + (CNT) / 2]; v[i_] = k_ + __shfl_xor(s_, (M)); } }
        HALVE(16, 32) HALVE(8, 16) HALVE(4, 8) HALVE(2, 4) HALVE(1, 2)
#undef HALVE
        float lg = v[0] + brl;
        int se[4]; float sv[4];
#pragma unroll
        for (int k = 0; k < 4; ++k) { float bv = lg; int bi = ex;
#pragma unroll
            for (int o = 1; o < 32; o <<= 1) { const float ov = __shfl_xor(bv, o); const int oi = __shfl_xor(bi, o); const bool take = (ov > bv) || (ov == bv && oi < bi); bv = take ? ov : bv; bi = take ? oi : bi; }
            se[k] = bi; sv[k] = bv; if (ex == bi) lg = -INFINITY; }
        float exv[4], sum = 0.f;
#pragma unroll
        for (int k = 0; k < 4; ++k) { exv[k] = __expf(sv[k] - sv[0]); sum += exv[k]; }
        const float inv = 1.f / sum;
        if (ex == 0) { const int m = m0 + hf;
#pragma unroll
            for (int k = 0; k < 4; ++k) { const int lr = atomicAdd((int*)&hist[se[k]], 1); tope[m * 4 + k] = se[k]; gate[m * 4 + k] = exv[k] * inv; lrank[m * 4 + k] = lr; } }
    }
    __syncthreads();
    if (PUBLISH && C.tid < 32) { unsigned* cnt = (unsigned*)(ws + WS_CTL) + CW_CNT; const int base = (int)atomicAdd(cnt + C.tid, (unsigned)hist[C.tid]); ((int*)(ws + WS_WGBASE))[blockIdx.x * 32 + C.tid] = base; }
}

__device__ __forceinline__ void p7_dispatch(const Params& P, const Ctx& C) {
    unsigned char* ws = P.ws;
    LAS int* ps = (LAS int*)(C.lds + MISC_OFF + 256);
    const unsigned* cnt = (const unsigned*)(ws + WS_CTL) + CW_CNT;
    int* tile_e = (int*)(ws + WS_TILEE);
    LAS int* pe = (LAS int*)(C.lds + MISC_OFF + 512);
    if (C.tid < 64) { const int e = C.tid & 31; const int c = (int)__hip_atomic_load(cnt + e, __ATOMIC_RELAXED, __HIP_MEMORY_SCOPE_AGENT); const int nt = (c + 255) >> 8; int inc = nt;
#pragma unroll
        for (int o = 1; o < 32; o <<= 1) { const int v = __shfl_up(inc, o); if ((C.tid & 31) >= o) inc += v; }
        if (C.tid < 32) { ps[e] = (inc - nt) << 8; pe[e] = inc; } }
    __syncthreads();
    if (blockIdx.x == 0) { const int ntot = pe[31];
        for (int t = C.tid; t < ntot; t += NTHR) { int e = 0;
#pragma unroll
            for (int q = 0; q < 31; ++q) e += (t >= pe[q]) ? 1 : 0;
            tile_e[t] = e; }
        if (C.tid == 0) tile_e[MAXTILES] = ntot; }
    const int* tope = (const int*)(ws + WS_TOPE); const float* gate = (const float*)(ws + WS_GATE); const int* lrank = (const int*)(ws + WS_LRANK);
    const int* wgb = (const int*)(ws + WS_WGBASE);
    int* tokslot = (int*)(ws + WS_TOKSLOT); float* slotgate = (float*)(ws + WS_SLOTGATE);
    const bf16* XB = (const bf16*)(ws + WS_XB); unsigned char* xs = ws + WS_XS;
    int m = C.gw; v4u f8n; int en[4], ln_[4]; float gn[4]; int wgn;
    if (m < NTOK) { f8n = *(const GAS v4u*)((const unsigned char*)XB + (size_t)m * D + 16 * C.lane); wgn = ((m >> 1) % C.ngw) >> 3;
#pragma unroll
        for (int k = 0; k < 4; ++k) { en[k] = tope[m * 4 + k]; ln_[k] = lrank[m * 4 + k]; gn[k] = gate[m * 4 + k]; } }
    for (; m < NTOK; m += C.ngw) {
        const v4u f8 = f8n; int e[4], lr[4]; float g[4]; const int wgm = wgn;
#pragma unroll
        for (int k = 0; k < 4; ++k) { e[k] = en[k]; lr[k] = ln_[k]; g[k] = gn[k]; }
        int wb[4];
#pragma unroll
        for (int k = 0; k < 4; ++k) wb[k] = wgb[wgm * 32 + e[k]];
        const int m2 = m + C.ngw;
        if (m2 < NTOK) { f8n = *(const GAS v4u*)((const unsigned char*)XB + (size_t)m2 * D + 16 * C.lane); wgn = ((m2 >> 1) % C.ngw) >> 3;
#pragma unroll
            for (int k = 0; k < 4; ++k) { en[k] = tope[m2 * 4 + k]; ln_[k] = lrank[m2 * 4 + k]; gn[k] = gate[m2 * 4 + k]; } }
#pragma unroll
        for (int k = 0; k < 4; ++k) { const int slot = ps[e[k]] + wb[k] + lr[k];
            *(GAS v4u*)(xs + (size_t)slot * D + 16 * C.lane) = f8;
            if (C.lane == 0) { slotgate[slot] = g[k]; tokslot[m * 4 + k] = slot; } }
    }
}

__device__ __forceinline__ void p10_combine_ln2(const Params& P, const Ctx& C) {
    unsigned char* ws = P.ws;
    const bf16* X1 = (const bf16*)(ws + WS_X1); bf16* XB = (bf16*)(ws + WS_XB); bf16* X2 = (bf16*)P.out;
    const int* tokslot = (const int*)(ws + WS_TOKSLOT); const unsigned char* ys = ws + WS_YSLOT;
    for (int m = C.gw; m < NTOK; m += C.ngw) {
        f32x4 v[4]; load_row_bf16(v, X1 + (size_t)m * D, C.lane);
#pragma unroll
        for (int j = 0; j < 4; ++j) v[j] = v[j] * ALPHA;
#if FEAT_MOE
        f32x4 fs[4] = {{0.f, 0.f, 0.f, 0.f}, {0.f, 0.f, 0.f, 0.f}, {0.f, 0.f, 0.f, 0.f}, {0.f, 0.f, 0.f, 0.f}};
#pragma unroll
        for (int k = 0; k < 4; ++k) { const int slot = tokslot[m * 4 + k]; const unsigned char* yr = ys + (size_t)slot * D;
#pragma unroll
            for (int j = 0; j < 4; ++j) fs[j] = fs[j] + fp8x4_to_f32(*(const GAS unsigned*)(yr + 4 * C.lane + 256 * j)); }
#pragma unroll
        for (int j = 0; j < 4; ++j) v[j] = v[j] + fs[j] * (1.f / 64.f);
#endif
        ln_row(v, P.in[I_LNFG], P.in[I_LNFB], C.lane);
        store_row_bf16(X2 + (size_t)m * D, v, C.lane);
        store_row_fp8x8((unsigned char*)XB + (size_t)m * D, v, C.lane);
    }
}

__device__ __forceinline__ void p12_final_ln(const Params& P, const Ctx& C) {
    const bf16* src = (const bf16*)(P.ws + WS_X1);
    for (int m = C.gw; m < NTOK; m += C.ngw) {
        f32x4 v[4]; load_row_bf16(v, src + (size_t)m * D, C.lane);
        ln_row(v, P.in[I_LNPG], P.in[I_LNPB], C.lane);
        store_row_f32(P.out + (size_t)m * D, v, C.lane);
    }
}
#define XB_TMO      128
#define XB_XCNT(j)  (256  + 64 * (j))
#define XB_XSUB(j)  (1280 + 64 * (j))
#define XB_XGEN(j)  (2304 + 64 * (j))
#define XB_TOP      3328
#define XB_TOPGEN   3392
#define XCD_BAR_WORDS 3456
#define XB_SPIN_CAP (1u << 18)
#define LAS __attribute__((address_space(3)))

__device__ __forceinline__ unsigned xb_ld(unsigned* p)              { return __hip_atomic_load(p, __ATOMIC_RELAXED, __HIP_MEMORY_SCOPE_AGENT); }
__device__ __forceinline__ unsigned xb_add(unsigned* p, unsigned v) { return __hip_atomic_fetch_add(p, v, __ATOMIC_RELAXED, __HIP_MEMORY_SCOPE_AGENT); }
__device__ __forceinline__ unsigned xb_xcc_id() { return (unsigned)__builtin_amdgcn_s_getreg((3 << 11) | 20) & 0xFu; }
#define XB_SPIN(cond, bar) do { unsigned _sp = 0; while (cond) { __builtin_amdgcn_s_sleep(1); \
    if ((++_sp & 255u) == 0u) { if (xb_ld(&(bar)[XB_TMO])) break; if (_sp > XB_SPIN_CAP) { atomicAdd(&(bar)[XB_TMO], 1u); break; } } } } while (0)

struct XcdBarrier {
    unsigned* bar; unsigned x;
    volatile LAS unsigned* st;
};

__device__ __forceinline__ XcdBarrier xcd_barrier_post(unsigned* bar, volatile LAS unsigned* st) {
    XcdBarrier b; b.bar = bar; b.x = xb_xcc_id(); b.st = st;
    if (threadIdx.x == 0) (void)xb_add(&bar[XB_XCNT(b.x)], 1u);
    return b;
}
__device__ __forceinline__ void xcd_barrier_complete(unsigned* bar, unsigned x, unsigned& nloc, unsigned& nx) {
    const unsigned G = gridDim.x * gridDim.y * gridDim.z;
    unsigned sum, cnt, mine, sp = 0u;
    for (;;) {
        sum = 0u; cnt = 0u; mine = 0u;
#pragma unroll
        for (unsigned j = 0; j < 16; ++j) { const unsigned c = xb_ld(&bar[XB_XCNT(j)]); sum += c; cnt += (c > 0u) ? 1u : 0u; mine = (j == x) ? c : mine; }
        if (sum == G) break;
        __builtin_amdgcn_s_sleep(1);
        if ((++sp & 255u) == 0u) { if (xb_ld(&bar[XB_TMO])) break; if (sp > XB_SPIN_CAP) { atomicAdd(&bar[XB_TMO], 1u); break; } }
    }
    nloc = mine > 0u ? mine : 1u; nx = cnt > 0u ? cnt : 1u;
}

__device__ __forceinline__ void xcd_barrier(const XcdBarrier& b) {
    asm volatile("s_waitcnt vmcnt(0)" ::: "memory");
    __syncthreads();
    if (threadIdx.x == 0) {
        unsigned* bar = b.bar;
        __builtin_amdgcn_s_waitcnt(0);
        unsigned nloc = b.st[0], nx = b.st[1];
        if (nloc == 0u) { xcd_barrier_complete(bar, b.x, nloc, nx); b.st[0] = nloc; b.st[1] = nx; }
        const unsigned old = xb_add(&bar[XB_XSUB(b.x)], 1u);
        const unsigned gen = old / nloc;
        if (old + 1u == (gen + 1u) * nloc) {
            __builtin_amdgcn_fence(__ATOMIC_RELEASE, "agent");
            asm volatile("s_waitcnt vmcnt(0)" ::: "memory");
            const unsigned og = xb_add(&bar[XB_TOP], 1u);
            const unsigned tg = og / nx;
            if (og + 1u == (tg + 1u) * nx) xb_add(&bar[XB_TOPGEN], 1u);
            else XB_SPIN(xb_ld(&bar[XB_TOPGEN]) == tg, bar);
            __builtin_amdgcn_fence(__ATOMIC_ACQUIRE, "agent");
            xb_add(&bar[XB_XGEN(b.x)], 1u);
            asm volatile("s_waitcnt vmcnt(0)" ::: "memory");
        } else {
            XB_SPIN(xb_ld(&bar[XB_XGEN(b.x)]) == gen, bar);
            __builtin_amdgcn_fence(__ATOMIC_ACQUIRE, "agent");
            asm volatile("s_waitcnt vmcnt(0)" ::: "memory");
        }
    }
    __syncthreads();
}


template <int PH> __device__ __forceinline__ void run_phase(const Params& P, const Ctx& C) {
    unsigned char* ws = P.ws;
    typedef pg8::bf16_t pbf;
    if constexpr (PH == 0) { p0_prologue(P, C); }
    else if constexpr (PH == 10) {
        pg8::Gemm g{(const pbf*)(ws + WS_XBF), (const pbf*)(ws + WS_WIN_T), NTOK, D_INP, D}; pg8::StaticOrder S; S.init(NTOK, D_INP, C.G, (int)blockIdx.x);
        pg8::EpiBf16s E{(pbf*)(ws + WS_H), D_INP};
        pg8::gemm_phase<pg8::EpiBf16s, pg8::StaticOrder, true, true>(C.lds, g, S, E); }
    else if constexpr (PH == 11) {
        pg8::Gemm g{(const pbf*)(ws + WS_PB), (const pbf*)(ws + WS_WPROJ_T), NTOK, D, PLE}; pg8::StaticOrder S; S.init(NTOK, D, C.G, (int)blockIdx.x);
        pg8::EpiBf16s E{(pbf*)(ws + WS_PROJ), D};
        pg8::gemm_phase<pg8::EpiBf16s, pg8::StaticOrder, true, true>(C.lds, g, S, E); }
    else if constexpr (PH == 20) { p2_post(P, C); }
    else if constexpr (PH == 21) { p2_hgrn_prep(P, C); }
    else if constexpr (PH == 30) {
        { pg8::Gemm g{(const pbf*)(ws + WS_CN), (const pbf*)(ws + WS_WUK_T), NTOK, 512, 256}; pg8::StaticOrder S; S.init(NTOK, 512, C.G, (int)blockIdx.x);
          pg8::EpiKhead E{(pbf*)(ws + WS_K)};
          pg8::gemm_phase<pg8::EpiKhead, pg8::StaticOrder, true, true>(C.lds, g, S, E); }
        { pg8::Gemm g{(const pbf*)(ws + WS_WUV_T), (const pbf*)(ws + WS_CN), 512, NTOK, 256}; pg8::StaticOrder S; S.init(512, NTOK, C.G, (int)blockIdx.x);
          pg8::EpiVt E{(pbf*)(ws + WS_VT)};
          pg8::gemm_phase<pg8::EpiVt, pg8::StaticOrder, true, true>(C.lds, g, S, E); }
    }
    else if constexpr (PH == 31) { p3_indexer(P, C); }
    else if constexpr (PH == 32) { p3_scan_convert(P, C); }
    else if constexpr (PH == 40) { p4_attention2(P, C); }
    else if constexpr (PH == 41) { p4_yrec(P, C); }
    else if constexpr (PH == 5) {
        pg8::Gemm g{(const pbf*)(ws + WS_YMIX), (const pbf*)(ws + WS_WO_T), NTOK, D, D / 2}; pg8::StaticOrder S; S.init(NTOK, D, C.G, (int)blockIdx.x);
        pg8::EpiResid E{(const pbf*)(ws + WS_XBF), (pbf*)P.out, D, ALPHA, 1.f / 512.f};
        pg8::gemm_phase<pg8::EpiResid, pg8::StaticOrder, true, true, 1>(C.lds, g, S, E);
    }
    else if constexpr (PH == 6) { p6_ln1_router<true>(P, C); }
    else if constexpr (PH == 60) { p6_ln1_router<false>(P, C); }
    else if constexpr (PH == 7) { p7_dispatch(P, C); }
    else if constexpr (PH == 8) {
        const int* tile_e = (const int*)(ws + WS_TILEE);
        pg8::Gemm g{(const pbf*)(ws + WS_XS), (const pbf*)(ws + WS_WUP_T), CAP, NE * 2048, D / 2};
        pg8::MoeOrder S{tile_e, tile_e[MAXTILES], 8, C.G, (int)blockIdx.x};
        pg8::EpiSwiglu E{ws + WS_HH, P.in[I_BUP]};
        pg8::gemm_phase<pg8::EpiSwiglu, pg8::MoeOrder, true, true, 1, 124, 121>(C.lds, g, S, E);
    }
    else if constexpr (PH == 9) {
        const int* tile_e = (const int*)(ws + WS_TILEE);
        pg8::Gemm g{(const pbf*)(ws + WS_HH), (const pbf*)(ws + WS_WDN_T), CAP, NE * 1024, DFF / 2};
        pg8::MoeOrder S{tile_e, tile_e[MAXTILES], 4, C.G, (int)blockIdx.x};
        pg8::EpiDown E{ws + WS_YSLOT, P.in[I_BDN], (const float*)(ws + WS_SLOTGATE)};
        pg8::gemm_phase<pg8::EpiDown, pg8::MoeOrder, true, true, 1, 125, 121>(C.lds, g, S, E);
    }
    else if constexpr (PH == 100) { p10_combine_ln2(P, C); }
    else if constexpr (PH == 110) {
        pg8::Gemm g{(const pbf*)(ws + WS_XB), (const pbf*)(ws + WS_WGATE_T), NTOK, D, D / 2}; pg8::StaticOrder S; S.init(NTOK, D, C.G, (int)blockIdx.x);
        pg8::EpiPle E{(const pbf*)P.out, (const pbf*)(ws + WS_PROJ), (pbf*)(ws + WS_X1), ALPHA, 1.f / 512.f};
        pg8::gemm_phase<pg8::EpiPle, pg8::StaticOrder, true, true, 1>(C.lds, g, S, E);
    }
    else { p12_final_ln(P, C); }
}
__global__ void __launch_bounds__(NTHR, 2) mega_fwd(Params P) {
    extern __shared__ __attribute__((aligned(16))) unsigned char lds_raw[];
#ifndef PLAIN_LAUNCH
    cg::grid_group grid = cg::this_grid();
#endif
#define MKCTX Ctx C; { int tid_ = threadIdx.x; asm volatile("" : "+v"(tid_)); C.lds = (LAS unsigned char*)lds_raw; C.tid = tid_; C.lane = tid_ & 63; C.wave = __builtin_amdgcn_readfirstlane(tid_ >> 6); \
      C.G = gridDim.x; C.gw = blockIdx.x * NWAVES + C.wave; C.ngw = C.G * NWAVES; }
#if SYNC_MODE != 0
    if (threadIdx.x < 4) ((LAS unsigned*)((LAS unsigned char*)lds_raw + XBW_OFF))[threadIdx.x] = 0u;
    __syncthreads();
    XcdBarrier bar = xcd_barrier_post((unsigned*)(P.ws + WS_CTL) + CW_BAR, (volatile LAS unsigned*)((LAS unsigned char*)lds_raw + XBW_OFF));
#define SY xcd_barrier(bar);
#else
#define SY grid.sync();
#endif
#ifdef PLAIN_LAUNCH
#define GS xcd_barrier(bar);
#else
#define GS grid.sync();
#endif
#define BS __syncthreads();
#define X(k) { MKCTX run_phase<k>(P, C); }
    PROGRAM
#undef X
#undef MKCTX
#undef SY
#undef GS
#undef BS
}

extern "C" void kernel_launch(void* const* d_in, const int* in_sizes, int n_in, void* d_out, int out_size, void* d_ws, size_t ws_size, hipStream_t stream) {
    static int grid = 0;
    if (grid == 0) {
        if (n_in != 25 || out_size != NTOK * D || ws_size < WS_END) { fprintf(stderr, "kernel_launch: unexpected shapes (n_in %d out %d ws %zu)\n", n_in, out_size, ws_size); grid = -1; return; }
        int dev = 0, cus = 0, per_cu = 0;
        if (hipGetDevice(&dev) != hipSuccess || hipDeviceGetAttribute(&cus, hipDeviceAttributeMultiprocessorCount, dev) != hipSuccess) { grid = -1; return; }
        if (hipFuncSetAttribute((const void*)mega_fwd, hipFuncAttributeMaxDynamicSharedMemorySize, LDS_BYTES) != hipSuccess) { fprintf(stderr, "kernel_launch: hipFuncSetAttribute failed\n"); grid = -1; return; }
        if (hipOccupancyMaxActiveBlocksPerMultiprocessor(&per_cu, (const void*)mega_fwd, NTHR, LDS_BYTES) != hipSuccess || per_cu < 1) { fprintf(stderr, "kernel_launch: occupancy query failed (%d)\n", per_cu); (void)hipGetLastError(); grid = -1; return; }
        grid = cus * per_cu;
        fprintf(stderr, "kernel_launch: grid %d (%d CUs x %d)\n", grid, cus, per_cu);
    }
    if (grid < 0) return;
    (void)hipMemsetAsync((char*)d_ws + WS_CTL, 0, CTL_ZERO_BYTES, stream);
    Params p{};
    for (int i = 0; i < 25; ++i) p.in[i] = (const float*)d_in[i];
    p.out = (float*)d_out; p.ws = (unsigned char*)d_ws;

    void* args[] = {&p};
#ifdef PLAIN_LAUNCH
    hipLaunchKernelGGL(mega_fwd, dim3(grid), dim3(NTHR), LDS_BYTES, stream, p); hipError_t e = hipPeekAtLastError(); (void)args;
#else
    hipError_t e = hipLaunchCooperativeKernel((const void*)mega_fwd, dim3(grid), dim3(NTHR), args, LDS_BYTES, stream);
#endif
    if (e != hipSuccess) fprintf(stderr, "kernel_launch: cooperative launch failed: %s (grid %d)\n", hipGetErrorString(e), grid);
}
```

```cpp
#define SYNC_MODE 1
#include <hip/hip_runtime.h>
#include <hip/hip_cooperative_groups.h>
#include <cstdio>
#include <cstdint>
namespace cg = cooperative_groups;

namespace pg8 {
#define PG8_LAS __attribute__((address_space(3)))
typedef unsigned short bf16_t;
typedef short bf16x8 __attribute__((ext_vector_type(8)));
typedef float f32x4 __attribute__((ext_vector_type(4)));
typedef unsigned u32x4 __attribute__((ext_vector_type(4)));
typedef int i32x4 __attribute__((ext_vector_type(4)));
typedef int i32x8 __attribute__((ext_vector_type(8)));
constexpr int BM = 256, BK = 64, HALF = 128, HTB = HALF * BK * 2  , STAGE_BYTES = 8 * HTB, NXCD = 8, WGM = 8;

__host__ __device__ __forceinline__ int lds_byte(int r, int c) { const int st = (r >> 4) * 2 + (c >> 5), rr = r & 15, cc = c & 31, ob = rr * 64 + cc * 2; return st * 1024 + (ob ^ (((ob >> 9) & 1) << 5)); }
__host__ __device__ __forceinline__ void stage_rc(int b, int& R, int& C) { const int st = b / 1024, sb = b % 1024, swz = sb ^ (((sb >> 9) & 1) << 5); R = (st >> 1) * 16 + swz / 64; C = (st & 1) * 32 + (swz % 64) / 2; }
__host__ __device__ __forceinline__ int perm32(int rho) { const int n = rho >> 4, i = rho & 15; return 8 * (i >> 2) + 4 * n + (i & 3); }

struct Unit { int pm, pn; };
struct Gemm { const bf16_t* A; const bf16_t* Bt; int M, N, K; };

struct StaticOrder {
    int nM, nN, nwg, G, c;
    __host__ __device__ void init(int M, int N, int G_, int c_) { nM = M / BM; nN = N / BM; nwg = nM * nN; G = G_; c = c_; }
    __host__ __device__ bool next(int i, Unit& u) const {
        const long L = (long)i * G + c; if (L >= nwg) return false;
        int wgid = (int)L; { const int q = nwg / NXCD, r = nwg % NXCD, xcd = wgid % NXCD, off = wgid / NXCD; wgid = (xcd < r ? xcd * (q + 1) : r * (q + 1) + (xcd - r) * q) + off; }
        const int nig = WGM * nN, gid = wgid / nig, fm = gid * WGM, gsz = (nM - fm) < WGM ? (nM - fm) : WGM;
        u.pm = fm + ((wgid % nig) % gsz); u.pn = (wgid % nig) / gsz; return true;
    }
    __device__ __forceinline__ void a_ready(const Unit&) const {}
    __device__ __forceinline__ void done(const Unit&) const {}
};

__device__ __forceinline__ unsigned cvt_pk_bf16(float lo, float hi) { unsigned r; asm volatile("v_cvt_pk_bf16_f32 %0, %1, %2" : "=v"(r) : "v"(lo), "v"(hi)); return r; }
typedef float f32x2 __attribute__((ext_vector_type(2)));
template <class Epi, class Sched, bool ALIGN_EPI = false, bool SP2 = false, int F8 = 0, int F8SA = 127, int F8SB = 127>
__device__ __forceinline__ void gemm_phase(PG8_LAS unsigned char* lds, const Gemm g, const Sched& S, const Epi& E) {
    const int tid = threadIdx.x, wid = __builtin_amdgcn_readfirstlane(tid >> 6), lane = tid & 63, wr = wid >> 2, wc = wid & 3, fr = lane & 15, fq = lane >> 4;
    const int K = g.K, nt = K / BK;
    unsigned voffA[2], voffB[2];
#pragma unroll
    for (int i = 0; i < 2; ++i) { int R, C; stage_rc(tid * 16 + i * 8192, R, C); const int Rb = Epi::PERM ? ((R & ~31) + perm32(R & 31)) : R;
        voffA[i] = (unsigned)(R * K + C) * 2u; voffB[i] = (unsigned)(Rb * K + C) * 2u; }
    const size_t kstep = (size_t)(BK * 2);
    const size_t hstep = (size_t)HALF * K * 2;
    const size_t tstep = 2 * hstep;
    const unsigned ldsw = (unsigned)wid * 1024u;
    const int aoff = lds_byte(wr * 64 + fr, fq * 8), boff = lds_byte(wc * 32 + fr, fq * 8);
#define PG8_SA(b, h) (((b) * 2 + (h)) * HTB)
#define PG8_SB(b, h) ((4 + (b) * 2 + (h)) * HTB)
#define PG8_STAGE(bufoff, gbase, voff) do { _Pragma("unroll") for (int _i = 0; _i < 2; ++_i) \
        __builtin_amdgcn_global_load_lds((const unsigned*)((const char*)(gbase) + (voff)[_i]), (PG8_LAS unsigned*)(lds + (bufoff) + ldsw + _i * 8192), 16, 0, 0); } while (0)
#define PG8_LDA(dst, b, h) do { _Pragma("unroll") for (int m = 0; m < 4; ++m) { dst[m].lo = *(const PG8_LAS i32x4*)(lds + PG8_SA(b, h) + aoff + m * 2048); dst[m].hi = *(const PG8_LAS i32x4*)(lds + PG8_SA(b, h) + aoff + m * 2048 + 1024); } } while (0)
#define PG8_LDB(dst, b, h) do { _Pragma("unroll") for (int n = 0; n < 2; ++n) { dst[n].lo = *(const PG8_LAS i32x4*)(lds + PG8_SB(b, h) + boff + n * 2048); dst[n].hi = *(const PG8_LAS i32x4*)(lds + PG8_SB(b, h) + boff + n * 2048 + 1024); } } while (0)
#define PG8_MMA(ai, bj, At, Bt) do { __builtin_amdgcn_s_setprio(1); \
        if constexpr (F8 == 0) { _Pragma("unroll") for (int m = 0; m < 4; ++m) _Pragma("unroll") for (int n = 0; n < 2; ++n) { \
            const i32x4 bl_ = Bt[n].lo, bh_ = Bt[n].hi, al_ = At[m].lo, ah_ = At[m].hi;     \
            acc[ai][bj][m][n] = __builtin_amdgcn_mfma_f32_16x16x32_bf16(__builtin_bit_cast(bf16x8, bl_), __builtin_bit_cast(bf16x8, al_), acc[ai][bj][m][n], 0, 0, 0); \
            acc[ai][bj][m][n] = __builtin_amdgcn_mfma_f32_16x16x32_bf16(__builtin_bit_cast(bf16x8, bh_), __builtin_bit_cast(bf16x8, ah_), acc[ai][bj][m][n], 0, 0, 0); } } \
        else { _Pragma("unroll") for (int m = 0; m < 4; ++m) _Pragma("unroll") for (int n = 0; n < 2; ++n) \
            asm volatile("v_mfma_f32_16x16x128_f8f6f4 %0, %1, %2, %0" : "+v"(acc[ai][bj][m][n]) : "v"(Bt[n]), "v"(At[m])); } \
        __builtin_amdgcn_s_setprio(0); } while (0)
#define PG8_WAIT_V(n) asm volatile("s_waitcnt vmcnt(" #n ")" ::: "memory")
#define PG8_WAIT_L(n) asm volatile("s_waitcnt lgkmcnt(" #n ")" ::: "memory")
#define PG8_BAR __builtin_amdgcn_s_barrier()
#define PG8_SCHED __builtin_amdgcn_sched_barrier(0)
    Unit cur, nxt; int ui = 0;
    if (!S.next(0, cur)) return;
    f32x4 acc[2][2][4][2];
#pragma unroll
    for (int a = 0; a < 2; ++a)
#pragma unroll
        for (int b = 0; b < 2; ++b)
#pragma unroll
            for (int m = 0; m < 4; ++m)
#pragma unroll
                for (int n = 0; n < 2; ++n) acc[a][b][m][n] = (f32x4){0.f, 0.f, 0.f, 0.f};
    i32x8 At[4], B0[2], B1[2];
    const char* cA = (const char*)g.A + (size_t)cur.pm * tstep; const char* cB = (const char*)g.Bt + (size_t)cur.pn * tstep;
    S.a_ready(cur);
    if constexpr (SP2) {
        PG8_STAGE(PG8_SB(0, 0), cB, voffB); PG8_STAGE(PG8_SB(0, 1), cB + hstep, voffB); PG8_STAGE(PG8_SA(0, 0), cA, voffA); PG8_STAGE(PG8_SA(0, 1), cA + hstep, voffA);
        if (wr == 1) PG8_BAR;
        PG8_WAIT_V(2); PG8_BAR;
        PG8_STAGE(PG8_SB(1, 0), cB + kstep, voffB); PG8_STAGE(PG8_SA(1, 0), cA + kstep, voffA); PG8_STAGE(PG8_SB(1, 1), cB + hstep + kstep, voffB);
        PG8_WAIT_V(6); PG8_BAR;
    } else {
        PG8_STAGE(PG8_SB(0, 0), cB, voffB); PG8_STAGE(PG8_SA(0, 0), cA, voffA); PG8_STAGE(PG8_SB(0, 1), cB + hstep, voffB); PG8_STAGE(PG8_SA(0, 1), cA + hstep, voffA);
        if (wr == 1) PG8_BAR;
        PG8_WAIT_V(4); PG8_BAR;
        PG8_STAGE(PG8_SB(1, 0), cB + kstep, voffB); PG8_STAGE(PG8_SA(1, 0), cA + kstep, voffA); PG8_STAGE(PG8_SB(1, 1), cB + hstep + kstep, voffB);
        PG8_WAIT_V(6); PG8_BAR;
    }
    for (;;) {
        const bool has_next = S.next(ui + 1, nxt);
        const char* nA = has_next ? (const char*)g.A + (size_t)nxt.pm * tstep : cA; const char* nB = has_next ? (const char*)g.Bt + (size_t)nxt.pn * tstep : cB;
_Pragma("nounroll")
        for (int t = 0; t < nt; t += 2) {
            const bool last = (t == nt - 2);
            const char* a1 = cA + (size_t)(t + 1) * kstep;
            const char* a2 = last ? nA : cA + (size_t)(t + 2) * kstep; const char* b2 = last ? nB : cB + (size_t)(t + 2) * kstep;
            const char* a3 = a2 + kstep; const char* b3 = b2 + kstep;
            if (last && has_next) S.a_ready(nxt);
            if constexpr (SP2) {
            PG8_LDB(B0, 0, 0); PG8_LDB(B1, 0, 1); PG8_SCHED; PG8_LDA(At, 0, 0); PG8_STAGE(PG8_SA(1, 1), a1 + hstep, voffA);
            PG8_WAIT_V(8); PG8_WAIT_L(0); PG8_BAR; PG8_MMA(0, 0, At, B0); PG8_MMA(0, 1, At, B1); PG8_BAR; PG8_SCHED;
            PG8_LDA(At, 0, 1); PG8_STAGE(PG8_SB(0, 0), b2, voffB); PG8_STAGE(PG8_SB(0, 1), b2 + hstep, voffB); PG8_STAGE(PG8_SA(0, 0), a2, voffA);
            PG8_WAIT_V(8); PG8_WAIT_L(0); PG8_BAR; PG8_MMA(1, 0, At, B0); PG8_MMA(1, 1, At, B1); PG8_BAR; PG8_SCHED;
            PG8_LDB(B0, 1, 0); PG8_LDB(B1, 1, 1); PG8_SCHED; PG8_LDA(At, 1, 0); PG8_STAGE(PG8_SA(0, 1), a2 + hstep, voffA);
            PG8_WAIT_V(8); PG8_WAIT_L(0); PG8_BAR; PG8_MMA(0, 0, At, B0); PG8_MMA(0, 1, At, B1); PG8_BAR; PG8_SCHED;
            PG8_LDA(At, 1, 1); PG8_STAGE(PG8_SB(1, 0), b3, voffB); PG8_STAGE(PG8_SB(1, 1), b3 + hstep, voffB); PG8_STAGE(PG8_SA(1, 0), a3, voffA);
            PG8_WAIT_V(8); PG8_WAIT_L(0); PG8_BAR; PG8_MMA(1, 0, At, B0); PG8_MMA(1, 1, At, B1); PG8_BAR; PG8_SCHED;
            } else {
            PG8_LDB(B0, 0, 0); PG8_SCHED; PG8_LDA(At, 0, 0); PG8_STAGE(PG8_SA(1, 1), a1 + hstep, voffA);
            PG8_WAIT_L(8); PG8_BAR; PG8_WAIT_L(0); PG8_MMA(0, 0, At, B0); PG8_BAR; PG8_SCHED;
            PG8_LDB(B1, 0, 1); PG8_STAGE(PG8_SB(0, 0), b2, voffB);
            PG8_BAR; PG8_WAIT_L(0); PG8_MMA(0, 1, At, B1); PG8_BAR;
            PG8_LDA(At, 0, 1); PG8_STAGE(PG8_SA(0, 0), a2, voffA);
            PG8_BAR; PG8_WAIT_L(0); PG8_MMA(1, 0, At, B0); PG8_BAR; PG8_SCHED;
            PG8_STAGE(PG8_SB(0, 1), b2 + hstep, voffB);
            PG8_WAIT_V(6); PG8_BAR; PG8_MMA(1, 1, At, B1); PG8_BAR;
            PG8_LDB(B0, 1, 0); PG8_SCHED; PG8_LDA(At, 1, 0); PG8_STAGE(PG8_SA(0, 1), a2 + hstep, voffA);
            PG8_WAIT_L(8); PG8_BAR; PG8_WAIT_L(0); PG8_MMA(0, 0, At, B0); PG8_BAR; PG8_SCHED;
            PG8_LDB(B1, 1, 1); PG8_STAGE(PG8_SB(1, 0), b3, voffB);
            PG8_BAR; PG8_WAIT_L(0); PG8_MMA(0, 1, At, B1); PG8_BAR;
            PG8_LDA(At, 1, 1); PG8_STAGE(PG8_SA(1, 0), a3, voffA);
            PG8_BAR; PG8_WAIT_L(0); PG8_MMA(1, 0, At, B0); PG8_BAR; PG8_SCHED;
            PG8_STAGE(PG8_SB(1, 1), b3 + hstep, voffB);
            PG8_WAIT_V(6); PG8_BAR; PG8_MMA(1, 1, At, B1); PG8_BAR;
            }
        }
        if constexpr (ALIGN_EPI) { if (wr == 0) PG8_BAR; }
        if constexpr (F8 != 0) asm volatile("s_nop 15\n\ts_nop 15" ::: "memory");
        if constexpr (!Epi::AFTER_DRAIN) { E(acc, cur, wr, wc, fr, fq); S.done(cur); }
        if (!has_next) break;
#pragma unroll
        for (int a = 0; a < 2; ++a)
#pragma unroll
            for (int b = 0; b < 2; ++b)
#pragma unroll
                for (int m = 0; m < 4; ++m)
#pragma unroll
                    for (int n = 0; n < 2; ++n) acc[a][b][m][n] = (f32x4){0.f, 0.f, 0.f, 0.f};
        cur = nxt; cA = nA; cB = nB; ++ui;
        if constexpr (ALIGN_EPI) { if (wr == 1) PG8_BAR; }
    }
    PG8_WAIT_V(0);
    if constexpr (!ALIGN_EPI) { if (wr == 0) PG8_BAR; }
    PG8_BAR;
    if constexpr (Epi::AFTER_DRAIN) { E.fused(acc, cur, wr, wc, fr, fq, lds, wid, lane); S.done(cur); }
#undef PG8_SA
#undef PG8_SB
#undef PG8_STAGE
#undef PG8_LDA
#undef PG8_LDB
#undef PG8_MMA
#undef PG8_WAIT_V
#undef PG8_WAIT_L
#undef PG8_BAR
#undef PG8_SCHED
}
}

constexpr int NB = 8, T = 4096, D = 1024, NTOK = NB * T;
constexpr int ATT_H = 8, ATT_D = 64, ATT_W = 512, KV_LAT = 256, IDX_H = 8, IDX_D = 64, TOPK = 256;
constexpr int HG_H = 4, HG_DK = 128, HG_DV = 128, HG_W = 512, HG_C = 32;
constexpr int D_IN = 3400, D_INP = 3584;
constexpr int C_AQ = 0, C_AC = 512, C_IQ = 768, C_IK = 1280, C_IW = 1344, C_GQ = 1352, C_GF = 1864, C_GI = 2376, C_GG = 2888;
constexpr int NE = 32, TOPE = 4, DFF = 1024, PLE = 256;
constexpr int NASSIGN = NTOK * TOPE, CAP = NASSIGN + NE * 256;
constexpr int MAXTILES = CAP / 256;
constexpr float LN_EPS = 1e-5f, RMS_EPS = 1e-6f, ALPHA = 1.189207115002721f;

constexpr size_t MiB = 1u << 20;
constexpr size_t WS_CTL = 0, CTL_ZERO_BYTES = 64 * 1024;
constexpr size_t WS_WIN_T = 1 * MiB, WS_WO_T = 8 * MiB, WS_WUP_T = 10 * MiB, WS_WDN_T = 138 * MiB, WS_WPROJ_T = 202 * MiB, WS_WGATE_T = 203 * MiB;
constexpr size_t WS_WUK_T = 205 * MiB, WS_WUV_T = 205 * MiB + 512 * 1024;
constexpr size_t WS_SMALL = 206 * MiB;
constexpr size_t WS_A = 208 * MiB;
constexpr size_t WS_B = 480 * MiB;
constexpr size_t WS_X1 = 752 * MiB;
constexpr size_t WS_XB = 880 * MiB;
constexpr size_t WS_PROJ = 944 * MiB;
constexpr size_t WS_SM2 = 1008 * MiB;
constexpr size_t WS_END = 1016 * MiB;
constexpr size_t WS_H = WS_A, WS_XS = WS_A, WS_YSLOT = WS_A;
constexpr size_t WS_XBF = WS_X1 + 64 * MiB, WS_U = WS_B, WS_YMIX = WS_B, WS_HH = WS_B;
constexpr size_t WS_QDEC = WS_B + 128 * MiB, WS_PB = WS_B + 128 * MiB, WS_OREC = WS_B + 160 * MiB, WS_CN = WS_B + 224 * MiB, WS_IKN = WS_B + 240 * MiB, WS_MASK = WS_B + 244 * MiB;
constexpr size_t WS_K = WS_XB, WS_VT = WS_XB + 32 * MiB;
constexpr size_t WS_TOPE = WS_SM2, WS_GATE = WS_SM2 + 512 * 1024, WS_LRANK = WS_SM2 + 1024 * 1024, WS_TOKSLOT = WS_SM2 + 1536 * 1024, WS_SLOTGATE = WS_SM2 + 2 * MiB, WS_DECAY = WS_SM2 + 3 * MiB;
constexpr size_t WS_WRT = WS_SMALL + 256 * 1024;
constexpr size_t WS_WGBASE = WS_SMALL, WS_TILEE = WS_SMALL + 64 * 1024;
constexpr int CW_CNT = 64;
constexpr int CW_BAR = 1024;
constexpr int XBW_OFF = 147456 - 16;

constexpr int RING_BYTES = 131072, MISC_OFF = RING_BYTES, LDS_BYTES = 147456;
constexpr int NWAVES = 8, NTHR = 512;

#define GAS __attribute__((address_space(1)))
#define LAS __attribute__((address_space(3)))
typedef unsigned short bf16;
typedef unsigned v4u __attribute__((ext_vector_type(4)));
typedef unsigned v2u __attribute__((ext_vector_type(2)));
typedef float f32x4 __attribute__((ext_vector_type(4)));
typedef short bf16x8 __attribute__((ext_vector_type(8)));
#define LDS_WAIT() asm volatile("s_waitcnt lgkmcnt(0)" ::: "memory")
#define VM_WAIT() asm volatile("s_waitcnt vmcnt(0)" ::: "memory")
__device__ __forceinline__ unsigned f2bf(float f) { unsigned u = __builtin_bit_cast(unsigned, f); return (u + 0x7fffu + ((u >> 16) & 1u)) >> 16; }
__device__ __forceinline__ unsigned pk2(float lo, float hi) { return f2bf(lo) | (f2bf(hi) << 16); }
__device__ __forceinline__ float bf2f(unsigned short b) { return __builtin_bit_cast(float, (unsigned)b << 16); }
__device__ __forceinline__ float bflo(unsigned w) { return __builtin_bit_cast(float, w << 16); }
__device__ __forceinline__ float bfhi(unsigned w) { return __builtin_bit_cast(float, w & 0xffff0000u); }
__device__ __forceinline__ float wave_sum(float v) {
#pragma unroll
    for (int o = 1; o < 64; o <<= 1) v += __shfl_xor(v, o);
    return v;
}
__device__ __forceinline__ float sigmoidf_(float x) { return __builtin_amdgcn_rcpf(1.f + __builtin_amdgcn_exp2f(x * -1.4426950408889634f)); }

__device__ __forceinline__ unsigned pk4_fp8(float a, float b, float c, float d);
struct Params { const float* in[25]; float* out; unsigned char* ws; };
enum { I_X = 0, I_P, I_WIN, I_KVG, I_IKG, I_IKB, I_WUK, I_WUV, I_HGLB, I_HGNG, I_WO, I_LNMG, I_LNMB, I_WR, I_BR, I_WUP, I_BUP, I_WDN, I_BDN, I_LNFG, I_LNFB, I_WPP, I_WPG, I_LNPG, I_LNPB };

struct Ctx { LAS unsigned char* lds; int tid, lane, wave, G, gw, ngw; };

namespace pg8 {
struct EpiBf16s {
    static constexpr bool PERM = true, AFTER_DRAIN = false;
    bf16_t* O; int ldc;
    __device__ __forceinline__ void operator()(const f32x4 (&acc)[2][2][4][2], const Unit& u, int wr, int wc, int fr, int fq) const {
        const int row0 = u.pm * BM + wr * 64 + fr, col0 = u.pn * BM + wc * 32 + 8 * fq;
#pragma unroll
        for (int ai = 0; ai < 2; ++ai)
#pragma unroll
            for (int m = 0; m < 4; ++m) { bf16_t* rowp = O + (size_t)(row0 + ai * HALF + m * 16) * ldc + col0;
#pragma unroll
                for (int bj = 0; bj < 2; ++bj) { const f32x4 v0 = acc[ai][bj][m][0], v1 = acc[ai][bj][m][1];
                    u32x4 w; w.x = cvt_pk_bf16(v0[0], v0[1]); w.y = cvt_pk_bf16(v0[2], v0[3]); w.z = cvt_pk_bf16(v1[0], v1[1]); w.w = cvt_pk_bf16(v1[2], v1[3]);
                    *(u32x4*)(rowp + bj * HALF) = w; } }
    }
};
struct EpiResid {
    static constexpr bool PERM = false, AFTER_DRAIN = false;
    const bf16_t* res; bf16_t* out; int ldc; float alpha, as;
    __device__ __forceinline__ void operator()(const f32x4 (&acc)[2][2][4][2], const Unit& u, int wr, int wc, int fr, int fq) const {
        const int row0 = u.pm * BM + wr * 64 + fr, col0 = u.pn * BM + wc * 32 + 4 * fq;
#pragma unroll
        for (int ai = 0; ai < 2; ++ai)
#pragma unroll
            for (int m = 0; m < 4; ++m) { const size_t off = (size_t)(row0 + ai * HALF + m * 16) * ldc + col0;
#pragma unroll
                for (int bj = 0; bj < 2; ++bj)
#pragma unroll
                    for (int n = 0; n < 2; ++n) { const v2u rw = *(const v2u*)(res + off + bj * HALF + n * 16); const f32x4 r = {bflo(rw.x), bfhi(rw.x), bflo(rw.y), bfhi(rw.y)}; const f32x4 o = r * alpha + acc[ai][bj][m][n] * as; v2u w; w.x = cvt_pk_bf16(o[0], o[1]); w.y = cvt_pk_bf16(o[2], o[3]); *(v2u*)(out + off + bj * HALF + n * 16) = w; }
                asm volatile("" ::: "memory"); }
    }
};
struct EpiPle {
    static constexpr bool PERM = false, AFTER_DRAIN = false;
    const bf16_t* x2; const bf16_t* proj; bf16_t* out; float alpha, as;
    __device__ __forceinline__ void operator()(const f32x4 (&acc)[2][2][4][2], const Unit& u, int wr, int wc, int fr, int fq) const {
        const int row0 = u.pm * BM + wr * 64 + fr, col0 = u.pn * BM + wc * 32 + 4 * fq;
#pragma unroll
        for (int ai = 0; ai < 2; ++ai)
#pragma unroll
            for (int m = 0; m < 4; ++m) { const size_t off = (size_t)(row0 + ai * HALF + m * 16) * 1024 + col0;
#pragma unroll
                for (int bj = 0; bj < 2; ++bj)
#pragma unroll
                    for (int n = 0; n < 2; ++n) { const size_t o2 = off + bj * HALF + n * 16; const v2u rw = *(const v2u*)(x2 + o2); const f32x4 r = {bflo(rw.x), bfhi(rw.x), bflo(rw.y), bfhi(rw.y)}; const v2u pw = *(const v2u*)(proj + o2);
                        const f32x4 a = acc[ai][bj][m][n] * as; f32x4 o;
                        o[0] = r[0] * alpha + bflo(pw.x) * sigmoidf_(a[0]); o[1] = r[1] * alpha + bfhi(pw.x) * sigmoidf_(a[1]);
                        o[2] = r[2] * alpha + bflo(pw.y) * sigmoidf_(a[2]); o[3] = r[3] * alpha + bfhi(pw.y) * sigmoidf_(a[3]);
                        v2u ow; ow.x = cvt_pk_bf16(o[0], o[1]); ow.y = cvt_pk_bf16(o[2], o[3]); *(v2u*)(out + o2) = ow; }
                asm volatile("" ::: "memory"); }
    }
};
struct EpiSwiglu {
    static constexpr bool PERM = true, AFTER_DRAIN = false;
    unsigned char* H; const float* b_up;
    __device__ __forceinline__ void operator()(const f32x4 (&acc)[2][2][4][2], const Unit& u, int wr, int wc, int fr, int fq) const {
        const int e = u.pn >> 3, pnT = u.pn & 7;
        const int row0 = u.pm * BM + wr * 64 + fr, col0 = pnT * 128 + wc * 32 + 8 * fq;
        const float* bg = b_up + (size_t)e * 2048 + col0; const float* bl = bg + 1024;
        float bgv[8], blv[8];
#pragma unroll
        for (int j = 0; j < 8; ++j) { bgv[j] = bg[j]; blv[j] = bl[j]; }
#pragma unroll
        for (int ai = 0; ai < 2; ++ai)
#pragma unroll
            for (int m = 0; m < 4; ++m) { unsigned char* rowp = H + (size_t)(row0 + ai * HALF + m * 16) * 1024 + col0; float a[8];
#pragma unroll
                for (int n = 0; n < 2; ++n)
#pragma unroll
                    for (int j = 0; j < 4; ++j) { float g = acc[ai][0][m][n][j] * (1.f / 512.f) + bgv[4 * n + j], l = acc[ai][1][m][n][j] * (1.f / 512.f) + blv[4 * n + j];
                        g = fminf(g, 7.0f); l = fminf(fmaxf(l, -7.0f), 7.0f); a[4 * n + j] = g * sigmoidf_(1.702f * g) * (l + 1.0f); }
                v2u w; w.x = pk4_fp8(a[0] * 4.f, a[1] * 4.f, a[2] * 4.f, a[3] * 4.f); w.y = pk4_fp8(a[4] * 4.f, a[5] * 4.f, a[6] * 4.f, a[7] * 4.f);
                *(v2u*)rowp = w; }
    }
};
struct EpiDown {
    static constexpr bool PERM = true, AFTER_DRAIN = false;
    unsigned char* Y; const float* b_dn; const float* gate;
    __device__ __forceinline__ void operator()(const f32x4 (&acc)[2][2][4][2], const Unit& u, int wr, int wc, int fr, int fq) const {
        const int e = u.pn >> 2, pnT = u.pn & 3;
        const int row0 = u.pm * BM + wr * 64 + fr, col0 = pnT * 256 + wc * 32 + 8 * fq;
        const float* bb = b_dn + (size_t)e * 1024 + col0;
        float bv[2][8];
#pragma unroll
        for (int bj = 0; bj < 2; ++bj)
#pragma unroll
            for (int j = 0; j < 8; ++j) bv[bj][j] = bb[bj * HALF + j];
#pragma unroll
        for (int ai = 0; ai < 2; ++ai)
#pragma unroll
            for (int m = 0; m < 4; ++m) { const int row = row0 + ai * HALF + m * 16; const float gt = gate[row] * 64.f; unsigned char* rowp = Y + (size_t)row * 1024 + col0;
#pragma unroll
                for (int bj = 0; bj < 2; ++bj) { const f32x4 v0 = acc[ai][bj][m][0], v1 = acc[ai][bj][m][1];
                    const float as = 1.f / 256.f;
                    v2u w; w.x = pk4_fp8((v0[0] * as + bv[bj][0]) * gt, (v0[1] * as + bv[bj][1]) * gt, (v0[2] * as + bv[bj][2]) * gt, (v0[3] * as + bv[bj][3]) * gt);
                    w.y = pk4_fp8((v1[0] * as + bv[bj][4]) * gt, (v1[1] * as + bv[bj][5]) * gt, (v1[2] * as + bv[bj][6]) * gt, (v1[3] * as + bv[bj][7]) * gt);
                    *(v2u*)(rowp + bj * HALF) = w; } }
    }
};
struct MoeOrder {
    const int* tile_e; int ntiles, nN, G, c;
    __device__ __forceinline__ bool next(int i, Unit& u) const {
        if ((G & 7) == 0) {
            const int x = c & 7, s = i * (G >> 3) + (c >> 3);
            const int cg = nN >> 2, rg = 8 / cg;
            const int ch = x % cg, rc = x / cg;
            const int lr = s >> 2, pl = 4 * ch + (s & 3), pm = rc + rg * lr;
            if (pm >= ntiles) return false;
            u.pm = pm; u.pn = tile_e[pm] * nN + pl; return true;
        }
        const int L = i * G + c; if (L >= ntiles * nN) return false;
        const int pm = L / nN, pl = L - pm * nN; u.pm = pm; u.pn = tile_e[pm] * nN + pl; return true;
    }
    __device__ __forceinline__ void a_ready(const Unit&) const {}
    __device__ __forceinline__ void done(const Unit&) const {}
};
}

template <class RowMap>
__device__ __forceinline__ void transpose_item(const float* W, int ldw, int Nvalid, bf16* WT, int Kdim, RowMap rm, LAS float* scr, int kb, int nb, int lane) {
    const int k0 = 64 * kb, n0 = 32 * nb; const int nl0 = lane & 31, nn = n0 + nl0;
#pragma unroll 8
    for (int i = 0; i < 32; ++i) { const int kk = 2 * i + (lane >> 5); scr[kk * 33 + nl0] = (nn < Nvalid) ? W[(size_t)(k0 + kk) * ldw + nn] : 0.f; }
    LDS_WAIT(); asm volatile("" ::: "memory");
    const int c = lane & 7;
#pragma unroll
    for (int j = 0; j < 4; ++j) { const int n = (lane >> 3) + 8 * j; const LAS float* s = scr + (8 * c) * 33 + n;
        v4u o; o.x = pk2(s[0 * 33], s[1 * 33]); o.y = pk2(s[2 * 33], s[3 * 33]); o.z = pk2(s[4 * 33], s[5 * 33]); o.w = pk2(s[6 * 33], s[7 * 33]);
        *(GAS v4u*)(WT + (size_t)rm(n0 + n) * Kdim + k0 + 8 * c) = o; }
    LDS_WAIT(); asm volatile("" ::: "memory");
}
__device__ __forceinline__ unsigned pk4_fp8(float a, float b, float c, float d) { int r = 0; r = __builtin_amdgcn_cvt_pk_fp8_f32(a, b, r, false); r = __builtin_amdgcn_cvt_pk_fp8_f32(c, d, r, true); return (unsigned)r; }
template <class RowMap>
__device__ __forceinline__ void transpose_item_f8(const float* W, int ldw, unsigned char* WT, int Kdim, RowMap rm, LAS float* scr, int kb, int nb, int lane, float mul) {
    const int k0 = 64 * kb, n0 = 32 * nb; const int nl0 = lane & 31, nn = n0 + nl0;
#pragma unroll 8
    for (int i = 0; i < 32; ++i) { const int kk = 2 * i + (lane >> 5); scr[kk * 33 + nl0] = W[(size_t)(k0 + kk) * ldw + nn] * mul; }
    LDS_WAIT(); asm volatile("" ::: "memory");
    const int c = lane & 7;
#pragma unroll
    for (int j = 0; j < 4; ++j) { const int n = (lane >> 3) + 8 * j; const LAS float* s = scr + (8 * c) * 33 + n;
        v2u o; o.x = pk4_fp8(s[0 * 33], s[1 * 33], s[2 * 33], s[3 * 33]); o.y = pk4_fp8(s[4 * 33], s[5 * 33], s[6 * 33], s[7 * 33]);
        *(GAS v2u*)(WT + (size_t)rm(n0 + n) * Kdim + k0 + 8 * c) = o; }
    LDS_WAIT(); asm volatile("" ::: "memory");
}
struct RmId { __device__ __forceinline__ int operator()(int n) const { return n; } };
struct RmUp { int e; __device__ __forceinline__ int operator()(int n) const { return e * 2048 + ((n & 1023) >> 7) * 256 + (n >> 10) * 128 + (n & 127); } };
struct RmOff { int off; __device__ __forceinline__ int operator()(int n) const { return off + n; } };

struct CvtItem { const float* src; unsigned char* dst; int ldw; };
__device__ __forceinline__ CvtItem cvt_decode(const Params& P, int r) {
    unsigned char* ws = P.ws; CvtItem c;
    constexpr int I_O = 8 * 32, I_UP = 8 * 64, I_DN = 8 * 32;
    if (r < I_O) { const int kb = r / 32, nb = r % 32; c.src = P.in[I_WO] + (size_t)(128 * kb) * 1024 + 32 * nb; c.ldw = 1024; c.dst = ws + WS_WO_T + (size_t)(32 * nb) * 1024 + 128 * kb; return c; } r -= I_O;
    if (r < NE * I_UP) { const int e = r / I_UP, q = r % I_UP, kb = q / 64, nb = q % 64, n0 = 32 * nb; c.src = P.in[I_WUP] + (size_t)e * 1024 * 2048 + (size_t)(128 * kb) * 2048 + n0; c.ldw = 2048;
        c.dst = ws + WS_WUP_T + (size_t)(e * 2048 + ((n0 & 1023) >> 7) * 256 + (n0 >> 10) * 128 + (n0 & 127)) * 1024 + 128 * kb; return c; } r -= NE * I_UP;
    if (r < NE * I_DN) { const int e = r / I_DN, q = r % I_DN, kb = q / 32, nb = q % 32; c.src = P.in[I_WDN] + (size_t)e * 1024 * 1024 + (size_t)(128 * kb) * 1024 + 32 * nb; c.ldw = 1024;
        c.dst = ws + WS_WDN_T + (size_t)(e * 1024 + 32 * nb) * 1024 + 128 * kb; return c; } r -= NE * I_DN;
    { const int kb = r / 32, nb = r % 32; c.src = P.in[I_WPG] + (size_t)(128 * kb) * 1024 + 32 * nb; c.ldw = 1024; c.dst = ws + WS_WGATE_T + (size_t)(32 * nb) * 1024 + 128 * kb; return c; }
}
__device__ __forceinline__ void cvt_load(const CvtItem& c, float (&v)[64], int lane) {
    const float* p = c.src + (size_t)(lane >> 5) * c.ldw + (lane & 31);
#pragma unroll
    for (int i = 0; i < 64; ++i) v[i] = p[(size_t)(2 * i) * c.ldw];
}
__device__ __forceinline__ void cvt_store(const CvtItem& c, const float (&v)[64], LAS float* scr, int lane) {
#pragma unroll
    for (int i = 0; i < 64; ++i) scr[(2 * i + (lane >> 5)) * 33 + (lane & 31)] = v[i] * 64.f;
    LDS_WAIT(); asm volatile("" ::: "memory");
    const int ch = lane & 15;
#pragma unroll
    for (int j = 0; j < 8; ++j) { const int n = (lane >> 4) + 4 * j; const LAS float* s = scr + (8 * ch) * 33 + n;
        v2u o; o.x = pk4_fp8(s[0 * 33], s[1 * 33], s[2 * 33], s[3 * 33]); o.y = pk4_fp8(s[4 * 33], s[5 * 33], s[6 * 33], s[7 * 33]);
        *(GAS v2u*)(c.dst + (size_t)n * 1024 + 8 * ch) = o; }
    LDS_WAIT(); asm volatile("" ::: "memory");
}
__device__ __forceinline__ void convert_late(const Params& P, LAS float* scr, int gwc, int ngwc, int lane) {
    constexpr int NT = 8 * 32 + NE * 8 * 64 + NE * 8 * 32 + 8 * 32;
    float va[64], vb[64];
    int it = gwc;
    if (it < NT) { const CvtItem c = cvt_decode(P, it); cvt_load(c, va, lane); }
    for (; it < NT; it += 2 * ngwc) {
        const int i1 = it + ngwc, i2 = it + 2 * ngwc;
        if (i1 < NT) { const CvtItem c = cvt_decode(P, i1); cvt_load(c, vb, lane); }
        { const CvtItem c = cvt_decode(P, it); cvt_store(c, va, scr, lane); }
        if (i2 < NT) { const CvtItem c = cvt_decode(P, i2); cvt_load(c, va, lane); }
        if (i1 < NT) { const CvtItem c = cvt_decode(P, i1); cvt_store(c, vb, scr, lane); }
    }
    for (int r = gwc; r < 512; r += ngwc) { const int i = r * 64 + lane; const int e = i >> 10, k = i & 1023; ((float*)(P.ws + WS_WRT))[i] = P.in[I_WR][k * 32 + e]; }
}
__device__ __forceinline__ void p0_prologue(const Params& P, const Ctx& C) {
    LAS float* scr = (LAS float*)(C.lds + C.wave * 16384);
    unsigned char* ws = P.ws;
    constexpr int I_IN = 16 * (D_INP / 32), I_PP = 4 * 32, I_UK = 4 * 16, I_UV = 4 * 16;
    constexpr int NITEMS = I_IN + I_PP + I_UK + I_UV;
    for (int it = C.gw; it < NITEMS; it += C.ngw) {
        int r = it;
        if (r < I_IN) { transpose_item(P.in[I_WIN], D_IN, D_IN, (bf16*)(ws + WS_WIN_T), 1024, RmId{}, scr, r / (D_INP / 32), r % (D_INP / 32), C.lane); continue; } r -= I_IN;
        if (r < I_PP) { transpose_item(P.in[I_WPP], 1024, 1024, (bf16*)(ws + WS_WPROJ_T), 256, RmId{}, scr, r / 32, r % 32, C.lane); continue; } r -= I_PP;
        if (r < I_UK) { transpose_item(P.in[I_WUK], 512, 512, (bf16*)(ws + WS_WUK_T), 256, RmId{}, scr, r / 16, r % 16, C.lane); continue; } r -= I_UK;
        transpose_item(P.in[I_WUV], 512, 512, (bf16*)(ws + WS_WUV_T), 256, RmId{}, scr, r / 16, r % 16, C.lane);
    }
    {
        const float* x = P.in[I_X]; bf16* xb = (bf16*)(ws + WS_XBF);
        const size_t n8 = (size_t)NTOK * D / 8, stride = (size_t)C.ngw * 64;
        for (size_t i = (size_t)C.gw * 64 + C.lane; i < n8; i += stride) { const f32x4 a = *(const GAS f32x4*)(x + i * 8), b = *(const GAS f32x4*)(x + i * 8 + 4);
            v4u o; o.x = pk2(a[0], a[1]); o.y = pk2(a[2], a[3]); o.z = pk2(b[0], b[1]); o.w = pk2(b[2], b[3]); *(GAS v4u*)(xb + i * 8) = o; }
        const float* p = P.in[I_P]; bf16* pb = (bf16*)(ws + WS_PB);
        const size_t m8 = (size_t)NTOK * PLE / 8;
        for (size_t i = (size_t)C.gw * 64 + C.lane; i < m8; i += stride) { const f32x4 a = *(const GAS f32x4*)(p + i * 8), b = *(const GAS f32x4*)(p + i * 8 + 4);
            v4u o; o.x = pk2(a[0], a[1]); o.y = pk2(a[2], a[3]); o.z = pk2(b[0], b[1]); o.w = pk2(b[2], b[3]); *(GAS v4u*)(pb + i * 8) = o; }
    }
}

__device__ __forceinline__ void ln_row(f32x4 (&v)[4], const float* g, const float* b, int lane) {
    float s = 0.f;
#pragma unroll
    for (int j = 0; j < 4; ++j) s += (v[j][0] + v[j][1]) + (v[j][2] + v[j][3]);
    const float mean = wave_sum(s) * (1.f / D); float s2 = 0.f;
#pragma unroll
    for (int j = 0; j < 4; ++j) { v[j] = v[j] - mean; s2 += (v[j][0] * v[j][0] + v[j][1] * v[j][1]) + (v[j][2] * v[j][2] + v[j][3] * v[j][3]); }
    const float rstd = __builtin_amdgcn_rsqf(wave_sum(s2) * (1.f / D) + LN_EPS);
#pragma unroll
    for (int j = 0; j < 4; ++j) { const f32x4 gg = *(const f32x4*)(g + 4 * lane + 256 * j), bb = *(const f32x4*)(b + 4 * lane + 256 * j); v[j] = v[j] * rstd * gg + bb; }
}
__device__ __forceinline__ void store_row_f32(float* row, const f32x4 (&v)[4], int lane) {
#pragma unroll
    for (int j = 0; j < 4; ++j) *(GAS f32x4*)(row + 4 * lane + 256 * j) = v[j];
}
__device__ __forceinline__ void store_row_bf16(bf16* row, const f32x4 (&v)[4], int lane) {
#pragma unroll
    for (int j = 0; j < 4; ++j) { v2u o; o.x = pk2(v[j][0], v[j][1]); o.y = pk2(v[j][2], v[j][3]); *(GAS v2u*)(row + 4 * lane + 256 * j) = o; }
}
__device__ __forceinline__ void store_row_fp8x8(unsigned char* row, const f32x4 (&v)[4], int lane) {
#pragma unroll
    for (int j = 0; j < 4; ++j) *(GAS unsigned*)(row + 4 * lane + 256 * j) = pk4_fp8(v[j][0] * 8.f, v[j][1] * 8.f, v[j][2] * 8.f, v[j][3] * 8.f);
}
__device__ __forceinline__ f32x4 fp8x4_to_f32(unsigned w) {
    typedef float f2 __attribute__((ext_vector_type(2)));
    const f2 lo = __builtin_amdgcn_cvt_pk_f32_fp8((int)w, false), hi = __builtin_amdgcn_cvt_pk_f32_fp8((int)w, true);
    return (f32x4){lo[0], lo[1], hi[0], hi[1]};
}
__device__ __forceinline__ void load_row_bf16(f32x4 (&v)[4], const bf16* row, int lane) {
#pragma unroll
    for (int j = 0; j < 4; ++j) { const v2u w = *(const GAS v2u*)(row + 4 * lane + 256 * j); v[j] = (f32x4){bflo(w.x), bfhi(w.x), bflo(w.y), bfhi(w.y)}; }
}
__device__ __forceinline__ void load_row_f32(f32x4 (&v)[4], const float* row, int lane) {
#pragma unroll
    for (int j = 0; j < 4; ++j) v[j] = *(const GAS f32x4*)(row + 4 * lane + 256 * j);
}
#ifndef FEAT_MIX
#define FEAT_MIX 1
#endif
#ifndef FEAT_MOE
#define FEAT_MOE 1
#endif
#ifndef FEAT_PLE
#define FEAT_PLE 1
#endif
#ifndef FEAT_ATT
#define FEAT_ATT 1
#endif
#ifndef SYNC_MODE
#define SYNC_MODE 0
#endif
#ifndef PROGRAM
#define PROGRAM X(0) GS X(10) X(11) SY X(20) X(21) SY X(30) X(31) BS X(32) SY X(40) X(41) SY X(5) SY X(6) SY X(7) SY X(8) SY X(9) SY X(100) SY X(110) SY X(120)
#endif
#ifndef COOP_LAUNCH
#define PLAIN_LAUNCH 1
#endif

typedef float f32x16 __attribute__((ext_vector_type(16)));
typedef short s16x4 __attribute__((ext_vector_type(4)));
__device__ __forceinline__ unsigned cvtpk(float lo, float hi) { typedef float f2 __attribute__((ext_vector_type(2))); typedef __bf16 b2 __attribute__((ext_vector_type(2))); f2 v = {lo, hi}; b2 b = __builtin_convertvector(v, b2); return __builtin_bit_cast(unsigned, b); }
__device__ __forceinline__ bf16x8 pack8(const f32x16& x, int base) {
    v4u w; w.x = cvtpk(x[base + 0], x[base + 1]); w.y = cvtpk(x[base + 2], x[base + 3]); w.z = cvtpk(x[base + 4], x[base + 5]); w.w = cvtpk(x[base + 6], x[base + 7]);
    return __builtin_bit_cast(bf16x8, w);
}

__device__ __forceinline__ void p2_post(const Params& P, const Ctx& C) {
    unsigned char* ws = P.ws;
    const bf16* H = (const bf16*)(ws + WS_H); bf16* CN = (bf16*)(ws + WS_CN); bf16* IKN = (bf16*)(ws + WS_IKN);
    const float* kvg = P.in[I_KVG]; const float* ikg = P.in[I_IKG]; const float* ikb = P.in[I_IKB];
    const f32x4 g4 = *(const f32x4*)(kvg + 4 * C.lane); const float ig = ikg[C.lane], ib = ikb[C.lane];
    for (int m = C.gw; m < NTOK; m += C.ngw) {
        const bf16* hr = H + (size_t)m * D_INP;
        const v2u w = *(const GAS v2u*)(hr + C_AC + 4 * C.lane);
        float a0 = bflo(w.x), a1 = bfhi(w.x), a2 = bflo(w.y), a3 = bfhi(w.y);
        const float ss = wave_sum((a0 * a0 + a1 * a1) + (a2 * a2 + a3 * a3));
        const float rs = __builtin_amdgcn_rsqf(ss * (1.f / 256.f) + RMS_EPS);
        v2u o; o.x = pk2(a0 * rs * g4[0], a1 * rs * g4[1]); o.y = pk2(a2 * rs * g4[2], a3 * rs * g4[3]);
        *(GAS v2u*)(CN + (size_t)m * 256 + 4 * C.lane) = o;
        const float k = bf2f(hr[C_IK + C.lane]);
        const float mu = wave_sum(k) * (1.f / 64.f); const float dk = k - mu;
        const float var = wave_sum(dk * dk) * (1.f / 64.f);
        IKN[(size_t)m * 64 + C.lane] = (bf16)f2bf(dk * __builtin_amdgcn_rsqf(var + LN_EPS) * ig + ib);
    }
}

constexpr int HP_QD = 0, HP_KI = 8704, HP_KET = 17408, HP_VT = 27648, HP_GS = 37888, HP_RAW = 40960;
__device__ __forceinline__ void p2_hgrn_prep(const Params& P, const Ctx& C) {
    unsigned char* ws = P.ws;
    const bf16* H = (const bf16*)(ws + WS_H);
    bf16* UT = (bf16*)(ws + WS_U); bf16* QDEC = (bf16*)(ws + WS_QDEC); float* OREC = (float*)(ws + WS_OREC); float* DEC = (float*)(ws + WS_DECAY);
    LAS bf16* QD = (LAS bf16*)(C.lds + HP_QD); LAS bf16* KI = (LAS bf16*)(C.lds + HP_KI); LAS bf16* KET = (LAS bf16*)(C.lds + HP_KET); LAS bf16* VT = (LAS bf16*)(C.lds + HP_VT);
    LAS float* GS = (LAS float*)(C.lds + HP_GS); LAS bf16* RAW = (LAS bf16*)(C.lds + HP_RAW);
    const int d = C.tid & 127, tg = C.tid >> 7;
    const int lane = C.lane, r32 = lane & 31, hf = lane >> 5;
    const int lc = C.tid >> 4, lg = C.tid & 15;
    const int NU = NB * HG_H * (T / HG_C);
    v4u rf, rq, ri;
    { const int unit = blockIdx.x; if (unit < NU) { const int n = unit & 127, hh = (unit >> 7) & 3, b = unit >> 9; const bf16* hr = H + (size_t)(b * T + n * HG_C + lc) * D_INP + hh * 128 + 8 * lg;
        rf = *(const GAS v4u*)(hr + C_GF); rq = *(const GAS v4u*)(hr + C_GQ); ri = *(const GAS v4u*)(hr + C_GI); } }
    for (int unit = blockIdx.x; unit < NU; unit += C.G) {
        const int n = unit & 127, hh = (unit >> 7) & 3, b = unit >> 9;
        const int m0 = b * T + n * HG_C;
        *(LAS v4u*)(RAW + lc * 128 + 8 * lg) = rf; *(LAS v4u*)(RAW + 4096 + lc * 128 + 8 * lg) = rq; *(LAS v4u*)(RAW + 8192 + lc * 128 + 8 * lg) = ri;
        __syncthreads();
        { const int un = unit + C.G; if (un < NU) { const int n2 = un & 127, h2 = (un >> 7) & 3, b2 = un >> 9; const bf16* hr = H + (size_t)(b2 * T + n2 * HG_C + lc) * D_INP + h2 * 128 + 8 * lg;
            rf = *(const GAS v4u*)(hr + C_GF); rq = *(const GAS v4u*)(hr + C_GQ); ri = *(const GAS v4u*)(hr + C_GI); } }
        const float l0 = P.in[I_HGLB][hh * 128 + d], l1 = P.in[I_HGLB][512 + hh * 128 + d];
        const float lb = sigmoidf_(l0 - l1);
        float fg[8], bl[8], qv[8]; float run = 0.f; unsigned vv[4];
#pragma unroll
        for (int c = 0; c < 8; ++c) { const int tok = tg * 8 + c;
            const float f = bf2f(RAW[tok * 128 + d]), q = bf2f(RAW[4096 + tok * 128 + d]); const unsigned iv = RAW[8192 + tok * 128 + d];
            fg[c] = lb + (1.f - lb) * sigmoidf_(f); run += __logf(fg[c]); bl[c] = run; qv[c] = q * sigmoidf_(q);
            if (c & 1) vv[c >> 1] |= iv << 16; else vv[c >> 1] = iv; }
        GS[tg * 128 + d] = run;
        *(LAS v4u*)(VT + d * 40 + tg * 8) = (v4u){vv[0], vv[1], vv[2], vv[3]};
        __syncthreads();
        float pre = 0.f, tot = 0.f;
#pragma unroll
        for (int g = 0; g < 4; ++g) { const float sg = GS[g * 128 + d]; tot += sg; if (g < tg) pre += sg; }
        unsigned ke[4];
#pragma unroll
        for (int c = 0; c < 8; ++c) { const float bc = pre + bl[c]; const float kc = 1.f - fg[c];
            const float qd = qv[c] * __expf(bc), ki = kc * __expf(-bc), kend = kc * __expf(tot - bc);
            const unsigned qb = f2bf(qd);
            QD[(tg * 8 + c) * 136 + d] = (bf16)qb; KI[(tg * 8 + c) * 136 + d] = (bf16)f2bf(ki);
            if (c & 1) ke[c >> 1] |= f2bf(kend) << 16; else ke[c >> 1] = f2bf(kend); }
        *(LAS v4u*)(KET + d * 40 + tg * 8) = (v4u){ke[0], ke[1], ke[2], ke[3]};
        if (tg == 0) DEC[(size_t)unit * 128 + d] = __expf(tot);
        __syncthreads();
        *(GAS v4u*)(QDEC + (size_t)(m0 + lc) * 512 + hh * 128 + 8 * lg) = *(const LAS v4u*)(QD + lc * 136 + 8 * lg);
        if (C.wave < 4) {
            f32x16 X = {0.f, 0.f, 0.f, 0.f, 0.f, 0.f, 0.f, 0.f, 0.f, 0.f, 0.f, 0.f, 0.f, 0.f, 0.f, 0.f};
#pragma unroll
            for (int k = 0; k < 8; ++k) { const bf16x8 a = *(const LAS bf16x8*)(KI + r32 * 136 + 16 * k + 8 * hf), bq = *(const LAS bf16x8*)(QD + r32 * 136 + 16 * k + 8 * hf);
                X = __builtin_amdgcn_mfma_f32_32x32x16_bf16(a, bq, X, 0, 0, 0); }
#pragma unroll
            for (int r = 0; r < 16; ++r) { const int sidx = (r & 3) + 8 * (r >> 2) + 4 * hf; if (sidx > r32) X[r] = 0.f; }
            f32x16 Z = {0.f, 0.f, 0.f, 0.f, 0.f, 0.f, 0.f, 0.f, 0.f, 0.f, 0.f, 0.f, 0.f, 0.f, 0.f, 0.f};
            const int e = C.wave * 32 + r32;
#pragma unroll
            for (int sp = 0; sp < 2; ++sp) { const bf16x8 a = pack8(X, 8 * sp);
                const s16x4 lo = *(const LAS s16x4*)(VT + e * 40 + 16 * sp + 4 * hf), hi = *(const LAS s16x4*)(VT + e * 40 + 16 * sp + 8 + 4 * hf);
                const bf16x8 bv = (bf16x8){lo[0], lo[1], lo[2], lo[3], hi[0], hi[1], hi[2], hi[3]};
                Z = __builtin_amdgcn_mfma_f32_32x32x16_bf16(a, bv, Z, 0, 0, 0); }
#pragma unroll
            for (int r = 0; r < 16; ++r) { const int c = (r & 3) + 8 * (r >> 2) + 4 * hf; OREC[(size_t)(m0 + c) * 512 + hh * 128 + e] = Z[r]; }
        }
        {
            const int dt = C.wave >> 1;
            const bf16x8 a0 = *(const LAS bf16x8*)(KET + (dt * 32 + r32) * 40 + 8 * hf), a1 = *(const LAS bf16x8*)(KET + (dt * 32 + r32) * 40 + 16 + 8 * hf);
#pragma unroll
            for (int ei = 0; ei < 2; ++ei) { const int et = 2 * (C.wave & 1) + ei;
                const bf16x8 b0 = *(const LAS bf16x8*)(VT + (et * 32 + r32) * 40 + 8 * hf), b1 = *(const LAS bf16x8*)(VT + (et * 32 + r32) * 40 + 16 + 8 * hf);
                f32x16 U = {0.f, 0.f, 0.f, 0.f, 0.f, 0.f, 0.f, 0.f, 0.f, 0.f, 0.f, 0.f, 0.f, 0.f, 0.f, 0.f};
                U = __builtin_amdgcn_mfma_f32_32x32x16_bf16(a0, b0, U, 0, 0, 0); U = __builtin_amdgcn_mfma_f32_32x32x16_bf16(a1, b1, U, 0, 0, 0);
                bf16* up = UT + (size_t)unit * 16384 + (size_t)(et * 32 + r32) * 128 + dt * 32 + 4 * hf;
#pragma unroll
                for (int q = 0; q < 4; ++q) { v2u o; o.x = cvtpk(U[4 * q], U[4 * q + 1]); o.y = cvtpk(U[4 * q + 2], U[4 * q + 3]); *(GAS v2u*)(up + 8 * q) = o; } }
        }
        __syncthreads();
    }
}

__device__ __forceinline__ void scan_wave(const Params& P, LAS unsigned char* lds, int unit, int lane) {
    unsigned char* ws = P.ws;
    const bf16* UT = (const bf16*)(ws + WS_U); const bf16* QDEC = (const bf16*)(ws + WS_QDEC); float* OREC = (float*)(ws + WS_OREC); const float* DEC = (const float*)(ws + WS_DECAY);
    typedef float f32x4v __attribute__((ext_vector_type(4)));
    const int xcd = (unit >> 1) & 7, loc = ((unit >> 4) << 1) | (unit & 1);
    const int bh = xcd + 8 * (loc >> 4), sl = loc & 15; const int b = bh >> 2, hh = bh & 3, e0 = 8 * sl;
    LAS bf16* ST = (LAS bf16*)lds;
    const int e = lane & 7, dq = lane >> 3;
    const int fr = lane & 15, fq = lane >> 4;
    float S[16];
#pragma unroll
    for (int i = 0; i < 16; ++i) S[i] = 0.f;
    for (int i = lane; i < 2 * 16 * 136 / 8; i += 64) *(LAS v4u*)(ST + 8 * i) = (v4u){0u, 0u, 0u, 0u};
    const int cu0 = (b * HG_H + hh) * 128;
    const bf16* up = UT + (size_t)cu0 * 16384 + (size_t)(e0 + e) * 128 + 16 * dq;
    const float* dp = DEC + (size_t)cu0 * 128 + 16 * dq;
    const bf16* qp = QDEC + (size_t)(b * T + fr) * 512 + hh * 128 + 8 * fq;
    float* op = OREC + (size_t)(b * T + 4 * fq) * 512 + hh * 128 + e0 + fr;
    const float* opl = OREC + (size_t)(b * T + 4 * fq) * 512 + hh * 128 + e0 + (fr & 7);
    const bool ov = fr < 8;
    v4u un[4][2]; float oi[4][2][4]; f32x4 dn[2][4]; bf16x8 qa[2][2][4];
#define SC_LD_U(slot, n) { un[slot][0] = *(const GAS v4u*)(up + (size_t)(n) * 16384); un[slot][1] = *(const GAS v4u*)(up + (size_t)(n) * 16384 + 8); \
        _Pragma("unroll") for (int t_ = 0; t_ < 2; ++t_) _Pragma("unroll") for (int j_ = 0; j_ < 4; ++j_) oi[slot][t_][j_] = opl[(size_t)((n) * 32 + 16 * t_ + j_) * 512]; }
#define SC_LD_Q(slot, n) { _Pragma("unroll") for (int i_ = 0; i_ < 4; ++i_) dn[slot][i_] = *(const GAS f32x4*)(dp + (size_t)(n) * 128 + 4 * i_); \
        _Pragma("unroll") for (int t_ = 0; t_ < 2; ++t_) _Pragma("unroll") for (int k_ = 0; k_ < 4; ++k_) qa[slot][t_][k_] = *(const GAS bf16x8*)(qp + (size_t)((n) * 32 + 16 * t_) * 512 + 32 * k_); }
    SC_LD_U(0, 0) SC_LD_U(1, 1) SC_LD_U(2, 2) SC_LD_U(3, 3) SC_LD_Q(0, 0) SC_LD_Q(1, 1)
    LDS_WAIT();
    for (int nb = 0; nb < 32; ++nb) {
#pragma unroll
        for (int s = 0; s < 4; ++s) {
            const int n = 4 * nb + s; const int su = s, sq = s & 1;
            const LAS bf16* stc = ST + (n & 1) * (16 * 136); LAS bf16* stn = ST + ((n + 1) & 1) * (16 * 136);
            bf16x8 bs[4];
#pragma unroll
            for (int k = 0; k < 4; ++k) bs[k] = *(const LAS bf16x8*)(stc + fr * 136 + 32 * k + 8 * fq);
#pragma unroll
            for (int t = 0; t < 2; ++t) { f32x4v acc = {oi[su][t][0], oi[su][t][1], oi[su][t][2], oi[su][t][3]};
#pragma unroll
                for (int k = 0; k < 4; ++k) acc = __builtin_amdgcn_mfma_f32_16x16x32_bf16(qa[sq][t][k], bs[k], acc, 0, 0, 0);
                if (ov) {
#pragma unroll
                    for (int j = 0; j < 4; ++j) op[(size_t)(n * 32 + 16 * t + j) * 512] = acc[j]; } }
            {
                const unsigned uw[8] = {un[su][0].x, un[su][0].y, un[su][0].z, un[su][0].w, un[su][1].x, un[su][1].y, un[su][1].z, un[su][1].w};
                unsigned pk[8];
#pragma unroll
                for (int i = 0; i < 8; ++i) { S[2 * i] = dn[sq][i >> 1][(2 * i) & 3] * S[2 * i] + bflo(uw[i]); S[2 * i + 1] = dn[sq][i >> 1][(2 * i + 1) & 3] * S[2 * i + 1] + bfhi(uw[i]); pk[i] = cvtpk(S[2 * i], S[2 * i + 1]); }
                *(LAS v4u*)(stn + e * 136 + 16 * dq) = (v4u){pk[0], pk[1], pk[2], pk[3]}; *(LAS v4u*)(stn + e * 136 + 16 * dq + 8) = (v4u){pk[4], pk[5], pk[6], pk[7]};
            }
            if (n + 4 < 128) SC_LD_U(su, n + 4)
            if (n + 2 < 128) SC_LD_Q(sq, n + 2)
        }
    }
#undef SC_LD_U
#undef SC_LD_Q
}
__device__ __forceinline__ void p3_scan_convert(const Params& P, const Ctx& C) {
    if (C.wave < 2) {
        for (int u = blockIdx.x * 2 + C.wave; u < NB * HG_H * 16; u += C.G * 2) scan_wave(P, C.lds + C.wave * 8704, u, C.lane);
    } else {
        convert_late(P, (LAS float*)(C.lds + 32768 + (C.wave - 2) * 17408), blockIdx.x * 6 + (C.wave - 2), C.G * 6, C.lane);
    }
}

__device__ __forceinline__ void p4_yrec(const Params& P, const Ctx& C) {
    unsigned char* ws = P.ws;
    const float* OREC = (const float*)(ws + WS_OREC); const bf16* H = (const bf16*)(ws + WS_H); bf16* YM = (bf16*)(ws + WS_YMIX);
    const float* ng = P.in[I_HGNG];
    const f32x4 g0 = *(const f32x4*)(ng + 8 * C.lane), g1 = *(const f32x4*)(ng + 8 * C.lane + 4);
    for (int m = C.gw; m < NTOK; m += C.ngw) {
        const f32x4 a = *(const GAS f32x4*)(OREC + (size_t)m * 512 + 8 * C.lane), bq = *(const GAS f32x4*)(OREC + (size_t)m * 512 + 8 * C.lane + 4);
        float ss = (a[0] * a[0] + a[1] * a[1]) + (a[2] * a[2] + a[3] * a[3]) + (bq[0] * bq[0] + bq[1] * bq[1]) + (bq[2] * bq[2] + bq[3] * bq[3]);
        ss += __shfl_xor(ss, 1); ss += __shfl_xor(ss, 2); ss += __shfl_xor(ss, 4); ss += __shfl_xor(ss, 8);
        const float rs = __builtin_amdgcn_rsqf(ss * (1.f / 128.f) + RMS_EPS);
        const v4u gw = *(const GAS v4u*)(H + (size_t)m * D_INP + C_GG + 8 * C.lane);
        float gv[8] = {bflo(gw.x), bfhi(gw.x), bflo(gw.y), bfhi(gw.y), bflo(gw.z), bfhi(gw.z), bflo(gw.w), bfhi(gw.w)};
        float o[8];
#pragma unroll
        for (int j = 0; j < 4; ++j) { o[j] = a[j] * rs * g0[j] * (gv[j] * sigmoidf_(gv[j])); o[4 + j] = bq[j] * rs * g1[j] * (gv[4 + j] * sigmoidf_(gv[4 + j])); }
        v2u w; w.x = pk4_fp8(o[0] * 8.f, o[1] * 8.f, o[2] * 8.f, o[3] * 8.f); w.y = pk4_fp8(o[4] * 8.f, o[5] * 8.f, o[6] * 8.f, o[7] * 8.f);
        *(GAS v2u*)((unsigned char*)YM + (size_t)m * D + 512 + 8 * C.lane) = w;
#if !FEAT_ATT
        *(GAS v4u*)(YM + (size_t)m * D + 8 * C.lane) = (v4u){0u, 0u, 0u, 0u};
#endif
    }
}

namespace pg8 {
struct EpiKhead {
    static constexpr bool PERM = true, AFTER_DRAIN = false;
    bf16_t* O;
    __device__ __forceinline__ void operator()(const f32x4 (&acc)[2][2][4][2], const Unit& u, int wr, int wc, int fr, int fq) const {
        const int row0 = u.pm * BM + wr * 64 + fr, col0 = u.pn * BM + wc * 32 + 8 * fq;
#pragma unroll
        for (int ai = 0; ai < 2; ++ai)
#pragma unroll
            for (int m = 0; m < 4; ++m) { const int row = row0 + ai * HALF + m * 16; const int b = row >> 12, t = row & 4095;
#pragma unroll
                for (int bj = 0; bj < 2; ++bj) { const int col = col0 + bj * HALF; const f32x4 v0 = acc[ai][bj][m][0], v1 = acc[ai][bj][m][1];
                    u32x4 w; w.x = cvt_pk_bf16(v0[0], v0[1]); w.y = cvt_pk_bf16(v0[2], v0[3]); w.z = cvt_pk_bf16(v1[0], v1[1]); w.w = cvt_pk_bf16(v1[2], v1[3]);
                    *(u32x4*)(O + ((size_t)((b * 8 + (col >> 6)) * 4096 + t)) * 64 + (col & 63)) = w; } }
    }
};
struct EpiVt {
    static constexpr bool PERM = true, AFTER_DRAIN = false;
    bf16_t* O;
    __device__ __forceinline__ void operator()(const f32x4 (&acc)[2][2][4][2], const Unit& u, int wr, int wc, int fr, int fq) const {
        const int row0 = u.pm * BM + wr * 64 + fr, col0 = u.pn * BM + wc * 32 + 8 * fq;
#pragma unroll
        for (int ai = 0; ai < 2; ++ai)
#pragma unroll
            for (int m = 0; m < 4; ++m) { const int row = row0 + ai * HALF + m * 16;
#pragma unroll
                for (int bj = 0; bj < 2; ++bj) { const int col = col0 + bj * HALF; const int b = col >> 12, t = col & 4095; const f32x4 v0 = acc[ai][bj][m][0], v1 = acc[ai][bj][m][1];
                    u32x4 w; w.x = cvt_pk_bf16(v0[0], v0[1]); w.y = cvt_pk_bf16(v0[2], v0[3]); w.z = cvt_pk_bf16(v1[0], v1[1]); w.w = cvt_pk_bf16(v1[2], v1[3]);
                    *(u32x4*)(O + ((size_t)(b * 512 + row)) * 4096 + t) = w; } }
    }
};
}

__device__ __forceinline__ unsigned f2ord(float x) { const unsigned b = __builtin_bit_cast(unsigned, x); return b ^ ((unsigned)((int)b >> 31) | 0x80000000u); }
typedef _Float16 h16;
typedef _Float16 h16x8 __attribute__((ext_vector_type(8)));
__device__ __forceinline__ float relu_i(float x) { const int b = __builtin_bit_cast(int, x); return __builtin_bit_cast(float, b > 0 ? b : 0); }
__device__ __forceinline__ unsigned h2ord(unsigned hb) { return (hb ^ ((hb & 0x8000u) ? 0xffffu : 0x8000u)) & 0xffffu; }
__device__ __forceinline__ int isc_bucket(float x, float mu, float scale) { const float t = fminf(fmaxf(fmaf(x - mu, scale, 128.f), 0.f), 255.f); return (int)t; }
__device__ __forceinline__ void p3_indexer(const Params& P, const Ctx& C) {
    unsigned char* ws = P.ws;
    const bf16* H = (const bf16*)(ws + WS_H); const bf16* IKN = (const bf16*)(ws + WS_IKN); unsigned* MASK = (unsigned*)(ws + WS_MASK);
    LAS h16* ISC = (LAS h16*)C.lds; LAS unsigned* HIST = (LAS unsigned*)(C.lds + 131072) + C.wave * 256; LAS float* STAT = (LAS float*)(C.lds + 139264); LAS float* W16 = (LAS float*)(C.lds + 140288);
    const int lane = C.lane, r32 = lane & 31, hf = lane >> 5;
    const int ql = 2 * (r32 >> 4) + ((r32 >> 2) & 1), hd = 4 * ((r32 >> 3) & 1) + (r32 & 3);
    constexpr int CAND_CAP = 120, QU = 16;
    for (int u = blockIdx.x; u < NTOK / QU; u += C.G) {
        const int b = u & 7, j = (u >> 3) & 31, i = u >> 8; const int pi = i >> 1; const int blk = (i & 1) ? (255 - (j + 32 * pi)) : (j + 32 * pi);
        const int t0 = blk * QU; const size_t mb = (size_t)b * T;
        const int nkt = (t0 + QU + 31) >> 5;
        bf16x8 af[4][4];
#pragma unroll
        for (int a = 0; a < 4; ++a) {
            const bf16* qp = H + (mb + t0 + 4 * a + ql) * D_INP + C_IQ + hd * 64 + 8 * hf;
#pragma unroll
            for (int k = 0; k < 4; ++k) af[a][k] = *(const GAS bf16x8*)(qp + 16 * k);
        }
        if (C.tid < 128) { const int q = C.tid >> 3, h8 = C.tid & 7; W16[C.tid] = bf2f(H[(mb + t0 + q) * D_INP + C_IW + h8]) * (0.125f * 0.35355339059327373f); }
        __syncthreads();
        {
            int kt = C.wave; bf16x8 bk[4], bn[4];
            if (kt < nkt) { const bf16* kp = IKN + (mb + kt * 32 + r32) * 64 + 8 * hf;
#pragma unroll
                for (int k = 0; k < 4; ++k) bk[k] = *(const GAS bf16x8*)(kp + 16 * k); }
            for (; kt < nkt; kt += NWAVES) {
                const int s0 = kt * 32;
                if (kt + NWAVES < nkt) { const bf16* kp = IKN + (mb + s0 + 32 * NWAVES + r32) * 64 + 8 * hf;
#pragma unroll
                    for (int k = 0; k < 4; ++k) bn[k] = *(const GAS bf16x8*)(kp + 16 * k); }
#pragma unroll
                for (int a = 0; a < 4; ++a) {
                    f32x16 acc = {0.f, 0.f, 0.f, 0.f, 0.f, 0.f, 0.f, 0.f, 0.f, 0.f, 0.f, 0.f, 0.f, 0.f, 0.f, 0.f};
#pragma unroll
                    for (int k = 0; k < 4; ++k) acc = __builtin_amdgcn_mfma_f32_32x32x16_bf16(af[a][k], bk[k], acc, 0, 0, 0);
#pragma unroll
                    for (int qh = 0; qh < 2; ++qh) { float sa = 0.f, sb = 0.f;
                        const int q = 4 * a + 2 * qh + hf, key = s0 + r32;
                        const f32x4 wl = *(const LAS f32x4*)(W16 + q * 8), wh = *(const LAS f32x4*)(W16 + q * 8 + 4);
                        sa = fmaf(wl[0], relu_i(acc[8 * qh + 0]), sa); sb = fmaf(wl[1], relu_i(acc[8 * qh + 1]), sb); sa = fmaf(wl[2], relu_i(acc[8 * qh + 2]), sa); sb = fmaf(wl[3], relu_i(acc[8 * qh + 3]), sb);
                        sa = fmaf(wh[0], relu_i(acc[8 * qh + 4]), sa); sb = fmaf(wh[1], relu_i(acc[8 * qh + 5]), sb); sa = fmaf(wh[2], relu_i(acc[8 * qh + 6]), sa); sb = fmaf(wh[3], relu_i(acc[8 * qh + 7]), sb);
                        float sv = sa + sb; const bool valid = key <= t0 + q; sv += 0.0f;
                        ISC[q * 4096 + key] = valid ? (h16)sv : (h16)(-INFINITY);
                    }
                }
#pragma unroll
                for (int k = 0; k < 4; ++k) bk[k] = bn[k];
            }
        }
        __syncthreads();
#ifdef PROBE_SEL
        for (int rep_ = 0; rep_ < 2; ++rep_)
#endif
        {
            const LAS unsigned short* row[2]; int tq[2], nq[2]; unsigned* mrow[2];
#pragma unroll
            for (int z = 0; z < 2; ++z) { const int q = C.wave + 8 * z; row[z] = (const LAS unsigned short*)(ISC + q * 4096); tq[z] = t0 + q; nq[z] = tq[z] + 1; mrow[z] = MASK + (mb + tq[z]) * 128; }
            const int nmax = nq[1];
            unsigned dhi[2] = {0u, 0u}; int need[2];
#pragma unroll
            for (int z = 0; z < 2; ++z) need[z] = nq[z] < TOPK ? nq[z] : TOPK;
#pragma unroll
            for (int pass = 1; pass >= 0; --pass) {
                LDS_WAIT();
#pragma unroll
                for (int zz = 0; zz < 4; ++zz) HIST[lane + 64 * zz] = 0u;
                for (int e0 = 8 * lane; e0 < nmax; e0 += 512) {
                    v4u v[2];
#pragma unroll
                    for (int z = 0; z < 2; ++z) v[z] = *(const LAS v4u*)(row[z] + e0);
#pragma unroll
                    for (int z = 0; z < 2; ++z)
#pragma unroll
                        for (int jj = 0; jj < 8; ++jj) { const unsigned w = (jj < 2) ? v[z].x : (jj < 4) ? v[z].y : (jj < 6) ? v[z].z : v[z].w; const unsigned hb = (jj & 1) ? (w >> 16) : (w & 0xffffu);
                            const unsigned key = h2ord(hb); const unsigned bin = pass == 1 ? (key >> 8) : (key & 255u);
                            const bool ok = (e0 + jj < nq[z]) && (pass == 1 || (key >> 8) == dhi[z]);
                            if (ok) atomicAdd((unsigned*)&HIST[128 * z + (bin >> 1)], 1u << (16 * (bin & 1u))); }
                }
                LDS_WAIT();
                unsigned c[2][4], s4[2], suf[2];
#pragma unroll
                for (int z = 0; z < 2; ++z) { const v2u w2 = *(const LAS v2u*)(HIST + 128 * z + 2 * lane); c[z][0] = w2.x & 0xffffu; c[z][1] = w2.x >> 16; c[z][2] = w2.y & 0xffffu; c[z][3] = w2.y >> 16; s4[z] = c[z][0] + c[z][1] + c[z][2] + c[z][3]; suf[z] = s4[z]; }
#pragma unroll
                for (int o = 1; o < 64; o <<= 1) {
#pragma unroll
                    for (int z = 0; z < 2; ++z) { const unsigned v2 = __shfl_down(suf[z], o); if (lane + o < 64) suf[z] += v2; } }
#pragma unroll
                for (int z = 0; z < 2; ++z) { unsigned cum = suf[z] - s4[z]; int dsel = -1; int nnew = 0; const unsigned nd = (unsigned)need[z];
#pragma unroll
                    for (int bb = 3; bb >= 0; --bb) { if (dsel < 0 && cum < nd && nd <= cum + c[z][bb]) { dsel = 4 * lane + bb; nnew = (int)(nd - cum); } cum += c[z][bb]; }
                    const unsigned long long bal = __ballot(dsel >= 0);
                    const int src = (bal != 0ull) ? (int)__builtin_ctzll(bal) : 0;
                    const int dd = __shfl(dsel, src); need[z] = __shfl(nnew, src);
                    if (pass == 1) dhi[z] = (unsigned)dd; else dhi[z] = (dhi[z] << 8) | (unsigned)dd; }
            }
            int run_eq[2] = {0, 0}; unsigned long long mine[2] = {0ull, 0ull}; const int nit = (tq[1] >> 6) + 1;
            const unsigned long long ltm = (1ull << lane) - 1ull;
#pragma unroll 2
            for (int it = 0; it < nit; ++it) { const int e = it * 64 + lane;
#pragma unroll
                for (int z = 0; z < 2; ++z) { const unsigned key = h2ord(row[z][e]); const bool valid = e <= tq[z];
                    const bool eq = valid && (key == dhi[z]); const unsigned long long beq = __ballot(eq);
                    const int rk = run_eq[z] + __builtin_popcountll(beq & ltm);
                    const bool sel = valid && ((key > dhi[z]) || (eq && rk < need[z])); run_eq[z] += __builtin_popcountll(beq);
                    const unsigned long long bs = __ballot(sel);
                    if (lane == it) mine[z] = bs; } }
#pragma unroll
            for (int z = 0; z < 2; ++z) *(GAS v2u*)(mrow[z] + 2 * lane) = (v2u){(unsigned)mine[z], (unsigned)(mine[z] >> 32)};
        }
        __syncthreads();
    }
}

__device__ __forceinline__ void attn_task(const bf16* H, const bf16* KH, const bf16* VT, const unsigned* MASK, bf16* YM, int b, int hh, int t0, int lane) {
    const int r32 = lane & 31, hf = lane >> 5;
    const float LOG2E = 1.4426950408889634f; const float c1 = 0.125f * LOG2E; const float sl2 = exp2f(-(float)(hh + 1)) * LOG2E;
    const size_t mb = (size_t)b * T;
    bf16x8 qf[4];
#pragma unroll
    for (int k = 0; k < 4; ++k) qf[k] = *(const GAS bf16x8*)(H + (mb + t0 + r32) * D_INP + C_AQ + hh * 64 + 16 * k + 8 * hf);
    const bf16* kbase = KH + ((size_t)(b * 8 + hh) * T) * 64; const bf16* vbase = VT + ((size_t)(b * 512 + hh * 64)) * T; const unsigned* mrow = MASK + (mb + t0 + r32) * 128;
    float m_run = -1e30f, l = 0.f;
    f32x16 O0 = {0.f, 0.f, 0.f, 0.f, 0.f, 0.f, 0.f, 0.f, 0.f, 0.f, 0.f, 0.f, 0.f, 0.f, 0.f, 0.f}, O1 = O0;
    const int nkt = (t0 + 32 + 63) >> 6;
    for (int kt = 0; kt < nkt; ++kt) {
        const int s0 = kt * 64;
        bf16x8 kf[2][4];
#pragma unroll
        for (int uu = 0; uu < 2; ++uu)
#pragma unroll
            for (int k = 0; k < 4; ++k) kf[uu][k] = *(const GAS bf16x8*)(kbase + (size_t)(s0 + 32 * uu + r32) * 64 + 16 * k + 8 * hf);
        const v2u mw = *(const GAS v2u*)(mrow + 2 * kt);
        s16x4 vl[2][2][2], vh[2][2][2];
#pragma unroll
        for (int uu = 0; uu < 2; ++uu)
#pragma unroll
            for (int sp = 0; sp < 2; ++sp)
#pragma unroll
                for (int dt = 0; dt < 2; ++dt) { const bf16* vp = vbase + (size_t)(dt * 32 + r32) * T + s0 + 32 * uu + 16 * sp + 4 * hf;
                    vl[uu][sp][dt] = *(const GAS s16x4*)vp; vh[uu][sp][dt] = *(const GAS s16x4*)(vp + 8); }
        f32x16 a0 = {0.f, 0.f, 0.f, 0.f, 0.f, 0.f, 0.f, 0.f, 0.f, 0.f, 0.f, 0.f, 0.f, 0.f, 0.f, 0.f}, a1 = a0;
#pragma unroll
        for (int k = 0; k < 4; ++k) { a0 = __builtin_amdgcn_mfma_f32_32x32x16_bf16(kf[0][k], qf[k], a0, 0, 0, 0); a1 = __builtin_amdgcn_mfma_f32_32x32x16_bf16(kf[1][k], qf[k], a1, 0, 0, 0); }
        const float dist0 = (float)(t0 + r32 - s0 - 4 * hf);
        const unsigned m0 = mw.x >> (4 * hf), m1 = mw.y >> (4 * hf);
        float mx = -1e30f;
#pragma unroll
        for (int r = 0; r < 16; ++r) { const int ko = (r & 3) + 8 * (r >> 2);
            const float d0 = dist0 - (float)ko;
            a0[r] = ((m0 >> ko) & 1u) ? (a0[r] * c1 - sl2 * d0) : -1e30f;
            a1[r] = ((m1 >> ko) & 1u) ? (a1[r] * c1 - sl2 * (d0 - 32.f)) : -1e30f;
            mx = fmaxf(mx, fmaxf(a0[r], a1[r])); }
        mx = fmaxf(mx, __shfl_xor(mx, 32));
        const float m_new = fmaxf(m_run, mx); const float alpha = __builtin_amdgcn_exp2f(m_run - m_new); m_run = m_new;
        float ps = 0.f;
#pragma unroll
        for (int r = 0; r < 16; ++r) { const int ko = (r & 3) + 8 * (r >> 2);
            const float p0 = ((m0 >> ko) & 1u) ? __builtin_amdgcn_exp2f(a0[r] - m_new) : 0.f;
            const float p1 = ((m1 >> ko) & 1u) ? __builtin_amdgcn_exp2f(a1[r] - m_new) : 0.f;
            a0[r] = p0; a1[r] = p1; ps += p0 + p1; }
        l = l * alpha + ps;
#pragma unroll
        for (int r = 0; r < 16; ++r) { O0[r] *= alpha; O1[r] *= alpha; }
#pragma unroll
        for (int sp = 0; sp < 2; ++sp) {
            const bf16x8 pb0 = pack8(a0, 8 * sp), pb1 = pack8(a1, 8 * sp);
#define VFR(uu, dt) ((bf16x8){vl[uu][sp][dt][0], vl[uu][sp][dt][1], vl[uu][sp][dt][2], vl[uu][sp][dt][3], vh[uu][sp][dt][0], vh[uu][sp][dt][1], vh[uu][sp][dt][2], vh[uu][sp][dt][3]})
            O0 = __builtin_amdgcn_mfma_f32_32x32x16_bf16(VFR(0, 0), pb0, O0, 0, 0, 0);
            O1 = __builtin_amdgcn_mfma_f32_32x32x16_bf16(VFR(0, 1), pb0, O1, 0, 0, 0);
            O0 = __builtin_amdgcn_mfma_f32_32x32x16_bf16(VFR(1, 0), pb1, O0, 0, 0, 0);
            O1 = __builtin_amdgcn_mfma_f32_32x32x16_bf16(VFR(1, 1), pb1, O1, 0, 0, 0);
#undef VFR
        }
    }
    l += __shfl_xor(l, 32);
    const float inv = 1.f / l;
    bf16* yp = YM + (mb + t0 + r32) * D + hh * 64 + 4 * hf;
#pragma unroll
    for (int rq = 0; rq < 4; ++rq) {
        v2u o; o.x = cvtpk(O0[4 * rq] * inv, O0[4 * rq + 1] * inv); o.y = cvtpk(O0[4 * rq + 2] * inv, O0[4 * rq + 3] * inv); *(GAS v2u*)(yp + 8 * rq) = o;
        v2u o2; o2.x = cvtpk(O1[4 * rq] * inv, O1[4 * rq + 1] * inv); o2.y = cvtpk(O1[4 * rq + 2] * inv, O1[4 * rq + 3] * inv); *(GAS v2u*)(yp + 32 + 8 * rq) = o2; }
}
__device__ __forceinline__ void p4_attention(const Params& P, const Ctx& C) {
    unsigned char* ws = P.ws;
    const bf16* H = (const bf16*)(ws + WS_H); const bf16* KH = (const bf16*)(ws + WS_K); const bf16* VT = (const bf16*)(ws + WS_VT); const unsigned* MASK = (const unsigned*)(ws + WS_MASK); bf16* YM = (bf16*)(ws + WS_YMIX);
    for (int p = blockIdx.x; p < 512; p += C.G) {
        const int bh = p >> 3, j = p & 7; const int b = bh >> 3, hh = bh & 7;
        attn_task(H, KH, VT, MASK, YM, b, hh, j * 256 + C.wave * 32, C.lane);
        attn_task(H, KH, VT, MASK, YM, b, hh, (15 - j) * 256 + (7 - C.wave) * 32, C.lane);
    }
}

constexpr int AT_KB = 64 * 144, AT_VB = 64 * 136, AT_VOFF = 2 * AT_KB;
__device__ __forceinline__ void attn_block(const Ctx& C, const bf16* H, const bf16* KH, const bf16* VT, const unsigned* MASK, bf16* YM, int b, int hh, int qb) {
    const int lane = C.lane, r32 = lane & 31, hf = lane >> 5, tid = C.tid;
    const float LOG2E = 1.4426950408889634f; const float c1 = 0.125f * LOG2E; const float sl2 = exp2f(-(float)(hh + 1)) * LOG2E;
    const size_t mb = (size_t)b * T; const int t0 = qb * 256 + C.wave * 32;
    bf16x8 qf[4];
#pragma unroll
    for (int k = 0; k < 4; ++k) { const v4u w = *(const GAS v4u*)(H + (mb + t0 + r32) * D_INP + C_AQ + hh * 64 + 16 * k + 8 * hf);
        v4u o; o.x = cvtpk(bflo(w.x) * c1, bfhi(w.x) * c1); o.y = cvtpk(bflo(w.y) * c1, bfhi(w.y) * c1); o.z = cvtpk(bflo(w.z) * c1, bfhi(w.z) * c1); o.w = cvtpk(bflo(w.w) * c1, bfhi(w.w) * c1);
        qf[k] = __builtin_bit_cast(bf16x8, o); }
    const bf16* kbase = KH + ((size_t)(b * 8 + hh) * T) * 64; const bf16* vbase = VT + ((size_t)(b * 512 + hh * 64)) * T; const unsigned* mrow = MASK + (mb + t0 + r32) * 128;
    const int srow = tid >> 3, sch = tid & 7;
    const bf16* kst = kbase + (size_t)srow * 64 + 8 * sch; const bf16* vst = vbase + (size_t)srow * T + 8 * sch;
    LAS unsigned char* kw = C.lds + srow * 144 + 16 * sch; LAS unsigned char* vw = C.lds + AT_VOFF + srow * 136 + 16 * sch;
    const LAS unsigned char* kr = C.lds + r32 * 144 + 16 * hf; const LAS unsigned char* vr = C.lds + AT_VOFF + r32 * 136 + 8 * hf;
    float m_run = -1e30f, l = 0.f;
    f32x16 O0 = {0.f, 0.f, 0.f, 0.f, 0.f, 0.f, 0.f, 0.f, 0.f, 0.f, 0.f, 0.f, 0.f, 0.f, 0.f, 0.f}, O1 = O0;
    f32x16 bias0, bias1;
#pragma unroll
    for (int r = 0; r < 16; ++r) { const float ko = (float)((r & 3) + 8 * (r >> 2) + 4 * hf - t0 - r32); bias0[r] = sl2 * ko; bias1[r] = sl2 * (ko + 32.f); }
    const int nkt = 4 * (qb + 1), ktw = (t0 + 31) >> 6;
    v4u kn = *(const GAS v4u*)kst, vn = *(const GAS v4u*)vst; v2u mwn = *(const GAS v2u*)mrow;
    *(LAS v4u*)kw = kn; *(LAS v2u*)vw = (v2u){vn.x, vn.y}; *(LAS v2u*)(vw + 8) = (v2u){vn.z, vn.w};
    __syncthreads();
    for (int kt = 0; kt < nkt; ++kt) {
        const int s0 = kt * 64; const int cur = kt & 1; const v2u mw = mwn;
        if (kt + 1 < nkt) { kn = *(const GAS v4u*)(kst + (size_t)(s0 + 64) * 64); vn = *(const GAS v4u*)(vst + s0 + 64); mwn = *(const GAS v2u*)(mrow + 2 * kt + 2); }
        if (kt <= ktw) {
            const LAS unsigned char* kc = kr + cur * AT_KB; const LAS unsigned char* vc = vr + cur * AT_VB;
            const float sh = sl2 * (float)s0;
            f32x16 a0, a1;
#pragma unroll
            for (int k = 0; k < 4; ++k) { const bf16x8 k0 = *(const LAS bf16x8*)(kc + 32 * k), k1 = *(const LAS bf16x8*)(kc + 32 * 144 + 32 * k);
                a0 = __builtin_amdgcn_mfma_f32_32x32x16_bf16(k0, qf[k], k == 0 ? bias0 : a0, 0, 0, 0); a1 = __builtin_amdgcn_mfma_f32_32x32x16_bf16(k1, qf[k], k == 0 ? bias1 : a1, 0, 0, 0); }
            const unsigned m0 = mw.x >> (4 * hf), m1 = mw.y >> (4 * hf);
            float mx = -1e30f;
#pragma unroll
            for (int r = 0; r < 16; ++r) { const int ko = (r & 3) + 8 * (r >> 2);
                const unsigned k0m = (unsigned)__builtin_amdgcn_sbfe((int)m0, ko, 1), k1m = (unsigned)__builtin_amdgcn_sbfe((int)m1, ko, 1);
                const float x0 = a0[r], x1 = a1[r];
                a0[r] = __builtin_bit_cast(float, (__builtin_bit_cast(unsigned, x0) & k0m) | (0xf149f2cau & ~k0m));
                a1[r] = __builtin_bit_cast(float, (__builtin_bit_cast(unsigned, x1) & k1m) | (0xf149f2cau & ~k1m));
                mx = fmaxf(mx, fmaxf(a0[r], a1[r])); }
            mx = fmaxf(mx, __shfl_xor(mx, 32));
            const float m_new = fmaxf(m_run, mx + sh);
            const float m_use = fmaxf(m_new, -1e20f) - sh;
            float ps = 0.f;
#pragma unroll
            for (int r = 0; r < 16; ++r) { const float p0 = __builtin_amdgcn_exp2f(a0[r] - m_use), p1 = __builtin_amdgcn_exp2f(a1[r] - m_use); a0[r] = p0; a1[r] = p1; ps += p0 + p1; }
            if (__builtin_amdgcn_ballot_w64(m_new != m_run) != 0ull) {
                const float alpha = __builtin_amdgcn_exp2f(m_run - m_new); m_run = m_new;
                l *= alpha;
#pragma unroll
                for (int r = 0; r < 16; ++r) { O0[r] *= alpha; O1[r] *= alpha; }
            }
            l += ps;
#pragma unroll
            for (int sp = 0; sp < 2; ++sp) {
                const bf16x8 pb0 = pack8(a0, 8 * sp), pb1 = pack8(a1, 8 * sp);
#define VLD(uu, dt) ({ const s16x4 lo_ = *(const LAS s16x4*)(vc + (dt) * 32 * 136 + 2 * (32 * (uu) + 16 * sp)), hi_ = *(const LAS s16x4*)(vc + (dt) * 32 * 136 + 2 * (32 * (uu) + 16 * sp + 8)); (bf16x8){lo_[0], lo_[1], lo_[2], lo_[3], hi_[0], hi_[1], hi_[2], hi_[3]}; })
                O0 = __builtin_amdgcn_mfma_f32_32x32x16_bf16(VLD(0, 0), pb0, O0, 0, 0, 0);
                O1 = __builtin_amdgcn_mfma_f32_32x32x16_bf16(VLD(0, 1), pb0, O1, 0, 0, 0);
                O0 = __builtin_amdgcn_mfma_f32_32x32x16_bf16(VLD(1, 0), pb1, O0, 0, 0, 0);
                O1 = __builtin_amdgcn_mfma_f32_32x32x16_bf16(VLD(1, 1), pb1, O1, 0, 0, 0);
#undef VLD
            }
        }
        if (kt + 1 < nkt) { const int nx = cur ^ 1; *(LAS v4u*)(kw + nx * AT_KB) = kn; *(LAS v2u*)(vw + nx * AT_VB) = (v2u){vn.x, vn.y}; *(LAS v2u*)(vw + nx * AT_VB + 8) = (v2u){vn.z, vn.w}; }
        __syncthreads();
    }
    l += __shfl_xor(l, 32);
    const float inv = __builtin_amdgcn_rcpf(l);
    unsigned char* yp = (unsigned char*)YM + (mb + t0 + r32) * D + hh * 64 + 4 * hf;
    const float i8 = inv * 8.f;
#pragma unroll
    for (int rq = 0; rq < 4; ++rq) {
        *(GAS unsigned*)(yp + 8 * rq) = pk4_fp8(O0[4 * rq] * i8, O0[4 * rq + 1] * i8, O0[4 * rq + 2] * i8, O0[4 * rq + 3] * i8);
        *(GAS unsigned*)(yp + 32 + 8 * rq) = pk4_fp8(O1[4 * rq] * i8, O1[4 * rq + 1] * i8, O1[4 * rq + 2] * i8, O1[4 * rq + 3] * i8); }
}
__device__ __forceinline__ void p4_attention2(const Params& P, const Ctx& C) {
    unsigned char* ws = P.ws;
    const bf16* H = (const bf16*)(ws + WS_H); const bf16* KH = (const bf16*)(ws + WS_K); const bf16* VT = (const bf16*)(ws + WS_VT); const unsigned* MASK = (const unsigned*)(ws + WS_MASK); bf16* YM = (bf16*)(ws + WS_YMIX);
    for (int p = blockIdx.x; p < 512; p += C.G) {
        const int b = p & 7, q = p >> 3; const int hh = q >> 3, j = q & 7;
        attn_block(C, H, KH, VT, MASK, YM, b, hh, j);
        attn_block(C, H, KH, VT, MASK, YM, b, hh, 15 - j);
    }
}


#ifndef FEAT_MIX
#define FEAT_MIX 1
#endif
#ifndef FEAT_MOE
#define FEAT_MOE 1
#endif
#ifndef FEAT_PLE
#define FEAT_PLE 1
#endif
#ifndef FEAT_ATT
#define FEAT_ATT 1
#endif

template <bool PUBLISH = true> __device__ __forceinline__ void p6_ln1_router(const Params& P, const Ctx& C) {
    unsigned char* ws = P.ws;
    bf16* X1 = (bf16*)(ws + WS_X1); unsigned char* XB = ws + WS_XB;
    LAS float* wl = (LAS float*)C.lds;
    LAS int* hist = (LAS int*)(C.lds + MISC_OFF);
    { const float* wrt = (const float*)(ws + WS_WRT);
      for (int i = C.tid; i < 32 * 1024 / 4; i += NTHR) *(LAS f32x4*)(wl + 4 * i) = *(const GAS f32x4*)(wrt + 4 * i);
      if (C.tid < 32) hist[C.tid] = 0; }
    __syncthreads();
    int* tope = (int*)(ws + WS_TOPE); float* gate = (float*)(ws + WS_GATE); int* lrank = (int*)(ws + WS_LRANK);
    const bf16* src = (const bf16*)P.out;
    const int lane = C.lane, hf = lane >> 5, ex = lane & 31;
    const float brl = P.in[I_BR][ex];
    for (int m0 = 2 * C.gw; m0 < NTOK; m0 += 2 * C.ngw) {
        f32x4 va[4], vb[4]; load_row_bf16(va, src + (size_t)m0 * D, lane); load_row_bf16(vb, src + (size_t)(m0 + 1) * D, lane);
        ln_row(va, P.in[I_LNMG], P.in[I_LNMB], lane); ln_row(vb, P.in[I_LNMG], P.in[I_LNMB], lane);
        store_row_bf16(X1 + (size_t)m0 * D, va, lane); store_row_bf16(X1 + (size_t)(m0 + 1) * D, vb, lane);
        store_row_fp8x8(XB + (size_t)m0 * D, va, lane); store_row_fp8x8(XB + (size_t)(m0 + 1) * D, vb, lane);
        float v[32];
#pragma unroll
        for (int e = 0; e < 32; ++e) { float pa = 0.f, pb = 0.f;
#pragma unroll
            for (int j = 0; j < 4; ++j) { const f32x4 w = *(const LAS f32x4*)(wl + e * 1024 + 4 * lane + 256 * j);
                pa += (va[j][0] * w[0] + va[j][1] * w[1]) + (va[j][2] * w[2] + va[j][3] * w[3]); pb += (vb[j][0] * w[0] + vb[j][1] * w[1]) + (vb[j][2] * w[2] + vb[j][3] * w[3]); }
            const float keep = hf ? pb : pa, send = hf ? pa : pb; v[e] = keep + __shfl_xor(send, 32); }
#define HALVE(M, CNT) { const bool up_ = (lane & (M)) != 0; _Pragma("unroll") for (int i_ = 0; i_ < (CNT) / 2; ++i_) { const float k_ = up_ ? v[i_ + (CNT) / 2] : v[i_], s_ = up_ ? v[i_] : v[i_ + (CNT) / 2]; v[i_] = k_ + __shfl_xor(s_, (M)); } }
        HALVE(16, 32) HALVE(8, 16) HALVE(4, 8) HALVE(2, 4) HALVE(1, 2)
#undef HALVE
        float lg = v[0] + brl;
        int se[4]; float sv[4];
#pragma unroll
        for (int k = 0; k < 4; ++k) { float bv = lg; int bi = ex;
#pragma unroll
            for (int o = 1; o < 32; o <<= 1) { const float ov = __shfl_xor(bv, o); const int oi = __shfl_xor(bi, o); const bool take = (ov > bv) || (ov == bv && oi < bi); bv = take ? ov : bv; bi = take ? oi : bi; }
            se[k] = bi; sv[k] = bv; if (ex == bi) lg = -INFINITY; }
        float exv[4], sum = 0.f;
#pragma unroll
        for (int k = 0; k < 4; ++k) { exv[k] = __expf(sv[k] - sv[0]); sum += exv[k]; }
        const float inv = 1.f / sum;
        if (ex == 0) { const int m = m0 + hf;
#pragma unroll
            for (int k = 0; k < 4; ++k) { const int lr = atomicAdd((int*)&hist[se[k]], 1); tope[m * 4 + k] = se[k]; gate[m * 4 + k] = exv[k] * inv; lrank[m * 4 + k] = lr; } }
    }
    __syncthreads();
    if (PUBLISH && C.tid < 32) { unsigned* cnt = (unsigned*)(ws + WS_CTL) + CW_CNT; const int base = (int)atomicAdd(cnt + C.tid, (unsigned)hist[C.tid]); ((int*)(ws + WS_WGBASE))[blockIdx.x * 32 + C.tid] = base; }
}

__device__ __forceinline__ void p7_dispatch(const Params& P, const Ctx& C) {
    unsigned char* ws = P.ws;
    LAS int* ps = (LAS int*)(C.lds + MISC_OFF + 256);
    const unsigned* cnt = (const unsigned*)(ws + WS_CTL) + CW_CNT;
    int* tile_e = (int*)(ws + WS_TILEE);
    LAS int* pe = (LAS int*)(C.lds + MISC_OFF + 512);
    if (C.tid < 64) { const int e = C.tid & 31; const int c = (int)__hip_atomic_load(cnt + e, __ATOMIC_RELAXED, __HIP_MEMORY_SCOPE_AGENT); const int nt = (c + 255) >> 8; int inc = nt;
#pragma unroll
        for (int o = 1; o < 32; o <<= 1) { const int v = __shfl_up(inc, o); if ((C.tid & 31) >= o) inc += v; }
        if (C.tid < 32) { ps[e] = (inc - nt) << 8; pe[e] = inc; } }
    __syncthreads();
    if (blockIdx.x == 0) { const int ntot = pe[31];
        for (int t = C.tid; t < ntot; t += NTHR) { int e = 0;
#pragma unroll
            for (int q = 0; q < 31; ++q) e += (t >= pe[q]) ? 1 : 0;
            tile_e[t] = e; }
        if (C.tid == 0) tile_e[MAXTILES] = ntot; }
    const int* tope = (const int*)(ws + WS_TOPE); const float* gate = (const float*)(ws + WS_GATE); const int* lrank = (const int*)(ws + WS_LRANK);
    const int* wgb = (const int*)(ws + WS_WGBASE);
    int* tokslot = (int*)(ws + WS_TOKSLOT); float* slotgate = (float*)(ws + WS_SLOTGATE);
    const bf16* XB = (const bf16*)(ws + WS_XB); unsigned char* xs = ws + WS_XS;
    int m = C.gw; v4u f8n; int en[4], ln_[4]; float gn[4]; int wgn;
    if (m < NTOK) { f8n = *(const GAS v4u*)((const unsigned char*)XB + (size_t)m * D + 16 * C.lane); wgn = ((m >> 1) % C.ngw) >> 3;
#pragma unroll
        for (int k = 0; k < 4; ++k) { en[k] = tope[m * 4 + k]; ln_[k] = lrank[m * 4 + k]; gn[k] = gate[m * 4 + k]; } }
    for (; m < NTOK; m += C.ngw) {
        const v4u f8 = f8n; int e[4], lr[4]; float g[4]; const int wgm = wgn;
#pragma unroll
        for (int k = 0; k < 4; ++k) { e[k] = en[k]; lr[k] = ln_[k]; g[k] = gn[k]; }
        int wb[4];
#pragma unroll
        for (int k = 0; k < 4; ++k) wb[k] = wgb[wgm * 32 + e[k]];
        const int m2 = m + C.ngw;
        if (m2 < NTOK) { f8n = *(const GAS v4u*)((const unsigned char*)XB + (size_t)m2 * D + 16 * C.lane); wgn = ((m2 >> 1) % C.ngw) >> 3;
#pragma unroll
            for (int k = 0; k < 4; ++k) { en[k] = tope[m2 * 4 + k]; ln_[k] = lrank[m2 * 4 + k]; gn[k] = gate[m2 * 4 + k]; } }
#pragma unroll
        for (int k = 0; k < 4; ++k) { const int slot = ps[e[k]] + wb[k] + lr[k];
            *(GAS v4u*)(xs + (size_t)slot * D + 16 * C.lane) = f8;
            if (C.lane == 0) { slotgate[slot] = g[k]; tokslot[m * 4 + k] = slot; } }
    }
}

__device__ __forceinline__ void p10_combine_ln2(const Params& P, const Ctx& C) {
    unsigned char* ws = P.ws;
    const bf16* X1 = (const bf16*)(ws + WS_X1); bf16* XB = (bf16*)(ws + WS_XB); bf16* X2 = (bf16*)P.out;
    const int* tokslot = (const int*)(ws + WS_TOKSLOT); const unsigned char* ys = ws + WS_YSLOT;
    for (int m = C.gw; m < NTOK; m += C.ngw) {
        f32x4 v[4]; load_row_bf16(v, X1 + (size_t)m * D, C.lane);
#pragma unroll
        for (int j = 0; j < 4; ++j) v[j] = v[j] * ALPHA;
#if FEAT_MOE
        f32x4 fs[4] = {{0.f, 0.f, 0.f, 0.f}, {0.f, 0.f, 0.f, 0.f}, {0.f, 0.f, 0.f, 0.f}, {0.f, 0.f, 0.f, 0.f}};
#pragma unroll
        for (int k = 0; k < 4; ++k) { const int slot = tokslot[m * 4 + k]; const unsigned char* yr = ys + (size_t)slot * D;
#pragma unroll
            for (int j = 0; j < 4; ++j) fs[j] = fs[j] + fp8x4_to_f32(*(const GAS unsigned*)(yr + 4 * C.lane + 256 * j)); }
#pragma unroll
        for (int j = 0; j < 4; ++j) v[j] = v[j] + fs[j] * (1.f / 64.f);
#endif
        ln_row(v, P.in[I_LNFG], P.in[I_LNFB], C.lane);
        store_row_bf16(X2 + (size_t)m * D, v, C.lane);
        store_row_fp8x8((unsigned char*)XB + (size_t)m * D, v, C.lane);
    }
}

__device__ __forceinline__ void p12_final_ln(const Params& P, const Ctx& C) {
    const bf16* src = (const bf16*)(P.ws + WS_X1);
    for (int m = C.gw; m < NTOK; m += C.ngw) {
        f32x4 v[4]; load_row_bf16(v, src + (size_t)m * D, C.lane);
        ln_row(v, P.in[I_LNPG], P.in[I_LNPB], C.lane);
        store_row_f32(P.out + (size_t)m * D, v, C.lane);
    }
}
#define XB_TMO      128
#define XB_XCNT(j)  (256  + 64 * (j))
#define XB_XSUB(j)  (1280 + 64 * (j))
#define XB_XGEN(j)  (2304 + 64 * (j))
#define XB_TOP      3328
#define XB_TOPGEN   3392
#define XCD_BAR_WORDS 3456
#define XB_SPIN_CAP (1u << 18)
#define LAS __attribute__((address_space(3)))

__device__ __forceinline__ unsigned xb_ld(unsigned* p)              { return __hip_atomic_load(p, __ATOMIC_RELAXED, __HIP_MEMORY_SCOPE_AGENT); }
__device__ __forceinline__ unsigned xb_add(unsigned* p, unsigned v) { return __hip_atomic_fetch_add(p, v, __ATOMIC_RELAXED, __HIP_MEMORY_SCOPE_AGENT); }
__device__ __forceinline__ unsigned xb_xcc_id() { return (unsigned)__builtin_amdgcn_s_getreg((3 << 11) | 20) & 0xFu; }
#define XB_SPIN(cond, bar) do { unsigned _sp = 0; while (cond) { __builtin_amdgcn_s_sleep(1); \
    if ((++_sp & 255u) == 0u) { if (xb_ld(&(bar)[XB_TMO])) break; if (_sp > XB_SPIN_CAP) { atomicAdd(&(bar)[XB_TMO], 1u); break; } } } } while (0)

struct XcdBarrier {
    unsigned* bar; unsigned x;
    volatile LAS unsigned* st;
};

__device__ __forceinline__ XcdBarrier xcd_barrier_post(unsigned* bar, volatile LAS unsigned* st) {
    XcdBarrier b; b.bar = bar; b.x = xb_xcc_id(); b.st = st;
    if (threadIdx.x == 0) (void)xb_add(&bar[XB_XCNT(b.x)], 1u);
    return b;
}
__device__ __forceinline__ void xcd_barrier_complete(unsigned* bar, unsigned x, unsigned& nloc, unsigned& nx) {
    const unsigned G = gridDim.x * gridDim.y * gridDim.z;
    unsigned sum, cnt, mine, sp = 0u;
    for (;;) {
        sum = 0u; cnt = 0u; mine = 0u;
#pragma unroll
        for (unsigned j = 0; j < 16; ++j) { const unsigned c = xb_ld(&bar[XB_XCNT(j)]); sum += c; cnt += (c > 0u) ? 1u : 0u; mine = (j == x) ? c : mine; }
        if (sum == G) break;
        __builtin_amdgcn_s_sleep(1);
        if ((++sp & 255u) == 0u) { if (xb_ld(&bar[XB_TMO])) break; if (sp > XB_SPIN_CAP) { atomicAdd(&bar[XB_TMO], 1u); break; } }
    }
    nloc = mine > 0u ? mine : 1u; nx = cnt > 0u ? cnt : 1u;
}

__device__ __forceinline__ void xcd_barrier(const XcdBarrier& b) {
    asm volatile("s_waitcnt vmcnt(0)" ::: "memory");
    __syncthreads();
    if (threadIdx.x == 0) {
        unsigned* bar = b.bar;
        __builtin_amdgcn_s_waitcnt(0);
        unsigned nloc = b.st[0], nx = b.st[1];
        if (nloc == 0u) { xcd_barrier_complete(bar, b.x, nloc, nx); b.st[0] = nloc; b.st[1] = nx; }
        const unsigned old = xb_add(&bar[XB_XSUB(b.x)], 1u);
        const unsigned gen = old / nloc;
        if (old + 1u == (gen + 1u) * nloc) {
            __builtin_amdgcn_fence(__ATOMIC_RELEASE, "agent");
            asm volatile("s_waitcnt vmcnt(0)" ::: "memory");
            const unsigned og = xb_add(&bar[XB_TOP], 1u);
            const unsigned tg = og / nx;
            if (og + 1u == (tg + 1u) * nx) xb_add(&bar[XB_TOPGEN], 1u);
            else XB_SPIN(xb_ld(&bar[XB_TOPGEN]) == tg, bar);
            __builtin_amdgcn_fence(__ATOMIC_ACQUIRE, "agent");
            xb_add(&bar[XB_XGEN(b.x)], 1u);
            asm volatile("s_waitcnt vmcnt(0)" ::: "memory");
        } else {
            XB_SPIN(xb_ld(&bar[XB_XGEN(b.x)]) == gen, bar);
            __builtin_amdgcn_fence(__ATOMIC_ACQUIRE, "agent");
            asm volatile("s_waitcnt vmcnt(0)" ::: "memory");
        }
    }
    __syncthreads();
}


template <int PH> __device__ __forceinline__ void run_phase(const Params& P, const Ctx& C) {
    unsigned char* ws = P.ws;
    typedef pg8::bf16_t pbf;
    if constexpr (PH == 0) { p0_prologue(P, C); }
    else if constexpr (PH == 10) {
        pg8::Gemm g{(const pbf*)(ws + WS_XBF), (const pbf*)(ws + WS_WIN_T), NTOK, D_INP, D}; pg8::StaticOrder S; S.init(NTOK, D_INP, C.G, (int)blockIdx.x);
        pg8::EpiBf16s E{(pbf*)(ws + WS_H), D_INP};
        pg8::gemm_phase<pg8::EpiBf16s, pg8::StaticOrder, true, true>(C.lds, g, S, E); }
    else if constexpr (PH == 11) {
        pg8::Gemm g{(const pbf*)(ws + WS_PB), (const pbf*)(ws + WS_WPROJ_T), NTOK, D, PLE}; pg8::StaticOrder S; S.init(NTOK, D, C.G, (int)blockIdx.x);
        pg8::EpiBf16s E{(pbf*)(ws + WS_PROJ), D};
        pg8::gemm_phase<pg8::EpiBf16s, pg8::StaticOrder, true, true>(C.lds, g, S, E); }
    else if constexpr (PH == 20) { p2_post(P, C); }
    else if constexpr (PH == 21) { p2_hgrn_prep(P, C); }
    else if constexpr (PH == 30) {
        { pg8::Gemm g{(const pbf*)(ws + WS_CN), (const pbf*)(ws + WS_WUK_T), NTOK, 512, 256}; pg8::StaticOrder S; S.init(NTOK, 512, C.G, (int)blockIdx.x);
          pg8::EpiKhead E{(pbf*)(ws + WS_K)};
          pg8::gemm_phase<pg8::EpiKhead, pg8::StaticOrder, true, true>(C.lds, g, S, E); }
        { pg8::Gemm g{(const pbf*)(ws + WS_WUV_T), (const pbf*)(ws + WS_CN), 512, NTOK, 256}; pg8::StaticOrder S; S.init(512, NTOK, C.G, (int)blockIdx.x);
          pg8::EpiVt E{(pbf*)(ws + WS_VT)};
          pg8::gemm_phase<pg8::EpiVt, pg8::StaticOrder, true, true>(C.lds, g, S, E); }
    }
    else if constexpr (PH == 31) { p3_indexer(P, C); }
    else if constexpr (PH == 32) { p3_scan_convert(P, C); }
    else if constexpr (PH == 40) { p4_attention2(P, C); }
    else if constexpr (PH == 41) { p4_yrec(P, C); }
    else if constexpr (PH == 5) {
        pg8::Gemm g{(const pbf*)(ws + WS_YMIX), (const pbf*)(ws + WS_WO_T), NTOK, D, D / 2}; pg8::StaticOrder S; S.init(NTOK, D, C.G, (int)blockIdx.x);
        pg8::EpiResid E{(const pbf*)(ws + WS_XBF), (pbf*)P.out, D, ALPHA, 1.f / 512.f};
        pg8::gemm_phase<pg8::EpiResid, pg8::StaticOrder, true, true, 1>(C.lds, g, S, E);
    }
    else if constexpr (PH == 6) { p6_ln1_router<true>(P, C); }
    else if constexpr (PH == 60) { p6_ln1_router<false>(P, C); }
    else if constexpr (PH == 7) { p7_dispatch(P, C); }
    else if constexpr (PH == 8) {
        const int* tile_e = (const int*)(ws + WS_TILEE);
        pg8::Gemm g{(const pbf*)(ws + WS_XS), (const pbf*)(ws + WS_WUP_T), CAP, NE * 2048, D / 2};
        pg8::MoeOrder S{tile_e, tile_e[MAXTILES], 8, C.G, (int)blockIdx.x};
        pg8::EpiSwiglu E{ws + WS_HH, P.in[I_BUP]};
        pg8::gemm_phase<pg8::EpiSwiglu, pg8::MoeOrder, true, true, 1, 124, 121>(C.lds, g, S, E);
    }
    else if constexpr (PH == 9) {
        const int* tile_e = (const int*)(ws + WS_TILEE);
        pg8::Gemm g{(const pbf*)(ws + WS_HH), (const pbf*)(ws + WS_WDN_T), CAP, NE * 1024, DFF / 2};
        pg8::MoeOrder S{tile_e, tile_e[MAXTILES], 4, C.G, (int)blockIdx.x};
        pg8::EpiDown E{ws + WS_YSLOT, P.in[I_BDN], (const float*)(ws + WS_SLOTGATE)};
        pg8::gemm_phase<pg8::EpiDown, pg8::MoeOrder, true, true, 1, 125, 121>(C.lds, g, S, E);
    }
    else if constexpr (PH == 100) { p10_combine_ln2(P, C); }
    else if constexpr (PH == 110) {
        pg8::Gemm g{(const pbf*)(ws + WS_XB), (const pbf*)(ws + WS_WGATE_T), NTOK, D, D / 2}; pg8::StaticOrder S; S.init(NTOK, D, C.G, (int)blockIdx.x);
        pg8::EpiPle E{(const pbf*)P.out, (const pbf*)(ws + WS_PROJ), (pbf*)(ws + WS_X1), ALPHA, 1.f / 512.f};
        pg8::gemm_phase<pg8::EpiPle, pg8::StaticOrder, true, true, 1>(C.lds, g, S, E);
    }
    else { p12_final_ln(P, C); }
}
__global__ void __launch_bounds__(NTHR, 2) mega_fwd(Params P) {
    extern __shared__ __attribute__((aligned(16))) unsigned char lds_raw[];
#ifndef PLAIN_LAUNCH
    cg::grid_group grid = cg::this_grid();
#endif
#define MKCTX Ctx C; { int tid_ = threadIdx.x; asm volatile("" : "+v"(tid_)); C.lds = (LAS unsigned char*)lds_raw; C.tid = tid_; C.lane = tid_ & 63; C.wave = __builtin_amdgcn_readfirstlane(tid_ >> 6); \
      C.G = gridDim.x; C.gw = blockIdx.x * NWAVES + C.wave; C.ngw = C.G * NWAVES; }
#if SYNC_MODE != 0
    if (threadIdx.x < 4) ((LAS unsigned*)((LAS unsigned char*)lds_raw + XBW_OFF))[threadIdx.x] = 0u;
    __syncthreads();
    XcdBarrier bar = xcd_barrier_post((unsigned*)(P.ws + WS_CTL) + CW_BAR, (volatile LAS unsigned*)((LAS unsigned char*)lds_raw + XBW_OFF));
#define SY xcd_barrier(bar);
#else
#define SY grid.sync();
#endif
#ifdef PLAIN_LAUNCH
#define GS xcd_barrier(bar);
#else
#define GS grid.sync();
#endif
#define BS __syncthreads();
#define X(k) { MKCTX run_phase<k>(P, C); }
    PROGRAM
#undef X
#undef MKCTX
#undef SY
#undef GS
#undef BS
}

extern "C" void kernel_launch(void* const* d_in, const int* in_sizes, int n_in, void* d_out, int out_size, void* d_ws, size_t ws_size, hipStream_t stream) {
    static int grid = 0;
    if (grid == 0) {
        if (n_in != 25 || out_size != NTOK * D || ws_size < WS_END) { fprintf(stderr, "kernel_launch: unexpected shapes (n_in %d out %d ws %zu)\n", n_in, out_size, ws_size); grid = -1; return; }
        int dev = 0, cus = 0, per_cu = 0;
        if (hipGetDevice(&dev) != hipSuccess || hipDeviceGetAttribute(&cus, hipDeviceAttributeMultiprocessorCount, dev) != hipSuccess) { grid = -1; return; }
        if (hipFuncSetAttribute((const void*)mega_fwd, hipFuncAttributeMaxDynamicSharedMemorySize, LDS_BYTES) != hipSuccess) { fprintf(stderr, "kernel_launch: hipFuncSetAttribute failed\n"); grid = -1; return; }
        if (hipOccupancyMaxActiveBlocksPerMultiprocessor(&per_cu, (const void*)mega_fwd, NTHR, LDS_BYTES) != hipSuccess || per_cu < 1) { fprintf(stderr, "kernel_launch: occupancy query failed (%d)\n", per_cu); (void)hipGetLastError(); grid = -1; return; }
        grid = cus * per_cu;
        fprintf(stderr, "kernel_launch: grid %d (%d CUs x %d)\n", grid, cus, per_cu);
    }
    if (grid < 0) return;
    (void)hipMemsetAsync((char*)d_ws + WS_CTL, 0, CTL_ZERO_BYTES, stream);
    Params p{};
    for (int i = 0; i < 25; ++i) p.in[i] = (const float*)d_in[i];
    p.out = (float*)d_out; p.ws = (unsigned char*)d_ws;

    void* args[] = {&p};
#ifdef PLAIN_LAUNCH
    hipLaunchKernelGGL(mega_fwd, dim3(grid), dim3(NTHR), LDS_BYTES, stream, p); hipError_t e = hipPeekAtLastError(); (void)args;
#else
    hipError_t e = hipLaunchCooperativeKernel((const void*)mega_fwd, dim3(grid), dim3(NTHR), args, LDS_BYTES, stream);
#endif
    if (e != hipSuccess) fprintf(stderr, "kernel_launch: cooperative launch failed: %s (grid %d)\n", hipGetErrorString(e), grid);
}
```

```cpp
#define SYNC_MODE 1
#include <hip/hip_runtime.h>
#include <hip/hip_cooperative_groups.h>
#include <cstdio>
#include <cstdint>
namespace cg = cooperative_groups;

namespace pg8 {
#define PG8_LAS __attribute__((address_space(3)))
typedef unsigned short bf16_t;
typedef short bf16x8 __attribute__((ext_vector_type(8)));
typedef float f32x4 __attribute__((ext_vector_type(4)));
typedef unsigned u32x4 __attribute__((ext_vector_type(4)));
typedef int i32x4 __attribute__((ext_vector_type(4)));
typedef int i32x8 __attribute__((ext_vector_type(8)));
constexpr int BM = 256, BK = 64, HALF = 128, HTB = HALF * BK * 2  , STAGE_BYTES = 8 * HTB, NXCD = 8, WGM = 8;

__host__ __device__ __forceinline__ int lds_byte(int r, int c) { const int st = (r >> 4) * 2 + (c >> 5), rr = r & 15, cc = c & 31, ob = rr * 64 + cc * 2; return st * 1024 + (ob ^ (((ob >> 9) & 1) << 5)); }
__host__ __device__ __forceinline__ void stage_rc(int b, int& R, int& C) { const int st = b / 1024, sb = b % 1024, swz = sb ^ (((sb >> 9) & 1) << 5); R = (st >> 1) * 16 + swz / 64; C = (st & 1) * 32 + (swz % 64) / 2; }
__host__ __device__ __forceinline__ int perm32(int rho) { const int n = rho >> 4, i = rho & 15; return 8 * (i >> 2) + 4 * n + (i & 3); }

struct Unit { int pm, pn; };
struct Gemm { const bf16_t* A; const bf16_t* Bt; int M, N, K; const int* aidx = nullptr; };

struct StaticOrder {
    int nM, nN, nwg, G, c;
    __host__ __device__ void init(int M, int N, int G_, int c_) { nM = M / BM; nN = N / BM; nwg = nM * nN; G = G_; c = c_; }
    __host__ __device__ bool next(int i, Unit& u) const {
        const long L = (long)i * G + c; if (L >= nwg) return false;
        int wgid = (int)L; { const int q = nwg / NXCD, r = nwg % NXCD, xcd = wgid % NXCD, off = wgid / NXCD; wgid = (xcd < r ? xcd * (q + 1) : r * (q + 1) + (xcd - r) * q) + off; }
        const int nig = WGM * nN, gid = wgid / nig, fm = gid * WGM, gsz = (nM - fm) < WGM ? (nM - fm) : WGM;
        u.pm = fm + ((wgid % nig) % gsz); u.pn = (wgid % nig) / gsz; return true;
    }
    __device__ __forceinline__ void a_ready(const Unit&) const {}
    __device__ __forceinline__ void done(const Unit&) const {}
};

__device__ __forceinline__ unsigned cvt_pk_bf16(float lo, float hi) { unsigned r; asm volatile("v_cvt_pk_bf16_f32 %0, %1, %2" : "=v"(r) : "v"(lo), "v"(hi)); return r; }
typedef float f32x2 __attribute__((ext_vector_type(2)));
template <class Epi, class Sched, bool ALIGN_EPI = false, bool SP2 = false, int F8 = 0, int F8SA = 127, int F8SB = 127, bool GATHER = false>
__device__ __forceinline__ void gemm_phase(PG8_LAS unsigned char* lds, const Gemm g, const Sched& S, const Epi& E) {
    const int tid = threadIdx.x, wid = __builtin_amdgcn_readfirstlane(tid >> 6), lane = tid & 63, wr = wid >> 2, wc = wid & 3, fr = lane & 15, fq = lane >> 4;
    const int K = g.K, nt = K / BK;
    unsigned voffA[2], voffB[2]; int gR[2]; unsigned gC2[2];
#pragma unroll
    for (int i = 0; i < 2; ++i) { int R, C; stage_rc(tid * 16 + i * 8192, R, C); const int Rb = Epi::PERM ? ((R & ~31) + perm32(R & 31)) : R;
        voffA[i] = (unsigned)(R * K + C) * 2u; voffB[i] = (unsigned)(Rb * K + C) * 2u; gR[i] = R; gC2[i] = (unsigned)C * 2u; }
    unsigned vgc[2][2] = {{0u, 0u}, {0u, 0u}}, vgn[2][2] = {{0u, 0u}, {0u, 0u}};
#define PG8_LDIDX(dst, pm_) do { _Pragma("unroll") for (int h_ = 0; h_ < 2; ++h_) _Pragma("unroll") for (int i_ = 0; i_ < 2; ++i_) \
        dst[h_][i_] = (unsigned)g.aidx[(pm_) * BM + h_ * HALF + gR[i_]] * (unsigned)(K * 2) + gC2[i_]; } while (0)
    const size_t kstep = (size_t)(BK * 2);
    const size_t hstep = (size_t)HALF * K * 2;
    const size_t tstep = 2 * hstep;
    const unsigned ldsw = (unsigned)wid * 1024u;
    const int aoff = lds_byte(wr * 64 + fr, fq * 8), boff = lds_byte(wc * 32 + fr, fq * 8);
#define PG8_SA(b, h) (((b) * 2 + (h)) * HTB)
#define PG8_SB(b, h) ((4 + (b) * 2 + (h)) * HTB)
#define PG8_STAGE(bufoff, gbase, voff) do { _Pragma("unroll") for (int _i = 0; _i < 2; ++_i) \
        __builtin_amdgcn_global_load_lds((const unsigned*)((const char*)(gbase) + (voff)[_i]), (PG8_LAS unsigned*)(lds + (bufoff) + ldsw + _i * 8192), 16, 0, 0); } while (0)
#define PG8_STAGE_A(bufoff, ptr, h, NX) do { if constexpr (GATHER) { const unsigned vo_[2] = {(NX) ? vgn[h][0] : vgc[h][0], (NX) ? vgn[h][1] : vgc[h][1]}; PG8_STAGE(bufoff, ptr, vo_); } \
        else { PG8_STAGE(bufoff, (ptr) + (size_t)(h) * hstep, voffA); } } while (0)
#define PG8_LDA(dst, b, h) do { _Pragma("unroll") for (int m = 0; m < 4; ++m) { dst[m].lo = *(const PG8_LAS i32x4*)(lds + PG8_SA(b, h) + aoff + m * 2048); dst[m].hi = *(const PG8_LAS i32x4*)(lds + PG8_SA(b, h) + aoff + m * 2048 + 1024); } } while (0)
#define PG8_LDB(dst, b, h) do { _Pragma("unroll") for (int n = 0; n < 2; ++n) { dst[n].lo = *(const PG8_LAS i32x4*)(lds + PG8_SB(b, h) + boff + n * 2048); dst[n].hi = *(const PG8_LAS i32x4*)(lds + PG8_SB(b, h) + boff + n * 2048 + 1024); } } while (0)
#define PG8_MMA(ai, bj, At, Bt) do { __builtin_amdgcn_s_setprio(1); \
        if constexpr (F8 == 0) { _Pragma("unroll") for (int m = 0; m < 4; ++m) _Pragma("unroll") for (int n = 0; n < 2; ++n) { \
            const i32x4 bl_ = Bt[n].lo, bh_ = Bt[n].hi, al_ = At[m].lo, ah_ = At[m].hi;     \
            acc[ai][bj][m][n] = __builtin_amdgcn_mfma_f32_16x16x32_bf16(__builtin_bit_cast(bf16x8, bl_), __builtin_bit_cast(bf16x8, al_), acc[ai][bj][m][n], 0, 0, 0); \
            acc[ai][bj][m][n] = __builtin_amdgcn_mfma_f32_16x16x32_bf16(__builtin_bit_cast(bf16x8, bh_), __builtin_bit_cast(bf16x8, ah_), acc[ai][bj][m][n], 0, 0, 0); } } \
        else { _Pragma("unroll") for (int m = 0; m < 4; ++m) _Pragma("unroll") for (int n = 0; n < 2; ++n) \
            asm volatile("v_mfma_f32_16x16x128_f8f6f4 %0, %1, %2, %0" : "+v"(acc[ai][bj][m][n]) : "v"(Bt[n]), "v"(At[m])); } \
        __builtin_amdgcn_s_setprio(0); } while (0)
#define PG8_WAIT_V(n) asm volatile("s_waitcnt vmcnt(" #n ")" ::: "memory")
#define PG8_WAIT_L(n) asm volatile("s_waitcnt lgkmcnt(" #n ")" ::: "memory")
#define PG8_BAR __builtin_amdgcn_s_barrier()
#define PG8_SCHED __builtin_amdgcn_sched_barrier(0)
    Unit cur, nxt; int ui = 0;
    if (!S.next(0, cur)) return;
    f32x4 acc[2][2][4][2];
#pragma unroll
    for (int a = 0; a < 2; ++a)
#pragma unroll
        for (int b = 0; b < 2; ++b)
#pragma unroll
            for (int m = 0; m < 4; ++m)
#pragma unroll
                for (int n = 0; n < 2; ++n) acc[a][b][m][n] = (f32x4){0.f, 0.f, 0.f, 0.f};
    i32x8 At[4], B0[2], B1[2];
    const char* cA = GATHER ? (const char*)g.A : (const char*)g.A + (size_t)cur.pm * tstep; const char* cB = (const char*)g.Bt + (size_t)cur.pn * tstep;
    if constexpr (GATHER) PG8_LDIDX(vgc, cur.pm);
    S.a_ready(cur);
    if constexpr (SP2) {
        PG8_STAGE(PG8_SB(0, 0), cB, voffB); PG8_STAGE(PG8_SB(0, 1), cB + hstep, voffB); PG8_STAGE_A(PG8_SA(0, 0), cA, 0, false); PG8_STAGE_A(PG8_SA(0, 1), cA, 1, false);
        if (wr == 1) PG8_BAR;
        PG8_WAIT_V(2); PG8_BAR;
        PG8_STAGE(PG8_SB(1, 0), cB + kstep, voffB); PG8_STAGE_A(PG8_SA(1, 0), cA + kstep, 0, false); PG8_STAGE(PG8_SB(1, 1), cB + hstep + kstep, voffB);
        PG8_WAIT_V(6); PG8_BAR;
    } else {
        PG8_STAGE(PG8_SB(0, 0), cB, voffB); PG8_STAGE_A(PG8_SA(0, 0), cA, 0, false); PG8_STAGE(PG8_SB(0, 1), cB + hstep, voffB); PG8_STAGE_A(PG8_SA(0, 1), cA, 1, false);
        if (wr == 1) PG8_BAR;
        PG8_WAIT_V(4); PG8_BAR;
        PG8_STAGE(PG8_SB(1, 0), cB + kstep, voffB); PG8_STAGE_A(PG8_SA(1, 0), cA + kstep, 0, false); PG8_STAGE(PG8_SB(1, 1), cB + hstep + kstep, voffB);
        PG8_WAIT_V(6); PG8_BAR;
    }
    for (;;) {
        const bool has_next = S.next(ui + 1, nxt);
        const char* nA = GATHER ? cA : (has_next ? (const char*)g.A + (size_t)nxt.pm * tstep : cA);
        if constexpr (GATHER) { if (has_next) PG8_LDIDX(vgn, nxt.pm); else { vgn[0][0] = vgc[0][0]; vgn[0][1] = vgc[0][1]; vgn[1][0] = vgc[1][0]; vgn[1][1] = vgc[1][1]; } }
        const char* nB = has_next ? (const char*)g.Bt + (size_t)nxt.pn * tstep : cB;
_Pragma("nounroll")
        for (int t = 0; t < nt; t += 2) {
            const bool last = (t == nt - 2);
            const char* a1 = cA + (size_t)(t + 1) * kstep;
            const char* a2 = last ? nA : cA + (size_t)(t + 2) * kstep; const char* b2 = last ? nB : cB + (size_t)(t + 2) * kstep;
            const char* a3 = a2 + kstep; const char* b3 = b2 + kstep;
            if (last && has_next) S.a_ready(nxt);
            if constexpr (SP2) {
            PG8_LDB(B0, 0, 0); PG8_LDB(B1, 0, 1); PG8_SCHED; PG8_LDA(At, 0, 0); PG8_STAGE_A(PG8_SA(1, 1), a1, 1, false);
            PG8_WAIT_V(8); PG8_WAIT_L(0); PG8_BAR; PG8_MMA(0, 0, At, B0); PG8_MMA(0, 1, At, B1); PG8_BAR; PG8_SCHED;
            PG8_LDA(At, 0, 1); PG8_STAGE(PG8_SB(0, 0), b2, voffB); PG8_STAGE(PG8_SB(0, 1), b2 + hstep, voffB); PG8_STAGE_A(PG8_SA(0, 0), a2, 0, last);
            PG8_WAIT_V(8); PG8_WAIT_L(0); PG8_BAR; PG8_MMA(1, 0, At, B0); PG8_MMA(1, 1, At, B1); PG8_BAR; PG8_SCHED;
            PG8_LDB(B0, 1, 0); PG8_LDB(B1, 1, 1); PG8_SCHED; PG8_LDA(At, 1, 0); PG8_STAGE_A(PG8_SA(0, 1), a2, 1, last);
            PG8_WAIT_V(8); PG8_WAIT_L(0); PG8_BAR; PG8_MMA(0, 0, At, B0); PG8_MMA(0, 1, At, B1); PG8_BAR; PG8_SCHED;
            PG8_LDA(At, 1, 1); PG8_STAGE(PG8_SB(1, 0), b3, voffB); PG8_STAGE(PG8_SB(1, 1), b3 + hstep, voffB); PG8_STAGE_A(PG8_SA(1, 0), a3, 0, last);
            PG8_WAIT_V(8); PG8_WAIT_L(0); PG8_BAR; PG8_MMA(1, 0, At, B0); PG8_MMA(1, 1, At, B1); PG8_BAR; PG8_SCHED;
            } else {
            PG8_LDB(B0, 0, 0); PG8_SCHED; PG8_LDA(At, 0, 0); PG8_STAGE_A(PG8_SA(1, 1), a1, 1, false);
            PG8_WAIT_L(8); PG8_BAR; PG8_WAIT_L(0); PG8_MMA(0, 0, At, B0); PG8_BAR; PG8_SCHED;
            PG8_LDB(B1, 0, 1); PG8_STAGE(PG8_SB(0, 0), b2, voffB);
            PG8_BAR; PG8_WAIT_L(0); PG8_MMA(0, 1, At, B1); PG8_BAR;
            PG8_LDA(At, 0, 1); PG8_STAGE_A(PG8_SA(0, 0), a2, 0, last);
            PG8_BAR; PG8_WAIT_L(0); PG8_MMA(1, 0, At, B0); PG8_BAR; PG8_SCHED;
            PG8_STAGE(PG8_SB(0, 1), b2 + hstep, voffB);
            PG8_WAIT_V(6); PG8_BAR; PG8_MMA(1, 1, At, B1); PG8_BAR;
            PG8_LDB(B0, 1, 0); PG8_SCHED; PG8_LDA(At, 1, 0); PG8_STAGE_A(PG8_SA(0, 1), a2, 1, last);
            PG8_WAIT_L(8); PG8_BAR; PG8_WAIT_L(0); PG8_MMA(0, 0, At, B0); PG8_BAR; PG8_SCHED;
            PG8_LDB(B1, 1, 1); PG8_STAGE(PG8_SB(1, 0), b3, voffB);
            PG8_BAR; PG8_WAIT_L(0); PG8_MMA(0, 1, At, B1); PG8_BAR;
            PG8_LDA(At, 1, 1); PG8_STAGE_A(PG8_SA(1, 0), a3, 0, last);
            PG8_BAR; PG8_WAIT_L(0); PG8_MMA(1, 0, At, B0); PG8_BAR; PG8_SCHED;
            PG8_STAGE(PG8_SB(1, 1), b3 + hstep, voffB);
            PG8_WAIT_V(6); PG8_BAR; PG8_MMA(1, 1, At, B1); PG8_BAR;
            }
        }
        if constexpr (ALIGN_EPI) { if (wr == 0) PG8_BAR; }
        if constexpr (F8 != 0) asm volatile("s_nop 15\n\ts_nop 15" ::: "memory");
        if constexpr (!Epi::AFTER_DRAIN) { E(acc, cur, wr, wc, fr, fq); S.done(cur); }
        if (!has_next) break;
#pragma unroll
        for (int a = 0; a < 2; ++a)
#pragma unroll
            for (int b = 0; b < 2; ++b)
#pragma unroll
                for (int m = 0; m < 4; ++m)
#pragma unroll
                    for (int n = 0; n < 2; ++n) acc[a][b][m][n] = (f32x4){0.f, 0.f, 0.f, 0.f};
        cur = nxt; cA = nA; cB = nB; ++ui;
        if constexpr (GATHER) { vgc[0][0] = vgn[0][0]; vgc[0][1] = vgn[0][1]; vgc[1][0] = vgn[1][0]; vgc[1][1] = vgn[1][1]; }
        if constexpr (ALIGN_EPI) { if (wr == 1) PG8_BAR; }
    }
    PG8_WAIT_V(0);
    if constexpr (!ALIGN_EPI) { if (wr == 0) PG8_BAR; }
    PG8_BAR;
    if constexpr (Epi::AFTER_DRAIN) { E.fused(acc, cur, wr, wc, fr, fq, lds, wid, lane); S.done(cur); }
#undef PG8_SA
#undef PG8_SB
#undef PG8_STAGE
#undef PG8_LDA
#undef PG8_STAGE_A
#undef PG8_LDIDX
#undef PG8_LDB
#undef PG8_MMA
#undef PG8_WAIT_V
#undef PG8_WAIT_L
#undef PG8_BAR
#undef PG8_SCHED
}
}

constexpr int NB = 8, T = 4096, D = 1024, NTOK = NB * T;
constexpr int ATT_H = 8, ATT_D = 64, ATT_W = 512, KV_LAT = 256, IDX_H = 8, IDX_D = 64, TOPK = 256;
constexpr int HG_H = 4, HG_DK = 128, HG_DV = 128, HG_W = 512, HG_C = 32;
constexpr int D_IN = 3400, D_INP = 3584;
constexpr int C_AQ = 0, C_AC = 512, C_IQ = 768, C_IK = 1280, C_IW = 1344, C_GQ = 1352, C_GF = 1864, C_GI = 2376, C_GG = 2888;
constexpr int NE = 32, TOPE = 4, DFF = 1024, PLE = 256;
constexpr int NASSIGN = NTOK * TOPE, CAP = NASSIGN + NE * 256;
constexpr int MAXTILES = CAP / 256;
constexpr float LN_EPS = 1e-5f, RMS_EPS = 1e-6f, ALPHA = 1.189207115002721f;

constexpr size_t MiB = 1u << 20;
constexpr size_t WS_CTL = 0, CTL_ZERO_BYTES = 64 * 1024;
constexpr size_t WS_WIN_T = 1 * MiB, WS_WO_T = 8 * MiB, WS_WUP_T = 10 * MiB, WS_WDN_T = 138 * MiB, WS_WPROJ_T = 202 * MiB, WS_WGATE_T = 203 * MiB;
constexpr size_t WS_WUK_T = 205 * MiB, WS_WUV_T = 205 * MiB + 512 * 1024;
constexpr size_t WS_SMALL = 206 * MiB;
constexpr size_t WS_A = 208 * MiB;
constexpr size_t WS_B = 480 * MiB;
constexpr size_t WS_X1 = 752 * MiB;
constexpr size_t WS_XB = 880 * MiB;
constexpr size_t WS_PROJ = 944 * MiB;
constexpr size_t WS_SM2 = 1008 * MiB;
constexpr size_t WS_END = 1016 * MiB;
constexpr size_t WS_H = WS_A, WS_XS = WS_A, WS_YSLOT = WS_A;
constexpr size_t WS_XBF = WS_X1 + 64 * MiB, WS_U = WS_B, WS_YMIX = WS_B, WS_HH = WS_B;
constexpr size_t WS_QDEC = WS_B + 128 * MiB, WS_PB = WS_B + 128 * MiB, WS_OREC = WS_B + 160 * MiB, WS_CN = WS_B + 224 * MiB, WS_IKN = WS_B + 240 * MiB, WS_MASK = WS_B + 244 * MiB;
constexpr size_t WS_K = WS_XB, WS_VT = WS_XB + 32 * MiB;
constexpr size_t WS_SLOTTOK = WS_SM2 + 5 * MiB;
constexpr size_t WS_TOPE = WS_SM2, WS_GATE = WS_SM2 + 512 * 1024, WS_LRANK = WS_SM2 + 1024 * 1024, WS_TOKSLOT = WS_SM2 + 1536 * 1024, WS_SLOTGATE = WS_SM2 + 2 * MiB, WS_DECAY = WS_SM2 + 3 * MiB;
constexpr size_t WS_WRT = WS_SMALL + 256 * 1024;
constexpr size_t WS_WGBASE = WS_SMALL, WS_TILEE = WS_SMALL + 64 * 1024;
constexpr int CW_CNT = 64;
constexpr int CW_BAR = 1024;
constexpr int XBW_OFF = 147456 - 16;

constexpr int RING_BYTES = 131072, MISC_OFF = RING_BYTES, LDS_BYTES = 147456;
constexpr int NWAVES = 8, NTHR = 512;

#define GAS __attribute__((address_space(1)))
#define LAS __attribute__((address_space(3)))
typedef unsigned short bf16;
typedef unsigned v4u __attribute__((ext_vector_type(4)));
typedef unsigned v2u __attribute__((ext_vector_type(2)));
typedef float f32x4 __attribute__((ext_vector_type(4)));
typedef short bf16x8 __attribute__((ext_vector_type(8)));
#define LDS_WAIT() asm volatile("s_waitcnt lgkmcnt(0)" ::: "memory")
#define VM_WAIT() asm volatile("s_waitcnt vmcnt(0)" ::: "memory")
__device__ __forceinline__ unsigned f2bf(float f) { unsigned u = __builtin_bit_cast(unsigned, f); return (u + 0x7fffu + ((u >> 16) & 1u)) >> 16; }
__device__ __forceinline__ unsigned pk2(float lo, float hi) { return f2bf(lo) | (f2bf(hi) << 16); }
__device__ __forceinline__ float bf2f(unsigned short b) { return __builtin_bit_cast(float, (unsigned)b << 16); }
__device__ __forceinline__ float bflo(unsigned w) { return __builtin_bit_cast(float, w << 16); }
__device__ __forceinline__ float bfhi(unsigned w) { return __builtin_bit_cast(float, w & 0xffff0000u); }
__device__ __forceinline__ float wave_sum(float v) {
#pragma unroll
    for (int o = 1; o < 64; o <<= 1) v += __shfl_xor(v, o);
    return v;
}
__device__ __forceinline__ float sigmoidf_(float x) { return __builtin_amdgcn_rcpf(1.f + __builtin_amdgcn_exp2f(x * -1.4426950408889634f)); }

__device__ __forceinline__ unsigned pk4_fp8(float a, float b, float c, float d);
struct Params { const float* in[25]; float* out; unsigned char* ws; };
enum { I_X = 0, I_P, I_WIN, I_KVG, I_IKG, I_IKB, I_WUK, I_WUV, I_HGLB, I_HGNG, I_WO, I_LNMG, I_LNMB, I_WR, I_BR, I_WUP, I_BUP, I_WDN, I_BDN, I_LNFG, I_LNFB, I_WPP, I_WPG, I_LNPG, I_LNPB };

struct Ctx { LAS unsigned char* lds; int tid, lane, wave, G, gw, ngw; };

namespace pg8 {
struct EpiBf16s {
    static constexpr bool PERM = true, AFTER_DRAIN = false;
    bf16_t* O; int ldc;
    __device__ __forceinline__ void operator()(const f32x4 (&acc)[2][2][4][2], const Unit& u, int wr, int wc, int fr, int fq) const {
        const int row0 = u.pm * BM + wr * 64 + fr, col0 = u.pn * BM + wc * 32 + 8 * fq;
#pragma unroll
        for (int ai = 0; ai < 2; ++ai)
#pragma unroll
            for (int m = 0; m < 4; ++m) { bf16_t* rowp = O + (size_t)(row0 + ai * HALF + m * 16) * ldc + col0;
#pragma unroll
                for (int bj = 0; bj < 2; ++bj) { const f32x4 v0 = acc[ai][bj][m][0], v1 = acc[ai][bj][m][1];
                    u32x4 w; w.x = cvt_pk_bf16(v0[0], v0[1]); w.y = cvt_pk_bf16(v0[2], v0[3]); w.z = cvt_pk_bf16(v1[0], v1[1]); w.w = cvt_pk_bf16(v1[2], v1[3]);
                    *(u32x4*)(rowp + bj * HALF) = w; } }
    }
};
struct EpiResid {
    static constexpr bool PERM = false, AFTER_DRAIN = false;
    const bf16_t* res; bf16_t* out; int ldc; float alpha, as;
    __device__ __forceinline__ void operator()(const f32x4 (&acc)[2][2][4][2], const Unit& u, int wr, int wc, int fr, int fq) const {
        const int row0 = u.pm * BM + wr * 64 + fr, col0 = u.pn * BM + wc * 32 + 4 * fq;
#pragma unroll
        for (int ai = 0; ai < 2; ++ai)
#pragma unroll
            for (int m = 0; m < 4; ++m) { const size_t off = (size_t)(row0 + ai * HALF + m * 16) * ldc + col0;
#pragma unroll
                for (int bj = 0; bj < 2; ++bj)
#pragma unroll
                    for (int n = 0; n < 2; ++n) { const v2u rw = *(const v2u*)(res + off + bj * HALF + n * 16); const f32x4 r = {bflo(rw.x), bfhi(rw.x), bflo(rw.y), bfhi(rw.y)}; const f32x4 o = r * alpha + acc[ai][bj][m][n] * as; v2u w; w.x = cvt_pk_bf16(o[0], o[1]); w.y = cvt_pk_bf16(o[2], o[3]); *(v2u*)(out + off + bj * HALF + n * 16) = w; }
                asm volatile("" ::: "memory"); }
    }
};
struct EpiPle {
    static constexpr bool PERM = false, AFTER_DRAIN = false;
    const bf16_t* x2; const bf16_t* proj; bf16_t* out; float alpha, as;
    __device__ __forceinline__ void operator()(const f32x4 (&acc)[2][2][4][2], const Unit& u, int wr, int wc, int fr, int fq) const {
        const int row0 = u.pm * BM + wr * 64 + fr, col0 = u.pn * BM + wc * 32 + 4 * fq;
#pragma unroll
        for (int ai = 0; ai < 2; ++ai)
#pragma unroll
            for (int m = 0; m < 4; ++m) { const size_t off = (size_t)(row0 + ai * HALF + m * 16) * 1024 + col0;
#pragma unroll
                for (int bj = 0; bj < 2; ++bj)
#pragma unroll
                    for (int n = 0; n < 2; ++n) { const size_t o2 = off + bj * HALF + n * 16; const v2u rw = *(const v2u*)(x2 + o2); const f32x4 r = {bflo(rw.x), bfhi(rw.x), bflo(rw.y), bfhi(rw.y)}; const v2u pw = *(const v2u*)(proj + o2);
                        const f32x4 a = acc[ai][bj][m][n] * as; f32x4 o;
                        o[0] = r[0] * alpha + bflo(pw.x) * sigmoidf_(a[0]); o[1] = r[1] * alpha + bfhi(pw.x) * sigmoidf_(a[1]);
                        o[2] = r[2] * alpha + bflo(pw.y) * sigmoidf_(a[2]); o[3] = r[3] * alpha + bfhi(pw.y) * sigmoidf_(a[3]);
                        v2u ow; ow.x = cvt_pk_bf16(o[0], o[1]); ow.y = cvt_pk_bf16(o[2], o[3]); *(v2u*)(out + o2) = ow; }
                asm volatile("" ::: "memory"); }
    }
};
struct EpiSwiglu {
    static constexpr bool PERM = true, AFTER_DRAIN = false;
    unsigned char* H; const float* b_up;
    __device__ __forceinline__ void operator()(const f32x4 (&acc)[2][2][4][2], const Unit& u, int wr, int wc, int fr, int fq) const {
        const int e = u.pn >> 3, pnT = u.pn & 7;
        const int row0 = u.pm * BM + wr * 64 + fr, col0 = pnT * 128 + wc * 32 + 8 * fq;
        const float* bg = b_up + (size_t)e * 2048 + col0; const float* bl = bg + 1024;
        float bgv[8], blv[8];
#pragma unroll
        for (int j = 0; j < 8; ++j) { bgv[j] = bg[j]; blv[j] = bl[j]; }
#pragma unroll
        for (int ai = 0; ai < 2; ++ai)
#pragma unroll
            for (int m = 0; m < 4; ++m) { unsigned char* rowp = H + (size_t)(row0 + ai * HALF + m * 16) * 1024 + col0; float a[8];
#pragma unroll
                for (int n = 0; n < 2; ++n)
#pragma unroll
                    for (int j = 0; j < 4; ++j) { float g = acc[ai][0][m][n][j] * (1.f / 512.f) + bgv[4 * n + j], l = acc[ai][1][m][n][j] * (1.f / 512.f) + blv[4 * n + j];
                        g = fminf(g, 7.0f); l = fminf(fmaxf(l, -7.0f), 7.0f); a[4 * n + j] = g * sigmoidf_(1.702f * g) * (l + 1.0f); }
                v2u w; w.x = pk4_fp8(a[0] * 4.f, a[1] * 4.f, a[2] * 4.f, a[3] * 4.f); w.y = pk4_fp8(a[4] * 4.f, a[5] * 4.f, a[6] * 4.f, a[7] * 4.f);
                *(v2u*)rowp = w; }
    }
};
struct EpiDown {
    static constexpr bool PERM = true, AFTER_DRAIN = false;
    unsigned char* Y; const float* b_dn; const float* gate;
    __device__ __forceinline__ void operator()(const f32x4 (&acc)[2][2][4][2], const Unit& u, int wr, int wc, int fr, int fq) const {
        const int e = u.pn >> 2, pnT = u.pn & 3;
        const int row0 = u.pm * BM + wr * 64 + fr, col0 = pnT * 256 + wc * 32 + 8 * fq;
        const float* bb = b_dn + (size_t)e * 1024 + col0;
        float bv[2][8];
#pragma unroll
        for (int bj = 0; bj < 2; ++bj)
#pragma unroll
            for (int j = 0; j < 8; ++j) bv[bj][j] = bb[bj * HALF + j];
#pragma unroll
        for (int ai = 0; ai < 2; ++ai)
#pragma unroll
            for (int m = 0; m < 4; ++m) { const int row = row0 + ai * HALF + m * 16; const float gt = gate[row] * 64.f; unsigned char* rowp = Y + (size_t)row * 1024 + col0;
#pragma unroll
                for (int bj = 0; bj < 2; ++bj) { const f32x4 v0 = acc[ai][bj][m][0], v1 = acc[ai][bj][m][1];
                    const float as = 1.f / 256.f;
                    v2u w; w.x = pk4_fp8((v0[0] * as + bv[bj][0]) * gt, (v0[1] * as + bv[bj][1]) * gt, (v0[2] * as + bv[bj][2]) * gt, (v0[3] * as + bv[bj][3]) * gt);
                    w.y = pk4_fp8((v1[0] * as + bv[bj][4]) * gt, (v1[1] * as + bv[bj][5]) * gt, (v1[2] * as + bv[bj][6]) * gt, (v1[3] * as + bv[bj][7]) * gt);
                    *(v2u*)(rowp + bj * HALF) = w; } }
    }
};
struct MoeOrder {
    const int* tile_e; int ntiles, nN, G, c;
    __device__ __forceinline__ bool next(int i, Unit& u) const {
        if ((G & 7) == 0) {
            const int x = c & 7, s = i * (G >> 3) + (c >> 3);
            const int cg = nN >> 2, rg = 8 / cg;
            const int ch = x % cg, rc = x / cg;
            const int lr = s >> 2, pl = 4 * ch + (s & 3), pm = rc + rg * lr;
            if (pm >= ntiles) return false;
            u.pm = pm; u.pn = tile_e[pm] * nN + pl; return true;
        }
        const int L = i * G + c; if (L >= ntiles * nN) return false;
        const int pm = L / nN, pl = L - pm * nN; u.pm = pm; u.pn = tile_e[pm] * nN + pl; return true;
    }
    __device__ __forceinline__ void a_ready(const Unit&) const {}
    __device__ __forceinline__ void done(const Unit&) const {}
};
}

template <class RowMap>
__device__ __forceinline__ void transpose_item(const float* W, int ldw, int Nvalid, bf16* WT, int Kdim, RowMap rm, LAS float* scr, int kb, int nb, int lane) {
    const int k0 = 64 * kb, n0 = 32 * nb; const int nl0 = lane & 31, nn = n0 + nl0;
#pragma unroll 8
    for (int i = 0; i < 32; ++i) { const int kk = 2 * i + (lane >> 5); scr[kk * 33 + nl0] = (nn < Nvalid) ? W[(size_t)(k0 + kk) * ldw + nn] : 0.f; }
    LDS_WAIT(); asm volatile("" ::: "memory");
    const int c = lane & 7;
#pragma unroll
    for (int j = 0; j < 4; ++j) { const int n = (lane >> 3) + 8 * j; const LAS float* s = scr + (8 * c) * 33 + n;
        v4u o; o.x = pk2(s[0 * 33], s[1 * 33]); o.y = pk2(s[2 * 33], s[3 * 33]); o.z = pk2(s[4 * 33], s[5 * 33]); o.w = pk2(s[6 * 33], s[7 * 33]);
        *(GAS v4u*)(WT + (size_t)rm(n0 + n) * Kdim + k0 + 8 * c) = o; }
    LDS_WAIT(); asm volatile("" ::: "memory");
}
__device__ __forceinline__ unsigned pk4_fp8(float a, float b, float c, float d) { int r = 0; r = __builtin_amdgcn_cvt_pk_fp8_f32(a, b, r, false); r = __builtin_amdgcn_cvt_pk_fp8_f32(c, d, r, true); return (unsigned)r; }
template <class RowMap>
__device__ __forceinline__ void transpose_item_f8(const float* W, int ldw, unsigned char* WT, int Kdim, RowMap rm, LAS float* scr, int kb, int nb, int lane, float mul) {
    const int k0 = 64 * kb, n0 = 32 * nb; const int nl0 = lane & 31, nn = n0 + nl0;
#pragma unroll 8
    for (int i = 0; i < 32; ++i) { const int kk = 2 * i + (lane >> 5); scr[kk * 33 + nl0] = W[(size_t)(k0 + kk) * ldw + nn] * mul; }
    LDS_WAIT(); asm volatile("" ::: "memory");
    const int c = lane & 7;
#pragma unroll
    for (int j = 0; j < 4; ++j) { const int n = (lane >> 3) + 8 * j; const LAS float* s = scr + (8 * c) * 33 + n;
        v2u o; o.x = pk4_fp8(s[0 * 33], s[1 * 33], s[2 * 33], s[3 * 33]); o.y = pk4_fp8(s[4 * 33], s[5 * 33], s[6 * 33], s[7 * 33]);
        *(GAS v2u*)(WT + (size_t)rm(n0 + n) * Kdim + k0 + 8 * c) = o; }
    LDS_WAIT(); asm volatile("" ::: "memory");
}
struct RmId { __device__ __forceinline__ int operator()(int n) const { return n; } };
struct RmUp { int e; __device__ __forceinline__ int operator()(int n) const { return e * 2048 + ((n & 1023) >> 7) * 256 + (n >> 10) * 128 + (n & 127); } };
struct RmOff { int off; __device__ __forceinline__ int operator()(int n) const { return off + n; } };

struct CvtItem { const float* src; unsigned char* dst; int ldw; };
__device__ __forceinline__ CvtItem cvt_decode(const Params& P, int r) {
    unsigned char* ws = P.ws; CvtItem c;
    constexpr int I_O = 8 * 32, I_UP = 8 * 64, I_DN = 8 * 32;
    if (r < I_O) { const int kb = r / 32, nb = r % 32; c.src = P.in[I_WO] + (size_t)(128 * kb) * 1024 + 32 * nb; c.ldw = 1024; c.dst = ws + WS_WO_T + (size_t)(32 * nb) * 1024 + 128 * kb; return c; } r -= I_O;
    if (r < NE * I_UP) { const int e = r / I_UP, q = r % I_UP, kb = q / 64, nb = q % 64, n0 = 32 * nb; c.src = P.in[I_WUP] + (size_t)e * 1024 * 2048 + (size_t)(128 * kb) * 2048 + n0; c.ldw = 2048;
        c.dst = ws + WS_WUP_T + (size_t)(e * 2048 + ((n0 & 1023) >> 7) * 256 + (n0 >> 10) * 128 + (n0 & 127)) * 1024 + 128 * kb; return c; } r -= NE * I_UP;
    if (r < NE * I_DN) { const int e = r / I_DN, q = r % I_DN, kb = q / 32, nb = q % 32; c.src = P.in[I_WDN] + (size_t)e * 1024 * 1024 + (size_t)(128 * kb) * 1024 + 32 * nb; c.ldw = 1024;
        c.dst = ws + WS_WDN_T + (size_t)(e * 1024 + 32 * nb) * 1024 + 128 * kb; return c; } r -= NE * I_DN;
    { const int kb = r / 32, nb = r % 32; c.src = P.in[I_WPG] + (size_t)(128 * kb) * 1024 + 32 * nb; c.ldw = 1024; c.dst = ws + WS_WGATE_T + (size_t)(32 * nb) * 1024 + 128 * kb; return c; }
}
__device__ __forceinline__ void cvt_load(const CvtItem& c, float (&v)[64], int lane) {
    const float* p = c.src + (size_t)(lane >> 5) * c.ldw + (lane & 31);
#pragma unroll
    for (int i = 0; i < 64; ++i) v[i] = p[(size_t)(2 * i) * c.ldw];
}
__device__ __forceinline__ void cvt_store(const CvtItem& c, const float (&v)[64], LAS float* scr, int lane) {
#pragma unroll
    for (int i = 0; i < 64; ++i) scr[(2 * i + (lane >> 5)) * 33 + (lane & 31)] = v[i] * 64.f;
    LDS_WAIT(); asm volatile("" ::: "memory");
    const int ch = lane & 15;
#pragma unroll
    for (int j = 0; j < 8; ++j) { const int n = (lane >> 4) + 4 * j; const LAS float* s = scr + (8 * ch) * 33 + n;
        v2u o; o.x = pk4_fp8(s[0 * 33], s[1 * 33], s[2 * 33], s[3 * 33]); o.y = pk4_fp8(s[4 * 33], s[5 * 33], s[6 * 33], s[7 * 33]);
        *(GAS v2u*)(c.dst + (size_t)n * 1024 + 8 * ch) = o; }
    LDS_WAIT(); asm volatile("" ::: "memory");
}
__device__ __forceinline__ void convert_late(const Params& P, LAS float* scr, int gwc, int ngwc, int lane) {
    constexpr int NT = 8 * 32 + NE * 8 * 64 + NE * 8 * 32 + 8 * 32;
    float va[64], vb[64];
    int it = gwc;
    if (it < NT) { const CvtItem c = cvt_decode(P, it); cvt_load(c, va, lane); }
    for (; it < NT; it += 2 * ngwc) {
        const int i1 = it + ngwc, i2 = it + 2 * ngwc;
        if (i1 < NT) { const CvtItem c = cvt_decode(P, i1); cvt_load(c, vb, lane); }
        { const CvtItem c = cvt_decode(P, it); cvt_store(c, va, scr, lane); }
        if (i2 < NT) { const CvtItem c = cvt_decode(P, i2); cvt_load(c, va, lane); }
        if (i1 < NT) { const CvtItem c = cvt_decode(P, i1); cvt_store(c, vb, scr, lane); }
    }
    for (int r = gwc; r < 512; r += ngwc) { const int i = r * 64 + lane; const int e = i >> 10, k = i & 1023; ((float*)(P.ws + WS_WRT))[i] = P.in[I_WR][k * 32 + e]; }
}
__device__ __forceinline__ void p0_prologue(const Params& P, const Ctx& C) {
    LAS float* scr = (LAS float*)(C.lds + C.wave * 16384);
    unsigned char* ws = P.ws;
    constexpr int I_IN = 16 * (D_INP / 32), I_PP = 4 * 32, I_UK = 4 * 16, I_UV = 4 * 16;
    constexpr int NITEMS = I_IN + I_PP + I_UK + I_UV;
    for (int it = C.gw; it < NITEMS; it += C.ngw) {
        int r = it;
        if (r < I_IN) { transpose_item(P.in[I_WIN], D_IN, D_IN, (bf16*)(ws + WS_WIN_T), 1024, RmId{}, scr, r / (D_INP / 32), r % (D_INP / 32), C.lane); continue; } r -= I_IN;
        if (r < I_PP) { transpose_item(P.in[I_WPP], 1024, 1024, (bf16*)(ws + WS_WPROJ_T), 256, RmId{}, scr, r / 32, r % 32, C.lane); continue; } r -= I_PP;
        if (r < I_UK) { transpose_item(P.in[I_WUK], 512, 512, (bf16*)(ws + WS_WUK_T), 256, RmId{}, scr, r / 16, r % 16, C.lane); continue; } r -= I_UK;
        transpose_item(P.in[I_WUV], 512, 512, (bf16*)(ws + WS_WUV_T), 256, RmId{}, scr, r / 16, r % 16, C.lane);
    }
    {
        const float* x = P.in[I_X]; bf16* xb = (bf16*)(ws + WS_XBF);
        const size_t n8 = (size_t)NTOK * D / 8, stride = (size_t)C.ngw * 64;
        for (size_t i = (size_t)C.gw * 64 + C.lane; i < n8; i += stride) { const f32x4 a = *(const GAS f32x4*)(x + i * 8), b = *(const GAS f32x4*)(x + i * 8 + 4);
            v4u o; o.x = pk2(a[0], a[1]); o.y = pk2(a[2], a[3]); o.z = pk2(b[0], b[1]); o.w = pk2(b[2], b[3]); *(GAS v4u*)(xb + i * 8) = o; }
        const float* p = P.in[I_P]; bf16* pb = (bf16*)(ws + WS_PB);
        const size_t m8 = (size_t)NTOK * PLE / 8;
        for (size_t i = (size_t)C.gw * 64 + C.lane; i < m8; i += stride) { const f32x4 a = *(const GAS f32x4*)(p + i * 8), b = *(const GAS f32x4*)(p + i * 8 + 4);
            v4u o; o.x = pk2(a[0], a[1]); o.y = pk2(a[2], a[3]); o.z = pk2(b[0], b[1]); o.w = pk2(b[2], b[3]); *(GAS v4u*)(pb + i * 8) = o; }
    }
}

__device__ __forceinline__ void ln_row(f32x4 (&v)[4], const float* g, const float* b, int lane) {
    float s = 0.f;
#pragma unroll
    for (int j = 0; j < 4; ++j) s += (v[j][0] + v[j][1]) + (v[j][2] + v[j][3]);
    const float mean = wave_sum(s) * (1.f / D); float s2 = 0.f;
#pragma unroll
    for (int j = 0; j < 4; ++j) { v[j] = v[j] - mean; s2 += (v[j][0] * v[j][0] + v[j][1] * v[j][1]) + (v[j][2] * v[j][2] + v[j][3] * v[j][3]); }
    const float rstd = __builtin_amdgcn_rsqf(wave_sum(s2) * (1.f / D) + LN_EPS);
#pragma unroll
    for (int j = 0; j < 4; ++j) { const f32x4 gg = *(const f32x4*)(g + 4 * lane + 256 * j), bb = *(const f32x4*)(b + 4 * lane + 256 * j); v[j] = v[j] * rstd * gg + bb; }
}
__device__ __forceinline__ void store_row_f32(float* row, const f32x4 (&v)[4], int lane) {
#pragma unroll
    for (int j = 0; j < 4; ++j) *(GAS f32x4*)(row + 4 * lane + 256 * j) = v[j];
}
__device__ __forceinline__ void store_row_bf16(bf16* row, const f32x4 (&v)[4], int lane) {
#pragma unroll
    for (int j = 0; j < 4; ++j) { v2u o; o.x = pk2(v[j][0], v[j][1]); o.y = pk2(v[j][2], v[j][3]); *(GAS v2u*)(row + 4 * lane + 256 * j) = o; }
}
__device__ __forceinline__ void store_row_fp8x8(unsigned char* row, const f32x4 (&v)[4], int lane) {
#pragma unroll
    for (int j = 0; j < 4; ++j) *(GAS unsigned*)(row + 4 * lane + 256 * j) = pk4_fp8(v[j][0] * 8.f, v[j][1] * 8.f, v[j][2] * 8.f, v[j][3] * 8.f);
}
__device__ __forceinline__ f32x4 fp8x4_to_f32(unsigned w) {
    typedef float f2 __attribute__((ext_vector_type(2)));
    const f2 lo = __builtin_amdgcn_cvt_pk_f32_fp8((int)w, false), hi = __builtin_amdgcn_cvt_pk_f32_fp8((int)w, true);
    return (f32x4){lo[0], lo[1], hi[0], hi[1]};
}
__device__ __forceinline__ void load_row_bf16(f32x4 (&v)[4], const bf16* row, int lane) {
#pragma unroll
    for (int j = 0; j < 4; ++j) { const v2u w = *(const GAS v2u*)(row + 4 * lane + 256 * j); v[j] = (f32x4){bflo(w.x), bfhi(w.x), bflo(w.y), bfhi(w.y)}; }
}
__device__ __forceinline__ void load_row_f32(f32x4 (&v)[4], const float* row, int lane) {
#pragma unroll
    for (int j = 0; j < 4; ++j) v[j] = *(const GAS f32x4*)(row + 4 * lane + 256 * j);
}
#ifndef FEAT_MIX
#define FEAT_MIX 1
#endif
#ifndef FEAT_MOE
#define FEAT_MOE 1
#endif
#ifndef FEAT_PLE
#define FEAT_PLE 1
#endif
#ifndef FEAT_ATT
#define FEAT_ATT 1
#endif
#ifndef SYNC_MODE
#define SYNC_MODE 0
#endif
#ifndef PROGRAM
#define PROGRAM X(0) GS X(10) X(11) SY X(20) X(21) SY X(30) X(31) BS X(32) SY X(40) X(41) SY X(5) SY X(6) SY X(7) SY X(8) SY X(9) SY X(100) SY X(110) SY X(120)
#endif
#ifndef COOP_LAUNCH
#define PLAIN_LAUNCH 1
#endif

typedef float f32x16 __attribute__((ext_vector_type(16)));
typedef short s16x4 __attribute__((ext_vector_type(4)));
__device__ __forceinline__ unsigned cvtpk(float lo, float hi) { typedef float f2 __attribute__((ext_vector_type(2))); typedef __bf16 b2 __attribute__((ext_vector_type(2))); f2 v = {lo, hi}; b2 b = __builtin_convertvector(v, b2); return __builtin_bit_cast(unsigned, b); }
__device__ __forceinline__ bf16x8 pack8(const f32x16& x, int base) {
    v4u w; w.x = cvtpk(x[base + 0], x[base + 1]); w.y = cvtpk(x[base + 2], x[base + 3]); w.z = cvtpk(x[base + 4], x[base + 5]); w.w = cvtpk(x[base + 6], x[base + 7]);
    return __builtin_bit_cast(bf16x8, w);
}

__device__ __forceinline__ void p2_post(const Params& P, const Ctx& C) {
    unsigned char* ws = P.ws;
    const bf16* H = (const bf16*)(ws + WS_H); bf16* CN = (bf16*)(ws + WS_CN); bf16* IKN = (bf16*)(ws + WS_IKN);
    const float* kvg = P.in[I_KVG]; const float* ikg = P.in[I_IKG]; const float* ikb = P.in[I_IKB];
    const f32x4 g4 = *(const f32x4*)(kvg + 4 * C.lane); const float ig = ikg[C.lane], ib = ikb[C.lane];
    for (int m = C.gw; m < NTOK; m += C.ngw) {
        const bf16* hr = H + (size_t)m * D_INP;
        const v2u w = *(const GAS v2u*)(hr + C_AC + 4 * C.lane);
        float a0 = bflo(w.x), a1 = bfhi(w.x), a2 = bflo(w.y), a3 = bfhi(w.y);
        const float ss = wave_sum((a0 * a0 + a1 * a1) + (a2 * a2 + a3 * a3));
        const float rs = __builtin_amdgcn_rsqf(ss * (1.f / 256.f) + RMS_EPS);
        v2u o; o.x = pk2(a0 * rs * g4[0], a1 * rs * g4[1]); o.y = pk2(a2 * rs * g4[2], a3 * rs * g4[3]);
        *(GAS v2u*)(CN + (size_t)m * 256 + 4 * C.lane) = o;
        const float k = bf2f(hr[C_IK + C.lane]);
        const float mu = wave_sum(k) * (1.f / 64.f); const float dk = k - mu;
        const float var = wave_sum(dk * dk) * (1.f / 64.f);
        IKN[(size_t)m * 64 + C.lane] = (bf16)f2bf(dk * __builtin_amdgcn_rsqf(var + LN_EPS) * ig + ib);
    }
}

constexpr int HP_QD = 0, HP_KI = 8704, HP_KET = 17408, HP_VT = 27648, HP_GS = 37888, HP_RAW = 40960;
__device__ __forceinline__ void p2_hgrn_prep(const Params& P, const Ctx& C) {
    unsigned char* ws = P.ws;
    const bf16* H = (const bf16*)(ws + WS_H);
    bf16* UT = (bf16*)(ws + WS_U); bf16* QDEC = (bf16*)(ws + WS_QDEC); float* OREC = (float*)(ws + WS_OREC); float* DEC = (float*)(ws + WS_DECAY);
    LAS bf16* QD = (LAS bf16*)(C.lds + HP_QD); LAS bf16* KI = (LAS bf16*)(C.lds + HP_KI); LAS bf16* KET = (LAS bf16*)(C.lds + HP_KET); LAS bf16* VT = (LAS bf16*)(C.lds + HP_VT);
    LAS float* GS = (LAS float*)(C.lds + HP_GS); LAS bf16* RAW = (LAS bf16*)(C.lds + HP_RAW);
    const int d = C.tid & 127, tg = C.tid >> 7;
    const int lane = C.lane, r32 = lane & 31, hf = lane >> 5;
    const int lc = C.tid >> 4, lg = C.tid & 15;
    const int NU = NB * HG_H * (T / HG_C);
    v4u rf, rq, ri;
    { const int unit = blockIdx.x; if (unit < NU) { const int n = unit & 127, hh = (unit >> 7) & 3, b = unit >> 9; const bf16* hr = H + (size_t)(b * T + n * HG_C + lc) * D_INP + hh * 128 + 8 * lg;
        rf = *(const GAS v4u*)(hr + C_GF); rq = *(const GAS v4u*)(hr + C_GQ); ri = *(const GAS v4u*)(hr + C_GI); } }
    for (int unit = blockIdx.x; unit < NU; unit += C.G) {
        const int n = unit & 127, hh = (unit >> 7) & 3, b = unit >> 9;
        const int m0 = b * T + n * HG_C;
        *(LAS v4u*)(RAW + lc * 128 + 8 * lg) = rf; *(LAS v4u*)(RAW + 4096 + lc * 128 + 8 * lg) = rq; *(LAS v4u*)(RAW + 8192 + lc * 128 + 8 * lg) = ri;
        __syncthreads();
        { const int un = unit + C.G; if (un < NU) { const int n2 = un & 127, h2 = (un >> 7) & 3, b2 = un >> 9; const bf16* hr = H + (size_t)(b2 * T + n2 * HG_C + lc) * D_INP + h2 * 128 + 8 * lg;
            rf = *(const GAS v4u*)(hr + C_GF); rq = *(const GAS v4u*)(hr + C_GQ); ri = *(const GAS v4u*)(hr + C_GI); } }
        const float l0 = P.in[I_HGLB][hh * 128 + d], l1 = P.in[I_HGLB][512 + hh * 128 + d];
        const float lb = sigmoidf_(l0 - l1);
        float fg[8], bl[8], qv[8]; float run = 0.f; unsigned vv[4];
#pragma unroll
        for (int c = 0; c < 8; ++c) { const int tok = tg * 8 + c;
            const float f = bf2f(RAW[tok * 128 + d]), q = bf2f(RAW[4096 + tok * 128 + d]); const unsigned iv = RAW[8192 + tok * 128 + d];
            fg[c] = lb + (1.f - lb) * sigmoidf_(f); run += __logf(fg[c]); bl[c] = run; qv[c] = q * sigmoidf_(q);
            if (c & 1) vv[c >> 1] |= iv << 16; else vv[c >> 1] = iv; }
        GS[tg * 128 + d] = run;
        *(LAS v4u*)(VT + d * 40 + tg * 8) = (v4u){vv[0], vv[1], vv[2], vv[3]};
        __syncthreads();
        float pre = 0.f, tot = 0.f;
#pragma unroll
        for (int g = 0; g < 4; ++g) { const float sg = GS[g * 128 + d]; tot += sg; if (g < tg) pre += sg; }
        unsigned ke[4];
#pragma unroll
        for (int c = 0; c < 8; ++c) { const float bc = pre + bl[c]; const float kc = 1.f - fg[c];
            const float qd = qv[c] * __expf(bc), ki = kc * __expf(-bc), kend = kc * __expf(tot - bc);
            const unsigned qb = f2bf(qd);
            QD[(tg * 8 + c) * 136 + d] = (bf16)qb; KI[(tg * 8 + c) * 136 + d] = (bf16)f2bf(ki);
            if (c & 1) ke[c >> 1] |= f2bf(kend) << 16; else ke[c >> 1] = f2bf(kend); }
        *(LAS v4u*)(KET + d * 40 + tg * 8) = (v4u){ke[0], ke[1], ke[2], ke[3]};
        if (tg == 0) DEC[(size_t)unit * 128 + d] = __expf(tot);
        __syncthreads();
        *(GAS v4u*)(QDEC + (size_t)(m0 + lc) * 512 + hh * 128 + 8 * lg) = *(const LAS v4u*)(QD + lc * 136 + 8 * lg);
        if (C.wave < 4) {
            f32x16 X = {0.f, 0.f, 0.f, 0.f, 0.f, 0.f, 0.f, 0.f, 0.f, 0.f, 0.f, 0.f, 0.f, 0.f, 0.f, 0.f};
#pragma unroll
            for (int k = 0; k < 8; ++k) { const bf16x8 a = *(const LAS bf16x8*)(KI + r32 * 136 + 16 * k + 8 * hf), bq = *(const LAS bf16x8*)(QD + r32 * 136 + 16 * k + 8 * hf);
                X = __builtin_amdgcn_mfma_f32_32x32x16_bf16(a, bq, X, 0, 0, 0); }
#pragma unroll
            for (int r = 0; r < 16; ++r) { const int sidx = (r & 3) + 8 * (r >> 2) + 4 * hf; if (sidx > r32) X[r] = 0.f; }
            f32x16 Z = {0.f, 0.f, 0.f, 0.f, 0.f, 0.f, 0.f, 0.f, 0.f, 0.f, 0.f, 0.f, 0.f, 0.f, 0.f, 0.f};
            const int e = C.wave * 32 + r32;
#pragma unroll
            for (int sp = 0; sp < 2; ++sp) { const bf16x8 a = pack8(X, 8 * sp);
                const s16x4 lo = *(const LAS s16x4*)(VT + e * 40 + 16 * sp + 4 * hf), hi = *(const LAS s16x4*)(VT + e * 40 + 16 * sp + 8 + 4 * hf);
                const bf16x8 bv = (bf16x8){lo[0], lo[1], lo[2], lo[3], hi[0], hi[1], hi[2], hi[3]};
                Z = __builtin_amdgcn_mfma_f32_32x32x16_bf16(a, bv, Z, 0, 0, 0); }
#pragma unroll
            for (int r = 0; r < 16; ++r) { const int c = (r & 3) + 8 * (r >> 2) + 4 * hf; OREC[(size_t)(m0 + c) * 512 + hh * 128 + e] = Z[r]; }
        }
        {
            const int dt = C.wave >> 1;
            const bf16x8 a0 = *(const LAS bf16x8*)(KET + (dt * 32 + r32) * 40 + 8 * hf), a1 = *(const LAS bf16x8*)(KET + (dt * 32 + r32) * 40 + 16 + 8 * hf);
#pragma unroll
            for (int ei = 0; ei < 2; ++ei) { const int et = 2 * (C.wave & 1) + ei;
                const bf16x8 b0 = *(const LAS bf16x8*)(VT + (et * 32 + r32) * 40 + 8 * hf), b1 = *(const LAS bf16x8*)(VT + (et * 32 + r32) * 40 + 16 + 8 * hf);
                f32x16 U = {0.f, 0.f, 0.f, 0.f, 0.f, 0.f, 0.f, 0.f, 0.f, 0.f, 0.f, 0.f, 0.f, 0.f, 0.f, 0.f};
                U = __builtin_amdgcn_mfma_f32_32x32x16_bf16(a0, b0, U, 0, 0, 0); U = __builtin_amdgcn_mfma_f32_32x32x16_bf16(a1, b1, U, 0, 0, 0);
                bf16* up = UT + (size_t)unit * 16384 + (size_t)(et * 32 + r32) * 128 + dt * 32 + 4 * hf;
#pragma unroll
                for (int q = 0; q < 4; ++q) { v2u o; o.x = cvtpk(U[4 * q], U[4 * q + 1]); o.y = cvtpk(U[4 * q + 2], U[4 * q + 3]); *(GAS v2u*)(up + 8 * q) = o; } }
        }
        __syncthreads();
    }
}

__device__ __forceinline__ void scan_wave(const Params& P, LAS unsigned char* lds, int unit, int lane) {
    unsigned char* ws = P.ws;
    const bf16* UT = (const bf16*)(ws + WS_U); const bf16* QDEC = (const bf16*)(ws + WS_QDEC); float* OREC = (float*)(ws + WS_OREC); const float* DEC = (const float*)(ws + WS_DECAY);
    typedef float f32x4v __attribute__((ext_vector_type(4)));
    const int xcd = (unit >> 1) & 7, loc = ((unit >> 4) << 1) | (unit & 1);
    const int bh = xcd + 8 * (loc >> 4), sl = loc & 15; const int b = bh >> 2, hh = bh & 3, e0 = 8 * sl;
    LAS bf16* ST = (LAS bf16*)lds;
    const int e = lane & 7, dq = lane >> 3;
    const int fr = lane & 15, fq = lane >> 4;
    float S[16];
#pragma unroll
    for (int i = 0; i < 16; ++i) S[i] = 0.f;
    for (int i = lane; i < 2 * 16 * 136 / 8; i += 64) *(LAS v4u*)(ST + 8 * i) = (v4u){0u, 0u, 0u, 0u};
    const int cu0 = (b * HG_H + hh) * 128;
    const bf16* up = UT + (size_t)cu0 * 16384 + (size_t)(e0 + e) * 128 + 16 * dq;
    const float* dp = DEC + (size_t)cu0 * 128 + 16 * dq;
    const bf16* qp = QDEC + (size_t)(b * T + fr) * 512 + hh * 128 + 8 * fq;
    float* op = OREC + (size_t)(b * T + 4 * fq) * 512 + hh * 128 + e0 + fr;
    const float* opl = OREC + (size_t)(b * T + 4 * fq) * 512 + hh * 128 + e0 + (fr & 7);
    const bool ov = fr < 8;
    v4u un[4][2]; float oi[4][2][4]; f32x4 dn[2][4]; bf16x8 qa[2][2][4];
#define SC_LD_U(slot, n) { un[slot][0] = *(const GAS v4u*)(up + (size_t)(n) * 16384); un[slot][1] = *(const GAS v4u*)(up + (size_t)(n) * 16384 + 8); \
        _Pragma("unroll") for (int t_ = 0; t_ < 2; ++t_) _Pragma("unroll") for (int j_ = 0; j_ < 4; ++j_) oi[slot][t_][j_] = opl[(size_t)((n) * 32 + 16 * t_ + j_) * 512]; }
#define SC_LD_Q(slot, n) { _Pragma("unroll") for (int i_ = 0; i_ < 4; ++i_) dn[slot][i_] = *(const GAS f32x4*)(dp + (size_t)(n) * 128 + 4 * i_); \
        _Pragma("unroll") for (int t_ = 0; t_ < 2; ++t_) _Pragma("unroll") for (int k_ = 0; k_ < 4; ++k_) qa[slot][t_][k_] = *(const GAS bf16x8*)(qp + (size_t)((n) * 32 + 16 * t_) * 512 + 32 * k_); }
    SC_LD_U(0, 0) SC_LD_U(1, 1) SC_LD_U(2, 2) SC_LD_U(3, 3) SC_LD_Q(0, 0) SC_LD_Q(1, 1)
    LDS_WAIT();
    for (int nb = 0; nb < 32; ++nb) {
#pragma unroll
        for (int s = 0; s < 4; ++s) {
            const int n = 4 * nb + s; const int su = s, sq = s & 1;
            const LAS bf16* stc = ST + (n & 1) * (16 * 136); LAS bf16* stn = ST + ((n + 1) & 1) * (16 * 136);
            bf16x8 bs[4];
#pragma unroll
            for (int k = 0; k < 4; ++k) bs[k] = *(const LAS bf16x8*)(stc + fr * 136 + 32 * k + 8 * fq);
#pragma unroll
            for (int t = 0; t < 2; ++t) { f32x4v acc = {oi[su][t][0], oi[su][t][1], oi[su][t][2], oi[su][t][3]};
#pragma unroll
                for (int k = 0; k < 4; ++k) acc = __builtin_amdgcn_mfma_f32_16x16x32_bf16(qa[sq][t][k], bs[k], acc, 0, 0, 0);
                if (ov) {
#pragma unroll
                    for (int j = 0; j < 4; ++j) op[(size_t)(n * 32 + 16 * t + j) * 512] = acc[j]; } }
            {
                const unsigned uw[8] = {un[su][0].x, un[su][0].y, un[su][0].z, un[su][0].w, un[su][1].x, un[su][1].y, un[su][1].z, un[su][1].w};
                unsigned pk[8];
#pragma unroll
                for (int i = 0; i < 8; ++i) { S[2 * i] = dn[sq][i >> 1][(2 * i) & 3] * S[2 * i] + bflo(uw[i]); S[2 * i + 1] = dn[sq][i >> 1][(2 * i + 1) & 3] * S[2 * i + 1] + bfhi(uw[i]); pk[i] = cvtpk(S[2 * i], S[2 * i + 1]); }
                *(LAS v4u*)(stn + e * 136 + 16 * dq) = (v4u){pk[0], pk[1], pk[2], pk[3]}; *(LAS v4u*)(stn + e * 136 + 16 * dq + 8) = (v4u){pk[4], pk[5], pk[6], pk[7]};
            }
            if (n + 4 < 128) SC_LD_U(su, n + 4)
            if (n + 2 < 128) SC_LD_Q(sq, n + 2)
        }
    }
#undef SC_LD_U
#undef SC_LD_Q
}
__device__ __forceinline__ void p3_scan_convert(const Params& P, const Ctx& C) {
    if (C.wave < 2) {
        for (int u = blockIdx.x * 2 + C.wave; u < NB * HG_H * 16; u += C.G * 2) scan_wave(P, C.lds + C.wave * 8704, u, C.lane);
    } else {
        convert_late(P, (LAS float*)(C.lds + 32768 + (C.wave - 2) * 17408), blockIdx.x * 6 + (C.wave - 2), C.G * 6, C.lane);
    }
}

__device__ __forceinline__ void p4_yrec(const Params& P, const Ctx& C) {
    unsigned char* ws = P.ws;
    const float* OREC = (const float*)(ws + WS_OREC); const bf16* H = (const bf16*)(ws + WS_H); bf16* YM = (bf16*)(ws + WS_YMIX);
    const float* ng = P.in[I_HGNG];
    const f32x4 g0 = *(const f32x4*)(ng + 8 * C.lane), g1 = *(const f32x4*)(ng + 8 * C.lane + 4);
    for (int m = C.gw; m < NTOK; m += C.ngw) {
        const f32x4 a = *(const GAS f32x4*)(OREC + (size_t)m * 512 + 8 * C.lane), bq = *(const GAS f32x4*)(OREC + (size_t)m * 512 + 8 * C.lane + 4);
        float ss = (a[0] * a[0] + a[1] * a[1]) + (a[2] * a[2] + a[3] * a[3]) + (bq[0] * bq[0] + bq[1] * bq[1]) + (bq[2] * bq[2] + bq[3] * bq[3]);
        ss += __shfl_xor(ss, 1); ss += __shfl_xor(ss, 2); ss += __shfl_xor(ss, 4); ss += __shfl_xor(ss, 8);
        const float rs = __builtin_amdgcn_rsqf(ss * (1.f / 128.f) + RMS_EPS);
        const v4u gw = *(const GAS v4u*)(H + (size_t)m * D_INP + C_GG + 8 * C.lane);
        float gv[8] = {bflo(gw.x), bfhi(gw.x), bflo(gw.y), bfhi(gw.y), bflo(gw.z), bfhi(gw.z), bflo(gw.w), bfhi(gw.w)};
        float o[8];
#pragma unroll
        for (int j = 0; j < 4; ++j) { o[j] = a[j] * rs * g0[j] * (gv[j] * sigmoidf_(gv[j])); o[4 + j] = bq[j] * rs * g1[j] * (gv[4 + j] * sigmoidf_(gv[4 + j])); }
        v2u w; w.x = pk4_fp8(o[0] * 8.f, o[1] * 8.f, o[2] * 8.f, o[3] * 8.f); w.y = pk4_fp8(o[4] * 8.f, o[5] * 8.f, o[6] * 8.f, o[7] * 8.f);
        *(GAS v2u*)((unsigned char*)YM + (size_t)m * D + 512 + 8 * C.lane) = w;
#if !FEAT_ATT
        *(GAS v4u*)(YM + (size_t)m * D + 8 * C.lane) = (v4u){0u, 0u, 0u, 0u};
#endif
    }
}

namespace pg8 {
struct EpiKhead {
    static constexpr bool PERM = true, AFTER_DRAIN = false;
    bf16_t* O;
    __device__ __forceinline__ void operator()(const f32x4 (&acc)[2][2][4][2], const Unit& u, int wr, int wc, int fr, int fq) const {
        const int row0 = u.pm * BM + wr * 64 + fr, col0 = u.pn * BM + wc * 32 + 8 * fq;
#pragma unroll
        for (int ai = 0; ai < 2; ++ai)
#pragma unroll
            for (int m = 0; m < 4; ++m) { const int row = row0 + ai * HALF + m * 16; const int b = row >> 12, t = row & 4095;
#pragma unroll
                for (int bj = 0; bj < 2; ++bj) { const int col = col0 + bj * HALF; const f32x4 v0 = acc[ai][bj][m][0], v1 = acc[ai][bj][m][1];
                    u32x4 w; w.x = cvt_pk_bf16(v0[0], v0[1]); w.y = cvt_pk_bf16(v0[2], v0[3]); w.z = cvt_pk_bf16(v1[0], v1[1]); w.w = cvt_pk_bf16(v1[2], v1[3]);
                    *(u32x4*)(O + ((size_t)((b * 8 + (col >> 6)) * 4096 + t)) * 64 + (col & 63)) = w; } }
    }
};
struct EpiVt {
    static constexpr bool PERM = true, AFTER_DRAIN = false;
    bf16_t* O;
    __device__ __forceinline__ void operator()(const f32x4 (&acc)[2][2][4][2], const Unit& u, int wr, int wc, int fr, int fq) const {
        const int row0 = u.pm * BM + wr * 64 + fr, col0 = u.pn * BM + wc * 32 + 8 * fq;
#pragma unroll
        for (int ai = 0; ai < 2; ++ai)
#pragma unroll
            for (int m = 0; m < 4; ++m) { const int row = row0 + ai * HALF + m * 16;
#pragma unroll
                for (int bj = 0; bj < 2; ++bj) { const int col = col0 + bj * HALF; const int b = col >> 12, t = col & 4095; const f32x4 v0 = acc[ai][bj][m][0], v1 = acc[ai][bj][m][1];
                    u32x4 w; w.x = cvt_pk_bf16(v0[0], v0[1]); w.y = cvt_pk_bf16(v0[2], v0[3]); w.z = cvt_pk_bf16(v1[0], v1[1]); w.w = cvt_pk_bf16(v1[2], v1[3]);
                    *(u32x4*)(O + ((size_t)(b * 512 + row)) * 4096 + t) = w; } }
    }
};
}

__device__ __forceinline__ unsigned f2ord(float x) { const unsigned b = __builtin_bit_cast(unsigned, x); return b ^ ((unsigned)((int)b >> 31) | 0x80000000u); }
typedef _Float16 h16;
typedef _Float16 h16x8 __attribute__((ext_vector_type(8)));
__device__ __forceinline__ float relu_i(float x) { const int b = __builtin_bit_cast(int, x); return __builtin_bit_cast(float, b > 0 ? b : 0); }
__device__ __forceinline__ unsigned h2ord(unsigned hb) { return (hb ^ ((hb & 0x8000u) ? 0xffffu : 0x8000u)) & 0xffffu; }
__device__ __forceinline__ int isc_bucket(float x, float mu, float scale) { const float t = fminf(fmaxf(fmaf(x - mu, scale, 128.f), 0.f), 255.f); return (int)t; }
__device__ __forceinline__ void p3_indexer(const Params& P, const Ctx& C) {
    unsigned char* ws = P.ws;
    const bf16* H = (const bf16*)(ws + WS_H); const bf16* IKN = (const bf16*)(ws + WS_IKN); unsigned* MASK = (unsigned*)(ws + WS_MASK);
    LAS h16* ISC = (LAS h16*)C.lds; LAS unsigned* HIST = (LAS unsigned*)(C.lds + 131072) + C.wave * 256; LAS float* STAT = (LAS float*)(C.lds + 139264); LAS float* W16 = (LAS float*)(C.lds + 140288);
    const int lane = C.lane, r32 = lane & 31, hf = lane >> 5;
    const int ql = 2 * (r32 >> 4) + ((r32 >> 2) & 1), hd = 4 * ((r32 >> 3) & 1) + (r32 & 3);
    constexpr int CAND_CAP = 120, QU = 16;
    for (int u = blockIdx.x; u < NTOK / QU; u += C.G) {
        const int b = u & 7, j = (u >> 3) & 31, i = u >> 8; const int pi = i >> 1; const int blk = (i & 1) ? (255 - (j + 32 * pi)) : (j + 32 * pi);
        const int t0 = blk * QU; const size_t mb = (size_t)b * T;
        const int nkt = (t0 + QU + 31) >> 5;
        bf16x8 af[4][4];
#pragma unroll
        for (int a = 0; a < 4; ++a) {
            const bf16* qp = H + (mb + t0 + 4 * a + ql) * D_INP + C_IQ + hd * 64 + 8 * hf;
#pragma unroll
            for (int k = 0; k < 4; ++k) af[a][k] = *(const GAS bf16x8*)(qp + 16 * k);
        }
        if (C.tid < 128) { const int q = C.tid >> 3, h8 = C.tid & 7; W16[C.tid] = bf2f(H[(mb + t0 + q) * D_INP + C_IW + h8]) * (0.125f * 0.35355339059327373f); }
        __syncthreads();
        {
            int kt = C.wave; bf16x8 bk[4], bn[4];
            if (kt < nkt) { const bf16* kp = IKN + (mb + kt * 32 + r32) * 64 + 8 * hf;
#pragma unroll
                for (int k = 0; k < 4; ++k) bk[k] = *(const GAS bf16x8*)(kp + 16 * k); }
            for (; kt < nkt; kt += NWAVES) {
                const int s0 = kt * 32;
                if (kt + NWAVES < nkt) { const bf16* kp = IKN + (mb + s0 + 32 * NWAVES + r32) * 64 + 8 * hf;
#pragma unroll
                    for (int k = 0; k < 4; ++k) bn[k] = *(const GAS bf16x8*)(kp + 16 * k); }
#pragma unroll
                for (int a = 0; a < 4; ++a) {
                    f32x16 acc = {0.f, 0.f, 0.f, 0.f, 0.f, 0.f, 0.f, 0.f, 0.f, 0.f, 0.f, 0.f, 0.f, 0.f, 0.f, 0.f};
#pragma unroll
                    for (int k = 0; k < 4; ++k) acc = __builtin_amdgcn_mfma_f32_32x32x16_bf16(af[a][k], bk[k], acc, 0, 0, 0);
#pragma unroll
                    for (int qh = 0; qh < 2; ++qh) { float sa = 0.f, sb = 0.f;
                        const int q = 4 * a + 2 * qh + hf, key = s0 + r32;
                        const f32x4 wl = *(const LAS f32x4*)(W16 + q * 8), wh = *(const LAS f32x4*)(W16 + q * 8 + 4);
                        sa = fmaf(wl[0], relu_i(acc[8 * qh + 0]), sa); sb = fmaf(wl[1], relu_i(acc[8 * qh + 1]), sb); sa = fmaf(wl[2], relu_i(acc[8 * qh + 2]), sa); sb = fmaf(wl[3], relu_i(acc[8 * qh + 3]), sb);
                        sa = fmaf(wh[0], relu_i(acc[8 * qh + 4]), sa); sb = fmaf(wh[1], relu_i(acc[8 * qh + 5]), sb); sa = fmaf(wh[2], relu_i(acc[8 * qh + 6]), sa); sb = fmaf(wh[3], relu_i(acc[8 * qh + 7]), sb);
                        float sv = sa + sb; const bool valid = key <= t0 + q; sv += 0.0f;
                        ISC[q * 4096 + key] = valid ? (h16)sv : (h16)(-INFINITY);
                    }
                }
#pragma unroll
                for (int k = 0; k < 4; ++k) bk[k] = bn[k];
            }
        }
        __syncthreads();
#ifdef PROBE_SEL
        for (int rep_ = 0; rep_ < 2; ++rep_)
#endif
        {
            const LAS unsigned short* row[2]; int tq[2], nq[2]; unsigned* mrow[2];
#pragma unroll
            for (int z = 0; z < 2; ++z) { const int q = C.wave + 8 * z; row[z] = (const LAS unsigned short*)(ISC + q * 4096); tq[z] = t0 + q; nq[z] = tq[z] + 1; mrow[z] = MASK + (mb + tq[z]) * 128; }
            const int nmax = nq[1];
            unsigned dhi[2] = {0u, 0u}; int need[2];
#pragma unroll
            for (int z = 0; z < 2; ++z) need[z] = nq[z] < TOPK ? nq[z] : TOPK;
#pragma unroll
            for (int pass = 1; pass >= 0; --pass) {
                LDS_WAIT();
#pragma unroll
                for (int zz = 0; zz < 4; ++zz) HIST[lane + 64 * zz] = 0u;
                for (int e0 = 8 * lane; e0 < nmax; e0 += 512) {
                    v4u v[2];
#pragma unroll
                    for (int z = 0; z < 2; ++z) v[z] = *(const LAS v4u*)(row[z] + e0);
#pragma unroll
                    for (int z = 0; z < 2; ++z)
#pragma unroll
                        for (int jj = 0; jj < 8; ++jj) { const unsigned w = (jj < 2) ? v[z].x : (jj < 4) ? v[z].y : (jj < 6) ? v[z].z : v[z].w; const unsigned hb = (jj & 1) ? (w >> 16) : (w & 0xffffu);
                            const unsigned key = h2ord(hb); const unsigned bin = pass == 1 ? (key >> 8) : (key & 255u);
                            const bool ok = (e0 + jj < nq[z]) && (pass == 1 || (key >> 8) == dhi[z]);
                            if (ok) atomicAdd((unsigned*)&HIST[128 * z + (bin >> 1)], 1u << (16 * (bin & 1u))); }
                }
                LDS_WAIT();
                unsigned c[2][4], s4[2], suf[2];
#pragma unroll
                for (int z = 0; z < 2; ++z) { const v2u w2 = *(const LAS v2u*)(HIST + 128 * z + 2 * lane); c[z][0] = w2.x & 0xffffu; c[z][1] = w2.x >> 16; c[z][2] = w2.y & 0xffffu; c[z][3] = w2.y >> 16; s4[z] = c[z][0] + c[z][1] + c[z][2] + c[z][3]; suf[z] = s4[z]; }
#pragma unroll
                for (int o = 1; o < 64; o <<= 1) {
#pragma unroll
                    for (int z = 0; z < 2; ++z) { const unsigned v2 = __shfl_down(suf[z], o); if (lane + o < 64) suf[z] += v2; } }
#pragma unroll
                for (int z = 0; z < 2; ++z) { unsigned cum = suf[z] - s4[z]; int dsel = -1; int nnew = 0; const unsigned nd = (unsigned)need[z];
#pragma unroll
                    for (int bb = 3; bb >= 0; --bb) { if (dsel < 0 && cum < nd && nd <= cum + c[z][bb]) { dsel = 4 * lane + bb; nnew = (int)(nd - cum); } cum += c[z][bb]; }
                    const unsigned long long bal = __ballot(dsel >= 0);
                    const int src = (bal != 0ull) ? (int)__builtin_ctzll(bal) : 0;
                    const int dd = __shfl(dsel, src); need[z] = __shfl(nnew, src);
                    if (pass == 1) dhi[z] = (unsigned)dd; else dhi[z] = (dhi[z] << 8) | (unsigned)dd; }
            }
            int run_eq[2] = {0, 0}; unsigned long long mine[2] = {0ull, 0ull}; const int nit = (tq[1] >> 6) + 1;
            const unsigned long long ltm = (1ull << lane) - 1ull;
#pragma unroll 2
            for (int it = 0; it < nit; ++it) { const int e = it * 64 + lane;
#pragma unroll
                for (int z = 0; z < 2; ++z) { const unsigned key = h2ord(row[z][e]); const bool valid = e <= tq[z];
                    const bool eq = valid && (key == dhi[z]); const unsigned long long beq = __ballot(eq);
                    const int rk = run_eq[z] + __builtin_popcountll(beq & ltm);
                    const bool sel = valid && ((key > dhi[z]) || (eq && rk < need[z])); run_eq[z] += __builtin_popcountll(beq);
                    const unsigned long long bs = __ballot(sel);
                    if (lane == it) mine[z] = bs; } }
#pragma unroll
            for (int z = 0; z < 2; ++z) *(GAS v2u*)(mrow[z] + 2 * lane) = (v2u){(unsigned)mine[z], (unsigned)(mine[z] >> 32)};
        }
        __syncthreads();
    }
}

__device__ __forceinline__ void attn_task(const bf16* H, const bf16* KH, const bf16* VT, const unsigned* MASK, bf16* YM, int b, int hh, int t0, int lane) {
    const int r32 = lane & 31, hf = lane >> 5;
    const float LOG2E = 1.4426950408889634f; const float c1 = 0.125f * LOG2E; const float sl2 = exp2f(-(float)(hh + 1)) * LOG2E;
    const size_t mb = (size_t)b * T;
    bf16x8 qf[4];
#pragma unroll
    for (int k = 0; k < 4; ++k) qf[k] = *(const GAS bf16x8*)(H + (mb + t0 + r32) * D_INP + C_AQ + hh * 64 + 16 * k + 8 * hf);
    const bf16* kbase = KH + ((size_t)(b * 8 + hh) * T) * 64; const bf16* vbase = VT + ((size_t)(b * 512 + hh * 64)) * T; const unsigned* mrow = MASK + (mb + t0 + r32) * 128;
    float m_run = -1e30f, l = 0.f;
    f32x16 O0 = {0.f, 0.f, 0.f, 0.f, 0.f, 0.f, 0.f, 0.f, 0.f, 0.f, 0.f, 0.f, 0.f, 0.f, 0.f, 0.f}, O1 = O0;
    const int nkt = (t0 + 32 + 63) >> 6;
    for (int kt = 0; kt < nkt; ++kt) {
        const int s0 = kt * 64;
        bf16x8 kf[2][4];
#pragma unroll
        for (int uu = 0; uu < 2; ++uu)
#pragma unroll
            for (int k = 0; k < 4; ++k) kf[uu][k] = *(const GAS bf16x8*)(kbase + (size_t)(s0 + 32 * uu + r32) * 64 + 16 * k + 8 * hf);
        const v2u mw = *(const GAS v2u*)(mrow + 2 * kt);
        s16x4 vl[2][2][2], vh[2][2][2];
#pragma unroll
        for (int uu = 0; uu < 2; ++uu)
#pragma unroll
            for (int sp = 0; sp < 2; ++sp)
#pragma unroll
                for (int dt = 0; dt < 2; ++dt) { const bf16* vp = vbase + (size_t)(dt * 32 + r32) * T + s0 + 32 * uu + 16 * sp + 4 * hf;
                    vl[uu][sp][dt] = *(const GAS s16x4*)vp; vh[uu][sp][dt] = *(const GAS s16x4*)(vp + 8); }
        f32x16 a0 = {0.f, 0.f, 0.f, 0.f, 0.f, 0.f, 0.f, 0.f, 0.f, 0.f, 0.f, 0.f, 0.f, 0.f, 0.f, 0.f}, a1 = a0;
#pragma unroll
        for (int k = 0; k < 4; ++k) { a0 = __builtin_amdgcn_mfma_f32_32x32x16_bf16(kf[0][k], qf[k], a0, 0, 0, 0); a1 = __builtin_amdgcn_mfma_f32_32x32x16_bf16(kf[1][k], qf[k], a1, 0, 0, 0); }
        const float dist0 = (float)(t0 + r32 - s0 - 4 * hf);
        const unsigned m0 = mw.x >> (4 * hf), m1 = mw.y >> (4 * hf);
        float mx = -1e30f;
#pragma unroll
        for (int r = 0; r < 16; ++r) { const int ko = (r & 3) + 8 * (r >> 2);
            const float d0 = dist0 - (float)ko;
            a0[r] = ((m0 >> ko) & 1u) ? (a0[r] * c1 - sl2 * d0) : -1e30f;
            a1[r] = ((m1 >> ko) & 1u) ? (a1[r] * c1 - sl2 * (d0 - 32.f)) : -1e30f;
            mx = fmaxf(mx, fmaxf(a0[r], a1[r])); }
        mx = fmaxf(mx, __shfl_xor(mx, 32));
        const float m_new = fmaxf(m_run, mx); const float alpha = __builtin_amdgcn_exp2f(m_run - m_new); m_run = m_new;
        float ps = 0.f;
#pragma unroll
        for (int r = 0; r < 16; ++r) { const int ko = (r & 3) + 8 * (r >> 2);
            const float p0 = ((m0 >> ko) & 1u) ? __builtin_amdgcn_exp2f(a0[r] - m_new) : 0.f;
            const float p1 = ((m1 >> ko) & 1u) ? __builtin_amdgcn_exp2f(a1[r] - m_new) : 0.f;
            a0[r] = p0; a1[r] = p1; ps += p0 + p1; }
        l = l * alpha + ps;
#pragma unroll
        for (int r = 0; r < 16; ++r) { O0[r] *= alpha; O1[r] *= alpha; }
#pragma unroll
        for (int sp = 0; sp < 2; ++sp) {
            const bf16x8 pb0 = pack8(a0, 8 * sp), pb1 = pack8(a1, 8 * sp);
#define VFR(uu, dt) ((bf16x8){vl[uu][sp][dt][0], vl[uu][sp][dt][1], vl[uu][sp][dt][2], vl[uu][sp][dt][3], vh[uu][sp][dt][0], vh[uu][sp][dt][1], vh[uu][sp][dt][2], vh[uu][sp][dt][3]})
            O0 = __builtin_amdgcn_mfma_f32_32x32x16_bf16(VFR(0, 0), pb0, O0, 0, 0, 0);
            O1 = __builtin_amdgcn_mfma_f32_32x32x16_bf16(VFR(0, 1), pb0, O1, 0, 0, 0);
            O0 = __builtin_amdgcn_mfma_f32_32x32x16_bf16(VFR(1, 0), pb1, O0, 0, 0, 0);
            O1 = __builtin_amdgcn_mfma_f32_32x32x16_bf16(VFR(1, 1), pb1, O1, 0, 0, 0);
#undef VFR
        }
    }
    l += __shfl_xor(l, 32);
    const float inv = 1.f / l;
    bf16* yp = YM + (mb + t0 + r32) * D + hh * 64 + 4 * hf;
#pragma unroll
    for (int rq = 0; rq < 4; ++rq) {
        v2u o; o.x = cvtpk(O0[4 * rq] * inv, O0[4 * rq + 1] * inv); o.y = cvtpk(O0[4 * rq + 2] * inv, O0[4 * rq + 3] * inv); *(GAS v2u*)(yp + 8 * rq) = o;
        v2u o2; o2.x = cvtpk(O1[4 * rq] * inv, O1[4 * rq + 1] * inv); o2.y = cvtpk(O1[4 * rq + 2] * inv, O1[4 * rq + 3] * inv); *(GAS v2u*)(yp + 32 + 8 * rq) = o2; }
}
__device__ __forceinline__ void p4_attention(const Params& P, const Ctx& C) {
    unsigned char* ws = P.ws;
    const bf16* H = (const bf16*)(ws + WS_H); const bf16* KH = (const bf16*)(ws + WS_K); const bf16* VT = (const bf16*)(ws + WS_VT); const unsigned* MASK = (const unsigned*)(ws + WS_MASK); bf16* YM = (bf16*)(ws + WS_YMIX);
    for (int p = blockIdx.x; p < 512; p += C.G) {
        const int bh = p >> 3, j = p & 7; const int b = bh >> 3, hh = bh & 7;
        attn_task(H, KH, VT, MASK, YM, b, hh, j * 256 + C.wave * 32, C.lane);
        attn_task(H, KH, VT, MASK, YM, b, hh, (15 - j) * 256 + (7 - C.wave) * 32, C.lane);
    }
}

constexpr int AT_KB = 64 * 144, AT_VB = 64 * 136, AT_VOFF = 2 * AT_KB;
__device__ __forceinline__ void attn_block(const Ctx& C, const bf16* H, const bf16* KH, const bf16* VT, const unsigned* MASK, bf16* YM, int b, int hh, int qb) {
    const int lane = C.lane, r32 = lane & 31, hf = lane >> 5, tid = C.tid;
    const float LOG2E = 1.4426950408889634f; const float c1 = 0.125f * LOG2E; const float sl2 = exp2f(-(float)(hh + 1)) * LOG2E;
    const size_t mb = (size_t)b * T; const int t0 = qb * 256 + C.wave * 32;
    bf16x8 qf[4];
#pragma unroll
    for (int k = 0; k < 4; ++k) { const v4u w = *(const GAS v4u*)(H + (mb + t0 + r32) * D_INP + C_AQ + hh * 64 + 16 * k + 8 * hf);
        v4u o; o.x = cvtpk(bflo(w.x) * c1, bfhi(w.x) * c1); o.y = cvtpk(bflo(w.y) * c1, bfhi(w.y) * c1); o.z = cvtpk(bflo(w.z) * c1, bfhi(w.z) * c1); o.w = cvtpk(bflo(w.w) * c1, bfhi(w.w) * c1);
        qf[k] = __builtin_bit_cast(bf16x8, o); }
    const bf16* kbase = KH + ((size_t)(b * 8 + hh) * T) * 64; const bf16* vbase = VT + ((size_t)(b * 512 + hh * 64)) * T; const unsigned* mrow = MASK + (mb + t0 + r32) * 128;
    const int srow = tid >> 3, sch = tid & 7;
    const bf16* kst = kbase + (size_t)srow * 64 + 8 * sch; const bf16* vst = vbase + (size_t)srow * T + 8 * sch;
    LAS unsigned char* kw = C.lds + srow * 144 + 16 * sch; LAS unsigned char* vw = C.lds + AT_VOFF + srow * 136 + 16 * sch;
    const LAS unsigned char* kr = C.lds + r32 * 144 + 16 * hf; const LAS unsigned char* vr = C.lds + AT_VOFF + r32 * 136 + 8 * hf;
    float m_run = -1e30f, l = 0.f;
    f32x16 O0 = {0.f, 0.f, 0.f, 0.f, 0.f, 0.f, 0.f, 0.f, 0.f, 0.f, 0.f, 0.f, 0.f, 0.f, 0.f, 0.f}, O1 = O0;
    f32x16 bias0, bias1;
#pragma unroll
    for (int r = 0; r < 16; ++r) { const float ko = (float)((r & 3) + 8 * (r >> 2) + 4 * hf - t0 - r32); bias0[r] = sl2 * ko; bias1[r] = sl2 * (ko + 32.f); }
    const int nkt = 4 * (qb + 1), ktw = (t0 + 31) >> 6;
    v4u kn = *(const GAS v4u*)kst, vn = *(const GAS v4u*)vst; v2u mwn = *(const GAS v2u*)mrow;
    *(LAS v4u*)kw = kn; *(LAS v2u*)vw = (v2u){vn.x, vn.y}; *(LAS v2u*)(vw + 8) = (v2u){vn.z, vn.w};
    __syncthreads();
    for (int kt = 0; kt < nkt; ++kt) {
        const int s0 = kt * 64; const int cur = kt & 1; const v2u mw = mwn;
        if (kt + 1 < nkt) { kn = *(const GAS v4u*)(kst + (size_t)(s0 + 64) * 64); vn = *(const GAS v4u*)(vst + s0 + 64); mwn = *(const GAS v2u*)(mrow + 2 * kt + 2); }
        if (kt <= ktw) {
            const LAS unsigned char* kc = kr + cur * AT_KB; const LAS unsigned char* vc = vr + cur * AT_VB;
            const float sh = sl2 * (float)s0;
            f32x16 a0, a1;
#pragma unroll
            for (int k = 0; k < 4; ++k) { const bf16x8 k0 = *(const LAS bf16x8*)(kc + 32 * k), k1 = *(const LAS bf16x8*)(kc + 32 * 144 + 32 * k);
                a0 = __builtin_amdgcn_mfma_f32_32x32x16_bf16(k0, qf[k], k == 0 ? bias0 : a0, 0, 0, 0); a1 = __builtin_amdgcn_mfma_f32_32x32x16_bf16(k1, qf[k], k == 0 ? bias1 : a1, 0, 0, 0); }
            const unsigned m0 = mw.x >> (4 * hf), m1 = mw.y >> (4 * hf);
            float mx = -1e30f;
#pragma unroll
            for (int r = 0; r < 16; ++r) { const int ko = (r & 3) + 8 * (r >> 2);
                const unsigned k0m = (unsigned)__builtin_amdgcn_sbfe((int)m0, ko, 1), k1m = (unsigned)__builtin_amdgcn_sbfe((int)m1, ko, 1);
                const float x0 = a0[r], x1 = a1[r];
                a0[r] = __builtin_bit_cast(float, (__builtin_bit_cast(unsigned, x0) & k0m) | (0xf149f2cau & ~k0m));
                a1[r] = __builtin_bit_cast(float, (__builtin_bit_cast(unsigned, x1) & k1m) | (0xf149f2cau & ~k1m));
                mx = fmaxf(mx, fmaxf(a0[r], a1[r])); }
            mx = fmaxf(mx, __shfl_xor(mx, 32));
            const float m_new = fmaxf(m_run, mx + sh);
            const float m_use = fmaxf(m_new, -1e20f) - sh;
            float ps = 0.f;
#pragma unroll
            for (int r = 0; r < 16; ++r) { const float p0 = __builtin_amdgcn_exp2f(a0[r] - m_use), p1 = __builtin_amdgcn_exp2f(a1[r] - m_use); a0[r] = p0; a1[r] = p1; ps += p0 + p1; }
            if (__builtin_amdgcn_ballot_w64(m_new != m_run) != 0ull) {
                const float alpha = __builtin_amdgcn_exp2f(m_run - m_new); m_run = m_new;
                l *= alpha;
#pragma unroll
                for (int r = 0; r < 16; ++r) { O0[r] *= alpha; O1[r] *= alpha; }
            }
            l += ps;
#pragma unroll
            for (int sp = 0; sp < 2; ++sp) {
                const bf16x8 pb0 = pack8(a0, 8 * sp), pb1 = pack8(a1, 8 * sp);
#define VLD(uu, dt) ({ const s16x4 lo_ = *(const LAS s16x4*)(vc + (dt) * 32 * 136 + 2 * (32 * (uu) + 16 * sp)), hi_ = *(const LAS s16x4*)(vc + (dt) * 32 * 136 + 2 * (32 * (uu) + 16 * sp + 8)); (bf16x8){lo_[0], lo_[1], lo_[2], lo_[3], hi_[0], hi_[1], hi_[2], hi_[3]}; })
                O0 = __builtin_amdgcn_mfma_f32_32x32x16_bf16(VLD(0, 0), pb0, O0, 0, 0, 0);
                O1 = __builtin_amdgcn_mfma_f32_32x32x16_bf16(VLD(0, 1), pb0, O1, 0, 0, 0);
                O0 = __builtin_amdgcn_mfma_f32_32x32x16_bf16(VLD(1, 0), pb1, O0, 0, 0, 0);
                O1 = __builtin_amdgcn_mfma_f32_32x32x16_bf16(VLD(1, 1), pb1, O1, 0, 0, 0);
#undef VLD
            }
        }
        if (kt + 1 < nkt) { const int nx = cur ^ 1; *(LAS v4u*)(kw + nx * AT_KB) = kn; *(LAS v2u*)(vw + nx * AT_VB) = (v2u){vn.x, vn.y}; *(LAS v2u*)(vw + nx * AT_VB + 8) = (v2u){vn.z, vn.w}; }
        __syncthreads();
    }
    l += __shfl_xor(l, 32);
    const float inv = __builtin_amdgcn_rcpf(l);
    unsigned char* yp = (unsigned char*)YM + (mb + t0 + r32) * D + hh * 64 + 4 * hf;
    const float i8 = inv * 8.f;
#pragma unroll
    for (int rq = 0; rq < 4; ++rq) {
        *(GAS unsigned*)(yp + 8 * rq) = pk4_fp8(O0[4 * rq] * i8, O0[4 * rq + 1] * i8, O0[4 * rq + 2] * i8, O0[4 * rq + 3] * i8);
        *(GAS unsigned*)(yp + 32 + 8 * rq) = pk4_fp8(O1[4 * rq] * i8, O1[4 * rq + 1] * i8, O1[4 * rq + 2] * i8, O1[4 * rq + 3] * i8); }
}
__device__ __forceinline__ void p4_attention2(const Params& P, const Ctx& C) {
    unsigned char* ws = P.ws;
    const bf16* H = (const bf16*)(ws + WS_H); const bf16* KH = (const bf16*)(ws + WS_K); const bf16* VT = (const bf16*)(ws + WS_VT); const unsigned* MASK = (const unsigned*)(ws + WS_MASK); bf16* YM = (bf16*)(ws + WS_YMIX);
    for (int p = blockIdx.x; p < 512; p += C.G) {
        const int b = p & 7, q = p >> 3; const int hh = q >> 3, j = q & 7;
        attn_block(C, H, KH, VT, MASK, YM, b, hh, j);
        attn_block(C, H, KH, VT, MASK, YM, b, hh, 15 - j);
    }
}


#ifndef FEAT_MIX
#define FEAT_MIX 1
#endif
#ifndef FEAT_MOE
#define FEAT_MOE 1
#endif
#ifndef FEAT_PLE
#define FEAT_PLE 1
#endif
#ifndef FEAT_ATT
#define FEAT_ATT 1
#endif

template <bool PUBLISH = true> __device__ __forceinline__ void p6_ln1_router(const Params& P, const Ctx& C) {
    unsigned char* ws = P.ws;
    bf16* X1 = (bf16*)(ws + WS_X1); unsigned char* XB = ws + WS_XB;
    LAS float* wl = (LAS float*)C.lds;
    LAS int* hist = (LAS int*)(C.lds + MISC_OFF);
    { const float* wrt = (const float*)(ws + WS_WRT);
      for (int i = C.tid; i < 32 * 1024 / 4; i += NTHR) *(LAS f32x4*)(wl + 4 * i) = *(const GAS f32x4*)(wrt + 4 * i);
      if (C.tid < 32) hist[C.tid] = 0; }
    __syncthreads();
    int* tope = (int*)(ws + WS_TOPE); float* gate = (float*)(ws + WS_GATE); int* lrank = (int*)(ws + WS_LRANK);
    const bf16* src = (const bf16*)P.out;
    const int lane = C.lane, hf = lane >> 5, ex = lane & 31;
    const float brl = P.in[I_BR][ex];
    for (int m0 = 2 * C.gw; m0 < NTOK; m0 += 2 * C.ngw) {
        f32x4 va[4], vb[4]; load_row_bf16(va, src + (size_t)m0 * D, lane); load_row_bf16(vb, src + (size_t)(m0 + 1) * D, lane);
        ln_row(va, P.in[I_LNMG], P.in[I_LNMB], lane); ln_row(vb, P.in[I_LNMG], P.in[I_LNMB], lane);
        store_row_bf16(X1 + (size_t)m0 * D, va, lane); store_row_bf16(X1 + (size_t)(m0 + 1) * D, vb, lane);
        store_row_fp8x8(XB + (size_t)m0 * D, va, lane); store_row_fp8x8(XB + (size_t)(m0 + 1) * D, vb, lane);
        float v[32];
#pragma unroll
        for (int e = 0; e < 32; ++e) { float pa = 0.f, pb = 0.f;
#pragma unroll
            for (int j = 0; j < 4; ++j) { const f32x4 w = *(const LAS f32x4*)(wl + e * 1024 + 4 * lane + 256 * j);
                pa += (va[j][0] * w[0] + va[j][1] * w[1]) + (va[j][2] * w[2] + va[j][3] * w[3]); pb += (vb[j][0] * w[0] + vb[j][1] * w[1]) + (vb[j][2] * w[2] + vb[j][3] * w[3]); }
            const float keep = hf ? pb : pa, send = hf ? pa : pb; v[e] = keep + __shfl_xor(send, 32); }
#define HALVE(M, CNT) { const bool up_ = (lane & (M)) != 0; _Pragma("unroll") for (int i_ = 0; i_ < (CNT) / 2; ++i_) { const float k_ = up_ ? v[i_ + (CNT) / 2] : v[i_], s_ = up_ ? v[i_] : v[i_ + (CNT) / 2]; v[i_] = k_ + __shfl_xor(s_, (M)); } }
        HALVE(16, 32) HALVE(8, 16) HALVE(4, 8) HALVE(2, 4) HALVE(1, 2)
#undef HALVE
        float lg = v[0] + brl;
        int se[4]; float sv[4];
#pragma unroll
        for (int k = 0; k < 4; ++k) { float bv = lg; int bi = ex;
#pragma unroll
            for (int o = 1; o < 32; o <<= 1) { const float ov = __shfl_xor(bv, o); const int oi = __shfl_xor(bi, o); const bool take = (ov > bv) || (ov == bv && oi < bi); bv = take ? ov : bv; bi = take ? oi : bi; }
            se[k] = bi; sv[k] = bv; if (ex == bi) lg = -INFINITY; }
        float exv[4], sum = 0.f;
#pragma unroll
        for (int k = 0; k < 4; ++k) { exv[k] = __expf(sv[k] - sv[0]); sum += exv[k]; }
        const float inv = 1.f / sum;
        if (ex == 0) { const int m = m0 + hf;
#pragma unroll
            for (int k = 0; k < 4; ++k) { const int lr = atomicAdd((int*)&hist[se[k]], 1); tope[m * 4 + k] = se[k]; gate[m * 4 + k] = exv[k] * inv; lrank[m * 4 + k] = lr; } }
    }
    __syncthreads();
    if (PUBLISH && C.tid < 32) { unsigned* cnt = (unsigned*)(ws + WS_CTL) + CW_CNT; const int base = (int)atomicAdd(cnt + C.tid, (unsigned)hist[C.tid]); ((int*)(ws + WS_WGBASE))[blockIdx.x * 32 + C.tid] = base; }
}

__device__ __forceinline__ void p7_dispatch(const Params& P, const Ctx& C) {
    unsigned char* ws = P.ws;
    LAS int* ps = (LAS int*)(C.lds + MISC_OFF + 256);
    const unsigned* cnt = (const unsigned*)(ws + WS_CTL) + CW_CNT;
    int* tile_e = (int*)(ws + WS_TILEE);
    LAS int* pe = (LAS int*)(C.lds + MISC_OFF + 512);
    if (C.tid < 64) { const int e = C.tid & 31; const int c = (int)__hip_atomic_load(cnt + e, __ATOMIC_RELAXED, __HIP_MEMORY_SCOPE_AGENT); const int nt = (c + 255) >> 8; int inc = nt;
#pragma unroll
        for (int o = 1; o < 32; o <<= 1) { const int v = __shfl_up(inc, o); if ((C.tid & 31) >= o) inc += v; }
        if (C.tid < 32) { ps[e] = (inc - nt) << 8; pe[e] = inc; } }
    __syncthreads();
    if (blockIdx.x == 0) { const int ntot = pe[31];
        for (int t = C.tid; t < ntot; t += NTHR) { int e = 0;
#pragma unroll
            for (int q = 0; q < 31; ++q) e += (t >= pe[q]) ? 1 : 0;
            tile_e[t] = e; }
        if (C.tid == 0) tile_e[MAXTILES] = ntot; }
    int* slottok = (int*)(ws + WS_SLOTTOK);
    if (blockIdx.x < NE) { const int e = blockIdx.x; const int c = (int)__hip_atomic_load(cnt + e, __ATOMIC_RELAXED, __HIP_MEMORY_SCOPE_AGENT); const int endp = pe[e] << 8;
        for (int s_ = ps[e] + c + C.tid; s_ < endp; s_ += NTHR) slottok[s_] = 0; }
    const int* tope = (const int*)(ws + WS_TOPE); const float* gate = (const float*)(ws + WS_GATE); const int* lrank = (const int*)(ws + WS_LRANK);
    const int* wgb = (const int*)(ws + WS_WGBASE);
    int* tokslot = (int*)(ws + WS_TOKSLOT); float* slotgate = (float*)(ws + WS_SLOTGATE);
    for (int a = (C.gw * 64 + C.lane); a < NASSIGN; a += C.ngw * 64) { const int m = a >> 2; const int wgm = ((m >> 1) % C.ngw) >> 3;
        const int e = tope[a]; const int slot = ps[e] + wgb[wgm * 32 + e] + lrank[a];
        slottok[slot] = m; slotgate[slot] = gate[a]; tokslot[a] = slot; }
}

__device__ __forceinline__ void p10_combine_ln2(const Params& P, const Ctx& C) {
    unsigned char* ws = P.ws;
    const bf16* X1 = (const bf16*)(ws + WS_X1); bf16* XB = (bf16*)(ws + WS_XB); bf16* X2 = (bf16*)P.out;
    const int* tokslot = (const int*)(ws + WS_TOKSLOT); const unsigned char* ys = ws + WS_YSLOT;
    for (int m = C.gw; m < NTOK; m += C.ngw) {
        f32x4 v[4]; load_row_bf16(v, X1 + (size_t)m * D, C.lane);
#pragma unroll
        for (int j = 0; j < 4; ++j) v[j] = v[j] * ALPHA;
#if FEAT_MOE
        f32x4 fs[4] = {{0.f, 0.f, 0.f, 0.f}, {0.f, 0.f, 0.f, 0.f}, {0.f, 0.f, 0.f, 0.f}, {0.f, 0.f, 0.f, 0.f}};
#pragma unroll
        for (int k = 0; k < 4; ++k) { const int slot = tokslot[m * 4 + k]; const unsigned char* yr = ys + (size_t)slot * D;
#pragma unroll
            for (int j = 0; j < 4; ++j) fs[j] = fs[j] + fp8x4_to_f32(*(const GAS unsigned*)(yr + 4 * C.lane + 256 * j)); }
#pragma unroll
        for (int j = 0; j < 4; ++j) v[j] = v[j] + fs[j] * (1.f / 64.f);
#endif
        ln_row(v, P.in[I_LNFG], P.in[I_LNFB], C.lane);
        store_row_bf16(X2 + (size_t)m * D, v, C.lane);
        store_row_fp8x8((unsigned char*)XB + (size_t)m * D, v, C.lane);
    }
}

__device__ __forceinline__ void p12_final_ln(const Params& P, const Ctx& C) {
    const bf16* src = (const bf16*)(P.ws + WS_X1);
    for (int m = C.gw; m < NTOK; m += C.ngw) {
        f32x4 v[4]; load_row_bf16(v, src + (size_t)m * D, C.lane);
        ln_row(v, P.in[I_LNPG], P.in[I_LNPB], C.lane);
        store_row_f32(P.out + (size_t)m * D, v, C.lane);
    }
}
#define XB_TMO      128
#define XB_XCNT(j)  (256  + 64 * (j))
#define XB_XSUB(j)  (1280 + 64 * (j))
#define XB_XGEN(j)  (2304 + 64 * (j))
#define XB_TOP      3328
#define XB_TOPGEN   3392
#define XCD_BAR_WORDS 3456
#define XB_SPIN_CAP (1u << 18)
#define LAS __attribute__((address_space(3)))

__device__ __forceinline__ unsigned xb_ld(unsigned* p)              { return __hip_atomic_load(p, __ATOMIC_RELAXED, __HIP_MEMORY_SCOPE_AGENT); }
__device__ __forceinline__ unsigned xb_add(unsigned* p, unsigned v) { return __hip_atomic_fetch_add(p, v, __ATOMIC_RELAXED, __HIP_MEMORY_SCOPE_AGENT); }
__device__ __forceinline__ unsigned xb_xcc_id() { return (unsigned)__builtin_amdgcn_s_getreg((3 << 11) | 20) & 0xFu; }
#define XB_SPIN(cond, bar) do { unsigned _sp = 0; while (cond) { __builtin_amdgcn_s_sleep(1); \
    if ((++_sp & 255u) == 0u) { if (xb_ld(&(bar)[XB_TMO])) break; if (_sp > XB_SPIN_CAP) { atomicAdd(&(bar)[XB_TMO], 1u); break; } } } } while (0)

struct XcdBarrier {
    unsigned* bar; unsigned x;
    volatile LAS unsigned* st;
};

__device__ __forceinline__ XcdBarrier xcd_barrier_post(unsigned* bar, volatile LAS unsigned* st) {
    XcdBarrier b; b.bar = bar; b.x = xb_xcc_id(); b.st = st;
    if (threadIdx.x == 0) (void)xb_add(&bar[XB_XCNT(b.x)], 1u);
    return b;
}
__device__ __forceinline__ void xcd_barrier_complete(unsigned* bar, unsigned x, unsigned& nloc, unsigned& nx) {
    const unsigned G = gridDim.x * gridDim.y * gridDim.z;
    unsigned sum, cnt, mine, sp = 0u;
    for (;;) {
        sum = 0u; cnt = 0u; mine = 0u;
#pragma unroll
        for (unsigned j = 0; j < 16; ++j) { const unsigned c = xb_ld(&bar[XB_XCNT(j)]); sum += c; cnt += (c > 0u) ? 1u : 0u; mine = (j == x) ? c : mine; }
        if (sum == G) break;
        __builtin_amdgcn_s_sleep(1);
        if ((++sp & 255u) == 0u) { if (xb_ld(&bar[XB_TMO])) break; if (sp > XB_SPIN_CAP) { atomicAdd(&bar[XB_TMO], 1u); break; } }
    }
    nloc = mine > 0u ? mine : 1u; nx = cnt > 0u ? cnt : 1u;
}

__device__ __forceinline__ void xcd_barrier(const XcdBarrier& b) {
    asm volatile("s_waitcnt vmcnt(0)" ::: "memory");
    __syncthreads();
    if (threadIdx.x == 0) {
        unsigned* bar = b.bar;
        __builtin_amdgcn_s_waitcnt(0);
        unsigned nloc = b.st[0], nx = b.st[1];
        if (nloc == 0u) { xcd_barrier_complete(bar, b.x, nloc, nx); b.st[0] = nloc; b.st[1] = nx; }
        const unsigned old = xb_add(&bar[XB_XSUB(b.x)], 1u);
        const unsigned gen = old / nloc;
        if (old + 1u == (gen + 1u) * nloc) {
            __builtin_amdgcn_fence(__ATOMIC_RELEASE, "agent");
            asm volatile("s_waitcnt vmcnt(0)" ::: "memory");
            const unsigned og = xb_add(&bar[XB_TOP], 1u);
            const unsigned tg = og / nx;
            if (og + 1u == (tg + 1u) * nx) xb_add(&bar[XB_TOPGEN], 1u);
            else XB_SPIN(xb_ld(&bar[XB_TOPGEN]) == tg, bar);
            __builtin_amdgcn_fence(__ATOMIC_ACQUIRE, "agent");
            xb_add(&bar[XB_XGEN(b.x)], 1u);
            asm volatile("s_waitcnt vmcnt(0)" ::: "memory");
        } else {
            XB_SPIN(xb_ld(&bar[XB_XGEN(b.x)]) == gen, bar);
            __builtin_amdgcn_fence(__ATOMIC_ACQUIRE, "agent");
            asm volatile("s_waitcnt vmcnt(0)" ::: "memory");
        }
    }
    __syncthreads();
}


template <int PH> __device__ __forceinline__ void run_phase(const Params& P, const Ctx& C) {
    unsigned char* ws = P.ws;
    typedef pg8::bf16_t pbf;
    if constexpr (PH == 0) { p0_prologue(P, C); }
    else if constexpr (PH == 10) {
        pg8::Gemm g{(const pbf*)(ws + WS_XBF), (const pbf*)(ws + WS_WIN_T), NTOK, D_INP, D}; pg8::StaticOrder S; S.init(NTOK, D_INP, C.G, (int)blockIdx.x);
        pg8::EpiBf16s E{(pbf*)(ws + WS_H), D_INP};
        pg8::gemm_phase<pg8::EpiBf16s, pg8::StaticOrder, true, true>(C.lds, g, S, E); }
    else if constexpr (PH == 11) {
        pg8::Gemm g{(const pbf*)(ws + WS_PB), (const pbf*)(ws + WS_WPROJ_T), NTOK, D, PLE}; pg8::StaticOrder S; S.init(NTOK, D, C.G, (int)blockIdx.x);
        pg8::EpiBf16s E{(pbf*)(ws + WS_PROJ), D};
        pg8::gemm_phase<pg8::EpiBf16s, pg8::StaticOrder, true, true>(C.lds, g, S, E); }
    else if constexpr (PH == 20) { p2_post(P, C); }
    else if constexpr (PH == 21) { p2_hgrn_prep(P, C); }
    else if constexpr (PH == 30) {
        { pg8::Gemm g{(const pbf*)(ws + WS_CN), (const pbf*)(ws + WS_WUK_T), NTOK, 512, 256}; pg8::StaticOrder S; S.init(NTOK, 512, C.G, (int)blockIdx.x);
          pg8::EpiKhead E{(pbf*)(ws + WS_K)};
          pg8::gemm_phase<pg8::EpiKhead, pg8::StaticOrder, true, true>(C.lds, g, S, E); }
        { pg8::Gemm g{(const pbf*)(ws + WS_WUV_T), (const pbf*)(ws + WS_CN), 512, NTOK, 256}; pg8::StaticOrder S; S.init(512, NTOK, C.G, (int)blockIdx.x);
          pg8::EpiVt E{(pbf*)(ws + WS_VT)};
          pg8::gemm_phase<pg8::EpiVt, pg8::StaticOrder, true, true>(C.lds, g, S, E); }
    }
    else if constexpr (PH == 31) { p3_indexer(P, C); }
    else if constexpr (PH == 32) { p3_scan_convert(P, C); }
    else if constexpr (PH == 40) { p4_attention2(P, C); }
    else if constexpr (PH == 41) { p4_yrec(P, C); }
    else if constexpr (PH == 5) {
        pg8::Gemm g{(const pbf*)(ws + WS_YMIX), (const pbf*)(ws + WS_WO_T), NTOK, D, D / 2}; pg8::StaticOrder S; S.init(NTOK, D, C.G, (int)blockIdx.x);
        pg8::EpiResid E{(const pbf*)(ws + WS_XBF), (pbf*)P.out, D, ALPHA, 1.f / 512.f};
        pg8::gemm_phase<pg8::EpiResid, pg8::StaticOrder, true, true, 1>(C.lds, g, S, E);
    }
    else if constexpr (PH == 6) { p6_ln1_router<true>(P, C); }
    else if constexpr (PH == 60) { p6_ln1_router<false>(P, C); }
    else if constexpr (PH == 7) { p7_dispatch(P, C); }
    else if constexpr (PH == 8) {
        const int* tile_e = (const int*)(ws + WS_TILEE);
        pg8::Gemm g{(const pbf*)(ws + WS_XB), (const pbf*)(ws + WS_WUP_T), CAP, NE * 2048, D / 2, (const int*)(ws + WS_SLOTTOK)};
        pg8::MoeOrder S{tile_e, tile_e[MAXTILES], 8, C.G, (int)blockIdx.x};
        pg8::EpiSwiglu E{ws + WS_HH, P.in[I_BUP]};
        pg8::gemm_phase<pg8::EpiSwiglu, pg8::MoeOrder, true, true, 1, 124, 121, true>(C.lds, g, S, E);
    }
    else if constexpr (PH == 9) {
        const int* tile_e = (const int*)(ws + WS_TILEE);
        pg8::Gemm g{(const pbf*)(ws + WS_HH), (const pbf*)(ws + WS_WDN_T), CAP, NE * 1024, DFF / 2};
        pg8::MoeOrder S{tile_e, tile_e[MAXTILES], 4, C.G, (int)blockIdx.x};
        pg8::EpiDown E{ws + WS_YSLOT, P.in[I_BDN], (const float*)(ws + WS_SLOTGATE)};
        pg8::gemm_phase<pg8::EpiDown, pg8::MoeOrder, true, true, 1, 125, 121>(C.lds, g, S, E);
    }
    else if constexpr (PH == 100) { p10_combine_ln2(P, C); }
    else if constexpr (PH == 110) {
        pg8::Gemm g{(const pbf*)(ws + WS_XB), (const pbf*)(ws + WS_WGATE_T), NTOK, D, D / 2}; pg8::StaticOrder S; S.init(NTOK, D, C.G, (int)blockIdx.x);
        pg8::EpiPle E{(const pbf*)P.out, (const pbf*)(ws + WS_PROJ), (pbf*)(ws + WS_X1), ALPHA, 1.f / 512.f};
        pg8::gemm_phase<pg8::EpiPle, pg8::StaticOrder, true, true, 1>(C.lds, g, S, E);
    }
    else { p12_final_ln(P, C); }
}
__global__ void __launch_bounds__(NTHR, 2) mega_fwd(Params P) {
    extern __shared__ __attribute__((aligned(16))) unsigned char lds_raw[];
#ifndef PLAIN_LAUNCH
    cg::grid_group grid = cg::this_grid();
#endif
#define MKCTX Ctx C; { int tid_ = threadIdx.x; asm volatile("" : "+v"(tid_)); C.lds = (LAS unsigned char*)lds_raw; C.tid = tid_; C.lane = tid_ & 63; C.wave = __builtin_amdgcn_readfirstlane(tid_ >> 6); \
      C.G = gridDim.x; C.gw = blockIdx.x * NWAVES + C.wave; C.ngw = C.G * NWAVES; }
#if SYNC_MODE != 0
    if (threadIdx.x < 4) ((LAS unsigned*)((LAS unsigned char*)lds_raw + XBW_OFF))[threadIdx.x] = 0u;
    __syncthreads();
    XcdBarrier bar = xcd_barrier_post((unsigned*)(P.ws + WS_CTL) + CW_BAR, (volatile LAS unsigned*)((LAS unsigned char*)lds_raw + XBW_OFF));
#define SY xcd_barrier(bar);
#else
#define SY grid.sync();
#endif
#ifdef PLAIN_LAUNCH
#define GS xcd_barrier(bar);
#else
#define GS grid.sync();
#endif
#define BS __syncthreads();
#define X(k) { MKCTX run_phase<k>(P, C); }
    PROGRAM
#undef X
#undef MKCTX
#undef SY
#undef GS
#undef BS
}

extern "C" void kernel_launch(void* const* d_in, const int* in_sizes, int n_in, void* d_out, int out_size, void* d_ws, size_t ws_size, hipStream_t stream) {
    static int grid = 0;
    if (grid == 0) {
        if (n_in != 25 || out_size != NTOK * D || ws_size < WS_END) { fprintf(stderr, "kernel_launch: unexpected shapes (n_in %d out %d ws %zu)\n", n_in, out_size, ws_size); grid = -1; return; }
        int dev = 0, cus = 0, per_cu = 0;
        if (hipGetDevice(&dev) != hipSuccess || hipDeviceGetAttribute(&cus, hipDeviceAttributeMultiprocessorCount, dev) != hipSuccess) { grid = -1; return; }
        if (hipFuncSetAttribute((const void*)mega_fwd, hipFuncAttributeMaxDynamicSharedMemorySize, LDS_BYTES) != hipSuccess) { fprintf(stderr, "kernel_launch: hipFuncSetAttribute failed\n"); grid = -1; return; }
        if (hipOccupancyMaxActiveBlocksPerMultiprocessor(&per_cu, (const void*)mega_fwd, NTHR, LDS_BYTES) != hipSuccess || per_cu < 1) { fprintf(stderr, "kernel_launch: occupancy query failed (%d)\n", per_cu); (void)hipGetLastError(); grid = -1; return; }
        grid = cus * per_cu;
        fprintf(stderr, "kernel_launch: grid %d (%d CUs x %d)\n", grid, cus, per_cu);
    }
    if (grid < 0) return;
    (void)hipMemsetAsync((char*)d_ws + WS_CTL, 0, CTL_ZERO_BYTES, stream);
    Params p{};
    for (int i = 0; i < 25; ++i) p.in[i] = (const float*)d_in[i];
    p.out = (float*)d_out; p.ws = (unsigned char*)d_ws;

    void* args[] = {&p};
#ifdef PLAIN_LAUNCH
    hipLaunchKernelGGL(mega_fwd, dim3(grid), dim3(NTHR), LDS_BYTES, stream, p); hipError_t e = hipPeekAtLastError(); (void)args;
#else
    hipError_t e = hipLaunchCooperativeKernel((const void*)mega_fwd, dim3(grid), dim3(NTHR), args, LDS_BYTES, stream);
#endif
    if (e != hipSuccess) fprintf(stderr, "kernel_launch: cooperative launch failed: %s (grid %d)\n", hipGetErrorString(e), grid);
}
```
